# Optimizing an MI355X kernel written in HIP

```python
import math
import jax
import jax.numpy as jnp
from jax import lax
import numpy as np


D_MODEL = 1024
BATCH = 4
SEQ = 8192
DEPTH = 4

GRID_W = 64
CTX_LEN = 256
N_EVEN = (DEPTH + 1) // 2
N_ODD = DEPTH // 2
N_MOD = 6
NORM_EPS = 1e-6
ROPE_BASE = 10000.0
Q_BLOCK = 128
NEG_INF = -1e30

A_GROUPS = 4
A_GROUP_DIM = 128
A_WIDTH = A_GROUPS * A_GROUP_DIM
CHUNK = 128
B_HEADS = 4
B_HEAD_DIM = 64
B_WIDTH = B_HEADS * 2 * B_HEAD_DIM
EVEN_IN = 2 * A_WIDTH + 3 * B_WIDTH
C_HEADS = 8
C_HEAD_DIM = 64
C_WIDTH = C_HEADS * C_HEAD_DIM
WIN_H = 8
WIN_W = 16
D_HEADS = 4
D_NOPE = 64
D_ROPE = 32
D_VDIM = 128
Q_LORA = 256
KV_LORA = 128
D_WIDTH = D_HEADS * D_VDIM
ODD_IN = 3 * C_WIDTH + Q_LORA + KV_LORA + D_ROPE
MIX_WIDTH = A_WIDTH + B_WIDTH
D_FF = 2816
N_EXPERTS = 8
TOP_K = 2
D_FF_EXPERT = 3584

kernel_name = 'hybrid_diffusion_trunk'


def rmsnorm(x, g):
    xf = x.astype(jnp.float32)
    y = xf * lax.rsqrt(jnp.mean(xf * xf, axis=-1, keepdims=True) + NORM_EPS)
    return (y * g.astype(jnp.float32)).astype(x.dtype)


def layernorm(x, g):
    xf = x.astype(jnp.float32)
    xc = xf - jnp.mean(xf, axis=-1, keepdims=True)
    y = xc * lax.rsqrt(jnp.mean(xc * xc, axis=-1, keepdims=True) + NORM_EPS)
    return (y * g.astype(jnp.float32)).astype(x.dtype)


def modulate(h, shift, scale):
    return h * (1 + scale) + shift


def axial_rope_tables(row, col, dim):
    n_freq = dim // 4
    inv = 1.0 / (ROPE_BASE ** (jnp.arange(n_freq, dtype=jnp.float32) / n_freq))
    ang = jnp.concatenate([row.astype(jnp.float32)[:, None] * inv, col.astype(jnp.float32)[:, None] * inv], axis=-1)
    return jnp.cos(ang), jnp.sin(ang)


def apply_rope(x, cos, sin):
    xf = x.astype(jnp.float32)
    x1, x2 = jnp.split(xf, 2, axis=-1)
    cs, sn = cos[None, :, None, :], sin[None, :, None, :]
    return jnp.concatenate([x1 * cs - x2 * sn, x2 * cs + x1 * sn], axis=-1).astype(x.dtype)


def blocked_attention(q, k, v, map_w, scale):
    bsz, s_len, heads, n_maps, dk = q.shape
    qb = jnp.moveaxis(q.reshape(bsz, s_len // Q_BLOCK, Q_BLOCK, heads, n_maps, dk), 1, 0)
    w = map_w.astype(jnp.float32)

    def one_block(qi):
        s = jnp.einsum('bqhmd,bkhmd->bhmqk', qi, k).astype(jnp.float32) * scale
        p = jnp.einsum('bhmqk,m->bhqk', jax.nn.softmax(s, axis=-1), w)
        return jnp.einsum('bhqk,bkhd->bqhd', p.astype(v.dtype), v)

    out = lax.map(one_block, qb)
    return jnp.moveaxis(out, 0, 1).reshape(bsz, s_len, heads, v.shape[-1])


def chunk_spatial_gating(a, w_s, b_s, g_v):
    u, v = jnp.split(a, 2, axis=-1)
    v = layernorm(v, g_v)
    bsz, s_len, _ = v.shape
    vc = v.reshape(bsz, s_len // CHUNK, CHUNK, A_GROUPS, A_GROUP_DIM)
    mixed = jnp.einsum('gpq,bcqgd->bcpgd', w_s, vc) + b_s.T[None, None, :, :, None]
    return u * mixed.reshape(bsz, s_len, A_WIDTH)


def neighbourhood_attention(q, k, v, k_ctx, v_ctx, rpb, scale):
    bsz, s_len, heads, d = q.shape
    rows = s_len // GRID_W
    kh = min(WIN_H, rows)
    r = jnp.arange(rows)
    row_start = jnp.clip(r - WIN_H // 2, 0, rows - kh)
    ridx = row_start[:, None] + jnp.arange(kh)[None, :]
    qg = q.reshape(bsz, rows, GRID_W, heads, d)
    kg = k.reshape(bsz, rows, GRID_W, heads, d)[:, ridx].reshape(bsz, rows, kh * GRID_W, heads, d)
    vg = v.reshape(bsz, rows, GRID_W, heads, d)[:, ridx].reshape(bsz, rows, kh * GRID_W, heads, d)
    cq = jnp.arange(GRID_W)
    col_start = jnp.clip(cq - WIN_W // 2, 0, GRID_W - WIN_W)
    in_win = (cq[None, :] >= col_start[:, None]) & (cq[None, :] < col_start[:, None] + WIN_W)
    ro = ridx - r[:, None] + (WIN_H - 1)
    co = jnp.clip(cq[None, :] - cq[:, None] + (WIN_W - 1), 0, 2 * WIN_W - 2)
    bias = rpb[:, ro[:, None, :, None], co[None, :, None, :]]
    bias = bias.astype(jnp.float32).reshape(heads, rows, GRID_W, kh * GRID_W)
    mask = jnp.broadcast_to(in_win[:, None, :], (GRID_W, kh, GRID_W)).reshape(GRID_W, kh * GRID_W)
    bias = jnp.where(mask, bias, NEG_INF)
    s_loc = jnp.einsum('brqhd,brkhd->bhrqk', qg, kg).astype(jnp.float32) * scale + bias[None]
    s_ctx = jnp.einsum('brqhd,bkhd->bhrqk', qg, k_ctx).astype(jnp.float32) * scale
    p = jax.nn.softmax(jnp.concatenate([s_loc, s_ctx], axis=-1), axis=-1)
    n_loc = kh * GRID_W
    o = (jnp.einsum('bhrqk,brkhd->brqhd', p[..., :n_loc].astype(v.dtype), vg)
         + jnp.einsum('bhrqk,bkhd->brqhd', p[..., n_loc:].astype(v.dtype), v_ctx))
    return o.reshape(bsz, s_len, heads, d)


def swiglu(h, w1, w3, w2):
    return (jax.nn.silu(h @ w1) * (h @ w3)) @ w2


def moe_swiglu(h, router_w, w1, w3, w2):
    logits = (h @ router_w).astype(jnp.float32)
    top_val, top_idx = lax.top_k(logits, TOP_K)
    gates = jax.nn.softmax(top_val, axis=-1)
    dense_gate = jnp.sum(jax.nn.one_hot(top_idx, N_EXPERTS, dtype=jnp.float32) * gates[..., None], axis=-2).astype(h.dtype)
    out = jnp.zeros_like(h)
    for e in range(N_EXPERTS):
        out = out + dense_gate[..., e:e + 1] * swiglu(h, w1[e], w3[e], w2[e])
    return out


def even_mixer(h, hc, layer, w_in, w_out, sgu_w, sgu_b, sgu_g, lq1, lk1, lq2, lk2, subln_g, rope, need_ctx):
    lam_init = 0.8 - 0.6 * math.exp(-0.3 * layer)
    lam = (jnp.exp(jnp.sum(lq1.astype(jnp.float32) * lk1.astype(jnp.float32)))
           - jnp.exp(jnp.sum(lq2.astype(jnp.float32) * lk2.astype(jnp.float32))) + lam_init)
    map_w = jnp.stack([jnp.ones_like(lam), -lam])
    scale = 1.0 / math.sqrt(B_HEAD_DIM)

    def qkv(p):
        bsz, s_len = p.shape[:2]
        q, k, v = jnp.split(p[..., 2 * A_WIDTH:], 3, axis=-1)
        return (q.reshape(bsz, s_len, 2 * B_HEADS, B_HEAD_DIM),
                k.reshape(bsz, s_len, 2 * B_HEADS, B_HEAD_DIM),
                v.reshape(bsz, s_len, B_HEADS, 2 * B_HEAD_DIM))

    def maps(t):
        return t.reshape(t.shape[0], t.shape[1], B_HEADS, 2, B_HEAD_DIM)

    def merge(p, q, k, v):
        o = rmsnorm(blocked_attention(maps(q), k, v, map_w, scale), subln_g) * (1 - lam_init)
        y_a = chunk_spatial_gating(jax.nn.gelu(p[..., :2 * A_WIDTH]), sgu_w, sgu_b, sgu_g)
        return jnp.concatenate([y_a, o.reshape(p.shape[0], p.shape[1], B_WIDTH)], axis=-1) @ w_out

    p, pc = h @ w_in, hc @ w_in
    q, k, v = qkv(p)
    qc, kc, vc = qkv(pc)
    cos, sin = rope
    q, k = apply_rope(q, cos, sin), apply_rope(k, cos, sin)
    k_all = jnp.concatenate([maps(kc), maps(k)], axis=1)
    v_all = jnp.concatenate([vc, v], axis=1)
    y = merge(p, q, k_all, v_all)
    yc = merge(pc, qc, maps(kc), vc) if need_ctx else None
    return y, yc


def odd_mixer(h, hc, w_in, w_out, rpb, gq, w_uq, gkv, w_ukv, rope, need_ctx):
    scale_c = 1.0 / math.sqrt(C_HEAD_DIM)
    scale_d = 1.0 / math.sqrt(D_NOPE + D_ROPE)
    one_map = jnp.ones((1,), jnp.float32)
    o_cq = 3 * C_WIDTH
    o_ckv = o_cq + Q_LORA
    o_kr = o_ckv + KV_LORA

    def na_qkv(p):
        bsz, s_len = p.shape[:2]
        q, k, v = jnp.split(p[..., :3 * C_WIDTH], 3, axis=-1)
        return (q.reshape(bsz, s_len, C_HEADS, C_HEAD_DIM), k.reshape(bsz, s_len, C_HEADS, C_HEAD_DIM),
                v.reshape(bsz, s_len, C_HEADS, C_HEAD_DIM))

    def mla_q(p):
        bsz, s_len = p.shape[:2]
        return (rmsnorm(p[..., o_cq:o_ckv], gq) @ w_uq).reshape(bsz, s_len, D_HEADS, D_NOPE + D_ROPE)

    def mla_kv(p):
        bsz, s_len = p.shape[:2]
        kv = (rmsnorm(p[..., o_ckv:o_kr], gkv) @ w_ukv).reshape(bsz, s_len, D_HEADS, D_NOPE + D_VDIM)
        return kv[..., :D_NOPE], kv[..., D_NOPE:], p[..., o_kr:][:, :, None, :]

    def mla_key(k_nope, k_rope):
        return jnp.concatenate([k_nope, jnp.broadcast_to(k_rope, k_nope.shape[:3] + (D_ROPE,))], axis=-1)

    def merge(o_c, o_d):
        bsz, s_len = o_c.shape[:2]
        return jnp.concatenate([o_c.reshape(bsz, s_len, C_WIDTH), o_d.reshape(bsz, s_len, D_WIDTH)], axis=-1) @ w_out

    p, pc = h @ w_in, hc @ w_in
    cos, sin = rope
    q_c, k_c, v_c = na_qkv(p)
    q_cc, k_cc, v_cc = na_qkv(pc)
    q_d = mla_q(p)
    q_d = jnp.concatenate([q_d[..., :D_NOPE], apply_rope(q_d[..., D_NOPE:], cos, sin)], axis=-1)
    kn, v_d, kr = mla_kv(p)
    k_d = mla_key(kn, apply_rope(kr, cos, sin))
    kn_c, v_dc, kr_c = mla_kv(pc)
    k_dc = mla_key(kn_c, kr_c)
    o_c = neighbourhood_attention(q_c, k_c, v_c, k_cc, v_cc, rpb, scale_c)
    o_d = blocked_attention(q_d[:, :, :, None], jnp.concatenate([k_dc, k_d], axis=1)[:, :, :, None],
                            jnp.concatenate([v_dc, v_d], axis=1), one_map, scale_d)
    y = merge(o_c, o_d)
    if need_ctx:
        oc_c = blocked_attention(q_cc[:, :, :, None], k_cc[:, :, :, None], v_cc, one_map, scale_c)
        od_c = blocked_attention(mla_q(pc)[:, :, :, None], k_dc[:, :, :, None], v_dc, one_map, scale_d)
        yc = merge(oc_c, od_c)
    else:
        yc = None
    return y, yc


def setup_inputs(seed: int = 0) -> dict:
    key = jax.random.key(seed)
    ks = jax.random.split(key, 31)
    f32 = jnp.float32

    def nrm(k, shape, scale):
        return jax.random.normal(k, shape, f32) * scale

    def gain(k, shape):
        return 1.0 + 0.05 * jax.random.normal(k, shape, f32)

    return {
        'x': nrm(ks[0], (BATCH, SEQ, D_MODEL), 1.0),
        'c': nrm(ks[1], (BATCH, D_MODEL), 1.0),
        'ctx': nrm(ks[2], (BATCH, CTX_LEN, D_MODEL), 1.0),
        'c_ctx': nrm(ks[3], (D_MODEL,), 1.0),
        'w_mod': nrm(ks[4], (DEPTH, D_MODEL, N_MOD * D_MODEL), 0.5 * D_MODEL ** -0.5),
        'b_mod': nrm(ks[5], (DEPTH, N_MOD * D_MODEL), 0.01),
        'norm_g': gain(ks[6], (DEPTH, 4, D_MODEL)),
        'ev_w_in': nrm(ks[7], (N_EVEN, D_MODEL, EVEN_IN), D_MODEL ** -0.5),
        'ev_w_out': nrm(ks[8], (N_EVEN, MIX_WIDTH, D_MODEL), MIX_WIDTH ** -0.5),
        'sgu_w': nrm(ks[9], (N_EVEN, A_GROUPS, CHUNK, CHUNK), CHUNK ** -0.5),
        'sgu_b': gain(ks[10], (N_EVEN, A_GROUPS, CHUNK)),
        'sgu_g': gain(ks[11], (N_EVEN, A_WIDTH)),
        'diff_lq1': nrm(ks[12], (N_EVEN, B_HEAD_DIM), 0.1),
        'diff_lk1': nrm(ks[13], (N_EVEN, B_HEAD_DIM), 0.1),
        'diff_lq2': nrm(ks[14], (N_EVEN, B_HEAD_DIM), 0.1),
        'diff_lk2': nrm(ks[15], (N_EVEN, B_HEAD_DIM), 0.1),
        'diff_subln_g': gain(ks[16], (N_EVEN, 2 * B_HEAD_DIM)),
        'ffn_w1': nrm(ks[17], (N_EVEN, D_MODEL, D_FF), D_MODEL ** -0.5),
        'ffn_w3': nrm(ks[18], (N_EVEN, D_MODEL, D_FF), D_MODEL ** -0.5),
        'ffn_w2': nrm(ks[19], (N_EVEN, D_FF, D_MODEL), D_FF ** -0.5),
        'od_w_in': nrm(ks[20], (N_ODD, D_MODEL, ODD_IN), D_MODEL ** -0.5),
        'od_w_out': nrm(ks[21], (N_ODD, MIX_WIDTH, D_MODEL), MIX_WIDTH ** -0.5),
        'na_rpb': nrm(ks[22], (N_ODD, C_HEADS, 2 * WIN_H - 1, 2 * WIN_W - 1), 0.2),
        'mla_gq': gain(ks[23], (N_ODD, Q_LORA)),
        'mla_w_uq': nrm(ks[24], (N_ODD, Q_LORA, D_HEADS * (D_NOPE + D_ROPE)), Q_LORA ** -0.5),
        'mla_gkv': gain(ks[25], (N_ODD, KV_LORA)),
        'mla_w_ukv': nrm(ks[26], (N_ODD, KV_LORA, D_HEADS * (D_NOPE + D_VDIM)), KV_LORA ** -0.5),
        'router_w': nrm(ks[27], (N_ODD, D_MODEL, N_EXPERTS), D_MODEL ** -0.5),
        'moe_w1': nrm(ks[28], (N_ODD, N_EXPERTS, D_MODEL, D_FF_EXPERT), D_MODEL ** -0.5),
        'moe_w3': nrm(ks[29], (N_ODD, N_EXPERTS, D_MODEL, D_FF_EXPERT), D_MODEL ** -0.5),
        'moe_w2': nrm(ks[30], (N_ODD, N_EXPERTS, D_FF_EXPERT, D_MODEL), D_FF_EXPERT ** -0.5),
    }


def reference(x, c, ctx, c_ctx, w_mod, b_mod, norm_g, ev_w_in, ev_w_out, sgu_w, sgu_b, sgu_g,
              diff_lq1, diff_lk1, diff_lq2, diff_lk2, diff_subln_g, ffn_w1, ffn_w3, ffn_w2,
              od_w_in, od_w_out, na_rpb, mla_gq, mla_w_uq, mla_gkv, mla_w_ukv,
              router_w, moe_w1, moe_w3, moe_w2):
    bsz, s_len, _ = x.shape
    t = jnp.arange(s_len, dtype=jnp.int32)
    row, col = t // GRID_W, t % GRID_W
    rope_b = axial_rope_tables(row, col, B_HEAD_DIM)
    rope_d = axial_rope_tables(row, col, D_ROPE)
    silu_c = jax.nn.silu(c)
    silu_cc = jax.nn.silu(c_ctx)
    for l in range(DEPTH):
        i = l // 2
        need_ctx = l < DEPTH - 1
        mod = (silu_c @ w_mod[l] + b_mod[l]).reshape(bsz, N_MOD, 1, D_MODEL)
        mod_c = (silu_cc @ w_mod[l] + b_mod[l]).reshape(N_MOD, D_MODEL)
        sh1, sc1, g1, sh2, sc2, g2 = [mod[:, j] for j in range(N_MOD)]
        ch1, cs1, cg1, ch2, cs2, cg2 = [mod_c[j] for j in range(N_MOD)]
        h = modulate(rmsnorm(x, norm_g[l, 0]), sh1, sc1)
        hc = modulate(rmsnorm(ctx, norm_g[l, 0]), ch1, cs1)
        if l % 2 == 0:
            y, yc = even_mixer(h, hc, l, ev_w_in[i], ev_w_out[i], sgu_w[i], sgu_b[i], sgu_g[i],
                               diff_lq1[i], diff_lk1[i], diff_lq2[i], diff_lk2[i], diff_subln_g[i],
                               rope_b, need_ctx)

            def ffn(z):
                return swiglu(z, ffn_w1[i], ffn_w3[i], ffn_w2[i])
        else:
            y, yc = odd_mixer(h, hc, od_w_in[i], od_w_out[i], na_rpb[i], mla_gq[i], mla_w_uq[i],
                              mla_gkv[i], mla_w_ukv[i], rope_d, need_ctx)

            def ffn(z):
                return moe_swiglu(z, router_w[i], moe_w1[i], moe_w3[i], moe_w2[i])
        x = x + g1 * rmsnorm(y, norm_g[l, 1])
        h = modulate(rmsnorm(x, norm_g[l, 2]), sh2, sc2)
        x = x + g2 * rmsnorm(ffn(h), norm_g[l, 3])
        if need_ctx:
            ctx = ctx + cg1 * rmsnorm(yc, norm_g[l, 1])
            hc = modulate(rmsnorm(ctx, norm_g[l, 2]), ch2, cs2)
            ctx = ctx + cg2 * rmsnorm(ffn(hc), norm_g[l, 3])
    return x
```

```cpp
#include <hip/hip_runtime.h>
#include <stdint.h>
#include <stdio.h>

#ifndef MK_PER_PHASE
#define MK_PER_PHASE 0
#endif

#define LAS __attribute__((address_space(3)))
typedef unsigned short bf16_t;
typedef short bf16x8 __attribute__((ext_vector_type(8)));
typedef short s16x4 __attribute__((ext_vector_type(4)));
typedef float f32x4 __attribute__((ext_vector_type(4)));
typedef float f32x2 __attribute__((ext_vector_type(2)));
typedef float f32x16 __attribute__((ext_vector_type(16)));
typedef unsigned u32x4 __attribute__((ext_vector_type(4)));
typedef unsigned u32x2 __attribute__((ext_vector_type(2)));

constexpr int DM = 1024, NB = 4, SEQ = 8192, NLAT = NB * SEQ, CTXL = 256, NCTX = NB * CTXL, MTOT = NLAT + NCTX;
constexpr int NMOD = 6;
constexpr int EV_IN = 2560, OD_IN = 1952, OD_INP = 2048, DFF = 2816, DFFE = 3584, NEXP = 8;
constexpr int MLA_N = 1280, MLA_K = 512;
constexpr int MS_MAX = 2 * MTOT + NEXP * 256;
constexpr float EPS = 1e-6f;
constexpr float LOG2E = 1.4426950408889634f;

constexpr size_t MiB = (size_t)1 << 20;
constexpr size_t WS_CTL = 0, CTL_BYTES = MiB;
constexpr size_t WS_MODS = 1 * MiB;
constexpr size_t WS_ROPEB = 2 * MiB;
constexpr size_t WS_ROPED = 4 * MiB;
constexpr size_t WS_SGUW = 5 * MiB;
constexpr size_t WS_TOKINFO = 6 * MiB;
constexpr size_t WS_TOKPOS = 8 * MiB;
constexpr size_t WS_CTXX = 10 * MiB;
constexpr size_t WS_WMLA = 14 * MiB;
constexpr size_t WS_WINE = 17 * MiB;
constexpr size_t WS_WOUTE = 27 * MiB;
constexpr size_t WS_W13E = 31 * MiB;
constexpr size_t WS_W2E = 53 * MiB;
constexpr size_t WS_WINO = 64 * MiB;
constexpr size_t WS_WOUTO = 72 * MiB;
constexpr size_t WS_W13M = 76 * MiB;
constexpr size_t WS_W2M = 188 * MiB;
constexpr size_t WS_HB = 244 * MiB;
constexpr size_t WS_U = 310 * MiB;
constexpr size_t U_PB = 0;
constexpr size_t U_MIX = 165 * MiB;
constexpr size_t U_A2 = 231 * MiB;
constexpr size_t U_MLAO = 264 * MiB;
constexpr size_t U_YB = 347 * MiB;
constexpr size_t U_HID = 0;
constexpr size_t U_YS = 478 * MiB;
constexpr size_t WS_END = WS_U + 616 * MiB;
static_assert((size_t)MS_MAX * DFFE * 2 <= U_YS, "hid fits");
static_assert(U_YS + (size_t)MS_MAX * DM * 2 <= 616 * MiB, "ys fits");

constexpr int CW_BAR = 4096;
constexpr int CW_MOECNT = 1024;

constexpr int LDS_BYTES = 147456;
constexpr int LDS_MISC = 131072;

__device__ __forceinline__ unsigned cvtpk(float lo, float hi) { unsigned r; asm volatile("v_cvt_pk_bf16_f32 %0, %1, %2" : "=v"(r) : "v"(lo), "v"(hi)); return r; }
__device__ __forceinline__ float bf2f(unsigned short b) { return __uint_as_float(((unsigned)b) << 16); }
__device__ __forceinline__ float bflo(unsigned w) { return __uint_as_float(w << 16); }
__device__ __forceinline__ float bfhi(unsigned w) { return __uint_as_float(w & 0xffff0000u); }
__device__ __forceinline__ bf16_t f2bf(float f) { return (bf16_t)(cvtpk(f, 0.f) & 0xffffu); }
__device__ __forceinline__ float wave_sum(float v) {
#pragma unroll
    for (int o = 1; o < 64; o <<= 1) v += __shfl_xor(v, o);
    return v;
}
__device__ __forceinline__ float fast_exp2(float x) { return __builtin_amdgcn_exp2f(x); }
__device__ __forceinline__ float fast_rcp(float x) { return __builtin_amdgcn_rcpf(x); }
__device__ __forceinline__ float silu_f(float x) { return x * fast_rcp(1.f + fast_exp2(-x * LOG2E)); }
__device__ __forceinline__ float gelu_tanh_f(float x) { const float u = 0.7978845608028654f * (x + 0.044715f * x * x * x); return x * fast_rcp(1.f + fast_exp2(-2.f * LOG2E * u)); }
#define LDS_WAIT() asm volatile("s_waitcnt lgkmcnt(0)" ::: "memory")
#define VM_WAIT() asm volatile("s_waitcnt vmcnt(0)" ::: "memory")
__device__ __forceinline__ int opaque_tid() { int t = threadIdx.x; asm volatile("" : "+v"(t)); return t; }

#define XB_TMO      128
#define XB_XCNT(j)  (256  + 64 * (j))
#define XB_XSUB(j)  (1280 + 64 * (j))
#define XB_XGEN(j)  (2304 + 64 * (j))
#define XB_TOP      3328
#define XB_TOPGEN   3392
#define XCD_BAR_WORDS 3456
#define XB_SPIN_CAP (1u << 22)
__device__ __forceinline__ unsigned xb_ld(unsigned* p)              { return __hip_atomic_load(p, __ATOMIC_RELAXED, __HIP_MEMORY_SCOPE_AGENT); }
__device__ __forceinline__ unsigned xb_add(unsigned* p, unsigned v) { return __hip_atomic_fetch_add(p, v, __ATOMIC_RELAXED, __HIP_MEMORY_SCOPE_AGENT); }
__device__ __forceinline__ unsigned xb_xcc_id() { return (unsigned)__builtin_amdgcn_s_getreg((3 << 11) | 20) & 0xFu; }
#define XB_SPIN(cond, bar) do { unsigned _sp = 0; while (cond) { __builtin_amdgcn_s_sleep(1); \
    if ((++_sp & 255u) == 0u) { if (xb_ld(&(bar)[XB_TMO])) break; if (_sp > XB_SPIN_CAP) { atomicAdd(&(bar)[XB_TMO], 1u); break; } } } } while (0)
struct XcdBarrier { unsigned* bar; unsigned x; volatile LAS unsigned* st; };
__device__ __forceinline__ XcdBarrier xcd_barrier_post(unsigned* bar, volatile LAS unsigned* st) {
    XcdBarrier b; b.bar = bar; b.x = xb_xcc_id(); b.st = st;
    if (threadIdx.x == 0) (void)xb_add(&bar[XB_XCNT(b.x)], 1u);
    return b;
}
__device__ __forceinline__ void xcd_barrier_complete(unsigned* bar, unsigned x, unsigned& nloc, unsigned& nx) {
    const unsigned G = gridDim.x * gridDim.y * gridDim.z;
    unsigned sum, cnt, mine, sp = 0u;
    for (;;) {
        sum = 0u; cnt = 0u; mine = 0u;
#pragma unroll
        for (unsigned j = 0; j < 16; ++j) { const unsigned c = xb_ld(&bar[XB_XCNT(j)]); sum += c; cnt += (c > 0u) ? 1u : 0u; mine = (j == x) ? c : mine; }
        if (sum == G) break;
        __builtin_amdgcn_s_sleep(1);
        if ((++sp & 255u) == 0u) { if (xb_ld(&bar[XB_TMO])) break; if (sp > XB_SPIN_CAP) { atomicAdd(&bar[XB_TMO], 1u); break; } }
    }
    nloc = mine > 0u ? mine : 1u; nx = cnt > 0u ? cnt : 1u;
}
__device__ __forceinline__ void xcd_barrier(const XcdBarrier& b) {
    asm volatile("s_waitcnt vmcnt(0)" ::: "memory");
    __syncthreads();
    if (threadIdx.x == 0) {
        unsigned* bar = b.bar;
        __builtin_amdgcn_s_waitcnt(0);
        unsigned nloc = b.st[0], nx = b.st[1];
        if (nloc == 0u) { xcd_barrier_complete(bar, b.x, nloc, nx); b.st[0] = nloc; b.st[1] = nx; }
        const unsigned old = xb_add(&bar[XB_XSUB(b.x)], 1u);
        const unsigned gen = old / nloc;
        if (old + 1u == (gen + 1u) * nloc) {
            __builtin_amdgcn_fence(__ATOMIC_RELEASE, "agent");
            asm volatile("s_waitcnt vmcnt(0)" ::: "memory");
            const unsigned og = xb_add(&bar[XB_TOP], 1u);
            const unsigned tg = og / nx;
            if (og + 1u == (tg + 1u) * nx) xb_add(&bar[XB_TOPGEN], 1u);
            else XB_SPIN(xb_ld(&bar[XB_TOPGEN]) == tg, bar);
            __builtin_amdgcn_fence(__ATOMIC_ACQUIRE, "agent");
            xb_add(&bar[XB_XGEN(b.x)], 1u);
            asm volatile("s_waitcnt vmcnt(0)" ::: "memory");
        } else {
            XB_SPIN(xb_ld(&bar[XB_XGEN(b.x)]) == gen, bar);
            __builtin_amdgcn_fence(__ATOMIC_ACQUIRE, "agent");
            asm volatile("s_waitcnt vmcnt(0)" ::: "memory");
        }
    }
    __syncthreads();
}

namespace pg8 {
constexpr int BM = 256, BK = 64, HALF = 128, HTB = HALF * BK * 2, STAGE_BYTES = 8 * HTB, NXCD = 8, WGM = 8;
__device__ __forceinline__ int lds_byte(int r, int c) { const int st = (r >> 4) * 2 + (c >> 5), rr = r & 15, cc = c & 31, ob = rr * 64 + cc * 2; return st * 1024 + (ob ^ (((ob >> 9) & 1) << 5)); }
__device__ __forceinline__ void stage_rc(int b, int& R, int& C) { const int st = b / 1024, sb = b % 1024, swz = sb ^ (((sb >> 9) & 1) << 5); R = (st >> 1) * 16 + swz / 64; C = (st & 1) * 32 + (swz % 64) / 2; }
__device__ __forceinline__ int perm32(int rho) { const int n = rho >> 4, i = rho & 15; return 8 * (i >> 2) + 4 * n + (i & 3); }
struct Unit { int pm, pn, e; };
struct Gemm {
    const bf16_t* A; int lda;
    const bf16_t* Bt; int K;
    int nM, nN;
    int grouped; int toff[9]; size_t estride;
};
struct StaticOrder {
    int nM, nN, nwg, G, c;
    __device__ void init(int nM_, int nN_, int G_, int c_) { nM = nM_; nN = nN_; nwg = nM * nN; G = G_; c = c_; }
    __device__ __forceinline__ bool next(int i, Unit& u) const {
        const long L = (long)i * G + c; if (L >= nwg) return false;
        int wgid = (int)L; { const int q = nwg / NXCD, r = nwg % NXCD, xcd = wgid % NXCD, off = wgid / NXCD; wgid = (xcd < r ? xcd * (q + 1) : r * (q + 1) + (xcd - r) * q) + off; }
        const int nig = WGM * nN, gid = wgid / nig, fm = gid * WGM, gsz = (nM - fm) < WGM ? (nM - fm) : WGM;
        u.pm = fm + ((wgid % nig) % gsz); u.pn = (wgid % nig) / gsz; u.e = 0; return true;
    }
};
struct EpiBf16 {
    bf16_t* O; int ldc;
    __device__ __forceinline__ void operator()(const f32x4 (&acc)[2][2][4][2], const Unit& u, int wr, int wc, int fr, int fq) const {
        const int row0 = u.pm * BM + wr * 64 + fr, col0 = u.pn * BM + wc * 32 + 8 * fq;
#pragma unroll
        for (int ai = 0; ai < 2; ++ai)
#pragma unroll
            for (int m = 0; m < 4; ++m) { bf16_t* rowp = O + (size_t)(row0 + ai * HALF + m * 16) * ldc + col0;
#pragma unroll
                for (int bj = 0; bj < 2; ++bj) { const f32x4 v0 = acc[ai][bj][m][0], v1 = acc[ai][bj][m][1];
                    u32x4 w; w.x = cvtpk(v0[0], v0[1]); w.y = cvtpk(v0[2], v0[3]); w.z = cvtpk(v1[0], v1[1]); w.w = cvtpk(v1[2], v1[3]);
                    *(u32x4*)(rowp + bj * HALF) = w; } }
    }
};
struct EpiSwiGLU {
    bf16_t* O; int ldc;
    __device__ __forceinline__ void operator()(const f32x4 (&acc)[2][2][4][2], const Unit& u, int wr, int wc, int fr, int fq) const {
        const int row0 = u.pm * BM + wr * 64 + fr, col0 = u.pn * HALF + wc * 32 + 8 * fq;
#pragma unroll
        for (int ai = 0; ai < 2; ++ai)
#pragma unroll
            for (int m = 0; m < 4; ++m) { bf16_t* rowp = O + (size_t)(row0 + ai * HALF + m * 16) * ldc + col0;
                float r[8];
#pragma unroll
                for (int n = 0; n < 2; ++n)
#pragma unroll
                    for (int j = 0; j < 4; ++j) r[n * 4 + j] = silu_f(acc[ai][0][m][n][j]) * acc[ai][1][m][n][j];
                u32x4 w; w.x = cvtpk(r[0], r[1]); w.y = cvtpk(r[2], r[3]); w.z = cvtpk(r[4], r[5]); w.w = cvtpk(r[6], r[7]);
                *(u32x4*)rowp = w; }
    }
};

template <class Epi>
__device__ __forceinline__ void gemm_phase(LAS unsigned char* lds, const Gemm& g, const Epi& E) {
    const int tid = opaque_tid(), wid = __builtin_amdgcn_readfirstlane(tid >> 6), lane = tid & 63, wr = wid >> 2, wc = wid & 3, fr = lane & 15, fq = lane >> 4;
    const int K = g.K, nt = K / BK, lda = g.lda;
    StaticOrder S; S.init(g.nM, g.nN, (int)gridDim.x, (int)blockIdx.x);
    unsigned voffA[2], voffB[2];
#pragma unroll
    for (int i = 0; i < 2; ++i) { int R, C; stage_rc(tid * 16 + i * 8192, R, C); const int Rb = (R & ~31) + perm32(R & 31);
        voffA[i] = (unsigned)(R * lda + C) * 2u; voffB[i] = (unsigned)(Rb * K + C) * 2u; }
    const size_t kstep = (size_t)(BK * 2);
    const size_t hA = (size_t)HALF * lda * 2, tA = 2 * hA, hB = (size_t)HALF * K * 2, tB = 2 * hB;
    const unsigned ldsw = (unsigned)wid * 1024u;
    const int aoff = lds_byte(wr * 64 + fr, fq * 8), boff = lds_byte(wc * 32 + fr, fq * 8);
#define PG8_SA(b, h) (((b) * 2 + (h)) * HTB)
#define PG8_SB(b, h) ((4 + (b) * 2 + (h)) * HTB)
#define PG8_STAGE(bufoff, gbase, voff) do { _Pragma("unroll") for (int _i = 0; _i < 2; ++_i) \
        __builtin_amdgcn_global_load_lds((const unsigned*)((const char*)(gbase) + (voff)[_i]), (LAS unsigned*)(lds + (bufoff) + ldsw + _i * 8192), 16, 0, 0); } while (0)
#define PG8_LDA(dst, b, h) do { _Pragma("unroll") for (int m = 0; m < 4; ++m) _Pragma("unroll") for (int k = 0; k < 2; ++k) dst[m][k] = *(const LAS bf16x8*)(lds + PG8_SA(b, h) + aoff + m * 2048 + k * 1024); } while (0)
#define PG8_LDB(dst, b, h) do { _Pragma("unroll") for (int n = 0; n < 2; ++n) _Pragma("unroll") for (int k = 0; k < 2; ++k) dst[n][k] = *(const LAS bf16x8*)(lds + PG8_SB(b, h) + boff + n * 2048 + k * 1024); } while (0)
#define PG8_MMA(ai, bj, At, Bt) do { __builtin_amdgcn_s_setprio(1); _Pragma("unroll") for (int m = 0; m < 4; ++m) _Pragma("unroll") for (int n = 0; n < 2; ++n) _Pragma("unroll") for (int k = 0; k < 2; ++k) \
        acc[ai][bj][m][n] = __builtin_amdgcn_mfma_f32_16x16x32_bf16(Bt[n][k], At[m][k], acc[ai][bj][m][n], 0, 0, 0); __builtin_amdgcn_s_setprio(0); } while (0)
#define PG8_WAIT_V(n) asm volatile("s_waitcnt vmcnt(" #n ")" ::: "memory")
#define PG8_WAIT_L(n) asm volatile("s_waitcnt lgkmcnt(" #n ")" ::: "memory")
#define PG8_BAR __builtin_amdgcn_s_barrier()
#define PG8_SCHED __builtin_amdgcn_sched_barrier(0)
#define PG8_EXPERT(u) do { if (g.grouped) { int _e = 0; _Pragma("unroll") for (int _k = 1; _k < 8; ++_k) _e += ((u).pm >= g.toff[_k]) ? 1 : 0; (u).e = _e; } } while (0)
    Unit cur, nxt; int ui = 0;
    if (!S.next(0, cur)) return;
    PG8_EXPERT(cur);
    f32x4 acc[2][2][4][2];
#pragma unroll
    for (int a = 0; a < 2; ++a)
#pragma unroll
        for (int b = 0; b < 2; ++b)
#pragma unroll
            for (int m = 0; m < 4; ++m)
#pragma unroll
                for (int n = 0; n < 2; ++n) acc[a][b][m][n] = (f32x4){0.f, 0.f, 0.f, 0.f};
    bf16x8 At[4][2], B0[2][2], B1[2][2];
    const char* cA = (const char*)g.A + (size_t)cur.pm * tA; const char* cB = (const char*)(g.Bt + (size_t)cur.e * g.estride) + (size_t)cur.pn * tB;
    PG8_STAGE(PG8_SB(0, 0), cB, voffB); PG8_STAGE(PG8_SA(0, 0), cA, voffA); PG8_STAGE(PG8_SB(0, 1), cB + hB, voffB); PG8_STAGE(PG8_SA(0, 1), cA + hA, voffA);
    if (wr == 1) PG8_BAR;
    PG8_WAIT_V(4); PG8_BAR;
    PG8_STAGE(PG8_SB(1, 0), cB + kstep, voffB); PG8_STAGE(PG8_SA(1, 0), cA + kstep, voffA); PG8_STAGE(PG8_SB(1, 1), cB + hB + kstep, voffB);
    PG8_WAIT_V(6); PG8_BAR;
    for (;;) {
        const bool has_next = S.next(ui + 1, nxt);
        if (has_next) PG8_EXPERT(nxt);
        const char* nA = has_next ? (const char*)g.A + (size_t)nxt.pm * tA : cA; const char* nB = has_next ? (const char*)(g.Bt + (size_t)nxt.e * g.estride) + (size_t)nxt.pn * tB : cB;
        for (int t = 0; t < nt; t += 2) {
            const bool last = (t == nt - 2);
            const char* a1 = cA + (size_t)(t + 1) * kstep;
            const char* a2 = last ? nA : cA + (size_t)(t + 2) * kstep; const char* b2 = last ? nB : cB + (size_t)(t + 2) * kstep;
            const char* a3 = a2 + kstep; const char* b3 = b2 + kstep;
            PG8_LDB(B0, 0, 0); PG8_SCHED; PG8_LDA(At, 0, 0); PG8_STAGE(PG8_SA(1, 1), a1 + hA, voffA);
            PG8_WAIT_L(8); PG8_BAR; PG8_WAIT_L(0); PG8_MMA(0, 0, At, B0); PG8_BAR; PG8_SCHED;
            PG8_LDB(B1, 0, 1); PG8_STAGE(PG8_SB(0, 0), b2, voffB);
            PG8_BAR; PG8_WAIT_L(0); PG8_MMA(0, 1, At, B1); PG8_BAR;
            PG8_LDA(At, 0, 1); PG8_STAGE(PG8_SA(0, 0), a2, voffA);
            PG8_BAR; PG8_WAIT_L(0); PG8_MMA(1, 0, At, B0); PG8_BAR; PG8_SCHED;
            PG8_STAGE(PG8_SB(0, 1), b2 + hB, voffB);
            PG8_WAIT_V(6); PG8_BAR; PG8_MMA(1, 1, At, B1); PG8_BAR;
            PG8_LDB(B0, 1, 0); PG8_SCHED; PG8_LDA(At, 1, 0); PG8_STAGE(PG8_SA(0, 1), a2 + hA, voffA);
            PG8_WAIT_L(8); PG8_BAR; PG8_WAIT_L(0); PG8_MMA(0, 0, At, B0); PG8_BAR; PG8_SCHED;
            PG8_LDB(B1, 1, 1); PG8_STAGE(PG8_SB(1, 0), b3, voffB);
            PG8_BAR; PG8_WAIT_L(0); PG8_MMA(0, 1, At, B1); PG8_BAR;
            PG8_LDA(At, 1, 1); PG8_STAGE(PG8_SA(1, 0), a3, voffA);
            PG8_BAR; PG8_WAIT_L(0); PG8_MMA(1, 0, At, B0); PG8_BAR; PG8_SCHED;
            PG8_STAGE(PG8_SB(1, 1), b3 + hB, voffB);
            PG8_WAIT_V(6); PG8_BAR; PG8_MMA(1, 1, At, B1); PG8_BAR;
        }
        E(acc, cur, wr, wc, fr, fq);
        if (!has_next) break;
#pragma unroll
        for (int a = 0; a < 2; ++a)
#pragma unroll
            for (int b = 0; b < 2; ++b)
#pragma unroll
                for (int m = 0; m < 4; ++m)
#pragma unroll
                    for (int n = 0; n < 2; ++n) acc[a][b][m][n] = (f32x4){0.f, 0.f, 0.f, 0.f};
        cur = nxt; cA = nA; cB = nB; ++ui;
    }
    PG8_WAIT_V(0);
    if (wr == 0) PG8_BAR;
    PG8_BAR;
#undef PG8_SA
#undef PG8_SB
#undef PG8_STAGE
#undef PG8_LDA
#undef PG8_LDB
#undef PG8_MMA
#undef PG8_WAIT_V
#undef PG8_WAIT_L
#undef PG8_BAR
#undef PG8_SCHED
#undef PG8_EXPERT
}
}

__device__ __forceinline__ void gemm_bf16(LAS unsigned char* lds, const pg8::Gemm& g, bf16_t* O, int ldc) { pg8::EpiBf16 E{O, ldc}; pg8::gemm_phase(lds, g, E); }
__device__ __forceinline__ void gemm_swiglu(LAS unsigned char* lds, const pg8::Gemm& g, bf16_t* O, int ldc) { pg8::EpiSwiGLU E{O, ldc}; pg8::gemm_phase(lds, g, E); }

namespace att {
#define SBAR() __builtin_amdgcn_sched_barrier(0)
__device__ __forceinline__ int crow(int r, int hi) { return (r & 3) + 8 * (r >> 2) + 4 * hi; }
__device__ __forceinline__ int v_st(int k, int c) { const int kk = (k & ~0xC) | ((k & 4) << 1) | ((k & 8) >> 1); return ((kk >> 3) * 4 + (c >> 5)) * 512 + ((kk & 7) * 32 + (c & 31)) * 2; }
__device__ __forceinline__ int v_rd_base(int lane) { return ((lane & 3) << 3) | (((lane >> 2) & 3) << 6) | (((lane >> 4) & 1) << 5) | (((lane >> 5) & 1) << 8); }
constexpr int v_rd_off(int d0, int ks, int half) { return d0 * 512 + ks * 4096 + half * 2048; }
template <int OFF> __device__ __forceinline__ s16x4 tr_read(unsigned vb) {
    s16x4 r; asm volatile("ds_read_b64_tr_b16 %0, %1 offset:%2" : "=&v"(r) : "v"(vb), "i"(OFF) : "memory"); return r;
}
template <int D0> __device__ __forceinline__ void pv_one(f32x16& od, unsigned vb, bf16x8 pa0, bf16x8 pa1, bf16x8 pa2, bf16x8 pa3) {
    const s16x4 l0 = tr_read<v_rd_off(D0, 0, 0)>(vb), h0 = tr_read<v_rd_off(D0, 0, 1)>(vb), l1 = tr_read<v_rd_off(D0, 1, 0)>(vb), h1 = tr_read<v_rd_off(D0, 1, 1)>(vb);
    const s16x4 l2 = tr_read<v_rd_off(D0, 2, 0)>(vb), h2 = tr_read<v_rd_off(D0, 2, 1)>(vb), l3 = tr_read<v_rd_off(D0, 3, 0)>(vb), h3 = tr_read<v_rd_off(D0, 3, 1)>(vb);
    asm volatile("s_waitcnt lgkmcnt(0)" ::: "memory"); SBAR();
#define PK(L, H) (bf16x8){L[0], L[1], L[2], L[3], H[0], H[1], H[2], H[3]}
    od = __builtin_amdgcn_mfma_f32_32x32x16_bf16(pa0, PK(l0, h0), od, 0, 0, 0);
    od = __builtin_amdgcn_mfma_f32_32x32x16_bf16(pa1, PK(l1, h1), od, 0, 0, 0);
    od = __builtin_amdgcn_mfma_f32_32x32x16_bf16(pa2, PK(l2, h2), od, 0, 0, 0);
    od = __builtin_amdgcn_mfma_f32_32x32x16_bf16(pa3, PK(l3, h3), od, 0, 0, 0);
#undef PK
}
__device__ __forceinline__ void rot8(bf16x8& a, bf16x8& b, const float* cs, const float* sn) {
    const f32x4 c0 = *(const f32x4*)cs, c1 = *(const f32x4*)(cs + 4), s0 = *(const f32x4*)sn, s1 = *(const f32x4*)(sn + 4);
    float c[8] = {c0[0], c0[1], c0[2], c0[3], c1[0], c1[1], c1[2], c1[3]}, s[8] = {s0[0], s0[1], s0[2], s0[3], s1[0], s1[1], s1[2], s1[3]};
    float o1[8], o2[8];
#pragma unroll
    for (int e = 0; e < 8; ++e) { const float x1 = bf2f((unsigned short)a[e]), x2 = bf2f((unsigned short)b[e]); o1[e] = x1 * c[e] - x2 * s[e]; o2[e] = x2 * c[e] + x1 * s[e]; }
    u32x4 wa = {cvtpk(o1[0], o1[1]), cvtpk(o1[2], o1[3]), cvtpk(o1[4], o1[5]), cvtpk(o1[6], o1[7])};
    u32x4 wb = {cvtpk(o2[0], o2[1]), cvtpk(o2[2], o2[3]), cvtpk(o2[4], o2[5]), cvtpk(o2[6], o2[7])};
    a = *reinterpret_cast<bf16x8*>(&wa); b = *reinterpret_cast<bf16x8*>(&wb);
}

struct Args {
    const bf16_t* Q; int ldq, qcol;
    const bf16_t* K; int ldk, kcol;
    const bf16_t* V; int ldv, vcol;
    int q_row0;
    int kctx_row0, klat_row0, nt_ctx, nt_lat;
    float C;
    int rope;
    const float* rcos; const float* rsin;
    bf16_t* O; int ldo, ocol;
    int g, u0; const float* rpb;
    float lam, oscale; const float* subg;
};

template <int DQK, int KW, int DV, int MODE>
__device__ __forceinline__ void attn_unit(LAS unsigned char* lds, const Args& a) {
    constexpr int ND = DQK / 16, NO = DV / 32;
    constexpr int KSTR = KW * 2 + 16, KBUF = 64 * KSTR;
    constexpr int OFF_V = 2 * KBUF, OFF_WS = OFF_V + 2 * 16384, OFF_RPB = OFF_WS + 2048;
    constexpr int KCH = KW / 8, NKCH = 64 * KCH, NKC = (NKCH + 511) / 512;
    constexpr int VCH = DV / 8, NVCH = 64 * VCH, NVC = (NVCH + 511) / 512;
    constexpr float THR2 = 8.f * LOG2E;
    const int tid = opaque_tid(), wid = __builtin_amdgcn_readfirstlane(tid >> 6), lane = tid & 63, r32 = lane & 31, hi = lane >> 5;
    LAS unsigned char* Kl = lds; LAS unsigned char* Vl = lds + OFF_V;
    LAS float* wsf = (LAS float*)(lds + OFF_WS) + wid * 64; LAS float* li_l = wsf; LAS float* al_l = wsf + 32;
    LAS float* rpbl = (LAS float*)(lds + OFF_RPB);
    const int wq = (MODE == 1) ? (wid & 3) : wid, wmap = (MODE == 1) ? (wid >> 2) : 0;
    bf16x8 qr[ND];
    const int qrow = a.q_row0 + wq * 32 + r32;
    {
        const bf16_t* Qw = a.Q + (size_t)qrow * a.ldq + a.qcol + wmap * 64 + hi * 8;
#pragma unroll
        for (int d0 = 0; d0 < ND; ++d0) qr[d0] = *(const bf16x8*)(Qw + d0 * 16);
        if (a.rope == 1) { if constexpr (ND >= 4) { const int s = qrow & (SEQ - 1); const float* cs = a.rcos + s * 32 + hi * 8; const float* sn = a.rsin + s * 32 + hi * 8;
            rot8(qr[0], qr[2], cs, sn); rot8(qr[1], qr[3], cs + 16, sn + 16); } }
        if (a.rope == 2) { if constexpr (ND >= 6) { const int s = qrow & (SEQ - 1); rot8(qr[4], qr[5], a.rcos + s * 16 + hi * 8, a.rsin + s * 16 + hi * 8); } }
    }
    if (MODE == 2) { if (tid < 465) rpbl[tid] = a.rpb[tid] * LOG2E; }
    const int cq = (wid & 1) * 32 + r32, rq = 4 * a.g + (wid >> 1);
    const int rs = min(max(rq - 4, 0), 120), cs_ = min(max(cq - 8, 0), 48);
    int kgo[NKC], klo[NKC], vgo[NVC], vlo[NVC];
#pragma unroll
    for (int i = 0; i < NKC; ++i) { const int c = tid + 512 * i, row = c / KCH, ch = c % KCH; kgo[i] = row * a.ldk + ch * 8; klo[i] = row * KSTR + ch * 16; }
#pragma unroll
    for (int i = 0; i < NVC; ++i) { const int c = tid + 512 * i, row = c / VCH, ch = c % VCH; vgo[i] = row * a.ldv + ch * 8; vlo[i] = v_st(row, ch * 8); }
    u32x4 ks[NKC], vs[NVC];
    const int NT = a.nt_ctx + a.nt_lat;
#define TILE_ROW(j) ((j) < a.nt_ctx ? a.kctx_row0 + 64 * (j) : a.klat_row0 + 64 * ((j) - a.nt_ctx))
#define SLOAD(j) do { const int _r0 = TILE_ROW(j); const bf16_t* _kp = a.K + (size_t)_r0 * a.ldk + a.kcol; const bf16_t* _vp = a.V + (size_t)_r0 * a.ldv + a.vcol; \
    _Pragma("unroll") for (int _i = 0; _i < NKC; ++_i) if ((NKCH % 512 == 0) || tid + 512 * _i < NKCH) ks[_i] = *(const u32x4*)(_kp + kgo[_i]); \
    _Pragma("unroll") for (int _i = 0; _i < NVC; ++_i) if ((NVCH % 512 == 0) || tid + 512 * _i < NVCH) vs[_i] = *(const u32x4*)(_vp + vgo[_i]); } while (0)
#define SWRITE(b) do { \
    _Pragma("unroll") for (int _i = 0; _i < NKC; ++_i) if ((NKCH % 512 == 0) || tid + 512 * _i < NKCH) *(LAS u32x4*)(Kl + (b) * KBUF + klo[_i]) = ks[_i]; \
    _Pragma("unroll") for (int _i = 0; _i < NVC; ++_i) if ((NVCH % 512 == 0) || tid + 512 * _i < NVCH) *(LAS u32x4*)(Vl + (b) * 16384 + vlo[_i]) = vs[_i]; } while (0)
    float m_reg = -1e30f, l_reg = 0.f;
    f32x16 o[NO];
#pragma unroll
    for (int d = 0; d < NO; ++d) o[d] = (f32x16){0.f, 0.f, 0.f, 0.f, 0.f, 0.f, 0.f, 0.f, 0.f, 0.f, 0.f, 0.f, 0.f, 0.f, 0.f, 0.f};
    const unsigned vb0 = (unsigned)(size_t)Vl + (unsigned)v_rd_base(lane);
    SLOAD(0); SWRITE(0); __syncthreads();
    for (int j = 0; j < NT; ++j) {
        const int buf = j & 1;
        if (j + 1 < NT) SLOAD(j + 1);
        bool active = true; int ro = 0;
        if (MODE == 2) { if (j >= a.nt_ctx) { const int kr = a.u0 + (j - a.nt_ctx); active = (kr >= rs) && (kr < rs + 8); ro = kr - rq + 7; } }
        if (active) {
            f32x16 p0 = (f32x16){0.f, 0.f, 0.f, 0.f, 0.f, 0.f, 0.f, 0.f, 0.f, 0.f, 0.f, 0.f, 0.f, 0.f, 0.f, 0.f}, p1 = p0;
            const LAS unsigned char* Kb = Kl + buf * KBUF + wmap * 128;
#pragma unroll
            for (int d0 = 0; d0 < ND; ++d0) { const int cb = (d0 * 16 + hi * 8) * 2;
                const bf16x8 b0 = *(const LAS bf16x8*)(Kb + r32 * KSTR + cb), b1 = *(const LAS bf16x8*)(Kb + (32 + r32) * KSTR + cb);
                p0 = __builtin_amdgcn_mfma_f32_32x32x16_bf16(b0, qr[d0], p0, 0, 0, 0);
                p1 = __builtin_amdgcn_mfma_f32_32x32x16_bf16(b1, qr[d0], p1, 0, 0, 0); }
            const bool biased = (MODE == 2) && (j >= a.nt_ctx);
            if (biased) {
                const LAS float* brow = rpbl + ro * 31;
#pragma unroll
                for (int r = 0; r < 16; ++r) {
                    { const int ck = crow(r, hi), dd = min(max(ck - cq + 15, 0), 30); const bool inw = (unsigned)(ck - cs_) < 16u; const float bv = brow[dd]; p0[r] = inw ? fmaf(p0[r], a.C, bv) : -1e30f; }
                    { const int ck = 32 + crow(r, hi), dd = min(max(ck - cq + 15, 0), 30); const bool inw = (unsigned)(ck - cs_) < 16u; const float bv = brow[dd]; p1[r] = inw ? fmaf(p1[r], a.C, bv) : -1e30f; }
                }
            } else {
#pragma unroll
                for (int r = 0; r < 16; ++r) { p0[r] *= a.C; p1[r] *= a.C; }
            }
            float pmax = p0[0];
#pragma unroll
            for (int r = 1; r < 16; ++r) pmax = fmaxf(pmax, p0[r]);
#pragma unroll
            for (int r = 0; r < 16; ++r) pmax = fmaxf(pmax, p1[r]);
            { auto rr = __builtin_amdgcn_permlane32_swap(__float_as_uint(pmax), __float_as_uint(pmax), false, false);
              pmax = fmaxf(__uint_as_float(rr[0]), __uint_as_float(rr[1])); }
            float mn, alpha;
            if (__all(pmax - m_reg <= THR2)) { mn = m_reg; alpha = 1.f; }
            else { mn = fmaxf(m_reg, pmax); alpha = fast_exp2(m_reg - mn); m_reg = mn; }
#pragma unroll
            for (int r = 0; r < 16; ++r) { p0[r] = fast_exp2(p0[r] - mn); p1[r] = fast_exp2(p1[r] - mn); }
            float ps = 0.f;
#pragma unroll
            for (int r = 0; r < 16; ++r) ps += p0[r];
#pragma unroll
            for (int r = 0; r < 16; ++r) ps += p1[r];
            { auto rr = __builtin_amdgcn_permlane32_swap(__float_as_uint(ps), __float_as_uint(ps), false, false);
              ps = __uint_as_float(rr[0]) + __uint_as_float(rr[1]); }
            l_reg = l_reg * alpha + ps;
            if (__any(alpha < 1.f)) { if (hi == 0) al_l[r32] = alpha; LDS_WAIT();
#pragma unroll
                for (int r = 0; r < 16; ++r) { const float av = al_l[crow(r, hi)];
#pragma unroll
                    for (int d = 0; d < NO; ++d) o[d][r] *= av; } }
            bf16x8 pa0, pa1, pa2, pa3;
#define PK4(P, BASE, OUT) do { unsigned a0 = cvtpk(P[BASE + 0], P[BASE + 1]), a1 = cvtpk(P[BASE + 2], P[BASE + 3]);   \
    unsigned b0 = cvtpk(P[BASE + 4], P[BASE + 5]), b1 = cvtpk(P[BASE + 6], P[BASE + 7]);                              \
    auto r0 = __builtin_amdgcn_permlane32_swap(a0, b0, false, false); auto r1 = __builtin_amdgcn_permlane32_swap(a1, b1, false, false); \
    u32x4 w = {r0[0], r1[0], r0[1], r1[1]}; OUT = *reinterpret_cast<bf16x8*>(&w); } while (0)
            PK4(p0, 0, pa0); PK4(p0, 8, pa1); PK4(p1, 0, pa2); PK4(p1, 8, pa3);
#undef PK4
            const unsigned vb = vb0 + (unsigned)buf * 16384u;
            pv_one<0>(o[0], vb, pa0, pa1, pa2, pa3); pv_one<1>(o[1], vb, pa0, pa1, pa2, pa3);
            if constexpr (NO == 4) { pv_one<2>(o[2], vb, pa0, pa1, pa2, pa3); pv_one<3>(o[3], vb, pa0, pa1, pa2, pa3); }
        }
        if (j + 1 < NT) SWRITE(buf ^ 1);
        __syncthreads();
    }
#undef TILE_ROW
#undef SLOAD
#undef SWRITE
    if (hi == 0) li_l[r32] = l_reg; LDS_WAIT();
    float rli[16];
#pragma unroll
    for (int r = 0; r < 16; ++r) rli[r] = fast_rcp(li_l[crow(r, hi)]);
    if (MODE != 1) {
        bf16_t* Ow = a.O + (size_t)(a.q_row0 + wid * 32) * a.ldo + a.ocol + r32;
#pragma unroll
        for (int r = 0; r < 16; ++r) { const int orow = crow(r, hi);
#pragma unroll
            for (int d0 = 0; d0 < NO; ++d0) Ow[(size_t)orow * a.ldo + d0 * 32] = f2bf(o[d0][r] * rli[r]); }
    } else {
        LAS float* cb = (LAS float*)lds;
        if (wmap == 1) {
#pragma unroll
            for (int r = 0; r < 16; ++r) { const int row = wq * 32 + crow(r, hi);
#pragma unroll
                for (int d0 = 0; d0 < NO; ++d0) cb[row * 129 + d0 * 32 + r32] = a.lam * o[d0][r] * rli[r]; }
        }
        __syncthreads();
        if (wmap == 0) {
#pragma unroll
            for (int r = 0; r < 16; ++r) { const int row = wq * 32 + crow(r, hi);
#pragma unroll
                for (int d0 = 0; d0 < NO; ++d0) { const int ix = row * 129 + d0 * 32 + r32; cb[ix] = o[d0][r] * rli[r] - cb[ix]; } }
        }
        __syncthreads();
        const int row = tid >> 2, qd = tid & 3;
        float v[32]; float ss = 0.f;
#pragma unroll
        for (int i = 0; i < 32; ++i) { v[i] = cb[row * 129 + qd * 32 + i]; ss += v[i] * v[i]; }
        ss += __shfl_xor(ss, 1); ss += __shfl_xor(ss, 2);
        const float rstd = rsqrtf(ss * (1.f / 128.f) + EPS) * a.oscale;
        bf16_t* Ow = a.O + (size_t)(a.q_row0 + row) * a.ldo + a.ocol + qd * 32;
#pragma unroll
        for (int c = 0; c < 4; ++c) { float w[8];
#pragma unroll
            for (int e = 0; e < 8; ++e) w[e] = v[c * 8 + e] * rstd * a.subg[qd * 32 + c * 8 + e];
            u32x4 pk = {cvtpk(w[0], w[1]), cvtpk(w[2], w[3]), cvtpk(w[4], w[5]), cvtpk(w[6], w[7])};
            *(u32x4*)(Ow + c * 8) = pk; }
    }
    __syncthreads();
}

__device__ __forceinline__ void sgu_unit(LAS unsigned char* lds, const bf16_t* PB, const bf16_t* Wsb, const float* bs, bf16_t* MIX, int rowbase, int g) {
    const int tid = opaque_tid(), wid = __builtin_amdgcn_readfirstlane(tid >> 6), lane = tid & 63, r32 = lane & 31, hi = lane >> 5;
    LAS unsigned char* Vl = lds;
#pragma unroll
    for (int i = 0; i < 4; ++i) { const int c = tid + 512 * i, row = c >> 4, ch = c & 15;
        const u32x4 x = *(const u32x4*)(PB + (size_t)(rowbase + row) * EV_IN + 512 + g * 128 + ch * 8);
        *(LAS u32x4*)(Vl + (row >> 6) * 16384 + v_st(row & 63, ch * 8)) = x; }
    const int prow = (wid & 3) * 32, dh = wid >> 2;
    bf16x8 pa[2][4];
#pragma unroll
    for (int kt = 0; kt < 2; ++kt)
#pragma unroll
        for (int ks = 0; ks < 4; ++ks) pa[kt][ks] = *(const bf16x8*)(Wsb + (size_t)(g * 128 + prow + r32) * 128 + kt * 64 + ks * 16 + hi * 8);
    __syncthreads();
    f32x16 o[2];
    o[0] = (f32x16){0.f, 0.f, 0.f, 0.f, 0.f, 0.f, 0.f, 0.f, 0.f, 0.f, 0.f, 0.f, 0.f, 0.f, 0.f, 0.f}; o[1] = o[0];
    const unsigned vb0 = (unsigned)(size_t)Vl + (unsigned)v_rd_base(lane);
#pragma unroll
    for (int kt = 0; kt < 2; ++kt) { const unsigned vb = vb0 + kt * 16384u;
        if (dh == 0) { pv_one<0>(o[0], vb, pa[kt][0], pa[kt][1], pa[kt][2], pa[kt][3]); pv_one<1>(o[1], vb, pa[kt][0], pa[kt][1], pa[kt][2], pa[kt][3]); }
        else { pv_one<2>(o[0], vb, pa[kt][0], pa[kt][1], pa[kt][2], pa[kt][3]); pv_one<3>(o[1], vb, pa[kt][0], pa[kt][1], pa[kt][2], pa[kt][3]); } }
#pragma unroll
    for (int r = 0; r < 16; ++r) { const int p = prow + crow(r, hi); const float bias = bs[g * 128 + p];
#pragma unroll
        for (int dd = 0; dd < 2; ++dd) { const int d = (2 * dh + dd) * 32 + r32;
            const float u = bf2f(PB[(size_t)(rowbase + p) * EV_IN + g * 128 + d]);
            MIX[(size_t)(rowbase + p) * DM + g * 128 + d] = f2bf(u * (o[dd][r] + bias)); } }
    __syncthreads();
}
}

struct Params {
    const float* in[31];
    float* out;
    unsigned char* ws;
    int ph_lo, ph_hi;
};

struct Ctx {
    LAS unsigned char* lds;
    int tid, lane, wid, gw, NGW;
};
__device__ __forceinline__ Ctx make_ctx(LAS unsigned char* lds) { const int t = opaque_tid(), w = __builtin_amdgcn_readfirstlane(t >> 6); return Ctx{lds, t, t & 63, w, (int)blockIdx.x * 8 + w, (int)gridDim.x * 8}; }
typedef const __attribute__((address_space(4))) Params KParams;
__device__ __forceinline__ KParams& kparams() { KParams* p = (KParams*)__builtin_amdgcn_kernarg_segment_ptr(); asm volatile("" : "+s"(p)); return *p; }

__device__ __forceinline__ float* xrow_ptr(KParams& P, int row) { return row < NLAT ? P.out + (size_t)row * DM : (float*)(P.ws + WS_CTXX) + (size_t)(row - NLAT) * DM; }
__device__ __forceinline__ int mod_r(int row) { return row < NLAT ? (row >> 13) : 4; }
__device__ __forceinline__ f32x4 ld4(const float* p) { return *(const f32x4*)p; }
__device__ __forceinline__ f32x4 ldbf4(const bf16_t* p) { const u32x2 w = *(const u32x2*)p; return (f32x4){bflo(w.x), bfhi(w.x), bflo(w.y), bfhi(w.y)}; }
__device__ __forceinline__ void stbf4(bf16_t* p, f32x4 v) { u32x2 w; w.x = cvtpk(v[0], v[1]); w.y = cvtpk(v[2], v[3]); *(u32x2*)p = w; }
__device__ __forceinline__ float sumsq4(const f32x4 (&v)[4]) { float s = 0.f;
#pragma unroll
    for (int j = 0; j < 4; ++j) s += (v[j][0] * v[j][0] + v[j][1] * v[j][1]) + (v[j][2] * v[j][2] + v[j][3] * v[j][3]);
    return wave_sum(s); }
__device__ __forceinline__ void norm_mod(const f32x4 (&x)[4], f32x4 (&hv)[4], const float* gain, const float* shift, const float* scale, int lane) {
    const float rstd = rsqrtf(sumsq4(x) * (1.f / DM) + EPS);
#pragma unroll
    for (int j = 0; j < 4; ++j) { const int c = 4 * lane + 256 * j; const f32x4 g = ld4(gain + c), sh = ld4(shift + c), sc = ld4(scale + c);
        hv[j] = (x[j] * rstd) * g * (sc + 1.f) + sh; }
}
__device__ __forceinline__ void resid_add(f32x4 (&x)[4], const f32x4 (&y)[4], const float* gain, const float* gate, int lane) {
    const float rstd = rsqrtf(sumsq4(y) * (1.f / DM) + EPS);
#pragma unroll
    for (int j = 0; j < 4; ++j) { const int c = 4 * lane + 256 * j; const f32x4 g = ld4(gain + c), gt = ld4(gate + c);
        x[j] = x[j] + gt * ((y[j] * rstd) * g); }
}

__device__ __forceinline__ void tr_item(const float* W, int ldw, bf16_t* WT, int ldt, int k0, int n0, int drow, LAS float* scr, int lane) {
#pragma unroll 8
    for (int i = 0; i < 32; ++i) { const int kk = 2 * i + (lane >> 5); scr[kk * 33 + (lane & 31)] = W[(size_t)(k0 + kk) * ldw + n0 + (lane & 31)]; }
    LDS_WAIT(); asm volatile("" ::: "memory");
    const int c = lane & 7;
#pragma unroll
    for (int j = 0; j < 4; ++j) { const int n = (lane >> 3) + 8 * j; const LAS float* s = scr + (8 * c) * 33 + n;
        u32x4 o; o.x = cvtpk(s[0 * 33], s[1 * 33]); o.y = cvtpk(s[2 * 33], s[3 * 33]); o.z = cvtpk(s[4 * 33], s[5 * 33]); o.w = cvtpk(s[6 * 33], s[7 * 33]);
        *(u32x4*)(WT + (size_t)(drow + n) * ldt + k0 + 8 * c) = o; }
    LDS_WAIT(); asm volatile("" ::: "memory");
}
__device__ __forceinline__ void tr_matrix(const Ctx& c, const float* W, int K, int N, bf16_t* WT, int mode, int row_off) {
    LAS float* scr = (LAS float*)(c.lds + c.wid * 16384);
    const int nblk = N / 32, nitems = (K / 64) * nblk;
    for (int it = c.gw; it < nitems; it += c.NGW) { const int kb = it / nblk, nb = it % nblk, n0 = 32 * nb;
        const int drow = (mode == 0) ? row_off + n0 : (n0 >> 7) * 256 + (n0 & 127) + (mode == 2 ? 128 : 0);
        tr_item(W, N, WT, K, 64 * kb, n0, drow, scr, c.lane); }
}
__device__ __forceinline__ void convert_moe(const Ctx& c_, int i) {
    const Ctx c = make_ctx(c_.lds);
    KParams& P = kparams();
    for (int e = 0; e < NEXP; ++e) {
        tr_matrix(c, P.in[28] + ((size_t)i * NEXP + e) * DM * DFFE, DM, DFFE, (bf16_t*)(P.ws + WS_W13M) + (size_t)e * 2 * DFFE * DM, 1, 0);
        tr_matrix(c, P.in[29] + ((size_t)i * NEXP + e) * DM * DFFE, DM, DFFE, (bf16_t*)(P.ws + WS_W13M) + (size_t)e * 2 * DFFE * DM, 2, 0);
        tr_matrix(c, P.in[30] + ((size_t)i * NEXP + e) * DFFE * DM, DFFE, DM, (bf16_t*)(P.ws + WS_W2M) + (size_t)e * DM * DFFE, 0, 0);
    }
}
__device__ __forceinline__ void prologue0(const Ctx& c_) {
    const Ctx c = make_ctx(c_.lds);
    KParams& P = kparams(); unsigned char* ws = P.ws;
    if (blockIdx.x < 96) {
        LAS float* sl = (LAS float*)c.lds;
        LAS float* part = (LAS float*)(c.lds + 32768);
        for (int i = c.tid; i < 5 * DM; i += 512) { const int r = i >> 10, k = i & 1023; const float x = r < 4 ? P.in[1][r * DM + k] : P.in[3][k]; sl[i] = x / (1.f + expf(-x)); }
        __syncthreads();
        const int t = blockIdx.x, lm = t / 24, cbk = t % 24, n = cbk * 256 + 4 * c.lane;
        const float* W = P.in[4] + (size_t)lm * DM * (NMOD * DM) + n;
        f32x4 acc[5];
#pragma unroll
        for (int r = 0; r < 5; ++r) acc[r] = (f32x4){0.f, 0.f, 0.f, 0.f};
        const int kb = c.wid * 128;
        for (int k0 = 0; k0 < 128; k0 += 8) {
            f32x4 wv[8];
#pragma unroll
            for (int u = 0; u < 8; ++u) wv[u] = ld4(W + (size_t)(kb + k0 + u) * (NMOD * DM));
#pragma unroll
            for (int u = 0; u < 8; ++u)
#pragma unroll
                for (int r = 0; r < 5; ++r) acc[r] += wv[u] * sl[r * DM + kb + k0 + u];
        }
#pragma unroll
        for (int r = 0; r < 5; ++r) *(LAS f32x4*)(part + (c.wid * 5 + r) * 256 + 4 * c.lane) = acc[r];
        __syncthreads();
        for (int i = c.tid; i < 5 * 256; i += 512) { const int r = i >> 8, cc = i & 255; float s = 0.f;
#pragma unroll
            for (int w = 0; w < 8; ++w) s += part[(w * 5 + r) * 256 + cc];
            ((float*)(ws + WS_MODS))[(size_t)(lm * 5 + r) * (NMOD * DM) + cbk * 256 + cc] = s + P.in[5][lm * (NMOD * DM) + cbk * 256 + cc]; }
        __syncthreads();
    }
    for (int i = 0; i < 2; ++i) {
        tr_matrix(c, P.in[7] + (size_t)i * DM * EV_IN, DM, EV_IN, (bf16_t*)(ws + WS_WINE) + (size_t)i * EV_IN * DM, 0, 0);
        tr_matrix(c, P.in[8] + (size_t)i * DM * DM, DM, DM, (bf16_t*)(ws + WS_WOUTE) + (size_t)i * DM * DM, 0, 0);
        tr_matrix(c, P.in[17] + (size_t)i * DM * DFF, DM, DFF, (bf16_t*)(ws + WS_W13E) + (size_t)i * 2 * DFF * DM, 1, 0);
        tr_matrix(c, P.in[18] + (size_t)i * DM * DFF, DM, DFF, (bf16_t*)(ws + WS_W13E) + (size_t)i * 2 * DFF * DM, 2, 0);
        tr_matrix(c, P.in[19] + (size_t)i * DFF * DM, DFF, DM, (bf16_t*)(ws + WS_W2E) + (size_t)i * DM * DFF, 0, 0);
        tr_matrix(c, P.in[20] + (size_t)i * DM * OD_IN, DM, OD_IN, (bf16_t*)(ws + WS_WINO) + (size_t)i * OD_INP * DM, 0, 0);
        tr_matrix(c, P.in[21] + (size_t)i * DM * DM, DM, DM, (bf16_t*)(ws + WS_WOUTO) + (size_t)i * DM * DM, 0, 0);
    }
    const int gt = blockIdx.x * 512 + c.tid, NGT = gridDim.x * 512;
    for (int i = gt; i < 2 * (OD_INP - OD_IN) * DM; i += NGT) { const int l = i / ((OD_INP - OD_IN) * DM), r = i % ((OD_INP - OD_IN) * DM);
        ((bf16_t*)(ws + WS_WINO))[(size_t)l * OD_INP * DM + (size_t)OD_IN * DM + r] = 0; }
    for (int i = gt; i < 2 * MLA_N * MLA_K; i += NGT) { const int l = i / (MLA_N * MLA_K), n = (i / MLA_K) % MLA_N, k = i % MLA_K; float v = 0.f;
        if (n < 384) { if (k < 256) v = P.in[24][((size_t)l * 256 + k) * 384 + n]; }
        else if (n < 768) { const int h = (n - 384) / 96, j = (n - 384) % 96;
            if (j < 64) { if (k >= 256 && k < 384) v = P.in[26][((size_t)l * 128 + (k - 256)) * 768 + h * 192 + j]; }
            else { if (k == 384 + (j - 64)) v = 1.f; } }
        else { const int h = (n - 768) / 128, j = (n - 768) % 128; if (k >= 256 && k < 384) v = P.in[26][((size_t)l * 128 + (k - 256)) * 768 + h * 192 + 64 + j]; }
        ((bf16_t*)(ws + WS_WMLA))[i] = f2bf(v); }
    for (int i = gt; i < 2 * 4 * 128 * 128; i += NGT) ((bf16_t*)(ws + WS_SGUW))[i] = f2bf(P.in[9][i]);
    for (int i = gt; i < SEQ * 32; i += NGT) { const int s = i >> 5, f = i & 31; const int pos = f < 16 ? (s >> 6) : (s & 63);
        const float inv = 1.0f / powf(10000.0f, (float)(f & 15) / 16.0f); const float ang = (float)pos * inv;
        ((float*)(ws + WS_ROPEB))[i] = (float)cos((double)ang); ((float*)(ws + WS_ROPEB))[SEQ * 32 + i] = (float)sin((double)ang); }
    for (int i = gt; i < SEQ * 16; i += NGT) { const int s = i >> 4, f = i & 15; const int pos = f < 8 ? (s >> 6) : (s & 63);
        const float inv = 1.0f / powf(10000.0f, (float)(f & 7) / 8.0f); const float ang = (float)pos * inv;
        ((float*)(ws + WS_ROPED))[i] = (float)cos((double)ang); ((float*)(ws + WS_ROPED))[SEQ * 16 + i] = (float)sin((double)ang); }
    convert_moe(c, 0);
}

__device__ __forceinline__ void ew_first(const Ctx& c_) {
    const Ctx c = make_ctx(c_.lds);
    KParams& P = kparams(); const float* mods = (const float*)(P.ws + WS_MODS); bf16_t* HB = (bf16_t*)(P.ws + WS_HB);
    for (int row = c.gw; row < MTOT; row += c.NGW) {
        const float* src = row < NLAT ? P.in[0] + (size_t)row * DM : P.in[2] + (size_t)(row - NLAT) * DM;
        float* xr = xrow_ptr(P, row); const int r = mod_r(row);
        f32x4 x[4], h[4];
#pragma unroll
        for (int j = 0; j < 4; ++j) { x[j] = ld4(src + 4 * c.lane + 256 * j); *(f32x4*)(xr + 4 * c.lane + 256 * j) = x[j]; }
        const float* mb = mods + (size_t)(0 * 5 + r) * (NMOD * DM);
        norm_mod(x, h, P.in[6] + (0 * 4 + 0) * DM, mb + 0 * DM, mb + 1 * DM, c.lane);
#pragma unroll
        for (int j = 0; j < 4; ++j) stbf4(HB + (size_t)row * DM + 4 * c.lane + 256 * j, h[j]);
    }
}

__device__ __forceinline__ void ew_even_mix(const Ctx& c_, int i) {
    const Ctx c = make_ctx(c_.lds);
    KParams& P = kparams(); bf16_t* PB = (bf16_t*)(P.ws + WS_U + U_PB);
    const float* sg = P.in[11] + i * 512; const float* rc = (const float*)(P.ws + WS_ROPEB); const float* rsn = rc + SEQ * 32;
    for (int row = c.gw; row < MTOT; row += c.NGW) {
        bf16_t* pr = PB + (size_t)row * EV_IN;
        {
            const u32x4 w = *(const u32x4*)(pr + 8 * c.lane); float f[8] = {bflo(w.x), bfhi(w.x), bflo(w.y), bfhi(w.y), bflo(w.z), bfhi(w.z), bflo(w.w), bfhi(w.w)};
#pragma unroll
            for (int e = 0; e < 8; ++e) f[e] = gelu_tanh_f(f[e]);
            u32x4 o = {cvtpk(f[0], f[1]), cvtpk(f[2], f[3]), cvtpk(f[4], f[5]), cvtpk(f[6], f[7])}; *(u32x4*)(pr + 8 * c.lane) = o;
        }
        {
            const u32x4 w = *(const u32x4*)(pr + 512 + 8 * c.lane); float f[8] = {bflo(w.x), bfhi(w.x), bflo(w.y), bfhi(w.y), bflo(w.z), bfhi(w.z), bflo(w.w), bfhi(w.w)};
            float s = 0.f;
#pragma unroll
            for (int e = 0; e < 8; ++e) { f[e] = gelu_tanh_f(f[e]); s += f[e]; }
            const float mean = wave_sum(s) * (1.f / 512.f); float q = 0.f;
#pragma unroll
            for (int e = 0; e < 8; ++e) { f[e] -= mean; q += f[e] * f[e]; }
            const float rstd = rsqrtf(wave_sum(q) * (1.f / 512.f) + EPS);
            const f32x4 g0 = ld4(sg + 8 * c.lane), g1 = ld4(sg + 8 * c.lane + 4);
            float gg[8] = {g0[0], g0[1], g0[2], g0[3], g1[0], g1[1], g1[2], g1[3]};
#pragma unroll
            for (int e = 0; e < 8; ++e) f[e] = f[e] * rstd * gg[e];
            u32x4 o = {cvtpk(f[0], f[1]), cvtpk(f[2], f[3]), cvtpk(f[4], f[5]), cvtpk(f[6], f[7])}; *(u32x4*)(pr + 512 + 8 * c.lane) = o;
        }
        if (row < NLAT) {
            const int s = row & (SEQ - 1), hj = c.lane >> 3, sub = c.lane & 7;
            bf16_t* kp = pr + 1536 + hj * 64 + 4 * sub;
            const f32x4 x1 = ldbf4(kp), x2 = ldbf4(kp + 32), cs = ld4(rc + s * 32 + 4 * sub), sn = ld4(rsn + s * 32 + 4 * sub);
            stbf4(kp, x1 * cs - x2 * sn); stbf4(kp + 32, x2 * cs + x1 * sn);
        }
    }
}

__device__ __forceinline__ void ew_odd_mla(const Ctx& c_, int i) {
    const Ctx c = make_ctx(c_.lds);
    KParams& P = kparams(); const bf16_t* PB = (const bf16_t*)(P.ws + WS_U + U_PB); bf16_t* A2 = (bf16_t*)(P.ws + WS_U + U_A2);
    const float* gq = P.in[23] + i * 256; const float* gkv = P.in[25] + i * 128; const float* rc = (const float*)(P.ws + WS_ROPED); const float* rsn = rc + SEQ * 16;
    for (int row = c.gw; row < MTOT; row += c.NGW) {
        const bf16_t* pr = PB + (size_t)row * OD_INP; bf16_t* ar = A2 + (size_t)row * MLA_K;
        f32x4 q = ldbf4(pr + 1536 + 4 * c.lane);
        const float rq = rsqrtf(wave_sum(q[0] * q[0] + q[1] * q[1] + q[2] * q[2] + q[3] * q[3]) * (1.f / 256.f) + EPS);
        stbf4(ar + 4 * c.lane, q * rq * ld4(gq + 4 * c.lane));
        const unsigned kw = *(const unsigned*)(pr + 1792 + 2 * c.lane); const float k0 = bflo(kw), k1 = bfhi(kw);
        const float rk = rsqrtf(wave_sum(k0 * k0 + k1 * k1) * (1.f / 128.f) + EPS);
        *(unsigned*)(ar + 256 + 2 * c.lane) = cvtpk(k0 * rk * gkv[2 * c.lane], k1 * rk * gkv[2 * c.lane + 1]);
        if (c.lane < 16) { float x1 = bf2f(pr[1920 + c.lane]), x2 = bf2f(pr[1920 + 16 + c.lane]);
            if (row < NLAT) { const int s = row & (SEQ - 1); const float cs = rc[s * 16 + c.lane], sn = rsn[s * 16 + c.lane]; const float o1 = x1 * cs - x2 * sn, o2 = x2 * cs + x1 * sn; x1 = o1; x2 = o2; }
            ar[384 + c.lane] = f2bf(x1); ar[384 + 16 + c.lane] = f2bf(x2); }
        else { *(unsigned*)(ar + 416 + 2 * (c.lane - 16)) = 0u; }
    }
}

__device__ __forceinline__ void ew_mid(const Ctx& c_, int l, int mtok) {
    const Ctx c = make_ctx(c_.lds);
    KParams& P = kparams(); const float* mods = (const float*)(P.ws + WS_MODS); bf16_t* HB = (bf16_t*)(P.ws + WS_HB);
    const bf16_t* YB = (const bf16_t*)(P.ws + WS_U + U_YB);
    const bool odd = (l & 1) != 0; const int li = l >> 1;
    LAS float* wrl = (LAS float*)c.lds;
    if (odd) { for (int i = c.tid; i < DM * NEXP; i += 512) { const int col = i >> 3, e = i & 7; wrl[e * DM + col] = P.in[27][(size_t)li * DM * NEXP + i]; } __syncthreads(); }
    unsigned long long cw = 0ull; int st_e1 = 0, st_e2 = 0, st_l1 = 0, st_l2 = 0; float st_g1 = 0.f; int nrow = 0;
    for (int row = c.gw; row < mtok; row += c.NGW, ++nrow) {
        float* xr = xrow_ptr(P, row); const int r = mod_r(row); const float* mb = mods + (size_t)(l * 5 + r) * (NMOD * DM);
        f32x4 x[4], y[4], h[4];
#pragma unroll
        for (int j = 0; j < 4; ++j) { x[j] = ld4(xr + 4 * c.lane + 256 * j); y[j] = ldbf4(YB + (size_t)row * DM + 4 * c.lane + 256 * j); }
        resid_add(x, y, P.in[6] + (l * 4 + 1) * DM, mb + 2 * DM, c.lane);
#pragma unroll
        for (int j = 0; j < 4; ++j) *(f32x4*)(xr + 4 * c.lane + 256 * j) = x[j];
        norm_mod(x, h, P.in[6] + (l * 4 + 2) * DM, mb + 3 * DM, mb + 4 * DM, c.lane);
#pragma unroll
        for (int j = 0; j < 4; ++j) stbf4(HB + (size_t)row * DM + 4 * c.lane + 256 * j, h[j]);
        if (odd) {
            float lg[8];
#pragma unroll
            for (int e = 0; e < 8; ++e) { float s = 0.f;
#pragma unroll
                for (int j = 0; j < 4; ++j) { const f32x4 w = *(const LAS f32x4*)(wrl + e * DM + 4 * c.lane + 256 * j); s += (h[j][0] * w[0] + h[j][1] * w[1]) + (h[j][2] * w[2] + h[j][3] * w[3]); }
                lg[e] = wave_sum(s); }
            int e1 = 0; float v1 = lg[0];
#pragma unroll
            for (int e = 1; e < 8; ++e) if (lg[e] > v1) { v1 = lg[e]; e1 = e; }
            int e2 = -1; float v2 = -3.0e38f;
#pragma unroll
            for (int e = 0; e < 8; ++e) if (e != e1 && lg[e] > v2) { v2 = lg[e]; e2 = e; }
            if (e2 < 0) e2 = (e1 + 1) & 7;
            const float g1 = 1.f / (1.f + expf(v2 - v1));
            const int l1 = (int)((cw >> (8 * e1)) & 0xffull); cw += 1ull << (8 * e1);
            const int l2 = (int)((cw >> (8 * e2)) & 0xffull); cw += 1ull << (8 * e2);
            if (c.lane == nrow) { st_e1 = e1; st_e2 = e2; st_l1 = l1; st_l2 = l2; st_g1 = g1; }
        }
    }
    if (odd) {
        unsigned* cnt = (unsigned*)(P.ws + WS_CTL) + CW_MOECNT + li * 64;
        int base = 0;
        if (c.lane < 8) { const unsigned wc = (unsigned)((cw >> (8 * c.lane)) & 0xffull); base = wc ? (int)atomicAdd(cnt + c.lane, wc) : 0; }
        const int b1 = __shfl(base, st_e1), b2 = __shfl(base, st_e2);
        if (c.lane < nrow) { const int row = c.gw + c.lane * c.NGW; int4* ti = (int4*)(P.ws + WS_TOKINFO) + (size_t)row * 2;
            ti[0] = make_int4(st_e1, b1 + st_l1, st_e2, b2 + st_l2); ti[1] = make_int4(__float_as_int(st_g1), __float_as_int(1.f - st_g1), 0, 0); }
        __syncthreads();
    }
}

__device__ __forceinline__ void moe_offsets(KParams& P, int li, int (&toff)[9]) {
    const unsigned* cnt = (const unsigned*)(P.ws + WS_CTL) + CW_MOECNT + li * 64; int acc = 0;
#pragma unroll
    for (int e = 0; e < 8; ++e) { toff[e] = acc; const unsigned n = __builtin_amdgcn_readfirstlane(__hip_atomic_load(cnt + e, __ATOMIC_RELAXED, __HIP_MEMORY_SCOPE_AGENT)); acc += (int)((n + 255u) >> 8); }
    toff[8] = acc;
}
__device__ __forceinline__ void moe_gather(const Ctx& c_, int li, int mtok) {
    const Ctx c = make_ctx(c_.lds);
    KParams& P = kparams(); int toff[9]; moe_offsets(P, li, toff);
    int tv = 0;
#pragma unroll
    for (int e = 0; e < 8; ++e) tv = (c.lane == e) ? toff[e] : tv;
    const bf16_t* HB = (const bf16_t*)(P.ws + WS_HB); bf16_t* HS = (bf16_t*)(P.ws + WS_U + U_YS);
    for (int row = c.gw; row < mtok; row += c.NGW) {
        const int4* ti = (const int4*)(P.ws + WS_TOKINFO) + (size_t)row * 2; const int4 a = ti[0], b = ti[1];
        const int pA = __shfl(tv, a.x) * 256 + a.y, pB = __shfl(tv, a.z) * 256 + a.w;
        if (c.lane == 0) ((int4*)(P.ws + WS_TOKPOS))[row] = make_int4(pA, pB, b.x, b.y);
        const u32x4* src = (const u32x4*)(HB + (size_t)row * DM); const u32x4 v0 = src[c.lane], v1 = src[64 + c.lane];
        u32x4* dA = (u32x4*)(HS + (size_t)pA * DM); u32x4* dB = (u32x4*)(HS + (size_t)pB * DM);
        dA[c.lane] = v0; dA[64 + c.lane] = v1; dB[c.lane] = v0; dB[64 + c.lane] = v1;
    }
}

__device__ __forceinline__ void ew_last(const Ctx& c_, int l, int mtok) {
    const Ctx c = make_ctx(c_.lds);
    KParams& P = kparams(); const float* mods = (const float*)(P.ws + WS_MODS); bf16_t* HB = (bf16_t*)(P.ws + WS_HB);
    const bf16_t* YS = (const bf16_t*)(P.ws + WS_U + U_YS); const bool odd = (l & 1) != 0;
    for (int row = c.gw; row < mtok; row += c.NGW) {
        float* xr = xrow_ptr(P, row); const int r = mod_r(row); const float* mb = mods + (size_t)(l * 5 + r) * (NMOD * DM);
        f32x4 x[4], y[4], h[4];
        if (odd) { const int4 tp = ((const int4*)(P.ws + WS_TOKPOS))[row]; const float gA = __int_as_float(tp.z), gB = __int_as_float(tp.w);
#pragma unroll
            for (int j = 0; j < 4; ++j) y[j] = ldbf4(YS + (size_t)tp.x * DM + 4 * c.lane + 256 * j) * gA + ldbf4(YS + (size_t)tp.y * DM + 4 * c.lane + 256 * j) * gB;
        } else {
#pragma unroll
            for (int j = 0; j < 4; ++j) y[j] = ldbf4(YS + (size_t)row * DM + 4 * c.lane + 256 * j);
        }
#pragma unroll
        for (int j = 0; j < 4; ++j) x[j] = ld4(xr + 4 * c.lane + 256 * j);
        resid_add(x, y, P.in[6] + (l * 4 + 3) * DM, mb + 5 * DM, c.lane);
#pragma unroll
        for (int j = 0; j < 4; ++j) *(f32x4*)(xr + 4 * c.lane + 256 * j) = x[j];
        if (l < 3) { const float* mn = mods + (size_t)((l + 1) * 5 + r) * (NMOD * DM);
            norm_mod(x, h, P.in[6] + ((l + 1) * 4 + 0) * DM, mn + 0 * DM, mn + 1 * DM, c.lane);
#pragma unroll
            for (int j = 0; j < 4; ++j) stbf4(HB + (size_t)row * DM + 4 * c.lane + 256 * j, h[j]); }
    }
}

__device__ __forceinline__ void attn_even(const Ctx& c_, int l) {
    const Ctx c = make_ctx(c_.lds);
    KParams& P = kparams(); const int i = l >> 1; const bool need_ctx = l < 3;
    const bf16_t* PB = (const bf16_t*)(P.ws + WS_U + U_PB); bf16_t* MIX = (bf16_t*)(P.ws + WS_U + U_MIX);
    const int nchunk = need_ctx ? 264 : 256;
    for (int u = blockIdx.x; u < nchunk * 4; u += gridDim.x) att::sgu_unit(c.lds, PB, (const bf16_t*)(P.ws + WS_SGUW) + (size_t)i * 4 * 128 * 128, P.in[10] + i * 512, MIX, (u >> 2) * 128, u & 3);
    float d1 = 0.f, d2 = 0.f;
    if (c.lane < 64) { d1 = P.in[12][i * 64 + c.lane] * P.in[13][i * 64 + c.lane]; d2 = P.in[14][i * 64 + c.lane] * P.in[15][i * 64 + c.lane]; }
    const float lam_init = 0.8f - 0.6f * expf(-0.3f * (float)l);
    const float lam = expf(wave_sum(d1)) - expf(wave_sum(d2)) + lam_init;
    att::Args a;
    a.Q = PB; a.ldq = EV_IN; a.K = PB; a.ldk = EV_IN; a.V = PB; a.ldv = EV_IN; a.C = 0.125f * LOG2E;
    a.rcos = (const float*)(P.ws + WS_ROPEB); a.rsin = a.rcos + SEQ * 32; a.O = MIX; a.ldo = DM; a.g = 0; a.u0 = 0; a.rpb = nullptr;
    a.lam = lam; a.oscale = 1.f - lam_init; a.subg = P.in[16] + i * 128; a.nt_ctx = 4;
    const int nctxu = need_ctx ? 32 : 0, nu = nctxu + 1024;
    for (int u = blockIdx.x; u < nu; u += gridDim.x) {
        int b, h;
        if (u < nctxu) { b = u >> 3; h = (u >> 1) & 3; a.q_row0 = NLAT + b * CTXL + (u & 1) * 128; a.nt_lat = 0; a.rope = 0; }
        else { const int v = u - nctxu; b = v >> 8; h = (v >> 6) & 3; a.q_row0 = b * SEQ + (v & 63) * 128; a.nt_lat = SEQ / 64; a.rope = 1; }
        a.qcol = 1024 + h * 128; a.kcol = 1536 + h * 128; a.vcol = 2048 + h * 128; a.ocol = 512 + h * 128;
        a.kctx_row0 = NLAT + b * CTXL; a.klat_row0 = b * SEQ;
        att::attn_unit<64, 128, 128, 1>(c.lds, a);
    }
}
__device__ __forceinline__ void attn_odd_na(const Ctx& c_, int l) {
    const Ctx c = make_ctx(c_.lds);
    KParams& P = kparams(); const int i = l >> 1; const bool need_ctx = l < 3;
    const bf16_t* PB = (const bf16_t*)(P.ws + WS_U + U_PB); bf16_t* MIX = (bf16_t*)(P.ws + WS_U + U_MIX);
    att::Args a;
    a.Q = PB; a.ldq = OD_INP; a.K = PB; a.ldk = OD_INP; a.V = PB; a.ldv = OD_INP; a.C = 0.125f * LOG2E; a.rope = 0; a.rcos = nullptr; a.rsin = nullptr;
    a.O = MIX; a.ldo = DM; a.lam = 0.f; a.oscale = 1.f; a.subg = nullptr; a.nt_ctx = 4;
    const int nctxu = need_ctx ? 32 : 0, nu = nctxu + 1024;
    for (int u = blockIdx.x; u < nu; u += gridDim.x) {
        int b, h;
        if (u < nctxu) { b = u >> 3; h = u & 7; a.q_row0 = NLAT + b * CTXL; a.nt_lat = 0; a.g = 0; a.u0 = 0; a.klat_row0 = 0; }
        else { const int v = u - nctxu; b = v >> 8; h = (v >> 5) & 7; const int g = v & 31; a.g = g; a.u0 = min(max(4 * g - 4, 0), 117);
            a.q_row0 = b * SEQ + g * 256; a.nt_lat = 11; a.klat_row0 = b * SEQ + a.u0 * 64; }
        a.qcol = h * 64; a.kcol = 512 + h * 64; a.vcol = 1024 + h * 64; a.ocol = h * 64; a.kctx_row0 = NLAT + b * CTXL;
        a.rpb = P.in[22] + ((size_t)i * 8 + h) * 465;
        att::attn_unit<64, 64, 64, 2>(c.lds, a);
    }
}
__device__ __forceinline__ void attn_odd_mla(const Ctx& c_, int l) {
    const Ctx c = make_ctx(c_.lds);
    KParams& P = kparams(); const bool need_ctx = l < 3;
    const bf16_t* MO = (const bf16_t*)(P.ws + WS_U + U_MLAO); bf16_t* MIX = (bf16_t*)(P.ws + WS_U + U_MIX);
    att::Args a;
    a.Q = MO; a.ldq = MLA_N; a.K = MO; a.ldk = MLA_N; a.V = MO; a.ldv = MLA_N; a.C = 0.10206207261596575f * LOG2E;
    a.rcos = (const float*)(P.ws + WS_ROPED); a.rsin = a.rcos + SEQ * 16; a.O = MIX; a.ldo = DM; a.g = 0; a.u0 = 0; a.rpb = nullptr; a.lam = 0.f; a.oscale = 1.f; a.subg = nullptr; a.nt_ctx = 4;
    const int nctxu = need_ctx ? 16 : 0, nu = nctxu + 512;
    for (int u = blockIdx.x; u < nu; u += gridDim.x) {
        int b, h;
        if (u < nctxu) { b = u >> 2; h = u & 3; a.q_row0 = NLAT + b * CTXL; a.nt_lat = 0; a.rope = 0; }
        else { const int v = u - nctxu; b = v >> 7; h = (v >> 5) & 3; a.q_row0 = b * SEQ + (v & 31) * 256; a.nt_lat = SEQ / 64; a.rope = 2; }
        a.qcol = h * 96; a.kcol = 384 + h * 96; a.vcol = 768 + h * 128; a.ocol = 512 + h * 128; a.kctx_row0 = NLAT + b * CTXL; a.klat_row0 = b * SEQ;
        att::attn_unit<96, 96, 128, 0>(c.lds, a);
    }
}

constexpr int N_PHASES = 2 + 2 * (8 + 10);
__global__ void __launch_bounds__(512, 2) fwd_kernel(Params prm) {
    extern __shared__ __attribute__((aligned(16))) unsigned char lds_raw[];
    LAS unsigned char* lds = (LAS unsigned char*)lds_raw;
    const Ctx c{lds, 0, 0, 0, 0, 0};
    for (int u = threadIdx.x; u < (LDS_BYTES - LDS_MISC) / 4; u += 512) ((LAS unsigned*)(lds + LDS_MISC))[u] = 0u;
    __syncthreads();
    XcdBarrier bar;
    { unsigned char* ws0 = kparams().ws; bar.bar = (unsigned*)(ws0 + WS_CTL) + CW_BAR; bar.x = 0; bar.st = nullptr;
#if !MK_PER_PHASE
      bar = xcd_barrier_post((unsigned*)(ws0 + WS_CTL) + CW_BAR, (volatile LAS unsigned*)(lds + LDS_MISC + 32));
#endif
    }
    const int lo = kparams().ph_lo, hi = kparams().ph_hi; int ph = 0;
#ifndef PMASK
#define PMASK 0xffffffffu
#endif
#define PM(b) ((PMASK >> (b)) & 1u)
#define PH_ON() (ph >= lo && ph < hi)
#define PH_END() do { if (ph >= lo && ph + 1 < hi) xcd_barrier(bar); ++ph; } while (0)
#define WSP(off) ((bf16_t*)(ws + (off)))
#define HB WSP(WS_HB)
#define PB WSP(WS_U + U_PB)
#define MIX WSP(WS_U + U_MIX)
#define YB WSP(WS_U + U_YB)
#define HID WSP(WS_U + U_HID)
#define YS WSP(WS_U + U_YS)
#define A2 WSP(WS_U + U_A2)
#define MO WSP(WS_U + U_MLAO)

    if (PM(0) && PH_ON()) prologue0(c);
    PH_END();
    if (PM(1) && PH_ON()) ew_first(c);
    PH_END();
    for (int lp = 0; lp < 2; ++lp) {
        {
            const int l = 2 * lp, i = lp; const int mtok = l < 3 ? MTOT : NLAT, nMt = mtok / 256;
            if (PM(2) && PH_ON()) { unsigned char* ws = kparams().ws; pg8::Gemm g{}; g.A = HB; g.lda = DM; g.Bt = (const bf16_t*)(ws + WS_WINE) + (size_t)i * EV_IN * DM; g.K = DM; g.nM = MTOT / 256; g.nN = EV_IN / 256; g.grouped = 0; g.estride = 0;
                gemm_bf16(lds, g, PB, EV_IN); }
            PH_END();
            if (PM(3) && PH_ON()) { ew_even_mix(c, i); if (l == 2) convert_moe(c, 1); }
            PH_END();
            if (PM(4) && PH_ON()) attn_even(c, l);
            PH_END();
            if (PM(5) && PH_ON()) { unsigned char* ws = kparams().ws; pg8::Gemm g{}; g.A = MIX; g.lda = DM; g.Bt = (const bf16_t*)(ws + WS_WOUTE) + (size_t)i * DM * DM; g.K = DM; g.nM = nMt; g.nN = DM / 256; g.grouped = 0; g.estride = 0;
                gemm_bf16(lds, g, YB, DM); }
            PH_END();
            if (PM(6) && PH_ON()) ew_mid(c, l, mtok);
            PH_END();
            if (PM(7) && PH_ON()) { unsigned char* ws = kparams().ws; pg8::Gemm g{}; g.A = HB; g.lda = DM; g.Bt = (const bf16_t*)(ws + WS_W13E) + (size_t)i * 2 * DFF * DM; g.K = DM; g.nM = nMt; g.nN = 2 * DFF / 256; g.grouped = 0; g.estride = 0;
                gemm_swiglu(lds, g, HID, DFF); }
            PH_END();
            if (PM(8) && PH_ON()) { unsigned char* ws = kparams().ws; pg8::Gemm g{}; g.A = HID; g.lda = DFF; g.Bt = (const bf16_t*)(ws + WS_W2E) + (size_t)i * DM * DFF; g.K = DFF; g.nM = nMt; g.nN = DM / 256; g.grouped = 0; g.estride = 0;
                gemm_bf16(lds, g, YS, DM); }
            PH_END();
            if (PM(9) && PH_ON()) ew_last(c, l, mtok);
            PH_END();
        }
        {
            const int l = 2 * lp + 1, i = lp; const int mtok = l < 3 ? MTOT : NLAT, nMt = mtok / 256;
            if (PM(10) && PH_ON()) { unsigned char* ws = kparams().ws; pg8::Gemm g{}; g.A = HB; g.lda = DM; g.Bt = (const bf16_t*)(ws + WS_WINO) + (size_t)i * OD_INP * DM; g.K = DM; g.nM = MTOT / 256; g.nN = OD_INP / 256; g.grouped = 0; g.estride = 0;
                gemm_bf16(lds, g, PB, OD_INP); }
            PH_END();
            if (PM(11) && PH_ON()) ew_odd_mla(c, i);
            PH_END();
            if (PM(12) && PH_ON()) { unsigned char* ws = kparams().ws; pg8::Gemm g{}; g.A = A2; g.lda = MLA_K; g.Bt = (const bf16_t*)(ws + WS_WMLA) + (size_t)i * MLA_N * MLA_K; g.K = MLA_K; g.nM = MTOT / 256; g.nN = MLA_N / 256; g.grouped = 0; g.estride = 0;
                gemm_bf16(lds, g, MO, MLA_N); }
            PH_END();
            if (PH_ON()) { if (PM(13)) attn_odd_na(c, l); if (PM(14)) attn_odd_mla(c, l); }
            PH_END();
            if (PM(15) && PH_ON()) { unsigned char* ws = kparams().ws; pg8::Gemm g{}; g.A = MIX; g.lda = DM; g.Bt = (const bf16_t*)(ws + WS_WOUTO) + (size_t)i * DM * DM; g.K = DM; g.nM = nMt; g.nN = DM / 256; g.grouped = 0; g.estride = 0;
                gemm_bf16(lds, g, YB, DM); }
            PH_END();
            if (PM(16) && PH_ON()) ew_mid(c, l, mtok);
            PH_END();
            if (PM(17) && PH_ON()) moe_gather(c, i, mtok);
            PH_END();
            if (PM(18) && PH_ON()) { unsigned char* ws = kparams().ws; pg8::Gemm g{}; g.A = YS; g.lda = DM; g.Bt = (const bf16_t*)(ws + WS_W13M); g.K = DM; g.nN = 2 * DFFE / 256; g.grouped = 1; g.estride = (size_t)2 * DFFE * DM;
                moe_offsets(kparams(), i, g.toff); g.nM = g.toff[8]; gemm_swiglu(lds, g, HID, DFFE); }
            PH_END();
            if (PM(19) && PH_ON()) { unsigned char* ws = kparams().ws; pg8::Gemm g{}; g.A = HID; g.lda = DFFE; g.Bt = (const bf16_t*)(ws + WS_W2M); g.K = DFFE; g.nN = DM / 256; g.grouped = 1; g.estride = (size_t)DM * DFFE;
                moe_offsets(kparams(), i, g.toff); g.nM = g.toff[8]; gemm_bf16(lds, g, YS, DM); }
            PH_END();
            if (PM(20) && PH_ON()) ew_last(c, l, mtok);
            PH_END();
        }
    }
#undef PH_ON
#undef PH_END
#undef HB
#undef PB
#undef MIX
#undef YB
#undef HID
#undef YS
#undef A2
#undef MO
}

extern "C" void kernel_launch(void* const* d_in, const int* in_sizes, int n_in, void* d_out, int out_size, void* d_ws, size_t ws_size, hipStream_t stream) {
    static int grid = 0;
    if (grid == 0) {
        int dev = 0, cus = 0;
        if (n_in != 31 || out_size != NLAT * DM || ws_size < WS_END) { fprintf(stderr, "kernel_launch: unexpected shapes or workspace (n_in %d out %d ws %zu need %zu)\n", n_in, out_size, ws_size, (size_t)WS_END); grid = -1; }
        else if (hipGetDevice(&dev) != hipSuccess || hipDeviceGetAttribute(&cus, hipDeviceAttributeMultiprocessorCount, dev) != hipSuccess) grid = -1;
        else if (hipFuncSetAttribute((const void*)fwd_kernel, hipFuncAttributeMaxDynamicSharedMemorySize, LDS_BYTES) != hipSuccess) grid = -1;
        else { int per_cu = 0; (void)hipOccupancyMaxActiveBlocksPerMultiprocessor(&per_cu, (const void*)fwd_kernel, 512, LDS_BYTES); (void)hipGetLastError(); grid = cus; }
    }
    if (grid < 0) { (void)hipMemsetAsync(d_out, 0, (size_t)out_size * 4, stream); return; }
    (void)hipMemsetAsync((char*)d_ws + WS_CTL, 0, CTL_BYTES, stream);
    Params p{};
    for (int i = 0; i < 31; ++i) p.in[i] = (const float*)d_in[i];
    p.out = (float*)d_out; p.ws = (unsigned char*)d_ws;
#if MK_PER_PHASE
    for (int k = 0; k < N_PHASES; ++k) { p.ph_lo = k; p.ph_hi = k + 1; hipLaunchKernelGGL(fwd_kernel, dim3(grid), dim3(512), LDS_BYTES, stream, p); }
#else
    p.ph_lo = 0; p.ph_hi = N_PHASES;
    hipLaunchKernelGGL(fwd_kernel, dim3(grid), dim3(512), LDS_BYTES, stream, p);
#endif
}
```

```cpp
#include <hip/hip_runtime.h>
#include <stdint.h>
#include <stdio.h>

#ifndef MK_PER_PHASE
#define MK_PER_PHASE 0
#endif
#ifndef DUP_MASK
#define DUP_MASK 0u
#endif
#define DUPN(b) (1 + (int)((DUP_MASK >> (b)) & 1u))
#ifndef MOE_F8
#define MOE_F8 1
#endif

#define LAS __attribute__((address_space(3)))
typedef unsigned short bf16_t;
typedef short bf16x8 __attribute__((ext_vector_type(8)));
typedef short s16x4 __attribute__((ext_vector_type(4)));
typedef float f32x4 __attribute__((ext_vector_type(4)));
typedef float f32x2 __attribute__((ext_vector_type(2)));
typedef float f32x16 __attribute__((ext_vector_type(16)));
typedef unsigned u32x4 __attribute__((ext_vector_type(4)));
typedef unsigned u32x2 __attribute__((ext_vector_type(2)));

constexpr int DM = 1024, NB = 4, SEQ = 8192, NLAT = NB * SEQ, CTXL = 256, NCTX = NB * CTXL, MTOT = NLAT + NCTX;
constexpr int NMOD = 6;
constexpr int EV_IN = 2560, OD_IN = 1952, OD_INP = 2048, DFF = 2816, DFFE = 3584, NEXP = 8;
constexpr int MLA_N = 1280, MLA_K = 512;
constexpr int MS_MAX = 2 * MTOT + NEXP * 256;
constexpr float EPS = 1e-6f;
constexpr float LOG2E = 1.4426950408889634f;

constexpr size_t MiB = (size_t)1 << 20;
constexpr size_t WS_CTL = 0, CTL_BYTES = MiB;
constexpr size_t WS_MODS = 1 * MiB;
constexpr size_t WS_ROPEB = 2 * MiB;
constexpr size_t WS_ROPED = 4 * MiB;
constexpr size_t WS_SGUW = 5 * MiB;
constexpr size_t WS_TOKINFO = 6 * MiB;
constexpr size_t WS_TOKPOS = 8 * MiB;
constexpr size_t WS_CTXX = 10 * MiB;
constexpr size_t WS_WMLA = 14 * MiB;
constexpr size_t WS_WINE = 17 * MiB;
constexpr size_t WS_WOUTE = 27 * MiB;
constexpr size_t WS_W13E = 31 * MiB;
constexpr size_t WS_W2E = 53 * MiB;
constexpr size_t WS_WINO = 64 * MiB;
constexpr size_t WS_WOUTO = 72 * MiB;
constexpr size_t WS_W13M = 76 * MiB;
constexpr size_t WS_W2M = 188 * MiB;
constexpr size_t WS_HB = 244 * MiB;
constexpr size_t WS_U = 310 * MiB;
constexpr size_t U_PB = 0;
constexpr size_t U_MIX = 165 * MiB;
constexpr size_t U_A2 = 231 * MiB;
constexpr size_t U_MLAO = 264 * MiB;
constexpr size_t U_YB = 347 * MiB;
constexpr size_t U_HID = 0;
constexpr size_t U_YS = 478 * MiB;
constexpr size_t WS_END = WS_U + 616 * MiB;
static_assert((size_t)MS_MAX * DFFE * 2 <= U_YS, "hid fits");
static_assert(U_YS + (size_t)MS_MAX * DM * 2 <= 616 * MiB, "ys fits");

constexpr int CW_BAR = 4096;
constexpr int CW_MOECNT = 1024;

constexpr int LDS_BYTES = 147456;
constexpr int LDS_MISC = 131072;

__device__ __forceinline__ unsigned cvtpk(float lo, float hi) { unsigned r; asm volatile("v_cvt_pk_bf16_f32 %0, %1, %2" : "=v"(r) : "v"(lo), "v"(hi)); return r; }
__device__ __forceinline__ float bf2f(unsigned short b) { return __uint_as_float(((unsigned)b) << 16); }
__device__ __forceinline__ float bflo(unsigned w) { return __uint_as_float(w << 16); }
__device__ __forceinline__ float bfhi(unsigned w) { return __uint_as_float(w & 0xffff0000u); }
__device__ __forceinline__ bf16_t f2bf(float f) { return (bf16_t)(cvtpk(f, 0.f) & 0xffffu); }
typedef int i32x8 __attribute__((ext_vector_type(8)));
typedef int i32x4 __attribute__((ext_vector_type(4)));
constexpr float F8_ACT_SCALE = 4.f, F8_W_SCALE = 64.f, F8_INV = 1.f / (F8_ACT_SCALE * F8_W_SCALE);
__device__ __forceinline__ unsigned pk4_fp8(float a, float b, float c, float d) {
    a = __builtin_amdgcn_fmed3f(a, -448.f, 448.f); b = __builtin_amdgcn_fmed3f(b, -448.f, 448.f); c = __builtin_amdgcn_fmed3f(c, -448.f, 448.f); d = __builtin_amdgcn_fmed3f(d, -448.f, 448.f);
    int w = 0; w = __builtin_amdgcn_cvt_pk_fp8_f32(a, b, w, false); w = __builtin_amdgcn_cvt_pk_fp8_f32(c, d, w, true); return (unsigned)w; }
__device__ __forceinline__ float wave_sum(float v) {
#pragma unroll
    for (int o = 1; o < 64; o <<= 1) v += __shfl_xor(v, o);
    return v;
}
__device__ __forceinline__ float fast_exp2(float x) { return __builtin_amdgcn_exp2f(x); }
__device__ __forceinline__ float fast_rcp(float x) { return __builtin_amdgcn_rcpf(x); }
__device__ __forceinline__ float silu_f(float x) { return x * fast_rcp(1.f + fast_exp2(-x * LOG2E)); }
__device__ __forceinline__ float gelu_tanh_f(float x) { const float u = 0.7978845608028654f * (x + 0.044715f * x * x * x); return x * fast_rcp(1.f + fast_exp2(-2.f * LOG2E * u)); }
#define LDS_WAIT() asm volatile("s_waitcnt lgkmcnt(0)" ::: "memory")
#define VM_WAIT() asm volatile("s_waitcnt vmcnt(0)" ::: "memory")
__device__ __forceinline__ int opaque_tid() { int t = threadIdx.x; asm volatile("" : "+v"(t)); return t; }

#define XB_TMO      128
#define XB_XCNT(j)  (256  + 64 * (j))
#define XB_XSUB(j)  (1280 + 64 * (j))
#define XB_XGEN(j)  (2304 + 64 * (j))
#define XB_TOP      3328
#define XB_TOPGEN   3392
#define XCD_BAR_WORDS 3456
#define XB_SPIN_CAP (1u << 22)
__device__ __forceinline__ unsigned xb_ld(unsigned* p)              { return __hip_atomic_load(p, __ATOMIC_RELAXED, __HIP_MEMORY_SCOPE_AGENT); }
__device__ __forceinline__ unsigned xb_add(unsigned* p, unsigned v) { return __hip_atomic_fetch_add(p, v, __ATOMIC_RELAXED, __HIP_MEMORY_SCOPE_AGENT); }
__device__ __forceinline__ unsigned xb_xcc_id() { return (unsigned)__builtin_amdgcn_s_getreg((3 << 11) | 20) & 0xFu; }
#define XB_SPIN(cond, bar) do { unsigned _sp = 0; while (cond) { __builtin_amdgcn_s_sleep(1); \
    if ((++_sp & 255u) == 0u) { if (xb_ld(&(bar)[XB_TMO])) break; if (_sp > XB_SPIN_CAP) { atomicAdd(&(bar)[XB_TMO], 1u); break; } } } } while (0)
struct XcdBarrier { unsigned* bar; unsigned x; volatile LAS unsigned* st; };
__device__ __forceinline__ XcdBarrier xcd_barrier_post(unsigned* bar, volatile LAS unsigned* st) {
    XcdBarrier b; b.bar = bar; b.x = xb_xcc_id(); b.st = st;
    if (threadIdx.x == 0) (void)xb_add(&bar[XB_XCNT(b.x)], 1u);
    return b;
}
__device__ __forceinline__ void xcd_barrier_complete(unsigned* bar, unsigned x, unsigned& nloc, unsigned& nx) {
    const unsigned G = gridDim.x * gridDim.y * gridDim.z;
    unsigned sum, cnt, mine, sp = 0u;
    for (;;) {
        sum = 0u; cnt = 0u; mine = 0u;
#pragma unroll
        for (unsigned j = 0; j < 16; ++j) { const unsigned c = xb_ld(&bar[XB_XCNT(j)]); sum += c; cnt += (c > 0u) ? 1u : 0u; mine = (j == x) ? c : mine; }
        if (sum == G) break;
        __builtin_amdgcn_s_sleep(1);
        if ((++sp & 255u) == 0u) { if (xb_ld(&bar[XB_TMO])) break; if (sp > XB_SPIN_CAP) { atomicAdd(&bar[XB_TMO], 1u); break; } }
    }
    nloc = mine > 0u ? mine : 1u; nx = cnt > 0u ? cnt : 1u;
}
__device__ __forceinline__ void xcd_barrier(const XcdBarrier& b) {
    asm volatile("s_waitcnt vmcnt(0)" ::: "memory");
    __syncthreads();
    if (threadIdx.x == 0) {
        unsigned* bar = b.bar;
        __builtin_amdgcn_s_waitcnt(0);
        unsigned nloc = b.st[0], nx = b.st[1];
        if (nloc == 0u) { xcd_barrier_complete(bar, b.x, nloc, nx); b.st[0] = nloc; b.st[1] = nx; }
        const unsigned old = xb_add(&bar[XB_XSUB(b.x)], 1u);
        const unsigned gen = old / nloc;
        if (old + 1u == (gen + 1u) * nloc) {
            __builtin_amdgcn_fence(__ATOMIC_RELEASE, "agent");
            asm volatile("s_waitcnt vmcnt(0)" ::: "memory");
            const unsigned og = xb_add(&bar[XB_TOP], 1u);
            const unsigned tg = og / nx;
            if (og + 1u == (tg + 1u) * nx) xb_add(&bar[XB_TOPGEN], 1u);
            else XB_SPIN(xb_ld(&bar[XB_TOPGEN]) == tg, bar);
            __builtin_amdgcn_fence(__ATOMIC_ACQUIRE, "agent");
            xb_add(&bar[XB_XGEN(b.x)], 1u);
            asm volatile("s_waitcnt vmcnt(0)" ::: "memory");
        } else {
            XB_SPIN(xb_ld(&bar[XB_XGEN(b.x)]) == gen, bar);
            __builtin_amdgcn_fence(__ATOMIC_ACQUIRE, "agent");
            asm volatile("s_waitcnt vmcnt(0)" ::: "memory");
        }
    }
    __syncthreads();
}

namespace pg8 {
constexpr int BM = 256, BK = 64, HALF = 128, HTB = HALF * BK * 2, STAGE_BYTES = 8 * HTB, NXCD = 8, WGM = 8;
__device__ __forceinline__ int lds_byte(int r, int c) { const int st = (r >> 4) * 2 + (c >> 5), rr = r & 15, cc = c & 31, ob = rr * 64 + cc * 2; return st * 1024 + (ob ^ (((ob >> 9) & 1) << 5)); }
__device__ __forceinline__ void stage_rc(int b, int& R, int& C) { const int st = b / 1024, sb = b % 1024, swz = sb ^ (((sb >> 9) & 1) << 5); R = (st >> 1) * 16 + swz / 64; C = (st & 1) * 32 + (swz % 64) / 2; }
__device__ __forceinline__ int perm32(int rho) { const int n = rho >> 4, i = rho & 15; return 8 * (i >> 2) + 4 * n + (i & 3); }
struct Unit { int pm, pn, e; };
struct Gemm {
    const void* A; int lda;
    const void* Bt; int K;
    int nM, nN;
    int grouped; int toff[9]; size_t estride;
};
struct StaticOrder {
    int nM, nN, nwg, G, c;
    __device__ void init(int nM_, int nN_, int G_, int c_) { nM = nM_; nN = nN_; nwg = nM * nN; G = G_; c = c_; }
    __device__ __forceinline__ bool next(int i, Unit& u) const {
        const long L = (long)i * G + c; if (L >= nwg) return false;
        int wgid = (int)L; { const int q = nwg / NXCD, r = nwg % NXCD, xcd = wgid % NXCD, off = wgid / NXCD; wgid = (xcd < r ? xcd * (q + 1) : r * (q + 1) + (xcd - r) * q) + off; }
        const int nig = WGM * nN, gid = wgid / nig, fm = gid * WGM, gsz = (nM - fm) < WGM ? (nM - fm) : WGM;
        u.pm = fm + ((wgid % nig) % gsz); u.pn = (wgid % nig) / gsz; u.e = 0; return true;
    }
};
struct EpiBf16 {
    bf16_t* O; int ldc; float scale;
    __device__ __forceinline__ void operator()(const f32x4 (&acc)[2][2][4][2], const Unit& u, int wr, int wc, int fr, int fq) const {
        const int row0 = u.pm * BM + wr * 64 + fr, col0 = u.pn * BM + wc * 32 + 8 * fq;
#pragma unroll
        for (int ai = 0; ai < 2; ++ai)
#pragma unroll
            for (int m = 0; m < 4; ++m) { bf16_t* rowp = O + (size_t)(row0 + ai * HALF + m * 16) * ldc + col0;
#pragma unroll
                for (int bj = 0; bj < 2; ++bj) { const f32x4 v0 = acc[ai][bj][m][0] * scale, v1 = acc[ai][bj][m][1] * scale;
                    u32x4 w; w.x = cvtpk(v0[0], v0[1]); w.y = cvtpk(v0[2], v0[3]); w.z = cvtpk(v1[0], v1[1]); w.w = cvtpk(v1[2], v1[3]);
                    *(u32x4*)(rowp + bj * HALF) = w; } }
    }
};
struct EpiSwiGLU {
    bf16_t* O; int ldc;
    __device__ __forceinline__ void operator()(const f32x4 (&acc)[2][2][4][2], const Unit& u, int wr, int wc, int fr, int fq) const {
        const int row0 = u.pm * BM + wr * 64 + fr, col0 = u.pn * HALF + wc * 32 + 8 * fq;
#pragma unroll
        for (int ai = 0; ai < 2; ++ai)
#pragma unroll
            for (int m = 0; m < 4; ++m) { bf16_t* rowp = O + (size_t)(row0 + ai * HALF + m * 16) * ldc + col0;
                float r[8];
#pragma unroll
                for (int n = 0; n < 2; ++n)
#pragma unroll
                    for (int j = 0; j < 4; ++j) r[n * 4 + j] = silu_f(acc[ai][0][m][n][j]) * acc[ai][1][m][n][j];
                u32x4 w; w.x = cvtpk(r[0], r[1]); w.y = cvtpk(r[2], r[3]); w.z = cvtpk(r[4], r[5]); w.w = cvtpk(r[6], r[7]);
                *(u32x4*)rowp = w; }
    }
};

struct EpiSwiGLU8 {
    unsigned char* O; int ldc; float scale;
    __device__ __forceinline__ void operator()(const f32x4 (&acc)[2][2][4][2], const Unit& u, int wr, int wc, int fr, int fq) const {
        const int row0 = u.pm * BM + wr * 64 + fr, col0 = u.pn * HALF + wc * 32 + 8 * fq;
#pragma unroll
        for (int ai = 0; ai < 2; ++ai)
#pragma unroll
            for (int m = 0; m < 4; ++m) { unsigned char* rowp = O + (size_t)(row0 + ai * HALF + m * 16) * ldc + col0;
                float r[8];
#pragma unroll
                for (int n = 0; n < 2; ++n)
#pragma unroll
                    for (int j = 0; j < 4; ++j) r[n * 4 + j] = F8_ACT_SCALE * silu_f(acc[ai][0][m][n][j] * scale) * (acc[ai][1][m][n][j] * scale);
                u32x2 w; w.x = pk4_fp8(r[0], r[1], r[2], r[3]); w.y = pk4_fp8(r[4], r[5], r[6], r[7]);
                *(u32x2*)rowp = w; }
    }
};

template <class Epi, bool F8 = false>
__device__ __forceinline__ void gemm_phase(LAS unsigned char* lds, const Gemm& g, const Epi& E) {
    const int tid = opaque_tid(), wid = __builtin_amdgcn_readfirstlane(tid >> 6), lane = tid & 63, wr = wid >> 2, wc = wid & 3, fr = lane & 15, fq = lane >> 4;
    constexpr int ES = F8 ? 1 : 2;
    const int K = g.K, nt = K * ES / (BK * 2), lda = g.lda;
    StaticOrder S; S.init(g.nM, g.nN, (int)gridDim.x, (int)blockIdx.x);
    unsigned voffA[2], voffB[2];
#pragma unroll
    for (int i = 0; i < 2; ++i) { int R, C; stage_rc(tid * 16 + i * 8192, R, C); const int Rb = (R & ~31) + perm32(R & 31);
        voffA[i] = (unsigned)(R * lda * ES + C * 2); voffB[i] = (unsigned)(Rb * K * ES + C * 2); }
    const size_t kstep = (size_t)(BK * 2);
    const size_t hA = (size_t)HALF * lda * ES, tA = 2 * hA, hB = (size_t)HALF * K * ES, tB = 2 * hB;
    const unsigned ldsw = (unsigned)wid * 1024u;
    const int aoff = lds_byte(wr * 64 + fr, fq * 8), boff = lds_byte(wc * 32 + fr, fq * 8);
#define PG8_SA(b, h) (((b) * 2 + (h)) * HTB)
#define PG8_SB(b, h) ((4 + (b) * 2 + (h)) * HTB)
#define PG8_STAGE(bufoff, gbase, voff) do { _Pragma("unroll") for (int _i = 0; _i < 2; ++_i) \
        __builtin_amdgcn_global_load_lds((const unsigned*)((const char*)(gbase) + (voff)[_i]), (LAS unsigned*)(lds + (bufoff) + ldsw + _i * 8192), 16, 0, 0); } while (0)
#define PG8_LD8(base) __builtin_shufflevector(*(const LAS i32x4*)(base), *(const LAS i32x4*)((base) + 1024), 0, 1, 2, 3, 4, 5, 6, 7)
#define PG8_LDA(dst, b, h) do { _Pragma("unroll") for (int m = 0; m < 4; ++m) dst[m] = PG8_LD8(lds + PG8_SA(b, h) + aoff + m * 2048); } while (0)
#define PG8_LDB(dst, b, h) do { _Pragma("unroll") for (int n = 0; n < 2; ++n) dst[n] = PG8_LD8(lds + PG8_SB(b, h) + boff + n * 2048); } while (0)
#define PG8_H0(x) __builtin_bit_cast(bf16x8, __builtin_shufflevector(x, x, 0, 1, 2, 3))
#define PG8_H1(x) __builtin_bit_cast(bf16x8, __builtin_shufflevector(x, x, 4, 5, 6, 7))
#define PG8_MMA(ai, bj, At, Bt) do { __builtin_amdgcn_s_setprio(1); _Pragma("unroll") for (int m = 0; m < 4; ++m) _Pragma("unroll") for (int n = 0; n < 2; ++n) { \
        if constexpr (F8) asm volatile("v_mfma_f32_16x16x128_f8f6f4 %0, %1, %2, %0" : "+v"(acc[ai][bj][m][n]) : "v"(Bt[n]), "v"(At[m])); \
        else { acc[ai][bj][m][n] = __builtin_amdgcn_mfma_f32_16x16x32_bf16(PG8_H0(Bt[n]), PG8_H0(At[m]), acc[ai][bj][m][n], 0, 0, 0); \
               acc[ai][bj][m][n] = __builtin_amdgcn_mfma_f32_16x16x32_bf16(PG8_H1(Bt[n]), PG8_H1(At[m]), acc[ai][bj][m][n], 0, 0, 0); } } \
        __builtin_amdgcn_s_setprio(0); } while (0)
#define PG8_WAIT_V(n) asm volatile("s_waitcnt vmcnt(" #n ")" ::: "memory")
#define PG8_WAIT_L(n) asm volatile("s_waitcnt lgkmcnt(" #n ")" ::: "memory")
#define PG8_BAR __builtin_amdgcn_s_barrier()
#define PG8_SCHED __builtin_amdgcn_sched_barrier(0)
#define PG8_EXPERT(u) do { if (g.grouped) { int _e = 0; _Pragma("unroll") for (int _k = 1; _k < 8; ++_k) _e += ((u).pm >= g.toff[_k]) ? 1 : 0; (u).e = _e; } } while (0)
    Unit cur, nxt; int ui = 0;
    if (!S.next(0, cur)) return;
    PG8_EXPERT(cur);
    f32x4 acc[2][2][4][2];
#pragma unroll
    for (int a = 0; a < 2; ++a)
#pragma unroll
        for (int b = 0; b < 2; ++b)
#pragma unroll
            for (int m = 0; m < 4; ++m)
#pragma unroll
                for (int n = 0; n < 2; ++n) acc[a][b][m][n] = (f32x4){0.f, 0.f, 0.f, 0.f};
    i32x8 At[4], B0[2], B1[2];
    const char* cA = (const char*)g.A + (size_t)cur.pm * tA; const char* cB = ((const char*)g.Bt + (size_t)cur.e * g.estride * ES) + (size_t)cur.pn * tB;
    PG8_STAGE(PG8_SB(0, 0), cB, voffB); PG8_STAGE(PG8_SA(0, 0), cA, voffA); PG8_STAGE(PG8_SB(0, 1), cB + hB, voffB); PG8_STAGE(PG8_SA(0, 1), cA + hA, voffA);
    if (wr == 1) PG8_BAR;
    PG8_WAIT_V(4); PG8_BAR;
    PG8_STAGE(PG8_SB(1, 0), cB + kstep, voffB); PG8_STAGE(PG8_SA(1, 0), cA + kstep, voffA); PG8_STAGE(PG8_SB(1, 1), cB + hB + kstep, voffB);
    PG8_WAIT_V(6); PG8_BAR;
    for (;;) {
        const bool has_next = S.next(ui + 1, nxt);
        if (has_next) PG8_EXPERT(nxt);
        const char* nA = has_next ? (const char*)g.A + (size_t)nxt.pm * tA : cA; const char* nB = has_next ? ((const char*)g.Bt + (size_t)nxt.e * g.estride * ES) + (size_t)nxt.pn * tB : cB;
        for (int t = 0; t < nt; t += 2) {
            const bool last = (t == nt - 2);
            const char* a1 = cA + (size_t)(t + 1) * kstep;
            const char* a2 = last ? nA : cA + (size_t)(t + 2) * kstep; const char* b2 = last ? nB : cB + (size_t)(t + 2) * kstep;
            const char* a3 = a2 + kstep; const char* b3 = b2 + kstep;
            PG8_LDB(B0, 0, 0); PG8_SCHED; PG8_LDA(At, 0, 0); PG8_STAGE(PG8_SA(1, 1), a1 + hA, voffA);
            PG8_WAIT_L(8); PG8_BAR; PG8_WAIT_L(0); PG8_MMA(0, 0, At, B0); PG8_BAR; PG8_SCHED;
            PG8_LDB(B1, 0, 1); PG8_STAGE(PG8_SB(0, 0), b2, voffB);
            PG8_BAR; PG8_WAIT_L(0); PG8_MMA(0, 1, At, B1); PG8_BAR;
            PG8_LDA(At, 0, 1); PG8_STAGE(PG8_SA(0, 0), a2, voffA);
            PG8_BAR; PG8_WAIT_L(0); PG8_MMA(1, 0, At, B0); PG8_BAR; PG8_SCHED;
            PG8_STAGE(PG8_SB(0, 1), b2 + hB, voffB);
            PG8_WAIT_V(6); PG8_BAR; PG8_MMA(1, 1, At, B1); PG8_BAR;
            PG8_LDB(B0, 1, 0); PG8_SCHED; PG8_LDA(At, 1, 0); PG8_STAGE(PG8_SA(0, 1), a2 + hA, voffA);
            PG8_WAIT_L(8); PG8_BAR; PG8_WAIT_L(0); PG8_MMA(0, 0, At, B0); PG8_BAR; PG8_SCHED;
            PG8_LDB(B1, 1, 1); PG8_STAGE(PG8_SB(1, 0), b3, voffB);
            PG8_BAR; PG8_WAIT_L(0); PG8_MMA(0, 1, At, B1); PG8_BAR;
            PG8_LDA(At, 1, 1); PG8_STAGE(PG8_SA(1, 0), a3, voffA);
            PG8_BAR; PG8_WAIT_L(0); PG8_MMA(1, 0, At, B0); PG8_BAR; PG8_SCHED;
            PG8_STAGE(PG8_SB(1, 1), b3 + hB, voffB);
            PG8_WAIT_V(6); PG8_BAR; PG8_MMA(1, 1, At, B1); PG8_BAR;
        }
        if constexpr (F8) asm volatile("s_nop 15\n\ts_nop 15" ::: "memory");
        E(acc, cur, wr, wc, fr, fq);
        if (!has_next) break;
#pragma unroll
        for (int a = 0; a < 2; ++a)
#pragma unroll
            for (int b = 0; b < 2; ++b)
#pragma unroll
                for (int m = 0; m < 4; ++m)
#pragma unroll
                    for (int n = 0; n < 2; ++n) acc[a][b][m][n] = (f32x4){0.f, 0.f, 0.f, 0.f};
        cur = nxt; cA = nA; cB = nB; ++ui;
    }
    PG8_WAIT_V(0);
    if (wr == 0) PG8_BAR;
    PG8_BAR;
#undef PG8_SA
#undef PG8_SB
#undef PG8_STAGE
#undef PG8_LDA
#undef PG8_LDB
#undef PG8_MMA
#undef PG8_H0
#undef PG8_H1
#undef PG8_LD8
#undef PG8_WAIT_V
#undef PG8_WAIT_L
#undef PG8_BAR
#undef PG8_SCHED
#undef PG8_EXPERT
}
}

__device__ __forceinline__ void gemm_bf16(LAS unsigned char* lds, const pg8::Gemm& g, bf16_t* O, int ldc) { pg8::EpiBf16 E{O, ldc, 1.f}; pg8::gemm_phase(lds, g, E); }
__device__ __forceinline__ void gemm8_bf16(LAS unsigned char* lds, const pg8::Gemm& g, bf16_t* O, int ldc) { pg8::EpiBf16 E{O, ldc, F8_INV}; pg8::gemm_phase<pg8::EpiBf16, true>(lds, g, E); }
__device__ __forceinline__ void gemm8_swiglu8(LAS unsigned char* lds, const pg8::Gemm& g, unsigned char* O, int ldc) { pg8::EpiSwiGLU8 E{O, ldc, F8_INV}; pg8::gemm_phase<pg8::EpiSwiGLU8, true>(lds, g, E); }
__device__ __forceinline__ void gemm_swiglu(LAS unsigned char* lds, const pg8::Gemm& g, bf16_t* O, int ldc) { pg8::EpiSwiGLU E{O, ldc}; pg8::gemm_phase(lds, g, E); }

namespace att {
#define SBAR() __builtin_amdgcn_sched_barrier(0)
__device__ __forceinline__ int crow(int r, int hi) { return (r & 3) + 8 * (r >> 2) + 4 * hi; }
__device__ __forceinline__ int v_st(int k, int c) { const int kk = (k & ~0xC) | ((k & 4) << 1) | ((k & 8) >> 1); return ((kk >> 3) * 4 + (c >> 5)) * 512 + ((kk & 7) * 32 + (c & 31)) * 2; }
__device__ __forceinline__ int v_rd_base(int lane) { return ((lane & 3) << 3) | (((lane >> 2) & 3) << 6) | (((lane >> 4) & 1) << 5) | (((lane >> 5) & 1) << 8); }
constexpr int v_rd_off(int d0, int ks, int half) { return d0 * 512 + ks * 4096 + half * 2048; }
template <int OFF> __device__ __forceinline__ s16x4 tr_read(unsigned vb) {
    s16x4 r; asm volatile("ds_read_b64_tr_b16 %0, %1 offset:%2" : "=&v"(r) : "v"(vb), "i"(OFF) : "memory"); return r;
}
template <int D0> __device__ __forceinline__ void pv_one(f32x16& od, unsigned vb, bf16x8 pa0, bf16x8 pa1, bf16x8 pa2, bf16x8 pa3) {
    const s16x4 l0 = tr_read<v_rd_off(D0, 0, 0)>(vb), h0 = tr_read<v_rd_off(D0, 0, 1)>(vb), l1 = tr_read<v_rd_off(D0, 1, 0)>(vb), h1 = tr_read<v_rd_off(D0, 1, 1)>(vb);
    const s16x4 l2 = tr_read<v_rd_off(D0, 2, 0)>(vb), h2 = tr_read<v_rd_off(D0, 2, 1)>(vb), l3 = tr_read<v_rd_off(D0, 3, 0)>(vb), h3 = tr_read<v_rd_off(D0, 3, 1)>(vb);
    asm volatile("s_waitcnt lgkmcnt(0)" ::: "memory"); SBAR();
#define PK(L, H) (bf16x8){L[0], L[1], L[2], L[3], H[0], H[1], H[2], H[3]}
    od = __builtin_amdgcn_mfma_f32_32x32x16_bf16(pa0, PK(l0, h0), od, 0, 0, 0);
    od = __builtin_amdgcn_mfma_f32_32x32x16_bf16(pa1, PK(l1, h1), od, 0, 0, 0);
    od = __builtin_amdgcn_mfma_f32_32x32x16_bf16(pa2, PK(l2, h2), od, 0, 0, 0);
    od = __builtin_amdgcn_mfma_f32_32x32x16_bf16(pa3, PK(l3, h3), od, 0, 0, 0);
#undef PK
}
__device__ __forceinline__ void rot8(bf16x8& a, bf16x8& b, const float* cs, const float* sn) {
    const f32x4 c0 = *(const f32x4*)cs, c1 = *(const f32x4*)(cs + 4), s0 = *(const f32x4*)sn, s1 = *(const f32x4*)(sn + 4);
    float c[8] = {c0[0], c0[1], c0[2], c0[3], c1[0], c1[1], c1[2], c1[3]}, s[8] = {s0[0], s0[1], s0[2], s0[3], s1[0], s1[1], s1[2], s1[3]};
    float o1[8], o2[8];
#pragma unroll
    for (int e = 0; e < 8; ++e) { const float x1 = bf2f((unsigned short)a[e]), x2 = bf2f((unsigned short)b[e]); o1[e] = x1 * c[e] - x2 * s[e]; o2[e] = x2 * c[e] + x1 * s[e]; }
    u32x4 wa = {cvtpk(o1[0], o1[1]), cvtpk(o1[2], o1[3]), cvtpk(o1[4], o1[5]), cvtpk(o1[6], o1[7])};
    u32x4 wb = {cvtpk(o2[0], o2[1]), cvtpk(o2[2], o2[3]), cvtpk(o2[4], o2[5]), cvtpk(o2[6], o2[7])};
    a = *reinterpret_cast<bf16x8*>(&wa); b = *reinterpret_cast<bf16x8*>(&wb);
}

struct Args {
    const bf16_t* Q; int ldq, qcol;
    const bf16_t* K; int ldk, kcol;
    const bf16_t* V; int ldv, vcol;
    int q_row0;
    int kctx_row0, klat_row0, nt_ctx, nt_lat;
    float C;
    int rope;
    const float* rcos; const float* rsin;
    bf16_t* O; int ldo, ocol;
    int g, u0; const float* rpb;
    float lam, oscale; const float* subg;
};

template <int DQK, int KW, int DV, int MODE>
__device__ __forceinline__ void attn_unit(LAS unsigned char* lds, const Args& a) {
    constexpr int ND = DQK / 16, NO = DV / 32;
    constexpr int KSTR = KW * 2 + 16, KBUF = 64 * KSTR;
    constexpr int OFF_V = 2 * KBUF, OFF_WS = OFF_V + 2 * 16384, OFF_RPB = OFF_WS + 2048;
    constexpr int KCH = KW / 8, NKCH = 64 * KCH, NKC = (NKCH + 511) / 512;
    constexpr int VCH = DV / 8, NVCH = 64 * VCH, NVC = (NVCH + 511) / 512;
    constexpr float THR2 = 8.f * LOG2E;
    const int tid = opaque_tid(), wid = __builtin_amdgcn_readfirstlane(tid >> 6), lane = tid & 63, r32 = lane & 31, hi = lane >> 5;
    LAS unsigned char* Kl = lds; LAS unsigned char* Vl = lds + OFF_V;
    LAS float* wsf = (LAS float*)(lds + OFF_WS) + wid * 64; LAS float* li_l = wsf; LAS float* al_l = wsf + 32;
    LAS float* rpbl = (LAS float*)(lds + OFF_RPB);
    const int wq = (MODE == 1) ? (wid & 3) : wid, wmap = (MODE == 1) ? (wid >> 2) : 0;
    const float Cs = (MODE == 2) ? 1.f : a.C; const float thr = THR2 / Cs;
    bf16x8 qr[ND];
    const int qrow = a.q_row0 + wq * 32 + r32;
    {
        const bf16_t* Qw = a.Q + (size_t)qrow * a.ldq + a.qcol + wmap * 64 + hi * 8;
#pragma unroll
        for (int d0 = 0; d0 < ND; ++d0) qr[d0] = *(const bf16x8*)(Qw + d0 * 16);
        if (a.rope == 1) { if constexpr (ND >= 4) { const int s = qrow & (SEQ - 1); const float* cs = a.rcos + s * 32 + hi * 8; const float* sn = a.rsin + s * 32 + hi * 8;
            rot8(qr[0], qr[2], cs, sn); rot8(qr[1], qr[3], cs + 16, sn + 16); } }
        if (a.rope == 2) { if constexpr (ND >= 6) { const int s = qrow & (SEQ - 1); rot8(qr[4], qr[5], a.rcos + s * 16 + hi * 8, a.rsin + s * 16 + hi * 8); } }
    }
    if (MODE == 2) { if (tid < 465) rpbl[tid] = a.rpb[tid] * LOG2E; }
    const int cq = (wid & 1) * 32 + r32, rq = 4 * a.g + (wid >> 1);
    const int rs = min(max(rq - 4, 0), 120), cs_ = min(max(cq - 8, 0), 48);
    int kgo[NKC], klo[NKC], vgo[NVC], vlo[NVC];
#pragma unroll
    for (int i = 0; i < NKC; ++i) { const int c = tid + 512 * i, row = c / KCH, ch = c % KCH; kgo[i] = row * a.ldk + ch * 8; klo[i] = row * KSTR + ch * 16; }
#pragma unroll
    for (int i = 0; i < NVC; ++i) { const int c = tid + 512 * i, row = c / VCH, ch = c % VCH; vgo[i] = row * a.ldv + ch * 8; vlo[i] = v_st(row, ch * 8); }
    u32x4 ksA[NKC], vsA[NVC], ksB[NKC], vsB[NVC];
    const int NT = a.nt_ctx + a.nt_lat;
#define TILE_ROW(j) ((j) < a.nt_ctx ? a.kctx_row0 + 64 * (j) : a.klat_row0 + 64 * ((j) - a.nt_ctx))
#define SLOAD(KS, VS, j) do { const int _r0 = TILE_ROW(j); const bf16_t* _kp = a.K + (size_t)_r0 * a.ldk + a.kcol; const bf16_t* _vp = a.V + (size_t)_r0 * a.ldv + a.vcol; \
    _Pragma("unroll") for (int _i = 0; _i < NKC; ++_i) if ((NKCH % 512 == 0) || tid + 512 * _i < NKCH) KS[_i] = *(const u32x4*)(_kp + kgo[_i]); \
    _Pragma("unroll") for (int _i = 0; _i < NVC; ++_i) if ((NVCH % 512 == 0) || tid + 512 * _i < NVCH) VS[_i] = *(const u32x4*)(_vp + vgo[_i]); } while (0)
#define SWRITE(b, KS, VS) do { \
    _Pragma("unroll") for (int _i = 0; _i < NKC; ++_i) if ((NKCH % 512 == 0) || tid + 512 * _i < NKCH) *(LAS u32x4*)(Kl + (b) * KBUF + klo[_i]) = KS[_i]; \
    _Pragma("unroll") for (int _i = 0; _i < NVC; ++_i) if ((NVCH % 512 == 0) || tid + 512 * _i < NVCH) *(LAS u32x4*)(Vl + (b) * 16384 + vlo[_i]) = VS[_i]; } while (0)
#define SWAIT() asm volatile("s_waitcnt vmcnt(%0)" :: "n"(NKC + NVC) : "memory")
    float m_reg = -1e30f, l_reg = 0.f;
    f32x16 o[NO];
#pragma unroll
    for (int d = 0; d < NO; ++d) o[d] = (f32x16){0.f, 0.f, 0.f, 0.f, 0.f, 0.f, 0.f, 0.f, 0.f, 0.f, 0.f, 0.f, 0.f, 0.f, 0.f, 0.f};
    const unsigned vb0 = (unsigned)(size_t)Vl + (unsigned)v_rd_base(lane);
#define QKT(P0, P1, b) do { P0 = (f32x16){0.f, 0.f, 0.f, 0.f, 0.f, 0.f, 0.f, 0.f, 0.f, 0.f, 0.f, 0.f, 0.f, 0.f, 0.f, 0.f}; P1 = P0; \
    const LAS unsigned char* _Kb = Kl + (b) * KBUF + wmap * 128; \
    _Pragma("unroll") for (int d0 = 0; d0 < ND; ++d0) { const int cb = (d0 * 16 + hi * 8) * 2; \
        const bf16x8 b0 = *(const LAS bf16x8*)(_Kb + r32 * KSTR + cb), b1 = *(const LAS bf16x8*)(_Kb + (32 + r32) * KSTR + cb); \
        P0 = __builtin_amdgcn_mfma_f32_32x32x16_bf16(b0, qr[d0], P0, 0, 0, 0); \
        P1 = __builtin_amdgcn_mfma_f32_32x32x16_bf16(b1, qr[d0], P1, 0, 0, 0); } } while (0)
#define PARTIAL(P0, P1, MN, AL, j) do { \
    if (MODE == 2) { \
        if ((j) >= a.nt_ctx) { const int kr = a.u0 + ((j) - a.nt_ctx); const bool rowok = (kr >= rs) && (kr < rs + 8); const int ro = min(max(kr - rq + 7, 0), 14); const LAS float* brow = rpbl + ro * 31; \
            _Pragma("unroll") for (int r = 0; r < 16; ++r) { \
                { const int ck = crow(r, hi), dd = min(max(ck - cq + 15, 0), 30); const bool inw = rowok && ((unsigned)(ck - cs_) < 16u); const float bv = brow[dd]; P0[r] = inw ? fmaf(P0[r], a.C, bv) : -1e30f; } \
                { const int ck = 32 + crow(r, hi), dd = min(max(ck - cq + 15, 0), 30); const bool inw = rowok && ((unsigned)(ck - cs_) < 16u); const float bv = brow[dd]; P1[r] = inw ? fmaf(P1[r], a.C, bv) : -1e30f; } } \
        } else { _Pragma("unroll") for (int r = 0; r < 16; ++r) { P0[r] *= a.C; P1[r] *= a.C; } } } \
    float pmax = P0[0]; \
    _Pragma("unroll") for (int r = 1; r < 16; ++r) pmax = fmaxf(pmax, P0[r]); \
    _Pragma("unroll") for (int r = 0; r < 16; ++r) pmax = fmaxf(pmax, P1[r]); \
    { auto rr = __builtin_amdgcn_permlane32_swap(__float_as_uint(pmax), __float_as_uint(pmax), false, false); pmax = fmaxf(__uint_as_float(rr[0]), __uint_as_float(rr[1])); } \
    if (__builtin_expect(__all(pmax - m_reg <= thr), 1)) { MN = m_reg; AL = 1.f; } \
    else { MN = fmaxf(m_reg, pmax); AL = fast_exp2((m_reg - MN) * Cs); m_reg = MN; } \
    const float mnC = -MN * Cs; \
    _Pragma("unroll") for (int r = 0; r < 16; ++r) P0[r] = fmaf(P0[r], Cs, mnC); \
    _Pragma("unroll") for (int r = 0; r < 16; ++r) P1[r] = fmaf(P1[r], Cs, mnC); \
    _Pragma("unroll") for (int r = 0; r < 16; ++r) P0[r] = fast_exp2(P0[r]); } while (0)
#define PK4(P, BASE, OUT) do { unsigned a0 = cvtpk(P[BASE + 0], P[BASE + 1]), a1 = cvtpk(P[BASE + 2], P[BASE + 3]);   \
    unsigned b0 = cvtpk(P[BASE + 4], P[BASE + 5]), b1 = cvtpk(P[BASE + 6], P[BASE + 7]);                              \
    auto r0 = __builtin_amdgcn_permlane32_swap(a0, b0, false, false); auto r1 = __builtin_amdgcn_permlane32_swap(a1, b1, false, false); \
    u32x4 w = {r0[0], r1[0], r0[1], r1[1]}; OUT = *reinterpret_cast<bf16x8*>(&w); } while (0)
#define FINISH(P0, P1, AL) do { \
    _Pragma("unroll") for (int r = 0; r < 16; ++r) P1[r] = fast_exp2(P1[r]); \
    float ps = 0.f; \
    _Pragma("unroll") for (int r = 0; r < 16; ++r) ps += P0[r]; \
    _Pragma("unroll") for (int r = 0; r < 16; ++r) ps += P1[r]; \
    { auto rr = __builtin_amdgcn_permlane32_swap(__float_as_uint(ps), __float_as_uint(ps), false, false); ps = __uint_as_float(rr[0]) + __uint_as_float(rr[1]); } \
    l_reg = l_reg * AL + ps; \
    PK4(P0, 0, pa0); PK4(P0, 8, pa1); PK4(P1, 0, pa2); PK4(P1, 8, pa3); } while (0)
#define PV(b) do { const unsigned _vb = vb0 + (unsigned)(b) * 16384u; \
    pv_one<0>(o[0], _vb, pa0, pa1, pa2, pa3); pv_one<1>(o[1], _vb, pa0, pa1, pa2, pa3); \
    if constexpr (NO == 4) { pv_one<2>(o[2], _vb, pa0, pa1, pa2, pa3); pv_one<3>(o[3], _vb, pa0, pa1, pa2, pa3); } } while (0)
#define RESC(AL) do { if (__any((AL) < 1.f)) { if (hi == 0) al_l[r32] = (AL); LDS_WAIT(); \
    _Pragma("unroll") for (int r = 0; r < 16; ++r) { const float av = al_l[crow(r, hi)]; \
        _Pragma("unroll") for (int d = 0; d < NO; ++d) o[d][r] *= av; } } } while (0)
    f32x16 pA0, pA1, pB0, pB1; float mnA, mnB, alA, alB; bf16x8 pa0, pa1, pa2, pa3;
    SLOAD(ksA, vsA, 0); VM_WAIT(); SWRITE(0, ksA, vsA); __syncthreads();
    QKT(pA0, pA1, 0); PARTIAL(pA0, pA1, mnA, alA, 0);
    SLOAD(ksB, vsB, 1); if (2 < NT) SLOAD(ksA, vsA, 2);
    SWAIT(); SWRITE(1, ksB, vsB); __syncthreads();
    for (int j = 1; j + 1 < NT; j += 2) {
        SBAR(); QKT(pB0, pB1, 1);
        FINISH(pA0, pA1, alA); SBAR();
        SLOAD(ksB, vsB, j + 2); SBAR();
        PV(0); PARTIAL(pB0, pB1, mnB, alB, j);
        __syncthreads(); SWAIT(); SWRITE(0, ksA, vsA);
        RESC(alB); __syncthreads();
        SBAR(); QKT(pA0, pA1, 0);
        FINISH(pB0, pB1, alB); SBAR();
        if (j + 3 < NT) SLOAD(ksA, vsA, j + 3); SBAR();
        PV(1); PARTIAL(pA0, pA1, mnA, alA, j + 1);
        __syncthreads(); SWAIT(); SWRITE(1, ksB, vsB);
        RESC(alA); __syncthreads();
    }
    SBAR(); QKT(pB0, pB1, 1);
    FINISH(pA0, pA1, alA); SBAR();
    PV(0); PARTIAL(pB0, pB1, mnB, alB, NT - 1);
    __syncthreads(); RESC(alB);
    FINISH(pB0, pB1, alB); SBAR();
    PV(1);
    __syncthreads();
#undef TILE_ROW
#undef SLOAD
#undef SWRITE
#undef SWAIT
#undef QKT
#undef PARTIAL
#undef PK4
#undef FINISH
#undef PV
#undef RESC
    if (hi == 0) li_l[r32] = l_reg; LDS_WAIT();
    float rli[16];
#pragma unroll
    for (int r = 0; r < 16; ++r) rli[r] = fast_rcp(li_l[crow(r, hi)]);
    if (MODE != 1) {
        bf16_t* Ow = a.O + (size_t)(a.q_row0 + wid * 32) * a.ldo + a.ocol + r32;
#pragma unroll
        for (int r = 0; r < 16; ++r) { const int orow = crow(r, hi);
#pragma unroll
            for (int d0 = 0; d0 < NO; ++d0) Ow[(size_t)orow * a.ldo + d0 * 32] = f2bf(o[d0][r] * rli[r]); }
    } else {
        LAS float* cb = (LAS float*)lds;
        if (wmap == 1) {
#pragma unroll
            for (int r = 0; r < 16; ++r) { const int row = wq * 32 + crow(r, hi);
#pragma unroll
                for (int d0 = 0; d0 < NO; ++d0) cb[row * 129 + d0 * 32 + r32] = a.lam * o[d0][r] * rli[r]; }
        }
        __syncthreads();
        if (wmap == 0) {
#pragma unroll
            for (int r = 0; r < 16; ++r) { const int row = wq * 32 + crow(r, hi);
#pragma unroll
                for (int d0 = 0; d0 < NO; ++d0) { const int ix = row * 129 + d0 * 32 + r32; cb[ix] = o[d0][r] * rli[r] - cb[ix]; } }
        }
        __syncthreads();
        const int row = tid >> 2, qd = tid & 3;
        float v[32]; float ss = 0.f;
#pragma unroll
        for (int i = 0; i < 32; ++i) { v[i] = cb[row * 129 + qd * 32 + i]; ss += v[i] * v[i]; }
        ss += __shfl_xor(ss, 1); ss += __shfl_xor(ss, 2);
        const float rstd = rsqrtf(ss * (1.f / 128.f) + EPS) * a.oscale;
        bf16_t* Ow = a.O + (size_t)(a.q_row0 + row) * a.ldo + a.ocol + qd * 32;
#pragma unroll
        for (int c = 0; c < 4; ++c) { float w[8];
#pragma unroll
            for (int e = 0; e < 8; ++e) w[e] = v[c * 8 + e] * rstd * a.subg[qd * 32 + c * 8 + e];
            u32x4 pk = {cvtpk(w[0], w[1]), cvtpk(w[2], w[3]), cvtpk(w[4], w[5]), cvtpk(w[6], w[7])};
            *(u32x4*)(Ow + c * 8) = pk; }
    }
    __syncthreads();
}

__device__ __forceinline__ void sgu_unit(LAS unsigned char* lds, const bf16_t* PB, const bf16_t* Wsb, const float* bs, bf16_t* MIX, int rowbase, int g) {
    const int tid = opaque_tid(), wid = __builtin_amdgcn_readfirstlane(tid >> 6), lane = tid & 63, r32 = lane & 31, hi = lane >> 5;
    LAS unsigned char* Vl = lds;
#pragma unroll
    for (int i = 0; i < 4; ++i) { const int c = tid + 512 * i, row = c >> 4, ch = c & 15;
        const u32x4 x = *(const u32x4*)(PB + (size_t)(rowbase + row) * EV_IN + 512 + g * 128 + ch * 8);
        *(LAS u32x4*)(Vl + (row >> 6) * 16384 + v_st(row & 63, ch * 8)) = x; }
    const int prow = (wid & 3) * 32, dh = wid >> 2;
    bf16x8 pa[2][4];
#pragma unroll
    for (int kt = 0; kt < 2; ++kt)
#pragma unroll
        for (int ks = 0; ks < 4; ++ks) pa[kt][ks] = *(const bf16x8*)(Wsb + (size_t)(g * 128 + prow + r32) * 128 + kt * 64 + ks * 16 + hi * 8);
    __syncthreads();
    f32x16 o[2];
    o[0] = (f32x16){0.f, 0.f, 0.f, 0.f, 0.f, 0.f, 0.f, 0.f, 0.f, 0.f, 0.f, 0.f, 0.f, 0.f, 0.f, 0.f}; o[1] = o[0];
    const unsigned vb0 = (unsigned)(size_t)Vl + (unsigned)v_rd_base(lane);
#pragma unroll
    for (int kt = 0; kt < 2; ++kt) { const unsigned vb = vb0 + kt * 16384u;
        if (dh == 0) { pv_one<0>(o[0], vb, pa[kt][0], pa[kt][1], pa[kt][2], pa[kt][3]); pv_one<1>(o[1], vb, pa[kt][0], pa[kt][1], pa[kt][2], pa[kt][3]); }
        else { pv_one<2>(o[0], vb, pa[kt][0], pa[kt][1], pa[kt][2], pa[kt][3]); pv_one<3>(o[1], vb, pa[kt][0], pa[kt][1], pa[kt][2], pa[kt][3]); } }
#pragma unroll
    for (int r = 0; r < 16; ++r) { const int p = prow + crow(r, hi); const float bias = bs[g * 128 + p];
#pragma unroll
        for (int dd = 0; dd < 2; ++dd) { const int d = (2 * dh + dd) * 32 + r32;
            const float u = bf2f(PB[(size_t)(rowbase + p) * EV_IN + g * 128 + d]);
            MIX[(size_t)(rowbase + p) * DM + g * 128 + d] = f2bf(u * (o[dd][r] + bias)); } }
    __syncthreads();
}
}

struct Params {
    const float* in[31];
    float* out;
    unsigned char* ws;
    int ph_lo, ph_hi;
};

struct Ctx {
    LAS unsigned char* lds;
    int tid, lane, wid, gw, NGW;
};
__device__ __forceinline__ Ctx make_ctx(LAS unsigned char* lds) { const int t = opaque_tid(), w = __builtin_amdgcn_readfirstlane(t >> 6); return Ctx{lds, t, t & 63, w, (int)blockIdx.x * 8 + w, (int)gridDim.x * 8}; }
typedef const __attribute__((address_space(4))) Params KParams;
__device__ __forceinline__ KParams& kparams() { KParams* p = (KParams*)__builtin_amdgcn_kernarg_segment_ptr(); asm volatile("" : "+s"(p)); return *p; }

__device__ __forceinline__ float* xrow_ptr(KParams& P, int row) { return row < NLAT ? P.out + (size_t)row * DM : (float*)(P.ws + WS_CTXX) + (size_t)(row - NLAT) * DM; }
__device__ __forceinline__ int mod_r(int row) { return row < NLAT ? (row >> 13) : 4; }
__device__ __forceinline__ f32x4 ld4(const float* p) { return *(const f32x4*)p; }
__device__ __forceinline__ f32x4 ldbf4(const bf16_t* p) { const u32x2 w = *(const u32x2*)p; return (f32x4){bflo(w.x), bfhi(w.x), bflo(w.y), bfhi(w.y)}; }
__device__ __forceinline__ void stbf4(bf16_t* p, f32x4 v) { u32x2 w; w.x = cvtpk(v[0], v[1]); w.y = cvtpk(v[2], v[3]); *(u32x2*)p = w; }
__device__ __forceinline__ float sumsq4(const f32x4 (&v)[4]) { float s = 0.f;
#pragma unroll
    for (int j = 0; j < 4; ++j) s += (v[j][0] * v[j][0] + v[j][1] * v[j][1]) + (v[j][2] * v[j][2] + v[j][3] * v[j][3]);
    return wave_sum(s); }
__device__ __forceinline__ void norm_mod(const f32x4 (&x)[4], f32x4 (&hv)[4], const float* gain, const float* shift, const float* scale, int lane) {
    const float rstd = rsqrtf(sumsq4(x) * (1.f / DM) + EPS);
#pragma unroll
    for (int j = 0; j < 4; ++j) { const int c = 4 * lane + 256 * j; const f32x4 g = ld4(gain + c), sh = ld4(shift + c), sc = ld4(scale + c);
        hv[j] = (x[j] * rstd) * g * (sc + 1.f) + sh; }
}
__device__ __forceinline__ void resid_add(f32x4 (&x)[4], const f32x4 (&y)[4], const float* gain, const float* gate, int lane) {
    const float rstd = rsqrtf(sumsq4(y) * (1.f / DM) + EPS);
#pragma unroll
    for (int j = 0; j < 4; ++j) { const int c = 4 * lane + 256 * j; const f32x4 g = ld4(gain + c), gt = ld4(gate + c);
        x[j] = x[j] + gt * ((y[j] * rstd) * g); }
}

__device__ __forceinline__ void tr_item(const float* W, int ldw, bf16_t* WT, int ldt, int k0, int n0, int drow, LAS float* scr, int lane) {
#pragma unroll 8
    for (int i = 0; i < 32; ++i) { const int kk = 2 * i + (lane >> 5); scr[kk * 33 + (lane & 31)] = W[(size_t)(k0 + kk) * ldw + n0 + (lane & 31)]; }
    LDS_WAIT(); asm volatile("" ::: "memory");
    const int c = lane & 7;
#pragma unroll
    for (int j = 0; j < 4; ++j) { const int n = (lane >> 3) + 8 * j; const LAS float* s = scr + (8 * c) * 33 + n;
        u32x4 o; o.x = cvtpk(s[0 * 33], s[1 * 33]); o.y = cvtpk(s[2 * 33], s[3 * 33]); o.z = cvtpk(s[4 * 33], s[5 * 33]); o.w = cvtpk(s[6 * 33], s[7 * 33]);
        *(u32x4*)(WT + (size_t)(drow + n) * ldt + k0 + 8 * c) = o; }
    LDS_WAIT(); asm volatile("" ::: "memory");
}
__device__ __forceinline__ void tr_item8(const float* W, int ldw, unsigned char* WT, int ldt, int k0, int n0, int drow, LAS float* scr, int lane) {
#pragma unroll 8
    for (int i = 0; i < 32; ++i) { const int kk = 2 * i + (lane >> 5); scr[kk * 33 + (lane & 31)] = W[(size_t)(k0 + kk) * ldw + n0 + (lane & 31)] * F8_W_SCALE; }
    LDS_WAIT(); asm volatile("" ::: "memory");
    const int c = lane & 7;
#pragma unroll
    for (int j = 0; j < 4; ++j) { const int n = (lane >> 3) + 8 * j; const LAS float* s = scr + (8 * c) * 33 + n;
        u32x2 o; o.x = pk4_fp8(s[0 * 33], s[1 * 33], s[2 * 33], s[3 * 33]); o.y = pk4_fp8(s[4 * 33], s[5 * 33], s[6 * 33], s[7 * 33]);
        *(u32x2*)(WT + (size_t)(drow + n) * ldt + k0 + 8 * c) = o; }
    LDS_WAIT(); asm volatile("" ::: "memory");
}
__device__ __forceinline__ void tr_matrix8(const Ctx& c, const float* W, int K, int N, unsigned char* WT, int mode, int row_off) {
    LAS float* scr = (LAS float*)(c.lds + c.wid * 16384);
    const int nblk = N / 32, nitems = (K / 64) * nblk;
    for (int it = c.gw; it < nitems; it += c.NGW) { const int kb = it / nblk, nb = it % nblk, n0 = 32 * nb;
        const int drow = (mode == 0) ? row_off + n0 : (n0 >> 7) * 256 + (n0 & 127) + (mode == 2 ? 128 : 0);
        tr_item8(W, N, WT, K, 64 * kb, n0, drow, scr, c.lane); }
}
__device__ __forceinline__ void tr_matrix(const Ctx& c, const float* W, int K, int N, bf16_t* WT, int mode, int row_off) {
    LAS float* scr = (LAS float*)(c.lds + c.wid * 16384);
    const int nblk = N / 32, nitems = (K / 64) * nblk;
    for (int it = c.gw; it < nitems; it += c.NGW) { const int kb = it / nblk, nb = it % nblk, n0 = 32 * nb;
        const int drow = (mode == 0) ? row_off + n0 : (n0 >> 7) * 256 + (n0 & 127) + (mode == 2 ? 128 : 0);
        tr_item(W, N, WT, K, 64 * kb, n0, drow, scr, c.lane); }
}
__device__ __forceinline__ void convert_moe(const Ctx& c_, int i) {
    const Ctx c = make_ctx(c_.lds);
    KParams& P = kparams();
    for (int e = 0; e < NEXP; ++e) {
#if MOE_F8
        tr_matrix8(c, P.in[28] + ((size_t)i * NEXP + e) * DM * DFFE, DM, DFFE, (unsigned char*)(P.ws + WS_W13M) + (size_t)e * 2 * DFFE * DM, 1, 0);
        tr_matrix8(c, P.in[29] + ((size_t)i * NEXP + e) * DM * DFFE, DM, DFFE, (unsigned char*)(P.ws + WS_W13M) + (size_t)e * 2 * DFFE * DM, 2, 0);
        tr_matrix8(c, P.in[30] + ((size_t)i * NEXP + e) * DFFE * DM, DFFE, DM, (unsigned char*)(P.ws + WS_W2M) + (size_t)e * DM * DFFE, 0, 0);
#else
        tr_matrix(c, P.in[28] + ((size_t)i * NEXP + e) * DM * DFFE, DM, DFFE, (bf16_t*)(P.ws + WS_W13M) + (size_t)e * 2 * DFFE * DM, 1, 0);
        tr_matrix(c, P.in[29] + ((size_t)i * NEXP + e) * DM * DFFE, DM, DFFE, (bf16_t*)(P.ws + WS_W13M) + (size_t)e * 2 * DFFE * DM, 2, 0);
        tr_matrix(c, P.in[30] + ((size_t)i * NEXP + e) * DFFE * DM, DFFE, DM, (bf16_t*)(P.ws + WS_W2M) + (size_t)e * DM * DFFE, 0, 0);
#endif
    }
}
__device__ __forceinline__ void prologue0(const Ctx& c_) {
    const Ctx c = make_ctx(c_.lds);
    KParams& P = kparams(); unsigned char* ws = P.ws;
    if (blockIdx.x < 96) {
        LAS float* sl = (LAS float*)c.lds;
        LAS float* part = (LAS float*)(c.lds + 32768);
        for (int i = c.tid; i < 5 * DM; i += 512) { const int r = i >> 10, k = i & 1023; const float x = r < 4 ? P.in[1][r * DM + k] : P.in[3][k]; sl[i] = x / (1.f + expf(-x)); }
        __syncthreads();
        const int t = blockIdx.x, lm = t / 24, cbk = t % 24, n = cbk * 256 + 4 * c.lane;
        const float* W = P.in[4] + (size_t)lm * DM * (NMOD * DM) + n;
        f32x4 acc[5];
#pragma unroll
        for (int r = 0; r < 5; ++r) acc[r] = (f32x4){0.f, 0.f, 0.f, 0.f};
        const int kb = c.wid * 128;
        for (int k0 = 0; k0 < 128; k0 += 8) {
            f32x4 wv[8];
#pragma unroll
            for (int u = 0; u < 8; ++u) wv[u] = ld4(W + (size_t)(kb + k0 + u) * (NMOD * DM));
#pragma unroll
            for (int u = 0; u < 8; ++u)
#pragma unroll
                for (int r = 0; r < 5; ++r) acc[r] += wv[u] * sl[r * DM + kb + k0 + u];
        }
#pragma unroll
        for (int r = 0; r < 5; ++r) *(LAS f32x4*)(part + (c.wid * 5 + r) * 256 + 4 * c.lane) = acc[r];
        __syncthreads();
        for (int i = c.tid; i < 5 * 256; i += 512) { const int r = i >> 8, cc = i & 255; float s = 0.f;
#pragma unroll
            for (int w = 0; w < 8; ++w) s += part[(w * 5 + r) * 256 + cc];
            ((float*)(ws + WS_MODS))[(size_t)(lm * 5 + r) * (NMOD * DM) + cbk * 256 + cc] = s + P.in[5][lm * (NMOD * DM) + cbk * 256 + cc]; }
        __syncthreads();
    }
    for (int i = 0; i < 2; ++i) {
        tr_matrix(c, P.in[7] + (size_t)i * DM * EV_IN, DM, EV_IN, (bf16_t*)(ws + WS_WINE) + (size_t)i * EV_IN * DM, 0, 0);
        tr_matrix(c, P.in[8] + (size_t)i * DM * DM, DM, DM, (bf16_t*)(ws + WS_WOUTE) + (size_t)i * DM * DM, 0, 0);
        tr_matrix(c, P.in[17] + (size_t)i * DM * DFF, DM, DFF, (bf16_t*)(ws + WS_W13E) + (size_t)i * 2 * DFF * DM, 1, 0);
        tr_matrix(c, P.in[18] + (size_t)i * DM * DFF, DM, DFF, (bf16_t*)(ws + WS_W13E) + (size_t)i * 2 * DFF * DM, 2, 0);
        tr_matrix(c, P.in[19] + (size_t)i * DFF * DM, DFF, DM, (bf16_t*)(ws + WS_W2E) + (size_t)i * DM * DFF, 0, 0);
        tr_matrix(c, P.in[20] + (size_t)i * DM * OD_IN, DM, OD_IN, (bf16_t*)(ws + WS_WINO) + (size_t)i * OD_INP * DM, 0, 0);
        tr_matrix(c, P.in[21] + (size_t)i * DM * DM, DM, DM, (bf16_t*)(ws + WS_WOUTO) + (size_t)i * DM * DM, 0, 0);
    }
    const int gt = blockIdx.x * 512 + c.tid, NGT = gridDim.x * 512;
    for (int i = gt; i < 2 * (OD_INP - OD_IN) * DM; i += NGT) { const int l = i / ((OD_INP - OD_IN) * DM), r = i % ((OD_INP - OD_IN) * DM);
        ((bf16_t*)(ws + WS_WINO))[(size_t)l * OD_INP * DM + (size_t)OD_IN * DM + r] = 0; }
    for (int i = gt; i < 2 * MLA_N * MLA_K; i += NGT) { const int l = i / (MLA_N * MLA_K), n = (i / MLA_K) % MLA_N, k = i % MLA_K; float v = 0.f;
        if (n < 384) { if (k < 256) v = P.in[24][((size_t)l * 256 + k) * 384 + n]; }
        else if (n < 768) { const int h = (n - 384) / 96, j = (n - 384) % 96;
            if (j < 64) { if (k >= 256 && k < 384) v = P.in[26][((size_t)l * 128 + (k - 256)) * 768 + h * 192 + j]; }
            else { if (k == 384 + (j - 64)) v = 1.f; } }
        else { const int h = (n - 768) / 128, j = (n - 768) % 128; if (k >= 256 && k < 384) v = P.in[26][((size_t)l * 128 + (k - 256)) * 768 + h * 192 + 64 + j]; }
        ((bf16_t*)(ws + WS_WMLA))[i] = f2bf(v); }
    for (int i = gt; i < 2 * 4 * 128 * 128; i += NGT) ((bf16_t*)(ws + WS_SGUW))[i] = f2bf(P.in[9][i]);
    for (int i = gt; i < SEQ * 32; i += NGT) { const int s = i >> 5, f = i & 31; const int pos = f < 16 ? (s >> 6) : (s & 63);
        const float inv = 1.0f / powf(10000.0f, (float)(f & 15) / 16.0f); const float ang = (float)pos * inv;
        ((float*)(ws + WS_ROPEB))[i] = (float)cos((double)ang); ((float*)(ws + WS_ROPEB))[SEQ * 32 + i] = (float)sin((double)ang); }
    for (int i = gt; i < SEQ * 16; i += NGT) { const int s = i >> 4, f = i & 15; const int pos = f < 8 ? (s >> 6) : (s & 63);
        const float inv = 1.0f / powf(10000.0f, (float)(f & 7) / 8.0f); const float ang = (float)pos * inv;
        ((float*)(ws + WS_ROPED))[i] = (float)cos((double)ang); ((float*)(ws + WS_ROPED))[SEQ * 16 + i] = (float)sin((double)ang); }
    convert_moe(c, 0);
}

__device__ __forceinline__ void ew_first(const Ctx& c_) {
    const Ctx c = make_ctx(c_.lds);
    KParams& P = kparams(); const float* mods = (const float*)(P.ws + WS_MODS); bf16_t* HB = (bf16_t*)(P.ws + WS_HB);
    for (int row = c.gw; row < MTOT; row += c.NGW) {
        const float* src = row < NLAT ? P.in[0] + (size_t)row * DM : P.in[2] + (size_t)(row - NLAT) * DM;
        float* xr = xrow_ptr(P, row); const int r = mod_r(row);
        f32x4 x[4], h[4];
#pragma unroll
        for (int j = 0; j < 4; ++j) { x[j] = ld4(src + 4 * c.lane + 256 * j); *(f32x4*)(xr + 4 * c.lane + 256 * j) = x[j]; }
        const float* mb = mods + (size_t)(0 * 5 + r) * (NMOD * DM);
        norm_mod(x, h, P.in[6] + (0 * 4 + 0) * DM, mb + 0 * DM, mb + 1 * DM, c.lane);
#pragma unroll
        for (int j = 0; j < 4; ++j) stbf4(HB + (size_t)row * DM + 4 * c.lane + 256 * j, h[j]);
    }
}

__device__ __forceinline__ void ew_even_mix(const Ctx& c_, int i) {
    const Ctx c = make_ctx(c_.lds);
    KParams& P = kparams(); bf16_t* PB = (bf16_t*)(P.ws + WS_U + U_PB);
    const float* sg = P.in[11] + i * 512; const float* rc = (const float*)(P.ws + WS_ROPEB); const float* rsn = rc + SEQ * 32;
    for (int row = c.gw; row < MTOT; row += c.NGW) {
        bf16_t* pr = PB + (size_t)row * EV_IN;
        {
            const u32x4 w = *(const u32x4*)(pr + 8 * c.lane); float f[8] = {bflo(w.x), bfhi(w.x), bflo(w.y), bfhi(w.y), bflo(w.z), bfhi(w.z), bflo(w.w), bfhi(w.w)};
#pragma unroll
            for (int e = 0; e < 8; ++e) f[e] = gelu_tanh_f(f[e]);
            u32x4 o = {cvtpk(f[0], f[1]), cvtpk(f[2], f[3]), cvtpk(f[4], f[5]), cvtpk(f[6], f[7])}; *(u32x4*)(pr + 8 * c.lane) = o;
        }
        {
            const u32x4 w = *(const u32x4*)(pr + 512 + 8 * c.lane); float f[8] = {bflo(w.x), bfhi(w.x), bflo(w.y), bfhi(w.y), bflo(w.z), bfhi(w.z), bflo(w.w), bfhi(w.w)};
            float s = 0.f;
#pragma unroll
            for (int e = 0; e < 8; ++e) { f[e] = gelu_tanh_f(f[e]); s += f[e]; }
            const float mean = wave_sum(s) * (1.f / 512.f); float q = 0.f;
#pragma unroll
            for (int e = 0; e < 8; ++e) { f[e] -= mean; q += f[e] * f[e]; }
            const float rstd = rsqrtf(wave_sum(q) * (1.f / 512.f) + EPS);
            const f32x4 g0 = ld4(sg + 8 * c.lane), g1 = ld4(sg + 8 * c.lane + 4);
            float gg[8] = {g0[0], g0[1], g0[2], g0[3], g1[0], g1[1], g1[2], g1[3]};
#pragma unroll
            for (int e = 0; e < 8; ++e) f[e] = f[e] * rstd * gg[e];
            u32x4 o = {cvtpk(f[0], f[1]), cvtpk(f[2], f[3]), cvtpk(f[4], f[5]), cvtpk(f[6], f[7])}; *(u32x4*)(pr + 512 + 8 * c.lane) = o;
        }
        if (row < NLAT) {
            const int s = row & (SEQ - 1), hj = c.lane >> 3, sub = c.lane & 7;
            bf16_t* kp = pr + 1536 + hj * 64 + 4 * sub;
            const f32x4 x1 = ldbf4(kp), x2 = ldbf4(kp + 32), cs = ld4(rc + s * 32 + 4 * sub), sn = ld4(rsn + s * 32 + 4 * sub);
            stbf4(kp, x1 * cs - x2 * sn); stbf4(kp + 32, x2 * cs + x1 * sn);
        }
    }
}

__device__ __forceinline__ void ew_odd_mla(const Ctx& c_, int i) {
    const Ctx c = make_ctx(c_.lds);
    KParams& P = kparams(); const bf16_t* PB = (const bf16_t*)(P.ws + WS_U + U_PB); bf16_t* A2 = (bf16_t*)(P.ws + WS_U + U_A2);
    const float* gq = P.in[23] + i * 256; const float* gkv = P.in[25] + i * 128; const float* rc = (const float*)(P.ws + WS_ROPED); const float* rsn = rc + SEQ * 16;
    for (int row = c.gw; row < MTOT; row += c.NGW) {
        const bf16_t* pr = PB + (size_t)row * OD_INP; bf16_t* ar = A2 + (size_t)row * MLA_K;
        f32x4 q = ldbf4(pr + 1536 + 4 * c.lane);
        const float rq = rsqrtf(wave_sum(q[0] * q[0] + q[1] * q[1] + q[2] * q[2] + q[3] * q[3]) * (1.f / 256.f) + EPS);
        stbf4(ar + 4 * c.lane, q * rq * ld4(gq + 4 * c.lane));
        const unsigned kw = *(const unsigned*)(pr + 1792 + 2 * c.lane); const float k0 = bflo(kw), k1 = bfhi(kw);
        const float rk = rsqrtf(wave_sum(k0 * k0 + k1 * k1) * (1.f / 128.f) + EPS);
        *(unsigned*)(ar + 256 + 2 * c.lane) = cvtpk(k0 * rk * gkv[2 * c.lane], k1 * rk * gkv[2 * c.lane + 1]);
        if (c.lane < 16) { float x1 = bf2f(pr[1920 + c.lane]), x2 = bf2f(pr[1920 + 16 + c.lane]);
            if (row < NLAT) { const int s = row & (SEQ - 1); const float cs = rc[s * 16 + c.lane], sn = rsn[s * 16 + c.lane]; const float o1 = x1 * cs - x2 * sn, o2 = x2 * cs + x1 * sn; x1 = o1; x2 = o2; }
            ar[384 + c.lane] = f2bf(x1); ar[384 + 16 + c.lane] = f2bf(x2); }
        else { *(unsigned*)(ar + 416 + 2 * (c.lane - 16)) = 0u; }
    }
}

__device__ __forceinline__ void ew_mid(const Ctx& c_, int l, int mtok) {
    const Ctx c = make_ctx(c_.lds);
    KParams& P = kparams(); const float* mods = (const float*)(P.ws + WS_MODS); bf16_t* HB = (bf16_t*)(P.ws + WS_HB);
    const bf16_t* YB = (const bf16_t*)(P.ws + WS_U + U_YB);
    const bool odd = (l & 1) != 0; const int li = l >> 1;
    LAS float* wrl = (LAS float*)c.lds;
    if (odd) { for (int i = c.tid; i < DM * NEXP; i += 512) { const int col = i >> 3, e = i & 7; wrl[e * DM + col] = P.in[27][(size_t)li * DM * NEXP + i]; } __syncthreads(); }
    unsigned long long cw = 0ull; int st_e1 = 0, st_e2 = 0, st_l1 = 0, st_l2 = 0; float st_g1 = 0.f; int nrow = 0;
    for (int row = c.gw; row < mtok; row += c.NGW, ++nrow) {
        float* xr = xrow_ptr(P, row); const int r = mod_r(row); const float* mb = mods + (size_t)(l * 5 + r) * (NMOD * DM);
        f32x4 x[4], y[4], h[4];
#pragma unroll
        for (int j = 0; j < 4; ++j) { x[j] = ld4(xr + 4 * c.lane + 256 * j); y[j] = ldbf4(YB + (size_t)row * DM + 4 * c.lane + 256 * j); }
        resid_add(x, y, P.in[6] + (l * 4 + 1) * DM, mb + 2 * DM, c.lane);
#pragma unroll
        for (int j = 0; j < 4; ++j) *(f32x4*)(xr + 4 * c.lane + 256 * j) = x[j];
        norm_mod(x, h, P.in[6] + (l * 4 + 2) * DM, mb + 3 * DM, mb + 4 * DM, c.lane);
#pragma unroll
        for (int j = 0; j < 4; ++j) stbf4(HB + (size_t)row * DM + 4 * c.lane + 256 * j, h[j]);
        if (odd) {
            float lg[8];
#pragma unroll
            for (int e = 0; e < 8; ++e) { float s = 0.f;
#pragma unroll
                for (int j = 0; j < 4; ++j) { const f32x4 w = *(const LAS f32x4*)(wrl + e * DM + 4 * c.lane + 256 * j); s += (h[j][0] * w[0] + h[j][1] * w[1]) + (h[j][2] * w[2] + h[j][3] * w[3]); }
                lg[e] = wave_sum(s); }
            int e1 = 0; float v1 = lg[0];
#pragma unroll
            for (int e = 1; e < 8; ++e) if (lg[e] > v1) { v1 = lg[e]; e1 = e; }
            int e2 = -1; float v2 = -3.0e38f;
#pragma unroll
            for (int e = 0; e < 8; ++e) if (e != e1 && lg[e] > v2) { v2 = lg[e]; e2 = e; }
            if (e2 < 0) e2 = (e1 + 1) & 7;
            const float g1 = 1.f / (1.f + expf(v2 - v1));
            const int l1 = (int)((cw >> (8 * e1)) & 0xffull); cw += 1ull << (8 * e1);
            const int l2 = (int)((cw >> (8 * e2)) & 0xffull); cw += 1ull << (8 * e2);
            if (c.lane == nrow) { st_e1 = e1; st_e2 = e2; st_l1 = l1; st_l2 = l2; st_g1 = g1; }
        }
    }
    if (odd) {
        unsigned* cnt = (unsigned*)(P.ws + WS_CTL) + CW_MOECNT + li * 64;
        int base = 0;
        if (c.lane < 8) { const unsigned wc = (unsigned)((cw >> (8 * c.lane)) & 0xffull); base = wc ? (int)atomicAdd(cnt + c.lane, wc) : 0; }
        const int b1 = __shfl(base, st_e1), b2 = __shfl(base, st_e2);
        if (c.lane < nrow) { const int row = c.gw + c.lane * c.NGW; int4* ti = (int4*)(P.ws + WS_TOKINFO) + (size_t)row * 2;
            ti[0] = make_int4(st_e1, b1 + st_l1, st_e2, b2 + st_l2); ti[1] = make_int4(__float_as_int(st_g1), __float_as_int(1.f - st_g1), 0, 0); }
        __syncthreads();
    }
}

__device__ __forceinline__ void moe_offsets(KParams& P, int li, int (&toff)[9]) {
    const unsigned* cnt = (const unsigned*)(P.ws + WS_CTL) + CW_MOECNT + li * 64; int acc = 0;
#pragma unroll
    for (int e = 0; e < 8; ++e) { toff[e] = acc; const unsigned n = __builtin_amdgcn_readfirstlane(__hip_atomic_load(cnt + e, __ATOMIC_RELAXED, __HIP_MEMORY_SCOPE_AGENT)); acc += (int)((n + 255u) >> 8); }
    toff[8] = acc;
}
__device__ __forceinline__ void moe_gather(const Ctx& c_, int li, int mtok) {
    const Ctx c = make_ctx(c_.lds);
    KParams& P = kparams(); int toff[9]; moe_offsets(P, li, toff);
    int tv = 0;
#pragma unroll
    for (int e = 0; e < 8; ++e) tv = (c.lane == e) ? toff[e] : tv;
    const bf16_t* HB = (const bf16_t*)(P.ws + WS_HB); bf16_t* HS = (bf16_t*)(P.ws + WS_U + U_YS);
    for (int row = c.gw; row < mtok; row += c.NGW) {
        const int4* ti = (const int4*)(P.ws + WS_TOKINFO) + (size_t)row * 2; const int4 a = ti[0], b = ti[1];
        const int pA = __shfl(tv, a.x) * 256 + a.y, pB = __shfl(tv, a.z) * 256 + a.w;
        if (c.lane == 0) ((int4*)(P.ws + WS_TOKPOS))[row] = make_int4(pA, pB, b.x, b.y);
        const u32x4* src = (const u32x4*)(HB + (size_t)row * DM); const u32x4 v0 = src[c.lane], v1 = src[64 + c.lane];
#if MOE_F8
        u32x2 q0, q1; const float sc = F8_ACT_SCALE;
        q0.x = pk4_fp8(bflo(v0.x) * sc, bfhi(v0.x) * sc, bflo(v0.y) * sc, bfhi(v0.y) * sc); q0.y = pk4_fp8(bflo(v0.z) * sc, bfhi(v0.z) * sc, bflo(v0.w) * sc, bfhi(v0.w) * sc);
        q1.x = pk4_fp8(bflo(v1.x) * sc, bfhi(v1.x) * sc, bflo(v1.y) * sc, bfhi(v1.y) * sc); q1.y = pk4_fp8(bflo(v1.z) * sc, bfhi(v1.z) * sc, bflo(v1.w) * sc, bfhi(v1.w) * sc);
        u32x2* dA = (u32x2*)((unsigned char*)HS + (size_t)pA * DM); u32x2* dB = (u32x2*)((unsigned char*)HS + (size_t)pB * DM);
        dA[c.lane] = q0; dA[64 + c.lane] = q1; dB[c.lane] = q0; dB[64 + c.lane] = q1;
#else
        u32x4* dA = (u32x4*)(HS + (size_t)pA * DM); u32x4* dB = (u32x4*)(HS + (size_t)pB * DM);
        dA[c.lane] = v0; dA[64 + c.lane] = v1; dB[c.lane] = v0; dB[64 + c.lane] = v1;
#endif
    }
}

__device__ __forceinline__ void ew_last(const Ctx& c_, int l, int mtok) {
    const Ctx c = make_ctx(c_.lds);
    KParams& P = kparams(); const float* mods = (const float*)(P.ws + WS_MODS); bf16_t* HB = (bf16_t*)(P.ws + WS_HB);
    const bf16_t* YS = (const bf16_t*)(P.ws + WS_U + U_YS); const bool odd = (l & 1) != 0;
    for (int row = c.gw; row < mtok; row += c.NGW) {
        float* xr = xrow_ptr(P, row); const int r = mod_r(row); const float* mb = mods + (size_t)(l * 5 + r) * (NMOD * DM);
        f32x4 x[4], y[4], h[4];
        if (odd) { const int4 tp = ((const int4*)(P.ws + WS_TOKPOS))[row]; const float gA = __int_as_float(tp.z), gB = __int_as_float(tp.w);
#pragma unroll
            for (int j = 0; j < 4; ++j) y[j] = ldbf4(YS + (size_t)tp.x * DM + 4 * c.lane + 256 * j) * gA + ldbf4(YS + (size_t)tp.y * DM + 4 * c.lane + 256 * j) * gB;
        } else {
#pragma unroll
            for (int j = 0; j < 4; ++j) y[j] = ldbf4(YS + (size_t)row * DM + 4 * c.lane + 256 * j);
        }
#pragma unroll
        for (int j = 0; j < 4; ++j) x[j] = ld4(xr + 4 * c.lane + 256 * j);
        resid_add(x, y, P.in[6] + (l * 4 + 3) * DM, mb + 5 * DM, c.lane);
#pragma unroll
        for (int j = 0; j < 4; ++j) *(f32x4*)(xr + 4 * c.lane + 256 * j) = x[j];
        if (l < 3) { const float* mn = mods + (size_t)((l + 1) * 5 + r) * (NMOD * DM);
            norm_mod(x, h, P.in[6] + ((l + 1) * 4 + 0) * DM, mn + 0 * DM, mn + 1 * DM, c.lane);
#pragma unroll
            for (int j = 0; j < 4; ++j) stbf4(HB + (size_t)row * DM + 4 * c.lane + 256 * j, h[j]); }
    }
}

__device__ __forceinline__ void attn_even(const Ctx& c_, int l) {
    const Ctx c = make_ctx(c_.lds);
    KParams& P = kparams(); const int i = l >> 1; const bool need_ctx = l < 3;
    const bf16_t* PB = (const bf16_t*)(P.ws + WS_U + U_PB); bf16_t* MIX = (bf16_t*)(P.ws + WS_U + U_MIX);
    const int nchunk = need_ctx ? 264 : 256;
    for (int u = blockIdx.x; u < nchunk * 4; u += gridDim.x) att::sgu_unit(c.lds, PB, (const bf16_t*)(P.ws + WS_SGUW) + (size_t)i * 4 * 128 * 128, P.in[10] + i * 512, MIX, (u >> 2) * 128, u & 3);
    float d1 = 0.f, d2 = 0.f;
    if (c.lane < 64) { d1 = P.in[12][i * 64 + c.lane] * P.in[13][i * 64 + c.lane]; d2 = P.in[14][i * 64 + c.lane] * P.in[15][i * 64 + c.lane]; }
    const float lam_init = 0.8f - 0.6f * expf(-0.3f * (float)l);
    const float lam = expf(wave_sum(d1)) - expf(wave_sum(d2)) + lam_init;
    att::Args a;
    a.Q = PB; a.ldq = EV_IN; a.K = PB; a.ldk = EV_IN; a.V = PB; a.ldv = EV_IN; a.C = 0.125f * LOG2E;
    a.rcos = (const float*)(P.ws + WS_ROPEB); a.rsin = a.rcos + SEQ * 32; a.O = MIX; a.ldo = DM; a.g = 0; a.u0 = 0; a.rpb = nullptr;
    a.lam = lam; a.oscale = 1.f - lam_init; a.subg = P.in[16] + i * 128; a.nt_ctx = 4;
    const int nctxu = need_ctx ? 32 : 0, nu = nctxu + 1024;
    for (int u = blockIdx.x; u < nu; u += gridDim.x) {
        int b, h;
        if (u < nctxu) { b = u >> 3; h = (u >> 1) & 3; a.q_row0 = NLAT + b * CTXL + (u & 1) * 128; a.nt_lat = 0; a.rope = 0; }
        else { const int v = u - nctxu; b = v >> 8; h = (v >> 6) & 3; a.q_row0 = b * SEQ + (v & 63) * 128; a.nt_lat = SEQ / 64; a.rope = 1; }
        a.qcol = 1024 + h * 128; a.kcol = 1536 + h * 128; a.vcol = 2048 + h * 128; a.ocol = 512 + h * 128;
        a.kctx_row0 = NLAT + b * CTXL; a.klat_row0 = b * SEQ;
        att::attn_unit<64, 128, 128, 1>(c.lds, a);
    }
}
__device__ __forceinline__ void attn_odd_na(const Ctx& c_, int l) {
    const Ctx c = make_ctx(c_.lds);
    KParams& P = kparams(); const int i = l >> 1; const bool need_ctx = l < 3;
    const bf16_t* PB = (const bf16_t*)(P.ws + WS_U + U_PB); bf16_t* MIX = (bf16_t*)(P.ws + WS_U + U_MIX);
    att::Args a;
    a.Q = PB; a.ldq = OD_INP; a.K = PB; a.ldk = OD_INP; a.V = PB; a.ldv = OD_INP; a.C = 0.125f * LOG2E; a.rope = 0; a.rcos = nullptr; a.rsin = nullptr;
    a.O = MIX; a.ldo = DM; a.lam = 0.f; a.oscale = 1.f; a.subg = nullptr; a.nt_ctx = 4;
    const int nctxu = need_ctx ? 32 : 0, nu = nctxu + 1024;
    for (int u = blockIdx.x; u < nu; u += gridDim.x) {
        int b, h;
        if (u < nctxu) { b = u >> 3; h = u & 7; a.q_row0 = NLAT + b * CTXL; a.nt_lat = 0; a.g = 0; a.u0 = 0; a.klat_row0 = 0; }
        else { const int v = u - nctxu; b = v >> 8; h = (v >> 5) & 7; const int g = v & 31; a.g = g; a.u0 = min(max(4 * g - 4, 0), 116);
            a.q_row0 = b * SEQ + g * 256; a.nt_lat = 12; a.klat_row0 = b * SEQ + a.u0 * 64; }
        a.qcol = h * 64; a.kcol = 512 + h * 64; a.vcol = 1024 + h * 64; a.ocol = h * 64; a.kctx_row0 = NLAT + b * CTXL;
        a.rpb = P.in[22] + ((size_t)i * 8 + h) * 465;
        att::attn_unit<64, 64, 64, 2>(c.lds, a);
    }
}
__device__ __forceinline__ void attn_odd_mla(const Ctx& c_, int l) {
    const Ctx c = make_ctx(c_.lds);
    KParams& P = kparams(); const bool need_ctx = l < 3;
    const bf16_t* MO = (const bf16_t*)(P.ws + WS_U + U_MLAO); bf16_t* MIX = (bf16_t*)(P.ws + WS_U + U_MIX);
    att::Args a;
    a.Q = MO; a.ldq = MLA_N; a.K = MO; a.ldk = MLA_N; a.V = MO; a.ldv = MLA_N; a.C = 0.10206207261596575f * LOG2E;
    a.rcos = (const float*)(P.ws + WS_ROPED); a.rsin = a.rcos + SEQ * 16; a.O = MIX; a.ldo = DM; a.g = 0; a.u0 = 0; a.rpb = nullptr; a.lam = 0.f; a.oscale = 1.f; a.subg = nullptr; a.nt_ctx = 4;
    const int nctxu = need_ctx ? 16 : 0, nu = nctxu + 512;
    for (int u = blockIdx.x; u < nu; u += gridDim.x) {
        int b, h;
        if (u < nctxu) { b = u >> 2; h = u & 3; a.q_row0 = NLAT + b * CTXL; a.nt_lat = 0; a.rope = 0; }
        else { const int v = u - nctxu; b = v >> 7; h = (v >> 5) & 3; a.q_row0 = b * SEQ + (v & 31) * 256; a.nt_lat = SEQ / 64; a.rope = 2; }
        a.qcol = h * 96; a.kcol = 384 + h * 96; a.vcol = 768 + h * 128; a.ocol = 512 + h * 128; a.kctx_row0 = NLAT + b * CTXL; a.klat_row0 = b * SEQ;
        att::attn_unit<96, 96, 128, 0>(c.lds, a);
    }
}

constexpr int N_PHASES = 2 + 2 * (8 + 10);
__global__ void __launch_bounds__(512, 2) fwd_kernel(Params prm) {
    extern __shared__ __attribute__((aligned(16))) unsigned char lds_raw[];
    LAS unsigned char* lds = (LAS unsigned char*)lds_raw;
    const Ctx c{lds, 0, 0, 0, 0, 0};
    for (int u = threadIdx.x; u < (LDS_BYTES - LDS_MISC) / 4; u += 512) ((LAS unsigned*)(lds + LDS_MISC))[u] = 0u;
    __syncthreads();
    XcdBarrier bar;
    { unsigned char* ws0 = kparams().ws; bar.bar = (unsigned*)(ws0 + WS_CTL) + CW_BAR; bar.x = 0; bar.st = nullptr;
#if !MK_PER_PHASE
      bar = xcd_barrier_post((unsigned*)(ws0 + WS_CTL) + CW_BAR, (volatile LAS unsigned*)(lds + LDS_MISC + 32));
#endif
    }
    const int lo = kparams().ph_lo, hi = kparams().ph_hi; int ph = 0;
#ifndef PMASK
#define PMASK 0xffffffffu
#endif
#define PM(b) ((PMASK >> (b)) & 1u)
#define PH_ON() (ph >= lo && ph < hi)
#define PH_END() do { if (ph >= lo && ph + 1 < hi) xcd_barrier(bar); ++ph; } while (0)
#define WSP(off) ((bf16_t*)(ws + (off)))
#define HB WSP(WS_HB)
#define PB WSP(WS_U + U_PB)
#define MIX WSP(WS_U + U_MIX)
#define YB WSP(WS_U + U_YB)
#define HID WSP(WS_U + U_HID)
#define YS WSP(WS_U + U_YS)
#define A2 WSP(WS_U + U_A2)
#define MO WSP(WS_U + U_MLAO)

    if (PM(0) && PH_ON()) for (int rep = 0; rep < DUPN(0); ++rep) prologue0(c);
    PH_END();
    if (PM(1) && PH_ON()) for (int rep = 0; rep < DUPN(1); ++rep) ew_first(c);
    PH_END();
    for (int lp = 0; lp < 2; ++lp) {
        {
            const int l = 2 * lp, i = lp; const int mtok = l < 3 ? MTOT : NLAT, nMt = mtok / 256;
            if (PM(2) && PH_ON()) for (int rep = 0; rep < DUPN(2); ++rep) { unsigned char* ws = kparams().ws; pg8::Gemm g{}; g.A = HB; g.lda = DM; g.Bt = (const bf16_t*)(ws + WS_WINE) + (size_t)i * EV_IN * DM; g.K = DM; g.nM = MTOT / 256; g.nN = EV_IN / 256; g.grouped = 0; g.estride = 0;
                gemm_bf16(lds, g, PB, EV_IN); }
            PH_END();
            if (PM(3) && PH_ON()) { ew_even_mix(c, i); if (l == 2) convert_moe(c, 1); }
            PH_END();
            if (PM(4) && PH_ON()) for (int rep = 0; rep < DUPN(4); ++rep) attn_even(c, l);
            PH_END();
            if (PM(5) && PH_ON()) for (int rep = 0; rep < DUPN(5); ++rep) { unsigned char* ws = kparams().ws; pg8::Gemm g{}; g.A = MIX; g.lda = DM; g.Bt = (const bf16_t*)(ws + WS_WOUTE) + (size_t)i * DM * DM; g.K = DM; g.nM = nMt; g.nN = DM / 256; g.grouped = 0; g.estride = 0;
                gemm_bf16(lds, g, YB, DM); }
            PH_END();
            if (PM(6) && PH_ON()) ew_mid(c, l, mtok);
            PH_END();
            if (PM(7) && PH_ON()) for (int rep = 0; rep < DUPN(7); ++rep) { unsigned char* ws = kparams().ws; pg8::Gemm g{}; g.A = HB; g.lda = DM; g.Bt = (const bf16_t*)(ws + WS_W13E) + (size_t)i * 2 * DFF * DM; g.K = DM; g.nM = nMt; g.nN = 2 * DFF / 256; g.grouped = 0; g.estride = 0;
                gemm_swiglu(lds, g, HID, DFF); }
            PH_END();
            if (PM(8) && PH_ON()) for (int rep = 0; rep < DUPN(8); ++rep) { unsigned char* ws = kparams().ws; pg8::Gemm g{}; g.A = HID; g.lda = DFF; g.Bt = (const bf16_t*)(ws + WS_W2E) + (size_t)i * DM * DFF; g.K = DFF; g.nM = nMt; g.nN = DM / 256; g.grouped = 0; g.estride = 0;
                gemm_bf16(lds, g, YS, DM); }
            PH_END();
            if (PM(9) && PH_ON()) ew_last(c, l, mtok);
            PH_END();
        }
        {
            const int l = 2 * lp + 1, i = lp; const int mtok = l < 3 ? MTOT : NLAT, nMt = mtok / 256;
            if (PM(10) && PH_ON()) for (int rep = 0; rep < DUPN(10); ++rep) { unsigned char* ws = kparams().ws; pg8::Gemm g{}; g.A = HB; g.lda = DM; g.Bt = (const bf16_t*)(ws + WS_WINO) + (size_t)i * OD_INP * DM; g.K = DM; g.nM = MTOT / 256; g.nN = OD_INP / 256; g.grouped = 0; g.estride = 0;
                gemm_bf16(lds, g, PB, OD_INP); }
            PH_END();
            if (PM(11) && PH_ON()) for (int rep = 0; rep < DUPN(11); ++rep) ew_odd_mla(c, i);
            PH_END();
            if (PM(12) && PH_ON()) for (int rep = 0; rep < DUPN(12); ++rep) { unsigned char* ws = kparams().ws; pg8::Gemm g{}; g.A = A2; g.lda = MLA_K; g.Bt = (const bf16_t*)(ws + WS_WMLA) + (size_t)i * MLA_N * MLA_K; g.K = MLA_K; g.nM = MTOT / 256; g.nN = MLA_N / 256; g.grouped = 0; g.estride = 0;
                gemm_bf16(lds, g, MO, MLA_N); }
            PH_END();
            if (PH_ON()) { if (PM(13)) for (int rep = 0; rep < DUPN(13); ++rep) attn_odd_na(c, l); if (PM(14)) for (int rep = 0; rep < DUPN(14); ++rep) attn_odd_mla(c, l); }
            PH_END();
            if (PM(15) && PH_ON()) for (int rep = 0; rep < DUPN(15); ++rep) { unsigned char* ws = kparams().ws; pg8::Gemm g{}; g.A = MIX; g.lda = DM; g.Bt = (const bf16_t*)(ws + WS_WOUTO) + (size_t)i * DM * DM; g.K = DM; g.nM = nMt; g.nN = DM / 256; g.grouped = 0; g.estride = 0;
                gemm_bf16(lds, g, YB, DM); }
            PH_END();
            if (PM(16) && PH_ON()) ew_mid(c, l, mtok);
            PH_END();
            if (PM(17) && PH_ON()) for (int rep = 0; rep < DUPN(17); ++rep) moe_gather(c, i, mtok);
            PH_END();
            if (PM(18) && PH_ON()) for (int rep = 0; rep < DUPN(18); ++rep) { unsigned char* ws = kparams().ws; pg8::Gemm g{}; g.A = YS; g.lda = DM; g.Bt = (const bf16_t*)(ws + WS_W13M); g.K = DM; g.nN = 2 * DFFE / 256; g.grouped = 1; g.estride = (size_t)2 * DFFE * DM;
                moe_offsets(kparams(), i, g.toff); g.nM = g.toff[8];
#if MOE_F8
                gemm8_swiglu8(lds, g, (unsigned char*)HID, DFFE);
#else
                gemm_swiglu(lds, g, HID, DFFE);
#endif
            }
            PH_END();
            if (PM(19) && PH_ON()) for (int rep = 0; rep < DUPN(19); ++rep) { unsigned char* ws = kparams().ws; pg8::Gemm g{}; g.A = HID; g.lda = DFFE; g.Bt = (const bf16_t*)(ws + WS_W2M); g.K = DFFE; g.nN = DM / 256; g.grouped = 1; g.estride = (size_t)DM * DFFE;
                moe_offsets(kparams(), i, g.toff); g.nM = g.toff[8];
#if MOE_F8
                gemm8_bf16(lds, g, YS, DM);
#else
                gemm_bf16(lds, g, YS, DM);
#endif
            }
            PH_END();
            if (PM(20) && PH_ON()) ew_last(c, l, mtok);
            PH_END();
        }
    }
#undef PH_ON
#undef PH_END
#undef HB
#undef PB
#undef MIX
#undef YB
#undef HID
#undef YS
#undef A2
#undef MO
}

extern "C" void kernel_launch(void* const* d_in, const int* in_sizes, int n_in, void* d_out, int out_size, void* d_ws, size_t ws_size, hipStream_t stream) {
    static int grid = 0;
    if (grid == 0) {
        int dev = 0, cus = 0;
        if (n_in != 31 || out_size != NLAT * DM || ws_size < WS_END) { fprintf(stderr, "kernel_launch: unexpected shapes or workspace (n_in %d out %d ws %zu need %zu)\n", n_in, out_size, ws_size, (size_t)WS_END); grid = -1; }
        else if (hipGetDevice(&dev) != hipSuccess || hipDeviceGetAttribute(&cus, hipDeviceAttributeMultiprocessorCount, dev) != hipSuccess) grid = -1;
        else if (hipFuncSetAttribute((const void*)fwd_kernel, hipFuncAttributeMaxDynamicSharedMemorySize, LDS_BYTES) != hipSuccess) grid = -1;
        else { int per_cu = 0; (void)hipOccupancyMaxActiveBlocksPerMultiprocessor(&per_cu, (const void*)fwd_kernel, 512, LDS_BYTES); (void)hipGetLastError(); grid = cus; }
    }
    if (grid < 0) { (void)hipMemsetAsync(d_out, 0, (size_t)out_size * 4, stream); return; }
    (void)hipMemsetAsync((char*)d_ws + WS_CTL, 0, CTL_BYTES, stream);
    Params p{};
    for (int i = 0; i < 31; ++i) p.in[i] = (const float*)d_in[i];
    p.out = (float*)d_out; p.ws = (unsigned char*)d_ws;
#if MK_PER_PHASE
    for (int k = 0; k < N_PHASES; ++k) { p.ph_lo = k; p.ph_hi = k + 1; hipLaunchKernelGGL(fwd_kernel, dim3(grid), dim3(512), LDS_BYTES, stream, p); }
#else
    p.ph_lo = 0; p.ph_hi = N_PHASES;
    hipLaunchKernelGGL(fwd_kernel, dim3(grid), dim3(512), LDS_BYTES, stream, p);
#endif
}
```

```cpp
#include <hip/hip_runtime.h>
#include <stdint.h>
#include <stdio.h>

#ifndef MK_PER_PHASE
#define MK_PER_PHASE 0
#endif
#ifndef DUP_MASK
#define DUP_MASK 0u
#endif
#define DUPN(b) (1 + (int)((DUP_MASK >> (b)) & 1u))
#ifndef MOE_F8
#define MOE_F8 1
#endif

#define LAS __attribute__((address_space(3)))
typedef unsigned short bf16_t;
typedef short bf16x8 __attribute__((ext_vector_type(8)));
typedef short s16x4 __attribute__((ext_vector_type(4)));
typedef float f32x4 __attribute__((ext_vector_type(4)));
typedef float f32x2 __attribute__((ext_vector_type(2)));
typedef float f32x16 __attribute__((ext_vector_type(16)));
typedef unsigned u32x4 __attribute__((ext_vector_type(4)));
typedef unsigned u32x2 __attribute__((ext_vector_type(2)));

constexpr int DM = 1024, NB = 4, SEQ = 8192, NLAT = NB * SEQ, CTXL = 256, NCTX = NB * CTXL, MTOT = NLAT + NCTX;
constexpr int NMOD = 6;
constexpr int EV_IN = 2560, OD_IN = 1952, OD_INP = 2048, DFF = 2816, DFFE = 3584, NEXP = 8;
constexpr int MLA_N = 1280, MLA_K = 512;
constexpr int MS_MAX = 2 * MTOT + NEXP * 256;
constexpr float EPS = 1e-6f;
constexpr float LOG2E = 1.4426950408889634f;

constexpr size_t MiB = (size_t)1 << 20;
constexpr size_t WS_CTL = 0, CTL_BYTES = MiB;
constexpr size_t WS_MODS = 1 * MiB;
constexpr size_t WS_ROPEB = 2 * MiB;
constexpr size_t WS_ROPED = 4 * MiB;
constexpr size_t WS_SGUW = 5 * MiB;
constexpr size_t WS_TOKINFO = 6 * MiB;
constexpr size_t WS_TOKPOS = 8 * MiB;
constexpr size_t WS_CTXX = 10 * MiB;
constexpr size_t WS_WMLA = 14 * MiB;
constexpr size_t WS_WINE = 17 * MiB;
constexpr size_t WS_WOUTE = 27 * MiB;
constexpr size_t WS_W13E = 31 * MiB;
constexpr size_t WS_W2E = 53 * MiB;
constexpr size_t WS_WINO = 64 * MiB;
constexpr size_t WS_WOUTO = 72 * MiB;
constexpr size_t WS_W13M = 76 * MiB;
constexpr size_t WS_W2M = 188 * MiB;
constexpr size_t WS_HB = 244 * MiB;
constexpr size_t WS_U = 310 * MiB;
constexpr size_t U_PB = 0;
constexpr size_t U_MIX = 165 * MiB;
constexpr size_t U_A2 = 231 * MiB;
constexpr size_t U_MLAO = 264 * MiB;
constexpr size_t U_YB = 347 * MiB;
constexpr size_t U_HID = 0;
constexpr size_t U_YS = 478 * MiB;
constexpr size_t WS_STATS = WS_U + 616 * MiB;
constexpr size_t WS_END = WS_STATS + 4 * MiB;
static_assert((size_t)MS_MAX * DFFE * 2 <= U_YS, "hid fits");
static_assert(U_YS + (size_t)MS_MAX * DM * 2 <= 616 * MiB, "ys fits");

constexpr int CW_BAR = 4096;
constexpr int CW_MOECNT = 1024;

constexpr int LDS_BYTES = 147456;
constexpr int LDS_MISC = 131072;

__device__ __forceinline__ unsigned cvtpk(float lo, float hi) { unsigned r; asm volatile("v_cvt_pk_bf16_f32 %0, %1, %2" : "=v"(r) : "v"(lo), "v"(hi)); return r; }
__device__ __forceinline__ float bf2f(unsigned short b) { return __uint_as_float(((unsigned)b) << 16); }
__device__ __forceinline__ float bflo(unsigned w) { return __uint_as_float(w << 16); }
__device__ __forceinline__ float bfhi(unsigned w) { return __uint_as_float(w & 0xffff0000u); }
__device__ __forceinline__ bf16_t f2bf(float f) { return (bf16_t)(cvtpk(f, 0.f) & 0xffffu); }
typedef int i32x8 __attribute__((ext_vector_type(8)));
typedef int i32x4 __attribute__((ext_vector_type(4)));
constexpr float F8_ACT_SCALE = 4.f, F8_W_SCALE = 64.f, F8_INV = 1.f / (F8_ACT_SCALE * F8_W_SCALE);
__device__ __forceinline__ unsigned pk4_fp8(float a, float b, float c, float d) {
    a = __builtin_amdgcn_fmed3f(a, -448.f, 448.f); b = __builtin_amdgcn_fmed3f(b, -448.f, 448.f); c = __builtin_amdgcn_fmed3f(c, -448.f, 448.f); d = __builtin_amdgcn_fmed3f(d, -448.f, 448.f);
    int w = 0; w = __builtin_amdgcn_cvt_pk_fp8_f32(a, b, w, false); w = __builtin_amdgcn_cvt_pk_fp8_f32(c, d, w, true); return (unsigned)w; }
__device__ __forceinline__ float wave_sum(float v) {
#pragma unroll
    for (int o = 1; o < 64; o <<= 1) v += __shfl_xor(v, o);
    return v;
}
__device__ __forceinline__ float fast_exp2(float x) { return __builtin_amdgcn_exp2f(x); }
__device__ __forceinline__ float fast_rcp(float x) { return __builtin_amdgcn_rcpf(x); }
__device__ __forceinline__ float silu_f(float x) { return x * fast_rcp(1.f + fast_exp2(-x * LOG2E)); }
__device__ __forceinline__ float gelu_tanh_f(float x) { const float u = 0.7978845608028654f * (x + 0.044715f * x * x * x); return x * fast_rcp(1.f + fast_exp2(-2.f * LOG2E * u)); }
#define LDS_WAIT() asm volatile("s_waitcnt lgkmcnt(0)" ::: "memory")
#define VM_WAIT() asm volatile("s_waitcnt vmcnt(0)" ::: "memory")
__device__ __forceinline__ int opaque_bid() { int b = blockIdx.x; asm volatile("" : "+s"(b)); return b; }
__device__ __forceinline__ int opaque_tid() { int t = threadIdx.x; asm volatile("" : "+v"(t)); return t; }

#define XB_TMO      128
#define XB_XCNT(j)  (256  + 64 * (j))
#define XB_XSUB(j)  (1280 + 64 * (j))
#define XB_XGEN(j)  (2304 + 64 * (j))
#define XB_TOP      3328
#define XB_TOPGEN   3392
#define XCD_BAR_WORDS 3456
#define XB_SPIN_CAP (1u << 22)
__device__ __forceinline__ unsigned xb_ld(unsigned* p)              { return __hip_atomic_load(p, __ATOMIC_RELAXED, __HIP_MEMORY_SCOPE_AGENT); }
__device__ __forceinline__ unsigned xb_add(unsigned* p, unsigned v) { return __hip_atomic_fetch_add(p, v, __ATOMIC_RELAXED, __HIP_MEMORY_SCOPE_AGENT); }
__device__ __forceinline__ unsigned xb_xcc_id() { return (unsigned)__builtin_amdgcn_s_getreg((3 << 11) | 20) & 0xFu; }
#define XB_SPIN(cond, bar) do { unsigned _sp = 0; while (cond) { __builtin_amdgcn_s_sleep(1); \
    if ((++_sp & 255u) == 0u) { if (xb_ld(&(bar)[XB_TMO])) break; if (_sp > XB_SPIN_CAP) { atomicAdd(&(bar)[XB_TMO], 1u); break; } } } } while (0)
struct XcdBarrier { unsigned* bar; unsigned x; volatile LAS unsigned* st; };
__device__ __forceinline__ XcdBarrier xcd_barrier_post(unsigned* bar, volatile LAS unsigned* st) {
    XcdBarrier b; b.bar = bar; b.x = xb_xcc_id(); b.st = st;
    if (threadIdx.x == 0) (void)xb_add(&bar[XB_XCNT(b.x)], 1u);
    return b;
}
__device__ __forceinline__ void xcd_barrier_complete(unsigned* bar, unsigned x, unsigned& nloc, unsigned& nx) {
    const unsigned G = gridDim.x * gridDim.y * gridDim.z;
    unsigned sum, cnt, mine, sp = 0u;
    for (;;) {
        sum = 0u; cnt = 0u; mine = 0u;
#pragma unroll
        for (unsigned j = 0; j < 16; ++j) { const unsigned c = xb_ld(&bar[XB_XCNT(j)]); sum += c; cnt += (c > 0u) ? 1u : 0u; mine = (j == x) ? c : mine; }
        if (sum == G) break;
        __builtin_amdgcn_s_sleep(1);
        if ((++sp & 255u) == 0u) { if (xb_ld(&bar[XB_TMO])) break; if (sp > XB_SPIN_CAP) { atomicAdd(&bar[XB_TMO], 1u); break; } }
    }
    nloc = mine > 0u ? mine : 1u; nx = cnt > 0u ? cnt : 1u;
}
__device__ __forceinline__ void xcd_barrier(const XcdBarrier& b) {
    asm volatile("s_waitcnt vmcnt(0)" ::: "memory");
    __syncthreads();
    if (threadIdx.x == 0) {
        unsigned* bar = b.bar;
        __builtin_amdgcn_s_waitcnt(0);
        unsigned nloc = b.st[0], nx = b.st[1];
        if (nloc == 0u) { xcd_barrier_complete(bar, b.x, nloc, nx); b.st[0] = nloc; b.st[1] = nx; }
        const unsigned old = xb_add(&bar[XB_XSUB(b.x)], 1u);
        const unsigned gen = old / nloc;
        if (old + 1u == (gen + 1u) * nloc) {
            __builtin_amdgcn_fence(__ATOMIC_RELEASE, "agent");
            asm volatile("s_waitcnt vmcnt(0)" ::: "memory");
            const unsigned og = xb_add(&bar[XB_TOP], 1u);
            const unsigned tg = og / nx;
            if (og + 1u == (tg + 1u) * nx) xb_add(&bar[XB_TOPGEN], 1u);
            else XB_SPIN(xb_ld(&bar[XB_TOPGEN]) == tg, bar);
            __builtin_amdgcn_fence(__ATOMIC_ACQUIRE, "agent");
            xb_add(&bar[XB_XGEN(b.x)], 1u);
            asm volatile("s_waitcnt vmcnt(0)" ::: "memory");
        } else {
            XB_SPIN(xb_ld(&bar[XB_XGEN(b.x)]) == gen, bar);
            __builtin_amdgcn_fence(__ATOMIC_ACQUIRE, "agent");
            asm volatile("s_waitcnt vmcnt(0)" ::: "memory");
        }
    }
    __syncthreads();
}

namespace pg8 {
constexpr int BM = 256, BK = 64, HALF = 128, HTB = HALF * BK * 2, STAGE_BYTES = 8 * HTB, NXCD = 8, WGM = 8;
__device__ __forceinline__ int lds_byte(int r, int c) { const int st = (r >> 4) * 2 + (c >> 5), rr = r & 15, cc = c & 31, ob = rr * 64 + cc * 2; return st * 1024 + (ob ^ (((ob >> 9) & 1) << 5)); }
__device__ __forceinline__ void stage_rc(int b, int& R, int& C) { const int st = b / 1024, sb = b % 1024, swz = sb ^ (((sb >> 9) & 1) << 5); R = (st >> 1) * 16 + swz / 64; C = (st & 1) * 32 + (swz % 64) / 2; }
__device__ __forceinline__ int perm32(int rho) { const int n = rho >> 4, i = rho & 15; return 8 * (i >> 2) + 4 * n + (i & 3); }
struct Unit { int pm, pn, e; };
struct Gemm {
    const void* A; int lda;
    const void* Bt; int K;
    int nM, nN;
    int grouped; int toff[9]; size_t estride;
};
struct StaticOrder {
    int nM, nN, nwg, G, c;
    __device__ void init(int nM_, int nN_, int G_, int c_) { nM = nM_; nN = nN_; nwg = nM * nN; G = G_; c = c_; }
    __device__ __forceinline__ bool next(int i, Unit& u) const {
        const long L = (long)i * G + c; if (L >= nwg) return false;
        int wgid = (int)L; { const int q = nwg / NXCD, r = nwg % NXCD, xcd = wgid % NXCD, off = wgid / NXCD; wgid = (xcd < r ? xcd * (q + 1) : r * (q + 1) + (xcd - r) * q) + off; }
        const int nig = WGM * nN, gid = wgid / nig, fm = gid * WGM, gsz = (nM - fm) < WGM ? (nM - fm) : WGM;
        u.pm = fm + ((wgid % nig) % gsz); u.pn = (wgid % nig) / gsz; u.e = 0; return true;
    }
};
struct EpiBf16 {
    bf16_t* O; int ldc; float scale;
    __device__ __forceinline__ void operator()(const f32x4 (&acc)[2][2][4][2], const Unit& u, int wr, int wc, int fr, int fq) const {
        const int row0 = u.pm * BM + wr * 64 + fr, col0 = u.pn * BM + wc * 32 + 8 * fq;
#pragma unroll
        for (int ai = 0; ai < 2; ++ai)
#pragma unroll
            for (int m = 0; m < 4; ++m) { bf16_t* rowp = O + (size_t)(row0 + ai * HALF + m * 16) * ldc + col0;
#pragma unroll
                for (int bj = 0; bj < 2; ++bj) { const f32x4 v0 = acc[ai][bj][m][0] * scale, v1 = acc[ai][bj][m][1] * scale;
                    u32x4 w; w.x = cvtpk(v0[0], v0[1]); w.y = cvtpk(v0[2], v0[3]); w.z = cvtpk(v1[0], v1[1]); w.w = cvtpk(v1[2], v1[3]);
                    *(u32x4*)(rowp + bj * HALF) = w; } }
    }
};
struct EpiSwiGLU {
    bf16_t* O; int ldc;
    __device__ __forceinline__ void operator()(const f32x4 (&acc)[2][2][4][2], const Unit& u, int wr, int wc, int fr, int fq) const {
        const int row0 = u.pm * BM + wr * 64 + fr, col0 = u.pn * HALF + wc * 32 + 8 * fq;
#pragma unroll
        for (int ai = 0; ai < 2; ++ai)
#pragma unroll
            for (int m = 0; m < 4; ++m) { bf16_t* rowp = O + (size_t)(row0 + ai * HALF + m * 16) * ldc + col0;
                float r[8];
#pragma unroll
                for (int n = 0; n < 2; ++n)
#pragma unroll
                    for (int j = 0; j < 4; ++j) r[n * 4 + j] = silu_f(acc[ai][0][m][n][j]) * acc[ai][1][m][n][j];
                u32x4 w; w.x = cvtpk(r[0], r[1]); w.y = cvtpk(r[2], r[3]); w.z = cvtpk(r[4], r[5]); w.w = cvtpk(r[6], r[7]);
                *(u32x4*)rowp = w; }
    }
};

struct EpiEvenIn {
    bf16_t* O; int ldc; f32x2* stats; const float* rcos; const float* rsin;
    __device__ __forceinline__ void operator()(const f32x4 (&acc)[2][2][4][2], const Unit& u, int wr, int wc, int fr, int fq) const {
        int upm = u.pm, upn = u.pn; asm volatile("" : "+s"(upm), "+s"(upn));
        const int row0 = upm * BM + wr * 64 + fr, col0 = upn * BM + wc * 32 + 8 * fq;
        const int kind = upn < 2 ? 0 : (upn < 4 ? 1 : (upn < 8 ? 2 : 3)); const bool lat = upm < NLAT / BM; const int t4 = 4 * (4 * (wc & 1) + fq);
#pragma unroll
        for (int ai = 0; ai < 2; ++ai)
#pragma unroll
            for (int m = 0; m < 4; ++m) { const int row = row0 + ai * HALF + m * 16; bf16_t* rowp = O + (size_t)row * ldc + col0;
                f32x4 cs = {1.f, 1.f, 1.f, 1.f}, sn = {0.f, 0.f, 0.f, 0.f}; float s1 = 0.f, s2 = 0.f;
                if (kind == 2 && lat) { const int sp = row & (SEQ - 1); cs = *(const f32x4*)(rcos + sp * 32 + t4); sn = *(const f32x4*)(rsin + sp * 32 + t4); }
#pragma unroll
                for (int bj = 0; bj < 2; ++bj) { f32x4 v0 = acc[ai][bj][m][0], v1 = acc[ai][bj][m][1];
                    if (kind < 2) {
#pragma unroll
                        for (int j = 0; j < 4; ++j) { v0[j] = gelu_tanh_f(v0[j]); v1[j] = gelu_tanh_f(v1[j]); }
                        if (kind == 1) { s1 += (v0[0] + v0[1]) + (v0[2] + v0[3]) + (v1[0] + v1[1]) + (v1[2] + v1[3]);
                            s2 += (v0[0] * v0[0] + v0[1] * v0[1]) + (v0[2] * v0[2] + v0[3] * v0[3]) + (v1[0] * v1[0] + v1[1] * v1[1]) + (v1[2] * v1[2] + v1[3] * v1[3]); } }
                    else if (kind == 2) { const f32x4 o0 = v0 * cs - v1 * sn, o1 = v1 * cs + v0 * sn; v0 = o0; v1 = o1; }
                    u32x4 w; w.x = cvtpk(v0[0], v0[1]); w.y = cvtpk(v0[2], v0[3]); w.z = cvtpk(v1[0], v1[1]); w.w = cvtpk(v1[2], v1[3]);
                    *(u32x4*)(rowp + bj * HALF) = w; }
                if (kind == 1) { s1 += __shfl_xor(s1, 16); s1 += __shfl_xor(s1, 32); s2 += __shfl_xor(s2, 16); s2 += __shfl_xor(s2, 32);
                    if (fq == 0) stats[(size_t)row * 8 + (upn - 2) * 4 + wc] = (f32x2){s1, s2}; } }
    }
};
struct EpiOddIn {
    bf16_t* O; int ldc; float* stats; const float* rcos; const float* rsin;
    __device__ __forceinline__ void operator()(const f32x4 (&acc)[2][2][4][2], const Unit& u, int wr, int wc, int fr, int fq) const {
        int upm = u.pm, upn = u.pn; asm volatile("" : "+s"(upm), "+s"(upn));
        const int row0 = upm * BM + wr * 64 + fr, col0 = upn * BM + wc * 32 + 8 * fq; const bool lat = upm < NLAT / BM;
#pragma unroll
        for (int ai = 0; ai < 2; ++ai)
#pragma unroll
            for (int m = 0; m < 4; ++m) { const int row = row0 + ai * HALF + m * 16; bf16_t* rowp = O + (size_t)row * ldc + col0; float ss = 0.f;
#pragma unroll
                for (int bj = 0; bj < 2; ++bj) { f32x4 v0 = acc[ai][bj][m][0], v1 = acc[ai][bj][m][1];
                    if (upn == 6 || (upn == 7 && bj == 0)) ss += (v0[0] * v0[0] + v0[1] * v0[1]) + (v0[2] * v0[2] + v0[3] * v0[3]) + (v1[0] * v1[0] + v1[1] * v1[1]) + (v1[2] * v1[2] + v1[3] * v1[3]);
                    if (upn == 7 && bj == 1 && wc == 0 && lat) { const int sp = row & (SEQ - 1); const f32x4 cs = *(const f32x4*)(rcos + sp * 16 + 4 * fq), sn = *(const f32x4*)(rsin + sp * 16 + 4 * fq);
                        const f32x4 o0 = v0 * cs - v1 * sn, o1 = v1 * cs + v0 * sn; v0 = o0; v1 = o1; }
                    u32x4 w; w.x = cvtpk(v0[0], v0[1]); w.y = cvtpk(v0[2], v0[3]); w.z = cvtpk(v1[0], v1[1]); w.w = cvtpk(v1[2], v1[3]);
                    *(u32x4*)(rowp + bj * HALF) = w; }
                if (upn >= 6) { ss += __shfl_xor(ss, 16); ss += __shfl_xor(ss, 32); if (fq == 0) stats[(size_t)row * 8 + (upn - 6) * 4 + wc] = ss; } }
    }
};
struct EpiMlaUp {
    bf16_t* O; int ldc; const float* stats;
    __device__ __forceinline__ void operator()(const f32x4 (&acc)[2][2][4][2], const Unit& u, int wr, int wc, int fr, int fq) const {
        const int row0 = u.pm * BM + wr * 64 + fr, col0 = u.pn * BM + wc * 32 + 8 * fq;
#pragma unroll
        for (int ai = 0; ai < 2; ++ai)
#pragma unroll
            for (int m = 0; m < 4; ++m) { const int row = row0 + ai * HALF + m * 16; bf16_t* rowp = O + (size_t)row * ldc + col0;
                const f32x4 pq = *(const f32x4*)(stats + (size_t)row * 8), pk = *(const f32x4*)(stats + (size_t)row * 8 + 4);
                const float rq = rsqrtf(((pq[0] + pq[1]) + (pq[2] + pq[3])) * (1.f / 256.f) + EPS), rk = rsqrtf(((pk[0] + pk[1]) + (pk[2] + pk[3])) * (1.f / 128.f) + EPS);
#pragma unroll
                for (int bj = 0; bj < 2; ++bj) { const int c0 = col0 + bj * HALF; const float sc = c0 < 384 ? rq : (c0 < 768 ? (((c0 - 384) % 96) < 64 ? rk : 1.f) : rk);
                    const f32x4 v0 = acc[ai][bj][m][0] * sc, v1 = acc[ai][bj][m][1] * sc;
                    u32x4 w; w.x = cvtpk(v0[0], v0[1]); w.y = cvtpk(v0[2], v0[3]); w.z = cvtpk(v1[0], v1[1]); w.w = cvtpk(v1[2], v1[3]);
                    *(u32x4*)(rowp + bj * HALF) = w; } }
    }
};
struct EpiSwiGLU8 {
    unsigned char* O; int ldc; float scale;
    __device__ __forceinline__ void operator()(const f32x4 (&acc)[2][2][4][2], const Unit& u, int wr, int wc, int fr, int fq) const {
        const int row0 = u.pm * BM + wr * 64 + fr, col0 = u.pn * HALF + wc * 32 + 8 * fq;
#pragma unroll
        for (int ai = 0; ai < 2; ++ai)
#pragma unroll
            for (int m = 0; m < 4; ++m) { unsigned char* rowp = O + (size_t)(row0 + ai * HALF + m * 16) * ldc + col0;
                float r[8];
#pragma unroll
                for (int n = 0; n < 2; ++n)
#pragma unroll
                    for (int j = 0; j < 4; ++j) r[n * 4 + j] = F8_ACT_SCALE * silu_f(acc[ai][0][m][n][j] * scale) * (acc[ai][1][m][n][j] * scale);
                u32x2 w; w.x = pk4_fp8(r[0], r[1], r[2], r[3]); w.y = pk4_fp8(r[4], r[5], r[6], r[7]);
                *(u32x2*)rowp = w; }
    }
};

template <class Epi, bool F8 = false>
__device__ __forceinline__ void gemm_phase(LAS unsigned char* lds, const Gemm& g, const Epi& E) {
    const int tid = opaque_tid(), wid = __builtin_amdgcn_readfirstlane(tid >> 6), lane = tid & 63, wr = wid >> 2, wc = wid & 3, fr = lane & 15, fq = lane >> 4;
    constexpr int ES = F8 ? 1 : 2;
    const int K = g.K, nt = K * ES / (BK * 2), lda = g.lda;
    StaticOrder S; S.init(g.nM, g.nN, (int)gridDim.x, opaque_bid());
    unsigned voffA[2], voffB[2];
#pragma unroll
    for (int i = 0; i < 2; ++i) { int R, C; stage_rc(tid * 16 + i * 8192, R, C); const int Rb = (R & ~31) + perm32(R & 31);
        voffA[i] = (unsigned)(R * lda * ES + C * 2); voffB[i] = (unsigned)(Rb * K * ES + C * 2); }
    const size_t kstep = (size_t)(BK * 2);
    const size_t hA = (size_t)HALF * lda * ES, tA = 2 * hA, hB = (size_t)HALF * K * ES, tB = 2 * hB;
    const unsigned ldsw = (unsigned)wid * 1024u;
    const int aoff = lds_byte(wr * 64 + fr, fq * 8), boff = lds_byte(wc * 32 + fr, fq * 8);
#define PG8_SA(b, h) (((b) * 2 + (h)) * HTB)
#define PG8_SB(b, h) ((4 + (b) * 2 + (h)) * HTB)
#define PG8_STAGE(bufoff, gbase, voff) do { _Pragma("unroll") for (int _i = 0; _i < 2; ++_i) \
        __builtin_amdgcn_global_load_lds((const unsigned*)((const char*)(gbase) + (voff)[_i]), (LAS unsigned*)(lds + (bufoff) + ldsw + _i * 8192), 16, 0, 0); } while (0)
#define PG8_LD8(base) __builtin_shufflevector(*(const LAS i32x4*)(base), *(const LAS i32x4*)((base) + 1024), 0, 1, 2, 3, 4, 5, 6, 7)
#define PG8_LDA(dst, b, h) do { _Pragma("unroll") for (int m = 0; m < 4; ++m) dst[m] = PG8_LD8(lds + PG8_SA(b, h) + aoff + m * 2048); } while (0)
#define PG8_LDB(dst, b, h) do { _Pragma("unroll") for (int n = 0; n < 2; ++n) dst[n] = PG8_LD8(lds + PG8_SB(b, h) + boff + n * 2048); } while (0)
#define PG8_H0(x) __builtin_bit_cast(bf16x8, __builtin_shufflevector(x, x, 0, 1, 2, 3))
#define PG8_H1(x) __builtin_bit_cast(bf16x8, __builtin_shufflevector(x, x, 4, 5, 6, 7))
#define PG8_MMA(ai, bj, At, Bt) do { __builtin_amdgcn_s_setprio(1); _Pragma("unroll") for (int m = 0; m < 4; ++m) _Pragma("unroll") for (int n = 0; n < 2; ++n) { \
        if constexpr (F8) asm volatile("v_mfma_f32_16x16x128_f8f6f4 %0, %1, %2, %0" : "+v"(acc[ai][bj][m][n]) : "v"(Bt[n]), "v"(At[m])); \
        else { acc[ai][bj][m][n] = __builtin_amdgcn_mfma_f32_16x16x32_bf16(PG8_H0(Bt[n]), PG8_H0(At[m]), acc[ai][bj][m][n], 0, 0, 0); \
               acc[ai][bj][m][n] = __builtin_amdgcn_mfma_f32_16x16x32_bf16(PG8_H1(Bt[n]), PG8_H1(At[m]), acc[ai][bj][m][n], 0, 0, 0); } } \
        __builtin_amdgcn_s_setprio(0); } while (0)
#define PG8_WAIT_V(n) asm volatile("s_waitcnt vmcnt(" #n ")" ::: "memory")
#define PG8_WAIT_L(n) asm volatile("s_waitcnt lgkmcnt(" #n ")" ::: "memory")
#define PG8_BAR __builtin_amdgcn_s_barrier()
#define PG8_SCHED __builtin_amdgcn_sched_barrier(0)
#define PG8_EXPERT(u) do { if (g.grouped) { int _e = 0; _Pragma("unroll") for (int _k = 1; _k < 8; ++_k) _e += ((u).pm >= g.toff[_k]) ? 1 : 0; (u).e = _e; } } while (0)
    Unit cur, nxt; int ui = 0;
    if (!S.next(0, cur)) return;
    PG8_EXPERT(cur);
    f32x4 acc[2][2][4][2];
#pragma unroll
    for (int a = 0; a < 2; ++a)
#pragma unroll
        for (int b = 0; b < 2; ++b)
#pragma unroll
            for (int m = 0; m < 4; ++m)
#pragma unroll
                for (int n = 0; n < 2; ++n) acc[a][b][m][n] = (f32x4){0.f, 0.f, 0.f, 0.f};
    i32x8 At[4], B0[2], B1[2];
    const char* cA = (const char*)g.A + (size_t)cur.pm * tA; const char* cB = ((const char*)g.Bt + (size_t)cur.e * g.estride * ES) + (size_t)cur.pn * tB;
    PG8_STAGE(PG8_SB(0, 0), cB, voffB); PG8_STAGE(PG8_SA(0, 0), cA, voffA); PG8_STAGE(PG8_SB(0, 1), cB + hB, voffB); PG8_STAGE(PG8_SA(0, 1), cA + hA, voffA);
    if (wr == 1) PG8_BAR;
    PG8_WAIT_V(4); PG8_BAR;
    PG8_STAGE(PG8_SB(1, 0), cB + kstep, voffB); PG8_STAGE(PG8_SA(1, 0), cA + kstep, voffA); PG8_STAGE(PG8_SB(1, 1), cB + hB + kstep, voffB);
    PG8_WAIT_V(6); PG8_BAR;
    for (;;) {
        const bool has_next = S.next(ui + 1, nxt);
        if (has_next) PG8_EXPERT(nxt);
        const char* nA = has_next ? (const char*)g.A + (size_t)nxt.pm * tA : cA; const char* nB = has_next ? ((const char*)g.Bt + (size_t)nxt.e * g.estride * ES) + (size_t)nxt.pn * tB : cB;
        for (int t = 0; t < nt; t += 2) {
            const bool last = (t == nt - 2);
            const char* a1 = cA + (size_t)(t + 1) * kstep;
            const char* a2 = last ? nA : cA + (size_t)(t + 2) * kstep; const char* b2 = last ? nB : cB + (size_t)(t + 2) * kstep;
            const char* a3 = a2 + kstep; const char* b3 = b2 + kstep;
            PG8_LDB(B0, 0, 0); PG8_SCHED; PG8_LDA(At, 0, 0); PG8_STAGE(PG8_SA(1, 1), a1 + hA, voffA);
            PG8_WAIT_L(8); PG8_BAR; PG8_WAIT_L(0); PG8_MMA(0, 0, At, B0); PG8_BAR; PG8_SCHED;
            PG8_LDB(B1, 0, 1); PG8_STAGE(PG8_SB(0, 0), b2, voffB);
            PG8_BAR; PG8_WAIT_L(0); PG8_MMA(0, 1, At, B1); PG8_BAR;
            PG8_LDA(At, 0, 1); PG8_STAGE(PG8_SA(0, 0), a2, voffA);
            PG8_BAR; PG8_WAIT_L(0); PG8_MMA(1, 0, At, B0); PG8_BAR; PG8_SCHED;
            PG8_STAGE(PG8_SB(0, 1), b2 + hB, voffB);
            PG8_WAIT_V(6); PG8_BAR; PG8_MMA(1, 1, At, B1); PG8_BAR;
            PG8_LDB(B0, 1, 0); PG8_SCHED; PG8_LDA(At, 1, 0); PG8_STAGE(PG8_SA(0, 1), a2 + hA, voffA);
            PG8_WAIT_L(8); PG8_BAR; PG8_WAIT_L(0); PG8_MMA(0, 0, At, B0); PG8_BAR; PG8_SCHED;
            PG8_LDB(B1, 1, 1); PG8_STAGE(PG8_SB(1, 0), b3, voffB);
            PG8_BAR; PG8_WAIT_L(0); PG8_MMA(0, 1, At, B1); PG8_BAR;
            PG8_LDA(At, 1, 1); PG8_STAGE(PG8_SA(1, 0), a3, voffA);
            PG8_BAR; PG8_WAIT_L(0); PG8_MMA(1, 0, At, B0); PG8_BAR; PG8_SCHED;
            PG8_STAGE(PG8_SB(1, 1), b3 + hB, voffB);
            PG8_WAIT_V(6); PG8_BAR; PG8_MMA(1, 1, At, B1); PG8_BAR;
        }
        if constexpr (F8) asm volatile("s_nop 15\n\ts_nop 15" ::: "memory");
        E(acc, cur, wr, wc, fr, fq);
        if (!has_next) break;
#pragma unroll
        for (int a = 0; a < 2; ++a)
#pragma unroll
            for (int b = 0; b < 2; ++b)
#pragma unroll
                for (int m = 0; m < 4; ++m)
#pragma unroll
                    for (int n = 0; n < 2; ++n) acc[a][b][m][n] = (f32x4){0.f, 0.f, 0.f, 0.f};
        cur = nxt; cA = nA; cB = nB; ++ui;
    }
    PG8_WAIT_V(0);
    if (wr == 0) PG8_BAR;
    PG8_BAR;
#undef PG8_SA
#undef PG8_SB
#undef PG8_STAGE
#undef PG8_LDA
#undef PG8_LDB
#undef PG8_MMA
#undef PG8_H0
#undef PG8_H1
#undef PG8_LD8
#undef PG8_WAIT_V
#undef PG8_WAIT_L
#undef PG8_BAR
#undef PG8_SCHED
#undef PG8_EXPERT
}
}

__device__ __forceinline__ void gemm_bf16(LAS unsigned char* lds, const pg8::Gemm& g, bf16_t* O, int ldc) { pg8::EpiBf16 E{O, ldc, 1.f}; pg8::gemm_phase(lds, g, E); }
__device__ __forceinline__ void gemm_even_in(LAS unsigned char* lds, const pg8::Gemm& g, const pg8::EpiEvenIn& E) { pg8::gemm_phase(lds, g, E); }
__device__ __forceinline__ void gemm_odd_in(LAS unsigned char* lds, const pg8::Gemm& g, const pg8::EpiOddIn& E) { pg8::gemm_phase(lds, g, E); }
__device__ __forceinline__ void gemm_mla_up(LAS unsigned char* lds, const pg8::Gemm& g, const pg8::EpiMlaUp& E) { pg8::gemm_phase(lds, g, E); }
__device__ __forceinline__ void gemm8_bf16(LAS unsigned char* lds, const pg8::Gemm& g, bf16_t* O, int ldc) { pg8::EpiBf16 E{O, ldc, F8_INV}; pg8::gemm_phase<pg8::EpiBf16, true>(lds, g, E); }
__device__ __forceinline__ void gemm8_swiglu8(LAS unsigned char* lds, const pg8::Gemm& g, unsigned char* O, int ldc) { pg8::EpiSwiGLU8 E{O, ldc, F8_INV}; pg8::gemm_phase<pg8::EpiSwiGLU8, true>(lds, g, E); }
__device__ __forceinline__ void gemm_swiglu(LAS unsigned char* lds, const pg8::Gemm& g, bf16_t* O, int ldc) { pg8::EpiSwiGLU E{O, ldc}; pg8::gemm_phase(lds, g, E); }

namespace att {
#define SBAR() __builtin_amdgcn_sched_barrier(0)
__device__ __forceinline__ int crow(int r, int hi) { return (r & 3) + 8 * (r >> 2) + 4 * hi; }
__device__ __forceinline__ int v_st(int k, int c) { const int kk = (k & ~0xC) | ((k & 4) << 1) | ((k & 8) >> 1); return ((kk >> 3) * 4 + (c >> 5)) * 512 + ((kk & 7) * 32 + (c & 31)) * 2; }
__device__ __forceinline__ int v_rd_base(int lane) { return ((lane & 3) << 3) | (((lane >> 2) & 3) << 6) | (((lane >> 4) & 1) << 5) | (((lane >> 5) & 1) << 8); }
constexpr int v_rd_off(int d0, int ks, int half) { return d0 * 512 + ks * 4096 + half * 2048; }
template <int OFF> __device__ __forceinline__ s16x4 tr_read(unsigned vb) {
    s16x4 r; asm volatile("ds_read_b64_tr_b16 %0, %1 offset:%2" : "=&v"(r) : "v"(vb), "i"(OFF) : "memory"); return r;
}
template <int D0> __device__ __forceinline__ void pv_one(f32x16& od, unsigned vb, bf16x8 pa0, bf16x8 pa1, bf16x8 pa2, bf16x8 pa3) {
    const s16x4 l0 = tr_read<v_rd_off(D0, 0, 0)>(vb), h0 = tr_read<v_rd_off(D0, 0, 1)>(vb), l1 = tr_read<v_rd_off(D0, 1, 0)>(vb), h1 = tr_read<v_rd_off(D0, 1, 1)>(vb);
    const s16x4 l2 = tr_read<v_rd_off(D0, 2, 0)>(vb), h2 = tr_read<v_rd_off(D0, 2, 1)>(vb), l3 = tr_read<v_rd_off(D0, 3, 0)>(vb), h3 = tr_read<v_rd_off(D0, 3, 1)>(vb);
    asm volatile("s_waitcnt lgkmcnt(0)" ::: "memory"); SBAR();
#define PK(L, H) (bf16x8){L[0], L[1], L[2], L[3], H[0], H[1], H[2], H[3]}
    od = __builtin_amdgcn_mfma_f32_32x32x16_bf16(pa0, PK(l0, h0), od, 0, 0, 0);
    od = __builtin_amdgcn_mfma_f32_32x32x16_bf16(pa1, PK(l1, h1), od, 0, 0, 0);
    od = __builtin_amdgcn_mfma_f32_32x32x16_bf16(pa2, PK(l2, h2), od, 0, 0, 0);
    od = __builtin_amdgcn_mfma_f32_32x32x16_bf16(pa3, PK(l3, h3), od, 0, 0, 0);
#undef PK
}
__device__ __forceinline__ void rot8(bf16x8& a, bf16x8& b, const float* cs, const float* sn) {
    const f32x4 c0 = *(const f32x4*)cs, c1 = *(const f32x4*)(cs + 4), s0 = *(const f32x4*)sn, s1 = *(const f32x4*)(sn + 4);
    float c[8] = {c0[0], c0[1], c0[2], c0[3], c1[0], c1[1], c1[2], c1[3]}, s[8] = {s0[0], s0[1], s0[2], s0[3], s1[0], s1[1], s1[2], s1[3]};
    float o1[8], o2[8];
#pragma unroll
    for (int e = 0; e < 8; ++e) { const float x1 = bf2f((unsigned short)a[e]), x2 = bf2f((unsigned short)b[e]); o1[e] = x1 * c[e] - x2 * s[e]; o2[e] = x2 * c[e] + x1 * s[e]; }
    u32x4 wa = {cvtpk(o1[0], o1[1]), cvtpk(o1[2], o1[3]), cvtpk(o1[4], o1[5]), cvtpk(o1[6], o1[7])};
    u32x4 wb = {cvtpk(o2[0], o2[1]), cvtpk(o2[2], o2[3]), cvtpk(o2[4], o2[5]), cvtpk(o2[6], o2[7])};
    a = *reinterpret_cast<bf16x8*>(&wa); b = *reinterpret_cast<bf16x8*>(&wb);
}

__device__ __forceinline__ void rot4(bf16x8& a, const float* cs, const float* sn) {
    const f32x4 c = *(const f32x4*)cs, s = *(const f32x4*)sn; float o[8];
#pragma unroll
    for (int e = 0; e < 4; ++e) { const float x1 = bf2f((unsigned short)a[e]), x2 = bf2f((unsigned short)a[4 + e]); o[e] = x1 * c[e] - x2 * s[e]; o[4 + e] = x2 * c[e] + x1 * s[e]; }
    u32x4 w = {cvtpk(o[0], o[1]), cvtpk(o[2], o[3]), cvtpk(o[4], o[5]), cvtpk(o[6], o[7])};
    a = *reinterpret_cast<bf16x8*>(&w);
}
struct Args {
    const bf16_t* Q; int ldq, qcol;
    const bf16_t* K; int ldk, kcol;
    const bf16_t* V; int ldv, vcol;
    int q_row0;
    int kctx_row0, klat_row0, nt_ctx, nt_lat;
    float C;
    int rope;
    const float* rcos; const float* rsin;
    bf16_t* O; int ldo, ocol;
    int g, u0; const float* rpb;
    float lam, oscale; const float* subg;
};

template <int DQK, int KW, int DV, int MODE>
__device__ __forceinline__ void attn_unit(LAS unsigned char* lds, const Args& a) {
    constexpr int ND = DQK / 16, NO = DV / 32;
    constexpr int KSTR = KW * 2 + 16, KBUF = 64 * KSTR;
    constexpr int OFF_V = 2 * KBUF, OFF_WS = OFF_V + 2 * 16384, OFF_RPB = OFF_WS + 2048;
    constexpr int KCH = KW / 8, NKCH = 64 * KCH, NKC = (NKCH + 511) / 512;
    constexpr int VCH = DV / 8, NVCH = 64 * VCH, NVC = (NVCH + 511) / 512;
    constexpr float THR2 = 8.f * LOG2E;
    const int tid = opaque_tid(), wid = __builtin_amdgcn_readfirstlane(tid >> 6), lane = tid & 63, r32 = lane & 31, hi = lane >> 5;
    LAS unsigned char* Kl = lds; LAS unsigned char* Vl = lds + OFF_V;
    LAS float* wsf = (LAS float*)(lds + OFF_WS) + wid * 64; LAS float* li_l = wsf; LAS float* al_l = wsf + 32;
    LAS float* rpbl = (LAS float*)(lds + OFF_RPB);
    const int wq = (MODE == 1) ? (wid & 3) : wid, wmap = (MODE == 1) ? (wid >> 2) : 0;
    const float Cs = (MODE == 2) ? 1.f : a.C; const float thr = THR2 / Cs;
    bf16x8 qr[ND];
    const int qrow = a.q_row0 + wq * 32 + r32;
    {
        const bf16_t* Qw = a.Q + (size_t)qrow * a.ldq + a.qcol + wmap * 64 + hi * 8;
#pragma unroll
        for (int d0 = 0; d0 < ND; ++d0) qr[d0] = *(const bf16x8*)(Qw + d0 * 16);
        if (a.rope == 2) { if constexpr (ND >= 6) { const int s = qrow & (SEQ - 1); rot4(qr[4], a.rcos + s * 16 + 4 * hi, a.rsin + s * 16 + 4 * hi); rot4(qr[5], a.rcos + s * 16 + 8 + 4 * hi, a.rsin + s * 16 + 8 + 4 * hi); } }
    }
    if (MODE == 2) { if (tid < 465) rpbl[tid] = a.rpb[tid] * LOG2E; }
    const int cq = (wid & 1) * 32 + r32, rq = 4 * a.g + (wid >> 1);
    const int rs = min(max(rq - 4, 0), 120), cs_ = min(max(cq - 8, 0), 48);
    int kgo[NKC], klo[NKC], vgo[NVC], vlo[NVC];
#pragma unroll
    for (int i = 0; i < NKC; ++i) { const int c = tid + 512 * i, row = c / KCH, ch = c % KCH; kgo[i] = row * a.ldk + ch * 8; klo[i] = row * KSTR + ch * 16; }
#pragma unroll
    for (int i = 0; i < NVC; ++i) { const int c = tid + 512 * i, row = c / VCH, ch = c % VCH; vgo[i] = row * a.ldv + ch * 8; vlo[i] = v_st(row, ch * 8); }
    u32x4 ksA[NKC], vsA[NVC], ksB[NKC], vsB[NVC];
    const int NT = a.nt_ctx + a.nt_lat;
#define TILE_ROW(j) ((j) < a.nt_ctx ? a.kctx_row0 + 64 * (j) : a.klat_row0 + 64 * ((j) - a.nt_ctx))
#define SLOAD(KS, VS, j) do { const int _r0 = TILE_ROW(j); const bf16_t* _kp = a.K + (size_t)_r0 * a.ldk + a.kcol; const bf16_t* _vp = a.V + (size_t)_r0 * a.ldv + a.vcol; \
    _Pragma("unroll") for (int _i = 0; _i < NKC; ++_i) if ((NKCH % 512 == 0) || tid + 512 * _i < NKCH) KS[_i] = *(const u32x4*)(_kp + kgo[_i]); \
    _Pragma("unroll") for (int _i = 0; _i < NVC; ++_i) if ((NVCH % 512 == 0) || tid + 512 * _i < NVCH) VS[_i] = *(const u32x4*)(_vp + vgo[_i]); } while (0)
#define SWRITE(b, KS, VS) do { \
    _Pragma("unroll") for (int _i = 0; _i < NKC; ++_i) if ((NKCH % 512 == 0) || tid + 512 * _i < NKCH) *(LAS u32x4*)(Kl + (b) * KBUF + klo[_i]) = KS[_i]; \
    _Pragma("unroll") for (int _i = 0; _i < NVC; ++_i) if ((NVCH % 512 == 0) || tid + 512 * _i < NVCH) *(LAS u32x4*)(Vl + (b) * 16384 + vlo[_i]) = VS[_i]; } while (0)
#define SWAIT() asm volatile("s_waitcnt vmcnt(%0)" :: "n"(NKC + NVC) : "memory")
    float m_reg = -1e30f, l_reg = 0.f;
    f32x16 o[NO];
#pragma unroll
    for (int d = 0; d < NO; ++d) o[d] = (f32x16){0.f, 0.f, 0.f, 0.f, 0.f, 0.f, 0.f, 0.f, 0.f, 0.f, 0.f, 0.f, 0.f, 0.f, 0.f, 0.f};
    const unsigned vb0 = (unsigned)(size_t)Vl + (unsigned)v_rd_base(lane);
#define QKT(P0, P1, b) do { P0 = (f32x16){0.f, 0.f, 0.f, 0.f, 0.f, 0.f, 0.f, 0.f, 0.f, 0.f, 0.f, 0.f, 0.f, 0.f, 0.f, 0.f}; P1 = P0; \
    const LAS unsigned char* _Kb = Kl + (b) * KBUF + wmap * 128; \
    _Pragma("unroll") for (int d0 = 0; d0 < ND; ++d0) { const int cb = (d0 * 16 + hi * 8) * 2; \
        const bf16x8 b0 = *(const LAS bf16x8*)(_Kb + r32 * KSTR + cb), b1 = *(const LAS bf16x8*)(_Kb + (32 + r32) * KSTR + cb); \
        P0 = __builtin_amdgcn_mfma_f32_32x32x16_bf16(b0, qr[d0], P0, 0, 0, 0); \
        P1 = __builtin_amdgcn_mfma_f32_32x32x16_bf16(b1, qr[d0], P1, 0, 0, 0); } } while (0)
#define PARTIAL(P0, P1, MN, AL, j) do { \
    if (MODE == 2) { \
        if ((j) >= a.nt_ctx) { const int kr = a.u0 + ((j) - a.nt_ctx); const bool rowok = (kr >= rs) && (kr < rs + 8); const int ro = min(max(kr - rq + 7, 0), 14); const LAS float* brow = rpbl + ro * 31; \
            _Pragma("unroll") for (int r = 0; r < 16; ++r) { \
                { const int ck = crow(r, hi), dd = min(max(ck - cq + 15, 0), 30); const bool inw = rowok && ((unsigned)(ck - cs_) < 16u); const float bv = brow[dd]; P0[r] = inw ? fmaf(P0[r], a.C, bv) : -1e30f; } \
                { const int ck = 32 + crow(r, hi), dd = min(max(ck - cq + 15, 0), 30); const bool inw = rowok && ((unsigned)(ck - cs_) < 16u); const float bv = brow[dd]; P1[r] = inw ? fmaf(P1[r], a.C, bv) : -1e30f; } } \
        } else { _Pragma("unroll") for (int r = 0; r < 16; ++r) { P0[r] *= a.C; P1[r] *= a.C; } } } \
    float pmax = P0[0]; \
    _Pragma("unroll") for (int r = 1; r < 16; ++r) pmax = fmaxf(pmax, P0[r]); \
    _Pragma("unroll") for (int r = 0; r < 16; ++r) pmax = fmaxf(pmax, P1[r]); \
    { auto rr = __builtin_amdgcn_permlane32_swap(__float_as_uint(pmax), __float_as_uint(pmax), false, false); pmax = fmaxf(__uint_as_float(rr[0]), __uint_as_float(rr[1])); } \
    if (__builtin_expect(__all(pmax - m_reg <= thr), 1)) { MN = m_reg; AL = 1.f; } \
    else { MN = fmaxf(m_reg, pmax); AL = fast_exp2((m_reg - MN) * Cs); m_reg = MN; } \
    const float mnC = -MN * Cs; \
    _Pragma("unroll") for (int r = 0; r < 16; ++r) P0[r] = fmaf(P0[r], Cs, mnC); \
    _Pragma("unroll") for (int r = 0; r < 16; ++r) P1[r] = fmaf(P1[r], Cs, mnC); \
    _Pragma("unroll") for (int r = 0; r < 16; ++r) P0[r] = fast_exp2(P0[r]); } while (0)
#define PK4(P, BASE, OUT) do { unsigned a0 = cvtpk(P[BASE + 0], P[BASE + 1]), a1 = cvtpk(P[BASE + 2], P[BASE + 3]);   \
    unsigned b0 = cvtpk(P[BASE + 4], P[BASE + 5]), b1 = cvtpk(P[BASE + 6], P[BASE + 7]);                              \
    auto r0 = __builtin_amdgcn_permlane32_swap(a0, b0, false, false); auto r1 = __builtin_amdgcn_permlane32_swap(a1, b1, false, false); \
    u32x4 w = {r0[0], r1[0], r0[1], r1[1]}; OUT = *reinterpret_cast<bf16x8*>(&w); } while (0)
#define FINISH(P0, P1, AL) do { \
    _Pragma("unroll") for (int r = 0; r < 16; ++r) P1[r] = fast_exp2(P1[r]); \
    float ps = 0.f; \
    _Pragma("unroll") for (int r = 0; r < 16; ++r) ps += P0[r]; \
    _Pragma("unroll") for (int r = 0; r < 16; ++r) ps += P1[r]; \
    { auto rr = __builtin_amdgcn_permlane32_swap(__float_as_uint(ps), __float_as_uint(ps), false, false); ps = __uint_as_float(rr[0]) + __uint_as_float(rr[1]); } \
    l_reg = l_reg * AL + ps; \
    PK4(P0, 0, pa0); PK4(P0, 8, pa1); PK4(P1, 0, pa2); PK4(P1, 8, pa3); } while (0)
#define PV(b) do { const unsigned _vb = vb0 + (unsigned)(b) * 16384u; \
    pv_one<0>(o[0], _vb, pa0, pa1, pa2, pa3); pv_one<1>(o[1], _vb, pa0, pa1, pa2, pa3); \
    if constexpr (NO == 4) { pv_one<2>(o[2], _vb, pa0, pa1, pa2, pa3); pv_one<3>(o[3], _vb, pa0, pa1, pa2, pa3); } } while (0)
#define RESC(AL) do { if (__any((AL) < 1.f)) { if (hi == 0) al_l[r32] = (AL); LDS_WAIT(); \
    _Pragma("unroll") for (int r = 0; r < 16; ++r) { const float av = al_l[crow(r, hi)]; \
        _Pragma("unroll") for (int d = 0; d < NO; ++d) o[d][r] *= av; } } } while (0)
    f32x16 pA0, pA1, pB0, pB1; float mnA, mnB, alA, alB; bf16x8 pa0, pa1, pa2, pa3;
    SLOAD(ksA, vsA, 0); VM_WAIT(); SWRITE(0, ksA, vsA); __syncthreads();
    QKT(pA0, pA1, 0); PARTIAL(pA0, pA1, mnA, alA, 0);
    SLOAD(ksB, vsB, 1); if (2 < NT) SLOAD(ksA, vsA, 2);
    SWAIT(); SWRITE(1, ksB, vsB); __syncthreads();
    for (int j = 1; j + 1 < NT; j += 2) {
        SBAR(); QKT(pB0, pB1, 1);
        FINISH(pA0, pA1, alA); SBAR();
        SLOAD(ksB, vsB, j + 2); SBAR();
        PV(0); PARTIAL(pB0, pB1, mnB, alB, j);
        __syncthreads(); SWAIT(); SWRITE(0, ksA, vsA);
        RESC(alB); __syncthreads();
        SBAR(); QKT(pA0, pA1, 0);
        FINISH(pB0, pB1, alB); SBAR();
        if (j + 3 < NT) SLOAD(ksA, vsA, j + 3); SBAR();
        PV(1); PARTIAL(pA0, pA1, mnA, alA, j + 1);
        __syncthreads(); SWAIT(); SWRITE(1, ksB, vsB);
        RESC(alA); __syncthreads();
    }
    SBAR(); QKT(pB0, pB1, 1);
    FINISH(pA0, pA1, alA); SBAR();
    PV(0); PARTIAL(pB0, pB1, mnB, alB, NT - 1);
    __syncthreads(); RESC(alB);
    FINISH(pB0, pB1, alB); SBAR();
    PV(1);
    __syncthreads();
#undef TILE_ROW
#undef SLOAD
#undef SWRITE
#undef SWAIT
#undef QKT
#undef PARTIAL
#undef PK4
#undef FINISH
#undef PV
#undef RESC
    if (hi == 0) li_l[r32] = l_reg; LDS_WAIT();
    float rli[16];
#pragma unroll
    for (int r = 0; r < 16; ++r) rli[r] = fast_rcp(li_l[crow(r, hi)]);
    if (MODE != 1) {
        bf16_t* Ow = a.O + (size_t)(a.q_row0 + wid * 32) * a.ldo + a.ocol + r32;
#pragma unroll
        for (int r = 0; r < 16; ++r) { const int orow = crow(r, hi);
#pragma unroll
            for (int d0 = 0; d0 < NO; ++d0) Ow[(size_t)orow * a.ldo + d0 * 32] = f2bf(o[d0][r] * rli[r]); }
    } else {
        LAS float* cb = (LAS float*)lds;
        if (wmap == 1) {
#pragma unroll
            for (int r = 0; r < 16; ++r) { const int row = wq * 32 + crow(r, hi);
#pragma unroll
                for (int d0 = 0; d0 < NO; ++d0) cb[row * 129 + d0 * 32 + r32] = a.lam * o[d0][r] * rli[r]; }
        }
        __syncthreads();
        if (wmap == 0) {
#pragma unroll
            for (int r = 0; r < 16; ++r) { const int row = wq * 32 + crow(r, hi);
#pragma unroll
                for (int d0 = 0; d0 < NO; ++d0) { const int ix = row * 129 + d0 * 32 + r32; cb[ix] = o[d0][r] * rli[r] - cb[ix]; } }
        }
        __syncthreads();
        const int row = tid >> 2, qd = tid & 3;
        float v[32]; float ss = 0.f;
#pragma unroll
        for (int i = 0; i < 32; ++i) { v[i] = cb[row * 129 + qd * 32 + i]; ss += v[i] * v[i]; }
        ss += __shfl_xor(ss, 1); ss += __shfl_xor(ss, 2);
        const float rstd = rsqrtf(ss * (1.f / 128.f) + EPS) * a.oscale;
        bf16_t* Ow = a.O + (size_t)(a.q_row0 + row) * a.ldo + a.ocol + qd * 32;
#pragma unroll
        for (int c = 0; c < 4; ++c) { float w[8];
#pragma unroll
            for (int e = 0; e < 8; ++e) w[e] = v[c * 8 + e] * rstd * a.subg[qd * 32 + c * 8 + e];
            u32x4 pk = {cvtpk(w[0], w[1]), cvtpk(w[2], w[3]), cvtpk(w[4], w[5]), cvtpk(w[6], w[7])};
            *(u32x4*)(Ow + c * 8) = pk; }
    }
    __syncthreads();
}

__device__ __forceinline__ void sgu_unit(LAS unsigned char* lds, const bf16_t* PB, const bf16_t* Wsb, const float* bs, const float* stats, const float* sgain, bf16_t* MIX, int rowbase, int g) {
    const int tid = opaque_tid(), wid = __builtin_amdgcn_readfirstlane(tid >> 6), lane = tid & 63, r32 = lane & 31, hi = lane >> 5;
    LAS unsigned char* Vl = lds;
#pragma unroll 2
    for (int i = 0; i < 4; ++i) { const int c = tid + 512 * i, row = c >> 4, ch = c & 15;
        const u32x4 x = *(const u32x4*)(PB + (size_t)(rowbase + row) * EV_IN + 512 + g * 128 + ch * 8);
        const f32x4* st = (const f32x4*)(stats + (size_t)(rowbase + row) * 16); const f32x4 a0 = st[0], a1 = st[1], a2 = st[2], a3 = st[3];
        const float s1 = ((a0[0] + a0[2]) + (a1[0] + a1[2])) + ((a2[0] + a2[2]) + (a3[0] + a3[2])), s2 = ((a0[1] + a0[3]) + (a1[1] + a1[3])) + ((a2[1] + a2[3]) + (a3[1] + a3[3]));
        const float mean = s1 * (1.f / 512.f), rstd = rsqrtf(fmaxf(s2 * (1.f / 512.f) - mean * mean, 0.f) + EPS);
        const f32x4 g0 = *(const f32x4*)(sgain + g * 128 + ch * 8), g1 = *(const f32x4*)(sgain + g * 128 + ch * 8 + 4);
        u32x4 y; y.x = cvtpk((bflo(x.x) - mean) * rstd * g0[0], (bfhi(x.x) - mean) * rstd * g0[1]); y.y = cvtpk((bflo(x.y) - mean) * rstd * g0[2], (bfhi(x.y) - mean) * rstd * g0[3]);
        y.z = cvtpk((bflo(x.z) - mean) * rstd * g1[0], (bfhi(x.z) - mean) * rstd * g1[1]); y.w = cvtpk((bflo(x.w) - mean) * rstd * g1[2], (bfhi(x.w) - mean) * rstd * g1[3]);
        *(LAS u32x4*)(Vl + (row >> 6) * 16384 + v_st(row & 63, ch * 8)) = y; }
    const int prow = (wid & 3) * 32, dh = wid >> 2;
    bf16x8 pa[2][4];
#pragma unroll
    for (int kt = 0; kt < 2; ++kt)
#pragma unroll
        for (int ks = 0; ks < 4; ++ks) pa[kt][ks] = *(const bf16x8*)(Wsb + (size_t)(g * 128 + prow + r32) * 128 + kt * 64 + ks * 16 + hi * 8);
    __syncthreads();
    f32x16 o[2];
    o[0] = (f32x16){0.f, 0.f, 0.f, 0.f, 0.f, 0.f, 0.f, 0.f, 0.f, 0.f, 0.f, 0.f, 0.f, 0.f, 0.f, 0.f}; o[1] = o[0];
    const unsigned vb0 = (unsigned)(size_t)Vl + (unsigned)v_rd_base(lane);
#pragma unroll
    for (int kt = 0; kt < 2; ++kt) { const unsigned vb = vb0 + kt * 16384u;
        if (dh == 0) { pv_one<0>(o[0], vb, pa[kt][0], pa[kt][1], pa[kt][2], pa[kt][3]); pv_one<1>(o[1], vb, pa[kt][0], pa[kt][1], pa[kt][2], pa[kt][3]); }
        else { pv_one<2>(o[0], vb, pa[kt][0], pa[kt][1], pa[kt][2], pa[kt][3]); pv_one<3>(o[1], vb, pa[kt][0], pa[kt][1], pa[kt][2], pa[kt][3]); } }
#pragma unroll
    for (int r = 0; r < 16; ++r) { const int p = prow + crow(r, hi); const float bias = bs[g * 128 + p];
#pragma unroll
        for (int dd = 0; dd < 2; ++dd) { const int d = (2 * dh + dd) * 32 + r32;
            const float u = bf2f(PB[(size_t)(rowbase + p) * EV_IN + g * 128 + d]);
            MIX[(size_t)(rowbase + p) * DM + g * 128 + d] = f2bf(u * (o[dd][r] + bias)); } }
    __syncthreads();
}
}

struct Params {
    const float* in[31];
    float* out;
    unsigned char* ws;
    int ph_lo, ph_hi;
};

struct Ctx {
    LAS unsigned char* lds;
    int tid, lane, wid, gw, NGW;
};
__device__ __forceinline__ Ctx make_ctx(LAS unsigned char* lds) { const int t = opaque_tid(), w = __builtin_amdgcn_readfirstlane(t >> 6); return Ctx{lds, t, t & 63, w, opaque_bid() * 8 + w, (int)gridDim.x * 8}; }
typedef const __attribute__((address_space(4))) Params KParams;
__device__ __forceinline__ KParams& kparams() { KParams* p = (KParams*)__builtin_amdgcn_kernarg_segment_ptr(); asm volatile("" : "+s"(p)); return *p; }

__device__ __forceinline__ float* xrow_ptr(KParams& P, int row) { return row < NLAT ? P.out + (size_t)row * DM : (float*)(P.ws + WS_CTXX) + (size_t)(row - NLAT) * DM; }
__device__ __forceinline__ int mod_r(int row) { return row < NLAT ? (row >> 13) : 4; }
__device__ __forceinline__ f32x4 ld4(const float* p) { return *(const f32x4*)p; }
__device__ __forceinline__ f32x4 ldbf4(const bf16_t* p) { const u32x2 w = *(const u32x2*)p; return (f32x4){bflo(w.x), bfhi(w.x), bflo(w.y), bfhi(w.y)}; }
__device__ __forceinline__ void stbf4(bf16_t* p, f32x4 v) { u32x2 w; w.x = cvtpk(v[0], v[1]); w.y = cvtpk(v[2], v[3]); *(u32x2*)p = w; }
__device__ __forceinline__ float sumsq4(const f32x4 (&v)[4]) { float s = 0.f;
#pragma unroll
    for (int j = 0; j < 4; ++j) s += (v[j][0] * v[j][0] + v[j][1] * v[j][1]) + (v[j][2] * v[j][2] + v[j][3] * v[j][3]);
    return wave_sum(s); }
__device__ __forceinline__ void norm_mod(const f32x4 (&x)[4], f32x4 (&hv)[4], const float* gain, const float* shift, const float* scale, int lane) {
    const float rstd = rsqrtf(sumsq4(x) * (1.f / DM) + EPS);
#pragma unroll
    for (int j = 0; j < 4; ++j) { const int c = 4 * lane + 256 * j; const f32x4 g = ld4(gain + c), sh = ld4(shift + c), sc = ld4(scale + c);
        hv[j] = (x[j] * rstd) * g * (sc + 1.f) + sh; }
}
__device__ __forceinline__ void resid_add(f32x4 (&x)[4], const f32x4 (&y)[4], const float* gain, const float* gate, int lane) {
    const float rstd = rsqrtf(sumsq4(y) * (1.f / DM) + EPS);
#pragma unroll
    for (int j = 0; j < 4; ++j) { const int c = 4 * lane + 256 * j; const f32x4 g = ld4(gain + c), gt = ld4(gate + c);
        x[j] = x[j] + gt * ((y[j] * rstd) * g); }
}

__device__ __forceinline__ void wave_rows(const Ctx& c, int mtok, int& r0, int& r1) {
    const int bid = opaque_bid(); const int rpw = mtok / (int)gridDim.x, base = bid * rpw;
    r0 = base + (c.wid * rpw) / 8; r1 = base + ((c.wid + 1) * rpw) / 8;
    if (bid == (int)gridDim.x - 1 && c.wid == 7) r1 = mtok;
}
__device__ __forceinline__ void ld_gate(f32x4 (&G)[4], const float* gain, const float* gate, int lane) {
#pragma unroll
    for (int j = 0; j < 4; ++j) { const int cc = 4 * lane + 256 * j; G[j] = ld4(gain + cc) * ld4(gate + cc); } }
__device__ __forceinline__ void ld_mod(f32x4 (&A)[4], f32x4 (&B)[4], const float* gain, const float* shift, const float* scale, int lane) {
#pragma unroll
    for (int j = 0; j < 4; ++j) { const int cc = 4 * lane + 256 * j; A[j] = ld4(gain + cc) * (ld4(scale + cc) + 1.f); B[j] = ld4(shift + cc); } }
__device__ __forceinline__ void resid_add2(f32x4 (&x)[4], const f32x4 (&y)[4], const f32x4 (&G)[4]) {
    const float rstd = rsqrtf(sumsq4(y) * (1.f / DM) + EPS);
#pragma unroll
    for (int j = 0; j < 4; ++j) x[j] = x[j] + G[j] * (y[j] * rstd);
}
__device__ __forceinline__ void norm_mod2(const f32x4 (&x)[4], f32x4 (&hv)[4], const f32x4 (&A)[4], const f32x4 (&B)[4]) {
    const float rstd = rsqrtf(sumsq4(x) * (1.f / DM) + EPS);
#pragma unroll
    for (int j = 0; j < 4; ++j) hv[j] = (x[j] * rstd) * A[j] + B[j];
}

__device__ __forceinline__ int perm_row(int pmode, int n) {
    if (pmode == 1) { if (n >= 1024 && n < 2048) { const int d = n & 63, hb = n & ~63; return hb + ((d < 32) ? 8 * (d >> 2) + (d & 3) : 8 * ((d - 32) >> 2) + 4 + (d & 3)); } }
    else if (pmode == 2) { if (n >= 1920 && n < 1952) { const int d = n - 1920; return 1920 + ((d < 16) ? 8 * (d >> 2) + (d & 3) : 8 * ((d - 16) >> 2) + 4 + (d & 3)); } }
    return n;
}
__device__ __forceinline__ void tr_item(const float* W, int ldw, bf16_t* WT, int ldt, int k0, int n0, int drow, LAS float* scr, int lane, int pmode = 0) {
#pragma unroll 8
    for (int i = 0; i < 32; ++i) { const int kk = 2 * i + (lane >> 5); scr[kk * 33 + (lane & 31)] = W[(size_t)(k0 + kk) * ldw + n0 + (lane & 31)]; }
    LDS_WAIT(); asm volatile("" ::: "memory");
    const int c = lane & 7;
#pragma unroll
    for (int j = 0; j < 4; ++j) { const int n = (lane >> 3) + 8 * j; const LAS float* s = scr + (8 * c) * 33 + n;
        u32x4 o; o.x = cvtpk(s[0 * 33], s[1 * 33]); o.y = cvtpk(s[2 * 33], s[3 * 33]); o.z = cvtpk(s[4 * 33], s[5 * 33]); o.w = cvtpk(s[6 * 33], s[7 * 33]);
        const int dr = pmode ? perm_row(pmode, n0 + n) : drow + n;
        *(u32x4*)(WT + (size_t)dr * ldt + k0 + 8 * c) = o; }
    LDS_WAIT(); asm volatile("" ::: "memory");
}
__device__ __forceinline__ void tr_item8(const float* W, int ldw, unsigned char* WT, int ldt, int k0, int n0, int drow, LAS float* scr, int lane) {
#pragma unroll 8
    for (int i = 0; i < 32; ++i) { const int kk = 2 * i + (lane >> 5); scr[kk * 33 + (lane & 31)] = W[(size_t)(k0 + kk) * ldw + n0 + (lane & 31)] * F8_W_SCALE; }
    LDS_WAIT(); asm volatile("" ::: "memory");
    const int c = lane & 7;
#pragma unroll
    for (int j = 0; j < 4; ++j) { const int n = (lane >> 3) + 8 * j; const LAS float* s = scr + (8 * c) * 33 + n;
        u32x2 o; o.x = pk4_fp8(s[0 * 33], s[1 * 33], s[2 * 33], s[3 * 33]); o.y = pk4_fp8(s[4 * 33], s[5 * 33], s[6 * 33], s[7 * 33]);
        *(u32x2*)(WT + (size_t)(drow + n) * ldt + k0 + 8 * c) = o; }
    LDS_WAIT(); asm volatile("" ::: "memory");
}
__device__ __forceinline__ void tr_matrix8(const Ctx& c, const float* W, int K, int N, unsigned char* WT, int mode, int row_off) {
    LAS float* scr = (LAS float*)(c.lds + c.wid * 16384);
    const int nblk = N / 32, nitems = (K / 64) * nblk;
    for (int it = c.gw; it < nitems; it += c.NGW) { const int kb = it / nblk, nb = it % nblk, n0 = 32 * nb;
        const int drow = (mode == 0) ? row_off + n0 : (n0 >> 7) * 256 + (n0 & 127) + (mode == 2 ? 128 : 0);
        tr_item8(W, N, WT, K, 64 * kb, n0, drow, scr, c.lane); }
}
__device__ __forceinline__ void tr_matrix(const Ctx& c, const float* W, int K, int N, bf16_t* WT, int mode, int row_off, int pmode = 0) {
    LAS float* scr = (LAS float*)(c.lds + c.wid * 16384);
    const int nblk = N / 32, nitems = (K / 64) * nblk;
    for (int it = c.gw; it < nitems; it += c.NGW) { const int kb = it / nblk, nb = it % nblk, n0 = 32 * nb;
        const int drow = (mode == 0) ? row_off + n0 : (n0 >> 7) * 256 + (n0 & 127) + (mode == 2 ? 128 : 0);
        tr_item(W, N, WT, K, 64 * kb, n0, drow, scr, c.lane, pmode); }
}
constexpr int MOE_CVT_ITEMS = 24 * 1792;
__device__ __forceinline__ void convert_moe_items(const Ctx& c, int i, int t0, int t1) {
    KParams& P = kparams();
    LAS float* scr = (LAS float*)(c.lds + c.wid * 16384);
    for (int t = t0 + c.gw; t < t1; t += c.NGW) {
        const int mat = t / 1792, r = t % 1792, e = mat / 3, which = mat % 3;
        if (which < 2) {
            const float* W = P.in[28 + which] + ((size_t)i * NEXP + e) * DM * DFFE; const int kb = r / 112, n0 = 32 * (r % 112);
            const int drow = (n0 >> 7) * 256 + (n0 & 127) + which * 128;
#if MOE_F8
            tr_item8(W, DFFE, (unsigned char*)(P.ws + WS_W13M) + (size_t)e * 2 * DFFE * DM, DM, 64 * kb, n0, drow, scr, c.lane);
#else
            tr_item(W, DFFE, (bf16_t*)(P.ws + WS_W13M) + (size_t)e * 2 * DFFE * DM, DM, 64 * kb, n0, drow, scr, c.lane);
#endif
        } else {
            const float* W = P.in[30] + ((size_t)i * NEXP + e) * DFFE * DM; const int kb = r / 32, n0 = 32 * (r % 32);
#if MOE_F8
            tr_item8(W, DM, (unsigned char*)(P.ws + WS_W2M) + (size_t)e * DM * DFFE, DFFE, 64 * kb, n0, n0, scr, c.lane);
#else
            tr_item(W, DM, (bf16_t*)(P.ws + WS_W2M) + (size_t)e * DM * DFFE, DFFE, 64 * kb, n0, n0, scr, c.lane);
#endif
        }
    }
}
__device__ __forceinline__ void prologue0(const Ctx& c_) {
    const Ctx c = make_ctx(c_.lds);
    KParams& P = kparams(); unsigned char* ws = P.ws;
    if (blockIdx.x < 96) {
        LAS float* sl = (LAS float*)c.lds;
        LAS float* part = (LAS float*)(c.lds + 32768);
        for (int i = c.tid; i < 5 * DM; i += 512) { const int r = i >> 10, k = i & 1023; const float x = r < 4 ? P.in[1][r * DM + k] : P.in[3][k]; sl[i] = x / (1.f + expf(-x)); }
        __syncthreads();
        const int t = blockIdx.x, lm = t / 24, cbk = t % 24, n = cbk * 256 + 4 * c.lane;
        const float* W = P.in[4] + (size_t)lm * DM * (NMOD * DM) + n;
        f32x4 acc[5];
#pragma unroll
        for (int r = 0; r < 5; ++r) acc[r] = (f32x4){0.f, 0.f, 0.f, 0.f};
        const int kb = c.wid * 128;
        for (int k0 = 0; k0 < 128; k0 += 8) {
            f32x4 wv[8];
#pragma unroll
            for (int u = 0; u < 8; ++u) wv[u] = ld4(W + (size_t)(kb + k0 + u) * (NMOD * DM));
#pragma unroll
            for (int u = 0; u < 8; ++u)
#pragma unroll
                for (int r = 0; r < 5; ++r) acc[r] += wv[u] * sl[r * DM + kb + k0 + u];
        }
#pragma unroll
        for (int r = 0; r < 5; ++r) *(LAS f32x4*)(part + (c.wid * 5 + r) * 256 + 4 * c.lane) = acc[r];
        __syncthreads();
        for (int i = c.tid; i < 5 * 256; i += 512) { const int r = i >> 8, cc = i & 255; float s = 0.f;
#pragma unroll
            for (int w = 0; w < 8; ++w) s += part[(w * 5 + r) * 256 + cc];
            ((float*)(ws + WS_MODS))[(size_t)(lm * 5 + r) * (NMOD * DM) + cbk * 256 + cc] = s + P.in[5][lm * (NMOD * DM) + cbk * 256 + cc]; }
        __syncthreads();
    }
    for (int i = 0; i < 2; ++i) {
        tr_matrix(c, P.in[7] + (size_t)i * DM * EV_IN, DM, EV_IN, (bf16_t*)(ws + WS_WINE) + (size_t)i * EV_IN * DM, 0, 0, 1);
        tr_matrix(c, P.in[8] + (size_t)i * DM * DM, DM, DM, (bf16_t*)(ws + WS_WOUTE) + (size_t)i * DM * DM, 0, 0);
        tr_matrix(c, P.in[17] + (size_t)i * DM * DFF, DM, DFF, (bf16_t*)(ws + WS_W13E) + (size_t)i * 2 * DFF * DM, 1, 0);
        tr_matrix(c, P.in[18] + (size_t)i * DM * DFF, DM, DFF, (bf16_t*)(ws + WS_W13E) + (size_t)i * 2 * DFF * DM, 2, 0);
        tr_matrix(c, P.in[19] + (size_t)i * DFF * DM, DFF, DM, (bf16_t*)(ws + WS_W2E) + (size_t)i * DM * DFF, 0, 0);
        tr_matrix(c, P.in[20] + (size_t)i * DM * OD_IN, DM, OD_IN, (bf16_t*)(ws + WS_WINO) + (size_t)i * OD_INP * DM, 0, 0, 2);
        tr_matrix(c, P.in[21] + (size_t)i * DM * DM, DM, DM, (bf16_t*)(ws + WS_WOUTO) + (size_t)i * DM * DM, 0, 0);
    }
    const int gt = blockIdx.x * 512 + c.tid, NGT = gridDim.x * 512;
    for (int i = gt; i < 2 * (OD_INP - OD_IN) * DM; i += NGT) { const int l = i / ((OD_INP - OD_IN) * DM), r = i % ((OD_INP - OD_IN) * DM);
        ((bf16_t*)(ws + WS_WINO))[(size_t)l * OD_INP * DM + (size_t)OD_IN * DM + r] = 0; }
    for (int i = gt; i < 2 * MLA_N * MLA_K; i += NGT) { const int l = i / (MLA_N * MLA_K), n = (i / MLA_K) % MLA_N, k = i % MLA_K; float v = 0.f;
        if (n < 384) { if (k < 256) { const int h = n / 96, j = n % 96; int sc = n;
                if (j >= 64) { const int p = j - 64, t = p >> 3, e = p & 7; sc = h * 96 + 64 + ((e < 4) ? 4 * t + e : 16 + 4 * t + (e - 4)); }
                v = P.in[24][((size_t)l * 256 + k) * 384 + sc] * P.in[23][l * 256 + k]; } }
        else if (n < 768) { const int h = (n - 384) / 96, j = (n - 384) % 96;
            if (j < 64) { if (k >= 256 && k < 384) v = P.in[26][((size_t)l * 128 + (k - 256)) * 768 + h * 192 + j] * P.in[25][l * 128 + (k - 256)]; }
            else { if (k == 384 + (j - 64)) v = 1.f; } }
        else { const int h = (n - 768) / 128, j = (n - 768) % 128; if (k >= 256 && k < 384) v = P.in[26][((size_t)l * 128 + (k - 256)) * 768 + h * 192 + 64 + j] * P.in[25][l * 128 + (k - 256)]; }
        ((bf16_t*)(ws + WS_WMLA))[i] = f2bf(v); }
    for (int i = gt; i < 2 * 4 * 128 * 128; i += NGT) ((bf16_t*)(ws + WS_SGUW))[i] = f2bf(P.in[9][i]);
    for (int i = gt; i < SEQ * 32; i += NGT) { const int s = i >> 5, f = i & 31; const int pos = f < 16 ? (s >> 6) : (s & 63);
        const float inv = 1.0f / powf(10000.0f, (float)(f & 15) / 16.0f); const float ang = (float)pos * inv;
        ((float*)(ws + WS_ROPEB))[i] = (float)cos((double)ang); ((float*)(ws + WS_ROPEB))[SEQ * 32 + i] = (float)sin((double)ang); }
    for (int i = gt; i < SEQ * 16; i += NGT) { const int s = i >> 4, f = i & 15; const int pos = f < 8 ? (s >> 6) : (s & 63);
        const float inv = 1.0f / powf(10000.0f, (float)(f & 7) / 8.0f); const float ang = (float)pos * inv;
        ((float*)(ws + WS_ROPED))[i] = (float)cos((double)ang); ((float*)(ws + WS_ROPED))[SEQ * 16 + i] = (float)sin((double)ang); }
}

__device__ __forceinline__ void ew_first(const Ctx& c_) {
    const Ctx c = make_ctx(c_.lds);
    KParams& P = kparams(); const float* mods = (const float*)(P.ws + WS_MODS); bf16_t* HB = (bf16_t*)(P.ws + WS_HB);
    int r0, r1; wave_rows(c, MTOT, r0, r1);
    f32x4 A0[4], B0[4]; int rcur = -1;
    for (int row = r0; row < r1; ++row) {
        const float* src = row < NLAT ? P.in[0] + (size_t)row * DM : P.in[2] + (size_t)(row - NLAT) * DM;
        float* xr = xrow_ptr(P, row); const int r = mod_r(row);
        if (r != rcur) { rcur = r; const float* mb = mods + (size_t)(0 * 5 + r) * (NMOD * DM); ld_mod(A0, B0, P.in[6] + (0 * 4 + 0) * DM, mb + 0 * DM, mb + 1 * DM, c.lane); }
        f32x4 x[4], h[4];
#pragma unroll
        for (int j = 0; j < 4; ++j) { x[j] = ld4(src + 4 * c.lane + 256 * j); *(f32x4*)(xr + 4 * c.lane + 256 * j) = x[j]; }
        norm_mod2(x, h, A0, B0);
#pragma unroll
        for (int j = 0; j < 4; ++j) stbf4(HB + (size_t)row * DM + 4 * c.lane + 256 * j, h[j]);
    }
}

__device__ __forceinline__ void ew_even_mix(const Ctx& c_, int i) {
    const Ctx c = make_ctx(c_.lds);
    KParams& P = kparams(); bf16_t* PB = (bf16_t*)(P.ws + WS_U + U_PB);
    const float* sg = P.in[11] + i * 512; const float* rc = (const float*)(P.ws + WS_ROPEB); const float* rsn = rc + SEQ * 32;
    for (int row = c.gw; row < MTOT; row += c.NGW) {
        bf16_t* pr = PB + (size_t)row * EV_IN;
        {
            const u32x4 w = *(const u32x4*)(pr + 8 * c.lane); float f[8] = {bflo(w.x), bfhi(w.x), bflo(w.y), bfhi(w.y), bflo(w.z), bfhi(w.z), bflo(w.w), bfhi(w.w)};
#pragma unroll
            for (int e = 0; e < 8; ++e) f[e] = gelu_tanh_f(f[e]);
            u32x4 o = {cvtpk(f[0], f[1]), cvtpk(f[2], f[3]), cvtpk(f[4], f[5]), cvtpk(f[6], f[7])}; *(u32x4*)(pr + 8 * c.lane) = o;
        }
        {
            const u32x4 w = *(const u32x4*)(pr + 512 + 8 * c.lane); float f[8] = {bflo(w.x), bfhi(w.x), bflo(w.y), bfhi(w.y), bflo(w.z), bfhi(w.z), bflo(w.w), bfhi(w.w)};
            float s = 0.f;
#pragma unroll
            for (int e = 0; e < 8; ++e) { f[e] = gelu_tanh_f(f[e]); s += f[e]; }
            const float mean = wave_sum(s) * (1.f / 512.f); float q = 0.f;
#pragma unroll
            for (int e = 0; e < 8; ++e) { f[e] -= mean; q += f[e] * f[e]; }
            const float rstd = rsqrtf(wave_sum(q) * (1.f / 512.f) + EPS);
            const f32x4 g0 = ld4(sg + 8 * c.lane), g1 = ld4(sg + 8 * c.lane + 4);
            float gg[8] = {g0[0], g0[1], g0[2], g0[3], g1[0], g1[1], g1[2], g1[3]};
#pragma unroll
            for (int e = 0; e < 8; ++e) f[e] = f[e] * rstd * gg[e];
            u32x4 o = {cvtpk(f[0], f[1]), cvtpk(f[2], f[3]), cvtpk(f[4], f[5]), cvtpk(f[6], f[7])}; *(u32x4*)(pr + 512 + 8 * c.lane) = o;
        }
        if (row < NLAT) {
            const int s = row & (SEQ - 1), hj = c.lane >> 3, sub = c.lane & 7;
            bf16_t* kp = pr + 1536 + hj * 64 + 4 * sub;
            const f32x4 x1 = ldbf4(kp), x2 = ldbf4(kp + 32), cs = ld4(rc + s * 32 + 4 * sub), sn = ld4(rsn + s * 32 + 4 * sub);
            stbf4(kp, x1 * cs - x2 * sn); stbf4(kp + 32, x2 * cs + x1 * sn);
        }
    }
}

__device__ __forceinline__ void ew_odd_mla(const Ctx& c_, int i) {
    const Ctx c = make_ctx(c_.lds);
    KParams& P = kparams(); const bf16_t* PB = (const bf16_t*)(P.ws + WS_U + U_PB); bf16_t* A2 = (bf16_t*)(P.ws + WS_U + U_A2);
    const float* gq = P.in[23] + i * 256; const float* gkv = P.in[25] + i * 128; const float* rc = (const float*)(P.ws + WS_ROPED); const float* rsn = rc + SEQ * 16;
    for (int row = c.gw; row < MTOT; row += c.NGW) {
        const bf16_t* pr = PB + (size_t)row * OD_INP; bf16_t* ar = A2 + (size_t)row * MLA_K;
        f32x4 q = ldbf4(pr + 1536 + 4 * c.lane);
        const float rq = rsqrtf(wave_sum(q[0] * q[0] + q[1] * q[1] + q[2] * q[2] + q[3] * q[3]) * (1.f / 256.f) + EPS);
        stbf4(ar + 4 * c.lane, q * rq * ld4(gq + 4 * c.lane));
        const unsigned kw = *(const unsigned*)(pr + 1792 + 2 * c.lane); const float k0 = bflo(kw), k1 = bfhi(kw);
        const float rk = rsqrtf(wave_sum(k0 * k0 + k1 * k1) * (1.f / 128.f) + EPS);
        *(unsigned*)(ar + 256 + 2 * c.lane) = cvtpk(k0 * rk * gkv[2 * c.lane], k1 * rk * gkv[2 * c.lane + 1]);
        if (c.lane < 16) { float x1 = bf2f(pr[1920 + c.lane]), x2 = bf2f(pr[1920 + 16 + c.lane]);
            if (row < NLAT) { const int s = row & (SEQ - 1); const float cs = rc[s * 16 + c.lane], sn = rsn[s * 16 + c.lane]; const float o1 = x1 * cs - x2 * sn, o2 = x2 * cs + x1 * sn; x1 = o1; x2 = o2; }
            ar[384 + c.lane] = f2bf(x1); ar[384 + 16 + c.lane] = f2bf(x2); }
        else { *(unsigned*)(ar + 416 + 2 * (c.lane - 16)) = 0u; }
    }
}

__device__ __forceinline__ void ew_mid(const Ctx& c_, int l, int mtok, bool dry = false) {
    const Ctx c = make_ctx(c_.lds);
    KParams& P = kparams(); const float* mods = (const float*)(P.ws + WS_MODS); bf16_t* HB = (bf16_t*)(P.ws + WS_HB);
    const bf16_t* YB = (const bf16_t*)(P.ws + WS_U + U_YB);
    const bool odd = (l & 1) != 0; const int li = l >> 1;
    LAS float* wrl = (LAS float*)c.lds;
    if (odd) { for (int i = c.tid; i < DM * NEXP; i += 512) { const int col = i >> 3, e = i & 7; wrl[e * DM + col] = P.in[27][(size_t)li * DM * NEXP + i]; } __syncthreads(); }
    unsigned long long cw = 0ull; int st_e1 = 0, st_e2 = 0, st_l1 = 0, st_l2 = 0; float st_g1 = 0.f; int nrow = 0;
    int r0, r1; wave_rows(c, mtok, r0, r1);
    f32x4 G1[4], A2[4], B2[4]; int rcur = -1;
    f32x4 xn[4], yn[4];
    if (r0 < r1) {
#pragma unroll
        for (int j = 0; j < 4; ++j) { xn[j] = ld4(xrow_ptr(P, r0) + 4 * c.lane + 256 * j); yn[j] = ldbf4(YB + (size_t)r0 * DM + 4 * c.lane + 256 * j); } }
    for (int row = r0; row < r1; ++row, ++nrow) {
        float* xr = xrow_ptr(P, row); const int r = mod_r(row);
        if (r != rcur) { rcur = r; const float* mb = mods + (size_t)(l * 5 + r) * (NMOD * DM);
            ld_gate(G1, P.in[6] + (l * 4 + 1) * DM, mb + 2 * DM, c.lane); ld_mod(A2, B2, P.in[6] + (l * 4 + 2) * DM, mb + 3 * DM, mb + 4 * DM, c.lane); }
        f32x4 x[4], y[4], h[4];
#pragma unroll
        for (int j = 0; j < 4; ++j) { x[j] = xn[j]; y[j] = yn[j]; }
        if (row + 1 < r1) {
#pragma unroll
            for (int j = 0; j < 4; ++j) { xn[j] = ld4(xrow_ptr(P, row + 1) + 4 * c.lane + 256 * j); yn[j] = ldbf4(YB + (size_t)(row + 1) * DM + 4 * c.lane + 256 * j); } }
        resid_add2(x, y, G1);
        float* xw = dry ? (float*)(P.ws + WS_U + U_YS) + (size_t)row * DM : xr; bf16_t* hw = (dry ? (bf16_t*)(P.ws + WS_U + U_PB) : HB) + (size_t)row * DM;
#pragma unroll
        for (int j = 0; j < 4; ++j) *(f32x4*)(xw + 4 * c.lane + 256 * j) = x[j];
        norm_mod2(x, h, A2, B2);
#pragma unroll
        for (int j = 0; j < 4; ++j) stbf4(hw + 4 * c.lane + 256 * j, h[j]);
        if (odd && !dry) {
            float lg[8];
#pragma unroll
            for (int e = 0; e < 8; ++e) { float sacc = 0.f;
#pragma unroll
                for (int j = 0; j < 4; ++j) { const f32x4 w = *(const LAS f32x4*)(wrl + e * DM + 4 * c.lane + 256 * j); sacc += (h[j][0] * w[0] + h[j][1] * w[1]) + (h[j][2] * w[2] + h[j][3] * w[3]); }
                lg[e] = wave_sum(sacc); }
            int e1 = 0; float v1 = lg[0];
#pragma unroll
            for (int e = 1; e < 8; ++e) if (lg[e] > v1) { v1 = lg[e]; e1 = e; }
            int e2 = -1; float v2 = -3.0e38f;
#pragma unroll
            for (int e = 0; e < 8; ++e) if (e != e1 && lg[e] > v2) { v2 = lg[e]; e2 = e; }
            if (e2 < 0) e2 = (e1 + 1) & 7;
            const float g1 = 1.f / (1.f + expf(v2 - v1));
            const int l1 = (int)((cw >> (8 * e1)) & 0xffull); cw += 1ull << (8 * e1);
            const int l2 = (int)((cw >> (8 * e2)) & 0xffull); cw += 1ull << (8 * e2);
            if (c.lane == nrow) { st_e1 = e1; st_e2 = e2; st_l1 = l1; st_l2 = l2; st_g1 = g1; }
        }
    }
    if (odd && !dry) {
        unsigned* cnt = (unsigned*)(P.ws + WS_CTL) + CW_MOECNT + li * 64;
        int base = 0;
        if (c.lane < 8) { const unsigned wc = (unsigned)((cw >> (8 * c.lane)) & 0xffull); base = wc ? (int)atomicAdd(cnt + c.lane, wc) : 0; }
        const int b1 = __shfl(base, st_e1), b2 = __shfl(base, st_e2);
        if (c.lane < nrow) { const int row = r0 + c.lane; int4* ti = (int4*)(P.ws + WS_TOKINFO) + (size_t)row * 2;
            ti[0] = make_int4(st_e1, b1 + st_l1, st_e2, b2 + st_l2); ti[1] = make_int4(__float_as_int(st_g1), __float_as_int(1.f - st_g1), 0, 0); }
        __syncthreads();
    }
}

__device__ __forceinline__ void moe_offsets(KParams& P, int li, int (&toff)[9]) {
    const unsigned* cnt = (const unsigned*)(P.ws + WS_CTL) + CW_MOECNT + li * 64; int acc = 0;
#pragma unroll
    for (int e = 0; e < 8; ++e) { toff[e] = acc; const unsigned n = __builtin_amdgcn_readfirstlane(__hip_atomic_load(cnt + e, __ATOMIC_RELAXED, __HIP_MEMORY_SCOPE_AGENT)); acc += (int)((n + 255u) >> 8); }
    toff[8] = acc;
}
__device__ __forceinline__ void moe_gather(const Ctx& c_, int li, int mtok) {
    const Ctx c = make_ctx(c_.lds);
    KParams& P = kparams(); int toff[9]; moe_offsets(P, li, toff);
    int tv = 0;
#pragma unroll
    for (int e = 0; e < 8; ++e) tv = (c.lane == e) ? toff[e] : tv;
    const bf16_t* HB = (const bf16_t*)(P.ws + WS_HB); bf16_t* HS = (bf16_t*)(P.ws + WS_U + U_YS);
    int r0, r1; wave_rows(c, mtok, r0, r1);
    for (int row = r0; row < r1; ++row) {
        const int4* ti = (const int4*)(P.ws + WS_TOKINFO) + (size_t)row * 2; const int4 a = ti[0], b = ti[1];
        const int pA = __shfl(tv, a.x) * 256 + a.y, pB = __shfl(tv, a.z) * 256 + a.w;
        if (c.lane == 0) ((int4*)(P.ws + WS_TOKPOS))[row] = make_int4(pA, pB, b.x, b.y);
        const u32x4* src = (const u32x4*)(HB + (size_t)row * DM); const u32x4 v0 = src[c.lane], v1 = src[64 + c.lane];
#if MOE_F8
        u32x2 q0, q1; const float sc = F8_ACT_SCALE;
        q0.x = pk4_fp8(bflo(v0.x) * sc, bfhi(v0.x) * sc, bflo(v0.y) * sc, bfhi(v0.y) * sc); q0.y = pk4_fp8(bflo(v0.z) * sc, bfhi(v0.z) * sc, bflo(v0.w) * sc, bfhi(v0.w) * sc);
        q1.x = pk4_fp8(bflo(v1.x) * sc, bfhi(v1.x) * sc, bflo(v1.y) * sc, bfhi(v1.y) * sc); q1.y = pk4_fp8(bflo(v1.z) * sc, bfhi(v1.z) * sc, bflo(v1.w) * sc, bfhi(v1.w) * sc);
        u32x2* dA = (u32x2*)((unsigned char*)HS + (size_t)pA * DM); u32x2* dB = (u32x2*)((unsigned char*)HS + (size_t)pB * DM);
        dA[c.lane] = q0; dA[64 + c.lane] = q1; dB[c.lane] = q0; dB[64 + c.lane] = q1;
#else
        u32x4* dA = (u32x4*)(HS + (size_t)pA * DM); u32x4* dB = (u32x4*)(HS + (size_t)pB * DM);
        dA[c.lane] = v0; dA[64 + c.lane] = v1; dB[c.lane] = v0; dB[64 + c.lane] = v1;
#endif
    }
}

__device__ __forceinline__ void ew_last(const Ctx& c_, int l, int mtok, bool dry = false) {
    const Ctx c = make_ctx(c_.lds);
    KParams& P = kparams(); const float* mods = (const float*)(P.ws + WS_MODS); bf16_t* HB = (bf16_t*)(P.ws + WS_HB);
    const bf16_t* YS = (const bf16_t*)(P.ws + WS_U + U_YS); const bool odd = (l & 1) != 0;
    int r0, r1; wave_rows(c, mtok, r0, r1);
    f32x4 G3[4], A0[4], B0[4]; int rcur = -1;
    f32x4 xn[4], yn[4];
#define EWL_LOAD(rw) do { const int _row = (rw); const float* _xr = xrow_ptr(P, _row); \
        if (odd) { const int4 tp = ((const int4*)(P.ws + WS_TOKPOS))[_row]; const float gA = __int_as_float(tp.z), gB = __int_as_float(tp.w); \
            _Pragma("unroll") for (int j = 0; j < 4; ++j) yn[j] = ldbf4(YS + (size_t)tp.x * DM + 4 * c.lane + 256 * j) * gA + ldbf4(YS + (size_t)tp.y * DM + 4 * c.lane + 256 * j) * gB; } \
        else { _Pragma("unroll") for (int j = 0; j < 4; ++j) yn[j] = ldbf4(YS + (size_t)_row * DM + 4 * c.lane + 256 * j); } \
        _Pragma("unroll") for (int j = 0; j < 4; ++j) xn[j] = ld4(_xr + 4 * c.lane + 256 * j); } while (0)
    if (r0 < r1) EWL_LOAD(r0);
    for (int row = r0; row < r1; ++row) {
        float* xr = xrow_ptr(P, row); const int r = mod_r(row);
        if (r != rcur) { rcur = r; const float* mb = mods + (size_t)(l * 5 + r) * (NMOD * DM);
            ld_gate(G3, P.in[6] + (l * 4 + 3) * DM, mb + 5 * DM, c.lane);
            if (l < 3) { const float* mn = mods + (size_t)((l + 1) * 5 + r) * (NMOD * DM); ld_mod(A0, B0, P.in[6] + ((l + 1) * 4 + 0) * DM, mn + 0 * DM, mn + 1 * DM, c.lane); } }
        f32x4 x[4], y[4], h[4];
#pragma unroll
        for (int j = 0; j < 4; ++j) { x[j] = xn[j]; y[j] = yn[j]; }
        if (row + 1 < r1) EWL_LOAD(row + 1);
        resid_add2(x, y, G3);
        float* xw = dry ? (float*)(P.ws + WS_U + U_PB) + (size_t)row * DM : xr; bf16_t* hw = (dry ? (bf16_t*)(P.ws + WS_U + U_MIX) : HB) + (size_t)row * DM;
#pragma unroll
        for (int j = 0; j < 4; ++j) *(f32x4*)(xw + 4 * c.lane + 256 * j) = x[j];
        if (l < 3) { norm_mod2(x, h, A0, B0);
#pragma unroll
            for (int j = 0; j < 4; ++j) stbf4(hw + 4 * c.lane + 256 * j, h[j]); }
    }
#undef EWL_LOAD
}

__device__ __forceinline__ void attn_even(const Ctx& c_, int l) {
    const Ctx c = make_ctx(c_.lds);
    KParams& P = kparams(); const int i = l >> 1; const bool need_ctx = l < 3;
    const bf16_t* PB = (const bf16_t*)(P.ws + WS_U + U_PB); bf16_t* MIX = (bf16_t*)(P.ws + WS_U + U_MIX);
    const int nchunk = need_ctx ? 264 : 256;
    for (int u = opaque_bid(); u < nchunk * 4; u += gridDim.x) att::sgu_unit(c.lds, PB, (const bf16_t*)(P.ws + WS_SGUW) + (size_t)i * 4 * 128 * 128, P.in[10] + i * 512, (const float*)(P.ws + WS_STATS), P.in[11] + i * 512, MIX, (u >> 2) * 128, u & 3);
    float d1 = 0.f, d2 = 0.f;
    if (c.lane < 64) { d1 = P.in[12][i * 64 + c.lane] * P.in[13][i * 64 + c.lane]; d2 = P.in[14][i * 64 + c.lane] * P.in[15][i * 64 + c.lane]; }
    const float lam_init = 0.8f - 0.6f * expf(-0.3f * (float)l);
    const float lam = expf(wave_sum(d1)) - expf(wave_sum(d2)) + lam_init;
    att::Args a;
    a.Q = PB; a.ldq = EV_IN; a.K = PB; a.ldk = EV_IN; a.V = PB; a.ldv = EV_IN; a.C = 0.125f * LOG2E;
    a.rcos = (const float*)(P.ws + WS_ROPEB); a.rsin = a.rcos + SEQ * 32; a.O = MIX; a.ldo = DM; a.g = 0; a.u0 = 0; a.rpb = nullptr;
    a.lam = lam; a.oscale = 1.f - lam_init; a.subg = P.in[16] + i * 128; a.nt_ctx = 4;
    const int nctxu = need_ctx ? 32 : 0, nu = nctxu + 1024; int kit = 0;
    for (int u = opaque_bid(); u < nu; u += gridDim.x) {
        int b, h;
        if (u < nctxu) { b = u >> 3; h = (u >> 1) & 3; a.q_row0 = NLAT + b * CTXL + (u & 1) * 128; a.nt_lat = 0; a.rope = 0; }
        else { const int v = u - nctxu; b = v >> 8; h = (v >> 6) & 3; a.q_row0 = b * SEQ + (v & 63) * 128; a.nt_lat = SEQ / 64; a.rope = 0; }
        a.qcol = 1024 + h * 128; a.kcol = 1536 + h * 128; a.vcol = 2048 + h * 128; a.ocol = 512 + h * 128;
        a.kctx_row0 = NLAT + b * CTXL; a.klat_row0 = b * SEQ;
        att::attn_unit<64, 128, 128, 1>(c.lds, a);
        if (kit < 4) { convert_moe_items(c, i, kit * (MOE_CVT_ITEMS / 4), (kit + 1) * (MOE_CVT_ITEMS / 4)); __syncthreads(); }
        ++kit;
    }
    for (; kit < 4; ++kit) { convert_moe_items(c, i, kit * (MOE_CVT_ITEMS / 4), (kit + 1) * (MOE_CVT_ITEMS / 4)); __syncthreads(); }
}
__device__ __forceinline__ void attn_odd_na(const Ctx& c_, int l) {
    const Ctx c = make_ctx(c_.lds);
    KParams& P = kparams(); const int i = l >> 1; const bool need_ctx = l < 3;
    const bf16_t* PB = (const bf16_t*)(P.ws + WS_U + U_PB); bf16_t* MIX = (bf16_t*)(P.ws + WS_U + U_MIX);
    att::Args a;
    a.Q = PB; a.ldq = OD_INP; a.K = PB; a.ldk = OD_INP; a.V = PB; a.ldv = OD_INP; a.C = 0.125f * LOG2E; a.rope = 0; a.rcos = nullptr; a.rsin = nullptr;
    a.O = MIX; a.ldo = DM; a.lam = 0.f; a.oscale = 1.f; a.subg = nullptr; a.nt_ctx = 4;
    const int nctxu = need_ctx ? 32 : 0, nu = nctxu + 1024;
    for (int u = opaque_bid(); u < nu; u += gridDim.x) {
        int b, h;
        if (u < nctxu) { b = u >> 3; h = u & 7; a.q_row0 = NLAT + b * CTXL; a.nt_lat = 0; a.g = 0; a.u0 = 0; a.klat_row0 = 0; }
        else { const int v = u - nctxu; b = v >> 8; h = (v >> 5) & 7; const int g = v & 31; a.g = g; a.u0 = min(max(4 * g - 4, 0), 116);
            a.q_row0 = b * SEQ + g * 256; a.nt_lat = 12; a.klat_row0 = b * SEQ + a.u0 * 64; }
        a.qcol = h * 64; a.kcol = 512 + h * 64; a.vcol = 1024 + h * 64; a.ocol = h * 64; a.kctx_row0 = NLAT + b * CTXL;
        a.rpb = P.in[22] + ((size_t)i * 8 + h) * 465;
        att::attn_unit<64, 64, 64, 2>(c.lds, a);
    }
}
__device__ __forceinline__ void attn_odd_mla(const Ctx& c_, int l) {
    const Ctx c = make_ctx(c_.lds);
    KParams& P = kparams(); const bool need_ctx = l < 3;
    const bf16_t* MO = (const bf16_t*)(P.ws + WS_U + U_MLAO); bf16_t* MIX = (bf16_t*)(P.ws + WS_U + U_MIX);
    att::Args a;
    a.Q = MO; a.ldq = MLA_N; a.K = MO; a.ldk = MLA_N; a.V = MO; a.ldv = MLA_N; a.C = 0.10206207261596575f * LOG2E;
    a.rcos = (const float*)(P.ws + WS_ROPED); a.rsin = a.rcos + SEQ * 16; a.O = MIX; a.ldo = DM; a.g = 0; a.u0 = 0; a.rpb = nullptr; a.lam = 0.f; a.oscale = 1.f; a.subg = nullptr; a.nt_ctx = 4;
    const int nctxu = need_ctx ? 16 : 0, nu = nctxu + 512;
    for (int u = opaque_bid(); u < nu; u += gridDim.x) {
        int b, h;
        if (u < nctxu) { b = u >> 2; h = u & 3; a.q_row0 = NLAT + b * CTXL; a.nt_lat = 0; a.rope = 0; }
        else { const int v = u - nctxu; b = v >> 7; h = (v >> 5) & 3; a.q_row0 = b * SEQ + (v & 31) * 256; a.nt_lat = SEQ / 64; a.rope = 2; }
        a.qcol = h * 96; a.kcol = 384 + h * 96; a.vcol = 768 + h * 128; a.ocol = 512 + h * 128; a.kctx_row0 = NLAT + b * CTXL; a.klat_row0 = b * SEQ;
        att::attn_unit<96, 96, 128, 0>(c.lds, a);
    }
}

constexpr int N_PHASES = 2 + 2 * (7 + 9);
__global__ void __launch_bounds__(512, 2) fwd_kernel(Params prm) {
    extern __shared__ __attribute__((aligned(16))) unsigned char lds_raw[];
    LAS unsigned char* lds = (LAS unsigned char*)lds_raw;
    const Ctx c{lds, 0, 0, 0, 0, 0};
    for (int u = threadIdx.x; u < (LDS_BYTES - LDS_MISC) / 4; u += 512) ((LAS unsigned*)(lds + LDS_MISC))[u] = 0u;
    __syncthreads();
    XcdBarrier bar;
    { unsigned char* ws0 = kparams().ws; bar.bar = (unsigned*)(ws0 + WS_CTL) + CW_BAR; bar.x = 0; bar.st = nullptr;
#if !MK_PER_PHASE
      bar = xcd_barrier_post((unsigned*)(ws0 + WS_CTL) + CW_BAR, (volatile LAS unsigned*)(lds + LDS_MISC + 32));
#endif
    }
    int ph = 0;
#ifndef PMASK
#define PMASK 0xffffffffu
#endif
#define PM(b) ((PMASK >> (b)) & 1u)
#define PH_ON() (ph >= kparams().ph_lo && ph < kparams().ph_hi)
#define PH_END() do { if (ph >= kparams().ph_lo && ph + 1 < kparams().ph_hi) xcd_barrier(bar); ++ph; } while (0)
#define WSP(off) ((bf16_t*)(ws + (off)))
#define HB WSP(WS_HB)
#define PB WSP(WS_U + U_PB)
#define MIX WSP(WS_U + U_MIX)
#define YB WSP(WS_U + U_YB)
#define HID WSP(WS_U + U_HID)
#define YS WSP(WS_U + U_YS)
#define A2 WSP(WS_U + U_A2)
#define MO WSP(WS_U + U_MLAO)

    if (PM(0) && PH_ON()) for (int rep = 0; rep < DUPN(0); ++rep) prologue0(c);
    PH_END();
    if (PM(1) && PH_ON()) for (int rep = 0; rep < DUPN(1); ++rep) ew_first(c);
    PH_END();
    for (int lp = 0; lp < 2; ++lp) {
        {
            const int l = 2 * lp, i = lp; const int mtok = l < 3 ? MTOT : NLAT, nMt = mtok / 256;
            if (PM(2) && PH_ON()) for (int rep = 0; rep < DUPN(2); ++rep) { unsigned char* ws = kparams().ws; pg8::Gemm g{}; g.A = HB; g.lda = DM; g.Bt = (const bf16_t*)(ws + WS_WINE) + (size_t)i * EV_IN * DM; g.K = DM; g.nM = MTOT / 256; g.nN = EV_IN / 256; g.grouped = 0; g.estride = 0;
                pg8::EpiEvenIn E{PB, EV_IN, (f32x2*)(ws + WS_STATS), (const float*)(ws + WS_ROPEB), (const float*)(ws + WS_ROPEB) + SEQ * 32}; gemm_even_in(lds, g, E); }
            PH_END();
            if (PM(4) && PH_ON()) for (int rep = 0; rep < DUPN(4); ++rep) attn_even(c, l);
            PH_END();
            if (PM(5) && PH_ON()) for (int rep = 0; rep < DUPN(5); ++rep) { unsigned char* ws = kparams().ws; pg8::Gemm g{}; g.A = MIX; g.lda = DM; g.Bt = (const bf16_t*)(ws + WS_WOUTE) + (size_t)i * DM * DM; g.K = DM; g.nM = nMt; g.nN = DM / 256; g.grouped = 0; g.estride = 0;
                gemm_bf16(lds, g, YB, DM); }
            PH_END();
            if (PM(6) && PH_ON()) { if (DUPN(6) > 1) ew_mid(c, l, mtok, true); ew_mid(c, l, mtok); }
            PH_END();
            if (PM(7) && PH_ON()) for (int rep = 0; rep < DUPN(7); ++rep) { unsigned char* ws = kparams().ws; pg8::Gemm g{}; g.A = HB; g.lda = DM; g.Bt = (const bf16_t*)(ws + WS_W13E) + (size_t)i * 2 * DFF * DM; g.K = DM; g.nM = nMt; g.nN = 2 * DFF / 256; g.grouped = 0; g.estride = 0;
                gemm_swiglu(lds, g, HID, DFF); }
            PH_END();
            if (PM(8) && PH_ON()) for (int rep = 0; rep < DUPN(8); ++rep) { unsigned char* ws = kparams().ws; pg8::Gemm g{}; g.A = HID; g.lda = DFF; g.Bt = (const bf16_t*)(ws + WS_W2E) + (size_t)i * DM * DFF; g.K = DFF; g.nM = nMt; g.nN = DM / 256; g.grouped = 0; g.estride = 0;
                gemm_bf16(lds, g, YS, DM); }
            PH_END();
            if (PM(9) && PH_ON()) { if (DUPN(9) > 1) ew_last(c, l, mtok, true); ew_last(c, l, mtok); }
            PH_END();
        }
        {
            const int l = 2 * lp + 1, i = lp; const int mtok = l < 3 ? MTOT : NLAT, nMt = mtok / 256;
            if (PM(10) && PH_ON()) for (int rep = 0; rep < DUPN(10); ++rep) { unsigned char* ws = kparams().ws; pg8::Gemm g{}; g.A = HB; g.lda = DM; g.Bt = (const bf16_t*)(ws + WS_WINO) + (size_t)i * OD_INP * DM; g.K = DM; g.nM = MTOT / 256; g.nN = OD_INP / 256; g.grouped = 0; g.estride = 0;
                pg8::EpiOddIn E{PB, OD_INP, (float*)(ws + WS_STATS), (const float*)(ws + WS_ROPED), (const float*)(ws + WS_ROPED) + SEQ * 16}; gemm_odd_in(lds, g, E); }
            PH_END();
            if (PM(12) && PH_ON()) for (int rep = 0; rep < DUPN(12); ++rep) { unsigned char* ws = kparams().ws; pg8::Gemm g{}; g.A = PB + 1536; g.lda = OD_INP; g.Bt = (const bf16_t*)(ws + WS_WMLA) + (size_t)i * MLA_N * MLA_K; g.K = MLA_K; g.nM = MTOT / 256; g.nN = MLA_N / 256; g.grouped = 0; g.estride = 0;
                pg8::EpiMlaUp E{MO, MLA_N, (const float*)(ws + WS_STATS)}; gemm_mla_up(lds, g, E); }
            PH_END();
            if (PH_ON()) { if (PM(13)) for (int rep = 0; rep < DUPN(13); ++rep) attn_odd_na(c, l); if (PM(14)) for (int rep = 0; rep < DUPN(14); ++rep) attn_odd_mla(c, l); }
            PH_END();
            if (PM(15) && PH_ON()) for (int rep = 0; rep < DUPN(15); ++rep) { unsigned char* ws = kparams().ws; pg8::Gemm g{}; g.A = MIX; g.lda = DM; g.Bt = (const bf16_t*)(ws + WS_WOUTO) + (size_t)i * DM * DM; g.K = DM; g.nM = nMt; g.nN = DM / 256; g.grouped = 0; g.estride = 0;
                gemm_bf16(lds, g, YB, DM); }
            PH_END();
            if (PM(16) && PH_ON()) { if (DUPN(16) > 1) ew_mid(c, l, mtok, true); ew_mid(c, l, mtok); }
            PH_END();
            if (PM(17) && PH_ON()) for (int rep = 0; rep < DUPN(17); ++rep) moe_gather(c, i, mtok);
            PH_END();
            if (PM(18) && PH_ON()) for (int rep = 0; rep < DUPN(18); ++rep) { unsigned char* ws = kparams().ws; pg8::Gemm g{}; g.A = YS; g.lda = DM; g.Bt = (const bf16_t*)(ws + WS_W13M); g.K = DM; g.nN = 2 * DFFE / 256; g.grouped = 1; g.estride = (size_t)2 * DFFE * DM;
                moe_offsets(kparams(), i, g.toff); g.nM = g.toff[8];
#if MOE_F8
                gemm8_swiglu8(lds, g, (unsigned char*)HID, DFFE);
#else
                gemm_swiglu(lds, g, HID, DFFE);
#endif
            }
            PH_END();
            if (PM(19) && PH_ON()) for (int rep = 0; rep < DUPN(19); ++rep) { unsigned char* ws = kparams().ws; pg8::Gemm g{}; g.A = HID; g.lda = DFFE; g.Bt = (const bf16_t*)(ws + WS_W2M); g.K = DFFE; g.nN = DM / 256; g.grouped = 1; g.estride = (size_t)DM * DFFE;
                moe_offsets(kparams(), i, g.toff); g.nM = g.toff[8];
#if MOE_F8
                gemm8_bf16(lds, g, YS, DM);
#else
                gemm_bf16(lds, g, YS, DM);
#endif
            }
            PH_END();
            if (PM(20) && PH_ON()) { if (DUPN(20) > 1) ew_last(c, l, mtok, true); ew_last(c, l, mtok); }
            PH_END();
        }
    }
#undef PH_ON
#undef PH_END
#undef HB
#undef PB
#undef MIX
#undef YB
#undef HID
#undef YS
#undef A2
#undef MO
}

extern "C" void kernel_launch(void* const* d_in, const int* in_sizes, int n_in, void* d_out, int out_size, void* d_ws, size_t ws_size, hipStream_t stream) {
    static int grid = 0;
    if (grid == 0) {
        int dev = 0, cus = 0;
        if (n_in != 31 || out_size != NLAT * DM || ws_size < WS_END) { fprintf(stderr, "kernel_launch: unexpected shapes or workspace (n_in %d out %d ws %zu need %zu)\n", n_in, out_size, ws_size, (size_t)WS_END); grid = -1; }
        else if (hipGetDevice(&dev) != hipSuccess || hipDeviceGetAttribute(&cus, hipDeviceAttributeMultiprocessorCount, dev) != hipSuccess) grid = -1;
        else if (hipFuncSetAttribute((const void*)fwd_kernel, hipFuncAttributeMaxDynamicSharedMemorySize, LDS_BYTES) != hipSuccess) grid = -1;
        else { int per_cu = 0; (void)hipOccupancyMaxActiveBlocksPerMultiprocessor(&per_cu, (const void*)fwd_kernel, 512, LDS_BYTES); (void)hipGetLastError(); grid = cus; }
    }
    if (grid < 0) { (void)hipMemsetAsync(d_out, 0, (size_t)out_size * 4, stream); return; }
    (void)hipMemsetAsync((char*)d_ws + WS_CTL, 0, CTL_BYTES, stream);
    Params p{};
    for (int i = 0; i < 31; ++i) p.in[i] = (const float*)d_in[i];
    p.out = (float*)d_out; p.ws = (unsigned char*)d_ws;
#if MK_PER_PHASE
    for (int k = 0; k < N_PHASES; ++k) { p.ph_lo = k; p.ph_hi = k + 1; hipLaunchKernelGGL(fwd_kernel, dim3(grid), dim3(512), LDS_BYTES, stream, p); }
#else
    p.ph_lo = 0; p.ph_hi = N_PHASES;
    hipLaunchKernelGGL(fwd_kernel, dim3(grid), dim3(512), LDS_BYTES, stream, p);
#endif
}
```

```cpp
#include <hip/hip_runtime.h>
#include <stdint.h>
#include <stdio.h>

#ifndef MK_PER_PHASE
#define MK_PER_PHASE 0
#endif
#ifndef DUP_MASK
#define DUP_MASK 0u
#endif
#define DUPN(b) (1 + (int)((DUP_MASK >> (b)) & 1u))
#ifndef ATT_X
#define ATT_X 0
#endif
#ifndef MOE_F8
#define MOE_F8 1
#endif

#define LAS __attribute__((address_space(3)))
typedef unsigned short bf16_t;
typedef short bf16x8 __attribute__((ext_vector_type(8)));
typedef short s16x4 __attribute__((ext_vector_type(4)));
typedef float f32x4 __attribute__((ext_vector_type(4)));
typedef float f32x2 __attribute__((ext_vector_type(2)));
typedef float f32x16 __attribute__((ext_vector_type(16)));
typedef unsigned u32x4 __attribute__((ext_vector_type(4)));
typedef unsigned u32x2 __attribute__((ext_vector_type(2)));

constexpr int DM = 1024, NB = 4, SEQ = 8192, NLAT = NB * SEQ, CTXL = 256, NCTX = NB * CTXL, MTOT = NLAT + NCTX;
constexpr int NMOD = 6;
constexpr int EV_IN = 2560, OD_IN = 1952, OD_INP = 2048, DFF = 2816, DFFE = 3584, NEXP = 8;
constexpr int MLA_N = 1280, MLA_K = 512;
constexpr int MS_MAX = 2 * MTOT + NEXP * 256;
constexpr float EPS = 1e-6f;
constexpr float LOG2E = 1.4426950408889634f;

constexpr size_t MiB = (size_t)1 << 20;
constexpr size_t WS_CTL = 0, CTL_BYTES = MiB;
constexpr size_t WS_MODS = 1 * MiB;
constexpr size_t WS_ROPEB = 2 * MiB;
constexpr size_t WS_ROPED = 4 * MiB;
constexpr size_t WS_SGUW = 5 * MiB;
constexpr size_t WS_TOKINFO = 6 * MiB;
constexpr size_t WS_TOKPOS = 8 * MiB;
constexpr size_t WS_CTXX = 10 * MiB;
constexpr size_t WS_WMLA = 14 * MiB;
constexpr size_t WS_WINE = 17 * MiB;
constexpr size_t WS_WOUTE = 27 * MiB;
constexpr size_t WS_W13E = 31 * MiB;
constexpr size_t WS_W2E = 53 * MiB;
constexpr size_t WS_WINO = 64 * MiB;
constexpr size_t WS_WOUTO = 72 * MiB;
constexpr size_t WS_W13M = 76 * MiB;
constexpr size_t WS_W2M = 188 * MiB;
constexpr size_t WS_HB = 244 * MiB;
constexpr size_t WS_U = 310 * MiB;
constexpr size_t U_PB = 0;
constexpr size_t U_MIX = 165 * MiB;
constexpr size_t U_A2 = 231 * MiB;
constexpr size_t U_MLAO = 264 * MiB;
constexpr size_t U_YB = 347 * MiB;
constexpr size_t U_HID = 0;
constexpr size_t U_XB = 549 * MiB;
constexpr size_t U_YS = 413 * MiB;
constexpr size_t WS_STATS = WS_U + 616 * MiB;
constexpr size_t WS_END = WS_STATS + 4 * MiB;
static_assert((size_t)MS_MAX * DFFE * (MOE_F8 ? 1 : 2) <= 347 * MiB && (size_t)MTOT * DFF * 2 <= 347 * MiB, "hid must stay clear of YB");
static_assert(U_YS + (size_t)MS_MAX * DM * 2 <= U_XB && U_XB + (size_t)MTOT * DM * 2 <= 616 * MiB, "ys / xb fit");

constexpr int CW_BAR = 4096;
constexpr int CW_MOECNT = 1024;

constexpr int LDS_BYTES = 147456;
constexpr int LDS_MISC = 131072;

__device__ __forceinline__ unsigned cvtpk(float lo, float hi) { unsigned r; asm volatile("v_cvt_pk_bf16_f32 %0, %1, %2" : "=v"(r) : "v"(lo), "v"(hi)); return r; }
__device__ __forceinline__ float bf2f(unsigned short b) { return __uint_as_float(((unsigned)b) << 16); }
__device__ __forceinline__ float bflo(unsigned w) { return __uint_as_float(w << 16); }
__device__ __forceinline__ float bfhi(unsigned w) { return __uint_as_float(w & 0xffff0000u); }
__device__ __forceinline__ bf16_t f2bf(float f) { return (bf16_t)(cvtpk(f, 0.f) & 0xffffu); }
typedef int i32x8 __attribute__((ext_vector_type(8)));
typedef int i32x4 __attribute__((ext_vector_type(4)));
constexpr float F8_ACT_SCALE = 4.f, F8_W_SCALE = 64.f, F8_INV = 1.f / (F8_ACT_SCALE * F8_W_SCALE);
__device__ __forceinline__ unsigned pk4_fp8(float a, float b, float c, float d) {
    a = __builtin_amdgcn_fmed3f(a, -448.f, 448.f); b = __builtin_amdgcn_fmed3f(b, -448.f, 448.f); c = __builtin_amdgcn_fmed3f(c, -448.f, 448.f); d = __builtin_amdgcn_fmed3f(d, -448.f, 448.f);
    int w = 0; w = __builtin_amdgcn_cvt_pk_fp8_f32(a, b, w, false); w = __builtin_amdgcn_cvt_pk_fp8_f32(c, d, w, true); return (unsigned)w; }
__device__ __forceinline__ float wave_sum(float v) {
#pragma unroll
    for (int o = 1; o < 64; o <<= 1) v += __shfl_xor(v, o);
    return v;
}
__device__ __forceinline__ float fast_exp2(float x) { return __builtin_amdgcn_exp2f(x); }
__device__ __forceinline__ float fast_rcp(float x) { return __builtin_amdgcn_rcpf(x); }
__device__ __forceinline__ float silu_f(float x) { return x * fast_rcp(1.f + fast_exp2(-x * LOG2E)); }
__device__ __forceinline__ float gelu_tanh_f(float x) { const float u = 0.7978845608028654f * (x + 0.044715f * x * x * x); return x * fast_rcp(1.f + fast_exp2(-2.f * LOG2E * u)); }
#define LDS_WAIT() asm volatile("s_waitcnt lgkmcnt(0)" ::: "memory")
#define VM_WAIT() asm volatile("s_waitcnt vmcnt(0)" ::: "memory")
__device__ __forceinline__ int opaque_bid() { int b = blockIdx.x; asm volatile("" : "+s"(b)); return b; }
__device__ __forceinline__ int xcd_unit_base() { const int b = opaque_bid(), G = (int)gridDim.x; return (G % 8 == 0) ? (b & 7) * (G >> 3) + (b >> 3) : b; }
__device__ __forceinline__ int opaque_tid() { int t = threadIdx.x; asm volatile("" : "+v"(t)); return t; }

#define XB_TMO      128
#define XB_XCNT(j)  (256  + 64 * (j))
#define XB_XSUB(j)  (1280 + 64 * (j))
#define XB_XGEN(j)  (2304 + 64 * (j))
#define XB_TOP      3328
#define XB_TOPGEN   3392
#define XCD_BAR_WORDS 3456
#define XB_SPIN_CAP (1u << 22)
__device__ __forceinline__ unsigned xb_ld(unsigned* p)              { return __hip_atomic_load(p, __ATOMIC_RELAXED, __HIP_MEMORY_SCOPE_AGENT); }
__device__ __forceinline__ unsigned xb_add(unsigned* p, unsigned v) { return __hip_atomic_fetch_add(p, v, __ATOMIC_RELAXED, __HIP_MEMORY_SCOPE_AGENT); }
__device__ __forceinline__ unsigned xb_xcc_id() { return (unsigned)__builtin_amdgcn_s_getreg((3 << 11) | 20) & 0xFu; }
#define XB_SPIN(cond, bar) do { unsigned _sp = 0; while (cond) { __builtin_amdgcn_s_sleep(1); \
    if ((++_sp & 255u) == 0u) { if (xb_ld(&(bar)[XB_TMO])) break; if (_sp > XB_SPIN_CAP) { atomicAdd(&(bar)[XB_TMO], 1u); break; } } } } while (0)
struct XcdBarrier { unsigned* bar; unsigned x; volatile LAS unsigned* st; };
__device__ __forceinline__ XcdBarrier xcd_barrier_post(unsigned* bar, volatile LAS unsigned* st) {
    XcdBarrier b; b.bar = bar; b.x = xb_xcc_id(); b.st = st;
    if (threadIdx.x == 0) (void)xb_add(&bar[XB_XCNT(b.x)], 1u);
    return b;
}
__device__ __forceinline__ void xcd_barrier_complete(unsigned* bar, unsigned x, unsigned& nloc, unsigned& nx) {
    const unsigned G = gridDim.x * gridDim.y * gridDim.z;
    unsigned sum, cnt, mine, sp = 0u;
    for (;;) {
        sum = 0u; cnt = 0u; mine = 0u;
#pragma unroll
        for (unsigned j = 0; j < 16; ++j) { const unsigned c = xb_ld(&bar[XB_XCNT(j)]); sum += c; cnt += (c > 0u) ? 1u : 0u; mine = (j == x) ? c : mine; }
        if (sum == G) break;
        __builtin_amdgcn_s_sleep(1);
        if ((++sp & 255u) == 0u) { if (xb_ld(&bar[XB_TMO])) break; if (sp > XB_SPIN_CAP) { atomicAdd(&bar[XB_TMO], 1u); break; } }
    }
    nloc = mine > 0u ? mine : 1u; nx = cnt > 0u ? cnt : 1u;
}
__device__ __forceinline__ void xcd_barrier(const XcdBarrier& b) {
    asm volatile("s_waitcnt vmcnt(0)" ::: "memory");
    __syncthreads();
    if (threadIdx.x == 0) {
        unsigned* bar = b.bar;
        __builtin_amdgcn_s_waitcnt(0);
        unsigned nloc = b.st[0], nx = b.st[1];
        if (nloc == 0u) { xcd_barrier_complete(bar, b.x, nloc, nx); b.st[0] = nloc; b.st[1] = nx; }
        const unsigned old = xb_add(&bar[XB_XSUB(b.x)], 1u);
        const unsigned gen = old / nloc;
        if (old + 1u == (gen + 1u) * nloc) {
            __builtin_amdgcn_fence(__ATOMIC_RELEASE, "agent");
            asm volatile("s_waitcnt vmcnt(0)" ::: "memory");
            const unsigned og = xb_add(&bar[XB_TOP], 1u);
            const unsigned tg = og / nx;
            if (og + 1u == (tg + 1u) * nx) xb_add(&bar[XB_TOPGEN], 1u);
            else XB_SPIN(xb_ld(&bar[XB_TOPGEN]) == tg, bar);
            __builtin_amdgcn_fence(__ATOMIC_ACQUIRE, "agent");
            xb_add(&bar[XB_XGEN(b.x)], 1u);
            asm volatile("s_waitcnt vmcnt(0)" ::: "memory");
        } else {
            XB_SPIN(xb_ld(&bar[XB_XGEN(b.x)]) == gen, bar);
            __builtin_amdgcn_fence(__ATOMIC_ACQUIRE, "agent");
            asm volatile("s_waitcnt vmcnt(0)" ::: "memory");
        }
    }
    __syncthreads();
}

namespace pg8 {
constexpr int BM = 256, BK = 64, HALF = 128, HTB = HALF * BK * 2, STAGE_BYTES = 8 * HTB, NXCD = 8, WGM = 8;
__device__ __forceinline__ int lds_byte(int r, int c) { const int st = (r >> 4) * 2 + (c >> 5), rr = r & 15, cc = c & 31, ob = rr * 64 + cc * 2; return st * 1024 + (ob ^ (((ob >> 9) & 1) << 5)); }
__device__ __forceinline__ void stage_rc(int b, int& R, int& C) { const int st = b / 1024, sb = b % 1024, swz = sb ^ (((sb >> 9) & 1) << 5); R = (st >> 1) * 16 + swz / 64; C = (st & 1) * 32 + (swz % 64) / 2; }
__device__ __forceinline__ int perm32(int rho) { const int n = rho >> 4, i = rho & 15; return 8 * (i >> 2) + 4 * n + (i & 3); }
struct Unit { int pm, pn, e; };
struct Gemm {
    const void* A; int lda;
    const void* Bt; int K;
    int nM, nN;
    int grouped; int toff[9]; size_t estride;
};
struct StaticOrder {
    int nM, nN, nwg, G, c;
    __device__ void init(int nM_, int nN_, int G_, int c_) { nM = nM_; nN = nN_; nwg = nM * nN; G = G_; c = c_; }
    __device__ __forceinline__ bool next(int i, Unit& u) const {
        const long L = (long)i * G + c; if (L >= nwg) return false;
        int wgid = (int)L; { const int q = nwg / NXCD, r = nwg % NXCD, xcd = wgid % NXCD, off = wgid / NXCD; wgid = (xcd < r ? xcd * (q + 1) : r * (q + 1) + (xcd - r) * q) + off; }
        const int nig = WGM * nN, gid = wgid / nig, fm = gid * WGM, gsz = (nM - fm) < WGM ? (nM - fm) : WGM;
        u.pm = fm + ((wgid % nig) % gsz); u.pn = (wgid % nig) / gsz; u.e = 0; return true;
    }
};
struct EpiBf16 {
    bf16_t* O; int ldc; float scale;
    __device__ __forceinline__ void operator()(const f32x4 (&acc)[2][2][4][2], const Unit& u, int wr, int wc, int fr, int fq) const {
        const int row0 = u.pm * BM + wr * 64 + fr, col0 = u.pn * BM + wc * 32 + 8 * fq;
#pragma unroll
        for (int ai = 0; ai < 2; ++ai)
#pragma unroll
            for (int m = 0; m < 4; ++m) { bf16_t* rowp = O + (size_t)(row0 + ai * HALF + m * 16) * ldc + col0;
#pragma unroll
                for (int bj = 0; bj < 2; ++bj) { const f32x4 v0 = acc[ai][bj][m][0] * scale, v1 = acc[ai][bj][m][1] * scale;
                    u32x4 w; w.x = cvtpk(v0[0], v0[1]); w.y = cvtpk(v0[2], v0[3]); w.z = cvtpk(v1[0], v1[1]); w.w = cvtpk(v1[2], v1[3]);
                    *(u32x4*)(rowp + bj * HALF) = w; } }
    }
};
struct EpiSwiGLU {
    bf16_t* O; int ldc;
    __device__ __forceinline__ void operator()(const f32x4 (&acc)[2][2][4][2], const Unit& u, int wr, int wc, int fr, int fq) const {
        const int row0 = u.pm * BM + wr * 64 + fr, col0 = u.pn * HALF + wc * 32 + 8 * fq;
#pragma unroll
        for (int ai = 0; ai < 2; ++ai)
#pragma unroll
            for (int m = 0; m < 4; ++m) { bf16_t* rowp = O + (size_t)(row0 + ai * HALF + m * 16) * ldc + col0;
                float r[8];
#pragma unroll
                for (int n = 0; n < 2; ++n)
#pragma unroll
                    for (int j = 0; j < 4; ++j) r[n * 4 + j] = silu_f(acc[ai][0][m][n][j]) * acc[ai][1][m][n][j];
                u32x4 w; w.x = cvtpk(r[0], r[1]); w.y = cvtpk(r[2], r[3]); w.z = cvtpk(r[4], r[5]); w.w = cvtpk(r[6], r[7]);
                *(u32x4*)rowp = w; }
    }
};

struct EpiEvenIn {
    bf16_t* O; int ldc; f32x2* stats; const float* rcos; const float* rsin;
    __device__ __forceinline__ void operator()(const f32x4 (&acc)[2][2][4][2], const Unit& u, int wr, int wc, int fr, int fq) const {
        int upm = u.pm, upn = u.pn; asm volatile("" : "+s"(upm), "+s"(upn));
        const int row0 = upm * BM + wr * 64 + fr, col0 = upn * BM + wc * 32 + 8 * fq;
        const int kind = upn < 2 ? 0 : (upn < 4 ? 1 : (upn < 8 ? 2 : 3)); const bool lat = upm < NLAT / BM; const int t4 = 4 * (4 * (wc & 1) + fq);
#pragma unroll
        for (int ai = 0; ai < 2; ++ai)
#pragma unroll
            for (int m = 0; m < 4; ++m) { const int row = row0 + ai * HALF + m * 16; bf16_t* rowp = O + (size_t)row * ldc + col0;
                f32x4 cs = {1.f, 1.f, 1.f, 1.f}, sn = {0.f, 0.f, 0.f, 0.f}; float s1 = 0.f, s2 = 0.f;
                if (kind == 2 && lat) { const int sp = row & (SEQ - 1); cs = *(const f32x4*)(rcos + sp * 32 + t4); sn = *(const f32x4*)(rsin + sp * 32 + t4); }
#pragma unroll
                for (int bj = 0; bj < 2; ++bj) { f32x4 v0 = acc[ai][bj][m][0], v1 = acc[ai][bj][m][1];
                    if (kind < 2) {
#pragma unroll
                        for (int j = 0; j < 4; ++j) { v0[j] = gelu_tanh_f(v0[j]); v1[j] = gelu_tanh_f(v1[j]); }
                        if (kind == 1) { s1 += (v0[0] + v0[1]) + (v0[2] + v0[3]) + (v1[0] + v1[1]) + (v1[2] + v1[3]);
                            s2 += (v0[0] * v0[0] + v0[1] * v0[1]) + (v0[2] * v0[2] + v0[3] * v0[3]) + (v1[0] * v1[0] + v1[1] * v1[1]) + (v1[2] * v1[2] + v1[3] * v1[3]); } }
                    else if (kind == 2) { const f32x4 o0 = v0 * cs - v1 * sn, o1 = v1 * cs + v0 * sn; v0 = o0; v1 = o1; }
                    u32x4 w; w.x = cvtpk(v0[0], v0[1]); w.y = cvtpk(v0[2], v0[3]); w.z = cvtpk(v1[0], v1[1]); w.w = cvtpk(v1[2], v1[3]);
                    *(u32x4*)(rowp + bj * HALF) = w; }
                if (kind == 1) { s1 += __shfl_xor(s1, 16); s1 += __shfl_xor(s1, 32); s2 += __shfl_xor(s2, 16); s2 += __shfl_xor(s2, 32);
                    if (fq == 0) stats[(size_t)row * 8 + (upn - 2) * 4 + wc] = (f32x2){s1, s2}; } }
    }
};
struct EpiOddIn {
    bf16_t* O; int ldc; float* stats; const float* rcos; const float* rsin;
    __device__ __forceinline__ void operator()(const f32x4 (&acc)[2][2][4][2], const Unit& u, int wr, int wc, int fr, int fq) const {
        int upm = u.pm, upn = u.pn; asm volatile("" : "+s"(upm), "+s"(upn));
        const int row0 = upm * BM + wr * 64 + fr, col0 = upn * BM + wc * 32 + 8 * fq; const bool lat = upm < NLAT / BM;
#pragma unroll
        for (int ai = 0; ai < 2; ++ai)
#pragma unroll
            for (int m = 0; m < 4; ++m) { const int row = row0 + ai * HALF + m * 16; bf16_t* rowp = O + (size_t)row * ldc + col0; float ss = 0.f;
#pragma unroll
                for (int bj = 0; bj < 2; ++bj) { f32x4 v0 = acc[ai][bj][m][0], v1 = acc[ai][bj][m][1];
                    if (upn == 6 || (upn == 7 && bj == 0)) ss += (v0[0] * v0[0] + v0[1] * v0[1]) + (v0[2] * v0[2] + v0[3] * v0[3]) + (v1[0] * v1[0] + v1[1] * v1[1]) + (v1[2] * v1[2] + v1[3] * v1[3]);
                    if (upn == 7 && bj == 1 && wc == 0 && lat) { const int sp = row & (SEQ - 1); const f32x4 cs = *(const f32x4*)(rcos + sp * 16 + 4 * fq), sn = *(const f32x4*)(rsin + sp * 16 + 4 * fq);
                        const f32x4 o0 = v0 * cs - v1 * sn, o1 = v1 * cs + v0 * sn; v0 = o0; v1 = o1; }
                    u32x4 w; w.x = cvtpk(v0[0], v0[1]); w.y = cvtpk(v0[2], v0[3]); w.z = cvtpk(v1[0], v1[1]); w.w = cvtpk(v1[2], v1[3]);
                    *(u32x4*)(rowp + bj * HALF) = w; }
                if (upn >= 6) { ss += __shfl_xor(ss, 16); ss += __shfl_xor(ss, 32); if (fq == 0) stats[(size_t)row * 8 + (upn - 6) * 4 + wc] = ss; } }
    }
};
struct EpiMlaUp {
    bf16_t* O; int ldc; const float* stats;
    __device__ __forceinline__ void operator()(const f32x4 (&acc)[2][2][4][2], const Unit& u, int wr, int wc, int fr, int fq) const {
        const int row0 = u.pm * BM + wr * 64 + fr, col0 = u.pn * BM + wc * 32 + 8 * fq;
#pragma unroll
        for (int ai = 0; ai < 2; ++ai)
#pragma unroll
            for (int m = 0; m < 4; ++m) { const int row = row0 + ai * HALF + m * 16; bf16_t* rowp = O + (size_t)row * ldc + col0;
                const f32x4 pq = *(const f32x4*)(stats + (size_t)row * 8), pk = *(const f32x4*)(stats + (size_t)row * 8 + 4);
                const float rq = rsqrtf(((pq[0] + pq[1]) + (pq[2] + pq[3])) * (1.f / 256.f) + EPS), rk = rsqrtf(((pk[0] + pk[1]) + (pk[2] + pk[3])) * (1.f / 128.f) + EPS);
#pragma unroll
                for (int bj = 0; bj < 2; ++bj) { const int c0 = col0 + bj * HALF; const float sc = c0 < 384 ? rq : (c0 < 768 ? (((c0 - 384) % 96) < 64 ? rk : 1.f) : rk);
                    const f32x4 v0 = acc[ai][bj][m][0] * sc, v1 = acc[ai][bj][m][1] * sc;
                    u32x4 w; w.x = cvtpk(v0[0], v0[1]); w.y = cvtpk(v0[2], v0[3]); w.z = cvtpk(v1[0], v1[1]); w.w = cvtpk(v1[2], v1[3]);
                    *(u32x4*)(rowp + bj * HALF) = w; } }
    }
};
struct EpiSwiGLU8 {
    unsigned char* O; int ldc; float scale;
    __device__ __forceinline__ void operator()(const f32x4 (&acc)[2][2][4][2], const Unit& u, int wr, int wc, int fr, int fq) const {
        const int row0 = u.pm * BM + wr * 64 + fr, col0 = u.pn * HALF + wc * 32 + 8 * fq;
#pragma unroll
        for (int ai = 0; ai < 2; ++ai)
#pragma unroll
            for (int m = 0; m < 4; ++m) { unsigned char* rowp = O + (size_t)(row0 + ai * HALF + m * 16) * ldc + col0;
                float r[8];
#pragma unroll
                for (int n = 0; n < 2; ++n)
#pragma unroll
                    for (int j = 0; j < 4; ++j) r[n * 4 + j] = F8_ACT_SCALE * silu_f(acc[ai][0][m][n][j] * scale) * (acc[ai][1][m][n][j] * scale);
                u32x2 w; w.x = pk4_fp8(r[0], r[1], r[2], r[3]); w.y = pk4_fp8(r[4], r[5], r[6], r[7]);
                *(u32x2*)rowp = w; }
    }
};

template <class Epi, bool F8 = false>
__device__ __forceinline__ void gemm_phase(LAS unsigned char* lds, const Gemm& g, const Epi& E) {
    const int tid = opaque_tid(), wid = __builtin_amdgcn_readfirstlane(tid >> 6), lane = tid & 63, wr = wid >> 2, wc = wid & 3, fr = lane & 15, fq = lane >> 4;
    constexpr int ES = F8 ? 1 : 2;
    const int K = g.K, nt = K * ES / (BK * 2), lda = g.lda;
    StaticOrder S; S.init(g.nM, g.nN, (int)gridDim.x, opaque_bid());
    unsigned voffA[2], voffB[2];
#pragma unroll
    for (int i = 0; i < 2; ++i) { int R, C; stage_rc(tid * 16 + i * 8192, R, C); const int Rb = (R & ~31) + perm32(R & 31);
        voffA[i] = (unsigned)(R * lda * ES + C * 2); voffB[i] = (unsigned)(Rb * K * ES + C * 2); }
    const size_t kstep = (size_t)(BK * 2);
    const size_t hA = (size_t)HALF * lda * ES, tA = 2 * hA, hB = (size_t)HALF * K * ES, tB = 2 * hB;
    const unsigned ldsw = (unsigned)wid * 1024u;
    const int aoff = lds_byte(wr * 64 + fr, fq * 8), boff = lds_byte(wc * 32 + fr, fq * 8);
#define PG8_SA(b, h) (((b) * 2 + (h)) * HTB)
#define PG8_SB(b, h) ((4 + (b) * 2 + (h)) * HTB)
#define PG8_STAGE(bufoff, gbase, voff) do { _Pragma("unroll") for (int _i = 0; _i < 2; ++_i) \
        __builtin_amdgcn_global_load_lds((const unsigned*)((const char*)(gbase) + (voff)[_i]), (LAS unsigned*)(lds + (bufoff) + ldsw + _i * 8192), 16, 0, 0); } while (0)
#define PG8_LD8(base) __builtin_shufflevector(*(const LAS i32x4*)(base), *(const LAS i32x4*)((base) + 1024), 0, 1, 2, 3, 4, 5, 6, 7)
#define PG8_LDA(dst, b, h) do { _Pragma("unroll") for (int m = 0; m < 4; ++m) dst[m] = PG8_LD8(lds + PG8_SA(b, h) + aoff + m * 2048); } while (0)
#define PG8_LDB(dst, b, h) do { _Pragma("unroll") for (int n = 0; n < 2; ++n) dst[n] = PG8_LD8(lds + PG8_SB(b, h) + boff + n * 2048); } while (0)
#define PG8_H0(x) __builtin_bit_cast(bf16x8, __builtin_shufflevector(x, x, 0, 1, 2, 3))
#define PG8_H1(x) __builtin_bit_cast(bf16x8, __builtin_shufflevector(x, x, 4, 5, 6, 7))
#define PG8_MMA(ai, bj, At, Bt) do { __builtin_amdgcn_s_setprio(1); _Pragma("unroll") for (int m = 0; m < 4; ++m) _Pragma("unroll") for (int n = 0; n < 2; ++n) { \
        if constexpr (F8) asm volatile("v_mfma_f32_16x16x128_f8f6f4 %0, %1, %2, %0" : "+v"(acc[ai][bj][m][n]) : "v"(Bt[n]), "v"(At[m])); \
        else { acc[ai][bj][m][n] = __builtin_amdgcn_mfma_f32_16x16x32_bf16(PG8_H0(Bt[n]), PG8_H0(At[m]), acc[ai][bj][m][n], 0, 0, 0); \
               acc[ai][bj][m][n] = __builtin_amdgcn_mfma_f32_16x16x32_bf16(PG8_H1(Bt[n]), PG8_H1(At[m]), acc[ai][bj][m][n], 0, 0, 0); } } \
        __builtin_amdgcn_s_setprio(0); } while (0)
#define PG8_WAIT_V(n) asm volatile("s_waitcnt vmcnt(" #n ")" ::: "memory")
#define PG8_WAIT_L(n) asm volatile("s_waitcnt lgkmcnt(" #n ")" ::: "memory")
#define PG8_BAR __builtin_amdgcn_s_barrier()
#define PG8_SCHED __builtin_amdgcn_sched_barrier(0)
#define PG8_EXPERT(u) do { if (g.grouped) { int _e = 0; _Pragma("unroll") for (int _k = 1; _k < 8; ++_k) _e += ((u).pm >= g.toff[_k]) ? 1 : 0; (u).e = _e; } } while (0)
    Unit cur, nxt; int ui = 0;
    if (!S.next(0, cur)) return;
    PG8_EXPERT(cur);
    f32x4 acc[2][2][4][2];
#pragma unroll
    for (int a = 0; a < 2; ++a)
#pragma unroll
        for (int b = 0; b < 2; ++b)
#pragma unroll
            for (int m = 0; m < 4; ++m)
#pragma unroll
                for (int n = 0; n < 2; ++n) acc[a][b][m][n] = (f32x4){0.f, 0.f, 0.f, 0.f};
    i32x8 At[4], B0[2], B1[2];
    const char* cA = (const char*)g.A + (size_t)cur.pm * tA; const char* cB = ((const char*)g.Bt + (size_t)cur.e * g.estride * ES) + (size_t)cur.pn * tB;
    PG8_STAGE(PG8_SB(0, 0), cB, voffB); PG8_STAGE(PG8_SA(0, 0), cA, voffA); PG8_STAGE(PG8_SB(0, 1), cB + hB, voffB); PG8_STAGE(PG8_SA(0, 1), cA + hA, voffA);
    if (wr == 1) PG8_BAR;
    PG8_WAIT_V(4); PG8_BAR;
    PG8_STAGE(PG8_SB(1, 0), cB + kstep, voffB); PG8_STAGE(PG8_SA(1, 0), cA + kstep, voffA); PG8_STAGE(PG8_SB(1, 1), cB + hB + kstep, voffB);
    PG8_WAIT_V(6); PG8_BAR;
    for (;;) {
        const bool has_next = S.next(ui + 1, nxt);
        if (has_next) PG8_EXPERT(nxt);
        const char* nA = has_next ? (const char*)g.A + (size_t)nxt.pm * tA : cA; const char* nB = has_next ? ((const char*)g.Bt + (size_t)nxt.e * g.estride * ES) + (size_t)nxt.pn * tB : cB;
        for (int t = 0; t < nt; t += 2) {
            const bool last = (t == nt - 2);
            const char* a1 = cA + (size_t)(t + 1) * kstep;
            const char* a2 = last ? nA : cA + (size_t)(t + 2) * kstep; const char* b2 = last ? nB : cB + (size_t)(t + 2) * kstep;
            const char* a3 = a2 + kstep; const char* b3 = b2 + kstep;
            PG8_LDB(B0, 0, 0); PG8_SCHED; PG8_LDA(At, 0, 0); PG8_STAGE(PG8_SA(1, 1), a1 + hA, voffA);
            PG8_WAIT_L(8); PG8_BAR; PG8_WAIT_L(0); PG8_MMA(0, 0, At, B0); PG8_BAR; PG8_SCHED;
            PG8_LDB(B1, 0, 1); PG8_STAGE(PG8_SB(0, 0), b2, voffB);
            PG8_BAR; PG8_WAIT_L(0); PG8_MMA(0, 1, At, B1); PG8_BAR;
            PG8_LDA(At, 0, 1); PG8_STAGE(PG8_SA(0, 0), a2, voffA);
            PG8_BAR; PG8_WAIT_L(0); PG8_MMA(1, 0, At, B0); PG8_BAR; PG8_SCHED;
            PG8_STAGE(PG8_SB(0, 1), b2 + hB, voffB);
            PG8_WAIT_V(6); PG8_BAR; PG8_MMA(1, 1, At, B1); PG8_BAR;
            PG8_LDB(B0, 1, 0); PG8_SCHED; PG8_LDA(At, 1, 0); PG8_STAGE(PG8_SA(0, 1), a2 + hA, voffA);
            PG8_WAIT_L(8); PG8_BAR; PG8_WAIT_L(0); PG8_MMA(0, 0, At, B0); PG8_BAR; PG8_SCHED;
            PG8_LDB(B1, 1, 1); PG8_STAGE(PG8_SB(1, 0), b3, voffB);
            PG8_BAR; PG8_WAIT_L(0); PG8_MMA(0, 1, At, B1); PG8_BAR;
            PG8_LDA(At, 1, 1); PG8_STAGE(PG8_SA(1, 0), a3, voffA);
            PG8_BAR; PG8_WAIT_L(0); PG8_MMA(1, 0, At, B0); PG8_BAR; PG8_SCHED;
            PG8_STAGE(PG8_SB(1, 1), b3 + hB, voffB);
            PG8_WAIT_V(6); PG8_BAR; PG8_MMA(1, 1, At, B1); PG8_BAR;
        }
        if constexpr (F8) asm volatile("s_nop 15\n\ts_nop 15" ::: "memory");
        E(acc, cur, wr, wc, fr, fq);
        if (!has_next) break;
#pragma unroll
        for (int a = 0; a < 2; ++a)
#pragma unroll
            for (int b = 0; b < 2; ++b)
#pragma unroll
                for (int m = 0; m < 4; ++m)
#pragma unroll
                    for (int n = 0; n < 2; ++n) acc[a][b][m][n] = (f32x4){0.f, 0.f, 0.f, 0.f};
        cur = nxt; cA = nA; cB = nB; ++ui;
    }
    PG8_WAIT_V(0);
    if (wr == 0) PG8_BAR;
    PG8_BAR;
#undef PG8_SA
#undef PG8_SB
#undef PG8_STAGE
#undef PG8_LDA
#undef PG8_LDB
#undef PG8_MMA
#undef PG8_H0
#undef PG8_H1
#undef PG8_LD8
#undef PG8_WAIT_V
#undef PG8_WAIT_L
#undef PG8_BAR
#undef PG8_SCHED
#undef PG8_EXPERT
}
}

__device__ __forceinline__ void gemm_bf16(LAS unsigned char* lds, const pg8::Gemm& g, bf16_t* O, int ldc) { pg8::EpiBf16 E{O, ldc, 1.f}; pg8::gemm_phase(lds, g, E); }
__device__ __forceinline__ void gemm_even_in(LAS unsigned char* lds, const pg8::Gemm& g, const pg8::EpiEvenIn& E) { pg8::gemm_phase(lds, g, E); }
__device__ __forceinline__ void gemm_odd_in(LAS unsigned char* lds, const pg8::Gemm& g, const pg8::EpiOddIn& E) { pg8::gemm_phase(lds, g, E); }
__device__ __forceinline__ void gemm_mla_up(LAS unsigned char* lds, const pg8::Gemm& g, const pg8::EpiMlaUp& E) { pg8::gemm_phase(lds, g, E); }
__device__ __forceinline__ void gemm8_bf16(LAS unsigned char* lds, const pg8::Gemm& g, bf16_t* O, int ldc) { pg8::EpiBf16 E{O, ldc, F8_INV}; pg8::gemm_phase<pg8::EpiBf16, true>(lds, g, E); }
__device__ __forceinline__ void gemm8_swiglu8(LAS unsigned char* lds, const pg8::Gemm& g, unsigned char* O, int ldc) { pg8::EpiSwiGLU8 E{O, ldc, F8_INV}; pg8::gemm_phase<pg8::EpiSwiGLU8, true>(lds, g, E); }
__device__ __forceinline__ void gemm_swiglu(LAS unsigned char* lds, const pg8::Gemm& g, bf16_t* O, int ldc) { pg8::EpiSwiGLU E{O, ldc}; pg8::gemm_phase(lds, g, E); }

namespace att {
#define SBAR() __builtin_amdgcn_sched_barrier(0)
__device__ __forceinline__ int crow(int r, int hi) { return (r & 3) + 8 * (r >> 2) + 4 * hi; }
__device__ __forceinline__ int v_st(int k, int c) { const int kk = (k & ~0xC) | ((k & 4) << 1) | ((k & 8) >> 1); return ((kk >> 3) * 4 + (c >> 5)) * 512 + ((kk & 7) * 32 + (c & 31)) * 2; }
__device__ __forceinline__ int v_st_plain(int k, int c) { return ((k >> 3) * 4 + (c >> 5)) * 512 + ((k & 7) * 32 + (c & 31)) * 2; }
__device__ __forceinline__ int v_rd_base(int lane) { return ((lane & 3) << 3) | (((lane >> 2) & 3) << 6) | (((lane >> 4) & 1) << 5) | (((lane >> 5) & 1) << 8); }
constexpr int v_rd_off(int d0, int ks, int half) { return d0 * 512 + ks * 4096 + half * 2048; }
template <int OFF> __device__ __forceinline__ s16x4 tr_read(unsigned vb) {
    s16x4 r; asm volatile("ds_read_b64_tr_b16 %0, %1 offset:%2" : "=&v"(r) : "v"(vb), "i"(OFF) : "memory"); return r;
}
template <int D0> __device__ __forceinline__ void pv_one(f32x16& od, unsigned vb, bf16x8 pa0, bf16x8 pa1, bf16x8 pa2, bf16x8 pa3) {
    const s16x4 l0 = tr_read<v_rd_off(D0, 0, 0)>(vb), h0 = tr_read<v_rd_off(D0, 0, 1)>(vb), l1 = tr_read<v_rd_off(D0, 1, 0)>(vb), h1 = tr_read<v_rd_off(D0, 1, 1)>(vb);
    const s16x4 l2 = tr_read<v_rd_off(D0, 2, 0)>(vb), h2 = tr_read<v_rd_off(D0, 2, 1)>(vb), l3 = tr_read<v_rd_off(D0, 3, 0)>(vb), h3 = tr_read<v_rd_off(D0, 3, 1)>(vb);
    asm volatile("s_waitcnt lgkmcnt(0)" ::: "memory"); SBAR();
#define PK(L, H) (bf16x8){L[0], L[1], L[2], L[3], H[0], H[1], H[2], H[3]}
    od = __builtin_amdgcn_mfma_f32_32x32x16_bf16(pa0, PK(l0, h0), od, 0, 0, 0);
    od = __builtin_amdgcn_mfma_f32_32x32x16_bf16(pa1, PK(l1, h1), od, 0, 0, 0);
    od = __builtin_amdgcn_mfma_f32_32x32x16_bf16(pa2, PK(l2, h2), od, 0, 0, 0);
    od = __builtin_amdgcn_mfma_f32_32x32x16_bf16(pa3, PK(l3, h3), od, 0, 0, 0);
#undef PK
}
template <int KS, int NO> __device__ __forceinline__ void pv_step(f32x16 (&o)[NO], unsigned vb, bf16x8 pa) {
    s16x4 l[NO], h[NO];
    l[0] = tr_read<v_rd_off(0, KS, 0)>(vb); h[0] = tr_read<v_rd_off(0, KS, 1)>(vb); l[1] = tr_read<v_rd_off(1, KS, 0)>(vb); h[1] = tr_read<v_rd_off(1, KS, 1)>(vb);
    if constexpr (NO == 4) { l[2] = tr_read<v_rd_off(2, KS, 0)>(vb); h[2] = tr_read<v_rd_off(2, KS, 1)>(vb); l[3] = tr_read<v_rd_off(3, KS, 0)>(vb); h[3] = tr_read<v_rd_off(3, KS, 1)>(vb); }
    asm volatile("s_waitcnt lgkmcnt(0)" ::: "memory"); SBAR();
#pragma unroll
    for (int d = 0; d < NO; ++d) o[d] = __builtin_amdgcn_mfma_f32_32x32x16_bf16(pa, (bf16x8){l[d][0], l[d][1], l[d][2], l[d][3], h[d][0], h[d][1], h[d][2], h[d][3]}, o[d], 0, 0, 0);
}
__device__ __forceinline__ void rot8(bf16x8& a, bf16x8& b, const float* cs, const float* sn) {
    const f32x4 c0 = *(const f32x4*)cs, c1 = *(const f32x4*)(cs + 4), s0 = *(const f32x4*)sn, s1 = *(const f32x4*)(sn + 4);
    float c[8] = {c0[0], c0[1], c0[2], c0[3], c1[0], c1[1], c1[2], c1[3]}, s[8] = {s0[0], s0[1], s0[2], s0[3], s1[0], s1[1], s1[2], s1[3]};
    float o1[8], o2[8];
#pragma unroll
    for (int e = 0; e < 8; ++e) { const float x1 = bf2f((unsigned short)a[e]), x2 = bf2f((unsigned short)b[e]); o1[e] = x1 * c[e] - x2 * s[e]; o2[e] = x2 * c[e] + x1 * s[e]; }
    u32x4 wa = {cvtpk(o1[0], o1[1]), cvtpk(o1[2], o1[3]), cvtpk(o1[4], o1[5]), cvtpk(o1[6], o1[7])};
    u32x4 wb = {cvtpk(o2[0], o2[1]), cvtpk(o2[2], o2[3]), cvtpk(o2[4], o2[5]), cvtpk(o2[6], o2[7])};
    a = *reinterpret_cast<bf16x8*>(&wa); b = *reinterpret_cast<bf16x8*>(&wb);
}

__device__ __forceinline__ void rot4(bf16x8& a, const float* cs, const float* sn) {
    const f32x4 c = *(const f32x4*)cs, s = *(const f32x4*)sn; float o[8];
#pragma unroll
    for (int e = 0; e < 4; ++e) { const float x1 = bf2f((unsigned short)a[e]), x2 = bf2f((unsigned short)a[4 + e]); o[e] = x1 * c[e] - x2 * s[e]; o[4 + e] = x2 * c[e] + x1 * s[e]; }
    u32x4 w = {cvtpk(o[0], o[1]), cvtpk(o[2], o[3]), cvtpk(o[4], o[5]), cvtpk(o[6], o[7])};
    a = *reinterpret_cast<bf16x8*>(&w);
}
struct Args {
    const bf16_t* Q; int ldq, qcol;
    const bf16_t* K; int ldk, kcol;
    const bf16_t* V; int ldv, vcol;
    int q_row0;
    int kctx_row0, klat_row0, nt_ctx, nt_lat;
    float C;
    int rope;
    const float* rcos; const float* rsin;
    bf16_t* O; int ldo, ocol;
    int g, u0; const float* rpb;
    float lam, oscale; const float* subg;
};

template <int DQK, int KW, int DV, int MODE>
__device__ __forceinline__ void attn_unit(LAS unsigned char* lds, const Args& a) {
    constexpr int ND = DQK / 16, NO = DV / 32;
    constexpr int KSTR = KW * 2 + 16, KBUF = 64 * KSTR;
    constexpr int OFF_V = 3 * KBUF, OFF_WS = OFF_V + 3 * 16384, OFF_RPB = OFF_WS + 2048;
    constexpr int KCH = KW / 8, NKCH = 64 * KCH, NKC = (NKCH + 511) / 512;
    constexpr int VCH = DV / 8, NVCH = 64 * VCH, NVC = (NVCH + 511) / 512;
    const int tid = opaque_tid(), wid = __builtin_amdgcn_readfirstlane(tid >> 6), lane = tid & 63, r32 = lane & 31, hi = lane >> 5;
    LAS unsigned char* Kl = lds; LAS unsigned char* Vl = lds + OFF_V;
    LAS float* wsf = (LAS float*)(lds + OFF_WS) + wid * 64; LAS float* li_l = wsf;
    LAS float* rpbl = (LAS float*)(lds + OFF_RPB);
    const int wq = (MODE == 1) ? (wid & 3) : wid, wmap = (MODE == 1) ? (wid >> 2) : 0;
    bf16x8 qr[ND];
    const int qrow = a.q_row0 + wq * 32 + r32;
    {
        const bf16_t* Qw = a.Q + (size_t)qrow * a.ldq + a.qcol + wmap * 64 + hi * 8;
#pragma unroll
        for (int d0 = 0; d0 < ND; ++d0) qr[d0] = *(const bf16x8*)(Qw + d0 * 16);
        if (a.rope == 2) { if constexpr (ND >= 6) { const int s = qrow & (SEQ - 1); rot4(qr[4], a.rcos + s * 16 + 4 * hi, a.rsin + s * 16 + 4 * hi); rot4(qr[5], a.rcos + s * 16 + 8 + 4 * hi, a.rsin + s * 16 + 8 + 4 * hi); } }
#pragma unroll
        for (int d0 = 0; d0 < ND; ++d0) { float f[8];
#pragma unroll
            for (int e = 0; e < 8; ++e) f[e] = bf2f((unsigned short)qr[d0][e]) * a.C;
            u32x4 w = {cvtpk(f[0], f[1]), cvtpk(f[2], f[3]), cvtpk(f[4], f[5]), cvtpk(f[6], f[7])}; qr[d0] = *reinterpret_cast<bf16x8*>(&w); }
    }
    if (MODE == 2) { if (tid < 465) rpbl[tid] = a.rpb[tid] * LOG2E; }
    const int cq = (wid & 1) * 32 + r32, rq = 4 * a.g + (wid >> 1);
    const int rs = min(max(rq - 4, 0), 120), cs_ = min(max(cq - 8, 0), 48);
    int kgo[NKC], klo[NKC], vgo[NVC], vlo[NVC];
#pragma unroll
    for (int i = 0; i < NKC; ++i) { if (i > 0 && KCH == 16) { kgo[i] = kgo[0] + 32 * i * a.ldk; klo[i] = klo[0] + 32 * i * KSTR; } else { const int c = tid + 512 * i, row = c / KCH, ch = c % KCH; kgo[i] = row * a.ldk + ch * 8; klo[i] = row * KSTR + ch * 16; } }
#pragma unroll
    for (int i = 0; i < NVC; ++i) { if (i > 0 && VCH == 16) { vgo[i] = vgo[0] + 32 * i * a.ldv; vlo[i] = vlo[0] + 8192 * i; } else { const int c = tid + 512 * i, row = c / VCH, ch = c % VCH; vgo[i] = row * a.ldv + ch * 8; vlo[i] = v_st_plain(row, ch * 8); } }
    u32x4 ksA[NKC], vsA[NVC];
    const int NT = a.nt_ctx + a.nt_lat;
#define TILE_ROW(j) ((j) < a.nt_ctx ? a.kctx_row0 + 64 * (j) : a.klat_row0 + 64 * ((j) - a.nt_ctx))
#define SLOAD(j) do { const int _r0 = TILE_ROW(j); const bf16_t* _kp = a.K + (size_t)_r0 * a.ldk + a.kcol; const bf16_t* _vp = a.V + (size_t)_r0 * a.ldv + a.vcol; \
    _Pragma("unroll") for (int _i = 0; _i < NKC; ++_i) if ((NKCH % 512 == 0) || tid + 512 * _i < NKCH) ksA[_i] = *(const u32x4*)(_kp + kgo[_i]); \
    _Pragma("unroll") for (int _i = 0; _i < NVC; ++_i) if ((NVCH % 512 == 0) || tid + 512 * _i < NVCH) vsA[_i] = *(const u32x4*)(_vp + vgo[_i]); } while (0)
#define SWRITE(b) do { \
    _Pragma("unroll") for (int _i = 0; _i < NKC; ++_i) if ((NKCH % 512 == 0) || tid + 512 * _i < NKCH) *(LAS u32x4*)(Kl + (b) * KBUF + klo[_i]) = ksA[_i]; \
    _Pragma("unroll") for (int _i = 0; _i < NVC; ++_i) if ((NVCH % 512 == 0) || tid + 512 * _i < NVCH) *(LAS u32x4*)(Vl + (b) * 16384 + vlo[_i]) = vsA[_i]; } while (0)
    float l_reg = 0.f;
    f32x16 o[NO];
#pragma unroll
    for (int d = 0; d < NO; ++d) o[d] = (f32x16){0.f, 0.f, 0.f, 0.f, 0.f, 0.f, 0.f, 0.f, 0.f, 0.f, 0.f, 0.f, 0.f, 0.f, 0.f, 0.f};
    const unsigned vb0 = (unsigned)(size_t)Vl + (unsigned)v_rd_base(lane);
#define QKT(P0, P1, b) do { const LAS unsigned char* _Kb = Kl + (b) * KBUF + wmap * 128; \
    _Pragma("unroll") for (int d0 = 0; d0 < ND; ++d0) { const int cb = (d0 * 16 + hi * 8) * 2; \
        const bf16x8 b0 = *(const LAS bf16x8*)(_Kb + r32 * KSTR + cb), b1 = *(const LAS bf16x8*)(_Kb + (32 + r32) * KSTR + cb); \
        if (d0 == 0) { const f32x16 z16 = {0.f, 0.f, 0.f, 0.f, 0.f, 0.f, 0.f, 0.f, 0.f, 0.f, 0.f, 0.f, 0.f, 0.f, 0.f, 0.f}; P0 = __builtin_amdgcn_mfma_f32_32x32x16_bf16(b0, qr[0], z16, 0, 0, 0); P1 = __builtin_amdgcn_mfma_f32_32x32x16_bf16(b1, qr[0], z16, 0, 0, 0); } \
        else { P0 = __builtin_amdgcn_mfma_f32_32x32x16_bf16(b0, qr[d0], P0, 0, 0, 0); P1 = __builtin_amdgcn_mfma_f32_32x32x16_bf16(b1, qr[d0], P1, 0, 0, 0); } } } while (0)
#define PARTIAL(P0, P1, j) do { \
    if (MODE == 2) { if ((j) >= a.nt_ctx) { const int kr = a.u0 + ((j) - a.nt_ctx); const bool rowok = (kr >= rs) && (kr < rs + 8); const int ro = min(max(kr - rq + 7, 0), 14); const LAS float* brow = rpbl + ro * 31; \
        _Pragma("unroll") for (int r = 0; r < 16; ++r) { \
            { const int ck = crow(r, hi), dd = min(max(ck - cq + 15, 0), 30); const bool inw = rowok && ((unsigned)(ck - cs_) < 16u); const float bv = brow[dd]; P0[r] = inw ? P0[r] + bv : -1e30f; } \
            { const int ck = 32 + crow(r, hi), dd = min(max(ck - cq + 15, 0), 30); const bool inw = rowok && ((unsigned)(ck - cs_) < 16u); const float bv = brow[dd]; P1[r] = inw ? P1[r] + bv : -1e30f; } } } } \
    _Pragma("unroll") for (int r = 0; r < 16; ++r) P0[r] = fast_exp2(P0[r]); } while (0)
#define PK4(P, BASE, OUT) do { u32x4 w = {cvtpk(P[BASE + 0], P[BASE + 1]), cvtpk(P[BASE + 2], P[BASE + 3]), cvtpk(P[BASE + 4], P[BASE + 5]), cvtpk(P[BASE + 6], P[BASE + 7])}; \
    OUT = *reinterpret_cast<bf16x8*>(&w); } while (0)
#define FINISH(P0, P1) do { \
    _Pragma("unroll") for (int r = 0; r < 16; ++r) P1[r] = fast_exp2(P1[r]); \
    float ps = 0.f; \
    _Pragma("unroll") for (int r = 0; r < 16; ++r) ps += P0[r]; \
    _Pragma("unroll") for (int r = 0; r < 16; ++r) ps += P1[r]; \
    l_reg += ps; \
    PK4(P0, 0, pa0); PK4(P0, 8, pa1); PK4(P1, 0, pa2); PK4(P1, 8, pa3); } while (0)
#define PV(b) do { const unsigned _vb = vb0 + (unsigned)(b) * 16384u; \
    pv_step<0, NO>(o, _vb, pa0); pv_step<1, NO>(o, _vb, pa1); pv_step<2, NO>(o, _vb, pa2); pv_step<3, NO>(o, _vb, pa3); } while (0)
    f32x16 pA0, pA1, pB0, pB1; bf16x8 pa0, pa1, pa2, pa3;
    SLOAD(0); SWRITE(0); SLOAD(1); __syncthreads();
    QKT(pA0, pA1, 0); PARTIAL(pA0, pA1, 0);
    SWRITE(1); if (2 < NT) SLOAD(2);
    __syncthreads();
    int bm1 = 0, bj = 1, bn = 2;
    for (int j = 1; j + 1 < NT; j += 2) {
        SBAR(); QKT(pB0, pB1, bj);
        FINISH(pA0, pA1); SBAR();
        PV(bm1); PARTIAL(pB0, pB1, j);
        SBAR(); SWRITE(bn); SLOAD(j + 2);
        __syncthreads();
        SBAR(); QKT(pA0, pA1, bn);
        FINISH(pB0, pB1); SBAR();
        PV(bj); PARTIAL(pA0, pA1, j + 1);
        SBAR(); SWRITE(bm1); if (j + 3 < NT) SLOAD(j + 3);
        __syncthreads();
        { const int t0 = bm1; bm1 = bn; bn = bj; bj = t0; }
    }
    SBAR(); QKT(pB0, pB1, bj);
    FINISH(pA0, pA1); SBAR();
    PV(bm1); PARTIAL(pB0, pB1, NT - 1);
    FINISH(pB0, pB1); SBAR();
    PV(bj);
    __syncthreads();
#undef TILE_ROW
#undef SLOAD
#undef SWRITE
#undef QKT
#undef PARTIAL
#undef PK4
#undef FINISH
#undef PV
    const int tid_e = opaque_tid(), lane_e = tid_e & 63, r32e = lane_e & 31, hie = lane_e >> 5;
    { auto rr = __builtin_amdgcn_permlane32_swap(__float_as_uint(l_reg), __float_as_uint(l_reg), false, false); l_reg = __uint_as_float(rr[0]) + __uint_as_float(rr[1]); }
    if (hie == 0) li_l[r32e] = fmaxf(l_reg, 1e-37f); LDS_WAIT();
    float rli[16];
#pragma unroll
    for (int r = 0; r < 16; ++r) rli[r] = fast_rcp(li_l[crow(r, hie)]);
    if (MODE != 1) {
        bf16_t* Ow = a.O + (size_t)(a.q_row0 + wid * 32) * a.ldo + a.ocol + r32e;
#pragma unroll
        for (int r = 0; r < 16; ++r) { const int orow = crow(r, hie);
#pragma unroll
            for (int d0 = 0; d0 < NO; ++d0) Ow[(size_t)orow * a.ldo + d0 * 32] = f2bf(o[d0][r] * rli[r]); }
    } else {
        LAS float* cb = (LAS float*)lds;
        if (wmap == 1) {
#pragma unroll
            for (int r = 0; r < 16; ++r) { const int row = wq * 32 + crow(r, hie);
#pragma unroll
                for (int d0 = 0; d0 < NO; ++d0) cb[row * 129 + d0 * 32 + r32e] = a.lam * o[d0][r] * rli[r]; }
        }
        __syncthreads();
        if (wmap == 0) {
#pragma unroll
            for (int r = 0; r < 16; ++r) { const int row = wq * 32 + crow(r, hie);
#pragma unroll
                for (int d0 = 0; d0 < NO; ++d0) { const int ix = row * 129 + d0 * 32 + r32e; cb[ix] = o[d0][r] * rli[r] - cb[ix]; } }
        }
        __syncthreads();
        const int row = tid_e >> 2, qd = tid_e & 3;
        float v[32]; float ss = 0.f;
#pragma unroll
        for (int i = 0; i < 32; ++i) { v[i] = cb[row * 129 + qd * 32 + i]; ss += v[i] * v[i]; }
        ss += __shfl_xor(ss, 1); ss += __shfl_xor(ss, 2);
        const float rstd = rsqrtf(ss * (1.f / 128.f) + EPS) * a.oscale;
        bf16_t* Ow = a.O + (size_t)(a.q_row0 + row) * a.ldo + a.ocol + qd * 32;
#pragma unroll
        for (int c = 0; c < 4; ++c) { float w[8];
#pragma unroll
            for (int e = 0; e < 8; ++e) w[e] = v[c * 8 + e] * rstd * a.subg[qd * 32 + c * 8 + e];
            u32x4 pk = {cvtpk(w[0], w[1]), cvtpk(w[2], w[3]), cvtpk(w[4], w[5]), cvtpk(w[6], w[7])};
            *(u32x4*)(Ow + c * 8) = pk; }
    }
    __syncthreads();
}

__device__ __forceinline__ void sgu_unit(LAS unsigned char* lds, const bf16_t* PB, const bf16_t* Wsb, const float* bs, const float* stats, const float* sgain, bf16_t* MIX, int rowbase, int g) {
    const int tid = opaque_tid(), wid = __builtin_amdgcn_readfirstlane(tid >> 6), lane = tid & 63, r32 = lane & 31, hi = lane >> 5;
    LAS unsigned char* Vl = lds;
#pragma unroll 2
    for (int i = 0; i < 4; ++i) { const int c = tid + 512 * i, row = c >> 4, ch = c & 15;
        const u32x4 x = *(const u32x4*)(PB + (size_t)(rowbase + row) * EV_IN + 512 + g * 128 + ch * 8);
        const f32x4* st = (const f32x4*)(stats + (size_t)(rowbase + row) * 16); const f32x4 a0 = st[0], a1 = st[1], a2 = st[2], a3 = st[3];
        const float s1 = ((a0[0] + a0[2]) + (a1[0] + a1[2])) + ((a2[0] + a2[2]) + (a3[0] + a3[2])), s2 = ((a0[1] + a0[3]) + (a1[1] + a1[3])) + ((a2[1] + a2[3]) + (a3[1] + a3[3]));
        const float mean = s1 * (1.f / 512.f), rstd = rsqrtf(fmaxf(s2 * (1.f / 512.f) - mean * mean, 0.f) + EPS);
        const f32x4 g0 = *(const f32x4*)(sgain + g * 128 + ch * 8), g1 = *(const f32x4*)(sgain + g * 128 + ch * 8 + 4);
        u32x4 y; y.x = cvtpk((bflo(x.x) - mean) * rstd * g0[0], (bfhi(x.x) - mean) * rstd * g0[1]); y.y = cvtpk((bflo(x.y) - mean) * rstd * g0[2], (bfhi(x.y) - mean) * rstd * g0[3]);
        y.z = cvtpk((bflo(x.z) - mean) * rstd * g1[0], (bfhi(x.z) - mean) * rstd * g1[1]); y.w = cvtpk((bflo(x.w) - mean) * rstd * g1[2], (bfhi(x.w) - mean) * rstd * g1[3]);
        *(LAS u32x4*)(Vl + (row >> 6) * 16384 + v_st(row & 63, ch * 8)) = y; }
    const int prow = (wid & 3) * 32, dh = wid >> 2;
    bf16x8 pa[2][4];
#pragma unroll
    for (int kt = 0; kt < 2; ++kt)
#pragma unroll
        for (int ks = 0; ks < 4; ++ks) pa[kt][ks] = *(const bf16x8*)(Wsb + (size_t)(g * 128 + prow + r32) * 128 + kt * 64 + ks * 16 + hi * 8);
    __syncthreads();
    f32x16 o[2];
    o[0] = (f32x16){0.f, 0.f, 0.f, 0.f, 0.f, 0.f, 0.f, 0.f, 0.f, 0.f, 0.f, 0.f, 0.f, 0.f, 0.f, 0.f}; o[1] = o[0];
    const unsigned vb0 = (unsigned)(size_t)Vl + (unsigned)v_rd_base(lane);
#pragma unroll
    for (int kt = 0; kt < 2; ++kt) { const unsigned vb = vb0 + kt * 16384u;
        if (dh == 0) { pv_one<0>(o[0], vb, pa[kt][0], pa[kt][1], pa[kt][2], pa[kt][3]); pv_one<1>(o[1], vb, pa[kt][0], pa[kt][1], pa[kt][2], pa[kt][3]); }
        else { pv_one<2>(o[0], vb, pa[kt][0], pa[kt][1], pa[kt][2], pa[kt][3]); pv_one<3>(o[1], vb, pa[kt][0], pa[kt][1], pa[kt][2], pa[kt][3]); } }
#pragma unroll
    for (int r = 0; r < 16; ++r) { const int p = prow + crow(r, hi); const float bias = bs[g * 128 + p];
#pragma unroll
        for (int dd = 0; dd < 2; ++dd) { const int d = (2 * dh + dd) * 32 + r32;
            const float u = bf2f(PB[(size_t)(rowbase + p) * EV_IN + g * 128 + d]);
            MIX[(size_t)(rowbase + p) * DM + g * 128 + d] = f2bf(u * (o[dd][r] + bias)); } }
    __syncthreads();
}
}

struct Params {
    const float* in[31];
    float* out;
    unsigned char* ws;
    int ph_lo, ph_hi;
};

struct Ctx {
    LAS unsigned char* lds;
    int tid, lane, wid, gw, NGW;
};
__device__ __forceinline__ Ctx make_ctx(LAS unsigned char* lds) { const int t = opaque_tid(), w = __builtin_amdgcn_readfirstlane(t >> 6); return Ctx{lds, t, t & 63, w, opaque_bid() * 8 + w, (int)gridDim.x * 8}; }
typedef const __attribute__((address_space(4))) Params KParams;
__device__ __forceinline__ KParams& kparams() { KParams* p = (KParams*)__builtin_amdgcn_kernarg_segment_ptr(); asm volatile("" : "+s"(p)); return *p; }

__device__ __forceinline__ bf16_t* xrow_ptr(KParams& P, int row) { return (bf16_t*)(P.ws + WS_U + U_XB) + (size_t)row * DM; }
__device__ __forceinline__ int mod_r(int row) { return row < NLAT ? (row >> 13) : 4; }
__device__ __forceinline__ f32x4 ld4(const float* p) { return *(const f32x4*)p; }
__device__ __forceinline__ f32x4 ldbf4(const bf16_t* p) { const u32x2 w = *(const u32x2*)p; return (f32x4){bflo(w.x), bfhi(w.x), bflo(w.y), bfhi(w.y)}; }
__device__ __forceinline__ void stbf4(bf16_t* p, f32x4 v) { u32x2 w; w.x = cvtpk(v[0], v[1]); w.y = cvtpk(v[2], v[3]); *(u32x2*)p = w; }
__device__ __forceinline__ float sumsq4(const f32x4 (&v)[4]) { float s = 0.f;
#pragma unroll
    for (int j = 0; j < 4; ++j) s += (v[j][0] * v[j][0] + v[j][1] * v[j][1]) + (v[j][2] * v[j][2] + v[j][3] * v[j][3]);
    return wave_sum(s); }
__device__ __forceinline__ void norm_mod(const f32x4 (&x)[4], f32x4 (&hv)[4], const float* gain, const float* shift, const float* scale, int lane) {
    const float rstd = rsqrtf(sumsq4(x) * (1.f / DM) + EPS);
#pragma unroll
    for (int j = 0; j < 4; ++j) { const int c = 4 * lane + 256 * j; const f32x4 g = ld4(gain + c), sh = ld4(shift + c), sc = ld4(scale + c);
        hv[j] = (x[j] * rstd) * g * (sc + 1.f) + sh; }
}
__device__ __forceinline__ void resid_add(f32x4 (&x)[4], const f32x4 (&y)[4], const float* gain, const float* gate, int lane) {
    const float rstd = rsqrtf(sumsq4(y) * (1.f / DM) + EPS);
#pragma unroll
    for (int j = 0; j < 4; ++j) { const int c = 4 * lane + 256 * j; const f32x4 g = ld4(gain + c), gt = ld4(gate + c);
        x[j] = x[j] + gt * ((y[j] * rstd) * g); }
}

__device__ __forceinline__ void wave_rows(const Ctx& c, int mtok, int& r0, int& r1) {
    const int bid = opaque_bid(); const int rpw = mtok / (int)gridDim.x, base = bid * rpw;
    r0 = base + (c.wid * rpw) / 8; r1 = base + ((c.wid + 1) * rpw) / 8;
    if (bid == (int)gridDim.x - 1 && c.wid == 7) r1 = mtok;
}
__device__ __forceinline__ void ld_gate(f32x4 (&G)[4], const float* gain, const float* gate, int lane) {
#pragma unroll
    for (int j = 0; j < 4; ++j) { const int cc = 4 * lane + 256 * j; G[j] = ld4(gain + cc) * ld4(gate + cc); } }
__device__ __forceinline__ void ld_mod(f32x4 (&A)[4], f32x4 (&B)[4], const float* gain, const float* shift, const float* scale, int lane) {
#pragma unroll
    for (int j = 0; j < 4; ++j) { const int cc = 4 * lane + 256 * j; A[j] = ld4(gain + cc) * (ld4(scale + cc) + 1.f); B[j] = ld4(shift + cc); } }
__device__ __forceinline__ void resid_add2(f32x4 (&x)[4], const f32x4 (&y)[4], const f32x4 (&G)[4]) {
    const float rstd = rsqrtf(sumsq4(y) * (1.f / DM) + EPS);
#pragma unroll
    for (int j = 0; j < 4; ++j) x[j] = x[j] + G[j] * (y[j] * rstd);
}
__device__ __forceinline__ void norm_mod2(const f32x4 (&x)[4], f32x4 (&hv)[4], const f32x4 (&A)[4], const f32x4 (&B)[4]) {
    const float rstd = rsqrtf(sumsq4(x) * (1.f / DM) + EPS);
#pragma unroll
    for (int j = 0; j < 4; ++j) hv[j] = (x[j] * rstd) * A[j] + B[j];
}

__device__ __forceinline__ int perm_row(int pmode, int n) {
    if (pmode == 1) { if (n >= 1024 && n < 2048) { const int d = n & 63, hb = n & ~63; return hb + ((d < 32) ? 8 * (d >> 2) + (d & 3) : 8 * ((d - 32) >> 2) + 4 + (d & 3)); } }
    else if (pmode == 2) { if (n >= 1920 && n < 1952) { const int d = n - 1920; return 1920 + ((d < 16) ? 8 * (d >> 2) + (d & 3) : 8 * ((d - 16) >> 2) + 4 + (d & 3)); } }
    return n;
}
__device__ __forceinline__ void tr_item(const float* W, int ldw, bf16_t* WT, int ldt, int k0, int n0, int drow, LAS float* scr, int lane, int pmode = 0) {
#pragma unroll 8
    for (int i = 0; i < 32; ++i) { const int kk = 2 * i + (lane >> 5); scr[kk * 33 + (lane & 31)] = W[(size_t)(k0 + kk) * ldw + n0 + (lane & 31)]; }
    LDS_WAIT(); asm volatile("" ::: "memory");
    const int c = lane & 7;
#pragma unroll
    for (int j = 0; j < 4; ++j) { const int n = (lane >> 3) + 8 * j; const LAS float* s = scr + (8 * c) * 33 + n;
        u32x4 o; o.x = cvtpk(s[0 * 33], s[1 * 33]); o.y = cvtpk(s[2 * 33], s[3 * 33]); o.z = cvtpk(s[4 * 33], s[5 * 33]); o.w = cvtpk(s[6 * 33], s[7 * 33]);
        const int dr = pmode ? perm_row(pmode, n0 + n) : drow + n;
        *(u32x4*)(WT + (size_t)dr * ldt + k0 + 8 * c) = o; }
    LDS_WAIT(); asm volatile("" ::: "memory");
}
__device__ __forceinline__ void tr_item8(const float* W, int ldw, unsigned char* WT, int ldt, int k0, int n0, int drow, LAS float* scr, int lane) {
#pragma unroll 8
    for (int i = 0; i < 32; ++i) { const int kk = 2 * i + (lane >> 5); scr[kk * 33 + (lane & 31)] = W[(size_t)(k0 + kk) * ldw + n0 + (lane & 31)] * F8_W_SCALE; }
    LDS_WAIT(); asm volatile("" ::: "memory");
    const int c = lane & 7;
#pragma unroll
    for (int j = 0; j < 4; ++j) { const int n = (lane >> 3) + 8 * j; const LAS float* s = scr + (8 * c) * 33 + n;
        u32x2 o; o.x = pk4_fp8(s[0 * 33], s[1 * 33], s[2 * 33], s[3 * 33]); o.y = pk4_fp8(s[4 * 33], s[5 * 33], s[6 * 33], s[7 * 33]);
        *(u32x2*)(WT + (size_t)(drow + n) * ldt + k0 + 8 * c) = o; }
    LDS_WAIT(); asm volatile("" ::: "memory");
}
__device__ __forceinline__ void tr_matrix8(const Ctx& c, const float* W, int K, int N, unsigned char* WT, int mode, int row_off) {
    LAS float* scr = (LAS float*)(c.lds + c.wid * 16384);
    const int nblk = N / 32, nitems = (K / 64) * nblk;
    for (int it = c.gw; it < nitems; it += c.NGW) { const int kb = it / nblk, nb = it % nblk, n0 = 32 * nb;
        const int drow = (mode == 0) ? row_off + n0 : (n0 >> 7) * 256 + (n0 & 127) + (mode == 2 ? 128 : 0);
        tr_item8(W, N, WT, K, 64 * kb, n0, drow, scr, c.lane); }
}
__device__ __forceinline__ void tr_matrix(const Ctx& c, const float* W, int K, int N, bf16_t* WT, int mode, int row_off, int pmode = 0) {
    LAS float* scr = (LAS float*)(c.lds + c.wid * 16384);
    const int nblk = N / 32, nitems = (K / 64) * nblk;
    for (int it = c.gw; it < nitems; it += c.NGW) { const int kb = it / nblk, nb = it % nblk, n0 = 32 * nb;
        const int drow = (mode == 0) ? row_off + n0 : (n0 >> 7) * 256 + (n0 & 127) + (mode == 2 ? 128 : 0);
        tr_item(W, N, WT, K, 64 * kb, n0, drow, scr, c.lane, pmode); }
}
constexpr int MOE_CVT_ITEMS = 24 * 1792;
__device__ __forceinline__ void convert_moe_items(const Ctx& c, int i, int t0, int t1, int wsel, int nsel) {
    KParams& P = kparams();
    LAS float* scr = (LAS float*)(c.lds + c.wid * 16384);
    if (wsel < 0) return;
    for (int t = t0 + wsel; t < t1; t += nsel) {
        const int mat = t / 1792, r = t % 1792, e = mat / 3, which = mat % 3;
        if (which < 2) {
            const float* W = P.in[28 + which] + ((size_t)i * NEXP + e) * DM * DFFE; const int kb = r / 112, n0 = 32 * (r % 112);
            const int drow = (n0 >> 7) * 256 + (n0 & 127) + which * 128;
#if MOE_F8
            tr_item8(W, DFFE, (unsigned char*)(P.ws + WS_W13M) + (size_t)e * 2 * DFFE * DM, DM, 64 * kb, n0, drow, scr, c.lane);
#else
            tr_item(W, DFFE, (bf16_t*)(P.ws + WS_W13M) + (size_t)e * 2 * DFFE * DM, DM, 64 * kb, n0, drow, scr, c.lane);
#endif
        } else {
            const float* W = P.in[30] + ((size_t)i * NEXP + e) * DFFE * DM; const int kb = r / 32, n0 = 32 * (r % 32);
#if MOE_F8
            tr_item8(W, DM, (unsigned char*)(P.ws + WS_W2M) + (size_t)e * DM * DFFE, DFFE, 64 * kb, n0, n0, scr, c.lane);
#else
            tr_item(W, DM, (bf16_t*)(P.ws + WS_W2M) + (size_t)e * DM * DFFE, DFFE, 64 * kb, n0, n0, scr, c.lane);
#endif
        }
    }
}
__device__ __forceinline__ void prologue0(const Ctx& c_) {
    const Ctx c = make_ctx(c_.lds);
    KParams& P = kparams(); unsigned char* ws = P.ws;
    if (blockIdx.x < 96) {
        LAS float* sl = (LAS float*)c.lds;
        LAS float* part = (LAS float*)(c.lds + 32768);
        for (int i = c.tid; i < 5 * DM; i += 512) { const int r = i >> 10, k = i & 1023; const float x = r < 4 ? P.in[1][r * DM + k] : P.in[3][k]; sl[i] = x / (1.f + expf(-x)); }
        __syncthreads();
        const int t = blockIdx.x, lm = t / 24, cbk = t % 24, n = cbk * 256 + 4 * c.lane;
        const float* W = P.in[4] + (size_t)lm * DM * (NMOD * DM) + n;
        f32x4 acc[5];
#pragma unroll
        for (int r = 0; r < 5; ++r) acc[r] = (f32x4){0.f, 0.f, 0.f, 0.f};
        const int kb = c.wid * 128;
        for (int k0 = 0; k0 < 128; k0 += 8) {
            f32x4 wv[8];
#pragma unroll
            for (int u = 0; u < 8; ++u) wv[u] = ld4(W + (size_t)(kb + k0 + u) * (NMOD * DM));
#pragma unroll
            for (int u = 0; u < 8; ++u)
#pragma unroll
                for (int r = 0; r < 5; ++r) acc[r] += wv[u] * sl[r * DM + kb + k0 + u];
        }
#pragma unroll
        for (int r = 0; r < 5; ++r) *(LAS f32x4*)(part + (c.wid * 5 + r) * 256 + 4 * c.lane) = acc[r];
        __syncthreads();
        for (int i = c.tid; i < 5 * 256; i += 512) { const int r = i >> 8, cc = i & 255; float s = 0.f;
#pragma unroll
            for (int w = 0; w < 8; ++w) s += part[(w * 5 + r) * 256 + cc];
            ((float*)(ws + WS_MODS))[(size_t)(lm * 5 + r) * (NMOD * DM) + cbk * 256 + cc] = s + P.in[5][lm * (NMOD * DM) + cbk * 256 + cc]; }
        __syncthreads();
    }
    for (int i = 0; i < 2; ++i) {
        tr_matrix(c, P.in[7] + (size_t)i * DM * EV_IN, DM, EV_IN, (bf16_t*)(ws + WS_WINE) + (size_t)i * EV_IN * DM, 0, 0, 1);
        tr_matrix(c, P.in[8] + (size_t)i * DM * DM, DM, DM, (bf16_t*)(ws + WS_WOUTE) + (size_t)i * DM * DM, 0, 0);
        tr_matrix(c, P.in[17] + (size_t)i * DM * DFF, DM, DFF, (bf16_t*)(ws + WS_W13E) + (size_t)i * 2 * DFF * DM, 1, 0);
        tr_matrix(c, P.in[18] + (size_t)i * DM * DFF, DM, DFF, (bf16_t*)(ws + WS_W13E) + (size_t)i * 2 * DFF * DM, 2, 0);
        tr_matrix(c, P.in[19] + (size_t)i * DFF * DM, DFF, DM, (bf16_t*)(ws + WS_W2E) + (size_t)i * DM * DFF, 0, 0);
        tr_matrix(c, P.in[20] + (size_t)i * DM * OD_IN, DM, OD_IN, (bf16_t*)(ws + WS_WINO) + (size_t)i * OD_INP * DM, 0, 0, 2);
        tr_matrix(c, P.in[21] + (size_t)i * DM * DM, DM, DM, (bf16_t*)(ws + WS_WOUTO) + (size_t)i * DM * DM, 0, 0);
    }
    const int gt = blockIdx.x * 512 + c.tid, NGT = gridDim.x * 512;
    for (int i = gt; i < 2 * (OD_INP - OD_IN) * DM; i += NGT) { const int l = i / ((OD_INP - OD_IN) * DM), r = i % ((OD_INP - OD_IN) * DM);
        ((bf16_t*)(ws + WS_WINO))[(size_t)l * OD_INP * DM + (size_t)OD_IN * DM + r] = 0; }
    for (int i = gt; i < 2 * MLA_N * MLA_K; i += NGT) { const int l = i / (MLA_N * MLA_K), n = (i / MLA_K) % MLA_N, k = i % MLA_K; float v = 0.f;
        if (n < 384) { if (k < 256) { const int h = n / 96, j = n % 96; int sc = n;
                if (j >= 64) { const int p = j - 64, t = p >> 3, e = p & 7; sc = h * 96 + 64 + ((e < 4) ? 4 * t + e : 16 + 4 * t + (e - 4)); }
                v = P.in[24][((size_t)l * 256 + k) * 384 + sc] * P.in[23][l * 256 + k]; } }
        else if (n < 768) { const int h = (n - 384) / 96, j = (n - 384) % 96;
            if (j < 64) { if (k >= 256 && k < 384) v = P.in[26][((size_t)l * 128 + (k - 256)) * 768 + h * 192 + j] * P.in[25][l * 128 + (k - 256)]; }
            else { if (k == 384 + (j - 64)) v = 1.f; } }
        else { const int h = (n - 768) / 128, j = (n - 768) % 128; if (k >= 256 && k < 384) v = P.in[26][((size_t)l * 128 + (k - 256)) * 768 + h * 192 + 64 + j] * P.in[25][l * 128 + (k - 256)]; }
        ((bf16_t*)(ws + WS_WMLA))[i] = f2bf(v); }
    for (int i = gt; i < 2 * 4 * 128 * 128; i += NGT) ((bf16_t*)(ws + WS_SGUW))[i] = f2bf(P.in[9][i]);
    for (int i = gt; i < SEQ * 32; i += NGT) { const int s = i >> 5, f = i & 31; const int pos = f < 16 ? (s >> 6) : (s & 63);
        const float inv = 1.0f / powf(10000.0f, (float)(f & 15) / 16.0f); const float ang = (float)pos * inv;
        ((float*)(ws + WS_ROPEB))[i] = (float)cos((double)ang); ((float*)(ws + WS_ROPEB))[SEQ * 32 + i] = (float)sin((double)ang); }
    for (int i = gt; i < SEQ * 16; i += NGT) { const int s = i >> 4, f = i & 15; const int pos = f < 8 ? (s >> 6) : (s & 63);
        const float inv = 1.0f / powf(10000.0f, (float)(f & 7) / 8.0f); const float ang = (float)pos * inv;
        ((float*)(ws + WS_ROPED))[i] = (float)cos((double)ang); ((float*)(ws + WS_ROPED))[SEQ * 16 + i] = (float)sin((double)ang); }
}

__device__ __forceinline__ void convert_moe_tail(const Ctx& c_, int i, int t0, int t1, int nunits) {
    const Ctx c = make_ctx(c_.lds);
    const int G = (int)gridDim.x, rem = nunits % G, bid = opaque_bid();
    const int first = rem;
    convert_moe_items(c, i, t0, t1, bid >= first ? (bid - first) * 8 + c.wid : -1, (G - first) * 8);
}

__device__ __forceinline__ void ew_first(const Ctx& c_) {
    const Ctx c = make_ctx(c_.lds);
    KParams& P = kparams(); const float* mods = (const float*)(P.ws + WS_MODS); bf16_t* HB = (bf16_t*)(P.ws + WS_HB);
    int r0, r1; wave_rows(c, MTOT, r0, r1);
    f32x4 A0[4], B0[4]; int rcur = -1;
    for (int row = r0; row < r1; ++row) {
        const float* src = row < NLAT ? P.in[0] + (size_t)row * DM : P.in[2] + (size_t)(row - NLAT) * DM;
        bf16_t* xr = xrow_ptr(P, row); const int r = mod_r(row);
        if (r != rcur) { rcur = r; const float* mb = mods + (size_t)(0 * 5 + r) * (NMOD * DM); ld_mod(A0, B0, P.in[6] + (0 * 4 + 0) * DM, mb + 0 * DM, mb + 1 * DM, c.lane); }
        f32x4 x[4], h[4];
#pragma unroll
        for (int j = 0; j < 4; ++j) { x[j] = ld4(src + 4 * c.lane + 256 * j); stbf4(xr + 4 * c.lane + 256 * j, x[j]); }
        norm_mod2(x, h, A0, B0);
#pragma unroll
        for (int j = 0; j < 4; ++j) stbf4(HB + (size_t)row * DM + 4 * c.lane + 256 * j, h[j]);
    }
}

__device__ __forceinline__ void ew_even_mix(const Ctx& c_, int i) {
    const Ctx c = make_ctx(c_.lds);
    KParams& P = kparams(); bf16_t* PB = (bf16_t*)(P.ws + WS_U + U_PB);
    const float* sg = P.in[11] + i * 512; const float* rc = (const float*)(P.ws + WS_ROPEB); const float* rsn = rc + SEQ * 32;
    for (int row = c.gw; row < MTOT; row += c.NGW) {
        bf16_t* pr = PB + (size_t)row * EV_IN;
        {
            const u32x4 w = *(const u32x4*)(pr + 8 * c.lane); float f[8] = {bflo(w.x), bfhi(w.x), bflo(w.y), bfhi(w.y), bflo(w.z), bfhi(w.z), bflo(w.w), bfhi(w.w)};
#pragma unroll
            for (int e = 0; e < 8; ++e) f[e] = gelu_tanh_f(f[e]);
            u32x4 o = {cvtpk(f[0], f[1]), cvtpk(f[2], f[3]), cvtpk(f[4], f[5]), cvtpk(f[6], f[7])}; *(u32x4*)(pr + 8 * c.lane) = o;
        }
        {
            const u32x4 w = *(const u32x4*)(pr + 512 + 8 * c.lane); float f[8] = {bflo(w.x), bfhi(w.x), bflo(w.y), bfhi(w.y), bflo(w.z), bfhi(w.z), bflo(w.w), bfhi(w.w)};
            float s = 0.f;
#pragma unroll
            for (int e = 0; e < 8; ++e) { f[e] = gelu_tanh_f(f[e]); s += f[e]; }
            const float mean = wave_sum(s) * (1.f / 512.f); float q = 0.f;
#pragma unroll
            for (int e = 0; e < 8; ++e) { f[e] -= mean; q += f[e] * f[e]; }
            const float rstd = rsqrtf(wave_sum(q) * (1.f / 512.f) + EPS);
            const f32x4 g0 = ld4(sg + 8 * c.lane), g1 = ld4(sg + 8 * c.lane + 4);
            float gg[8] = {g0[0], g0[1], g0[2], g0[3], g1[0], g1[1], g1[2], g1[3]};
#pragma unroll
            for (int e = 0; e < 8; ++e) f[e] = f[e] * rstd * gg[e];
            u32x4 o = {cvtpk(f[0], f[1]), cvtpk(f[2], f[3]), cvtpk(f[4], f[5]), cvtpk(f[6], f[7])}; *(u32x4*)(pr + 512 + 8 * c.lane) = o;
        }
        if (row < NLAT) {
            const int s = row & (SEQ - 1), hj = c.lane >> 3, sub = c.lane & 7;
            bf16_t* kp = pr + 1536 + hj * 64 + 4 * sub;
            const f32x4 x1 = ldbf4(kp), x2 = ldbf4(kp + 32), cs = ld4(rc + s * 32 + 4 * sub), sn = ld4(rsn + s * 32 + 4 * sub);
            stbf4(kp, x1 * cs - x2 * sn); stbf4(kp + 32, x2 * cs + x1 * sn);
        }
    }
}

__device__ __forceinline__ void ew_odd_mla(const Ctx& c_, int i) {
    const Ctx c = make_ctx(c_.lds);
    KParams& P = kparams(); const bf16_t* PB = (const bf16_t*)(P.ws + WS_U + U_PB); bf16_t* A2 = (bf16_t*)(P.ws + WS_U + U_A2);
    const float* gq = P.in[23] + i * 256; const float* gkv = P.in[25] + i * 128; const float* rc = (const float*)(P.ws + WS_ROPED); const float* rsn = rc + SEQ * 16;
    for (int row = c.gw; row < MTOT; row += c.NGW) {
        const bf16_t* pr = PB + (size_t)row * OD_INP; bf16_t* ar = A2 + (size_t)row * MLA_K;
        f32x4 q = ldbf4(pr + 1536 + 4 * c.lane);
        const float rq = rsqrtf(wave_sum(q[0] * q[0] + q[1] * q[1] + q[2] * q[2] + q[3] * q[3]) * (1.f / 256.f) + EPS);
        stbf4(ar + 4 * c.lane, q * rq * ld4(gq + 4 * c.lane));
        const unsigned kw = *(const unsigned*)(pr + 1792 + 2 * c.lane); const float k0 = bflo(kw), k1 = bfhi(kw);
        const float rk = rsqrtf(wave_sum(k0 * k0 + k1 * k1) * (1.f / 128.f) + EPS);
        *(unsigned*)(ar + 256 + 2 * c.lane) = cvtpk(k0 * rk * gkv[2 * c.lane], k1 * rk * gkv[2 * c.lane + 1]);
        if (c.lane < 16) { float x1 = bf2f(pr[1920 + c.lane]), x2 = bf2f(pr[1920 + 16 + c.lane]);
            if (row < NLAT) { const int s = row & (SEQ - 1); const float cs = rc[s * 16 + c.lane], sn = rsn[s * 16 + c.lane]; const float o1 = x1 * cs - x2 * sn, o2 = x2 * cs + x1 * sn; x1 = o1; x2 = o2; }
            ar[384 + c.lane] = f2bf(x1); ar[384 + 16 + c.lane] = f2bf(x2); }
        else { *(unsigned*)(ar + 416 + 2 * (c.lane - 16)) = 0u; }
    }
}

__device__ __forceinline__ void ew_mid(const Ctx& c_, int l, int mtok, bool dry = false) {
    const Ctx c = make_ctx(c_.lds);
    KParams& P = kparams(); const float* mods = (const float*)(P.ws + WS_MODS); bf16_t* HB = (bf16_t*)(P.ws + WS_HB);
    const bf16_t* YB = (const bf16_t*)(P.ws + WS_U + U_YB);
    const bool odd = (l & 1) != 0; const int li = l >> 1;
    LAS float* wrl = (LAS float*)c.lds;
    if (odd) { for (int i = c.tid; i < DM * NEXP; i += 512) { const int col = i >> 3, e = i & 7; wrl[e * DM + col] = P.in[27][(size_t)li * DM * NEXP + i]; } __syncthreads(); }
    unsigned long long cw = 0ull; int st_e1 = 0, st_e2 = 0, st_l1 = 0, st_l2 = 0; float st_g1 = 0.f; int nrow = 0;
    int r0, r1; wave_rows(c, mtok, r0, r1);
    f32x4 G1[4], A2[4], B2[4]; int rcur = -1;
    f32x4 xn[4], yn[4];
    if (r0 < r1) {
#pragma unroll
        for (int j = 0; j < 4; ++j) { xn[j] = ldbf4(xrow_ptr(P, r0) + 4 * c.lane + 256 * j); yn[j] = ldbf4(YB + (size_t)r0 * DM + 4 * c.lane + 256 * j); } }
    for (int row = r0; row < r1; ++row, ++nrow) {
        bf16_t* xr = xrow_ptr(P, row); const int r = mod_r(row);
        if (r != rcur) { rcur = r; const float* mb = mods + (size_t)(l * 5 + r) * (NMOD * DM);
            ld_gate(G1, P.in[6] + (l * 4 + 1) * DM, mb + 2 * DM, c.lane); ld_mod(A2, B2, P.in[6] + (l * 4 + 2) * DM, mb + 3 * DM, mb + 4 * DM, c.lane); }
        f32x4 x[4], y[4], h[4];
#pragma unroll
        for (int j = 0; j < 4; ++j) { x[j] = xn[j]; y[j] = yn[j]; }
        if (row + 1 < r1) {
#pragma unroll
            for (int j = 0; j < 4; ++j) { xn[j] = ldbf4(xrow_ptr(P, row + 1) + 4 * c.lane + 256 * j); yn[j] = ldbf4(YB + (size_t)(row + 1) * DM + 4 * c.lane + 256 * j); } }
        resid_add2(x, y, G1);
        bf16_t* xw = dry ? (bf16_t*)(P.ws + WS_U + U_YS) + (size_t)row * DM : xr; bf16_t* hw = (dry ? (bf16_t*)(P.ws + WS_U + U_PB) : HB) + (size_t)row * DM;
#pragma unroll
        for (int j = 0; j < 4; ++j) stbf4(xw + 4 * c.lane + 256 * j, x[j]);
        norm_mod2(x, h, A2, B2);
#pragma unroll
        for (int j = 0; j < 4; ++j) stbf4(hw + 4 * c.lane + 256 * j, h[j]);
        if (odd && !dry) {
            float lg[8];
#pragma unroll
            for (int e = 0; e < 8; ++e) { float sacc = 0.f;
#pragma unroll
                for (int j = 0; j < 4; ++j) { const f32x4 w = *(const LAS f32x4*)(wrl + e * DM + 4 * c.lane + 256 * j); sacc += (h[j][0] * w[0] + h[j][1] * w[1]) + (h[j][2] * w[2] + h[j][3] * w[3]); }
                lg[e] = wave_sum(sacc); }
            int e1 = 0; float v1 = lg[0];
#pragma unroll
            for (int e = 1; e < 8; ++e) if (lg[e] > v1) { v1 = lg[e]; e1 = e; }
            int e2 = -1; float v2 = -3.0e38f;
#pragma unroll
            for (int e = 0; e < 8; ++e) if (e != e1 && lg[e] > v2) { v2 = lg[e]; e2 = e; }
            if (e2 < 0) e2 = (e1 + 1) & 7;
            const float g1 = 1.f / (1.f + expf(v2 - v1));
            const int l1 = (int)((cw >> (8 * e1)) & 0xffull); cw += 1ull << (8 * e1);
            const int l2 = (int)((cw >> (8 * e2)) & 0xffull); cw += 1ull << (8 * e2);
            if (c.lane == nrow) { st_e1 = e1; st_e2 = e2; st_l1 = l1; st_l2 = l2; st_g1 = g1; }
        }
    }
    if (odd && !dry) {
        unsigned* cnt = (unsigned*)(P.ws + WS_CTL) + CW_MOECNT + li * 64;
        int base = 0;
        if (c.lane < 8) { const unsigned wc = (unsigned)((cw >> (8 * c.lane)) & 0xffull); base = wc ? (int)atomicAdd(cnt + c.lane, wc) : 0; }
        const int b1 = __shfl(base, st_e1), b2 = __shfl(base, st_e2);
        if (c.lane < nrow) { const int row = r0 + c.lane; int4* ti = (int4*)(P.ws + WS_TOKINFO) + (size_t)row * 2;
            ti[0] = make_int4(st_e1, b1 + st_l1, st_e2, b2 + st_l2); ti[1] = make_int4(__float_as_int(st_g1), __float_as_int(1.f - st_g1), 0, 0); }
        __syncthreads();
    }
}

__device__ __forceinline__ void moe_offsets(KParams& P, int li, int (&toff)[9]) {
    const unsigned* cnt = (const unsigned*)(P.ws + WS_CTL) + CW_MOECNT + li * 64; int acc = 0;
#pragma unroll
    for (int e = 0; e < 8; ++e) { toff[e] = acc; const unsigned n = __builtin_amdgcn_readfirstlane(__hip_atomic_load(cnt + e, __ATOMIC_RELAXED, __HIP_MEMORY_SCOPE_AGENT)); acc += (int)((n + 255u) >> 8); }
    toff[8] = acc;
}
__device__ __forceinline__ void moe_gather(const Ctx& c_, int li, int mtok) {
    const Ctx c = make_ctx(c_.lds);
    KParams& P = kparams(); int toff[9]; moe_offsets(P, li, toff);
    int tv = 0;
#pragma unroll
    for (int e = 0; e < 8; ++e) tv = (c.lane == e) ? toff[e] : tv;
    const bf16_t* HB = (const bf16_t*)(P.ws + WS_HB); bf16_t* HS = (bf16_t*)(P.ws + WS_U + U_YS);
    int r0, r1; wave_rows(c, mtok, r0, r1);
    for (int row = r0; row < r1; ++row) {
        const int4* ti = (const int4*)(P.ws + WS_TOKINFO) + (size_t)row * 2; const int4 a = ti[0], b = ti[1];
        const int pA = __shfl(tv, a.x) * 256 + a.y, pB = __shfl(tv, a.z) * 256 + a.w;
        if (c.lane == 0) ((int4*)(P.ws + WS_TOKPOS))[row] = make_int4(pA, pB, b.x, b.y);
        const u32x4* src = (const u32x4*)(HB + (size_t)row * DM); const u32x4 v0 = src[c.lane], v1 = src[64 + c.lane];
#if MOE_F8
        u32x2 q0, q1; const float sc = F8_ACT_SCALE;
        q0.x = pk4_fp8(bflo(v0.x) * sc, bfhi(v0.x) * sc, bflo(v0.y) * sc, bfhi(v0.y) * sc); q0.y = pk4_fp8(bflo(v0.z) * sc, bfhi(v0.z) * sc, bflo(v0.w) * sc, bfhi(v0.w) * sc);
        q1.x = pk4_fp8(bflo(v1.x) * sc, bfhi(v1.x) * sc, bflo(v1.y) * sc, bfhi(v1.y) * sc); q1.y = pk4_fp8(bflo(v1.z) * sc, bfhi(v1.z) * sc, bflo(v1.w) * sc, bfhi(v1.w) * sc);
        u32x2* dA = (u32x2*)((unsigned char*)HS + (size_t)pA * DM); u32x2* dB = (u32x2*)((unsigned char*)HS + (size_t)pB * DM);
        dA[c.lane] = q0; dA[64 + c.lane] = q1; dB[c.lane] = q0; dB[64 + c.lane] = q1;
#else
        u32x4* dA = (u32x4*)(HS + (size_t)pA * DM); u32x4* dB = (u32x4*)(HS + (size_t)pB * DM);
        dA[c.lane] = v0; dA[64 + c.lane] = v1; dB[c.lane] = v0; dB[64 + c.lane] = v1;
#endif
    }
}

__device__ __forceinline__ void ew_last(const Ctx& c_, int l, int mtok, bool dry = false) {
    const Ctx c = make_ctx(c_.lds);
    KParams& P = kparams(); const float* mods = (const float*)(P.ws + WS_MODS); bf16_t* HB = (bf16_t*)(P.ws + WS_HB);
    const bf16_t* YS = (const bf16_t*)(P.ws + WS_U + U_YS); const bool odd = (l & 1) != 0;
    int r0, r1; wave_rows(c, mtok, r0, r1);
    f32x4 G3[4], A0[4], B0[4]; int rcur = -1;
    f32x4 xn[4], yn[4];
#define EWL_LOAD(rw) do { const int _row = (rw); const bf16_t* _xr = xrow_ptr(P, _row); \
        if (odd) { const int4 tp = ((const int4*)(P.ws + WS_TOKPOS))[_row]; const float gA = __int_as_float(tp.z), gB = __int_as_float(tp.w); \
            _Pragma("unroll") for (int j = 0; j < 4; ++j) yn[j] = ldbf4(YS + (size_t)tp.x * DM + 4 * c.lane + 256 * j) * gA + ldbf4(YS + (size_t)tp.y * DM + 4 * c.lane + 256 * j) * gB; } \
        else { _Pragma("unroll") for (int j = 0; j < 4; ++j) yn[j] = ldbf4(YS + (size_t)_row * DM + 4 * c.lane + 256 * j); } \
        _Pragma("unroll") for (int j = 0; j < 4; ++j) xn[j] = ldbf4(_xr + 4 * c.lane + 256 * j); } while (0)
    if (r0 < r1) EWL_LOAD(r0);
    for (int row = r0; row < r1; ++row) {
        bf16_t* xr = xrow_ptr(P, row); const int r = mod_r(row);
        if (r != rcur) { rcur = r; const float* mb = mods + (size_t)(l * 5 + r) * (NMOD * DM);
            ld_gate(G3, P.in[6] + (l * 4 + 3) * DM, mb + 5 * DM, c.lane);
            if (l < 3) { const float* mn = mods + (size_t)((l + 1) * 5 + r) * (NMOD * DM); ld_mod(A0, B0, P.in[6] + ((l + 1) * 4 + 0) * DM, mn + 0 * DM, mn + 1 * DM, c.lane); } }
        f32x4 x[4], y[4], h[4];
#pragma unroll
        for (int j = 0; j < 4; ++j) { x[j] = xn[j]; y[j] = yn[j]; }
        if (row + 1 < r1) EWL_LOAD(row + 1);
        resid_add2(x, y, G3);
        bf16_t* hw = (dry ? (bf16_t*)(P.ws + WS_U + U_MIX) : HB) + (size_t)row * DM;
        if (l == 3 && !dry) { float* ow = P.out + (size_t)row * DM;
#pragma unroll
            for (int j = 0; j < 4; ++j) *(f32x4*)(ow + 4 * c.lane + 256 * j) = x[j]; }
        else { bf16_t* xw = dry ? (bf16_t*)(P.ws + WS_U + U_PB) + (size_t)row * DM : xr;
#pragma unroll
            for (int j = 0; j < 4; ++j) stbf4(xw + 4 * c.lane + 256 * j, x[j]); }
        if (l < 3) { norm_mod2(x, h, A0, B0);
#pragma unroll
            for (int j = 0; j < 4; ++j) stbf4(hw + 4 * c.lane + 256 * j, h[j]); }
    }
#undef EWL_LOAD
}

__device__ __forceinline__ void attn_even(const Ctx& c_, int l) {
    const Ctx c = make_ctx(c_.lds);
    KParams& P = kparams(); const int i = l >> 1; const bool need_ctx = l < 3;
    const bf16_t* PB = (const bf16_t*)(P.ws + WS_U + U_PB); bf16_t* MIX = (bf16_t*)(P.ws + WS_U + U_MIX);
    const int nchunk = need_ctx ? 264 : 256;
    for (int u = opaque_bid(); u < nchunk * 4; u += gridDim.x) att::sgu_unit(c.lds, PB, (const bf16_t*)(P.ws + WS_SGUW) + (size_t)i * 4 * 128 * 128, P.in[10] + i * 512, (const float*)(P.ws + WS_STATS), P.in[11] + i * 512, MIX, (u >> 2) * 128, u & 3);
    float d1 = 0.f, d2 = 0.f;
    if (c.lane < 64) { d1 = P.in[12][i * 64 + c.lane] * P.in[13][i * 64 + c.lane]; d2 = P.in[14][i * 64 + c.lane] * P.in[15][i * 64 + c.lane]; }
    const float lam_init = 0.8f - 0.6f * expf(-0.3f * (float)l);
    const float lam = expf(wave_sum(d1)) - expf(wave_sum(d2)) + lam_init;
    att::Args a;
    a.Q = PB; a.ldq = EV_IN; a.K = PB; a.ldk = EV_IN; a.V = PB; a.ldv = EV_IN; a.C = 0.125f * LOG2E;
    a.rcos = (const float*)(P.ws + WS_ROPEB); a.rsin = a.rcos + SEQ * 32; a.O = MIX; a.ldo = DM; a.g = 0; a.u0 = 0; a.rpb = nullptr;
    a.lam = lam; a.oscale = 1.f - lam_init; a.subg = P.in[16] + i * 128; a.nt_ctx = 4;
    const int nctxu = need_ctx ? 32 : 0, nu = nctxu + 1024;
    for (int u = xcd_unit_base(); u < nu; u += gridDim.x) {
        int b, h;
        if (u < nctxu) { b = u >> 3; h = (u >> 1) & 3; a.q_row0 = NLAT + b * CTXL + (u & 1) * 128; a.nt_lat = 0; a.rope = 0; }
        else { const int v = u - nctxu; b = v >> 8; h = (v >> 6) & 3; a.q_row0 = b * SEQ + (v & 63) * 128; a.nt_lat = SEQ / 64; a.rope = 0; }
        a.qcol = 1024 + h * 128; a.kcol = 1536 + h * 128; a.vcol = 2048 + h * 128; a.ocol = 512 + h * 128;
        a.kctx_row0 = NLAT + b * CTXL; a.klat_row0 = b * SEQ;
        att::attn_unit<64, 128, 128, 1>(c.lds, a);
    }
}
__device__ __forceinline__ void attn_odd_na(const Ctx& c_, int l) {
    const Ctx c = make_ctx(c_.lds);
    KParams& P = kparams(); const int i = l >> 1; const bool need_ctx = l < 3;
    const bf16_t* PB = (const bf16_t*)(P.ws + WS_U + U_PB); bf16_t* MIX = (bf16_t*)(P.ws + WS_U + U_MIX);
    att::Args a;
    a.Q = PB; a.ldq = OD_INP; a.K = PB; a.ldk = OD_INP; a.V = PB; a.ldv = OD_INP; a.C = 0.125f * LOG2E; a.rope = 0; a.rcos = nullptr; a.rsin = nullptr;
    a.O = MIX; a.ldo = DM; a.lam = 0.f; a.oscale = 1.f; a.subg = nullptr; a.nt_ctx = 4;
    const int nctxu = need_ctx ? 32 : 0, nu = nctxu + 1024;
    for (int u = xcd_unit_base(); u < nu; u += gridDim.x) {
        int b, h;
        if (u < nctxu) { b = u >> 3; h = u & 7; a.q_row0 = NLAT + b * CTXL; a.nt_lat = 0; a.g = 0; a.u0 = 0; a.klat_row0 = 0; }
        else { const int v = u - nctxu; b = v >> 8; h = (v >> 5) & 7; const int g = v & 31; a.g = g; a.u0 = min(max(4 * g - 4, 0), 116);
            a.q_row0 = b * SEQ + g * 256; a.nt_lat = 12; a.klat_row0 = b * SEQ + a.u0 * 64; }
        a.qcol = h * 64; a.kcol = 512 + h * 64; a.vcol = 1024 + h * 64; a.ocol = h * 64; a.kctx_row0 = NLAT + b * CTXL;
        a.rpb = P.in[22] + ((size_t)i * 8 + h) * 465;
        att::attn_unit<64, 64, 64, 2>(c.lds, a);
    }
}
__device__ __forceinline__ void attn_odd_mla(const Ctx& c_, int l) {
    const Ctx c = make_ctx(c_.lds);
    KParams& P = kparams(); const bool need_ctx = l < 3;
    const bf16_t* MO = (const bf16_t*)(P.ws + WS_U + U_MLAO); bf16_t* MIX = (bf16_t*)(P.ws + WS_U + U_MIX);
    att::Args a;
    a.Q = MO; a.ldq = MLA_N; a.K = MO; a.ldk = MLA_N; a.V = MO; a.ldv = MLA_N; a.C = 0.10206207261596575f * LOG2E;
    a.rcos = (const float*)(P.ws + WS_ROPED); a.rsin = a.rcos + SEQ * 16; a.O = MIX; a.ldo = DM; a.g = 0; a.u0 = 0; a.rpb = nullptr; a.lam = 0.f; a.oscale = 1.f; a.subg = nullptr; a.nt_ctx = 4;
    const int nctxu = need_ctx ? 16 : 0, nu = nctxu + 512;
    for (int u = xcd_unit_base(); u < nu; u += gridDim.x) {
        int b, h;
        if (u < nctxu) { b = u >> 2; h = u & 3; a.q_row0 = NLAT + b * CTXL; a.nt_lat = 0; a.rope = 0; }
        else { const int v = u - nctxu; b = v >> 7; h = (v >> 5) & 3; a.q_row0 = b * SEQ + (v & 31) * 256; a.nt_lat = SEQ / 64; a.rope = 2; }
        a.qcol = h * 96; a.kcol = 384 + h * 96; a.vcol = 768 + h * 128; a.ocol = 512 + h * 128; a.kctx_row0 = NLAT + b * CTXL; a.klat_row0 = b * SEQ;
        att::attn_unit<96, 96, 128, 0>(c.lds, a);
    }
}

constexpr int N_PHASES = 2 + 2 * (7 + 9);
__global__ void __launch_bounds__(512, 2) fwd_kernel(Params prm) {
    extern __shared__ __attribute__((aligned(16))) unsigned char lds_raw[];
    LAS unsigned char* lds = (LAS unsigned char*)lds_raw;
    const Ctx c{lds, 0, 0, 0, 0, 0};
    for (int u = threadIdx.x; u < (LDS_BYTES - LDS_MISC) / 4; u += 512) ((LAS unsigned*)(lds + LDS_MISC))[u] = 0u;
    __syncthreads();
    XcdBarrier bar;
    { unsigned char* ws0 = kparams().ws; bar.bar = (unsigned*)(ws0 + WS_CTL) + CW_BAR; bar.x = 0; bar.st = nullptr;
#if !MK_PER_PHASE
      bar = xcd_barrier_post((unsigned*)(ws0 + WS_CTL) + CW_BAR, (volatile LAS unsigned*)(lds + LDS_MISC + 32));
#endif
    }
    int ph = 0;
#ifndef PMASK
#define PMASK 0xffffffffu
#endif
#define PM(b) ((PMASK >> (b)) & 1u)
#define PH_ON() (ph >= kparams().ph_lo && ph < kparams().ph_hi)
#define PH_END() do { if (ph >= kparams().ph_lo && ph + 1 < kparams().ph_hi) xcd_barrier(bar); ++ph; } while (0)
#define WSP(off) ((bf16_t*)(ws + (off)))
#define HB WSP(WS_HB)
#define PB WSP(WS_U + U_PB)
#define MIX WSP(WS_U + U_MIX)
#define YB WSP(WS_U + U_YB)
#define HID WSP(WS_U + U_HID)
#define YS WSP(WS_U + U_YS)
#define A2 WSP(WS_U + U_A2)
#define MO WSP(WS_U + U_MLAO)

    if (PM(0) && PH_ON()) for (int rep = 0; rep < DUPN(0); ++rep) { prologue0(c); __syncthreads(); }
    PH_END();
    if (PM(1) && PH_ON()) for (int rep = 0; rep < DUPN(1); ++rep) ew_first(c);
    PH_END();
    for (int lp = 0; lp < 2; ++lp) {
        {
            const int l = 2 * lp, i = lp; const int mtok = l < 3 ? MTOT : NLAT, nMt = mtok / 256;
            if (PM(2) && PH_ON()) for (int rep = 0; rep < DUPN(2); ++rep) { unsigned char* ws = kparams().ws; pg8::Gemm g{}; g.A = HB; g.lda = DM; g.Bt = (const bf16_t*)(ws + WS_WINE) + (size_t)i * EV_IN * DM; g.K = DM; g.nM = MTOT / 256; g.nN = EV_IN / 256; g.grouped = 0; g.estride = 0;
                pg8::EpiEvenIn E{PB, EV_IN, (f32x2*)(ws + WS_STATS), (const float*)(ws + WS_ROPEB), (const float*)(ws + WS_ROPEB) + SEQ * 32}; gemm_even_in(lds, g, E); if (rep == 0) convert_moe_tail(c, i, 0, 7296, (MTOT / 256) * (EV_IN / 256)); }
            PH_END();
            if (PM(4) && PH_ON()) for (int rep = 0; rep < DUPN(4); ++rep) attn_even(c, l);
            PH_END();
            if (PM(5) && PH_ON()) for (int rep = 0; rep < DUPN(5); ++rep) { unsigned char* ws = kparams().ws; pg8::Gemm g{}; g.A = MIX; g.lda = DM; g.Bt = (const bf16_t*)(ws + WS_WOUTE) + (size_t)i * DM * DM; g.K = DM; g.nM = nMt; g.nN = DM / 256; g.grouped = 0; g.estride = 0;
                gemm_bf16(lds, g, YB, DM); if (rep == 0) convert_moe_tail(c, i, 7296, 14592, nMt * (DM / 256)); }
            PH_END();
            if (PM(6) && PH_ON()) { if (DUPN(6) > 1) ew_mid(c, l, mtok, true); ew_mid(c, l, mtok); }
            PH_END();
            if (PM(7) && PH_ON()) for (int rep = 0; rep < DUPN(7); ++rep) { unsigned char* ws = kparams().ws; pg8::Gemm g{}; g.A = HB; g.lda = DM; g.Bt = (const bf16_t*)(ws + WS_W13E) + (size_t)i * 2 * DFF * DM; g.K = DM; g.nM = nMt; g.nN = 2 * DFF / 256; g.grouped = 0; g.estride = 0;
                gemm_swiglu(lds, g, HID, DFF); if (rep == 0) convert_moe_tail(c, i, 14592, 20224, nMt * (2 * DFF / 256)); }
            PH_END();
            if (PM(8) && PH_ON()) for (int rep = 0; rep < DUPN(8); ++rep) { unsigned char* ws = kparams().ws; pg8::Gemm g{}; g.A = HID; g.lda = DFF; g.Bt = (const bf16_t*)(ws + WS_W2E) + (size_t)i * DM * DFF; g.K = DFF; g.nM = nMt; g.nN = DM / 256; g.grouped = 0; g.estride = 0;
                gemm_bf16(lds, g, YS, DM); if (rep == 0) convert_moe_tail(c, i, 20224, MOE_CVT_ITEMS, nMt * (DM / 256)); }
            PH_END();
            if (PM(9) && PH_ON()) { if (DUPN(9) > 1) ew_last(c, l, mtok, true); ew_last(c, l, mtok); }
            PH_END();
        }
        {
            const int l = 2 * lp + 1, i = lp; const int mtok = l < 3 ? MTOT : NLAT, nMt = mtok / 256;
            if (PM(10) && PH_ON()) for (int rep = 0; rep < DUPN(10); ++rep) { unsigned char* ws = kparams().ws; pg8::Gemm g{}; g.A = HB; g.lda = DM; g.Bt = (const bf16_t*)(ws + WS_WINO) + (size_t)i * OD_INP * DM; g.K = DM; g.nM = MTOT / 256; g.nN = OD_INP / 256; g.grouped = 0; g.estride = 0;
                pg8::EpiOddIn E{PB, OD_INP, (float*)(ws + WS_STATS), (const float*)(ws + WS_ROPED), (const float*)(ws + WS_ROPED) + SEQ * 16}; gemm_odd_in(lds, g, E); }
            PH_END();
            if (PM(12) && PH_ON()) for (int rep = 0; rep < DUPN(12); ++rep) { unsigned char* ws = kparams().ws; pg8::Gemm g{}; g.A = PB + 1536; g.lda = OD_INP; g.Bt = (const bf16_t*)(ws + WS_WMLA) + (size_t)i * MLA_N * MLA_K; g.K = MLA_K; g.nM = MTOT / 256; g.nN = MLA_N / 256; g.grouped = 0; g.estride = 0;
                pg8::EpiMlaUp E{MO, MLA_N, (const float*)(ws + WS_STATS)}; gemm_mla_up(lds, g, E); }
            PH_END();
            if (PH_ON()) { if (PM(13)) for (int rep = 0; rep < DUPN(13); ++rep) attn_odd_na(c, l); if (PM(14)) for (int rep = 0; rep < DUPN(14); ++rep) attn_odd_mla(c, l); }
            PH_END();
            if (PM(15) && PH_ON()) for (int rep = 0; rep < DUPN(15); ++rep) { unsigned char* ws = kparams().ws; pg8::Gemm g{}; g.A = MIX; g.lda = DM; g.Bt = (const bf16_t*)(ws + WS_WOUTO) + (size_t)i * DM * DM; g.K = DM; g.nM = nMt; g.nN = DM / 256; g.grouped = 0; g.estride = 0;
                gemm_bf16(lds, g, YB, DM); }
            PH_END();
            if (PM(16) && PH_ON()) { if (DUPN(16) > 1) ew_mid(c, l, mtok, true); ew_mid(c, l, mtok); }
            PH_END();
            if (PM(17) && PH_ON()) for (int rep = 0; rep < DUPN(17); ++rep) moe_gather(c, i, mtok);
            PH_END();
            if (PM(18) && PH_ON()) for (int rep = 0; rep < DUPN(18); ++rep) { unsigned char* ws = kparams().ws; pg8::Gemm g{}; g.A = YS; g.lda = DM; g.Bt = (const bf16_t*)(ws + WS_W13M); g.K = DM; g.nN = 2 * DFFE / 256; g.grouped = 1; g.estride = (size_t)2 * DFFE * DM;
                moe_offsets(kparams(), i, g.toff); g.nM = g.toff[8];
#if MOE_F8
                gemm8_swiglu8(lds, g, (unsigned char*)HID, DFFE);
#else
                gemm_swiglu(lds, g, HID, DFFE);
#endif
            }
            PH_END();
            if (PM(19) && PH_ON()) for (int rep = 0; rep < DUPN(19); ++rep) { unsigned char* ws = kparams().ws; pg8::Gemm g{}; g.A = HID; g.lda = DFFE; g.Bt = (const bf16_t*)(ws + WS_W2M); g.K = DFFE; g.nN = DM / 256; g.grouped = 1; g.estride = (size_t)DM * DFFE;
                moe_offsets(kparams(), i, g.toff); g.nM = g.toff[8];
#if MOE_F8
                gemm8_bf16(lds, g, YS, DM);
#else
                gemm_bf16(lds, g, YS, DM);
#endif
            }
            PH_END();
            if (PM(20) && PH_ON()) { if (DUPN(20) > 1) ew_last(c, l, mtok, true); ew_last(c, l, mtok); }
            PH_END();
        }
    }
#undef PH_ON
#undef PH_END
#undef HB
#undef PB
#undef MIX
#undef YB
#undef HID
#undef YS
#undef A2
#undef MO
}

extern "C" void kernel_launch(void* const* d_in, const int* in_sizes, int n_in, void* d_out, int out_size, void* d_ws, size_t ws_size, hipStream_t stream) {
    static int grid = 0;
    if (grid == 0) {
        int dev = 0, cus = 0;
        if (n_in != 31 || out_size != NLAT * DM || ws_size < WS_END) { fprintf(stderr, "kernel_launch: unexpected shapes or workspace (n_in %d out %d ws %zu need %zu)\n", n_in, out_size, ws_size, (size_t)WS_END); grid = -1; }
        else if (hipGetDevice(&dev) != hipSuccess || hipDeviceGetAttribute(&cus, hipDeviceAttributeMultiprocessorCount, dev) != hipSuccess) grid = -1;
        else if (hipFuncSetAttribute((const void*)fwd_kernel, hipFuncAttributeMaxDynamicSharedMemorySize, LDS_BYTES) != hipSuccess) grid = -1;
        else { int per_cu = 0; (void)hipOccupancyMaxActiveBlocksPerMultiprocessor(&per_cu, (const void*)fwd_kernel, 512, LDS_BYTES); (void)hipGetLastError(); grid = cus; }
    }
    if (grid < 0) { (void)hipMemsetAsync(d_out, 0, (size_t)out_size * 4, stream); return; }
    (void)hipMemsetAsync((char*)d_ws + WS_CTL, 0, CTL_BYTES, stream);
    Params p{};
    for (int i = 0; i < 31; ++i) p.in[i] = (const float*)d_in[i];
    p.out = (float*)d_out; p.ws = (unsigned char*)d_ws;
#if MK_PER_PHASE
    for (int k = 0; k < N_PHASES; ++k) { p.ph_lo = k; p.ph_hi = k + 1; hipLaunchKernelGGL(fwd_kernel, dim3(grid), dim3(512), LDS_BYTES, stream, p); }
#else
    p.ph_lo = 0; p.ph_hi = N_PHASES;
    hipLaunchKernelGGL(fwd_kernel, dim3(grid), dim3(512), LDS_BYTES, stream, p);
#endif
}
```

```cpp
#include <hip/hip_runtime.h>
#include <stdint.h>
#include <stdio.h>

#ifndef MK_PER_PHASE
#define MK_PER_PHASE 0
#endif
#ifndef DUP_MASK
#define DUP_MASK 0u
#endif
#define DUPN(b) (1 + (int)((DUP_MASK >> (b)) & 1u))
#ifndef ATT_X
#define ATT_X 0
#endif
#ifndef FFN_F8
#define FFN_F8 1
#endif
#ifndef FFN_F8_FROM
#define FFN_F8_FROM 1
#endif
#define FFN8(i) (FFN_F8 && (i) >= FFN_F8_FROM)
#ifndef MOE_F8
#define MOE_F8 1
#endif

#define LAS __attribute__((address_space(3)))
typedef unsigned short bf16_t;
typedef short bf16x8 __attribute__((ext_vector_type(8)));
typedef short s16x4 __attribute__((ext_vector_type(4)));
typedef float f32x4 __attribute__((ext_vector_type(4)));
typedef float f32x2 __attribute__((ext_vector_type(2)));
typedef float f32x16 __attribute__((ext_vector_type(16)));
typedef unsigned u32x4 __attribute__((ext_vector_type(4)));
typedef unsigned u32x2 __attribute__((ext_vector_type(2)));

constexpr int DM = 1024, NB = 4, SEQ = 8192, NLAT = NB * SEQ, CTXL = 256, NCTX = NB * CTXL, MTOT = NLAT + NCTX;
constexpr int NMOD = 6;
constexpr int EV_IN = 2560, OD_IN = 1952, OD_INP = 2048, DFF = 2816, DFFE = 3584, NEXP = 8;
constexpr int MLA_N = 1280, MLA_K = 512;
constexpr int MS_MAX = 2 * MTOT + NEXP * 256;
constexpr float EPS = 1e-6f;
constexpr float LOG2E = 1.4426950408889634f;

constexpr size_t MiB = (size_t)1 << 20;
constexpr size_t WS_CTL = 0, CTL_BYTES = MiB;
constexpr size_t WS_MODS = 1 * MiB;
constexpr size_t WS_ROPEB = 2 * MiB;
constexpr size_t WS_ROPED = 4 * MiB;
constexpr size_t WS_SGUW = 5 * MiB;
constexpr size_t WS_TOKINFO = 6 * MiB;
constexpr size_t WS_TOKPOS = 8 * MiB;
constexpr size_t WS_CTXX = 10 * MiB;
constexpr size_t WS_WMLA = 14 * MiB;
constexpr size_t WS_WINE = 17 * MiB;
constexpr size_t WS_WOUTE = 27 * MiB;
constexpr size_t WS_W13E = 31 * MiB;
constexpr size_t WS_W2E = 53 * MiB;
constexpr size_t WS_WINO = 64 * MiB;
constexpr size_t WS_WOUTO = 72 * MiB;
constexpr size_t WS_W13M = 76 * MiB;
constexpr size_t WS_W2M = 188 * MiB;
constexpr size_t WS_HB = 244 * MiB;
constexpr size_t WS_U = 310 * MiB;
constexpr size_t U_PB = 0;
constexpr size_t U_MIX = 165 * MiB;
constexpr size_t U_A2 = 231 * MiB;
constexpr size_t U_MLAO = 264 * MiB;
constexpr size_t U_YB = 347 * MiB;
constexpr size_t U_HID = 0;
constexpr size_t U_XB = 549 * MiB;
constexpr size_t U_YS = 413 * MiB;
constexpr size_t WS_STATS = WS_U + 616 * MiB;
constexpr size_t WS_END = WS_STATS + 4 * MiB;
static_assert((size_t)MS_MAX * DFFE * (MOE_F8 ? 1 : 2) <= 347 * MiB && (size_t)MTOT * DFF * 2 <= 347 * MiB, "hid must stay clear of YB");
static_assert(U_YS + (size_t)MS_MAX * DM * 2 <= U_XB && U_XB + (size_t)MTOT * DM * 2 <= 616 * MiB, "ys / xb fit");

constexpr int CW_BAR = 4096;
constexpr int CW_MOECNT = 1024;

constexpr int LDS_BYTES = 147456;
constexpr int LDS_MISC = 131072;

__device__ __forceinline__ unsigned cvtpk(float lo, float hi) { unsigned r; asm volatile("v_cvt_pk_bf16_f32 %0, %1, %2" : "=v"(r) : "v"(lo), "v"(hi)); return r; }
__device__ __forceinline__ float bf2f(unsigned short b) { return __uint_as_float(((unsigned)b) << 16); }
__device__ __forceinline__ float bflo(unsigned w) { return __uint_as_float(w << 16); }
__device__ __forceinline__ float bfhi(unsigned w) { return __uint_as_float(w & 0xffff0000u); }
__device__ __forceinline__ bf16_t f2bf(float f) { return (bf16_t)(cvtpk(f, 0.f) & 0xffffu); }
typedef int i32x8 __attribute__((ext_vector_type(8)));
typedef int i32x4 __attribute__((ext_vector_type(4)));
constexpr float F8_ACT_SCALE = 4.f, F8_W_SCALE = 64.f, F8_INV = 1.f / (F8_ACT_SCALE * F8_W_SCALE);
__device__ __forceinline__ unsigned pk4_fp8(float a, float b, float c, float d) {
    a = __builtin_amdgcn_fmed3f(a, -448.f, 448.f); b = __builtin_amdgcn_fmed3f(b, -448.f, 448.f); c = __builtin_amdgcn_fmed3f(c, -448.f, 448.f); d = __builtin_amdgcn_fmed3f(d, -448.f, 448.f);
    int w = 0; w = __builtin_amdgcn_cvt_pk_fp8_f32(a, b, w, false); w = __builtin_amdgcn_cvt_pk_fp8_f32(c, d, w, true); return (unsigned)w; }
__device__ __forceinline__ float wave_sum(float v) {
#pragma unroll
    for (int o = 1; o < 64; o <<= 1) v += __shfl_xor(v, o);
    return v;
}
__device__ __forceinline__ float fast_exp2(float x) { return __builtin_amdgcn_exp2f(x); }
__device__ __forceinline__ float fast_rcp(float x) { return __builtin_amdgcn_rcpf(x); }
__device__ __forceinline__ float silu_f(float x) { return x * fast_rcp(1.f + fast_exp2(-x * LOG2E)); }
__device__ __forceinline__ float gelu_tanh_f(float x) { const float u = 0.7978845608028654f * (x + 0.044715f * x * x * x); return x * fast_rcp(1.f + fast_exp2(-2.f * LOG2E * u)); }
#define LDS_WAIT() asm volatile("s_waitcnt lgkmcnt(0)" ::: "memory")
#define VM_WAIT() asm volatile("s_waitcnt vmcnt(0)" ::: "memory")
__device__ __forceinline__ int opaque_bid() { int b = blockIdx.x; asm volatile("" : "+s"(b)); return b; }
__device__ __forceinline__ int xcd_unit_base() { const int b = opaque_bid(), G = (int)gridDim.x; return (G % 8 == 0) ? (b & 7) * (G >> 3) + (b >> 3) : b; }
__device__ __forceinline__ int opaque_tid() { int t = threadIdx.x; asm volatile("" : "+v"(t)); return t; }

#define XB_TMO      128
#define XB_XCNT(j)  (256  + 64 * (j))
#define XB_XSUB(j)  (1280 + 64 * (j))
#define XB_XGEN(j)  (2304 + 64 * (j))
#define XB_TOP      3328
#define XB_TOPGEN   3392
#define XCD_BAR_WORDS 3456
#define XB_SPIN_CAP (1u << 22)
__device__ __forceinline__ unsigned xb_ld(unsigned* p)              { return __hip_atomic_load(p, __ATOMIC_RELAXED, __HIP_MEMORY_SCOPE_AGENT); }
__device__ __forceinline__ unsigned xb_add(unsigned* p, unsigned v) { return __hip_atomic_fetch_add(p, v, __ATOMIC_RELAXED, __HIP_MEMORY_SCOPE_AGENT); }
__device__ __forceinline__ unsigned xb_xcc_id() { return (unsigned)__builtin_amdgcn_s_getreg((3 << 11) | 20) & 0xFu; }
#define XB_SPIN(cond, bar) do { unsigned _sp = 0; while (cond) { __builtin_amdgcn_s_sleep(1); \
    if ((++_sp & 255u) == 0u) { if (xb_ld(&(bar)[XB_TMO])) break; if (_sp > XB_SPIN_CAP) { atomicAdd(&(bar)[XB_TMO], 1u); break; } } } } while (0)
struct XcdBarrier { unsigned* bar; unsigned x; volatile LAS unsigned* st; };
__device__ __forceinline__ XcdBarrier xcd_barrier_post(unsigned* bar, volatile LAS unsigned* st) {
    XcdBarrier b; b.bar = bar; b.x = xb_xcc_id(); b.st = st;
    if (threadIdx.x == 0) (void)xb_add(&bar[XB_XCNT(b.x)], 1u);
    return b;
}
__device__ __forceinline__ void xcd_barrier_complete(unsigned* bar, unsigned x, unsigned& nloc, unsigned& nx) {
    const unsigned G = gridDim.x * gridDim.y * gridDim.z;
    unsigned sum, cnt, mine, sp = 0u;
    for (;;) {
        sum = 0u; cnt = 0u; mine = 0u;
#pragma unroll
        for (unsigned j = 0; j < 16; ++j) { const unsigned c = xb_ld(&bar[XB_XCNT(j)]); sum += c; cnt += (c > 0u) ? 1u : 0u; mine = (j == x) ? c : mine; }
        if (sum == G) break;
        __builtin_amdgcn_s_sleep(1);
        if ((++sp & 255u) == 0u) { if (xb_ld(&bar[XB_TMO])) break; if (sp > XB_SPIN_CAP) { atomicAdd(&bar[XB_TMO], 1u); break; } }
    }
    nloc = mine > 0u ? mine : 1u; nx = cnt > 0u ? cnt : 1u;
}
__device__ __forceinline__ void xcd_barrier(const XcdBarrier& b) {
    asm volatile("s_waitcnt vmcnt(0)" ::: "memory");
    __syncthreads();
    if (threadIdx.x == 0) {
        unsigned* bar = b.bar;
        __builtin_amdgcn_s_waitcnt(0);
        unsigned nloc = b.st[0], nx = b.st[1];
        if (nloc == 0u) { xcd_barrier_complete(bar, b.x, nloc, nx); b.st[0] = nloc; b.st[1] = nx; }
        const unsigned old = xb_add(&bar[XB_XSUB(b.x)], 1u);
        const unsigned gen = old / nloc;
        if (old + 1u == (gen + 1u) * nloc) {
            __builtin_amdgcn_fence(__ATOMIC_RELEASE, "agent");
            asm volatile("s_waitcnt vmcnt(0)" ::: "memory");
            const unsigned og = xb_add(&bar[XB_TOP], 1u);
            const unsigned tg = og / nx;
            if (og + 1u == (tg + 1u) * nx) xb_add(&bar[XB_TOPGEN], 1u);
            else XB_SPIN(xb_ld(&bar[XB_TOPGEN]) == tg, bar);
            __builtin_amdgcn_fence(__ATOMIC_ACQUIRE, "agent");
            xb_add(&bar[XB_XGEN(b.x)], 1u);
            asm volatile("s_waitcnt vmcnt(0)" ::: "memory");
        } else {
            XB_SPIN(xb_ld(&bar[XB_XGEN(b.x)]) == gen, bar);
            __builtin_amdgcn_fence(__ATOMIC_ACQUIRE, "agent");
            asm volatile("s_waitcnt vmcnt(0)" ::: "memory");
        }
    }
    __syncthreads();
}

namespace pg8 {
constexpr int BM = 256, BK = 64, HALF = 128, HTB = HALF * BK * 2, STAGE_BYTES = 8 * HTB, NXCD = 8, WGM = 8;
__device__ __forceinline__ int lds_byte(int r, int c) { const int st = (r >> 4) * 2 + (c >> 5), rr = r & 15, cc = c & 31, ob = rr * 64 + cc * 2; return st * 1024 + (ob ^ (((ob >> 9) & 1) << 5)); }
__device__ __forceinline__ void stage_rc(int b, int& R, int& C) { const int st = b / 1024, sb = b % 1024, swz = sb ^ (((sb >> 9) & 1) << 5); R = (st >> 1) * 16 + swz / 64; C = (st & 1) * 32 + (swz % 64) / 2; }
__device__ __forceinline__ int perm32(int rho) { const int n = rho >> 4, i = rho & 15; return 8 * (i >> 2) + 4 * n + (i & 3); }
struct Unit { int pm, pn, e; };
struct Gemm {
    const void* A; int lda;
    const void* Bt; int K;
    int nM, nN;
    int grouped; int toff[9]; size_t estride;
};
struct StaticOrder {
    int nM, nN, nwg, G, c;
    __device__ void init(int nM_, int nN_, int G_, int c_) { nM = nM_; nN = nN_; nwg = nM * nN; G = G_; c = c_; }
    __device__ __forceinline__ bool next(int i, Unit& u) const {
        const long L = (long)i * G + c; if (L >= nwg) return false;
        int wgid = (int)L; { const int q = nwg / NXCD, r = nwg % NXCD, xcd = wgid % NXCD, off = wgid / NXCD; wgid = (xcd < r ? xcd * (q + 1) : r * (q + 1) + (xcd - r) * q) + off; }
        const int nig = WGM * nN, gid = wgid / nig, fm = gid * WGM, gsz = (nM - fm) < WGM ? (nM - fm) : WGM;
        u.pm = fm + ((wgid % nig) % gsz); u.pn = (wgid % nig) / gsz; u.e = 0; return true;
    }
};
struct EpiBf16 {
    bf16_t* O; int ldc; float scale;
    __device__ __forceinline__ void operator()(const f32x4 (&acc)[2][2][4][2], const Unit& u, int wr, int wc, int fr, int fq) const {
        const int row0 = u.pm * BM + wr * 64 + fr, col0 = u.pn * BM + wc * 32 + 8 * fq;
#pragma unroll
        for (int ai = 0; ai < 2; ++ai)
#pragma unroll
            for (int m = 0; m < 4; ++m) { bf16_t* rowp = O + (size_t)(row0 + ai * HALF + m * 16) * ldc + col0;
#pragma unroll
                for (int bj = 0; bj < 2; ++bj) { const f32x4 v0 = acc[ai][bj][m][0] * scale, v1 = acc[ai][bj][m][1] * scale;
                    u32x4 w; w.x = cvtpk(v0[0], v0[1]); w.y = cvtpk(v0[2], v0[3]); w.z = cvtpk(v1[0], v1[1]); w.w = cvtpk(v1[2], v1[3]);
                    *(u32x4*)(rowp + bj * HALF) = w; } }
    }
};
struct EpiSwiGLU {
    bf16_t* O; int ldc;
    __device__ __forceinline__ void operator()(const f32x4 (&acc)[2][2][4][2], const Unit& u, int wr, int wc, int fr, int fq) const {
        const int row0 = u.pm * BM + wr * 64 + fr, col0 = u.pn * HALF + wc * 32 + 8 * fq;
#pragma unroll
        for (int ai = 0; ai < 2; ++ai)
#pragma unroll
            for (int m = 0; m < 4; ++m) { bf16_t* rowp = O + (size_t)(row0 + ai * HALF + m * 16) * ldc + col0;
                float r[8];
#pragma unroll
                for (int n = 0; n < 2; ++n)
#pragma unroll
                    for (int j = 0; j < 4; ++j) r[n * 4 + j] = silu_f(acc[ai][0][m][n][j]) * acc[ai][1][m][n][j];
                u32x4 w; w.x = cvtpk(r[0], r[1]); w.y = cvtpk(r[2], r[3]); w.z = cvtpk(r[4], r[5]); w.w = cvtpk(r[6], r[7]);
                *(u32x4*)rowp = w; }
    }
};

struct EpiEvenIn {
    bf16_t* O; int ldc; f32x2* stats; const float* rcos; const float* rsin;
    __device__ __forceinline__ void operator()(const f32x4 (&acc)[2][2][4][2], const Unit& u, int wr, int wc, int fr, int fq) const {
        int upm = u.pm, upn = u.pn; asm volatile("" : "+s"(upm), "+s"(upn));
        const int row0 = upm * BM + wr * 64 + fr, col0 = upn * BM + wc * 32 + 8 * fq;
        const int kind = upn < 2 ? 0 : (upn < 4 ? 1 : (upn < 8 ? 2 : 3)); const bool lat = upm < NLAT / BM; const int t4 = 4 * (4 * (wc & 1) + fq);
#pragma unroll
        for (int ai = 0; ai < 2; ++ai)
#pragma unroll
            for (int m = 0; m < 4; ++m) { const int row = row0 + ai * HALF + m * 16; bf16_t* rowp = O + (size_t)row * ldc + col0;
                f32x4 cs = {1.f, 1.f, 1.f, 1.f}, sn = {0.f, 0.f, 0.f, 0.f}; float s1 = 0.f, s2 = 0.f;
                if (kind == 2 && lat) { const int sp = row & (SEQ - 1); cs = *(const f32x4*)(rcos + sp * 32 + t4); sn = *(const f32x4*)(rsin + sp * 32 + t4); }
#pragma unroll
                for (int bj = 0; bj < 2; ++bj) { f32x4 v0 = acc[ai][bj][m][0], v1 = acc[ai][bj][m][1];
                    if (kind < 2) {
#pragma unroll
                        for (int j = 0; j < 4; ++j) { v0[j] = gelu_tanh_f(v0[j]); v1[j] = gelu_tanh_f(v1[j]); }
                        if (kind == 1) { s1 += (v0[0] + v0[1]) + (v0[2] + v0[3]) + (v1[0] + v1[1]) + (v1[2] + v1[3]);
                            s2 += (v0[0] * v0[0] + v0[1] * v0[1]) + (v0[2] * v0[2] + v0[3] * v0[3]) + (v1[0] * v1[0] + v1[1] * v1[1]) + (v1[2] * v1[2] + v1[3] * v1[3]); } }
                    else if (kind == 2) { const f32x4 o0 = v0 * cs - v1 * sn, o1 = v1 * cs + v0 * sn; v0 = o0; v1 = o1; }
                    u32x4 w; w.x = cvtpk(v0[0], v0[1]); w.y = cvtpk(v0[2], v0[3]); w.z = cvtpk(v1[0], v1[1]); w.w = cvtpk(v1[2], v1[3]);
                    *(u32x4*)(rowp + bj * HALF) = w; }
                if (kind == 1) { s1 += __shfl_xor(s1, 16); s1 += __shfl_xor(s1, 32); s2 += __shfl_xor(s2, 16); s2 += __shfl_xor(s2, 32);
                    if (fq == 0) stats[(size_t)row * 8 + (upn - 2) * 4 + wc] = (f32x2){s1, s2}; } }
    }
};
struct EpiOddIn {
    bf16_t* O; int ldc; float* stats; const float* rcos; const float* rsin;
    __device__ __forceinline__ void operator()(const f32x4 (&acc)[2][2][4][2], const Unit& u, int wr, int wc, int fr, int fq) const {
        int upm = u.pm, upn = u.pn; asm volatile("" : "+s"(upm), "+s"(upn));
        const int row0 = upm * BM + wr * 64 + fr, col0 = upn * BM + wc * 32 + 8 * fq; const bool lat = upm < NLAT / BM;
#pragma unroll
        for (int ai = 0; ai < 2; ++ai)
#pragma unroll
            for (int m = 0; m < 4; ++m) { const int row = row0 + ai * HALF + m * 16; bf16_t* rowp = O + (size_t)row * ldc + col0; float ss = 0.f;
#pragma unroll
                for (int bj = 0; bj < 2; ++bj) { f32x4 v0 = acc[ai][bj][m][0], v1 = acc[ai][bj][m][1];
                    if (upn == 6 || (upn == 7 && bj == 0)) ss += (v0[0] * v0[0] + v0[1] * v0[1]) + (v0[2] * v0[2] + v0[3] * v0[3]) + (v1[0] * v1[0] + v1[1] * v1[1]) + (v1[2] * v1[2] + v1[3] * v1[3]);
                    if (upn == 7 && bj == 1 && wc == 0 && lat) { const int sp = row & (SEQ - 1); const f32x4 cs = *(const f32x4*)(rcos + sp * 16 + 4 * fq), sn = *(const f32x4*)(rsin + sp * 16 + 4 * fq);
                        const f32x4 o0 = v0 * cs - v1 * sn, o1 = v1 * cs + v0 * sn; v0 = o0; v1 = o1; }
                    u32x4 w; w.x = cvtpk(v0[0], v0[1]); w.y = cvtpk(v0[2], v0[3]); w.z = cvtpk(v1[0], v1[1]); w.w = cvtpk(v1[2], v1[3]);
                    *(u32x4*)(rowp + bj * HALF) = w; }
                if (upn >= 6) { ss += __shfl_xor(ss, 16); ss += __shfl_xor(ss, 32); if (fq == 0) stats[(size_t)row * 8 + (upn - 6) * 4 + wc] = ss; } }
    }
};
struct EpiMlaUp {
    bf16_t* O; int ldc; const float* stats;
    __device__ __forceinline__ void operator()(const f32x4 (&acc)[2][2][4][2], const Unit& u, int wr, int wc, int fr, int fq) const {
        const int row0 = u.pm * BM + wr * 64 + fr, col0 = u.pn * BM + wc * 32 + 8 * fq;
#pragma unroll
        for (int ai = 0; ai < 2; ++ai)
#pragma unroll
            for (int m = 0; m < 4; ++m) { const int row = row0 + ai * HALF + m * 16; bf16_t* rowp = O + (size_t)row * ldc + col0;
                const f32x4 pq = *(const f32x4*)(stats + (size_t)row * 8), pk = *(const f32x4*)(stats + (size_t)row * 8 + 4);
                const float rq = rsqrtf(((pq[0] + pq[1]) + (pq[2] + pq[3])) * (1.f / 256.f) + EPS), rk = rsqrtf(((pk[0] + pk[1]) + (pk[2] + pk[3])) * (1.f / 128.f) + EPS);
#pragma unroll
                for (int bj = 0; bj < 2; ++bj) { const int c0 = col0 + bj * HALF; const float sc = c0 < 384 ? rq : (c0 < 768 ? (((c0 - 384) % 96) < 64 ? rk : 1.f) : rk);
                    const f32x4 v0 = acc[ai][bj][m][0] * sc, v1 = acc[ai][bj][m][1] * sc;
                    u32x4 w; w.x = cvtpk(v0[0], v0[1]); w.y = cvtpk(v0[2], v0[3]); w.z = cvtpk(v1[0], v1[1]); w.w = cvtpk(v1[2], v1[3]);
                    *(u32x4*)(rowp + bj * HALF) = w; } }
    }
};
struct EpiSwiGLU8 {
    unsigned char* O; int ldc; float scale;
    __device__ __forceinline__ void operator()(const f32x4 (&acc)[2][2][4][2], const Unit& u, int wr, int wc, int fr, int fq) const {
        const int row0 = u.pm * BM + wr * 64 + fr, col0 = u.pn * HALF + wc * 32 + 8 * fq;
#pragma unroll
        for (int ai = 0; ai < 2; ++ai)
#pragma unroll
            for (int m = 0; m < 4; ++m) { unsigned char* rowp = O + (size_t)(row0 + ai * HALF + m * 16) * ldc + col0;
                float r[8];
#pragma unroll
                for (int n = 0; n < 2; ++n)
#pragma unroll
                    for (int j = 0; j < 4; ++j) r[n * 4 + j] = F8_ACT_SCALE * silu_f(acc[ai][0][m][n][j] * scale) * (acc[ai][1][m][n][j] * scale);
                u32x2 w; w.x = pk4_fp8(r[0], r[1], r[2], r[3]); w.y = pk4_fp8(r[4], r[5], r[6], r[7]);
                *(u32x2*)rowp = w; }
    }
};

template <class Epi, bool F8 = false>
__device__ __forceinline__ void gemm_phase(LAS unsigned char* lds, const Gemm& g, const Epi& E) {
    const int tid = opaque_tid(), wid = __builtin_amdgcn_readfirstlane(tid >> 6), lane = tid & 63, wr = wid >> 2, wc = wid & 3, fr = lane & 15, fq = lane >> 4;
    constexpr int ES = F8 ? 1 : 2;
    const int K = g.K, nt = K * ES / (BK * 2), lda = g.lda;
    StaticOrder S; S.init(g.nM, g.nN, (int)gridDim.x, opaque_bid());
    unsigned voffA[2], voffB[2];
#pragma unroll
    for (int i = 0; i < 2; ++i) { int R, C; stage_rc(tid * 16 + i * 8192, R, C); const int Rb = (R & ~31) + perm32(R & 31);
        voffA[i] = (unsigned)(R * lda * ES + C * 2); voffB[i] = (unsigned)(Rb * K * ES + C * 2); }
    const size_t kstep = (size_t)(BK * 2);
    const size_t hA = (size_t)HALF * lda * ES, tA = 2 * hA, hB = (size_t)HALF * K * ES, tB = 2 * hB;
    const unsigned ldsw = (unsigned)wid * 1024u;
    const int aoff = lds_byte(wr * 64 + fr, fq * 8), boff = lds_byte(wc * 32 + fr, fq * 8);
#define PG8_SA(b, h) (((b) * 2 + (h)) * HTB)
#define PG8_SB(b, h) ((4 + (b) * 2 + (h)) * HTB)
#define PG8_STAGE(bufoff, gbase, voff) do { _Pragma("unroll") for (int _i = 0; _i < 2; ++_i) \
        __builtin_amdgcn_global_load_lds((const unsigned*)((const char*)(gbase) + (voff)[_i]), (LAS unsigned*)(lds + (bufoff) + ldsw + _i * 8192), 16, 0, 0); } while (0)
#define PG8_LD8(base) __builtin_shufflevector(*(const LAS i32x4*)(base), *(const LAS i32x4*)((base) + 1024), 0, 1, 2, 3, 4, 5, 6, 7)
#define PG8_LDA(dst, b, h) do { _Pragma("unroll") for (int m = 0; m < 4; ++m) dst[m] = PG8_LD8(lds + PG8_SA(b, h) + aoff + m * 2048); } while (0)
#define PG8_LDB(dst, b, h) do { _Pragma("unroll") for (int n = 0; n < 2; ++n) dst[n] = PG8_LD8(lds + PG8_SB(b, h) + boff + n * 2048); } while (0)
#define PG8_H0(x) __builtin_bit_cast(bf16x8, __builtin_shufflevector(x, x, 0, 1, 2, 3))
#define PG8_H1(x) __builtin_bit_cast(bf16x8, __builtin_shufflevector(x, x, 4, 5, 6, 7))
#define PG8_MMA(ai, bj, At, Bt) do { __builtin_amdgcn_s_setprio(1); _Pragma("unroll") for (int m = 0; m < 4; ++m) _Pragma("unroll") for (int n = 0; n < 2; ++n) { \
        if constexpr (F8) asm volatile("v_mfma_f32_16x16x128_f8f6f4 %0, %1, %2, %0" : "+v"(acc[ai][bj][m][n]) : "v"(Bt[n]), "v"(At[m])); \
        else { acc[ai][bj][m][n] = __builtin_amdgcn_mfma_f32_16x16x32_bf16(PG8_H0(Bt[n]), PG8_H0(At[m]), acc[ai][bj][m][n], 0, 0, 0); \
               acc[ai][bj][m][n] = __builtin_amdgcn_mfma_f32_16x16x32_bf16(PG8_H1(Bt[n]), PG8_H1(At[m]), acc[ai][bj][m][n], 0, 0, 0); } } \
        __builtin_amdgcn_s_setprio(0); } while (0)
#define PG8_WAIT_V(n) asm volatile("s_waitcnt vmcnt(" #n ")" ::: "memory")
#define PG8_WAIT_L(n) asm volatile("s_waitcnt lgkmcnt(" #n ")" ::: "memory")
#define PG8_BAR __builtin_amdgcn_s_barrier()
#define PG8_SCHED __builtin_amdgcn_sched_barrier(0)
#define PG8_EXPERT(u) do { if (g.grouped) { int _e = 0; _Pragma("unroll") for (int _k = 1; _k < 8; ++_k) _e += ((u).pm >= g.toff[_k]) ? 1 : 0; (u).e = _e; } } while (0)
    Unit cur, nxt; int ui = 0;
    if (!S.next(0, cur)) return;
    PG8_EXPERT(cur);
    f32x4 acc[2][2][4][2];
#pragma unroll
    for (int a = 0; a < 2; ++a)
#pragma unroll
        for (int b = 0; b < 2; ++b)
#pragma unroll
            for (int m = 0; m < 4; ++m)
#pragma unroll
                for (int n = 0; n < 2; ++n) acc[a][b][m][n] = (f32x4){0.f, 0.f, 0.f, 0.f};
    i32x8 At[4], B0[2], B1[2];
    const char* cA = (const char*)g.A + (size_t)cur.pm * tA; const char* cB = ((const char*)g.Bt + (size_t)cur.e * g.estride * ES) + (size_t)cur.pn * tB;
    PG8_STAGE(PG8_SB(0, 0), cB, voffB); PG8_STAGE(PG8_SA(0, 0), cA, voffA); PG8_STAGE(PG8_SB(0, 1), cB + hB, voffB); PG8_STAGE(PG8_SA(0, 1), cA + hA, voffA);
    if (wr == 1) PG8_BAR;
    PG8_WAIT_V(4); PG8_BAR;
    PG8_STAGE(PG8_SB(1, 0), cB + kstep, voffB); PG8_STAGE(PG8_SA(1, 0), cA + kstep, voffA); PG8_STAGE(PG8_SB(1, 1), cB + hB + kstep, voffB);
    PG8_WAIT_V(6); PG8_BAR;
    for (;;) {
        const bool has_next = S.next(ui + 1, nxt);
        if (has_next) PG8_EXPERT(nxt);
        const char* nA = has_next ? (const char*)g.A + (size_t)nxt.pm * tA : cA; const char* nB = has_next ? ((const char*)g.Bt + (size_t)nxt.e * g.estride * ES) + (size_t)nxt.pn * tB : cB;
        for (int t = 0; t < nt; t += 2) {
            const bool last = (t == nt - 2);
            const char* a1 = cA + (size_t)(t + 1) * kstep;
            const char* a2 = last ? nA : cA + (size_t)(t + 2) * kstep; const char* b2 = last ? nB : cB + (size_t)(t + 2) * kstep;
            const char* a3 = a2 + kstep; const char* b3 = b2 + kstep;
            PG8_LDB(B0, 0, 0); PG8_SCHED; PG8_LDA(At, 0, 0); PG8_STAGE(PG8_SA(1, 1), a1 + hA, voffA);
            PG8_WAIT_L(8); PG8_BAR; PG8_WAIT_L(0); PG8_MMA(0, 0, At, B0); PG8_BAR; PG8_SCHED;
            PG8_LDB(B1, 0, 1); PG8_STAGE(PG8_SB(0, 0), b2, voffB);
            PG8_BAR; PG8_WAIT_L(0); PG8_MMA(0, 1, At, B1); PG8_BAR;
            PG8_LDA(At, 0, 1); PG8_STAGE(PG8_SA(0, 0), a2, voffA);
            PG8_BAR; PG8_WAIT_L(0); PG8_MMA(1, 0, At, B0); PG8_BAR; PG8_SCHED;
            PG8_STAGE(PG8_SB(0, 1), b2 + hB, voffB);
            PG8_WAIT_V(6); PG8_BAR; PG8_MMA(1, 1, At, B1); PG8_BAR;
            PG8_LDB(B0, 1, 0); PG8_SCHED; PG8_LDA(At, 1, 0); PG8_STAGE(PG8_SA(0, 1), a2 + hA, voffA);
            PG8_WAIT_L(8); PG8_BAR; PG8_WAIT_L(0); PG8_MMA(0, 0, At, B0); PG8_BAR; PG8_SCHED;
            PG8_LDB(B1, 1, 1); PG8_STAGE(PG8_SB(1, 0), b3, voffB);
            PG8_BAR; PG8_WAIT_L(0); PG8_MMA(0, 1, At, B1); PG8_BAR;
            PG8_LDA(At, 1, 1); PG8_STAGE(PG8_SA(1, 0), a3, voffA);
            PG8_BAR; PG8_WAIT_L(0); PG8_MMA(1, 0, At, B0); PG8_BAR; PG8_SCHED;
            PG8_STAGE(PG8_SB(1, 1), b3 + hB, voffB);
            PG8_WAIT_V(6); PG8_BAR; PG8_MMA(1, 1, At, B1); PG8_BAR;
        }
        if constexpr (F8) asm volatile("s_nop 15\n\ts_nop 15" ::: "memory");
        E(acc, cur, wr, wc, fr, fq);
        if (!has_next) break;
#pragma unroll
        for (int a = 0; a < 2; ++a)
#pragma unroll
            for (int b = 0; b < 2; ++b)
#pragma unroll
                for (int m = 0; m < 4; ++m)
#pragma unroll
                    for (int n = 0; n < 2; ++n) acc[a][b][m][n] = (f32x4){0.f, 0.f, 0.f, 0.f};
        cur = nxt; cA = nA; cB = nB; ++ui;
    }
    PG8_WAIT_V(0);
    if (wr == 0) PG8_BAR;
    PG8_BAR;
#undef PG8_SA
#undef PG8_SB
#undef PG8_STAGE
#undef PG8_LDA
#undef PG8_LDB
#undef PG8_MMA
#undef PG8_H0
#undef PG8_H1
#undef PG8_LD8
#undef PG8_WAIT_V
#undef PG8_WAIT_L
#undef PG8_BAR
#undef PG8_SCHED
#undef PG8_EXPERT
}
}

__device__ __forceinline__ void gemm_bf16(LAS unsigned char* lds, const pg8::Gemm& g, bf16_t* O, int ldc) { pg8::EpiBf16 E{O, ldc, 1.f}; pg8::gemm_phase(lds, g, E); }
__device__ __forceinline__ void gemm_even_in(LAS unsigned char* lds, const pg8::Gemm& g, const pg8::EpiEvenIn& E) { pg8::gemm_phase(lds, g, E); }
__device__ __forceinline__ void gemm_odd_in(LAS unsigned char* lds, const pg8::Gemm& g, const pg8::EpiOddIn& E) { pg8::gemm_phase(lds, g, E); }
__device__ __forceinline__ void gemm_mla_up(LAS unsigned char* lds, const pg8::Gemm& g, const pg8::EpiMlaUp& E) { pg8::gemm_phase(lds, g, E); }
__device__ __forceinline__ void gemm8_bf16(LAS unsigned char* lds, const pg8::Gemm& g, bf16_t* O, int ldc) { pg8::EpiBf16 E{O, ldc, F8_INV}; pg8::gemm_phase<pg8::EpiBf16, true>(lds, g, E); }
__device__ __forceinline__ void gemm8_swiglu8(LAS unsigned char* lds, const pg8::Gemm& g, unsigned char* O, int ldc) { pg8::EpiSwiGLU8 E{O, ldc, F8_INV}; pg8::gemm_phase<pg8::EpiSwiGLU8, true>(lds, g, E); }
__device__ __forceinline__ void gemm_swiglu(LAS unsigned char* lds, const pg8::Gemm& g, bf16_t* O, int ldc) { pg8::EpiSwiGLU E{O, ldc}; pg8::gemm_phase(lds, g, E); }

namespace att {
#define SBAR() __builtin_amdgcn_sched_barrier(0)
__device__ __forceinline__ int crow(int r, int hi) { return (r & 3) + 8 * (r >> 2) + 4 * hi; }
__device__ __forceinline__ int v_st(int k, int c) { const int kk = (k & ~0xC) | ((k & 4) << 1) | ((k & 8) >> 1); return ((kk >> 3) * 4 + (c >> 5)) * 512 + ((kk & 7) * 32 + (c & 31)) * 2; }
__device__ __forceinline__ int v_st_plain(int k, int c) { return ((k >> 3) * 4 + (c >> 5)) * 512 + ((k & 7) * 32 + (c & 31)) * 2; }
__device__ __forceinline__ int v_rd_base(int lane) { return ((lane & 3) << 3) | (((lane >> 2) & 3) << 6) | (((lane >> 4) & 1) << 5) | (((lane >> 5) & 1) << 8); }
constexpr int v_rd_off(int d0, int ks, int half) { return d0 * 512 + ks * 4096 + half * 2048; }
template <int OFF> __device__ __forceinline__ s16x4 tr_read(unsigned vb) {
    s16x4 r; asm volatile("ds_read_b64_tr_b16 %0, %1 offset:%2" : "=&v"(r) : "v"(vb), "i"(OFF) : "memory"); return r;
}
template <int D0> __device__ __forceinline__ void pv_one(f32x16& od, unsigned vb, bf16x8 pa0, bf16x8 pa1, bf16x8 pa2, bf16x8 pa3) {
    const s16x4 l0 = tr_read<v_rd_off(D0, 0, 0)>(vb), h0 = tr_read<v_rd_off(D0, 0, 1)>(vb), l1 = tr_read<v_rd_off(D0, 1, 0)>(vb), h1 = tr_read<v_rd_off(D0, 1, 1)>(vb);
    const s16x4 l2 = tr_read<v_rd_off(D0, 2, 0)>(vb), h2 = tr_read<v_rd_off(D0, 2, 1)>(vb), l3 = tr_read<v_rd_off(D0, 3, 0)>(vb), h3 = tr_read<v_rd_off(D0, 3, 1)>(vb);
    asm volatile("s_waitcnt lgkmcnt(0)" ::: "memory"); SBAR();
#define PK(L, H) (bf16x8){L[0], L[1], L[2], L[3], H[0], H[1], H[2], H[3]}
    od = __builtin_amdgcn_mfma_f32_32x32x16_bf16(pa0, PK(l0, h0), od, 0, 0, 0);
    od = __builtin_amdgcn_mfma_f32_32x32x16_bf16(pa1, PK(l1, h1), od, 0, 0, 0);
    od = __builtin_amdgcn_mfma_f32_32x32x16_bf16(pa2, PK(l2, h2), od, 0, 0, 0);
    od = __builtin_amdgcn_mfma_f32_32x32x16_bf16(pa3, PK(l3, h3), od, 0, 0, 0);
#undef PK
}
template <int KS, int NO> __device__ __forceinline__ void pv_step(f32x16 (&o)[NO], unsigned vb, bf16x8 pa) {
    s16x4 l[NO], h[NO];
    l[0] = tr_read<v_rd_off(0, KS, 0)>(vb); h[0] = tr_read<v_rd_off(0, KS, 1)>(vb); l[1] = tr_read<v_rd_off(1, KS, 0)>(vb); h[1] = tr_read<v_rd_off(1, KS, 1)>(vb);
    if constexpr (NO == 4) { l[2] = tr_read<v_rd_off(2, KS, 0)>(vb); h[2] = tr_read<v_rd_off(2, KS, 1)>(vb); l[3] = tr_read<v_rd_off(3, KS, 0)>(vb); h[3] = tr_read<v_rd_off(3, KS, 1)>(vb); }
    asm volatile("s_waitcnt lgkmcnt(0)" ::: "memory"); SBAR();
#pragma unroll
    for (int d = 0; d < NO; ++d) o[d] = __builtin_amdgcn_mfma_f32_32x32x16_bf16(pa, (bf16x8){l[d][0], l[d][1], l[d][2], l[d][3], h[d][0], h[d][1], h[d][2], h[d][3]}, o[d], 0, 0, 0);
}
__device__ __forceinline__ void rot8(bf16x8& a, bf16x8& b, const float* cs, const float* sn) {
    const f32x4 c0 = *(const f32x4*)cs, c1 = *(const f32x4*)(cs + 4), s0 = *(const f32x4*)sn, s1 = *(const f32x4*)(sn + 4);
    float c[8] = {c0[0], c0[1], c0[2], c0[3], c1[0], c1[1], c1[2], c1[3]}, s[8] = {s0[0], s0[1], s0[2], s0[3], s1[0], s1[1], s1[2], s1[3]};
    float o1[8], o2[8];
#pragma unroll
    for (int e = 0; e < 8; ++e) { const float x1 = bf2f((unsigned short)a[e]), x2 = bf2f((unsigned short)b[e]); o1[e] = x1 * c[e] - x2 * s[e]; o2[e] = x2 * c[e] + x1 * s[e]; }
    u32x4 wa = {cvtpk(o1[0], o1[1]), cvtpk(o1[2], o1[3]), cvtpk(o1[4], o1[5]), cvtpk(o1[6], o1[7])};
    u32x4 wb = {cvtpk(o2[0], o2[1]), cvtpk(o2[2], o2[3]), cvtpk(o2[4], o2[5]), cvtpk(o2[6], o2[7])};
    a = *reinterpret_cast<bf16x8*>(&wa); b = *reinterpret_cast<bf16x8*>(&wb);
}

__device__ __forceinline__ void rot4(bf16x8& a, const float* cs, const float* sn) {
    const f32x4 c = *(const f32x4*)cs, s = *(const f32x4*)sn; float o[8];
#pragma unroll
    for (int e = 0; e < 4; ++e) { const float x1 = bf2f((unsigned short)a[e]), x2 = bf2f((unsigned short)a[4 + e]); o[e] = x1 * c[e] - x2 * s[e]; o[4 + e] = x2 * c[e] + x1 * s[e]; }
    u32x4 w = {cvtpk(o[0], o[1]), cvtpk(o[2], o[3]), cvtpk(o[4], o[5]), cvtpk(o[6], o[7])};
    a = *reinterpret_cast<bf16x8*>(&w);
}
struct Args {
    const bf16_t* Q; int ldq, qcol;
    const bf16_t* K; int ldk, kcol;
    const bf16_t* V; int ldv, vcol;
    int q_row0;
    int kctx_row0, klat_row0, nt_ctx, nt_lat;
    float C;
    int rope;
    const float* rcos; const float* rsin;
    bf16_t* O; int ldo, ocol;
    int g, u0; const float* rpb;
    float lam, oscale; const float* subg;
};

template <int DQK, int KW, int DV, int MODE>
__device__ __forceinline__ void attn_unit(LAS unsigned char* lds, const Args& a) {
    constexpr int ND = DQK / 16, NO = DV / 32;
    constexpr int KSTR = KW * 2 + 16, KBUF = 64 * KSTR;
    constexpr int OFF_V = 3 * KBUF, OFF_WS = OFF_V + 3 * 16384, OFF_RPB = OFF_WS + 2048;
    constexpr int KCH = KW / 8, NKCH = 64 * KCH, NKC = (NKCH + 511) / 512;
    constexpr int VCH = DV / 8, NVCH = 64 * VCH, NVC = (NVCH + 511) / 512;
    const int tid = opaque_tid(), wid = __builtin_amdgcn_readfirstlane(tid >> 6), lane = tid & 63, r32 = lane & 31, hi = lane >> 5;
    LAS unsigned char* Kl = lds; LAS unsigned char* Vl = lds + OFF_V;
    LAS float* wsf = (LAS float*)(lds + OFF_WS) + wid * 64; LAS float* li_l = wsf;
    LAS float* rpbl = (LAS float*)(lds + OFF_RPB);
    const int wq = (MODE == 1) ? (wid & 3) : wid, wmap = (MODE == 1) ? (wid >> 2) : 0;
    bf16x8 qr[ND];
    const int qrow = a.q_row0 + wq * 32 + r32;
    {
        const bf16_t* Qw = a.Q + (size_t)qrow * a.ldq + a.qcol + wmap * 64 + hi * 8;
#pragma unroll
        for (int d0 = 0; d0 < ND; ++d0) qr[d0] = *(const bf16x8*)(Qw + d0 * 16);
        if (a.rope == 2) { if constexpr (ND >= 6) { const int s = qrow & (SEQ - 1); rot4(qr[4], a.rcos + s * 16 + 4 * hi, a.rsin + s * 16 + 4 * hi); rot4(qr[5], a.rcos + s * 16 + 8 + 4 * hi, a.rsin + s * 16 + 8 + 4 * hi); } }
#pragma unroll
        for (int d0 = 0; d0 < ND; ++d0) { float f[8];
#pragma unroll
            for (int e = 0; e < 8; ++e) f[e] = bf2f((unsigned short)qr[d0][e]) * a.C;
            u32x4 w = {cvtpk(f[0], f[1]), cvtpk(f[2], f[3]), cvtpk(f[4], f[5]), cvtpk(f[6], f[7])}; qr[d0] = *reinterpret_cast<bf16x8*>(&w); }
    }
    if (MODE == 2) { if (tid < 465) rpbl[tid] = a.rpb[tid] * LOG2E; }
    const int cq = (wid & 1) * 32 + r32, rq = 4 * a.g + (wid >> 1);
    const int rs = min(max(rq - 4, 0), 120), cs_ = min(max(cq - 8, 0), 48);
    int kgo[NKC], klo[NKC], vgo[NVC], vlo[NVC];
#pragma unroll
    for (int i = 0; i < NKC; ++i) { if (i > 0 && KCH == 16) { kgo[i] = kgo[0] + 32 * i * a.ldk; klo[i] = klo[0] + 32 * i * KSTR; } else { const int c = tid + 512 * i, row = c / KCH, ch = c % KCH; kgo[i] = row * a.ldk + ch * 8; klo[i] = row * KSTR + ch * 16; } }
#pragma unroll
    for (int i = 0; i < NVC; ++i) { if (i > 0 && VCH == 16) { vgo[i] = vgo[0] + 32 * i * a.ldv; vlo[i] = vlo[0] + 8192 * i; } else { const int c = tid + 512 * i, row = c / VCH, ch = c % VCH; vgo[i] = row * a.ldv + ch * 8; vlo[i] = v_st_plain(row, ch * 8); } }
    u32x4 ksA[NKC], vsA[NVC];
    const int NT = a.nt_ctx + a.nt_lat;
#define TILE_ROW(j) ((j) < a.nt_ctx ? a.kctx_row0 + 64 * (j) : a.klat_row0 + 64 * ((j) - a.nt_ctx))
#define SLOAD(j) do { const int _r0 = TILE_ROW(j); const bf16_t* _kp = a.K + (size_t)_r0 * a.ldk + a.kcol; const bf16_t* _vp = a.V + (size_t)_r0 * a.ldv + a.vcol; \
    _Pragma("unroll") for (int _i = 0; _i < NKC; ++_i) if ((NKCH % 512 == 0) || tid + 512 * _i < NKCH) ksA[_i] = *(const u32x4*)(_kp + kgo[_i]); \
    _Pragma("unroll") for (int _i = 0; _i < NVC; ++_i) if ((NVCH % 512 == 0) || tid + 512 * _i < NVCH) vsA[_i] = *(const u32x4*)(_vp + vgo[_i]); } while (0)
#define SWRITE(b) do { \
    _Pragma("unroll") for (int _i = 0; _i < NKC; ++_i) if ((NKCH % 512 == 0) || tid + 512 * _i < NKCH) *(LAS u32x4*)(Kl + (b) * KBUF + klo[_i]) = ksA[_i]; \
    _Pragma("unroll") for (int _i = 0; _i < NVC; ++_i) if ((NVCH % 512 == 0) || tid + 512 * _i < NVCH) *(LAS u32x4*)(Vl + (b) * 16384 + vlo[_i]) = vsA[_i]; } while (0)
    float l_reg = 0.f;
    f32x16 o[NO];
#pragma unroll
    for (int d = 0; d < NO; ++d) o[d] = (f32x16){0.f, 0.f, 0.f, 0.f, 0.f, 0.f, 0.f, 0.f, 0.f, 0.f, 0.f, 0.f, 0.f, 0.f, 0.f, 0.f};
    const unsigned vb0 = (unsigned)(size_t)Vl + (unsigned)v_rd_base(lane);
#define QKT(P0, P1, b) do { const LAS unsigned char* _Kb = Kl + (b) * KBUF + wmap * 128; \
    _Pragma("unroll") for (int d0 = 0; d0 < ND; ++d0) { const int cb = (d0 * 16 + hi * 8) * 2; \
        const bf16x8 b0 = *(const LAS bf16x8*)(_Kb + r32 * KSTR + cb), b1 = *(const LAS bf16x8*)(_Kb + (32 + r32) * KSTR + cb); \
        if (d0 == 0) { const f32x16 z16 = {0.f, 0.f, 0.f, 0.f, 0.f, 0.f, 0.f, 0.f, 0.f, 0.f, 0.f, 0.f, 0.f, 0.f, 0.f, 0.f}; P0 = __builtin_amdgcn_mfma_f32_32x32x16_bf16(b0, qr[0], z16, 0, 0, 0); P1 = __builtin_amdgcn_mfma_f32_32x32x16_bf16(b1, qr[0], z16, 0, 0, 0); } \
        else { P0 = __builtin_amdgcn_mfma_f32_32x32x16_bf16(b0, qr[d0], P0, 0, 0, 0); P1 = __builtin_amdgcn_mfma_f32_32x32x16_bf16(b1, qr[d0], P1, 0, 0, 0); } } } while (0)
#define PARTIAL(P0, P1, j) do { \
    if (MODE == 2) { if ((j) >= a.nt_ctx) { const int kr = a.u0 + ((j) - a.nt_ctx); const bool rowok = (kr >= rs) && (kr < rs + 8); const int ro = min(max(kr - rq + 7, 0), 14); const LAS float* brow = rpbl + ro * 31; \
        _Pragma("unroll") for (int r = 0; r < 16; ++r) { \
            { const int ck = crow(r, hi), dd = min(max(ck - cq + 15, 0), 30); const bool inw = rowok && ((unsigned)(ck - cs_) < 16u); const float bv = brow[dd]; P0[r] = inw ? P0[r] + bv : -1e30f; } \
            { const int ck = 32 + crow(r, hi), dd = min(max(ck - cq + 15, 0), 30); const bool inw = rowok && ((unsigned)(ck - cs_) < 16u); const float bv = brow[dd]; P1[r] = inw ? P1[r] + bv : -1e30f; } } } } \
    _Pragma("unroll") for (int r = 0; r < 16; ++r) P0[r] = fast_exp2(P0[r]); } while (0)
#define PK4(P, BASE, OUT) do { u32x4 w = {cvtpk(P[BASE + 0], P[BASE + 1]), cvtpk(P[BASE + 2], P[BASE + 3]), cvtpk(P[BASE + 4], P[BASE + 5]), cvtpk(P[BASE + 6], P[BASE + 7])}; \
    OUT = *reinterpret_cast<bf16x8*>(&w); } while (0)
#define FINISH(P0, P1) do { \
    _Pragma("unroll") for (int r = 0; r < 16; ++r) P1[r] = fast_exp2(P1[r]); \
    float ps = 0.f; \
    _Pragma("unroll") for (int r = 0; r < 16; ++r) ps += P0[r]; \
    _Pragma("unroll") for (int r = 0; r < 16; ++r) ps += P1[r]; \
    l_reg += ps; \
    PK4(P0, 0, pa0); PK4(P0, 8, pa1); PK4(P1, 0, pa2); PK4(P1, 8, pa3); } while (0)
#define PV(b) do { const unsigned _vb = vb0 + (unsigned)(b) * 16384u; \
    pv_step<0, NO>(o, _vb, pa0); pv_step<1, NO>(o, _vb, pa1); pv_step<2, NO>(o, _vb, pa2); pv_step<3, NO>(o, _vb, pa3); } while (0)
    f32x16 pA0, pA1, pB0, pB1; bf16x8 pa0, pa1, pa2, pa3;
    SLOAD(0); SWRITE(0); SLOAD(1); __syncthreads();
    QKT(pA0, pA1, 0); PARTIAL(pA0, pA1, 0);
    SWRITE(1); if (2 < NT) SLOAD(2);
    __syncthreads();
    int bm1 = 0, bj = 1, bn = 2;
    for (int j = 1; j + 1 < NT; j += 2) {
        SBAR(); QKT(pB0, pB1, bj);
        FINISH(pA0, pA1); SBAR();
        PV(bm1); PARTIAL(pB0, pB1, j);
        SBAR(); SWRITE(bn); SLOAD(j + 2);
        __syncthreads();
        SBAR(); QKT(pA0, pA1, bn);
        FINISH(pB0, pB1); SBAR();
        PV(bj); PARTIAL(pA0, pA1, j + 1);
        SBAR(); SWRITE(bm1); if (j + 3 < NT) SLOAD(j + 3);
        __syncthreads();
        { const int t0 = bm1; bm1 = bn; bn = bj; bj = t0; }
    }
    SBAR(); QKT(pB0, pB1, bj);
    FINISH(pA0, pA1); SBAR();
    PV(bm1); PARTIAL(pB0, pB1, NT - 1);
    FINISH(pB0, pB1); SBAR();
    PV(bj);
    __syncthreads();
#undef TILE_ROW
#undef SLOAD
#undef SWRITE
#undef QKT
#undef PARTIAL
#undef PK4
#undef FINISH
#undef PV
    const int tid_e = opaque_tid(), lane_e = tid_e & 63, r32e = lane_e & 31, hie = lane_e >> 5;
    { auto rr = __builtin_amdgcn_permlane32_swap(__float_as_uint(l_reg), __float_as_uint(l_reg), false, false); l_reg = __uint_as_float(rr[0]) + __uint_as_float(rr[1]); }
    if (hie == 0) li_l[r32e] = fmaxf(l_reg, 1e-37f); LDS_WAIT();
    float rli[16];
#pragma unroll
    for (int r = 0; r < 16; ++r) rli[r] = fast_rcp(li_l[crow(r, hie)]);
    if (MODE != 1) {
        bf16_t* Ow = a.O + (size_t)(a.q_row0 + wid * 32) * a.ldo + a.ocol + r32e;
#pragma unroll
        for (int r = 0; r < 16; ++r) { const int orow = crow(r, hie);
#pragma unroll
            for (int d0 = 0; d0 < NO; ++d0) Ow[(size_t)orow * a.ldo + d0 * 32] = f2bf(o[d0][r] * rli[r]); }
    } else {
        LAS float* cb = (LAS float*)lds;
        if (wmap == 1) {
#pragma unroll
            for (int r = 0; r < 16; ++r) { const int row = wq * 32 + crow(r, hie);
#pragma unroll
                for (int d0 = 0; d0 < NO; ++d0) cb[row * 129 + d0 * 32 + r32e] = a.lam * o[d0][r] * rli[r]; }
        }
        __syncthreads();
        if (wmap == 0) {
#pragma unroll
            for (int r = 0; r < 16; ++r) { const int row = wq * 32 + crow(r, hie);
#pragma unroll
                for (int d0 = 0; d0 < NO; ++d0) { const int ix = row * 129 + d0 * 32 + r32e; cb[ix] = o[d0][r] * rli[r] - cb[ix]; } }
        }
        __syncthreads();
        const int row = tid_e >> 2, qd = tid_e & 3;
        float v[32]; float ss = 0.f;
#pragma unroll
        for (int i = 0; i < 32; ++i) { v[i] = cb[row * 129 + qd * 32 + i]; ss += v[i] * v[i]; }
        ss += __shfl_xor(ss, 1); ss += __shfl_xor(ss, 2);
        const float rstd = rsqrtf(ss * (1.f / 128.f) + EPS) * a.oscale;
        bf16_t* Ow = a.O + (size_t)(a.q_row0 + row) * a.ldo + a.ocol + qd * 32;
#pragma unroll
        for (int c = 0; c < 4; ++c) { float w[8];
#pragma unroll
            for (int e = 0; e < 8; ++e) w[e] = v[c * 8 + e] * rstd * a.subg[qd * 32 + c * 8 + e];
            u32x4 pk = {cvtpk(w[0], w[1]), cvtpk(w[2], w[3]), cvtpk(w[4], w[5]), cvtpk(w[6], w[7])};
            *(u32x4*)(Ow + c * 8) = pk; }
    }
    __syncthreads();
}

__device__ __forceinline__ void sgu_unit(LAS unsigned char* lds, const bf16_t* PB, const bf16_t* Wsb, const float* bs, const float* stats, const float* sgain, bf16_t* MIX, int rowbase, int g) {
    const int tid = opaque_tid(), wid = __builtin_amdgcn_readfirstlane(tid >> 6), lane = tid & 63, r32 = lane & 31, hi = lane >> 5;
    LAS unsigned char* Vl = lds;
#pragma unroll 2
    for (int i = 0; i < 4; ++i) { const int c = tid + 512 * i, row = c >> 4, ch = c & 15;
        const u32x4 x = *(const u32x4*)(PB + (size_t)(rowbase + row) * EV_IN + 512 + g * 128 + ch * 8);
        const f32x4* st = (const f32x4*)(stats + (size_t)(rowbase + row) * 16); const f32x4 a0 = st[0], a1 = st[1], a2 = st[2], a3 = st[3];
        const float s1 = ((a0[0] + a0[2]) + (a1[0] + a1[2])) + ((a2[0] + a2[2]) + (a3[0] + a3[2])), s2 = ((a0[1] + a0[3]) + (a1[1] + a1[3])) + ((a2[1] + a2[3]) + (a3[1] + a3[3]));
        const float mean = s1 * (1.f / 512.f), rstd = rsqrtf(fmaxf(s2 * (1.f / 512.f) - mean * mean, 0.f) + EPS);
        const f32x4 g0 = *(const f32x4*)(sgain + g * 128 + ch * 8), g1 = *(const f32x4*)(sgain + g * 128 + ch * 8 + 4);
        u32x4 y; y.x = cvtpk((bflo(x.x) - mean) * rstd * g0[0], (bfhi(x.x) - mean) * rstd * g0[1]); y.y = cvtpk((bflo(x.y) - mean) * rstd * g0[2], (bfhi(x.y) - mean) * rstd * g0[3]);
        y.z = cvtpk((bflo(x.z) - mean) * rstd * g1[0], (bfhi(x.z) - mean) * rstd * g1[1]); y.w = cvtpk((bflo(x.w) - mean) * rstd * g1[2], (bfhi(x.w) - mean) * rstd * g1[3]);
        *(LAS u32x4*)(Vl + (row >> 6) * 16384 + v_st(row & 63, ch * 8)) = y; }
    const int prow = (wid & 3) * 32, dh = wid >> 2;
    bf16x8 pa[2][4];
#pragma unroll
    for (int kt = 0; kt < 2; ++kt)
#pragma unroll
        for (int ks = 0; ks < 4; ++ks) pa[kt][ks] = *(const bf16x8*)(Wsb + (size_t)(g * 128 + prow + r32) * 128 + kt * 64 + ks * 16 + hi * 8);
    __syncthreads();
    f32x16 o[2];
    o[0] = (f32x16){0.f, 0.f, 0.f, 0.f, 0.f, 0.f, 0.f, 0.f, 0.f, 0.f, 0.f, 0.f, 0.f, 0.f, 0.f, 0.f}; o[1] = o[0];
    const unsigned vb0 = (unsigned)(size_t)Vl + (unsigned)v_rd_base(lane);
#pragma unroll
    for (int kt = 0; kt < 2; ++kt) { const unsigned vb = vb0 + kt * 16384u;
        if (dh == 0) { pv_one<0>(o[0], vb, pa[kt][0], pa[kt][1], pa[kt][2], pa[kt][3]); pv_one<1>(o[1], vb, pa[kt][0], pa[kt][1], pa[kt][2], pa[kt][3]); }
        else { pv_one<2>(o[0], vb, pa[kt][0], pa[kt][1], pa[kt][2], pa[kt][3]); pv_one<3>(o[1], vb, pa[kt][0], pa[kt][1], pa[kt][2], pa[kt][3]); } }
#pragma unroll
    for (int r = 0; r < 16; ++r) { const int p = prow + crow(r, hi); const float bias = bs[g * 128 + p];
#pragma unroll
        for (int dd = 0; dd < 2; ++dd) { const int d = (2 * dh + dd) * 32 + r32;
            const float u = bf2f(PB[(size_t)(rowbase + p) * EV_IN + g * 128 + d]);
            MIX[(size_t)(rowbase + p) * DM + g * 128 + d] = f2bf(u * (o[dd][r] + bias)); } }
    __syncthreads();
}
}

struct Params {
    const float* in[31];
    float* out;
    unsigned char* ws;
    int ph_lo, ph_hi;
};

struct Ctx {
    LAS unsigned char* lds;
    int tid, lane, wid, gw, NGW;
};
__device__ __forceinline__ Ctx make_ctx(LAS unsigned char* lds) { const int t = opaque_tid(), w = __builtin_amdgcn_readfirstlane(t >> 6); return Ctx{lds, t, t & 63, w, opaque_bid() * 8 + w, (int)gridDim.x * 8}; }
typedef const __attribute__((address_space(4))) Params KParams;
__device__ __forceinline__ KParams& kparams() { KParams* p = (KParams*)__builtin_amdgcn_kernarg_segment_ptr(); asm volatile("" : "+s"(p)); return *p; }

__device__ __forceinline__ bf16_t* xrow_ptr(KParams& P, int row) { return (bf16_t*)(P.ws + WS_U + U_XB) + (size_t)row * DM; }
__device__ __forceinline__ int mod_r(int row) { return row < NLAT ? (row >> 13) : 4; }
__device__ __forceinline__ f32x4 ld4(const float* p) { return *(const f32x4*)p; }
__device__ __forceinline__ f32x4 ldbf4(const bf16_t* p) { const u32x2 w = *(const u32x2*)p; return (f32x4){bflo(w.x), bfhi(w.x), bflo(w.y), bfhi(w.y)}; }
__device__ __forceinline__ void stbf4(bf16_t* p, f32x4 v) { u32x2 w; w.x = cvtpk(v[0], v[1]); w.y = cvtpk(v[2], v[3]); *(u32x2*)p = w; }
__device__ __forceinline__ float sumsq4(const f32x4 (&v)[4]) { float s = 0.f;
#pragma unroll
    for (int j = 0; j < 4; ++j) s += (v[j][0] * v[j][0] + v[j][1] * v[j][1]) + (v[j][2] * v[j][2] + v[j][3] * v[j][3]);
    return wave_sum(s); }
__device__ __forceinline__ void norm_mod(const f32x4 (&x)[4], f32x4 (&hv)[4], const float* gain, const float* shift, const float* scale, int lane) {
    const float rstd = rsqrtf(sumsq4(x) * (1.f / DM) + EPS);
#pragma unroll
    for (int j = 0; j < 4; ++j) { const int c = 4 * lane + 256 * j; const f32x4 g = ld4(gain + c), sh = ld4(shift + c), sc = ld4(scale + c);
        hv[j] = (x[j] * rstd) * g * (sc + 1.f) + sh; }
}
__device__ __forceinline__ void resid_add(f32x4 (&x)[4], const f32x4 (&y)[4], const float* gain, const float* gate, int lane) {
    const float rstd = rsqrtf(sumsq4(y) * (1.f / DM) + EPS);
#pragma unroll
    for (int j = 0; j < 4; ++j) { const int c = 4 * lane + 256 * j; const f32x4 g = ld4(gain + c), gt = ld4(gate + c);
        x[j] = x[j] + gt * ((y[j] * rstd) * g); }
}

__device__ __forceinline__ void wave_rows(const Ctx& c, int mtok, int& r0, int& r1) {
    const int bid = opaque_bid(); const int rpw = mtok / (int)gridDim.x, base = bid * rpw;
    r0 = base + (c.wid * rpw) / 8; r1 = base + ((c.wid + 1) * rpw) / 8;
    if (bid == (int)gridDim.x - 1 && c.wid == 7) r1 = mtok;
}
__device__ __forceinline__ void ld_gate(f32x4 (&G)[4], const float* gain, const float* gate, int lane) {
#pragma unroll
    for (int j = 0; j < 4; ++j) { const int cc = 4 * lane + 256 * j; G[j] = ld4(gain + cc) * ld4(gate + cc); } }
__device__ __forceinline__ void ld_mod(f32x4 (&A)[4], f32x4 (&B)[4], const float* gain, const float* shift, const float* scale, int lane) {
#pragma unroll
    for (int j = 0; j < 4; ++j) { const int cc = 4 * lane + 256 * j; A[j] = ld4(gain + cc) * (ld4(scale + cc) + 1.f); B[j] = ld4(shift + cc); } }
__device__ __forceinline__ void resid_add2(f32x4 (&x)[4], const f32x4 (&y)[4], const f32x4 (&G)[4]) {
    const float rstd = rsqrtf(sumsq4(y) * (1.f / DM) + EPS);
#pragma unroll
    for (int j = 0; j < 4; ++j) x[j] = x[j] + G[j] * (y[j] * rstd);
}
__device__ __forceinline__ void norm_mod2(const f32x4 (&x)[4], f32x4 (&hv)[4], const f32x4 (&A)[4], const f32x4 (&B)[4]) {
    const float rstd = rsqrtf(sumsq4(x) * (1.f / DM) + EPS);
#pragma unroll
    for (int j = 0; j < 4; ++j) hv[j] = (x[j] * rstd) * A[j] + B[j];
}

__device__ __forceinline__ int perm_row(int pmode, int n) {
    if (pmode == 1) { if (n >= 1024 && n < 2048) { const int d = n & 63, hb = n & ~63; return hb + ((d < 32) ? 8 * (d >> 2) + (d & 3) : 8 * ((d - 32) >> 2) + 4 + (d & 3)); } }
    else if (pmode == 2) { if (n >= 1920 && n < 1952) { const int d = n - 1920; return 1920 + ((d < 16) ? 8 * (d >> 2) + (d & 3) : 8 * ((d - 16) >> 2) + 4 + (d & 3)); } }
    return n;
}
__device__ __forceinline__ void tr_item(const float* W, int ldw, bf16_t* WT, int ldt, int k0, int n0, int drow, LAS float* scr, int lane, int pmode = 0) {
#pragma unroll 8
    for (int i = 0; i < 32; ++i) { const int kk = 2 * i + (lane >> 5); scr[kk * 33 + (lane & 31)] = W[(size_t)(k0 + kk) * ldw + n0 + (lane & 31)]; }
    LDS_WAIT(); asm volatile("" ::: "memory");
    const int c = lane & 7;
#pragma unroll
    for (int j = 0; j < 4; ++j) { const int n = (lane >> 3) + 8 * j; const LAS float* s = scr + (8 * c) * 33 + n;
        u32x4 o; o.x = cvtpk(s[0 * 33], s[1 * 33]); o.y = cvtpk(s[2 * 33], s[3 * 33]); o.z = cvtpk(s[4 * 33], s[5 * 33]); o.w = cvtpk(s[6 * 33], s[7 * 33]);
        const int dr = pmode ? perm_row(pmode, n0 + n) : drow + n;
        *(u32x4*)(WT + (size_t)dr * ldt + k0 + 8 * c) = o; }
    LDS_WAIT(); asm volatile("" ::: "memory");
}
__device__ __forceinline__ void tr_item8(const float* W, int ldw, unsigned char* WT, int ldt, int k0, int n0, int drow, LAS float* scr, int lane) {
#pragma unroll 8
    for (int i = 0; i < 32; ++i) { const int kk = 2 * i + (lane >> 5); scr[kk * 33 + (lane & 31)] = W[(size_t)(k0 + kk) * ldw + n0 + (lane & 31)] * F8_W_SCALE; }
    LDS_WAIT(); asm volatile("" ::: "memory");
    const int c = lane & 7;
#pragma unroll
    for (int j = 0; j < 4; ++j) { const int n = (lane >> 3) + 8 * j; const LAS float* s = scr + (8 * c) * 33 + n;
        u32x2 o; o.x = pk4_fp8(s[0 * 33], s[1 * 33], s[2 * 33], s[3 * 33]); o.y = pk4_fp8(s[4 * 33], s[5 * 33], s[6 * 33], s[7 * 33]);
        *(u32x2*)(WT + (size_t)(drow + n) * ldt + k0 + 8 * c) = o; }
    LDS_WAIT(); asm volatile("" ::: "memory");
}
__device__ __forceinline__ void tr_matrix8(const Ctx& c, const float* W, int K, int N, unsigned char* WT, int mode, int row_off) {
    LAS float* scr = (LAS float*)(c.lds + c.wid * 16384);
    const int nblk = N / 32, nitems = (K / 64) * nblk;
    for (int it = c.gw; it < nitems; it += c.NGW) { const int kb = it / nblk, nb = it % nblk, n0 = 32 * nb;
        const int drow = (mode == 0) ? row_off + n0 : (n0 >> 7) * 256 + (n0 & 127) + (mode == 2 ? 128 : 0);
        tr_item8(W, N, WT, K, 64 * kb, n0, drow, scr, c.lane); }
}
__device__ __forceinline__ void tr_matrix(const Ctx& c, const float* W, int K, int N, bf16_t* WT, int mode, int row_off, int pmode = 0) {
    LAS float* scr = (LAS float*)(c.lds + c.wid * 16384);
    const int nblk = N / 32, nitems = (K / 64) * nblk;
    for (int it = c.gw; it < nitems; it += c.NGW) { const int kb = it / nblk, nb = it % nblk, n0 = 32 * nb;
        const int drow = (mode == 0) ? row_off + n0 : (n0 >> 7) * 256 + (n0 & 127) + (mode == 2 ? 128 : 0);
        tr_item(W, N, WT, K, 64 * kb, n0, drow, scr, c.lane, pmode); }
}
constexpr int MOE_CVT_ITEMS = 24 * 1792;
__device__ __forceinline__ void convert_moe_items(const Ctx& c, int i, int t0, int t1, int wsel, int nsel) {
    KParams& P = kparams();
    LAS float* scr = (LAS float*)(c.lds + c.wid * 16384);
    if (wsel < 0) return;
    for (int t = t0 + wsel; t < t1; t += nsel) {
        const int mat = t / 1792, r = t % 1792, e = mat / 3, which = mat % 3;
        if (which < 2) {
            const float* W = P.in[28 + which] + ((size_t)i * NEXP + e) * DM * DFFE; const int kb = r / 112, n0 = 32 * (r % 112);
            const int drow = (n0 >> 7) * 256 + (n0 & 127) + which * 128;
#if MOE_F8
            tr_item8(W, DFFE, (unsigned char*)(P.ws + WS_W13M) + (size_t)e * 2 * DFFE * DM, DM, 64 * kb, n0, drow, scr, c.lane);
#else
            tr_item(W, DFFE, (bf16_t*)(P.ws + WS_W13M) + (size_t)e * 2 * DFFE * DM, DM, 64 * kb, n0, drow, scr, c.lane);
#endif
        } else {
            const float* W = P.in[30] + ((size_t)i * NEXP + e) * DFFE * DM; const int kb = r / 32, n0 = 32 * (r % 32);
#if MOE_F8
            tr_item8(W, DM, (unsigned char*)(P.ws + WS_W2M) + (size_t)e * DM * DFFE, DFFE, 64 * kb, n0, n0, scr, c.lane);
#else
            tr_item(W, DM, (bf16_t*)(P.ws + WS_W2M) + (size_t)e * DM * DFFE, DFFE, 64 * kb, n0, n0, scr, c.lane);
#endif
        }
    }
}
__device__ __forceinline__ void prologue0(const Ctx& c_) {
    const Ctx c = make_ctx(c_.lds);
    KParams& P = kparams(); unsigned char* ws = P.ws;
    if (blockIdx.x < 96) {
        LAS float* sl = (LAS float*)c.lds;
        LAS float* part = (LAS float*)(c.lds + 32768);
        for (int i = c.tid; i < 5 * DM; i += 512) { const int r = i >> 10, k = i & 1023; const float x = r < 4 ? P.in[1][r * DM + k] : P.in[3][k]; sl[i] = x / (1.f + expf(-x)); }
        __syncthreads();
        const int t = blockIdx.x, lm = t / 24, cbk = t % 24, n = cbk * 256 + 4 * c.lane;
        const float* W = P.in[4] + (size_t)lm * DM * (NMOD * DM) + n;
        f32x4 acc[5];
#pragma unroll
        for (int r = 0; r < 5; ++r) acc[r] = (f32x4){0.f, 0.f, 0.f, 0.f};
        const int kb = c.wid * 128;
        for (int k0 = 0; k0 < 128; k0 += 8) {
            f32x4 wv[8];
#pragma unroll
            for (int u = 0; u < 8; ++u) wv[u] = ld4(W + (size_t)(kb + k0 + u) * (NMOD * DM));
#pragma unroll
            for (int u = 0; u < 8; ++u)
#pragma unroll
                for (int r = 0; r < 5; ++r) acc[r] += wv[u] * sl[r * DM + kb + k0 + u];
        }
#pragma unroll
        for (int r = 0; r < 5; ++r) *(LAS f32x4*)(part + (c.wid * 5 + r) * 256 + 4 * c.lane) = acc[r];
        __syncthreads();
        for (int i = c.tid; i < 5 * 256; i += 512) { const int r = i >> 8, cc = i & 255; float s = 0.f;
#pragma unroll
            for (int w = 0; w < 8; ++w) s += part[(w * 5 + r) * 256 + cc];
            ((float*)(ws + WS_MODS))[(size_t)(lm * 5 + r) * (NMOD * DM) + cbk * 256 + cc] = s + P.in[5][lm * (NMOD * DM) + cbk * 256 + cc]; }
        __syncthreads();
    }
    for (int i = 0; i < 2; ++i) {
        tr_matrix(c, P.in[7] + (size_t)i * DM * EV_IN, DM, EV_IN, (bf16_t*)(ws + WS_WINE) + (size_t)i * EV_IN * DM, 0, 0, 1);
        tr_matrix(c, P.in[8] + (size_t)i * DM * DM, DM, DM, (bf16_t*)(ws + WS_WOUTE) + (size_t)i * DM * DM, 0, 0);
        if (FFN8(i)) {
            tr_matrix8(c, P.in[17] + (size_t)i * DM * DFF, DM, DFF, (unsigned char*)(ws + WS_W13E) + (size_t)i * 2 * DFF * DM * 2, 1, 0);
            tr_matrix8(c, P.in[18] + (size_t)i * DM * DFF, DM, DFF, (unsigned char*)(ws + WS_W13E) + (size_t)i * 2 * DFF * DM * 2, 2, 0);
            tr_matrix8(c, P.in[19] + (size_t)i * DFF * DM, DFF, DM, (unsigned char*)(ws + WS_W2E) + (size_t)i * DM * DFF * 2, 0, 0);
        } else {
            tr_matrix(c, P.in[17] + (size_t)i * DM * DFF, DM, DFF, (bf16_t*)(ws + WS_W13E) + (size_t)i * 2 * DFF * DM, 1, 0);
            tr_matrix(c, P.in[18] + (size_t)i * DM * DFF, DM, DFF, (bf16_t*)(ws + WS_W13E) + (size_t)i * 2 * DFF * DM, 2, 0);
            tr_matrix(c, P.in[19] + (size_t)i * DFF * DM, DFF, DM, (bf16_t*)(ws + WS_W2E) + (size_t)i * DM * DFF, 0, 0);
        }
        tr_matrix(c, P.in[20] + (size_t)i * DM * OD_IN, DM, OD_IN, (bf16_t*)(ws + WS_WINO) + (size_t)i * OD_INP * DM, 0, 0, 2);
        tr_matrix(c, P.in[21] + (size_t)i * DM * DM, DM, DM, (bf16_t*)(ws + WS_WOUTO) + (size_t)i * DM * DM, 0, 0);
    }
    const int gt = blockIdx.x * 512 + c.tid, NGT = gridDim.x * 512;
    for (int i = gt; i < 2 * (OD_INP - OD_IN) * DM; i += NGT) { const int l = i / ((OD_INP - OD_IN) * DM), r = i % ((OD_INP - OD_IN) * DM);
        ((bf16_t*)(ws + WS_WINO))[(size_t)l * OD_INP * DM + (size_t)OD_IN * DM + r] = 0; }
    for (int i = gt; i < 2 * MLA_N * MLA_K; i += NGT) { const int l = i / (MLA_N * MLA_K), n = (i / MLA_K) % MLA_N, k = i % MLA_K; float v = 0.f;
        if (n < 384) { if (k < 256) { const int h = n / 96, j = n % 96; int sc = n;
                if (j >= 64) { const int p = j - 64, t = p >> 3, e = p & 7; sc = h * 96 + 64 + ((e < 4) ? 4 * t + e : 16 + 4 * t + (e - 4)); }
                v = P.in[24][((size_t)l * 256 + k) * 384 + sc] * P.in[23][l * 256 + k]; } }
        else if (n < 768) { const int h = (n - 384) / 96, j = (n - 384) % 96;
            if (j < 64) { if (k >= 256 && k < 384) v = P.in[26][((size_t)l * 128 + (k - 256)) * 768 + h * 192 + j] * P.in[25][l * 128 + (k - 256)]; }
            else { if (k == 384 + (j - 64)) v = 1.f; } }
        else { const int h = (n - 768) / 128, j = (n - 768) % 128; if (k >= 256 && k < 384) v = P.in[26][((size_t)l * 128 + (k - 256)) * 768 + h * 192 + 64 + j] * P.in[25][l * 128 + (k - 256)]; }
        ((bf16_t*)(ws + WS_WMLA))[i] = f2bf(v); }
    for (int i = gt; i < 2 * 4 * 128 * 128; i += NGT) ((bf16_t*)(ws + WS_SGUW))[i] = f2bf(P.in[9][i]);
    for (int i = gt; i < SEQ * 32; i += NGT) { const int s = i >> 5, f = i & 31; const int pos = f < 16 ? (s >> 6) : (s & 63);
        const float inv = 1.0f / powf(10000.0f, (float)(f & 15) / 16.0f); const float ang = (float)pos * inv;
        ((float*)(ws + WS_ROPEB))[i] = (float)cos((double)ang); ((float*)(ws + WS_ROPEB))[SEQ * 32 + i] = (float)sin((double)ang); }
    for (int i = gt; i < SEQ * 16; i += NGT) { const int s = i >> 4, f = i & 15; const int pos = f < 8 ? (s >> 6) : (s & 63);
        const float inv = 1.0f / powf(10000.0f, (float)(f & 7) / 8.0f); const float ang = (float)pos * inv;
        ((float*)(ws + WS_ROPED))[i] = (float)cos((double)ang); ((float*)(ws + WS_ROPED))[SEQ * 16 + i] = (float)sin((double)ang); }
}

__device__ __forceinline__ void convert_moe_tail(const Ctx& c_, int i, int t0, int t1, int nunits) {
    const Ctx c = make_ctx(c_.lds);
    const int G = (int)gridDim.x, rem = nunits % G, bid = opaque_bid();
    const int first = rem;
    convert_moe_items(c, i, t0, t1, bid >= first ? (bid - first) * 8 + c.wid : -1, (G - first) * 8);
}

__device__ __forceinline__ void ew_first(const Ctx& c_) {
    const Ctx c = make_ctx(c_.lds);
    KParams& P = kparams(); const float* mods = (const float*)(P.ws + WS_MODS); bf16_t* HB = (bf16_t*)(P.ws + WS_HB);
    int r0, r1; wave_rows(c, MTOT, r0, r1);
    f32x4 A0[4], B0[4]; int rcur = -1;
    for (int row = r0; row < r1; ++row) {
        const float* src = row < NLAT ? P.in[0] + (size_t)row * DM : P.in[2] + (size_t)(row - NLAT) * DM;
        bf16_t* xr = xrow_ptr(P, row); const int r = mod_r(row);
        if (r != rcur) { rcur = r; const float* mb = mods + (size_t)(0 * 5 + r) * (NMOD * DM); ld_mod(A0, B0, P.in[6] + (0 * 4 + 0) * DM, mb + 0 * DM, mb + 1 * DM, c.lane); }
        f32x4 x[4], h[4];
#pragma unroll
        for (int j = 0; j < 4; ++j) { x[j] = ld4(src + 4 * c.lane + 256 * j); stbf4(xr + 4 * c.lane + 256 * j, x[j]); }
        norm_mod2(x, h, A0, B0);
#pragma unroll
        for (int j = 0; j < 4; ++j) stbf4(HB + (size_t)row * DM + 4 * c.lane + 256 * j, h[j]);
    }
}

__device__ __forceinline__ void ew_even_mix(const Ctx& c_, int i) {
    const Ctx c = make_ctx(c_.lds);
    KParams& P = kparams(); bf16_t* PB = (bf16_t*)(P.ws + WS_U + U_PB);
    const float* sg = P.in[11] + i * 512; const float* rc = (const float*)(P.ws + WS_ROPEB); const float* rsn = rc + SEQ * 32;
    for (int row = c.gw; row < MTOT; row += c.NGW) {
        bf16_t* pr = PB + (size_t)row * EV_IN;
        {
            const u32x4 w = *(const u32x4*)(pr + 8 * c.lane); float f[8] = {bflo(w.x), bfhi(w.x), bflo(w.y), bfhi(w.y), bflo(w.z), bfhi(w.z), bflo(w.w), bfhi(w.w)};
#pragma unroll
            for (int e = 0; e < 8; ++e) f[e] = gelu_tanh_f(f[e]);
            u32x4 o = {cvtpk(f[0], f[1]), cvtpk(f[2], f[3]), cvtpk(f[4], f[5]), cvtpk(f[6], f[7])}; *(u32x4*)(pr + 8 * c.lane) = o;
        }
        {
            const u32x4 w = *(const u32x4*)(pr + 512 + 8 * c.lane); float f[8] = {bflo(w.x), bfhi(w.x), bflo(w.y), bfhi(w.y), bflo(w.z), bfhi(w.z), bflo(w.w), bfhi(w.w)};
            float s = 0.f;
#pragma unroll
            for (int e = 0; e < 8; ++e) { f[e] = gelu_tanh_f(f[e]); s += f[e]; }
            const float mean = wave_sum(s) * (1.f / 512.f); float q = 0.f;
#pragma unroll
            for (int e = 0; e < 8; ++e) { f[e] -= mean; q += f[e] * f[e]; }
            const float rstd = rsqrtf(wave_sum(q) * (1.f / 512.f) + EPS);
            const f32x4 g0 = ld4(sg + 8 * c.lane), g1 = ld4(sg + 8 * c.lane + 4);
            float gg[8] = {g0[0], g0[1], g0[2], g0[3], g1[0], g1[1], g1[2], g1[3]};
#pragma unroll
            for (int e = 0; e < 8; ++e) f[e] = f[e] * rstd * gg[e];
            u32x4 o = {cvtpk(f[0], f[1]), cvtpk(f[2], f[3]), cvtpk(f[4], f[5]), cvtpk(f[6], f[7])}; *(u32x4*)(pr + 512 + 8 * c.lane) = o;
        }
        if (row < NLAT) {
            const int s = row & (SEQ - 1), hj = c.lane >> 3, sub = c.lane & 7;
            bf16_t* kp = pr + 1536 + hj * 64 + 4 * sub;
            const f32x4 x1 = ldbf4(kp), x2 = ldbf4(kp + 32), cs = ld4(rc + s * 32 + 4 * sub), sn = ld4(rsn + s * 32 + 4 * sub);
            stbf4(kp, x1 * cs - x2 * sn); stbf4(kp + 32, x2 * cs + x1 * sn);
        }
    }
}

__device__ __forceinline__ void ew_odd_mla(const Ctx& c_, int i) {
    const Ctx c = make_ctx(c_.lds);
    KParams& P = kparams(); const bf16_t* PB = (const bf16_t*)(P.ws + WS_U + U_PB); bf16_t* A2 = (bf16_t*)(P.ws + WS_U + U_A2);
    const float* gq = P.in[23] + i * 256; const float* gkv = P.in[25] + i * 128; const float* rc = (const float*)(P.ws + WS_ROPED); const float* rsn = rc + SEQ * 16;
    for (int row = c.gw; row < MTOT; row += c.NGW) {
        const bf16_t* pr = PB + (size_t)row * OD_INP; bf16_t* ar = A2 + (size_t)row * MLA_K;
        f32x4 q = ldbf4(pr + 1536 + 4 * c.lane);
        const float rq = rsqrtf(wave_sum(q[0] * q[0] + q[1] * q[1] + q[2] * q[2] + q[3] * q[3]) * (1.f / 256.f) + EPS);
        stbf4(ar + 4 * c.lane, q * rq * ld4(gq + 4 * c.lane));
        const unsigned kw = *(const unsigned*)(pr + 1792 + 2 * c.lane); const float k0 = bflo(kw), k1 = bfhi(kw);
        const float rk = rsqrtf(wave_sum(k0 * k0 + k1 * k1) * (1.f / 128.f) + EPS);
        *(unsigned*)(ar + 256 + 2 * c.lane) = cvtpk(k0 * rk * gkv[2 * c.lane], k1 * rk * gkv[2 * c.lane + 1]);
        if (c.lane < 16) { float x1 = bf2f(pr[1920 + c.lane]), x2 = bf2f(pr[1920 + 16 + c.lane]);
            if (row < NLAT) { const int s = row & (SEQ - 1); const float cs = rc[s * 16 + c.lane], sn = rsn[s * 16 + c.lane]; const float o1 = x1 * cs - x2 * sn, o2 = x2 * cs + x1 * sn; x1 = o1; x2 = o2; }
            ar[384 + c.lane] = f2bf(x1); ar[384 + 16 + c.lane] = f2bf(x2); }
        else { *(unsigned*)(ar + 416 + 2 * (c.lane - 16)) = 0u; }
    }
}

__device__ __forceinline__ void ew_mid(const Ctx& c_, int l, int mtok, bool dry = false) {
    const Ctx c = make_ctx(c_.lds);
    KParams& P = kparams(); const float* mods = (const float*)(P.ws + WS_MODS); bf16_t* HB = (bf16_t*)(P.ws + WS_HB);
    const bf16_t* YB = (const bf16_t*)(P.ws + WS_U + U_YB);
    const bool odd = (l & 1) != 0; const int li = l >> 1;
    LAS float* wrl = (LAS float*)c.lds;
    if (odd) { for (int i = c.tid; i < DM * NEXP; i += 512) { const int col = i >> 3, e = i & 7; wrl[e * DM + col] = P.in[27][(size_t)li * DM * NEXP + i]; } __syncthreads(); }
    unsigned long long cw = 0ull; int st_e1 = 0, st_e2 = 0, st_l1 = 0, st_l2 = 0; float st_g1 = 0.f; int nrow = 0;
    int r0, r1; wave_rows(c, mtok, r0, r1);
    f32x4 G1[4], A2[4], B2[4]; int rcur = -1;
    f32x4 xn[4], yn[4];
    if (r0 < r1) {
#pragma unroll
        for (int j = 0; j < 4; ++j) { xn[j] = ldbf4(xrow_ptr(P, r0) + 4 * c.lane + 256 * j); yn[j] = ldbf4(YB + (size_t)r0 * DM + 4 * c.lane + 256 * j); } }
    for (int row = r0; row < r1; ++row, ++nrow) {
        bf16_t* xr = xrow_ptr(P, row); const int r = mod_r(row);
        if (r != rcur) { rcur = r; const float* mb = mods + (size_t)(l * 5 + r) * (NMOD * DM);
            ld_gate(G1, P.in[6] + (l * 4 + 1) * DM, mb + 2 * DM, c.lane); ld_mod(A2, B2, P.in[6] + (l * 4 + 2) * DM, mb + 3 * DM, mb + 4 * DM, c.lane); }
        f32x4 x[4], y[4], h[4];
#pragma unroll
        for (int j = 0; j < 4; ++j) { x[j] = xn[j]; y[j] = yn[j]; }
        if (row + 1 < r1) {
#pragma unroll
            for (int j = 0; j < 4; ++j) { xn[j] = ldbf4(xrow_ptr(P, row + 1) + 4 * c.lane + 256 * j); yn[j] = ldbf4(YB + (size_t)(row + 1) * DM + 4 * c.lane + 256 * j); } }
        resid_add2(x, y, G1);
        bf16_t* xw = dry ? (bf16_t*)(P.ws + WS_U + U_YS) + (size_t)row * DM : xr; bf16_t* hw = (dry ? (bf16_t*)(P.ws + WS_U + U_PB) : HB) + (size_t)row * DM;
#pragma unroll
        for (int j = 0; j < 4; ++j) stbf4(xw + 4 * c.lane + 256 * j, x[j]);
        norm_mod2(x, h, A2, B2);
        if ((odd && MOE_F8) || (!odd && FFN8(li))) {
            unsigned char* h8 = (unsigned char*)(dry ? (bf16_t*)(P.ws + WS_U + U_PB) : HB) + (size_t)row * DM;
#pragma unroll
            for (int j = 0; j < 4; ++j) *(unsigned*)(h8 + 4 * c.lane + 256 * j) = pk4_fp8(h[j][0] * F8_ACT_SCALE, h[j][1] * F8_ACT_SCALE, h[j][2] * F8_ACT_SCALE, h[j][3] * F8_ACT_SCALE);
        } else {
#pragma unroll
            for (int j = 0; j < 4; ++j) stbf4(hw + 4 * c.lane + 256 * j, h[j]);
        }
        if (odd && !dry) {
            float lg[8];
#pragma unroll
            for (int e = 0; e < 8; ++e) { float sacc = 0.f;
#pragma unroll
                for (int j = 0; j < 4; ++j) { const f32x4 w = *(const LAS f32x4*)(wrl + e * DM + 4 * c.lane + 256 * j); sacc += (h[j][0] * w[0] + h[j][1] * w[1]) + (h[j][2] * w[2] + h[j][3] * w[3]); }
                lg[e] = wave_sum(sacc); }
            int e1 = 0; float v1 = lg[0];
#pragma unroll
            for (int e = 1; e < 8; ++e) if (lg[e] > v1) { v1 = lg[e]; e1 = e; }
            int e2 = -1; float v2 = -3.0e38f;
#pragma unroll
            for (int e = 0; e < 8; ++e) if (e != e1 && lg[e] > v2) { v2 = lg[e]; e2 = e; }
            if (e2 < 0) e2 = (e1 + 1) & 7;
            const float g1 = 1.f / (1.f + expf(v2 - v1));
            const int l1 = (int)((cw >> (8 * e1)) & 0xffull); cw += 1ull << (8 * e1);
            const int l2 = (int)((cw >> (8 * e2)) & 0xffull); cw += 1ull << (8 * e2);
            if (c.lane == nrow) { st_e1 = e1; st_e2 = e2; st_l1 = l1; st_l2 = l2; st_g1 = g1; }
        }
    }
    if (odd && !dry) {
        unsigned* cnt = (unsigned*)(P.ws + WS_CTL) + CW_MOECNT + li * 64;
        int base = 0;
        if (c.lane < 8) { const unsigned wc = (unsigned)((cw >> (8 * c.lane)) & 0xffull); base = wc ? (int)atomicAdd(cnt + c.lane, wc) : 0; }
        const int b1 = __shfl(base, st_e1), b2 = __shfl(base, st_e2);
        if (c.lane < nrow) { const int row = r0 + c.lane; int4* ti = (int4*)(P.ws + WS_TOKINFO) + (size_t)row * 2;
            ti[0] = make_int4(st_e1, b1 + st_l1, st_e2, b2 + st_l2); ti[1] = make_int4(__float_as_int(st_g1), __float_as_int(1.f - st_g1), 0, 0); }
        __syncthreads();
    }
}

__device__ __forceinline__ void moe_offsets(KParams& P, int li, int (&toff)[9]) {
    const unsigned* cnt = (const unsigned*)(P.ws + WS_CTL) + CW_MOECNT + li * 64; int acc = 0;
#pragma unroll
    for (int e = 0; e < 8; ++e) { toff[e] = acc; const unsigned n = __builtin_amdgcn_readfirstlane(__hip_atomic_load(cnt + e, __ATOMIC_RELAXED, __HIP_MEMORY_SCOPE_AGENT)); acc += (int)((n + 255u) >> 8); }
    toff[8] = acc;
}
__device__ __forceinline__ void moe_gather(const Ctx& c_, int li, int mtok) {
    const Ctx c = make_ctx(c_.lds);
    KParams& P = kparams(); int toff[9]; moe_offsets(P, li, toff);
    int tv = 0;
#pragma unroll
    for (int e = 0; e < 8; ++e) tv = (c.lane == e) ? toff[e] : tv;
    const bf16_t* HB = (const bf16_t*)(P.ws + WS_HB); bf16_t* HS = (bf16_t*)(P.ws + WS_U + U_YS);
    int r0, r1; wave_rows(c, mtok, r0, r1);
    for (int row = r0; row < r1; ++row) {
        const int4* ti = (const int4*)(P.ws + WS_TOKINFO) + (size_t)row * 2; const int4 a = ti[0], b = ti[1];
        const int pA = __shfl(tv, a.x) * 256 + a.y, pB = __shfl(tv, a.z) * 256 + a.w;
        if (c.lane == 0) ((int4*)(P.ws + WS_TOKPOS))[row] = make_int4(pA, pB, b.x, b.y);
#if MOE_F8
        const u32x4 v0 = ((const u32x4*)((const unsigned char*)HB + (size_t)row * DM))[c.lane];
        ((u32x4*)((unsigned char*)HS + (size_t)pA * DM))[c.lane] = v0; ((u32x4*)((unsigned char*)HS + (size_t)pB * DM))[c.lane] = v0;
#else
        const u32x4* src = (const u32x4*)(HB + (size_t)row * DM); const u32x4 v0 = src[c.lane], v1 = src[64 + c.lane];
        u32x4* dA = (u32x4*)(HS + (size_t)pA * DM); u32x4* dB = (u32x4*)(HS + (size_t)pB * DM);
        dA[c.lane] = v0; dA[64 + c.lane] = v1; dB[c.lane] = v0; dB[64 + c.lane] = v1;
#endif
    }
}

__device__ __forceinline__ void ew_last(const Ctx& c_, int l, int mtok, bool dry = false) {
    const Ctx c = make_ctx(c_.lds);
    KParams& P = kparams(); const float* mods = (const float*)(P.ws + WS_MODS); bf16_t* HB = (bf16_t*)(P.ws + WS_HB);
    const bf16_t* YS = (const bf16_t*)(P.ws + WS_U + U_YS); const bool odd = (l & 1) != 0;
    int r0, r1; wave_rows(c, mtok, r0, r1);
    f32x4 G3[4], A0[4], B0[4]; int rcur = -1;
    f32x4 xn[4], yn[4];
#define EWL_LOAD(rw) do { const int _row = (rw); const bf16_t* _xr = xrow_ptr(P, _row); \
        if (odd) { const int4 tp = ((const int4*)(P.ws + WS_TOKPOS))[_row]; const float gA = __int_as_float(tp.z), gB = __int_as_float(tp.w); \
            _Pragma("unroll") for (int j = 0; j < 4; ++j) yn[j] = ldbf4(YS + (size_t)tp.x * DM + 4 * c.lane + 256 * j) * gA + ldbf4(YS + (size_t)tp.y * DM + 4 * c.lane + 256 * j) * gB; } \
        else { _Pragma("unroll") for (int j = 0; j < 4; ++j) yn[j] = ldbf4(YS + (size_t)_row * DM + 4 * c.lane + 256 * j); } \
        _Pragma("unroll") for (int j = 0; j < 4; ++j) xn[j] = ldbf4(_xr + 4 * c.lane + 256 * j); } while (0)
    if (r0 < r1) EWL_LOAD(r0);
    for (int row = r0; row < r1; ++row) {
        bf16_t* xr = xrow_ptr(P, row); const int r = mod_r(row);
        if (r != rcur) { rcur = r; const float* mb = mods + (size_t)(l * 5 + r) * (NMOD * DM);
            ld_gate(G3, P.in[6] + (l * 4 + 3) * DM, mb + 5 * DM, c.lane);
            if (l < 3) { const float* mn = mods + (size_t)((l + 1) * 5 + r) * (NMOD * DM); ld_mod(A0, B0, P.in[6] + ((l + 1) * 4 + 0) * DM, mn + 0 * DM, mn + 1 * DM, c.lane); } }
        f32x4 x[4], y[4], h[4];
#pragma unroll
        for (int j = 0; j < 4; ++j) { x[j] = xn[j]; y[j] = yn[j]; }
        if (row + 1 < r1) EWL_LOAD(row + 1);
        resid_add2(x, y, G3);
        bf16_t* hw = (dry ? (bf16_t*)(P.ws + WS_U + U_MIX) : HB) + (size_t)row * DM;
        if (l == 3 && !dry) { float* ow = P.out + (size_t)row * DM;
#pragma unroll
            for (int j = 0; j < 4; ++j) *(f32x4*)(ow + 4 * c.lane + 256 * j) = x[j]; }
        else { bf16_t* xw = dry ? (bf16_t*)(P.ws + WS_U + U_PB) + (size_t)row * DM : xr;
#pragma unroll
            for (int j = 0; j < 4; ++j) stbf4(xw + 4 * c.lane + 256 * j, x[j]); }
        if (l < 3) { norm_mod2(x, h, A0, B0);
#pragma unroll
            for (int j = 0; j < 4; ++j) stbf4(hw + 4 * c.lane + 256 * j, h[j]); }
    }
#undef EWL_LOAD
}

__device__ __forceinline__ void attn_even(const Ctx& c_, int l) {
    const Ctx c = make_ctx(c_.lds);
    KParams& P = kparams(); const int i = l >> 1; const bool need_ctx = l < 3;
    const bf16_t* PB = (const bf16_t*)(P.ws + WS_U + U_PB); bf16_t* MIX = (bf16_t*)(P.ws + WS_U + U_MIX);
    const int nchunk = need_ctx ? 264 : 256;
    for (int u = opaque_bid(); u < nchunk * 4; u += gridDim.x) att::sgu_unit(c.lds, PB, (const bf16_t*)(P.ws + WS_SGUW) + (size_t)i * 4 * 128 * 128, P.in[10] + i * 512, (const float*)(P.ws + WS_STATS), P.in[11] + i * 512, MIX, (u >> 2) * 128, u & 3);
    float d1 = 0.f, d2 = 0.f;
    if (c.lane < 64) { d1 = P.in[12][i * 64 + c.lane] * P.in[13][i * 64 + c.lane]; d2 = P.in[14][i * 64 + c.lane] * P.in[15][i * 64 + c.lane]; }
    const float lam_init = 0.8f - 0.6f * expf(-0.3f * (float)l);
    const float lam = expf(wave_sum(d1)) - expf(wave_sum(d2)) + lam_init;
    att::Args a;
    a.Q = PB; a.ldq = EV_IN; a.K = PB; a.ldk = EV_IN; a.V = PB; a.ldv = EV_IN; a.C = 0.125f * LOG2E;
    a.rcos = (const float*)(P.ws + WS_ROPEB); a.rsin = a.rcos + SEQ * 32; a.O = MIX; a.ldo = DM; a.g = 0; a.u0 = 0; a.rpb = nullptr;
    a.lam = lam; a.oscale = 1.f - lam_init; a.subg = P.in[16] + i * 128; a.nt_ctx = 4;
    const int nctxu = need_ctx ? 32 : 0, nu = nctxu + 1024;
    for (int u = xcd_unit_base(); u < nu; u += gridDim.x) {
        int b, h;
        if (u < nctxu) { b = u >> 3; h = (u >> 1) & 3; a.q_row0 = NLAT + b * CTXL + (u & 1) * 128; a.nt_lat = 0; a.rope = 0; }
        else { const int v = u - nctxu; b = v >> 8; h = (v >> 6) & 3; a.q_row0 = b * SEQ + (v & 63) * 128; a.nt_lat = SEQ / 64; a.rope = 0; }
        a.qcol = 1024 + h * 128; a.kcol = 1536 + h * 128; a.vcol = 2048 + h * 128; a.ocol = 512 + h * 128;
        a.kctx_row0 = NLAT + b * CTXL; a.klat_row0 = b * SEQ;
        att::attn_unit<64, 128, 128, 1>(c.lds, a);
    }
}
__device__ __forceinline__ void attn_odd_na(const Ctx& c_, int l) {
    const Ctx c = make_ctx(c_.lds);
    KParams& P = kparams(); const int i = l >> 1; const bool need_ctx = l < 3;
    const bf16_t* PB = (const bf16_t*)(P.ws + WS_U + U_PB); bf16_t* MIX = (bf16_t*)(P.ws + WS_U + U_MIX);
    att::Args a;
    a.Q = PB; a.ldq = OD_INP; a.K = PB; a.ldk = OD_INP; a.V = PB; a.ldv = OD_INP; a.C = 0.125f * LOG2E; a.rope = 0; a.rcos = nullptr; a.rsin = nullptr;
    a.O = MIX; a.ldo = DM; a.lam = 0.f; a.oscale = 1.f; a.subg = nullptr; a.nt_ctx = 4;
    const int nctxu = need_ctx ? 32 : 0, nu = nctxu + 1024;
    for (int u = xcd_unit_base(); u < nu; u += gridDim.x) {
        int b, h;
        if (u < nctxu) { b = u >> 3; h = u & 7; a.q_row0 = NLAT + b * CTXL; a.nt_lat = 0; a.g = 0; a.u0 = 0; a.klat_row0 = 0; }
        else { const int v = u - nctxu; b = v >> 8; h = (v >> 5) & 7; const int g = v & 31; a.g = g; a.u0 = min(max(4 * g - 4, 0), 116);
            a.q_row0 = b * SEQ + g * 256; a.nt_lat = 12; a.klat_row0 = b * SEQ + a.u0 * 64; }
        a.qcol = h * 64; a.kcol = 512 + h * 64; a.vcol = 1024 + h * 64; a.ocol = h * 64; a.kctx_row0 = NLAT + b * CTXL;
        a.rpb = P.in[22] + ((size_t)i * 8 + h) * 465;
        att::attn_unit<64, 64, 64, 2>(c.lds, a);
    }
}
__device__ __forceinline__ void attn_odd_mla(const Ctx& c_, int l) {
    const Ctx c = make_ctx(c_.lds);
    KParams& P = kparams(); const bool need_ctx = l < 3;
    const bf16_t* MO = (const bf16_t*)(P.ws + WS_U + U_MLAO); bf16_t* MIX = (bf16_t*)(P.ws + WS_U + U_MIX);
    att::Args a;
    a.Q = MO; a.ldq = MLA_N; a.K = MO; a.ldk = MLA_N; a.V = MO; a.ldv = MLA_N; a.C = 0.10206207261596575f * LOG2E;
    a.rcos = (const float*)(P.ws + WS_ROPED); a.rsin = a.rcos + SEQ * 16; a.O = MIX; a.ldo = DM; a.g = 0; a.u0 = 0; a.rpb = nullptr; a.lam = 0.f; a.oscale = 1.f; a.subg = nullptr; a.nt_ctx = 4;
    const int nctxu = need_ctx ? 16 : 0, nu = nctxu + 512;
    for (int u = xcd_unit_base(); u < nu; u += gridDim.x) {
        int b, h;
        if (u < nctxu) { b = u >> 2; h = u & 3; a.q_row0 = NLAT + b * CTXL; a.nt_lat = 0; a.rope = 0; }
        else { const int v = u - nctxu; b = v >> 7; h = (v >> 5) & 3; a.q_row0 = b * SEQ + (v & 31) * 256; a.nt_lat = SEQ / 64; a.rope = 2; }
        a.qcol = h * 96; a.kcol = 384 + h * 96; a.vcol = 768 + h * 128; a.ocol = 512 + h * 128; a.kctx_row0 = NLAT + b * CTXL; a.klat_row0 = b * SEQ;
        att::attn_unit<96, 96, 128, 0>(c.lds, a);
    }
}

constexpr int N_PHASES = 2 + 2 * (7 + 9);
__global__ void __launch_bounds__(512, 2) fwd_kernel(Params prm) {
    extern __shared__ __attribute__((aligned(16))) unsigned char lds_raw[];
    LAS unsigned char* lds = (LAS unsigned char*)lds_raw;
    const Ctx c{lds, 0, 0, 0, 0, 0};
    for (int u = threadIdx.x; u < (LDS_BYTES - LDS_MISC) / 4; u += 512) ((LAS unsigned*)(lds + LDS_MISC))[u] = 0u;
    __syncthreads();
    XcdBarrier bar;
    { unsigned char* ws0 = kparams().ws; bar.bar = (unsigned*)(ws0 + WS_CTL) + CW_BAR; bar.x = 0; bar.st = nullptr;
#if !MK_PER_PHASE
      bar = xcd_barrier_post((unsigned*)(ws0 + WS_CTL) + CW_BAR, (volatile LAS unsigned*)(lds + LDS_MISC + 32));
#endif
    }
    int ph = 0;
#ifndef PMASK
#define PMASK 0xffffffffu
#endif
#define PM(b) ((PMASK >> (b)) & 1u)
#define PH_ON() (ph >= kparams().ph_lo && ph < kparams().ph_hi)
#define PH_END() do { if (ph >= kparams().ph_lo && ph + 1 < kparams().ph_hi) xcd_barrier(bar); ++ph; } while (0)
#define WSP(off) ((bf16_t*)(ws + (off)))
#define HB WSP(WS_HB)
#define PB WSP(WS_U + U_PB)
#define MIX WSP(WS_U + U_MIX)
#define YB WSP(WS_U + U_YB)
#define HID WSP(WS_U + U_HID)
#define YS WSP(WS_U + U_YS)
#define A2 WSP(WS_U + U_A2)
#define MO WSP(WS_U + U_MLAO)

    if (PM(0) && PH_ON()) for (int rep = 0; rep < DUPN(0); ++rep) { prologue0(c); __syncthreads(); }
    PH_END();
    if (PM(1) && PH_ON()) for (int rep = 0; rep < DUPN(1); ++rep) ew_first(c);
    PH_END();
    for (int lp = 0; lp < 2; ++lp) {
        {
            const int l = 2 * lp, i = lp; const int mtok = l < 3 ? MTOT : NLAT, nMt = mtok / 256;
            if (PM(2) && PH_ON()) for (int rep = 0; rep < DUPN(2); ++rep) { unsigned char* ws = kparams().ws; pg8::Gemm g{}; g.A = HB; g.lda = DM; g.Bt = (const bf16_t*)(ws + WS_WINE) + (size_t)i * EV_IN * DM; g.K = DM; g.nM = MTOT / 256; g.nN = EV_IN / 256; g.grouped = 0; g.estride = 0;
                pg8::EpiEvenIn E{PB, EV_IN, (f32x2*)(ws + WS_STATS), (const float*)(ws + WS_ROPEB), (const float*)(ws + WS_ROPEB) + SEQ * 32}; gemm_even_in(lds, g, E); if (rep == 0) convert_moe_tail(c, i, 0, 7296, (MTOT / 256) * (EV_IN / 256)); }
            PH_END();
            if (PM(4) && PH_ON()) for (int rep = 0; rep < DUPN(4); ++rep) attn_even(c, l);
            PH_END();
            if (PM(5) && PH_ON()) for (int rep = 0; rep < DUPN(5); ++rep) { unsigned char* ws = kparams().ws; pg8::Gemm g{}; g.A = MIX; g.lda = DM; g.Bt = (const bf16_t*)(ws + WS_WOUTE) + (size_t)i * DM * DM; g.K = DM; g.nM = nMt; g.nN = DM / 256; g.grouped = 0; g.estride = 0;
                gemm_bf16(lds, g, YB, DM); if (rep == 0) convert_moe_tail(c, i, 7296, 14592, nMt * (DM / 256)); }
            PH_END();
            if (PM(6) && PH_ON()) { if (DUPN(6) > 1) ew_mid(c, l, mtok, true); ew_mid(c, l, mtok); }
            PH_END();
            if (PM(7) && PH_ON()) for (int rep = 0; rep < DUPN(7); ++rep) { unsigned char* ws = kparams().ws; pg8::Gemm g{}; g.A = HB; g.lda = DM; g.Bt = (const unsigned char*)(ws + WS_W13E) + (size_t)i * 2 * DFF * DM * 2; g.K = DM; g.nM = nMt; g.nN = 2 * DFF / 256; g.grouped = 0; g.estride = 0;
                if (FFN8(i)) gemm8_swiglu8(lds, g, (unsigned char*)HID, DFF); else gemm_swiglu(lds, g, HID, DFF);
                if (rep == 0) convert_moe_tail(c, i, 14592, 20224, nMt * (2 * DFF / 256)); }
            PH_END();
            if (PM(8) && PH_ON()) for (int rep = 0; rep < DUPN(8); ++rep) { unsigned char* ws = kparams().ws; pg8::Gemm g{}; g.A = HID; g.lda = DFF; g.Bt = (const unsigned char*)(ws + WS_W2E) + (size_t)i * DM * DFF * 2; g.K = DFF; g.nM = nMt; g.nN = DM / 256; g.grouped = 0; g.estride = 0;
                if (FFN8(i)) gemm8_bf16(lds, g, YS, DM); else gemm_bf16(lds, g, YS, DM);
                if (rep == 0) convert_moe_tail(c, i, 20224, MOE_CVT_ITEMS, nMt * (DM / 256)); }
            PH_END();
            if (PM(9) && PH_ON()) { if (DUPN(9) > 1) ew_last(c, l, mtok, true); ew_last(c, l, mtok); }
            PH_END();
        }
        {
            const int l = 2 * lp + 1, i = lp; const int mtok = l < 3 ? MTOT : NLAT, nMt = mtok / 256;
            if (PM(10) && PH_ON()) for (int rep = 0; rep < DUPN(10); ++rep) { unsigned char* ws = kparams().ws; pg8::Gemm g{}; g.A = HB; g.lda = DM; g.Bt = (const bf16_t*)(ws + WS_WINO) + (size_t)i * OD_INP * DM; g.K = DM; g.nM = MTOT / 256; g.nN = OD_INP / 256; g.grouped = 0; g.estride = 0;
                pg8::EpiOddIn E{PB, OD_INP, (float*)(ws + WS_STATS), (const float*)(ws + WS_ROPED), (const float*)(ws + WS_ROPED) + SEQ * 16}; gemm_odd_in(lds, g, E); }
            PH_END();
            if (PM(12) && PH_ON()) for (int rep = 0; rep < DUPN(12); ++rep) { unsigned char* ws = kparams().ws; pg8::Gemm g{}; g.A = PB + 1536; g.lda = OD_INP; g.Bt = (const bf16_t*)(ws + WS_WMLA) + (size_t)i * MLA_N * MLA_K; g.K = MLA_K; g.nM = MTOT / 256; g.nN = MLA_N / 256; g.grouped = 0; g.estride = 0;
                pg8::EpiMlaUp E{MO, MLA_N, (const float*)(ws + WS_STATS)}; gemm_mla_up(lds, g, E); }
            PH_END();
            if (PH_ON()) { if (PM(13)) for (int rep = 0; rep < DUPN(13); ++rep) attn_odd_na(c, l); if (PM(14)) for (int rep = 0; rep < DUPN(14); ++rep) attn_odd_mla(c, l); }
            PH_END();
            if (PM(15) && PH_ON()) for (int rep = 0; rep < DUPN(15); ++rep) { unsigned char* ws = kparams().ws; pg8::Gemm g{}; g.A = MIX; g.lda = DM; g.Bt = (const bf16_t*)(ws + WS_WOUTO) + (size_t)i * DM * DM; g.K = DM; g.nM = nMt; g.nN = DM / 256; g.grouped = 0; g.estride = 0;
                gemm_bf16(lds, g, YB, DM); }
            PH_END();
            if (PM(16) && PH_ON()) { if (DUPN(16) > 1) ew_mid(c, l, mtok, true); ew_mid(c, l, mtok); }
            PH_END();
            if (PM(17) && PH_ON()) for (int rep = 0; rep < DUPN(17); ++rep) moe_gather(c, i, mtok);
            PH_END();
            if (PM(18) && PH_ON()) for (int rep = 0; rep < DUPN(18); ++rep) { unsigned char* ws = kparams().ws; pg8::Gemm g{}; g.A = YS; g.lda = DM; g.Bt = (const bf16_t*)(ws + WS_W13M); g.K = DM; g.nN = 2 * DFFE / 256; g.grouped = 1; g.estride = (size_t)2 * DFFE * DM;
                moe_offsets(kparams(), i, g.toff); g.nM = g.toff[8];
#if MOE_F8
                gemm8_swiglu8(lds, g, (unsigned char*)HID, DFFE);
#else
                gemm_swiglu(lds, g, HID, DFFE);
#endif
            }
            PH_END();
            if (PM(19) && PH_ON()) for (int rep = 0; rep < DUPN(19); ++rep) { unsigned char* ws = kparams().ws; pg8::Gemm g{}; g.A = HID; g.lda = DFFE; g.Bt = (const bf16_t*)(ws + WS_W2M); g.K = DFFE; g.nN = DM / 256; g.grouped = 1; g.estride = (size_t)DM * DFFE;
                moe_offsets(kparams(), i, g.toff); g.nM = g.toff[8];
#if MOE_F8
                gemm8_bf16(lds, g, YS, DM);
#else
                gemm_bf16(lds, g, YS, DM);
#endif
            }
            PH_END();
            if (PM(20) && PH_ON()) { if (DUPN(20) > 1) ew_last(c, l, mtok, true); ew_last(c, l, mtok); }
            PH_END();
        }
    }
#undef PH_ON
#undef PH_END
#undef HB
#undef PB
#undef MIX
#undef YB
#undef HID
#undef YS
#undef A2
#undef MO
}

extern "C" void kernel_launch(void* const* d_in, const int* in_sizes, int n_in, void* d_out, int out_size, void* d_ws, size_t ws_size, hipStream_t stream) {
    static int grid = 0;
    if (grid == 0) {
        int dev = 0, cus = 0;
        if (n_in != 31 || out_size != NLAT * DM || ws_size < WS_END) { fprintf(stderr, "kernel_launch: unexpected shapes or workspace (n_in %d out %d ws %zu need %zu)\n", n_in, out_size, ws_size, (size_t)WS_END); grid = -1; }
        else if (hipGetDevice(&dev) != hipSuccess || hipDeviceGetAttribute(&cus, hipDeviceAttributeMultiprocessorCount, dev) != hipSuccess) grid = -1;
        else if (hipFuncSetAttribute((const void*)fwd_kernel, hipFuncAttributeMaxDynamicSharedMemorySize, LDS_BYTES) != hipSuccess) grid = -1;
        else { int per_cu = 0; (void)hipOccupancyMaxActiveBlocksPerMultiprocessor(&per_cu, (const void*)fwd_kernel, 512, LDS_BYTES); (void)hipGetLastError(); grid = cus; }
    }
    if (grid < 0) { (void)hipMemsetAsync(d_out, 0, (size_t)out_size * 4, stream); return; }
    (void)hipMemsetAsync((char*)d_ws + WS_CTL, 0, CTL_BYTES, stream);
    Params p{};
    for (int i = 0; i < 31; ++i) p.in[i] = (const float*)d_in[i];
    p.out = (float*)d_out; p.ws = (unsigned char*)d_ws;
#if MK_PER_PHASE
    for (int k = 0; k < N_PHASES; ++k) { p.ph_lo = k; p.ph_hi = k + 1; hipLaunchKernelGGL(fwd_kernel, dim3(grid), dim3(512), LDS_BYTES, stream, p); }
#else
    p.ph_lo = 0; p.ph_hi = N_PHASES;
    hipLaunchKernelGGL(fwd_kernel, dim3(grid), dim3(512), LDS_BYTES, stream, p);
#endif
}
```

```cpp
#include <hip/hip_runtime.h>
#include <stdint.h>
#include <stdio.h>

#ifndef MK_PER_PHASE
#define MK_PER_PHASE 0
#endif
#ifndef DUP_MASK
#define DUP_MASK 0u
#endif
#define DUPN(b) (1 + (int)((DUP_MASK >> (b)) & 1u))
#ifndef ATT_X
#define ATT_X 0
#endif
#ifndef FFN_F8
#define FFN_F8 1
#endif
#ifndef FFN_F8_FROM
#define FFN_F8_FROM 1
#endif
#define FFN8(i) (FFN_F8 && (i) >= FFN_F8_FROM)
#ifndef MOE_F8
#define MOE_F8 1
#endif

#define LAS __attribute__((address_space(3)))
typedef unsigned short bf16_t;
typedef short bf16x8 __attribute__((ext_vector_type(8)));
typedef short s16x4 __attribute__((ext_vector_type(4)));
typedef float f32x4 __attribute__((ext_vector_type(4)));
typedef float f32x2 __attribute__((ext_vector_type(2)));
typedef float f32x16 __attribute__((ext_vector_type(16)));
typedef unsigned u32x4 __attribute__((ext_vector_type(4)));
typedef unsigned u32x2 __attribute__((ext_vector_type(2)));

constexpr int DM = 1024, NB = 4, SEQ = 8192, NLAT = NB * SEQ, CTXL = 256, NCTX = NB * CTXL, MTOT = NLAT + NCTX;
constexpr int NMOD = 6;
constexpr int EV_IN = 2560, OD_IN = 1952, OD_INP = 2048, DFF = 2816, DFFE = 3584, NEXP = 8;
constexpr int MLA_N = 1280, MLA_K = 512;
constexpr int MS_MAX = 2 * MTOT + NEXP * 256;
constexpr float EPS = 1e-6f;
constexpr float LOG2E = 1.4426950408889634f;

constexpr size_t MiB = (size_t)1 << 20;
constexpr size_t WS_CTL = 0, CTL_BYTES = MiB;
constexpr size_t WS_MODS = 1 * MiB;
constexpr size_t WS_ROPEB = 2 * MiB;
constexpr size_t WS_ROPED = 4 * MiB;
constexpr size_t WS_SGUW = 5 * MiB;
constexpr size_t WS_TOKINFO = 6 * MiB;
constexpr size_t WS_TOKPOS = 8 * MiB;
constexpr size_t WS_CTXX = 10 * MiB;
constexpr size_t WS_WMLA = 14 * MiB;
constexpr size_t WS_WINE = 17 * MiB;
constexpr size_t WS_WOUTE = 27 * MiB;
constexpr size_t WS_W13E = 31 * MiB;
constexpr size_t WS_W2E = 53 * MiB;
constexpr size_t WS_WINO = 64 * MiB;
constexpr size_t WS_WOUTO = 72 * MiB;
constexpr size_t WS_W13M = 76 * MiB;
constexpr size_t WS_W2M = 188 * MiB;
constexpr size_t WS_HB = 244 * MiB;
constexpr size_t WS_U = 310 * MiB;
constexpr size_t U_PB = 0;
constexpr size_t U_MIX = 165 * MiB;
constexpr size_t U_A2 = 231 * MiB;
constexpr size_t U_MLAO = 264 * MiB;
constexpr size_t U_YB = 347 * MiB;
constexpr size_t U_HID = 0;
constexpr size_t U_XB = 549 * MiB;
constexpr size_t U_YS = 413 * MiB;
constexpr size_t WS_STATS = WS_U + 616 * MiB;
constexpr size_t WS_END = WS_STATS + 4 * MiB;
static_assert((size_t)MS_MAX * DFFE * (MOE_F8 ? 1 : 2) <= 347 * MiB && (size_t)MTOT * DFF * 2 <= 347 * MiB, "hid must stay clear of YB");
static_assert(U_YS + (size_t)MS_MAX * DM * 2 <= U_XB && U_XB + (size_t)MTOT * DM * 2 <= 616 * MiB, "ys / xb fit");

constexpr int CW_BAR = 4096;
constexpr int CW_MOECNT = 1024;

constexpr int LDS_BYTES = 147456;
constexpr int LDS_MISC = 131072;

__device__ __forceinline__ unsigned cvtpk(float lo, float hi) { unsigned r; asm volatile("v_cvt_pk_bf16_f32 %0, %1, %2" : "=v"(r) : "v"(lo), "v"(hi)); return r; }
__device__ __forceinline__ float bf2f(unsigned short b) { return __uint_as_float(((unsigned)b) << 16); }
__device__ __forceinline__ float bflo(unsigned w) { return __uint_as_float(w << 16); }
__device__ __forceinline__ float bfhi(unsigned w) { return __uint_as_float(w & 0xffff0000u); }
__device__ __forceinline__ bf16_t f2bf(float f) { return (bf16_t)(cvtpk(f, 0.f) & 0xffffu); }
typedef int i32x8 __attribute__((ext_vector_type(8)));
typedef int i32x4 __attribute__((ext_vector_type(4)));
constexpr float F8_ACT_SCALE = 4.f, F8_W_SCALE = 64.f, F8_INV = 1.f / (F8_ACT_SCALE * F8_W_SCALE);
__device__ __forceinline__ unsigned pk4_fp8(float a, float b, float c, float d) {
    a = __builtin_amdgcn_fmed3f(a, -448.f, 448.f); b = __builtin_amdgcn_fmed3f(b, -448.f, 448.f); c = __builtin_amdgcn_fmed3f(c, -448.f, 448.f); d = __builtin_amdgcn_fmed3f(d, -448.f, 448.f);
    int w = 0; w = __builtin_amdgcn_cvt_pk_fp8_f32(a, b, w, false); w = __builtin_amdgcn_cvt_pk_fp8_f32(c, d, w, true); return (unsigned)w; }
__device__ __forceinline__ float wave_sum(float v) {
#pragma unroll
    for (int o = 1; o < 64; o <<= 1) v += __shfl_xor(v, o);
    return v;
}
__device__ __forceinline__ float fast_exp2(float x) { return __builtin_amdgcn_exp2f(x); }
__device__ __forceinline__ float fast_rcp(float x) { return __builtin_amdgcn_rcpf(x); }
__device__ __forceinline__ float silu_f(float x) { return x * fast_rcp(1.f + fast_exp2(-x * LOG2E)); }
__device__ __forceinline__ float gelu_tanh_f(float x) { const float u = 0.7978845608028654f * (x + 0.044715f * x * x * x); return x * fast_rcp(1.f + fast_exp2(-2.f * LOG2E * u)); }
#define LDS_WAIT() asm volatile("s_waitcnt lgkmcnt(0)" ::: "memory")
#define VM_WAIT() asm volatile("s_waitcnt vmcnt(0)" ::: "memory")
__device__ __forceinline__ int opaque_bid() { int b = blockIdx.x; asm volatile("" : "+s"(b)); return b; }
__device__ __forceinline__ int xcd_unit_base() { const int b = opaque_bid(), G = (int)gridDim.x; return (G % 8 == 0) ? (b & 7) * (G >> 3) + (b >> 3) : b; }
__device__ __forceinline__ int opaque_tid() { int t = threadIdx.x; asm volatile("" : "+v"(t)); return t; }

#define XB_TMO      128
#define XB_XCNT(j)  (256  + 64 * (j))
#define XB_XSUB(j)  (1280 + 64 * (j))
#define XB_XGEN(j)  (2304 + 64 * (j))
#define XB_TOP      3328
#define XB_TOPGEN   3392
#define XCD_BAR_WORDS 3456
#define XB_SPIN_CAP (1u << 22)
__device__ __forceinline__ unsigned xb_ld(unsigned* p)              { return __hip_atomic_load(p, __ATOMIC_RELAXED, __HIP_MEMORY_SCOPE_AGENT); }
__device__ __forceinline__ unsigned xb_add(unsigned* p, unsigned v) { return __hip_atomic_fetch_add(p, v, __ATOMIC_RELAXED, __HIP_MEMORY_SCOPE_AGENT); }
__device__ __forceinline__ unsigned xb_xcc_id() { return (unsigned)__builtin_amdgcn_s_getreg((3 << 11) | 20) & 0xFu; }
#define XB_SPIN(cond, bar) do { unsigned _sp = 0; while (cond) { __builtin_amdgcn_s_sleep(1); \
    if ((++_sp & 255u) == 0u) { if (xb_ld(&(bar)[XB_TMO])) break; if (_sp > XB_SPIN_CAP) { atomicAdd(&(bar)[XB_TMO], 1u); break; } } } } while (0)
struct XcdBarrier { unsigned* bar; unsigned x; volatile LAS unsigned* st; };
__device__ __forceinline__ XcdBarrier xcd_barrier_post(unsigned* bar, volatile LAS unsigned* st) {
    XcdBarrier b; b.bar = bar; b.x = xb_xcc_id(); b.st = st;
    if (threadIdx.x == 0) (void)xb_add(&bar[XB_XCNT(b.x)], 1u);
    return b;
}
__device__ __forceinline__ void xcd_barrier_complete(unsigned* bar, unsigned x, unsigned& nloc, unsigned& nx) {
    const unsigned G = gridDim.x * gridDim.y * gridDim.z;
    unsigned sum, cnt, mine, sp = 0u;
    for (;;) {
        sum = 0u; cnt = 0u; mine = 0u;
#pragma unroll
        for (unsigned j = 0; j < 16; ++j) { const unsigned c = xb_ld(&bar[XB_XCNT(j)]); sum += c; cnt += (c > 0u) ? 1u : 0u; mine = (j == x) ? c : mine; }
        if (sum == G) break;
        __builtin_amdgcn_s_sleep(1);
        if ((++sp & 255u) == 0u) { if (xb_ld(&bar[XB_TMO])) break; if (sp > XB_SPIN_CAP) { atomicAdd(&bar[XB_TMO], 1u); break; } }
    }
    nloc = mine > 0u ? mine : 1u; nx = cnt > 0u ? cnt : 1u;
}
__device__ __forceinline__ void xcd_barrier(const XcdBarrier& b) {
    asm volatile("s_waitcnt vmcnt(0)" ::: "memory");
    __syncthreads();
    if (threadIdx.x == 0) {
        unsigned* bar = b.bar;
        __builtin_amdgcn_s_waitcnt(0);
        unsigned nloc = b.st[0], nx = b.st[1];
        if (nloc == 0u) { xcd_barrier_complete(bar, b.x, nloc, nx); b.st[0] = nloc; b.st[1] = nx; }
        const unsigned old = xb_add(&bar[XB_XSUB(b.x)], 1u);
        const unsigned gen = old / nloc;
        if (old + 1u == (gen + 1u) * nloc) {
            __builtin_amdgcn_fence(__ATOMIC_RELEASE, "agent");
            asm volatile("s_waitcnt vmcnt(0)" ::: "memory");
            const unsigned og = xb_add(&bar[XB_TOP], 1u);
            const unsigned tg = og / nx;
            if (og + 1u == (tg + 1u) * nx) xb_add(&bar[XB_TOPGEN], 1u);
            else XB_SPIN(xb_ld(&bar[XB_TOPGEN]) == tg, bar);
            __builtin_amdgcn_fence(__ATOMIC_ACQUIRE, "agent");
            xb_add(&bar[XB_XGEN(b.x)], 1u);
            asm volatile("s_waitcnt vmcnt(0)" ::: "memory");
        } else {
            XB_SPIN(xb_ld(&bar[XB_XGEN(b.x)]) == gen, bar);
            __builtin_amdgcn_fence(__ATOMIC_ACQUIRE, "agent");
            asm volatile("s_waitcnt vmcnt(0)" ::: "memory");
        }
    }
    __syncthreads();
}

namespace pg8 {
constexpr int BM = 256, BK = 64, HALF = 128, HTB = HALF * BK * 2, STAGE_BYTES = 8 * HTB, NXCD = 8, WGM = 8;
__device__ __forceinline__ int lds_byte(int r, int c) { const int st = (r >> 4) * 2 + (c >> 5), rr = r & 15, cc = c & 31, ob = rr * 64 + cc * 2; return st * 1024 + (ob ^ (((ob >> 9) & 1) << 5)); }
__device__ __forceinline__ void stage_rc(int b, int& R, int& C) { const int st = b / 1024, sb = b % 1024, swz = sb ^ (((sb >> 9) & 1) << 5); R = (st >> 1) * 16 + swz / 64; C = (st & 1) * 32 + (swz % 64) / 2; }
__device__ __forceinline__ int perm32(int rho) { const int n = rho >> 4, i = rho & 15; return 8 * (i >> 2) + 4 * n + (i & 3); }
struct Unit { int pm, pn, e; };
struct Gemm {
    const void* A; int lda;
    const void* Bt; int K;
    int nM, nN;
    int grouped; int toff[9]; size_t estride;
};
struct StaticOrder {
    int nM, nN, nwg, G, c;
    __device__ void init(int nM_, int nN_, int G_, int c_) { nM = nM_; nN = nN_; nwg = nM * nN; G = G_; c = c_; }
    __device__ __forceinline__ bool next(int i, Unit& u) const {
        const long L = (long)i * G + c; if (L >= nwg) return false;
        int wgid = (int)L; { const int q = nwg / NXCD, r = nwg % NXCD, xcd = wgid % NXCD, off = wgid / NXCD; wgid = (xcd < r ? xcd * (q + 1) : r * (q + 1) + (xcd - r) * q) + off; }
        const int nig = WGM * nN, gid = wgid / nig, fm = gid * WGM, gsz = (nM - fm) < WGM ? (nM - fm) : WGM;
        u.pm = fm + ((wgid % nig) % gsz); u.pn = (wgid % nig) / gsz; u.e = 0; return true;
    }
};
struct EpiBf16 {
    bf16_t* O; int ldc; float scale;
    __device__ __forceinline__ void operator()(const f32x4 (&acc)[2][2][4][2], const Unit& u, int wr, int wc, int fr, int fq) const {
        const int row0 = u.pm * BM + wr * 64 + fr, col0 = u.pn * BM + wc * 32 + 8 * fq;
#pragma unroll
        for (int ai = 0; ai < 2; ++ai)
#pragma unroll
            for (int m = 0; m < 4; ++m) { bf16_t* rowp = O + (size_t)(row0 + ai * HALF + m * 16) * ldc + col0;
#pragma unroll
                for (int bj = 0; bj < 2; ++bj) { const f32x4 v0 = acc[ai][bj][m][0] * scale, v1 = acc[ai][bj][m][1] * scale;
                    u32x4 w; w.x = cvtpk(v0[0], v0[1]); w.y = cvtpk(v0[2], v0[3]); w.z = cvtpk(v1[0], v1[1]); w.w = cvtpk(v1[2], v1[3]);
                    *(u32x4*)(rowp + bj * HALF) = w; } }
    }
};
struct EpiSwiGLU {
    bf16_t* O; int ldc;
    __device__ __forceinline__ void operator()(const f32x4 (&acc)[2][2][4][2], const Unit& u, int wr, int wc, int fr, int fq) const {
        const int row0 = u.pm * BM + wr * 64 + fr, col0 = u.pn * HALF + wc * 32 + 8 * fq;
#pragma unroll
        for (int ai = 0; ai < 2; ++ai)
#pragma unroll
            for (int m = 0; m < 4; ++m) { bf16_t* rowp = O + (size_t)(row0 + ai * HALF + m * 16) * ldc + col0;
                float r[8];
#pragma unroll
                for (int n = 0; n < 2; ++n)
#pragma unroll
                    for (int j = 0; j < 4; ++j) r[n * 4 + j] = silu_f(acc[ai][0][m][n][j]) * acc[ai][1][m][n][j];
                u32x4 w; w.x = cvtpk(r[0], r[1]); w.y = cvtpk(r[2], r[3]); w.z = cvtpk(r[4], r[5]); w.w = cvtpk(r[6], r[7]);
                *(u32x4*)rowp = w; }
    }
};

struct EpiEvenIn {
    bf16_t* O; int ldc; f32x2* stats; const float* rcos; const float* rsin;
    __device__ __forceinline__ void operator()(const f32x4 (&acc)[2][2][4][2], const Unit& u, int wr, int wc, int fr, int fq) const {
        int upm = u.pm, upn = u.pn; asm volatile("" : "+s"(upm), "+s"(upn));
        const int row0 = upm * BM + wr * 64 + fr, col0 = upn * BM + wc * 32 + 8 * fq;
        const int kind = upn < 2 ? 0 : (upn < 4 ? 1 : (upn < 8 ? 2 : 3)); const bool lat = upm < NLAT / BM; const int t4 = 4 * (4 * (wc & 1) + fq);
#pragma unroll
        for (int ai = 0; ai < 2; ++ai)
#pragma unroll
            for (int m = 0; m < 4; ++m) { const int row = row0 + ai * HALF + m * 16; bf16_t* rowp = O + (size_t)row * ldc + col0;
                f32x4 cs = {1.f, 1.f, 1.f, 1.f}, sn = {0.f, 0.f, 0.f, 0.f}; float s1 = 0.f, s2 = 0.f;
                if (kind == 2 && lat) { const int sp = row & (SEQ - 1); cs = *(const f32x4*)(rcos + sp * 32 + t4); sn = *(const f32x4*)(rsin + sp * 32 + t4); }
#pragma unroll
                for (int bj = 0; bj < 2; ++bj) { f32x4 v0 = acc[ai][bj][m][0], v1 = acc[ai][bj][m][1];
                    if (kind < 2) {
#pragma unroll
                        for (int j = 0; j < 4; ++j) { v0[j] = gelu_tanh_f(v0[j]); v1[j] = gelu_tanh_f(v1[j]); }
                        if (kind == 1) { s1 += (v0[0] + v0[1]) + (v0[2] + v0[3]) + (v1[0] + v1[1]) + (v1[2] + v1[3]);
                            s2 += (v0[0] * v0[0] + v0[1] * v0[1]) + (v0[2] * v0[2] + v0[3] * v0[3]) + (v1[0] * v1[0] + v1[1] * v1[1]) + (v1[2] * v1[2] + v1[3] * v1[3]); } }
                    else if (kind == 2) { const f32x4 o0 = v0 * cs - v1 * sn, o1 = v1 * cs + v0 * sn; v0 = o0; v1 = o1; }
                    u32x4 w; w.x = cvtpk(v0[0], v0[1]); w.y = cvtpk(v0[2], v0[3]); w.z = cvtpk(v1[0], v1[1]); w.w = cvtpk(v1[2], v1[3]);
                    *(u32x4*)(rowp + bj * HALF) = w; }
                if (kind == 1) { s1 += __shfl_xor(s1, 16); s1 += __shfl_xor(s1, 32); s2 += __shfl_xor(s2, 16); s2 += __shfl_xor(s2, 32);
                    if (fq == 0) stats[(size_t)row * 8 + (upn - 2) * 4 + wc] = (f32x2){s1, s2}; } }
    }
};
struct EpiOddIn {
    bf16_t* O; int ldc; float* stats; const float* rcos; const float* rsin;
    __device__ __forceinline__ void operator()(const f32x4 (&acc)[2][2][4][2], const Unit& u, int wr, int wc, int fr, int fq) const {
        int upm = u.pm, upn = u.pn; asm volatile("" : "+s"(upm), "+s"(upn));
        const int row0 = upm * BM + wr * 64 + fr, col0 = upn * BM + wc * 32 + 8 * fq; const bool lat = upm < NLAT / BM;
#pragma unroll
        for (int ai = 0; ai < 2; ++ai)
#pragma unroll
            for (int m = 0; m < 4; ++m) { const int row = row0 + ai * HALF + m * 16; bf16_t* rowp = O + (size_t)row * ldc + col0; float ss = 0.f;
#pragma unroll
                for (int bj = 0; bj < 2; ++bj) { f32x4 v0 = acc[ai][bj][m][0], v1 = acc[ai][bj][m][1];
                    if (upn == 6 || (upn == 7 && bj == 0)) ss += (v0[0] * v0[0] + v0[1] * v0[1]) + (v0[2] * v0[2] + v0[3] * v0[3]) + (v1[0] * v1[0] + v1[1] * v1[1]) + (v1[2] * v1[2] + v1[3] * v1[3]);
                    if (upn == 7 && bj == 1 && wc == 0 && lat) { const int sp = row & (SEQ - 1); const f32x4 cs = *(const f32x4*)(rcos + sp * 16 + 4 * fq), sn = *(const f32x4*)(rsin + sp * 16 + 4 * fq);
                        const f32x4 o0 = v0 * cs - v1 * sn, o1 = v1 * cs + v0 * sn; v0 = o0; v1 = o1; }
                    u32x4 w; w.x = cvtpk(v0[0], v0[1]); w.y = cvtpk(v0[2], v0[3]); w.z = cvtpk(v1[0], v1[1]); w.w = cvtpk(v1[2], v1[3]);
                    *(u32x4*)(rowp + bj * HALF) = w; }
                if (upn >= 6) { ss += __shfl_xor(ss, 16); ss += __shfl_xor(ss, 32); if (fq == 0) stats[(size_t)row * 8 + (upn - 6) * 4 + wc] = ss; } }
    }
};
struct EpiMlaUp {
    bf16_t* O; int ldc; const float* stats;
    __device__ __forceinline__ void operator()(const f32x4 (&acc)[2][2][4][2], const Unit& u, int wr, int wc, int fr, int fq) const {
        const int row0 = u.pm * BM + wr * 64 + fr, col0 = u.pn * BM + wc * 32 + 8 * fq;
#pragma unroll
        for (int ai = 0; ai < 2; ++ai)
#pragma unroll
            for (int m = 0; m < 4; ++m) { const int row = row0 + ai * HALF + m * 16; bf16_t* rowp = O + (size_t)row * ldc + col0;
                const f32x4 pq = *(const f32x4*)(stats + (size_t)row * 8), pk = *(const f32x4*)(stats + (size_t)row * 8 + 4);
                const float rq = rsqrtf(((pq[0] + pq[1]) + (pq[2] + pq[3])) * (1.f / 256.f) + EPS), rk = rsqrtf(((pk[0] + pk[1]) + (pk[2] + pk[3])) * (1.f / 128.f) + EPS);
#pragma unroll
                for (int bj = 0; bj < 2; ++bj) { const int c0 = col0 + bj * HALF; const float sc = c0 < 384 ? rq : (c0 < 768 ? (((c0 - 384) % 96) < 64 ? rk : 1.f) : rk);
                    const f32x4 v0 = acc[ai][bj][m][0] * sc, v1 = acc[ai][bj][m][1] * sc;
                    u32x4 w; w.x = cvtpk(v0[0], v0[1]); w.y = cvtpk(v0[2], v0[3]); w.z = cvtpk(v1[0], v1[1]); w.w = cvtpk(v1[2], v1[3]);
                    *(u32x4*)(rowp + bj * HALF) = w; } }
    }
};
struct EpiSwiGLU8 {
    unsigned char* O; int ldc; float scale;
    __device__ __forceinline__ void operator()(const f32x4 (&acc)[2][2][4][2], const Unit& u, int wr, int wc, int fr, int fq) const {
        const int row0 = u.pm * BM + wr * 64 + fr, col0 = u.pn * HALF + wc * 32 + 8 * fq;
#pragma unroll
        for (int ai = 0; ai < 2; ++ai)
#pragma unroll
            for (int m = 0; m < 4; ++m) { unsigned char* rowp = O + (size_t)(row0 + ai * HALF + m * 16) * ldc + col0;
                float r[8];
#pragma unroll
                for (int n = 0; n < 2; ++n)
#pragma unroll
                    for (int j = 0; j < 4; ++j) r[n * 4 + j] = F8_ACT_SCALE * silu_f(acc[ai][0][m][n][j] * scale) * (acc[ai][1][m][n][j] * scale);
                u32x2 w; w.x = pk4_fp8(r[0], r[1], r[2], r[3]); w.y = pk4_fp8(r[4], r[5], r[6], r[7]);
                *(u32x2*)rowp = w; }
    }
};

template <class Epi, bool F8 = false>
__device__ __forceinline__ void gemm_phase(LAS unsigned char* lds, const Gemm& g, const Epi& E) {
    const int tid = opaque_tid(), wid = __builtin_amdgcn_readfirstlane(tid >> 6), lane = tid & 63, wr = wid >> 2, wc = wid & 3, fr = lane & 15, fq = lane >> 4;
    constexpr int ES = F8 ? 1 : 2;
    const int K = g.K, nt = K * ES / (BK * 2), lda = g.lda;
    StaticOrder S; S.init(g.nM, g.nN, (int)gridDim.x, opaque_bid());
    unsigned voffA[2], voffB[2];
#pragma unroll
    for (int i = 0; i < 2; ++i) { int R, C; stage_rc(tid * 16 + i * 8192, R, C); const int Rb = (R & ~31) + perm32(R & 31);
        voffA[i] = (unsigned)(R * lda * ES + C * 2); voffB[i] = (unsigned)(Rb * K * ES + C * 2); }
    const size_t kstep = (size_t)(BK * 2);
    const size_t hA = (size_t)HALF * lda * ES, tA = 2 * hA, hB = (size_t)HALF * K * ES, tB = 2 * hB;
    const unsigned ldsw = (unsigned)wid * 1024u;
    const int aoff = lds_byte(wr * 64 + fr, fq * 8), boff = lds_byte(wc * 32 + fr, fq * 8);
#define PG8_SA(b, h) (((b) * 2 + (h)) * HTB)
#define PG8_SB(b, h) ((4 + (b) * 2 + (h)) * HTB)
#define PG8_STAGE(bufoff, gbase, voff) do { _Pragma("unroll") for (int _i = 0; _i < 2; ++_i) \
        __builtin_amdgcn_global_load_lds((const unsigned*)((const char*)(gbase) + (voff)[_i]), (LAS unsigned*)(lds + (bufoff) + ldsw + _i * 8192), 16, 0, 0); } while (0)
#define PG8_LD8(base) __builtin_shufflevector(*(const LAS i32x4*)(base), *(const LAS i32x4*)((base) + 1024), 0, 1, 2, 3, 4, 5, 6, 7)
#define PG8_LDA(dst, b, h) do { _Pragma("unroll") for (int m = 0; m < 4; ++m) dst[m] = PG8_LD8(lds + PG8_SA(b, h) + aoff + m * 2048); } while (0)
#define PG8_LDB(dst, b, h) do { _Pragma("unroll") for (int n = 0; n < 2; ++n) dst[n] = PG8_LD8(lds + PG8_SB(b, h) + boff + n * 2048); } while (0)
#define PG8_H0(x) __builtin_bit_cast(bf16x8, __builtin_shufflevector(x, x, 0, 1, 2, 3))
#define PG8_H1(x) __builtin_bit_cast(bf16x8, __builtin_shufflevector(x, x, 4, 5, 6, 7))
#define PG8_MMA(ai, bj, At, Bt) do { __builtin_amdgcn_s_setprio(1); _Pragma("unroll") for (int m = 0; m < 4; ++m) _Pragma("unroll") for (int n = 0; n < 2; ++n) { \
        if constexpr (F8) asm volatile("v_mfma_f32_16x16x128_f8f6f4 %0, %1, %2, %0" : "+v"(acc[ai][bj][m][n]) : "v"(Bt[n]), "v"(At[m])); \
        else { acc[ai][bj][m][n] = __builtin_amdgcn_mfma_f32_16x16x32_bf16(PG8_H0(Bt[n]), PG8_H0(At[m]), acc[ai][bj][m][n], 0, 0, 0); \
               acc[ai][bj][m][n] = __builtin_amdgcn_mfma_f32_16x16x32_bf16(PG8_H1(Bt[n]), PG8_H1(At[m]), acc[ai][bj][m][n], 0, 0, 0); } } \
        __builtin_amdgcn_s_setprio(0); } while (0)
#define PG8_WAIT_V(n) asm volatile("s_waitcnt vmcnt(" #n ")" ::: "memory")
#define PG8_WAIT_L(n) asm volatile("s_waitcnt lgkmcnt(" #n ")" ::: "memory")
#define PG8_BAR __builtin_amdgcn_s_barrier()
#define PG8_SCHED __builtin_amdgcn_sched_barrier(0)
#define PG8_EXPERT(u) do { if (g.grouped) { int _e = 0; _Pragma("unroll") for (int _k = 1; _k < 8; ++_k) _e += ((u).pm >= g.toff[_k]) ? 1 : 0; (u).e = _e; } } while (0)
    Unit cur, nxt; int ui = 0;
    if (!S.next(0, cur)) return;
    PG8_EXPERT(cur);
    f32x4 acc[2][2][4][2];
#pragma unroll
    for (int a = 0; a < 2; ++a)
#pragma unroll
        for (int b = 0; b < 2; ++b)
#pragma unroll
            for (int m = 0; m < 4; ++m)
#pragma unroll
                for (int n = 0; n < 2; ++n) acc[a][b][m][n] = (f32x4){0.f, 0.f, 0.f, 0.f};
    i32x8 At[4], B0[2], B1[2];
    const char* cA = (const char*)g.A + (size_t)cur.pm * tA; const char* cB = ((const char*)g.Bt + (size_t)cur.e * g.estride * ES) + (size_t)cur.pn * tB;
    PG8_STAGE(PG8_SB(0, 0), cB, voffB); PG8_STAGE(PG8_SA(0, 0), cA, voffA); PG8_STAGE(PG8_SB(0, 1), cB + hB, voffB); PG8_STAGE(PG8_SA(0, 1), cA + hA, voffA);
    if (wr == 1) PG8_BAR;
    PG8_WAIT_V(4); PG8_BAR;
    PG8_STAGE(PG8_SB(1, 0), cB + kstep, voffB); PG8_STAGE(PG8_SA(1, 0), cA + kstep, voffA); PG8_STAGE(PG8_SB(1, 1), cB + hB + kstep, voffB);
    PG8_WAIT_V(6); PG8_BAR;
    for (;;) {
        const bool has_next = S.next(ui + 1, nxt);
        if (has_next) PG8_EXPERT(nxt);
        const char* nA = has_next ? (const char*)g.A + (size_t)nxt.pm * tA : cA; const char* nB = has_next ? ((const char*)g.Bt + (size_t)nxt.e * g.estride * ES) + (size_t)nxt.pn * tB : cB;
        for (int t = 0; t < nt; t += 2) {
            const bool last = (t == nt - 2);
            const char* a1 = cA + (size_t)(t + 1) * kstep;
            const char* a2 = last ? nA : cA + (size_t)(t + 2) * kstep; const char* b2 = last ? nB : cB + (size_t)(t + 2) * kstep;
            const char* a3 = a2 + kstep; const char* b3 = b2 + kstep;
            PG8_LDB(B0, 0, 0); PG8_SCHED; PG8_LDA(At, 0, 0); PG8_STAGE(PG8_SA(1, 1), a1 + hA, voffA);
            PG8_WAIT_L(8); PG8_BAR; PG8_WAIT_L(0); PG8_MMA(0, 0, At, B0); PG8_BAR; PG8_SCHED;
            PG8_LDB(B1, 0, 1); PG8_STAGE(PG8_SB(0, 0), b2, voffB);
            PG8_BAR; PG8_WAIT_L(0); PG8_MMA(0, 1, At, B1); PG8_BAR;
            PG8_LDA(At, 0, 1); PG8_STAGE(PG8_SA(0, 0), a2, voffA);
            PG8_BAR; PG8_WAIT_L(0); PG8_MMA(1, 0, At, B0); PG8_BAR; PG8_SCHED;
            PG8_STAGE(PG8_SB(0, 1), b2 + hB, voffB);
            PG8_WAIT_V(6); PG8_BAR; PG8_MMA(1, 1, At, B1); PG8_BAR;
            PG8_LDB(B0, 1, 0); PG8_SCHED; PG8_LDA(At, 1, 0); PG8_STAGE(PG8_SA(0, 1), a2 + hA, voffA);
            PG8_WAIT_L(8); PG8_BAR; PG8_WAIT_L(0); PG8_MMA(0, 0, At, B0); PG8_BAR; PG8_SCHED;
            PG8_LDB(B1, 1, 1); PG8_STAGE(PG8_SB(1, 0), b3, voffB);
            PG8_BAR; PG8_WAIT_L(0); PG8_MMA(0, 1, At, B1); PG8_BAR;
            PG8_LDA(At, 1, 1); PG8_STAGE(PG8_SA(1, 0), a3, voffA);
            PG8_BAR; PG8_WAIT_L(0); PG8_MMA(1, 0, At, B0); PG8_BAR; PG8_SCHED;
            PG8_STAGE(PG8_SB(1, 1), b3 + hB, voffB);
            PG8_WAIT_V(6); PG8_BAR; PG8_MMA(1, 1, At, B1); PG8_BAR;
        }
        if constexpr (F8) asm volatile("s_nop 15\n\ts_nop 15" ::: "memory");
        E(acc, cur, wr, wc, fr, fq);
        if (!has_next) break;
#pragma unroll
        for (int a = 0; a < 2; ++a)
#pragma unroll
            for (int b = 0; b < 2; ++b)
#pragma unroll
                for (int m = 0; m < 4; ++m)
#pragma unroll
                    for (int n = 0; n < 2; ++n) acc[a][b][m][n] = (f32x4){0.f, 0.f, 0.f, 0.f};
        cur = nxt; cA = nA; cB = nB; ++ui;
    }
    PG8_WAIT_V(0);
    if (wr == 0) PG8_BAR;
    PG8_BAR;
#undef PG8_SA
#undef PG8_SB
#undef PG8_STAGE
#undef PG8_LDA
#undef PG8_LDB
#undef PG8_MMA
#undef PG8_H0
#undef PG8_H1
#undef PG8_LD8
#undef PG8_WAIT_V
#undef PG8_WAIT_L
#undef PG8_BAR
#undef PG8_SCHED
#undef PG8_EXPERT
}
}

__device__ __forceinline__ void gemm_bf16(LAS unsigned char* lds, const pg8::Gemm& g, bf16_t* O, int ldc) { pg8::EpiBf16 E{O, ldc, 1.f}; pg8::gemm_phase(lds, g, E); }
__device__ __forceinline__ void gemm_even_in(LAS unsigned char* lds, const pg8::Gemm& g, const pg8::EpiEvenIn& E) { pg8::gemm_phase(lds, g, E); }
__device__ __forceinline__ void gemm_odd_in(LAS unsigned char* lds, const pg8::Gemm& g, const pg8::EpiOddIn& E) { pg8::gemm_phase(lds, g, E); }
__device__ __forceinline__ void gemm_mla_up(LAS unsigned char* lds, const pg8::Gemm& g, const pg8::EpiMlaUp& E) { pg8::gemm_phase(lds, g, E); }
__device__ __forceinline__ void gemm8_bf16(LAS unsigned char* lds, const pg8::Gemm& g, bf16_t* O, int ldc) { pg8::EpiBf16 E{O, ldc, F8_INV}; pg8::gemm_phase<pg8::EpiBf16, true>(lds, g, E); }
__device__ __forceinline__ void gemm8_swiglu8(LAS unsigned char* lds, const pg8::Gemm& g, unsigned char* O, int ldc) { pg8::EpiSwiGLU8 E{O, ldc, F8_INV}; pg8::gemm_phase<pg8::EpiSwiGLU8, true>(lds, g, E); }
__device__ __forceinline__ void gemm_swiglu(LAS unsigned char* lds, const pg8::Gemm& g, bf16_t* O, int ldc) { pg8::EpiSwiGLU E{O, ldc}; pg8::gemm_phase(lds, g, E); }

namespace att {
#define SBAR() __builtin_amdgcn_sched_barrier(0)
__device__ __forceinline__ int crow(int r, int hi) { return (r & 3) + 8 * (r >> 2) + 4 * hi; }
__device__ __forceinline__ int v_st(int k, int c) { const int kk = (k & ~0xC) | ((k & 4) << 1) | ((k & 8) >> 1); return ((kk >> 3) * 4 + (c >> 5)) * 512 + ((kk & 7) * 32 + (c & 31)) * 2; }
__device__ __forceinline__ int v_st_plain(int k, int c) { return ((k >> 3) * 4 + (c >> 5)) * 512 + ((k & 7) * 32 + (c & 31)) * 2; }
__device__ __forceinline__ int v_rd_base(int lane) { return ((lane & 3) << 3) | (((lane >> 2) & 3) << 6) | (((lane >> 4) & 1) << 5) | (((lane >> 5) & 1) << 8); }
constexpr int v_rd_off(int d0, int ks, int half) { return d0 * 512 + ks * 4096 + half * 2048; }
template <int OFF> __device__ __forceinline__ s16x4 tr_read(unsigned vb) {
    s16x4 r; asm volatile("ds_read_b64_tr_b16 %0, %1 offset:%2" : "=&v"(r) : "v"(vb), "i"(OFF) : "memory"); return r;
}
template <int D0> __device__ __forceinline__ void pv_one(f32x16& od, unsigned vb, bf16x8 pa0, bf16x8 pa1, bf16x8 pa2, bf16x8 pa3) {
    const s16x4 l0 = tr_read<v_rd_off(D0, 0, 0)>(vb), h0 = tr_read<v_rd_off(D0, 0, 1)>(vb), l1 = tr_read<v_rd_off(D0, 1, 0)>(vb), h1 = tr_read<v_rd_off(D0, 1, 1)>(vb);
    const s16x4 l2 = tr_read<v_rd_off(D0, 2, 0)>(vb), h2 = tr_read<v_rd_off(D0, 2, 1)>(vb), l3 = tr_read<v_rd_off(D0, 3, 0)>(vb), h3 = tr_read<v_rd_off(D0, 3, 1)>(vb);
    asm volatile("s_waitcnt lgkmcnt(0)" ::: "memory"); SBAR();
#define PK(L, H) (bf16x8){L[0], L[1], L[2], L[3], H[0], H[1], H[2], H[3]}
    od = __builtin_amdgcn_mfma_f32_32x32x16_bf16(pa0, PK(l0, h0), od, 0, 0, 0);
    od = __builtin_amdgcn_mfma_f32_32x32x16_bf16(pa1, PK(l1, h1), od, 0, 0, 0);
    od = __builtin_amdgcn_mfma_f32_32x32x16_bf16(pa2, PK(l2, h2), od, 0, 0, 0);
    od = __builtin_amdgcn_mfma_f32_32x32x16_bf16(pa3, PK(l3, h3), od, 0, 0, 0);
#undef PK
}
template <int KS, int NO> __device__ __forceinline__ void pv_step(f32x16 (&o)[NO], unsigned vb, bf16x8 pa) {
    s16x4 l[NO], h[NO];
    l[0] = tr_read<v_rd_off(0, KS, 0)>(vb); h[0] = tr_read<v_rd_off(0, KS, 1)>(vb); l[1] = tr_read<v_rd_off(1, KS, 0)>(vb); h[1] = tr_read<v_rd_off(1, KS, 1)>(vb);
    if constexpr (NO == 4) { l[2] = tr_read<v_rd_off(2, KS, 0)>(vb); h[2] = tr_read<v_rd_off(2, KS, 1)>(vb); l[3] = tr_read<v_rd_off(3, KS, 0)>(vb); h[3] = tr_read<v_rd_off(3, KS, 1)>(vb); }
    asm volatile("s_waitcnt lgkmcnt(0)" ::: "memory"); SBAR();
#pragma unroll
    for (int d = 0; d < NO; ++d) o[d] = __builtin_amdgcn_mfma_f32_32x32x16_bf16(pa, (bf16x8){l[d][0], l[d][1], l[d][2], l[d][3], h[d][0], h[d][1], h[d][2], h[d][3]}, o[d], 0, 0, 0);
}
__device__ __forceinline__ void rot8(bf16x8& a, bf16x8& b, const float* cs, const float* sn) {
    const f32x4 c0 = *(const f32x4*)cs, c1 = *(const f32x4*)(cs + 4), s0 = *(const f32x4*)sn, s1 = *(const f32x4*)(sn + 4);
    float c[8] = {c0[0], c0[1], c0[2], c0[3], c1[0], c1[1], c1[2], c1[3]}, s[8] = {s0[0], s0[1], s0[2], s0[3], s1[0], s1[1], s1[2], s1[3]};
    float o1[8], o2[8];
#pragma unroll
    for (int e = 0; e < 8; ++e) { const float x1 = bf2f((unsigned short)a[e]), x2 = bf2f((unsigned short)b[e]); o1[e] = x1 * c[e] - x2 * s[e]; o2[e] = x2 * c[e] + x1 * s[e]; }
    u32x4 wa = {cvtpk(o1[0], o1[1]), cvtpk(o1[2], o1[3]), cvtpk(o1[4], o1[5]), cvtpk(o1[6], o1[7])};
    u32x4 wb = {cvtpk(o2[0], o2[1]), cvtpk(o2[2], o2[3]), cvtpk(o2[4], o2[5]), cvtpk(o2[6], o2[7])};
    a = *reinterpret_cast<bf16x8*>(&wa); b = *reinterpret_cast<bf16x8*>(&wb);
}

__device__ __forceinline__ void rot4(bf16x8& a, const float* cs, const float* sn) {
    const f32x4 c = *(const f32x4*)cs, s = *(const f32x4*)sn; float o[8];
#pragma unroll
    for (int e = 0; e < 4; ++e) { const float x1 = bf2f((unsigned short)a[e]), x2 = bf2f((unsigned short)a[4 + e]); o[e] = x1 * c[e] - x2 * s[e]; o[4 + e] = x2 * c[e] + x1 * s[e]; }
    u32x4 w = {cvtpk(o[0], o[1]), cvtpk(o[2], o[3]), cvtpk(o[4], o[5]), cvtpk(o[6], o[7])};
    a = *reinterpret_cast<bf16x8*>(&w);
}
struct Args {
    const bf16_t* Q; int ldq, qcol;
    const bf16_t* K; int ldk, kcol;
    const bf16_t* V; int ldv, vcol;
    int q_row0;
    int kctx_row0, klat_row0, nt_ctx, nt_lat;
    float C;
    int rope;
    const float* rcos; const float* rsin;
    bf16_t* O; int ldo, ocol;
    int g, u0; const float* rpb;
    float lam, oscale; const float* subg;
};

template <int DQK, int KW, int DV, int MODE>
__device__ __forceinline__ void attn_unit(LAS unsigned char* lds, const Args& a) {
    constexpr int ND = DQK / 16, NO = DV / 32;
    constexpr int KSTR = KW * 2 + 16, KBUF = 64 * KSTR;
    constexpr int OFF_V = 3 * KBUF, OFF_WS = OFF_V + 3 * 16384, OFF_RPB = OFF_WS + 2048;
    constexpr int KCH = KW / 8, NKCH = 64 * KCH, NKC = (NKCH + 511) / 512;
    constexpr int VCH = DV / 8, NVCH = 64 * VCH, NVC = (NVCH + 511) / 512;
    const int tid = opaque_tid(), wid = __builtin_amdgcn_readfirstlane(tid >> 6), lane = tid & 63, r32 = lane & 31, hi = lane >> 5;
    LAS unsigned char* Kl = lds; LAS unsigned char* Vl = lds + OFF_V;
    LAS float* wsf = (LAS float*)(lds + OFF_WS) + wid * 64; LAS float* li_l = wsf;
    LAS float* rpbl = (LAS float*)(lds + OFF_RPB);
    const int wq = (MODE == 1) ? (wid & 3) : wid, wmap = (MODE == 1) ? (wid >> 2) : 0;
    bf16x8 qr[ND];
    const int qrow = a.q_row0 + wq * 32 + r32;
    {
        const bf16_t* Qw = a.Q + (size_t)qrow * a.ldq + a.qcol + wmap * 64 + hi * 8;
#pragma unroll
        for (int d0 = 0; d0 < ND; ++d0) qr[d0] = *(const bf16x8*)(Qw + d0 * 16);
        if (a.rope == 2) { if constexpr (ND >= 6) { const int s = qrow & (SEQ - 1); rot4(qr[4], a.rcos + s * 16 + 4 * hi, a.rsin + s * 16 + 4 * hi); rot4(qr[5], a.rcos + s * 16 + 8 + 4 * hi, a.rsin + s * 16 + 8 + 4 * hi); } }
#pragma unroll
        for (int d0 = 0; d0 < ND; ++d0) { float f[8];
#pragma unroll
            for (int e = 0; e < 8; ++e) f[e] = bf2f((unsigned short)qr[d0][e]) * a.C;
            u32x4 w = {cvtpk(f[0], f[1]), cvtpk(f[2], f[3]), cvtpk(f[4], f[5]), cvtpk(f[6], f[7])}; qr[d0] = *reinterpret_cast<bf16x8*>(&w); }
    }
    if (MODE == 2) { if (tid < 465) rpbl[tid] = a.rpb[tid] * LOG2E; }
    const int cq = (wid & 1) * 32 + r32, rq = 4 * a.g + (wid >> 1);
    const int rs = min(max(rq - 4, 0), 120), cs_ = min(max(cq - 8, 0), 48);
    int kgo[NKC], klo[NKC], vgo[NVC], vlo[NVC];
#pragma unroll
    for (int i = 0; i < NKC; ++i) { if (i > 0 && KCH == 16) { kgo[i] = kgo[0] + 32 * i * a.ldk; klo[i] = klo[0] + 32 * i * KSTR; } else { const int c = tid + 512 * i, row = c / KCH, ch = c % KCH; kgo[i] = row * a.ldk + ch * 8; klo[i] = row * KSTR + ch * 16; } }
#pragma unroll
    for (int i = 0; i < NVC; ++i) { if (i > 0 && VCH == 16) { vgo[i] = vgo[0] + 32 * i * a.ldv; vlo[i] = vlo[0] + 8192 * i; } else { const int c = tid + 512 * i, row = c / VCH, ch = c % VCH; vgo[i] = row * a.ldv + ch * 8; vlo[i] = v_st_plain(row, ch * 8); } }
    u32x4 ksA[NKC], vsA[NVC];
    const int NT = a.nt_ctx + a.nt_lat;
#define TILE_ROW(j) ((j) < a.nt_ctx ? a.kctx_row0 + 64 * (j) : a.klat_row0 + 64 * ((j) - a.nt_ctx))
#define SLOAD(j) do { const int _r0 = TILE_ROW(j); const bf16_t* _kp = a.K + (size_t)_r0 * a.ldk + a.kcol; const bf16_t* _vp = a.V + (size_t)_r0 * a.ldv + a.vcol; \
    _Pragma("unroll") for (int _i = 0; _i < NKC; ++_i) if ((NKCH % 512 == 0) || tid + 512 * _i < NKCH) ksA[_i] = *(const u32x4*)(_kp + kgo[_i]); \
    _Pragma("unroll") for (int _i = 0; _i < NVC; ++_i) if ((NVCH % 512 == 0) || tid + 512 * _i < NVCH) vsA[_i] = *(const u32x4*)(_vp + vgo[_i]); } while (0)
#define SWRITE(b) do { \
    _Pragma("unroll") for (int _i = 0; _i < NKC; ++_i) if ((NKCH % 512 == 0) || tid + 512 * _i < NKCH) *(LAS u32x4*)(Kl + (b) * KBUF + klo[_i]) = ksA[_i]; \
    _Pragma("unroll") for (int _i = 0; _i < NVC; ++_i) if ((NVCH % 512 == 0) || tid + 512 * _i < NVCH) *(LAS u32x4*)(Vl + (b) * 16384 + vlo[_i]) = vsA[_i]; } while (0)
    float l_reg = 0.f;
    f32x16 o[NO];
#pragma unroll
    for (int d = 0; d < NO; ++d) o[d] = (f32x16){0.f, 0.f, 0.f, 0.f, 0.f, 0.f, 0.f, 0.f, 0.f, 0.f, 0.f, 0.f, 0.f, 0.f, 0.f, 0.f};
    const unsigned vb0 = (unsigned)(size_t)Vl + (unsigned)v_rd_base(lane);
#define QKT(P0, P1, b) do { const LAS unsigned char* _Kb = Kl + (b) * KBUF + wmap * 128; \
    _Pragma("unroll") for (int d0 = 0; d0 < ND; ++d0) { const int cb = (d0 * 16 + hi * 8) * 2; \
        const bf16x8 b0 = *(const LAS bf16x8*)(_Kb + r32 * KSTR + cb), b1 = *(const LAS bf16x8*)(_Kb + (32 + r32) * KSTR + cb); \
        if (d0 == 0) { const f32x16 z16 = {0.f, 0.f, 0.f, 0.f, 0.f, 0.f, 0.f, 0.f, 0.f, 0.f, 0.f, 0.f, 0.f, 0.f, 0.f, 0.f}; P0 = __builtin_amdgcn_mfma_f32_32x32x16_bf16(b0, qr[0], z16, 0, 0, 0); P1 = __builtin_amdgcn_mfma_f32_32x32x16_bf16(b1, qr[0], z16, 0, 0, 0); } \
        else { P0 = __builtin_amdgcn_mfma_f32_32x32x16_bf16(b0, qr[d0], P0, 0, 0, 0); P1 = __builtin_amdgcn_mfma_f32_32x32x16_bf16(b1, qr[d0], P1, 0, 0, 0); } } } while (0)
#define PARTIAL(P0, P1, j) do { \
    if (MODE == 2) { if ((j) >= a.nt_ctx) { const int kr = a.u0 + ((j) - a.nt_ctx); const bool rowok = (kr >= rs) && (kr < rs + 8); const int ro = min(max(kr - rq + 7, 0), 14); const LAS float* brow = rpbl + ro * 31; \
        _Pragma("unroll") for (int r = 0; r < 16; ++r) { \
            { const int ck = crow(r, hi), dd = min(max(ck - cq + 15, 0), 30); const bool inw = rowok && ((unsigned)(ck - cs_) < 16u); const float bv = brow[dd]; P0[r] = inw ? P0[r] + bv : -1e30f; } \
            { const int ck = 32 + crow(r, hi), dd = min(max(ck - cq + 15, 0), 30); const bool inw = rowok && ((unsigned)(ck - cs_) < 16u); const float bv = brow[dd]; P1[r] = inw ? P1[r] + bv : -1e30f; } } } } \
    _Pragma("unroll") for (int r = 0; r < 16; ++r) P0[r] = fast_exp2(P0[r]); } while (0)
#define PK4(P, BASE, OUT) do { u32x4 w = {cvtpk(P[BASE + 0], P[BASE + 1]), cvtpk(P[BASE + 2], P[BASE + 3]), cvtpk(P[BASE + 4], P[BASE + 5]), cvtpk(P[BASE + 6], P[BASE + 7])}; \
    OUT = *reinterpret_cast<bf16x8*>(&w); } while (0)
#define FINISH(P0, P1) do { \
    _Pragma("unroll") for (int r = 0; r < 16; ++r) P1[r] = fast_exp2(P1[r]); \
    float ps = 0.f; \
    _Pragma("unroll") for (int r = 0; r < 16; ++r) ps += P0[r]; \
    _Pragma("unroll") for (int r = 0; r < 16; ++r) ps += P1[r]; \
    l_reg += ps; \
    PK4(P0, 0, pa0); PK4(P0, 8, pa1); PK4(P1, 0, pa2); PK4(P1, 8, pa3); } while (0)
#define PV(b) do { const unsigned _vb = vb0 + (unsigned)(b) * 16384u; \
    pv_step<0, NO>(o, _vb, pa0); pv_step<1, NO>(o, _vb, pa1); pv_step<2, NO>(o, _vb, pa2); pv_step<3, NO>(o, _vb, pa3); } while (0)
    f32x16 pA0, pA1, pB0, pB1; bf16x8 pa0, pa1, pa2, pa3;
    SLOAD(0); SWRITE(0); SLOAD(1); __syncthreads();
    QKT(pA0, pA1, 0); PARTIAL(pA0, pA1, 0);
    SWRITE(1); if (2 < NT) SLOAD(2);
    __syncthreads();
    int bm1 = 0, bj = 1, bn = 2;
    for (int j = 1; j + 1 < NT; j += 2) {
        SBAR(); QKT(pB0, pB1, bj);
        FINISH(pA0, pA1); SBAR();
        PV(bm1); PARTIAL(pB0, pB1, j);
        SBAR(); SWRITE(bn); SLOAD(j + 2);
        __syncthreads();
        SBAR(); QKT(pA0, pA1, bn);
        FINISH(pB0, pB1); SBAR();
        PV(bj); PARTIAL(pA0, pA1, j + 1);
        SBAR(); SWRITE(bm1); if (j + 3 < NT) SLOAD(j + 3);
        __syncthreads();
        { const int t0 = bm1; bm1 = bn; bn = bj; bj = t0; }
    }
    SBAR(); QKT(pB0, pB1, bj);
    FINISH(pA0, pA1); SBAR();
    PV(bm1); PARTIAL(pB0, pB1, NT - 1);
    FINISH(pB0, pB1); SBAR();
    PV(bj);
    __syncthreads();
#undef TILE_ROW
#undef SLOAD
#undef SWRITE
#undef QKT
#undef PARTIAL
#undef PK4
#undef FINISH
#undef PV
    const int tid_e = opaque_tid(), lane_e = tid_e & 63, r32e = lane_e & 31, hie = lane_e >> 5;
    { auto rr = __builtin_amdgcn_permlane32_swap(__float_as_uint(l_reg), __float_as_uint(l_reg), false, false); l_reg = __uint_as_float(rr[0]) + __uint_as_float(rr[1]); }
    if (hie == 0) li_l[r32e] = fmaxf(l_reg, 1e-37f); LDS_WAIT();
    float rli[16];
#pragma unroll
    for (int r = 0; r < 16; ++r) rli[r] = fast_rcp(li_l[crow(r, hie)]);
    if (MODE != 1) {
        bf16_t* Ow = a.O + (size_t)(a.q_row0 + wid * 32) * a.ldo + a.ocol + r32e;
#pragma unroll
        for (int r = 0; r < 16; ++r) { const int orow = crow(r, hie);
#pragma unroll
            for (int d0 = 0; d0 < NO; ++d0) Ow[(size_t)orow * a.ldo + d0 * 32] = f2bf(o[d0][r] * rli[r]); }
    } else {
        LAS float* cb = (LAS float*)lds;
        if (wmap == 1) {
#pragma unroll
            for (int r = 0; r < 16; ++r) { const int row = wq * 32 + crow(r, hie);
#pragma unroll
                for (int d0 = 0; d0 < NO; ++d0) cb[row * 129 + d0 * 32 + r32e] = a.lam * o[d0][r] * rli[r]; }
        }
        __syncthreads();
        if (wmap == 0) {
#pragma unroll
            for (int r = 0; r < 16; ++r) { const int row = wq * 32 + crow(r, hie);
#pragma unroll
                for (int d0 = 0; d0 < NO; ++d0) { const int ix = row * 129 + d0 * 32 + r32e; cb[ix] = o[d0][r] * rli[r] - cb[ix]; } }
        }
        __syncthreads();
        const int row = tid_e >> 2, qd = tid_e & 3;
        float v[32]; float ss = 0.f;
#pragma unroll
        for (int i = 0; i < 32; ++i) { v[i] = cb[row * 129 + qd * 32 + i]; ss += v[i] * v[i]; }
        ss += __shfl_xor(ss, 1); ss += __shfl_xor(ss, 2);
        const float rstd = rsqrtf(ss * (1.f / 128.f) + EPS) * a.oscale;
        bf16_t* Ow = a.O + (size_t)(a.q_row0 + row) * a.ldo + a.ocol + qd * 32;
#pragma unroll
        for (int c = 0; c < 4; ++c) { float w[8];
#pragma unroll
            for (int e = 0; e < 8; ++e) w[e] = v[c * 8 + e] * rstd * a.subg[qd * 32 + c * 8 + e];
            u32x4 pk = {cvtpk(w[0], w[1]), cvtpk(w[2], w[3]), cvtpk(w[4], w[5]), cvtpk(w[6], w[7])};
            *(u32x4*)(Ow + c * 8) = pk; }
    }
    __syncthreads();
}

__device__ __forceinline__ void sgu_unit(LAS unsigned char* lds, const bf16_t* PB, const bf16_t* Wsb, const float* bs, const float* stats, const float* sgain, bf16_t* MIX, int rowbase, int g) {
    const int tid = opaque_tid(), wid = __builtin_amdgcn_readfirstlane(tid >> 6), lane = tid & 63, r32 = lane & 31, hi = lane >> 5;
    LAS unsigned char* Vl = lds;
#pragma unroll 2
    for (int i = 0; i < 4; ++i) { const int c = tid + 512 * i, row = c >> 4, ch = c & 15;
        const u32x4 x = *(const u32x4*)(PB + (size_t)(rowbase + row) * EV_IN + 512 + g * 128 + ch * 8);
        const f32x4* st = (const f32x4*)(stats + (size_t)(rowbase + row) * 16); const f32x4 a0 = st[0], a1 = st[1], a2 = st[2], a3 = st[3];
        const float s1 = ((a0[0] + a0[2]) + (a1[0] + a1[2])) + ((a2[0] + a2[2]) + (a3[0] + a3[2])), s2 = ((a0[1] + a0[3]) + (a1[1] + a1[3])) + ((a2[1] + a2[3]) + (a3[1] + a3[3]));
        const float mean = s1 * (1.f / 512.f), rstd = rsqrtf(fmaxf(s2 * (1.f / 512.f) - mean * mean, 0.f) + EPS);
        const f32x4 g0 = *(const f32x4*)(sgain + g * 128 + ch * 8), g1 = *(const f32x4*)(sgain + g * 128 + ch * 8 + 4);
        u32x4 y; y.x = cvtpk((bflo(x.x) - mean) * rstd * g0[0], (bfhi(x.x) - mean) * rstd * g0[1]); y.y = cvtpk((bflo(x.y) - mean) * rstd * g0[2], (bfhi(x.y) - mean) * rstd * g0[3]);
        y.z = cvtpk((bflo(x.z) - mean) * rstd * g1[0], (bfhi(x.z) - mean) * rstd * g1[1]); y.w = cvtpk((bflo(x.w) - mean) * rstd * g1[2], (bfhi(x.w) - mean) * rstd * g1[3]);
        *(LAS u32x4*)(Vl + (row >> 6) * 16384 + v_st(row & 63, ch * 8)) = y; }
    const int prow = (wid & 3) * 32, dh = wid >> 2;
    bf16x8 pa[2][4];
#pragma unroll
    for (int kt = 0; kt < 2; ++kt)
#pragma unroll
        for (int ks = 0; ks < 4; ++ks) pa[kt][ks] = *(const bf16x8*)(Wsb + (size_t)(g * 128 + prow + r32) * 128 + kt * 64 + ks * 16 + hi * 8);
    __syncthreads();
    f32x16 o[2];
    o[0] = (f32x16){0.f, 0.f, 0.f, 0.f, 0.f, 0.f, 0.f, 0.f, 0.f, 0.f, 0.f, 0.f, 0.f, 0.f, 0.f, 0.f}; o[1] = o[0];
    const unsigned vb0 = (unsigned)(size_t)Vl + (unsigned)v_rd_base(lane);
#pragma unroll
    for (int kt = 0; kt < 2; ++kt) { const unsigned vb = vb0 + kt * 16384u;
        if (dh == 0) { pv_one<0>(o[0], vb, pa[kt][0], pa[kt][1], pa[kt][2], pa[kt][3]); pv_one<1>(o[1], vb, pa[kt][0], pa[kt][1], pa[kt][2], pa[kt][3]); }
        else { pv_one<2>(o[0], vb, pa[kt][0], pa[kt][1], pa[kt][2], pa[kt][3]); pv_one<3>(o[1], vb, pa[kt][0], pa[kt][1], pa[kt][2], pa[kt][3]); } }
#pragma unroll
    for (int r = 0; r < 16; ++r) { const int p = prow + crow(r, hi); const float bias = bs[g * 128 + p];
#pragma unroll
        for (int dd = 0; dd < 2; ++dd) { const int d = (2 * dh + dd) * 32 + r32;
            const float u = bf2f(PB[(size_t)(rowbase + p) * EV_IN + g * 128 + d]);
            MIX[(size_t)(rowbase + p) * DM + g * 128 + d] = f2bf(u * (o[dd][r] + bias)); } }
    __syncthreads();
}
}

struct Params {
    const float* in[31];
    float* out;
    unsigned char* ws;
    int ph_lo, ph_hi;
};

struct Ctx {
    LAS unsigned char* lds;
    int tid, lane, wid, gw, NGW;
};
__device__ __forceinline__ Ctx make_ctx(LAS unsigned char* lds) { const int t = opaque_tid(), w = __builtin_amdgcn_readfirstlane(t >> 6); return Ctx{lds, t, t & 63, w, opaque_bid() * 8 + w, (int)gridDim.x * 8}; }
typedef const __attribute__((address_space(4))) Params KParams;
__device__ __forceinline__ KParams& kparams() { KParams* p = (KParams*)__builtin_amdgcn_kernarg_segment_ptr(); asm volatile("" : "+s"(p)); return *p; }

__device__ __forceinline__ bf16_t* xrow_ptr(KParams& P, int row) { return (bf16_t*)(P.ws + WS_U + U_XB) + (size_t)row * DM; }
__device__ __forceinline__ int mod_r(int row) { return row < NLAT ? (row >> 13) : 4; }
__device__ __forceinline__ f32x4 ld4(const float* p) { return *(const f32x4*)p; }
__device__ __forceinline__ f32x4 ldbf4(const bf16_t* p) { const u32x2 w = *(const u32x2*)p; return (f32x4){bflo(w.x), bfhi(w.x), bflo(w.y), bfhi(w.y)}; }
__device__ __forceinline__ void stbf4(bf16_t* p, f32x4 v) { u32x2 w; w.x = cvtpk(v[0], v[1]); w.y = cvtpk(v[2], v[3]); *(u32x2*)p = w; }
__device__ __forceinline__ float sumsq4(const f32x4 (&v)[4]) { float s = 0.f;
#pragma unroll
    for (int j = 0; j < 4; ++j) s += (v[j][0] * v[j][0] + v[j][1] * v[j][1]) + (v[j][2] * v[j][2] + v[j][3] * v[j][3]);
    return wave_sum(s); }
__device__ __forceinline__ void norm_mod(const f32x4 (&x)[4], f32x4 (&hv)[4], const float* gain, const float* shift, const float* scale, int lane) {
    const float rstd = rsqrtf(sumsq4(x) * (1.f / DM) + EPS);
#pragma unroll
    for (int j = 0; j < 4; ++j) { const int c = 4 * lane + 256 * j; const f32x4 g = ld4(gain + c), sh = ld4(shift + c), sc = ld4(scale + c);
        hv[j] = (x[j] * rstd) * g * (sc + 1.f) + sh; }
}
__device__ __forceinline__ void resid_add(f32x4 (&x)[4], const f32x4 (&y)[4], const float* gain, const float* gate, int lane) {
    const float rstd = rsqrtf(sumsq4(y) * (1.f / DM) + EPS);
#pragma unroll
    for (int j = 0; j < 4; ++j) { const int c = 4 * lane + 256 * j; const f32x4 g = ld4(gain + c), gt = ld4(gate + c);
        x[j] = x[j] + gt * ((y[j] * rstd) * g); }
}

__device__ __forceinline__ void wave_rows(const Ctx& c, int mtok, int& r0, int& r1) {
    const int bid = opaque_bid(); const int rpw = mtok / (int)gridDim.x, base = bid * rpw;
    r0 = base + (c.wid * rpw) / 8; r1 = base + ((c.wid + 1) * rpw) / 8;
    if (bid == (int)gridDim.x - 1 && c.wid == 7) r1 = mtok;
}
__device__ __forceinline__ void ld_gate(f32x4 (&G)[4], const float* gain, const float* gate, int lane) {
#pragma unroll
    for (int j = 0; j < 4; ++j) { const int cc = 4 * lane + 256 * j; G[j] = ld4(gain + cc) * ld4(gate + cc); } }
__device__ __forceinline__ void ld_mod(f32x4 (&A)[4], f32x4 (&B)[4], const float* gain, const float* shift, const float* scale, int lane) {
#pragma unroll
    for (int j = 0; j < 4; ++j) { const int cc = 4 * lane + 256 * j; A[j] = ld4(gain + cc) * (ld4(scale + cc) + 1.f); B[j] = ld4(shift + cc); } }
__device__ __forceinline__ void resid_add2(f32x4 (&x)[4], const f32x4 (&y)[4], const f32x4 (&G)[4]) {
    const float rstd = rsqrtf(sumsq4(y) * (1.f / DM) + EPS);
#pragma unroll
    for (int j = 0; j < 4; ++j) x[j] = x[j] + G[j] * (y[j] * rstd);
}
__device__ __forceinline__ void norm_mod2(const f32x4 (&x)[4], f32x4 (&hv)[4], const f32x4 (&A)[4], const f32x4 (&B)[4]) {
    const float rstd = rsqrtf(sumsq4(x) * (1.f / DM) + EPS);
#pragma unroll
    for (int j = 0; j < 4; ++j) hv[j] = (x[j] * rstd) * A[j] + B[j];
}

__device__ __forceinline__ int perm_row(int pmode, int n) {
    if (pmode == 1) { if (n >= 1024 && n < 2048) { const int d = n & 63, hb = n & ~63; return hb + ((d < 32) ? 8 * (d >> 2) + (d & 3) : 8 * ((d - 32) >> 2) + 4 + (d & 3)); } }
    else if (pmode == 2) { if (n >= 1920 && n < 1952) { const int d = n - 1920; return 1920 + ((d < 16) ? 8 * (d >> 2) + (d & 3) : 8 * ((d - 16) >> 2) + 4 + (d & 3)); } }
    return n;
}
__device__ __forceinline__ void tr_item(const float* W, int ldw, bf16_t* WT, int ldt, int k0, int n0, int drow, LAS float* scr, int lane, int pmode = 0) {
#pragma unroll 8
    for (int i = 0; i < 32; ++i) { const int kk = 2 * i + (lane >> 5); scr[kk * 33 + (lane & 31)] = W[(size_t)(k0 + kk) * ldw + n0 + (lane & 31)]; }
    LDS_WAIT(); asm volatile("" ::: "memory");
    const int c = lane & 7;
#pragma unroll
    for (int j = 0; j < 4; ++j) { const int n = (lane >> 3) + 8 * j; const LAS float* s = scr + (8 * c) * 33 + n;
        u32x4 o; o.x = cvtpk(s[0 * 33], s[1 * 33]); o.y = cvtpk(s[2 * 33], s[3 * 33]); o.z = cvtpk(s[4 * 33], s[5 * 33]); o.w = cvtpk(s[6 * 33], s[7 * 33]);
        const int dr = pmode ? perm_row(pmode, n0 + n) : drow + n;
        *(u32x4*)(WT + (size_t)dr * ldt + k0 + 8 * c) = o; }
    LDS_WAIT(); asm volatile("" ::: "memory");
}
__device__ __forceinline__ void tr_item8(const float* W, int ldw, unsigned char* WT, int ldt, int k0, int n0, int drow, LAS float* scr, int lane) {
#pragma unroll 8
    for (int i = 0; i < 32; ++i) { const int kk = 2 * i + (lane >> 5); scr[kk * 33 + (lane & 31)] = W[(size_t)(k0 + kk) * ldw + n0 + (lane & 31)] * F8_W_SCALE; }
    LDS_WAIT(); asm volatile("" ::: "memory");
    const int c = lane & 7;
#pragma unroll
    for (int j = 0; j < 4; ++j) { const int n = (lane >> 3) + 8 * j; const LAS float* s = scr + (8 * c) * 33 + n;
        u32x2 o; o.x = pk4_fp8(s[0 * 33], s[1 * 33], s[2 * 33], s[3 * 33]); o.y = pk4_fp8(s[4 * 33], s[5 * 33], s[6 * 33], s[7 * 33]);
        *(u32x2*)(WT + (size_t)(drow + n) * ldt + k0 + 8 * c) = o; }
    LDS_WAIT(); asm volatile("" ::: "memory");
}
__device__ __forceinline__ void tr_matrix8(const Ctx& c, const float* W, int K, int N, unsigned char* WT, int mode, int row_off) {
    LAS float* scr = (LAS float*)(c.lds + c.wid * 16384);
    const int nblk = N / 32, nitems = (K / 64) * nblk;
    for (int it = c.gw; it < nitems; it += c.NGW) { const int kb = it / nblk, nb = it % nblk, n0 = 32 * nb;
        const int drow = (mode == 0) ? row_off + n0 : (n0 >> 7) * 256 + (n0 & 127) + (mode == 2 ? 128 : 0);
        tr_item8(W, N, WT, K, 64 * kb, n0, drow, scr, c.lane); }
}
__device__ __forceinline__ void tr_matrix(const Ctx& c, const float* W, int K, int N, bf16_t* WT, int mode, int row_off, int pmode = 0) {
    LAS float* scr = (LAS float*)(c.lds + c.wid * 16384);
    const int nblk = N / 32, nitems = (K / 64) * nblk;
    for (int it = c.gw; it < nitems; it += c.NGW) { const int kb = it / nblk, nb = it % nblk, n0 = 32 * nb;
        const int drow = (mode == 0) ? row_off + n0 : (n0 >> 7) * 256 + (n0 & 127) + (mode == 2 ? 128 : 0);
        tr_item(W, N, WT, K, 64 * kb, n0, drow, scr, c.lane, pmode); }
}
constexpr int MOE_CVT_ITEMS = 24 * 1792;
__device__ __forceinline__ void convert_moe_items(const Ctx& c, int i, int t0, int t1, int wsel, int nsel) {
    KParams& P = kparams();
    LAS float* scr = (LAS float*)(c.lds + c.wid * 16384);
    if (wsel < 0) return;
    for (int t = t0 + wsel; t < t1; t += nsel) {
        const int mat = t / 1792, r = t % 1792, e = mat / 3, which = mat % 3;
        if (which < 2) {
            const float* W = P.in[28 + which] + ((size_t)i * NEXP + e) * DM * DFFE; const int kb = r / 112, n0 = 32 * (r % 112);
            const int drow = (n0 >> 7) * 256 + (n0 & 127) + which * 128;
#if MOE_F8
            tr_item8(W, DFFE, (unsigned char*)(P.ws + WS_W13M) + (size_t)e * 2 * DFFE * DM, DM, 64 * kb, n0, drow, scr, c.lane);
#else
            tr_item(W, DFFE, (bf16_t*)(P.ws + WS_W13M) + (size_t)e * 2 * DFFE * DM, DM, 64 * kb, n0, drow, scr, c.lane);
#endif
        } else {
            const float* W = P.in[30] + ((size_t)i * NEXP + e) * DFFE * DM; const int kb = r / 32, n0 = 32 * (r % 32);
#if MOE_F8
            tr_item8(W, DM, (unsigned char*)(P.ws + WS_W2M) + (size_t)e * DM * DFFE, DFFE, 64 * kb, n0, n0, scr, c.lane);
#else
            tr_item(W, DM, (bf16_t*)(P.ws + WS_W2M) + (size_t)e * DM * DFFE, DFFE, 64 * kb, n0, n0, scr, c.lane);
#endif
        }
    }
}
__device__ __forceinline__ void prologue0(const Ctx& c_) {
    const Ctx c = make_ctx(c_.lds);
    KParams& P = kparams(); unsigned char* ws = P.ws;
    if (blockIdx.x < 96) {
        LAS float* sl = (LAS float*)c.lds;
        LAS float* part = (LAS float*)(c.lds + 32768);
        for (int i = c.tid; i < 5 * DM; i += 512) { const int r = i >> 10, k = i & 1023; const float x = r < 4 ? P.in[1][r * DM + k] : P.in[3][k]; sl[i] = x / (1.f + expf(-x)); }
        __syncthreads();
        const int t = blockIdx.x, lm = t / 24, cbk = t % 24, n = cbk * 256 + 4 * c.lane;
        const float* W = P.in[4] + (size_t)lm * DM * (NMOD * DM) + n;
        f32x4 acc[5];
#pragma unroll
        for (int r = 0; r < 5; ++r) acc[r] = (f32x4){0.f, 0.f, 0.f, 0.f};
        const int kb = c.wid * 128;
        for (int k0 = 0; k0 < 128; k0 += 8) {
            f32x4 wv[8];
#pragma unroll
            for (int u = 0; u < 8; ++u) wv[u] = ld4(W + (size_t)(kb + k0 + u) * (NMOD * DM));
#pragma unroll
            for (int u = 0; u < 8; ++u)
#pragma unroll
                for (int r = 0; r < 5; ++r) acc[r] += wv[u] * sl[r * DM + kb + k0 + u];
        }
#pragma unroll
        for (int r = 0; r < 5; ++r) *(LAS f32x4*)(part + (c.wid * 5 + r) * 256 + 4 * c.lane) = acc[r];
        __syncthreads();
        for (int i = c.tid; i < 5 * 256; i += 512) { const int r = i >> 8, cc = i & 255; float s = 0.f;
#pragma unroll
            for (int w = 0; w < 8; ++w) s += part[(w * 5 + r) * 256 + cc];
            ((float*)(ws + WS_MODS))[(size_t)(lm * 5 + r) * (NMOD * DM) + cbk * 256 + cc] = s + P.in[5][lm * (NMOD * DM) + cbk * 256 + cc]; }
        __syncthreads();
    }
    for (int i = 0; i < 2; ++i) {
        tr_matrix(c, P.in[7] + (size_t)i * DM * EV_IN, DM, EV_IN, (bf16_t*)(ws + WS_WINE) + (size_t)i * EV_IN * DM, 0, 0, 1);
        tr_matrix(c, P.in[8] + (size_t)i * DM * DM, DM, DM, (bf16_t*)(ws + WS_WOUTE) + (size_t)i * DM * DM, 0, 0);
        if (FFN8(i)) {
            tr_matrix8(c, P.in[17] + (size_t)i * DM * DFF, DM, DFF, (unsigned char*)(ws + WS_W13E) + (size_t)i * 2 * DFF * DM * 2, 1, 0);
            tr_matrix8(c, P.in[18] + (size_t)i * DM * DFF, DM, DFF, (unsigned char*)(ws + WS_W13E) + (size_t)i * 2 * DFF * DM * 2, 2, 0);
            tr_matrix8(c, P.in[19] + (size_t)i * DFF * DM, DFF, DM, (unsigned char*)(ws + WS_W2E) + (size_t)i * DM * DFF * 2, 0, 0);
        } else {
            tr_matrix(c, P.in[17] + (size_t)i * DM * DFF, DM, DFF, (bf16_t*)(ws + WS_W13E) + (size_t)i * 2 * DFF * DM, 1, 0);
            tr_matrix(c, P.in[18] + (size_t)i * DM * DFF, DM, DFF, (bf16_t*)(ws + WS_W13E) + (size_t)i * 2 * DFF * DM, 2, 0);
            tr_matrix(c, P.in[19] + (size_t)i * DFF * DM, DFF, DM, (bf16_t*)(ws + WS_W2E) + (size_t)i * DM * DFF, 0, 0);
        }
        tr_matrix(c, P.in[20] + (size_t)i * DM * OD_IN, DM, OD_IN, (bf16_t*)(ws + WS_WINO) + (size_t)i * OD_INP * DM, 0, 0, 2);
        tr_matrix(c, P.in[21] + (size_t)i * DM * DM, DM, DM, (bf16_t*)(ws + WS_WOUTO) + (size_t)i * DM * DM, 0, 0);
    }
    const int gt = blockIdx.x * 512 + c.tid, NGT = gridDim.x * 512;
    for (int i = gt; i < 2 * (OD_INP - OD_IN) * DM; i += NGT) { const int l = i / ((OD_INP - OD_IN) * DM), r = i % ((OD_INP - OD_IN) * DM);
        ((bf16_t*)(ws + WS_WINO))[(size_t)l * OD_INP * DM + (size_t)OD_IN * DM + r] = 0; }
    for (int i = gt; i < 2 * MLA_N * MLA_K; i += NGT) { const int l = i / (MLA_N * MLA_K), n = (i / MLA_K) % MLA_N, k = i % MLA_K; float v = 0.f;
        if (n < 384) { if (k < 256) { const int h = n / 96, j = n % 96; int sc = n;
                if (j >= 64) { const int p = j - 64, t = p >> 3, e = p & 7; sc = h * 96 + 64 + ((e < 4) ? 4 * t + e : 16 + 4 * t + (e - 4)); }
                v = P.in[24][((size_t)l * 256 + k) * 384 + sc] * P.in[23][l * 256 + k]; } }
        else if (n < 768) { const int h = (n - 384) / 96, j = (n - 384) % 96;
            if (j < 64) { if (k >= 256 && k < 384) v = P.in[26][((size_t)l * 128 + (k - 256)) * 768 + h * 192 + j] * P.in[25][l * 128 + (k - 256)]; }
            else { if (k == 384 + (j - 64)) v = 1.f; } }
        else { const int h = (n - 768) / 128, j = (n - 768) % 128; if (k >= 256 && k < 384) v = P.in[26][((size_t)l * 128 + (k - 256)) * 768 + h * 192 + 64 + j] * P.in[25][l * 128 + (k - 256)]; }
        ((bf16_t*)(ws + WS_WMLA))[i] = f2bf(v); }
    for (int i = gt; i < 2 * 4 * 128 * 128; i += NGT) ((bf16_t*)(ws + WS_SGUW))[i] = f2bf(P.in[9][i]);
    for (int i = gt; i < SEQ * 32; i += NGT) { const int s = i >> 5, f = i & 31; const int pos = f < 16 ? (s >> 6) : (s & 63);
        const float inv = 1.0f / powf(10000.0f, (float)(f & 15) / 16.0f); const float ang = (float)pos * inv;
        ((float*)(ws + WS_ROPEB))[i] = (float)cos((double)ang); ((float*)(ws + WS_ROPEB))[SEQ * 32 + i] = (float)sin((double)ang); }
    for (int i = gt; i < SEQ * 16; i += NGT) { const int s = i >> 4, f = i & 15; const int pos = f < 8 ? (s >> 6) : (s & 63);
        const float inv = 1.0f / powf(10000.0f, (float)(f & 7) / 8.0f); const float ang = (float)pos * inv;
        ((float*)(ws + WS_ROPED))[i] = (float)cos((double)ang); ((float*)(ws + WS_ROPED))[SEQ * 16 + i] = (float)sin((double)ang); }
}

__device__ __forceinline__ void convert_moe_tail(const Ctx& c_, int i, int t0, int t1, int nunits) {
    const Ctx c = make_ctx(c_.lds);
    const int G = (int)gridDim.x, rem = nunits % G, bid = opaque_bid();
    const int first = rem;
    convert_moe_items(c, i, t0, t1, bid >= first ? (bid - first) * 8 + c.wid : -1, (G - first) * 8);
}

__device__ __forceinline__ void ew_first(const Ctx& c_) {
    const Ctx c = make_ctx(c_.lds);
    KParams& P = kparams(); const float* mods = (const float*)(P.ws + WS_MODS); bf16_t* HB = (bf16_t*)(P.ws + WS_HB);
    int r0, r1; wave_rows(c, MTOT, r0, r1);
    f32x4 A0[4], B0[4]; int rcur = -1;
    for (int row = r0; row < r1; ++row) {
        const float* src = row < NLAT ? P.in[0] + (size_t)row * DM : P.in[2] + (size_t)(row - NLAT) * DM;
        bf16_t* xr = xrow_ptr(P, row); const int r = mod_r(row);
        if (r != rcur) { rcur = r; const float* mb = mods + (size_t)(0 * 5 + r) * (NMOD * DM); ld_mod(A0, B0, P.in[6] + (0 * 4 + 0) * DM, mb + 0 * DM, mb + 1 * DM, c.lane); }
        f32x4 x[4], h[4];
#pragma unroll
        for (int j = 0; j < 4; ++j) { x[j] = ld4(src + 4 * c.lane + 256 * j); stbf4(xr + 4 * c.lane + 256 * j, x[j]); }
        norm_mod2(x, h, A0, B0);
#pragma unroll
        for (int j = 0; j < 4; ++j) stbf4(HB + (size_t)row * DM + 4 * c.lane + 256 * j, h[j]);
    }
}

__device__ __forceinline__ void ew_even_mix(const Ctx& c_, int i) {
    const Ctx c = make_ctx(c_.lds);
    KParams& P = kparams(); bf16_t* PB = (bf16_t*)(P.ws + WS_U + U_PB);
    const float* sg = P.in[11] + i * 512; const float* rc = (const float*)(P.ws + WS_ROPEB); const float* rsn = rc + SEQ * 32;
    for (int row = c.gw; row < MTOT; row += c.NGW) {
        bf16_t* pr = PB + (size_t)row * EV_IN;
        {
            const u32x4 w = *(const u32x4*)(pr + 8 * c.lane); float f[8] = {bflo(w.x), bfhi(w.x), bflo(w.y), bfhi(w.y), bflo(w.z), bfhi(w.z), bflo(w.w), bfhi(w.w)};
#pragma unroll
            for (int e = 0; e < 8; ++e) f[e] = gelu_tanh_f(f[e]);
            u32x4 o = {cvtpk(f[0], f[1]), cvtpk(f[2], f[3]), cvtpk(f[4], f[5]), cvtpk(f[6], f[7])}; *(u32x4*)(pr + 8 * c.lane) = o;
        }
        {
            const u32x4 w = *(const u32x4*)(pr + 512 + 8 * c.lane); float f[8] = {bflo(w.x), bfhi(w.x), bflo(w.y), bfhi(w.y), bflo(w.z), bfhi(w.z), bflo(w.w), bfhi(w.w)};
            float s = 0.f;
#pragma unroll
            for (int e = 0; e < 8; ++e) { f[e] = gelu_tanh_f(f[e]); s += f[e]; }
            const float mean = wave_sum(s) * (1.f / 512.f); float q = 0.f;
#pragma unroll
            for (int e = 0; e < 8; ++e) { f[e] -= mean; q += f[e] * f[e]; }
            const float rstd = rsqrtf(wave_sum(q) * (1.f / 512.f) + EPS);
            const f32x4 g0 = ld4(sg + 8 * c.lane), g1 = ld4(sg + 8 * c.lane + 4);
            float gg[8] = {g0[0], g0[1], g0[2], g0[3], g1[0], g1[1], g1[2], g1[3]};
#pragma unroll
            for (int e = 0; e < 8; ++e) f[e] = f[e] * rstd * gg[e];
            u32x4 o = {cvtpk(f[0], f[1]), cvtpk(f[2], f[3]), cvtpk(f[4], f[5]), cvtpk(f[6], f[7])}; *(u32x4*)(pr + 512 + 8 * c.lane) = o;
        }
        if (row < NLAT) {
            const int s = row & (SEQ - 1), hj = c.lane >> 3, sub = c.lane & 7;
            bf16_t* kp = pr + 1536 + hj * 64 + 4 * sub;
            const f32x4 x1 = ldbf4(kp), x2 = ldbf4(kp + 32), cs = ld4(rc + s * 32 + 4 * sub), sn = ld4(rsn + s * 32 + 4 * sub);
            stbf4(kp, x1 * cs - x2 * sn); stbf4(kp + 32, x2 * cs + x1 * sn);
        }
    }
}

__device__ __forceinline__ void ew_odd_mla(const Ctx& c_, int i) {
    const Ctx c = make_ctx(c_.lds);
    KParams& P = kparams(); const bf16_t* PB = (const bf16_t*)(P.ws + WS_U + U_PB); bf16_t* A2 = (bf16_t*)(P.ws + WS_U + U_A2);
    const float* gq = P.in[23] + i * 256; const float* gkv = P.in[25] + i * 128; const float* rc = (const float*)(P.ws + WS_ROPED); const float* rsn = rc + SEQ * 16;
    for (int row = c.gw; row < MTOT; row += c.NGW) {
        const bf16_t* pr = PB + (size_t)row * OD_INP; bf16_t* ar = A2 + (size_t)row * MLA_K;
        f32x4 q = ldbf4(pr + 1536 + 4 * c.lane);
        const float rq = rsqrtf(wave_sum(q[0] * q[0] + q[1] * q[1] + q[2] * q[2] + q[3] * q[3]) * (1.f / 256.f) + EPS);
        stbf4(ar + 4 * c.lane, q * rq * ld4(gq + 4 * c.lane));
        const unsigned kw = *(const unsigned*)(pr + 1792 + 2 * c.lane); const float k0 = bflo(kw), k1 = bfhi(kw);
        const float rk = rsqrtf(wave_sum(k0 * k0 + k1 * k1) * (1.f / 128.f) + EPS);
        *(unsigned*)(ar + 256 + 2 * c.lane) = cvtpk(k0 * rk * gkv[2 * c.lane], k1 * rk * gkv[2 * c.lane + 1]);
        if (c.lane < 16) { float x1 = bf2f(pr[1920 + c.lane]), x2 = bf2f(pr[1920 + 16 + c.lane]);
            if (row < NLAT) { const int s = row & (SEQ - 1); const float cs = rc[s * 16 + c.lane], sn = rsn[s * 16 + c.lane]; const float o1 = x1 * cs - x2 * sn, o2 = x2 * cs + x1 * sn; x1 = o1; x2 = o2; }
            ar[384 + c.lane] = f2bf(x1); ar[384 + 16 + c.lane] = f2bf(x2); }
        else { *(unsigned*)(ar + 416 + 2 * (c.lane - 16)) = 0u; }
    }
}

__device__ __forceinline__ void ew_mid(const Ctx& c_, int l, int mtok, bool dry = false) {
    const Ctx c = make_ctx(c_.lds);
    KParams& P = kparams(); const float* mods = (const float*)(P.ws + WS_MODS); bf16_t* HB = (bf16_t*)(P.ws + WS_HB);
    const bf16_t* YB = (const bf16_t*)(P.ws + WS_U + U_YB);
    const bool odd = (l & 1) != 0; const int li = l >> 1;
    LAS float* wrl = (LAS float*)c.lds;
    if (odd) { for (int i = c.tid; i < DM * NEXP; i += 512) { const int col = i >> 3, e = i & 7; wrl[e * DM + col] = P.in[27][(size_t)li * DM * NEXP + i]; } __syncthreads(); }
    unsigned long long cw = 0ull; int st_e1 = 0, st_e2 = 0, st_l1 = 0, st_l2 = 0; float st_g1 = 0.f; int nrow = 0;
    int r0, r1; wave_rows(c, mtok, r0, r1);
    f32x4 G1[4], A2[4], B2[4]; int rcur = -1;
    u32x2 xa[4], ya[4], xb[4], yb[4];
#define EWM_LOAD(X, Y, rw) do { const int _row = (rw); const bf16_t* _xr = xrow_ptr(P, _row); \
        _Pragma("unroll") for (int j = 0; j < 4; ++j) { X[j] = *(const u32x2*)(_xr + 4 * c.lane + 256 * j); Y[j] = *(const u32x2*)(YB + (size_t)_row * DM + 4 * c.lane + 256 * j); } } while (0)
    if (r0 < r1) EWM_LOAD(xa, ya, r0);
    if (r0 + 1 < r1) EWM_LOAD(xb, yb, r0 + 1);
    for (int row = r0; row < r1; ++row, ++nrow) {
        bf16_t* xr = xrow_ptr(P, row); const int r = mod_r(row);
        if (r != rcur) { rcur = r; const float* mb = mods + (size_t)(l * 5 + r) * (NMOD * DM);
            ld_gate(G1, P.in[6] + (l * 4 + 1) * DM, mb + 2 * DM, c.lane); ld_mod(A2, B2, P.in[6] + (l * 4 + 2) * DM, mb + 3 * DM, mb + 4 * DM, c.lane); }
        f32x4 x[4], y[4], h[4];
#pragma unroll
        for (int j = 0; j < 4; ++j) { x[j] = (f32x4){bflo(xa[j].x), bfhi(xa[j].x), bflo(xa[j].y), bfhi(xa[j].y)}; y[j] = (f32x4){bflo(ya[j].x), bfhi(ya[j].x), bflo(ya[j].y), bfhi(ya[j].y)}; xa[j] = xb[j]; ya[j] = yb[j]; }
        if (row + 2 < r1) EWM_LOAD(xb, yb, row + 2);
        resid_add2(x, y, G1);
        bf16_t* xw = dry ? (bf16_t*)(P.ws + WS_U + U_YS) + (size_t)row * DM : xr; bf16_t* hw = (dry ? (bf16_t*)(P.ws + WS_U + U_PB) : HB) + (size_t)row * DM;
#pragma unroll
        for (int j = 0; j < 4; ++j) stbf4(xw + 4 * c.lane + 256 * j, x[j]);
        norm_mod2(x, h, A2, B2);
        if ((odd && MOE_F8) || (!odd && FFN8(li))) {
            unsigned char* h8 = (unsigned char*)(dry ? (bf16_t*)(P.ws + WS_U + U_PB) : HB) + (size_t)row * DM;
#pragma unroll
            for (int j = 0; j < 4; ++j) *(unsigned*)(h8 + 4 * c.lane + 256 * j) = pk4_fp8(h[j][0] * F8_ACT_SCALE, h[j][1] * F8_ACT_SCALE, h[j][2] * F8_ACT_SCALE, h[j][3] * F8_ACT_SCALE);
        } else {
#pragma unroll
            for (int j = 0; j < 4; ++j) stbf4(hw + 4 * c.lane + 256 * j, h[j]);
        }
        if (odd && !dry) {
            float lg[8];
#pragma unroll
            for (int e = 0; e < 8; ++e) { float sacc = 0.f;
#pragma unroll
                for (int j = 0; j < 4; ++j) { const f32x4 w = *(const LAS f32x4*)(wrl + e * DM + 4 * c.lane + 256 * j); sacc += (h[j][0] * w[0] + h[j][1] * w[1]) + (h[j][2] * w[2] + h[j][3] * w[3]); }
                lg[e] = wave_sum(sacc); }
            int e1 = 0; float v1 = lg[0];
#pragma unroll
            for (int e = 1; e < 8; ++e) if (lg[e] > v1) { v1 = lg[e]; e1 = e; }
            int e2 = -1; float v2 = -3.0e38f;
#pragma unroll
            for (int e = 0; e < 8; ++e) if (e != e1 && lg[e] > v2) { v2 = lg[e]; e2 = e; }
            if (e2 < 0) e2 = (e1 + 1) & 7;
            const float g1 = 1.f / (1.f + expf(v2 - v1));
            const int l1 = (int)((cw >> (8 * e1)) & 0xffull); cw += 1ull << (8 * e1);
            const int l2 = (int)((cw >> (8 * e2)) & 0xffull); cw += 1ull << (8 * e2);
            if (c.lane == nrow) { st_e1 = e1; st_e2 = e2; st_l1 = l1; st_l2 = l2; st_g1 = g1; }
        }
    }
    if (odd && !dry) {
        unsigned* cnt = (unsigned*)(P.ws + WS_CTL) + CW_MOECNT + li * 64;
        int base = 0;
        if (c.lane < 8) { const unsigned wc = (unsigned)((cw >> (8 * c.lane)) & 0xffull); base = wc ? (int)atomicAdd(cnt + c.lane, wc) : 0; }
        const int b1 = __shfl(base, st_e1), b2 = __shfl(base, st_e2);
        if (c.lane < nrow) { const int row = r0 + c.lane; int4* ti = (int4*)(P.ws + WS_TOKINFO) + (size_t)row * 2;
            ti[0] = make_int4(st_e1, b1 + st_l1, st_e2, b2 + st_l2); ti[1] = make_int4(__float_as_int(st_g1), __float_as_int(1.f - st_g1), 0, 0); }
        __syncthreads();
    }
#undef EWM_LOAD
}

__device__ __forceinline__ void moe_offsets(KParams& P, int li, int (&toff)[9]) {
    const unsigned* cnt = (const unsigned*)(P.ws + WS_CTL) + CW_MOECNT + li * 64; int acc = 0;
#pragma unroll
    for (int e = 0; e < 8; ++e) { toff[e] = acc; const unsigned n = __builtin_amdgcn_readfirstlane(__hip_atomic_load(cnt + e, __ATOMIC_RELAXED, __HIP_MEMORY_SCOPE_AGENT)); acc += (int)((n + 255u) >> 8); }
    toff[8] = acc;
}
__device__ __forceinline__ void moe_gather(const Ctx& c_, int li, int mtok) {
    const Ctx c = make_ctx(c_.lds);
    KParams& P = kparams(); int toff[9]; moe_offsets(P, li, toff);
    int tv = 0;
#pragma unroll
    for (int e = 0; e < 8; ++e) tv = (c.lane == e) ? toff[e] : tv;
    const bf16_t* HB = (const bf16_t*)(P.ws + WS_HB); bf16_t* HS = (bf16_t*)(P.ws + WS_U + U_YS);
    int r0, r1; wave_rows(c, mtok, r0, r1);
    for (int row = r0; row < r1; ++row) {
        const int4* ti = (const int4*)(P.ws + WS_TOKINFO) + (size_t)row * 2; const int4 a = ti[0], b = ti[1];
        const int pA = __shfl(tv, a.x) * 256 + a.y, pB = __shfl(tv, a.z) * 256 + a.w;
        if (c.lane == 0) ((int4*)(P.ws + WS_TOKPOS))[row] = make_int4(pA, pB, b.x, b.y);
#if MOE_F8
        const u32x4 v0 = ((const u32x4*)((const unsigned char*)HB + (size_t)row * DM))[c.lane];
        ((u32x4*)((unsigned char*)HS + (size_t)pA * DM))[c.lane] = v0; ((u32x4*)((unsigned char*)HS + (size_t)pB * DM))[c.lane] = v0;
#else
        const u32x4* src = (const u32x4*)(HB + (size_t)row * DM); const u32x4 v0 = src[c.lane], v1 = src[64 + c.lane];
        u32x4* dA = (u32x4*)(HS + (size_t)pA * DM); u32x4* dB = (u32x4*)(HS + (size_t)pB * DM);
        dA[c.lane] = v0; dA[64 + c.lane] = v1; dB[c.lane] = v0; dB[64 + c.lane] = v1;
#endif
    }
}

__device__ __forceinline__ void ew_last(const Ctx& c_, int l, int mtok, bool dry = false) {
    const Ctx c = make_ctx(c_.lds);
    KParams& P = kparams(); const float* mods = (const float*)(P.ws + WS_MODS); bf16_t* HB = (bf16_t*)(P.ws + WS_HB);
    const bf16_t* YS = (const bf16_t*)(P.ws + WS_U + U_YS); const bool odd = (l & 1) != 0;
    int r0, r1; wave_rows(c, mtok, r0, r1);
    f32x4 G3[4], A0[4], B0[4]; int rcur = -1;
    u32x2 xa[4], ya[4], za[4], xb[4], yb[4], zb[4]; float gAa = 0.f, gBa = 0.f, gAb = 0.f, gBb = 0.f;
#define EWL_LOAD(X, Y, Z, GA, GB, rw) do { const int _row = (rw); const bf16_t* _xr = xrow_ptr(P, _row); \
        if (odd) { const int4 tp = ((const int4*)(P.ws + WS_TOKPOS))[_row]; GA = __int_as_float(tp.z); GB = __int_as_float(tp.w); \
            _Pragma("unroll") for (int j = 0; j < 4; ++j) { Y[j] = *(const u32x2*)(YS + (size_t)tp.x * DM + 4 * c.lane + 256 * j); Z[j] = *(const u32x2*)(YS + (size_t)tp.y * DM + 4 * c.lane + 256 * j); } } \
        else { _Pragma("unroll") for (int j = 0; j < 4; ++j) Y[j] = *(const u32x2*)(YS + (size_t)_row * DM + 4 * c.lane + 256 * j); } \
        _Pragma("unroll") for (int j = 0; j < 4; ++j) X[j] = *(const u32x2*)(_xr + 4 * c.lane + 256 * j); } while (0)
    if (r0 < r1) EWL_LOAD(xa, ya, za, gAa, gBa, r0);
    if (r0 + 1 < r1) EWL_LOAD(xb, yb, zb, gAb, gBb, r0 + 1);
    for (int row = r0; row < r1; ++row) {
        bf16_t* xr = xrow_ptr(P, row); const int r = mod_r(row);
        if (r != rcur) { rcur = r; const float* mb = mods + (size_t)(l * 5 + r) * (NMOD * DM);
            ld_gate(G3, P.in[6] + (l * 4 + 3) * DM, mb + 5 * DM, c.lane);
            if (l < 3) { const float* mn = mods + (size_t)((l + 1) * 5 + r) * (NMOD * DM); ld_mod(A0, B0, P.in[6] + ((l + 1) * 4 + 0) * DM, mn + 0 * DM, mn + 1 * DM, c.lane); } }
        f32x4 x[4], y[4], h[4];
#pragma unroll
        for (int j = 0; j < 4; ++j) { x[j] = (f32x4){bflo(xa[j].x), bfhi(xa[j].x), bflo(xa[j].y), bfhi(xa[j].y)};
            y[j] = (f32x4){bflo(ya[j].x), bfhi(ya[j].x), bflo(ya[j].y), bfhi(ya[j].y)};
            if (odd) y[j] = y[j] * gAa + (f32x4){bflo(za[j].x), bfhi(za[j].x), bflo(za[j].y), bfhi(za[j].y)} * gBa;
            xa[j] = xb[j]; ya[j] = yb[j]; za[j] = zb[j]; }
        gAa = gAb; gBa = gBb;
        if (row + 2 < r1) EWL_LOAD(xb, yb, zb, gAb, gBb, row + 2);
        resid_add2(x, y, G3);
        bf16_t* hw = (dry ? (bf16_t*)(P.ws + WS_U + U_MIX) : HB) + (size_t)row * DM;
        if (l == 3 && !dry) { float* ow = P.out + (size_t)row * DM;
#pragma unroll
            for (int j = 0; j < 4; ++j) *(f32x4*)(ow + 4 * c.lane + 256 * j) = x[j]; }
        else { bf16_t* xw = dry ? (bf16_t*)(P.ws + WS_U + U_PB) + (size_t)row * DM : xr;
#pragma unroll
            for (int j = 0; j < 4; ++j) stbf4(xw + 4 * c.lane + 256 * j, x[j]); }
        if (l < 3) { norm_mod2(x, h, A0, B0);
#pragma unroll
            for (int j = 0; j < 4; ++j) stbf4(hw + 4 * c.lane + 256 * j, h[j]); }
    }
#undef EWL_LOAD
}

__device__ __forceinline__ void attn_even(const Ctx& c_, int l) {
    const Ctx c = make_ctx(c_.lds);
    KParams& P = kparams(); const int i = l >> 1; const bool need_ctx = l < 3;
    const bf16_t* PB = (const bf16_t*)(P.ws + WS_U + U_PB); bf16_t* MIX = (bf16_t*)(P.ws + WS_U + U_MIX);
    const int nchunk = need_ctx ? 264 : 256;
    for (int u = opaque_bid(); u < nchunk * 4; u += gridDim.x) att::sgu_unit(c.lds, PB, (const bf16_t*)(P.ws + WS_SGUW) + (size_t)i * 4 * 128 * 128, P.in[10] + i * 512, (const float*)(P.ws + WS_STATS), P.in[11] + i * 512, MIX, (u >> 2) * 128, u & 3);
    float d1 = 0.f, d2 = 0.f;
    if (c.lane < 64) { d1 = P.in[12][i * 64 + c.lane] * P.in[13][i * 64 + c.lane]; d2 = P.in[14][i * 64 + c.lane] * P.in[15][i * 64 + c.lane]; }
    const float lam_init = 0.8f - 0.6f * expf(-0.3f * (float)l);
    const float lam = expf(wave_sum(d1)) - expf(wave_sum(d2)) + lam_init;
    att::Args a;
    a.Q = PB; a.ldq = EV_IN; a.K = PB; a.ldk = EV_IN; a.V = PB; a.ldv = EV_IN; a.C = 0.125f * LOG2E;
    a.rcos = (const float*)(P.ws + WS_ROPEB); a.rsin = a.rcos + SEQ * 32; a.O = MIX; a.ldo = DM; a.g = 0; a.u0 = 0; a.rpb = nullptr;
    a.lam = lam; a.oscale = 1.f - lam_init; a.subg = P.in[16] + i * 128; a.nt_ctx = 4;
    const int nctxu = need_ctx ? 32 : 0, nu = nctxu + 1024;
    for (int u = xcd_unit_base(); u < nu; u += gridDim.x) {
        int b, h;
        if (u < nctxu) { b = u >> 3; h = (u >> 1) & 3; a.q_row0 = NLAT + b * CTXL + (u & 1) * 128; a.nt_lat = 0; a.rope = 0; }
        else { const int v = u - nctxu; b = v >> 8; h = (v >> 6) & 3; a.q_row0 = b * SEQ + (v & 63) * 128; a.nt_lat = SEQ / 64; a.rope = 0; }
        a.qcol = 1024 + h * 128; a.kcol = 1536 + h * 128; a.vcol = 2048 + h * 128; a.ocol = 512 + h * 128;
        a.kctx_row0 = NLAT + b * CTXL; a.klat_row0 = b * SEQ;
        att::attn_unit<64, 128, 128, 1>(c.lds, a);
    }
}
__device__ __forceinline__ void attn_odd_na(const Ctx& c_, int l) {
    const Ctx c = make_ctx(c_.lds);
    KParams& P = kparams(); const int i = l >> 1; const bool need_ctx = l < 3;
    const bf16_t* PB = (const bf16_t*)(P.ws + WS_U + U_PB); bf16_t* MIX = (bf16_t*)(P.ws + WS_U + U_MIX);
    att::Args a;
    a.Q = PB; a.ldq = OD_INP; a.K = PB; a.ldk = OD_INP; a.V = PB; a.ldv = OD_INP; a.C = 0.125f * LOG2E; a.rope = 0; a.rcos = nullptr; a.rsin = nullptr;
    a.O = MIX; a.ldo = DM; a.lam = 0.f; a.oscale = 1.f; a.subg = nullptr; a.nt_ctx = 4;
    const int nctxu = need_ctx ? 32 : 0, nu = nctxu + 1024;
    for (int u = xcd_unit_base(); u < nu; u += gridDim.x) {
        int b, h;
        if (u < nctxu) { b = u >> 3; h = u & 7; a.q_row0 = NLAT + b * CTXL; a.nt_lat = 0; a.g = 0; a.u0 = 0; a.klat_row0 = 0; }
        else { const int v = u - nctxu; b = v >> 8; h = (v >> 5) & 7; const int g = v & 31; a.g = g; a.u0 = min(max(4 * g - 4, 0), 116);
            a.q_row0 = b * SEQ + g * 256; a.nt_lat = 12; a.klat_row0 = b * SEQ + a.u0 * 64; }
        a.qcol = h * 64; a.kcol = 512 + h * 64; a.vcol = 1024 + h * 64; a.ocol = h * 64; a.kctx_row0 = NLAT + b * CTXL;
        a.rpb = P.in[22] + ((size_t)i * 8 + h) * 465;
        att::attn_unit<64, 64, 64, 2>(c.lds, a);
    }
}
__device__ __forceinline__ void attn_odd_mla(const Ctx& c_, int l) {
    const Ctx c = make_ctx(c_.lds);
    KParams& P = kparams(); const bool need_ctx = l < 3;
    const bf16_t* MO = (const bf16_t*)(P.ws + WS_U + U_MLAO); bf16_t* MIX = (bf16_t*)(P.ws + WS_U + U_MIX);
    att::Args a;
    a.Q = MO; a.ldq = MLA_N; a.K = MO; a.ldk = MLA_N; a.V = MO; a.ldv = MLA_N; a.C = 0.10206207261596575f * LOG2E;
    a.rcos = (const float*)(P.ws + WS_ROPED); a.rsin = a.rcos + SEQ * 16; a.O = MIX; a.ldo = DM; a.g = 0; a.u0 = 0; a.rpb = nullptr; a.lam = 0.f; a.oscale = 1.f; a.subg = nullptr; a.nt_ctx = 4;
    const int nctxu = need_ctx ? 16 : 0, nu = nctxu + 512;
    for (int u = xcd_unit_base(); u < nu; u += gridDim.x) {
        int b, h;
        if (u < nctxu) { b = u >> 2; h = u & 3; a.q_row0 = NLAT + b * CTXL; a.nt_lat = 0; a.rope = 0; }
        else { const int v = u - nctxu; b = v >> 7; h = (v >> 5) & 3; a.q_row0 = b * SEQ + (v & 31) * 256; a.nt_lat = SEQ / 64; a.rope = 2; }
        a.qcol = h * 96; a.kcol = 384 + h * 96; a.vcol = 768 + h * 128; a.ocol = 512 + h * 128; a.kctx_row0 = NLAT + b * CTXL; a.klat_row0 = b * SEQ;
        att::attn_unit<96, 96, 128, 0>(c.lds, a);
    }
}

constexpr int N_PHASES = 2 + 2 * (7 + 9);
__global__ void __launch_bounds__(512, 2) fwd_kernel(Params prm) {
    extern __shared__ __attribute__((aligned(16))) unsigned char lds_raw[];
    LAS unsigned char* lds = (LAS unsigned char*)lds_raw;
    const Ctx c{lds, 0, 0, 0, 0, 0};
    for (int u = threadIdx.x; u < (LDS_BYTES - LDS_MISC) / 4; u += 512) ((LAS unsigned*)(lds + LDS_MISC))[u] = 0u;
    __syncthreads();
    XcdBarrier bar;
    { unsigned char* ws0 = kparams().ws; bar.bar = (unsigned*)(ws0 + WS_CTL) + CW_BAR; bar.x = 0; bar.st = nullptr;
#if !MK_PER_PHASE
      bar = xcd_barrier_post((unsigned*)(ws0 + WS_CTL) + CW_BAR, (volatile LAS unsigned*)(lds + LDS_MISC + 32));
#endif
    }
    int ph = 0;
#ifndef PMASK
#define PMASK 0xffffffffu
#endif
#define PM(b) ((PMASK >> (b)) & 1u)
#define PH_ON() (ph >= kparams().ph_lo && ph < kparams().ph_hi)
#define PH_END() do { if (ph >= kparams().ph_lo && ph + 1 < kparams().ph_hi) xcd_barrier(bar); ++ph; } while (0)
#define WSP(off) ((bf16_t*)(ws + (off)))
#define HB WSP(WS_HB)
#define PB WSP(WS_U + U_PB)
#define MIX WSP(WS_U + U_MIX)
#define YB WSP(WS_U + U_YB)
#define HID WSP(WS_U + U_HID)
#define YS WSP(WS_U + U_YS)
#define A2 WSP(WS_U + U_A2)
#define MO WSP(WS_U + U_MLAO)

    if (PM(0) && PH_ON()) for (int rep = 0; rep < DUPN(0); ++rep) { prologue0(c); __syncthreads(); }
    PH_END();
    if (PM(1) && PH_ON()) for (int rep = 0; rep < DUPN(1); ++rep) ew_first(c);
    PH_END();
    for (int lp = 0; lp < 2; ++lp) {
        {
            const int l = 2 * lp, i = lp; const int mtok = l < 3 ? MTOT : NLAT, nMt = mtok / 256;
            if (PM(2) && PH_ON()) for (int rep = 0; rep < DUPN(2); ++rep) { unsigned char* ws = kparams().ws; pg8::Gemm g{}; g.A = HB; g.lda = DM; g.Bt = (const bf16_t*)(ws + WS_WINE) + (size_t)i * EV_IN * DM; g.K = DM; g.nM = MTOT / 256; g.nN = EV_IN / 256; g.grouped = 0; g.estride = 0;
                pg8::EpiEvenIn E{PB, EV_IN, (f32x2*)(ws + WS_STATS), (const float*)(ws + WS_ROPEB), (const float*)(ws + WS_ROPEB) + SEQ * 32}; gemm_even_in(lds, g, E); if (rep == 0) convert_moe_tail(c, i, 0, 7296, (MTOT / 256) * (EV_IN / 256)); }
            PH_END();
            if (PM(4) && PH_ON()) for (int rep = 0; rep < DUPN(4); ++rep) attn_even(c, l);
            PH_END();
            if (PM(5) && PH_ON()) for (int rep = 0; rep < DUPN(5); ++rep) { unsigned char* ws = kparams().ws; pg8::Gemm g{}; g.A = MIX; g.lda = DM; g.Bt = (const bf16_t*)(ws + WS_WOUTE) + (size_t)i * DM * DM; g.K = DM; g.nM = nMt; g.nN = DM / 256; g.grouped = 0; g.estride = 0;
                gemm_bf16(lds, g, YB, DM); if (rep == 0) convert_moe_tail(c, i, 7296, 14592, nMt * (DM / 256)); }
            PH_END();
            if (PM(6) && PH_ON()) { if (DUPN(6) > 1) ew_mid(c, l, mtok, true); ew_mid(c, l, mtok); }
            PH_END();
            if (PM(7) && PH_ON()) for (int rep = 0; rep < DUPN(7); ++rep) { unsigned char* ws = kparams().ws; pg8::Gemm g{}; g.A = HB; g.lda = DM; g.Bt = (const unsigned char*)(ws + WS_W13E) + (size_t)i * 2 * DFF * DM * 2; g.K = DM; g.nM = nMt; g.nN = 2 * DFF / 256; g.grouped = 0; g.estride = 0;
                if (FFN8(i)) gemm8_swiglu8(lds, g, (unsigned char*)HID, DFF); else gemm_swiglu(lds, g, HID, DFF);
                if (rep == 0) convert_moe_tail(c, i, 14592, 20224, nMt * (2 * DFF / 256)); }
            PH_END();
            if (PM(8) && PH_ON()) for (int rep = 0; rep < DUPN(8); ++rep) { unsigned char* ws = kparams().ws; pg8::Gemm g{}; g.A = HID; g.lda = DFF; g.Bt = (const unsigned char*)(ws + WS_W2E) + (size_t)i * DM * DFF * 2; g.K = DFF; g.nM = nMt; g.nN = DM / 256; g.grouped = 0; g.estride = 0;
                if (FFN8(i)) gemm8_bf16(lds, g, YS, DM); else gemm_bf16(lds, g, YS, DM);
                if (rep == 0) convert_moe_tail(c, i, 20224, MOE_CVT_ITEMS, nMt * (DM / 256)); }
            PH_END();
            if (PM(9) && PH_ON()) { if (DUPN(9) > 1) ew_last(c, l, mtok, true); ew_last(c, l, mtok); }
            PH_END();
        }
        {
            const int l = 2 * lp + 1, i = lp; const int mtok = l < 3 ? MTOT : NLAT, nMt = mtok / 256;
            if (PM(10) && PH_ON()) for (int rep = 0; rep < DUPN(10); ++rep) { unsigned char* ws = kparams().ws; pg8::Gemm g{}; g.A = HB; g.lda = DM; g.Bt = (const bf16_t*)(ws + WS_WINO) + (size_t)i * OD_INP * DM; g.K = DM; g.nM = MTOT / 256; g.nN = OD_INP / 256; g.grouped = 0; g.estride = 0;
                pg8::EpiOddIn E{PB, OD_INP, (float*)(ws + WS_STATS), (const float*)(ws + WS_ROPED), (const float*)(ws + WS_ROPED) + SEQ * 16}; gemm_odd_in(lds, g, E); }
            PH_END();
            if (PM(12) && PH_ON()) for (int rep = 0; rep < DUPN(12); ++rep) { unsigned char* ws = kparams().ws; pg8::Gemm g{}; g.A = PB + 1536; g.lda = OD_INP; g.Bt = (const bf16_t*)(ws + WS_WMLA) + (size_t)i * MLA_N * MLA_K; g.K = MLA_K; g.nM = MTOT / 256; g.nN = MLA_N / 256; g.grouped = 0; g.estride = 0;
                pg8::EpiMlaUp E{MO, MLA_N, (const float*)(ws + WS_STATS)}; gemm_mla_up(lds, g, E); }
            PH_END();
            if (PH_ON()) { if (PM(13)) for (int rep = 0; rep < DUPN(13); ++rep) attn_odd_na(c, l); if (PM(14)) for (int rep = 0; rep < DUPN(14); ++rep) attn_odd_mla(c, l); }
            PH_END();
            if (PM(15) && PH_ON()) for (int rep = 0; rep < DUPN(15); ++rep) { unsigned char* ws = kparams().ws; pg8::Gemm g{}; g.A = MIX; g.lda = DM; g.Bt = (const bf16_t*)(ws + WS_WOUTO) + (size_t)i * DM * DM; g.K = DM; g.nM = nMt; g.nN = DM / 256; g.grouped = 0; g.estride = 0;
                gemm_bf16(lds, g, YB, DM); }
            PH_END();
            if (PM(16) && PH_ON()) { if (DUPN(16) > 1) ew_mid(c, l, mtok, true); ew_mid(c, l, mtok); }
            PH_END();
            if (PM(17) && PH_ON()) for (int rep = 0; rep < DUPN(17); ++rep) moe_gather(c, i, mtok);
            PH_END();
            if (PM(18) && PH_ON()) for (int rep = 0; rep < DUPN(18); ++rep) { unsigned char* ws = kparams().ws; pg8::Gemm g{}; g.A = YS; g.lda = DM; g.Bt = (const bf16_t*)(ws + WS_W13M); g.K = DM; g.nN = 2 * DFFE / 256; g.grouped = 1; g.estride = (size_t)2 * DFFE * DM;
                moe_offsets(kparams(), i, g.toff); g.nM = g.toff[8];
#if MOE_F8
                gemm8_swiglu8(lds, g, (unsigned char*)HID, DFFE);
#else
                gemm_swiglu(lds, g, HID, DFFE);
#endif
            }
            PH_END();
            if (PM(19) && PH_ON()) for (int rep = 0; rep < DUPN(19); ++rep) { unsigned char* ws = kparams().ws; pg8::Gemm g{}; g.A = HID; g.lda = DFFE; g.Bt = (const bf16_t*)(ws + WS_W2M); g.K = DFFE; g.nN = DM / 256; g.grouped = 1; g.estride = (size_t)DM * DFFE;
                moe_offsets(kparams(), i, g.toff); g.nM = g.toff[8];
#if MOE_F8
                gemm8_bf16(lds, g, YS, DM);
#else
                gemm_bf16(lds, g, YS, DM);
#endif
            }
            PH_END();
            if (PM(20) && PH_ON()) { if (DUPN(20) > 1) ew_last(c, l, mtok, true); ew_last(c, l, mtok); }
            PH_END();
        }
    }
#undef PH_ON
#undef PH_END
#undef HB
#undef PB
#undef MIX
#undef YB
#undef HID
#undef YS
#undef A2
#undef MO
}

extern "C" void kernel_launch(void* const* d_in, const int* in_sizes, int n_in, void* d_out, int out_size, void* d_ws, size_t ws_size, hipStream_t stream) {
    static int grid = 0;
    if (grid == 0) {
        int dev = 0, cus = 0;
        if (n_in != 31 || out_size != NLAT * DM || ws_size < WS_END) { fprintf(stderr, "kernel_launch: unexpected shapes or workspace (n_in %d out %d ws %zu need %zu)\n", n_in, out_size, ws_size, (size_t)WS_END); grid = -1; }
        else if (hipGetDevice(&dev) != hipSuccess || hipDeviceGetAttribute(&cus, hipDeviceAttributeMultiprocessorCount, dev) != hipSuccess) grid = -1;
        else if (hipFuncSetAttribute((const void*)fwd_kernel, hipFuncAttributeMaxDynamicSharedMemorySize, LDS_BYTES) != hipSuccess) grid = -1;
        else { int per_cu = 0; (void)hipOccupancyMaxActiveBlocksPerMultiprocessor(&per_cu, (const void*)fwd_kernel, 512, LDS_BYTES); (void)hipGetLastError(); grid = cus; }
    }
    if (grid < 0) { (void)hipMemsetAsync(d_out, 0, (size_t)out_size * 4, stream); return; }
    (void)hipMemsetAsync((char*)d_ws + WS_CTL, 0, CTL_BYTES, stream);
    Params p{};
    for (int i = 0; i < 31; ++i) p.in[i] = (const float*)d_in[i];
    p.out = (float*)d_out; p.ws = (unsigned char*)d_ws;
#if MK_PER_PHASE
    for (int k = 0; k < N_PHASES; ++k) { p.ph_lo = k; p.ph_hi = k + 1; hipLaunchKernelGGL(fwd_kernel, dim3(grid), dim3(512), LDS_BYTES, stream, p); }
#else
    p.ph_lo = 0; p.ph_hi = N_PHASES;
    hipLaunchKernelGGL(fwd_kernel, dim3(grid), dim3(512), LDS_BYTES, stream, p);
#endif
}
```

```cpp
#include <hip/hip_runtime.h>
#include <stdint.h>
#include <stdio.h>

#ifndef MK_PER_PHASE
#define MK_PER_PHASE 0
#endif
#ifndef DUP_MASK
#define DUP_MASK 0u
#endif
#define DUPN(b) (1 + (int)((DUP_MASK >> (b)) & 1u))
#ifndef ATT_X
#define ATT_X 0
#endif
#ifndef FFN_F8
#define FFN_F8 1
#endif
#ifndef FFN_F8_FROM
#define FFN_F8_FROM 1
#endif
#define FFN8(i) (FFN_F8 && (i) >= FFN_F8_FROM)
#ifndef WIN_F8_FROM
#define WIN_F8_FROM 2
#endif
#define WIN8(l) ((l) >= WIN_F8_FROM)
#ifndef MOE_F8
#define MOE_F8 1
#endif

#define LAS __attribute__((address_space(3)))
typedef unsigned short bf16_t;
typedef short bf16x8 __attribute__((ext_vector_type(8)));
typedef short s16x4 __attribute__((ext_vector_type(4)));
typedef float f32x4 __attribute__((ext_vector_type(4)));
typedef float f32x2 __attribute__((ext_vector_type(2)));
typedef float f32x16 __attribute__((ext_vector_type(16)));
typedef unsigned u32x4 __attribute__((ext_vector_type(4)));
typedef unsigned u32x2 __attribute__((ext_vector_type(2)));

constexpr int DM = 1024, NB = 4, SEQ = 8192, NLAT = NB * SEQ, CTXL = 256, NCTX = NB * CTXL, MTOT = NLAT + NCTX;
constexpr int NMOD = 6;
constexpr int EV_IN = 2560, OD_IN = 1952, OD_INP = 2048, DFF = 2816, DFFE = 3584, NEXP = 8;
constexpr int MLA_N = 1280, MLA_K = 512;
constexpr int MS_MAX = 2 * MTOT + NEXP * 256;
constexpr float EPS = 1e-6f;
constexpr float LOG2E = 1.4426950408889634f;

constexpr size_t MiB = (size_t)1 << 20;
constexpr size_t WS_CTL = 0, CTL_BYTES = MiB;
constexpr size_t WS_MODS = 1 * MiB;
constexpr size_t WS_ROPEB = 2 * MiB;
constexpr size_t WS_ROPED = 4 * MiB;
constexpr size_t WS_SGUW = 5 * MiB;
constexpr size_t WS_TOKINFO = 6 * MiB;
constexpr size_t WS_TOKPOS = 8 * MiB;
constexpr size_t WS_CTXX = 10 * MiB;
constexpr size_t WS_WMLA = 14 * MiB;
constexpr size_t WS_WINE = 17 * MiB;
constexpr size_t WS_WOUTE = 27 * MiB;
constexpr size_t WS_W13E = 31 * MiB;
constexpr size_t WS_W2E = 53 * MiB;
constexpr size_t WS_WINO = 64 * MiB;
constexpr size_t WS_WOUTO = 72 * MiB;
constexpr size_t WS_W13M = 76 * MiB;
constexpr size_t WS_W2M = 188 * MiB;
constexpr size_t WS_HB = 244 * MiB;
constexpr size_t WS_U = 310 * MiB;
constexpr size_t U_PB = 0;
constexpr size_t U_MIX = 165 * MiB;
constexpr size_t U_A2 = 231 * MiB;
constexpr size_t U_MLAO = 264 * MiB;
constexpr size_t U_YB = 347 * MiB;
constexpr size_t U_HID = 0;
constexpr size_t U_XB = 549 * MiB;
constexpr size_t U_YS = 413 * MiB;
constexpr size_t WS_STATS = WS_U + 616 * MiB;
constexpr size_t WS_END = WS_STATS + 4 * MiB;
static_assert((size_t)MS_MAX * DFFE * (MOE_F8 ? 1 : 2) <= 347 * MiB && (size_t)MTOT * DFF * 2 <= 347 * MiB, "hid must stay clear of YB");
static_assert(U_YS + (size_t)MS_MAX * DM * 2 <= U_XB && U_XB + (size_t)MTOT * DM * 2 <= 616 * MiB, "ys / xb fit");

constexpr int CW_BAR = 4096;
constexpr int CW_MOECNT = 1024;

constexpr int LDS_BYTES = 147456;
constexpr int LDS_MISC = 131072;

__device__ __forceinline__ unsigned cvtpk(float lo, float hi) { unsigned r; asm volatile("v_cvt_pk_bf16_f32 %0, %1, %2" : "=v"(r) : "v"(lo), "v"(hi)); return r; }
__device__ __forceinline__ float bf2f(unsigned short b) { return __uint_as_float(((unsigned)b) << 16); }
__device__ __forceinline__ float bflo(unsigned w) { return __uint_as_float(w << 16); }
__device__ __forceinline__ float bfhi(unsigned w) { return __uint_as_float(w & 0xffff0000u); }
__device__ __forceinline__ bf16_t f2bf(float f) { return (bf16_t)(cvtpk(f, 0.f) & 0xffffu); }
typedef int i32x8 __attribute__((ext_vector_type(8)));
typedef int i32x4 __attribute__((ext_vector_type(4)));
constexpr float F8_ACT_SCALE = 4.f, F8_W_SCALE = 64.f, F8_INV = 1.f / (F8_ACT_SCALE * F8_W_SCALE);
__device__ __forceinline__ unsigned pk4_fp8(float a, float b, float c, float d) {
    a = __builtin_amdgcn_fmed3f(a, -448.f, 448.f); b = __builtin_amdgcn_fmed3f(b, -448.f, 448.f); c = __builtin_amdgcn_fmed3f(c, -448.f, 448.f); d = __builtin_amdgcn_fmed3f(d, -448.f, 448.f);
    int w = 0; w = __builtin_amdgcn_cvt_pk_fp8_f32(a, b, w, false); w = __builtin_amdgcn_cvt_pk_fp8_f32(c, d, w, true); return (unsigned)w; }
__device__ __forceinline__ float wave_sum(float v) {
#pragma unroll
    for (int o = 1; o < 64; o <<= 1) v += __shfl_xor(v, o);
    return v;
}
__device__ __forceinline__ float fast_exp2(float x) { return __builtin_amdgcn_exp2f(x); }
__device__ __forceinline__ float fast_rcp(float x) { return __builtin_amdgcn_rcpf(x); }
__device__ __forceinline__ float silu_f(float x) { return x * fast_rcp(1.f + fast_exp2(-x * LOG2E)); }
__device__ __forceinline__ float gelu_tanh_f(float x) { const float u = 0.7978845608028654f * (x + 0.044715f * x * x * x); return x * fast_rcp(1.f + fast_exp2(-2.f * LOG2E * u)); }
#define LDS_WAIT() asm volatile("s_waitcnt lgkmcnt(0)" ::: "memory")
#define VM_WAIT() asm volatile("s_waitcnt vmcnt(0)" ::: "memory")
__device__ __forceinline__ int opaque_bid() { int b = blockIdx.x; asm volatile("" : "+s"(b)); return b; }
__device__ __forceinline__ int xcd_unit_base() { const int b = opaque_bid(), G = (int)gridDim.x; return (G % 8 == 0) ? (b & 7) * (G >> 3) + (b >> 3) : b; }
__device__ __forceinline__ int opaque_tid() { int t = threadIdx.x; asm volatile("" : "+v"(t)); return t; }

#define XB_TMO      128
#define XB_XCNT(j)  (256  + 64 * (j))
#define XB_XSUB(j)  (1280 + 64 * (j))
#define XB_XGEN(j)  (2304 + 64 * (j))
#define XB_TOP      3328
#define XB_TOPGEN   3392
#define XCD_BAR_WORDS 3456
#define XB_SPIN_CAP (1u << 22)
__device__ __forceinline__ unsigned xb_ld(unsigned* p)              { return __hip_atomic_load(p, __ATOMIC_RELAXED, __HIP_MEMORY_SCOPE_AGENT); }
__device__ __forceinline__ unsigned xb_add(unsigned* p, unsigned v) { return __hip_atomic_fetch_add(p, v, __ATOMIC_RELAXED, __HIP_MEMORY_SCOPE_AGENT); }
__device__ __forceinline__ unsigned xb_xcc_id() { return (unsigned)__builtin_amdgcn_s_getreg((3 << 11) | 20) & 0xFu; }
#define XB_SPIN(cond, bar) do { unsigned _sp = 0; while (cond) { __builtin_amdgcn_s_sleep(1); \
    if ((++_sp & 255u) == 0u) { if (xb_ld(&(bar)[XB_TMO])) break; if (_sp > XB_SPIN_CAP) { atomicAdd(&(bar)[XB_TMO], 1u); break; } } } } while (0)
struct XcdBarrier { unsigned* bar; unsigned x; volatile LAS unsigned* st; };
__device__ __forceinline__ XcdBarrier xcd_barrier_post(unsigned* bar, volatile LAS unsigned* st) {
    XcdBarrier b; b.bar = bar; b.x = xb_xcc_id(); b.st = st;
    if (threadIdx.x == 0) (void)xb_add(&bar[XB_XCNT(b.x)], 1u);
    return b;
}
__device__ __forceinline__ void xcd_barrier_complete(unsigned* bar, unsigned x, unsigned& nloc, unsigned& nx) {
    const unsigned G = gridDim.x * gridDim.y * gridDim.z;
    unsigned sum, cnt, mine, sp = 0u;
    for (;;) {
        sum = 0u; cnt = 0u; mine = 0u;
#pragma unroll
        for (unsigned j = 0; j < 16; ++j) { const unsigned c = xb_ld(&bar[XB_XCNT(j)]); sum += c; cnt += (c > 0u) ? 1u : 0u; mine = (j == x) ? c : mine; }
        if (sum == G) break;
        __builtin_amdgcn_s_sleep(1);
        if ((++sp & 255u) == 0u) { if (xb_ld(&bar[XB_TMO])) break; if (sp > XB_SPIN_CAP) { atomicAdd(&bar[XB_TMO], 1u); break; } }
    }
    nloc = mine > 0u ? mine : 1u; nx = cnt > 0u ? cnt : 1u;
}
__device__ __forceinline__ void xcd_barrier(const XcdBarrier& b) {
    asm volatile("s_waitcnt vmcnt(0)" ::: "memory");
    __syncthreads();
    if (threadIdx.x == 0) {
        unsigned* bar = b.bar;
        __builtin_amdgcn_s_waitcnt(0);
        unsigned nloc = b.st[0], nx = b.st[1];
        if (nloc == 0u) { xcd_barrier_complete(bar, b.x, nloc, nx); b.st[0] = nloc; b.st[1] = nx; }
        const unsigned old = xb_add(&bar[XB_XSUB(b.x)], 1u);
        const unsigned gen = old / nloc;
        if (old + 1u == (gen + 1u) * nloc) {
            __builtin_amdgcn_fence(__ATOMIC_RELEASE, "agent");
            asm volatile("s_waitcnt vmcnt(0)" ::: "memory");
            const unsigned og = xb_add(&bar[XB_TOP], 1u);
            const unsigned tg = og / nx;
            if (og + 1u == (tg + 1u) * nx) xb_add(&bar[XB_TOPGEN], 1u);
            else XB_SPIN(xb_ld(&bar[XB_TOPGEN]) == tg, bar);
            __builtin_amdgcn_fence(__ATOMIC_ACQUIRE, "agent");
            xb_add(&bar[XB_XGEN(b.x)], 1u);
            asm volatile("s_waitcnt vmcnt(0)" ::: "memory");
        } else {
            XB_SPIN(xb_ld(&bar[XB_XGEN(b.x)]) == gen, bar);
            __builtin_amdgcn_fence(__ATOMIC_ACQUIRE, "agent");
            asm volatile("s_waitcnt vmcnt(0)" ::: "memory");
        }
    }
    __syncthreads();
}

namespace pg8 {
constexpr int BM = 256, BK = 64, HALF = 128, HTB = HALF * BK * 2, STAGE_BYTES = 8 * HTB, NXCD = 8, WGM = 8;
__device__ __forceinline__ int lds_byte(int r, int c) { const int st = (r >> 4) * 2 + (c >> 5), rr = r & 15, cc = c & 31, ob = rr * 64 + cc * 2; return st * 1024 + (ob ^ (((ob >> 9) & 1) << 5)); }
__device__ __forceinline__ void stage_rc(int b, int& R, int& C) { const int st = b / 1024, sb = b % 1024, swz = sb ^ (((sb >> 9) & 1) << 5); R = (st >> 1) * 16 + swz / 64; C = (st & 1) * 32 + (swz % 64) / 2; }
__device__ __forceinline__ int perm32(int rho) { const int n = rho >> 4, i = rho & 15; return 8 * (i >> 2) + 4 * n + (i & 3); }
struct Unit { int pm, pn, e; };
struct Gemm {
    const void* A; int lda;
    const void* Bt; int K;
    int nM, nN;
    int grouped; int toff[9]; size_t estride;
};
struct StaticOrder {
    int nM, nN, nwg, G, c;
    __device__ void init(int nM_, int nN_, int G_, int c_) { nM = nM_; nN = nN_; nwg = nM * nN; G = G_; c = c_; }
    __device__ __forceinline__ bool next(int i, Unit& u) const {
        const long L = (long)i * G + c; if (L >= nwg) return false;
        int wgid = (int)L; { const int q = nwg / NXCD, r = nwg % NXCD, xcd = wgid % NXCD, off = wgid / NXCD; wgid = (xcd < r ? xcd * (q + 1) : r * (q + 1) + (xcd - r) * q) + off; }
        const int nig = WGM * nN, gid = wgid / nig, fm = gid * WGM, gsz = (nM - fm) < WGM ? (nM - fm) : WGM;
        u.pm = fm + ((wgid % nig) % gsz); u.pn = (wgid % nig) / gsz; u.e = 0; return true;
    }
};
struct EpiBf16 {
    bf16_t* O; int ldc; float scale;
    __device__ __forceinline__ void operator()(const f32x4 (&acc)[2][2][4][2], const Unit& u, int wr, int wc, int fr, int fq) const {
        const int row0 = u.pm * BM + wr * 64 + fr, col0 = u.pn * BM + wc * 32 + 8 * fq;
#pragma unroll
        for (int ai = 0; ai < 2; ++ai)
#pragma unroll
            for (int m = 0; m < 4; ++m) { bf16_t* rowp = O + (size_t)(row0 + ai * HALF + m * 16) * ldc + col0;
#pragma unroll
                for (int bj = 0; bj < 2; ++bj) { const f32x4 v0 = acc[ai][bj][m][0] * scale, v1 = acc[ai][bj][m][1] * scale;
                    u32x4 w; w.x = cvtpk(v0[0], v0[1]); w.y = cvtpk(v0[2], v0[3]); w.z = cvtpk(v1[0], v1[1]); w.w = cvtpk(v1[2], v1[3]);
                    *(u32x4*)(rowp + bj * HALF) = w; } }
    }
};
struct EpiSwiGLU {
    bf16_t* O; int ldc;
    __device__ __forceinline__ void operator()(const f32x4 (&acc)[2][2][4][2], const Unit& u, int wr, int wc, int fr, int fq) const {
        const int row0 = u.pm * BM + wr * 64 + fr, col0 = u.pn * HALF + wc * 32 + 8 * fq;
#pragma unroll
        for (int ai = 0; ai < 2; ++ai)
#pragma unroll
            for (int m = 0; m < 4; ++m) { bf16_t* rowp = O + (size_t)(row0 + ai * HALF + m * 16) * ldc + col0;
                float r[8];
#pragma unroll
                for (int n = 0; n < 2; ++n)
#pragma unroll
                    for (int j = 0; j < 4; ++j) r[n * 4 + j] = silu_f(acc[ai][0][m][n][j]) * acc[ai][1][m][n][j];
                u32x4 w; w.x = cvtpk(r[0], r[1]); w.y = cvtpk(r[2], r[3]); w.z = cvtpk(r[4], r[5]); w.w = cvtpk(r[6], r[7]);
                *(u32x4*)rowp = w; }
    }
};

struct EpiEvenIn {
    bf16_t* O; int ldc; f32x2* stats; const float* rcos; const float* rsin; float scale;
    __device__ __forceinline__ void operator()(const f32x4 (&acc)[2][2][4][2], const Unit& u, int wr, int wc, int fr, int fq) const {
        int upm = u.pm, upn = u.pn; asm volatile("" : "+s"(upm), "+s"(upn));
        const int row0 = upm * BM + wr * 64 + fr, col0 = upn * BM + wc * 32 + 8 * fq;
        const int kind = upn < 2 ? 0 : (upn < 4 ? 1 : (upn < 8 ? 2 : 3)); const bool lat = upm < NLAT / BM; const int t4 = 4 * (4 * (wc & 1) + fq);
#pragma unroll
        for (int ai = 0; ai < 2; ++ai)
#pragma unroll
            for (int m = 0; m < 4; ++m) { const int row = row0 + ai * HALF + m * 16; bf16_t* rowp = O + (size_t)row * ldc + col0;
                f32x4 cs = {1.f, 1.f, 1.f, 1.f}, sn = {0.f, 0.f, 0.f, 0.f}; float s1 = 0.f, s2 = 0.f;
                if (kind == 2 && lat) { const int sp = row & (SEQ - 1); cs = *(const f32x4*)(rcos + sp * 32 + t4); sn = *(const f32x4*)(rsin + sp * 32 + t4); }
#pragma unroll
                for (int bj = 0; bj < 2; ++bj) { f32x4 v0 = acc[ai][bj][m][0] * scale, v1 = acc[ai][bj][m][1] * scale;
                    if (kind < 2) {
#pragma unroll
                        for (int j = 0; j < 4; ++j) { v0[j] = gelu_tanh_f(v0[j]); v1[j] = gelu_tanh_f(v1[j]); }
                        if (kind == 1) { s1 += (v0[0] + v0[1]) + (v0[2] + v0[3]) + (v1[0] + v1[1]) + (v1[2] + v1[3]);
                            s2 += (v0[0] * v0[0] + v0[1] * v0[1]) + (v0[2] * v0[2] + v0[3] * v0[3]) + (v1[0] * v1[0] + v1[1] * v1[1]) + (v1[2] * v1[2] + v1[3] * v1[3]); } }
                    else if (kind == 2) { const f32x4 o0 = v0 * cs - v1 * sn, o1 = v1 * cs + v0 * sn; v0 = o0; v1 = o1; }
                    u32x4 w; w.x = cvtpk(v0[0], v0[1]); w.y = cvtpk(v0[2], v0[3]); w.z = cvtpk(v1[0], v1[1]); w.w = cvtpk(v1[2], v1[3]);
                    *(u32x4*)(rowp + bj * HALF) = w; }
                if (kind == 1) { s1 += __shfl_xor(s1, 16); s1 += __shfl_xor(s1, 32); s2 += __shfl_xor(s2, 16); s2 += __shfl_xor(s2, 32);
                    if (fq == 0) stats[(size_t)row * 8 + (upn - 2) * 4 + wc] = (f32x2){s1, s2}; } }
    }
};
struct EpiOddIn {
    bf16_t* O; int ldc; float* stats; const float* rcos; const float* rsin; float scale;
    __device__ __forceinline__ void operator()(const f32x4 (&acc)[2][2][4][2], const Unit& u, int wr, int wc, int fr, int fq) const {
        int upm = u.pm, upn = u.pn; asm volatile("" : "+s"(upm), "+s"(upn));
        const int row0 = upm * BM + wr * 64 + fr, col0 = upn * BM + wc * 32 + 8 * fq; const bool lat = upm < NLAT / BM;
#pragma unroll
        for (int ai = 0; ai < 2; ++ai)
#pragma unroll
            for (int m = 0; m < 4; ++m) { const int row = row0 + ai * HALF + m * 16; bf16_t* rowp = O + (size_t)row * ldc + col0; float ss = 0.f;
#pragma unroll
                for (int bj = 0; bj < 2; ++bj) { f32x4 v0 = acc[ai][bj][m][0] * scale, v1 = acc[ai][bj][m][1] * scale;
                    if (upn == 6 || (upn == 7 && bj == 0)) ss += (v0[0] * v0[0] + v0[1] * v0[1]) + (v0[2] * v0[2] + v0[3] * v0[3]) + (v1[0] * v1[0] + v1[1] * v1[1]) + (v1[2] * v1[2] + v1[3] * v1[3]);
                    if (upn == 7 && bj == 1 && wc == 0 && lat) { const int sp = row & (SEQ - 1); const f32x4 cs = *(const f32x4*)(rcos + sp * 16 + 4 * fq), sn = *(const f32x4*)(rsin + sp * 16 + 4 * fq);
                        const f32x4 o0 = v0 * cs - v1 * sn, o1 = v1 * cs + v0 * sn; v0 = o0; v1 = o1; }
                    u32x4 w; w.x = cvtpk(v0[0], v0[1]); w.y = cvtpk(v0[2], v0[3]); w.z = cvtpk(v1[0], v1[1]); w.w = cvtpk(v1[2], v1[3]);
                    *(u32x4*)(rowp + bj * HALF) = w; }
                if (upn >= 6) { ss += __shfl_xor(ss, 16); ss += __shfl_xor(ss, 32); if (fq == 0) stats[(size_t)row * 8 + (upn - 6) * 4 + wc] = ss; } }
    }
};
struct EpiMlaUp {
    bf16_t* O; int ldc; const float* stats;
    __device__ __forceinline__ void operator()(const f32x4 (&acc)[2][2][4][2], const Unit& u, int wr, int wc, int fr, int fq) const {
        const int row0 = u.pm * BM + wr * 64 + fr, col0 = u.pn * BM + wc * 32 + 8 * fq;
#pragma unroll
        for (int ai = 0; ai < 2; ++ai)
#pragma unroll
            for (int m = 0; m < 4; ++m) { const int row = row0 + ai * HALF + m * 16; bf16_t* rowp = O + (size_t)row * ldc + col0;
                const f32x4 pq = *(const f32x4*)(stats + (size_t)row * 8), pk = *(const f32x4*)(stats + (size_t)row * 8 + 4);
                const float rq = rsqrtf(((pq[0] + pq[1]) + (pq[2] + pq[3])) * (1.f / 256.f) + EPS), rk = rsqrtf(((pk[0] + pk[1]) + (pk[2] + pk[3])) * (1.f / 128.f) + EPS);
#pragma unroll
                for (int bj = 0; bj < 2; ++bj) { const int c0 = col0 + bj * HALF; const float sc = c0 < 384 ? rq : (c0 < 768 ? (((c0 - 384) % 96) < 64 ? rk : 1.f) : rk);
                    const f32x4 v0 = acc[ai][bj][m][0] * sc, v1 = acc[ai][bj][m][1] * sc;
                    u32x4 w; w.x = cvtpk(v0[0], v0[1]); w.y = cvtpk(v0[2], v0[3]); w.z = cvtpk(v1[0], v1[1]); w.w = cvtpk(v1[2], v1[3]);
                    *(u32x4*)(rowp + bj * HALF) = w; } }
    }
};
struct EpiSwiGLU8 {
    unsigned char* O; int ldc; float scale;
    __device__ __forceinline__ void operator()(const f32x4 (&acc)[2][2][4][2], const Unit& u, int wr, int wc, int fr, int fq) const {
        const int row0 = u.pm * BM + wr * 64 + fr, col0 = u.pn * HALF + wc * 32 + 8 * fq;
#pragma unroll
        for (int ai = 0; ai < 2; ++ai)
#pragma unroll
            for (int m = 0; m < 4; ++m) { unsigned char* rowp = O + (size_t)(row0 + ai * HALF + m * 16) * ldc + col0;
                float r[8];
#pragma unroll
                for (int n = 0; n < 2; ++n)
#pragma unroll
                    for (int j = 0; j < 4; ++j) r[n * 4 + j] = F8_ACT_SCALE * silu_f(acc[ai][0][m][n][j] * scale) * (acc[ai][1][m][n][j] * scale);
                u32x2 w; w.x = pk4_fp8(r[0], r[1], r[2], r[3]); w.y = pk4_fp8(r[4], r[5], r[6], r[7]);
                *(u32x2*)rowp = w; }
    }
};

template <class Epi, bool F8 = false>
__device__ __forceinline__ void gemm_phase(LAS unsigned char* lds, const Gemm& g, const Epi& E) {
    const int tid = opaque_tid(), wid = __builtin_amdgcn_readfirstlane(tid >> 6), lane = tid & 63, wr = wid >> 2, wc = wid & 3, fr = lane & 15, fq = lane >> 4;
    constexpr int ES = F8 ? 1 : 2;
    const int K = g.K, nt = K * ES / (BK * 2), lda = g.lda;
    StaticOrder S; S.init(g.nM, g.nN, (int)gridDim.x, opaque_bid());
    unsigned voffA[2], voffB[2];
#pragma unroll
    for (int i = 0; i < 2; ++i) { int R, C; stage_rc(tid * 16 + i * 8192, R, C); const int Rb = (R & ~31) + perm32(R & 31);
        voffA[i] = (unsigned)(R * lda * ES + C * 2); voffB[i] = (unsigned)(Rb * K * ES + C * 2); }
    const size_t kstep = (size_t)(BK * 2);
    const size_t hA = (size_t)HALF * lda * ES, tA = 2 * hA, hB = (size_t)HALF * K * ES, tB = 2 * hB;
    const unsigned ldsw = (unsigned)wid * 1024u;
    const int aoff = lds_byte(wr * 64 + fr, fq * 8), boff = lds_byte(wc * 32 + fr, fq * 8);
#define PG8_SA(b, h) (((b) * 2 + (h)) * HTB)
#define PG8_SB(b, h) ((4 + (b) * 2 + (h)) * HTB)
#define PG8_STAGE(bufoff, gbase, voff) do { _Pragma("unroll") for (int _i = 0; _i < 2; ++_i) \
        __builtin_amdgcn_global_load_lds((const unsigned*)((const char*)(gbase) + (voff)[_i]), (LAS unsigned*)(lds + (bufoff) + ldsw + _i * 8192), 16, 0, 0); } while (0)
#define PG8_LD8(base) __builtin_shufflevector(*(const LAS i32x4*)(base), *(const LAS i32x4*)((base) + 1024), 0, 1, 2, 3, 4, 5, 6, 7)
#define PG8_LDA(dst, b, h) do { _Pragma("unroll") for (int m = 0; m < 4; ++m) dst[m] = PG8_LD8(lds + PG8_SA(b, h) + aoff + m * 2048); } while (0)
#define PG8_LDB(dst, b, h) do { _Pragma("unroll") for (int n = 0; n < 2; ++n) dst[n] = PG8_LD8(lds + PG8_SB(b, h) + boff + n * 2048); } while (0)
#define PG8_H0(x) __builtin_bit_cast(bf16x8, __builtin_shufflevector(x, x, 0, 1, 2, 3))
#define PG8_H1(x) __builtin_bit_cast(bf16x8, __builtin_shufflevector(x, x, 4, 5, 6, 7))
#define PG8_MMA(ai, bj, At, Bt) do { __builtin_amdgcn_s_setprio(1); _Pragma("unroll") for (int m = 0; m < 4; ++m) _Pragma("unroll") for (int n = 0; n < 2; ++n) { \
        if constexpr (F8) asm volatile("v_mfma_f32_16x16x128_f8f6f4 %0, %1, %2, %0" : "+v"(acc[ai][bj][m][n]) : "v"(Bt[n]), "v"(At[m])); \
        else { acc[ai][bj][m][n] = __builtin_amdgcn_mfma_f32_16x16x32_bf16(PG8_H0(Bt[n]), PG8_H0(At[m]), acc[ai][bj][m][n], 0, 0, 0); \
               acc[ai][bj][m][n] = __builtin_amdgcn_mfma_f32_16x16x32_bf16(PG8_H1(Bt[n]), PG8_H1(At[m]), acc[ai][bj][m][n], 0, 0, 0); } } \
        __builtin_amdgcn_s_setprio(0); } while (0)
#define PG8_WAIT_V(n) asm volatile("s_waitcnt vmcnt(" #n ")" ::: "memory")
#define PG8_WAIT_L(n) asm volatile("s_waitcnt lgkmcnt(" #n ")" ::: "memory")
#define PG8_BAR __builtin_amdgcn_s_barrier()
#define PG8_SCHED __builtin_amdgcn_sched_barrier(0)
#define PG8_EXPERT(u) do { if (g.grouped) { int _e = 0; _Pragma("unroll") for (int _k = 1; _k < 8; ++_k) _e += ((u).pm >= g.toff[_k]) ? 1 : 0; (u).e = _e; } } while (0)
    Unit cur, nxt; int ui = 0;
    if (!S.next(0, cur)) return;
    PG8_EXPERT(cur);
    f32x4 acc[2][2][4][2];
#pragma unroll
    for (int a = 0; a < 2; ++a)
#pragma unroll
        for (int b = 0; b < 2; ++b)
#pragma unroll
            for (int m = 0; m < 4; ++m)
#pragma unroll
                for (int n = 0; n < 2; ++n) acc[a][b][m][n] = (f32x4){0.f, 0.f, 0.f, 0.f};
    i32x8 At[4], B0[2], B1[2];
    const char* cA = (const char*)g.A + (size_t)cur.pm * tA; const char* cB = ((const char*)g.Bt + (size_t)cur.e * g.estride * ES) + (size_t)cur.pn * tB;
    PG8_STAGE(PG8_SB(0, 0), cB, voffB); PG8_STAGE(PG8_SA(0, 0), cA, voffA); PG8_STAGE(PG8_SB(0, 1), cB + hB, voffB); PG8_STAGE(PG8_SA(0, 1), cA + hA, voffA);
    if (wr == 1) PG8_BAR;
    PG8_WAIT_V(4); PG8_BAR;
    PG8_STAGE(PG8_SB(1, 0), cB + kstep, voffB); PG8_STAGE(PG8_SA(1, 0), cA + kstep, voffA); PG8_STAGE(PG8_SB(1, 1), cB + hB + kstep, voffB);
    PG8_WAIT_V(6); PG8_BAR;
    for (;;) {
        const bool has_next = S.next(ui + 1, nxt);
        if (has_next) PG8_EXPERT(nxt);
        const char* nA = has_next ? (const char*)g.A + (size_t)nxt.pm * tA : cA; const char* nB = has_next ? ((const char*)g.Bt + (size_t)nxt.e * g.estride * ES) + (size_t)nxt.pn * tB : cB;
        for (int t = 0; t < nt; t += 2) {
            const bool last = (t == nt - 2);
            const char* a1 = cA + (size_t)(t + 1) * kstep;
            const char* a2 = last ? nA : cA + (size_t)(t + 2) * kstep; const char* b2 = last ? nB : cB + (size_t)(t + 2) * kstep;
            const char* a3 = a2 + kstep; const char* b3 = b2 + kstep;
            PG8_LDB(B0, 0, 0); PG8_SCHED; PG8_LDA(At, 0, 0); PG8_STAGE(PG8_SA(1, 1), a1 + hA, voffA);
            PG8_WAIT_L(8); PG8_BAR; PG8_WAIT_L(0); PG8_MMA(0, 0, At, B0); PG8_BAR; PG8_SCHED;
            PG8_LDB(B1, 0, 1); PG8_STAGE(PG8_SB(0, 0), b2, voffB);
            PG8_BAR; PG8_WAIT_L(0); PG8_MMA(0, 1, At, B1); PG8_BAR;
            PG8_LDA(At, 0, 1); PG8_STAGE(PG8_SA(0, 0), a2, voffA);
            PG8_BAR; PG8_WAIT_L(0); PG8_MMA(1, 0, At, B0); PG8_BAR; PG8_SCHED;
            PG8_STAGE(PG8_SB(0, 1), b2 + hB, voffB);
            PG8_WAIT_V(6); PG8_BAR; PG8_MMA(1, 1, At, B1); PG8_BAR;
            PG8_LDB(B0, 1, 0); PG8_SCHED; PG8_LDA(At, 1, 0); PG8_STAGE(PG8_SA(0, 1), a2 + hA, voffA);
            PG8_WAIT_L(8); PG8_BAR; PG8_WAIT_L(0); PG8_MMA(0, 0, At, B0); PG8_BAR; PG8_SCHED;
            PG8_LDB(B1, 1, 1); PG8_STAGE(PG8_SB(1, 0), b3, voffB);
            PG8_BAR; PG8_WAIT_L(0); PG8_MMA(0, 1, At, B1); PG8_BAR;
            PG8_LDA(At, 1, 1); PG8_STAGE(PG8_SA(1, 0), a3, voffA);
            PG8_BAR; PG8_WAIT_L(0); PG8_MMA(1, 0, At, B0); PG8_BAR; PG8_SCHED;
            PG8_STAGE(PG8_SB(1, 1), b3 + hB, voffB);
            PG8_WAIT_V(6); PG8_BAR; PG8_MMA(1, 1, At, B1); PG8_BAR;
        }
        if constexpr (F8) asm volatile("s_nop 15\n\ts_nop 15" ::: "memory");
        E(acc, cur, wr, wc, fr, fq);
        if (!has_next) break;
#pragma unroll
        for (int a = 0; a < 2; ++a)
#pragma unroll
            for (int b = 0; b < 2; ++b)
#pragma unroll
                for (int m = 0; m < 4; ++m)
#pragma unroll
                    for (int n = 0; n < 2; ++n) acc[a][b][m][n] = (f32x4){0.f, 0.f, 0.f, 0.f};
        cur = nxt; cA = nA; cB = nB; ++ui;
    }
    PG8_WAIT_V(0);
    if (wr == 0) PG8_BAR;
    PG8_BAR;
#undef PG8_SA
#undef PG8_SB
#undef PG8_STAGE
#undef PG8_LDA
#undef PG8_LDB
#undef PG8_MMA
#undef PG8_H0
#undef PG8_H1
#undef PG8_LD8
#undef PG8_WAIT_V
#undef PG8_WAIT_L
#undef PG8_BAR
#undef PG8_SCHED
#undef PG8_EXPERT
}
}

__device__ __forceinline__ void gemm_bf16(LAS unsigned char* lds, const pg8::Gemm& g, bf16_t* O, int ldc) { pg8::EpiBf16 E{O, ldc, 1.f}; pg8::gemm_phase(lds, g, E); }
__device__ __forceinline__ void gemm_even_in(LAS unsigned char* lds, const pg8::Gemm& g, const pg8::EpiEvenIn& E) { pg8::gemm_phase(lds, g, E); }
__device__ __forceinline__ void gemm8_even_in(LAS unsigned char* lds, const pg8::Gemm& g, const pg8::EpiEvenIn& E) { pg8::gemm_phase<pg8::EpiEvenIn, true>(lds, g, E); }
__device__ __forceinline__ void gemm8_odd_in(LAS unsigned char* lds, const pg8::Gemm& g, const pg8::EpiOddIn& E) { pg8::gemm_phase<pg8::EpiOddIn, true>(lds, g, E); }
__device__ __forceinline__ void gemm_odd_in(LAS unsigned char* lds, const pg8::Gemm& g, const pg8::EpiOddIn& E) { pg8::gemm_phase(lds, g, E); }
__device__ __forceinline__ void gemm_mla_up(LAS unsigned char* lds, const pg8::Gemm& g, const pg8::EpiMlaUp& E) { pg8::gemm_phase(lds, g, E); }
__device__ __forceinline__ void gemm8_bf16(LAS unsigned char* lds, const pg8::Gemm& g, bf16_t* O, int ldc) { pg8::EpiBf16 E{O, ldc, F8_INV}; pg8::gemm_phase<pg8::EpiBf16, true>(lds, g, E); }
__device__ __forceinline__ void gemm8_swiglu8(LAS unsigned char* lds, const pg8::Gemm& g, unsigned char* O, int ldc) { pg8::EpiSwiGLU8 E{O, ldc, F8_INV}; pg8::gemm_phase<pg8::EpiSwiGLU8, true>(lds, g, E); }
__device__ __forceinline__ void gemm_swiglu(LAS unsigned char* lds, const pg8::Gemm& g, bf16_t* O, int ldc) { pg8::EpiSwiGLU E{O, ldc}; pg8::gemm_phase(lds, g, E); }

namespace att {
#define SBAR() __builtin_amdgcn_sched_barrier(0)
__device__ __forceinline__ int crow(int r, int hi) { return (r & 3) + 8 * (r >> 2) + 4 * hi; }
__device__ __forceinline__ int v_st(int k, int c) { const int kk = (k & ~0xC) | ((k & 4) << 1) | ((k & 8) >> 1); return ((kk >> 3) * 4 + (c >> 5)) * 512 + ((kk & 7) * 32 + (c & 31)) * 2; }
__device__ __forceinline__ int v_st_plain(int k, int c) { return ((k >> 3) * 4 + (c >> 5)) * 512 + ((k & 7) * 32 + (c & 31)) * 2; }
__device__ __forceinline__ int v_rd_base(int lane) { return ((lane & 3) << 3) | (((lane >> 2) & 3) << 6) | (((lane >> 4) & 1) << 5) | (((lane >> 5) & 1) << 8); }
constexpr int v_rd_off(int d0, int ks, int half) { return d0 * 512 + ks * 4096 + half * 2048; }
template <int OFF> __device__ __forceinline__ s16x4 tr_read(unsigned vb) {
    s16x4 r; asm volatile("ds_read_b64_tr_b16 %0, %1 offset:%2" : "=&v"(r) : "v"(vb), "i"(OFF) : "memory"); return r;
}
template <int D0> __device__ __forceinline__ void pv_one(f32x16& od, unsigned vb, bf16x8 pa0, bf16x8 pa1, bf16x8 pa2, bf16x8 pa3) {
    const s16x4 l0 = tr_read<v_rd_off(D0, 0, 0)>(vb), h0 = tr_read<v_rd_off(D0, 0, 1)>(vb), l1 = tr_read<v_rd_off(D0, 1, 0)>(vb), h1 = tr_read<v_rd_off(D0, 1, 1)>(vb);
    const s16x4 l2 = tr_read<v_rd_off(D0, 2, 0)>(vb), h2 = tr_read<v_rd_off(D0, 2, 1)>(vb), l3 = tr_read<v_rd_off(D0, 3, 0)>(vb), h3 = tr_read<v_rd_off(D0, 3, 1)>(vb);
    asm volatile("s_waitcnt lgkmcnt(0)" ::: "memory"); SBAR();
#define PK(L, H) (bf16x8){L[0], L[1], L[2], L[3], H[0], H[1], H[2], H[3]}
    od = __builtin_amdgcn_mfma_f32_32x32x16_bf16(pa0, PK(l0, h0), od, 0, 0, 0);
    od = __builtin_amdgcn_mfma_f32_32x32x16_bf16(pa1, PK(l1, h1), od, 0, 0, 0);
    od = __builtin_amdgcn_mfma_f32_32x32x16_bf16(pa2, PK(l2, h2), od, 0, 0, 0);
    od = __builtin_amdgcn_mfma_f32_32x32x16_bf16(pa3, PK(l3, h3), od, 0, 0, 0);
#undef PK
}
template <int KS, int NO> __device__ __forceinline__ void pv_step(f32x16 (&o)[NO], unsigned vb, bf16x8 pa) {
    s16x4 l[NO], h[NO];
    l[0] = tr_read<v_rd_off(0, KS, 0)>(vb); h[0] = tr_read<v_rd_off(0, KS, 1)>(vb); l[1] = tr_read<v_rd_off(1, KS, 0)>(vb); h[1] = tr_read<v_rd_off(1, KS, 1)>(vb);
    if constexpr (NO == 4) { l[2] = tr_read<v_rd_off(2, KS, 0)>(vb); h[2] = tr_read<v_rd_off(2, KS, 1)>(vb); l[3] = tr_read<v_rd_off(3, KS, 0)>(vb); h[3] = tr_read<v_rd_off(3, KS, 1)>(vb); }
    asm volatile("s_waitcnt lgkmcnt(0)" ::: "memory"); SBAR();
#pragma unroll
    for (int d = 0; d < NO; ++d) o[d] = __builtin_amdgcn_mfma_f32_32x32x16_bf16(pa, (bf16x8){l[d][0], l[d][1], l[d][2], l[d][3], h[d][0], h[d][1], h[d][2], h[d][3]}, o[d], 0, 0, 0);
}
__device__ __forceinline__ void rot8(bf16x8& a, bf16x8& b, const float* cs, const float* sn) {
    const f32x4 c0 = *(const f32x4*)cs, c1 = *(const f32x4*)(cs + 4), s0 = *(const f32x4*)sn, s1 = *(const f32x4*)(sn + 4);
    float c[8] = {c0[0], c0[1], c0[2], c0[3], c1[0], c1[1], c1[2], c1[3]}, s[8] = {s0[0], s0[1], s0[2], s0[3], s1[0], s1[1], s1[2], s1[3]};
    float o1[8], o2[8];
#pragma unroll
    for (int e = 0; e < 8; ++e) { const float x1 = bf2f((unsigned short)a[e]), x2 = bf2f((unsigned short)b[e]); o1[e] = x1 * c[e] - x2 * s[e]; o2[e] = x2 * c[e] + x1 * s[e]; }
    u32x4 wa = {cvtpk(o1[0], o1[1]), cvtpk(o1[2], o1[3]), cvtpk(o1[4], o1[5]), cvtpk(o1[6], o1[7])};
    u32x4 wb = {cvtpk(o2[0], o2[1]), cvtpk(o2[2], o2[3]), cvtpk(o2[4], o2[5]), cvtpk(o2[6], o2[7])};
    a = *reinterpret_cast<bf16x8*>(&wa); b = *reinterpret_cast<bf16x8*>(&wb);
}

__device__ __forceinline__ void rot4(bf16x8& a, const float* cs, const float* sn) {
    const f32x4 c = *(const f32x4*)cs, s = *(const f32x4*)sn; float o[8];
#pragma unroll
    for (int e = 0; e < 4; ++e) { const float x1 = bf2f((unsigned short)a[e]), x2 = bf2f((unsigned short)a[4 + e]); o[e] = x1 * c[e] - x2 * s[e]; o[4 + e] = x2 * c[e] + x1 * s[e]; }
    u32x4 w = {cvtpk(o[0], o[1]), cvtpk(o[2], o[3]), cvtpk(o[4], o[5]), cvtpk(o[6], o[7])};
    a = *reinterpret_cast<bf16x8*>(&w);
}
struct Args {
    const bf16_t* Q; int ldq, qcol;
    const bf16_t* K; int ldk, kcol;
    const bf16_t* V; int ldv, vcol;
    int q_row0;
    int kctx_row0, klat_row0, nt_ctx, nt_lat;
    float C;
    int rope;
    const float* rcos; const float* rsin;
    bf16_t* O; int ldo, ocol;
    int g, u0; const float* rpb;
    float lam, oscale; const float* subg;
};

template <int DQK, int KW, int DV, int MODE>
__device__ __forceinline__ void attn_unit(LAS unsigned char* lds, const Args& a) {
    constexpr int ND = DQK / 16, NO = DV / 32;
    constexpr int KSTR = KW * 2 + 16, KBUF = 64 * KSTR;
    constexpr int OFF_V = 3 * KBUF, OFF_WS = OFF_V + 3 * 16384, OFF_RPB = OFF_WS + 2048;
    constexpr int KCH = KW / 8, NKCH = 64 * KCH, NKC = (NKCH + 511) / 512;
    constexpr int VCH = DV / 8, NVCH = 64 * VCH, NVC = (NVCH + 511) / 512;
    const int tid = opaque_tid(), wid = __builtin_amdgcn_readfirstlane(tid >> 6), lane = tid & 63, r32 = lane & 31, hi = lane >> 5;
    LAS unsigned char* Kl = lds; LAS unsigned char* Vl = lds + OFF_V;
    LAS float* wsf = (LAS float*)(lds + OFF_WS) + wid * 64; LAS float* li_l = wsf;
    LAS float* rpbl = (LAS float*)(lds + OFF_RPB);
    const int wq = (MODE == 1) ? (wid & 3) : wid, wmap = (MODE == 1) ? (wid >> 2) : 0;
    bf16x8 qr[ND];
    const int qrow = a.q_row0 + wq * 32 + r32;
    {
        const bf16_t* Qw = a.Q + (size_t)qrow * a.ldq + a.qcol + wmap * 64 + hi * 8;
#pragma unroll
        for (int d0 = 0; d0 < ND; ++d0) qr[d0] = *(const bf16x8*)(Qw + d0 * 16);
        if (a.rope == 2) { if constexpr (ND >= 6) { const int s = qrow & (SEQ - 1); rot4(qr[4], a.rcos + s * 16 + 4 * hi, a.rsin + s * 16 + 4 * hi); rot4(qr[5], a.rcos + s * 16 + 8 + 4 * hi, a.rsin + s * 16 + 8 + 4 * hi); } }
#pragma unroll
        for (int d0 = 0; d0 < ND; ++d0) { float f[8];
#pragma unroll
            for (int e = 0; e < 8; ++e) f[e] = bf2f((unsigned short)qr[d0][e]) * a.C;
            u32x4 w = {cvtpk(f[0], f[1]), cvtpk(f[2], f[3]), cvtpk(f[4], f[5]), cvtpk(f[6], f[7])}; qr[d0] = *reinterpret_cast<bf16x8*>(&w); }
    }
    if (MODE == 2) { if (tid < 465) rpbl[tid] = a.rpb[tid] * LOG2E; }
    const int cq = (wid & 1) * 32 + r32, rq = 4 * a.g + (wid >> 1);
    const int rs = min(max(rq - 4, 0), 120), cs_ = min(max(cq - 8, 0), 48);
    int kgo[NKC], klo[NKC], vgo[NVC], vlo[NVC];
#pragma unroll
    for (int i = 0; i < NKC; ++i) { if (i > 0 && KCH == 16) { kgo[i] = kgo[0] + 32 * i * a.ldk; klo[i] = klo[0] + 32 * i * KSTR; } else { const int c = tid + 512 * i, row = c / KCH, ch = c % KCH; kgo[i] = row * a.ldk + ch * 8; klo[i] = row * KSTR + ch * 16; } }
#pragma unroll
    for (int i = 0; i < NVC; ++i) { if (i > 0 && VCH == 16) { vgo[i] = vgo[0] + 32 * i * a.ldv; vlo[i] = vlo[0] + 8192 * i; } else { const int c = tid + 512 * i, row = c / VCH, ch = c % VCH; vgo[i] = row * a.ldv + ch * 8; vlo[i] = v_st_plain(row, ch * 8); } }
    u32x4 ksA[NKC], vsA[NVC];
    const int NT = a.nt_ctx + a.nt_lat;
#define TILE_ROW(j) ((j) < a.nt_ctx ? a.kctx_row0 + 64 * (j) : a.klat_row0 + 64 * ((j) - a.nt_ctx))
#define SLOAD(j) do { const int _r0 = TILE_ROW(j); const bf16_t* _kp = a.K + (size_t)_r0 * a.ldk + a.kcol; const bf16_t* _vp = a.V + (size_t)_r0 * a.ldv + a.vcol; \
    _Pragma("unroll") for (int _i = 0; _i < NKC; ++_i) if ((NKCH % 512 == 0) || tid + 512 * _i < NKCH) ksA[_i] = *(const u32x4*)(_kp + kgo[_i]); \
    _Pragma("unroll") for (int _i = 0; _i < NVC; ++_i) if ((NVCH % 512 == 0) || tid + 512 * _i < NVCH) vsA[_i] = *(const u32x4*)(_vp + vgo[_i]); } while (0)
#define SWRITE(b) do { \
    _Pragma("unroll") for (int _i = 0; _i < NKC; ++_i) if ((NKCH % 512 == 0) || tid + 512 * _i < NKCH) *(LAS u32x4*)(Kl + (b) * KBUF + klo[_i]) = ksA[_i]; \
    _Pragma("unroll") for (int _i = 0; _i < NVC; ++_i) if ((NVCH % 512 == 0) || tid + 512 * _i < NVCH) *(LAS u32x4*)(Vl + (b) * 16384 + vlo[_i]) = vsA[_i]; } while (0)
    float l_reg = 0.f;
    f32x16 o[NO];
#pragma unroll
    for (int d = 0; d < NO; ++d) o[d] = (f32x16){0.f, 0.f, 0.f, 0.f, 0.f, 0.f, 0.f, 0.f, 0.f, 0.f, 0.f, 0.f, 0.f, 0.f, 0.f, 0.f};
    const unsigned vb0 = (unsigned)(size_t)Vl + (unsigned)v_rd_base(lane);
#define QKT(P0, P1, b) do { const LAS unsigned char* _Kb = Kl + (b) * KBUF + wmap * 128; \
    _Pragma("unroll") for (int d0 = 0; d0 < ND; ++d0) { const int cb = (d0 * 16 + hi * 8) * 2; \
        const bf16x8 b0 = *(const LAS bf16x8*)(_Kb + r32 * KSTR + cb), b1 = *(const LAS bf16x8*)(_Kb + (32 + r32) * KSTR + cb); \
        if (d0 == 0) { const f32x16 z16 = {0.f, 0.f, 0.f, 0.f, 0.f, 0.f, 0.f, 0.f, 0.f, 0.f, 0.f, 0.f, 0.f, 0.f, 0.f, 0.f}; P0 = __builtin_amdgcn_mfma_f32_32x32x16_bf16(b0, qr[0], z16, 0, 0, 0); P1 = __builtin_amdgcn_mfma_f32_32x32x16_bf16(b1, qr[0], z16, 0, 0, 0); } \
        else { P0 = __builtin_amdgcn_mfma_f32_32x32x16_bf16(b0, qr[d0], P0, 0, 0, 0); P1 = __builtin_amdgcn_mfma_f32_32x32x16_bf16(b1, qr[d0], P1, 0, 0, 0); } } } while (0)
#define PARTIAL(P0, P1, j) do { \
    if (MODE == 2) { if ((j) >= a.nt_ctx) { const int kr = a.u0 + ((j) - a.nt_ctx); const bool rowok = (kr >= rs) && (kr < rs + 8); const int ro = min(max(kr - rq + 7, 0), 14); const LAS float* brow = rpbl + ro * 31; \
        _Pragma("unroll") for (int r = 0; r < 16; ++r) { \
            { const int ck = crow(r, hi), dd = min(max(ck - cq + 15, 0), 30); const bool inw = rowok && ((unsigned)(ck - cs_) < 16u); const float bv = brow[dd]; P0[r] = inw ? P0[r] + bv : -1e30f; } \
            { const int ck = 32 + crow(r, hi), dd = min(max(ck - cq + 15, 0), 30); const bool inw = rowok && ((unsigned)(ck - cs_) < 16u); const float bv = brow[dd]; P1[r] = inw ? P1[r] + bv : -1e30f; } } } } \
    _Pragma("unroll") for (int r = 0; r < 16; ++r) P0[r] = fast_exp2(P0[r]); } while (0)
#define PK4(P, BASE, OUT) do { u32x4 w = {cvtpk(P[BASE + 0], P[BASE + 1]), cvtpk(P[BASE + 2], P[BASE + 3]), cvtpk(P[BASE + 4], P[BASE + 5]), cvtpk(P[BASE + 6], P[BASE + 7])}; \
    OUT = *reinterpret_cast<bf16x8*>(&w); } while (0)
#define FINISH(P0, P1) do { \
    _Pragma("unroll") for (int r = 0; r < 16; ++r) P1[r] = fast_exp2(P1[r]); \
    float ps = 0.f; \
    _Pragma("unroll") for (int r = 0; r < 16; ++r) ps += P0[r]; \
    _Pragma("unroll") for (int r = 0; r < 16; ++r) ps += P1[r]; \
    l_reg += ps; \
    PK4(P0, 0, pa0); PK4(P0, 8, pa1); PK4(P1, 0, pa2); PK4(P1, 8, pa3); } while (0)
#define PV(b) do { const unsigned _vb = vb0 + (unsigned)(b) * 16384u; \
    pv_step<0, NO>(o, _vb, pa0); pv_step<1, NO>(o, _vb, pa1); pv_step<2, NO>(o, _vb, pa2); pv_step<3, NO>(o, _vb, pa3); } while (0)
    f32x16 pA0, pA1, pB0, pB1; bf16x8 pa0, pa1, pa2, pa3;
    SLOAD(0); SWRITE(0); SLOAD(1); __syncthreads();
    QKT(pA0, pA1, 0); PARTIAL(pA0, pA1, 0);
    SWRITE(1); if (2 < NT) SLOAD(2);
    __syncthreads();
    int bm1 = 0, bj = 1, bn = 2;
    for (int j = 1; j + 1 < NT; j += 2) {
        SBAR(); QKT(pB0, pB1, bj);
        FINISH(pA0, pA1); SBAR();
        PV(bm1); PARTIAL(pB0, pB1, j);
        SBAR(); SWRITE(bn); SLOAD(j + 2);
        __syncthreads();
        SBAR(); QKT(pA0, pA1, bn);
        FINISH(pB0, pB1); SBAR();
        PV(bj); PARTIAL(pA0, pA1, j + 1);
        SBAR(); SWRITE(bm1); if (j + 3 < NT) SLOAD(j + 3);
        __syncthreads();
        { const int t0 = bm1; bm1 = bn; bn = bj; bj = t0; }
    }
    SBAR(); QKT(pB0, pB1, bj);
    FINISH(pA0, pA1); SBAR();
    PV(bm1); PARTIAL(pB0, pB1, NT - 1);
    FINISH(pB0, pB1); SBAR();
    PV(bj);
    __syncthreads();
#undef TILE_ROW
#undef SLOAD
#undef SWRITE
#undef QKT
#undef PARTIAL
#undef PK4
#undef FINISH
#undef PV
    const int tid_e = opaque_tid(), lane_e = tid_e & 63, r32e = lane_e & 31, hie = lane_e >> 5;
    { auto rr = __builtin_amdgcn_permlane32_swap(__float_as_uint(l_reg), __float_as_uint(l_reg), false, false); l_reg = __uint_as_float(rr[0]) + __uint_as_float(rr[1]); }
    if (hie == 0) li_l[r32e] = fmaxf(l_reg, 1e-37f); LDS_WAIT();
    float rli[16];
#pragma unroll
    for (int r = 0; r < 16; ++r) rli[r] = fast_rcp(li_l[crow(r, hie)]);
    if (MODE != 1) {
        bf16_t* Ow = a.O + (size_t)(a.q_row0 + wid * 32) * a.ldo + a.ocol + r32e;
#pragma unroll
        for (int r = 0; r < 16; ++r) { const int orow = crow(r, hie);
#pragma unroll
            for (int d0 = 0; d0 < NO; ++d0) Ow[(size_t)orow * a.ldo + d0 * 32] = f2bf(o[d0][r] * rli[r]); }
    } else {
        LAS float* cb = (LAS float*)lds;
        if (wmap == 1) {
#pragma unroll
            for (int r = 0; r < 16; ++r) { const int row = wq * 32 + crow(r, hie);
#pragma unroll
                for (int d0 = 0; d0 < NO; ++d0) cb[row * 129 + d0 * 32 + r32e] = a.lam * o[d0][r] * rli[r]; }
        }
        __syncthreads();
        if (wmap == 0) {
#pragma unroll
            for (int r = 0; r < 16; ++r) { const int row = wq * 32 + crow(r, hie);
#pragma unroll
                for (int d0 = 0; d0 < NO; ++d0) { const int ix = row * 129 + d0 * 32 + r32e; cb[ix] = o[d0][r] * rli[r] - cb[ix]; } }
        }
        __syncthreads();
        const int row = tid_e >> 2, qd = tid_e & 3;
        float v[32]; float ss = 0.f;
#pragma unroll
        for (int i = 0; i < 32; ++i) { v[i] = cb[row * 129 + qd * 32 + i]; ss += v[i] * v[i]; }
        ss += __shfl_xor(ss, 1); ss += __shfl_xor(ss, 2);
        const float rstd = rsqrtf(ss * (1.f / 128.f) + EPS) * a.oscale;
        bf16_t* Ow = a.O + (size_t)(a.q_row0 + row) * a.ldo + a.ocol + qd * 32;
#pragma unroll
        for (int c = 0; c < 4; ++c) { float w[8];
#pragma unroll
            for (int e = 0; e < 8; ++e) w[e] = v[c * 8 + e] * rstd * a.subg[qd * 32 + c * 8 + e];
            u32x4 pk = {cvtpk(w[0], w[1]), cvtpk(w[2], w[3]), cvtpk(w[4], w[5]), cvtpk(w[6], w[7])};
            *(u32x4*)(Ow + c * 8) = pk; }
    }
    __syncthreads();
}

__device__ __forceinline__ void sgu_unit(LAS unsigned char* lds, const bf16_t* PB, const bf16_t* Wsb, const float* bs, const float* stats, const float* sgain, bf16_t* MIX, int rowbase, int g) {
    const int tid = opaque_tid(), wid = __builtin_amdgcn_readfirstlane(tid >> 6), lane = tid & 63, r32 = lane & 31, hi = lane >> 5;
    LAS unsigned char* Vl = lds;
#pragma unroll 2
    for (int i = 0; i < 4; ++i) { const int c = tid + 512 * i, row = c >> 4, ch = c & 15;
        const u32x4 x = *(const u32x4*)(PB + (size_t)(rowbase + row) * EV_IN + 512 + g * 128 + ch * 8);
        const f32x4* st = (const f32x4*)(stats + (size_t)(rowbase + row) * 16); const f32x4 a0 = st[0], a1 = st[1], a2 = st[2], a3 = st[3];
        const float s1 = ((a0[0] + a0[2]) + (a1[0] + a1[2])) + ((a2[0] + a2[2]) + (a3[0] + a3[2])), s2 = ((a0[1] + a0[3]) + (a1[1] + a1[3])) + ((a2[1] + a2[3]) + (a3[1] + a3[3]));
        const float mean = s1 * (1.f / 512.f), rstd = rsqrtf(fmaxf(s2 * (1.f / 512.f) - mean * mean, 0.f) + EPS);
        const f32x4 g0 = *(const f32x4*)(sgain + g * 128 + ch * 8), g1 = *(const f32x4*)(sgain + g * 128 + ch * 8 + 4);
        u32x4 y; y.x = cvtpk((bflo(x.x) - mean) * rstd * g0[0], (bfhi(x.x) - mean) * rstd * g0[1]); y.y = cvtpk((bflo(x.y) - mean) * rstd * g0[2], (bfhi(x.y) - mean) * rstd * g0[3]);
        y.z = cvtpk((bflo(x.z) - mean) * rstd * g1[0], (bfhi(x.z) - mean) * rstd * g1[1]); y.w = cvtpk((bflo(x.w) - mean) * rstd * g1[2], (bfhi(x.w) - mean) * rstd * g1[3]);
        *(LAS u32x4*)(Vl + (row >> 6) * 16384 + v_st(row & 63, ch * 8)) = y; }
    const int prow = (wid & 3) * 32, dh = wid >> 2;
    bf16x8 pa[2][4];
#pragma unroll
    for (int kt = 0; kt < 2; ++kt)
#pragma unroll
        for (int ks = 0; ks < 4; ++ks) pa[kt][ks] = *(const bf16x8*)(Wsb + (size_t)(g * 128 + prow + r32) * 128 + kt * 64 + ks * 16 + hi * 8);
    __syncthreads();
    f32x16 o[2];
    o[0] = (f32x16){0.f, 0.f, 0.f, 0.f, 0.f, 0.f, 0.f, 0.f, 0.f, 0.f, 0.f, 0.f, 0.f, 0.f, 0.f, 0.f}; o[1] = o[0];
    const unsigned vb0 = (unsigned)(size_t)Vl + (unsigned)v_rd_base(lane);
#pragma unroll
    for (int kt = 0; kt < 2; ++kt) { const unsigned vb = vb0 + kt * 16384u;
        if (dh == 0) { pv_one<0>(o[0], vb, pa[kt][0], pa[kt][1], pa[kt][2], pa[kt][3]); pv_one<1>(o[1], vb, pa[kt][0], pa[kt][1], pa[kt][2], pa[kt][3]); }
        else { pv_one<2>(o[0], vb, pa[kt][0], pa[kt][1], pa[kt][2], pa[kt][3]); pv_one<3>(o[1], vb, pa[kt][0], pa[kt][1], pa[kt][2], pa[kt][3]); } }
#pragma unroll
    for (int r = 0; r < 16; ++r) { const int p = prow + crow(r, hi); const float bias = bs[g * 128 + p];
#pragma unroll
        for (int dd = 0; dd < 2; ++dd) { const int d = (2 * dh + dd) * 32 + r32;
            const float u = bf2f(PB[(size_t)(rowbase + p) * EV_IN + g * 128 + d]);
            MIX[(size_t)(rowbase + p) * DM + g * 128 + d] = f2bf(u * (o[dd][r] + bias)); } }
    __syncthreads();
}
}

struct Params {
    const float* in[31];
    float* out;
    unsigned char* ws;
    int ph_lo, ph_hi;
};

struct Ctx {
    LAS unsigned char* lds;
    int tid, lane, wid, gw, NGW;
};
__device__ __forceinline__ Ctx make_ctx(LAS unsigned char* lds) { const int t = opaque_tid(), w = __builtin_amdgcn_readfirstlane(t >> 6); return Ctx{lds, t, t & 63, w, opaque_bid() * 8 + w, (int)gridDim.x * 8}; }
typedef const __attribute__((address_space(4))) Params KParams;
__device__ __forceinline__ KParams& kparams() { KParams* p = (KParams*)__builtin_amdgcn_kernarg_segment_ptr(); asm volatile("" : "+s"(p)); return *p; }

__device__ __forceinline__ bf16_t* xrow_ptr(KParams& P, int row) { return (bf16_t*)(P.ws + WS_U + U_XB) + (size_t)row * DM; }
__device__ __forceinline__ int mod_r(int row) { return row < NLAT ? (row >> 13) : 4; }
__device__ __forceinline__ f32x4 ld4(const float* p) { return *(const f32x4*)p; }
__device__ __forceinline__ f32x4 ldbf4(const bf16_t* p) { const u32x2 w = *(const u32x2*)p; return (f32x4){bflo(w.x), bfhi(w.x), bflo(w.y), bfhi(w.y)}; }
__device__ __forceinline__ void stbf4(bf16_t* p, f32x4 v) { u32x2 w; w.x = cvtpk(v[0], v[1]); w.y = cvtpk(v[2], v[3]); *(u32x2*)p = w; }
__device__ __forceinline__ float sumsq4(const f32x4 (&v)[4]) { float s = 0.f;
#pragma unroll
    for (int j = 0; j < 4; ++j) s += (v[j][0] * v[j][0] + v[j][1] * v[j][1]) + (v[j][2] * v[j][2] + v[j][3] * v[j][3]);
    return wave_sum(s); }
__device__ __forceinline__ void norm_mod(const f32x4 (&x)[4], f32x4 (&hv)[4], const float* gain, const float* shift, const float* scale, int lane) {
    const float rstd = rsqrtf(sumsq4(x) * (1.f / DM) + EPS);
#pragma unroll
    for (int j = 0; j < 4; ++j) { const int c = 4 * lane + 256 * j; const f32x4 g = ld4(gain + c), sh = ld4(shift + c), sc = ld4(scale + c);
        hv[j] = (x[j] * rstd) * g * (sc + 1.f) + sh; }
}
__device__ __forceinline__ void resid_add(f32x4 (&x)[4], const f32x4 (&y)[4], const float* gain, const float* gate, int lane) {
    const float rstd = rsqrtf(sumsq4(y) * (1.f / DM) + EPS);
#pragma unroll
    for (int j = 0; j < 4; ++j) { const int c = 4 * lane + 256 * j; const f32x4 g = ld4(gain + c), gt = ld4(gate + c);
        x[j] = x[j] + gt * ((y[j] * rstd) * g); }
}

__device__ __forceinline__ void wave_rows(const Ctx& c, int mtok, int& r0, int& r1) {
    const int bid = opaque_bid(); const int rpw = mtok / (int)gridDim.x, base = bid * rpw;
    r0 = base + (c.wid * rpw) / 8; r1 = base + ((c.wid + 1) * rpw) / 8;
    if (bid == (int)gridDim.x - 1 && c.wid == 7) r1 = mtok;
}
__device__ __forceinline__ void ld_gate(f32x4 (&G)[4], const float* gain, const float* gate, int lane) {
#pragma unroll
    for (int j = 0; j < 4; ++j) { const int cc = 4 * lane + 256 * j; G[j] = ld4(gain + cc) * ld4(gate + cc); } }
__device__ __forceinline__ void ld_mod(f32x4 (&A)[4], f32x4 (&B)[4], const float* gain, const float* shift, const float* scale, int lane) {
#pragma unroll
    for (int j = 0; j < 4; ++j) { const int cc = 4 * lane + 256 * j; A[j] = ld4(gain + cc) * (ld4(scale + cc) + 1.f); B[j] = ld4(shift + cc); } }
__device__ __forceinline__ void resid_add2(f32x4 (&x)[4], const f32x4 (&y)[4], const f32x4 (&G)[4]) {
    const float rstd = rsqrtf(sumsq4(y) * (1.f / DM) + EPS);
#pragma unroll
    for (int j = 0; j < 4; ++j) x[j] = x[j] + G[j] * (y[j] * rstd);
}
__device__ __forceinline__ void norm_mod2(const f32x4 (&x)[4], f32x4 (&hv)[4], const f32x4 (&A)[4], const f32x4 (&B)[4]) {
    const float rstd = rsqrtf(sumsq4(x) * (1.f / DM) + EPS);
#pragma unroll
    for (int j = 0; j < 4; ++j) hv[j] = (x[j] * rstd) * A[j] + B[j];
}

__device__ __forceinline__ int perm_row(int pmode, int n) {
    if (pmode == 1) { if (n >= 1024 && n < 2048) { const int d = n & 63, hb = n & ~63; return hb + ((d < 32) ? 8 * (d >> 2) + (d & 3) : 8 * ((d - 32) >> 2) + 4 + (d & 3)); } }
    else if (pmode == 2) { if (n >= 1920 && n < 1952) { const int d = n - 1920; return 1920 + ((d < 16) ? 8 * (d >> 2) + (d & 3) : 8 * ((d - 16) >> 2) + 4 + (d & 3)); } }
    return n;
}
__device__ __forceinline__ void tr_item(const float* W, int ldw, bf16_t* WT, int ldt, int k0, int n0, int drow, LAS float* scr, int lane, int pmode = 0) {
#pragma unroll 8
    for (int i = 0; i < 32; ++i) { const int kk = 2 * i + (lane >> 5); scr[kk * 33 + (lane & 31)] = W[(size_t)(k0 + kk) * ldw + n0 + (lane & 31)]; }
    LDS_WAIT(); asm volatile("" ::: "memory");
    const int c = lane & 7;
#pragma unroll
    for (int j = 0; j < 4; ++j) { const int n = (lane >> 3) + 8 * j; const LAS float* s = scr + (8 * c) * 33 + n;
        u32x4 o; o.x = cvtpk(s[0 * 33], s[1 * 33]); o.y = cvtpk(s[2 * 33], s[3 * 33]); o.z = cvtpk(s[4 * 33], s[5 * 33]); o.w = cvtpk(s[6 * 33], s[7 * 33]);
        const int dr = pmode ? perm_row(pmode, n0 + n) : drow + n;
        *(u32x4*)(WT + (size_t)dr * ldt + k0 + 8 * c) = o; }
    LDS_WAIT(); asm volatile("" ::: "memory");
}
__device__ __forceinline__ void tr_item8(const float* W, int ldw, unsigned char* WT, int ldt, int k0, int n0, int drow, LAS float* scr, int lane, int pmode = 0) {
#pragma unroll 8
    for (int i = 0; i < 32; ++i) { const int kk = 2 * i + (lane >> 5); scr[kk * 33 + (lane & 31)] = W[(size_t)(k0 + kk) * ldw + n0 + (lane & 31)] * F8_W_SCALE; }
    LDS_WAIT(); asm volatile("" ::: "memory");
    const int c = lane & 7;
#pragma unroll
    for (int j = 0; j < 4; ++j) { const int n = (lane >> 3) + 8 * j; const LAS float* s = scr + (8 * c) * 33 + n;
        u32x2 o; o.x = pk4_fp8(s[0 * 33], s[1 * 33], s[2 * 33], s[3 * 33]); o.y = pk4_fp8(s[4 * 33], s[5 * 33], s[6 * 33], s[7 * 33]);
        const int dr = pmode ? perm_row(pmode, n0 + n) : drow + n;
        *(u32x2*)(WT + (size_t)dr * ldt + k0 + 8 * c) = o; }
    LDS_WAIT(); asm volatile("" ::: "memory");
}
__device__ __forceinline__ void tr_matrix8(const Ctx& c, const float* W, int K, int N, unsigned char* WT, int mode, int row_off, int pmode = 0) {
    LAS float* scr = (LAS float*)(c.lds + c.wid * 16384);
    const int nblk = N / 32, nitems = (K / 64) * nblk;
    for (int it = c.gw; it < nitems; it += c.NGW) { const int kb = it / nblk, nb = it % nblk, n0 = 32 * nb;
        const int drow = (mode == 0) ? row_off + n0 : (n0 >> 7) * 256 + (n0 & 127) + (mode == 2 ? 128 : 0);
        tr_item8(W, N, WT, K, 64 * kb, n0, drow, scr, c.lane, pmode); }
}
__device__ __forceinline__ void tr_matrix(const Ctx& c, const float* W, int K, int N, bf16_t* WT, int mode, int row_off, int pmode = 0) {
    LAS float* scr = (LAS float*)(c.lds + c.wid * 16384);
    const int nblk = N / 32, nitems = (K / 64) * nblk;
    for (int it = c.gw; it < nitems; it += c.NGW) { const int kb = it / nblk, nb = it % nblk, n0 = 32 * nb;
        const int drow = (mode == 0) ? row_off + n0 : (n0 >> 7) * 256 + (n0 & 127) + (mode == 2 ? 128 : 0);
        tr_item(W, N, WT, K, 64 * kb, n0, drow, scr, c.lane, pmode); }
}
constexpr int MOE_CVT_ITEMS = 24 * 1792;
__device__ __forceinline__ void convert_moe_items(const Ctx& c, int i, int t0, int t1, int wsel, int nsel) {
    KParams& P = kparams();
    LAS float* scr = (LAS float*)(c.lds + c.wid * 16384);
    if (wsel < 0) return;
    for (int t = t0 + wsel; t < t1; t += nsel) {
        const int mat = t / 1792, r = t % 1792, e = mat / 3, which = mat % 3;
        if (which < 2) {
            const float* W = P.in[28 + which] + ((size_t)i * NEXP + e) * DM * DFFE; const int kb = r / 112, n0 = 32 * (r % 112);
            const int drow = (n0 >> 7) * 256 + (n0 & 127) + which * 128;
#if MOE_F8
            tr_item8(W, DFFE, (unsigned char*)(P.ws + WS_W13M) + (size_t)e * 2 * DFFE * DM, DM, 64 * kb, n0, drow, scr, c.lane);
#else
            tr_item(W, DFFE, (bf16_t*)(P.ws + WS_W13M) + (size_t)e * 2 * DFFE * DM, DM, 64 * kb, n0, drow, scr, c.lane);
#endif
        } else {
            const float* W = P.in[30] + ((size_t)i * NEXP + e) * DFFE * DM; const int kb = r / 32, n0 = 32 * (r % 32);
#if MOE_F8
            tr_item8(W, DM, (unsigned char*)(P.ws + WS_W2M) + (size_t)e * DM * DFFE, DFFE, 64 * kb, n0, n0, scr, c.lane);
#else
            tr_item(W, DM, (bf16_t*)(P.ws + WS_W2M) + (size_t)e * DM * DFFE, DFFE, 64 * kb, n0, n0, scr, c.lane);
#endif
        }
    }
}
__device__ __forceinline__ void prologue0(const Ctx& c_) {
    const Ctx c = make_ctx(c_.lds);
    KParams& P = kparams(); unsigned char* ws = P.ws;
    if (blockIdx.x < 96) {
        LAS float* sl = (LAS float*)c.lds;
        LAS float* part = (LAS float*)(c.lds + 32768);
        for (int i = c.tid; i < 5 * DM; i += 512) { const int r = i >> 10, k = i & 1023; const float x = r < 4 ? P.in[1][r * DM + k] : P.in[3][k]; sl[i] = x / (1.f + expf(-x)); }
        __syncthreads();
        const int t = blockIdx.x, lm = t / 24, cbk = t % 24, n = cbk * 256 + 4 * c.lane;
        const float* W = P.in[4] + (size_t)lm * DM * (NMOD * DM) + n;
        f32x4 acc[5];
#pragma unroll
        for (int r = 0; r < 5; ++r) acc[r] = (f32x4){0.f, 0.f, 0.f, 0.f};
        const int kb = c.wid * 128;
        for (int k0 = 0; k0 < 128; k0 += 8) {
            f32x4 wv[8];
#pragma unroll
            for (int u = 0; u < 8; ++u) wv[u] = ld4(W + (size_t)(kb + k0 + u) * (NMOD * DM));
#pragma unroll
            for (int u = 0; u < 8; ++u)
#pragma unroll
                for (int r = 0; r < 5; ++r) acc[r] += wv[u] * sl[r * DM + kb + k0 + u];
        }
#pragma unroll
        for (int r = 0; r < 5; ++r) *(LAS f32x4*)(part + (c.wid * 5 + r) * 256 + 4 * c.lane) = acc[r];
        __syncthreads();
        for (int i = c.tid; i < 5 * 256; i += 512) { const int r = i >> 8, cc = i & 255; float s = 0.f;
#pragma unroll
            for (int w = 0; w < 8; ++w) s += part[(w * 5 + r) * 256 + cc];
            ((float*)(ws + WS_MODS))[(size_t)(lm * 5 + r) * (NMOD * DM) + cbk * 256 + cc] = s + P.in[5][lm * (NMOD * DM) + cbk * 256 + cc]; }
        __syncthreads();
    }
    for (int i = 0; i < 2; ++i) {
        if (WIN8(2 * i)) tr_matrix8(c, P.in[7] + (size_t)i * DM * EV_IN, DM, EV_IN, (unsigned char*)(ws + WS_WINE) + (size_t)i * EV_IN * DM * 2, 0, 0, 1);
        else tr_matrix(c, P.in[7] + (size_t)i * DM * EV_IN, DM, EV_IN, (bf16_t*)(ws + WS_WINE) + (size_t)i * EV_IN * DM, 0, 0, 1);
        tr_matrix(c, P.in[8] + (size_t)i * DM * DM, DM, DM, (bf16_t*)(ws + WS_WOUTE) + (size_t)i * DM * DM, 0, 0);
        if (FFN8(i)) {
            tr_matrix8(c, P.in[17] + (size_t)i * DM * DFF, DM, DFF, (unsigned char*)(ws + WS_W13E) + (size_t)i * 2 * DFF * DM * 2, 1, 0);
            tr_matrix8(c, P.in[18] + (size_t)i * DM * DFF, DM, DFF, (unsigned char*)(ws + WS_W13E) + (size_t)i * 2 * DFF * DM * 2, 2, 0);
            tr_matrix8(c, P.in[19] + (size_t)i * DFF * DM, DFF, DM, (unsigned char*)(ws + WS_W2E) + (size_t)i * DM * DFF * 2, 0, 0);
        } else {
            tr_matrix(c, P.in[17] + (size_t)i * DM * DFF, DM, DFF, (bf16_t*)(ws + WS_W13E) + (size_t)i * 2 * DFF * DM, 1, 0);
            tr_matrix(c, P.in[18] + (size_t)i * DM * DFF, DM, DFF, (bf16_t*)(ws + WS_W13E) + (size_t)i * 2 * DFF * DM, 2, 0);
            tr_matrix(c, P.in[19] + (size_t)i * DFF * DM, DFF, DM, (bf16_t*)(ws + WS_W2E) + (size_t)i * DM * DFF, 0, 0);
        }
        if (WIN8(2 * i + 1)) tr_matrix8(c, P.in[20] + (size_t)i * DM * OD_IN, DM, OD_IN, (unsigned char*)(ws + WS_WINO) + (size_t)i * OD_INP * DM * 2, 0, 0, 2);
        else tr_matrix(c, P.in[20] + (size_t)i * DM * OD_IN, DM, OD_IN, (bf16_t*)(ws + WS_WINO) + (size_t)i * OD_INP * DM, 0, 0, 2);
        tr_matrix(c, P.in[21] + (size_t)i * DM * DM, DM, DM, (bf16_t*)(ws + WS_WOUTO) + (size_t)i * DM * DM, 0, 0);
    }
    const int gt = blockIdx.x * 512 + c.tid, NGT = gridDim.x * 512;
    for (int i = gt; i < 2 * (OD_INP - OD_IN) * DM; i += NGT) { const int l = i / ((OD_INP - OD_IN) * DM), r = i % ((OD_INP - OD_IN) * DM);
        if (WIN8(2 * l + 1)) ((unsigned char*)(ws + WS_WINO))[(size_t)l * OD_INP * DM * 2 + (size_t)OD_IN * DM + r] = 0;
        else ((bf16_t*)(ws + WS_WINO))[(size_t)l * OD_INP * DM + (size_t)OD_IN * DM + r] = 0; }
    for (int i = gt; i < 2 * MLA_N * MLA_K; i += NGT) { const int l = i / (MLA_N * MLA_K), n = (i / MLA_K) % MLA_N, k = i % MLA_K; float v = 0.f;
        if (n < 384) { if (k < 256) { const int h = n / 96, j = n % 96; int sc = n;
                if (j >= 64) { const int p = j - 64, t = p >> 3, e = p & 7; sc = h * 96 + 64 + ((e < 4) ? 4 * t + e : 16 + 4 * t + (e - 4)); }
                v = P.in[24][((size_t)l * 256 + k) * 384 + sc] * P.in[23][l * 256 + k]; } }
        else if (n < 768) { const int h = (n - 384) / 96, j = (n - 384) % 96;
            if (j < 64) { if (k >= 256 && k < 384) v = P.in[26][((size_t)l * 128 + (k - 256)) * 768 + h * 192 + j] * P.in[25][l * 128 + (k - 256)]; }
            else { if (k == 384 + (j - 64)) v = 1.f; } }
        else { const int h = (n - 768) / 128, j = (n - 768) % 128; if (k >= 256 && k < 384) v = P.in[26][((size_t)l * 128 + (k - 256)) * 768 + h * 192 + 64 + j] * P.in[25][l * 128 + (k - 256)]; }
        ((bf16_t*)(ws + WS_WMLA))[i] = f2bf(v); }
    for (int i = gt; i < 2 * 4 * 128 * 128; i += NGT) ((bf16_t*)(ws + WS_SGUW))[i] = f2bf(P.in[9][i]);
    for (int i = gt; i < SEQ * 32; i += NGT) { const int s = i >> 5, f = i & 31; const int pos = f < 16 ? (s >> 6) : (s & 63);
        const float inv = 1.0f / powf(10000.0f, (float)(f & 15) / 16.0f); const float ang = (float)pos * inv;
        ((float*)(ws + WS_ROPEB))[i] = (float)cos((double)ang); ((float*)(ws + WS_ROPEB))[SEQ * 32 + i] = (float)sin((double)ang); }
    for (int i = gt; i < SEQ * 16; i += NGT) { const int s = i >> 4, f = i & 15; const int pos = f < 8 ? (s >> 6) : (s & 63);
        const float inv = 1.0f / powf(10000.0f, (float)(f & 7) / 8.0f); const float ang = (float)pos * inv;
        ((float*)(ws + WS_ROPED))[i] = (float)cos((double)ang); ((float*)(ws + WS_ROPED))[SEQ * 16 + i] = (float)sin((double)ang); }
}

__device__ __forceinline__ void convert_moe_tail(const Ctx& c_, int i, int t0, int t1, int nunits) {
    const Ctx c = make_ctx(c_.lds);
    const int G = (int)gridDim.x, rem = nunits % G, bid = opaque_bid();
    const int first = rem;
    convert_moe_items(c, i, t0, t1, bid >= first ? (bid - first) * 8 + c.wid : -1, (G - first) * 8);
}

__device__ __forceinline__ void ew_first(const Ctx& c_) {
    const Ctx c = make_ctx(c_.lds);
    KParams& P = kparams(); const float* mods = (const float*)(P.ws + WS_MODS); bf16_t* HB = (bf16_t*)(P.ws + WS_HB);
    int r0, r1; wave_rows(c, MTOT, r0, r1);
    f32x4 A0[4], B0[4]; int rcur = -1;
    for (int row = r0; row < r1; ++row) {
        const float* src = row < NLAT ? P.in[0] + (size_t)row * DM : P.in[2] + (size_t)(row - NLAT) * DM;
        bf16_t* xr = xrow_ptr(P, row); const int r = mod_r(row);
        if (r != rcur) { rcur = r; const float* mb = mods + (size_t)(0 * 5 + r) * (NMOD * DM); ld_mod(A0, B0, P.in[6] + (0 * 4 + 0) * DM, mb + 0 * DM, mb + 1 * DM, c.lane); }
        f32x4 x[4], h[4];
#pragma unroll
        for (int j = 0; j < 4; ++j) { x[j] = ld4(src + 4 * c.lane + 256 * j); stbf4(xr + 4 * c.lane + 256 * j, x[j]); }
        norm_mod2(x, h, A0, B0);
#pragma unroll
        for (int j = 0; j < 4; ++j) stbf4(HB + (size_t)row * DM + 4 * c.lane + 256 * j, h[j]);
    }
}

__device__ __forceinline__ void ew_even_mix(const Ctx& c_, int i) {
    const Ctx c = make_ctx(c_.lds);
    KParams& P = kparams(); bf16_t* PB = (bf16_t*)(P.ws + WS_U + U_PB);
    const float* sg = P.in[11] + i * 512; const float* rc = (const float*)(P.ws + WS_ROPEB); const float* rsn = rc + SEQ * 32;
    for (int row = c.gw; row < MTOT; row += c.NGW) {
        bf16_t* pr = PB + (size_t)row * EV_IN;
        {
            const u32x4 w = *(const u32x4*)(pr + 8 * c.lane); float f[8] = {bflo(w.x), bfhi(w.x), bflo(w.y), bfhi(w.y), bflo(w.z), bfhi(w.z), bflo(w.w), bfhi(w.w)};
#pragma unroll
            for (int e = 0; e < 8; ++e) f[e] = gelu_tanh_f(f[e]);
            u32x4 o = {cvtpk(f[0], f[1]), cvtpk(f[2], f[3]), cvtpk(f[4], f[5]), cvtpk(f[6], f[7])}; *(u32x4*)(pr + 8 * c.lane) = o;
        }
        {
            const u32x4 w = *(const u32x4*)(pr + 512 + 8 * c.lane); float f[8] = {bflo(w.x), bfhi(w.x), bflo(w.y), bfhi(w.y), bflo(w.z), bfhi(w.z), bflo(w.w), bfhi(w.w)};
            float s = 0.f;
#pragma unroll
            for (int e = 0; e < 8; ++e) { f[e] = gelu_tanh_f(f[e]); s += f[e]; }
            const float mean = wave_sum(s) * (1.f / 512.f); float q = 0.f;
#pragma unroll
            for (int e = 0; e < 8; ++e) { f[e] -= mean; q += f[e] * f[e]; }
            const float rstd = rsqrtf(wave_sum(q) * (1.f / 512.f) + EPS);
            const f32x4 g0 = ld4(sg + 8 * c.lane), g1 = ld4(sg + 8 * c.lane + 4);
            float gg[8] = {g0[0], g0[1], g0[2], g0[3], g1[0], g1[1], g1[2], g1[3]};
#pragma unroll
            for (int e = 0; e < 8; ++e) f[e] = f[e] * rstd * gg[e];
            u32x4 o = {cvtpk(f[0], f[1]), cvtpk(f[2], f[3]), cvtpk(f[4], f[5]), cvtpk(f[6], f[7])}; *(u32x4*)(pr + 512 + 8 * c.lane) = o;
        }
        if (row < NLAT) {
            const int s = row & (SEQ - 1), hj = c.lane >> 3, sub = c.lane & 7;
            bf16_t* kp = pr + 1536 + hj * 64 + 4 * sub;
            const f32x4 x1 = ldbf4(kp), x2 = ldbf4(kp + 32), cs = ld4(rc + s * 32 + 4 * sub), sn = ld4(rsn + s * 32 + 4 * sub);
            stbf4(kp, x1 * cs - x2 * sn); stbf4(kp + 32, x2 * cs + x1 * sn);
        }
    }
}

__device__ __forceinline__ void ew_odd_mla(const Ctx& c_, int i) {
    const Ctx c = make_ctx(c_.lds);
    KParams& P = kparams(); const bf16_t* PB = (const bf16_t*)(P.ws + WS_U + U_PB); bf16_t* A2 = (bf16_t*)(P.ws + WS_U + U_A2);
    const float* gq = P.in[23] + i * 256; const float* gkv = P.in[25] + i * 128; const float* rc = (const float*)(P.ws + WS_ROPED); const float* rsn = rc + SEQ * 16;
    for (int row = c.gw; row < MTOT; row += c.NGW) {
        const bf16_t* pr = PB + (size_t)row * OD_INP; bf16_t* ar = A2 + (size_t)row * MLA_K;
        f32x4 q = ldbf4(pr + 1536 + 4 * c.lane);
        const float rq = rsqrtf(wave_sum(q[0] * q[0] + q[1] * q[1] + q[2] * q[2] + q[3] * q[3]) * (1.f / 256.f) + EPS);
        stbf4(ar + 4 * c.lane, q * rq * ld4(gq + 4 * c.lane));
        const unsigned kw = *(const unsigned*)(pr + 1792 + 2 * c.lane); const float k0 = bflo(kw), k1 = bfhi(kw);
        const float rk = rsqrtf(wave_sum(k0 * k0 + k1 * k1) * (1.f / 128.f) + EPS);
        *(unsigned*)(ar + 256 + 2 * c.lane) = cvtpk(k0 * rk * gkv[2 * c.lane], k1 * rk * gkv[2 * c.lane + 1]);
        if (c.lane < 16) { float x1 = bf2f(pr[1920 + c.lane]), x2 = bf2f(pr[1920 + 16 + c.lane]);
            if (row < NLAT) { const int s = row & (SEQ - 1); const float cs = rc[s * 16 + c.lane], sn = rsn[s * 16 + c.lane]; const float o1 = x1 * cs - x2 * sn, o2 = x2 * cs + x1 * sn; x1 = o1; x2 = o2; }
            ar[384 + c.lane] = f2bf(x1); ar[384 + 16 + c.lane] = f2bf(x2); }
        else { *(unsigned*)(ar + 416 + 2 * (c.lane - 16)) = 0u; }
    }
}

__device__ __forceinline__ void ew_mid(const Ctx& c_, int l, int mtok, bool dry = false) {
    const Ctx c = make_ctx(c_.lds);
    KParams& P = kparams(); const float* mods = (const float*)(P.ws + WS_MODS); bf16_t* HB = (bf16_t*)(P.ws + WS_HB);
    const bf16_t* YB = (const bf16_t*)(P.ws + WS_U + U_YB);
    const bool odd = (l & 1) != 0; const int li = l >> 1;
    LAS float* wrl = (LAS float*)c.lds;
    if (odd) { for (int i = c.tid; i < DM * NEXP; i += 512) { const int col = i >> 3, e = i & 7; wrl[e * DM + col] = P.in[27][(size_t)li * DM * NEXP + i]; } __syncthreads(); }
    unsigned long long cw = 0ull; int st_e1 = 0, st_e2 = 0, st_l1 = 0, st_l2 = 0; float st_g1 = 0.f; int nrow = 0;
    int r0, r1; wave_rows(c, mtok, r0, r1);
    f32x4 G1[4], A2[4], B2[4]; int rcur = -1;
    u32x2 xa[4], ya[4], xb[4], yb[4];
#define EWM_LOAD(X, Y, rw) do { const int _row = (rw); const bf16_t* _xr = xrow_ptr(P, _row); \
        _Pragma("unroll") for (int j = 0; j < 4; ++j) { X[j] = *(const u32x2*)(_xr + 4 * c.lane + 256 * j); Y[j] = *(const u32x2*)(YB + (size_t)_row * DM + 4 * c.lane + 256 * j); } } while (0)
    if (r0 < r1) EWM_LOAD(xa, ya, r0);
    if (r0 + 1 < r1) EWM_LOAD(xb, yb, r0 + 1);
    for (int row = r0; row < r1; ++row, ++nrow) {
        bf16_t* xr = xrow_ptr(P, row); const int r = mod_r(row);
        if (r != rcur) { rcur = r; const float* mb = mods + (size_t)(l * 5 + r) * (NMOD * DM);
            ld_gate(G1, P.in[6] + (l * 4 + 1) * DM, mb + 2 * DM, c.lane); ld_mod(A2, B2, P.in[6] + (l * 4 + 2) * DM, mb + 3 * DM, mb + 4 * DM, c.lane); }
        f32x4 x[4], y[4], h[4];
#pragma unroll
        for (int j = 0; j < 4; ++j) { x[j] = (f32x4){bflo(xa[j].x), bfhi(xa[j].x), bflo(xa[j].y), bfhi(xa[j].y)}; y[j] = (f32x4){bflo(ya[j].x), bfhi(ya[j].x), bflo(ya[j].y), bfhi(ya[j].y)}; xa[j] = xb[j]; ya[j] = yb[j]; }
        if (row + 2 < r1) EWM_LOAD(xb, yb, row + 2);
        resid_add2(x, y, G1);
        bf16_t* xw = dry ? (bf16_t*)(P.ws + WS_U + U_YS) + (size_t)row * DM : xr; bf16_t* hw = (dry ? (bf16_t*)(P.ws + WS_U + U_PB) : HB) + (size_t)row * DM;
#pragma unroll
        for (int j = 0; j < 4; ++j) stbf4(xw + 4 * c.lane + 256 * j, x[j]);
        norm_mod2(x, h, A2, B2);
        if ((odd && MOE_F8) || (!odd && FFN8(li))) {
            unsigned char* h8 = (unsigned char*)(dry ? (bf16_t*)(P.ws + WS_U + U_PB) : HB) + (size_t)row * DM;
#pragma unroll
            for (int j = 0; j < 4; ++j) *(unsigned*)(h8 + 4 * c.lane + 256 * j) = pk4_fp8(h[j][0] * F8_ACT_SCALE, h[j][1] * F8_ACT_SCALE, h[j][2] * F8_ACT_SCALE, h[j][3] * F8_ACT_SCALE);
        } else {
#pragma unroll
            for (int j = 0; j < 4; ++j) stbf4(hw + 4 * c.lane + 256 * j, h[j]);
        }
        if (odd && !dry) {
            float lg[8];
#pragma unroll
            for (int e = 0; e < 8; ++e) { float sacc = 0.f;
#pragma unroll
                for (int j = 0; j < 4; ++j) { const f32x4 w = *(const LAS f32x4*)(wrl + e * DM + 4 * c.lane + 256 * j); sacc += (h[j][0] * w[0] + h[j][1] * w[1]) + (h[j][2] * w[2] + h[j][3] * w[3]); }
                lg[e] = wave_sum(sacc); }
            int e1 = 0; float v1 = lg[0];
#pragma unroll
            for (int e = 1; e < 8; ++e) if (lg[e] > v1) { v1 = lg[e]; e1 = e; }
            int e2 = -1; float v2 = -3.0e38f;
#pragma unroll
            for (int e = 0; e < 8; ++e) if (e != e1 && lg[e] > v2) { v2 = lg[e]; e2 = e; }
            if (e2 < 0) e2 = (e1 + 1) & 7;
            const float g1 = 1.f / (1.f + expf(v2 - v1));
            const int l1 = (int)((cw >> (8 * e1)) & 0xffull); cw += 1ull << (8 * e1);
            const int l2 = (int)((cw >> (8 * e2)) & 0xffull); cw += 1ull << (8 * e2);
            if (c.lane == nrow) { st_e1 = e1; st_e2 = e2; st_l1 = l1; st_l2 = l2; st_g1 = g1; }
        }
    }
    if (odd && !dry) {
        unsigned* cnt = (unsigned*)(P.ws + WS_CTL) + CW_MOECNT + li * 64;
        int base = 0;
        if (c.lane < 8) { const unsigned wc = (unsigned)((cw >> (8 * c.lane)) & 0xffull); base = wc ? (int)atomicAdd(cnt + c.lane, wc) : 0; }
        const int b1 = __shfl(base, st_e1), b2 = __shfl(base, st_e2);
        if (c.lane < nrow) { const int row = r0 + c.lane; int4* ti = (int4*)(P.ws + WS_TOKINFO) + (size_t)row * 2;
            ti[0] = make_int4(st_e1, b1 + st_l1, st_e2, b2 + st_l2); ti[1] = make_int4(__float_as_int(st_g1), __float_as_int(1.f - st_g1), 0, 0); }
        __syncthreads();
    }
#undef EWM_LOAD
}

__device__ __forceinline__ void moe_offsets(KParams& P, int li, int (&toff)[9]) {
    const unsigned* cnt = (const unsigned*)(P.ws + WS_CTL) + CW_MOECNT + li * 64; int acc = 0;
#pragma unroll
    for (int e = 0; e < 8; ++e) { toff[e] = acc; const unsigned n = __builtin_amdgcn_readfirstlane(__hip_atomic_load(cnt + e, __ATOMIC_RELAXED, __HIP_MEMORY_SCOPE_AGENT)); acc += (int)((n + 255u) >> 8); }
    toff[8] = acc;
}
__device__ __forceinline__ void moe_gather(const Ctx& c_, int li, int mtok) {
    const Ctx c = make_ctx(c_.lds);
    KParams& P = kparams(); int toff[9]; moe_offsets(P, li, toff);
    int tv = 0;
#pragma unroll
    for (int e = 0; e < 8; ++e) tv = (c.lane == e) ? toff[e] : tv;
    const bf16_t* HB = (const bf16_t*)(P.ws + WS_HB); bf16_t* HS = (bf16_t*)(P.ws + WS_U + U_YS);
    int r0, r1; wave_rows(c, mtok, r0, r1);
    for (int row = r0; row < r1; ++row) {
        const int4* ti = (const int4*)(P.ws + WS_TOKINFO) + (size_t)row * 2; const int4 a = ti[0], b = ti[1];
        const int pA = __shfl(tv, a.x) * 256 + a.y, pB = __shfl(tv, a.z) * 256 + a.w;
        if (c.lane == 0) ((int4*)(P.ws + WS_TOKPOS))[row] = make_int4(pA, pB, b.x, b.y);
#if MOE_F8
        const u32x4 v0 = ((const u32x4*)((const unsigned char*)HB + (size_t)row * DM))[c.lane];
        ((u32x4*)((unsigned char*)HS + (size_t)pA * DM))[c.lane] = v0; ((u32x4*)((unsigned char*)HS + (size_t)pB * DM))[c.lane] = v0;
#else
        const u32x4* src = (const u32x4*)(HB + (size_t)row * DM); const u32x4 v0 = src[c.lane], v1 = src[64 + c.lane];
        u32x4* dA = (u32x4*)(HS + (size_t)pA * DM); u32x4* dB = (u32x4*)(HS + (size_t)pB * DM);
        dA[c.lane] = v0; dA[64 + c.lane] = v1; dB[c.lane] = v0; dB[64 + c.lane] = v1;
#endif
    }
}

__device__ __forceinline__ void ew_last(const Ctx& c_, int l, int mtok, bool dry = false) {
    const Ctx c = make_ctx(c_.lds);
    KParams& P = kparams(); const float* mods = (const float*)(P.ws + WS_MODS); bf16_t* HB = (bf16_t*)(P.ws + WS_HB);
    const bf16_t* YS = (const bf16_t*)(P.ws + WS_U + U_YS); const bool odd = (l & 1) != 0;
    int r0, r1; wave_rows(c, mtok, r0, r1);
    f32x4 G3[4], A0[4], B0[4]; int rcur = -1;
    u32x2 xa[4], ya[4], za[4], xb[4], yb[4], zb[4]; float gAa = 0.f, gBa = 0.f, gAb = 0.f, gBb = 0.f;
#define EWL_LOAD(X, Y, Z, GA, GB, rw) do { const int _row = (rw); const bf16_t* _xr = xrow_ptr(P, _row); \
        if (odd) { const int4 tp = ((const int4*)(P.ws + WS_TOKPOS))[_row]; GA = __int_as_float(tp.z); GB = __int_as_float(tp.w); \
            _Pragma("unroll") for (int j = 0; j < 4; ++j) { Y[j] = *(const u32x2*)(YS + (size_t)tp.x * DM + 4 * c.lane + 256 * j); Z[j] = *(const u32x2*)(YS + (size_t)tp.y * DM + 4 * c.lane + 256 * j); } } \
        else { _Pragma("unroll") for (int j = 0; j < 4; ++j) Y[j] = *(const u32x2*)(YS + (size_t)_row * DM + 4 * c.lane + 256 * j); } \
        _Pragma("unroll") for (int j = 0; j < 4; ++j) X[j] = *(const u32x2*)(_xr + 4 * c.lane + 256 * j); } while (0)
    if (r0 < r1) EWL_LOAD(xa, ya, za, gAa, gBa, r0);
    if (r0 + 1 < r1) EWL_LOAD(xb, yb, zb, gAb, gBb, r0 + 1);
    for (int row = r0; row < r1; ++row) {
        bf16_t* xr = xrow_ptr(P, row); const int r = mod_r(row);
        if (r != rcur) { rcur = r; const float* mb = mods + (size_t)(l * 5 + r) * (NMOD * DM);
            ld_gate(G3, P.in[6] + (l * 4 + 3) * DM, mb + 5 * DM, c.lane);
            if (l < 3) { const float* mn = mods + (size_t)((l + 1) * 5 + r) * (NMOD * DM); ld_mod(A0, B0, P.in[6] + ((l + 1) * 4 + 0) * DM, mn + 0 * DM, mn + 1 * DM, c.lane); } }
        f32x4 x[4], y[4], h[4];
#pragma unroll
        for (int j = 0; j < 4; ++j) { x[j] = (f32x4){bflo(xa[j].x), bfhi(xa[j].x), bflo(xa[j].y), bfhi(xa[j].y)};
            y[j] = (f32x4){bflo(ya[j].x), bfhi(ya[j].x), bflo(ya[j].y), bfhi(ya[j].y)};
            if (odd) y[j] = y[j] * gAa + (f32x4){bflo(za[j].x), bfhi(za[j].x), bflo(za[j].y), bfhi(za[j].y)} * gBa;
            xa[j] = xb[j]; ya[j] = yb[j]; za[j] = zb[j]; }
        gAa = gAb; gBa = gBb;
        if (row + 2 < r1) EWL_LOAD(xb, yb, zb, gAb, gBb, row + 2);
        resid_add2(x, y, G3);
        bf16_t* hw = (dry ? (bf16_t*)(P.ws + WS_U + U_MIX) : HB) + (size_t)row * DM;
        if (l == 3 && !dry) { float* ow = P.out + (size_t)row * DM;
#pragma unroll
            for (int j = 0; j < 4; ++j) *(f32x4*)(ow + 4 * c.lane + 256 * j) = x[j]; }
        else { bf16_t* xw = dry ? (bf16_t*)(P.ws + WS_U + U_PB) + (size_t)row * DM : xr;
#pragma unroll
            for (int j = 0; j < 4; ++j) stbf4(xw + 4 * c.lane + 256 * j, x[j]); }
        if (l < 3) { norm_mod2(x, h, A0, B0);
            if (WIN8(l + 1)) { unsigned char* h8 = (unsigned char*)(dry ? (bf16_t*)(P.ws + WS_U + U_MIX) : HB) + (size_t)row * DM;
#pragma unroll
                for (int j = 0; j < 4; ++j) *(unsigned*)(h8 + 4 * c.lane + 256 * j) = pk4_fp8(h[j][0] * F8_ACT_SCALE, h[j][1] * F8_ACT_SCALE, h[j][2] * F8_ACT_SCALE, h[j][3] * F8_ACT_SCALE); }
            else {
#pragma unroll
                for (int j = 0; j < 4; ++j) stbf4(hw + 4 * c.lane + 256 * j, h[j]); } }
    }
#undef EWL_LOAD
}

__device__ __forceinline__ void attn_even(const Ctx& c_, int l) {
    const Ctx c = make_ctx(c_.lds);
    KParams& P = kparams(); const int i = l >> 1; const bool need_ctx = l < 3;
    const bf16_t* PB = (const bf16_t*)(P.ws + WS_U + U_PB); bf16_t* MIX = (bf16_t*)(P.ws + WS_U + U_MIX);
    const int nchunk = need_ctx ? 264 : 256;
    for (int u = opaque_bid(); u < nchunk * 4; u += gridDim.x) att::sgu_unit(c.lds, PB, (const bf16_t*)(P.ws + WS_SGUW) + (size_t)i * 4 * 128 * 128, P.in[10] + i * 512, (const float*)(P.ws + WS_STATS), P.in[11] + i * 512, MIX, (u >> 2) * 128, u & 3);
    float d1 = 0.f, d2 = 0.f;
    if (c.lane < 64) { d1 = P.in[12][i * 64 + c.lane] * P.in[13][i * 64 + c.lane]; d2 = P.in[14][i * 64 + c.lane] * P.in[15][i * 64 + c.lane]; }
    const float lam_init = 0.8f - 0.6f * expf(-0.3f * (float)l);
    const float lam = expf(wave_sum(d1)) - expf(wave_sum(d2)) + lam_init;
    att::Args a;
    a.Q = PB; a.ldq = EV_IN; a.K = PB; a.ldk = EV_IN; a.V = PB; a.ldv = EV_IN; a.C = 0.125f * LOG2E;
    a.rcos = (const float*)(P.ws + WS_ROPEB); a.rsin = a.rcos + SEQ * 32; a.O = MIX; a.ldo = DM; a.g = 0; a.u0 = 0; a.rpb = nullptr;
    a.lam = lam; a.oscale = 1.f - lam_init; a.subg = P.in[16] + i * 128; a.nt_ctx = 4;
    const int nctxu = need_ctx ? 32 : 0, nu = nctxu + 1024;
    for (int u = xcd_unit_base(); u < nu; u += gridDim.x) {
        int b, h;
        if (u < nctxu) { b = u >> 3; h = (u >> 1) & 3; a.q_row0 = NLAT + b * CTXL + (u & 1) * 128; a.nt_lat = 0; a.rope = 0; }
        else { const int v = u - nctxu; b = v >> 8; h = (v >> 6) & 3; a.q_row0 = b * SEQ + (v & 63) * 128; a.nt_lat = SEQ / 64; a.rope = 0; }
        a.qcol = 1024 + h * 128; a.kcol = 1536 + h * 128; a.vcol = 2048 + h * 128; a.ocol = 512 + h * 128;
        a.kctx_row0 = NLAT + b * CTXL; a.klat_row0 = b * SEQ;
        att::attn_unit<64, 128, 128, 1>(c.lds, a);
    }
}
__device__ __forceinline__ void attn_odd_na(const Ctx& c_, int l) {
    const Ctx c = make_ctx(c_.lds);
    KParams& P = kparams(); const int i = l >> 1; const bool need_ctx = l < 3;
    const bf16_t* PB = (const bf16_t*)(P.ws + WS_U + U_PB); bf16_t* MIX = (bf16_t*)(P.ws + WS_U + U_MIX);
    att::Args a;
    a.Q = PB; a.ldq = OD_INP; a.K = PB; a.ldk = OD_INP; a.V = PB; a.ldv = OD_INP; a.C = 0.125f * LOG2E; a.rope = 0; a.rcos = nullptr; a.rsin = nullptr;
    a.O = MIX; a.ldo = DM; a.lam = 0.f; a.oscale = 1.f; a.subg = nullptr; a.nt_ctx = 4;
    const int nctxu = need_ctx ? 32 : 0, nu = nctxu + 1024;
    for (int u = xcd_unit_base(); u < nu; u += gridDim.x) {
        int b, h;
        if (u < nctxu) { b = u >> 3; h = u & 7; a.q_row0 = NLAT + b * CTXL; a.nt_lat = 0; a.g = 0; a.u0 = 0; a.klat_row0 = 0; }
        else { const int v = u - nctxu; b = v >> 8; h = (v >> 5) & 7; const int g = v & 31; a.g = g; a.u0 = min(max(4 * g - 4, 0), 116);
            a.q_row0 = b * SEQ + g * 256; a.nt_lat = 12; a.klat_row0 = b * SEQ + a.u0 * 64; }
        a.qcol = h * 64; a.kcol = 512 + h * 64; a.vcol = 1024 + h * 64; a.ocol = h * 64; a.kctx_row0 = NLAT + b * CTXL;
        a.rpb = P.in[22] + ((size_t)i * 8 + h) * 465;
        att::attn_unit<64, 64, 64, 2>(c.lds, a);
    }
}
__device__ __forceinline__ void attn_odd_mla(const Ctx& c_, int l) {
    const Ctx c = make_ctx(c_.lds);
    KParams& P = kparams(); const bool need_ctx = l < 3;
    const bf16_t* MO = (const bf16_t*)(P.ws + WS_U + U_MLAO); bf16_t* MIX = (bf16_t*)(P.ws + WS_U + U_MIX);
    att::Args a;
    a.Q = MO; a.ldq = MLA_N; a.K = MO; a.ldk = MLA_N; a.V = MO; a.ldv = MLA_N; a.C = 0.10206207261596575f * LOG2E;
    a.rcos = (const float*)(P.ws + WS_ROPED); a.rsin = a.rcos + SEQ * 16; a.O = MIX; a.ldo = DM; a.g = 0; a.u0 = 0; a.rpb = nullptr; a.lam = 0.f; a.oscale = 1.f; a.subg = nullptr; a.nt_ctx = 4;
    const int nctxu = need_ctx ? 16 : 0, nu = nctxu + 512;
    for (int u = xcd_unit_base(); u < nu; u += gridDim.x) {
        int b, h;
        if (u < nctxu) { b = u >> 2; h = u & 3; a.q_row0 = NLAT + b * CTXL; a.nt_lat = 0; a.rope = 0; }
        else { const int v = u - nctxu; b = v >> 7; h = (v >> 5) & 3; a.q_row0 = b * SEQ + (v & 31) * 256; a.nt_lat = SEQ / 64; a.rope = 2; }
        a.qcol = h * 96; a.kcol = 384 + h * 96; a.vcol = 768 + h * 128; a.ocol = 512 + h * 128; a.kctx_row0 = NLAT + b * CTXL; a.klat_row0 = b * SEQ;
        att::attn_unit<96, 96, 128, 0>(c.lds, a);
    }
}

constexpr int N_PHASES = 2 + 2 * (7 + 9);
__global__ void __launch_bounds__(512, 2) fwd_kernel(Params prm) {
    extern __shared__ __attribute__((aligned(16))) unsigned char lds_raw[];
    LAS unsigned char* lds = (LAS unsigned char*)lds_raw;
    const Ctx c{lds, 0, 0, 0, 0, 0};
    for (int u = threadIdx.x; u < (LDS_BYTES - LDS_MISC) / 4; u += 512) ((LAS unsigned*)(lds + LDS_MISC))[u] = 0u;
    __syncthreads();
    XcdBarrier bar;
    { unsigned char* ws0 = kparams().ws; bar.bar = (unsigned*)(ws0 + WS_CTL) + CW_BAR; bar.x = 0; bar.st = nullptr;
#if !MK_PER_PHASE
      bar = xcd_barrier_post((unsigned*)(ws0 + WS_CTL) + CW_BAR, (volatile LAS unsigned*)(lds + LDS_MISC + 32));
#endif
    }
    int ph = 0;
#ifndef PMASK
#define PMASK 0xffffffffu
#endif
#define PM(b) ((PMASK >> (b)) & 1u)
#define PH_ON() (ph >= kparams().ph_lo && ph < kparams().ph_hi)
#define PH_END() do { if (ph >= kparams().ph_lo && ph + 1 < kparams().ph_hi) xcd_barrier(bar); ++ph; } while (0)
#define WSP(off) ((bf16_t*)(ws + (off)))
#define HB WSP(WS_HB)
#define PB WSP(WS_U + U_PB)
#define MIX WSP(WS_U + U_MIX)
#define YB WSP(WS_U + U_YB)
#define HID WSP(WS_U + U_HID)
#define YS WSP(WS_U + U_YS)
#define A2 WSP(WS_U + U_A2)
#define MO WSP(WS_U + U_MLAO)

    if (PM(0) && PH_ON()) for (int rep = 0; rep < DUPN(0); ++rep) { prologue0(c); __syncthreads(); }
    PH_END();
    if (PM(1) && PH_ON()) for (int rep = 0; rep < DUPN(1); ++rep) ew_first(c);
    PH_END();
    for (int lp = 0; lp < 2; ++lp) {
        {
            const int l = 2 * lp, i = lp; const int mtok = l < 3 ? MTOT : NLAT, nMt = mtok / 256;
            if (PM(2) && PH_ON()) for (int rep = 0; rep < DUPN(2); ++rep) { unsigned char* ws = kparams().ws; pg8::Gemm g{}; g.A = HB; g.lda = DM; g.Bt = (const unsigned char*)(ws + WS_WINE) + (size_t)i * EV_IN * DM * 2; g.K = DM; g.nM = MTOT / 256; g.nN = EV_IN / 256; g.grouped = 0; g.estride = 0;
                pg8::EpiEvenIn E{PB, EV_IN, (f32x2*)(ws + WS_STATS), (const float*)(ws + WS_ROPEB), (const float*)(ws + WS_ROPEB) + SEQ * 32, WIN8(l) ? F8_INV : 1.f}; if (WIN8(l)) gemm8_even_in(lds, g, E); else gemm_even_in(lds, g, E); if (rep == 0) convert_moe_tail(c, i, 0, 7296, (MTOT / 256) * (EV_IN / 256)); }
            PH_END();
            if (PM(4) && PH_ON()) for (int rep = 0; rep < DUPN(4); ++rep) attn_even(c, l);
            PH_END();
            if (PM(5) && PH_ON()) for (int rep = 0; rep < DUPN(5); ++rep) { unsigned char* ws = kparams().ws; pg8::Gemm g{}; g.A = MIX; g.lda = DM; g.Bt = (const bf16_t*)(ws + WS_WOUTE) + (size_t)i * DM * DM; g.K = DM; g.nM = nMt; g.nN = DM / 256; g.grouped = 0; g.estride = 0;
                gemm_bf16(lds, g, YB, DM); if (rep == 0) convert_moe_tail(c, i, 7296, 14592, nMt * (DM / 256)); }
            PH_END();
            if (PM(6) && PH_ON()) { if (DUPN(6) > 1) ew_mid(c, l, mtok, true); ew_mid(c, l, mtok); }
            PH_END();
            if (PM(7) && PH_ON()) for (int rep = 0; rep < DUPN(7); ++rep) { unsigned char* ws = kparams().ws; pg8::Gemm g{}; g.A = HB; g.lda = DM; g.Bt = (const unsigned char*)(ws + WS_W13E) + (size_t)i * 2 * DFF * DM * 2; g.K = DM; g.nM = nMt; g.nN = 2 * DFF / 256; g.grouped = 0; g.estride = 0;
                if (FFN8(i)) gemm8_swiglu8(lds, g, (unsigned char*)HID, DFF); else gemm_swiglu(lds, g, HID, DFF);
                if (rep == 0) convert_moe_tail(c, i, 14592, 20224, nMt * (2 * DFF / 256)); }
            PH_END();
            if (PM(8) && PH_ON()) for (int rep = 0; rep < DUPN(8); ++rep) { unsigned char* ws = kparams().ws; pg8::Gemm g{}; g.A = HID; g.lda = DFF; g.Bt = (const unsigned char*)(ws + WS_W2E) + (size_t)i * DM * DFF * 2; g.K = DFF; g.nM = nMt; g.nN = DM / 256; g.grouped = 0; g.estride = 0;
                if (FFN8(i)) gemm8_bf16(lds, g, YS, DM); else gemm_bf16(lds, g, YS, DM);
                if (rep == 0) convert_moe_tail(c, i, 20224, MOE_CVT_ITEMS, nMt * (DM / 256)); }
            PH_END();
            if (PM(9) && PH_ON()) { if (DUPN(9) > 1) ew_last(c, l, mtok, true); ew_last(c, l, mtok); }
            PH_END();
        }
        {
            const int l = 2 * lp + 1, i = lp; const int mtok = l < 3 ? MTOT : NLAT, nMt = mtok / 256;
            if (PM(10) && PH_ON()) for (int rep = 0; rep < DUPN(10); ++rep) { unsigned char* ws = kparams().ws; pg8::Gemm g{}; g.A = HB; g.lda = DM; g.Bt = (const unsigned char*)(ws + WS_WINO) + (size_t)i * OD_INP * DM * 2; g.K = DM; g.nM = MTOT / 256; g.nN = OD_INP / 256; g.grouped = 0; g.estride = 0;
                pg8::EpiOddIn E{PB, OD_INP, (float*)(ws + WS_STATS), (const float*)(ws + WS_ROPED), (const float*)(ws + WS_ROPED) + SEQ * 16, WIN8(l) ? F8_INV : 1.f}; if (WIN8(l)) gemm8_odd_in(lds, g, E); else gemm_odd_in(lds, g, E); }
            PH_END();
            if (PM(12) && PH_ON()) for (int rep = 0; rep < DUPN(12); ++rep) { unsigned char* ws = kparams().ws; pg8::Gemm g{}; g.A = PB + 1536; g.lda = OD_INP; g.Bt = (const bf16_t*)(ws + WS_WMLA) + (size_t)i * MLA_N * MLA_K; g.K = MLA_K; g.nM = MTOT / 256; g.nN = MLA_N / 256; g.grouped = 0; g.estride = 0;
                pg8::EpiMlaUp E{MO, MLA_N, (const float*)(ws + WS_STATS)}; gemm_mla_up(lds, g, E); }
            PH_END();
            if (PH_ON()) { if (PM(13)) for (int rep = 0; rep < DUPN(13); ++rep) attn_odd_na(c, l); if (PM(14)) for (int rep = 0; rep < DUPN(14); ++rep) attn_odd_mla(c, l); }
            PH_END();
            if (PM(15) && PH_ON()) for (int rep = 0; rep < DUPN(15); ++rep) { unsigned char* ws = kparams().ws; pg8::Gemm g{}; g.A = MIX; g.lda = DM; g.Bt = (const bf16_t*)(ws + WS_WOUTO) + (size_t)i * DM * DM; g.K = DM; g.nM = nMt; g.nN = DM / 256; g.grouped = 0; g.estride = 0;
                gemm_bf16(lds, g, YB, DM); }
            PH_END();
            if (PM(16) && PH_ON()) { if (DUPN(16) > 1) ew_mid(c, l, mtok, true); ew_mid(c, l, mtok); }
            PH_END();
            if (PM(17) && PH_ON()) for (int rep = 0; rep < DUPN(17); ++rep) moe_gather(c, i, mtok);
            PH_END();
            if (PM(18) && PH_ON()) for (int rep = 0; rep < DUPN(18); ++rep) { unsigned char* ws = kparams().ws; pg8::Gemm g{}; g.A = YS; g.lda = DM; g.Bt = (const bf16_t*)(ws + WS_W13M); g.K = DM; g.nN = 2 * DFFE / 256; g.grouped = 1; g.estride = (size_t)2 * DFFE * DM;
                moe_offsets(kparams(), i, g.toff); g.nM = g.toff[8];
#if MOE_F8
                gemm8_swiglu8(lds, g, (unsigned char*)HID, DFFE);
#else
                gemm_swiglu(lds, g, HID, DFFE);
#endif
            }
            PH_END();
            if (PM(19) && PH_ON()) for (int rep = 0; rep < DUPN(19); ++rep) { unsigned char* ws = kparams().ws; pg8::Gemm g{}; g.A = HID; g.lda = DFFE; g.Bt = (const bf16_t*)(ws + WS_W2M); g.K = DFFE; g.nN = DM / 256; g.grouped = 1; g.estride = (size_t)DM * DFFE;
                moe_offsets(kparams(), i, g.toff); g.nM = g.toff[8];
#if MOE_F8
                gemm8_bf16(lds, g, YS, DM);
#else
                gemm_bf16(lds, g, YS, DM);
#endif
            }
            PH_END();
            if (PM(20) && PH_ON()) { if (DUPN(20) > 1) ew_last(c, l, mtok, true); ew_last(c, l, mtok); }
            PH_END();
        }
    }
#undef PH_ON
#undef PH_END
#undef HB
#undef PB
#undef MIX
#undef YB
#undef HID
#undef YS
#undef A2
#undef MO
}

extern "C" void kernel_launch(void* const* d_in, const int* in_sizes, int n_in, void* d_out, int out_size, void* d_ws, size_t ws_size, hipStream_t stream) {
    static int grid = 0;
    if (grid == 0) {
        int dev = 0, cus = 0;
        if (n_in != 31 || out_size != NLAT * DM || ws_size < WS_END) { fprintf(stderr, "kernel_launch: unexpected shapes or workspace (n_in %d out %d ws %zu need %zu)\n", n_in, out_size, ws_size, (size_t)WS_END); grid = -1; }
        else if (hipGetDevice(&dev) != hipSuccess || hipDeviceGetAttribute(&cus, hipDeviceAttributeMultiprocessorCount, dev) != hipSuccess) grid = -1;
        else if (hipFuncSetAttribute((const void*)fwd_kernel, hipFuncAttributeMaxDynamicSharedMemorySize, LDS_BYTES) != hipSuccess) grid = -1;
        else { int per_cu = 0; (void)hipOccupancyMaxActiveBlocksPerMultiprocessor(&per_cu, (const void*)fwd_kernel, 512, LDS_BYTES); (void)hipGetLastError(); grid = cus; }
    }
    if (grid < 0) { (void)hipMemsetAsync(d_out, 0, (size_t)out_size * 4, stream); return; }
    (void)hipMemsetAsync((char*)d_ws + WS_CTL, 0, CTL_BYTES, stream);
    Params p{};
    for (int i = 0; i < 31; ++i) p.in[i] = (const float*)d_in[i];
    p.out = (float*)d_out; p.ws = (unsigned char*)d_ws;
#if MK_PER_PHASE
    for (int k = 0; k < N_PHASES; ++k) { p.ph_lo = k; p.ph_hi = k + 1; hipLaunchKernelGGL(fwd_kernel, dim3(grid), dim3(512), LDS_BYTES, stream, p); }
#else
    p.ph_lo = 0; p.ph_hi = N_PHASES;
    hipLaunchKernelGGL(fwd_kernel, dim3(grid), dim3(512), LDS_BYTES, stream, p);
#endif
}
```

```cpp
#include <hip/hip_runtime.h>
#include <stdint.h>
#include <stdio.h>

#ifndef MK_PER_PHASE
#define MK_PER_PHASE 0
#endif
#ifndef DUP_MASK
#define DUP_MASK 0u
#endif
#define DUPN(b) (1 + (int)((DUP_MASK >> (b)) & 1u))
#ifndef FFN_F8
#define FFN_F8 1
#endif
#ifndef FFN_F8_FROM
#define FFN_F8_FROM 1
#endif
#define FFN8(i) (FFN_F8 && (i) >= FFN_F8_FROM)
#ifndef WIN_F8_FROM
#define WIN_F8_FROM 2
#endif
#define WIN8(l) ((l) >= WIN_F8_FROM)
#ifndef MOE_F8
#define MOE_F8 1
#endif

#define LAS __attribute__((address_space(3)))
typedef unsigned short bf16_t;
typedef short bf16x8 __attribute__((ext_vector_type(8)));
typedef short s16x4 __attribute__((ext_vector_type(4)));
typedef float f32x4 __attribute__((ext_vector_type(4)));
typedef float f32x2 __attribute__((ext_vector_type(2)));
typedef float f32x16 __attribute__((ext_vector_type(16)));
typedef unsigned u32x4 __attribute__((ext_vector_type(4)));
typedef unsigned u32x2 __attribute__((ext_vector_type(2)));

constexpr int DM = 1024, NB = 4, SEQ = 8192, NLAT = NB * SEQ, CTXL = 256, NCTX = NB * CTXL, MTOT = NLAT + NCTX;
constexpr int NMOD = 6;
constexpr int EV_IN = 2560, OD_IN = 1952, OD_INP = 2048, DFF = 2816, DFFE = 3584, NEXP = 8;
constexpr int MLA_N = 1280, MLA_K = 512;
constexpr int MS_MAX = 2 * MTOT + NEXP * 256;
constexpr float EPS = 1e-6f;
constexpr float LOG2E = 1.4426950408889634f;

constexpr size_t MiB = (size_t)1 << 20;
constexpr size_t WS_CTL = 0, CTL_BYTES = MiB;
constexpr size_t WS_MODS = 1 * MiB;
constexpr size_t WS_ROPEB = 2 * MiB;
constexpr size_t WS_ROPED = 4 * MiB;
constexpr size_t WS_SGUW = 5 * MiB;
constexpr size_t WS_TOKINFO = 6 * MiB;
constexpr size_t WS_TOKPOS = 8 * MiB;
constexpr size_t WS_CTXX = 10 * MiB;
constexpr size_t WS_WMLA = 14 * MiB;
constexpr size_t WS_WINE = 17 * MiB;
constexpr size_t WS_WOUTE = 27 * MiB;
constexpr size_t WS_W13E = 31 * MiB;
constexpr size_t WS_W2E = 53 * MiB;
constexpr size_t WS_WINO = 64 * MiB;
constexpr size_t WS_WOUTO = 72 * MiB;
constexpr size_t WS_W13M = 76 * MiB;
constexpr size_t WS_W2M = 188 * MiB;
constexpr size_t WS_HB = 244 * MiB;
constexpr size_t WS_U = 310 * MiB;
constexpr size_t U_PB = 0;
constexpr size_t U_MIX = 165 * MiB;
constexpr size_t U_A2 = 231 * MiB;
constexpr size_t U_MLAO = 264 * MiB;
constexpr size_t U_YB = 347 * MiB;
constexpr size_t U_HID = 0;
constexpr size_t U_XB = 549 * MiB;
constexpr size_t U_YS = 413 * MiB;
constexpr size_t WS_STATS = WS_U + 616 * MiB;
constexpr size_t WS_END = WS_STATS + 4 * MiB;
static_assert((size_t)MS_MAX * DFFE * (MOE_F8 ? 1 : 2) <= 347 * MiB && (size_t)MTOT * DFF * 2 <= 347 * MiB, "hid must stay clear of YB");
static_assert(U_YS + (size_t)MS_MAX * DM * 2 <= U_XB && U_XB + (size_t)MTOT * DM * 2 <= 616 * MiB, "ys / xb fit");

constexpr int CW_BAR = 4096;
constexpr int CW_MOECNT = 1024;

constexpr int LDS_BYTES = 147456;
constexpr int LDS_MISC = 131072;

__device__ __forceinline__ unsigned cvtpk(float lo, float hi) { unsigned r; asm volatile("v_cvt_pk_bf16_f32 %0, %1, %2" : "=v"(r) : "v"(lo), "v"(hi)); return r; }
__device__ __forceinline__ float bf2f(unsigned short b) { return __uint_as_float(((unsigned)b) << 16); }
__device__ __forceinline__ float bflo(unsigned w) { return __uint_as_float(w << 16); }
__device__ __forceinline__ float bfhi(unsigned w) { return __uint_as_float(w & 0xffff0000u); }
__device__ __forceinline__ bf16_t f2bf(float f) { return (bf16_t)(cvtpk(f, 0.f) & 0xffffu); }
typedef int i32x8 __attribute__((ext_vector_type(8)));
typedef int i32x4 __attribute__((ext_vector_type(4)));
constexpr float F8_ACT_SCALE = 4.f, F8_W_SCALE = 64.f, F8_INV = 1.f / (F8_ACT_SCALE * F8_W_SCALE);
__device__ __forceinline__ unsigned pk4_fp8(float a, float b, float c, float d) {
    a = __builtin_amdgcn_fmed3f(a, -448.f, 448.f); b = __builtin_amdgcn_fmed3f(b, -448.f, 448.f); c = __builtin_amdgcn_fmed3f(c, -448.f, 448.f); d = __builtin_amdgcn_fmed3f(d, -448.f, 448.f);
    int w = 0; w = __builtin_amdgcn_cvt_pk_fp8_f32(a, b, w, false); w = __builtin_amdgcn_cvt_pk_fp8_f32(c, d, w, true); return (unsigned)w; }
__device__ __forceinline__ float wave_sum(float v) {
#pragma unroll
    for (int o = 1; o < 64; o <<= 1) v += __shfl_xor(v, o);
    return v;
}
__device__ __forceinline__ float fast_exp2(float x) { return __builtin_amdgcn_exp2f(x); }
__device__ __forceinline__ float fast_rcp(float x) { return __builtin_amdgcn_rcpf(x); }
__device__ __forceinline__ float silu_f(float x) { return x * fast_rcp(1.f + fast_exp2(-x * LOG2E)); }
__device__ __forceinline__ float gelu_tanh_f(float x) { const float u = 0.7978845608028654f * (x + 0.044715f * x * x * x); return x * fast_rcp(1.f + fast_exp2(-2.f * LOG2E * u)); }
#define LDS_WAIT() asm volatile("s_waitcnt lgkmcnt(0)" ::: "memory")
#define VM_WAIT() asm volatile("s_waitcnt vmcnt(0)" ::: "memory")
__device__ __forceinline__ int opaque_bid() { int b = blockIdx.x; asm volatile("" : "+s"(b)); return b; }
__device__ __forceinline__ int xcd_unit_base() { const int b = opaque_bid(), G = (int)gridDim.x; return (G % 8 == 0) ? (b & 7) * (G >> 3) + (b >> 3) : b; }
__device__ __forceinline__ int opaque_tid() { int t = threadIdx.x; asm volatile("" : "+v"(t)); return t; }

#define XB_TMO      128
#define XB_XCNT(j)  (256  + 64 * (j))
#define XB_XSUB(j)  (1280 + 64 * (j))
#define XB_XGEN(j)  (2304 + 64 * (j))
#define XB_TOP      3328
#define XB_TOPGEN   3392
#define XCD_BAR_WORDS 3456
#define XB_SPIN_CAP (1u << 22)
__device__ __forceinline__ unsigned xb_ld(unsigned* p)              { return __hip_atomic_load(p, __ATOMIC_RELAXED, __HIP_MEMORY_SCOPE_AGENT); }
__device__ __forceinline__ unsigned xb_add(unsigned* p, unsigned v) { return __hip_atomic_fetch_add(p, v, __ATOMIC_RELAXED, __HIP_MEMORY_SCOPE_AGENT); }
__device__ __forceinline__ unsigned xb_xcc_id() { return (unsigned)__builtin_amdgcn_s_getreg((3 << 11) | 20) & 0xFu; }
#define XB_SPIN(cond, bar) do { unsigned _sp = 0; while (cond) { __builtin_amdgcn_s_sleep(1); \
    if ((++_sp & 255u) == 0u) { if (xb_ld(&(bar)[XB_TMO])) break; if (_sp > XB_SPIN_CAP) { atomicAdd(&(bar)[XB_TMO], 1u); break; } } } } while (0)
struct XcdBarrier { unsigned* bar; unsigned x; volatile LAS unsigned* st; };
__device__ __forceinline__ XcdBarrier xcd_barrier_post(unsigned* bar, volatile LAS unsigned* st) {
    XcdBarrier b; b.bar = bar; b.x = xb_xcc_id(); b.st = st;
    if (threadIdx.x == 0) (void)xb_add(&bar[XB_XCNT(b.x)], 1u);
    return b;
}
__device__ __forceinline__ void xcd_barrier_complete(unsigned* bar, unsigned x, unsigned& nloc, unsigned& nx) {
    const unsigned G = gridDim.x * gridDim.y * gridDim.z;
    unsigned sum, cnt, mine, sp = 0u;
    for (;;) {
        sum = 0u; cnt = 0u; mine = 0u;
#pragma unroll
        for (unsigned j = 0; j < 16; ++j) { const unsigned c = xb_ld(&bar[XB_XCNT(j)]); sum += c; cnt += (c > 0u) ? 1u : 0u; mine = (j == x) ? c : mine; }
        if (sum == G) break;
        __builtin_amdgcn_s_sleep(1);
        if ((++sp & 255u) == 0u) { if (xb_ld(&bar[XB_TMO])) break; if (sp > XB_SPIN_CAP) { atomicAdd(&bar[XB_TMO], 1u); break; } }
    }
    nloc = mine > 0u ? mine : 1u; nx = cnt > 0u ? cnt : 1u;
}
__device__ __forceinline__ void xcd_barrier(const XcdBarrier& b) {
    asm volatile("s_waitcnt vmcnt(0)" ::: "memory");
    __syncthreads();
    if (threadIdx.x == 0) {
        unsigned* bar = b.bar;
        __builtin_amdgcn_s_waitcnt(0);
        unsigned nloc = b.st[0], nx = b.st[1];
        if (nloc == 0u) { xcd_barrier_complete(bar, b.x, nloc, nx); b.st[0] = nloc; b.st[1] = nx; }
        const unsigned old = xb_add(&bar[XB_XSUB(b.x)], 1u);
        const unsigned gen = old / nloc;
        if (old + 1u == (gen + 1u) * nloc) {
            __builtin_amdgcn_fence(__ATOMIC_RELEASE, "agent");
            asm volatile("s_waitcnt vmcnt(0)" ::: "memory");
            const unsigned og = xb_add(&bar[XB_TOP], 1u);
            const unsigned tg = og / nx;
            if (og + 1u == (tg + 1u) * nx) xb_add(&bar[XB_TOPGEN], 1u);
            else XB_SPIN(xb_ld(&bar[XB_TOPGEN]) == tg, bar);
            __builtin_amdgcn_fence(__ATOMIC_ACQUIRE, "agent");
            xb_add(&bar[XB_XGEN(b.x)], 1u);
            asm volatile("s_waitcnt vmcnt(0)" ::: "memory");
        } else {
            XB_SPIN(xb_ld(&bar[XB_XGEN(b.x)]) == gen, bar);
            __builtin_amdgcn_fence(__ATOMIC_ACQUIRE, "agent");
            asm volatile("s_waitcnt vmcnt(0)" ::: "memory");
        }
    }
    __syncthreads();
}

namespace pg8 {
constexpr int BM = 256, BK = 64, HALF = 128, HTB = HALF * BK * 2, STAGE_BYTES = 8 * HTB, NXCD = 8, WGM = 8;
__device__ __forceinline__ int lds_byte(int r, int c) { const int st = (r >> 4) * 2 + (c >> 5), rr = r & 15, cc = c & 31, ob = rr * 64 + cc * 2; return st * 1024 + (ob ^ (((ob >> 9) & 1) << 5)); }
__device__ __forceinline__ void stage_rc(int b, int& R, int& C) { const int st = b / 1024, sb = b % 1024, swz = sb ^ (((sb >> 9) & 1) << 5); R = (st >> 1) * 16 + swz / 64; C = (st & 1) * 32 + (swz % 64) / 2; }
__device__ __forceinline__ int perm32(int rho) { const int n = rho >> 4, i = rho & 15; return 8 * (i >> 2) + 4 * n + (i & 3); }
struct Unit { int pm, pn, e; };
struct Gemm {
    const void* A; int lda;
    const void* Bt; int K;
    int nM, nN;
    int grouped; int toff[9]; size_t estride;
};
struct StaticOrder {
    int nM, nN, nwg, G, c;
    __device__ void init(int nM_, int nN_, int G_, int c_) { nM = nM_; nN = nN_; nwg = nM * nN; G = G_; c = c_; }
    __device__ __forceinline__ bool next(int i, Unit& u) const {
        const long L = (long)i * G + c; if (L >= nwg) return false;
        int wgid = (int)L; { const int q = nwg / NXCD, r = nwg % NXCD, xcd = wgid % NXCD, off = wgid / NXCD; wgid = (xcd < r ? xcd * (q + 1) : r * (q + 1) + (xcd - r) * q) + off; }
        const int nig = WGM * nN, gid = wgid / nig, fm = gid * WGM, gsz = (nM - fm) < WGM ? (nM - fm) : WGM;
        u.pm = fm + ((wgid % nig) % gsz); u.pn = (wgid % nig) / gsz; u.e = 0; return true;
    }
};
struct EpiBf16 {
    bf16_t* O; int ldc; float scale;
    __device__ __forceinline__ void operator()(const f32x4 (&acc)[2][2][4][2], const Unit& u, int wr, int wc, int fr, int fq) const {
        const int row0 = u.pm * BM + wr * 64 + fr, col0 = u.pn * BM + wc * 32 + 8 * fq;
#pragma unroll
        for (int ai = 0; ai < 2; ++ai)
#pragma unroll
            for (int m = 0; m < 4; ++m) { bf16_t* rowp = O + (size_t)(row0 + ai * HALF + m * 16) * ldc + col0;
#pragma unroll
                for (int bj = 0; bj < 2; ++bj) { const f32x4 v0 = acc[ai][bj][m][0] * scale, v1 = acc[ai][bj][m][1] * scale;
                    u32x4 w; w.x = cvtpk(v0[0], v0[1]); w.y = cvtpk(v0[2], v0[3]); w.z = cvtpk(v1[0], v1[1]); w.w = cvtpk(v1[2], v1[3]);
                    *(u32x4*)(rowp + bj * HALF) = w; } }
    }
};
__device__ __forceinline__ f32x4 swiglu4(f32x4 a, f32x4 b, float k1, float k2) {
    const f32x4 t = a * k1; f32x4 d;
#pragma unroll
    for (int j = 0; j < 4; ++j) d[j] = fast_exp2(t[j]);
    d = d + 1.f; f32x4 r;
#pragma unroll
    for (int j = 0; j < 4; ++j) r[j] = fast_rcp(d[j]);
    return (a * b) * (r * k2);
}
struct EpiSwiGLU {
    bf16_t* O; int ldc;
    __device__ __forceinline__ void operator()(const f32x4 (&acc)[2][2][4][2], const Unit& u, int wr, int wc, int fr, int fq) const {
        const int row0 = u.pm * BM + wr * 64 + fr, col0 = u.pn * HALF + wc * 32 + 8 * fq;
#pragma unroll
        for (int ai = 0; ai < 2; ++ai)
#pragma unroll
            for (int m = 0; m < 4; ++m) { bf16_t* rowp = O + (size_t)(row0 + ai * HALF + m * 16) * ldc + col0;
                const f32x4 r0 = swiglu4(acc[ai][0][m][0], acc[ai][1][m][0], -LOG2E, 1.f), r1 = swiglu4(acc[ai][0][m][1], acc[ai][1][m][1], -LOG2E, 1.f);
                u32x4 w; w.x = cvtpk(r0[0], r0[1]); w.y = cvtpk(r0[2], r0[3]); w.z = cvtpk(r1[0], r1[1]); w.w = cvtpk(r1[2], r1[3]);
                *(u32x4*)rowp = w; }
    }
};

struct EpiEvenIn {
    bf16_t* O; int ldc; f32x2* stats; const float* rcos; const float* rsin; float scale;
    __device__ __forceinline__ void operator()(const f32x4 (&acc)[2][2][4][2], const Unit& u, int wr, int wc, int fr, int fq) const {
        int upm = u.pm, upn = u.pn; asm volatile("" : "+s"(upm), "+s"(upn));
        const int row0 = upm * BM + wr * 64 + fr, col0 = upn * BM + wc * 32 + 8 * fq;
        const int kind = upn < 2 ? 0 : (upn < 4 ? 1 : (upn < 8 ? 2 : 3)); const bool lat = upm < NLAT / BM; const int t4 = 4 * (4 * (wc & 1) + fq);
#pragma unroll
        for (int ai = 0; ai < 2; ++ai)
#pragma unroll
            for (int m = 0; m < 4; ++m) { const int row = row0 + ai * HALF + m * 16; bf16_t* rowp = O + (size_t)row * ldc + col0;
                f32x4 cs = {1.f, 1.f, 1.f, 1.f}, sn = {0.f, 0.f, 0.f, 0.f}; float s1 = 0.f, s2 = 0.f;
                if (kind == 2 && lat) { const int sp = row & (SEQ - 1); cs = *(const f32x4*)(rcos + sp * 32 + t4); sn = *(const f32x4*)(rsin + sp * 32 + t4); }
#pragma unroll
                for (int bj = 0; bj < 2; ++bj) { f32x4 v0 = acc[ai][bj][m][0] * scale, v1 = acc[ai][bj][m][1] * scale;
                    if (kind < 2) {
#pragma unroll
                        for (int j = 0; j < 4; ++j) { v0[j] = gelu_tanh_f(v0[j]); v1[j] = gelu_tanh_f(v1[j]); }
                        if (kind == 1) { s1 += (v0[0] + v0[1]) + (v0[2] + v0[3]) + (v1[0] + v1[1]) + (v1[2] + v1[3]);
                            s2 += (v0[0] * v0[0] + v0[1] * v0[1]) + (v0[2] * v0[2] + v0[3] * v0[3]) + (v1[0] * v1[0] + v1[1] * v1[1]) + (v1[2] * v1[2] + v1[3] * v1[3]); } }
                    else if (kind == 2) { const f32x4 o0 = v0 * cs - v1 * sn, o1 = v1 * cs + v0 * sn; v0 = o0; v1 = o1; }
                    u32x4 w; w.x = cvtpk(v0[0], v0[1]); w.y = cvtpk(v0[2], v0[3]); w.z = cvtpk(v1[0], v1[1]); w.w = cvtpk(v1[2], v1[3]);
                    *(u32x4*)(rowp + bj * HALF) = w; }
                if (kind == 1) { s1 += __shfl_xor(s1, 16); s1 += __shfl_xor(s1, 32); s2 += __shfl_xor(s2, 16); s2 += __shfl_xor(s2, 32);
                    if (fq == 0) stats[(size_t)row * 8 + (upn - 2) * 4 + wc] = (f32x2){s1, s2}; } }
    }
};
struct EpiOddIn {
    bf16_t* O; int ldc; float* stats; const float* rcos; const float* rsin; float scale;
    __device__ __forceinline__ void operator()(const f32x4 (&acc)[2][2][4][2], const Unit& u, int wr, int wc, int fr, int fq) const {
        int upm = u.pm, upn = u.pn; asm volatile("" : "+s"(upm), "+s"(upn));
        const int row0 = upm * BM + wr * 64 + fr, col0 = upn * BM + wc * 32 + 8 * fq; const bool lat = upm < NLAT / BM;
#pragma unroll
        for (int ai = 0; ai < 2; ++ai)
#pragma unroll
            for (int m = 0; m < 4; ++m) { const int row = row0 + ai * HALF + m * 16; bf16_t* rowp = O + (size_t)row * ldc + col0; float ss = 0.f;
#pragma unroll
                for (int bj = 0; bj < 2; ++bj) { f32x4 v0 = acc[ai][bj][m][0] * scale, v1 = acc[ai][bj][m][1] * scale;
                    if (upn == 6 || (upn == 7 && bj == 0)) ss += (v0[0] * v0[0] + v0[1] * v0[1]) + (v0[2] * v0[2] + v0[3] * v0[3]) + (v1[0] * v1[0] + v1[1] * v1[1]) + (v1[2] * v1[2] + v1[3] * v1[3]);
                    if (upn == 7 && bj == 1 && wc == 0 && lat) { const int sp = row & (SEQ - 1); const f32x4 cs = *(const f32x4*)(rcos + sp * 16 + 4 * fq), sn = *(const f32x4*)(rsin + sp * 16 + 4 * fq);
                        const f32x4 o0 = v0 * cs - v1 * sn, o1 = v1 * cs + v0 * sn; v0 = o0; v1 = o1; }
                    u32x4 w; w.x = cvtpk(v0[0], v0[1]); w.y = cvtpk(v0[2], v0[3]); w.z = cvtpk(v1[0], v1[1]); w.w = cvtpk(v1[2], v1[3]);
                    *(u32x4*)(rowp + bj * HALF) = w; }
                if (upn >= 6) { ss += __shfl_xor(ss, 16); ss += __shfl_xor(ss, 32); if (fq == 0) stats[(size_t)row * 8 + (upn - 6) * 4 + wc] = ss; } }
    }
};
struct EpiMlaUp {
    bf16_t* O; int ldc; const float* stats;
    __device__ __forceinline__ void operator()(const f32x4 (&acc)[2][2][4][2], const Unit& u, int wr, int wc, int fr, int fq) const {
        const int row0 = u.pm * BM + wr * 64 + fr, col0 = u.pn * BM + wc * 32 + 8 * fq;
#pragma unroll
        for (int ai = 0; ai < 2; ++ai)
#pragma unroll
            for (int m = 0; m < 4; ++m) { const int row = row0 + ai * HALF + m * 16; bf16_t* rowp = O + (size_t)row * ldc + col0;
                const f32x4 pq = *(const f32x4*)(stats + (size_t)row * 8), pk = *(const f32x4*)(stats + (size_t)row * 8 + 4);
                const float rq = rsqrtf(((pq[0] + pq[1]) + (pq[2] + pq[3])) * (1.f / 256.f) + EPS), rk = rsqrtf(((pk[0] + pk[1]) + (pk[2] + pk[3])) * (1.f / 128.f) + EPS);
#pragma unroll
                for (int bj = 0; bj < 2; ++bj) { const int c0 = col0 + bj * HALF; const float sc = c0 < 384 ? rq : (c0 < 768 ? (((c0 - 384) % 96) < 64 ? rk : 1.f) : rk);
                    const f32x4 v0 = acc[ai][bj][m][0] * sc, v1 = acc[ai][bj][m][1] * sc;
                    u32x4 w; w.x = cvtpk(v0[0], v0[1]); w.y = cvtpk(v0[2], v0[3]); w.z = cvtpk(v1[0], v1[1]); w.w = cvtpk(v1[2], v1[3]);
                    *(u32x4*)(rowp + bj * HALF) = w; } }
    }
};
struct EpiSwiGLU8 {
    unsigned char* O; int ldc; float scale;
    __device__ __forceinline__ void operator()(const f32x4 (&acc)[2][2][4][2], const Unit& u, int wr, int wc, int fr, int fq) const {
        const int row0 = u.pm * BM + wr * 64 + fr, col0 = u.pn * HALF + wc * 32 + 8 * fq;
#pragma unroll
        for (int ai = 0; ai < 2; ++ai)
#pragma unroll
            for (int m = 0; m < 4; ++m) { unsigned char* rowp = O + (size_t)(row0 + ai * HALF + m * 16) * ldc + col0;
                const float k1 = -LOG2E * scale, k2 = F8_ACT_SCALE * scale * scale;
                const f32x4 r0 = swiglu4(acc[ai][0][m][0], acc[ai][1][m][0], k1, k2), r1 = swiglu4(acc[ai][0][m][1], acc[ai][1][m][1], k1, k2);
                u32x2 w; w.x = pk4_fp8(r0[0], r0[1], r0[2], r0[3]); w.y = pk4_fp8(r1[0], r1[1], r1[2], r1[3]);
                *(u32x2*)rowp = w; }
    }
};

template <class Epi, bool F8 = false>
__device__ __forceinline__ void gemm_phase(LAS unsigned char* lds, const Gemm& g, const Epi& E) {
    const int tid = opaque_tid(), wid = __builtin_amdgcn_readfirstlane(tid >> 6), lane = tid & 63, wr = wid >> 2, wc = wid & 3, fr = lane & 15, fq = lane >> 4;
    constexpr int ES = F8 ? 1 : 2;
    const int K = g.K, nt = K * ES / (BK * 2), lda = g.lda;
    StaticOrder S; S.init(g.nM, g.nN, (int)gridDim.x, opaque_bid());
    unsigned voffA[2], voffB[2];
#pragma unroll
    for (int i = 0; i < 2; ++i) { int R, C; stage_rc(tid * 16 + i * 8192, R, C); const int Rb = (R & ~31) + perm32(R & 31);
        voffA[i] = (unsigned)(R * lda * ES + C * 2); voffB[i] = (unsigned)(Rb * K * ES + C * 2); }
    const size_t kstep = (size_t)(BK * 2);
    const size_t hA = (size_t)HALF * lda * ES, tA = 2 * hA, hB = (size_t)HALF * K * ES, tB = 2 * hB;
    const unsigned ldsw = (unsigned)wid * 1024u;
    const int aoff = lds_byte(wr * 64 + fr, fq * 8), boff = lds_byte(wc * 32 + fr, fq * 8);
#define PG8_SA(b, h) (((b) * 2 + (h)) * HTB)
#define PG8_SB(b, h) ((4 + (b) * 2 + (h)) * HTB)
#define PG8_STAGE(bufoff, gbase, voff) do { _Pragma("unroll") for (int _i = 0; _i < 2; ++_i) \
        __builtin_amdgcn_global_load_lds((const unsigned*)((const char*)(gbase) + (voff)[_i]), (LAS unsigned*)(lds + (bufoff) + ldsw + _i * 8192), 16, 0, 0); } while (0)
#define PG8_LD8(base) __builtin_shufflevector(*(const LAS i32x4*)(base), *(const LAS i32x4*)((base) + 1024), 0, 1, 2, 3, 4, 5, 6, 7)
#define PG8_LDA(dst, b, h) do { _Pragma("unroll") for (int m = 0; m < 4; ++m) dst[m] = PG8_LD8(lds + PG8_SA(b, h) + aoff + m * 2048); } while (0)
#define PG8_LDB(dst, b, h) do { _Pragma("unroll") for (int n = 0; n < 2; ++n) dst[n] = PG8_LD8(lds + PG8_SB(b, h) + boff + n * 2048); } while (0)
#define PG8_H0(x) __builtin_bit_cast(bf16x8, __builtin_shufflevector(x, x, 0, 1, 2, 3))
#define PG8_H1(x) __builtin_bit_cast(bf16x8, __builtin_shufflevector(x, x, 4, 5, 6, 7))
#define PG8_MMA(ai, bj, At, Bt) do { __builtin_amdgcn_s_setprio(1); _Pragma("unroll") for (int m = 0; m < 4; ++m) _Pragma("unroll") for (int n = 0; n < 2; ++n) { \
        if constexpr (F8) asm volatile("v_mfma_f32_16x16x128_f8f6f4 %0, %1, %2, %0" : "+v"(acc[ai][bj][m][n]) : "v"(Bt[n]), "v"(At[m])); \
        else { acc[ai][bj][m][n] = __builtin_amdgcn_mfma_f32_16x16x32_bf16(PG8_H0(Bt[n]), PG8_H0(At[m]), acc[ai][bj][m][n], 0, 0, 0); \
               acc[ai][bj][m][n] = __builtin_amdgcn_mfma_f32_16x16x32_bf16(PG8_H1(Bt[n]), PG8_H1(At[m]), acc[ai][bj][m][n], 0, 0, 0); } } \
        __builtin_amdgcn_s_setprio(0); } while (0)
#define PG8_WAIT_V(n) asm volatile("s_waitcnt vmcnt(" #n ")" ::: "memory")
#define PG8_WAIT_L(n) asm volatile("s_waitcnt lgkmcnt(" #n ")" ::: "memory")
#define PG8_BAR __builtin_amdgcn_s_barrier()
#define PG8_SCHED __builtin_amdgcn_sched_barrier(0)
#define PG8_EXPERT(u) do { if (g.grouped) { int _e = 0; _Pragma("unroll") for (int _k = 1; _k < 8; ++_k) _e += ((u).pm >= g.toff[_k]) ? 1 : 0; (u).e = _e; } } while (0)
    Unit cur, nxt; int ui = 0;
    if (!S.next(0, cur)) return;
    PG8_EXPERT(cur);
    f32x4 acc[2][2][4][2];
#pragma unroll
    for (int a = 0; a < 2; ++a)
#pragma unroll
        for (int b = 0; b < 2; ++b)
#pragma unroll
            for (int m = 0; m < 4; ++m)
#pragma unroll
                for (int n = 0; n < 2; ++n) acc[a][b][m][n] = (f32x4){0.f, 0.f, 0.f, 0.f};
    i32x8 At[4], B0[2], B1[2];
    const char* cA = (const char*)g.A + (size_t)cur.pm * tA; const char* cB = ((const char*)g.Bt + (size_t)cur.e * g.estride * ES) + (size_t)cur.pn * tB;
    PG8_STAGE(PG8_SB(0, 0), cB, voffB); PG8_STAGE(PG8_SA(0, 0), cA, voffA); PG8_STAGE(PG8_SB(0, 1), cB + hB, voffB); PG8_STAGE(PG8_SA(0, 1), cA + hA, voffA);
    if (wr == 1) PG8_BAR;
    PG8_WAIT_V(4); PG8_BAR;
    PG8_STAGE(PG8_SB(1, 0), cB + kstep, voffB); PG8_STAGE(PG8_SA(1, 0), cA + kstep, voffA); PG8_STAGE(PG8_SB(1, 1), cB + hB + kstep, voffB);
    PG8_WAIT_V(6); PG8_BAR;
    for (;;) {
        const bool has_next = S.next(ui + 1, nxt);
        if (has_next) PG8_EXPERT(nxt);
        const char* nA = has_next ? (const char*)g.A + (size_t)nxt.pm * tA : cA; const char* nB = has_next ? ((const char*)g.Bt + (size_t)nxt.e * g.estride * ES) + (size_t)nxt.pn * tB : cB;
        for (int t = 0; t < nt; t += 2) {
            const bool last = (t == nt - 2);
            const char* a1 = cA + (size_t)(t + 1) * kstep;
            const char* a2 = last ? nA : cA + (size_t)(t + 2) * kstep; const char* b2 = last ? nB : cB + (size_t)(t + 2) * kstep;
            const char* a3 = a2 + kstep; const char* b3 = b2 + kstep;
            PG8_LDB(B0, 0, 0); PG8_SCHED; PG8_LDA(At, 0, 0); PG8_STAGE(PG8_SA(1, 1), a1 + hA, voffA);
            PG8_WAIT_L(8); PG8_BAR; PG8_WAIT_L(0); PG8_MMA(0, 0, At, B0); PG8_BAR; PG8_SCHED;
            PG8_LDB(B1, 0, 1); PG8_STAGE(PG8_SB(0, 0), b2, voffB);
            PG8_BAR; PG8_WAIT_L(0); PG8_MMA(0, 1, At, B1); PG8_BAR;
            PG8_LDA(At, 0, 1); PG8_STAGE(PG8_SA(0, 0), a2, voffA);
            PG8_BAR; PG8_WAIT_L(0); PG8_MMA(1, 0, At, B0); PG8_BAR; PG8_SCHED;
            PG8_STAGE(PG8_SB(0, 1), b2 + hB, voffB);
            PG8_WAIT_V(6); PG8_BAR; PG8_MMA(1, 1, At, B1); PG8_BAR;
            PG8_LDB(B0, 1, 0); PG8_SCHED; PG8_LDA(At, 1, 0); PG8_STAGE(PG8_SA(0, 1), a2 + hA, voffA);
            PG8_WAIT_L(8); PG8_BAR; PG8_WAIT_L(0); PG8_MMA(0, 0, At, B0); PG8_BAR; PG8_SCHED;
            PG8_LDB(B1, 1, 1); PG8_STAGE(PG8_SB(1, 0), b3, voffB);
            PG8_BAR; PG8_WAIT_L(0); PG8_MMA(0, 1, At, B1); PG8_BAR;
            PG8_LDA(At, 1, 1); PG8_STAGE(PG8_SA(1, 0), a3, voffA);
            PG8_BAR; PG8_WAIT_L(0); PG8_MMA(1, 0, At, B0); PG8_BAR; PG8_SCHED;
            PG8_STAGE(PG8_SB(1, 1), b3 + hB, voffB);
            PG8_WAIT_V(6); PG8_BAR; PG8_MMA(1, 1, At, B1); PG8_BAR;
        }
        if constexpr (F8) asm volatile("s_nop 15\n\ts_nop 15" ::: "memory");
        E(acc, cur, wr, wc, fr, fq);
        if (!has_next) break;
#pragma unroll
        for (int a = 0; a < 2; ++a)
#pragma unroll
            for (int b = 0; b < 2; ++b)
#pragma unroll
                for (int m = 0; m < 4; ++m)
#pragma unroll
                    for (int n = 0; n < 2; ++n) acc[a][b][m][n] = (f32x4){0.f, 0.f, 0.f, 0.f};
        cur = nxt; cA = nA; cB = nB; ++ui;
    }
    PG8_WAIT_V(0);
    if (wr == 0) PG8_BAR;
    PG8_BAR;
#undef PG8_SA
#undef PG8_SB
#undef PG8_STAGE
#undef PG8_LDA
#undef PG8_LDB
#undef PG8_MMA
#undef PG8_H0
#undef PG8_H1
#undef PG8_LD8
#undef PG8_WAIT_V
#undef PG8_WAIT_L
#undef PG8_BAR
#undef PG8_SCHED
#undef PG8_EXPERT
}
}

__device__ __forceinline__ void gemm_bf16(LAS unsigned char* lds, const pg8::Gemm& g, bf16_t* O, int ldc) { pg8::EpiBf16 E{O, ldc, 1.f}; pg8::gemm_phase(lds, g, E); }
__device__ __forceinline__ void gemm_even_in(LAS unsigned char* lds, const pg8::Gemm& g, const pg8::EpiEvenIn& E) { pg8::gemm_phase(lds, g, E); }
__device__ __forceinline__ void gemm8_even_in(LAS unsigned char* lds, const pg8::Gemm& g, const pg8::EpiEvenIn& E) { pg8::gemm_phase<pg8::EpiEvenIn, true>(lds, g, E); }
__device__ __forceinline__ void gemm8_odd_in(LAS unsigned char* lds, const pg8::Gemm& g, const pg8::EpiOddIn& E) { pg8::gemm_phase<pg8::EpiOddIn, true>(lds, g, E); }
__device__ __forceinline__ void gemm_odd_in(LAS unsigned char* lds, const pg8::Gemm& g, const pg8::EpiOddIn& E) { pg8::gemm_phase(lds, g, E); }
__device__ __forceinline__ void gemm_mla_up(LAS unsigned char* lds, const pg8::Gemm& g, const pg8::EpiMlaUp& E) { pg8::gemm_phase(lds, g, E); }
__device__ __forceinline__ void gemm8_bf16(LAS unsigned char* lds, const pg8::Gemm& g, bf16_t* O, int ldc) { pg8::EpiBf16 E{O, ldc, F8_INV}; pg8::gemm_phase<pg8::EpiBf16, true>(lds, g, E); }
__device__ __forceinline__ void gemm8_swiglu8(LAS unsigned char* lds, const pg8::Gemm& g, unsigned char* O, int ldc) { pg8::EpiSwiGLU8 E{O, ldc, F8_INV}; pg8::gemm_phase<pg8::EpiSwiGLU8, true>(lds, g, E); }
__device__ __forceinline__ void gemm_swiglu(LAS unsigned char* lds, const pg8::Gemm& g, bf16_t* O, int ldc) { pg8::EpiSwiGLU E{O, ldc}; pg8::gemm_phase(lds, g, E); }

namespace att {
#define SBAR() __builtin_amdgcn_sched_barrier(0)
__device__ __forceinline__ int crow(int r, int hi) { return (r & 3) + 8 * (r >> 2) + 4 * hi; }
__device__ __forceinline__ int v_st(int k, int c) { const int kk = (k & ~0xC) | ((k & 4) << 1) | ((k & 8) >> 1); return ((kk >> 3) * 4 + (c >> 5)) * 512 + ((kk & 7) * 32 + (c & 31)) * 2; }
__device__ __forceinline__ int v_st_plain(int k, int c) { return ((k >> 3) * 4 + (c >> 5)) * 512 + ((k & 7) * 32 + (c & 31)) * 2; }
__device__ __forceinline__ int v_rd_base(int lane) { return ((lane & 3) << 3) | (((lane >> 2) & 3) << 6) | (((lane >> 4) & 1) << 5) | (((lane >> 5) & 1) << 8); }
constexpr int v_rd_off(int d0, int ks, int half) { return d0 * 512 + ks * 4096 + half * 2048; }
template <int OFF> __device__ __forceinline__ s16x4 tr_read(unsigned vb) {
    s16x4 r; asm volatile("ds_read_b64_tr_b16 %0, %1 offset:%2" : "=&v"(r) : "v"(vb), "i"(OFF) : "memory"); return r;
}
template <int D0> __device__ __forceinline__ void pv_one(f32x16& od, unsigned vb, bf16x8 pa0, bf16x8 pa1, bf16x8 pa2, bf16x8 pa3) {
    const s16x4 l0 = tr_read<v_rd_off(D0, 0, 0)>(vb), h0 = tr_read<v_rd_off(D0, 0, 1)>(vb), l1 = tr_read<v_rd_off(D0, 1, 0)>(vb), h1 = tr_read<v_rd_off(D0, 1, 1)>(vb);
    const s16x4 l2 = tr_read<v_rd_off(D0, 2, 0)>(vb), h2 = tr_read<v_rd_off(D0, 2, 1)>(vb), l3 = tr_read<v_rd_off(D0, 3, 0)>(vb), h3 = tr_read<v_rd_off(D0, 3, 1)>(vb);
    asm volatile("s_waitcnt lgkmcnt(0)" ::: "memory"); SBAR();
#define PK(L, H) (bf16x8){L[0], L[1], L[2], L[3], H[0], H[1], H[2], H[3]}
    od = __builtin_amdgcn_mfma_f32_32x32x16_bf16(pa0, PK(l0, h0), od, 0, 0, 0);
    od = __builtin_amdgcn_mfma_f32_32x32x16_bf16(pa1, PK(l1, h1), od, 0, 0, 0);
    od = __builtin_amdgcn_mfma_f32_32x32x16_bf16(pa2, PK(l2, h2), od, 0, 0, 0);
    od = __builtin_amdgcn_mfma_f32_32x32x16_bf16(pa3, PK(l3, h3), od, 0, 0, 0);
#undef PK
}
template <int KS, int NO> __device__ __forceinline__ void pv_step(f32x16 (&o)[NO], unsigned vb, bf16x8 pa) {
    s16x4 l[NO], h[NO];
    l[0] = tr_read<v_rd_off(0, KS, 0)>(vb); h[0] = tr_read<v_rd_off(0, KS, 1)>(vb); l[1] = tr_read<v_rd_off(1, KS, 0)>(vb); h[1] = tr_read<v_rd_off(1, KS, 1)>(vb);
    if constexpr (NO == 4) { l[2] = tr_read<v_rd_off(2, KS, 0)>(vb); h[2] = tr_read<v_rd_off(2, KS, 1)>(vb); l[3] = tr_read<v_rd_off(3, KS, 0)>(vb); h[3] = tr_read<v_rd_off(3, KS, 1)>(vb); }
    asm volatile("s_waitcnt lgkmcnt(0)" ::: "memory"); SBAR();
#pragma unroll
    for (int d = 0; d < NO; ++d) o[d] = __builtin_amdgcn_mfma_f32_32x32x16_bf16(pa, (bf16x8){l[d][0], l[d][1], l[d][2], l[d][3], h[d][0], h[d][1], h[d][2], h[d][3]}, o[d], 0, 0, 0);
}
__device__ __forceinline__ void rot4(bf16x8& a, const float* cs, const float* sn) {
    const f32x4 c = *(const f32x4*)cs, s = *(const f32x4*)sn; float o[8];
#pragma unroll
    for (int e = 0; e < 4; ++e) { const float x1 = bf2f((unsigned short)a[e]), x2 = bf2f((unsigned short)a[4 + e]); o[e] = x1 * c[e] - x2 * s[e]; o[4 + e] = x2 * c[e] + x1 * s[e]; }
    u32x4 w = {cvtpk(o[0], o[1]), cvtpk(o[2], o[3]), cvtpk(o[4], o[5]), cvtpk(o[6], o[7])};
    a = *reinterpret_cast<bf16x8*>(&w);
}
struct Args {
    const bf16_t* Q; int ldq, qcol;
    const bf16_t* K; int ldk, kcol;
    const bf16_t* V; int ldv, vcol;
    int q_row0;
    int kctx_row0, klat_row0, nt_ctx, nt_lat;
    float C;
    int rope;
    const float* rcos; const float* rsin;
    bf16_t* O; int ldo, ocol;
    int g, u0; const float* rpb;
    float lam, oscale; const float* subg;
};

template <int DQK, int KW, int DV, int MODE>
__device__ __forceinline__ void attn_unit(LAS unsigned char* lds, const Args& a) {
    constexpr int ND = DQK / 16, NO = DV / 32;
    constexpr int KSTR = KW * 2 + 16, KBUF = 64 * KSTR;
    constexpr int OFF_V = 3 * KBUF, OFF_WS = OFF_V + 3 * 16384, OFF_RPB = OFF_WS + 2048;
    constexpr int KCH = KW / 8, NKCH = 64 * KCH, NKC = (NKCH + 511) / 512;
    constexpr int VCH = DV / 8, NVCH = 64 * VCH, NVC = (NVCH + 511) / 512;
    const int tid = opaque_tid(), wid = __builtin_amdgcn_readfirstlane(tid >> 6), lane = tid & 63, r32 = lane & 31, hi = lane >> 5;
    LAS unsigned char* Kl = lds; LAS unsigned char* Vl = lds + OFF_V;
    LAS float* wsf = (LAS float*)(lds + OFF_WS) + wid * 64; LAS float* li_l = wsf;
    LAS float* rpbl = (LAS float*)(lds + OFF_RPB);
    const int wq = (MODE == 1) ? (wid & 3) : wid, wmap = (MODE == 1) ? (wid >> 2) : 0;
    bf16x8 qr[ND];
    const int qrow = a.q_row0 + wq * 32 + r32;
    {
        const bf16_t* Qw = a.Q + (size_t)qrow * a.ldq + a.qcol + wmap * 64 + hi * 8;
#pragma unroll
        for (int d0 = 0; d0 < ND; ++d0) qr[d0] = *(const bf16x8*)(Qw + d0 * 16);
        if (a.rope == 2) { if constexpr (ND >= 6) { const int s = qrow & (SEQ - 1); rot4(qr[4], a.rcos + s * 16 + 4 * hi, a.rsin + s * 16 + 4 * hi); rot4(qr[5], a.rcos + s * 16 + 8 + 4 * hi, a.rsin + s * 16 + 8 + 4 * hi); } }
#pragma unroll
        for (int d0 = 0; d0 < ND; ++d0) { float f[8];
#pragma unroll
            for (int e = 0; e < 8; ++e) f[e] = bf2f((unsigned short)qr[d0][e]) * a.C;
            u32x4 w = {cvtpk(f[0], f[1]), cvtpk(f[2], f[3]), cvtpk(f[4], f[5]), cvtpk(f[6], f[7])}; qr[d0] = *reinterpret_cast<bf16x8*>(&w); }
    }
    if (MODE == 2) { if (tid < 465) rpbl[tid] = a.rpb[tid] * LOG2E; }
    const int cq = (wid & 1) * 32 + r32, rq = 4 * a.g + (wid >> 1);
    const int rs = min(max(rq - 4, 0), 120), cs_ = min(max(cq - 8, 0), 48);
    int kgo[NKC], klo[NKC], vgo[NVC], vlo[NVC];
#pragma unroll
    for (int i = 0; i < NKC; ++i) { if (i > 0 && KCH == 16) { kgo[i] = kgo[0] + 32 * i * a.ldk; klo[i] = klo[0] + 32 * i * KSTR; } else { const int c = tid + 512 * i, row = c / KCH, ch = c % KCH; kgo[i] = row * a.ldk + ch * 8; klo[i] = row * KSTR + ch * 16; } }
#pragma unroll
    for (int i = 0; i < NVC; ++i) { if (i > 0 && VCH == 16) { vgo[i] = vgo[0] + 32 * i * a.ldv; vlo[i] = vlo[0] + 8192 * i; } else { const int c = tid + 512 * i, row = c / VCH, ch = c % VCH; vgo[i] = row * a.ldv + ch * 8; vlo[i] = v_st_plain(row, ch * 8); } }
    u32x4 ksA[NKC], vsA[NVC];
    const int NT = a.nt_ctx + a.nt_lat;
#define TILE_ROW(j) ((j) < a.nt_ctx ? a.kctx_row0 + 64 * (j) : a.klat_row0 + 64 * ((j) - a.nt_ctx))
#define SLOAD(j) do { const int _r0 = TILE_ROW(j); const bf16_t* _kp = a.K + (size_t)_r0 * a.ldk + a.kcol; const bf16_t* _vp = a.V + (size_t)_r0 * a.ldv + a.vcol; \
    _Pragma("unroll") for (int _i = 0; _i < NKC; ++_i) if ((NKCH % 512 == 0) || tid + 512 * _i < NKCH) ksA[_i] = *(const u32x4*)(_kp + kgo[_i]); \
    _Pragma("unroll") for (int _i = 0; _i < NVC; ++_i) if ((NVCH % 512 == 0) || tid + 512 * _i < NVCH) vsA[_i] = *(const u32x4*)(_vp + vgo[_i]); } while (0)
#define SWRITE(b) do { \
    _Pragma("unroll") for (int _i = 0; _i < NKC; ++_i) if ((NKCH % 512 == 0) || tid + 512 * _i < NKCH) *(LAS u32x4*)(Kl + (b) * KBUF + klo[_i]) = ksA[_i]; \
    _Pragma("unroll") for (int _i = 0; _i < NVC; ++_i) if ((NVCH % 512 == 0) || tid + 512 * _i < NVCH) *(LAS u32x4*)(Vl + (b) * 16384 + vlo[_i]) = vsA[_i]; } while (0)
    float l_reg = 0.f;
    f32x16 o[NO];
#pragma unroll
    for (int d = 0; d < NO; ++d) o[d] = (f32x16){0.f, 0.f, 0.f, 0.f, 0.f, 0.f, 0.f, 0.f, 0.f, 0.f, 0.f, 0.f, 0.f, 0.f, 0.f, 0.f};
    const unsigned vb0 = (unsigned)(size_t)Vl + (unsigned)v_rd_base(lane);
#define QKT(P0, P1, b) do { const LAS unsigned char* _Kb = Kl + (b) * KBUF + wmap * 128; \
    _Pragma("unroll") for (int d0 = 0; d0 < ND; ++d0) { const int cb = (d0 * 16 + hi * 8) * 2; \
        const bf16x8 b0 = *(const LAS bf16x8*)(_Kb + r32 * KSTR + cb), b1 = *(const LAS bf16x8*)(_Kb + (32 + r32) * KSTR + cb); \
        if (d0 == 0) { const f32x16 z16 = {0.f, 0.f, 0.f, 0.f, 0.f, 0.f, 0.f, 0.f, 0.f, 0.f, 0.f, 0.f, 0.f, 0.f, 0.f, 0.f}; P0 = __builtin_amdgcn_mfma_f32_32x32x16_bf16(b0, qr[0], z16, 0, 0, 0); P1 = __builtin_amdgcn_mfma_f32_32x32x16_bf16(b1, qr[0], z16, 0, 0, 0); } \
        else { P0 = __builtin_amdgcn_mfma_f32_32x32x16_bf16(b0, qr[d0], P0, 0, 0, 0); P1 = __builtin_amdgcn_mfma_f32_32x32x16_bf16(b1, qr[d0], P1, 0, 0, 0); } } } while (0)
#define PARTIAL(P0, P1, j) do { \
    if (MODE == 2) { if ((j) >= a.nt_ctx) { const int kr = a.u0 + ((j) - a.nt_ctx); const bool rowok = (kr >= rs) && (kr < rs + 8); const int ro = min(max(kr - rq + 7, 0), 14); const LAS float* brow = rpbl + ro * 31; \
        _Pragma("unroll") for (int r = 0; r < 16; ++r) { \
            { const int ck = crow(r, hi), dd = min(max(ck - cq + 15, 0), 30); const bool inw = rowok && ((unsigned)(ck - cs_) < 16u); const float bv = brow[dd]; P0[r] = inw ? P0[r] + bv : -1e30f; } \
            { const int ck = 32 + crow(r, hi), dd = min(max(ck - cq + 15, 0), 30); const bool inw = rowok && ((unsigned)(ck - cs_) < 16u); const float bv = brow[dd]; P1[r] = inw ? P1[r] + bv : -1e30f; } } } } \
    _Pragma("unroll") for (int r = 0; r < 16; ++r) P0[r] = fast_exp2(P0[r]); } while (0)
#define PK4(P, BASE, OUT) do { u32x4 w = {cvtpk(P[BASE + 0], P[BASE + 1]), cvtpk(P[BASE + 2], P[BASE + 3]), cvtpk(P[BASE + 4], P[BASE + 5]), cvtpk(P[BASE + 6], P[BASE + 7])}; \
    OUT = *reinterpret_cast<bf16x8*>(&w); } while (0)
#define FINISH(P0, P1) do { \
    _Pragma("unroll") for (int r = 0; r < 16; ++r) P1[r] = fast_exp2(P1[r]); \
    float ps = 0.f; \
    _Pragma("unroll") for (int r = 0; r < 16; ++r) ps += P0[r]; \
    _Pragma("unroll") for (int r = 0; r < 16; ++r) ps += P1[r]; \
    l_reg += ps; \
    PK4(P0, 0, pa0); PK4(P0, 8, pa1); PK4(P1, 0, pa2); PK4(P1, 8, pa3); } while (0)
#define PV(b) do { const unsigned _vb = vb0 + (unsigned)(b) * 16384u; \
    pv_step<0, NO>(o, _vb, pa0); pv_step<1, NO>(o, _vb, pa1); pv_step<2, NO>(o, _vb, pa2); pv_step<3, NO>(o, _vb, pa3); } while (0)
    f32x16 pA0, pA1, pB0, pB1; bf16x8 pa0, pa1, pa2, pa3;
    SLOAD(0); SWRITE(0); SLOAD(1); __syncthreads();
    QKT(pA0, pA1, 0); PARTIAL(pA0, pA1, 0);
    SWRITE(1); if (2 < NT) SLOAD(2);
    __syncthreads();
    int bm1 = 0, bj = 1, bn = 2;
    for (int j = 1; j + 1 < NT; j += 2) {
        SBAR(); QKT(pB0, pB1, bj);
        FINISH(pA0, pA1); SBAR();
        PV(bm1); PARTIAL(pB0, pB1, j);
        SBAR(); SWRITE(bn); SLOAD(j + 2);
        __syncthreads();
        SBAR(); QKT(pA0, pA1, bn);
        FINISH(pB0, pB1); SBAR();
        PV(bj); PARTIAL(pA0, pA1, j + 1);
        SBAR(); SWRITE(bm1); if (j + 3 < NT) SLOAD(j + 3);
        __syncthreads();
        { const int t0 = bm1; bm1 = bn; bn = bj; bj = t0; }
    }
    SBAR(); QKT(pB0, pB1, bj);
    FINISH(pA0, pA1); SBAR();
    PV(bm1); PARTIAL(pB0, pB1, NT - 1);
    FINISH(pB0, pB1); SBAR();
    PV(bj);
    __syncthreads();
#undef TILE_ROW
#undef SLOAD
#undef SWRITE
#undef QKT
#undef PARTIAL
#undef PK4
#undef FINISH
#undef PV
    const int tid_e = opaque_tid(), lane_e = tid_e & 63, r32e = lane_e & 31, hie = lane_e >> 5;
    { auto rr = __builtin_amdgcn_permlane32_swap(__float_as_uint(l_reg), __float_as_uint(l_reg), false, false); l_reg = __uint_as_float(rr[0]) + __uint_as_float(rr[1]); }
    if (hie == 0) li_l[r32e] = fmaxf(l_reg, 1e-37f); LDS_WAIT();
    float rli[16];
#pragma unroll
    for (int r = 0; r < 16; ++r) rli[r] = fast_rcp(li_l[crow(r, hie)]);
    if (MODE != 1) {
        bf16_t* Ow = a.O + (size_t)(a.q_row0 + wid * 32) * a.ldo + a.ocol + r32e;
#pragma unroll
        for (int r = 0; r < 16; ++r) { const int orow = crow(r, hie);
#pragma unroll
            for (int d0 = 0; d0 < NO; ++d0) Ow[(size_t)orow * a.ldo + d0 * 32] = f2bf(o[d0][r] * rli[r]); }
    } else {
        LAS float* cb = (LAS float*)lds;
        if (wmap == 1) {
#pragma unroll
            for (int r = 0; r < 16; ++r) { const int row = wq * 32 + crow(r, hie);
#pragma unroll
                for (int d0 = 0; d0 < NO; ++d0) cb[row * 129 + d0 * 32 + r32e] = a.lam * o[d0][r] * rli[r]; }
        }
        __syncthreads();
        if (wmap == 0) {
#pragma unroll
            for (int r = 0; r < 16; ++r) { const int row = wq * 32 + crow(r, hie);
#pragma unroll
                for (int d0 = 0; d0 < NO; ++d0) { const int ix = row * 129 + d0 * 32 + r32e; cb[ix] = o[d0][r] * rli[r] - cb[ix]; } }
        }
        __syncthreads();
        const int row = tid_e >> 2, qd = tid_e & 3;
        float v[32]; float ss = 0.f;
#pragma unroll
        for (int i = 0; i < 32; ++i) { v[i] = cb[row * 129 + qd * 32 + i]; ss += v[i] * v[i]; }
        ss += __shfl_xor(ss, 1); ss += __shfl_xor(ss, 2);
        const float rstd = rsqrtf(ss * (1.f / 128.f) + EPS) * a.oscale;
        bf16_t* Ow = a.O + (size_t)(a.q_row0 + row) * a.ldo + a.ocol + qd * 32;
#pragma unroll
        for (int c = 0; c < 4; ++c) { float w[8];
#pragma unroll
            for (int e = 0; e < 8; ++e) w[e] = v[c * 8 + e] * rstd * a.subg[qd * 32 + c * 8 + e];
            u32x4 pk = {cvtpk(w[0], w[1]), cvtpk(w[2], w[3]), cvtpk(w[4], w[5]), cvtpk(w[6], w[7])};
            *(u32x4*)(Ow + c * 8) = pk; }
    }
    __syncthreads();
}

__device__ __forceinline__ void sgu_unit(LAS unsigned char* lds, const bf16_t* PB, const bf16_t* Wsb, const float* bs, const float* stats, const float* sgain, bf16_t* MIX, int rowbase, int g) {
    const int tid = opaque_tid(), wid = __builtin_amdgcn_readfirstlane(tid >> 6), lane = tid & 63, r32 = lane & 31, hi = lane >> 5;
    LAS unsigned char* Vl = lds;
#pragma unroll 2
    for (int i = 0; i < 4; ++i) { const int c = tid + 512 * i, row = c >> 4, ch = c & 15;
        const u32x4 x = *(const u32x4*)(PB + (size_t)(rowbase + row) * EV_IN + 512 + g * 128 + ch * 8);
        const f32x4* st = (const f32x4*)(stats + (size_t)(rowbase + row) * 16); const f32x4 a0 = st[0], a1 = st[1], a2 = st[2], a3 = st[3];
        const float s1 = ((a0[0] + a0[2]) + (a1[0] + a1[2])) + ((a2[0] + a2[2]) + (a3[0] + a3[2])), s2 = ((a0[1] + a0[3]) + (a1[1] + a1[3])) + ((a2[1] + a2[3]) + (a3[1] + a3[3]));
        const float mean = s1 * (1.f / 512.f), rstd = rsqrtf(fmaxf(s2 * (1.f / 512.f) - mean * mean, 0.f) + EPS);
        const f32x4 g0 = *(const f32x4*)(sgain + g * 128 + ch * 8), g1 = *(const f32x4*)(sgain + g * 128 + ch * 8 + 4);
        u32x4 y; y.x = cvtpk((bflo(x.x) - mean) * rstd * g0[0], (bfhi(x.x) - mean) * rstd * g0[1]); y.y = cvtpk((bflo(x.y) - mean) * rstd * g0[2], (bfhi(x.y) - mean) * rstd * g0[3]);
        y.z = cvtpk((bflo(x.z) - mean) * rstd * g1[0], (bfhi(x.z) - mean) * rstd * g1[1]); y.w = cvtpk((bflo(x.w) - mean) * rstd * g1[2], (bfhi(x.w) - mean) * rstd * g1[3]);
        *(LAS u32x4*)(Vl + (row >> 6) * 16384 + v_st(row & 63, ch * 8)) = y; }
    const int prow = (wid & 3) * 32, dh = wid >> 2;
    bf16x8 pa[2][4];
#pragma unroll
    for (int kt = 0; kt < 2; ++kt)
#pragma unroll
        for (int ks = 0; ks < 4; ++ks) pa[kt][ks] = *(const bf16x8*)(Wsb + (size_t)(g * 128 + prow + r32) * 128 + kt * 64 + ks * 16 + hi * 8);
    __syncthreads();
    f32x16 o[2];
    o[0] = (f32x16){0.f, 0.f, 0.f, 0.f, 0.f, 0.f, 0.f, 0.f, 0.f, 0.f, 0.f, 0.f, 0.f, 0.f, 0.f, 0.f}; o[1] = o[0];
    const unsigned vb0 = (unsigned)(size_t)Vl + (unsigned)v_rd_base(lane);
#pragma unroll
    for (int kt = 0; kt < 2; ++kt) { const unsigned vb = vb0 + kt * 16384u;
        if (dh == 0) { pv_one<0>(o[0], vb, pa[kt][0], pa[kt][1], pa[kt][2], pa[kt][3]); pv_one<1>(o[1], vb, pa[kt][0], pa[kt][1], pa[kt][2], pa[kt][3]); }
        else { pv_one<2>(o[0], vb, pa[kt][0], pa[kt][1], pa[kt][2], pa[kt][3]); pv_one<3>(o[1], vb, pa[kt][0], pa[kt][1], pa[kt][2], pa[kt][3]); } }
#pragma unroll
    for (int r = 0; r < 16; ++r) { const int p = prow + crow(r, hi); const float bias = bs[g * 128 + p];
#pragma unroll
        for (int dd = 0; dd < 2; ++dd) { const int d = (2 * dh + dd) * 32 + r32;
            const float u = bf2f(PB[(size_t)(rowbase + p) * EV_IN + g * 128 + d]);
            MIX[(size_t)(rowbase + p) * DM + g * 128 + d] = f2bf(u * (o[dd][r] + bias)); } }
    __syncthreads();
}
}

struct Params {
    const float* in[31];
    float* out;
    unsigned char* ws;
    int ph_lo, ph_hi;
};

struct Ctx {
    LAS unsigned char* lds;
    int tid, lane, wid, gw, NGW;
};
__device__ __forceinline__ Ctx make_ctx(LAS unsigned char* lds) { const int t = opaque_tid(), w = __builtin_amdgcn_readfirstlane(t >> 6); return Ctx{lds, t, t & 63, w, opaque_bid() * 8 + w, (int)gridDim.x * 8}; }
typedef const __attribute__((address_space(4))) Params KParams;
__device__ __forceinline__ KParams& kparams() { KParams* p = (KParams*)__builtin_amdgcn_kernarg_segment_ptr(); asm volatile("" : "+s"(p)); return *p; }

__device__ __forceinline__ bf16_t* xrow_ptr(KParams& P, int row) { return (bf16_t*)(P.ws + WS_U + U_XB) + (size_t)row * DM; }
__device__ __forceinline__ int mod_r(int row) { return row < NLAT ? (row >> 13) : 4; }
__device__ __forceinline__ f32x4 ld4(const float* p) { return *(const f32x4*)p; }
__device__ __forceinline__ f32x4 ldbf4(const bf16_t* p) { const u32x2 w = *(const u32x2*)p; return (f32x4){bflo(w.x), bfhi(w.x), bflo(w.y), bfhi(w.y)}; }
__device__ __forceinline__ void stbf4(bf16_t* p, f32x4 v) { u32x2 w; w.x = cvtpk(v[0], v[1]); w.y = cvtpk(v[2], v[3]); *(u32x2*)p = w; }
__device__ __forceinline__ float sumsq4(const f32x4 (&v)[4]) { float s = 0.f;
#pragma unroll
    for (int j = 0; j < 4; ++j) s += (v[j][0] * v[j][0] + v[j][1] * v[j][1]) + (v[j][2] * v[j][2] + v[j][3] * v[j][3]);
    return wave_sum(s); }
__device__ __forceinline__ void norm_mod(const f32x4 (&x)[4], f32x4 (&hv)[4], const float* gain, const float* shift, const float* scale, int lane) {
    const float rstd = rsqrtf(sumsq4(x) * (1.f / DM) + EPS);
#pragma unroll
    for (int j = 0; j < 4; ++j) { const int c = 4 * lane + 256 * j; const f32x4 g = ld4(gain + c), sh = ld4(shift + c), sc = ld4(scale + c);
        hv[j] = (x[j] * rstd) * g * (sc + 1.f) + sh; }
}
__device__ __forceinline__ void resid_add(f32x4 (&x)[4], const f32x4 (&y)[4], const float* gain, const float* gate, int lane) {
    const float rstd = rsqrtf(sumsq4(y) * (1.f / DM) + EPS);
#pragma unroll
    for (int j = 0; j < 4; ++j) { const int c = 4 * lane + 256 * j; const f32x4 g = ld4(gain + c), gt = ld4(gate + c);
        x[j] = x[j] + gt * ((y[j] * rstd) * g); }
}

__device__ __forceinline__ void wave_rows(const Ctx& c, int mtok, int& r0, int& r1) {
    const int bid = opaque_bid(); const int rpw = mtok / (int)gridDim.x, base = bid * rpw;
    r0 = base + (c.wid * rpw) / 8; r1 = base + ((c.wid + 1) * rpw) / 8;
    if (bid == (int)gridDim.x - 1 && c.wid == 7) r1 = mtok;
}
__device__ __forceinline__ void ld_gate(f32x4 (&G)[4], const float* gain, const float* gate, int lane) {
#pragma unroll
    for (int j = 0; j < 4; ++j) { const int cc = 4 * lane + 256 * j; G[j] = ld4(gain + cc) * ld4(gate + cc); } }
__device__ __forceinline__ void ld_mod(f32x4 (&A)[4], f32x4 (&B)[4], const float* gain, const float* shift, const float* scale, int lane) {
#pragma unroll
    for (int j = 0; j < 4; ++j) { const int cc = 4 * lane + 256 * j; A[j] = ld4(gain + cc) * (ld4(scale + cc) + 1.f); B[j] = ld4(shift + cc); } }
__device__ __forceinline__ void resid_add2(f32x4 (&x)[4], const f32x4 (&y)[4], const f32x4 (&G)[4]) {
    const float rstd = rsqrtf(sumsq4(y) * (1.f / DM) + EPS);
#pragma unroll
    for (int j = 0; j < 4; ++j) x[j] = x[j] + G[j] * (y[j] * rstd);
}
__device__ __forceinline__ void norm_mod2(const f32x4 (&x)[4], f32x4 (&hv)[4], const f32x4 (&A)[4], const f32x4 (&B)[4]) {
    const float rstd = rsqrtf(sumsq4(x) * (1.f / DM) + EPS);
#pragma unroll
    for (int j = 0; j < 4; ++j) hv[j] = (x[j] * rstd) * A[j] + B[j];
}

__device__ __forceinline__ int perm_row(int pmode, int n) {
    if (pmode == 1) { if (n >= 1024 && n < 2048) { const int d = n & 63, hb = n & ~63; return hb + ((d < 32) ? 8 * (d >> 2) + (d & 3) : 8 * ((d - 32) >> 2) + 4 + (d & 3)); } }
    else if (pmode == 2) { if (n >= 1920 && n < 1952) { const int d = n - 1920; return 1920 + ((d < 16) ? 8 * (d >> 2) + (d & 3) : 8 * ((d - 16) >> 2) + 4 + (d & 3)); } }
    return n;
}
__device__ __forceinline__ void tr_item(const float* W, int ldw, bf16_t* WT, int ldt, int k0, int n0, int drow, LAS float* scr, int lane, int pmode = 0) {
#pragma unroll 8
    for (int i = 0; i < 32; ++i) { const int kk = 2 * i + (lane >> 5); scr[kk * 33 + (lane & 31)] = W[(size_t)(k0 + kk) * ldw + n0 + (lane & 31)]; }
    LDS_WAIT(); asm volatile("" ::: "memory");
    const int c = lane & 7;
#pragma unroll
    for (int j = 0; j < 4; ++j) { const int n = (lane >> 3) + 8 * j; const LAS float* s = scr + (8 * c) * 33 + n;
        u32x4 o; o.x = cvtpk(s[0 * 33], s[1 * 33]); o.y = cvtpk(s[2 * 33], s[3 * 33]); o.z = cvtpk(s[4 * 33], s[5 * 33]); o.w = cvtpk(s[6 * 33], s[7 * 33]);
        const int dr = pmode ? perm_row(pmode, n0 + n) : drow + n;
        *(u32x4*)(WT + (size_t)dr * ldt + k0 + 8 * c) = o; }
    LDS_WAIT(); asm volatile("" ::: "memory");
}
__device__ __forceinline__ void tr_item8(const float* W, int ldw, unsigned char* WT, int ldt, int k0, int n0, int drow, LAS float* scr, int lane, int pmode = 0) {
#pragma unroll 8
    for (int i = 0; i < 32; ++i) { const int kk = 2 * i + (lane >> 5); scr[kk * 33 + (lane & 31)] = W[(size_t)(k0 + kk) * ldw + n0 + (lane & 31)] * F8_W_SCALE; }
    LDS_WAIT(); asm volatile("" ::: "memory");
    const int c = lane & 7;
#pragma unroll
    for (int j = 0; j < 4; ++j) { const int n = (lane >> 3) + 8 * j; const LAS float* s = scr + (8 * c) * 33 + n;
        u32x2 o; o.x = pk4_fp8(s[0 * 33], s[1 * 33], s[2 * 33], s[3 * 33]); o.y = pk4_fp8(s[4 * 33], s[5 * 33], s[6 * 33], s[7 * 33]);
        const int dr = pmode ? perm_row(pmode, n0 + n) : drow + n;
        *(u32x2*)(WT + (size_t)dr * ldt + k0 + 8 * c) = o; }
    LDS_WAIT(); asm volatile("" ::: "memory");
}
__device__ __forceinline__ void tr_matrix8(const Ctx& c, const float* W, int K, int N, unsigned char* WT, int mode, int row_off, int pmode = 0) {
    LAS float* scr = (LAS float*)(c.lds + c.wid * 16384);
    const int nblk = N / 32, nitems = (K / 64) * nblk;
    for (int it = c.gw; it < nitems; it += c.NGW) { const int kb = it / nblk, nb = it % nblk, n0 = 32 * nb;
        const int drow = (mode == 0) ? row_off + n0 : (n0 >> 7) * 256 + (n0 & 127) + (mode == 2 ? 128 : 0);
        tr_item8(W, N, WT, K, 64 * kb, n0, drow, scr, c.lane, pmode); }
}
__device__ __forceinline__ void tr_matrix(const Ctx& c, const float* W, int K, int N, bf16_t* WT, int mode, int row_off, int pmode = 0) {
    LAS float* scr = (LAS float*)(c.lds + c.wid * 16384);
    const int nblk = N / 32, nitems = (K / 64) * nblk;
    for (int it = c.gw; it < nitems; it += c.NGW) { const int kb = it / nblk, nb = it % nblk, n0 = 32 * nb;
        const int drow = (mode == 0) ? row_off + n0 : (n0 >> 7) * 256 + (n0 & 127) + (mode == 2 ? 128 : 0);
        tr_item(W, N, WT, K, 64 * kb, n0, drow, scr, c.lane, pmode); }
}
constexpr int MOE_CVT_ITEMS = 24 * 1792;
__device__ __forceinline__ void convert_moe_items(const Ctx& c, int i, int t0, int t1, int wsel, int nsel) {
    KParams& P = kparams();
    LAS float* scr = (LAS float*)(c.lds + c.wid * 16384);
    if (wsel < 0) return;
    for (int t = t0 + wsel; t < t1; t += nsel) {
        const int mat = t / 1792, r = t % 1792, e = mat / 3, which = mat % 3;
        if (which < 2) {
            const float* W = P.in[28 + which] + ((size_t)i * NEXP + e) * DM * DFFE; const int kb = r / 112, n0 = 32 * (r % 112);
            const int drow = (n0 >> 7) * 256 + (n0 & 127) + which * 128;
#if MOE_F8
            tr_item8(W, DFFE, (unsigned char*)(P.ws + WS_W13M) + (size_t)e * 2 * DFFE * DM, DM, 64 * kb, n0, drow, scr, c.lane);
#else
            tr_item(W, DFFE, (bf16_t*)(P.ws + WS_W13M) + (size_t)e * 2 * DFFE * DM, DM, 64 * kb, n0, drow, scr, c.lane);
#endif
        } else {
            const float* W = P.in[30] + ((size_t)i * NEXP + e) * DFFE * DM; const int kb = r / 32, n0 = 32 * (r % 32);
#if MOE_F8
            tr_item8(W, DM, (unsigned char*)(P.ws + WS_W2M) + (size_t)e * DM * DFFE, DFFE, 64 * kb, n0, n0, scr, c.lane);
#else
            tr_item(W, DM, (bf16_t*)(P.ws + WS_W2M) + (size_t)e * DM * DFFE, DFFE, 64 * kb, n0, n0, scr, c.lane);
#endif
        }
    }
}
__device__ __forceinline__ void prologue0(const Ctx& c_) {
    const Ctx c = make_ctx(c_.lds);
    KParams& P = kparams(); unsigned char* ws = P.ws;
    if (blockIdx.x < 96) {
        LAS float* sl = (LAS float*)c.lds;
        LAS float* part = (LAS float*)(c.lds + 32768);
        for (int i = c.tid; i < 5 * DM; i += 512) { const int r = i >> 10, k = i & 1023; const float x = r < 4 ? P.in[1][r * DM + k] : P.in[3][k]; sl[i] = x / (1.f + expf(-x)); }
        __syncthreads();
        const int t = blockIdx.x, lm = t / 24, cbk = t % 24, n = cbk * 256 + 4 * c.lane;
        const float* W = P.in[4] + (size_t)lm * DM * (NMOD * DM) + n;
        f32x4 acc[5];
#pragma unroll
        for (int r = 0; r < 5; ++r) acc[r] = (f32x4){0.f, 0.f, 0.f, 0.f};
        const int kb = c.wid * 128;
        for (int k0 = 0; k0 < 128; k0 += 8) {
            f32x4 wv[8];
#pragma unroll
            for (int u = 0; u < 8; ++u) wv[u] = ld4(W + (size_t)(kb + k0 + u) * (NMOD * DM));
#pragma unroll
            for (int u = 0; u < 8; ++u)
#pragma unroll
                for (int r = 0; r < 5; ++r) acc[r] += wv[u] * sl[r * DM + kb + k0 + u];
        }
#pragma unroll
        for (int r = 0; r < 5; ++r) *(LAS f32x4*)(part + (c.wid * 5 + r) * 256 + 4 * c.lane) = acc[r];
        __syncthreads();
        for (int i = c.tid; i < 5 * 256; i += 512) { const int r = i >> 8, cc = i & 255; float s = 0.f;
#pragma unroll
            for (int w = 0; w < 8; ++w) s += part[(w * 5 + r) * 256 + cc];
            ((float*)(ws + WS_MODS))[(size_t)(lm * 5 + r) * (NMOD * DM) + cbk * 256 + cc] = s + P.in[5][lm * (NMOD * DM) + cbk * 256 + cc]; }
        __syncthreads();
    }
    for (int i = 0; i < 2; ++i) {
        if (WIN8(2 * i)) tr_matrix8(c, P.in[7] + (size_t)i * DM * EV_IN, DM, EV_IN, (unsigned char*)(ws + WS_WINE) + (size_t)i * EV_IN * DM * 2, 0, 0, 1);
        else tr_matrix(c, P.in[7] + (size_t)i * DM * EV_IN, DM, EV_IN, (bf16_t*)(ws + WS_WINE) + (size_t)i * EV_IN * DM, 0, 0, 1);
        tr_matrix(c, P.in[8] + (size_t)i * DM * DM, DM, DM, (bf16_t*)(ws + WS_WOUTE) + (size_t)i * DM * DM, 0, 0);
        if (FFN8(i)) {
            tr_matrix8(c, P.in[17] + (size_t)i * DM * DFF, DM, DFF, (unsigned char*)(ws + WS_W13E) + (size_t)i * 2 * DFF * DM * 2, 1, 0);
            tr_matrix8(c, P.in[18] + (size_t)i * DM * DFF, DM, DFF, (unsigned char*)(ws + WS_W13E) + (size_t)i * 2 * DFF * DM * 2, 2, 0);
            tr_matrix8(c, P.in[19] + (size_t)i * DFF * DM, DFF, DM, (unsigned char*)(ws + WS_W2E) + (size_t)i * DM * DFF * 2, 0, 0);
        } else {
            tr_matrix(c, P.in[17] + (size_t)i * DM * DFF, DM, DFF, (bf16_t*)(ws + WS_W13E) + (size_t)i * 2 * DFF * DM, 1, 0);
            tr_matrix(c, P.in[18] + (size_t)i * DM * DFF, DM, DFF, (bf16_t*)(ws + WS_W13E) + (size_t)i * 2 * DFF * DM, 2, 0);
            tr_matrix(c, P.in[19] + (size_t)i * DFF * DM, DFF, DM, (bf16_t*)(ws + WS_W2E) + (size_t)i * DM * DFF, 0, 0);
        }
        if (WIN8(2 * i + 1)) tr_matrix8(c, P.in[20] + (size_t)i * DM * OD_IN, DM, OD_IN, (unsigned char*)(ws + WS_WINO) + (size_t)i * OD_INP * DM * 2, 0, 0, 2);
        else tr_matrix(c, P.in[20] + (size_t)i * DM * OD_IN, DM, OD_IN, (bf16_t*)(ws + WS_WINO) + (size_t)i * OD_INP * DM, 0, 0, 2);
        tr_matrix(c, P.in[21] + (size_t)i * DM * DM, DM, DM, (bf16_t*)(ws + WS_WOUTO) + (size_t)i * DM * DM, 0, 0);
    }
    const int gt = blockIdx.x * 512 + c.tid, NGT = gridDim.x * 512;
    for (int i = gt; i < 2 * (OD_INP - OD_IN) * DM; i += NGT) { const int l = i / ((OD_INP - OD_IN) * DM), r = i % ((OD_INP - OD_IN) * DM);
        if (WIN8(2 * l + 1)) ((unsigned char*)(ws + WS_WINO))[(size_t)l * OD_INP * DM * 2 + (size_t)OD_IN * DM + r] = 0;
        else ((bf16_t*)(ws + WS_WINO))[(size_t)l * OD_INP * DM + (size_t)OD_IN * DM + r] = 0; }
    for (int i = gt; i < 2 * MLA_N * MLA_K; i += NGT) { const int l = i / (MLA_N * MLA_K), n = (i / MLA_K) % MLA_N, k = i % MLA_K; float v = 0.f;
        if (n < 384) { if (k < 256) { const int h = n / 96, j = n % 96; int sc = n;
                if (j >= 64) { const int p = j - 64, t = p >> 3, e = p & 7; sc = h * 96 + 64 + ((e < 4) ? 4 * t + e : 16 + 4 * t + (e - 4)); }
                v = P.in[24][((size_t)l * 256 + k) * 384 + sc] * P.in[23][l * 256 + k]; } }
        else if (n < 768) { const int h = (n - 384) / 96, j = (n - 384) % 96;
            if (j < 64) { if (k >= 256 && k < 384) v = P.in[26][((size_t)l * 128 + (k - 256)) * 768 + h * 192 + j] * P.in[25][l * 128 + (k - 256)]; }
            else { if (k == 384 + (j - 64)) v = 1.f; } }
        else { const int h = (n - 768) / 128, j = (n - 768) % 128; if (k >= 256 && k < 384) v = P.in[26][((size_t)l * 128 + (k - 256)) * 768 + h * 192 + 64 + j] * P.in[25][l * 128 + (k - 256)]; }
        ((bf16_t*)(ws + WS_WMLA))[i] = f2bf(v); }
    for (int i = gt; i < 2 * 4 * 128 * 128; i += NGT) ((bf16_t*)(ws + WS_SGUW))[i] = f2bf(P.in[9][i]);
    for (int i = gt; i < SEQ * 32; i += NGT) { const int s = i >> 5, f = i & 31; const int pos = f < 16 ? (s >> 6) : (s & 63);
        const float inv = 1.0f / powf(10000.0f, (float)(f & 15) / 16.0f); const float ang = (float)pos * inv;
        ((float*)(ws + WS_ROPEB))[i] = (float)cos((double)ang); ((float*)(ws + WS_ROPEB))[SEQ * 32 + i] = (float)sin((double)ang); }
    for (int i = gt; i < SEQ * 16; i += NGT) { const int s = i >> 4, f = i & 15; const int pos = f < 8 ? (s >> 6) : (s & 63);
        const float inv = 1.0f / powf(10000.0f, (float)(f & 7) / 8.0f); const float ang = (float)pos * inv;
        ((float*)(ws + WS_ROPED))[i] = (float)cos((double)ang); ((float*)(ws + WS_ROPED))[SEQ * 16 + i] = (float)sin((double)ang); }
}

__device__ __forceinline__ void convert_moe_tail(const Ctx& c_, int i, int t0, int t1, int nunits) {
    const Ctx c = make_ctx(c_.lds);
    const int G = (int)gridDim.x, rem = nunits % G, bid = opaque_bid();
    const int first = rem;
    convert_moe_items(c, i, t0, t1, bid >= first ? (bid - first) * 8 + c.wid : -1, (G - first) * 8);
}

__device__ __forceinline__ void ew_first(const Ctx& c_) {
    const Ctx c = make_ctx(c_.lds);
    KParams& P = kparams(); const float* mods = (const float*)(P.ws + WS_MODS); bf16_t* HB = (bf16_t*)(P.ws + WS_HB);
    int r0, r1; wave_rows(c, MTOT, r0, r1);
    f32x4 A0[4], B0[4]; int rcur = -1;
    for (int row = r0; row < r1; ++row) {
        const float* src = row < NLAT ? P.in[0] + (size_t)row * DM : P.in[2] + (size_t)(row - NLAT) * DM;
        bf16_t* xr = xrow_ptr(P, row); const int r = mod_r(row);
        if (r != rcur) { rcur = r; const float* mb = mods + (size_t)(0 * 5 + r) * (NMOD * DM); ld_mod(A0, B0, P.in[6] + (0 * 4 + 0) * DM, mb + 0 * DM, mb + 1 * DM, c.lane); }
        f32x4 x[4], h[4];
#pragma unroll
        for (int j = 0; j < 4; ++j) { x[j] = ld4(src + 4 * c.lane + 256 * j); stbf4(xr + 4 * c.lane + 256 * j, x[j]); }
        norm_mod2(x, h, A0, B0);
#pragma unroll
        for (int j = 0; j < 4; ++j) stbf4(HB + (size_t)row * DM + 4 * c.lane + 256 * j, h[j]);
    }
}

__device__ __forceinline__ void ew_mid(const Ctx& c_, int l, int mtok, bool dry = false) {
    const Ctx c = make_ctx(c_.lds);
    KParams& P = kparams(); const float* mods = (const float*)(P.ws + WS_MODS); bf16_t* HB = (bf16_t*)(P.ws + WS_HB);
    const bf16_t* YB = (const bf16_t*)(P.ws + WS_U + U_YB);
    const bool odd = (l & 1) != 0; const int li = l >> 1;
    LAS float* wrl = (LAS float*)c.lds;
    if (odd) { for (int i = c.tid; i < DM * NEXP; i += 512) { const int col = i >> 3, e = i & 7; wrl[e * DM + col] = P.in[27][(size_t)li * DM * NEXP + i]; } __syncthreads(); }
    unsigned long long cw = 0ull; int st_e1 = 0, st_e2 = 0, st_l1 = 0, st_l2 = 0; float st_g1 = 0.f; int nrow = 0;
    int r0, r1; wave_rows(c, mtok, r0, r1);
    f32x4 G1[4], A2[4], B2[4]; int rcur = -1;
    u32x2 xa[4], ya[4], xb[4], yb[4];
#define EWM_LOAD(X, Y, rw) do { const int _row = (rw); const bf16_t* _xr = xrow_ptr(P, _row); \
        _Pragma("unroll") for (int j = 0; j < 4; ++j) { X[j] = *(const u32x2*)(_xr + 4 * c.lane + 256 * j); Y[j] = *(const u32x2*)(YB + (size_t)_row * DM + 4 * c.lane + 256 * j); } } while (0)
    if (r0 < r1) EWM_LOAD(xa, ya, r0);
    if (r0 + 1 < r1) EWM_LOAD(xb, yb, r0 + 1);
    for (int row = r0; row < r1; ++row, ++nrow) {
        bf16_t* xr = xrow_ptr(P, row); const int r = mod_r(row);
        if (r != rcur) { rcur = r; const float* mb = mods + (size_t)(l * 5 + r) * (NMOD * DM);
            ld_gate(G1, P.in[6] + (l * 4 + 1) * DM, mb + 2 * DM, c.lane); ld_mod(A2, B2, P.in[6] + (l * 4 + 2) * DM, mb + 3 * DM, mb + 4 * DM, c.lane); }
        f32x4 x[4], y[4], h[4];
#pragma unroll
        for (int j = 0; j < 4; ++j) { x[j] = (f32x4){bflo(xa[j].x), bfhi(xa[j].x), bflo(xa[j].y), bfhi(xa[j].y)}; y[j] = (f32x4){bflo(ya[j].x), bfhi(ya[j].x), bflo(ya[j].y), bfhi(ya[j].y)}; xa[j] = xb[j]; ya[j] = yb[j]; }
        if (row + 2 < r1) EWM_LOAD(xb, yb, row + 2);
        resid_add2(x, y, G1);
        bf16_t* xw = dry ? (bf16_t*)(P.ws + WS_U + U_YS) + (size_t)row * DM : xr; bf16_t* hw = (dry ? (bf16_t*)(P.ws + WS_U + U_PB) : HB) + (size_t)row * DM;
#pragma unroll
        for (int j = 0; j < 4; ++j) stbf4(xw + 4 * c.lane + 256 * j, x[j]);
        norm_mod2(x, h, A2, B2);
        if ((odd && MOE_F8) || (!odd && FFN8(li))) {
            unsigned char* h8 = (unsigned char*)(dry ? (bf16_t*)(P.ws + WS_U + U_PB) : HB) + (size_t)row * DM;
#pragma unroll
            for (int j = 0; j < 4; ++j) *(unsigned*)(h8 + 4 * c.lane + 256 * j) = pk4_fp8(h[j][0] * F8_ACT_SCALE, h[j][1] * F8_ACT_SCALE, h[j][2] * F8_ACT_SCALE, h[j][3] * F8_ACT_SCALE);
        } else {
#pragma unroll
            for (int j = 0; j < 4; ++j) stbf4(hw + 4 * c.lane + 256 * j, h[j]);
        }
        if (odd && !dry) {
            float lg[8];
#pragma unroll
            for (int e = 0; e < 8; ++e) { float sacc = 0.f;
#pragma unroll
                for (int j = 0; j < 4; ++j) { const f32x4 w = *(const LAS f32x4*)(wrl + e * DM + 4 * c.lane + 256 * j); sacc += (h[j][0] * w[0] + h[j][1] * w[1]) + (h[j][2] * w[2] + h[j][3] * w[3]); }
                lg[e] = wave_sum(sacc); }
            int e1 = 0; float v1 = lg[0];
#pragma unroll
            for (int e = 1; e < 8; ++e) if (lg[e] > v1) { v1 = lg[e]; e1 = e; }
            int e2 = -1; float v2 = -3.0e38f;
#pragma unroll
            for (int e = 0; e < 8; ++e) if (e != e1 && lg[e] > v2) { v2 = lg[e]; e2 = e; }
            if (e2 < 0) e2 = (e1 + 1) & 7;
            const float g1 = 1.f / (1.f + expf(v2 - v1));
            const int l1 = (int)((cw >> (8 * e1)) & 0xffull); cw += 1ull << (8 * e1);
            const int l2 = (int)((cw >> (8 * e2)) & 0xffull); cw += 1ull << (8 * e2);
            if (c.lane == nrow) { st_e1 = e1; st_e2 = e2; st_l1 = l1; st_l2 = l2; st_g1 = g1; }
        }
    }
    if (odd && !dry) {
        unsigned* cnt = (unsigned*)(P.ws + WS_CTL) + CW_MOECNT + li * 64;
        int base = 0;
        if (c.lane < 8) { const unsigned wc = (unsigned)((cw >> (8 * c.lane)) & 0xffull); base = wc ? (int)atomicAdd(cnt + c.lane, wc) : 0; }
        const int b1 = __shfl(base, st_e1), b2 = __shfl(base, st_e2);
        if (c.lane < nrow) { const int row = r0 + c.lane; int4* ti = (int4*)(P.ws + WS_TOKINFO) + (size_t)row * 2;
            ti[0] = make_int4(st_e1, b1 + st_l1, st_e2, b2 + st_l2); ti[1] = make_int4(__float_as_int(st_g1), __float_as_int(1.f - st_g1), 0, 0); }
        __syncthreads();
    }
#undef EWM_LOAD
}

__device__ __forceinline__ void moe_offsets(KParams& P, int li, int (&toff)[9]) {
    const unsigned* cnt = (const unsigned*)(P.ws + WS_CTL) + CW_MOECNT + li * 64; int acc = 0;
#pragma unroll
    for (int e = 0; e < 8; ++e) { toff[e] = acc; const unsigned n = __builtin_amdgcn_readfirstlane(__hip_atomic_load(cnt + e, __ATOMIC_RELAXED, __HIP_MEMORY_SCOPE_AGENT)); acc += (int)((n + 255u) >> 8); }
    toff[8] = acc;
}
__device__ __forceinline__ void moe_gather(const Ctx& c_, int li, int mtok) {
    const Ctx c = make_ctx(c_.lds);
    KParams& P = kparams(); int toff[9]; moe_offsets(P, li, toff);
    int tv = 0;
#pragma unroll
    for (int e = 0; e < 8; ++e) tv = (c.lane == e) ? toff[e] : tv;
    const bf16_t* HB = (const bf16_t*)(P.ws + WS_HB); bf16_t* HS = (bf16_t*)(P.ws + WS_U + U_YS);
    int r0, r1; wave_rows(c, mtok, r0, r1);
    for (int row = r0; row < r1; ++row) {
        const int4* ti = (const int4*)(P.ws + WS_TOKINFO) + (size_t)row * 2; const int4 a = ti[0], b = ti[1];
        const int pA = __shfl(tv, a.x) * 256 + a.y, pB = __shfl(tv, a.z) * 256 + a.w;
        if (c.lane == 0) ((int4*)(P.ws + WS_TOKPOS))[row] = make_int4(pA, pB, b.x, b.y);
#if MOE_F8
        const u32x4 v0 = ((const u32x4*)((const unsigned char*)HB + (size_t)row * DM))[c.lane];
        ((u32x4*)((unsigned char*)HS + (size_t)pA * DM))[c.lane] = v0; ((u32x4*)((unsigned char*)HS + (size_t)pB * DM))[c.lane] = v0;
#else
        const u32x4* src = (const u32x4*)(HB + (size_t)row * DM); const u32x4 v0 = src[c.lane], v1 = src[64 + c.lane];
        u32x4* dA = (u32x4*)(HS + (size_t)pA * DM); u32x4* dB = (u32x4*)(HS + (size_t)pB * DM);
        dA[c.lane] = v0; dA[64 + c.lane] = v1; dB[c.lane] = v0; dB[64 + c.lane] = v1;
#endif
    }
}

__device__ __forceinline__ void ew_last(const Ctx& c_, int l, int mtok, bool dry = false) {
    const Ctx c = make_ctx(c_.lds);
    KParams& P = kparams(); const float* mods = (const float*)(P.ws + WS_MODS); bf16_t* HB = (bf16_t*)(P.ws + WS_HB);
    const bf16_t* YS = (const bf16_t*)(P.ws + WS_U + U_YS); const bool odd = (l & 1) != 0;
    int r0, r1; wave_rows(c, mtok, r0, r1);
    f32x4 G3[4], A0[4], B0[4]; int rcur = -1;
    u32x2 xa[4], ya[4], za[4], xb[4], yb[4], zb[4]; float gAa = 0.f, gBa = 0.f, gAb = 0.f, gBb = 0.f;
#define EWL_LOAD(X, Y, Z, GA, GB, rw) do { const int _row = (rw); const bf16_t* _xr = xrow_ptr(P, _row); \
        if (odd) { const int4 tp = ((const int4*)(P.ws + WS_TOKPOS))[_row]; GA = __int_as_float(tp.z); GB = __int_as_float(tp.w); \
            _Pragma("unroll") for (int j = 0; j < 4; ++j) { Y[j] = *(const u32x2*)(YS + (size_t)tp.x * DM + 4 * c.lane + 256 * j); Z[j] = *(const u32x2*)(YS + (size_t)tp.y * DM + 4 * c.lane + 256 * j); } } \
        else { _Pragma("unroll") for (int j = 0; j < 4; ++j) Y[j] = *(const u32x2*)(YS + (size_t)_row * DM + 4 * c.lane + 256 * j); } \
        _Pragma("unroll") for (int j = 0; j < 4; ++j) X[j] = *(const u32x2*)(_xr + 4 * c.lane + 256 * j); } while (0)
    if (r0 < r1) EWL_LOAD(xa, ya, za, gAa, gBa, r0);
    if (r0 + 1 < r1) EWL_LOAD(xb, yb, zb, gAb, gBb, r0 + 1);
    for (int row = r0; row < r1; ++row) {
        bf16_t* xr = xrow_ptr(P, row); const int r = mod_r(row);
        if (r != rcur) { rcur = r; const float* mb = mods + (size_t)(l * 5 + r) * (NMOD * DM);
            ld_gate(G3, P.in[6] + (l * 4 + 3) * DM, mb + 5 * DM, c.lane);
            if (l < 3) { const float* mn = mods + (size_t)((l + 1) * 5 + r) * (NMOD * DM); ld_mod(A0, B0, P.in[6] + ((l + 1) * 4 + 0) * DM, mn + 0 * DM, mn + 1 * DM, c.lane); } }
        f32x4 x[4], y[4], h[4];
#pragma unroll
        for (int j = 0; j < 4; ++j) { x[j] = (f32x4){bflo(xa[j].x), bfhi(xa[j].x), bflo(xa[j].y), bfhi(xa[j].y)};
            y[j] = (f32x4){bflo(ya[j].x), bfhi(ya[j].x), bflo(ya[j].y), bfhi(ya[j].y)};
            if (odd) y[j] = y[j] * gAa + (f32x4){bflo(za[j].x), bfhi(za[j].x), bflo(za[j].y), bfhi(za[j].y)} * gBa;
            xa[j] = xb[j]; ya[j] = yb[j]; za[j] = zb[j]; }
        gAa = gAb; gBa = gBb;
        if (row + 2 < r1) EWL_LOAD(xb, yb, zb, gAb, gBb, row + 2);
        resid_add2(x, y, G3);
        bf16_t* hw = (dry ? (bf16_t*)(P.ws + WS_U + U_MIX) : HB) + (size_t)row * DM;
        if (l == 3 && !dry) { float* ow = P.out + (size_t)row * DM;
#pragma unroll
            for (int j = 0; j < 4; ++j) *(f32x4*)(ow + 4 * c.lane + 256 * j) = x[j]; }
        else { bf16_t* xw = dry ? (bf16_t*)(P.ws + WS_U + U_PB) + (size_t)row * DM : xr;
#pragma unroll
            for (int j = 0; j < 4; ++j) stbf4(xw + 4 * c.lane + 256 * j, x[j]); }
        if (l < 3) { norm_mod2(x, h, A0, B0);
            if (WIN8(l + 1)) { unsigned char* h8 = (unsigned char*)(dry ? (bf16_t*)(P.ws + WS_U + U_MIX) : HB) + (size_t)row * DM;
#pragma unroll
                for (int j = 0; j < 4; ++j) *(unsigned*)(h8 + 4 * c.lane + 256 * j) = pk4_fp8(h[j][0] * F8_ACT_SCALE, h[j][1] * F8_ACT_SCALE, h[j][2] * F8_ACT_SCALE, h[j][3] * F8_ACT_SCALE); }
            else {
#pragma unroll
                for (int j = 0; j < 4; ++j) stbf4(hw + 4 * c.lane + 256 * j, h[j]); } }
    }
#undef EWL_LOAD
}

__device__ __forceinline__ void attn_even(const Ctx& c_, int l) {
    const Ctx c = make_ctx(c_.lds);
    KParams& P = kparams(); const int i = l >> 1; const bool need_ctx = l < 3;
    const bf16_t* PB = (const bf16_t*)(P.ws + WS_U + U_PB); bf16_t* MIX = (bf16_t*)(P.ws + WS_U + U_MIX);
    const int nchunk = need_ctx ? 264 : 256;
    for (int u = opaque_bid(); u < nchunk * 4; u += gridDim.x) att::sgu_unit(c.lds, PB, (const bf16_t*)(P.ws + WS_SGUW) + (size_t)i * 4 * 128 * 128, P.in[10] + i * 512, (const float*)(P.ws + WS_STATS), P.in[11] + i * 512, MIX, (u >> 2) * 128, u & 3);
    float d1 = 0.f, d2 = 0.f;
    if (c.lane < 64) { d1 = P.in[12][i * 64 + c.lane] * P.in[13][i * 64 + c.lane]; d2 = P.in[14][i * 64 + c.lane] * P.in[15][i * 64 + c.lane]; }
    const float lam_init = 0.8f - 0.6f * expf(-0.3f * (float)l);
    const float lam = expf(wave_sum(d1)) - expf(wave_sum(d2)) + lam_init;
    att::Args a;
    a.Q = PB; a.ldq = EV_IN; a.K = PB; a.ldk = EV_IN; a.V = PB; a.ldv = EV_IN; a.C = 0.125f * LOG2E;
    a.rcos = (const float*)(P.ws + WS_ROPEB); a.rsin = a.rcos + SEQ * 32; a.O = MIX; a.ldo = DM; a.g = 0; a.u0 = 0; a.rpb = nullptr;
    a.lam = lam; a.oscale = 1.f - lam_init; a.subg = P.in[16] + i * 128; a.nt_ctx = 4;
    const int nctxu = need_ctx ? 32 : 0, nu = nctxu + 1024;
    for (int u = xcd_unit_base(); u < nu; u += gridDim.x) {
        int b, h;
        if (u < nctxu) { b = u >> 3; h = (u >> 1) & 3; a.q_row0 = NLAT + b * CTXL + (u & 1) * 128; a.nt_lat = 0; a.rope = 0; }
        else { const int v = u - nctxu; b = v >> 8; h = (v >> 6) & 3; a.q_row0 = b * SEQ + (v & 63) * 128; a.nt_lat = SEQ / 64; a.rope = 0; }
        a.qcol = 1024 + h * 128; a.kcol = 1536 + h * 128; a.vcol = 2048 + h * 128; a.ocol = 512 + h * 128;
        a.kctx_row0 = NLAT + b * CTXL; a.klat_row0 = b * SEQ;
        att::attn_unit<64, 128, 128, 1>(c.lds, a);
    }
}
__device__ __forceinline__ void attn_odd_na(const Ctx& c_, int l) {
    const Ctx c = make_ctx(c_.lds);
    KParams& P = kparams(); const int i = l >> 1; const bool need_ctx = l < 3;
    const bf16_t* PB = (const bf16_t*)(P.ws + WS_U + U_PB); bf16_t* MIX = (bf16_t*)(P.ws + WS_U + U_MIX);
    att::Args a;
    a.Q = PB; a.ldq = OD_INP; a.K = PB; a.ldk = OD_INP; a.V = PB; a.ldv = OD_INP; a.C = 0.125f * LOG2E; a.rope = 0; a.rcos = nullptr; a.rsin = nullptr;
    a.O = MIX; a.ldo = DM; a.lam = 0.f; a.oscale = 1.f; a.subg = nullptr; a.nt_ctx = 4;
    const int nctxu = need_ctx ? 32 : 0, nu = nctxu + 1024;
    for (int u = xcd_unit_base(); u < nu; u += gridDim.x) {
        int b, h;
        if (u < nctxu) { b = u >> 3; h = u & 7; a.q_row0 = NLAT + b * CTXL; a.nt_lat = 0; a.g = 0; a.u0 = 0; a.klat_row0 = 0; }
        else { const int v = u - nctxu; b = v >> 8; h = (v >> 5) & 7; const int g = v & 31; a.g = g; a.u0 = min(max(4 * g - 4, 0), 116);
            a.q_row0 = b * SEQ + g * 256; a.nt_lat = 12; a.klat_row0 = b * SEQ + a.u0 * 64; }
        a.qcol = h * 64; a.kcol = 512 + h * 64; a.vcol = 1024 + h * 64; a.ocol = h * 64; a.kctx_row0 = NLAT + b * CTXL;
        a.rpb = P.in[22] + ((size_t)i * 8 + h) * 465;
        att::attn_unit<64, 64, 64, 2>(c.lds, a);
    }
}
__device__ __forceinline__ void attn_odd_mla(const Ctx& c_, int l) {
    const Ctx c = make_ctx(c_.lds);
    KParams& P = kparams(); const bool need_ctx = l < 3;
    const bf16_t* MO = (const bf16_t*)(P.ws + WS_U + U_MLAO); bf16_t* MIX = (bf16_t*)(P.ws + WS_U + U_MIX);
    att::Args a;
    a.Q = MO; a.ldq = MLA_N; a.K = MO; a.ldk = MLA_N; a.V = MO; a.ldv = MLA_N; a.C = 0.10206207261596575f * LOG2E;
    a.rcos = (const float*)(P.ws + WS_ROPED); a.rsin = a.rcos + SEQ * 16; a.O = MIX; a.ldo = DM; a.g = 0; a.u0 = 0; a.rpb = nullptr; a.lam = 0.f; a.oscale = 1.f; a.subg = nullptr; a.nt_ctx = 4;
    const int nctxu = need_ctx ? 16 : 0, nu = nctxu + 512;
    for (int u = xcd_unit_base(); u < nu; u += gridDim.x) {
        int b, h;
        if (u < nctxu) { b = u >> 2; h = u & 3; a.q_row0 = NLAT + b * CTXL; a.nt_lat = 0; a.rope = 0; }
        else { const int v = u - nctxu; b = v >> 7; h = (v >> 5) & 3; a.q_row0 = b * SEQ + (v & 31) * 256; a.nt_lat = SEQ / 64; a.rope = 2; }
        a.qcol = h * 96; a.kcol = 384 + h * 96; a.vcol = 768 + h * 128; a.ocol = 512 + h * 128; a.kctx_row0 = NLAT + b * CTXL; a.klat_row0 = b * SEQ;
        att::attn_unit<96, 96, 128, 0>(c.lds, a);
    }
}

constexpr int N_PHASES = 2 + 2 * (7 + 9);
__global__ void __launch_bounds__(512, 2) fwd_kernel(Params prm) {
    extern __shared__ __attribute__((aligned(16))) unsigned char lds_raw[];
    LAS unsigned char* lds = (LAS unsigned char*)lds_raw;
    const Ctx c{lds, 0, 0, 0, 0, 0};
    for (int u = threadIdx.x; u < (LDS_BYTES - LDS_MISC) / 4; u += 512) ((LAS unsigned*)(lds + LDS_MISC))[u] = 0u;
    __syncthreads();
    XcdBarrier bar;
    { unsigned char* ws0 = kparams().ws; bar.bar = (unsigned*)(ws0 + WS_CTL) + CW_BAR; bar.x = 0; bar.st = nullptr;
#if !MK_PER_PHASE
      bar = xcd_barrier_post((unsigned*)(ws0 + WS_CTL) + CW_BAR, (volatile LAS unsigned*)(lds + LDS_MISC + 32));
#endif
    }
    int ph = 0;
#ifndef PMASK
#define PMASK 0xffffffffu
#endif
#define PM(b) ((PMASK >> (b)) & 1u)
#define PH_ON() (ph >= kparams().ph_lo && ph < kparams().ph_hi)
#define PH_END() do { if (ph >= kparams().ph_lo && ph + 1 < kparams().ph_hi) xcd_barrier(bar); ++ph; } while (0)
#define WSP(off) ((bf16_t*)(ws + (off)))
#define HB WSP(WS_HB)
#define PB WSP(WS_U + U_PB)
#define MIX WSP(WS_U + U_MIX)
#define YB WSP(WS_U + U_YB)
#define HID WSP(WS_U + U_HID)
#define YS WSP(WS_U + U_YS)
#define A2 WSP(WS_U + U_A2)
#define MO WSP(WS_U + U_MLAO)

    if (PM(0) && PH_ON()) for (int rep = 0; rep < DUPN(0); ++rep) { prologue0(c); __syncthreads(); }
    PH_END();
    if (PM(1) && PH_ON()) for (int rep = 0; rep < DUPN(1); ++rep) ew_first(c);
    PH_END();
    for (int lp = 0; lp < 2; ++lp) {
        {
            const int l = 2 * lp, i = lp; const int mtok = l < 3 ? MTOT : NLAT, nMt = mtok / 256;
            if (PM(2) && PH_ON()) for (int rep = 0; rep < DUPN(2); ++rep) { unsigned char* ws = kparams().ws; pg8::Gemm g{}; g.A = HB; g.lda = DM; g.Bt = (const unsigned char*)(ws + WS_WINE) + (size_t)i * EV_IN * DM * 2; g.K = DM; g.nM = MTOT / 256; g.nN = EV_IN / 256; g.grouped = 0; g.estride = 0;
                pg8::EpiEvenIn E{PB, EV_IN, (f32x2*)(ws + WS_STATS), (const float*)(ws + WS_ROPEB), (const float*)(ws + WS_ROPEB) + SEQ * 32, WIN8(l) ? F8_INV : 1.f}; if (WIN8(l)) gemm8_even_in(lds, g, E); else gemm_even_in(lds, g, E); if (rep == 0) convert_moe_tail(c, i, 0, 7296, (MTOT / 256) * (EV_IN / 256)); }
            PH_END();
            if (PM(4) && PH_ON()) for (int rep = 0; rep < DUPN(4); ++rep) attn_even(c, l);
            PH_END();
            if (PM(5) && PH_ON()) for (int rep = 0; rep < DUPN(5); ++rep) { unsigned char* ws = kparams().ws; pg8::Gemm g{}; g.A = MIX; g.lda = DM; g.Bt = (const bf16_t*)(ws + WS_WOUTE) + (size_t)i * DM * DM; g.K = DM; g.nM = nMt; g.nN = DM / 256; g.grouped = 0; g.estride = 0;
                gemm_bf16(lds, g, YB, DM); if (rep == 0) convert_moe_tail(c, i, 7296, 14592, nMt * (DM / 256)); }
            PH_END();
            if (PM(6) && PH_ON()) { if (DUPN(6) > 1) ew_mid(c, l, mtok, true); ew_mid(c, l, mtok); }
            PH_END();
            if (PM(7) && PH_ON()) for (int rep = 0; rep < DUPN(7); ++rep) { unsigned char* ws = kparams().ws; pg8::Gemm g{}; g.A = HB; g.lda = DM; g.Bt = (const unsigned char*)(ws + WS_W13E) + (size_t)i * 2 * DFF * DM * 2; g.K = DM; g.nM = nMt; g.nN = 2 * DFF / 256; g.grouped = 0; g.estride = 0;
                if (FFN8(i)) gemm8_swiglu8(lds, g, (unsigned char*)HID, DFF); else gemm_swiglu(lds, g, HID, DFF);
                if (rep == 0) convert_moe_tail(c, i, 14592, 20224, nMt * (2 * DFF / 256)); }
            PH_END();
            if (PM(8) && PH_ON()) for (int rep = 0; rep < DUPN(8); ++rep) { unsigned char* ws = kparams().ws; pg8::Gemm g{}; g.A = HID; g.lda = DFF; g.Bt = (const unsigned char*)(ws + WS_W2E) + (size_t)i * DM * DFF * 2; g.K = DFF; g.nM = nMt; g.nN = DM / 256; g.grouped = 0; g.estride = 0;
                if (FFN8(i)) gemm8_bf16(lds, g, YS, DM); else gemm_bf16(lds, g, YS, DM);
                if (rep == 0) convert_moe_tail(c, i, 20224, MOE_CVT_ITEMS, nMt * (DM / 256)); }
            PH_END();
            if (PM(9) && PH_ON()) { if (DUPN(9) > 1) ew_last(c, l, mtok, true); ew_last(c, l, mtok); }
            PH_END();
        }
        {
            const int l = 2 * lp + 1, i = lp; const int mtok = l < 3 ? MTOT : NLAT, nMt = mtok / 256;
            if (PM(10) && PH_ON()) for (int rep = 0; rep < DUPN(10); ++rep) { unsigned char* ws = kparams().ws; pg8::Gemm g{}; g.A = HB; g.lda = DM; g.Bt = (const unsigned char*)(ws + WS_WINO) + (size_t)i * OD_INP * DM * 2; g.K = DM; g.nM = MTOT / 256; g.nN = OD_INP / 256; g.grouped = 0; g.estride = 0;
                pg8::EpiOddIn E{PB, OD_INP, (float*)(ws + WS_STATS), (const float*)(ws + WS_ROPED), (const float*)(ws + WS_ROPED) + SEQ * 16, WIN8(l) ? F8_INV : 1.f}; if (WIN8(l)) gemm8_odd_in(lds, g, E); else gemm_odd_in(lds, g, E); }
            PH_END();
            if (PM(12) && PH_ON()) for (int rep = 0; rep < DUPN(12); ++rep) { unsigned char* ws = kparams().ws; pg8::Gemm g{}; g.A = PB + 1536; g.lda = OD_INP; g.Bt = (const bf16_t*)(ws + WS_WMLA) + (size_t)i * MLA_N * MLA_K; g.K = MLA_K; g.nM = MTOT / 256; g.nN = MLA_N / 256; g.grouped = 0; g.estride = 0;
                pg8::EpiMlaUp E{MO, MLA_N, (const float*)(ws + WS_STATS)}; gemm_mla_up(lds, g, E); }
            PH_END();
            if (PH_ON()) { if (PM(13)) for (int rep = 0; rep < DUPN(13); ++rep) attn_odd_na(c, l); if (PM(14)) for (int rep = 0; rep < DUPN(14); ++rep) attn_odd_mla(c, l); }
            PH_END();
            if (PM(15) && PH_ON()) for (int rep = 0; rep < DUPN(15); ++rep) { unsigned char* ws = kparams().ws; pg8::Gemm g{}; g.A = MIX; g.lda = DM; g.Bt = (const bf16_t*)(ws + WS_WOUTO) + (size_t)i * DM * DM; g.K = DM; g.nM = nMt; g.nN = DM / 256; g.grouped = 0; g.estride = 0;
                gemm_bf16(lds, g, YB, DM); }
            PH_END();
            if (PM(16) && PH_ON()) { if (DUPN(16) > 1) ew_mid(c, l, mtok, true); ew_mid(c, l, mtok); }
            PH_END();
            if (PM(17) && PH_ON()) for (int rep = 0; rep < DUPN(17); ++rep) moe_gather(c, i, mtok);
            PH_END();
            if (PM(18) && PH_ON()) for (int rep = 0; rep < DUPN(18); ++rep) { unsigned char* ws = kparams().ws; pg8::Gemm g{}; g.A = YS; g.lda = DM; g.Bt = (const bf16_t*)(ws + WS_W13M); g.K = DM; g.nN = 2 * DFFE / 256; g.grouped = 1; g.estride = (size_t)2 * DFFE * DM;
                moe_offsets(kparams(), i, g.toff); g.nM = g.toff[8];
#if MOE_F8
                gemm8_swiglu8(lds, g, (unsigned char*)HID, DFFE);
#else
                gemm_swiglu(lds, g, HID, DFFE);
#endif
            }
            PH_END();
            if (PM(19) && PH_ON()) for (int rep = 0; rep < DUPN(19); ++rep) { unsigned char* ws = kparams().ws; pg8::Gemm g{}; g.A = HID; g.lda = DFFE; g.Bt = (const bf16_t*)(ws + WS_W2M); g.K = DFFE; g.nN = DM / 256; g.grouped = 1; g.estride = (size_t)DM * DFFE;
                moe_offsets(kparams(), i, g.toff); g.nM = g.toff[8];
#if MOE_F8
                gemm8_bf16(lds, g, YS, DM);
#else
                gemm_bf16(lds, g, YS, DM);
#endif
            }
            PH_END();
            if (PM(20) && PH_ON()) { if (DUPN(20) > 1) ew_last(c, l, mtok, true); ew_last(c, l, mtok); }
            PH_END();
        }
    }
#undef PH_ON
#undef PH_END
#undef HB
#undef PB
#undef MIX
#undef YB
#undef HID
#undef YS
#undef A2
#undef MO
}

extern "C" void kernel_launch(void* const* d_in, const int* in_sizes, int n_in, void* d_out, int out_size, void* d_ws, size_t ws_size, hipStream_t stream) {
    static int grid = 0;
    if (grid == 0) {
        int dev = 0, cus = 0;
        if (n_in != 31 || out_size != NLAT * DM || ws_size < WS_END) { fprintf(stderr, "kernel_launch: unexpected shapes or workspace (n_in %d out %d ws %zu need %zu)\n", n_in, out_size, ws_size, (size_t)WS_END); grid = -1; }
        else if (hipGetDevice(&dev) != hipSuccess || hipDeviceGetAttribute(&cus, hipDeviceAttributeMultiprocessorCount, dev) != hipSuccess) grid = -1;
        else if (hipFuncSetAttribute((const void*)fwd_kernel, hipFuncAttributeMaxDynamicSharedMemorySize, LDS_BYTES) != hipSuccess) grid = -1;
        else { int per_cu = 0; (void)hipOccupancyMaxActiveBlocksPerMultiprocessor(&per_cu, (const void*)fwd_kernel, 512, LDS_BYTES); (void)hipGetLastError(); grid = cus; }
    }
    if (grid < 0) { (void)hipMemsetAsync(d_out, 0, (size_t)out_size * 4, stream); return; }
    (void)hipMemsetAsync((char*)d_ws + WS_CTL, 0, CTL_BYTES, stream);
    Params p{};
    for (int i = 0; i < 31; ++i) p.in[i] = (const float*)d_in[i];
    p.out = (float*)d_out; p.ws = (unsigned char*)d_ws;
#if MK_PER_PHASE
    for (int k = 0; k < N_PHASES; ++k) { p.ph_lo = k; p.ph_hi = k + 1; hipLaunchKernelGGL(fwd_kernel, dim3(grid), dim3(512), LDS_BYTES, stream, p); }
#else
    p.ph_lo = 0; p.ph_hi = N_PHASES;
    hipLaunchKernelGGL(fwd_kernel, dim3(grid), dim3(512), LDS_BYTES, stream, p);
#endif
}
```

```cpp
#include <hip/hip_runtime.h>
#include <stdint.h>
#include <stdio.h>

#ifndef MK_PER_PHASE
#define MK_PER_PHASE 0
#endif
#ifndef DUP_MASK
#define DUP_MASK 0u
#endif
#define DUPN(b) (1 + (int)((DUP_MASK >> (b)) & 1u))
#ifndef FFN_F8
#define FFN_F8 1
#endif
#ifndef FFN_F8_FROM
#define FFN_F8_FROM 1
#endif
#define FFN8(i) (FFN_F8 && (i) >= FFN_F8_FROM)
#ifndef WIN_F8_FROM
#define WIN_F8_FROM 2
#endif
#define WIN8(l) ((l) >= WIN_F8_FROM)
#ifndef MOE_F8
#define MOE_F8 1
#endif

#define LAS __attribute__((address_space(3)))
typedef unsigned short bf16_t;
typedef short bf16x8 __attribute__((ext_vector_type(8)));
typedef short s16x4 __attribute__((ext_vector_type(4)));
typedef float f32x4 __attribute__((ext_vector_type(4)));
typedef float f32x2 __attribute__((ext_vector_type(2)));
typedef float f32x16 __attribute__((ext_vector_type(16)));
typedef unsigned u32x4 __attribute__((ext_vector_type(4)));
typedef unsigned u32x2 __attribute__((ext_vector_type(2)));

constexpr int DM = 1024, NB = 4, SEQ = 8192, NLAT = NB * SEQ, CTXL = 256, NCTX = NB * CTXL, MTOT = NLAT + NCTX;
constexpr int NMOD = 6;
constexpr int EV_IN = 2560, OD_IN = 1952, OD_INP = 2048, DFF = 2816, DFFE = 3584, NEXP = 8;
constexpr int MLA_N = 1280, MLA_K = 512;
constexpr int MS_MAX = 2 * MTOT + NEXP * 256;
constexpr float EPS = 1e-6f;
constexpr float LOG2E = 1.4426950408889634f;

constexpr size_t MiB = (size_t)1 << 20;
constexpr size_t WS_CTL = 0, CTL_BYTES = MiB;
constexpr size_t WS_MODS = 1 * MiB;
constexpr size_t WS_ROPEB = 2 * MiB;
constexpr size_t WS_ROPED = 4 * MiB;
constexpr size_t WS_SGUW = 5 * MiB;
constexpr size_t WS_TOKINFO = 6 * MiB;
constexpr size_t WS_TOKPOS = 8 * MiB;
constexpr size_t WS_CTXX = 10 * MiB;
constexpr size_t WS_WMLA = 14 * MiB;
constexpr size_t WS_WINE = 17 * MiB;
constexpr size_t WS_WOUTE = 27 * MiB;
constexpr size_t WS_W13E = 31 * MiB;
constexpr size_t WS_W2E = 53 * MiB;
constexpr size_t WS_WINO = 64 * MiB;
constexpr size_t WS_WOUTO = 72 * MiB;
constexpr size_t WS_W13M = 76 * MiB;
constexpr size_t WS_W2M = 188 * MiB;
constexpr size_t WS_HB = 244 * MiB;
constexpr size_t WS_U = 310 * MiB;
constexpr size_t U_PB = 0;
constexpr size_t U_MIX = 165 * MiB;
constexpr size_t U_A2 = 231 * MiB;
constexpr size_t U_MLAO = 264 * MiB;
constexpr size_t U_YB = 347 * MiB;
constexpr size_t U_HID = 0;
constexpr size_t U_XB = 549 * MiB;
constexpr size_t U_YS = 413 * MiB;
constexpr size_t WS_STATS = WS_U + 616 * MiB;
constexpr size_t WS_END = WS_STATS + 4 * MiB;
static_assert((size_t)MS_MAX * DFFE * (MOE_F8 ? 1 : 2) <= 347 * MiB && (size_t)MTOT * DFF * 2 <= 347 * MiB, "hid must stay clear of YB");
static_assert(U_YS + (size_t)MS_MAX * DM * 2 <= U_XB && U_XB + (size_t)MTOT * DM * 2 <= 616 * MiB, "ys / xb fit");

constexpr int CW_BAR = 4096;
constexpr int CW_MOECNT = 1024;

constexpr int LDS_BYTES = 147456;
constexpr int LDS_MISC = 131072;

__device__ __forceinline__ unsigned cvtpk(float lo, float hi) { unsigned r; asm volatile("v_cvt_pk_bf16_f32 %0, %1, %2" : "=v"(r) : "v"(lo), "v"(hi)); return r; }
__device__ __forceinline__ float bf2f(unsigned short b) { return __uint_as_float(((unsigned)b) << 16); }
__device__ __forceinline__ float bflo(unsigned w) { return __uint_as_float(w << 16); }
__device__ __forceinline__ float bfhi(unsigned w) { return __uint_as_float(w & 0xffff0000u); }
__device__ __forceinline__ bf16_t f2bf(float f) { return (bf16_t)(cvtpk(f, 0.f) & 0xffffu); }
typedef int i32x8 __attribute__((ext_vector_type(8)));
typedef int i32x4 __attribute__((ext_vector_type(4)));
constexpr float F8_ACT_SCALE = 4.f, F8_W_SCALE = 64.f, F8_INV = 1.f / (F8_ACT_SCALE * F8_W_SCALE);
__device__ __forceinline__ unsigned pk4_fp8(float a, float b, float c, float d) {
    a = __builtin_amdgcn_fmed3f(a, -448.f, 448.f); b = __builtin_amdgcn_fmed3f(b, -448.f, 448.f); c = __builtin_amdgcn_fmed3f(c, -448.f, 448.f); d = __builtin_amdgcn_fmed3f(d, -448.f, 448.f);
    int w = 0; w = __builtin_amdgcn_cvt_pk_fp8_f32(a, b, w, false); w = __builtin_amdgcn_cvt_pk_fp8_f32(c, d, w, true); return (unsigned)w; }
__device__ __forceinline__ float wave_sum(float v) {
#pragma unroll
    for (int o = 1; o < 64; o <<= 1) v += __shfl_xor(v, o);
    return v;
}
__device__ __forceinline__ float fast_exp2(float x) { return __builtin_amdgcn_exp2f(x); }
__device__ __forceinline__ float fast_rcp(float x) { return __builtin_amdgcn_rcpf(x); }
__device__ __forceinline__ float silu_f(float x) { return x * fast_rcp(1.f + fast_exp2(-x * LOG2E)); }
__device__ __forceinline__ float gelu_tanh_f(float x) { const float u = 0.7978845608028654f * (x + 0.044715f * x * x * x); return x * fast_rcp(1.f + fast_exp2(-2.f * LOG2E * u)); }
#define LDS_WAIT() asm volatile("s_waitcnt lgkmcnt(0)" ::: "memory")
#define VM_WAIT() asm volatile("s_waitcnt vmcnt(0)" ::: "memory")
__device__ __forceinline__ int opaque_bid() { int b = blockIdx.x; asm volatile("" : "+s"(b)); return b; }
__device__ __forceinline__ int xcd_unit_base() { const int b = opaque_bid(), G = (int)gridDim.x; return (G % 8 == 0) ? (b & 7) * (G >> 3) + (b >> 3) : b; }
__device__ __forceinline__ int opaque_tid() { int t = threadIdx.x; asm volatile("" : "+v"(t)); return t; }

#define XB_TMO      128
#define XB_XCNT(j)  (256  + 64 * (j))
#define XB_XSUB(j)  (1280 + 64 * (j))
#define XB_XGEN(j)  (2304 + 64 * (j))
#define XB_TOP      3328
#define XB_TOPGEN   3392
#define XCD_BAR_WORDS 3456
#define XB_SPIN_CAP (1u << 22)
__device__ __forceinline__ unsigned xb_ld(unsigned* p)              { return __hip_atomic_load(p, __ATOMIC_RELAXED, __HIP_MEMORY_SCOPE_AGENT); }
__device__ __forceinline__ unsigned xb_add(unsigned* p, unsigned v) { return __hip_atomic_fetch_add(p, v, __ATOMIC_RELAXED, __HIP_MEMORY_SCOPE_AGENT); }
__device__ __forceinline__ unsigned xb_xcc_id() { return (unsigned)__builtin_amdgcn_s_getreg((3 << 11) | 20) & 0xFu; }
#define XB_SPIN(cond, bar) do { unsigned _sp = 0; while (cond) { __builtin_amdgcn_s_sleep(1); \
    if ((++_sp & 255u) == 0u) { if (xb_ld(&(bar)[XB_TMO])) break; if (_sp > XB_SPIN_CAP) { atomicAdd(&(bar)[XB_TMO], 1u); break; } } } } while (0)
struct XcdBarrier { unsigned* bar; unsigned x; volatile LAS unsigned* st; };
__device__ __forceinline__ XcdBarrier xcd_barrier_post(unsigned* bar, volatile LAS unsigned* st) {
    XcdBarrier b; b.bar = bar; b.x = xb_xcc_id(); b.st = st;
    if (threadIdx.x == 0) (void)xb_add(&bar[XB_XCNT(b.x)], 1u);
    return b;
}
__device__ __forceinline__ void xcd_barrier_complete(unsigned* bar, unsigned x, unsigned& nloc, unsigned& nx) {
    const unsigned G = gridDim.x * gridDim.y * gridDim.z;
    unsigned sum, cnt, mine, sp = 0u;
    for (;;) {
        sum = 0u; cnt = 0u; mine = 0u;
#pragma unroll
        for (unsigned j = 0; j < 16; ++j) { const unsigned c = xb_ld(&bar[XB_XCNT(j)]); sum += c; cnt += (c > 0u) ? 1u : 0u; mine = (j == x) ? c : mine; }
        if (sum == G) break;
        __builtin_amdgcn_s_sleep(1);
        if ((++sp & 255u) == 0u) { if (xb_ld(&bar[XB_TMO])) break; if (sp > XB_SPIN_CAP) { atomicAdd(&bar[XB_TMO], 1u); break; } }
    }
    nloc = mine > 0u ? mine : 1u; nx = cnt > 0u ? cnt : 1u;
}
__device__ __forceinline__ void xcd_barrier(const XcdBarrier& b) {
    asm volatile("s_waitcnt vmcnt(0)" ::: "memory");
    __syncthreads();
    if (threadIdx.x == 0) {
        unsigned* bar = b.bar;
        __builtin_amdgcn_s_waitcnt(0);
        unsigned nloc = b.st[0], nx = b.st[1];
        if (nloc == 0u) { xcd_barrier_complete(bar, b.x, nloc, nx); b.st[0] = nloc; b.st[1] = nx; }
        const unsigned old = xb_add(&bar[XB_XSUB(b.x)], 1u);
        const unsigned gen = old / nloc;
        if (old + 1u == (gen + 1u) * nloc) {
            __builtin_amdgcn_fence(__ATOMIC_RELEASE, "agent");
            asm volatile("s_waitcnt vmcnt(0)" ::: "memory");
            const unsigned og = xb_add(&bar[XB_TOP], 1u);
            const unsigned tg = og / nx;
            if (og + 1u == (tg + 1u) * nx) xb_add(&bar[XB_TOPGEN], 1u);
            else XB_SPIN(xb_ld(&bar[XB_TOPGEN]) == tg, bar);
            __builtin_amdgcn_fence(__ATOMIC_ACQUIRE, "agent");
            xb_add(&bar[XB_XGEN(b.x)], 1u);
            asm volatile("s_waitcnt vmcnt(0)" ::: "memory");
        } else {
            XB_SPIN(xb_ld(&bar[XB_XGEN(b.x)]) == gen, bar);
            __builtin_amdgcn_fence(__ATOMIC_ACQUIRE, "agent");
            asm volatile("s_waitcnt vmcnt(0)" ::: "memory");
        }
    }
    __syncthreads();
}

namespace pg8 {
constexpr int BM = 256, BK = 64, HALF = 128, HTB = HALF * BK * 2, STAGE_BYTES = 8 * HTB, NXCD = 8, WGM = 8;
__device__ __forceinline__ int lds_byte(int r, int c) { const int st = (r >> 4) * 2 + (c >> 5), rr = r & 15, cc = c & 31, ob = rr * 64 + cc * 2; return st * 1024 + (ob ^ (((ob >> 9) & 1) << 5)); }
__device__ __forceinline__ void stage_rc(int b, int& R, int& C) { const int st = b / 1024, sb = b % 1024, swz = sb ^ (((sb >> 9) & 1) << 5); R = (st >> 1) * 16 + swz / 64; C = (st & 1) * 32 + (swz % 64) / 2; }
__device__ __forceinline__ int perm32(int rho) { const int n = rho >> 4, i = rho & 15; return 8 * (i >> 2) + 4 * n + (i & 3); }
struct Unit { int pm, pn, e; };
struct Gemm {
    const void* A; int lda;
    const void* Bt; int K;
    int nM, nN;
    int grouped; int toff[9]; size_t estride;
};
struct StaticOrder {
    int nM, nN, nwg, G, c;
    __device__ void init(int nM_, int nN_, int G_, int c_) { nM = nM_; nN = nN_; nwg = nM * nN; G = G_; c = c_; }
    __device__ __forceinline__ bool next(int i, Unit& u) const {
        const long L = (long)i * G + c; if (L >= nwg) return false;
        int wgid = (int)L; { const int q = nwg / NXCD, r = nwg % NXCD, xcd = wgid % NXCD, off = wgid / NXCD; wgid = (xcd < r ? xcd * (q + 1) : r * (q + 1) + (xcd - r) * q) + off; }
        const int nig = WGM * nN, gid = wgid / nig, fm = gid * WGM, gsz = (nM - fm) < WGM ? (nM - fm) : WGM;
        u.pm = fm + ((wgid % nig) % gsz); u.pn = (wgid % nig) / gsz; u.e = 0; return true;
    }
};
struct EpiBf16 {
    bf16_t* O; int ldc; float scale;
    __device__ __forceinline__ void operator()(const f32x4 (&acc)[2][2][4][2], const Unit& u, int wr, int wc, int fr, int fq) const {
        const int row0 = u.pm * BM + wr * 64 + fr, col0 = u.pn * BM + wc * 32 + 8 * fq;
#pragma unroll
        for (int ai = 0; ai < 2; ++ai)
#pragma unroll
            for (int m = 0; m < 4; ++m) { bf16_t* rowp = O + (size_t)(row0 + ai * HALF + m * 16) * ldc + col0;
#pragma unroll
                for (int bj = 0; bj < 2; ++bj) { const f32x4 v0 = acc[ai][bj][m][0] * scale, v1 = acc[ai][bj][m][1] * scale;
                    u32x4 w; w.x = cvtpk(v0[0], v0[1]); w.y = cvtpk(v0[2], v0[3]); w.z = cvtpk(v1[0], v1[1]); w.w = cvtpk(v1[2], v1[3]);
                    *(u32x4*)(rowp + bj * HALF) = w; } }
    }
};
__device__ __forceinline__ f32x4 swiglu4(f32x4 a, f32x4 b, float k1, float k2) {
    const f32x4 t = a * k1; f32x4 d;
#pragma unroll
    for (int j = 0; j < 4; ++j) d[j] = fast_exp2(t[j]);
    d = d + 1.f; f32x4 r;
#pragma unroll
    for (int j = 0; j < 4; ++j) r[j] = fast_rcp(d[j]);
    return (a * b) * (r * k2);
}
struct EpiSwiGLU {
    bf16_t* O; int ldc;
    __device__ __forceinline__ void operator()(const f32x4 (&acc)[2][2][4][2], const Unit& u, int wr, int wc, int fr, int fq) const {
        const int row0 = u.pm * BM + wr * 64 + fr, col0 = u.pn * HALF + wc * 32 + 8 * fq;
#pragma unroll
        for (int ai = 0; ai < 2; ++ai)
#pragma unroll
            for (int m = 0; m < 4; ++m) { bf16_t* rowp = O + (size_t)(row0 + ai * HALF + m * 16) * ldc + col0;
                const f32x4 r0 = swiglu4(acc[ai][0][m][0], acc[ai][1][m][0], -LOG2E, 1.f), r1 = swiglu4(acc[ai][0][m][1], acc[ai][1][m][1], -LOG2E, 1.f);
                u32x4 w; w.x = cvtpk(r0[0], r0[1]); w.y = cvtpk(r0[2], r0[3]); w.z = cvtpk(r1[0], r1[1]); w.w = cvtpk(r1[2], r1[3]);
                *(u32x4*)rowp = w; }
    }
};

struct EpiEvenIn {
    bf16_t* O; int ldc; f32x2* stats; const float* rcos; const float* rsin; float scale;
    __device__ __forceinline__ void operator()(const f32x4 (&acc)[2][2][4][2], const Unit& u, int wr, int wc, int fr, int fq) const {
        int upm = u.pm, upn = u.pn; asm volatile("" : "+s"(upm), "+s"(upn));
        const int row0 = upm * BM + wr * 64 + fr, col0 = upn * BM + wc * 32 + 8 * fq;
        const int kind = upn < 2 ? 0 : (upn < 4 ? 1 : (upn < 8 ? 2 : 3)); const bool lat = upm < NLAT / BM; const int t4 = 4 * (4 * (wc & 1) + fq);
#pragma unroll
        for (int ai = 0; ai < 2; ++ai)
#pragma unroll
            for (int m = 0; m < 4; ++m) { const int row = row0 + ai * HALF + m * 16; bf16_t* rowp = O + (size_t)row * ldc + col0;
                f32x4 cs = {1.f, 1.f, 1.f, 1.f}, sn = {0.f, 0.f, 0.f, 0.f}; float s1 = 0.f, s2 = 0.f;
                if (kind == 2 && lat) { const int sp = row & (SEQ - 1); cs = *(const f32x4*)(rcos + sp * 32 + t4); sn = *(const f32x4*)(rsin + sp * 32 + t4); }
#pragma unroll
                for (int bj = 0; bj < 2; ++bj) { f32x4 v0 = acc[ai][bj][m][0] * scale, v1 = acc[ai][bj][m][1] * scale;
                    if (kind < 2) {
#pragma unroll
                        for (int j = 0; j < 4; ++j) { v0[j] = gelu_tanh_f(v0[j]); v1[j] = gelu_tanh_f(v1[j]); }
                        if (kind == 1) { s1 += (v0[0] + v0[1]) + (v0[2] + v0[3]) + (v1[0] + v1[1]) + (v1[2] + v1[3]);
                            s2 += (v0[0] * v0[0] + v0[1] * v0[1]) + (v0[2] * v0[2] + v0[3] * v0[3]) + (v1[0] * v1[0] + v1[1] * v1[1]) + (v1[2] * v1[2] + v1[3] * v1[3]); } }
                    else if (kind == 2) { const f32x4 o0 = v0 * cs - v1 * sn, o1 = v1 * cs + v0 * sn; v0 = o0; v1 = o1; }
                    u32x4 w; w.x = cvtpk(v0[0], v0[1]); w.y = cvtpk(v0[2], v0[3]); w.z = cvtpk(v1[0], v1[1]); w.w = cvtpk(v1[2], v1[3]);
                    *(u32x4*)(rowp + bj * HALF) = w; }
                if (kind == 1) { s1 += __shfl_xor(s1, 16); s1 += __shfl_xor(s1, 32); s2 += __shfl_xor(s2, 16); s2 += __shfl_xor(s2, 32);
                    if (fq == 0) stats[(size_t)row * 8 + (upn - 2) * 4 + wc] = (f32x2){s1, s2}; } }
    }
};
struct EpiOddIn {
    bf16_t* O; int ldc; float* stats; const float* rcos; const float* rsin; float scale;
    __device__ __forceinline__ void operator()(const f32x4 (&acc)[2][2][4][2], const Unit& u, int wr, int wc, int fr, int fq) const {
        int upm = u.pm, upn = u.pn; asm volatile("" : "+s"(upm), "+s"(upn));
        const int row0 = upm * BM + wr * 64 + fr, col0 = upn * BM + wc * 32 + 8 * fq; const bool lat = upm < NLAT / BM;
#pragma unroll
        for (int ai = 0; ai < 2; ++ai)
#pragma unroll
            for (int m = 0; m < 4; ++m) { const int row = row0 + ai * HALF + m * 16; bf16_t* rowp = O + (size_t)row * ldc + col0; float ss = 0.f;
#pragma unroll
                for (int bj = 0; bj < 2; ++bj) { f32x4 v0 = acc[ai][bj][m][0] * scale, v1 = acc[ai][bj][m][1] * scale;
                    if (upn == 6 || (upn == 7 && bj == 0)) ss += (v0[0] * v0[0] + v0[1] * v0[1]) + (v0[2] * v0[2] + v0[3] * v0[3]) + (v1[0] * v1[0] + v1[1] * v1[1]) + (v1[2] * v1[2] + v1[3] * v1[3]);
                    if (upn == 7 && bj == 1 && wc == 0 && lat) { const int sp = row & (SEQ - 1); const f32x4 cs = *(const f32x4*)(rcos + sp * 16 + 4 * fq), sn = *(const f32x4*)(rsin + sp * 16 + 4 * fq);
                        const f32x4 o0 = v0 * cs - v1 * sn, o1 = v1 * cs + v0 * sn; v0 = o0; v1 = o1; }
                    u32x4 w; w.x = cvtpk(v0[0], v0[1]); w.y = cvtpk(v0[2], v0[3]); w.z = cvtpk(v1[0], v1[1]); w.w = cvtpk(v1[2], v1[3]);
                    *(u32x4*)(rowp + bj * HALF) = w; }
                if (upn >= 6) { ss += __shfl_xor(ss, 16); ss += __shfl_xor(ss, 32); if (fq == 0) stats[(size_t)row * 8 + (upn - 6) * 4 + wc] = ss; } }
    }
};
struct EpiMlaUp {
    bf16_t* O; int ldc; const float* stats;
    __device__ __forceinline__ void operator()(const f32x4 (&acc)[2][2][4][2], const Unit& u, int wr, int wc, int fr, int fq) const {
        const int row0 = u.pm * BM + wr * 64 + fr, col0 = u.pn * BM + wc * 32 + 8 * fq;
#pragma unroll
        for (int ai = 0; ai < 2; ++ai)
#pragma unroll
            for (int m = 0; m < 4; ++m) { const int row = row0 + ai * HALF + m * 16; bf16_t* rowp = O + (size_t)row * ldc + col0;
                const f32x4 pq = *(const f32x4*)(stats + (size_t)row * 8), pk = *(const f32x4*)(stats + (size_t)row * 8 + 4);
                const float rq = rsqrtf(((pq[0] + pq[1]) + (pq[2] + pq[3])) * (1.f / 256.f) + EPS), rk = rsqrtf(((pk[0] + pk[1]) + (pk[2] + pk[3])) * (1.f / 128.f) + EPS);
#pragma unroll
                for (int bj = 0; bj < 2; ++bj) { const int c0 = col0 + bj * HALF; const float sc = c0 < 384 ? rq : (c0 < 768 ? (((c0 - 384) % 96) < 64 ? rk : 1.f) : rk);
                    const f32x4 v0 = acc[ai][bj][m][0] * sc, v1 = acc[ai][bj][m][1] * sc;
                    u32x4 w; w.x = cvtpk(v0[0], v0[1]); w.y = cvtpk(v0[2], v0[3]); w.z = cvtpk(v1[0], v1[1]); w.w = cvtpk(v1[2], v1[3]);
                    *(u32x4*)(rowp + bj * HALF) = w; } }
    }
};
struct EpiSwiGLU8 {
    unsigned char* O; int ldc; float scale;
    __device__ __forceinline__ void operator()(const f32x4 (&acc)[2][2][4][2], const Unit& u, int wr, int wc, int fr, int fq) const {
        const int row0 = u.pm * BM + wr * 64 + fr, col0 = u.pn * HALF + wc * 32 + 8 * fq;
#pragma unroll
        for (int ai = 0; ai < 2; ++ai)
#pragma unroll
            for (int m = 0; m < 4; ++m) { unsigned char* rowp = O + (size_t)(row0 + ai * HALF + m * 16) * ldc + col0;
                const float k1 = -LOG2E * scale, k2 = F8_ACT_SCALE * scale * scale;
                const f32x4 r0 = swiglu4(acc[ai][0][m][0], acc[ai][1][m][0], k1, k2), r1 = swiglu4(acc[ai][0][m][1], acc[ai][1][m][1], k1, k2);
                u32x2 w; w.x = pk4_fp8(r0[0], r0[1], r0[2], r0[3]); w.y = pk4_fp8(r1[0], r1[1], r1[2], r1[3]);
                *(u32x2*)rowp = w; }
    }
};

template <class Epi, bool F8 = false>
__device__ __forceinline__ void gemm_phase(LAS unsigned char* lds, const Gemm& g, const Epi& E) {
    const int tid = opaque_tid(), wid = __builtin_amdgcn_readfirstlane(tid >> 6), lane = tid & 63, wr = wid >> 2, wc = wid & 3, fr = lane & 15, fq = lane >> 4;
    constexpr int ES = F8 ? 1 : 2;
    const int K = g.K, nt = K * ES / (BK * 2), lda = g.lda;
    StaticOrder S; S.init(g.nM, g.nN, (int)gridDim.x, opaque_bid());
    unsigned voffA[2], voffB[2];
#pragma unroll
    for (int i = 0; i < 2; ++i) { int R, C; stage_rc(tid * 16 + i * 8192, R, C); const int Rb = (R & ~31) + perm32(R & 31);
        voffA[i] = (unsigned)(R * lda * ES + C * 2); voffB[i] = (unsigned)(Rb * K * ES + C * 2); }
    const size_t kstep = (size_t)(BK * 2);
    const size_t hA = (size_t)HALF * lda * ES, tA = 2 * hA, hB = (size_t)HALF * K * ES, tB = 2 * hB;
    const unsigned ldsw = (unsigned)wid * 1024u;
    const int aoff = lds_byte(wr * 64 + fr, fq * 8), boff = lds_byte(wc * 32 + fr, fq * 8);
#define PG8_SA(b, h) (((b) * 2 + (h)) * HTB)
#define PG8_SB(b, h) ((4 + (b) * 2 + (h)) * HTB)
#define PG8_STAGE(bufoff, gbase, voff) do { _Pragma("unroll") for (int _i = 0; _i < 2; ++_i) \
        __builtin_amdgcn_global_load_lds((const unsigned*)((const char*)(gbase) + (voff)[_i]), (LAS unsigned*)(lds + (bufoff) + ldsw + _i * 8192), 16, 0, 0); } while (0)
#define PG8_LD8(base) __builtin_shufflevector(*(const LAS i32x4*)(base), *(const LAS i32x4*)((base) + 1024), 0, 1, 2, 3, 4, 5, 6, 7)
#define PG8_LDA(dst, b, h) do { _Pragma("unroll") for (int m = 0; m < 4; ++m) dst[m] = PG8_LD8(lds + PG8_SA(b, h) + aoff + m * 2048); } while (0)
#define PG8_LDB(dst, b, h) do { _Pragma("unroll") for (int n = 0; n < 2; ++n) dst[n] = PG8_LD8(lds + PG8_SB(b, h) + boff + n * 2048); } while (0)
#define PG8_H0(x) __builtin_bit_cast(bf16x8, __builtin_shufflevector(x, x, 0, 1, 2, 3))
#define PG8_H1(x) __builtin_bit_cast(bf16x8, __builtin_shufflevector(x, x, 4, 5, 6, 7))
#define PG8_MMA(ai, bj, At, Bt) do { __builtin_amdgcn_s_setprio(1); _Pragma("unroll") for (int m = 0; m < 4; ++m) _Pragma("unroll") for (int n = 0; n < 2; ++n) { \
        if constexpr (F8) asm volatile("v_mfma_f32_16x16x128_f8f6f4 %0, %1, %2, %0" : "+v"(acc[ai][bj][m][n]) : "v"(Bt[n]), "v"(At[m])); \
        else { acc[ai][bj][m][n] = __builtin_amdgcn_mfma_f32_16x16x32_bf16(PG8_H0(Bt[n]), PG8_H0(At[m]), acc[ai][bj][m][n], 0, 0, 0); \
               acc[ai][bj][m][n] = __builtin_amdgcn_mfma_f32_16x16x32_bf16(PG8_H1(Bt[n]), PG8_H1(At[m]), acc[ai][bj][m][n], 0, 0, 0); } } \
        __builtin_amdgcn_s_setprio(0); } while (0)
#define PG8_WAIT_V(n) asm volatile("s_waitcnt vmcnt(" #n ")" ::: "memory")
#define PG8_WAIT_L(n) asm volatile("s_waitcnt lgkmcnt(" #n ")" ::: "memory")
#define PG8_BAR __builtin_amdgcn_s_barrier()
#define PG8_SCHED __builtin_amdgcn_sched_barrier(0)
#define PG8_EXPERT(u) do { if (g.grouped) { int _e = 0; _Pragma("unroll") for (int _k = 1; _k < 8; ++_k) _e += ((u).pm >= g.toff[_k]) ? 1 : 0; (u).e = _e; } } while (0)
    Unit cur, nxt; int ui = 0;
    if (!S.next(0, cur)) return;
    PG8_EXPERT(cur);
    f32x4 acc[2][2][4][2];
#pragma unroll
    for (int a = 0; a < 2; ++a)
#pragma unroll
        for (int b = 0; b < 2; ++b)
#pragma unroll
            for (int m = 0; m < 4; ++m)
#pragma unroll
                for (int n = 0; n < 2; ++n) acc[a][b][m][n] = (f32x4){0.f, 0.f, 0.f, 0.f};
    i32x8 At[4], B0[2], B1[2];
    const char* cA = (const char*)g.A + (size_t)cur.pm * tA; const char* cB = ((const char*)g.Bt + (size_t)cur.e * g.estride * ES) + (size_t)cur.pn * tB;
    PG8_STAGE(PG8_SB(0, 0), cB, voffB); PG8_STAGE(PG8_SA(0, 0), cA, voffA); PG8_STAGE(PG8_SB(0, 1), cB + hB, voffB); PG8_STAGE(PG8_SA(0, 1), cA + hA, voffA);
    if (wr == 1) PG8_BAR;
    PG8_WAIT_V(4); PG8_BAR;
    PG8_STAGE(PG8_SB(1, 0), cB + kstep, voffB); PG8_STAGE(PG8_SA(1, 0), cA + kstep, voffA); PG8_STAGE(PG8_SB(1, 1), cB + hB + kstep, voffB);
    PG8_WAIT_V(6); PG8_BAR;
    for (;;) {
        const bool has_next = S.next(ui + 1, nxt);
        if (has_next) PG8_EXPERT(nxt);
        const char* nA = has_next ? (const char*)g.A + (size_t)nxt.pm * tA : cA; const char* nB = has_next ? ((const char*)g.Bt + (size_t)nxt.e * g.estride * ES) + (size_t)nxt.pn * tB : cB;
        for (int t = 0; t < nt; t += 2) {
            const bool last = (t == nt - 2);
            const char* a1 = cA + (size_t)(t + 1) * kstep;
            const char* a2 = last ? nA : cA + (size_t)(t + 2) * kstep; const char* b2 = last ? nB : cB + (size_t)(t + 2) * kstep;
            const char* a3 = a2 + kstep; const char* b3 = b2 + kstep;
            PG8_LDB(B0, 0, 0); PG8_SCHED; PG8_LDA(At, 0, 0); PG8_STAGE(PG8_SA(1, 1), a1 + hA, voffA);
            PG8_WAIT_L(8); PG8_BAR; PG8_WAIT_L(0); PG8_MMA(0, 0, At, B0); PG8_BAR; PG8_SCHED;
            PG8_LDB(B1, 0, 1); PG8_STAGE(PG8_SB(0, 0), b2, voffB);
            PG8_BAR; PG8_WAIT_L(0); PG8_MMA(0, 1, At, B1); PG8_BAR;
            PG8_LDA(At, 0, 1); PG8_STAGE(PG8_SA(0, 0), a2, voffA);
            PG8_BAR; PG8_WAIT_L(0); PG8_MMA(1, 0, At, B0); PG8_BAR; PG8_SCHED;
            PG8_STAGE(PG8_SB(0, 1), b2 + hB, voffB);
            PG8_WAIT_V(6); PG8_BAR; PG8_MMA(1, 1, At, B1); PG8_BAR;
            PG8_LDB(B0, 1, 0); PG8_SCHED; PG8_LDA(At, 1, 0); PG8_STAGE(PG8_SA(0, 1), a2 + hA, voffA);
            PG8_WAIT_L(8); PG8_BAR; PG8_WAIT_L(0); PG8_MMA(0, 0, At, B0); PG8_BAR; PG8_SCHED;
            PG8_LDB(B1, 1, 1); PG8_STAGE(PG8_SB(1, 0), b3, voffB);
            PG8_BAR; PG8_WAIT_L(0); PG8_MMA(0, 1, At, B1); PG8_BAR;
            PG8_LDA(At, 1, 1); PG8_STAGE(PG8_SA(1, 0), a3, voffA);
            PG8_BAR; PG8_WAIT_L(0); PG8_MMA(1, 0, At, B0); PG8_BAR; PG8_SCHED;
            PG8_STAGE(PG8_SB(1, 1), b3 + hB, voffB);
            PG8_WAIT_V(6); PG8_BAR; PG8_MMA(1, 1, At, B1); PG8_BAR;
        }
        if constexpr (F8) asm volatile("s_nop 15\n\ts_nop 15" ::: "memory");
        E(acc, cur, wr, wc, fr, fq);
        if (!has_next) break;
#pragma unroll
        for (int a = 0; a < 2; ++a)
#pragma unroll
            for (int b = 0; b < 2; ++b)
#pragma unroll
                for (int m = 0; m < 4; ++m)
#pragma unroll
                    for (int n = 0; n < 2; ++n) acc[a][b][m][n] = (f32x4){0.f, 0.f, 0.f, 0.f};
        cur = nxt; cA = nA; cB = nB; ++ui;
    }
    PG8_WAIT_V(0);
    if (wr == 0) PG8_BAR;
    PG8_BAR;
#undef PG8_SA
#undef PG8_SB
#undef PG8_STAGE
#undef PG8_LDA
#undef PG8_LDB
#undef PG8_MMA
#undef PG8_H0
#undef PG8_H1
#undef PG8_LD8
#undef PG8_WAIT_V
#undef PG8_WAIT_L
#undef PG8_BAR
#undef PG8_SCHED
#undef PG8_EXPERT
}
}

__device__ __forceinline__ void gemm_bf16(LAS unsigned char* lds, const pg8::Gemm& g, bf16_t* O, int ldc) { pg8::EpiBf16 E{O, ldc, 1.f}; pg8::gemm_phase(lds, g, E); }
__device__ __forceinline__ void gemm_even_in(LAS unsigned char* lds, const pg8::Gemm& g, const pg8::EpiEvenIn& E) { pg8::gemm_phase(lds, g, E); }
__device__ __forceinline__ void gemm8_even_in(LAS unsigned char* lds, const pg8::Gemm& g, const pg8::EpiEvenIn& E) { pg8::gemm_phase<pg8::EpiEvenIn, true>(lds, g, E); }
__device__ __forceinline__ void gemm8_odd_in(LAS unsigned char* lds, const pg8::Gemm& g, const pg8::EpiOddIn& E) { pg8::gemm_phase<pg8::EpiOddIn, true>(lds, g, E); }
__device__ __forceinline__ void gemm_odd_in(LAS unsigned char* lds, const pg8::Gemm& g, const pg8::EpiOddIn& E) { pg8::gemm_phase(lds, g, E); }
__device__ __forceinline__ void gemm_mla_up(LAS unsigned char* lds, const pg8::Gemm& g, const pg8::EpiMlaUp& E) { pg8::gemm_phase(lds, g, E); }
__device__ __forceinline__ void gemm8_bf16(LAS unsigned char* lds, const pg8::Gemm& g, bf16_t* O, int ldc) { pg8::EpiBf16 E{O, ldc, F8_INV}; pg8::gemm_phase<pg8::EpiBf16, true>(lds, g, E); }
__device__ __forceinline__ void gemm8_swiglu8(LAS unsigned char* lds, const pg8::Gemm& g, unsigned char* O, int ldc) { pg8::EpiSwiGLU8 E{O, ldc, F8_INV}; pg8::gemm_phase<pg8::EpiSwiGLU8, true>(lds, g, E); }
__device__ __forceinline__ void gemm_swiglu(LAS unsigned char* lds, const pg8::Gemm& g, bf16_t* O, int ldc) { pg8::EpiSwiGLU E{O, ldc}; pg8::gemm_phase(lds, g, E); }

namespace att {
#define SBAR() __builtin_amdgcn_sched_barrier(0)
__device__ __forceinline__ int crow(int r, int hi) { return (r & 3) + 8 * (r >> 2) + 4 * hi; }
__device__ __forceinline__ int v_st(int k, int c) { const int kk = (k & ~0xC) | ((k & 4) << 1) | ((k & 8) >> 1); return ((kk >> 3) * 4 + (c >> 5)) * 512 + ((kk & 7) * 32 + (c & 31)) * 2; }
__device__ __forceinline__ int v_st_plain(int k, int c) { return ((k >> 3) * 4 + (c >> 5)) * 512 + ((k & 7) * 32 + (c & 31)) * 2; }
__device__ __forceinline__ int v_rd_base(int lane) { return ((lane & 3) << 3) | (((lane >> 2) & 3) << 6) | (((lane >> 4) & 1) << 5) | (((lane >> 5) & 1) << 8); }
constexpr int v_rd_off(int d0, int ks, int half) { return d0 * 512 + ks * 4096 + half * 2048; }
template <int OFF> __device__ __forceinline__ s16x4 tr_read(unsigned vb) {
    s16x4 r; asm volatile("ds_read_b64_tr_b16 %0, %1 offset:%2" : "=&v"(r) : "v"(vb), "i"(OFF) : "memory"); return r;
}
template <int D0> __device__ __forceinline__ void pv_one(f32x16& od, unsigned vb, bf16x8 pa0, bf16x8 pa1, bf16x8 pa2, bf16x8 pa3) {
    const s16x4 l0 = tr_read<v_rd_off(D0, 0, 0)>(vb), h0 = tr_read<v_rd_off(D0, 0, 1)>(vb), l1 = tr_read<v_rd_off(D0, 1, 0)>(vb), h1 = tr_read<v_rd_off(D0, 1, 1)>(vb);
    const s16x4 l2 = tr_read<v_rd_off(D0, 2, 0)>(vb), h2 = tr_read<v_rd_off(D0, 2, 1)>(vb), l3 = tr_read<v_rd_off(D0, 3, 0)>(vb), h3 = tr_read<v_rd_off(D0, 3, 1)>(vb);
    asm volatile("s_waitcnt lgkmcnt(0)" ::: "memory"); SBAR();
#define PK(L, H) (bf16x8){L[0], L[1], L[2], L[3], H[0], H[1], H[2], H[3]}
    od = __builtin_amdgcn_mfma_f32_32x32x16_bf16(pa0, PK(l0, h0), od, 0, 0, 0);
    od = __builtin_amdgcn_mfma_f32_32x32x16_bf16(pa1, PK(l1, h1), od, 0, 0, 0);
    od = __builtin_amdgcn_mfma_f32_32x32x16_bf16(pa2, PK(l2, h2), od, 0, 0, 0);
    od = __builtin_amdgcn_mfma_f32_32x32x16_bf16(pa3, PK(l3, h3), od, 0, 0, 0);
#undef PK
}
template <int KS, int NO> __device__ __forceinline__ void pv_step(f32x16 (&o)[NO], unsigned vb, bf16x8 pa) {
    s16x4 l[NO], h[NO];
    l[0] = tr_read<v_rd_off(0, KS, 0)>(vb); h[0] = tr_read<v_rd_off(0, KS, 1)>(vb); l[1] = tr_read<v_rd_off(1, KS, 0)>(vb); h[1] = tr_read<v_rd_off(1, KS, 1)>(vb);
    if constexpr (NO == 4) { l[2] = tr_read<v_rd_off(2, KS, 0)>(vb); h[2] = tr_read<v_rd_off(2, KS, 1)>(vb); l[3] = tr_read<v_rd_off(3, KS, 0)>(vb); h[3] = tr_read<v_rd_off(3, KS, 1)>(vb); }
    asm volatile("s_waitcnt lgkmcnt(0)" ::: "memory"); SBAR();
#pragma unroll
    for (int d = 0; d < NO; ++d) o[d] = __builtin_amdgcn_mfma_f32_32x32x16_bf16(pa, (bf16x8){l[d][0], l[d][1], l[d][2], l[d][3], h[d][0], h[d][1], h[d][2], h[d][3]}, o[d], 0, 0, 0);
}
__device__ __forceinline__ void rot4(bf16x8& a, const float* cs, const float* sn) {
    const f32x4 c = *(const f32x4*)cs, s = *(const f32x4*)sn; float o[8];
#pragma unroll
    for (int e = 0; e < 4; ++e) { const float x1 = bf2f((unsigned short)a[e]), x2 = bf2f((unsigned short)a[4 + e]); o[e] = x1 * c[e] - x2 * s[e]; o[4 + e] = x2 * c[e] + x1 * s[e]; }
    u32x4 w = {cvtpk(o[0], o[1]), cvtpk(o[2], o[3]), cvtpk(o[4], o[5]), cvtpk(o[6], o[7])};
    a = *reinterpret_cast<bf16x8*>(&w);
}
struct Args {
    const bf16_t* Q; int ldq, qcol;
    const bf16_t* K; int ldk, kcol;
    const bf16_t* V; int ldv, vcol;
    int q_row0;
    int kctx_row0, klat_row0, nt_ctx, nt_lat;
    float C;
    int rope;
    const float* rcos; const float* rsin;
    bf16_t* O; int ldo, ocol;
    int g, u0; const float* rpb;
    float lam, oscale; const float* subg;
};

template <int DQK, int KW, int DV, int MODE>
__device__ __forceinline__ void attn_unit(LAS unsigned char* lds, const Args& a) {
    constexpr int ND = DQK / 16, NO = DV / 32;
    constexpr int KSTR = KW * 2 + 16, KBUF = 64 * KSTR;
    constexpr int OFF_V = 3 * KBUF, OFF_WS = OFF_V + 3 * 16384, OFF_RPB = OFF_WS + 2048;
    constexpr int KCH = KW / 8, NKCH = 64 * KCH, NKC = (NKCH + 511) / 512;
    constexpr int VCH = DV / 8, NVCH = 64 * VCH, NVC = (NVCH + 511) / 512;
    const int tid = opaque_tid(), wid = __builtin_amdgcn_readfirstlane(tid >> 6), lane = tid & 63, r32 = lane & 31, hi = lane >> 5;
    LAS unsigned char* Kl = lds; LAS unsigned char* Vl = lds + OFF_V;
    LAS float* wsf = (LAS float*)(lds + OFF_WS) + wid * 64; LAS float* li_l = wsf;
    LAS float* rpbl = (LAS float*)(lds + OFF_RPB);
    const int wq = (MODE == 1) ? (wid & 3) : wid, wmap = (MODE == 1) ? (wid >> 2) : 0;
    bf16x8 qr[ND];
    const int qrow = a.q_row0 + wq * 32 + r32;
    {
        const bf16_t* Qw = a.Q + (size_t)qrow * a.ldq + a.qcol + wmap * 64 + hi * 8;
#pragma unroll
        for (int d0 = 0; d0 < ND; ++d0) qr[d0] = *(const bf16x8*)(Qw + d0 * 16);
        if (a.rope == 2) { if constexpr (ND >= 6) { const int s = qrow & (SEQ - 1); rot4(qr[4], a.rcos + s * 16 + 4 * hi, a.rsin + s * 16 + 4 * hi); rot4(qr[5], a.rcos + s * 16 + 8 + 4 * hi, a.rsin + s * 16 + 8 + 4 * hi); } }
#pragma unroll
        for (int d0 = 0; d0 < ND; ++d0) { float f[8];
#pragma unroll
            for (int e = 0; e < 8; ++e) f[e] = bf2f((unsigned short)qr[d0][e]) * a.C;
            u32x4 w = {cvtpk(f[0], f[1]), cvtpk(f[2], f[3]), cvtpk(f[4], f[5]), cvtpk(f[6], f[7])}; qr[d0] = *reinterpret_cast<bf16x8*>(&w); }
    }
    if (MODE == 2) { if (tid < 465) rpbl[tid] = a.rpb[tid] * LOG2E; }
    const int cq = (wid & 1) * 32 + r32, rq = 4 * a.g + (wid >> 1);
    const int rs = min(max(rq - 4, 0), 120), cs_ = min(max(cq - 8, 0), 48);
    constexpr int NKB = KBUF / 1024, NBT = NKB + 16, NB = (NBT + 7) / 8;
    static_assert(KBUF % 1024 == 0, "K image is a whole number of 1 KB blocks");
    unsigned soff[NB];
#pragma unroll
    for (int i = 0; i < NB; ++i) { const int bb = wid + 8 * i; unsigned so = 0u;
        if (bb < NKB) { const int A = bb * 1024 + lane * 16, row = A / KSTR; int off = A % KSTR; if (off >= KW * 2) off = 0; so = (unsigned)(row * a.ldk * 2 + off); }
        else if (bb < NBT) { const int A = (bb - NKB) * 1024 + lane * 16, sub = A >> 9, kg = sub >> 2; int cblk = sub & 3; if (DV == 64) cblk &= 1; const int w = (A & 511) >> 1, kr = w >> 5, cc = cblk * 32 + (w & 31);
            so = (unsigned)(((kg * 8 + kr) * a.ldv + cc) * 2); }
        soff[i] = so; }
    const int NT = a.nt_ctx + a.nt_lat;
#define TILE_ROW(j) ((j) < a.nt_ctx ? a.kctx_row0 + 64 * (j) : a.klat_row0 + 64 * ((j) - a.nt_ctx))
#define DMA(t) do { const int _r0 = TILE_ROW(t), _sl = (t) % 3; const char* _kp = (const char*)(a.K + (size_t)_r0 * a.ldk + a.kcol); const char* _vp = (const char*)(a.V + (size_t)_r0 * a.ldv + a.vcol); \
    _Pragma("unroll") for (int _i = 0; _i < NB; ++_i) { const int _bb = wid + 8 * _i; \
        if (_bb < NKB) __builtin_amdgcn_global_load_lds((const unsigned*)(_kp + soff[_i]), (LAS unsigned*)(Kl + _sl * KBUF + _bb * 1024), 16, 0, 0); \
        else if (_bb < NBT) __builtin_amdgcn_global_load_lds((const unsigned*)(_vp + soff[_i]), (LAS unsigned*)(Vl + _sl * 16384 + (_bb - NKB) * 1024), 16, 0, 0); } } while (0)
#define DMA_SYNC() do { asm volatile("s_waitcnt vmcnt(0)" ::: "memory"); __syncthreads(); } while (0)
    float l_reg = 0.f;
    f32x16 o[NO];
#pragma unroll
    for (int d = 0; d < NO; ++d) o[d] = (f32x16){0.f, 0.f, 0.f, 0.f, 0.f, 0.f, 0.f, 0.f, 0.f, 0.f, 0.f, 0.f, 0.f, 0.f, 0.f, 0.f};
    const unsigned vb0 = (unsigned)(size_t)Vl + (unsigned)v_rd_base(lane);
#define QKT(P0, P1, b) do { const LAS unsigned char* _Kb = Kl + (b) * KBUF + wmap * 128; bf16x8 _k0[ND], _k1[ND]; \
    _Pragma("unroll") for (int d0 = 0; d0 < ND; ++d0) { const int cb = (d0 * 16 + hi * 8) * 2; _k0[d0] = *(const LAS bf16x8*)(_Kb + r32 * KSTR + cb); _k1[d0] = *(const LAS bf16x8*)(_Kb + (32 + r32) * KSTR + cb); } \
    _Pragma("unroll") for (int d0 = 0; d0 < ND; ++d0) { \
        if (d0 == 0) { const f32x16 z16 = {0.f, 0.f, 0.f, 0.f, 0.f, 0.f, 0.f, 0.f, 0.f, 0.f, 0.f, 0.f, 0.f, 0.f, 0.f, 0.f}; P0 = __builtin_amdgcn_mfma_f32_32x32x16_bf16(_k0[0], qr[0], z16, 0, 0, 0); P1 = __builtin_amdgcn_mfma_f32_32x32x16_bf16(_k1[0], qr[0], z16, 0, 0, 0); } \
        else { P0 = __builtin_amdgcn_mfma_f32_32x32x16_bf16(_k0[d0], qr[d0], P0, 0, 0, 0); P1 = __builtin_amdgcn_mfma_f32_32x32x16_bf16(_k1[d0], qr[d0], P1, 0, 0, 0); } } } while (0)
#define PARTIAL(P0, P1, j) do { \
    if (MODE == 2) { if ((j) >= a.nt_ctx) { const int kr = a.u0 + ((j) - a.nt_ctx); const bool rowok = (kr >= rs) && (kr < rs + 8); const int ro = min(max(kr - rq + 7, 0), 14); const LAS float* brow = rpbl + ro * 31; \
        _Pragma("unroll") for (int r = 0; r < 16; ++r) { \
            { const int ck = crow(r, hi), dd = min(max(ck - cq + 15, 0), 30); const bool inw = rowok && ((unsigned)(ck - cs_) < 16u); const float bv = brow[dd]; P0[r] = inw ? P0[r] + bv : -1e30f; } \
            { const int ck = 32 + crow(r, hi), dd = min(max(ck - cq + 15, 0), 30); const bool inw = rowok && ((unsigned)(ck - cs_) < 16u); const float bv = brow[dd]; P1[r] = inw ? P1[r] + bv : -1e30f; } } } } \
    _Pragma("unroll") for (int r = 0; r < 16; ++r) P0[r] = fast_exp2(P0[r]); } while (0)
#define PK4(P, BASE, OUT) do { u32x4 w = {cvtpk(P[BASE + 0], P[BASE + 1]), cvtpk(P[BASE + 2], P[BASE + 3]), cvtpk(P[BASE + 4], P[BASE + 5]), cvtpk(P[BASE + 6], P[BASE + 7])}; \
    OUT = *reinterpret_cast<bf16x8*>(&w); } while (0)
#define FINISH(P0, P1) do { \
    _Pragma("unroll") for (int r = 0; r < 16; ++r) P1[r] = fast_exp2(P1[r]); \
    float ps = 0.f; \
    _Pragma("unroll") for (int r = 0; r < 16; ++r) ps += P0[r]; \
    _Pragma("unroll") for (int r = 0; r < 16; ++r) ps += P1[r]; \
    l_reg += ps; \
    PK4(P0, 0, pa0); PK4(P0, 8, pa1); PK4(P1, 0, pa2); PK4(P1, 8, pa3); } while (0)
#define PV(b) do { const unsigned _vb = vb0 + (unsigned)(b) * 16384u; \
    pv_step<0, NO>(o, _vb, pa0); pv_step<1, NO>(o, _vb, pa1); pv_step<2, NO>(o, _vb, pa2); pv_step<3, NO>(o, _vb, pa3); } while (0)
    f32x16 pA0, pA1, pB0, pB1; bf16x8 pa0, pa1, pa2, pa3;
    DMA(0); DMA_SYNC();
    DMA(1);
    QKT(pA0, pA1, 0); PARTIAL(pA0, pA1, 0);
    DMA_SYNC();
    int bm1 = 0, bj = 1, bn = 2;
    for (int j = 1; j + 1 < NT; j += 2) {
        DMA(j + 1);
        SBAR(); QKT(pB0, pB1, bj);
        FINISH(pA0, pA1); SBAR();
        PV(bm1); PARTIAL(pB0, pB1, j);
        DMA_SYNC();
        if (j + 2 < NT) DMA(j + 2);
        SBAR(); QKT(pA0, pA1, bn);
        FINISH(pB0, pB1); SBAR();
        PV(bj); PARTIAL(pA0, pA1, j + 1);
        DMA_SYNC();
        { const int t0 = bm1; bm1 = bn; bn = bj; bj = t0; }
    }
    SBAR(); QKT(pB0, pB1, bj);
    FINISH(pA0, pA1); SBAR();
    PV(bm1); PARTIAL(pB0, pB1, NT - 1);
    FINISH(pB0, pB1); SBAR();
    PV(bj);
    __syncthreads();
#undef TILE_ROW
#undef DMA
#undef DMA_SYNC
#undef QKT
#undef PARTIAL
#undef PK4
#undef FINISH
#undef PV
    const int tid_e = opaque_tid(), lane_e = tid_e & 63, r32e = lane_e & 31, hie = lane_e >> 5;
    { auto rr = __builtin_amdgcn_permlane32_swap(__float_as_uint(l_reg), __float_as_uint(l_reg), false, false); l_reg = __uint_as_float(rr[0]) + __uint_as_float(rr[1]); }
    if (hie == 0) li_l[r32e] = fmaxf(l_reg, 1e-37f); LDS_WAIT();
    float rli[16];
#pragma unroll
    for (int r = 0; r < 16; ++r) rli[r] = fast_rcp(li_l[crow(r, hie)]);
    if (MODE != 1) {
        bf16_t* Ow = a.O + (size_t)(a.q_row0 + wid * 32) * a.ldo + a.ocol + r32e;
#pragma unroll
        for (int r = 0; r < 16; ++r) { const int orow = crow(r, hie);
#pragma unroll
            for (int d0 = 0; d0 < NO; ++d0) Ow[(size_t)orow * a.ldo + d0 * 32] = f2bf(o[d0][r] * rli[r]); }
    } else {
        LAS float* cb = (LAS float*)lds;
        if (wmap == 1) {
#pragma unroll
            for (int r = 0; r < 16; ++r) { const int row = wq * 32 + crow(r, hie);
#pragma unroll
                for (int d0 = 0; d0 < NO; ++d0) cb[row * 129 + d0 * 32 + r32e] = a.lam * o[d0][r] * rli[r]; }
        }
        __syncthreads();
        if (wmap == 0) {
#pragma unroll
            for (int r = 0; r < 16; ++r) { const int row = wq * 32 + crow(r, hie);
#pragma unroll
                for (int d0 = 0; d0 < NO; ++d0) { const int ix = row * 129 + d0 * 32 + r32e; cb[ix] = o[d0][r] * rli[r] - cb[ix]; } }
        }
        __syncthreads();
        const int row = tid_e >> 2, qd = tid_e & 3;
        float v[32]; float ss = 0.f;
#pragma unroll
        for (int i = 0; i < 32; ++i) { v[i] = cb[row * 129 + qd * 32 + i]; ss += v[i] * v[i]; }
        ss += __shfl_xor(ss, 1); ss += __shfl_xor(ss, 2);
        const float rstd = rsqrtf(ss * (1.f / 128.f) + EPS) * a.oscale;
        bf16_t* Ow = a.O + (size_t)(a.q_row0 + row) * a.ldo + a.ocol + qd * 32;
#pragma unroll
        for (int c = 0; c < 4; ++c) { float w[8];
#pragma unroll
            for (int e = 0; e < 8; ++e) w[e] = v[c * 8 + e] * rstd * a.subg[qd * 32 + c * 8 + e];
            u32x4 pk = {cvtpk(w[0], w[1]), cvtpk(w[2], w[3]), cvtpk(w[4], w[5]), cvtpk(w[6], w[7])};
            *(u32x4*)(Ow + c * 8) = pk; }
    }
    __syncthreads();
}

__device__ __forceinline__ void sgu_unit(LAS unsigned char* lds, const bf16_t* PB, const bf16_t* Wsb, const float* bs, const float* stats, const float* sgain, bf16_t* MIX, int rowbase, int g) {
    const int tid = opaque_tid(), wid = __builtin_amdgcn_readfirstlane(tid >> 6), lane = tid & 63, r32 = lane & 31, hi = lane >> 5;
    LAS unsigned char* Vl = lds;
#pragma unroll 2
    for (int i = 0; i < 4; ++i) { const int c = tid + 512 * i, row = c >> 4, ch = c & 15;
        const u32x4 x = *(const u32x4*)(PB + (size_t)(rowbase + row) * EV_IN + 512 + g * 128 + ch * 8);
        const f32x4* st = (const f32x4*)(stats + (size_t)(rowbase + row) * 16); const f32x4 a0 = st[0], a1 = st[1], a2 = st[2], a3 = st[3];
        const float s1 = ((a0[0] + a0[2]) + (a1[0] + a1[2])) + ((a2[0] + a2[2]) + (a3[0] + a3[2])), s2 = ((a0[1] + a0[3]) + (a1[1] + a1[3])) + ((a2[1] + a2[3]) + (a3[1] + a3[3]));
        const float mean = s1 * (1.f / 512.f), rstd = rsqrtf(fmaxf(s2 * (1.f / 512.f) - mean * mean, 0.f) + EPS);
        const f32x4 g0 = *(const f32x4*)(sgain + g * 128 + ch * 8), g1 = *(const f32x4*)(sgain + g * 128 + ch * 8 + 4);
        u32x4 y; y.x = cvtpk((bflo(x.x) - mean) * rstd * g0[0], (bfhi(x.x) - mean) * rstd * g0[1]); y.y = cvtpk((bflo(x.y) - mean) * rstd * g0[2], (bfhi(x.y) - mean) * rstd * g0[3]);
        y.z = cvtpk((bflo(x.z) - mean) * rstd * g1[0], (bfhi(x.z) - mean) * rstd * g1[1]); y.w = cvtpk((bflo(x.w) - mean) * rstd * g1[2], (bfhi(x.w) - mean) * rstd * g1[3]);
        *(LAS u32x4*)(Vl + (row >> 6) * 16384 + v_st(row & 63, ch * 8)) = y; }
    const int prow = (wid & 3) * 32, dh = wid >> 2;
    bf16x8 pa[2][4];
#pragma unroll
    for (int kt = 0; kt < 2; ++kt)
#pragma unroll
        for (int ks = 0; ks < 4; ++ks) pa[kt][ks] = *(const bf16x8*)(Wsb + (size_t)(g * 128 + prow + r32) * 128 + kt * 64 + ks * 16 + hi * 8);
    __syncthreads();
    f32x16 o[2];
    o[0] = (f32x16){0.f, 0.f, 0.f, 0.f, 0.f, 0.f, 0.f, 0.f, 0.f, 0.f, 0.f, 0.f, 0.f, 0.f, 0.f, 0.f}; o[1] = o[0];
    const unsigned vb0 = (unsigned)(size_t)Vl + (unsigned)v_rd_base(lane);
#pragma unroll
    for (int kt = 0; kt < 2; ++kt) { const unsigned vb = vb0 + kt * 16384u;
        if (dh == 0) { pv_one<0>(o[0], vb, pa[kt][0], pa[kt][1], pa[kt][2], pa[kt][3]); pv_one<1>(o[1], vb, pa[kt][0], pa[kt][1], pa[kt][2], pa[kt][3]); }
        else { pv_one<2>(o[0], vb, pa[kt][0], pa[kt][1], pa[kt][2], pa[kt][3]); pv_one<3>(o[1], vb, pa[kt][0], pa[kt][1], pa[kt][2], pa[kt][3]); } }
#pragma unroll
    for (int r = 0; r < 16; ++r) { const int p = prow + crow(r, hi); const float bias = bs[g * 128 + p];
#pragma unroll
        for (int dd = 0; dd < 2; ++dd) { const int d = (2 * dh + dd) * 32 + r32;
            const float u = bf2f(PB[(size_t)(rowbase + p) * EV_IN + g * 128 + d]);
            MIX[(size_t)(rowbase + p) * DM + g * 128 + d] = f2bf(u * (o[dd][r] + bias)); } }
    __syncthreads();
}
}

struct Params {
    const float* in[31];
    float* out;
    unsigned char* ws;
    int ph_lo, ph_hi;
};

struct Ctx {
    LAS unsigned char* lds;
    int tid, lane, wid, gw, NGW;
};
__device__ __forceinline__ Ctx make_ctx(LAS unsigned char* lds) { const int t = opaque_tid(), w = __builtin_amdgcn_readfirstlane(t >> 6); return Ctx{lds, t, t & 63, w, opaque_bid() * 8 + w, (int)gridDim.x * 8}; }
typedef const __attribute__((address_space(4))) Params KParams;
__device__ __forceinline__ KParams& kparams() { KParams* p = (KParams*)__builtin_amdgcn_kernarg_segment_ptr(); asm volatile("" : "+s"(p)); return *p; }

__device__ __forceinline__ bf16_t* xrow_ptr(KParams& P, int row) { return (bf16_t*)(P.ws + WS_U + U_XB) + (size_t)row * DM; }
__device__ __forceinline__ int mod_r(int row) { return row < NLAT ? (row >> 13) : 4; }
__device__ __forceinline__ f32x4 ld4(const float* p) { return *(const f32x4*)p; }
__device__ __forceinline__ f32x4 ldbf4(const bf16_t* p) { const u32x2 w = *(const u32x2*)p; return (f32x4){bflo(w.x), bfhi(w.x), bflo(w.y), bfhi(w.y)}; }
__device__ __forceinline__ void stbf4(bf16_t* p, f32x4 v) { u32x2 w; w.x = cvtpk(v[0], v[1]); w.y = cvtpk(v[2], v[3]); *(u32x2*)p = w; }
__device__ __forceinline__ float sumsq4(const f32x4 (&v)[4]) { float s = 0.f;
#pragma unroll
    for (int j = 0; j < 4; ++j) s += (v[j][0] * v[j][0] + v[j][1] * v[j][1]) + (v[j][2] * v[j][2] + v[j][3] * v[j][3]);
    return wave_sum(s); }
__device__ __forceinline__ void norm_mod(const f32x4 (&x)[4], f32x4 (&hv)[4], const float* gain, const float* shift, const float* scale, int lane) {
    const float rstd = rsqrtf(sumsq4(x) * (1.f / DM) + EPS);
#pragma unroll
    for (int j = 0; j < 4; ++j) { const int c = 4 * lane + 256 * j; const f32x4 g = ld4(gain + c), sh = ld4(shift + c), sc = ld4(scale + c);
        hv[j] = (x[j] * rstd) * g * (sc + 1.f) + sh; }
}
__device__ __forceinline__ void resid_add(f32x4 (&x)[4], const f32x4 (&y)[4], const float* gain, const float* gate, int lane) {
    const float rstd = rsqrtf(sumsq4(y) * (1.f / DM) + EPS);
#pragma unroll
    for (int j = 0; j < 4; ++j) { const int c = 4 * lane + 256 * j; const f32x4 g = ld4(gain + c), gt = ld4(gate + c);
        x[j] = x[j] + gt * ((y[j] * rstd) * g); }
}

__device__ __forceinline__ void wave_rows(const Ctx& c, int mtok, int& r0, int& r1) {
    const int bid = opaque_bid(); const int rpw = mtok / (int)gridDim.x, base = bid * rpw;
    r0 = base + (c.wid * rpw) / 8; r1 = base + ((c.wid + 1) * rpw) / 8;
    if (bid == (int)gridDim.x - 1 && c.wid == 7) r1 = mtok;
}
__device__ __forceinline__ void ld_gate(f32x4 (&G)[4], const float* gain, const float* gate, int lane) {
#pragma unroll
    for (int j = 0; j < 4; ++j) { const int cc = 4 * lane + 256 * j; G[j] = ld4(gain + cc) * ld4(gate + cc); } }
__device__ __forceinline__ void ld_mod(f32x4 (&A)[4], f32x4 (&B)[4], const float* gain, const float* shift, const float* scale, int lane) {
#pragma unroll
    for (int j = 0; j < 4; ++j) { const int cc = 4 * lane + 256 * j; A[j] = ld4(gain + cc) * (ld4(scale + cc) + 1.f); B[j] = ld4(shift + cc); } }
__device__ __forceinline__ void resid_add2(f32x4 (&x)[4], const f32x4 (&y)[4], const f32x4 (&G)[4]) {
    const float rstd = rsqrtf(sumsq4(y) * (1.f / DM) + EPS);
#pragma unroll
    for (int j = 0; j < 4; ++j) x[j] = x[j] + G[j] * (y[j] * rstd);
}
__device__ __forceinline__ void norm_mod2(const f32x4 (&x)[4], f32x4 (&hv)[4], const f32x4 (&A)[4], const f32x4 (&B)[4]) {
    const float rstd = rsqrtf(sumsq4(x) * (1.f / DM) + EPS);
#pragma unroll
    for (int j = 0; j < 4; ++j) hv[j] = (x[j] * rstd) * A[j] + B[j];
}

__device__ __forceinline__ int perm_row(int pmode, int n) {
    if (pmode == 1) { if (n >= 1024 && n < 2048) { const int d = n & 63, hb = n & ~63; return hb + ((d < 32) ? 8 * (d >> 2) + (d & 3) : 8 * ((d - 32) >> 2) + 4 + (d & 3)); } }
    else if (pmode == 2) { if (n >= 1920 && n < 1952) { const int d = n - 1920; return 1920 + ((d < 16) ? 8 * (d >> 2) + (d & 3) : 8 * ((d - 16) >> 2) + 4 + (d & 3)); } }
    return n;
}
__device__ __forceinline__ void tr_item(const float* W, int ldw, bf16_t* WT, int ldt, int k0, int n0, int drow, LAS float* scr, int lane, int pmode = 0) {
#pragma unroll 8
    for (int i = 0; i < 32; ++i) { const int kk = 2 * i + (lane >> 5); scr[kk * 33 + (lane & 31)] = W[(size_t)(k0 + kk) * ldw + n0 + (lane & 31)]; }
    LDS_WAIT(); asm volatile("" ::: "memory");
    const int c = lane & 7;
#pragma unroll
    for (int j = 0; j < 4; ++j) { const int n = (lane >> 3) + 8 * j; const LAS float* s = scr + (8 * c) * 33 + n;
        u32x4 o; o.x = cvtpk(s[0 * 33], s[1 * 33]); o.y = cvtpk(s[2 * 33], s[3 * 33]); o.z = cvtpk(s[4 * 33], s[5 * 33]); o.w = cvtpk(s[6 * 33], s[7 * 33]);
        const int dr = pmode ? perm_row(pmode, n0 + n) : drow + n;
        *(u32x4*)(WT + (size_t)dr * ldt + k0 + 8 * c) = o; }
    LDS_WAIT(); asm volatile("" ::: "memory");
}
__device__ __forceinline__ void tr_item8(const float* W, int ldw, unsigned char* WT, int ldt, int k0, int n0, int drow, LAS float* scr, int lane, int pmode = 0) {
#pragma unroll 8
    for (int i = 0; i < 32; ++i) { const int kk = 2 * i + (lane >> 5); scr[kk * 33 + (lane & 31)] = W[(size_t)(k0 + kk) * ldw + n0 + (lane & 31)] * F8_W_SCALE; }
    LDS_WAIT(); asm volatile("" ::: "memory");
    const int c = lane & 7;
#pragma unroll
    for (int j = 0; j < 4; ++j) { const int n = (lane >> 3) + 8 * j; const LAS float* s = scr + (8 * c) * 33 + n;
        u32x2 o; o.x = pk4_fp8(s[0 * 33], s[1 * 33], s[2 * 33], s[3 * 33]); o.y = pk4_fp8(s[4 * 33], s[5 * 33], s[6 * 33], s[7 * 33]);
        const int dr = pmode ? perm_row(pmode, n0 + n) : drow + n;
        *(u32x2*)(WT + (size_t)dr * ldt + k0 + 8 * c) = o; }
    LDS_WAIT(); asm volatile("" ::: "memory");
}
__device__ __forceinline__ void tr_matrix8(const Ctx& c, const float* W, int K, int N, unsigned char* WT, int mode, int row_off, int pmode = 0) {
    LAS float* scr = (LAS float*)(c.lds + c.wid * 16384);
    const int nblk = N / 32, nitems = (K / 64) * nblk;
    for (int it = c.gw; it < nitems; it += c.NGW) { const int kb = it / nblk, nb = it % nblk, n0 = 32 * nb;
        const int drow = (mode == 0) ? row_off + n0 : (n0 >> 7) * 256 + (n0 & 127) + (mode == 2 ? 128 : 0);
        tr_item8(W, N, WT, K, 64 * kb, n0, drow, scr, c.lane, pmode); }
}
__device__ __forceinline__ void tr_matrix(const Ctx& c, const float* W, int K, int N, bf16_t* WT, int mode, int row_off, int pmode = 0) {
    LAS float* scr = (LAS float*)(c.lds + c.wid * 16384);
    const int nblk = N / 32, nitems = (K / 64) * nblk;
    for (int it = c.gw; it < nitems; it += c.NGW) { const int kb = it / nblk, nb = it % nblk, n0 = 32 * nb;
        const int drow = (mode == 0) ? row_off + n0 : (n0 >> 7) * 256 + (n0 & 127) + (mode == 2 ? 128 : 0);
        tr_item(W, N, WT, K, 64 * kb, n0, drow, scr, c.lane, pmode); }
}
constexpr int MOE_CVT_ITEMS = 24 * 1792;
__device__ __forceinline__ void convert_moe_items(const Ctx& c, int i, int t0, int t1, int wsel, int nsel) {
    KParams& P = kparams();
    LAS float* scr = (LAS float*)(c.lds + c.wid * 16384);
    if (wsel < 0) return;
    for (int t = t0 + wsel; t < t1; t += nsel) {
        const int mat = t / 1792, r = t % 1792, e = mat / 3, which = mat % 3;
        if (which < 2) {
            const float* W = P.in[28 + which] + ((size_t)i * NEXP + e) * DM * DFFE; const int kb = r / 112, n0 = 32 * (r % 112);
            const int drow = (n0 >> 7) * 256 + (n0 & 127) + which * 128;
#if MOE_F8
            tr_item8(W, DFFE, (unsigned char*)(P.ws + WS_W13M) + (size_t)e * 2 * DFFE * DM, DM, 64 * kb, n0, drow, scr, c.lane);
#else
            tr_item(W, DFFE, (bf16_t*)(P.ws + WS_W13M) + (size_t)e * 2 * DFFE * DM, DM, 64 * kb, n0, drow, scr, c.lane);
#endif
        } else {
            const float* W = P.in[30] + ((size_t)i * NEXP + e) * DFFE * DM; const int kb = r / 32, n0 = 32 * (r % 32);
#if MOE_F8
            tr_item8(W, DM, (unsigned char*)(P.ws + WS_W2M) + (size_t)e * DM * DFFE, DFFE, 64 * kb, n0, n0, scr, c.lane);
#else
            tr_item(W, DM, (bf16_t*)(P.ws + WS_W2M) + (size_t)e * DM * DFFE, DFFE, 64 * kb, n0, n0, scr, c.lane);
#endif
        }
    }
}
__device__ __forceinline__ void prologue0(const Ctx& c_) {
    const Ctx c = make_ctx(c_.lds);
    KParams& P = kparams(); unsigned char* ws = P.ws;
    if (blockIdx.x < 96) {
        LAS float* sl = (LAS float*)c.lds;
        LAS float* part = (LAS float*)(c.lds + 32768);
        for (int i = c.tid; i < 5 * DM; i += 512) { const int r = i >> 10, k = i & 1023; const float x = r < 4 ? P.in[1][r * DM + k] : P.in[3][k]; sl[i] = x / (1.f + expf(-x)); }
        __syncthreads();
        const int t = blockIdx.x, lm = t / 24, cbk = t % 24, n = cbk * 256 + 4 * c.lane;
        const float* W = P.in[4] + (size_t)lm * DM * (NMOD * DM) + n;
        f32x4 acc[5];
#pragma unroll
        for (int r = 0; r < 5; ++r) acc[r] = (f32x4){0.f, 0.f, 0.f, 0.f};
        const int kb = c.wid * 128;
        for (int k0 = 0; k0 < 128; k0 += 8) {
            f32x4 wv[8];
#pragma unroll
            for (int u = 0; u < 8; ++u) wv[u] = ld4(W + (size_t)(kb + k0 + u) * (NMOD * DM));
#pragma unroll
            for (int u = 0; u < 8; ++u)
#pragma unroll
                for (int r = 0; r < 5; ++r) acc[r] += wv[u] * sl[r * DM + kb + k0 + u];
        }
#pragma unroll
        for (int r = 0; r < 5; ++r) *(LAS f32x4*)(part + (c.wid * 5 + r) * 256 + 4 * c.lane) = acc[r];
        __syncthreads();
        for (int i = c.tid; i < 5 * 256; i += 512) { const int r = i >> 8, cc = i & 255; float s = 0.f;
#pragma unroll
            for (int w = 0; w < 8; ++w) s += part[(w * 5 + r) * 256 + cc];
            ((float*)(ws + WS_MODS))[(size_t)(lm * 5 + r) * (NMOD * DM) + cbk * 256 + cc] = s + P.in[5][lm * (NMOD * DM) + cbk * 256 + cc]; }
        __syncthreads();
    }
    for (int i = 0; i < 2; ++i) {
        if (WIN8(2 * i)) tr_matrix8(c, P.in[7] + (size_t)i * DM * EV_IN, DM, EV_IN, (unsigned char*)(ws + WS_WINE) + (size_t)i * EV_IN * DM * 2, 0, 0, 1);
        else tr_matrix(c, P.in[7] + (size_t)i * DM * EV_IN, DM, EV_IN, (bf16_t*)(ws + WS_WINE) + (size_t)i * EV_IN * DM, 0, 0, 1);
        tr_matrix(c, P.in[8] + (size_t)i * DM * DM, DM, DM, (bf16_t*)(ws + WS_WOUTE) + (size_t)i * DM * DM, 0, 0);
        if (FFN8(i)) {
            tr_matrix8(c, P.in[17] + (size_t)i * DM * DFF, DM, DFF, (unsigned char*)(ws + WS_W13E) + (size_t)i * 2 * DFF * DM * 2, 1, 0);
            tr_matrix8(c, P.in[18] + (size_t)i * DM * DFF, DM, DFF, (unsigned char*)(ws + WS_W13E) + (size_t)i * 2 * DFF * DM * 2, 2, 0);
            tr_matrix8(c, P.in[19] + (size_t)i * DFF * DM, DFF, DM, (unsigned char*)(ws + WS_W2E) + (size_t)i * DM * DFF * 2, 0, 0);
        } else {
            tr_matrix(c, P.in[17] + (size_t)i * DM * DFF, DM, DFF, (bf16_t*)(ws + WS_W13E) + (size_t)i * 2 * DFF * DM, 1, 0);
            tr_matrix(c, P.in[18] + (size_t)i * DM * DFF, DM, DFF, (bf16_t*)(ws + WS_W13E) + (size_t)i * 2 * DFF * DM, 2, 0);
            tr_matrix(c, P.in[19] + (size_t)i * DFF * DM, DFF, DM, (bf16_t*)(ws + WS_W2E) + (size_t)i * DM * DFF, 0, 0);
        }
        if (WIN8(2 * i + 1)) tr_matrix8(c, P.in[20] + (size_t)i * DM * OD_IN, DM, OD_IN, (unsigned char*)(ws + WS_WINO) + (size_t)i * OD_INP * DM * 2, 0, 0, 2);
        else tr_matrix(c, P.in[20] + (size_t)i * DM * OD_IN, DM, OD_IN, (bf16_t*)(ws + WS_WINO) + (size_t)i * OD_INP * DM, 0, 0, 2);
        tr_matrix(c, P.in[21] + (size_t)i * DM * DM, DM, DM, (bf16_t*)(ws + WS_WOUTO) + (size_t)i * DM * DM, 0, 0);
    }
    const int gt = blockIdx.x * 512 + c.tid, NGT = gridDim.x * 512;
    for (int i = gt; i < 2 * (OD_INP - OD_IN) * DM; i += NGT) { const int l = i / ((OD_INP - OD_IN) * DM), r = i % ((OD_INP - OD_IN) * DM);
        if (WIN8(2 * l + 1)) ((unsigned char*)(ws + WS_WINO))[(size_t)l * OD_INP * DM * 2 + (size_t)OD_IN * DM + r] = 0;
        else ((bf16_t*)(ws + WS_WINO))[(size_t)l * OD_INP * DM + (size_t)OD_IN * DM + r] = 0; }
    for (int i = gt; i < 2 * MLA_N * MLA_K; i += NGT) { const int l = i / (MLA_N * MLA_K), n = (i / MLA_K) % MLA_N, k = i % MLA_K; float v = 0.f;
        if (n < 384) { if (k < 256) { const int h = n / 96, j = n % 96; int sc = n;
                if (j >= 64) { const int p = j - 64, t = p >> 3, e = p & 7; sc = h * 96 + 64 + ((e < 4) ? 4 * t + e : 16 + 4 * t + (e - 4)); }
                v = P.in[24][((size_t)l * 256 + k) * 384 + sc] * P.in[23][l * 256 + k]; } }
        else if (n < 768) { const int h = (n - 384) / 96, j = (n - 384) % 96;
            if (j < 64) { if (k >= 256 && k < 384) v = P.in[26][((size_t)l * 128 + (k - 256)) * 768 + h * 192 + j] * P.in[25][l * 128 + (k - 256)]; }
            else { if (k == 384 + (j - 64)) v = 1.f; } }
        else { const int h = (n - 768) / 128, j = (n - 768) % 128; if (k >= 256 && k < 384) v = P.in[26][((size_t)l * 128 + (k - 256)) * 768 + h * 192 + 64 + j] * P.in[25][l * 128 + (k - 256)]; }
        ((bf16_t*)(ws + WS_WMLA))[i] = f2bf(v); }
    for (int i = gt; i < 2 * 4 * 128 * 128; i += NGT) ((bf16_t*)(ws + WS_SGUW))[i] = f2bf(P.in[9][i]);
    for (int i = gt; i < SEQ * 32; i += NGT) { const int s = i >> 5, f = i & 31; const int pos = f < 16 ? (s >> 6) : (s & 63);
        const float inv = 1.0f / powf(10000.0f, (float)(f & 15) / 16.0f); const float ang = (float)pos * inv;
        ((float*)(ws + WS_ROPEB))[i] = (float)cos((double)ang); ((float*)(ws + WS_ROPEB))[SEQ * 32 + i] = (float)sin((double)ang); }
    for (int i = gt; i < SEQ * 16; i += NGT) { const int s = i >> 4, f = i & 15; const int pos = f < 8 ? (s >> 6) : (s & 63);
        const float inv = 1.0f / powf(10000.0f, (float)(f & 7) / 8.0f); const float ang = (float)pos * inv;
        ((float*)(ws + WS_ROPED))[i] = (float)cos((double)ang); ((float*)(ws + WS_ROPED))[SEQ * 16 + i] = (float)sin((double)ang); }
}

__device__ __forceinline__ void convert_moe_tail(const Ctx& c_, int i, int t0, int t1, int nunits) {
    const Ctx c = make_ctx(c_.lds);
    const int G = (int)gridDim.x, rem = nunits % G, bid = opaque_bid();
    const int first = rem;
    convert_moe_items(c, i, t0, t1, bid >= first ? (bid - first) * 8 + c.wid : -1, (G - first) * 8);
}

__device__ __forceinline__ void ew_first(const Ctx& c_) {
    const Ctx c = make_ctx(c_.lds);
    KParams& P = kparams(); const float* mods = (const float*)(P.ws + WS_MODS); bf16_t* HB = (bf16_t*)(P.ws + WS_HB);
    int r0, r1; wave_rows(c, MTOT, r0, r1);
    f32x4 A0[4], B0[4]; int rcur = -1;
    for (int row = r0; row < r1; ++row) {
        const float* src = row < NLAT ? P.in[0] + (size_t)row * DM : P.in[2] + (size_t)(row - NLAT) * DM;
        bf16_t* xr = xrow_ptr(P, row); const int r = mod_r(row);
        if (r != rcur) { rcur = r; const float* mb = mods + (size_t)(0 * 5 + r) * (NMOD * DM); ld_mod(A0, B0, P.in[6] + (0 * 4 + 0) * DM, mb + 0 * DM, mb + 1 * DM, c.lane); }
        f32x4 x[4], h[4];
#pragma unroll
        for (int j = 0; j < 4; ++j) { x[j] = ld4(src + 4 * c.lane + 256 * j); stbf4(xr + 4 * c.lane + 256 * j, x[j]); }
        norm_mod2(x, h, A0, B0);
#pragma unroll
        for (int j = 0; j < 4; ++j) stbf4(HB + (size_t)row * DM + 4 * c.lane + 256 * j, h[j]);
    }
}

__device__ __forceinline__ void ew_mid(const Ctx& c_, int l, int mtok, bool dry = false) {
    const Ctx c = make_ctx(c_.lds);
    KParams& P = kparams(); const float* mods = (const float*)(P.ws + WS_MODS); bf16_t* HB = (bf16_t*)(P.ws + WS_HB);
    const bf16_t* YB = (const bf16_t*)(P.ws + WS_U + U_YB);
    const bool odd = (l & 1) != 0; const int li = l >> 1;
    LAS float* wrl = (LAS float*)c.lds;
    if (odd) { for (int i = c.tid; i < DM * NEXP; i += 512) { const int col = i >> 3, e = i & 7; wrl[e * DM + col] = P.in[27][(size_t)li * DM * NEXP + i]; } __syncthreads(); }
    unsigned long long cw = 0ull; int st_e1 = 0, st_e2 = 0, st_l1 = 0, st_l2 = 0; float st_g1 = 0.f; int nrow = 0;
    int r0, r1; wave_rows(c, mtok, r0, r1);
    f32x4 G1[4], A2[4], B2[4]; int rcur = -1;
    u32x2 xa[4], ya[4], xb[4], yb[4];
#define EWM_LOAD(X, Y, rw) do { const int _row = (rw); const bf16_t* _xr = xrow_ptr(P, _row); \
        _Pragma("unroll") for (int j = 0; j < 4; ++j) { X[j] = *(const u32x2*)(_xr + 4 * c.lane + 256 * j); Y[j] = *(const u32x2*)(YB + (size_t)_row * DM + 4 * c.lane + 256 * j); } } while (0)
    if (r0 < r1) EWM_LOAD(xa, ya, r0);
    if (r0 + 1 < r1) EWM_LOAD(xb, yb, r0 + 1);
    for (int row = r0; row < r1; ++row, ++nrow) {
        bf16_t* xr = xrow_ptr(P, row); const int r = mod_r(row);
        if (r != rcur) { rcur = r; const float* mb = mods + (size_t)(l * 5 + r) * (NMOD * DM);
            ld_gate(G1, P.in[6] + (l * 4 + 1) * DM, mb + 2 * DM, c.lane); ld_mod(A2, B2, P.in[6] + (l * 4 + 2) * DM, mb + 3 * DM, mb + 4 * DM, c.lane); }
        f32x4 x[4], y[4], h[4];
#pragma unroll
        for (int j = 0; j < 4; ++j) { x[j] = (f32x4){bflo(xa[j].x), bfhi(xa[j].x), bflo(xa[j].y), bfhi(xa[j].y)}; y[j] = (f32x4){bflo(ya[j].x), bfhi(ya[j].x), bflo(ya[j].y), bfhi(ya[j].y)}; xa[j] = xb[j]; ya[j] = yb[j]; }
        if (row + 2 < r1) EWM_LOAD(xb, yb, row + 2);
        resid_add2(x, y, G1);
        bf16_t* xw = dry ? (bf16_t*)(P.ws + WS_U + U_YS) + (size_t)row * DM : xr; bf16_t* hw = (dry ? (bf16_t*)(P.ws + WS_U + U_PB) : HB) + (size_t)row * DM;
#pragma unroll
        for (int j = 0; j < 4; ++j) stbf4(xw + 4 * c.lane + 256 * j, x[j]);
        norm_mod2(x, h, A2, B2);
        if ((odd && MOE_F8) || (!odd && FFN8(li))) {
            unsigned char* h8 = (unsigned char*)(dry ? (bf16_t*)(P.ws + WS_U + U_PB) : HB) + (size_t)row * DM;
#pragma unroll
            for (int j = 0; j < 4; ++j) *(unsigned*)(h8 + 4 * c.lane + 256 * j) = pk4_fp8(h[j][0] * F8_ACT_SCALE, h[j][1] * F8_ACT_SCALE, h[j][2] * F8_ACT_SCALE, h[j][3] * F8_ACT_SCALE);
        } else {
#pragma unroll
            for (int j = 0; j < 4; ++j) stbf4(hw + 4 * c.lane + 256 * j, h[j]);
        }
        if (odd && !dry) {
            float lg[8];
#pragma unroll
            for (int e = 0; e < 8; ++e) { float sacc = 0.f;
#pragma unroll
                for (int j = 0; j < 4; ++j) { const f32x4 w = *(const LAS f32x4*)(wrl + e * DM + 4 * c.lane + 256 * j); sacc += (h[j][0] * w[0] + h[j][1] * w[1]) + (h[j][2] * w[2] + h[j][3] * w[3]); }
                lg[e] = wave_sum(sacc); }
            int e1 = 0; float v1 = lg[0];
#pragma unroll
            for (int e = 1; e < 8; ++e) if (lg[e] > v1) { v1 = lg[e]; e1 = e; }
            int e2 = -1; float v2 = -3.0e38f;
#pragma unroll
            for (int e = 0; e < 8; ++e) if (e != e1 && lg[e] > v2) { v2 = lg[e]; e2 = e; }
            if (e2 < 0) e2 = (e1 + 1) & 7;
            const float g1 = 1.f / (1.f + expf(v2 - v1));
            const int l1 = (int)((cw >> (8 * e1)) & 0xffull); cw += 1ull << (8 * e1);
            const int l2 = (int)((cw >> (8 * e2)) & 0xffull); cw += 1ull << (8 * e2);
            if (c.lane == nrow) { st_e1 = e1; st_e2 = e2; st_l1 = l1; st_l2 = l2; st_g1 = g1; }
        }
    }
    if (odd && !dry) {
        unsigned* cnt = (unsigned*)(P.ws + WS_CTL) + CW_MOECNT + li * 64;
        int base = 0;
        if (c.lane < 8) { const unsigned wc = (unsigned)((cw >> (8 * c.lane)) & 0xffull); base = wc ? (int)atomicAdd(cnt + c.lane, wc) : 0; }
        const int b1 = __shfl(base, st_e1), b2 = __shfl(base, st_e2);
        if (c.lane < nrow) { const int row = r0 + c.lane; int4* ti = (int4*)(P.ws + WS_TOKINFO) + (size_t)row * 2;
            ti[0] = make_int4(st_e1, b1 + st_l1, st_e2, b2 + st_l2); ti[1] = make_int4(__float_as_int(st_g1), __float_as_int(1.f - st_g1), 0, 0); }
        __syncthreads();
    }
#undef EWM_LOAD
}

__device__ __forceinline__ void moe_offsets(KParams& P, int li, int (&toff)[9]) {
    const unsigned* cnt = (const unsigned*)(P.ws + WS_CTL) + CW_MOECNT + li * 64; int acc = 0;
#pragma unroll
    for (int e = 0; e < 8; ++e) { toff[e] = acc; const unsigned n = __builtin_amdgcn_readfirstlane(__hip_atomic_load(cnt + e, __ATOMIC_RELAXED, __HIP_MEMORY_SCOPE_AGENT)); acc += (int)((n + 255u) >> 8); }
    toff[8] = acc;
}
__device__ __forceinline__ void moe_gather(const Ctx& c_, int li, int mtok) {
    const Ctx c = make_ctx(c_.lds);
    KParams& P = kparams(); int toff[9]; moe_offsets(P, li, toff);
    int tv = 0;
#pragma unroll
    for (int e = 0; e < 8; ++e) tv = (c.lane == e) ? toff[e] : tv;
    const bf16_t* HB = (const bf16_t*)(P.ws + WS_HB); bf16_t* HS = (bf16_t*)(P.ws + WS_U + U_YS);
    int r0, r1; wave_rows(c, mtok, r0, r1);
    for (int row = r0; row < r1; ++row) {
        const int4* ti = (const int4*)(P.ws + WS_TOKINFO) + (size_t)row * 2; const int4 a = ti[0], b = ti[1];
        const int pA = __shfl(tv, a.x) * 256 + a.y, pB = __shfl(tv, a.z) * 256 + a.w;
        if (c.lane == 0) ((int4*)(P.ws + WS_TOKPOS))[row] = make_int4(pA, pB, b.x, b.y);
#if MOE_F8
        const u32x4 v0 = ((const u32x4*)((const unsigned char*)HB + (size_t)row * DM))[c.lane];
        ((u32x4*)((unsigned char*)HS + (size_t)pA * DM))[c.lane] = v0; ((u32x4*)((unsigned char*)HS + (size_t)pB * DM))[c.lane] = v0;
#else
        const u32x4* src = (const u32x4*)(HB + (size_t)row * DM); const u32x4 v0 = src[c.lane], v1 = src[64 + c.lane];
        u32x4* dA = (u32x4*)(HS + (size_t)pA * DM); u32x4* dB = (u32x4*)(HS + (size_t)pB * DM);
        dA[c.lane] = v0; dA[64 + c.lane] = v1; dB[c.lane] = v0; dB[64 + c.lane] = v1;
#endif
    }
}

__device__ __forceinline__ void ew_last(const Ctx& c_, int l, int mtok, bool dry = false) {
    const Ctx c = make_ctx(c_.lds);
    KParams& P = kparams(); const float* mods = (const float*)(P.ws + WS_MODS); bf16_t* HB = (bf16_t*)(P.ws + WS_HB);
    const bf16_t* YS = (const bf16_t*)(P.ws + WS_U + U_YS); const bool odd = (l & 1) != 0;
    int r0, r1; wave_rows(c, mtok, r0, r1);
    f32x4 G3[4], A0[4], B0[4]; int rcur = -1;
    u32x2 xa[4], ya[4], za[4], xb[4], yb[4], zb[4]; float gAa = 0.f, gBa = 0.f, gAb = 0.f, gBb = 0.f;
#define EWL_LOAD(X, Y, Z, GA, GB, rw) do { const int _row = (rw); const bf16_t* _xr = xrow_ptr(P, _row); \
        if (odd) { const int4 tp = ((const int4*)(P.ws + WS_TOKPOS))[_row]; GA = __int_as_float(tp.z); GB = __int_as_float(tp.w); \
            _Pragma("unroll") for (int j = 0; j < 4; ++j) { Y[j] = *(const u32x2*)(YS + (size_t)tp.x * DM + 4 * c.lane + 256 * j); Z[j] = *(const u32x2*)(YS + (size_t)tp.y * DM + 4 * c.lane + 256 * j); } } \
        else { _Pragma("unroll") for (int j = 0; j < 4; ++j) Y[j] = *(const u32x2*)(YS + (size_t)_row * DM + 4 * c.lane + 256 * j); } \
        _Pragma("unroll") for (int j = 0; j < 4; ++j) X[j] = *(const u32x2*)(_xr + 4 * c.lane + 256 * j); } while (0)
    if (r0 < r1) EWL_LOAD(xa, ya, za, gAa, gBa, r0);
    if (r0 + 1 < r1) EWL_LOAD(xb, yb, zb, gAb, gBb, r0 + 1);
    for (int row = r0; row < r1; ++row) {
        bf16_t* xr = xrow_ptr(P, row); const int r = mod_r(row);
        if (r != rcur) { rcur = r; const float* mb = mods + (size_t)(l * 5 + r) * (NMOD * DM);
            ld_gate(G3, P.in[6] + (l * 4 + 3) * DM, mb + 5 * DM, c.lane);
            if (l < 3) { const float* mn = mods + (size_t)((l + 1) * 5 + r) * (NMOD * DM); ld_mod(A0, B0, P.in[6] + ((l + 1) * 4 + 0) * DM, mn + 0 * DM, mn + 1 * DM, c.lane); } }
        f32x4 x[4], y[4], h[4];
#pragma unroll
        for (int j = 0; j < 4; ++j) { x[j] = (f32x4){bflo(xa[j].x), bfhi(xa[j].x), bflo(xa[j].y), bfhi(xa[j].y)};
            y[j] = (f32x4){bflo(ya[j].x), bfhi(ya[j].x), bflo(ya[j].y), bfhi(ya[j].y)};
            if (odd) y[j] = y[j] * gAa + (f32x4){bflo(za[j].x), bfhi(za[j].x), bflo(za[j].y), bfhi(za[j].y)} * gBa;
            xa[j] = xb[j]; ya[j] = yb[j]; za[j] = zb[j]; }
        gAa = gAb; gBa = gBb;
        if (row + 2 < r1) EWL_LOAD(xb, yb, zb, gAb, gBb, row + 2);
        resid_add2(x, y, G3);
        bf16_t* hw = (dry ? (bf16_t*)(P.ws + WS_U + U_MIX) : HB) + (size_t)row * DM;
        if (l == 3 && !dry) { float* ow = P.out + (size_t)row * DM;
#pragma unroll
            for (int j = 0; j < 4; ++j) *(f32x4*)(ow + 4 * c.lane + 256 * j) = x[j]; }
        else { bf16_t* xw = dry ? (bf16_t*)(P.ws + WS_U + U_PB) + (size_t)row * DM : xr;
#pragma unroll
            for (int j = 0; j < 4; ++j) stbf4(xw + 4 * c.lane + 256 * j, x[j]); }
        if (l < 3) { norm_mod2(x, h, A0, B0);
            if (WIN8(l + 1)) { unsigned char* h8 = (unsigned char*)(dry ? (bf16_t*)(P.ws + WS_U + U_MIX) : HB) + (size_t)row * DM;
#pragma unroll
                for (int j = 0; j < 4; ++j) *(unsigned*)(h8 + 4 * c.lane + 256 * j) = pk4_fp8(h[j][0] * F8_ACT_SCALE, h[j][1] * F8_ACT_SCALE, h[j][2] * F8_ACT_SCALE, h[j][3] * F8_ACT_SCALE); }
            else {
#pragma unroll
                for (int j = 0; j < 4; ++j) stbf4(hw + 4 * c.lane + 256 * j, h[j]); } }
    }
#undef EWL_LOAD
}

__device__ __forceinline__ void attn_even(const Ctx& c_, int l) {
    const Ctx c = make_ctx(c_.lds);
    KParams& P = kparams(); const int i = l >> 1; const bool need_ctx = l < 3;
    const bf16_t* PB = (const bf16_t*)(P.ws + WS_U + U_PB); bf16_t* MIX = (bf16_t*)(P.ws + WS_U + U_MIX);
    const int nchunk = need_ctx ? 264 : 256;
    for (int u = opaque_bid(); u < nchunk * 4; u += gridDim.x) att::sgu_unit(c.lds, PB, (const bf16_t*)(P.ws + WS_SGUW) + (size_t)i * 4 * 128 * 128, P.in[10] + i * 512, (const float*)(P.ws + WS_STATS), P.in[11] + i * 512, MIX, (u >> 2) * 128, u & 3);
    float d1 = 0.f, d2 = 0.f;
    if (c.lane < 64) { d1 = P.in[12][i * 64 + c.lane] * P.in[13][i * 64 + c.lane]; d2 = P.in[14][i * 64 + c.lane] * P.in[15][i * 64 + c.lane]; }
    const float lam_init = 0.8f - 0.6f * expf(-0.3f * (float)l);
    const float lam = expf(wave_sum(d1)) - expf(wave_sum(d2)) + lam_init;
    att::Args a;
    a.Q = PB; a.ldq = EV_IN; a.K = PB; a.ldk = EV_IN; a.V = PB; a.ldv = EV_IN; a.C = 0.125f * LOG2E;
    a.rcos = (const float*)(P.ws + WS_ROPEB); a.rsin = a.rcos + SEQ * 32; a.O = MIX; a.ldo = DM; a.g = 0; a.u0 = 0; a.rpb = nullptr;
    a.lam = lam; a.oscale = 1.f - lam_init; a.subg = P.in[16] + i * 128; a.nt_ctx = 4;
    const int nctxu = need_ctx ? 32 : 0, nu = nctxu + 1024;
    for (int u = xcd_unit_base(); u < nu; u += gridDim.x) {
        int b, h;
        if (u < nctxu) { b = u >> 3; h = (u >> 1) & 3; a.q_row0 = NLAT + b * CTXL + (u & 1) * 128; a.nt_lat = 0; a.rope = 0; }
        else { const int v = u - nctxu; b = v >> 8; h = (v >> 6) & 3; a.q_row0 = b * SEQ + (v & 63) * 128; a.nt_lat = SEQ / 64; a.rope = 0; }
        a.qcol = 1024 + h * 128; a.kcol = 1536 + h * 128; a.vcol = 2048 + h * 128; a.ocol = 512 + h * 128;
        a.kctx_row0 = NLAT + b * CTXL; a.klat_row0 = b * SEQ;
        att::attn_unit<64, 128, 128, 1>(c.lds, a);
    }
}
__device__ __forceinline__ void attn_odd_na(const Ctx& c_, int l) {
    const Ctx c = make_ctx(c_.lds);
    KParams& P = kparams(); const int i = l >> 1; const bool need_ctx = l < 3;
    const bf16_t* PB = (const bf16_t*)(P.ws + WS_U + U_PB); bf16_t* MIX = (bf16_t*)(P.ws + WS_U + U_MIX);
    att::Args a;
    a.Q = PB; a.ldq = OD_INP; a.K = PB; a.ldk = OD_INP; a.V = PB; a.ldv = OD_INP; a.C = 0.125f * LOG2E; a.rope = 0; a.rcos = nullptr; a.rsin = nullptr;
    a.O = MIX; a.ldo = DM; a.lam = 0.f; a.oscale = 1.f; a.subg = nullptr; a.nt_ctx = 4;
    const int nctxu = need_ctx ? 32 : 0, nu = nctxu + 1024;
    for (int u = xcd_unit_base(); u < nu; u += gridDim.x) {
        int b, h;
        if (u < nctxu) { b = u >> 3; h = u & 7; a.q_row0 = NLAT + b * CTXL; a.nt_lat = 0; a.g = 0; a.u0 = 0; a.klat_row0 = 0; }
        else { const int v = u - nctxu; b = v >> 8; h = (v >> 5) & 7; const int g = v & 31; a.g = g; a.u0 = min(max(4 * g - 4, 0), 116);
            a.q_row0 = b * SEQ + g * 256; a.nt_lat = 12; a.klat_row0 = b * SEQ + a.u0 * 64; }
        a.qcol = h * 64; a.kcol = 512 + h * 64; a.vcol = 1024 + h * 64; a.ocol = h * 64; a.kctx_row0 = NLAT + b * CTXL;
        a.rpb = P.in[22] + ((size_t)i * 8 + h) * 465;
        att::attn_unit<64, 64, 64, 2>(c.lds, a);
    }
}
__device__ __forceinline__ void attn_odd_mla(const Ctx& c_, int l) {
    const Ctx c = make_ctx(c_.lds);
    KParams& P = kparams(); const bool need_ctx = l < 3;
    const bf16_t* MO = (const bf16_t*)(P.ws + WS_U + U_MLAO); bf16_t* MIX = (bf16_t*)(P.ws + WS_U + U_MIX);
    att::Args a;
    a.Q = MO; a.ldq = MLA_N; a.K = MO; a.ldk = MLA_N; a.V = MO; a.ldv = MLA_N; a.C = 0.10206207261596575f * LOG2E;
    a.rcos = (const float*)(P.ws + WS_ROPED); a.rsin = a.rcos + SEQ * 16; a.O = MIX; a.ldo = DM; a.g = 0; a.u0 = 0; a.rpb = nullptr; a.lam = 0.f; a.oscale = 1.f; a.subg = nullptr; a.nt_ctx = 4;
    const int nctxu = need_ctx ? 16 : 0, nu = nctxu + 512;
    for (int u = xcd_unit_base(); u < nu; u += gridDim.x) {
        int b, h;
        if (u < nctxu) { b = u >> 2; h = u & 3; a.q_row0 = NLAT + b * CTXL; a.nt_lat = 0; a.rope = 0; }
        else { const int v = u - nctxu; b = v >> 7; h = (v >> 5) & 3; a.q_row0 = b * SEQ + (v & 31) * 256; a.nt_lat = SEQ / 64; a.rope = 2; }
        a.qcol = h * 96; a.kcol = 384 + h * 96; a.vcol = 768 + h * 128; a.ocol = 512 + h * 128; a.kctx_row0 = NLAT + b * CTXL; a.klat_row0 = b * SEQ;
        att::attn_unit<96, 96, 128, 0>(c.lds, a);
    }
}

constexpr int N_PHASES = 2 + 2 * (7 + 9);
__global__ void __launch_bounds__(512, 2) fwd_kernel(Params prm) {
    extern __shared__ __attribute__((aligned(16))) unsigned char lds_raw[];
    LAS unsigned char* lds = (LAS unsigned char*)lds_raw;
    const Ctx c{lds, 0, 0, 0, 0, 0};
    for (int u = threadIdx.x; u < (LDS_BYTES - LDS_MISC) / 4; u += 512) ((LAS unsigned*)(lds + LDS_MISC))[u] = 0u;
    __syncthreads();
    XcdBarrier bar;
    { unsigned char* ws0 = kparams().ws; bar.bar = (unsigned*)(ws0 + WS_CTL) + CW_BAR; bar.x = 0; bar.st = nullptr;
#if !MK_PER_PHASE
      bar = xcd_barrier_post((unsigned*)(ws0 + WS_CTL) + CW_BAR, (volatile LAS unsigned*)(lds + LDS_MISC + 32));
#endif
    }
    int ph = 0;
#ifndef PMASK
#define PMASK 0xffffffffu
#endif
#define PM(b) ((PMASK >> (b)) & 1u)
#define PH_ON() (ph >= kparams().ph_lo && ph < kparams().ph_hi)
#define PH_END() do { if (ph >= kparams().ph_lo && ph + 1 < kparams().ph_hi) xcd_barrier(bar); ++ph; } while (0)
#define WSP(off) ((bf16_t*)(ws + (off)))
#define HB WSP(WS_HB)
#define PB WSP(WS_U + U_PB)
#define MIX WSP(WS_U + U_MIX)
#define YB WSP(WS_U + U_YB)
#define HID WSP(WS_U + U_HID)
#define YS WSP(WS_U + U_YS)
#define A2 WSP(WS_U + U_A2)
#define MO WSP(WS_U + U_MLAO)

    if (PM(0) && PH_ON()) for (int rep = 0; rep < DUPN(0); ++rep) { prologue0(c); __syncthreads(); }
    PH_END();
    if (PM(1) && PH_ON()) for (int rep = 0; rep < DUPN(1); ++rep) ew_first(c);
    PH_END();
    for (int lp = 0; lp < 2; ++lp) {
        {
            const int l = 2 * lp, i = lp; const int mtok = l < 3 ? MTOT : NLAT, nMt = mtok / 256;
            if (PM(2) && PH_ON()) for (int rep = 0; rep < DUPN(2); ++rep) { unsigned char* ws = kparams().ws; pg8::Gemm g{}; g.A = HB; g.lda = DM; g.Bt = (const unsigned char*)(ws + WS_WINE) + (size_t)i * EV_IN * DM * 2; g.K = DM; g.nM = MTOT / 256; g.nN = EV_IN / 256; g.grouped = 0; g.estride = 0;
                pg8::EpiEvenIn E{PB, EV_IN, (f32x2*)(ws + WS_STATS), (const float*)(ws + WS_ROPEB), (const float*)(ws + WS_ROPEB) + SEQ * 32, WIN8(l) ? F8_INV : 1.f}; if (WIN8(l)) gemm8_even_in(lds, g, E); else gemm_even_in(lds, g, E); if (rep == 0) convert_moe_tail(c, i, 0, 7296, (MTOT / 256) * (EV_IN / 256)); }
            PH_END();
            if (PM(4) && PH_ON()) for (int rep = 0; rep < DUPN(4); ++rep) attn_even(c, l);
            PH_END();
            if (PM(5) && PH_ON()) for (int rep = 0; rep < DUPN(5); ++rep) { unsigned char* ws = kparams().ws; pg8::Gemm g{}; g.A = MIX; g.lda = DM; g.Bt = (const bf16_t*)(ws + WS_WOUTE) + (size_t)i * DM * DM; g.K = DM; g.nM = nMt; g.nN = DM / 256; g.grouped = 0; g.estride = 0;
                gemm_bf16(lds, g, YB, DM); if (rep == 0) convert_moe_tail(c, i, 7296, 14592, nMt * (DM / 256)); }
            PH_END();
            if (PM(6) && PH_ON()) { if (DUPN(6) > 1) ew_mid(c, l, mtok, true); ew_mid(c, l, mtok); }
            PH_END();
            if (PM(7) && PH_ON()) for (int rep = 0; rep < DUPN(7); ++rep) { unsigned char* ws = kparams().ws; pg8::Gemm g{}; g.A = HB; g.lda = DM; g.Bt = (const unsigned char*)(ws + WS_W13E) + (size_t)i * 2 * DFF * DM * 2; g.K = DM; g.nM = nMt; g.nN = 2 * DFF / 256; g.grouped = 0; g.estride = 0;
                if (FFN8(i)) gemm8_swiglu8(lds, g, (unsigned char*)HID, DFF); else gemm_swiglu(lds, g, HID, DFF);
                if (rep == 0) convert_moe_tail(c, i, 14592, 20224, nMt * (2 * DFF / 256)); }
            PH_END();
            if (PM(8) && PH_ON()) for (int rep = 0; rep < DUPN(8); ++rep) { unsigned char* ws = kparams().ws; pg8::Gemm g{}; g.A = HID; g.lda = DFF; g.Bt = (const unsigned char*)(ws + WS_W2E) + (size_t)i * DM * DFF * 2; g.K = DFF; g.nM = nMt; g.nN = DM / 256; g.grouped = 0; g.estride = 0;
                if (FFN8(i)) gemm8_bf16(lds, g, YS, DM); else gemm_bf16(lds, g, YS, DM);
                if (rep == 0) convert_moe_tail(c, i, 20224, MOE_CVT_ITEMS, nMt * (DM / 256)); }
            PH_END();
            if (PM(9) && PH_ON()) { if (DUPN(9) > 1) ew_last(c, l, mtok, true); ew_last(c, l, mtok); }
            PH_END();
        }
        {
            const int l = 2 * lp + 1, i = lp; const int mtok = l < 3 ? MTOT : NLAT, nMt = mtok / 256;
            if (PM(10) && PH_ON()) for (int rep = 0; rep < DUPN(10); ++rep) { unsigned char* ws = kparams().ws; pg8::Gemm g{}; g.A = HB; g.lda = DM; g.Bt = (const unsigned char*)(ws + WS_WINO) + (size_t)i * OD_INP * DM * 2; g.K = DM; g.nM = MTOT / 256; g.nN = OD_INP / 256; g.grouped = 0; g.estride = 0;
                pg8::EpiOddIn E{PB, OD_INP, (float*)(ws + WS_STATS), (const float*)(ws + WS_ROPED), (const float*)(ws + WS_ROPED) + SEQ * 16, WIN8(l) ? F8_INV : 1.f}; if (WIN8(l)) gemm8_odd_in(lds, g, E); else gemm_odd_in(lds, g, E); }
            PH_END();
            if (PM(12) && PH_ON()) for (int rep = 0; rep < DUPN(12); ++rep) { unsigned char* ws = kparams().ws; pg8::Gemm g{}; g.A = PB + 1536; g.lda = OD_INP; g.Bt = (const bf16_t*)(ws + WS_WMLA) + (size_t)i * MLA_N * MLA_K; g.K = MLA_K; g.nM = MTOT / 256; g.nN = MLA_N / 256; g.grouped = 0; g.estride = 0;
                pg8::EpiMlaUp E{MO, MLA_N, (const float*)(ws + WS_STATS)}; gemm_mla_up(lds, g, E); }
            PH_END();
            if (PH_ON()) { if (PM(13)) for (int rep = 0; rep < DUPN(13); ++rep) attn_odd_na(c, l); if (PM(14)) for (int rep = 0; rep < DUPN(14); ++rep) attn_odd_mla(c, l); }
            PH_END();
            if (PM(15) && PH_ON()) for (int rep = 0; rep < DUPN(15); ++rep) { unsigned char* ws = kparams().ws; pg8::Gemm g{}; g.A = MIX; g.lda = DM; g.Bt = (const bf16_t*)(ws + WS_WOUTO) + (size_t)i * DM * DM; g.K = DM; g.nM = nMt; g.nN = DM / 256; g.grouped = 0; g.estride = 0;
                gemm_bf16(lds, g, YB, DM); }
            PH_END();
            if (PM(16) && PH_ON()) { if (DUPN(16) > 1) ew_mid(c, l, mtok, true); ew_mid(c, l, mtok); }
            PH_END();
            if (PM(17) && PH_ON()) for (int rep = 0; rep < DUPN(17); ++rep) moe_gather(c, i, mtok);
            PH_END();
            if (PM(18) && PH_ON()) for (int rep = 0; rep < DUPN(18); ++rep) { unsigned char* ws = kparams().ws; pg8::Gemm g{}; g.A = YS; g.lda = DM; g.Bt = (const bf16_t*)(ws + WS_W13M); g.K = DM; g.nN = 2 * DFFE / 256; g.grouped = 1; g.estride = (size_t)2 * DFFE * DM;
                moe_offsets(kparams(), i, g.toff); g.nM = g.toff[8];
#if MOE_F8
                gemm8_swiglu8(lds, g, (unsigned char*)HID, DFFE);
#else
                gemm_swiglu(lds, g, HID, DFFE);
#endif
            }
            PH_END();
            if (PM(19) && PH_ON()) for (int rep = 0; rep < DUPN(19); ++rep) { unsigned char* ws = kparams().ws; pg8::Gemm g{}; g.A = HID; g.lda = DFFE; g.Bt = (const bf16_t*)(ws + WS_W2M); g.K = DFFE; g.nN = DM / 256; g.grouped = 1; g.estride = (size_t)DM * DFFE;
                moe_offsets(kparams(), i, g.toff); g.nM = g.toff[8];
#if MOE_F8
                gemm8_bf16(lds, g, YS, DM);
#else
                gemm_bf16(lds, g, YS, DM);
#endif
            }
            PH_END();
            if (PM(20) && PH_ON()) { if (DUPN(20) > 1) ew_last(c, l, mtok, true); ew_last(c, l, mtok); }
            PH_END();
        }
    }
#undef PH_ON
#undef PH_END
#undef HB
#undef PB
#undef MIX
#undef YB
#undef HID
#undef YS
#undef A2
#undef MO
}

extern "C" void kernel_launch(void* const* d_in, const int* in_sizes, int n_in, void* d_out, int out_size, void* d_ws, size_t ws_size, hipStream_t stream) {
    static int grid = 0;
    if (grid == 0) {
        int dev = 0, cus = 0;
        if (n_in != 31 || out_size != NLAT * DM || ws_size < WS_END) { fprintf(stderr, "kernel_launch: unexpected shapes or workspace (n_in %d out %d ws %zu need %zu)\n", n_in, out_size, ws_size, (size_t)WS_END); grid = -1; }
        else if (hipGetDevice(&dev) != hipSuccess || hipDeviceGetAttribute(&cus, hipDeviceAttributeMultiprocessorCount, dev) != hipSuccess) grid = -1;
        else if (hipFuncSetAttribute((const void*)fwd_kernel, hipFuncAttributeMaxDynamicSharedMemorySize, LDS_BYTES) != hipSuccess) grid = -1;
        else { int per_cu = 0; (void)hipOccupancyMaxActiveBlocksPerMultiprocessor(&per_cu, (const void*)fwd_kernel, 512, LDS_BYTES); (void)hipGetLastError(); grid = cus; }
    }
    if (grid < 0) { (void)hipMemsetAsync(d_out, 0, (size_t)out_size * 4, stream); return; }
    (void)hipMemsetAsync((char*)d_ws + WS_CTL, 0, CTL_BYTES, stream);
    Params p{};
    for (int i = 0; i < 31; ++i) p.in[i] = (const float*)d_in[i];
    p.out = (float*)d_out; p.ws = (unsigned char*)d_ws;
#if MK_PER_PHASE
    for (int k = 0; k < N_PHASES; ++k) { p.ph_lo = k; p.ph_hi = k + 1; hipLaunchKernelGGL(fwd_kernel, dim3(grid), dim3(512), LDS_BYTES, stream, p); }
#else
    p.ph_lo = 0; p.ph_hi = N_PHASES;
    hipLaunchKernelGGL(fwd_kernel, dim3(grid), dim3(512), LDS_BYTES, stream, p);
#endif
}
```

```cpp
#include <hip/hip_runtime.h>
#include <stdint.h>
#include <stdio.h>

#ifndef MK_PER_PHASE
#define MK_PER_PHASE 0
#endif
#ifndef DUP_MASK
#define DUP_MASK 0u
#endif
#define DUPN(b) (1 + (int)((DUP_MASK >> (b)) & 1u))
#ifndef FFN_F8
#define FFN_F8 1
#endif
#ifndef FFN_F8_FROM
#define FFN_F8_FROM 1
#endif
#define FFN8(i) (FFN_F8 && (i) >= FFN_F8_FROM)
#ifndef WIN_F8_FROM
#define WIN_F8_FROM 2
#endif
#define WIN8(l) ((l) >= WIN_F8_FROM)
#ifndef MOE_F8
#define MOE_F8 1
#endif

#define LAS __attribute__((address_space(3)))
typedef unsigned short bf16_t;
typedef short bf16x8 __attribute__((ext_vector_type(8)));
typedef short s16x4 __attribute__((ext_vector_type(4)));
typedef float f32x4 __attribute__((ext_vector_type(4)));
typedef float f32x2 __attribute__((ext_vector_type(2)));
typedef float f32x16 __attribute__((ext_vector_type(16)));
typedef unsigned u32x4 __attribute__((ext_vector_type(4)));
typedef unsigned u32x2 __attribute__((ext_vector_type(2)));

constexpr int DM = 1024, NB = 4, SEQ = 8192, NLAT = NB * SEQ, CTXL = 256, NCTX = NB * CTXL, MTOT = NLAT + NCTX;
constexpr int NMOD = 6;
constexpr int EV_IN = 2560, OD_IN = 1952, OD_INP = 2048, DFF = 2816, DFFE = 3584, NEXP = 8;
constexpr int MLA_N = 1280, MLA_K = 512;
constexpr int MS_MAX = 2 * MTOT + NEXP * 256;
constexpr float EPS = 1e-6f;
constexpr float LOG2E = 1.4426950408889634f;

constexpr size_t MiB = (size_t)1 << 20;
constexpr size_t WS_CTL = 0, CTL_BYTES = MiB;
constexpr size_t WS_MODS = 1 * MiB;
constexpr size_t WS_ROPEB = 2 * MiB;
constexpr size_t WS_ROPED = 4 * MiB;
constexpr size_t WS_SGUW = 5 * MiB;
constexpr size_t WS_TOKINFO = 6 * MiB;
constexpr size_t WS_TOKPOS = 8 * MiB;
constexpr size_t WS_CTXX = 10 * MiB;
constexpr size_t WS_WMLA = 14 * MiB;
constexpr size_t WS_WINE = 17 * MiB;
constexpr size_t WS_WOUTE = 27 * MiB;
constexpr size_t WS_W13E = 31 * MiB;
constexpr size_t WS_W2E = 53 * MiB;
constexpr size_t WS_WINO = 64 * MiB;
constexpr size_t WS_WOUTO = 72 * MiB;
constexpr size_t WS_W13M = 76 * MiB;
constexpr size_t WS_W2M = 188 * MiB;
constexpr size_t WS_HB = 244 * MiB;
constexpr size_t WS_U = 310 * MiB;
constexpr size_t U_PB = 0;
constexpr size_t U_MIX = 165 * MiB;
constexpr size_t U_A2 = 231 * MiB;
constexpr size_t U_MLAO = 264 * MiB;
constexpr size_t U_YB = 347 * MiB;
constexpr size_t U_HID = 0;
constexpr size_t U_XB = 549 * MiB;
constexpr size_t U_YS = 413 * MiB;
constexpr size_t WS_STATS = WS_U + 616 * MiB;
constexpr size_t WS_END = WS_STATS + 4 * MiB;
static_assert((size_t)MS_MAX * DFFE * (MOE_F8 ? 1 : 2) <= 347 * MiB && (size_t)MTOT * DFF * 2 <= 347 * MiB, "hid must stay clear of YB");
static_assert(U_YS + (size_t)MS_MAX * DM * 2 <= U_XB && U_XB + (size_t)MTOT * DM * 2 <= 616 * MiB, "ys / xb fit");

constexpr int CW_BAR = 4096;
constexpr int CW_MOECNT = 1024;

constexpr int LDS_BYTES = 147456;
constexpr int LDS_MISC = 131072;

__device__ __forceinline__ unsigned cvtpk(float lo, float hi) { unsigned r; asm volatile("v_cvt_pk_bf16_f32 %0, %1, %2" : "=v"(r) : "v"(lo), "v"(hi)); return r; }
__device__ __forceinline__ float bf2f(unsigned short b) { return __uint_as_float(((unsigned)b) << 16); }
__device__ __forceinline__ float bflo(unsigned w) { return __uint_as_float(w << 16); }
__device__ __forceinline__ float bfhi(unsigned w) { return __uint_as_float(w & 0xffff0000u); }
__device__ __forceinline__ bf16_t f2bf(float f) { return (bf16_t)(cvtpk(f, 0.f) & 0xffffu); }
typedef int i32x8 __attribute__((ext_vector_type(8)));
typedef int i32x4 __attribute__((ext_vector_type(4)));
constexpr float F8_ACT_SCALE = 4.f, F8_W_SCALE = 64.f, F8_INV = 1.f / (F8_ACT_SCALE * F8_W_SCALE);
__device__ __forceinline__ unsigned pk4_fp8(float a, float b, float c, float d) {
    a = __builtin_amdgcn_fmed3f(a, -448.f, 448.f); b = __builtin_amdgcn_fmed3f(b, -448.f, 448.f); c = __builtin_amdgcn_fmed3f(c, -448.f, 448.f); d = __builtin_amdgcn_fmed3f(d, -448.f, 448.f);
    int w = 0; w = __builtin_amdgcn_cvt_pk_fp8_f32(a, b, w, false); w = __builtin_amdgcn_cvt_pk_fp8_f32(c, d, w, true); return (unsigned)w; }
__device__ __forceinline__ float wave_sum(float v) {
#pragma unroll
    for (int o = 1; o < 64; o <<= 1) v += __shfl_xor(v, o);
    return v;
}
__device__ __forceinline__ float fast_exp2(float x) { return __builtin_amdgcn_exp2f(x); }
__device__ __forceinline__ float fast_rcp(float x) { return __builtin_amdgcn_rcpf(x); }
__device__ __forceinline__ float silu_f(float x) { return x * fast_rcp(1.f + fast_exp2(-x * LOG2E)); }
__device__ __forceinline__ float gelu_tanh_f(float x) { const float u = 0.7978845608028654f * (x + 0.044715f * x * x * x); return x * fast_rcp(1.f + fast_exp2(-2.f * LOG2E * u)); }
#define LDS_WAIT() asm volatile("s_waitcnt lgkmcnt(0)" ::: "memory")
#define VM_WAIT() asm volatile("s_waitcnt vmcnt(0)" ::: "memory")
__device__ __forceinline__ int opaque_bid() { int b = blockIdx.x; asm volatile("" : "+s"(b)); return b; }
__device__ __forceinline__ int xcd_unit_base() { const int b = opaque_bid(), G = (int)gridDim.x; return (G % 8 == 0) ? (b & 7) * (G >> 3) + (b >> 3) : b; }
__device__ __forceinline__ int opaque_tid() { int t = threadIdx.x; asm volatile("" : "+v"(t)); return t; }

#define XB_TMO      128
#define XB_XCNT(j)  (256  + 64 * (j))
#define XB_XSUB(j)  (1280 + 64 * (j))
#define XB_XGEN(j)  (2304 + 64 * (j))
#define XB_TOP      3328
#define XB_TOPGEN   3392
#define XCD_BAR_WORDS 3456
#define XB_SPIN_CAP (1u << 22)
__device__ __forceinline__ unsigned xb_ld(unsigned* p)              { return __hip_atomic_load(p, __ATOMIC_RELAXED, __HIP_MEMORY_SCOPE_AGENT); }
__device__ __forceinline__ unsigned xb_add(unsigned* p, unsigned v) { return __hip_atomic_fetch_add(p, v, __ATOMIC_RELAXED, __HIP_MEMORY_SCOPE_AGENT); }
__device__ __forceinline__ unsigned xb_xcc_id() { return (unsigned)__builtin_amdgcn_s_getreg((3 << 11) | 20) & 0xFu; }
#define XB_SPIN(cond, bar) do { unsigned _sp = 0; while (cond) { __builtin_amdgcn_s_sleep(1); \
    if ((++_sp & 255u) == 0u) { if (xb_ld(&(bar)[XB_TMO])) break; if (_sp > XB_SPIN_CAP) { atomicAdd(&(bar)[XB_TMO], 1u); break; } } } } while (0)
struct XcdBarrier { unsigned* bar; unsigned x; volatile LAS unsigned* st; };
__device__ __forceinline__ XcdBarrier xcd_barrier_post(unsigned* bar, volatile LAS unsigned* st) {
    XcdBarrier b; b.bar = bar; b.x = xb_xcc_id(); b.st = st;
    if (threadIdx.x == 0) (void)xb_add(&bar[XB_XCNT(b.x)], 1u);
    return b;
}
__device__ __forceinline__ void xcd_barrier_complete(unsigned* bar, unsigned x, unsigned& nloc, unsigned& nx) {
    const unsigned G = gridDim.x * gridDim.y * gridDim.z;
    unsigned sum, cnt, mine, sp = 0u;
    for (;;) {
        sum = 0u; cnt = 0u; mine = 0u;
#pragma unroll
        for (unsigned j = 0; j < 16; ++j) { const unsigned c = xb_ld(&bar[XB_XCNT(j)]); sum += c; cnt += (c > 0u) ? 1u : 0u; mine = (j == x) ? c : mine; }
        if (sum == G) break;
        __builtin_amdgcn_s_sleep(1);
        if ((++sp & 255u) == 0u) { if (xb_ld(&bar[XB_TMO])) break; if (sp > XB_SPIN_CAP) { atomicAdd(&bar[XB_TMO], 1u); break; } }
    }
    nloc = mine > 0u ? mine : 1u; nx = cnt > 0u ? cnt : 1u;
}
__device__ __forceinline__ void xcd_barrier(const XcdBarrier& b) {
    asm volatile("s_waitcnt vmcnt(0)" ::: "memory");
    __syncthreads();
    if (threadIdx.x == 0) {
        unsigned* bar = b.bar;
        __builtin_amdgcn_s_waitcnt(0);
        unsigned nloc = b.st[0], nx = b.st[1];
        if (nloc == 0u) { xcd_barrier_complete(bar, b.x, nloc, nx); b.st[0] = nloc; b.st[1] = nx; }
        const unsigned old = xb_add(&bar[XB_XSUB(b.x)], 1u);
        const unsigned gen = old / nloc;
        if (old + 1u == (gen + 1u) * nloc) {
            __builtin_amdgcn_fence(__ATOMIC_RELEASE, "agent");
            asm volatile("s_waitcnt vmcnt(0)" ::: "memory");
            const unsigned og = xb_add(&bar[XB_TOP], 1u);
            const unsigned tg = og / nx;
            if (og + 1u == (tg + 1u) * nx) xb_add(&bar[XB_TOPGEN], 1u);
            else XB_SPIN(xb_ld(&bar[XB_TOPGEN]) == tg, bar);
            __builtin_amdgcn_fence(__ATOMIC_ACQUIRE, "agent");
            xb_add(&bar[XB_XGEN(b.x)], 1u);
            asm volatile("s_waitcnt vmcnt(0)" ::: "memory");
        } else {
            XB_SPIN(xb_ld(&bar[XB_XGEN(b.x)]) == gen, bar);
            __builtin_amdgcn_fence(__ATOMIC_ACQUIRE, "agent");
            asm volatile("s_waitcnt vmcnt(0)" ::: "memory");
        }
    }
    __syncthreads();
}

namespace pg8 {
constexpr int BM = 256, BK = 64, HALF = 128, HTB = HALF * BK * 2, STAGE_BYTES = 8 * HTB, NXCD = 8, WGM = 4;
__device__ __forceinline__ int lds_byte(int r, int c) { const int st = (r >> 4) * 2 + (c >> 5), rr = r & 15, cc = c & 31, ob = rr * 64 + cc * 2; return st * 1024 + (ob ^ (((ob >> 9) & 1) << 5)); }
__device__ __forceinline__ void stage_rc(int b, int& R, int& C) { const int st = b / 1024, sb = b % 1024, swz = sb ^ (((sb >> 9) & 1) << 5); R = (st >> 1) * 16 + swz / 64; C = (st & 1) * 32 + (swz % 64) / 2; }
__device__ __forceinline__ int perm32(int rho) { const int n = rho >> 4, i = rho & 15; return 8 * (i >> 2) + 4 * n + (i & 3); }
struct Unit { int pm, pn, e; };
struct Gemm {
    const void* A; int lda;
    const void* Bt; int K;
    int nM, nN;
    int grouped; int toff[9]; size_t estride;
};
struct StaticOrder {
    int nM, nN, nwg, G, c;
    __device__ void init(int nM_, int nN_, int G_, int c_) { nM = nM_; nN = nN_; nwg = nM * nN; G = G_; c = c_; }
    __device__ __forceinline__ bool next(int i, Unit& u) const {
        const long L = (long)i * G + c; if (L >= nwg) return false;
        int wgid = (int)L; { const int q = nwg / NXCD, r = nwg % NXCD, xcd = wgid % NXCD, off = wgid / NXCD; wgid = (xcd < r ? xcd * (q + 1) : r * (q + 1) + (xcd - r) * q) + off; }
        const int nig = WGM * nN, gid = wgid / nig, fm = gid * WGM, gsz = (nM - fm) < WGM ? (nM - fm) : WGM;
        u.pm = fm + ((wgid % nig) % gsz); u.pn = (wgid % nig) / gsz; u.e = 0; return true;
    }
};
struct EpiBf16 {
    bf16_t* O; int ldc; float scale;
    __device__ __forceinline__ void operator()(const f32x4 (&acc)[2][2][4][2], const Unit& u, int wr, int wc, int fr, int fq) const {
        const int row0 = u.pm * BM + wr * 64 + fr, col0 = u.pn * BM + wc * 32 + 8 * fq;
#pragma unroll
        for (int ai = 0; ai < 2; ++ai)
#pragma unroll
            for (int m = 0; m < 4; ++m) { bf16_t* rowp = O + (size_t)(row0 + ai * HALF + m * 16) * ldc + col0;
#pragma unroll
                for (int bj = 0; bj < 2; ++bj) { const f32x4 v0 = acc[ai][bj][m][0] * scale, v1 = acc[ai][bj][m][1] * scale;
                    u32x4 w; w.x = cvtpk(v0[0], v0[1]); w.y = cvtpk(v0[2], v0[3]); w.z = cvtpk(v1[0], v1[1]); w.w = cvtpk(v1[2], v1[3]);
                    *(u32x4*)(rowp + bj * HALF) = w; } }
    }
};
__device__ __forceinline__ f32x4 swiglu4(f32x4 a, f32x4 b, float k1, float k2) {
    const f32x4 t = a * k1; f32x4 d;
#pragma unroll
    for (int j = 0; j < 4; ++j) d[j] = fast_exp2(t[j]);
    d = d + 1.f; f32x4 r;
#pragma unroll
    for (int j = 0; j < 4; ++j) r[j] = fast_rcp(d[j]);
    return (a * b) * (r * k2);
}
struct EpiSwiGLU {
    bf16_t* O; int ldc;
    __device__ __forceinline__ void operator()(const f32x4 (&acc)[2][2][4][2], const Unit& u, int wr, int wc, int fr, int fq) const {
        const int row0 = u.pm * BM + wr * 64 + fr, col0 = u.pn * HALF + wc * 32 + 8 * fq;
#pragma unroll
        for (int ai = 0; ai < 2; ++ai)
#pragma unroll
            for (int m = 0; m < 4; ++m) { bf16_t* rowp = O + (size_t)(row0 + ai * HALF + m * 16) * ldc + col0;
                const f32x4 r0 = swiglu4(acc[ai][0][m][0], acc[ai][1][m][0], -LOG2E, 1.f), r1 = swiglu4(acc[ai][0][m][1], acc[ai][1][m][1], -LOG2E, 1.f);
                u32x4 w; w.x = cvtpk(r0[0], r0[1]); w.y = cvtpk(r0[2], r0[3]); w.z = cvtpk(r1[0], r1[1]); w.w = cvtpk(r1[2], r1[3]);
                *(u32x4*)rowp = w; }
    }
};

struct EpiEvenIn {
    bf16_t* O; int ldc; f32x2* stats; const float* rcos; const float* rsin; float scale;
    __device__ __forceinline__ void operator()(const f32x4 (&acc)[2][2][4][2], const Unit& u, int wr, int wc, int fr, int fq) const {
        int upm = u.pm, upn = u.pn; asm volatile("" : "+s"(upm), "+s"(upn));
        const int row0 = upm * BM + wr * 64 + fr, col0 = upn * BM + wc * 32 + 8 * fq;
        const int kind = upn < 2 ? 0 : (upn < 4 ? 1 : (upn < 8 ? 2 : 3)); const bool lat = upm < NLAT / BM; const int t4 = 4 * (4 * (wc & 1) + fq);
#pragma unroll
        for (int ai = 0; ai < 2; ++ai)
#pragma unroll
            for (int m = 0; m < 4; ++m) { const int row = row0 + ai * HALF + m * 16; bf16_t* rowp = O + (size_t)row * ldc + col0;
                f32x4 cs = {1.f, 1.f, 1.f, 1.f}, sn = {0.f, 0.f, 0.f, 0.f}; float s1 = 0.f, s2 = 0.f;
                if (kind == 2 && lat) { const int sp = row & (SEQ - 1); cs = *(const f32x4*)(rcos + sp * 32 + t4); sn = *(const f32x4*)(rsin + sp * 32 + t4); }
#pragma unroll
                for (int bj = 0; bj < 2; ++bj) { f32x4 v0 = acc[ai][bj][m][0] * scale, v1 = acc[ai][bj][m][1] * scale;
                    if (kind < 2) {
#pragma unroll
                        for (int j = 0; j < 4; ++j) { v0[j] = gelu_tanh_f(v0[j]); v1[j] = gelu_tanh_f(v1[j]); }
                        if (kind == 1) { s1 += (v0[0] + v0[1]) + (v0[2] + v0[3]) + (v1[0] + v1[1]) + (v1[2] + v1[3]);
                            s2 += (v0[0] * v0[0] + v0[1] * v0[1]) + (v0[2] * v0[2] + v0[3] * v0[3]) + (v1[0] * v1[0] + v1[1] * v1[1]) + (v1[2] * v1[2] + v1[3] * v1[3]); } }
                    else if (kind == 2) { const f32x4 o0 = v0 * cs - v1 * sn, o1 = v1 * cs + v0 * sn; v0 = o0; v1 = o1; }
                    u32x4 w; w.x = cvtpk(v0[0], v0[1]); w.y = cvtpk(v0[2], v0[3]); w.z = cvtpk(v1[0], v1[1]); w.w = cvtpk(v1[2], v1[3]);
                    *(u32x4*)(rowp + bj * HALF) = w; }
                if (kind == 1) { s1 += __shfl_xor(s1, 16); s1 += __shfl_xor(s1, 32); s2 += __shfl_xor(s2, 16); s2 += __shfl_xor(s2, 32);
                    if (fq == 0) stats[(size_t)row * 8 + (upn - 2) * 4 + wc] = (f32x2){s1, s2}; } }
    }
};
struct EpiOddIn {
    bf16_t* O; int ldc; float* stats; const float* rcos; const float* rsin; float scale;
    __device__ __forceinline__ void operator()(const f32x4 (&acc)[2][2][4][2], const Unit& u, int wr, int wc, int fr, int fq) const {
        int upm = u.pm, upn = u.pn; asm volatile("" : "+s"(upm), "+s"(upn));
        const int row0 = upm * BM + wr * 64 + fr, col0 = upn * BM + wc * 32 + 8 * fq; const bool lat = upm < NLAT / BM;
#pragma unroll
        for (int ai = 0; ai < 2; ++ai)
#pragma unroll
            for (int m = 0; m < 4; ++m) { const int row = row0 + ai * HALF + m * 16; bf16_t* rowp = O + (size_t)row * ldc + col0; float ss = 0.f;
#pragma unroll
                for (int bj = 0; bj < 2; ++bj) { f32x4 v0 = acc[ai][bj][m][0] * scale, v1 = acc[ai][bj][m][1] * scale;
                    if (upn == 6 || (upn == 7 && bj == 0)) ss += (v0[0] * v0[0] + v0[1] * v0[1]) + (v0[2] * v0[2] + v0[3] * v0[3]) + (v1[0] * v1[0] + v1[1] * v1[1]) + (v1[2] * v1[2] + v1[3] * v1[3]);
                    if (upn == 7 && bj == 1 && wc == 0 && lat) { const int sp = row & (SEQ - 1); const f32x4 cs = *(const f32x4*)(rcos + sp * 16 + 4 * fq), sn = *(const f32x4*)(rsin + sp * 16 + 4 * fq);
                        const f32x4 o0 = v0 * cs - v1 * sn, o1 = v1 * cs + v0 * sn; v0 = o0; v1 = o1; }
                    u32x4 w; w.x = cvtpk(v0[0], v0[1]); w.y = cvtpk(v0[2], v0[3]); w.z = cvtpk(v1[0], v1[1]); w.w = cvtpk(v1[2], v1[3]);
                    *(u32x4*)(rowp + bj * HALF) = w; }
                if (upn >= 6) { ss += __shfl_xor(ss, 16); ss += __shfl_xor(ss, 32); if (fq == 0) stats[(size_t)row * 8 + (upn - 6) * 4 + wc] = ss; } }
    }
};
struct EpiMlaUp {
    bf16_t* O; int ldc; const float* stats;
    __device__ __forceinline__ void operator()(const f32x4 (&acc)[2][2][4][2], const Unit& u, int wr, int wc, int fr, int fq) const {
        const int row0 = u.pm * BM + wr * 64 + fr, col0 = u.pn * BM + wc * 32 + 8 * fq;
#pragma unroll
        for (int ai = 0; ai < 2; ++ai)
#pragma unroll
            for (int m = 0; m < 4; ++m) { const int row = row0 + ai * HALF + m * 16; bf16_t* rowp = O + (size_t)row * ldc + col0;
                const f32x4 pq = *(const f32x4*)(stats + (size_t)row * 8), pk = *(const f32x4*)(stats + (size_t)row * 8 + 4);
                const float rq = rsqrtf(((pq[0] + pq[1]) + (pq[2] + pq[3])) * (1.f / 256.f) + EPS), rk = rsqrtf(((pk[0] + pk[1]) + (pk[2] + pk[3])) * (1.f / 128.f) + EPS);
#pragma unroll
                for (int bj = 0; bj < 2; ++bj) { const int c0 = col0 + bj * HALF; const float sc = c0 < 384 ? rq : (c0 < 768 ? (((c0 - 384) % 96) < 64 ? rk : 1.f) : rk);
                    const f32x4 v0 = acc[ai][bj][m][0] * sc, v1 = acc[ai][bj][m][1] * sc;
                    u32x4 w; w.x = cvtpk(v0[0], v0[1]); w.y = cvtpk(v0[2], v0[3]); w.z = cvtpk(v1[0], v1[1]); w.w = cvtpk(v1[2], v1[3]);
                    *(u32x4*)(rowp + bj * HALF) = w; } }
    }
};
struct EpiSwiGLU8 {
    unsigned char* O; int ldc; float scale;
    __device__ __forceinline__ void operator()(const f32x4 (&acc)[2][2][4][2], const Unit& u, int wr, int wc, int fr, int fq) const {
        const int row0 = u.pm * BM + wr * 64 + fr, col0 = u.pn * HALF + wc * 32 + 8 * fq;
#pragma unroll
        for (int ai = 0; ai < 2; ++ai)
#pragma unroll
            for (int m = 0; m < 4; ++m) { unsigned char* rowp = O + (size_t)(row0 + ai * HALF + m * 16) * ldc + col0;
                const float k1 = -LOG2E * scale, k2 = F8_ACT_SCALE * scale * scale;
                const f32x4 r0 = swiglu4(acc[ai][0][m][0], acc[ai][1][m][0], k1, k2), r1 = swiglu4(acc[ai][0][m][1], acc[ai][1][m][1], k1, k2);
                u32x2 w; w.x = pk4_fp8(r0[0], r0[1], r0[2], r0[3]); w.y = pk4_fp8(r1[0], r1[1], r1[2], r1[3]);
                *(u32x2*)rowp = w; }
    }
};

template <class Epi, bool F8 = false>
__device__ __forceinline__ void gemm_phase(LAS unsigned char* lds, const Gemm& g, const Epi& E) {
    const int tid = opaque_tid(), wid = __builtin_amdgcn_readfirstlane(tid >> 6), lane = tid & 63, wr = wid >> 2, wc = wid & 3, fr = lane & 15, fq = lane >> 4;
    constexpr int ES = F8 ? 1 : 2;
    const int K = g.K, nt = K * ES / (BK * 2), lda = g.lda;
    StaticOrder S; S.init(g.nM, g.nN, (int)gridDim.x, opaque_bid());
    unsigned voffA[2], voffB[2];
#pragma unroll
    for (int i = 0; i < 2; ++i) { int R, C; stage_rc(tid * 16 + i * 8192, R, C); const int Rb = (R & ~31) + perm32(R & 31);
        voffA[i] = (unsigned)(R * lda * ES + C * 2); voffB[i] = (unsigned)(Rb * K * ES + C * 2); }
    const size_t kstep = (size_t)(BK * 2);
    const size_t hA = (size_t)HALF * lda * ES, tA = 2 * hA, hB = (size_t)HALF * K * ES, tB = 2 * hB;
    const unsigned ldsw = (unsigned)wid * 1024u;
    const int aoff = lds_byte(wr * 64 + fr, fq * 8), boff = lds_byte(wc * 32 + fr, fq * 8);
#define PG8_SA(b, h) (((b) * 2 + (h)) * HTB)
#define PG8_SB(b, h) ((4 + (b) * 2 + (h)) * HTB)
#define PG8_STAGE(bufoff, gbase, voff) do { _Pragma("unroll") for (int _i = 0; _i < 2; ++_i) \
        __builtin_amdgcn_global_load_lds((const unsigned*)((const char*)(gbase) + (voff)[_i]), (LAS unsigned*)(lds + (bufoff) + ldsw + _i * 8192), 16, 0, 0); } while (0)
#define PG8_LD8(base) __builtin_shufflevector(*(const LAS i32x4*)(base), *(const LAS i32x4*)((base) + 1024), 0, 1, 2, 3, 4, 5, 6, 7)
#define PG8_LDA(dst, b, h) do { _Pragma("unroll") for (int m = 0; m < 4; ++m) dst[m] = PG8_LD8(lds + PG8_SA(b, h) + aoff + m * 2048); } while (0)
#define PG8_LDB(dst, b, h) do { _Pragma("unroll") for (int n = 0; n < 2; ++n) dst[n] = PG8_LD8(lds + PG8_SB(b, h) + boff + n * 2048); } while (0)
#define PG8_H0(x) __builtin_bit_cast(bf16x8, __builtin_shufflevector(x, x, 0, 1, 2, 3))
#define PG8_H1(x) __builtin_bit_cast(bf16x8, __builtin_shufflevector(x, x, 4, 5, 6, 7))
#define PG8_MMA(ai, bj, At, Bt) do { __builtin_amdgcn_s_setprio(1); _Pragma("unroll") for (int m = 0; m < 4; ++m) _Pragma("unroll") for (int n = 0; n < 2; ++n) { \
        if constexpr (F8) asm volatile("v_mfma_f32_16x16x128_f8f6f4 %0, %1, %2, %0" : "+v"(acc[ai][bj][m][n]) : "v"(Bt[n]), "v"(At[m])); \
        else { acc[ai][bj][m][n] = __builtin_amdgcn_mfma_f32_16x16x32_bf16(PG8_H0(Bt[n]), PG8_H0(At[m]), acc[ai][bj][m][n], 0, 0, 0); \
               acc[ai][bj][m][n] = __builtin_amdgcn_mfma_f32_16x16x32_bf16(PG8_H1(Bt[n]), PG8_H1(At[m]), acc[ai][bj][m][n], 0, 0, 0); } } \
        __builtin_amdgcn_s_setprio(0); } while (0)
#define PG8_WAIT_V(n) asm volatile("s_waitcnt vmcnt(" #n ")" ::: "memory")
#define PG8_WAIT_L(n) asm volatile("s_waitcnt lgkmcnt(" #n ")" ::: "memory")
#define PG8_BAR __builtin_amdgcn_s_barrier()
#define PG8_SCHED __builtin_amdgcn_sched_barrier(0)
#define PG8_EXPERT(u) do { if (g.grouped) { int _e = 0; _Pragma("unroll") for (int _k = 1; _k < 8; ++_k) _e += ((u).pm >= g.toff[_k]) ? 1 : 0; (u).e = _e; } } while (0)
    Unit cur, nxt; int ui = 0;
    if (!S.next(0, cur)) return;
    PG8_EXPERT(cur);
    f32x4 acc[2][2][4][2];
#pragma unroll
    for (int a = 0; a < 2; ++a)
#pragma unroll
        for (int b = 0; b < 2; ++b)
#pragma unroll
            for (int m = 0; m < 4; ++m)
#pragma unroll
                for (int n = 0; n < 2; ++n) acc[a][b][m][n] = (f32x4){0.f, 0.f, 0.f, 0.f};
    i32x8 At[4], B0[2], B1[2];
    const char* cA = (const char*)g.A + (size_t)cur.pm * tA; const char* cB = ((const char*)g.Bt + (size_t)cur.e * g.estride * ES) + (size_t)cur.pn * tB;
    PG8_STAGE(PG8_SB(0, 0), cB, voffB); PG8_STAGE(PG8_SA(0, 0), cA, voffA); PG8_STAGE(PG8_SB(0, 1), cB + hB, voffB); PG8_STAGE(PG8_SA(0, 1), cA + hA, voffA);
    if (wr == 1) PG8_BAR;
    PG8_WAIT_V(4); PG8_BAR;
    PG8_STAGE(PG8_SB(1, 0), cB + kstep, voffB); PG8_STAGE(PG8_SA(1, 0), cA + kstep, voffA); PG8_STAGE(PG8_SB(1, 1), cB + hB + kstep, voffB);
    PG8_WAIT_V(6); PG8_BAR;
    for (;;) {
        const bool has_next = S.next(ui + 1, nxt);
        if (has_next) PG8_EXPERT(nxt);
        const char* nA = has_next ? (const char*)g.A + (size_t)nxt.pm * tA : cA; const char* nB = has_next ? ((const char*)g.Bt + (size_t)nxt.e * g.estride * ES) + (size_t)nxt.pn * tB : cB;
        for (int t = 0; t < nt; t += 2) {
            const bool last = (t == nt - 2);
            const char* a1 = cA + (size_t)(t + 1) * kstep;
            const char* a2 = last ? nA : cA + (size_t)(t + 2) * kstep; const char* b2 = last ? nB : cB + (size_t)(t + 2) * kstep;
            const char* a3 = a2 + kstep; const char* b3 = b2 + kstep;
            PG8_LDB(B0, 0, 0); PG8_SCHED; PG8_LDA(At, 0, 0); PG8_STAGE(PG8_SA(1, 1), a1 + hA, voffA);
            PG8_WAIT_L(8); PG8_BAR; PG8_WAIT_L(0); PG8_MMA(0, 0, At, B0); PG8_BAR; PG8_SCHED;
            PG8_LDB(B1, 0, 1); PG8_STAGE(PG8_SB(0, 0), b2, voffB);
            PG8_BAR; PG8_WAIT_L(0); PG8_MMA(0, 1, At, B1); PG8_BAR;
            PG8_LDA(At, 0, 1); PG8_STAGE(PG8_SA(0, 0), a2, voffA);
            PG8_BAR; PG8_WAIT_L(0); PG8_MMA(1, 0, At, B0); PG8_BAR; PG8_SCHED;
            PG8_STAGE(PG8_SB(0, 1), b2 + hB, voffB);
            PG8_WAIT_V(6); PG8_BAR; PG8_MMA(1, 1, At, B1); PG8_BAR;
            PG8_LDB(B0, 1, 0); PG8_SCHED; PG8_LDA(At, 1, 0); PG8_STAGE(PG8_SA(0, 1), a2 + hA, voffA);
            PG8_WAIT_L(8); PG8_BAR; PG8_WAIT_L(0); PG8_MMA(0, 0, At, B0); PG8_BAR; PG8_SCHED;
            PG8_LDB(B1, 1, 1); PG8_STAGE(PG8_SB(1, 0), b3, voffB);
            PG8_BAR; PG8_WAIT_L(0); PG8_MMA(0, 1, At, B1); PG8_BAR;
            PG8_LDA(At, 1, 1); PG8_STAGE(PG8_SA(1, 0), a3, voffA);
            PG8_BAR; PG8_WAIT_L(0); PG8_MMA(1, 0, At, B0); PG8_BAR; PG8_SCHED;
            PG8_STAGE(PG8_SB(1, 1), b3 + hB, voffB);
            PG8_WAIT_V(6); PG8_BAR; PG8_MMA(1, 1, At, B1); PG8_BAR;
        }
        if constexpr (F8) asm volatile("s_nop 15\n\ts_nop 15" ::: "memory");
        E(acc, cur, wr, wc, fr, fq);
        if (!has_next) break;
#pragma unroll
        for (int a = 0; a < 2; ++a)
#pragma unroll
            for (int b = 0; b < 2; ++b)
#pragma unroll
                for (int m = 0; m < 4; ++m)
#pragma unroll
                    for (int n = 0; n < 2; ++n) acc[a][b][m][n] = (f32x4){0.f, 0.f, 0.f, 0.f};
        cur = nxt; cA = nA; cB = nB; ++ui;
    }
    PG8_WAIT_V(0);
    if (wr == 0) PG8_BAR;
    PG8_BAR;
#undef PG8_SA
#undef PG8_SB
#undef PG8_STAGE
#undef PG8_LDA
#undef PG8_LDB
#undef PG8_MMA
#undef PG8_H0
#undef PG8_H1
#undef PG8_LD8
#undef PG8_WAIT_V
#undef PG8_WAIT_L
#undef PG8_BAR
#undef PG8_SCHED
#undef PG8_EXPERT
}
}

__device__ __forceinline__ void gemm_bf16(LAS unsigned char* lds, const pg8::Gemm& g, bf16_t* O, int ldc) { pg8::EpiBf16 E{O, ldc, 1.f}; pg8::gemm_phase(lds, g, E); }
__device__ __forceinline__ void gemm_even_in(LAS unsigned char* lds, const pg8::Gemm& g, const pg8::EpiEvenIn& E) { pg8::gemm_phase(lds, g, E); }
__device__ __forceinline__ void gemm8_even_in(LAS unsigned char* lds, const pg8::Gemm& g, const pg8::EpiEvenIn& E) { pg8::gemm_phase<pg8::EpiEvenIn, true>(lds, g, E); }
__device__ __forceinline__ void gemm8_odd_in(LAS unsigned char* lds, const pg8::Gemm& g, const pg8::EpiOddIn& E) { pg8::gemm_phase<pg8::EpiOddIn, true>(lds, g, E); }
__device__ __forceinline__ void gemm_odd_in(LAS unsigned char* lds, const pg8::Gemm& g, const pg8::EpiOddIn& E) { pg8::gemm_phase(lds, g, E); }
__device__ __forceinline__ void gemm_mla_up(LAS unsigned char* lds, const pg8::Gemm& g, const pg8::EpiMlaUp& E) { pg8::gemm_phase(lds, g, E); }
__device__ __forceinline__ void gemm8_bf16(LAS unsigned char* lds, const pg8::Gemm& g, bf16_t* O, int ldc) { pg8::EpiBf16 E{O, ldc, F8_INV}; pg8::gemm_phase<pg8::EpiBf16, true>(lds, g, E); }
__device__ __forceinline__ void gemm8_swiglu8(LAS unsigned char* lds, const pg8::Gemm& g, unsigned char* O, int ldc) { pg8::EpiSwiGLU8 E{O, ldc, F8_INV}; pg8::gemm_phase<pg8::EpiSwiGLU8, true>(lds, g, E); }
__device__ __forceinline__ void gemm_swiglu(LAS unsigned char* lds, const pg8::Gemm& g, bf16_t* O, int ldc) { pg8::EpiSwiGLU E{O, ldc}; pg8::gemm_phase(lds, g, E); }

namespace att {
#define SBAR() __builtin_amdgcn_sched_barrier(0)
__device__ __forceinline__ int crow(int r, int hi) { return (r & 3) + 8 * (r >> 2) + 4 * hi; }
__device__ __forceinline__ int v_st(int k, int c) { const int kk = (k & ~0xC) | ((k & 4) << 1) | ((k & 8) >> 1); return ((kk >> 3) * 4 + (c >> 5)) * 512 + ((kk & 7) * 32 + (c & 31)) * 2; }
__device__ __forceinline__ int v_st_plain(int k, int c) { return ((k >> 3) * 4 + (c >> 5)) * 512 + ((k & 7) * 32 + (c & 31)) * 2; }
__device__ __forceinline__ int v_rd_base(int lane) { return ((lane & 3) << 3) | (((lane >> 2) & 3) << 6) | (((lane >> 4) & 1) << 5) | (((lane >> 5) & 1) << 8); }
constexpr int v_rd_off(int d0, int ks, int half) { return d0 * 512 + ks * 4096 + half * 2048; }
template <int OFF> __device__ __forceinline__ s16x4 tr_read(unsigned vb) {
    s16x4 r; asm volatile("ds_read_b64_tr_b16 %0, %1 offset:%2" : "=&v"(r) : "v"(vb), "i"(OFF) : "memory"); return r;
}
template <int D0> __device__ __forceinline__ void pv_one(f32x16& od, unsigned vb, bf16x8 pa0, bf16x8 pa1, bf16x8 pa2, bf16x8 pa3) {
    const s16x4 l0 = tr_read<v_rd_off(D0, 0, 0)>(vb), h0 = tr_read<v_rd_off(D0, 0, 1)>(vb), l1 = tr_read<v_rd_off(D0, 1, 0)>(vb), h1 = tr_read<v_rd_off(D0, 1, 1)>(vb);
    const s16x4 l2 = tr_read<v_rd_off(D0, 2, 0)>(vb), h2 = tr_read<v_rd_off(D0, 2, 1)>(vb), l3 = tr_read<v_rd_off(D0, 3, 0)>(vb), h3 = tr_read<v_rd_off(D0, 3, 1)>(vb);
    asm volatile("s_waitcnt lgkmcnt(0)" ::: "memory"); SBAR();
#define PK(L, H) (bf16x8){L[0], L[1], L[2], L[3], H[0], H[1], H[2], H[3]}
    od = __builtin_amdgcn_mfma_f32_32x32x16_bf16(pa0, PK(l0, h0), od, 0, 0, 0);
    od = __builtin_amdgcn_mfma_f32_32x32x16_bf16(pa1, PK(l1, h1), od, 0, 0, 0);
    od = __builtin_amdgcn_mfma_f32_32x32x16_bf16(pa2, PK(l2, h2), od, 0, 0, 0);
    od = __builtin_amdgcn_mfma_f32_32x32x16_bf16(pa3, PK(l3, h3), od, 0, 0, 0);
#undef PK
}
template <int KS, int NO> __device__ __forceinline__ void pv_step(f32x16 (&o)[NO], unsigned vb, bf16x8 pa) {
    s16x4 l[NO], h[NO];
    l[0] = tr_read<v_rd_off(0, KS, 0)>(vb); h[0] = tr_read<v_rd_off(0, KS, 1)>(vb); l[1] = tr_read<v_rd_off(1, KS, 0)>(vb); h[1] = tr_read<v_rd_off(1, KS, 1)>(vb);
    if constexpr (NO == 4) { l[2] = tr_read<v_rd_off(2, KS, 0)>(vb); h[2] = tr_read<v_rd_off(2, KS, 1)>(vb); l[3] = tr_read<v_rd_off(3, KS, 0)>(vb); h[3] = tr_read<v_rd_off(3, KS, 1)>(vb); }
    asm volatile("s_waitcnt lgkmcnt(0)" ::: "memory"); SBAR();
#pragma unroll
    for (int d = 0; d < NO; ++d) o[d] = __builtin_amdgcn_mfma_f32_32x32x16_bf16(pa, (bf16x8){l[d][0], l[d][1], l[d][2], l[d][3], h[d][0], h[d][1], h[d][2], h[d][3]}, o[d], 0, 0, 0);
}
__device__ __forceinline__ void rot4(bf16x8& a, const float* cs, const float* sn) {
    const f32x4 c = *(const f32x4*)cs, s = *(const f32x4*)sn; float o[8];
#pragma unroll
    for (int e = 0; e < 4; ++e) { const float x1 = bf2f((unsigned short)a[e]), x2 = bf2f((unsigned short)a[4 + e]); o[e] = x1 * c[e] - x2 * s[e]; o[4 + e] = x2 * c[e] + x1 * s[e]; }
    u32x4 w = {cvtpk(o[0], o[1]), cvtpk(o[2], o[3]), cvtpk(o[4], o[5]), cvtpk(o[6], o[7])};
    a = *reinterpret_cast<bf16x8*>(&w);
}
struct Args {
    const bf16_t* Q; int ldq, qcol;
    const bf16_t* K; int ldk, kcol;
    const bf16_t* V; int ldv, vcol;
    int q_row0;
    int kctx_row0, klat_row0, nt_ctx, nt_lat;
    float C;
    int rope;
    const float* rcos; const float* rsin;
    bf16_t* O; int ldo, ocol;
    int g, u0; const float* rpb;
    float lam, oscale; const float* subg;
};

template <int DQK, int KW, int DV, int MODE>
__device__ __forceinline__ void attn_unit(LAS unsigned char* lds, const Args& a) {
    constexpr int ND = DQK / 16, NO = DV / 32;
    constexpr int KSTR = KW * 2 + 16, KBUF = 64 * KSTR;
    constexpr int OFF_V = 3 * KBUF, OFF_WS = OFF_V + 3 * 16384, OFF_RPB = OFF_WS + 2048;
    constexpr int KCH = KW / 8, NKCH = 64 * KCH, NKC = (NKCH + 511) / 512;
    constexpr int VCH = DV / 8, NVCH = 64 * VCH, NVC = (NVCH + 511) / 512;
    const int tid = opaque_tid(), wid = __builtin_amdgcn_readfirstlane(tid >> 6), lane = tid & 63, r32 = lane & 31, hi = lane >> 5;
    LAS unsigned char* Kl = lds; LAS unsigned char* Vl = lds + OFF_V;
    LAS float* wsf = (LAS float*)(lds + OFF_WS) + wid * 64; LAS float* li_l = wsf;
    LAS float* rpbl = (LAS float*)(lds + OFF_RPB);
    const int wq = (MODE == 1) ? (wid & 3) : wid, wmap = (MODE == 1) ? (wid >> 2) : 0;
    bf16x8 qr[ND];
    const int qrow = a.q_row0 + wq * 32 + r32;
    {
        const bf16_t* Qw = a.Q + (size_t)qrow * a.ldq + a.qcol + wmap * 64 + hi * 8;
#pragma unroll
        for (int d0 = 0; d0 < ND; ++d0) qr[d0] = *(const bf16x8*)(Qw + d0 * 16);
        if (a.rope == 2) { if constexpr (ND >= 6) { const int s = qrow & (SEQ - 1); rot4(qr[4], a.rcos + s * 16 + 4 * hi, a.rsin + s * 16 + 4 * hi); rot4(qr[5], a.rcos + s * 16 + 8 + 4 * hi, a.rsin + s * 16 + 8 + 4 * hi); } }
#pragma unroll
        for (int d0 = 0; d0 < ND; ++d0) { float f[8];
#pragma unroll
            for (int e = 0; e < 8; ++e) f[e] = bf2f((unsigned short)qr[d0][e]) * a.C;
            u32x4 w = {cvtpk(f[0], f[1]), cvtpk(f[2], f[3]), cvtpk(f[4], f[5]), cvtpk(f[6], f[7])}; qr[d0] = *reinterpret_cast<bf16x8*>(&w); }
    }
    if (MODE == 2) { if (tid < 465) rpbl[tid] = a.rpb[tid] * LOG2E; }
    const int cq = (wid & 1) * 32 + r32, rq = 4 * a.g + (wid >> 1);
    const int rs = min(max(rq - 4, 0), 120), cs_ = min(max(cq - 8, 0), 48);
    constexpr int NKB = KBUF / 1024, NBT = NKB + 16, NB = (NBT + 7) / 8;
    static_assert(KBUF % 1024 == 0, "K image is a whole number of 1 KB blocks");
    unsigned soff[NB];
#pragma unroll
    for (int i = 0; i < NB; ++i) { const int bb = wid + 8 * i; unsigned so = 0u;
        if (bb < NKB) { const int A = bb * 1024 + lane * 16, row = A / KSTR; int off = A % KSTR; if (off >= KW * 2) off = 0; so = (unsigned)(row * a.ldk * 2 + off); }
        else if (bb < NBT) { const int A = (bb - NKB) * 1024 + lane * 16, sub = A >> 9, kg = sub >> 2; int cblk = sub & 3; if (DV == 64) cblk &= 1; const int w = (A & 511) >> 1, kr = w >> 5, cc = cblk * 32 + (w & 31);
            so = (unsigned)(((kg * 8 + kr) * a.ldv + cc) * 2); }
        soff[i] = so; }
    const int NT = a.nt_ctx + a.nt_lat;
#define TILE_ROW(j) ((j) < a.nt_ctx ? a.kctx_row0 + 64 * (j) : a.klat_row0 + 64 * ((j) - a.nt_ctx))
#define DMA(t) do { const int _r0 = TILE_ROW(t), _sl = (t) % 3; const char* _kp = (const char*)(a.K + (size_t)_r0 * a.ldk + a.kcol); const char* _vp = (const char*)(a.V + (size_t)_r0 * a.ldv + a.vcol); \
    _Pragma("unroll") for (int _i = 0; _i < NB; ++_i) { const int _bb = wid + 8 * _i; \
        if (_bb < NKB) __builtin_amdgcn_global_load_lds((const unsigned*)(_kp + soff[_i]), (LAS unsigned*)(Kl + _sl * KBUF + _bb * 1024), 16, 0, 0); \
        else if (_bb < NBT) __builtin_amdgcn_global_load_lds((const unsigned*)(_vp + soff[_i]), (LAS unsigned*)(Vl + _sl * 16384 + (_bb - NKB) * 1024), 16, 0, 0); } } while (0)
#define DMA_SYNC() do { asm volatile("s_waitcnt vmcnt(0)" ::: "memory"); __syncthreads(); } while (0)
    float l_reg = 0.f;
    f32x16 o[NO];
#pragma unroll
    for (int d = 0; d < NO; ++d) o[d] = (f32x16){0.f, 0.f, 0.f, 0.f, 0.f, 0.f, 0.f, 0.f, 0.f, 0.f, 0.f, 0.f, 0.f, 0.f, 0.f, 0.f};
    const unsigned vb0 = (unsigned)(size_t)Vl + (unsigned)v_rd_base(lane);
#define QKT(P0, P1, b) do { const LAS unsigned char* _Kb = Kl + (b) * KBUF + wmap * 128; bf16x8 _k0[ND], _k1[ND]; \
    _Pragma("unroll") for (int d0 = 0; d0 < ND; ++d0) { const int cb = (d0 * 16 + hi * 8) * 2; _k0[d0] = *(const LAS bf16x8*)(_Kb + r32 * KSTR + cb); _k1[d0] = *(const LAS bf16x8*)(_Kb + (32 + r32) * KSTR + cb); } \
    _Pragma("unroll") for (int d0 = 0; d0 < ND; ++d0) { \
        if (d0 == 0) { const f32x16 z16 = {0.f, 0.f, 0.f, 0.f, 0.f, 0.f, 0.f, 0.f, 0.f, 0.f, 0.f, 0.f, 0.f, 0.f, 0.f, 0.f}; P0 = __builtin_amdgcn_mfma_f32_32x32x16_bf16(_k0[0], qr[0], z16, 0, 0, 0); P1 = __builtin_amdgcn_mfma_f32_32x32x16_bf16(_k1[0], qr[0], z16, 0, 0, 0); } \
        else { P0 = __builtin_amdgcn_mfma_f32_32x32x16_bf16(_k0[d0], qr[d0], P0, 0, 0, 0); P1 = __builtin_amdgcn_mfma_f32_32x32x16_bf16(_k1[d0], qr[d0], P1, 0, 0, 0); } } } while (0)
#define PARTIAL(P0, P1, j) do { \
    if (MODE == 2) { if ((j) >= a.nt_ctx) { const int kr = a.u0 + ((j) - a.nt_ctx); const bool rowok = (kr >= rs) && (kr < rs + 8); const int ro = min(max(kr - rq + 7, 0), 14); const LAS float* brow = rpbl + ro * 31; \
        _Pragma("unroll") for (int r = 0; r < 16; ++r) { \
            { const int ck = crow(r, hi), dd = min(max(ck - cq + 15, 0), 30); const bool inw = rowok && ((unsigned)(ck - cs_) < 16u); const float bv = brow[dd]; P0[r] = inw ? P0[r] + bv : -1e30f; } \
            { const int ck = 32 + crow(r, hi), dd = min(max(ck - cq + 15, 0), 30); const bool inw = rowok && ((unsigned)(ck - cs_) < 16u); const float bv = brow[dd]; P1[r] = inw ? P1[r] + bv : -1e30f; } } } } \
    _Pragma("unroll") for (int r = 0; r < 16; ++r) P0[r] = fast_exp2(P0[r]); } while (0)
#define PK4(P, BASE, OUT) do { u32x4 w = {cvtpk(P[BASE + 0], P[BASE + 1]), cvtpk(P[BASE + 2], P[BASE + 3]), cvtpk(P[BASE + 4], P[BASE + 5]), cvtpk(P[BASE + 6], P[BASE + 7])}; \
    OUT = *reinterpret_cast<bf16x8*>(&w); } while (0)
#define FINISH(P0, P1) do { \
    _Pragma("unroll") for (int r = 0; r < 16; ++r) P1[r] = fast_exp2(P1[r]); \
    float ps = 0.f; \
    _Pragma("unroll") for (int r = 0; r < 16; ++r) ps += P0[r]; \
    _Pragma("unroll") for (int r = 0; r < 16; ++r) ps += P1[r]; \
    l_reg += ps; \
    PK4(P0, 0, pa0); PK4(P0, 8, pa1); PK4(P1, 0, pa2); PK4(P1, 8, pa3); } while (0)
#define PV(b) do { const unsigned _vb = vb0 + (unsigned)(b) * 16384u; \
    pv_step<0, NO>(o, _vb, pa0); pv_step<1, NO>(o, _vb, pa1); pv_step<2, NO>(o, _vb, pa2); pv_step<3, NO>(o, _vb, pa3); } while (0)
    f32x16 pA0, pA1, pB0, pB1; bf16x8 pa0, pa1, pa2, pa3;
    DMA(0); DMA_SYNC();
    DMA(1);
    QKT(pA0, pA1, 0); PARTIAL(pA0, pA1, 0);
    DMA_SYNC();
    int bm1 = 0, bj = 1, bn = 2;
    for (int j = 1; j + 1 < NT; j += 2) {
        DMA(j + 1);
        SBAR(); QKT(pB0, pB1, bj);
        FINISH(pA0, pA1); SBAR();
        PV(bm1); PARTIAL(pB0, pB1, j);
        DMA_SYNC();
        if (j + 2 < NT) DMA(j + 2);
        SBAR(); QKT(pA0, pA1, bn);
        FINISH(pB0, pB1); SBAR();
        PV(bj); PARTIAL(pA0, pA1, j + 1);
        DMA_SYNC();
        { const int t0 = bm1; bm1 = bn; bn = bj; bj = t0; }
    }
    SBAR(); QKT(pB0, pB1, bj);
    FINISH(pA0, pA1); SBAR();
    PV(bm1); PARTIAL(pB0, pB1, NT - 1);
    FINISH(pB0, pB1); SBAR();
    PV(bj);
    __syncthreads();
#undef TILE_ROW
#undef DMA
#undef DMA_SYNC
#undef QKT
#undef PARTIAL
#undef PK4
#undef FINISH
#undef PV
    const int tid_e = opaque_tid(), lane_e = tid_e & 63, r32e = lane_e & 31, hie = lane_e >> 5;
    { auto rr = __builtin_amdgcn_permlane32_swap(__float_as_uint(l_reg), __float_as_uint(l_reg), false, false); l_reg = __uint_as_float(rr[0]) + __uint_as_float(rr[1]); }
    if (hie == 0) li_l[r32e] = fmaxf(l_reg, 1e-37f); LDS_WAIT();
    float rli[16];
#pragma unroll
    for (int r = 0; r < 16; ++r) rli[r] = fast_rcp(li_l[crow(r, hie)]);
    if (MODE != 1) {
        bf16_t* Ow = a.O + (size_t)(a.q_row0 + wid * 32) * a.ldo + a.ocol + r32e;
#pragma unroll
        for (int r = 0; r < 16; ++r) { const int orow = crow(r, hie);
#pragma unroll
            for (int d0 = 0; d0 < NO; ++d0) Ow[(size_t)orow * a.ldo + d0 * 32] = f2bf(o[d0][r] * rli[r]); }
    } else {
        LAS float* cb = (LAS float*)lds;
        if (wmap == 1) {
#pragma unroll
            for (int r = 0; r < 16; ++r) { const int row = wq * 32 + crow(r, hie);
#pragma unroll
                for (int d0 = 0; d0 < NO; ++d0) cb[row * 129 + d0 * 32 + r32e] = a.lam * o[d0][r] * rli[r]; }
        }
        __syncthreads();
        if (wmap == 0) {
#pragma unroll
            for (int r = 0; r < 16; ++r) { const int row = wq * 32 + crow(r, hie);
#pragma unroll
                for (int d0 = 0; d0 < NO; ++d0) { const int ix = row * 129 + d0 * 32 + r32e; cb[ix] = o[d0][r] * rli[r] - cb[ix]; } }
        }
        __syncthreads();
        const int row = tid_e >> 2, qd = tid_e & 3;
        float v[32]; float ss = 0.f;
#pragma unroll
        for (int i = 0; i < 32; ++i) { v[i] = cb[row * 129 + qd * 32 + i]; ss += v[i] * v[i]; }
        ss += __shfl_xor(ss, 1); ss += __shfl_xor(ss, 2);
        const float rstd = rsqrtf(ss * (1.f / 128.f) + EPS) * a.oscale;
        bf16_t* Ow = a.O + (size_t)(a.q_row0 + row) * a.ldo + a.ocol + qd * 32;
#pragma unroll
        for (int c = 0; c < 4; ++c) { float w[8];
#pragma unroll
            for (int e = 0; e < 8; ++e) w[e] = v[c * 8 + e] * rstd * a.subg[qd * 32 + c * 8 + e];
            u32x4 pk = {cvtpk(w[0], w[1]), cvtpk(w[2], w[3]), cvtpk(w[4], w[5]), cvtpk(w[6], w[7])};
            *(u32x4*)(Ow + c * 8) = pk; }
    }
    __syncthreads();
}

__device__ __forceinline__ void sgu_unit(LAS unsigned char* lds, const bf16_t* PB, const bf16_t* Wsb, const float* bs, const float* stats, const float* sgain, bf16_t* MIX, int rowbase, int g) {
    const int tid = opaque_tid(), wid = __builtin_amdgcn_readfirstlane(tid >> 6), lane = tid & 63, r32 = lane & 31, hi = lane >> 5;
    LAS unsigned char* Vl = lds;
#pragma unroll 2
    for (int i = 0; i < 4; ++i) { const int c = tid + 512 * i, row = c >> 4, ch = c & 15;
        const u32x4 x = *(const u32x4*)(PB + (size_t)(rowbase + row) * EV_IN + 512 + g * 128 + ch * 8);
        const f32x4* st = (const f32x4*)(stats + (size_t)(rowbase + row) * 16); const f32x4 a0 = st[0], a1 = st[1], a2 = st[2], a3 = st[3];
        const float s1 = ((a0[0] + a0[2]) + (a1[0] + a1[2])) + ((a2[0] + a2[2]) + (a3[0] + a3[2])), s2 = ((a0[1] + a0[3]) + (a1[1] + a1[3])) + ((a2[1] + a2[3]) + (a3[1] + a3[3]));
        const float mean = s1 * (1.f / 512.f), rstd = rsqrtf(fmaxf(s2 * (1.f / 512.f) - mean * mean, 0.f) + EPS);
        const f32x4 g0 = *(const f32x4*)(sgain + g * 128 + ch * 8), g1 = *(const f32x4*)(sgain + g * 128 + ch * 8 + 4);
        u32x4 y; y.x = cvtpk((bflo(x.x) - mean) * rstd * g0[0], (bfhi(x.x) - mean) * rstd * g0[1]); y.y = cvtpk((bflo(x.y) - mean) * rstd * g0[2], (bfhi(x.y) - mean) * rstd * g0[3]);
        y.z = cvtpk((bflo(x.z) - mean) * rstd * g1[0], (bfhi(x.z) - mean) * rstd * g1[1]); y.w = cvtpk((bflo(x.w) - mean) * rstd * g1[2], (bfhi(x.w) - mean) * rstd * g1[3]);
        *(LAS u32x4*)(Vl + (row >> 6) * 16384 + v_st(row & 63, ch * 8)) = y; }
    const int prow = (wid & 3) * 32, dh = wid >> 2;
    bf16x8 pa[2][4];
#pragma unroll
    for (int kt = 0; kt < 2; ++kt)
#pragma unroll
        for (int ks = 0; ks < 4; ++ks) pa[kt][ks] = *(const bf16x8*)(Wsb + (size_t)(g * 128 + prow + r32) * 128 + kt * 64 + ks * 16 + hi * 8);
    __syncthreads();
    f32x16 o[2];
    o[0] = (f32x16){0.f, 0.f, 0.f, 0.f, 0.f, 0.f, 0.f, 0.f, 0.f, 0.f, 0.f, 0.f, 0.f, 0.f, 0.f, 0.f}; o[1] = o[0];
    const unsigned vb0 = (unsigned)(size_t)Vl + (unsigned)v_rd_base(lane);
#pragma unroll
    for (int kt = 0; kt < 2; ++kt) { const unsigned vb = vb0 + kt * 16384u;
        if (dh == 0) { pv_one<0>(o[0], vb, pa[kt][0], pa[kt][1], pa[kt][2], pa[kt][3]); pv_one<1>(o[1], vb, pa[kt][0], pa[kt][1], pa[kt][2], pa[kt][3]); }
        else { pv_one<2>(o[0], vb, pa[kt][0], pa[kt][1], pa[kt][2], pa[kt][3]); pv_one<3>(o[1], vb, pa[kt][0], pa[kt][1], pa[kt][2], pa[kt][3]); } }
#pragma unroll
    for (int r = 0; r < 16; ++r) { const int p = prow + crow(r, hi); const float bias = bs[g * 128 + p];
#pragma unroll
        for (int dd = 0; dd < 2; ++dd) { const int d = (2 * dh + dd) * 32 + r32;
            const float u = bf2f(PB[(size_t)(rowbase + p) * EV_IN + g * 128 + d]);
            MIX[(size_t)(rowbase + p) * DM + g * 128 + d] = f2bf(u * (o[dd][r] + bias)); } }
    __syncthreads();
}
}

struct Params {
    const float* in[31];
    float* out;
    unsigned char* ws;
    int ph_lo, ph_hi;
};

struct Ctx {
    LAS unsigned char* lds;
    int tid, lane, wid, gw, NGW;
};
__device__ __forceinline__ Ctx make_ctx(LAS unsigned char* lds) { const int t = opaque_tid(), w = __builtin_amdgcn_readfirstlane(t >> 6); return Ctx{lds, t, t & 63, w, opaque_bid() * 8 + w, (int)gridDim.x * 8}; }
typedef const __attribute__((address_space(4))) Params KParams;
__device__ __forceinline__ KParams& kparams() { KParams* p = (KParams*)__builtin_amdgcn_kernarg_segment_ptr(); asm volatile("" : "+s"(p)); return *p; }

__device__ __forceinline__ bf16_t* xrow_ptr(KParams& P, int row) { return (bf16_t*)(P.ws + WS_U + U_XB) + (size_t)row * DM; }
__device__ __forceinline__ int mod_r(int row) { return row < NLAT ? (row >> 13) : 4; }
__device__ __forceinline__ f32x4 ld4(const float* p) { return *(const f32x4*)p; }
__device__ __forceinline__ f32x4 ldbf4(const bf16_t* p) { const u32x2 w = *(const u32x2*)p; return (f32x4){bflo(w.x), bfhi(w.x), bflo(w.y), bfhi(w.y)}; }
__device__ __forceinline__ void stbf4(bf16_t* p, f32x4 v) { u32x2 w; w.x = cvtpk(v[0], v[1]); w.y = cvtpk(v[2], v[3]); *(u32x2*)p = w; }
__device__ __forceinline__ float sumsq4(const f32x4 (&v)[4]) { float s = 0.f;
#pragma unroll
    for (int j = 0; j < 4; ++j) s += (v[j][0] * v[j][0] + v[j][1] * v[j][1]) + (v[j][2] * v[j][2] + v[j][3] * v[j][3]);
    return wave_sum(s); }
__device__ __forceinline__ void norm_mod(const f32x4 (&x)[4], f32x4 (&hv)[4], const float* gain, const float* shift, const float* scale, int lane) {
    const float rstd = rsqrtf(sumsq4(x) * (1.f / DM) + EPS);
#pragma unroll
    for (int j = 0; j < 4; ++j) { const int c = 4 * lane + 256 * j; const f32x4 g = ld4(gain + c), sh = ld4(shift + c), sc = ld4(scale + c);
        hv[j] = (x[j] * rstd) * g * (sc + 1.f) + sh; }
}
__device__ __forceinline__ void resid_add(f32x4 (&x)[4], const f32x4 (&y)[4], const float* gain, const float* gate, int lane) {
    const float rstd = rsqrtf(sumsq4(y) * (1.f / DM) + EPS);
#pragma unroll
    for (int j = 0; j < 4; ++j) { const int c = 4 * lane + 256 * j; const f32x4 g = ld4(gain + c), gt = ld4(gate + c);
        x[j] = x[j] + gt * ((y[j] * rstd) * g); }
}

__device__ __forceinline__ void wave_rows(const Ctx& c, int mtok, int& r0, int& r1) {
    const int bid = opaque_bid(); const int rpw = mtok / (int)gridDim.x, base = bid * rpw;
    r0 = base + (c.wid * rpw) / 8; r1 = base + ((c.wid + 1) * rpw) / 8;
    if (bid == (int)gridDim.x - 1 && c.wid == 7) r1 = mtok;
}
__device__ __forceinline__ void ld_gate(f32x4 (&G)[4], const float* gain, const float* gate, int lane) {
#pragma unroll
    for (int j = 0; j < 4; ++j) { const int cc = 4 * lane + 256 * j; G[j] = ld4(gain + cc) * ld4(gate + cc); } }
__device__ __forceinline__ void ld_mod(f32x4 (&A)[4], f32x4 (&B)[4], const float* gain, const float* shift, const float* scale, int lane) {
#pragma unroll
    for (int j = 0; j < 4; ++j) { const int cc = 4 * lane + 256 * j; A[j] = ld4(gain + cc) * (ld4(scale + cc) + 1.f); B[j] = ld4(shift + cc); } }
__device__ __forceinline__ void resid_add2(f32x4 (&x)[4], const f32x4 (&y)[4], const f32x4 (&G)[4]) {
    const float rstd = rsqrtf(sumsq4(y) * (1.f / DM) + EPS);
#pragma unroll
    for (int j = 0; j < 4; ++j) x[j] = x[j] + G[j] * (y[j] * rstd);
}
__device__ __forceinline__ void norm_mod2(const f32x4 (&x)[4], f32x4 (&hv)[4], const f32x4 (&A)[4], const f32x4 (&B)[4]) {
    const float rstd = rsqrtf(sumsq4(x) * (1.f / DM) + EPS);
#pragma unroll
    for (int j = 0; j < 4; ++j) hv[j] = (x[j] * rstd) * A[j] + B[j];
}

__device__ __forceinline__ int perm_row(int pmode, int n) {
    if (pmode == 1) { if (n >= 1024 && n < 2048) { const int d = n & 63, hb = n & ~63; return hb + ((d < 32) ? 8 * (d >> 2) + (d & 3) : 8 * ((d - 32) >> 2) + 4 + (d & 3)); } }
    else if (pmode == 2) { if (n >= 1920 && n < 1952) { const int d = n - 1920; return 1920 + ((d < 16) ? 8 * (d >> 2) + (d & 3) : 8 * ((d - 16) >> 2) + 4 + (d & 3)); } }
    return n;
}
__device__ __forceinline__ void tr_item(const float* W, int ldw, bf16_t* WT, int ldt, int k0, int n0, int drow, LAS float* scr, int lane, int pmode = 0) {
#pragma unroll 8
    for (int i = 0; i < 32; ++i) { const int kk = 2 * i + (lane >> 5); scr[kk * 33 + (lane & 31)] = W[(size_t)(k0 + kk) * ldw + n0 + (lane & 31)]; }
    LDS_WAIT(); asm volatile("" ::: "memory");
    const int c = lane & 7;
#pragma unroll
    for (int j = 0; j < 4; ++j) { const int n = (lane >> 3) + 8 * j; const LAS float* s = scr + (8 * c) * 33 + n;
        u32x4 o; o.x = cvtpk(s[0 * 33], s[1 * 33]); o.y = cvtpk(s[2 * 33], s[3 * 33]); o.z = cvtpk(s[4 * 33], s[5 * 33]); o.w = cvtpk(s[6 * 33], s[7 * 33]);
        const int dr = pmode ? perm_row(pmode, n0 + n) : drow + n;
        *(u32x4*)(WT + (size_t)dr * ldt + k0 + 8 * c) = o; }
    LDS_WAIT(); asm volatile("" ::: "memory");
}
__device__ __forceinline__ void tr_item8(const float* W, int ldw, unsigned char* WT, int ldt, int k0, int n0, int drow, LAS float* scr, int lane, int pmode = 0) {
#pragma unroll 8
    for (int i = 0; i < 32; ++i) { const int kk = 2 * i + (lane >> 5); scr[kk * 33 + (lane & 31)] = W[(size_t)(k0 + kk) * ldw + n0 + (lane & 31)] * F8_W_SCALE; }
    LDS_WAIT(); asm volatile("" ::: "memory");
    const int c = lane & 7;
#pragma unroll
    for (int j = 0; j < 4; ++j) { const int n = (lane >> 3) + 8 * j; const LAS float* s = scr + (8 * c) * 33 + n;
        u32x2 o; o.x = pk4_fp8(s[0 * 33], s[1 * 33], s[2 * 33], s[3 * 33]); o.y = pk4_fp8(s[4 * 33], s[5 * 33], s[6 * 33], s[7 * 33]);
        const int dr = pmode ? perm_row(pmode, n0 + n) : drow + n;
        *(u32x2*)(WT + (size_t)dr * ldt + k0 + 8 * c) = o; }
    LDS_WAIT(); asm volatile("" ::: "memory");
}
__device__ __forceinline__ void tr_matrix8(const Ctx& c, const float* W, int K, int N, unsigned char* WT, int mode, int row_off, int pmode = 0) {
    LAS float* scr = (LAS float*)(c.lds + c.wid * 16384);
    const int nblk = N / 32, nitems = (K / 64) * nblk;
    for (int it = c.gw; it < nitems; it += c.NGW) { const int kb = it / nblk, nb = it % nblk, n0 = 32 * nb;
        const int drow = (mode == 0) ? row_off + n0 : (n0 >> 7) * 256 + (n0 & 127) + (mode == 2 ? 128 : 0);
        tr_item8(W, N, WT, K, 64 * kb, n0, drow, scr, c.lane, pmode); }
}
__device__ __forceinline__ void tr_matrix(const Ctx& c, const float* W, int K, int N, bf16_t* WT, int mode, int row_off, int pmode = 0) {
    LAS float* scr = (LAS float*)(c.lds + c.wid * 16384);
    const int nblk = N / 32, nitems = (K / 64) * nblk;
    for (int it = c.gw; it < nitems; it += c.NGW) { const int kb = it / nblk, nb = it % nblk, n0 = 32 * nb;
        const int drow = (mode == 0) ? row_off + n0 : (n0 >> 7) * 256 + (n0 & 127) + (mode == 2 ? 128 : 0);
        tr_item(W, N, WT, K, 64 * kb, n0, drow, scr, c.lane, pmode); }
}
constexpr int MOE_CVT_ITEMS = 24 * 1792;
__device__ __forceinline__ void convert_moe_items(const Ctx& c, int i, int t0, int t1, int wsel, int nsel) {
    KParams& P = kparams();
    LAS float* scr = (LAS float*)(c.lds + c.wid * 16384);
    if (wsel < 0) return;
    for (int t = t0 + wsel; t < t1; t += nsel) {
        const int mat = t / 1792, r = t % 1792, e = mat / 3, which = mat % 3;
        if (which < 2) {
            const float* W = P.in[28 + which] + ((size_t)i * NEXP + e) * DM * DFFE; const int kb = r / 112, n0 = 32 * (r % 112);
            const int drow = (n0 >> 7) * 256 + (n0 & 127) + which * 128;
#if MOE_F8
            tr_item8(W, DFFE, (unsigned char*)(P.ws + WS_W13M) + (size_t)e * 2 * DFFE * DM, DM, 64 * kb, n0, drow, scr, c.lane);
#else
            tr_item(W, DFFE, (bf16_t*)(P.ws + WS_W13M) + (size_t)e * 2 * DFFE * DM, DM, 64 * kb, n0, drow, scr, c.lane);
#endif
        } else {
            const float* W = P.in[30] + ((size_t)i * NEXP + e) * DFFE * DM; const int kb = r / 32, n0 = 32 * (r % 32);
#if MOE_F8
            tr_item8(W, DM, (unsigned char*)(P.ws + WS_W2M) + (size_t)e * DM * DFFE, DFFE, 64 * kb, n0, n0, scr, c.lane);
#else
            tr_item(W, DM, (bf16_t*)(P.ws + WS_W2M) + (size_t)e * DM * DFFE, DFFE, 64 * kb, n0, n0, scr, c.lane);
#endif
        }
    }
}
__device__ __forceinline__ void prologue0(const Ctx& c_) {
    const Ctx c = make_ctx(c_.lds);
    KParams& P = kparams(); unsigned char* ws = P.ws;
    if (blockIdx.x < 96) {
        LAS float* sl = (LAS float*)c.lds;
        LAS float* part = (LAS float*)(c.lds + 32768);
        for (int i = c.tid; i < 5 * DM; i += 512) { const int r = i >> 10, k = i & 1023; const float x = r < 4 ? P.in[1][r * DM + k] : P.in[3][k]; sl[i] = x / (1.f + expf(-x)); }
        __syncthreads();
        const int t = blockIdx.x, lm = t / 24, cbk = t % 24, n = cbk * 256 + 4 * c.lane;
        const float* W = P.in[4] + (size_t)lm * DM * (NMOD * DM) + n;
        f32x4 acc[5];
#pragma unroll
        for (int r = 0; r < 5; ++r) acc[r] = (f32x4){0.f, 0.f, 0.f, 0.f};
        const int kb = c.wid * 128;
        for (int k0 = 0; k0 < 128; k0 += 8) {
            f32x4 wv[8];
#pragma unroll
            for (int u = 0; u < 8; ++u) wv[u] = ld4(W + (size_t)(kb + k0 + u) * (NMOD * DM));
#pragma unroll
            for (int u = 0; u < 8; ++u)
#pragma unroll
                for (int r = 0; r < 5; ++r) acc[r] += wv[u] * sl[r * DM + kb + k0 + u];
        }
#pragma unroll
        for (int r = 0; r < 5; ++r) *(LAS f32x4*)(part + (c.wid * 5 + r) * 256 + 4 * c.lane) = acc[r];
        __syncthreads();
        for (int i = c.tid; i < 5 * 256; i += 512) { const int r = i >> 8, cc = i & 255; float s = 0.f;
#pragma unroll
            for (int w = 0; w < 8; ++w) s += part[(w * 5 + r) * 256 + cc];
            ((float*)(ws + WS_MODS))[(size_t)(lm * 5 + r) * (NMOD * DM) + cbk * 256 + cc] = s + P.in[5][lm * (NMOD * DM) + cbk * 256 + cc]; }
        __syncthreads();
    }
    for (int i = 0; i < 2; ++i) {
        if (WIN8(2 * i)) tr_matrix8(c, P.in[7] + (size_t)i * DM * EV_IN, DM, EV_IN, (unsigned char*)(ws + WS_WINE) + (size_t)i * EV_IN * DM * 2, 0, 0, 1);
        else tr_matrix(c, P.in[7] + (size_t)i * DM * EV_IN, DM, EV_IN, (bf16_t*)(ws + WS_WINE) + (size_t)i * EV_IN * DM, 0, 0, 1);
        tr_matrix(c, P.in[8] + (size_t)i * DM * DM, DM, DM, (bf16_t*)(ws + WS_WOUTE) + (size_t)i * DM * DM, 0, 0);
        if (FFN8(i)) {
            tr_matrix8(c, P.in[17] + (size_t)i * DM * DFF, DM, DFF, (unsigned char*)(ws + WS_W13E) + (size_t)i * 2 * DFF * DM * 2, 1, 0);
            tr_matrix8(c, P.in[18] + (size_t)i * DM * DFF, DM, DFF, (unsigned char*)(ws + WS_W13E) + (size_t)i * 2 * DFF * DM * 2, 2, 0);
            tr_matrix8(c, P.in[19] + (size_t)i * DFF * DM, DFF, DM, (unsigned char*)(ws + WS_W2E) + (size_t)i * DM * DFF * 2, 0, 0);
        } else {
            tr_matrix(c, P.in[17] + (size_t)i * DM * DFF, DM, DFF, (bf16_t*)(ws + WS_W13E) + (size_t)i * 2 * DFF * DM, 1, 0);
            tr_matrix(c, P.in[18] + (size_t)i * DM * DFF, DM, DFF, (bf16_t*)(ws + WS_W13E) + (size_t)i * 2 * DFF * DM, 2, 0);
            tr_matrix(c, P.in[19] + (size_t)i * DFF * DM, DFF, DM, (bf16_t*)(ws + WS_W2E) + (size_t)i * DM * DFF, 0, 0);
        }
        if (WIN8(2 * i + 1)) tr_matrix8(c, P.in[20] + (size_t)i * DM * OD_IN, DM, OD_IN, (unsigned char*)(ws + WS_WINO) + (size_t)i * OD_INP * DM * 2, 0, 0, 2);
        else tr_matrix(c, P.in[20] + (size_t)i * DM * OD_IN, DM, OD_IN, (bf16_t*)(ws + WS_WINO) + (size_t)i * OD_INP * DM, 0, 0, 2);
        tr_matrix(c, P.in[21] + (size_t)i * DM * DM, DM, DM, (bf16_t*)(ws + WS_WOUTO) + (size_t)i * DM * DM, 0, 0);
    }
    const int gt = blockIdx.x * 512 + c.tid, NGT = gridDim.x * 512;
    for (int i = gt; i < 2 * (OD_INP - OD_IN) * DM; i += NGT) { const int l = i / ((OD_INP - OD_IN) * DM), r = i % ((OD_INP - OD_IN) * DM);
        if (WIN8(2 * l + 1)) ((unsigned char*)(ws + WS_WINO))[(size_t)l * OD_INP * DM * 2 + (size_t)OD_IN * DM + r] = 0;
        else ((bf16_t*)(ws + WS_WINO))[(size_t)l * OD_INP * DM + (size_t)OD_IN * DM + r] = 0; }
    for (int i = gt; i < 2 * MLA_N * MLA_K; i += NGT) { const int l = i / (MLA_N * MLA_K), n = (i / MLA_K) % MLA_N, k = i % MLA_K; float v = 0.f;
        if (n < 384) { if (k < 256) { const int h = n / 96, j = n % 96; int sc = n;
                if (j >= 64) { const int p = j - 64, t = p >> 3, e = p & 7; sc = h * 96 + 64 + ((e < 4) ? 4 * t + e : 16 + 4 * t + (e - 4)); }
                v = P.in[24][((size_t)l * 256 + k) * 384 + sc] * P.in[23][l * 256 + k]; } }
        else if (n < 768) { const int h = (n - 384) / 96, j = (n - 384) % 96;
            if (j < 64) { if (k >= 256 && k < 384) v = P.in[26][((size_t)l * 128 + (k - 256)) * 768 + h * 192 + j] * P.in[25][l * 128 + (k - 256)]; }
            else { if (k == 384 + (j - 64)) v = 1.f; } }
        else { const int h = (n - 768) / 128, j = (n - 768) % 128; if (k >= 256 && k < 384) v = P.in[26][((size_t)l * 128 + (k - 256)) * 768 + h * 192 + 64 + j] * P.in[25][l * 128 + (k - 256)]; }
        ((bf16_t*)(ws + WS_WMLA))[i] = f2bf(v); }
    for (int i = gt; i < 2 * 4 * 128 * 128; i += NGT) ((bf16_t*)(ws + WS_SGUW))[i] = f2bf(P.in[9][i]);
    for (int i = gt; i < SEQ * 32; i += NGT) { const int s = i >> 5, f = i & 31; const int pos = f < 16 ? (s >> 6) : (s & 63);
        const float inv = 1.0f / powf(10000.0f, (float)(f & 15) / 16.0f); const float ang = (float)pos * inv;
        ((float*)(ws + WS_ROPEB))[i] = (float)cos((double)ang); ((float*)(ws + WS_ROPEB))[SEQ * 32 + i] = (float)sin((double)ang); }
    for (int i = gt; i < SEQ * 16; i += NGT) { const int s = i >> 4, f = i & 15; const int pos = f < 8 ? (s >> 6) : (s & 63);
        const float inv = 1.0f / powf(10000.0f, (float)(f & 7) / 8.0f); const float ang = (float)pos * inv;
        ((float*)(ws + WS_ROPED))[i] = (float)cos((double)ang); ((float*)(ws + WS_ROPED))[SEQ * 16 + i] = (float)sin((double)ang); }
}

__device__ __forceinline__ void convert_moe_tail(const Ctx& c_, int i, int t0, int t1, int nunits) {
    const Ctx c = make_ctx(c_.lds);
    const int G = (int)gridDim.x, rem = nunits % G, bid = opaque_bid();
    const int first = rem;
    convert_moe_items(c, i, t0, t1, bid >= first ? (bid - first) * 8 + c.wid : -1, (G - first) * 8);
}

__device__ __forceinline__ void ew_first(const Ctx& c_) {
    const Ctx c = make_ctx(c_.lds);
    KParams& P = kparams(); const float* mods = (const float*)(P.ws + WS_MODS); bf16_t* HB = (bf16_t*)(P.ws + WS_HB);
    int r0, r1; wave_rows(c, MTOT, r0, r1);
    f32x4 A0[4], B0[4]; int rcur = -1;
    for (int row = r0; row < r1; ++row) {
        const float* src = row < NLAT ? P.in[0] + (size_t)row * DM : P.in[2] + (size_t)(row - NLAT) * DM;
        bf16_t* xr = xrow_ptr(P, row); const int r = mod_r(row);
        if (r != rcur) { rcur = r; const float* mb = mods + (size_t)(0 * 5 + r) * (NMOD * DM); ld_mod(A0, B0, P.in[6] + (0 * 4 + 0) * DM, mb + 0 * DM, mb + 1 * DM, c.lane); }
        f32x4 x[4], h[4];
#pragma unroll
        for (int j = 0; j < 4; ++j) { x[j] = ld4(src + 4 * c.lane + 256 * j); stbf4(xr + 4 * c.lane + 256 * j, x[j]); }
        norm_mod2(x, h, A0, B0);
#pragma unroll
        for (int j = 0; j < 4; ++j) stbf4(HB + (size_t)row * DM + 4 * c.lane + 256 * j, h[j]);
    }
}

__device__ __forceinline__ void ew_mid(const Ctx& c_, int l, int mtok, bool dry = false) {
    const Ctx c = make_ctx(c_.lds);
    KParams& P = kparams(); const float* mods = (const float*)(P.ws + WS_MODS); bf16_t* HB = (bf16_t*)(P.ws + WS_HB);
    const bf16_t* YB = (const bf16_t*)(P.ws + WS_U + U_YB);
    const bool odd = (l & 1) != 0; const int li = l >> 1;
    LAS float* wrl = (LAS float*)c.lds;
    if (odd) { for (int i = c.tid; i < DM * NEXP; i += 512) { const int col = i >> 3, e = i & 7; wrl[e * DM + col] = P.in[27][(size_t)li * DM * NEXP + i]; } __syncthreads(); }
    unsigned long long cw = 0ull; int st_e1 = 0, st_e2 = 0, st_l1 = 0, st_l2 = 0; float st_g1 = 0.f; int nrow = 0;
    int r0, r1; wave_rows(c, mtok, r0, r1);
    f32x4 G1[4], A2[4], B2[4]; int rcur = -1;
    u32x2 xa[4], ya[4], xb[4], yb[4];
#define EWM_LOAD(X, Y, rw) do { const int _row = (rw); const bf16_t* _xr = xrow_ptr(P, _row); \
        _Pragma("unroll") for (int j = 0; j < 4; ++j) { X[j] = *(const u32x2*)(_xr + 4 * c.lane + 256 * j); Y[j] = *(const u32x2*)(YB + (size_t)_row * DM + 4 * c.lane + 256 * j); } } while (0)
    if (r0 < r1) EWM_LOAD(xa, ya, r0);
    if (r0 + 1 < r1) EWM_LOAD(xb, yb, r0 + 1);
    for (int row = r0; row < r1; ++row, ++nrow) {
        bf16_t* xr = xrow_ptr(P, row); const int r = mod_r(row);
        if (r != rcur) { rcur = r; const float* mb = mods + (size_t)(l * 5 + r) * (NMOD * DM);
            ld_gate(G1, P.in[6] + (l * 4 + 1) * DM, mb + 2 * DM, c.lane); ld_mod(A2, B2, P.in[6] + (l * 4 + 2) * DM, mb + 3 * DM, mb + 4 * DM, c.lane); }
        f32x4 x[4], y[4], h[4];
#pragma unroll
        for (int j = 0; j < 4; ++j) { x[j] = (f32x4){bflo(xa[j].x), bfhi(xa[j].x), bflo(xa[j].y), bfhi(xa[j].y)}; y[j] = (f32x4){bflo(ya[j].x), bfhi(ya[j].x), bflo(ya[j].y), bfhi(ya[j].y)}; xa[j] = xb[j]; ya[j] = yb[j]; }
        if (row + 2 < r1) EWM_LOAD(xb, yb, row + 2);
        resid_add2(x, y, G1);
        bf16_t* xw = dry ? (bf16_t*)(P.ws + WS_U + U_YS) + (size_t)row * DM : xr; bf16_t* hw = (dry ? (bf16_t*)(P.ws + WS_U + U_PB) : HB) + (size_t)row * DM;
#pragma unroll
        for (int j = 0; j < 4; ++j) stbf4(xw + 4 * c.lane + 256 * j, x[j]);
        norm_mod2(x, h, A2, B2);
        if ((odd && MOE_F8) || (!odd && FFN8(li))) {
            unsigned char* h8 = (unsigned char*)(dry ? (bf16_t*)(P.ws + WS_U + U_PB) : HB) + (size_t)row * DM;
#pragma unroll
            for (int j = 0; j < 4; ++j) *(unsigned*)(h8 + 4 * c.lane + 256 * j) = pk4_fp8(h[j][0] * F8_ACT_SCALE, h[j][1] * F8_ACT_SCALE, h[j][2] * F8_ACT_SCALE, h[j][3] * F8_ACT_SCALE);
        } else {
#pragma unroll
            for (int j = 0; j < 4; ++j) stbf4(hw + 4 * c.lane + 256 * j, h[j]);
        }
        if (odd && !dry) {
            float lg[8];
#pragma unroll
            for (int e = 0; e < 8; ++e) { float sacc = 0.f;
#pragma unroll
                for (int j = 0; j < 4; ++j) { const f32x4 w = *(const LAS f32x4*)(wrl + e * DM + 4 * c.lane + 256 * j); sacc += (h[j][0] * w[0] + h[j][1] * w[1]) + (h[j][2] * w[2] + h[j][3] * w[3]); }
                lg[e] = wave_sum(sacc); }
            int e1 = 0; float v1 = lg[0];
#pragma unroll
            for (int e = 1; e < 8; ++e) if (lg[e] > v1) { v1 = lg[e]; e1 = e; }
            int e2 = -1; float v2 = -3.0e38f;
#pragma unroll
            for (int e = 0; e < 8; ++e) if (e != e1 && lg[e] > v2) { v2 = lg[e]; e2 = e; }
            if (e2 < 0) e2 = (e1 + 1) & 7;
            const float g1 = 1.f / (1.f + expf(v2 - v1));
            const int l1 = (int)((cw >> (8 * e1)) & 0xffull); cw += 1ull << (8 * e1);
            const int l2 = (int)((cw >> (8 * e2)) & 0xffull); cw += 1ull << (8 * e2);
            if (c.lane == nrow) { st_e1 = e1; st_e2 = e2; st_l1 = l1; st_l2 = l2; st_g1 = g1; }
        }
    }
    if (odd && !dry) {
        unsigned* cnt = (unsigned*)(P.ws + WS_CTL) + CW_MOECNT + li * 64;
        int base = 0;
        if (c.lane < 8) { const unsigned wc = (unsigned)((cw >> (8 * c.lane)) & 0xffull); base = wc ? (int)atomicAdd(cnt + c.lane, wc) : 0; }
        const int b1 = __shfl(base, st_e1), b2 = __shfl(base, st_e2);
        if (c.lane < nrow) { const int row = r0 + c.lane; int4* ti = (int4*)(P.ws + WS_TOKINFO) + (size_t)row * 2;
            ti[0] = make_int4(st_e1, b1 + st_l1, st_e2, b2 + st_l2); ti[1] = make_int4(__float_as_int(st_g1), __float_as_int(1.f - st_g1), 0, 0); }
        __syncthreads();
    }
#undef EWM_LOAD
}

__device__ __forceinline__ void moe_offsets(KParams& P, int li, int (&toff)[9]) {
    const unsigned* cnt = (const unsigned*)(P.ws + WS_CTL) + CW_MOECNT + li * 64; int acc = 0;
#pragma unroll
    for (int e = 0; e < 8; ++e) { toff[e] = acc; const unsigned n = __builtin_amdgcn_readfirstlane(__hip_atomic_load(cnt + e, __ATOMIC_RELAXED, __HIP_MEMORY_SCOPE_AGENT)); acc += (int)((n + 255u) >> 8); }
    toff[8] = acc;
}
__device__ __forceinline__ void moe_gather(const Ctx& c_, int li, int mtok) {
    const Ctx c = make_ctx(c_.lds);
    KParams& P = kparams(); int toff[9]; moe_offsets(P, li, toff);
    int tv = 0;
#pragma unroll
    for (int e = 0; e < 8; ++e) tv = (c.lane == e) ? toff[e] : tv;
    const bf16_t* HB = (const bf16_t*)(P.ws + WS_HB); bf16_t* HS = (bf16_t*)(P.ws + WS_U + U_YS);
    int r0, r1; wave_rows(c, mtok, r0, r1);
    for (int row = r0; row < r1; ++row) {
        const int4* ti = (const int4*)(P.ws + WS_TOKINFO) + (size_t)row * 2; const int4 a = ti[0], b = ti[1];
        const int pA = __shfl(tv, a.x) * 256 + a.y, pB = __shfl(tv, a.z) * 256 + a.w;
        if (c.lane == 0) ((int4*)(P.ws + WS_TOKPOS))[row] = make_int4(pA, pB, b.x, b.y);
#if MOE_F8
        const u32x4 v0 = ((const u32x4*)((const unsigned char*)HB + (size_t)row * DM))[c.lane];
        ((u32x4*)((unsigned char*)HS + (size_t)pA * DM))[c.lane] = v0; ((u32x4*)((unsigned char*)HS + (size_t)pB * DM))[c.lane] = v0;
#else
        const u32x4* src = (const u32x4*)(HB + (size_t)row * DM); const u32x4 v0 = src[c.lane], v1 = src[64 + c.lane];
        u32x4* dA = (u32x4*)(HS + (size_t)pA * DM); u32x4* dB = (u32x4*)(HS + (size_t)pB * DM);
        dA[c.lane] = v0; dA[64 + c.lane] = v1; dB[c.lane] = v0; dB[64 + c.lane] = v1;
#endif
    }
}

__device__ __forceinline__ void ew_last(const Ctx& c_, int l, int mtok, bool dry = false) {
    const Ctx c = make_ctx(c_.lds);
    KParams& P = kparams(); const float* mods = (const float*)(P.ws + WS_MODS); bf16_t* HB = (bf16_t*)(P.ws + WS_HB);
    const bf16_t* YS = (const bf16_t*)(P.ws + WS_U + U_YS); const bool odd = (l & 1) != 0;
    int r0, r1; wave_rows(c, mtok, r0, r1);
    f32x4 G3[4], A0[4], B0[4]; int rcur = -1;
    u32x2 xa[4], ya[4], za[4], xb[4], yb[4], zb[4]; float gAa = 0.f, gBa = 0.f, gAb = 0.f, gBb = 0.f;
#define EWL_LOAD(X, Y, Z, GA, GB, rw) do { const int _row = (rw); const bf16_t* _xr = xrow_ptr(P, _row); \
        if (odd) { const int4 tp = ((const int4*)(P.ws + WS_TOKPOS))[_row]; GA = __int_as_float(tp.z); GB = __int_as_float(tp.w); \
            _Pragma("unroll") for (int j = 0; j < 4; ++j) { Y[j] = *(const u32x2*)(YS + (size_t)tp.x * DM + 4 * c.lane + 256 * j); Z[j] = *(const u32x2*)(YS + (size_t)tp.y * DM + 4 * c.lane + 256 * j); } } \
        else { _Pragma("unroll") for (int j = 0; j < 4; ++j) Y[j] = *(const u32x2*)(YS + (size_t)_row * DM + 4 * c.lane + 256 * j); } \
        _Pragma("unroll") for (int j = 0; j < 4; ++j) X[j] = *(const u32x2*)(_xr + 4 * c.lane + 256 * j); } while (0)
    if (r0 < r1) EWL_LOAD(xa, ya, za, gAa, gBa, r0);
    if (r0 + 1 < r1) EWL_LOAD(xb, yb, zb, gAb, gBb, r0 + 1);
    for (int row = r0; row < r1; ++row) {
        bf16_t* xr = xrow_ptr(P, row); const int r = mod_r(row);
        if (r != rcur) { rcur = r; const float* mb = mods + (size_t)(l * 5 + r) * (NMOD * DM);
            ld_gate(G3, P.in[6] + (l * 4 + 3) * DM, mb + 5 * DM, c.lane);
            if (l < 3) { const float* mn = mods + (size_t)((l + 1) * 5 + r) * (NMOD * DM); ld_mod(A0, B0, P.in[6] + ((l + 1) * 4 + 0) * DM, mn + 0 * DM, mn + 1 * DM, c.lane); } }
        f32x4 x[4], y[4], h[4];
#pragma unroll
        for (int j = 0; j < 4; ++j) { x[j] = (f32x4){bflo(xa[j].x), bfhi(xa[j].x), bflo(xa[j].y), bfhi(xa[j].y)};
            y[j] = (f32x4){bflo(ya[j].x), bfhi(ya[j].x), bflo(ya[j].y), bfhi(ya[j].y)};
            if (odd) y[j] = y[j] * gAa + (f32x4){bflo(za[j].x), bfhi(za[j].x), bflo(za[j].y), bfhi(za[j].y)} * gBa;
            xa[j] = xb[j]; ya[j] = yb[j]; za[j] = zb[j]; }
        gAa = gAb; gBa = gBb;
        if (row + 2 < r1) EWL_LOAD(xb, yb, zb, gAb, gBb, row + 2);
        resid_add2(x, y, G3);
        bf16_t* hw = (dry ? (bf16_t*)(P.ws + WS_U + U_MIX) : HB) + (size_t)row * DM;
        if (l == 3 && !dry) { float* ow = P.out + (size_t)row * DM;
#pragma unroll
            for (int j = 0; j < 4; ++j) *(f32x4*)(ow + 4 * c.lane + 256 * j) = x[j]; }
        else { bf16_t* xw = dry ? (bf16_t*)(P.ws + WS_U + U_PB) + (size_t)row * DM : xr;
#pragma unroll
            for (int j = 0; j < 4; ++j) stbf4(xw + 4 * c.lane + 256 * j, x[j]); }
        if (l < 3) { norm_mod2(x, h, A0, B0);
            if (WIN8(l + 1)) { unsigned char* h8 = (unsigned char*)(dry ? (bf16_t*)(P.ws + WS_U + U_MIX) : HB) + (size_t)row * DM;
#pragma unroll
                for (int j = 0; j < 4; ++j) *(unsigned*)(h8 + 4 * c.lane + 256 * j) = pk4_fp8(h[j][0] * F8_ACT_SCALE, h[j][1] * F8_ACT_SCALE, h[j][2] * F8_ACT_SCALE, h[j][3] * F8_ACT_SCALE); }
            else {
#pragma unroll
                for (int j = 0; j < 4; ++j) stbf4(hw + 4 * c.lane + 256 * j, h[j]); } }
    }
#undef EWL_LOAD
}

__device__ __forceinline__ void attn_even(const Ctx& c_, int l) {
    const Ctx c = make_ctx(c_.lds);
    KParams& P = kparams(); const int i = l >> 1; const bool need_ctx = l < 3;
    const bf16_t* PB = (const bf16_t*)(P.ws + WS_U + U_PB); bf16_t* MIX = (bf16_t*)(P.ws + WS_U + U_MIX);
    const int nchunk = need_ctx ? 264 : 256;
    for (int u = opaque_bid(); u < nchunk * 4; u += gridDim.x) att::sgu_unit(c.lds, PB, (const bf16_t*)(P.ws + WS_SGUW) + (size_t)i * 4 * 128 * 128, P.in[10] + i * 512, (const float*)(P.ws + WS_STATS), P.in[11] + i * 512, MIX, (u >> 2) * 128, u & 3);
    float d1 = 0.f, d2 = 0.f;
    if (c.lane < 64) { d1 = P.in[12][i * 64 + c.lane] * P.in[13][i * 64 + c.lane]; d2 = P.in[14][i * 64 + c.lane] * P.in[15][i * 64 + c.lane]; }
    const float lam_init = 0.8f - 0.6f * expf(-0.3f * (float)l);
    const float lam = expf(wave_sum(d1)) - expf(wave_sum(d2)) + lam_init;
    att::Args a;
    a.Q = PB; a.ldq = EV_IN; a.K = PB; a.ldk = EV_IN; a.V = PB; a.ldv = EV_IN; a.C = 0.125f * LOG2E;
    a.rcos = (const float*)(P.ws + WS_ROPEB); a.rsin = a.rcos + SEQ * 32; a.O = MIX; a.ldo = DM; a.g = 0; a.u0 = 0; a.rpb = nullptr;
    a.lam = lam; a.oscale = 1.f - lam_init; a.subg = P.in[16] + i * 128; a.nt_ctx = 4;
    const int nctxu = need_ctx ? 32 : 0, nu = nctxu + 1024;
    for (int u = xcd_unit_base(); u < nu; u += gridDim.x) {
        int b, h;
        if (u < nctxu) { b = u >> 3; h = (u >> 1) & 3; a.q_row0 = NLAT + b * CTXL + (u & 1) * 128; a.nt_lat = 0; a.rope = 0; }
        else { const int v = u - nctxu; b = v >> 8; h = (v >> 6) & 3; a.q_row0 = b * SEQ + (v & 63) * 128; a.nt_lat = SEQ / 64; a.rope = 0; }
        a.qcol = 1024 + h * 128; a.kcol = 1536 + h * 128; a.vcol = 2048 + h * 128; a.ocol = 512 + h * 128;
        a.kctx_row0 = NLAT + b * CTXL; a.klat_row0 = b * SEQ;
        att::attn_unit<64, 128, 128, 1>(c.lds, a);
    }
}
__device__ __forceinline__ void attn_odd_na(const Ctx& c_, int l) {
    const Ctx c = make_ctx(c_.lds);
    KParams& P = kparams(); const int i = l >> 1; const bool need_ctx = l < 3;
    const bf16_t* PB = (const bf16_t*)(P.ws + WS_U + U_PB); bf16_t* MIX = (bf16_t*)(P.ws + WS_U + U_MIX);
    att::Args a;
    a.Q = PB; a.ldq = OD_INP; a.K = PB; a.ldk = OD_INP; a.V = PB; a.ldv = OD_INP; a.C = 0.125f * LOG2E; a.rope = 0; a.rcos = nullptr; a.rsin = nullptr;
    a.O = MIX; a.ldo = DM; a.lam = 0.f; a.oscale = 1.f; a.subg = nullptr; a.nt_ctx = 4;
    const int nctxu = need_ctx ? 32 : 0, nu = nctxu + 1024;
    for (int u = xcd_unit_base(); u < nu; u += gridDim.x) {
        int b, h;
        if (u < nctxu) { b = u >> 3; h = u & 7; a.q_row0 = NLAT + b * CTXL; a.nt_lat = 0; a.g = 0; a.u0 = 0; a.klat_row0 = 0; }
        else { const int v = u - nctxu; b = v >> 8; h = (v >> 5) & 7; const int g = v & 31; a.g = g; a.u0 = min(max(4 * g - 4, 0), 116);
            a.q_row0 = b * SEQ + g * 256; a.nt_lat = 12; a.klat_row0 = b * SEQ + a.u0 * 64; }
        a.qcol = h * 64; a.kcol = 512 + h * 64; a.vcol = 1024 + h * 64; a.ocol = h * 64; a.kctx_row0 = NLAT + b * CTXL;
        a.rpb = P.in[22] + ((size_t)i * 8 + h) * 465;
        att::attn_unit<64, 64, 64, 2>(c.lds, a);
    }
}
__device__ __forceinline__ void attn_odd_mla(const Ctx& c_, int l) {
    const Ctx c = make_ctx(c_.lds);
    KParams& P = kparams(); const bool need_ctx = l < 3;
    const bf16_t* MO = (const bf16_t*)(P.ws + WS_U + U_MLAO); bf16_t* MIX = (bf16_t*)(P.ws + WS_U + U_MIX);
    att::Args a;
    a.Q = MO; a.ldq = MLA_N; a.K = MO; a.ldk = MLA_N; a.V = MO; a.ldv = MLA_N; a.C = 0.10206207261596575f * LOG2E;
    a.rcos = (const float*)(P.ws + WS_ROPED); a.rsin = a.rcos + SEQ * 16; a.O = MIX; a.ldo = DM; a.g = 0; a.u0 = 0; a.rpb = nullptr; a.lam = 0.f; a.oscale = 1.f; a.subg = nullptr; a.nt_ctx = 4;
    const int nctxu = need_ctx ? 16 : 0, nu = nctxu + 512;
    for (int u = xcd_unit_base(); u < nu; u += gridDim.x) {
        int b, h;
        if (u < nctxu) { b = u >> 2; h = u & 3; a.q_row0 = NLAT + b * CTXL; a.nt_lat = 0; a.rope = 0; }
        else { const int v = u - nctxu; b = v >> 7; h = (v >> 5) & 3; a.q_row0 = b * SEQ + (v & 31) * 256; a.nt_lat = SEQ / 64; a.rope = 2; }
        a.qcol = h * 96; a.kcol = 384 + h * 96; a.vcol = 768 + h * 128; a.ocol = 512 + h * 128; a.kctx_row0 = NLAT + b * CTXL; a.klat_row0 = b * SEQ;
        att::attn_unit<96, 96, 128, 0>(c.lds, a);
    }
}

constexpr int N_PHASES = 2 + 2 * (7 + 9);
__global__ void __launch_bounds__(512, 2) fwd_kernel(Params prm) {
    extern __shared__ __attribute__((aligned(16))) unsigned char lds_raw[];
    LAS unsigned char* lds = (LAS unsigned char*)lds_raw;
    const Ctx c{lds, 0, 0, 0, 0, 0};
    for (int u = threadIdx.x; u < (LDS_BYTES - LDS_MISC) / 4; u += 512) ((LAS unsigned*)(lds + LDS_MISC))[u] = 0u;
    __syncthreads();
    XcdBarrier bar;
    { unsigned char* ws0 = kparams().ws; bar.bar = (unsigned*)(ws0 + WS_CTL) + CW_BAR; bar.x = 0; bar.st = nullptr;
#if !MK_PER_PHASE
      bar = xcd_barrier_post((unsigned*)(ws0 + WS_CTL) + CW_BAR, (volatile LAS unsigned*)(lds + LDS_MISC + 32));
#endif
    }
    int ph = 0;
#ifndef PMASK
#define PMASK 0xffffffffu
#endif
#define PM(b) ((PMASK >> (b)) & 1u)
#define PH_ON() (ph >= kparams().ph_lo && ph < kparams().ph_hi)
#define PH_END() do { if (ph >= kparams().ph_lo && ph + 1 < kparams().ph_hi) xcd_barrier(bar); ++ph; } while (0)
#define WSP(off) ((bf16_t*)(ws + (off)))
#define HB WSP(WS_HB)
#define PB WSP(WS_U + U_PB)
#define MIX WSP(WS_U + U_MIX)
#define YB WSP(WS_U + U_YB)
#define HID WSP(WS_U + U_HID)
#define YS WSP(WS_U + U_YS)
#define A2 WSP(WS_U + U_A2)
#define MO WSP(WS_U + U_MLAO)

    if (PM(0) && PH_ON()) for (int rep = 0; rep < DUPN(0); ++rep) { prologue0(c); __syncthreads(); }
    PH_END();
    if (PM(1) && PH_ON()) for (int rep = 0; rep < DUPN(1); ++rep) ew_first(c);
    PH_END();
    for (int lp = 0; lp < 2; ++lp) {
        {
            const int l = 2 * lp, i = lp; const int mtok = l < 3 ? MTOT : NLAT, nMt = mtok / 256;
            if (PM(2) && PH_ON()) for (int rep = 0; rep < DUPN(2); ++rep) { unsigned char* ws = kparams().ws; pg8::Gemm g{}; g.A = HB; g.lda = DM; g.Bt = (const unsigned char*)(ws + WS_WINE) + (size_t)i * EV_IN * DM * 2; g.K = DM; g.nM = MTOT / 256; g.nN = EV_IN / 256; g.grouped = 0; g.estride = 0;
                pg8::EpiEvenIn E{PB, EV_IN, (f32x2*)(ws + WS_STATS), (const float*)(ws + WS_ROPEB), (const float*)(ws + WS_ROPEB) + SEQ * 32, WIN8(l) ? F8_INV : 1.f}; if (WIN8(l)) gemm8_even_in(lds, g, E); else gemm_even_in(lds, g, E); if (rep == 0) convert_moe_tail(c, i, 0, 7296, (MTOT / 256) * (EV_IN / 256)); }
            PH_END();
            if (PM(4) && PH_ON()) for (int rep = 0; rep < DUPN(4); ++rep) attn_even(c, l);
            PH_END();
            if (PM(5) && PH_ON()) for (int rep = 0; rep < DUPN(5); ++rep) { unsigned char* ws = kparams().ws; pg8::Gemm g{}; g.A = MIX; g.lda = DM; g.Bt = (const bf16_t*)(ws + WS_WOUTE) + (size_t)i * DM * DM; g.K = DM; g.nM = nMt; g.nN = DM / 256; g.grouped = 0; g.estride = 0;
                gemm_bf16(lds, g, YB, DM); if (rep == 0) convert_moe_tail(c, i, 7296, 14592, nMt * (DM / 256)); }
            PH_END();
            if (PM(6) && PH_ON()) { if (DUPN(6) > 1) ew_mid(c, l, mtok, true); ew_mid(c, l, mtok); }
            PH_END();
            if (PM(7) && PH_ON()) for (int rep = 0; rep < DUPN(7); ++rep) { unsigned char* ws = kparams().ws; pg8::Gemm g{}; g.A = HB; g.lda = DM; g.Bt = (const unsigned char*)(ws + WS_W13E) + (size_t)i * 2 * DFF * DM * 2; g.K = DM; g.nM = nMt; g.nN = 2 * DFF / 256; g.grouped = 0; g.estride = 0;
                if (FFN8(i)) gemm8_swiglu8(lds, g, (unsigned char*)HID, DFF); else gemm_swiglu(lds, g, HID, DFF);
                if (rep == 0) convert_moe_tail(c, i, 14592, 20224, nMt * (2 * DFF / 256)); }
            PH_END();
            if (PM(8) && PH_ON()) for (int rep = 0; rep < DUPN(8); ++rep) { unsigned char* ws = kparams().ws; pg8::Gemm g{}; g.A = HID; g.lda = DFF; g.Bt = (const unsigned char*)(ws + WS_W2E) + (size_t)i * DM * DFF * 2; g.K = DFF; g.nM = nMt; g.nN = DM / 256; g.grouped = 0; g.estride = 0;
                if (FFN8(i)) gemm8_bf16(lds, g, YS, DM); else gemm_bf16(lds, g, YS, DM);
                if (rep == 0) convert_moe_tail(c, i, 20224, MOE_CVT_ITEMS, nMt * (DM / 256)); }
            PH_END();
            if (PM(9) && PH_ON()) { if (DUPN(9) > 1) ew_last(c, l, mtok, true); ew_last(c, l, mtok); }
            PH_END();
        }
        {
            const int l = 2 * lp + 1, i = lp; const int mtok = l < 3 ? MTOT : NLAT, nMt = mtok / 256;
            if (PM(10) && PH_ON()) for (int rep = 0; rep < DUPN(10); ++rep) { unsigned char* ws = kparams().ws; pg8::Gemm g{}; g.A = HB; g.lda = DM; g.Bt = (const unsigned char*)(ws + WS_WINO) + (size_t)i * OD_INP * DM * 2; g.K = DM; g.nM = MTOT / 256; g.nN = OD_INP / 256; g.grouped = 0; g.estride = 0;
                pg8::EpiOddIn E{PB, OD_INP, (float*)(ws + WS_STATS), (const float*)(ws + WS_ROPED), (const float*)(ws + WS_ROPED) + SEQ * 16, WIN8(l) ? F8_INV : 1.f}; if (WIN8(l)) gemm8_odd_in(lds, g, E); else gemm_odd_in(lds, g, E); }
            PH_END();
            if (PM(12) && PH_ON()) for (int rep = 0; rep < DUPN(12); ++rep) { unsigned char* ws = kparams().ws; pg8::Gemm g{}; g.A = PB + 1536; g.lda = OD_INP; g.Bt = (const bf16_t*)(ws + WS_WMLA) + (size_t)i * MLA_N * MLA_K; g.K = MLA_K; g.nM = MTOT / 256; g.nN = MLA_N / 256; g.grouped = 0; g.estride = 0;
                pg8::EpiMlaUp E{MO, MLA_N, (const float*)(ws + WS_STATS)}; gemm_mla_up(lds, g, E); }
            PH_END();
            if (PH_ON()) { if (PM(13)) for (int rep = 0; rep < DUPN(13); ++rep) attn_odd_na(c, l); if (PM(14)) for (int rep = 0; rep < DUPN(14); ++rep) attn_odd_mla(c, l); }
            PH_END();
            if (PM(15) && PH_ON()) for (int rep = 0; rep < DUPN(15); ++rep) { unsigned char* ws = kparams().ws; pg8::Gemm g{}; g.A = MIX; g.lda = DM; g.Bt = (const bf16_t*)(ws + WS_WOUTO) + (size_t)i * DM * DM; g.K = DM; g.nM = nMt; g.nN = DM / 256; g.grouped = 0; g.estride = 0;
                gemm_bf16(lds, g, YB, DM); }
            PH_END();
            if (PM(16) && PH_ON()) { if (DUPN(16) > 1) ew_mid(c, l, mtok, true); ew_mid(c, l, mtok); }
            PH_END();
            if (PM(17) && PH_ON()) for (int rep = 0; rep < DUPN(17); ++rep) moe_gather(c, i, mtok);
            PH_END();
            if (PM(18) && PH_ON()) for (int rep = 0; rep < DUPN(18); ++rep) { unsigned char* ws = kparams().ws; pg8::Gemm g{}; g.A = YS; g.lda = DM; g.Bt = (const bf16_t*)(ws + WS_W13M); g.K = DM; g.nN = 2 * DFFE / 256; g.grouped = 1; g.estride = (size_t)2 * DFFE * DM;
                moe_offsets(kparams(), i, g.toff); g.nM = g.toff[8];
#if MOE_F8
                gemm8_swiglu8(lds, g, (unsigned char*)HID, DFFE);
#else
                gemm_swiglu(lds, g, HID, DFFE);
#endif
            }
            PH_END();
            if (PM(19) && PH_ON()) for (int rep = 0; rep < DUPN(19); ++rep) { unsigned char* ws = kparams().ws; pg8::Gemm g{}; g.A = HID; g.lda = DFFE; g.Bt = (const bf16_t*)(ws + WS_W2M); g.K = DFFE; g.nN = DM / 256; g.grouped = 1; g.estride = (size_t)DM * DFFE;
                moe_offsets(kparams(), i, g.toff); g.nM = g.toff[8];
#if MOE_F8
                gemm8_bf16(lds, g, YS, DM);
#else
                gemm_bf16(lds, g, YS, DM);
#endif
            }
            PH_END();
            if (PM(20) && PH_ON()) { if (DUPN(20) > 1) ew_last(c, l, mtok, true); ew_last(c, l, mtok); }
            PH_END();
        }
    }
#undef PH_ON
#undef PH_END
#undef HB
#undef PB
#undef MIX
#undef YB
#undef HID
#undef YS
#undef A2
#undef MO
}

extern "C" void kernel_launch(void* const* d_in, const int* in_sizes, int n_in, void* d_out, int out_size, void* d_ws, size_t ws_size, hipStream_t stream) {
    static int grid = 0;
    if (grid == 0) {
        int dev = 0, cus = 0;
        if (n_in != 31 || out_size != NLAT * DM || ws_size < WS_END) { fprintf(stderr, "kernel_launch: unexpected shapes or workspace (n_in %d out %d ws %zu need %zu)\n", n_in, out_size, ws_size, (size_t)WS_END); grid = -1; }
        else if (hipGetDevice(&dev) != hipSuccess || hipDeviceGetAttribute(&cus, hipDeviceAttributeMultiprocessorCount, dev) != hipSuccess) grid = -1;
        else if (hipFuncSetAttribute((const void*)fwd_kernel, hipFuncAttributeMaxDynamicSharedMemorySize, LDS_BYTES) != hipSuccess) grid = -1;
        else { int per_cu = 0; (void)hipOccupancyMaxActiveBlocksPerMultiprocessor(&per_cu, (const void*)fwd_kernel, 512, LDS_BYTES); (void)hipGetLastError(); grid = cus; }
    }
    if (grid < 0) { (void)hipMemsetAsync(d_out, 0, (size_t)out_size * 4, stream); return; }
    (void)hipMemsetAsync((char*)d_ws + WS_CTL, 0, CTL_BYTES, stream);
    Params p{};
    for (int i = 0; i < 31; ++i) p.in[i] = (const float*)d_in[i];
    p.out = (float*)d_out; p.ws = (unsigned char*)d_ws;
#if MK_PER_PHASE
    for (int k = 0; k < N_PHASES; ++k) { p.ph_lo = k; p.ph_hi = k + 1; hipLaunchKernelGGL(fwd_kernel, dim3(grid), dim3(512), LDS_BYTES, stream, p); }
#else
    p.ph_lo = 0; p.ph_hi = N_PHASES;
    hipLaunchKernelGGL(fwd_kernel, dim3(grid), dim3(512), LDS_BYTES, stream, p);
#endif
}
```

```cpp
#include <hip/hip_runtime.h>
#include <stdint.h>
#include <stdio.h>

#ifndef MK_PER_PHASE
#define MK_PER_PHASE 0
#endif
#ifndef DUP_MASK
#define DUP_MASK 0u
#endif
#define DUPN(b) (1 + (int)((DUP_MASK >> (b)) & 1u))
#ifndef FFN_F8
#define FFN_F8 1
#endif
#ifndef FFN_F8_FROM
#define FFN_F8_FROM 1
#endif
#define FFN8(i) (FFN_F8 && (i) >= FFN_F8_FROM)
#ifndef WIN_F8_FROM
#define WIN_F8_FROM 2
#endif
#define WIN8(l) ((l) >= WIN_F8_FROM)
#ifndef MOE_F8
#define MOE_F8 1
#endif

#define LAS __attribute__((address_space(3)))
typedef unsigned short bf16_t;
typedef short bf16x8 __attribute__((ext_vector_type(8)));
typedef short s16x4 __attribute__((ext_vector_type(4)));
typedef float f32x4 __attribute__((ext_vector_type(4)));
typedef float f32x2 __attribute__((ext_vector_type(2)));
typedef float f32x16 __attribute__((ext_vector_type(16)));
typedef unsigned u32x4 __attribute__((ext_vector_type(4)));
typedef unsigned u32x2 __attribute__((ext_vector_type(2)));

constexpr int DM = 1024, NB = 4, SEQ = 8192, NLAT = NB * SEQ, CTXL = 256, NCTX = NB * CTXL, MTOT = NLAT + NCTX;
constexpr int NMOD = 6;
constexpr int EV_IN = 2560, OD_IN = 1952, OD_INP = 2048, DFF = 2816, DFFE = 3584, NEXP = 8;
constexpr int MLA_N = 1280, MLA_K = 512;
constexpr int MS_MAX = 2 * MTOT + NEXP * 256;
constexpr float EPS = 1e-6f;
constexpr float LOG2E = 1.4426950408889634f;

constexpr size_t MiB = (size_t)1 << 20;
constexpr size_t WS_CTL = 0, CTL_BYTES = MiB;
constexpr size_t WS_MODS = 1 * MiB;
constexpr size_t WS_ROPEB = 2 * MiB;
constexpr size_t WS_ROPED = 4 * MiB;
constexpr size_t WS_SGUW = 5 * MiB;
constexpr size_t WS_TOKINFO = 6 * MiB;
constexpr size_t WS_TOKPOS = 8 * MiB;
constexpr size_t WS_CTXX = 10 * MiB;
constexpr size_t WS_WMLA = 14 * MiB;
constexpr size_t WS_WINE = 17 * MiB;
constexpr size_t WS_WOUTE = 27 * MiB;
constexpr size_t WS_W13E = 31 * MiB;
constexpr size_t WS_W2E = 53 * MiB;
constexpr size_t WS_WINO = 64 * MiB;
constexpr size_t WS_WOUTO = 72 * MiB;
constexpr size_t WS_W13M = 76 * MiB;
constexpr size_t WS_W2M = 188 * MiB;
constexpr size_t WS_HB = 244 * MiB;
constexpr size_t WS_U = 310 * MiB;
constexpr size_t U_PB = 0;
constexpr size_t U_MIX = 165 * MiB;
constexpr size_t U_A2 = 231 * MiB;
constexpr size_t U_MLAO = 264 * MiB;
constexpr size_t U_YB = 347 * MiB;
constexpr size_t U_HID = 0;
constexpr size_t U_XB = 549 * MiB;
constexpr size_t U_YS = 413 * MiB;
constexpr size_t WS_STATS = WS_U + 616 * MiB;
constexpr size_t WS_END = WS_STATS + 4 * MiB;
static_assert((size_t)MS_MAX * DFFE * (MOE_F8 ? 1 : 2) <= 347 * MiB && (size_t)MTOT * DFF * 2 <= 347 * MiB, "hid must stay clear of YB");
static_assert(U_YS + (size_t)MS_MAX * DM * 2 <= U_XB && U_XB + (size_t)MTOT * DM * 2 <= 616 * MiB, "ys / xb fit");

constexpr int CW_BAR = 4096;
constexpr int CW_MOECNT = 1024;

constexpr int LDS_BYTES = 147456;
constexpr int LDS_MISC = 131072;

__device__ __forceinline__ unsigned cvtpk(float lo, float hi) { unsigned r; asm volatile("v_cvt_pk_bf16_f32 %0, %1, %2" : "=v"(r) : "v"(lo), "v"(hi)); return r; }
__device__ __forceinline__ float bf2f(unsigned short b) { return __uint_as_float(((unsigned)b) << 16); }
__device__ __forceinline__ float bflo(unsigned w) { return __uint_as_float(w << 16); }
__device__ __forceinline__ float bfhi(unsigned w) { return __uint_as_float(w & 0xffff0000u); }
__device__ __forceinline__ bf16_t f2bf(float f) { return (bf16_t)(cvtpk(f, 0.f) & 0xffffu); }
typedef int i32x8 __attribute__((ext_vector_type(8)));
typedef int i32x4 __attribute__((ext_vector_type(4)));
constexpr float F8_ACT_SCALE = 4.f, F8_W_SCALE = 64.f, F8_INV = 1.f / (F8_ACT_SCALE * F8_W_SCALE);
__device__ __forceinline__ unsigned pk4_fp8(float a, float b, float c, float d) {
    a = __builtin_amdgcn_fmed3f(a, -448.f, 448.f); b = __builtin_amdgcn_fmed3f(b, -448.f, 448.f); c = __builtin_amdgcn_fmed3f(c, -448.f, 448.f); d = __builtin_amdgcn_fmed3f(d, -448.f, 448.f);
    int w = 0; w = __builtin_amdgcn_cvt_pk_fp8_f32(a, b, w, false); w = __builtin_amdgcn_cvt_pk_fp8_f32(c, d, w, true); return (unsigned)w; }
__device__ __forceinline__ float wave_sum(float v) {
#pragma unroll
    for (int o = 1; o < 64; o <<= 1) v += __shfl_xor(v, o);
    return v;
}
__device__ __forceinline__ float fast_exp2(float x) { return __builtin_amdgcn_exp2f(x); }
__device__ __forceinline__ float fast_rcp(float x) { return __builtin_amdgcn_rcpf(x); }
__device__ __forceinline__ float silu_f(float x) { return x * fast_rcp(1.f + fast_exp2(-x * LOG2E)); }
__device__ __forceinline__ float gelu_tanh_f(float x) { const float u = 0.7978845608028654f * (x + 0.044715f * x * x * x); return x * fast_rcp(1.f + fast_exp2(-2.f * LOG2E * u)); }
#define LDS_WAIT() asm volatile("s_waitcnt lgkmcnt(0)" ::: "memory")
#define VM_WAIT() asm volatile("s_waitcnt vmcnt(0)" ::: "memory")
__device__ __forceinline__ int opaque_bid() { int b = blockIdx.x; asm volatile("" : "+s"(b)); return b; }
__device__ __forceinline__ int xcd_unit_base() { const int b = opaque_bid(), G = (int)gridDim.x; return (G % 8 == 0) ? (b & 7) * (G >> 3) + (b >> 3) : b; }
__device__ __forceinline__ int opaque_tid() { int t = threadIdx.x; asm volatile("" : "+v"(t)); return t; }

#define XB_TMO      128
#define XB_XCNT(j)  (256  + 64 * (j))
#define XB_XSUB(j)  (1280 + 64 * (j))
#define XB_XGEN(j)  (2304 + 64 * (j))
#define XB_TOP      3328
#define XB_TOPGEN   3392
#define XCD_BAR_WORDS 3456
#define XB_SPIN_CAP (1u << 22)
__device__ __forceinline__ unsigned xb_ld(unsigned* p)              { return __hip_atomic_load(p, __ATOMIC_RELAXED, __HIP_MEMORY_SCOPE_AGENT); }
__device__ __forceinline__ unsigned xb_add(unsigned* p, unsigned v) { return __hip_atomic_fetch_add(p, v, __ATOMIC_RELAXED, __HIP_MEMORY_SCOPE_AGENT); }
__device__ __forceinline__ unsigned xb_xcc_id() { return (unsigned)__builtin_amdgcn_s_getreg((3 << 11) | 20) & 0xFu; }
#define XB_SPIN(cond, bar) do { unsigned _sp = 0; while (cond) { __builtin_amdgcn_s_sleep(1); \
    if ((++_sp & 255u) == 0u) { if (xb_ld(&(bar)[XB_TMO])) break; if (_sp > XB_SPIN_CAP) { atomicAdd(&(bar)[XB_TMO], 1u); break; } } } } while (0)
struct XcdBarrier { unsigned* bar; unsigned x; volatile LAS unsigned* st; };
__device__ __forceinline__ XcdBarrier xcd_barrier_post(unsigned* bar, volatile LAS unsigned* st) {
    XcdBarrier b; b.bar = bar; b.x = xb_xcc_id(); b.st = st;
    if (threadIdx.x == 0) (void)xb_add(&bar[XB_XCNT(b.x)], 1u);
    return b;
}
__device__ __forceinline__ void xcd_barrier_complete(unsigned* bar, unsigned x, unsigned& nloc, unsigned& nx) {
    const unsigned G = gridDim.x * gridDim.y * gridDim.z;
    unsigned sum, cnt, mine, sp = 0u;
    for (;;) {
        sum = 0u; cnt = 0u; mine = 0u;
#pragma unroll
        for (unsigned j = 0; j < 16; ++j) { const unsigned c = xb_ld(&bar[XB_XCNT(j)]); sum += c; cnt += (c > 0u) ? 1u : 0u; mine = (j == x) ? c : mine; }
        if (sum == G) break;
        __builtin_amdgcn_s_sleep(1);
        if ((++sp & 255u) == 0u) { if (xb_ld(&bar[XB_TMO])) break; if (sp > XB_SPIN_CAP) { atomicAdd(&bar[XB_TMO], 1u); break; } }
    }
    nloc = mine > 0u ? mine : 1u; nx = cnt > 0u ? cnt : 1u;
}
__device__ __forceinline__ void xcd_barrier(const XcdBarrier& b) {
    asm volatile("s_waitcnt vmcnt(0)" ::: "memory");
    __syncthreads();
    if (threadIdx.x == 0) {
        unsigned* bar = b.bar;
        __builtin_amdgcn_s_waitcnt(0);
        unsigned nloc = b.st[0], nx = b.st[1];
        if (nloc == 0u) { xcd_barrier_complete(bar, b.x, nloc, nx); b.st[0] = nloc; b.st[1] = nx; }
        const unsigned old = xb_add(&bar[XB_XSUB(b.x)], 1u);
        const unsigned gen = old / nloc;
        if (old + 1u == (gen + 1u) * nloc) {
            __builtin_amdgcn_fence(__ATOMIC_RELEASE, "agent");
            asm volatile("s_waitcnt vmcnt(0)" ::: "memory");
            const unsigned og = xb_add(&bar[XB_TOP], 1u);
            const unsigned tg = og / nx;
            if (og + 1u == (tg + 1u) * nx) xb_add(&bar[XB_TOPGEN], 1u);
            else XB_SPIN(xb_ld(&bar[XB_TOPGEN]) == tg, bar);
            __builtin_amdgcn_fence(__ATOMIC_ACQUIRE, "agent");
            xb_add(&bar[XB_XGEN(b.x)], 1u);
            asm volatile("s_waitcnt vmcnt(0)" ::: "memory");
        } else {
            XB_SPIN(xb_ld(&bar[XB_XGEN(b.x)]) == gen, bar);
            __builtin_amdgcn_fence(__ATOMIC_ACQUIRE, "agent");
            asm volatile("s_waitcnt vmcnt(0)" ::: "memory");
        }
    }
    __syncthreads();
}

namespace pg8 {
constexpr int BM = 256, BK = 64, HALF = 128, HTB = HALF * BK * 2, STAGE_BYTES = 8 * HTB, NXCD = 8, WGM = 4;
__device__ __forceinline__ int lds_byte(int r, int c) { const int st = (r >> 4) * 2 + (c >> 5), rr = r & 15, cc = c & 31, ob = rr * 64 + cc * 2; return st * 1024 + (ob ^ (((ob >> 9) & 1) << 5)); }
__device__ __forceinline__ void stage_rc(int b, int& R, int& C) { const int st = b / 1024, sb = b % 1024, swz = sb ^ (((sb >> 9) & 1) << 5); R = (st >> 1) * 16 + swz / 64; C = (st & 1) * 32 + (swz % 64) / 2; }
__device__ __forceinline__ int perm32(int rho) { const int n = rho >> 4, i = rho & 15; return 8 * (i >> 2) + 4 * n + (i & 3); }
struct Unit { int pm, pn, e; };
struct Gemm {
    const void* A; int lda;
    const void* Bt; int K;
    int nM, nN;
    int grouped; int toff[9]; size_t estride;
};
struct StaticOrder {
    int nM, nN, nwg, G, c;
    __device__ void init(int nM_, int nN_, int G_, int c_) { nM = nM_; nN = nN_; nwg = nM * nN; G = G_; c = c_; }
    __device__ __forceinline__ bool next(int i, Unit& u) const {
        const long L = (long)i * G + c; if (L >= nwg) return false;
        int wgid = (int)L; { const int q = nwg / NXCD, r = nwg % NXCD, xcd = wgid % NXCD, off = wgid / NXCD; wgid = (xcd < r ? xcd * (q + 1) : r * (q + 1) + (xcd - r) * q) + off; }
        const int nig = WGM * nN, gid = wgid / nig, fm = gid * WGM, gsz = (nM - fm) < WGM ? (nM - fm) : WGM;
        u.pm = fm + ((wgid % nig) % gsz); u.pn = (wgid % nig) / gsz; u.e = 0; return true;
    }
};
struct EpiBf16 {
    bf16_t* O; int ldc; float scale;
    __device__ __forceinline__ void operator()(const f32x4 (&acc)[2][2][4][2], const Unit& u, int wr, int wc, int fr, int fq) const {
        const int row0 = u.pm * BM + wr * 64 + fr, col0 = u.pn * BM + wc * 32 + 8 * fq;
#pragma unroll
        for (int ai = 0; ai < 2; ++ai)
#pragma unroll
            for (int m = 0; m < 4; ++m) { bf16_t* rowp = O + (size_t)(row0 + ai * HALF + m * 16) * ldc + col0;
#pragma unroll
                for (int bj = 0; bj < 2; ++bj) { const f32x4 v0 = acc[ai][bj][m][0] * scale, v1 = acc[ai][bj][m][1] * scale;
                    u32x4 w; w.x = cvtpk(v0[0], v0[1]); w.y = cvtpk(v0[2], v0[3]); w.z = cvtpk(v1[0], v1[1]); w.w = cvtpk(v1[2], v1[3]);
                    *(u32x4*)(rowp + bj * HALF) = w; } }
    }
};
__device__ __forceinline__ f32x4 swiglu4(f32x4 a, f32x4 b, float k1, float k2) {
    const f32x4 t = a * k1; f32x4 d;
#pragma unroll
    for (int j = 0; j < 4; ++j) d[j] = fast_exp2(t[j]);
    d = d + 1.f; f32x4 r;
#pragma unroll
    for (int j = 0; j < 4; ++j) r[j] = fast_rcp(d[j]);
    return (a * b) * (r * k2);
}
struct EpiSwiGLU {
    bf16_t* O; int ldc;
    __device__ __forceinline__ void operator()(const f32x4 (&acc)[2][2][4][2], const Unit& u, int wr, int wc, int fr, int fq) const {
        const int row0 = u.pm * BM + wr * 64 + fr, col0 = u.pn * HALF + wc * 32 + 8 * fq;
#pragma unroll
        for (int ai = 0; ai < 2; ++ai)
#pragma unroll
            for (int m = 0; m < 4; ++m) { bf16_t* rowp = O + (size_t)(row0 + ai * HALF + m * 16) * ldc + col0;
                const f32x4 r0 = swiglu4(acc[ai][0][m][0], acc[ai][1][m][0], -LOG2E, 1.f), r1 = swiglu4(acc[ai][0][m][1], acc[ai][1][m][1], -LOG2E, 1.f);
                u32x4 w; w.x = cvtpk(r0[0], r0[1]); w.y = cvtpk(r0[2], r0[3]); w.z = cvtpk(r1[0], r1[1]); w.w = cvtpk(r1[2], r1[3]);
                *(u32x4*)rowp = w; }
    }
};

struct EpiEvenIn {
    bf16_t* O; int ldc; f32x2* stats; const float* rcos; const float* rsin; float scale;
    __device__ __forceinline__ void operator()(const f32x4 (&acc)[2][2][4][2], const Unit& u, int wr, int wc, int fr, int fq) const {
        int upm = u.pm, upn = u.pn; asm volatile("" : "+s"(upm), "+s"(upn));
        const int row0 = upm * BM + wr * 64 + fr, col0 = upn * BM + wc * 32 + 8 * fq;
        const int kind = upn < 2 ? 0 : (upn < 4 ? 1 : (upn < 8 ? 2 : 3)); const bool lat = upm < NLAT / BM; const int t4 = 4 * (4 * (wc & 1) + fq);
#pragma unroll
        for (int ai = 0; ai < 2; ++ai)
#pragma unroll
            for (int m = 0; m < 4; ++m) { const int row = row0 + ai * HALF + m * 16; bf16_t* rowp = O + (size_t)row * ldc + col0;
                f32x4 cs = {1.f, 1.f, 1.f, 1.f}, sn = {0.f, 0.f, 0.f, 0.f}; float s1 = 0.f, s2 = 0.f;
                if (kind == 2 && lat) { const int sp = row & (SEQ - 1); cs = *(const f32x4*)(rcos + sp * 32 + t4); sn = *(const f32x4*)(rsin + sp * 32 + t4); }
#pragma unroll
                for (int bj = 0; bj < 2; ++bj) { f32x4 v0 = acc[ai][bj][m][0] * scale, v1 = acc[ai][bj][m][1] * scale;
                    if (kind < 2) {
#pragma unroll
                        for (int j = 0; j < 4; ++j) { v0[j] = gelu_tanh_f(v0[j]); v1[j] = gelu_tanh_f(v1[j]); }
                        if (kind == 1) { s1 += (v0[0] + v0[1]) + (v0[2] + v0[3]) + (v1[0] + v1[1]) + (v1[2] + v1[3]);
                            s2 += (v0[0] * v0[0] + v0[1] * v0[1]) + (v0[2] * v0[2] + v0[3] * v0[3]) + (v1[0] * v1[0] + v1[1] * v1[1]) + (v1[2] * v1[2] + v1[3] * v1[3]); } }
                    else if (kind == 2) { const f32x4 o0 = v0 * cs - v1 * sn, o1 = v1 * cs + v0 * sn; v0 = o0; v1 = o1; }
                    u32x4 w; w.x = cvtpk(v0[0], v0[1]); w.y = cvtpk(v0[2], v0[3]); w.z = cvtpk(v1[0], v1[1]); w.w = cvtpk(v1[2], v1[3]);
                    *(u32x4*)(rowp + bj * HALF) = w; }
                if (kind == 1) { s1 += __shfl_xor(s1, 16); s1 += __shfl_xor(s1, 32); s2 += __shfl_xor(s2, 16); s2 += __shfl_xor(s2, 32);
                    if (fq == 0) stats[(size_t)row * 8 + (upn - 2) * 4 + wc] = (f32x2){s1, s2}; } }
    }
};
struct EpiOddIn {
    bf16_t* O; int ldc; float* stats; const float* rcos; const float* rsin; float scale;
    __device__ __forceinline__ void operator()(const f32x4 (&acc)[2][2][4][2], const Unit& u, int wr, int wc, int fr, int fq) const {
        int upm = u.pm, upn = u.pn; asm volatile("" : "+s"(upm), "+s"(upn));
        const int row0 = upm * BM + wr * 64 + fr, col0 = upn * BM + wc * 32 + 8 * fq; const bool lat = upm < NLAT / BM;
#pragma unroll
        for (int ai = 0; ai < 2; ++ai)
#pragma unroll
            for (int m = 0; m < 4; ++m) { const int row = row0 + ai * HALF + m * 16; bf16_t* rowp = O + (size_t)row * ldc + col0; float ss = 0.f;
#pragma unroll
                for (int bj = 0; bj < 2; ++bj) { f32x4 v0 = acc[ai][bj][m][0] * scale, v1 = acc[ai][bj][m][1] * scale;
                    if (upn == 6 || (upn == 7 && bj == 0)) ss += (v0[0] * v0[0] + v0[1] * v0[1]) + (v0[2] * v0[2] + v0[3] * v0[3]) + (v1[0] * v1[0] + v1[1] * v1[1]) + (v1[2] * v1[2] + v1[3] * v1[3]);
                    if (upn == 7 && bj == 1 && wc == 0 && lat) { const int sp = row & (SEQ - 1); const f32x4 cs = *(const f32x4*)(rcos + sp * 16 + 4 * fq), sn = *(const f32x4*)(rsin + sp * 16 + 4 * fq);
                        const f32x4 o0 = v0 * cs - v1 * sn, o1 = v1 * cs + v0 * sn; v0 = o0; v1 = o1; }
                    u32x4 w; w.x = cvtpk(v0[0], v0[1]); w.y = cvtpk(v0[2], v0[3]); w.z = cvtpk(v1[0], v1[1]); w.w = cvtpk(v1[2], v1[3]);
                    *(u32x4*)(rowp + bj * HALF) = w; }
                if (upn >= 6) { ss += __shfl_xor(ss, 16); ss += __shfl_xor(ss, 32); if (fq == 0) stats[(size_t)row * 8 + (upn - 6) * 4 + wc] = ss; } }
    }
};
struct EpiMlaUp {
    bf16_t* O; int ldc; const float* stats;
    __device__ __forceinline__ void operator()(const f32x4 (&acc)[2][2][4][2], const Unit& u, int wr, int wc, int fr, int fq) const {
        const int row0 = u.pm * BM + wr * 64 + fr, col0 = u.pn * BM + wc * 32 + 8 * fq;
#pragma unroll
        for (int ai = 0; ai < 2; ++ai)
#pragma unroll
            for (int m = 0; m < 4; ++m) { const int row = row0 + ai * HALF + m * 16; bf16_t* rowp = O + (size_t)row * ldc + col0;
                const f32x4 pq = *(const f32x4*)(stats + (size_t)row * 8), pk = *(const f32x4*)(stats + (size_t)row * 8 + 4);
                const float rq = rsqrtf(((pq[0] + pq[1]) + (pq[2] + pq[3])) * (1.f / 256.f) + EPS), rk = rsqrtf(((pk[0] + pk[1]) + (pk[2] + pk[3])) * (1.f / 128.f) + EPS);
#pragma unroll
                for (int bj = 0; bj < 2; ++bj) { const int c0 = col0 + bj * HALF; const float sc = c0 < 384 ? rq : (c0 < 768 ? (((c0 - 384) % 96) < 64 ? rk : 1.f) : rk);
                    const f32x4 v0 = acc[ai][bj][m][0] * sc, v1 = acc[ai][bj][m][1] * sc;
                    u32x4 w; w.x = cvtpk(v0[0], v0[1]); w.y = cvtpk(v0[2], v0[3]); w.z = cvtpk(v1[0], v1[1]); w.w = cvtpk(v1[2], v1[3]);
                    *(u32x4*)(rowp + bj * HALF) = w; } }
    }
};
struct EpiSwiGLU8 {
    unsigned char* O; int ldc; float scale;
    __device__ __forceinline__ void operator()(const f32x4 (&acc)[2][2][4][2], const Unit& u, int wr, int wc, int fr, int fq) const {
        const int row0 = u.pm * BM + wr * 64 + fr, col0 = u.pn * HALF + wc * 32 + 8 * fq;
#pragma unroll
        for (int ai = 0; ai < 2; ++ai)
#pragma unroll
            for (int m = 0; m < 4; ++m) { unsigned char* rowp = O + (size_t)(row0 + ai * HALF + m * 16) * ldc + col0;
                const float k1 = -LOG2E * scale, k2 = F8_ACT_SCALE * scale * scale;
                const f32x4 r0 = swiglu4(acc[ai][0][m][0], acc[ai][1][m][0], k1, k2), r1 = swiglu4(acc[ai][0][m][1], acc[ai][1][m][1], k1, k2);
                u32x2 w; w.x = pk4_fp8(r0[0], r0[1], r0[2], r0[3]); w.y = pk4_fp8(r1[0], r1[1], r1[2], r1[3]);
                *(u32x2*)rowp = w; }
    }
};

template <class Epi, bool F8 = false>
__device__ __forceinline__ void gemm_phase(LAS unsigned char* lds, const Gemm& g, const Epi& E) {
    const int tid = opaque_tid(), wid = __builtin_amdgcn_readfirstlane(tid >> 6), lane = tid & 63, wr = wid >> 2, wc = wid & 3, fr = lane & 15, fq = lane >> 4;
    constexpr int ES = F8 ? 1 : 2;
    const int K = g.K, nt = K * ES / (BK * 2), lda = g.lda;
    StaticOrder S; S.init(g.nM, g.nN, (int)gridDim.x, opaque_bid());
    unsigned voffA[2], voffB[2];
#pragma unroll
    for (int i = 0; i < 2; ++i) { int R, C; stage_rc(tid * 16 + i * 8192, R, C); const int Rb = (R & ~31) + perm32(R & 31);
        voffA[i] = (unsigned)(R * lda * ES + C * 2); voffB[i] = (unsigned)(Rb * K * ES + C * 2); }
    const size_t kstep = (size_t)(BK * 2);
    const size_t hA = (size_t)HALF * lda * ES, tA = 2 * hA, hB = (size_t)HALF * K * ES, tB = 2 * hB;
    const unsigned ldsw = (unsigned)wid * 1024u;
    const int aoff = lds_byte(wr * 64 + fr, fq * 8), boff = lds_byte(wc * 32 + fr, fq * 8);
#define PG8_SA(b, h) (((b) * 2 + (h)) * HTB)
#define PG8_SB(b, h) ((4 + (b) * 2 + (h)) * HTB)
#define PG8_STAGE(bufoff, gbase, voff) do { _Pragma("unroll") for (int _i = 0; _i < 2; ++_i) \
        __builtin_amdgcn_global_load_lds((const unsigned*)((const char*)(gbase) + (voff)[_i]), (LAS unsigned*)(lds + (bufoff) + ldsw + _i * 8192), 16, 0, 0); } while (0)
#define PG8_LD8(base) __builtin_shufflevector(*(const LAS i32x4*)(base), *(const LAS i32x4*)((base) + 1024), 0, 1, 2, 3, 4, 5, 6, 7)
#define PG8_LDA(dst, b, h) do { _Pragma("unroll") for (int m = 0; m < 4; ++m) dst[m] = PG8_LD8(lds + PG8_SA(b, h) + aoff + m * 2048); } while (0)
#define PG8_LDB(dst, b, h) do { _Pragma("unroll") for (int n = 0; n < 2; ++n) dst[n] = PG8_LD8(lds + PG8_SB(b, h) + boff + n * 2048); } while (0)
#define PG8_H0(x) __builtin_bit_cast(bf16x8, __builtin_shufflevector(x, x, 0, 1, 2, 3))
#define PG8_H1(x) __builtin_bit_cast(bf16x8, __builtin_shufflevector(x, x, 4, 5, 6, 7))
#define PG8_MMA(ai, bj, At, Bt) do { __builtin_amdgcn_s_setprio(1); _Pragma("unroll") for (int m = 0; m < 4; ++m) _Pragma("unroll") for (int n = 0; n < 2; ++n) { \
        if constexpr (F8) asm volatile("v_mfma_f32_16x16x128_f8f6f4 %0, %1, %2, %0" : "+v"(acc[ai][bj][m][n]) : "v"(Bt[n]), "v"(At[m])); \
        else { acc[ai][bj][m][n] = __builtin_amdgcn_mfma_f32_16x16x32_bf16(PG8_H0(Bt[n]), PG8_H0(At[m]), acc[ai][bj][m][n], 0, 0, 0); \
               acc[ai][bj][m][n] = __builtin_amdgcn_mfma_f32_16x16x32_bf16(PG8_H1(Bt[n]), PG8_H1(At[m]), acc[ai][bj][m][n], 0, 0, 0); } } \
        __builtin_amdgcn_s_setprio(0); } while (0)
#define PG8_WAIT_V(n) asm volatile("s_waitcnt vmcnt(" #n ")" ::: "memory")
#define PG8_WAIT_L(n) asm volatile("s_waitcnt lgkmcnt(" #n ")" ::: "memory")
#define PG8_BAR __builtin_amdgcn_s_barrier()
#define PG8_SCHED __builtin_amdgcn_sched_barrier(0)
#define PG8_EXPERT(u) do { if (g.grouped) { int _e = 0; _Pragma("unroll") for (int _k = 1; _k < 8; ++_k) _e += ((u).pm >= g.toff[_k]) ? 1 : 0; (u).e = _e; } } while (0)
    Unit cur, nxt; int ui = 0;
    if (!S.next(0, cur)) return;
    PG8_EXPERT(cur);
    f32x4 acc[2][2][4][2];
#pragma unroll
    for (int a = 0; a < 2; ++a)
#pragma unroll
        for (int b = 0; b < 2; ++b)
#pragma unroll
            for (int m = 0; m < 4; ++m)
#pragma unroll
                for (int n = 0; n < 2; ++n) acc[a][b][m][n] = (f32x4){0.f, 0.f, 0.f, 0.f};
    i32x8 At[4], B0[2], B1[2];
    const char* cA = (const char*)g.A + (size_t)cur.pm * tA; const char* cB = ((const char*)g.Bt + (size_t)cur.e * g.estride * ES) + (size_t)cur.pn * tB;
    PG8_STAGE(PG8_SB(0, 0), cB, voffB); PG8_STAGE(PG8_SA(0, 0), cA, voffA); PG8_STAGE(PG8_SB(0, 1), cB + hB, voffB); PG8_STAGE(PG8_SA(0, 1), cA + hA, voffA);
    if (wr == 1) PG8_BAR;
    PG8_WAIT_V(4); PG8_BAR;
    PG8_STAGE(PG8_SB(1, 0), cB + kstep, voffB); PG8_STAGE(PG8_SA(1, 0), cA + kstep, voffA); PG8_STAGE(PG8_SB(1, 1), cB + hB + kstep, voffB);
    PG8_WAIT_V(6); PG8_BAR;
    for (;;) {
        const bool has_next = S.next(ui + 1, nxt);
        if (has_next) PG8_EXPERT(nxt);
        const char* nA = has_next ? (const char*)g.A + (size_t)nxt.pm * tA : cA; const char* nB = has_next ? ((const char*)g.Bt + (size_t)nxt.e * g.estride * ES) + (size_t)nxt.pn * tB : cB;
        for (int t = 0; t < nt; t += 2) {
            const bool last = (t == nt - 2);
            const char* a1 = cA + (size_t)(t + 1) * kstep;
            const char* a2 = last ? nA : cA + (size_t)(t + 2) * kstep; const char* b2 = last ? nB : cB + (size_t)(t + 2) * kstep;
            const char* a3 = a2 + kstep; const char* b3 = b2 + kstep;
            PG8_LDB(B0, 0, 0); PG8_SCHED; PG8_LDA(At, 0, 0); PG8_STAGE(PG8_SA(1, 1), a1 + hA, voffA);
            PG8_WAIT_L(8); PG8_BAR; PG8_WAIT_L(0); PG8_MMA(0, 0, At, B0); PG8_BAR; PG8_SCHED;
            PG8_LDB(B1, 0, 1); PG8_STAGE(PG8_SB(0, 0), b2, voffB);
            PG8_BAR; PG8_WAIT_L(0); PG8_MMA(0, 1, At, B1); PG8_BAR;
            PG8_LDA(At, 0, 1); PG8_STAGE(PG8_SA(0, 0), a2, voffA);
            PG8_BAR; PG8_WAIT_L(0); PG8_MMA(1, 0, At, B0); PG8_BAR; PG8_SCHED;
            PG8_STAGE(PG8_SB(0, 1), b2 + hB, voffB);
            PG8_WAIT_V(6); PG8_BAR; PG8_MMA(1, 1, At, B1); PG8_BAR;
            PG8_LDB(B0, 1, 0); PG8_SCHED; PG8_LDA(At, 1, 0); PG8_STAGE(PG8_SA(0, 1), a2 + hA, voffA);
            PG8_WAIT_L(8); PG8_BAR; PG8_WAIT_L(0); PG8_MMA(0, 0, At, B0); PG8_BAR; PG8_SCHED;
            PG8_LDB(B1, 1, 1); PG8_STAGE(PG8_SB(1, 0), b3, voffB);
            PG8_BAR; PG8_WAIT_L(0); PG8_MMA(0, 1, At, B1); PG8_BAR;
            PG8_LDA(At, 1, 1); PG8_STAGE(PG8_SA(1, 0), a3, voffA);
            PG8_BAR; PG8_WAIT_L(0); PG8_MMA(1, 0, At, B0); PG8_BAR; PG8_SCHED;
            PG8_STAGE(PG8_SB(1, 1), b3 + hB, voffB);
            PG8_WAIT_V(6); PG8_BAR; PG8_MMA(1, 1, At, B1); PG8_BAR;
        }
        if constexpr (F8) asm volatile("s_nop 15\n\ts_nop 15" ::: "memory");
        E(acc, cur, wr, wc, fr, fq);
        if (!has_next) break;
#pragma unroll
        for (int a = 0; a < 2; ++a)
#pragma unroll
            for (int b = 0; b < 2; ++b)
#pragma unroll
                for (int m = 0; m < 4; ++m)
#pragma unroll
                    for (int n = 0; n < 2; ++n) acc[a][b][m][n] = (f32x4){0.f, 0.f, 0.f, 0.f};
        cur = nxt; cA = nA; cB = nB; ++ui;
    }
    PG8_WAIT_V(0);
    if (wr == 0) PG8_BAR;
    PG8_BAR;
#undef PG8_SA
#undef PG8_SB
#undef PG8_STAGE
#undef PG8_LDA
#undef PG8_LDB
#undef PG8_MMA
#undef PG8_H0
#undef PG8_H1
#undef PG8_LD8
#undef PG8_WAIT_V
#undef PG8_WAIT_L
#undef PG8_BAR
#undef PG8_SCHED
#undef PG8_EXPERT
}
}

__device__ __forceinline__ void gemm_bf16(LAS unsigned char* lds, const pg8::Gemm& g, bf16_t* O, int ldc) { pg8::EpiBf16 E{O, ldc, 1.f}; pg8::gemm_phase(lds, g, E); }
__device__ __forceinline__ void gemm_even_in(LAS unsigned char* lds, const pg8::Gemm& g, const pg8::EpiEvenIn& E) { pg8::gemm_phase(lds, g, E); }
__device__ __forceinline__ void gemm8_even_in(LAS unsigned char* lds, const pg8::Gemm& g, const pg8::EpiEvenIn& E) { pg8::gemm_phase<pg8::EpiEvenIn, true>(lds, g, E); }
__device__ __forceinline__ void gemm8_odd_in(LAS unsigned char* lds, const pg8::Gemm& g, const pg8::EpiOddIn& E) { pg8::gemm_phase<pg8::EpiOddIn, true>(lds, g, E); }
__device__ __forceinline__ void gemm_odd_in(LAS unsigned char* lds, const pg8::Gemm& g, const pg8::EpiOddIn& E) { pg8::gemm_phase(lds, g, E); }
__device__ __forceinline__ void gemm_mla_up(LAS unsigned char* lds, const pg8::Gemm& g, const pg8::EpiMlaUp& E) { pg8::gemm_phase(lds, g, E); }
__device__ __forceinline__ void gemm8_bf16(LAS unsigned char* lds, const pg8::Gemm& g, bf16_t* O, int ldc) { pg8::EpiBf16 E{O, ldc, F8_INV}; pg8::gemm_phase<pg8::EpiBf16, true>(lds, g, E); }
__device__ __forceinline__ void gemm8_swiglu8(LAS unsigned char* lds, const pg8::Gemm& g, unsigned char* O, int ldc) { pg8::EpiSwiGLU8 E{O, ldc, F8_INV}; pg8::gemm_phase<pg8::EpiSwiGLU8, true>(lds, g, E); }
__device__ __forceinline__ void gemm_swiglu(LAS unsigned char* lds, const pg8::Gemm& g, bf16_t* O, int ldc) { pg8::EpiSwiGLU E{O, ldc}; pg8::gemm_phase(lds, g, E); }

namespace att {
#define SBAR() __builtin_amdgcn_sched_barrier(0)
__device__ __forceinline__ int crow(int r, int hi) { return (r & 3) + 8 * (r >> 2) + 4 * hi; }
__device__ __forceinline__ int v_st(int k, int c) { const int kk = (k & ~0xC) | ((k & 4) << 1) | ((k & 8) >> 1); return ((kk >> 3) * 4 + (c >> 5)) * 512 + ((kk & 7) * 32 + (c & 31)) * 2; }
__device__ __forceinline__ int v_st_plain(int k, int c) { return ((k >> 3) * 4 + (c >> 5)) * 512 + ((k & 7) * 32 + (c & 31)) * 2; }
__device__ __forceinline__ int v_rd_base(int lane) { return ((lane & 3) << 3) | (((lane >> 2) & 3) << 6) | (((lane >> 4) & 1) << 5) | (((lane >> 5) & 1) << 8); }
constexpr int v_rd_off(int d0, int ks, int half) { return d0 * 512 + ks * 4096 + half * 2048; }
template <int OFF> __device__ __forceinline__ s16x4 tr_read(unsigned vb) {
    s16x4 r; asm volatile("ds_read_b64_tr_b16 %0, %1 offset:%2" : "=&v"(r) : "v"(vb), "i"(OFF) : "memory"); return r;
}
template <int D0> __device__ __forceinline__ void pv_one(f32x16& od, unsigned vb, bf16x8 pa0, bf16x8 pa1, bf16x8 pa2, bf16x8 pa3) {
    const s16x4 l0 = tr_read<v_rd_off(D0, 0, 0)>(vb), h0 = tr_read<v_rd_off(D0, 0, 1)>(vb), l1 = tr_read<v_rd_off(D0, 1, 0)>(vb), h1 = tr_read<v_rd_off(D0, 1, 1)>(vb);
    const s16x4 l2 = tr_read<v_rd_off(D0, 2, 0)>(vb), h2 = tr_read<v_rd_off(D0, 2, 1)>(vb), l3 = tr_read<v_rd_off(D0, 3, 0)>(vb), h3 = tr_read<v_rd_off(D0, 3, 1)>(vb);
    asm volatile("s_waitcnt lgkmcnt(0)" ::: "memory"); SBAR();
#define PK(L, H) (bf16x8){L[0], L[1], L[2], L[3], H[0], H[1], H[2], H[3]}
    od = __builtin_amdgcn_mfma_f32_32x32x16_bf16(pa0, PK(l0, h0), od, 0, 0, 0);
    od = __builtin_amdgcn_mfma_f32_32x32x16_bf16(pa1, PK(l1, h1), od, 0, 0, 0);
    od = __builtin_amdgcn_mfma_f32_32x32x16_bf16(pa2, PK(l2, h2), od, 0, 0, 0);
    od = __builtin_amdgcn_mfma_f32_32x32x16_bf16(pa3, PK(l3, h3), od, 0, 0, 0);
#undef PK
}
template <int KS, int NO> __device__ __forceinline__ void pv_step(f32x16 (&o)[NO], unsigned vb, bf16x8 pa) {
    s16x4 l[NO], h[NO];
    l[0] = tr_read<v_rd_off(0, KS, 0)>(vb); h[0] = tr_read<v_rd_off(0, KS, 1)>(vb); l[1] = tr_read<v_rd_off(1, KS, 0)>(vb); h[1] = tr_read<v_rd_off(1, KS, 1)>(vb);
    if constexpr (NO == 4) { l[2] = tr_read<v_rd_off(2, KS, 0)>(vb); h[2] = tr_read<v_rd_off(2, KS, 1)>(vb); l[3] = tr_read<v_rd_off(3, KS, 0)>(vb); h[3] = tr_read<v_rd_off(3, KS, 1)>(vb); }
    asm volatile("s_waitcnt lgkmcnt(0)" ::: "memory"); SBAR();
#pragma unroll
    for (int d = 0; d < NO; ++d) o[d] = __builtin_amdgcn_mfma_f32_32x32x16_bf16(pa, (bf16x8){l[d][0], l[d][1], l[d][2], l[d][3], h[d][0], h[d][1], h[d][2], h[d][3]}, o[d], 0, 0, 0);
}
__device__ __forceinline__ void rot4(bf16x8& a, const float* cs, const float* sn) {
    const f32x4 c = *(const f32x4*)cs, s = *(const f32x4*)sn; float o[8];
#pragma unroll
    for (int e = 0; e < 4; ++e) { const float x1 = bf2f((unsigned short)a[e]), x2 = bf2f((unsigned short)a[4 + e]); o[e] = x1 * c[e] - x2 * s[e]; o[4 + e] = x2 * c[e] + x1 * s[e]; }
    u32x4 w = {cvtpk(o[0], o[1]), cvtpk(o[2], o[3]), cvtpk(o[4], o[5]), cvtpk(o[6], o[7])};
    a = *reinterpret_cast<bf16x8*>(&w);
}
struct Args {
    const bf16_t* Q; int ldq, qcol;
    const bf16_t* K; int ldk, kcol;
    const bf16_t* V; int ldv, vcol;
    int q_row0;
    int kctx_row0, klat_row0, nt_ctx, nt_lat;
    float C;
    int rope;
    const float* rcos; const float* rsin;
    bf16_t* O; int ldo, ocol;
    int g, u0; const float* rpb;
    float lam, oscale; const float* subg;
};

__device__ __forceinline__ unsigned off_a(unsigned row, unsigned ch) { return 2048u * (row >> 3) + 512u * (ch >> 2) + 64u * (row & 7) + 16u * ((ch & 3) ^ ((row >> 2) & 3)); }
template <int OFF> __device__ __forceinline__ s16x4 tr_read_u(unsigned addr) {
    s16x4 r; asm volatile("ds_read_b64_tr_b16 %0, %1 offset:%2" : "=&v"(r) : "v"(addr), "i"(OFF) : "memory"); return r;
}
template <int KS2, int DB0, int NDB>
__device__ __forceinline__ void pv16_grp(f32x4 (&o)[2][NDB], const unsigned (&vb)[2][2], bf16x8 p0, bf16x8 p1) {
    s16x4 L[4], H[4];
#pragma unroll
    for (int i = 0; i < 4; ++i) { constexpr int dummy = 0; (void)dummy; }
    L[0] = tr_read_u<8192 * KS2 + 512 * ((DB0 + 0) >> 1)>(vb[(DB0 + 0) & 1][0]); H[0] = tr_read_u<8192 * KS2 + 512 * ((DB0 + 0) >> 1)>(vb[(DB0 + 0) & 1][1]);
    L[1] = tr_read_u<8192 * KS2 + 512 * ((DB0 + 1) >> 1)>(vb[(DB0 + 1) & 1][0]); H[1] = tr_read_u<8192 * KS2 + 512 * ((DB0 + 1) >> 1)>(vb[(DB0 + 1) & 1][1]);
    L[2] = tr_read_u<8192 * KS2 + 512 * ((DB0 + 2) >> 1)>(vb[(DB0 + 2) & 1][0]); H[2] = tr_read_u<8192 * KS2 + 512 * ((DB0 + 2) >> 1)>(vb[(DB0 + 2) & 1][1]);
    L[3] = tr_read_u<8192 * KS2 + 512 * ((DB0 + 3) >> 1)>(vb[(DB0 + 3) & 1][0]); H[3] = tr_read_u<8192 * KS2 + 512 * ((DB0 + 3) >> 1)>(vb[(DB0 + 3) & 1][1]);
    asm volatile("s_waitcnt lgkmcnt(0)" ::: "memory"); SBAR();
#pragma unroll
    for (int i = 0; i < 4; ++i) { const bf16x8 vf = {L[i][0], L[i][1], L[i][2], L[i][3], H[i][0], H[i][1], H[i][2], H[i][3]};
        o[0][DB0 + i] = __builtin_amdgcn_mfma_f32_16x16x32_bf16(p0, vf, o[0][DB0 + i], 0, 0, 0);
        o[1][DB0 + i] = __builtin_amdgcn_mfma_f32_16x16x32_bf16(p1, vf, o[1][DB0 + i], 0, 0, 0); }
}
template <int DQK, int KW, int DV, int MODE>
__device__ __forceinline__ void attn_unit(LAS unsigned char* lds, const Args& a) {
    constexpr int NKS = DQK / 32, NDB = DV / 16;
    constexpr int KSTR = KW * 2 + 16, KBUF = 64 * KSTR;
    constexpr int OFF_V = 3 * KBUF, OFF_WS = OFF_V + 3 * 16384, OFF_RPB = OFF_WS + 2048;
    const int tid = opaque_tid(), wid = __builtin_amdgcn_readfirstlane(tid >> 6), lane = tid & 63, n = lane & 15, g = lane >> 4;
    LAS unsigned char* Kl = lds; LAS unsigned char* Vl = lds + OFF_V;
    LAS float* wsf = (LAS float*)(lds + OFF_WS) + wid * 64; LAS float* li_l = wsf;
    LAS float* rpbl = (LAS float*)(lds + OFF_RPB);
    const int wq = (MODE == 1) ? (wid & 3) : wid, wmap = (MODE == 1) ? (wid >> 2) : 0;
    bf16x8 qf[2][NKS];
#pragma unroll
    for (int qb = 0; qb < 2; ++qb) {
        const int qrow = a.q_row0 + wq * 32 + qb * 16 + n;
        const bf16_t* Qw = a.Q + (size_t)qrow * a.ldq + a.qcol + wmap * 64 + g * 8;
#pragma unroll
        for (int ks = 0; ks < NKS; ++ks) qf[qb][ks] = *(const bf16x8*)(Qw + ks * 32);
        if (a.rope == 2) { if constexpr (NKS >= 3) { const int s = qrow & (SEQ - 1); rot4(qf[qb][2], a.rcos + s * 16 + 4 * g, a.rsin + s * 16 + 4 * g); } }
#pragma unroll
        for (int ks = 0; ks < NKS; ++ks) { float f[8];
#pragma unroll
            for (int e = 0; e < 8; ++e) f[e] = bf2f((unsigned short)qf[qb][ks][e]) * a.C;
            u32x4 w = {cvtpk(f[0], f[1]), cvtpk(f[2], f[3]), cvtpk(f[4], f[5]), cvtpk(f[6], f[7])}; qf[qb][ks] = *reinterpret_cast<bf16x8*>(&w); }
    }
    if (MODE == 2) { if (tid < 465) rpbl[tid] = a.rpb[tid] * LOG2E; }
    const int cq0 = (wid & 1) * 32 + n, cq1 = cq0 + 16, rq = 4 * a.g + (wid >> 1);
    const int rs = min(max(rq - 4, 0), 120), cs0 = min(max(cq0 - 8, 0), 48), cs1 = min(max(cq1 - 8, 0), 48);
    constexpr int NKB = KBUF / 1024, NBT = NKB + 16, NB = (NBT + 7) / 8;
    static_assert(KBUF % 1024 == 0, "K image is a whole number of 1 KB blocks");
    unsigned soff[NB];
#pragma unroll
    for (int i = 0; i < NB; ++i) { const int bb = wid + 8 * i; unsigned so = 0u;
        if (bb < NKB) { const int A = bb * 1024 + lane * 16, row = A / KSTR; int off = A % KSTR; if (off >= KW * 2) off = 0; so = (unsigned)(row * a.ldk * 2 + off); }
        else if (bb < NBT) { const int A = (bb - NKB) * 1024 + lane * 16, rho = ((A >> 11) << 3) | ((A >> 6) & 7); int ch = (((A >> 9) & 3) << 2) | (((A >> 4) & 3) ^ ((rho >> 2) & 3));
            if (DV == 64) ch &= 7;
            const int key = ((rho >> 5) * 2 + ((rho >> 2) & 1)) * 16 + 4 * ((rho >> 3) & 3) + (rho & 3);
            so = (unsigned)((key * a.ldv + ch * 8) * 2); }
        soff[i] = so; }
    const int NT = a.nt_ctx + a.nt_lat;
#define TILE_ROW(j) ((j) < a.nt_ctx ? a.kctx_row0 + 64 * (j) : a.klat_row0 + 64 * ((j) - a.nt_ctx))
#define DMA(t) do { const int _r0 = TILE_ROW(t), _sl = (t) % 3; const char* _kp = (const char*)(a.K + (size_t)_r0 * a.ldk + a.kcol); const char* _vp = (const char*)(a.V + (size_t)_r0 * a.ldv + a.vcol); \
    _Pragma("unroll") for (int _i = 0; _i < NB; ++_i) { const int _bb = wid + 8 * _i; \
        if (_bb < NKB) __builtin_amdgcn_global_load_lds((const unsigned*)(_kp + soff[_i]), (LAS unsigned*)(Kl + _sl * KBUF + _bb * 1024), 16, 0, 0); \
        else if (_bb < NBT) __builtin_amdgcn_global_load_lds((const unsigned*)(_vp + soff[_i]), (LAS unsigned*)(Vl + _sl * 16384 + (_bb - NKB) * 1024), 16, 0, 0); } } while (0)
#define DMA_SYNC() do { asm volatile("s_waitcnt vmcnt(0)" ::: "memory"); __syncthreads(); } while (0)
    float lsum0 = 0.f, lsum1 = 0.f;
    f32x4 o[2][NDB];
#pragma unroll
    for (int qb = 0; qb < 2; ++qb)
#pragma unroll
        for (int d = 0; d < NDB; ++d) o[qb][d] = (f32x4){0.f, 0.f, 0.f, 0.f};
    const unsigned kbase = (unsigned)(size_t)Kl + (unsigned)(n * KSTR + 16 * g + wmap * 128);
    unsigned vb0[2][2];
    { const unsigned q4 = (unsigned)n >> 2, p = (unsigned)n & 3;
#pragma unroll
      for (int cb = 0; cb < 2; ++cb)
#pragma unroll
          for (int t = 0; t < 2; ++t) vb0[cb][t] = (unsigned)(size_t)Vl + off_a(8u * g + 4u * t + q4, 2u * cb + (p >> 1)) + 8u * (p & 1); }
#define QKT(S, b) do { const unsigned _kb = kbase + (unsigned)((b) * KBUF); bf16x8 _kf[4][NKS]; \
    _Pragma("unroll") for (int kb = 0; kb < 4; ++kb) _Pragma("unroll") for (int ks = 0; ks < NKS; ++ks) _kf[kb][ks] = *(const LAS bf16x8*)(size_t)(_kb + kb * 16 * KSTR + ks * 64); \
    _Pragma("unroll") for (int kb = 0; kb < 4; ++kb) _Pragma("unroll") for (int qb = 0; qb < 2; ++qb) { f32x4 _acc = {0.f, 0.f, 0.f, 0.f}; \
        _Pragma("unroll") for (int ks = 0; ks < NKS; ++ks) _acc = __builtin_amdgcn_mfma_f32_16x16x32_bf16(_kf[kb][ks], qf[qb][ks], _acc, 0, 0, 0); \
        S[kb][qb] = _acc; } } while (0)
#define PARTIAL(S, j) do { \
    if (MODE == 2) { if ((j) >= a.nt_ctx) { const int kr = a.u0 + ((j) - a.nt_ctx); const bool rowok = (kr >= rs) && (kr < rs + 8); const int ro = min(max(kr - rq + 7, 0), 14); const LAS float* brow = rpbl + ro * 31; \
        _Pragma("unroll") for (int kb = 0; kb < 4; ++kb) _Pragma("unroll") for (int r = 0; r < 4; ++r) { const int ck = kb * 16 + 4 * g + r; \
            { const int dd = min(max(ck - cq0 + 15, 0), 30); const bool inw = rowok && ((unsigned)(ck - cs0) < 16u); const float bv = brow[dd]; S[kb][0][r] = inw ? S[kb][0][r] + bv : -1e30f; } \
            { const int dd = min(max(ck - cq1 + 15, 0), 30); const bool inw = rowok && ((unsigned)(ck - cs1) < 16u); const float bv = brow[dd]; S[kb][1][r] = inw ? S[kb][1][r] + bv : -1e30f; } } } } \
    _Pragma("unroll") for (int kb = 0; kb < 2; ++kb) _Pragma("unroll") for (int qb = 0; qb < 2; ++qb) _Pragma("unroll") for (int r = 0; r < 4; ++r) S[kb][qb][r] = fast_exp2(S[kb][qb][r]); } while (0)
#define FINISH(S) do { \
    _Pragma("unroll") for (int kb = 2; kb < 4; ++kb) _Pragma("unroll") for (int qb = 0; qb < 2; ++qb) _Pragma("unroll") for (int r = 0; r < 4; ++r) S[kb][qb][r] = fast_exp2(S[kb][qb][r]); \
    float _p0 = 0.f, _p1 = 0.f; \
    _Pragma("unroll") for (int kb = 0; kb < 4; ++kb) { _p0 += (S[kb][0][0] + S[kb][0][1]) + (S[kb][0][2] + S[kb][0][3]); _p1 += (S[kb][1][0] + S[kb][1][1]) + (S[kb][1][2] + S[kb][1][3]); } \
    lsum0 += _p0; lsum1 += _p1; \
    _Pragma("unroll") for (int qb = 0; qb < 2; ++qb) _Pragma("unroll") for (int k2 = 0; k2 < 2; ++k2) { \
        u32x4 _w = {cvtpk(S[2 * k2][qb][0], S[2 * k2][qb][1]), cvtpk(S[2 * k2][qb][2], S[2 * k2][qb][3]), cvtpk(S[2 * k2 + 1][qb][0], S[2 * k2 + 1][qb][1]), cvtpk(S[2 * k2 + 1][qb][2], S[2 * k2 + 1][qb][3])}; \
        pf[qb][k2] = *reinterpret_cast<bf16x8*>(&_w); } } while (0)
#define PV(b) do { unsigned _vb[2][2]; _Pragma("unroll") for (int cb = 0; cb < 2; ++cb) _Pragma("unroll") for (int t = 0; t < 2; ++t) _vb[cb][t] = vb0[cb][t] + (unsigned)(b) * 16384u; \
    pv16_grp<0, 0, NDB>(o, _vb, pf[0][0], pf[1][0]); if constexpr (NDB == 8) pv16_grp<0, 4, NDB>(o, _vb, pf[0][0], pf[1][0]); \
    pv16_grp<1, 0, NDB>(o, _vb, pf[0][1], pf[1][1]); if constexpr (NDB == 8) pv16_grp<1, 4, NDB>(o, _vb, pf[0][1], pf[1][1]); } while (0)
    f32x4 sA[4][2], sB[4][2]; bf16x8 pf[2][2];
    DMA(0); DMA_SYNC();
    DMA(1);
    QKT(sA, 0); PARTIAL(sA, 0);
    DMA_SYNC();
    int bm1 = 0, bj = 1, bn = 2;
    for (int j = 1; j + 1 < NT; j += 2) {
        DMA(j + 1);
        SBAR(); QKT(sB, bj);
        FINISH(sA); SBAR();
        PV(bm1); PARTIAL(sB, j);
        DMA_SYNC();
        if (j + 2 < NT) DMA(j + 2);
        SBAR(); QKT(sA, bn);
        FINISH(sB); SBAR();
        PV(bj); PARTIAL(sA, j + 1);
        DMA_SYNC();
        { const int t0 = bm1; bm1 = bn; bn = bj; bj = t0; }
    }
    SBAR(); QKT(sB, bj);
    FINISH(sA); SBAR();
    PV(bm1); PARTIAL(sB, NT - 1);
    FINISH(sB); SBAR();
    PV(bj);
    __syncthreads();
#undef TILE_ROW
#undef DMA
#undef DMA_SYNC
#undef QKT
#undef PARTIAL
#undef FINISH
#undef PV
    const int tid_e = opaque_tid(), lane_e = tid_e & 63, ne = lane_e & 15, ge = lane_e >> 4;
    lsum0 += __shfl_xor(lsum0, 16); lsum0 += __shfl_xor(lsum0, 32); lsum1 += __shfl_xor(lsum1, 16); lsum1 += __shfl_xor(lsum1, 32);
    if (ge == 0) { li_l[ne] = fmaxf(lsum0, 1e-37f); li_l[16 + ne] = fmaxf(lsum1, 1e-37f); } LDS_WAIT();
    float rl[2][4];
#pragma unroll
    for (int qb = 0; qb < 2; ++qb)
#pragma unroll
        for (int r = 0; r < 4; ++r) rl[qb][r] = fast_rcp(li_l[qb * 16 + 4 * ge + r]);
    if (MODE != 1) {
        constexpr int OS = DV + 8;
        LAS bf16_t* ob = (LAS bf16_t*)lds;
#pragma unroll
        for (int qb = 0; qb < 2; ++qb)
#pragma unroll
            for (int r = 0; r < 4; ++r) { const int orow = wid * 32 + qb * 16 + 4 * ge + r;
#pragma unroll
                for (int db = 0; db < NDB; ++db) ob[orow * OS + db * 16 + ne] = f2bf(o[qb][db][r] * rl[qb][r]); }
        __syncthreads();
        constexpr int CPT = DV / 16;
        const int row = tid_e >> 1, c0 = (tid_e & 1) * CPT;
        bf16_t* Ow = a.O + (size_t)(a.q_row0 + row) * a.ldo + a.ocol + c0 * 8;
#pragma unroll
        for (int cc = 0; cc < CPT; ++cc) *(u32x4*)(Ow + cc * 8) = *(const LAS u32x4*)(ob + row * OS + (c0 + cc) * 8);
    } else {
        LAS float* cb = (LAS float*)lds;
        if (wmap == 1) {
#pragma unroll
            for (int qb = 0; qb < 2; ++qb)
#pragma unroll
                for (int r = 0; r < 4; ++r) { const int row = wq * 32 + qb * 16 + 4 * ge + r;
#pragma unroll
                    for (int db = 0; db < NDB; ++db) cb[row * 129 + db * 16 + ne] = a.lam * o[qb][db][r] * rl[qb][r]; }
        }
        __syncthreads();
        if (wmap == 0) {
#pragma unroll
            for (int qb = 0; qb < 2; ++qb)
#pragma unroll
                for (int r = 0; r < 4; ++r) { const int row = wq * 32 + qb * 16 + 4 * ge + r;
#pragma unroll
                    for (int db = 0; db < NDB; ++db) { const int ix = row * 129 + db * 16 + ne; cb[ix] = o[qb][db][r] * rl[qb][r] - cb[ix]; } }
        }
        __syncthreads();
        const int row = tid_e >> 2, qd = tid_e & 3;
        float v[32]; float ss = 0.f;
#pragma unroll
        for (int i = 0; i < 32; ++i) { v[i] = cb[row * 129 + qd * 32 + i]; ss += v[i] * v[i]; }
        ss += __shfl_xor(ss, 1); ss += __shfl_xor(ss, 2);
        const float rstd = rsqrtf(ss * (1.f / 128.f) + EPS) * a.oscale;
        bf16_t* Ow = a.O + (size_t)(a.q_row0 + row) * a.ldo + a.ocol + qd * 32;
#pragma unroll
        for (int c = 0; c < 4; ++c) { float w[8];
#pragma unroll
            for (int e = 0; e < 8; ++e) w[e] = v[c * 8 + e] * rstd * a.subg[qd * 32 + c * 8 + e];
            u32x4 pk = {cvtpk(w[0], w[1]), cvtpk(w[2], w[3]), cvtpk(w[4], w[5]), cvtpk(w[6], w[7])};
            *(u32x4*)(Ow + c * 8) = pk; }
    }
    __syncthreads();
}

__device__ __forceinline__ void sgu_unit(LAS unsigned char* lds, const bf16_t* PB, const bf16_t* Wsb, const float* bs, const float* stats, const float* sgain, bf16_t* MIX, int rowbase, int g) {
    const int tid = opaque_tid(), wid = __builtin_amdgcn_readfirstlane(tid >> 6), lane = tid & 63, r32 = lane & 31, hi = lane >> 5;
    LAS unsigned char* Vl = lds;
#pragma unroll 2
    for (int i = 0; i < 4; ++i) { const int c = tid + 512 * i, row = c >> 4, ch = c & 15;
        const u32x4 x = *(const u32x4*)(PB + (size_t)(rowbase + row) * EV_IN + 512 + g * 128 + ch * 8);
        const f32x4* st = (const f32x4*)(stats + (size_t)(rowbase + row) * 16); const f32x4 a0 = st[0], a1 = st[1], a2 = st[2], a3 = st[3];
        const float s1 = ((a0[0] + a0[2]) + (a1[0] + a1[2])) + ((a2[0] + a2[2]) + (a3[0] + a3[2])), s2 = ((a0[1] + a0[3]) + (a1[1] + a1[3])) + ((a2[1] + a2[3]) + (a3[1] + a3[3]));
        const float mean = s1 * (1.f / 512.f), rstd = rsqrtf(fmaxf(s2 * (1.f / 512.f) - mean * mean, 0.f) + EPS);
        const f32x4 g0 = *(const f32x4*)(sgain + g * 128 + ch * 8), g1 = *(const f32x4*)(sgain + g * 128 + ch * 8 + 4);
        u32x4 y; y.x = cvtpk((bflo(x.x) - mean) * rstd * g0[0], (bfhi(x.x) - mean) * rstd * g0[1]); y.y = cvtpk((bflo(x.y) - mean) * rstd * g0[2], (bfhi(x.y) - mean) * rstd * g0[3]);
        y.z = cvtpk((bflo(x.z) - mean) * rstd * g1[0], (bfhi(x.z) - mean) * rstd * g1[1]); y.w = cvtpk((bflo(x.w) - mean) * rstd * g1[2], (bfhi(x.w) - mean) * rstd * g1[3]);
        *(LAS u32x4*)(Vl + (row >> 6) * 16384 + v_st(row & 63, ch * 8)) = y; }
    const int prow = (wid & 3) * 32, dh = wid >> 2;
    bf16x8 pa[2][4];
#pragma unroll
    for (int kt = 0; kt < 2; ++kt)
#pragma unroll
        for (int ks = 0; ks < 4; ++ks) pa[kt][ks] = *(const bf16x8*)(Wsb + (size_t)(g * 128 + prow + r32) * 128 + kt * 64 + ks * 16 + hi * 8);
    __syncthreads();
    f32x16 o[2];
    o[0] = (f32x16){0.f, 0.f, 0.f, 0.f, 0.f, 0.f, 0.f, 0.f, 0.f, 0.f, 0.f, 0.f, 0.f, 0.f, 0.f, 0.f}; o[1] = o[0];
    const unsigned vb0 = (unsigned)(size_t)Vl + (unsigned)v_rd_base(lane);
#pragma unroll
    for (int kt = 0; kt < 2; ++kt) { const unsigned vb = vb0 + kt * 16384u;
        if (dh == 0) { pv_one<0>(o[0], vb, pa[kt][0], pa[kt][1], pa[kt][2], pa[kt][3]); pv_one<1>(o[1], vb, pa[kt][0], pa[kt][1], pa[kt][2], pa[kt][3]); }
        else { pv_one<2>(o[0], vb, pa[kt][0], pa[kt][1], pa[kt][2], pa[kt][3]); pv_one<3>(o[1], vb, pa[kt][0], pa[kt][1], pa[kt][2], pa[kt][3]); } }
#pragma unroll
    for (int r = 0; r < 16; ++r) { const int p = prow + crow(r, hi); const float bias = bs[g * 128 + p];
#pragma unroll
        for (int dd = 0; dd < 2; ++dd) { const int d = (2 * dh + dd) * 32 + r32;
            const float u = bf2f(PB[(size_t)(rowbase + p) * EV_IN + g * 128 + d]);
            MIX[(size_t)(rowbase + p) * DM + g * 128 + d] = f2bf(u * (o[dd][r] + bias)); } }
    __syncthreads();
}
}

struct Params {
    const float* in[31];
    float* out;
    unsigned char* ws;
    int ph_lo, ph_hi;
};

struct Ctx {
    LAS unsigned char* lds;
    int tid, lane, wid, gw, NGW;
};
__device__ __forceinline__ Ctx make_ctx(LAS unsigned char* lds) { const int t = opaque_tid(), w = __builtin_amdgcn_readfirstlane(t >> 6); return Ctx{lds, t, t & 63, w, opaque_bid() * 8 + w, (int)gridDim.x * 8}; }
typedef const __attribute__((address_space(4))) Params KParams;
__device__ __forceinline__ KParams& kparams() { KParams* p = (KParams*)__builtin_amdgcn_kernarg_segment_ptr(); asm volatile("" : "+s"(p)); return *p; }

__device__ __forceinline__ bf16_t* xrow_ptr(KParams& P, int row) { return (bf16_t*)(P.ws + WS_U + U_XB) + (size_t)row * DM; }
__device__ __forceinline__ int mod_r(int row) { return row < NLAT ? (row >> 13) : 4; }
__device__ __forceinline__ f32x4 ld4(const float* p) { return *(const f32x4*)p; }
__device__ __forceinline__ f32x4 ldbf4(const bf16_t* p) { const u32x2 w = *(const u32x2*)p; return (f32x4){bflo(w.x), bfhi(w.x), bflo(w.y), bfhi(w.y)}; }
__device__ __forceinline__ void stbf4(bf16_t* p, f32x4 v) { u32x2 w; w.x = cvtpk(v[0], v[1]); w.y = cvtpk(v[2], v[3]); *(u32x2*)p = w; }
__device__ __forceinline__ float sumsq4(const f32x4 (&v)[4]) { float s = 0.f;
#pragma unroll
    for (int j = 0; j < 4; ++j) s += (v[j][0] * v[j][0] + v[j][1] * v[j][1]) + (v[j][2] * v[j][2] + v[j][3] * v[j][3]);
    return wave_sum(s); }
__device__ __forceinline__ void norm_mod(const f32x4 (&x)[4], f32x4 (&hv)[4], const float* gain, const float* shift, const float* scale, int lane) {
    const float rstd = rsqrtf(sumsq4(x) * (1.f / DM) + EPS);
#pragma unroll
    for (int j = 0; j < 4; ++j) { const int c = 4 * lane + 256 * j; const f32x4 g = ld4(gain + c), sh = ld4(shift + c), sc = ld4(scale + c);
        hv[j] = (x[j] * rstd) * g * (sc + 1.f) + sh; }
}
__device__ __forceinline__ void resid_add(f32x4 (&x)[4], const f32x4 (&y)[4], const float* gain, const float* gate, int lane) {
    const float rstd = rsqrtf(sumsq4(y) * (1.f / DM) + EPS);
#pragma unroll
    for (int j = 0; j < 4; ++j) { const int c = 4 * lane + 256 * j; const f32x4 g = ld4(gain + c), gt = ld4(gate + c);
        x[j] = x[j] + gt * ((y[j] * rstd) * g); }
}

__device__ __forceinline__ void wave_rows(const Ctx& c, int mtok, int& r0, int& r1) {
    const int bid = opaque_bid(); const int rpw = mtok / (int)gridDim.x, base = bid * rpw;
    r0 = base + (c.wid * rpw) / 8; r1 = base + ((c.wid + 1) * rpw) / 8;
    if (bid == (int)gridDim.x - 1 && c.wid == 7) r1 = mtok;
}
__device__ __forceinline__ void ld_gate(f32x4 (&G)[4], const float* gain, const float* gate, int lane) {
#pragma unroll
    for (int j = 0; j < 4; ++j) { const int cc = 4 * lane + 256 * j; G[j] = ld4(gain + cc) * ld4(gate + cc); } }
__device__ __forceinline__ void ld_mod(f32x4 (&A)[4], f32x4 (&B)[4], const float* gain, const float* shift, const float* scale, int lane) {
#pragma unroll
    for (int j = 0; j < 4; ++j) { const int cc = 4 * lane + 256 * j; A[j] = ld4(gain + cc) * (ld4(scale + cc) + 1.f); B[j] = ld4(shift + cc); } }
__device__ __forceinline__ void resid_add2(f32x4 (&x)[4], const f32x4 (&y)[4], const f32x4 (&G)[4]) {
    const float rstd = rsqrtf(sumsq4(y) * (1.f / DM) + EPS);
#pragma unroll
    for (int j = 0; j < 4; ++j) x[j] = x[j] + G[j] * (y[j] * rstd);
}
__device__ __forceinline__ void norm_mod2(const f32x4 (&x)[4], f32x4 (&hv)[4], const f32x4 (&A)[4], const f32x4 (&B)[4]) {
    const float rstd = rsqrtf(sumsq4(x) * (1.f / DM) + EPS);
#pragma unroll
    for (int j = 0; j < 4; ++j) hv[j] = (x[j] * rstd) * A[j] + B[j];
}

__device__ __forceinline__ int perm_row(int pmode, int n) {
    if (pmode == 1) { if (n >= 1024 && n < 2048) { const int d = n & 63, hb = n & ~63; return hb + ((d < 32) ? 8 * (d >> 2) + (d & 3) : 8 * ((d - 32) >> 2) + 4 + (d & 3)); } }
    else if (pmode == 2) { if (n >= 1920 && n < 1952) { const int d = n - 1920; return 1920 + ((d < 16) ? 8 * (d >> 2) + (d & 3) : 8 * ((d - 16) >> 2) + 4 + (d & 3)); } }
    return n;
}
__device__ __forceinline__ void tr_item(const float* W, int ldw, bf16_t* WT, int ldt, int k0, int n0, int drow, LAS float* scr, int lane, int pmode = 0) {
#pragma unroll 8
    for (int i = 0; i < 32; ++i) { const int kk = 2 * i + (lane >> 5); scr[kk * 33 + (lane & 31)] = W[(size_t)(k0 + kk) * ldw + n0 + (lane & 31)]; }
    LDS_WAIT(); asm volatile("" ::: "memory");
    const int c = lane & 7;
#pragma unroll
    for (int j = 0; j < 4; ++j) { const int n = (lane >> 3) + 8 * j; const LAS float* s = scr + (8 * c) * 33 + n;
        u32x4 o; o.x = cvtpk(s[0 * 33], s[1 * 33]); o.y = cvtpk(s[2 * 33], s[3 * 33]); o.z = cvtpk(s[4 * 33], s[5 * 33]); o.w = cvtpk(s[6 * 33], s[7 * 33]);
        const int dr = pmode ? perm_row(pmode, n0 + n) : drow + n;
        *(u32x4*)(WT + (size_t)dr * ldt + k0 + 8 * c) = o; }
    LDS_WAIT(); asm volatile("" ::: "memory");
}
__device__ __forceinline__ void tr_item8(const float* W, int ldw, unsigned char* WT, int ldt, int k0, int n0, int drow, LAS float* scr, int lane, int pmode = 0) {
#pragma unroll 8
    for (int i = 0; i < 32; ++i) { const int kk = 2 * i + (lane >> 5); scr[kk * 33 + (lane & 31)] = W[(size_t)(k0 + kk) * ldw + n0 + (lane & 31)] * F8_W_SCALE; }
    LDS_WAIT(); asm volatile("" ::: "memory");
    const int c = lane & 7;
#pragma unroll
    for (int j = 0; j < 4; ++j) { const int n = (lane >> 3) + 8 * j; const LAS float* s = scr + (8 * c) * 33 + n;
        u32x2 o; o.x = pk4_fp8(s[0 * 33], s[1 * 33], s[2 * 33], s[3 * 33]); o.y = pk4_fp8(s[4 * 33], s[5 * 33], s[6 * 33], s[7 * 33]);
        const int dr = pmode ? perm_row(pmode, n0 + n) : drow + n;
        *(u32x2*)(WT + (size_t)dr * ldt + k0 + 8 * c) = o; }
    LDS_WAIT(); asm volatile("" ::: "memory");
}
__device__ __forceinline__ void tr_matrix8(const Ctx& c, const float* W, int K, int N, unsigned char* WT, int mode, int row_off, int pmode = 0) {
    LAS float* scr = (LAS float*)(c.lds + c.wid * 16384);
    const int nblk = N / 32, nitems = (K / 64) * nblk;
    for (int it = c.gw; it < nitems; it += c.NGW) { const int kb = it / nblk, nb = it % nblk, n0 = 32 * nb;
        const int drow = (mode == 0) ? row_off + n0 : (n0 >> 7) * 256 + (n0 & 127) + (mode == 2 ? 128 : 0);
        tr_item8(W, N, WT, K, 64 * kb, n0, drow, scr, c.lane, pmode); }
}
__device__ __forceinline__ void tr_matrix(const Ctx& c, const float* W, int K, int N, bf16_t* WT, int mode, int row_off, int pmode = 0) {
    LAS float* scr = (LAS float*)(c.lds + c.wid * 16384);
    const int nblk = N / 32, nitems = (K / 64) * nblk;
    for (int it = c.gw; it < nitems; it += c.NGW) { const int kb = it / nblk, nb = it % nblk, n0 = 32 * nb;
        const int drow = (mode == 0) ? row_off + n0 : (n0 >> 7) * 256 + (n0 & 127) + (mode == 2 ? 128 : 0);
        tr_item(W, N, WT, K, 64 * kb, n0, drow, scr, c.lane, pmode); }
}
constexpr int MOE_CVT_ITEMS = 24 * 1792;
__device__ __forceinline__ void convert_moe_items(const Ctx& c, int i, int t0, int t1, int wsel, int nsel) {
    KParams& P = kparams();
    LAS float* scr = (LAS float*)(c.lds + c.wid * 16384);
    if (wsel < 0) return;
    for (int t = t0 + wsel; t < t1; t += nsel) {
        const int mat = t / 1792, r = t % 1792, e = mat / 3, which = mat % 3;
        if (which < 2) {
            const float* W = P.in[28 + which] + ((size_t)i * NEXP + e) * DM * DFFE; const int kb = r / 112, n0 = 32 * (r % 112);
            const int drow = (n0 >> 7) * 256 + (n0 & 127) + which * 128;
#if MOE_F8
            tr_item8(W, DFFE, (unsigned char*)(P.ws + WS_W13M) + (size_t)e * 2 * DFFE * DM, DM, 64 * kb, n0, drow, scr, c.lane);
#else
            tr_item(W, DFFE, (bf16_t*)(P.ws + WS_W13M) + (size_t)e * 2 * DFFE * DM, DM, 64 * kb, n0, drow, scr, c.lane);
#endif
        } else {
            const float* W = P.in[30] + ((size_t)i * NEXP + e) * DFFE * DM; const int kb = r / 32, n0 = 32 * (r % 32);
#if MOE_F8
            tr_item8(W, DM, (unsigned char*)(P.ws + WS_W2M) + (size_t)e * DM * DFFE, DFFE, 64 * kb, n0, n0, scr, c.lane);
#else
            tr_item(W, DM, (bf16_t*)(P.ws + WS_W2M) + (size_t)e * DM * DFFE, DFFE, 64 * kb, n0, n0, scr, c.lane);
#endif
        }
    }
}
__device__ __forceinline__ void prologue0(const Ctx& c_) {
    const Ctx c = make_ctx(c_.lds);
    KParams& P = kparams(); unsigned char* ws = P.ws;
    if (blockIdx.x < 96) {
        LAS float* sl = (LAS float*)c.lds;
        LAS float* part = (LAS float*)(c.lds + 32768);
        for (int i = c.tid; i < 5 * DM; i += 512) { const int r = i >> 10, k = i & 1023; const float x = r < 4 ? P.in[1][r * DM + k] : P.in[3][k]; sl[i] = x / (1.f + expf(-x)); }
        __syncthreads();
        const int t = blockIdx.x, lm = t / 24, cbk = t % 24, n = cbk * 256 + 4 * c.lane;
        const float* W = P.in[4] + (size_t)lm * DM * (NMOD * DM) + n;
        f32x4 acc[5];
#pragma unroll
        for (int r = 0; r < 5; ++r) acc[r] = (f32x4){0.f, 0.f, 0.f, 0.f};
        const int kb = c.wid * 128;
        for (int k0 = 0; k0 < 128; k0 += 8) {
            f32x4 wv[8];
#pragma unroll
            for (int u = 0; u < 8; ++u) wv[u] = ld4(W + (size_t)(kb + k0 + u) * (NMOD * DM));
#pragma unroll
            for (int u = 0; u < 8; ++u)
#pragma unroll
                for (int r = 0; r < 5; ++r) acc[r] += wv[u] * sl[r * DM + kb + k0 + u];
        }
#pragma unroll
        for (int r = 0; r < 5; ++r) *(LAS f32x4*)(part + (c.wid * 5 + r) * 256 + 4 * c.lane) = acc[r];
        __syncthreads();
        for (int i = c.tid; i < 5 * 256; i += 512) { const int r = i >> 8, cc = i & 255; float s = 0.f;
#pragma unroll
            for (int w = 0; w < 8; ++w) s += part[(w * 5 + r) * 256 + cc];
            ((float*)(ws + WS_MODS))[(size_t)(lm * 5 + r) * (NMOD * DM) + cbk * 256 + cc] = s + P.in[5][lm * (NMOD * DM) + cbk * 256 + cc]; }
        __syncthreads();
    }
    for (int i = 0; i < 2; ++i) {
        if (WIN8(2 * i)) tr_matrix8(c, P.in[7] + (size_t)i * DM * EV_IN, DM, EV_IN, (unsigned char*)(ws + WS_WINE) + (size_t)i * EV_IN * DM * 2, 0, 0, 1);
        else tr_matrix(c, P.in[7] + (size_t)i * DM * EV_IN, DM, EV_IN, (bf16_t*)(ws + WS_WINE) + (size_t)i * EV_IN * DM, 0, 0, 1);
        tr_matrix(c, P.in[8] + (size_t)i * DM * DM, DM, DM, (bf16_t*)(ws + WS_WOUTE) + (size_t)i * DM * DM, 0, 0);
        if (FFN8(i)) {
            tr_matrix8(c, P.in[17] + (size_t)i * DM * DFF, DM, DFF, (unsigned char*)(ws + WS_W13E) + (size_t)i * 2 * DFF * DM * 2, 1, 0);
            tr_matrix8(c, P.in[18] + (size_t)i * DM * DFF, DM, DFF, (unsigned char*)(ws + WS_W13E) + (size_t)i * 2 * DFF * DM * 2, 2, 0);
            tr_matrix8(c, P.in[19] + (size_t)i * DFF * DM, DFF, DM, (unsigned char*)(ws + WS_W2E) + (size_t)i * DM * DFF * 2, 0, 0);
        } else {
            tr_matrix(c, P.in[17] + (size_t)i * DM * DFF, DM, DFF, (bf16_t*)(ws + WS_W13E) + (size_t)i * 2 * DFF * DM, 1, 0);
            tr_matrix(c, P.in[18] + (size_t)i * DM * DFF, DM, DFF, (bf16_t*)(ws + WS_W13E) + (size_t)i * 2 * DFF * DM, 2, 0);
            tr_matrix(c, P.in[19] + (size_t)i * DFF * DM, DFF, DM, (bf16_t*)(ws + WS_W2E) + (size_t)i * DM * DFF, 0, 0);
        }
        if (WIN8(2 * i + 1)) tr_matrix8(c, P.in[20] + (size_t)i * DM * OD_IN, DM, OD_IN, (unsigned char*)(ws + WS_WINO) + (size_t)i * OD_INP * DM * 2, 0, 0, 2);
        else tr_matrix(c, P.in[20] + (size_t)i * DM * OD_IN, DM, OD_IN, (bf16_t*)(ws + WS_WINO) + (size_t)i * OD_INP * DM, 0, 0, 2);
        tr_matrix(c, P.in[21] + (size_t)i * DM * DM, DM, DM, (bf16_t*)(ws + WS_WOUTO) + (size_t)i * DM * DM, 0, 0);
    }
    const int gt = blockIdx.x * 512 + c.tid, NGT = gridDim.x * 512;
    for (int i = gt; i < 2 * (OD_INP - OD_IN) * DM; i += NGT) { const int l = i / ((OD_INP - OD_IN) * DM), r = i % ((OD_INP - OD_IN) * DM);
        if (WIN8(2 * l + 1)) ((unsigned char*)(ws + WS_WINO))[(size_t)l * OD_INP * DM * 2 + (size_t)OD_IN * DM + r] = 0;
        else ((bf16_t*)(ws + WS_WINO))[(size_t)l * OD_INP * DM + (size_t)OD_IN * DM + r] = 0; }
    for (int i = gt; i < 2 * MLA_N * MLA_K; i += NGT) { const int l = i / (MLA_N * MLA_K), n = (i / MLA_K) % MLA_N, k = i % MLA_K; float v = 0.f;
        if (n < 384) { if (k < 256) { const int h = n / 96, j = n % 96; int sc = n;
                if (j >= 64) { const int p = j - 64, t = p >> 3, e = p & 7; sc = h * 96 + 64 + ((e < 4) ? 4 * t + e : 16 + 4 * t + (e - 4)); }
                v = P.in[24][((size_t)l * 256 + k) * 384 + sc] * P.in[23][l * 256 + k]; } }
        else if (n < 768) { const int h = (n - 384) / 96, j = (n - 384) % 96;
            if (j < 64) { if (k >= 256 && k < 384) v = P.in[26][((size_t)l * 128 + (k - 256)) * 768 + h * 192 + j] * P.in[25][l * 128 + (k - 256)]; }
            else { if (k == 384 + (j - 64)) v = 1.f; } }
        else { const int h = (n - 768) / 128, j = (n - 768) % 128; if (k >= 256 && k < 384) v = P.in[26][((size_t)l * 128 + (k - 256)) * 768 + h * 192 + 64 + j] * P.in[25][l * 128 + (k - 256)]; }
        ((bf16_t*)(ws + WS_WMLA))[i] = f2bf(v); }
    for (int i = gt; i < 2 * 4 * 128 * 128; i += NGT) ((bf16_t*)(ws + WS_SGUW))[i] = f2bf(P.in[9][i]);
    for (int i = gt; i < SEQ * 32; i += NGT) { const int s = i >> 5, f = i & 31; const int pos = f < 16 ? (s >> 6) : (s & 63);
        const float inv = 1.0f / powf(10000.0f, (float)(f & 15) / 16.0f); const float ang = (float)pos * inv;
        ((float*)(ws + WS_ROPEB))[i] = (float)cos((double)ang); ((float*)(ws + WS_ROPEB))[SEQ * 32 + i] = (float)sin((double)ang); }
    for (int i = gt; i < SEQ * 16; i += NGT) { const int s = i >> 4, f = i & 15; const int pos = f < 8 ? (s >> 6) : (s & 63);
        const float inv = 1.0f / powf(10000.0f, (float)(f & 7) / 8.0f); const float ang = (float)pos * inv;
        ((float*)(ws + WS_ROPED))[i] = (float)cos((double)ang); ((float*)(ws + WS_ROPED))[SEQ * 16 + i] = (float)sin((double)ang); }
}

__device__ __forceinline__ void convert_moe_tail(const Ctx& c_, int i, int t0, int t1, int nunits) {
    const Ctx c = make_ctx(c_.lds);
    const int G = (int)gridDim.x, rem = nunits % G, bid = opaque_bid();
    const int first = rem;
    convert_moe_items(c, i, t0, t1, bid >= first ? (bid - first) * 8 + c.wid : -1, (G - first) * 8);
}

__device__ __forceinline__ void ew_first(const Ctx& c_) {
    const Ctx c = make_ctx(c_.lds);
    KParams& P = kparams(); const float* mods = (const float*)(P.ws + WS_MODS); bf16_t* HB = (bf16_t*)(P.ws + WS_HB);
    int r0, r1; wave_rows(c, MTOT, r0, r1);
    f32x4 A0[4], B0[4]; int rcur = -1;
    for (int row = r0; row < r1; ++row) {
        const float* src = row < NLAT ? P.in[0] + (size_t)row * DM : P.in[2] + (size_t)(row - NLAT) * DM;
        bf16_t* xr = xrow_ptr(P, row); const int r = mod_r(row);
        if (r != rcur) { rcur = r; const float* mb = mods + (size_t)(0 * 5 + r) * (NMOD * DM); ld_mod(A0, B0, P.in[6] + (0 * 4 + 0) * DM, mb + 0 * DM, mb + 1 * DM, c.lane); }
        f32x4 x[4], h[4];
#pragma unroll
        for (int j = 0; j < 4; ++j) { x[j] = ld4(src + 4 * c.lane + 256 * j); stbf4(xr + 4 * c.lane + 256 * j, x[j]); }
        norm_mod2(x, h, A0, B0);
#pragma unroll
        for (int j = 0; j < 4; ++j) stbf4(HB + (size_t)row * DM + 4 * c.lane + 256 * j, h[j]);
    }
}

__device__ __forceinline__ void ew_mid(const Ctx& c_, int l, int mtok, bool dry = false) {
    const Ctx c = make_ctx(c_.lds);
    KParams& P = kparams(); const float* mods = (const float*)(P.ws + WS_MODS); bf16_t* HB = (bf16_t*)(P.ws + WS_HB);
    const bf16_t* YB = (const bf16_t*)(P.ws + WS_U + U_YB);
    const bool odd = (l & 1) != 0; const int li = l >> 1;
    LAS float* wrl = (LAS float*)c.lds;
    if (odd) { for (int i = c.tid; i < DM * NEXP; i += 512) { const int col = i >> 3, e = i & 7; wrl[e * DM + col] = P.in[27][(size_t)li * DM * NEXP + i]; } __syncthreads(); }
    unsigned long long cw = 0ull; int st_e1 = 0, st_e2 = 0, st_l1 = 0, st_l2 = 0; float st_g1 = 0.f; int nrow = 0;
    int r0, r1; wave_rows(c, mtok, r0, r1);
    f32x4 G1[4], A2[4], B2[4]; int rcur = -1;
    u32x2 xa[4], ya[4], xb[4], yb[4];
#define EWM_LOAD(X, Y, rw) do { const int _row = (rw); const bf16_t* _xr = xrow_ptr(P, _row); \
        _Pragma("unroll") for (int j = 0; j < 4; ++j) { X[j] = *(const u32x2*)(_xr + 4 * c.lane + 256 * j); Y[j] = *(const u32x2*)(YB + (size_t)_row * DM + 4 * c.lane + 256 * j); } } while (0)
    if (r0 < r1) EWM_LOAD(xa, ya, r0);
    if (r0 + 1 < r1) EWM_LOAD(xb, yb, r0 + 1);
    for (int row = r0; row < r1; ++row, ++nrow) {
        bf16_t* xr = xrow_ptr(P, row); const int r = mod_r(row);
        if (r != rcur) { rcur = r; const float* mb = mods + (size_t)(l * 5 + r) * (NMOD * DM);
            ld_gate(G1, P.in[6] + (l * 4 + 1) * DM, mb + 2 * DM, c.lane); ld_mod(A2, B2, P.in[6] + (l * 4 + 2) * DM, mb + 3 * DM, mb + 4 * DM, c.lane); }
        f32x4 x[4], y[4], h[4];
#pragma unroll
        for (int j = 0; j < 4; ++j) { x[j] = (f32x4){bflo(xa[j].x), bfhi(xa[j].x), bflo(xa[j].y), bfhi(xa[j].y)}; y[j] = (f32x4){bflo(ya[j].x), bfhi(ya[j].x), bflo(ya[j].y), bfhi(ya[j].y)}; xa[j] = xb[j]; ya[j] = yb[j]; }
        if (row + 2 < r1) EWM_LOAD(xb, yb, row + 2);
        resid_add2(x, y, G1);
        bf16_t* xw = dry ? (bf16_t*)(P.ws + WS_U + U_YS) + (size_t)row * DM : xr; bf16_t* hw = (dry ? (bf16_t*)(P.ws + WS_U + U_PB) : HB) + (size_t)row * DM;
#pragma unroll
        for (int j = 0; j < 4; ++j) stbf4(xw + 4 * c.lane + 256 * j, x[j]);
        norm_mod2(x, h, A2, B2);
        if ((odd && MOE_F8) || (!odd && FFN8(li))) {
            unsigned char* h8 = (unsigned char*)(dry ? (bf16_t*)(P.ws + WS_U + U_PB) : HB) + (size_t)row * DM;
#pragma unroll
            for (int j = 0; j < 4; ++j) *(unsigned*)(h8 + 4 * c.lane + 256 * j) = pk4_fp8(h[j][0] * F8_ACT_SCALE, h[j][1] * F8_ACT_SCALE, h[j][2] * F8_ACT_SCALE, h[j][3] * F8_ACT_SCALE);
        } else {
#pragma unroll
            for (int j = 0; j < 4; ++j) stbf4(hw + 4 * c.lane + 256 * j, h[j]);
        }
        if (odd && !dry) {
            float lg[8];
#pragma unroll
            for (int e = 0; e < 8; ++e) { float sacc = 0.f;
#pragma unroll
                for (int j = 0; j < 4; ++j) { const f32x4 w = *(const LAS f32x4*)(wrl + e * DM + 4 * c.lane + 256 * j); sacc += (h[j][0] * w[0] + h[j][1] * w[1]) + (h[j][2] * w[2] + h[j][3] * w[3]); }
                lg[e] = wave_sum(sacc); }
            int e1 = 0; float v1 = lg[0];
#pragma unroll
            for (int e = 1; e < 8; ++e) if (lg[e] > v1) { v1 = lg[e]; e1 = e; }
            int e2 = -1; float v2 = -3.0e38f;
#pragma unroll
            for (int e = 0; e < 8; ++e) if (e != e1 && lg[e] > v2) { v2 = lg[e]; e2 = e; }
            if (e2 < 0) e2 = (e1 + 1) & 7;
            const float g1 = 1.f / (1.f + expf(v2 - v1));
            const int l1 = (int)((cw >> (8 * e1)) & 0xffull); cw += 1ull << (8 * e1);
            const int l2 = (int)((cw >> (8 * e2)) & 0xffull); cw += 1ull << (8 * e2);
            if (c.lane == nrow) { st_e1 = e1; st_e2 = e2; st_l1 = l1; st_l2 = l2; st_g1 = g1; }
        }
    }
    if (odd && !dry) {
        unsigned* cnt = (unsigned*)(P.ws + WS_CTL) + CW_MOECNT + li * 64;
        int base = 0;
        if (c.lane < 8) { const unsigned wc = (unsigned)((cw >> (8 * c.lane)) & 0xffull); base = wc ? (int)atomicAdd(cnt + c.lane, wc) : 0; }
        const int b1 = __shfl(base, st_e1), b2 = __shfl(base, st_e2);
        if (c.lane < nrow) { const int row = r0 + c.lane; int4* ti = (int4*)(P.ws + WS_TOKINFO) + (size_t)row * 2;
            ti[0] = make_int4(st_e1, b1 + st_l1, st_e2, b2 + st_l2); ti[1] = make_int4(__float_as_int(st_g1), __float_as_int(1.f - st_g1), 0, 0); }
        __syncthreads();
    }
#undef EWM_LOAD
}

__device__ __forceinline__ void moe_offsets(KParams& P, int li, int (&toff)[9]) {
    const unsigned* cnt = (const unsigned*)(P.ws + WS_CTL) + CW_MOECNT + li * 64; int acc = 0;
#pragma unroll
    for (int e = 0; e < 8; ++e) { toff[e] = acc; const unsigned n = __builtin_amdgcn_readfirstlane(__hip_atomic_load(cnt + e, __ATOMIC_RELAXED, __HIP_MEMORY_SCOPE_AGENT)); acc += (int)((n + 255u) >> 8); }
    toff[8] = acc;
}
__device__ __forceinline__ void moe_gather(const Ctx& c_, int li, int mtok) {
    const Ctx c = make_ctx(c_.lds);
    KParams& P = kparams(); int toff[9]; moe_offsets(P, li, toff);
    int tv = 0;
#pragma unroll
    for (int e = 0; e < 8; ++e) tv = (c.lane == e) ? toff[e] : tv;
    const bf16_t* HB = (const bf16_t*)(P.ws + WS_HB); bf16_t* HS = (bf16_t*)(P.ws + WS_U + U_YS);
    int r0, r1; wave_rows(c, mtok, r0, r1);
    for (int row = r0; row < r1; ++row) {
        const int4* ti = (const int4*)(P.ws + WS_TOKINFO) + (size_t)row * 2; const int4 a = ti[0], b = ti[1];
        const int pA = __shfl(tv, a.x) * 256 + a.y, pB = __shfl(tv, a.z) * 256 + a.w;
        if (c.lane == 0) ((int4*)(P.ws + WS_TOKPOS))[row] = make_int4(pA, pB, b.x, b.y);
#if MOE_F8
        const u32x4 v0 = ((const u32x4*)((const unsigned char*)HB + (size_t)row * DM))[c.lane];
        ((u32x4*)((unsigned char*)HS + (size_t)pA * DM))[c.lane] = v0; ((u32x4*)((unsigned char*)HS + (size_t)pB * DM))[c.lane] = v0;
#else
        const u32x4* src = (const u32x4*)(HB + (size_t)row * DM); const u32x4 v0 = src[c.lane], v1 = src[64 + c.lane];
        u32x4* dA = (u32x4*)(HS + (size_t)pA * DM); u32x4* dB = (u32x4*)(HS + (size_t)pB * DM);
        dA[c.lane] = v0; dA[64 + c.lane] = v1; dB[c.lane] = v0; dB[64 + c.lane] = v1;
#endif
    }
}

__device__ __forceinline__ void ew_last(const Ctx& c_, int l, int mtok, bool dry = false) {
    const Ctx c = make_ctx(c_.lds);
    KParams& P = kparams(); const float* mods = (const float*)(P.ws + WS_MODS); bf16_t* HB = (bf16_t*)(P.ws + WS_HB);
    const bf16_t* YS = (const bf16_t*)(P.ws + WS_U + U_YS); const bool odd = (l & 1) != 0;
    int r0, r1; wave_rows(c, mtok, r0, r1);
    f32x4 G3[4], A0[4], B0[4]; int rcur = -1;
    u32x2 xa[4], ya[4], za[4], xb[4], yb[4], zb[4]; float gAa = 0.f, gBa = 0.f, gAb = 0.f, gBb = 0.f;
#define EWL_LOAD(X, Y, Z, GA, GB, rw) do { const int _row = (rw); const bf16_t* _xr = xrow_ptr(P, _row); \
        if (odd) { const int4 tp = ((const int4*)(P.ws + WS_TOKPOS))[_row]; GA = __int_as_float(tp.z); GB = __int_as_float(tp.w); \
            _Pragma("unroll") for (int j = 0; j < 4; ++j) { Y[j] = *(const u32x2*)(YS + (size_t)tp.x * DM + 4 * c.lane + 256 * j); Z[j] = *(const u32x2*)(YS + (size_t)tp.y * DM + 4 * c.lane + 256 * j); } } \
        else { _Pragma("unroll") for (int j = 0; j < 4; ++j) Y[j] = *(const u32x2*)(YS + (size_t)_row * DM + 4 * c.lane + 256 * j); } \
        _Pragma("unroll") for (int j = 0; j < 4; ++j) X[j] = *(const u32x2*)(_xr + 4 * c.lane + 256 * j); } while (0)
    if (r0 < r1) EWL_LOAD(xa, ya, za, gAa, gBa, r0);
    if (r0 + 1 < r1) EWL_LOAD(xb, yb, zb, gAb, gBb, r0 + 1);
    for (int row = r0; row < r1; ++row) {
        bf16_t* xr = xrow_ptr(P, row); const int r = mod_r(row);
        if (r != rcur) { rcur = r; const float* mb = mods + (size_t)(l * 5 + r) * (NMOD * DM);
            ld_gate(G3, P.in[6] + (l * 4 + 3) * DM, mb + 5 * DM, c.lane);
            if (l < 3) { const float* mn = mods + (size_t)((l + 1) * 5 + r) * (NMOD * DM); ld_mod(A0, B0, P.in[6] + ((l + 1) * 4 + 0) * DM, mn + 0 * DM, mn + 1 * DM, c.lane); } }
        f32x4 x[4], y[4], h[4];
#pragma unroll
        for (int j = 0; j < 4; ++j) { x[j] = (f32x4){bflo(xa[j].x), bfhi(xa[j].x), bflo(xa[j].y), bfhi(xa[j].y)};
            y[j] = (f32x4){bflo(ya[j].x), bfhi(ya[j].x), bflo(ya[j].y), bfhi(ya[j].y)};
            if (odd) y[j] = y[j] * gAa + (f32x4){bflo(za[j].x), bfhi(za[j].x), bflo(za[j].y), bfhi(za[j].y)} * gBa;
            xa[j] = xb[j]; ya[j] = yb[j]; za[j] = zb[j]; }
        gAa = gAb; gBa = gBb;
        if (row + 2 < r1) EWL_LOAD(xb, yb, zb, gAb, gBb, row + 2);
        resid_add2(x, y, G3);
        bf16_t* hw = (dry ? (bf16_t*)(P.ws + WS_U + U_MIX) : HB) + (size_t)row * DM;
        if (l == 3 && !dry) { float* ow = P.out + (size_t)row * DM;
#pragma unroll
            for (int j = 0; j < 4; ++j) *(f32x4*)(ow + 4 * c.lane + 256 * j) = x[j]; }
        else { bf16_t* xw = dry ? (bf16_t*)(P.ws + WS_U + U_PB) + (size_t)row * DM : xr;
#pragma unroll
            for (int j = 0; j < 4; ++j) stbf4(xw + 4 * c.lane + 256 * j, x[j]); }
        if (l < 3) { norm_mod2(x, h, A0, B0);
            if (WIN8(l + 1)) { unsigned char* h8 = (unsigned char*)(dry ? (bf16_t*)(P.ws + WS_U + U_MIX) : HB) + (size_t)row * DM;
#pragma unroll
                for (int j = 0; j < 4; ++j) *(unsigned*)(h8 + 4 * c.lane + 256 * j) = pk4_fp8(h[j][0] * F8_ACT_SCALE, h[j][1] * F8_ACT_SCALE, h[j][2] * F8_ACT_SCALE, h[j][3] * F8_ACT_SCALE); }
            else {
#pragma unroll
                for (int j = 0; j < 4; ++j) stbf4(hw + 4 * c.lane + 256 * j, h[j]); } }
    }
#undef EWL_LOAD
}

__device__ __forceinline__ void attn_even(const Ctx& c_, int l) {
    const Ctx c = make_ctx(c_.lds);
    KParams& P = kparams(); const int i = l >> 1; const bool need_ctx = l < 3;
    const bf16_t* PB = (const bf16_t*)(P.ws + WS_U + U_PB); bf16_t* MIX = (bf16_t*)(P.ws + WS_U + U_MIX);
    const int nchunk = need_ctx ? 264 : 256;
    for (int u = opaque_bid(); u < nchunk * 4; u += gridDim.x) att::sgu_unit(c.lds, PB, (const bf16_t*)(P.ws + WS_SGUW) + (size_t)i * 4 * 128 * 128, P.in[10] + i * 512, (const float*)(P.ws + WS_STATS), P.in[11] + i * 512, MIX, (u >> 2) * 128, u & 3);
    float d1 = 0.f, d2 = 0.f;
    if (c.lane < 64) { d1 = P.in[12][i * 64 + c.lane] * P.in[13][i * 64 + c.lane]; d2 = P.in[14][i * 64 + c.lane] * P.in[15][i * 64 + c.lane]; }
    const float lam_init = 0.8f - 0.6f * expf(-0.3f * (float)l);
    const float lam = expf(wave_sum(d1)) - expf(wave_sum(d2)) + lam_init;
    att::Args a;
    a.Q = PB; a.ldq = EV_IN; a.K = PB; a.ldk = EV_IN; a.V = PB; a.ldv = EV_IN; a.C = 0.125f * LOG2E;
    a.rcos = (const float*)(P.ws + WS_ROPEB); a.rsin = a.rcos + SEQ * 32; a.O = MIX; a.ldo = DM; a.g = 0; a.u0 = 0; a.rpb = nullptr;
    a.lam = lam; a.oscale = 1.f - lam_init; a.subg = P.in[16] + i * 128; a.nt_ctx = 4;
    const int nctxu = need_ctx ? 32 : 0, nu = nctxu + 1024;
    for (int u = xcd_unit_base(); u < nu; u += gridDim.x) {
        int b, h;
        if (u < nctxu) { b = u >> 3; h = (u >> 1) & 3; a.q_row0 = NLAT + b * CTXL + (u & 1) * 128; a.nt_lat = 0; a.rope = 0; }
        else { const int v = u - nctxu; b = v >> 8; h = (v >> 6) & 3; a.q_row0 = b * SEQ + (v & 63) * 128; a.nt_lat = SEQ / 64; a.rope = 0; }
        a.qcol = 1024 + h * 128; a.kcol = 1536 + h * 128; a.vcol = 2048 + h * 128; a.ocol = 512 + h * 128;
        a.kctx_row0 = NLAT + b * CTXL; a.klat_row0 = b * SEQ;
        att::attn_unit<64, 128, 128, 1>(c.lds, a);
    }
}
__device__ __forceinline__ void attn_odd_na(const Ctx& c_, int l) {
    const Ctx c = make_ctx(c_.lds);
    KParams& P = kparams(); const int i = l >> 1; const bool need_ctx = l < 3;
    const bf16_t* PB = (const bf16_t*)(P.ws + WS_U + U_PB); bf16_t* MIX = (bf16_t*)(P.ws + WS_U + U_MIX);
    att::Args a;
    a.Q = PB; a.ldq = OD_INP; a.K = PB; a.ldk = OD_INP; a.V = PB; a.ldv = OD_INP; a.C = 0.125f * LOG2E; a.rope = 0; a.rcos = nullptr; a.rsin = nullptr;
    a.O = MIX; a.ldo = DM; a.lam = 0.f; a.oscale = 1.f; a.subg = nullptr; a.nt_ctx = 4;
    const int nctxu = need_ctx ? 32 : 0, nu = nctxu + 1024;
    for (int u = xcd_unit_base(); u < nu; u += gridDim.x) {
        int b, h;
        if (u < nctxu) { b = u >> 3; h = u & 7; a.q_row0 = NLAT + b * CTXL; a.nt_lat = 0; a.g = 0; a.u0 = 0; a.klat_row0 = 0; }
        else { const int v = u - nctxu; b = v >> 8; h = (v >> 5) & 7; const int g = v & 31; a.g = g; a.u0 = min(max(4 * g - 4, 0), 116);
            a.q_row0 = b * SEQ + g * 256; a.nt_lat = 12; a.klat_row0 = b * SEQ + a.u0 * 64; }
        a.qcol = h * 64; a.kcol = 512 + h * 64; a.vcol = 1024 + h * 64; a.ocol = h * 64; a.kctx_row0 = NLAT + b * CTXL;
        a.rpb = P.in[22] + ((size_t)i * 8 + h) * 465;
        att::attn_unit<64, 64, 64, 2>(c.lds, a);
    }
}
__device__ __forceinline__ void attn_odd_mla(const Ctx& c_, int l) {
    const Ctx c = make_ctx(c_.lds);
    KParams& P = kparams(); const bool need_ctx = l < 3;
    const bf16_t* MO = (const bf16_t*)(P.ws + WS_U + U_MLAO); bf16_t* MIX = (bf16_t*)(P.ws + WS_U + U_MIX);
    att::Args a;
    a.Q = MO; a.ldq = MLA_N; a.K = MO; a.ldk = MLA_N; a.V = MO; a.ldv = MLA_N; a.C = 0.10206207261596575f * LOG2E;
    a.rcos = (const float*)(P.ws + WS_ROPED); a.rsin = a.rcos + SEQ * 16; a.O = MIX; a.ldo = DM; a.g = 0; a.u0 = 0; a.rpb = nullptr; a.lam = 0.f; a.oscale = 1.f; a.subg = nullptr; a.nt_ctx = 4;
    const int nctxu = need_ctx ? 16 : 0, nu = nctxu + 512;
    for (int u = xcd_unit_base(); u < nu; u += gridDim.x) {
        int b, h;
        if (u < nctxu) { b = u >> 2; h = u & 3; a.q_row0 = NLAT + b * CTXL; a.nt_lat = 0; a.rope = 0; }
        else { const int v = u - nctxu; b = v >> 7; h = (v >> 5) & 3; a.q_row0 = b * SEQ + (v & 31) * 256; a.nt_lat = SEQ / 64; a.rope = 2; }
        a.qcol = h * 96; a.kcol = 384 + h * 96; a.vcol = 768 + h * 128; a.ocol = 512 + h * 128; a.kctx_row0 = NLAT + b * CTXL; a.klat_row0 = b * SEQ;
        att::attn_unit<96, 96, 128, 0>(c.lds, a);
    }
}

constexpr int N_PHASES = 2 + 2 * (7 + 9);
__global__ void __launch_bounds__(512, 2) fwd_kernel(Params prm) {
    extern __shared__ __attribute__((aligned(16))) unsigned char lds_raw[];
    LAS unsigned char* lds = (LAS unsigned char*)lds_raw;
    const Ctx c{lds, 0, 0, 0, 0, 0};
    for (int u = threadIdx.x; u < (LDS_BYTES - LDS_MISC) / 4; u += 512) ((LAS unsigned*)(lds + LDS_MISC))[u] = 0u;
    __syncthreads();
    XcdBarrier bar;
    { unsigned char* ws0 = kparams().ws; bar.bar = (unsigned*)(ws0 + WS_CTL) + CW_BAR; bar.x = 0; bar.st = nullptr;
#if !MK_PER_PHASE
      bar = xcd_barrier_post((unsigned*)(ws0 + WS_CTL) + CW_BAR, (volatile LAS unsigned*)(lds + LDS_MISC + 32));
#endif
    }
    int ph = 0;
#ifndef PMASK
#define PMASK 0xffffffffu
#endif
#define PM(b) ((PMASK >> (b)) & 1u)
#define PH_ON() (ph >= kparams().ph_lo && ph < kparams().ph_hi)
#define PH_END() do { if (ph >= kparams().ph_lo && ph + 1 < kparams().ph_hi) xcd_barrier(bar); ++ph; } while (0)
#define WSP(off) ((bf16_t*)(ws + (off)))
#define HB WSP(WS_HB)
#define PB WSP(WS_U + U_PB)
#define MIX WSP(WS_U + U_MIX)
#define YB WSP(WS_U + U_YB)
#define HID WSP(WS_U + U_HID)
#define YS WSP(WS_U + U_YS)
#define A2 WSP(WS_U + U_A2)
#define MO WSP(WS_U + U_MLAO)

    if (PM(0) && PH_ON()) for (int rep = 0; rep < DUPN(0); ++rep) { prologue0(c); __syncthreads(); }
    PH_END();
    if (PM(1) && PH_ON()) for (int rep = 0; rep < DUPN(1); ++rep) ew_first(c);
    PH_END();
    for (int lp = 0; lp < 2; ++lp) {
        {
            const int l = 2 * lp, i = lp; const int mtok = l < 3 ? MTOT : NLAT, nMt = mtok / 256;
            if (PM(2) && PH_ON()) for (int rep = 0; rep < DUPN(2); ++rep) { unsigned char* ws = kparams().ws; pg8::Gemm g{}; g.A = HB; g.lda = DM; g.Bt = (const unsigned char*)(ws + WS_WINE) + (size_t)i * EV_IN * DM * 2; g.K = DM; g.nM = MTOT / 256; g.nN = EV_IN / 256; g.grouped = 0; g.estride = 0;
                pg8::EpiEvenIn E{PB, EV_IN, (f32x2*)(ws + WS_STATS), (const float*)(ws + WS_ROPEB), (const float*)(ws + WS_ROPEB) + SEQ * 32, WIN8(l) ? F8_INV : 1.f}; if (WIN8(l)) gemm8_even_in(lds, g, E); else gemm_even_in(lds, g, E); if (rep == 0) convert_moe_tail(c, i, 0, 7296, (MTOT / 256) * (EV_IN / 256)); }
            PH_END();
            if (PM(4) && PH_ON()) for (int rep = 0; rep < DUPN(4); ++rep) attn_even(c, l);
            PH_END();
            if (PM(5) && PH_ON()) for (int rep = 0; rep < DUPN(5); ++rep) { unsigned char* ws = kparams().ws; pg8::Gemm g{}; g.A = MIX; g.lda = DM; g.Bt = (const bf16_t*)(ws + WS_WOUTE) + (size_t)i * DM * DM; g.K = DM; g.nM = nMt; g.nN = DM / 256; g.grouped = 0; g.estride = 0;
                gemm_bf16(lds, g, YB, DM); if (rep == 0) convert_moe_tail(c, i, 7296, 14592, nMt * (DM / 256)); }
            PH_END();
            if (PM(6) && PH_ON()) { if (DUPN(6) > 1) ew_mid(c, l, mtok, true); ew_mid(c, l, mtok); }
            PH_END();
            if (PM(7) && PH_ON()) for (int rep = 0; rep < DUPN(7); ++rep) { unsigned char* ws = kparams().ws; pg8::Gemm g{}; g.A = HB; g.lda = DM; g.Bt = (const unsigned char*)(ws + WS_W13E) + (size_t)i * 2 * DFF * DM * 2; g.K = DM; g.nM = nMt; g.nN = 2 * DFF / 256; g.grouped = 0; g.estride = 0;
                if (FFN8(i)) gemm8_swiglu8(lds, g, (unsigned char*)HID, DFF); else gemm_swiglu(lds, g, HID, DFF);
                if (rep == 0) convert_moe_tail(c, i, 14592, 20224, nMt * (2 * DFF / 256)); }
            PH_END();
            if (PM(8) && PH_ON()) for (int rep = 0; rep < DUPN(8); ++rep) { unsigned char* ws = kparams().ws; pg8::Gemm g{}; g.A = HID; g.lda = DFF; g.Bt = (const unsigned char*)(ws + WS_W2E) + (size_t)i * DM * DFF * 2; g.K = DFF; g.nM = nMt; g.nN = DM / 256; g.grouped = 0; g.estride = 0;
                if (FFN8(i)) gemm8_bf16(lds, g, YS, DM); else gemm_bf16(lds, g, YS, DM);
                if (rep == 0) convert_moe_tail(c, i, 20224, MOE_CVT_ITEMS, nMt * (DM / 256)); }
            PH_END();
            if (PM(9) && PH_ON()) { if (DUPN(9) > 1) ew_last(c, l, mtok, true); ew_last(c, l, mtok); }
            PH_END();
        }
        {
            const int l = 2 * lp + 1, i = lp; const int mtok = l < 3 ? MTOT : NLAT, nMt = mtok / 256;
            if (PM(10) && PH_ON()) for (int rep = 0; rep < DUPN(10); ++rep) { unsigned char* ws = kparams().ws; pg8::Gemm g{}; g.A = HB; g.lda = DM; g.Bt = (const unsigned char*)(ws + WS_WINO) + (size_t)i * OD_INP * DM * 2; g.K = DM; g.nM = MTOT / 256; g.nN = OD_INP / 256; g.grouped = 0; g.estride = 0;
                pg8::EpiOddIn E{PB, OD_INP, (float*)(ws + WS_STATS), (const float*)(ws + WS_ROPED), (const float*)(ws + WS_ROPED) + SEQ * 16, WIN8(l) ? F8_INV : 1.f}; if (WIN8(l)) gemm8_odd_in(lds, g, E); else gemm_odd_in(lds, g, E); }
            PH_END();
            if (PM(12) && PH_ON()) for (int rep = 0; rep < DUPN(12); ++rep) { unsigned char* ws = kparams().ws; pg8::Gemm g{}; g.A = PB + 1536; g.lda = OD_INP; g.Bt = (const bf16_t*)(ws + WS_WMLA) + (size_t)i * MLA_N * MLA_K; g.K = MLA_K; g.nM = MTOT / 256; g.nN = MLA_N / 256; g.grouped = 0; g.estride = 0;
                pg8::EpiMlaUp E{MO, MLA_N, (const float*)(ws + WS_STATS)}; gemm_mla_up(lds, g, E); }
            PH_END();
            if (PH_ON()) { if (PM(13)) for (int rep = 0; rep < DUPN(13); ++rep) attn_odd_na(c, l); if (PM(14)) for (int rep = 0; rep < DUPN(14); ++rep) attn_odd_mla(c, l); }
            PH_END();
            if (PM(15) && PH_ON()) for (int rep = 0; rep < DUPN(15); ++rep) { unsigned char* ws = kparams().ws; pg8::Gemm g{}; g.A = MIX; g.lda = DM; g.Bt = (const bf16_t*)(ws + WS_WOUTO) + (size_t)i * DM * DM; g.K = DM; g.nM = nMt; g.nN = DM / 256; g.grouped = 0; g.estride = 0;
                gemm_bf16(lds, g, YB, DM); }
            PH_END();
            if (PM(16) && PH_ON()) { if (DUPN(16) > 1) ew_mid(c, l, mtok, true); ew_mid(c, l, mtok); }
            PH_END();
            if (PM(17) && PH_ON()) for (int rep = 0; rep < DUPN(17); ++rep) moe_gather(c, i, mtok);
            PH_END();
            if (PM(18) && PH_ON()) for (int rep = 0; rep < DUPN(18); ++rep) { unsigned char* ws = kparams().ws; pg8::Gemm g{}; g.A = YS; g.lda = DM; g.Bt = (const bf16_t*)(ws + WS_W13M); g.K = DM; g.nN = 2 * DFFE / 256; g.grouped = 1; g.estride = (size_t)2 * DFFE * DM;
                moe_offsets(kparams(), i, g.toff); g.nM = g.toff[8];
#if MOE_F8
                gemm8_swiglu8(lds, g, (unsigned char*)HID, DFFE);
#else
                gemm_swiglu(lds, g, HID, DFFE);
#endif
            }
            PH_END();
            if (PM(19) && PH_ON()) for (int rep = 0; rep < DUPN(19); ++rep) { unsigned char* ws = kparams().ws; pg8::Gemm g{}; g.A = HID; g.lda = DFFE; g.Bt = (const bf16_t*)(ws + WS_W2M); g.K = DFFE; g.nN = DM / 256; g.grouped = 1; g.estride = (size_t)DM * DFFE;
                moe_offsets(kparams(), i, g.toff); g.nM = g.toff[8];
#if MOE_F8
                gemm8_bf16(lds, g, YS, DM);
#else
                gemm_bf16(lds, g, YS, DM);
#endif
            }
            PH_END();
            if (PM(20) && PH_ON()) { if (DUPN(20) > 1) ew_last(c, l, mtok, true); ew_last(c, l, mtok); }
            PH_END();
        }
    }
#undef PH_ON
#undef PH_END
#undef HB
#undef PB
#undef MIX
#undef YB
#undef HID
#undef YS
#undef A2
#undef MO
}

extern "C" void kernel_launch(void* const* d_in, const int* in_sizes, int n_in, void* d_out, int out_size, void* d_ws, size_t ws_size, hipStream_t stream) {
    static int grid = 0;
    if (grid == 0) {
        int dev = 0, cus = 0;
        if (n_in != 31 || out_size != NLAT * DM || ws_size < WS_END) { fprintf(stderr, "kernel_launch: unexpected shapes or workspace (n_in %d out %d ws %zu need %zu)\n", n_in, out_size, ws_size, (size_t)WS_END); grid = -1; }
        else if (hipGetDevice(&dev) != hipSuccess || hipDeviceGetAttribute(&cus, hipDeviceAttributeMultiprocessorCount, dev) != hipSuccess) grid = -1;
        else if (hipFuncSetAttribute((const void*)fwd_kernel, hipFuncAttributeMaxDynamicSharedMemorySize, LDS_BYTES) != hipSuccess) grid = -1;
        else { int per_cu = 0; (void)hipOccupancyMaxActiveBlocksPerMultiprocessor(&per_cu, (const void*)fwd_kernel, 512, LDS_BYTES); (void)hipGetLastError(); grid = cus; }
    }
    if (grid < 0) { (void)hipMemsetAsync(d_out, 0, (size_t)out_size * 4, stream); return; }
    (void)hipMemsetAsync((char*)d_ws + WS_CTL, 0, CTL_BYTES, stream);
    Params p{};
    for (int i = 0; i < 31; ++i) p.in[i] = (const float*)d_in[i];
    p.out = (float*)d_out; p.ws = (unsigned char*)d_ws;
#if MK_PER_PHASE
    for (int k = 0; k < N_PHASES; ++k) { p.ph_lo = k; p.ph_hi = k + 1; hipLaunchKernelGGL(fwd_kernel, dim3(grid), dim3(512), LDS_BYTES, stream, p); }
#else
    p.ph_lo = 0; p.ph_hi = N_PHASES;
    hipLaunchKernelGGL(fwd_kernel, dim3(grid), dim3(512), LDS_BYTES, stream, p);
#endif
}
```

```cpp
#include <hip/hip_runtime.h>
#include <stdint.h>
#include <stdio.h>

#ifndef MK_PER_PHASE
#define MK_PER_PHASE 0
#endif
#ifndef DUP_MASK
#define DUP_MASK 0u
#endif
#define DUPN(b) (1 + (int)((DUP_MASK >> (b)) & 1u))
#ifndef FFN_F8
#define FFN_F8 1
#endif
#ifndef FFN_F8_FROM
#define FFN_F8_FROM 1
#endif
#define FFN8(i) (FFN_F8 && (i) >= FFN_F8_FROM)
#ifndef WIN_F8_FROM
#define WIN_F8_FROM 2
#endif
#define WIN8(l) ((l) >= WIN_F8_FROM)
#ifndef MOE_F8
#define MOE_F8 1
#endif

#define LAS __attribute__((address_space(3)))
typedef unsigned short bf16_t;
typedef short bf16x8 __attribute__((ext_vector_type(8)));
typedef short s16x4 __attribute__((ext_vector_type(4)));
typedef float f32x4 __attribute__((ext_vector_type(4)));
typedef float f32x2 __attribute__((ext_vector_type(2)));
typedef float f32x16 __attribute__((ext_vector_type(16)));
typedef unsigned u32x4 __attribute__((ext_vector_type(4)));
typedef unsigned u32x2 __attribute__((ext_vector_type(2)));

constexpr int DM = 1024, NB = 4, SEQ = 8192, NLAT = NB * SEQ, CTXL = 256, NCTX = NB * CTXL, MTOT = NLAT + NCTX;
constexpr int NMOD = 6;
constexpr int EV_IN = 2560, OD_IN = 1952, OD_INP = 2048, DFF = 2816, DFFE = 3584, NEXP = 8;
constexpr int MLA_N = 1280, MLA_K = 512;
constexpr int MS_MAX = 2 * MTOT + NEXP * 256;
constexpr float EPS = 1e-6f;
constexpr float LOG2E = 1.4426950408889634f;

constexpr size_t MiB = (size_t)1 << 20;
constexpr size_t WS_CTL = 0, CTL_BYTES = MiB;
constexpr size_t WS_MODS = 1 * MiB;
constexpr size_t WS_ROPEB = 2 * MiB;
constexpr size_t WS_ROPED = 4 * MiB;
constexpr size_t WS_SGUW = 5 * MiB;
constexpr size_t WS_TOKINFO = 6 * MiB;
constexpr size_t WS_TOKPOS = 8 * MiB;
constexpr size_t WS_CTXX = 10 * MiB;
constexpr size_t WS_WMLA = 14 * MiB;
constexpr size_t WS_WINE = 17 * MiB;
constexpr size_t WS_WOUTE = 27 * MiB;
constexpr size_t WS_W13E = 31 * MiB;
constexpr size_t WS_W2E = 53 * MiB;
constexpr size_t WS_WINO = 64 * MiB;
constexpr size_t WS_WOUTO = 72 * MiB;
constexpr size_t WS_W13M = 76 * MiB;
constexpr size_t WS_W2M = 188 * MiB;
constexpr size_t WS_HB = 244 * MiB;
constexpr size_t WS_U = 310 * MiB;
constexpr size_t U_PB = 0;
constexpr size_t U_MIX = 165 * MiB;
constexpr size_t U_A2 = 231 * MiB;
constexpr size_t U_MLAO = 264 * MiB;
constexpr size_t U_YB = 347 * MiB;
constexpr size_t U_HID = 0;
constexpr size_t U_XB = 549 * MiB;
constexpr size_t U_YS = 413 * MiB;
constexpr size_t WS_STATS = WS_U + 616 * MiB;
constexpr size_t WS_END = WS_STATS + 4 * MiB;
static_assert((size_t)MS_MAX * DFFE * (MOE_F8 ? 1 : 2) <= 347 * MiB && (size_t)MTOT * DFF * 2 <= 347 * MiB, "hid must stay clear of YB");
static_assert(U_YS + (size_t)MS_MAX * DM * 2 <= U_XB && U_XB + (size_t)MTOT * DM * 2 <= 616 * MiB, "ys / xb fit");

constexpr int CW_BAR = 4096;
constexpr int CW_MOECNT = 1024;

constexpr int LDS_BYTES = 147456;
constexpr int LDS_MISC = 131072;

__device__ __forceinline__ unsigned cvtpk(float lo, float hi) { unsigned r; asm volatile("v_cvt_pk_bf16_f32 %0, %1, %2" : "=v"(r) : "v"(lo), "v"(hi)); return r; }
__device__ __forceinline__ float bf2f(unsigned short b) { return __uint_as_float(((unsigned)b) << 16); }
__device__ __forceinline__ float bflo(unsigned w) { return __uint_as_float(w << 16); }
__device__ __forceinline__ float bfhi(unsigned w) { return __uint_as_float(w & 0xffff0000u); }
__device__ __forceinline__ bf16_t f2bf(float f) { return (bf16_t)(cvtpk(f, 0.f) & 0xffffu); }
typedef int i32x8 __attribute__((ext_vector_type(8)));
typedef int i32x4 __attribute__((ext_vector_type(4)));
constexpr float F8_ACT_SCALE = 4.f, F8_W_SCALE = 64.f, F8_INV = 1.f / (F8_ACT_SCALE * F8_W_SCALE);
__device__ __forceinline__ unsigned pk4_fp8(float a, float b, float c, float d) {
    a = __builtin_amdgcn_fmed3f(a, -448.f, 448.f); b = __builtin_amdgcn_fmed3f(b, -448.f, 448.f); c = __builtin_amdgcn_fmed3f(c, -448.f, 448.f); d = __builtin_amdgcn_fmed3f(d, -448.f, 448.f);
    int w = 0; w = __builtin_amdgcn_cvt_pk_fp8_f32(a, b, w, false); w = __builtin_amdgcn_cvt_pk_fp8_f32(c, d, w, true); return (unsigned)w; }
__device__ __forceinline__ float wave_sum(float v) {
#pragma unroll
    for (int o = 1; o < 64; o <<= 1) v += __shfl_xor(v, o);
    return v;
}
__device__ __forceinline__ float fast_exp2(float x) { return __builtin_amdgcn_exp2f(x); }
__device__ __forceinline__ float fast_rcp(float x) { return __builtin_amdgcn_rcpf(x); }
__device__ __forceinline__ float silu_f(float x) { return x * fast_rcp(1.f + fast_exp2(-x * LOG2E)); }
__device__ __forceinline__ float gelu_tanh_f(float x) { const float u = 0.7978845608028654f * (x + 0.044715f * x * x * x); return x * fast_rcp(1.f + fast_exp2(-2.f * LOG2E * u)); }
#define LDS_WAIT() asm volatile("s_waitcnt lgkmcnt(0)" ::: "memory")
#define VM_WAIT() asm volatile("s_waitcnt vmcnt(0)" ::: "memory")
__device__ __forceinline__ int opaque_bid() { int b = blockIdx.x; asm volatile("" : "+s"(b)); return b; }
__device__ __forceinline__ int xcd_unit_base() { const int b = opaque_bid(), G = (int)gridDim.x; return (G % 8 == 0) ? (b & 7) * (G >> 3) + (b >> 3) : b; }
__device__ __forceinline__ int opaque_tid() { int t = threadIdx.x; asm volatile("" : "+v"(t)); return t; }

#define XB_TMO      128
#define XB_XCNT(j)  (256  + 64 * (j))
#define XB_XSUB(j)  (1280 + 64 * (j))
#define XB_XGEN(j)  (2304 + 64 * (j))
#define XB_TOP      3328
#define XB_TOPGEN   3392
#define XCD_BAR_WORDS 3456
#define XB_SPIN_CAP (1u << 22)
__device__ __forceinline__ unsigned xb_ld(unsigned* p)              { return __hip_atomic_load(p, __ATOMIC_RELAXED, __HIP_MEMORY_SCOPE_AGENT); }
__device__ __forceinline__ unsigned xb_add(unsigned* p, unsigned v) { return __hip_atomic_fetch_add(p, v, __ATOMIC_RELAXED, __HIP_MEMORY_SCOPE_AGENT); }
__device__ __forceinline__ unsigned xb_xcc_id() { return (unsigned)__builtin_amdgcn_s_getreg((3 << 11) | 20) & 0xFu; }
#define XB_SPIN(cond, bar) do { unsigned _sp = 0; while (cond) { __builtin_amdgcn_s_sleep(1); \
    if ((++_sp & 255u) == 0u) { if (xb_ld(&(bar)[XB_TMO])) break; if (_sp > XB_SPIN_CAP) { atomicAdd(&(bar)[XB_TMO], 1u); break; } } } } while (0)
struct XcdBarrier { unsigned* bar; unsigned x; volatile LAS unsigned* st; };
__device__ __forceinline__ XcdBarrier xcd_barrier_post(unsigned* bar, volatile LAS unsigned* st) {
    XcdBarrier b; b.bar = bar; b.x = xb_xcc_id(); b.st = st;
    if (threadIdx.x == 0) (void)xb_add(&bar[XB_XCNT(b.x)], 1u);
    return b;
}
__device__ __forceinline__ void xcd_barrier_complete(unsigned* bar, unsigned x, unsigned& nloc, unsigned& nx) {
    const unsigned G = gridDim.x * gridDim.y * gridDim.z;
    unsigned sum, cnt, mine, sp = 0u;
    for (;;) {
        sum = 0u; cnt = 0u; mine = 0u;
#pragma unroll
        for (unsigned j = 0; j < 16; ++j) { const unsigned c = xb_ld(&bar[XB_XCNT(j)]); sum += c; cnt += (c > 0u) ? 1u : 0u; mine = (j == x) ? c : mine; }
        if (sum == G) break;
        __builtin_amdgcn_s_sleep(1);
        if ((++sp & 255u) == 0u) { if (xb_ld(&bar[XB_TMO])) break; if (sp > XB_SPIN_CAP) { atomicAdd(&bar[XB_TMO], 1u); break; } }
    }
    nloc = mine > 0u ? mine : 1u; nx = cnt > 0u ? cnt : 1u;
}
__device__ __forceinline__ void xcd_barrier(const XcdBarrier& b) {
    asm volatile("s_waitcnt vmcnt(0)" ::: "memory");
    __syncthreads();
    if (threadIdx.x == 0) {
        unsigned* bar = b.bar;
        __builtin_amdgcn_s_waitcnt(0);
        unsigned nloc = b.st[0], nx = b.st[1];
        if (nloc == 0u) { xcd_barrier_complete(bar, b.x, nloc, nx); b.st[0] = nloc; b.st[1] = nx; }
        const unsigned old = xb_add(&bar[XB_XSUB(b.x)], 1u);
        const unsigned gen = old / nloc;
        if (old + 1u == (gen + 1u) * nloc) {
            __builtin_amdgcn_fence(__ATOMIC_RELEASE, "agent");
            asm volatile("s_waitcnt vmcnt(0)" ::: "memory");
            const unsigned og = xb_add(&bar[XB_TOP], 1u);
            const unsigned tg = og / nx;
            if (og + 1u == (tg + 1u) * nx) xb_add(&bar[XB_TOPGEN], 1u);
            else XB_SPIN(xb_ld(&bar[XB_TOPGEN]) == tg, bar);
            __builtin_amdgcn_fence(__ATOMIC_ACQUIRE, "agent");
            xb_add(&bar[XB_XGEN(b.x)], 1u);
            asm volatile("s_waitcnt vmcnt(0)" ::: "memory");
        } else {
            XB_SPIN(xb_ld(&bar[XB_XGEN(b.x)]) == gen, bar);
            __builtin_amdgcn_fence(__ATOMIC_ACQUIRE, "agent");
            asm volatile("s_waitcnt vmcnt(0)" ::: "memory");
        }
    }
    __syncthreads();
}

namespace pg8 {
constexpr int BM = 256, BK = 64, HALF = 128, HTB = HALF * BK * 2, STAGE_BYTES = 8 * HTB, NXCD = 8, WGM = 4;
__device__ __forceinline__ int lds_byte(int r, int c) { const int st = (r >> 4) * 2 + (c >> 5), rr = r & 15, cc = c & 31, ob = rr * 64 + cc * 2; return st * 1024 + (ob ^ (((ob >> 9) & 1) << 5)); }
__device__ __forceinline__ void stage_rc(int b, int& R, int& C) { const int st = b / 1024, sb = b % 1024, swz = sb ^ (((sb >> 9) & 1) << 5); R = (st >> 1) * 16 + swz / 64; C = (st & 1) * 32 + (swz % 64) / 2; }
__device__ __forceinline__ int perm32(int rho) { const int n = rho >> 4, i = rho & 15; return 8 * (i >> 2) + 4 * n + (i & 3); }
struct Unit { int pm, pn, e; };
struct Gemm {
    const void* A; int lda;
    const void* Bt; int K;
    int nM, nN;
    int grouped; int toff[9]; size_t estride;
};
struct StaticOrder {
    int nM, nN, nwg, G, c;
    __device__ void init(int nM_, int nN_, int G_, int c_) { nM = nM_; nN = nN_; nwg = nM * nN; G = G_; c = c_; }
    __device__ __forceinline__ bool next(int i, Unit& u) const {
        const long L = (long)i * G + c; if (L >= nwg) return false;
        int wgid = (int)L; { const int q = nwg / NXCD, r = nwg % NXCD, xcd = wgid % NXCD, off = wgid / NXCD; wgid = (xcd < r ? xcd * (q + 1) : r * (q + 1) + (xcd - r) * q) + off; }
        const int nig = WGM * nN, gid = wgid / nig, fm = gid * WGM, gsz = (nM - fm) < WGM ? (nM - fm) : WGM;
        u.pm = fm + ((wgid % nig) % gsz); u.pn = (wgid % nig) / gsz; u.e = 0; return true;
    }
};
struct EpiBf16 {
    bf16_t* O; int ldc; float scale;
    __device__ __forceinline__ void operator()(const f32x4 (&acc)[2][2][4][2], const Unit& u, int wr, int wc, int fr, int fq) const {
        const int row0 = u.pm * BM + wr * 64 + fr, col0 = u.pn * BM + wc * 32 + 8 * fq;
#pragma unroll
        for (int ai = 0; ai < 2; ++ai)
#pragma unroll
            for (int m = 0; m < 4; ++m) { bf16_t* rowp = O + (size_t)(row0 + ai * HALF + m * 16) * ldc + col0;
#pragma unroll
                for (int bj = 0; bj < 2; ++bj) { const f32x4 v0 = acc[ai][bj][m][0] * scale, v1 = acc[ai][bj][m][1] * scale;
                    u32x4 w; w.x = cvtpk(v0[0], v0[1]); w.y = cvtpk(v0[2], v0[3]); w.z = cvtpk(v1[0], v1[1]); w.w = cvtpk(v1[2], v1[3]);
                    *(u32x4*)(rowp + bj * HALF) = w; } }
    }
};
__device__ __forceinline__ f32x4 swiglu4(f32x4 a, f32x4 b, float k1, float k2) {
    const f32x4 t = a * k1; f32x4 d;
#pragma unroll
    for (int j = 0; j < 4; ++j) d[j] = fast_exp2(t[j]);
    d = d + 1.f; f32x4 r;
#pragma unroll
    for (int j = 0; j < 4; ++j) r[j] = fast_rcp(d[j]);
    return (a * b) * (r * k2);
}
struct EpiSwiGLU {
    bf16_t* O; int ldc;
    __device__ __forceinline__ void operator()(const f32x4 (&acc)[2][2][4][2], const Unit& u, int wr, int wc, int fr, int fq) const {
        const int row0 = u.pm * BM + wr * 64 + fr, col0 = u.pn * HALF + wc * 32 + 8 * fq;
#pragma unroll
        for (int ai = 0; ai < 2; ++ai)
#pragma unroll
            for (int m = 0; m < 4; ++m) { bf16_t* rowp = O + (size_t)(row0 + ai * HALF + m * 16) * ldc + col0;
                const f32x4 r0 = swiglu4(acc[ai][0][m][0], acc[ai][1][m][0], -LOG2E, 1.f), r1 = swiglu4(acc[ai][0][m][1], acc[ai][1][m][1], -LOG2E, 1.f);
                u32x4 w; w.x = cvtpk(r0[0], r0[1]); w.y = cvtpk(r0[2], r0[3]); w.z = cvtpk(r1[0], r1[1]); w.w = cvtpk(r1[2], r1[3]);
                *(u32x4*)rowp = w; }
    }
};

struct EpiEvenIn {
    bf16_t* O; int ldc; f32x2* stats; const float* rcos; const float* rsin; float scale;
    __device__ __forceinline__ void operator()(const f32x4 (&acc)[2][2][4][2], const Unit& u, int wr, int wc, int fr, int fq) const {
        int upm = u.pm, upn = u.pn; asm volatile("" : "+s"(upm), "+s"(upn));
        const int row0 = upm * BM + wr * 64 + fr, col0 = upn * BM + wc * 32 + 8 * fq;
        const int kind = upn < 2 ? 0 : (upn < 4 ? 1 : (upn < 8 ? 2 : 3)); const bool lat = upm < NLAT / BM; const int t4 = 4 * (4 * (wc & 1) + fq);
#pragma unroll
        for (int ai = 0; ai < 2; ++ai)
#pragma unroll
            for (int m = 0; m < 4; ++m) { const int row = row0 + ai * HALF + m * 16; bf16_t* rowp = O + (size_t)row * ldc + col0;
                f32x4 cs = {1.f, 1.f, 1.f, 1.f}, sn = {0.f, 0.f, 0.f, 0.f}; float s1 = 0.f, s2 = 0.f;
                if (kind == 2 && lat) { const int sp = row & (SEQ - 1); cs = *(const f32x4*)(rcos + sp * 32 + t4); sn = *(const f32x4*)(rsin + sp * 32 + t4); }
#pragma unroll
                for (int bj = 0; bj < 2; ++bj) { f32x4 v0 = acc[ai][bj][m][0] * scale, v1 = acc[ai][bj][m][1] * scale;
                    if (kind < 2) {
#pragma unroll
                        for (int j = 0; j < 4; ++j) { v0[j] = gelu_tanh_f(v0[j]); v1[j] = gelu_tanh_f(v1[j]); }
                        if (kind == 1) { s1 += (v0[0] + v0[1]) + (v0[2] + v0[3]) + (v1[0] + v1[1]) + (v1[2] + v1[3]);
                            s2 += (v0[0] * v0[0] + v0[1] * v0[1]) + (v0[2] * v0[2] + v0[3] * v0[3]) + (v1[0] * v1[0] + v1[1] * v1[1]) + (v1[2] * v1[2] + v1[3] * v1[3]); } }
                    else if (kind == 2) { const f32x4 o0 = v0 * cs - v1 * sn, o1 = v1 * cs + v0 * sn; v0 = o0; v1 = o1; }
                    u32x4 w; w.x = cvtpk(v0[0], v0[1]); w.y = cvtpk(v0[2], v0[3]); w.z = cvtpk(v1[0], v1[1]); w.w = cvtpk(v1[2], v1[3]);
                    *(u32x4*)(rowp + bj * HALF) = w; }
                if (kind == 1) { s1 += __shfl_xor(s1, 16); s1 += __shfl_xor(s1, 32); s2 += __shfl_xor(s2, 16); s2 += __shfl_xor(s2, 32);
                    if (fq == 0) stats[(size_t)row * 8 + (upn - 2) * 4 + wc] = (f32x2){s1, s2}; } }
    }
};
struct EpiOddIn {
    bf16_t* O; int ldc; float* stats; const float* rcos; const float* rsin; float scale;
    __device__ __forceinline__ void operator()(const f32x4 (&acc)[2][2][4][2], const Unit& u, int wr, int wc, int fr, int fq) const {
        int upm = u.pm, upn = u.pn; asm volatile("" : "+s"(upm), "+s"(upn));
        const int row0 = upm * BM + wr * 64 + fr, col0 = upn * BM + wc * 32 + 8 * fq; const bool lat = upm < NLAT / BM;
#pragma unroll
        for (int ai = 0; ai < 2; ++ai)
#pragma unroll
            for (int m = 0; m < 4; ++m) { const int row = row0 + ai * HALF + m * 16; bf16_t* rowp = O + (size_t)row * ldc + col0; float ss = 0.f;
#pragma unroll
                for (int bj = 0; bj < 2; ++bj) { f32x4 v0 = acc[ai][bj][m][0] * scale, v1 = acc[ai][bj][m][1] * scale;
                    if (upn == 6 || (upn == 7 && bj == 0)) ss += (v0[0] * v0[0] + v0[1] * v0[1]) + (v0[2] * v0[2] + v0[3] * v0[3]) + (v1[0] * v1[0] + v1[1] * v1[1]) + (v1[2] * v1[2] + v1[3] * v1[3]);
                    if (upn == 7 && bj == 1 && wc == 0 && lat) { const int sp = row & (SEQ - 1); const f32x4 cs = *(const f32x4*)(rcos + sp * 16 + 4 * fq), sn = *(const f32x4*)(rsin + sp * 16 + 4 * fq);
                        const f32x4 o0 = v0 * cs - v1 * sn, o1 = v1 * cs + v0 * sn; v0 = o0; v1 = o1; }
                    u32x4 w; w.x = cvtpk(v0[0], v0[1]); w.y = cvtpk(v0[2], v0[3]); w.z = cvtpk(v1[0], v1[1]); w.w = cvtpk(v1[2], v1[3]);
                    *(u32x4*)(rowp + bj * HALF) = w; }
                if (upn >= 6) { ss += __shfl_xor(ss, 16); ss += __shfl_xor(ss, 32); if (fq == 0) stats[(size_t)row * 8 + (upn - 6) * 4 + wc] = ss; } }
    }
};
struct EpiMlaUp {
    bf16_t* O; int ldc; const float* stats;
    __device__ __forceinline__ void operator()(const f32x4 (&acc)[2][2][4][2], const Unit& u, int wr, int wc, int fr, int fq) const {
        const int row0 = u.pm * BM + wr * 64 + fr, col0 = u.pn * BM + wc * 32 + 8 * fq;
#pragma unroll
        for (int ai = 0; ai < 2; ++ai)
#pragma unroll
            for (int m = 0; m < 4; ++m) { const int row = row0 + ai * HALF + m * 16; bf16_t* rowp = O + (size_t)row * ldc + col0;
                const f32x4 pq = *(const f32x4*)(stats + (size_t)row * 8), pk = *(const f32x4*)(stats + (size_t)row * 8 + 4);
                const float rq = rsqrtf(((pq[0] + pq[1]) + (pq[2] + pq[3])) * (1.f / 256.f) + EPS), rk = rsqrtf(((pk[0] + pk[1]) + (pk[2] + pk[3])) * (1.f / 128.f) + EPS);
#pragma unroll
                for (int bj = 0; bj < 2; ++bj) { const int c0 = col0 + bj * HALF; const float sc = c0 < 384 ? rq : (c0 < 768 ? (((c0 - 384) % 96) < 64 ? rk : 1.f) : rk);
                    const f32x4 v0 = acc[ai][bj][m][0] * sc, v1 = acc[ai][bj][m][1] * sc;
                    u32x4 w; w.x = cvtpk(v0[0], v0[1]); w.y = cvtpk(v0[2], v0[3]); w.z = cvtpk(v1[0], v1[1]); w.w = cvtpk(v1[2], v1[3]);
                    *(u32x4*)(rowp + bj * HALF) = w; } }
    }
};
struct EpiSwiGLU8 {
    unsigned char* O; int ldc; float scale;
    __device__ __forceinline__ void operator()(const f32x4 (&acc)[2][2][4][2], const Unit& u, int wr, int wc, int fr, int fq) const {
        const int row0 = u.pm * BM + wr * 64 + fr, col0 = u.pn * HALF + wc * 32 + 8 * fq;
#pragma unroll
        for (int ai = 0; ai < 2; ++ai)
#pragma unroll
            for (int m = 0; m < 4; ++m) { unsigned char* rowp = O + (size_t)(row0 + ai * HALF + m * 16) * ldc + col0;
                const float k1 = -LOG2E * scale, k2 = F8_ACT_SCALE * scale * scale;
                const f32x4 r0 = swiglu4(acc[ai][0][m][0], acc[ai][1][m][0], k1, k2), r1 = swiglu4(acc[ai][0][m][1], acc[ai][1][m][1], k1, k2);
                u32x2 w; w.x = pk4_fp8(r0[0], r0[1], r0[2], r0[3]); w.y = pk4_fp8(r1[0], r1[1], r1[2], r1[3]);
                *(u32x2*)rowp = w; }
    }
};

template <class Epi, bool F8 = false>
__device__ __forceinline__ void gemm_phase(LAS unsigned char* lds, const Gemm& g, const Epi& E) {
    const int tid = opaque_tid(), wid = __builtin_amdgcn_readfirstlane(tid >> 6), lane = tid & 63, wr = wid >> 2, wc = wid & 3, fr = lane & 15, fq = lane >> 4;
    constexpr int ES = F8 ? 1 : 2;
    const int K = g.K, nt = K * ES / (BK * 2), lda = g.lda;
    StaticOrder S; S.init(g.nM, g.nN, (int)gridDim.x, opaque_bid());
    unsigned voffA[2], voffB[2];
#pragma unroll
    for (int i = 0; i < 2; ++i) { int R, C; stage_rc(tid * 16 + i * 8192, R, C); const int Rb = (R & ~31) + perm32(R & 31);
        voffA[i] = (unsigned)(R * lda * ES + C * 2); voffB[i] = (unsigned)(Rb * K * ES + C * 2); }
    const size_t kstep = (size_t)(BK * 2);
    const size_t hA = (size_t)HALF * lda * ES, tA = 2 * hA, hB = (size_t)HALF * K * ES, tB = 2 * hB;
    const unsigned ldsw = (unsigned)wid * 1024u;
    const int aoff = lds_byte(wr * 64 + fr, fq * 8), boff = lds_byte(wc * 32 + fr, fq * 8);
#define PG8_SA(b, h) (((b) * 2 + (h)) * HTB)
#define PG8_SB(b, h) ((4 + (b) * 2 + (h)) * HTB)
#define PG8_STAGE(bufoff, gbase, voff) do { _Pragma("unroll") for (int _i = 0; _i < 2; ++_i) \
        __builtin_amdgcn_global_load_lds((const unsigned*)((const char*)(gbase) + (voff)[_i]), (LAS unsigned*)(lds + (bufoff) + ldsw + _i * 8192), 16, 0, 0); } while (0)
#define PG8_LD8(base) __builtin_shufflevector(*(const LAS i32x4*)(base), *(const LAS i32x4*)((base) + 1024), 0, 1, 2, 3, 4, 5, 6, 7)
#define PG8_LDA(dst, b, h) do { _Pragma("unroll") for (int m = 0; m < 4; ++m) dst[m] = PG8_LD8(lds + PG8_SA(b, h) + aoff + m * 2048); } while (0)
#define PG8_LDB(dst, b, h) do { _Pragma("unroll") for (int n = 0; n < 2; ++n) dst[n] = PG8_LD8(lds + PG8_SB(b, h) + boff + n * 2048); } while (0)
#define PG8_H0(x) __builtin_bit_cast(bf16x8, __builtin_shufflevector(x, x, 0, 1, 2, 3))
#define PG8_H1(x) __builtin_bit_cast(bf16x8, __builtin_shufflevector(x, x, 4, 5, 6, 7))
#define PG8_MMA(ai, bj, At, Bt) do { __builtin_amdgcn_s_setprio(1); _Pragma("unroll") for (int m = 0; m < 4; ++m) _Pragma("unroll") for (int n = 0; n < 2; ++n) { \
        if constexpr (F8) asm volatile("v_mfma_f32_16x16x128_f8f6f4 %0, %1, %2, %0" : "+v"(acc[ai][bj][m][n]) : "v"(Bt[n]), "v"(At[m])); \
        else { acc[ai][bj][m][n] = __builtin_amdgcn_mfma_f32_16x16x32_bf16(PG8_H0(Bt[n]), PG8_H0(At[m]), acc[ai][bj][m][n], 0, 0, 0); \
               acc[ai][bj][m][n] = __builtin_amdgcn_mfma_f32_16x16x32_bf16(PG8_H1(Bt[n]), PG8_H1(At[m]), acc[ai][bj][m][n], 0, 0, 0); } } \
        __builtin_amdgcn_s_setprio(0); } while (0)
#define PG8_WAIT_V(n) asm volatile("s_waitcnt vmcnt(" #n ")" ::: "memory")
#define PG8_WAIT_L(n) asm volatile("s_waitcnt lgkmcnt(" #n ")" ::: "memory")
#define PG8_BAR __builtin_amdgcn_s_barrier()
#define PG8_SCHED __builtin_amdgcn_sched_barrier(0)
#define PG8_EXPERT(u) do { if (g.grouped) { int _e = 0; _Pragma("unroll") for (int _k = 1; _k < 8; ++_k) _e += ((u).pm >= g.toff[_k]) ? 1 : 0; (u).e = _e; } } while (0)
    Unit cur, nxt; int ui = 0;
    if (!S.next(0, cur)) return;
    PG8_EXPERT(cur);
    f32x4 acc[2][2][4][2];
#pragma unroll
    for (int a = 0; a < 2; ++a)
#pragma unroll
        for (int b = 0; b < 2; ++b)
#pragma unroll
            for (int m = 0; m < 4; ++m)
#pragma unroll
                for (int n = 0; n < 2; ++n) acc[a][b][m][n] = (f32x4){0.f, 0.f, 0.f, 0.f};
    i32x8 At[4], B0[2], B1[2];
    const char* cA = (const char*)g.A + (size_t)cur.pm * tA; const char* cB = ((const char*)g.Bt + (size_t)cur.e * g.estride * ES) + (size_t)cur.pn * tB;
    PG8_STAGE(PG8_SB(0, 0), cB, voffB); PG8_STAGE(PG8_SA(0, 0), cA, voffA); PG8_STAGE(PG8_SB(0, 1), cB + hB, voffB); PG8_STAGE(PG8_SA(0, 1), cA + hA, voffA);
    if (wr == 1) PG8_BAR;
    PG8_WAIT_V(4); PG8_BAR;
    PG8_STAGE(PG8_SB(1, 0), cB + kstep, voffB); PG8_STAGE(PG8_SA(1, 0), cA + kstep, voffA); PG8_STAGE(PG8_SB(1, 1), cB + hB + kstep, voffB);
    PG8_WAIT_V(6); PG8_BAR;
    for (;;) {
        const bool has_next = S.next(ui + 1, nxt);
        if (has_next) PG8_EXPERT(nxt);
        const char* nA = has_next ? (const char*)g.A + (size_t)nxt.pm * tA : cA; const char* nB = has_next ? ((const char*)g.Bt + (size_t)nxt.e * g.estride * ES) + (size_t)nxt.pn * tB : cB;
        for (int t = 0; t < nt; t += 2) {
            const bool last = (t == nt - 2);
            const char* a1 = cA + (size_t)(t + 1) * kstep;
            const char* a2 = last ? nA : cA + (size_t)(t + 2) * kstep; const char* b2 = last ? nB : cB + (size_t)(t + 2) * kstep;
            const char* a3 = a2 + kstep; const char* b3 = b2 + kstep;
            PG8_LDB(B0, 0, 0); PG8_SCHED; PG8_LDA(At, 0, 0); PG8_STAGE(PG8_SA(1, 1), a1 + hA, voffA);
            PG8_WAIT_L(8); PG8_BAR; PG8_WAIT_L(0); PG8_MMA(0, 0, At, B0); PG8_BAR; PG8_SCHED;
            PG8_LDB(B1, 0, 1); PG8_STAGE(PG8_SB(0, 0), b2, voffB);
            PG8_BAR; PG8_WAIT_L(0); PG8_MMA(0, 1, At, B1); PG8_BAR;
            PG8_LDA(At, 0, 1); PG8_STAGE(PG8_SA(0, 0), a2, voffA);
            PG8_BAR; PG8_WAIT_L(0); PG8_MMA(1, 0, At, B0); PG8_BAR; PG8_SCHED;
            PG8_STAGE(PG8_SB(0, 1), b2 + hB, voffB);
            PG8_WAIT_V(6); PG8_BAR; PG8_MMA(1, 1, At, B1); PG8_BAR;
            PG8_LDB(B0, 1, 0); PG8_SCHED; PG8_LDA(At, 1, 0); PG8_STAGE(PG8_SA(0, 1), a2 + hA, voffA);
            PG8_WAIT_L(8); PG8_BAR; PG8_WAIT_L(0); PG8_MMA(0, 0, At, B0); PG8_BAR; PG8_SCHED;
            PG8_LDB(B1, 1, 1); PG8_STAGE(PG8_SB(1, 0), b3, voffB);
            PG8_BAR; PG8_WAIT_L(0); PG8_MMA(0, 1, At, B1); PG8_BAR;
            PG8_LDA(At, 1, 1); PG8_STAGE(PG8_SA(1, 0), a3, voffA);
            PG8_BAR; PG8_WAIT_L(0); PG8_MMA(1, 0, At, B0); PG8_BAR; PG8_SCHED;
            PG8_STAGE(PG8_SB(1, 1), b3 + hB, voffB);
            PG8_WAIT_V(6); PG8_BAR; PG8_MMA(1, 1, At, B1); PG8_BAR;
        }
        if constexpr (F8) asm volatile("s_nop 15\n\ts_nop 15" ::: "memory");
        E(acc, cur, wr, wc, fr, fq);
        if (!has_next) break;
#pragma unroll
        for (int a = 0; a < 2; ++a)
#pragma unroll
            for (int b = 0; b < 2; ++b)
#pragma unroll
                for (int m = 0; m < 4; ++m)
#pragma unroll
                    for (int n = 0; n < 2; ++n) acc[a][b][m][n] = (f32x4){0.f, 0.f, 0.f, 0.f};
        cur = nxt; cA = nA; cB = nB; ++ui;
    }
    PG8_WAIT_V(0);
    if (wr == 0) PG8_BAR;
    PG8_BAR;
#undef PG8_SA
#undef PG8_SB
#undef PG8_STAGE
#undef PG8_LDA
#undef PG8_LDB
#undef PG8_MMA
#undef PG8_H0
#undef PG8_H1
#undef PG8_LD8
#undef PG8_WAIT_V
#undef PG8_WAIT_L
#undef PG8_BAR
#undef PG8_SCHED
#undef PG8_EXPERT
}
}

__device__ __forceinline__ void gemm_bf16(LAS unsigned char* lds, const pg8::Gemm& g, bf16_t* O, int ldc) { pg8::EpiBf16 E{O, ldc, 1.f}; pg8::gemm_phase(lds, g, E); }
__device__ __forceinline__ void gemm_even_in(LAS unsigned char* lds, const pg8::Gemm& g, const pg8::EpiEvenIn& E) { pg8::gemm_phase(lds, g, E); }
__device__ __forceinline__ void gemm8_even_in(LAS unsigned char* lds, const pg8::Gemm& g, const pg8::EpiEvenIn& E) { pg8::gemm_phase<pg8::EpiEvenIn, true>(lds, g, E); }
__device__ __forceinline__ void gemm8_odd_in(LAS unsigned char* lds, const pg8::Gemm& g, const pg8::EpiOddIn& E) { pg8::gemm_phase<pg8::EpiOddIn, true>(lds, g, E); }
__device__ __forceinline__ void gemm_odd_in(LAS unsigned char* lds, const pg8::Gemm& g, const pg8::EpiOddIn& E) { pg8::gemm_phase(lds, g, E); }
__device__ __forceinline__ void gemm_mla_up(LAS unsigned char* lds, const pg8::Gemm& g, const pg8::EpiMlaUp& E) { pg8::gemm_phase(lds, g, E); }
__device__ __forceinline__ void gemm8_bf16(LAS unsigned char* lds, const pg8::Gemm& g, bf16_t* O, int ldc) { pg8::EpiBf16 E{O, ldc, F8_INV}; pg8::gemm_phase<pg8::EpiBf16, true>(lds, g, E); }
__device__ __forceinline__ void gemm8_swiglu8(LAS unsigned char* lds, const pg8::Gemm& g, unsigned char* O, int ldc) { pg8::EpiSwiGLU8 E{O, ldc, F8_INV}; pg8::gemm_phase<pg8::EpiSwiGLU8, true>(lds, g, E); }
__device__ __forceinline__ void gemm_swiglu(LAS unsigned char* lds, const pg8::Gemm& g, bf16_t* O, int ldc) { pg8::EpiSwiGLU E{O, ldc}; pg8::gemm_phase(lds, g, E); }

namespace att {
#define SBAR() __builtin_amdgcn_sched_barrier(0)
__device__ __forceinline__ int crow(int r, int hi) { return (r & 3) + 8 * (r >> 2) + 4 * hi; }
__device__ __forceinline__ int v_st(int k, int c) { const int kk = (k & ~0xC) | ((k & 4) << 1) | ((k & 8) >> 1); return ((kk >> 3) * 4 + (c >> 5)) * 512 + ((kk & 7) * 32 + (c & 31)) * 2; }
__device__ __forceinline__ int v_st_plain(int k, int c) { return ((k >> 3) * 4 + (c >> 5)) * 512 + ((k & 7) * 32 + (c & 31)) * 2; }
__device__ __forceinline__ int v_rd_base(int lane) { return ((lane & 3) << 3) | (((lane >> 2) & 3) << 6) | (((lane >> 4) & 1) << 5) | (((lane >> 5) & 1) << 8); }
constexpr int v_rd_off(int d0, int ks, int half) { return d0 * 512 + ks * 4096 + half * 2048; }
template <int OFF> __device__ __forceinline__ s16x4 tr_read(unsigned vb) {
    s16x4 r; asm volatile("ds_read_b64_tr_b16 %0, %1 offset:%2" : "=&v"(r) : "v"(vb), "i"(OFF) : "memory"); return r;
}
template <int D0> __device__ __forceinline__ void pv_one(f32x16& od, unsigned vb, bf16x8 pa0, bf16x8 pa1, bf16x8 pa2, bf16x8 pa3) {
    const s16x4 l0 = tr_read<v_rd_off(D0, 0, 0)>(vb), h0 = tr_read<v_rd_off(D0, 0, 1)>(vb), l1 = tr_read<v_rd_off(D0, 1, 0)>(vb), h1 = tr_read<v_rd_off(D0, 1, 1)>(vb);
    const s16x4 l2 = tr_read<v_rd_off(D0, 2, 0)>(vb), h2 = tr_read<v_rd_off(D0, 2, 1)>(vb), l3 = tr_read<v_rd_off(D0, 3, 0)>(vb), h3 = tr_read<v_rd_off(D0, 3, 1)>(vb);
    asm volatile("s_waitcnt lgkmcnt(0)" ::: "memory"); SBAR();
#define PK(L, H) (bf16x8){L[0], L[1], L[2], L[3], H[0], H[1], H[2], H[3]}
    od = __builtin_amdgcn_mfma_f32_32x32x16_bf16(pa0, PK(l0, h0), od, 0, 0, 0);
    od = __builtin_amdgcn_mfma_f32_32x32x16_bf16(pa1, PK(l1, h1), od, 0, 0, 0);
    od = __builtin_amdgcn_mfma_f32_32x32x16_bf16(pa2, PK(l2, h2), od, 0, 0, 0);
    od = __builtin_amdgcn_mfma_f32_32x32x16_bf16(pa3, PK(l3, h3), od, 0, 0, 0);
#undef PK
}
template <int KS, int NO> __device__ __forceinline__ void pv_step(f32x16 (&o)[NO], unsigned vb, bf16x8 pa) {
    s16x4 l[NO], h[NO];
    l[0] = tr_read<v_rd_off(0, KS, 0)>(vb); h[0] = tr_read<v_rd_off(0, KS, 1)>(vb); l[1] = tr_read<v_rd_off(1, KS, 0)>(vb); h[1] = tr_read<v_rd_off(1, KS, 1)>(vb);
    if constexpr (NO == 4) { l[2] = tr_read<v_rd_off(2, KS, 0)>(vb); h[2] = tr_read<v_rd_off(2, KS, 1)>(vb); l[3] = tr_read<v_rd_off(3, KS, 0)>(vb); h[3] = tr_read<v_rd_off(3, KS, 1)>(vb); }
    asm volatile("s_waitcnt lgkmcnt(0)" ::: "memory"); SBAR();
#pragma unroll
    for (int d = 0; d < NO; ++d) o[d] = __builtin_amdgcn_mfma_f32_32x32x16_bf16(pa, (bf16x8){l[d][0], l[d][1], l[d][2], l[d][3], h[d][0], h[d][1], h[d][2], h[d][3]}, o[d], 0, 0, 0);
}
__device__ __forceinline__ void rot4(bf16x8& a, const float* cs, const float* sn) {
    const f32x4 c = *(const f32x4*)cs, s = *(const f32x4*)sn; float o[8];
#pragma unroll
    for (int e = 0; e < 4; ++e) { const float x1 = bf2f((unsigned short)a[e]), x2 = bf2f((unsigned short)a[4 + e]); o[e] = x1 * c[e] - x2 * s[e]; o[4 + e] = x2 * c[e] + x1 * s[e]; }
    u32x4 w = {cvtpk(o[0], o[1]), cvtpk(o[2], o[3]), cvtpk(o[4], o[5]), cvtpk(o[6], o[7])};
    a = *reinterpret_cast<bf16x8*>(&w);
}
struct Args {
    const bf16_t* Q; int ldq, qcol;
    const bf16_t* K; int ldk, kcol;
    const bf16_t* V; int ldv, vcol;
    int q_row0;
    int kctx_row0, klat_row0, nt_ctx, nt_lat;
    float C;
    int rope;
    const float* rcos; const float* rsin;
    bf16_t* O; int ldo, ocol;
    int g, u0; const float* rpb;
    float lam, oscale; const float* subg;
};

__device__ __forceinline__ unsigned off_a(unsigned row, unsigned ch) { return 2048u * (row >> 3) + 512u * (ch >> 2) + 64u * (row & 7) + 16u * ((ch & 3) ^ ((row >> 2) & 3)); }
template <int OFF> __device__ __forceinline__ s16x4 tr_read_u(unsigned addr) {
    s16x4 r; asm volatile("ds_read_b64_tr_b16 %0, %1 offset:%2" : "=&v"(r) : "v"(addr), "i"(OFF) : "memory"); return r;
}
template <int KS2, int DB0>
__device__ __forceinline__ void pv16_load(s16x4 (&L)[4], s16x4 (&H)[4], const unsigned (&vb)[2][2]) {
    L[0] = tr_read_u<8192 * KS2 + 512 * ((DB0 + 0) >> 1)>(vb[(DB0 + 0) & 1][0]); H[0] = tr_read_u<8192 * KS2 + 512 * ((DB0 + 0) >> 1)>(vb[(DB0 + 0) & 1][1]);
    L[1] = tr_read_u<8192 * KS2 + 512 * ((DB0 + 1) >> 1)>(vb[(DB0 + 1) & 1][0]); H[1] = tr_read_u<8192 * KS2 + 512 * ((DB0 + 1) >> 1)>(vb[(DB0 + 1) & 1][1]);
    L[2] = tr_read_u<8192 * KS2 + 512 * ((DB0 + 2) >> 1)>(vb[(DB0 + 2) & 1][0]); H[2] = tr_read_u<8192 * KS2 + 512 * ((DB0 + 2) >> 1)>(vb[(DB0 + 2) & 1][1]);
    L[3] = tr_read_u<8192 * KS2 + 512 * ((DB0 + 3) >> 1)>(vb[(DB0 + 3) & 1][0]); H[3] = tr_read_u<8192 * KS2 + 512 * ((DB0 + 3) >> 1)>(vb[(DB0 + 3) & 1][1]);
}
template <int DB0, int NDB>
__device__ __forceinline__ void pv16_mma(f32x4 (&o)[2][NDB], const s16x4 (&L)[4], const s16x4 (&H)[4], bf16x8 p0, bf16x8 p1) {
#pragma unroll
    for (int i = 0; i < 4; ++i) { const bf16x8 vf = {L[i][0], L[i][1], L[i][2], L[i][3], H[i][0], H[i][1], H[i][2], H[i][3]};
        o[0][DB0 + i] = __builtin_amdgcn_mfma_f32_16x16x32_bf16(p0, vf, o[0][DB0 + i], 0, 0, 0);
        o[1][DB0 + i] = __builtin_amdgcn_mfma_f32_16x16x32_bf16(p1, vf, o[1][DB0 + i], 0, 0, 0); }
}
#define PV16_WAIT(n) do { asm volatile("s_waitcnt lgkmcnt(" #n ")" ::: "memory"); SBAR(); } while (0)
template <int DQK, int KW, int DV, int MODE>
__device__ __forceinline__ void attn_unit(LAS unsigned char* lds, const Args& a) {
    constexpr int NKS = DQK / 32, NDB = DV / 16;
    constexpr int KSTR = KW * 2 + 16, KBUF = 64 * KSTR;
    constexpr int OFF_V = 3 * KBUF, OFF_WS = OFF_V + 3 * 16384, OFF_RPB = OFF_WS + 2048;
    const int tid = opaque_tid(), wid = __builtin_amdgcn_readfirstlane(tid >> 6), lane = tid & 63, n = lane & 15, g = lane >> 4;
    LAS unsigned char* Kl = lds; LAS unsigned char* Vl = lds + OFF_V;
    LAS float* wsf = (LAS float*)(lds + OFF_WS) + wid * 64; LAS float* li_l = wsf;
    LAS float* rpbl = (LAS float*)(lds + OFF_RPB);
    const int wq = (MODE == 1) ? (wid & 3) : wid, wmap = (MODE == 1) ? (wid >> 2) : 0;
    bf16x8 qf[2][NKS];
#pragma unroll
    for (int qb = 0; qb < 2; ++qb) {
        const int qrow = a.q_row0 + wq * 32 + qb * 16 + n;
        const bf16_t* Qw = a.Q + (size_t)qrow * a.ldq + a.qcol + wmap * 64 + g * 8;
#pragma unroll
        for (int ks = 0; ks < NKS; ++ks) qf[qb][ks] = *(const bf16x8*)(Qw + ks * 32);
        if (a.rope == 2) { if constexpr (NKS >= 3) { const int s = qrow & (SEQ - 1); rot4(qf[qb][2], a.rcos + s * 16 + 4 * g, a.rsin + s * 16 + 4 * g); } }
#pragma unroll
        for (int ks = 0; ks < NKS; ++ks) { float f[8];
#pragma unroll
            for (int e = 0; e < 8; ++e) f[e] = bf2f((unsigned short)qf[qb][ks][e]) * a.C;
            u32x4 w = {cvtpk(f[0], f[1]), cvtpk(f[2], f[3]), cvtpk(f[4], f[5]), cvtpk(f[6], f[7])}; qf[qb][ks] = *reinterpret_cast<bf16x8*>(&w); }
    }
    if (MODE == 2) { if (tid < 465) rpbl[tid] = a.rpb[tid] * LOG2E; }
    const int cq0 = (wid & 1) * 32 + n, cq1 = cq0 + 16, rq = 4 * a.g + (wid >> 1);
    const int rs = min(max(rq - 4, 0), 120), cs0 = min(max(cq0 - 8, 0), 48), cs1 = min(max(cq1 - 8, 0), 48);
    constexpr int NKB = KBUF / 1024, NBT = NKB + 16, NB = (NBT + 7) / 8;
    static_assert(KBUF % 1024 == 0, "K image is a whole number of 1 KB blocks");
    unsigned soff[NB];
#pragma unroll
    for (int i = 0; i < NB; ++i) { const int bb = wid + 8 * i; unsigned so = 0u;
        if (bb < NKB) { const int A = bb * 1024 + lane * 16, row = A / KSTR; int off = A % KSTR; if (off >= KW * 2) off = 0; so = (unsigned)(row * a.ldk * 2 + off); }
        else if (bb < NBT) { const int A = (bb - NKB) * 1024 + lane * 16, rho = ((A >> 11) << 3) | ((A >> 6) & 7); int ch = (((A >> 9) & 3) << 2) | (((A >> 4) & 3) ^ ((rho >> 2) & 3));
            if (DV == 64) ch &= 7;
            const int key = ((rho >> 5) * 2 + ((rho >> 2) & 1)) * 16 + 4 * ((rho >> 3) & 3) + (rho & 3);
            so = (unsigned)((key * a.ldv + ch * 8) * 2); }
        soff[i] = so; }
    const int NT = a.nt_ctx + a.nt_lat;
#define TILE_ROW(j) ((j) < a.nt_ctx ? a.kctx_row0 + 64 * (j) : a.klat_row0 + 64 * ((j) - a.nt_ctx))
#define DMA(t) do { const int _r0 = TILE_ROW(t), _sl = (t) % 3; const char* _kp = (const char*)(a.K + (size_t)_r0 * a.ldk + a.kcol); const char* _vp = (const char*)(a.V + (size_t)_r0 * a.ldv + a.vcol); \
    _Pragma("unroll") for (int _i = 0; _i < NB; ++_i) { const int _bb = wid + 8 * _i; \
        if (_bb < NKB) __builtin_amdgcn_global_load_lds((const unsigned*)(_kp + soff[_i]), (LAS unsigned*)(Kl + _sl * KBUF + _bb * 1024), 16, 0, 0); \
        else if (_bb < NBT) __builtin_amdgcn_global_load_lds((const unsigned*)(_vp + soff[_i]), (LAS unsigned*)(Vl + _sl * 16384 + (_bb - NKB) * 1024), 16, 0, 0); } } while (0)
#define DMA_SYNC() do { asm volatile("s_waitcnt vmcnt(0)" ::: "memory"); __syncthreads(); } while (0)
    float lsum0 = 0.f, lsum1 = 0.f;
    f32x4 o[2][NDB];
#pragma unroll
    for (int qb = 0; qb < 2; ++qb)
#pragma unroll
        for (int d = 0; d < NDB; ++d) o[qb][d] = (f32x4){0.f, 0.f, 0.f, 0.f};
    const unsigned kbase = (unsigned)(size_t)Kl + (unsigned)(n * KSTR + 16 * g + wmap * 128);
    unsigned vb0[2][2];
    { const unsigned q4 = (unsigned)n >> 2, p = (unsigned)n & 3;
#pragma unroll
      for (int cb = 0; cb < 2; ++cb)
#pragma unroll
          for (int t = 0; t < 2; ++t) vb0[cb][t] = (unsigned)(size_t)Vl + off_a(8u * g + 4u * t + q4, 2u * cb + (p >> 1)) + 8u * (p & 1); }
#define QKT(S, b) do { const unsigned _kb = kbase + (unsigned)((b) * KBUF); bf16x8 _kf[4][NKS]; \
    _Pragma("unroll") for (int kb = 0; kb < 4; ++kb) _Pragma("unroll") for (int ks = 0; ks < NKS; ++ks) _kf[kb][ks] = *(const LAS bf16x8*)(size_t)(_kb + kb * 16 * KSTR + ks * 64); \
    _Pragma("unroll") for (int kb = 0; kb < 4; ++kb) _Pragma("unroll") for (int qb = 0; qb < 2; ++qb) { f32x4 _acc = {0.f, 0.f, 0.f, 0.f}; \
        _Pragma("unroll") for (int ks = 0; ks < NKS; ++ks) _acc = __builtin_amdgcn_mfma_f32_16x16x32_bf16(_kf[kb][ks], qf[qb][ks], _acc, 0, 0, 0); \
        S[kb][qb] = _acc; } } while (0)
#define PARTIAL(S, j) do { \
    if (MODE == 2) { if ((j) >= a.nt_ctx) { const int kr = a.u0 + ((j) - a.nt_ctx); const bool rowok = (kr >= rs) && (kr < rs + 8); const int ro = min(max(kr - rq + 7, 0), 14); const LAS float* brow = rpbl + ro * 31; \
        _Pragma("unroll") for (int kb = 0; kb < 4; ++kb) _Pragma("unroll") for (int r = 0; r < 4; ++r) { const int ck = kb * 16 + 4 * g + r; \
            { const int dd = min(max(ck - cq0 + 15, 0), 30); const bool inw = rowok && ((unsigned)(ck - cs0) < 16u); const float bv = brow[dd]; S[kb][0][r] = inw ? S[kb][0][r] + bv : -1e30f; } \
            { const int dd = min(max(ck - cq1 + 15, 0), 30); const bool inw = rowok && ((unsigned)(ck - cs1) < 16u); const float bv = brow[dd]; S[kb][1][r] = inw ? S[kb][1][r] + bv : -1e30f; } } } } \
    _Pragma("unroll") for (int kb = 0; kb < 2; ++kb) _Pragma("unroll") for (int qb = 0; qb < 2; ++qb) _Pragma("unroll") for (int r = 0; r < 4; ++r) S[kb][qb][r] = fast_exp2(S[kb][qb][r]); } while (0)
#define FINISH(S) do { \
    _Pragma("unroll") for (int kb = 2; kb < 4; ++kb) _Pragma("unroll") for (int qb = 0; qb < 2; ++qb) _Pragma("unroll") for (int r = 0; r < 4; ++r) S[kb][qb][r] = fast_exp2(S[kb][qb][r]); \
    float _p0 = 0.f, _p1 = 0.f; \
    _Pragma("unroll") for (int kb = 0; kb < 4; ++kb) { _p0 += (S[kb][0][0] + S[kb][0][1]) + (S[kb][0][2] + S[kb][0][3]); _p1 += (S[kb][1][0] + S[kb][1][1]) + (S[kb][1][2] + S[kb][1][3]); } \
    lsum0 += _p0; lsum1 += _p1; \
    _Pragma("unroll") for (int qb = 0; qb < 2; ++qb) _Pragma("unroll") for (int k2 = 0; k2 < 2; ++k2) { \
        u32x4 _w = {cvtpk(S[2 * k2][qb][0], S[2 * k2][qb][1]), cvtpk(S[2 * k2][qb][2], S[2 * k2][qb][3]), cvtpk(S[2 * k2 + 1][qb][0], S[2 * k2 + 1][qb][1]), cvtpk(S[2 * k2 + 1][qb][2], S[2 * k2 + 1][qb][3])}; \
        pf[qb][k2] = *reinterpret_cast<bf16x8*>(&_w); } } while (0)
#define PV(b) do { unsigned _vb[2][2]; _Pragma("unroll") for (int cb = 0; cb < 2; ++cb) _Pragma("unroll") for (int t = 0; t < 2; ++t) _vb[cb][t] = vb0[cb][t] + (unsigned)(b) * 16384u; \
    s16x4 _La[4], _Ha[4], _Lb[4], _Hb[4]; \
    if constexpr (NDB == 8) { \
        pv16_load<0, 0>(_La, _Ha, _vb); pv16_load<0, 4>(_Lb, _Hb, _vb); \
        PV16_WAIT(8); pv16_mma<0, NDB>(o, _La, _Ha, pf[0][0], pf[1][0]); pv16_load<1, 0>(_La, _Ha, _vb); \
        PV16_WAIT(8); pv16_mma<4, NDB>(o, _Lb, _Hb, pf[0][0], pf[1][0]); pv16_load<1, 4>(_Lb, _Hb, _vb); \
        PV16_WAIT(8); pv16_mma<0, NDB>(o, _La, _Ha, pf[0][1], pf[1][1]); \
        PV16_WAIT(0); pv16_mma<4, NDB>(o, _Lb, _Hb, pf[0][1], pf[1][1]); \
    } else {   \
        pv16_load<0, 0>(_La, _Ha, _vb); PV16_WAIT(0); pv16_mma<0, NDB>(o, _La, _Ha, pf[0][0], pf[1][0]); \
        pv16_load<1, 0>(_La, _Ha, _vb); PV16_WAIT(0); pv16_mma<0, NDB>(o, _La, _Ha, pf[0][1], pf[1][1]); \
    } } while (0)
    f32x4 sA[4][2], sB[4][2]; bf16x8 pf[2][2];
    DMA(0); DMA_SYNC();
    DMA(1);
    QKT(sA, 0); PARTIAL(sA, 0);
    DMA_SYNC();
    int bm1 = 0, bj = 1, bn = 2;
    for (int j = 1; j + 1 < NT; j += 2) {
        DMA(j + 1);
        SBAR(); QKT(sB, bj);
        FINISH(sA); SBAR();
        PV(bm1); PARTIAL(sB, j);
        DMA_SYNC();
        if (j + 2 < NT) DMA(j + 2);
        SBAR(); QKT(sA, bn);
        FINISH(sB); SBAR();
        PV(bj); PARTIAL(sA, j + 1);
        DMA_SYNC();
        { const int t0 = bm1; bm1 = bn; bn = bj; bj = t0; }
    }
    SBAR(); QKT(sB, bj);
    FINISH(sA); SBAR();
    PV(bm1); PARTIAL(sB, NT - 1);
    FINISH(sB); SBAR();
    PV(bj);
    __syncthreads();
#undef TILE_ROW
#undef DMA
#undef DMA_SYNC
#undef QKT
#undef PARTIAL
#undef FINISH
#undef PV
#undef PV16_WAIT
    const int tid_e = opaque_tid(), lane_e = tid_e & 63, ne = lane_e & 15, ge = lane_e >> 4;
    lsum0 += __shfl_xor(lsum0, 16); lsum0 += __shfl_xor(lsum0, 32); lsum1 += __shfl_xor(lsum1, 16); lsum1 += __shfl_xor(lsum1, 32);
    if (ge == 0) { li_l[ne] = fmaxf(lsum0, 1e-37f); li_l[16 + ne] = fmaxf(lsum1, 1e-37f); } LDS_WAIT();
    float rl[2][4];
#pragma unroll
    for (int qb = 0; qb < 2; ++qb)
#pragma unroll
        for (int r = 0; r < 4; ++r) rl[qb][r] = fast_rcp(li_l[qb * 16 + 4 * ge + r]);
    if (MODE != 1) {
        constexpr int OS = DV + 8;
        LAS bf16_t* ob = (LAS bf16_t*)lds;
#pragma unroll
        for (int qb = 0; qb < 2; ++qb)
#pragma unroll
            for (int r = 0; r < 4; ++r) { const int orow = wid * 32 + qb * 16 + 4 * ge + r;
#pragma unroll
                for (int db = 0; db < NDB; ++db) ob[orow * OS + db * 16 + ne] = f2bf(o[qb][db][r] * rl[qb][r]); }
        __syncthreads();
        constexpr int CPT = DV / 16;
        const int row = tid_e >> 1, c0 = (tid_e & 1) * CPT;
        bf16_t* Ow = a.O + (size_t)(a.q_row0 + row) * a.ldo + a.ocol + c0 * 8;
#pragma unroll
        for (int cc = 0; cc < CPT; ++cc) *(u32x4*)(Ow + cc * 8) = *(const LAS u32x4*)(ob + row * OS + (c0 + cc) * 8);
    } else {
        LAS float* cb = (LAS float*)lds;
        if (wmap == 1) {
#pragma unroll
            for (int qb = 0; qb < 2; ++qb)
#pragma unroll
                for (int r = 0; r < 4; ++r) { const int row = wq * 32 + qb * 16 + 4 * ge + r;
#pragma unroll
                    for (int db = 0; db < NDB; ++db) cb[row * 129 + db * 16 + ne] = a.lam * o[qb][db][r] * rl[qb][r]; }
        }
        __syncthreads();
        if (wmap == 0) {
#pragma unroll
            for (int qb = 0; qb < 2; ++qb)
#pragma unroll
                for (int r = 0; r < 4; ++r) { const int row = wq * 32 + qb * 16 + 4 * ge + r;
#pragma unroll
                    for (int db = 0; db < NDB; ++db) { const int ix = row * 129 + db * 16 + ne; cb[ix] = o[qb][db][r] * rl[qb][r] - cb[ix]; } }
        }
        __syncthreads();
        const int row = tid_e >> 2, qd = tid_e & 3;
        float v[32]; float ss = 0.f;
#pragma unroll
        for (int i = 0; i < 32; ++i) { v[i] = cb[row * 129 + qd * 32 + i]; ss += v[i] * v[i]; }
        ss += __shfl_xor(ss, 1); ss += __shfl_xor(ss, 2);
        const float rstd = rsqrtf(ss * (1.f / 128.f) + EPS) * a.oscale;
        bf16_t* Ow = a.O + (size_t)(a.q_row0 + row) * a.ldo + a.ocol + qd * 32;
#pragma unroll
        for (int c = 0; c < 4; ++c) { float w[8];
#pragma unroll
            for (int e = 0; e < 8; ++e) w[e] = v[c * 8 + e] * rstd * a.subg[qd * 32 + c * 8 + e];
            u32x4 pk = {cvtpk(w[0], w[1]), cvtpk(w[2], w[3]), cvtpk(w[4], w[5]), cvtpk(w[6], w[7])};
            *(u32x4*)(Ow + c * 8) = pk; }
    }
    __syncthreads();
}

__device__ __forceinline__ void sgu_unit(LAS unsigned char* lds, const bf16_t* PB, const bf16_t* Wsb, const float* bs, const float* stats, const float* sgain, bf16_t* MIX, int rowbase, int g) {
    const int tid = opaque_tid(), wid = __builtin_amdgcn_readfirstlane(tid >> 6), lane = tid & 63, r32 = lane & 31, hi = lane >> 5;
    LAS unsigned char* Vl = lds;
#pragma unroll 2
    for (int i = 0; i < 4; ++i) { const int c = tid + 512 * i, row = c >> 4, ch = c & 15;
        const u32x4 x = *(const u32x4*)(PB + (size_t)(rowbase + row) * EV_IN + 512 + g * 128 + ch * 8);
        const f32x4* st = (const f32x4*)(stats + (size_t)(rowbase + row) * 16); const f32x4 a0 = st[0], a1 = st[1], a2 = st[2], a3 = st[3];
        const float s1 = ((a0[0] + a0[2]) + (a1[0] + a1[2])) + ((a2[0] + a2[2]) + (a3[0] + a3[2])), s2 = ((a0[1] + a0[3]) + (a1[1] + a1[3])) + ((a2[1] + a2[3]) + (a3[1] + a3[3]));
        const float mean = s1 * (1.f / 512.f), rstd = rsqrtf(fmaxf(s2 * (1.f / 512.f) - mean * mean, 0.f) + EPS);
        const f32x4 g0 = *(const f32x4*)(sgain + g * 128 + ch * 8), g1 = *(const f32x4*)(sgain + g * 128 + ch * 8 + 4);
        u32x4 y; y.x = cvtpk((bflo(x.x) - mean) * rstd * g0[0], (bfhi(x.x) - mean) * rstd * g0[1]); y.y = cvtpk((bflo(x.y) - mean) * rstd * g0[2], (bfhi(x.y) - mean) * rstd * g0[3]);
        y.z = cvtpk((bflo(x.z) - mean) * rstd * g1[0], (bfhi(x.z) - mean) * rstd * g1[1]); y.w = cvtpk((bflo(x.w) - mean) * rstd * g1[2], (bfhi(x.w) - mean) * rstd * g1[3]);
        *(LAS u32x4*)(Vl + (row >> 6) * 16384 + v_st(row & 63, ch * 8)) = y; }
    const int prow = (wid & 3) * 32, dh = wid >> 2;
    bf16x8 pa[2][4];
#pragma unroll
    for (int kt = 0; kt < 2; ++kt)
#pragma unroll
        for (int ks = 0; ks < 4; ++ks) pa[kt][ks] = *(const bf16x8*)(Wsb + (size_t)(g * 128 + prow + r32) * 128 + kt * 64 + ks * 16 + hi * 8);
    __syncthreads();
    f32x16 o[2];
    o[0] = (f32x16){0.f, 0.f, 0.f, 0.f, 0.f, 0.f, 0.f, 0.f, 0.f, 0.f, 0.f, 0.f, 0.f, 0.f, 0.f, 0.f}; o[1] = o[0];
    const unsigned vb0 = (unsigned)(size_t)Vl + (unsigned)v_rd_base(lane);
#pragma unroll
    for (int kt = 0; kt < 2; ++kt) { const unsigned vb = vb0 + kt * 16384u;
        if (dh == 0) { pv_one<0>(o[0], vb, pa[kt][0], pa[kt][1], pa[kt][2], pa[kt][3]); pv_one<1>(o[1], vb, pa[kt][0], pa[kt][1], pa[kt][2], pa[kt][3]); }
        else { pv_one<2>(o[0], vb, pa[kt][0], pa[kt][1], pa[kt][2], pa[kt][3]); pv_one<3>(o[1], vb, pa[kt][0], pa[kt][1], pa[kt][2], pa[kt][3]); } }
#pragma unroll
    for (int r = 0; r < 16; ++r) { const int p = prow + crow(r, hi); const float bias = bs[g * 128 + p];
#pragma unroll
        for (int dd = 0; dd < 2; ++dd) { const int d = (2 * dh + dd) * 32 + r32;
            const float u = bf2f(PB[(size_t)(rowbase + p) * EV_IN + g * 128 + d]);
            MIX[(size_t)(rowbase + p) * DM + g * 128 + d] = f2bf(u * (o[dd][r] + bias)); } }
    __syncthreads();
}
}

struct Params {
    const float* in[31];
    float* out;
    unsigned char* ws;
    int ph_lo, ph_hi;
};

struct Ctx {
    LAS unsigned char* lds;
    int tid, lane, wid, gw, NGW;
};
__device__ __forceinline__ Ctx make_ctx(LAS unsigned char* lds) { const int t = opaque_tid(), w = __builtin_amdgcn_readfirstlane(t >> 6); return Ctx{lds, t, t & 63, w, opaque_bid() * 8 + w, (int)gridDim.x * 8}; }
typedef const __attribute__((address_space(4))) Params KParams;
__device__ __forceinline__ KParams& kparams() { KParams* p = (KParams*)__builtin_amdgcn_kernarg_segment_ptr(); asm volatile("" : "+s"(p)); return *p; }

__device__ __forceinline__ bf16_t* xrow_ptr(KParams& P, int row) { return (bf16_t*)(P.ws + WS_U + U_XB) + (size_t)row * DM; }
__device__ __forceinline__ int mod_r(int row) { return row < NLAT ? (row >> 13) : 4; }
__device__ __forceinline__ f32x4 ld4(const float* p) { return *(const f32x4*)p; }
__device__ __forceinline__ f32x4 ldbf4(const bf16_t* p) { const u32x2 w = *(const u32x2*)p; return (f32x4){bflo(w.x), bfhi(w.x), bflo(w.y), bfhi(w.y)}; }
__device__ __forceinline__ void stbf4(bf16_t* p, f32x4 v) { u32x2 w; w.x = cvtpk(v[0], v[1]); w.y = cvtpk(v[2], v[3]); *(u32x2*)p = w; }
__device__ __forceinline__ float sumsq4(const f32x4 (&v)[4]) { float s = 0.f;
#pragma unroll
    for (int j = 0; j < 4; ++j) s += (v[j][0] * v[j][0] + v[j][1] * v[j][1]) + (v[j][2] * v[j][2] + v[j][3] * v[j][3]);
    return wave_sum(s); }
__device__ __forceinline__ void norm_mod(const f32x4 (&x)[4], f32x4 (&hv)[4], const float* gain, const float* shift, const float* scale, int lane) {
    const float rstd = rsqrtf(sumsq4(x) * (1.f / DM) + EPS);
#pragma unroll
    for (int j = 0; j < 4; ++j) { const int c = 4 * lane + 256 * j; const f32x4 g = ld4(gain + c), sh = ld4(shift + c), sc = ld4(scale + c);
        hv[j] = (x[j] * rstd) * g * (sc + 1.f) + sh; }
}
__device__ __forceinline__ void resid_add(f32x4 (&x)[4], const f32x4 (&y)[4], const float* gain, const float* gate, int lane) {
    const float rstd = rsqrtf(sumsq4(y) * (1.f / DM) + EPS);
#pragma unroll
    for (int j = 0; j < 4; ++j) { const int c = 4 * lane + 256 * j; const f32x4 g = ld4(gain + c), gt = ld4(gate + c);
        x[j] = x[j] + gt * ((y[j] * rstd) * g); }
}

__device__ __forceinline__ void wave_rows(const Ctx& c, int mtok, int& r0, int& r1) {
    const int bid = opaque_bid(); const int rpw = mtok / (int)gridDim.x, base = bid * rpw;
    r0 = base + (c.wid * rpw) / 8; r1 = base + ((c.wid + 1) * rpw) / 8;
    if (bid == (int)gridDim.x - 1 && c.wid == 7) r1 = mtok;
}
__device__ __forceinline__ void ld_gate(f32x4 (&G)[4], const float* gain, const float* gate, int lane) {
#pragma unroll
    for (int j = 0; j < 4; ++j) { const int cc = 4 * lane + 256 * j; G[j] = ld4(gain + cc) * ld4(gate + cc); } }
__device__ __forceinline__ void ld_mod(f32x4 (&A)[4], f32x4 (&B)[4], const float* gain, const float* shift, const float* scale, int lane) {
#pragma unroll
    for (int j = 0; j < 4; ++j) { const int cc = 4 * lane + 256 * j; A[j] = ld4(gain + cc) * (ld4(scale + cc) + 1.f); B[j] = ld4(shift + cc); } }
__device__ __forceinline__ void resid_add2(f32x4 (&x)[4], const f32x4 (&y)[4], const f32x4 (&G)[4]) {
    const float rstd = rsqrtf(sumsq4(y) * (1.f / DM) + EPS);
#pragma unroll
    for (int j = 0; j < 4; ++j) x[j] = x[j] + G[j] * (y[j] * rstd);
}
__device__ __forceinline__ void norm_mod2(const f32x4 (&x)[4], f32x4 (&hv)[4], const f32x4 (&A)[4], const f32x4 (&B)[4]) {
    const float rstd = rsqrtf(sumsq4(x) * (1.f / DM) + EPS);
#pragma unroll
    for (int j = 0; j < 4; ++j) hv[j] = (x[j] * rstd) * A[j] + B[j];
}

__device__ __forceinline__ int perm_row(int pmode, int n) {
    if (pmode == 1) { if (n >= 1024 && n < 2048) { const int d = n & 63, hb = n & ~63; return hb + ((d < 32) ? 8 * (d >> 2) + (d & 3) : 8 * ((d - 32) >> 2) + 4 + (d & 3)); } }
    else if (pmode == 2) { if (n >= 1920 && n < 1952) { const int d = n - 1920; return 1920 + ((d < 16) ? 8 * (d >> 2) + (d & 3) : 8 * ((d - 16) >> 2) + 4 + (d & 3)); } }
    return n;
}
__device__ __forceinline__ void tr_item(const float* W, int ldw, bf16_t* WT, int ldt, int k0, int n0, int drow, LAS float* scr, int lane, int pmode = 0) {
#pragma unroll 8
    for (int i = 0; i < 32; ++i) { const int kk = 2 * i + (lane >> 5); scr[kk * 33 + (lane & 31)] = W[(size_t)(k0 + kk) * ldw + n0 + (lane & 31)]; }
    LDS_WAIT(); asm volatile("" ::: "memory");
    const int c = lane & 7;
#pragma unroll
    for (int j = 0; j < 4; ++j) { const int n = (lane >> 3) + 8 * j; const LAS float* s = scr + (8 * c) * 33 + n;
        u32x4 o; o.x = cvtpk(s[0 * 33], s[1 * 33]); o.y = cvtpk(s[2 * 33], s[3 * 33]); o.z = cvtpk(s[4 * 33], s[5 * 33]); o.w = cvtpk(s[6 * 33], s[7 * 33]);
        const int dr = pmode ? perm_row(pmode, n0 + n) : drow + n;
        *(u32x4*)(WT + (size_t)dr * ldt + k0 + 8 * c) = o; }
    LDS_WAIT(); asm volatile("" ::: "memory");
}
__device__ __forceinline__ void tr_item8(const float* W, int ldw, unsigned char* WT, int ldt, int k0, int n0, int drow, LAS float* scr, int lane, int pmode = 0) {
#pragma unroll 8
    for (int i = 0; i < 32; ++i) { const int kk = 2 * i + (lane >> 5); scr[kk * 33 + (lane & 31)] = W[(size_t)(k0 + kk) * ldw + n0 + (lane & 31)] * F8_W_SCALE; }
    LDS_WAIT(); asm volatile("" ::: "memory");
    const int c = lane & 7;
#pragma unroll
    for (int j = 0; j < 4; ++j) { const int n = (lane >> 3) + 8 * j; const LAS float* s = scr + (8 * c) * 33 + n;
        u32x2 o; o.x = pk4_fp8(s[0 * 33], s[1 * 33], s[2 * 33], s[3 * 33]); o.y = pk4_fp8(s[4 * 33], s[5 * 33], s[6 * 33], s[7 * 33]);
        const int dr = pmode ? perm_row(pmode, n0 + n) : drow + n;
        *(u32x2*)(WT + (size_t)dr * ldt + k0 + 8 * c) = o; }
    LDS_WAIT(); asm volatile("" ::: "memory");
}
__device__ __forceinline__ void tr_matrix8(const Ctx& c, const float* W, int K, int N, unsigned char* WT, int mode, int row_off, int pmode = 0) {
    LAS float* scr = (LAS float*)(c.lds + c.wid * 16384);
    const int nblk = N / 32, nitems = (K / 64) * nblk;
    for (int it = c.gw; it < nitems; it += c.NGW) { const int kb = it / nblk, nb = it % nblk, n0 = 32 * nb;
        const int drow = (mode == 0) ? row_off + n0 : (n0 >> 7) * 256 + (n0 & 127) + (mode == 2 ? 128 : 0);
        tr_item8(W, N, WT, K, 64 * kb, n0, drow, scr, c.lane, pmode); }
}
__device__ __forceinline__ void tr_matrix(const Ctx& c, const float* W, int K, int N, bf16_t* WT, int mode, int row_off, int pmode = 0) {
    LAS float* scr = (LAS float*)(c.lds + c.wid * 16384);
    const int nblk = N / 32, nitems = (K / 64) * nblk;
    for (int it = c.gw; it < nitems; it += c.NGW) { const int kb = it / nblk, nb = it % nblk, n0 = 32 * nb;
        const int drow = (mode == 0) ? row_off + n0 : (n0 >> 7) * 256 + (n0 & 127) + (mode == 2 ? 128 : 0);
        tr_item(W, N, WT, K, 64 * kb, n0, drow, scr, c.lane, pmode); }
}
constexpr int MOE_CVT_ITEMS = 24 * 1792;
__device__ __forceinline__ void convert_moe_items(const Ctx& c, int i, int t0, int t1, int wsel, int nsel) {
    KParams& P = kparams();
    LAS float* scr = (LAS float*)(c.lds + c.wid * 16384);
    if (wsel < 0) return;
    for (int t = t0 + wsel; t < t1; t += nsel) {
        const int mat = t / 1792, r = t % 1792, e = mat / 3, which = mat % 3;
        if (which < 2) {
            const float* W = P.in[28 + which] + ((size_t)i * NEXP + e) * DM * DFFE; const int kb = r / 112, n0 = 32 * (r % 112);
            const int drow = (n0 >> 7) * 256 + (n0 & 127) + which * 128;
#if MOE_F8
            tr_item8(W, DFFE, (unsigned char*)(P.ws + WS_W13M) + (size_t)e * 2 * DFFE * DM, DM, 64 * kb, n0, drow, scr, c.lane);
#else
            tr_item(W, DFFE, (bf16_t*)(P.ws + WS_W13M) + (size_t)e * 2 * DFFE * DM, DM, 64 * kb, n0, drow, scr, c.lane);
#endif
        } else {
            const float* W = P.in[30] + ((size_t)i * NEXP + e) * DFFE * DM; const int kb = r / 32, n0 = 32 * (r % 32);
#if MOE_F8
            tr_item8(W, DM, (unsigned char*)(P.ws + WS_W2M) + (size_t)e * DM * DFFE, DFFE, 64 * kb, n0, n0, scr, c.lane);
#else
            tr_item(W, DM, (bf16_t*)(P.ws + WS_W2M) + (size_t)e * DM * DFFE, DFFE, 64 * kb, n0, n0, scr, c.lane);
#endif
        }
    }
}
__device__ __forceinline__ void prologue0(const Ctx& c_) {
    const Ctx c = make_ctx(c_.lds);
    KParams& P = kparams(); unsigned char* ws = P.ws;
    if (blockIdx.x < 96) {
        LAS float* sl = (LAS float*)c.lds;
        LAS float* part = (LAS float*)(c.lds + 32768);
        for (int i = c.tid; i < 5 * DM; i += 512) { const int r = i >> 10, k = i & 1023; const float x = r < 4 ? P.in[1][r * DM + k] : P.in[3][k]; sl[i] = x / (1.f + expf(-x)); }
        __syncthreads();
        const int t = blockIdx.x, lm = t / 24, cbk = t % 24, n = cbk * 256 + 4 * c.lane;
        const float* W = P.in[4] + (size_t)lm * DM * (NMOD * DM) + n;
        f32x4 acc[5];
#pragma unroll
        for (int r = 0; r < 5; ++r) acc[r] = (f32x4){0.f, 0.f, 0.f, 0.f};
        const int kb = c.wid * 128;
        for (int k0 = 0; k0 < 128; k0 += 8) {
            f32x4 wv[8];
#pragma unroll
            for (int u = 0; u < 8; ++u) wv[u] = ld4(W + (size_t)(kb + k0 + u) * (NMOD * DM));
#pragma unroll
            for (int u = 0; u < 8; ++u)
#pragma unroll
                for (int r = 0; r < 5; ++r) acc[r] += wv[u] * sl[r * DM + kb + k0 + u];
        }
#pragma unroll
        for (int r = 0; r < 5; ++r) *(LAS f32x4*)(part + (c.wid * 5 + r) * 256 + 4 * c.lane) = acc[r];
        __syncthreads();
        for (int i = c.tid; i < 5 * 256; i += 512) { const int r = i >> 8, cc = i & 255; float s = 0.f;
#pragma unroll
            for (int w = 0; w < 8; ++w) s += part[(w * 5 + r) * 256 + cc];
            ((float*)(ws + WS_MODS))[(size_t)(lm * 5 + r) * (NMOD * DM) + cbk * 256 + cc] = s + P.in[5][lm * (NMOD * DM) + cbk * 256 + cc]; }
        __syncthreads();
    }
    for (int i = 0; i < 2; ++i) {
        if (WIN8(2 * i)) tr_matrix8(c, P.in[7] + (size_t)i * DM * EV_IN, DM, EV_IN, (unsigned char*)(ws + WS_WINE) + (size_t)i * EV_IN * DM * 2, 0, 0, 1);
        else tr_matrix(c, P.in[7] + (size_t)i * DM * EV_IN, DM, EV_IN, (bf16_t*)(ws + WS_WINE) + (size_t)i * EV_IN * DM, 0, 0, 1);
        tr_matrix(c, P.in[8] + (size_t)i * DM * DM, DM, DM, (bf16_t*)(ws + WS_WOUTE) + (size_t)i * DM * DM, 0, 0);
        if (FFN8(i)) {
            tr_matrix8(c, P.in[17] + (size_t)i * DM * DFF, DM, DFF, (unsigned char*)(ws + WS_W13E) + (size_t)i * 2 * DFF * DM * 2, 1, 0);
            tr_matrix8(c, P.in[18] + (size_t)i * DM * DFF, DM, DFF, (unsigned char*)(ws + WS_W13E) + (size_t)i * 2 * DFF * DM * 2, 2, 0);
            tr_matrix8(c, P.in[19] + (size_t)i * DFF * DM, DFF, DM, (unsigned char*)(ws + WS_W2E) + (size_t)i * DM * DFF * 2, 0, 0);
        } else {
            tr_matrix(c, P.in[17] + (size_t)i * DM * DFF, DM, DFF, (bf16_t*)(ws + WS_W13E) + (size_t)i * 2 * DFF * DM, 1, 0);
            tr_matrix(c, P.in[18] + (size_t)i * DM * DFF, DM, DFF, (bf16_t*)(ws + WS_W13E) + (size_t)i * 2 * DFF * DM, 2, 0);
            tr_matrix(c, P.in[19] + (size_t)i * DFF * DM, DFF, DM, (bf16_t*)(ws + WS_W2E) + (size_t)i * DM * DFF, 0, 0);
        }
        if (WIN8(2 * i + 1)) tr_matrix8(c, P.in[20] + (size_t)i * DM * OD_IN, DM, OD_IN, (unsigned char*)(ws + WS_WINO) + (size_t)i * OD_INP * DM * 2, 0, 0, 2);
        else tr_matrix(c, P.in[20] + (size_t)i * DM * OD_IN, DM, OD_IN, (bf16_t*)(ws + WS_WINO) + (size_t)i * OD_INP * DM, 0, 0, 2);
        tr_matrix(c, P.in[21] + (size_t)i * DM * DM, DM, DM, (bf16_t*)(ws + WS_WOUTO) + (size_t)i * DM * DM, 0, 0);
    }
    const int gt = blockIdx.x * 512 + c.tid, NGT = gridDim.x * 512;
    for (int i = gt; i < 2 * (OD_INP - OD_IN) * DM; i += NGT) { const int l = i / ((OD_INP - OD_IN) * DM), r = i % ((OD_INP - OD_IN) * DM);
        if (WIN8(2 * l + 1)) ((unsigned char*)(ws + WS_WINO))[(size_t)l * OD_INP * DM * 2 + (size_t)OD_IN * DM + r] = 0;
        else ((bf16_t*)(ws + WS_WINO))[(size_t)l * OD_INP * DM + (size_t)OD_IN * DM + r] = 0; }
    for (int i = gt; i < 2 * MLA_N * MLA_K; i += NGT) { const int l = i / (MLA_N * MLA_K), n = (i / MLA_K) % MLA_N, k = i % MLA_K; float v = 0.f;
        if (n < 384) { if (k < 256) { const int h = n / 96, j = n % 96; int sc = n;
                if (j >= 64) { const int p = j - 64, t = p >> 3, e = p & 7; sc = h * 96 + 64 + ((e < 4) ? 4 * t + e : 16 + 4 * t + (e - 4)); }
                v = P.in[24][((size_t)l * 256 + k) * 384 + sc] * P.in[23][l * 256 + k]; } }
        else if (n < 768) { const int h = (n - 384) / 96, j = (n - 384) % 96;
            if (j < 64) { if (k >= 256 && k < 384) v = P.in[26][((size_t)l * 128 + (k - 256)) * 768 + h * 192 + j] * P.in[25][l * 128 + (k - 256)]; }
            else { if (k == 384 + (j - 64)) v = 1.f; } }
        else { const int h = (n - 768) / 128, j = (n - 768) % 128; if (k >= 256 && k < 384) v = P.in[26][((size_t)l * 128 + (k - 256)) * 768 + h * 192 + 64 + j] * P.in[25][l * 128 + (k - 256)]; }
        ((bf16_t*)(ws + WS_WMLA))[i] = f2bf(v); }
    for (int i = gt; i < 2 * 4 * 128 * 128; i += NGT) ((bf16_t*)(ws + WS_SGUW))[i] = f2bf(P.in[9][i]);
    for (int i = gt; i < SEQ * 32; i += NGT) { const int s = i >> 5, f = i & 31; const int pos = f < 16 ? (s >> 6) : (s & 63);
        const float inv = 1.0f / powf(10000.0f, (float)(f & 15) / 16.0f); const float ang = (float)pos * inv;
        ((float*)(ws + WS_ROPEB))[i] = (float)cos((double)ang); ((float*)(ws + WS_ROPEB))[SEQ * 32 + i] = (float)sin((double)ang); }
    for (int i = gt; i < SEQ * 16; i += NGT) { const int s = i >> 4, f = i & 15; const int pos = f < 8 ? (s >> 6) : (s & 63);
        const float inv = 1.0f / powf(10000.0f, (float)(f & 7) / 8.0f); const float ang = (float)pos * inv;
        ((float*)(ws + WS_ROPED))[i] = (float)cos((double)ang); ((float*)(ws + WS_ROPED))[SEQ * 16 + i] = (float)sin((double)ang); }
}

__device__ __forceinline__ void convert_moe_tail(const Ctx& c_, int i, int t0, int t1, int nunits) {
    const Ctx c = make_ctx(c_.lds);
    const int G = (int)gridDim.x, rem = nunits % G, bid = opaque_bid();
    const int first = rem;
    convert_moe_items(c, i, t0, t1, bid >= first ? (bid - first) * 8 + c.wid : -1, (G - first) * 8);
}

__device__ __forceinline__ void ew_first(const Ctx& c_) {
    const Ctx c = make_ctx(c_.lds);
    KParams& P = kparams(); const float* mods = (const float*)(P.ws + WS_MODS); bf16_t* HB = (bf16_t*)(P.ws + WS_HB);
    int r0, r1; wave_rows(c, MTOT, r0, r1);
    f32x4 A0[4], B0[4]; int rcur = -1;
    for (int row = r0; row < r1; ++row) {
        const float* src = row < NLAT ? P.in[0] + (size_t)row * DM : P.in[2] + (size_t)(row - NLAT) * DM;
        bf16_t* xr = xrow_ptr(P, row); const int r = mod_r(row);
        if (r != rcur) { rcur = r; const float* mb = mods + (size_t)(0 * 5 + r) * (NMOD * DM); ld_mod(A0, B0, P.in[6] + (0 * 4 + 0) * DM, mb + 0 * DM, mb + 1 * DM, c.lane); }
        f32x4 x[4], h[4];
#pragma unroll
        for (int j = 0; j < 4; ++j) { x[j] = ld4(src + 4 * c.lane + 256 * j); stbf4(xr + 4 * c.lane + 256 * j, x[j]); }
        norm_mod2(x, h, A0, B0);
#pragma unroll
        for (int j = 0; j < 4; ++j) stbf4(HB + (size_t)row * DM + 4 * c.lane + 256 * j, h[j]);
    }
}

__device__ __forceinline__ void ew_mid(const Ctx& c_, int l, int mtok, bool dry = false) {
    const Ctx c = make_ctx(c_.lds);
    KParams& P = kparams(); const float* mods = (const float*)(P.ws + WS_MODS); bf16_t* HB = (bf16_t*)(P.ws + WS_HB);
    const bf16_t* YB = (const bf16_t*)(P.ws + WS_U + U_YB);
    const bool odd = (l & 1) != 0; const int li = l >> 1;
    LAS float* wrl = (LAS float*)c.lds;
    if (odd) { for (int i = c.tid; i < DM * NEXP; i += 512) { const int col = i >> 3, e = i & 7; wrl[e * DM + col] = P.in[27][(size_t)li * DM * NEXP + i]; } __syncthreads(); }
    unsigned long long cw = 0ull; int st_e1 = 0, st_e2 = 0, st_l1 = 0, st_l2 = 0; float st_g1 = 0.f; int nrow = 0;
    int r0, r1; wave_rows(c, mtok, r0, r1);
    f32x4 G1[4], A2[4], B2[4]; int rcur = -1;
    u32x2 xa[4], ya[4], xb[4], yb[4];
#define EWM_LOAD(X, Y, rw) do { const int _row = (rw); const bf16_t* _xr = xrow_ptr(P, _row); \
        _Pragma("unroll") for (int j = 0; j < 4; ++j) { X[j] = *(const u32x2*)(_xr + 4 * c.lane + 256 * j); Y[j] = *(const u32x2*)(YB + (size_t)_row * DM + 4 * c.lane + 256 * j); } } while (0)
    if (r0 < r1) EWM_LOAD(xa, ya, r0);
    if (r0 + 1 < r1) EWM_LOAD(xb, yb, r0 + 1);
    for (int row = r0; row < r1; ++row, ++nrow) {
        bf16_t* xr = xrow_ptr(P, row); const int r = mod_r(row);
        if (r != rcur) { rcur = r; const float* mb = mods + (size_t)(l * 5 + r) * (NMOD * DM);
            ld_gate(G1, P.in[6] + (l * 4 + 1) * DM, mb + 2 * DM, c.lane); ld_mod(A2, B2, P.in[6] + (l * 4 + 2) * DM, mb + 3 * DM, mb + 4 * DM, c.lane); }
        f32x4 x[4], y[4], h[4];
#pragma unroll
        for (int j = 0; j < 4; ++j) { x[j] = (f32x4){bflo(xa[j].x), bfhi(xa[j].x), bflo(xa[j].y), bfhi(xa[j].y)}; y[j] = (f32x4){bflo(ya[j].x), bfhi(ya[j].x), bflo(ya[j].y), bfhi(ya[j].y)}; xa[j] = xb[j]; ya[j] = yb[j]; }
        if (row + 2 < r1) EWM_LOAD(xb, yb, row + 2);
        resid_add2(x, y, G1);
        bf16_t* xw = dry ? (bf16_t*)(P.ws + WS_U + U_YS) + (size_t)row * DM : xr; bf16_t* hw = (dry ? (bf16_t*)(P.ws + WS_U + U_PB) : HB) + (size_t)row * DM;
#pragma unroll
        for (int j = 0; j < 4; ++j) stbf4(xw + 4 * c.lane + 256 * j, x[j]);
        norm_mod2(x, h, A2, B2);
        if ((odd && MOE_F8) || (!odd && FFN8(li))) {
            unsigned char* h8 = (unsigned char*)(dry ? (bf16_t*)(P.ws + WS_U + U_PB) : HB) + (size_t)row * DM;
#pragma unroll
            for (int j = 0; j < 4; ++j) *(unsigned*)(h8 + 4 * c.lane + 256 * j) = pk4_fp8(h[j][0] * F8_ACT_SCALE, h[j][1] * F8_ACT_SCALE, h[j][2] * F8_ACT_SCALE, h[j][3] * F8_ACT_SCALE);
        } else {
#pragma unroll
            for (int j = 0; j < 4; ++j) stbf4(hw + 4 * c.lane + 256 * j, h[j]);
        }
        if (odd && !dry) {
            float lg[8];
#pragma unroll
            for (int e = 0; e < 8; ++e) { float sacc = 0.f;
#pragma unroll
                for (int j = 0; j < 4; ++j) { const f32x4 w = *(const LAS f32x4*)(wrl + e * DM + 4 * c.lane + 256 * j); sacc += (h[j][0] * w[0] + h[j][1] * w[1]) + (h[j][2] * w[2] + h[j][3] * w[3]); }
                lg[e] = wave_sum(sacc); }
            int e1 = 0; float v1 = lg[0];
#pragma unroll
            for (int e = 1; e < 8; ++e) if (lg[e] > v1) { v1 = lg[e]; e1 = e; }
            int e2 = -1; float v2 = -3.0e38f;
#pragma unroll
            for (int e = 0; e < 8; ++e) if (e != e1 && lg[e] > v2) { v2 = lg[e]; e2 = e; }
            if (e2 < 0) e2 = (e1 + 1) & 7;
            const float g1 = 1.f / (1.f + expf(v2 - v1));
            const int l1 = (int)((cw >> (8 * e1)) & 0xffull); cw += 1ull << (8 * e1);
            const int l2 = (int)((cw >> (8 * e2)) & 0xffull); cw += 1ull << (8 * e2);
            if (c.lane == nrow) { st_e1 = e1; st_e2 = e2; st_l1 = l1; st_l2 = l2; st_g1 = g1; }
        }
    }
    if (odd && !dry) {
        unsigned* cnt = (unsigned*)(P.ws + WS_CTL) + CW_MOECNT + li * 64;
        int base = 0;
        if (c.lane < 8) { const unsigned wc = (unsigned)((cw >> (8 * c.lane)) & 0xffull); base = wc ? (int)atomicAdd(cnt + c.lane, wc) : 0; }
        const int b1 = __shfl(base, st_e1), b2 = __shfl(base, st_e2);
        if (c.lane < nrow) { const int row = r0 + c.lane; int4* ti = (int4*)(P.ws + WS_TOKINFO) + (size_t)row * 2;
            ti[0] = make_int4(st_e1, b1 + st_l1, st_e2, b2 + st_l2); ti[1] = make_int4(__float_as_int(st_g1), __float_as_int(1.f - st_g1), 0, 0); }
        __syncthreads();
    }
#undef EWM_LOAD
}

__device__ __forceinline__ void moe_offsets(KParams& P, int li, int (&toff)[9]) {
    const unsigned* cnt = (const unsigned*)(P.ws + WS_CTL) + CW_MOECNT + li * 64; int acc = 0;
#pragma unroll
    for (int e = 0; e < 8; ++e) { toff[e] = acc; const unsigned n = __builtin_amdgcn_readfirstlane(__hip_atomic_load(cnt + e, __ATOMIC_RELAXED, __HIP_MEMORY_SCOPE_AGENT)); acc += (int)((n + 255u) >> 8); }
    toff[8] = acc;
}
__device__ __forceinline__ void moe_gather(const Ctx& c_, int li, int mtok) {
    const Ctx c = make_ctx(c_.lds);
    KParams& P = kparams(); int toff[9]; moe_offsets(P, li, toff);
    int tv = 0;
#pragma unroll
    for (int e = 0; e < 8; ++e) tv = (c.lane == e) ? toff[e] : tv;
    const bf16_t* HB = (const bf16_t*)(P.ws + WS_HB); bf16_t* HS = (bf16_t*)(P.ws + WS_U + U_YS);
    int r0, r1; wave_rows(c, mtok, r0, r1);
    for (int row = r0; row < r1; ++row) {
        const int4* ti = (const int4*)(P.ws + WS_TOKINFO) + (size_t)row * 2; const int4 a = ti[0], b = ti[1];
        const int pA = __shfl(tv, a.x) * 256 + a.y, pB = __shfl(tv, a.z) * 256 + a.w;
        if (c.lane == 0) ((int4*)(P.ws + WS_TOKPOS))[row] = make_int4(pA, pB, b.x, b.y);
#if MOE_F8
        const u32x4 v0 = ((const u32x4*)((const unsigned char*)HB + (size_t)row * DM))[c.lane];
        ((u32x4*)((unsigned char*)HS + (size_t)pA * DM))[c.lane] = v0; ((u32x4*)((unsigned char*)HS + (size_t)pB * DM))[c.lane] = v0;
#else
        const u32x4* src = (const u32x4*)(HB + (size_t)row * DM); const u32x4 v0 = src[c.lane], v1 = src[64 + c.lane];
        u32x4* dA = (u32x4*)(HS + (size_t)pA * DM); u32x4* dB = (u32x4*)(HS + (size_t)pB * DM);
        dA[c.lane] = v0; dA[64 + c.lane] = v1; dB[c.lane] = v0; dB[64 + c.lane] = v1;
#endif
    }
}

__device__ __forceinline__ void ew_last(const Ctx& c_, int l, int mtok, bool dry = false) {
    const Ctx c = make_ctx(c_.lds);
    KParams& P = kparams(); const float* mods = (const float*)(P.ws + WS_MODS); bf16_t* HB = (bf16_t*)(P.ws + WS_HB);
    const bf16_t* YS = (const bf16_t*)(P.ws + WS_U + U_YS); const bool odd = (l & 1) != 0;
    int r0, r1; wave_rows(c, mtok, r0, r1);
    f32x4 G3[4], A0[4], B0[4]; int rcur = -1;
    u32x2 xa[4], ya[4], za[4], xb[4], yb[4], zb[4]; float gAa = 0.f, gBa = 0.f, gAb = 0.f, gBb = 0.f;
#define EWL_LOAD(X, Y, Z, GA, GB, rw) do { const int _row = (rw); const bf16_t* _xr = xrow_ptr(P, _row); \
        if (odd) { const int4 tp = ((const int4*)(P.ws + WS_TOKPOS))[_row]; GA = __int_as_float(tp.z); GB = __int_as_float(tp.w); \
            _Pragma("unroll") for (int j = 0; j < 4; ++j) { Y[j] = *(const u32x2*)(YS + (size_t)tp.x * DM + 4 * c.lane + 256 * j); Z[j] = *(const u32x2*)(YS + (size_t)tp.y * DM + 4 * c.lane + 256 * j); } } \
        else { _Pragma("unroll") for (int j = 0; j < 4; ++j) Y[j] = *(const u32x2*)(YS + (size_t)_row * DM + 4 * c.lane + 256 * j); } \
        _Pragma("unroll") for (int j = 0; j < 4; ++j) X[j] = *(const u32x2*)(_xr + 4 * c.lane + 256 * j); } while (0)
    if (r0 < r1) EWL_LOAD(xa, ya, za, gAa, gBa, r0);
    if (r0 + 1 < r1) EWL_LOAD(xb, yb, zb, gAb, gBb, r0 + 1);
    for (int row = r0; row < r1; ++row) {
        bf16_t* xr = xrow_ptr(P, row); const int r = mod_r(row);
        if (r != rcur) { rcur = r; const float* mb = mods + (size_t)(l * 5 + r) * (NMOD * DM);
            ld_gate(G3, P.in[6] + (l * 4 + 3) * DM, mb + 5 * DM, c.lane);
            if (l < 3) { const float* mn = mods + (size_t)((l + 1) * 5 + r) * (NMOD * DM); ld_mod(A0, B0, P.in[6] + ((l + 1) * 4 + 0) * DM, mn + 0 * DM, mn + 1 * DM, c.lane); } }
        f32x4 x[4], y[4], h[4];
#pragma unroll
        for (int j = 0; j < 4; ++j) { x[j] = (f32x4){bflo(xa[j].x), bfhi(xa[j].x), bflo(xa[j].y), bfhi(xa[j].y)};
            y[j] = (f32x4){bflo(ya[j].x), bfhi(ya[j].x), bflo(ya[j].y), bfhi(ya[j].y)};
            if (odd) y[j] = y[j] * gAa + (f32x4){bflo(za[j].x), bfhi(za[j].x), bflo(za[j].y), bfhi(za[j].y)} * gBa;
            xa[j] = xb[j]; ya[j] = yb[j]; za[j] = zb[j]; }
        gAa = gAb; gBa = gBb;
        if (row + 2 < r1) EWL_LOAD(xb, yb, zb, gAb, gBb, row + 2);
        resid_add2(x, y, G3);
        bf16_t* hw = (dry ? (bf16_t*)(P.ws + WS_U + U_MIX) : HB) + (size_t)row * DM;
        if (l == 3 && !dry) { float* ow = P.out + (size_t)row * DM;
#pragma unroll
            for (int j = 0; j < 4; ++j) *(f32x4*)(ow + 4 * c.lane + 256 * j) = x[j]; }
        else { bf16_t* xw = dry ? (bf16_t*)(P.ws + WS_U + U_PB) + (size_t)row * DM : xr;
#pragma unroll
            for (int j = 0; j < 4; ++j) stbf4(xw + 4 * c.lane + 256 * j, x[j]); }
        if (l < 3) { norm_mod2(x, h, A0, B0);
            if (WIN8(l + 1)) { unsigned char* h8 = (unsigned char*)(dry ? (bf16_t*)(P.ws + WS_U + U_MIX) : HB) + (size_t)row * DM;
#pragma unroll
                for (int j = 0; j < 4; ++j) *(unsigned*)(h8 + 4 * c.lane + 256 * j) = pk4_fp8(h[j][0] * F8_ACT_SCALE, h[j][1] * F8_ACT_SCALE, h[j][2] * F8_ACT_SCALE, h[j][3] * F8_ACT_SCALE); }
            else {
#pragma unroll
                for (int j = 0; j < 4; ++j) stbf4(hw + 4 * c.lane + 256 * j, h[j]); } }
    }
#undef EWL_LOAD
}

__device__ __forceinline__ void attn_even(const Ctx& c_, int l) {
    const Ctx c = make_ctx(c_.lds);
    KParams& P = kparams(); const int i = l >> 1; const bool need_ctx = l < 3;
    const bf16_t* PB = (const bf16_t*)(P.ws + WS_U + U_PB); bf16_t* MIX = (bf16_t*)(P.ws + WS_U + U_MIX);
    const int nchunk = need_ctx ? 264 : 256;
    for (int u = opaque_bid(); u < nchunk * 4; u += gridDim.x) att::sgu_unit(c.lds, PB, (const bf16_t*)(P.ws + WS_SGUW) + (size_t)i * 4 * 128 * 128, P.in[10] + i * 512, (const float*)(P.ws + WS_STATS), P.in[11] + i * 512, MIX, (u >> 2) * 128, u & 3);
    float d1 = 0.f, d2 = 0.f;
    if (c.lane < 64) { d1 = P.in[12][i * 64 + c.lane] * P.in[13][i * 64 + c.lane]; d2 = P.in[14][i * 64 + c.lane] * P.in[15][i * 64 + c.lane]; }
    const float lam_init = 0.8f - 0.6f * expf(-0.3f * (float)l);
    const float lam = expf(wave_sum(d1)) - expf(wave_sum(d2)) + lam_init;
    att::Args a;
    a.Q = PB; a.ldq = EV_IN; a.K = PB; a.ldk = EV_IN; a.V = PB; a.ldv = EV_IN; a.C = 0.125f * LOG2E;
    a.rcos = (const float*)(P.ws + WS_ROPEB); a.rsin = a.rcos + SEQ * 32; a.O = MIX; a.ldo = DM; a.g = 0; a.u0 = 0; a.rpb = nullptr;
    a.lam = lam; a.oscale = 1.f - lam_init; a.subg = P.in[16] + i * 128; a.nt_ctx = 4;
    const int nctxu = need_ctx ? 32 : 0, nu = nctxu + 1024;
    for (int u = xcd_unit_base(); u < nu; u += gridDim.x) {
        int b, h;
        if (u < nctxu) { b = u >> 3; h = (u >> 1) & 3; a.q_row0 = NLAT + b * CTXL + (u & 1) * 128; a.nt_lat = 0; a.rope = 0; }
        else { const int v = u - nctxu; b = v >> 8; h = (v >> 6) & 3; a.q_row0 = b * SEQ + (v & 63) * 128; a.nt_lat = SEQ / 64; a.rope = 0; }
        a.qcol = 1024 + h * 128; a.kcol = 1536 + h * 128; a.vcol = 2048 + h * 128; a.ocol = 512 + h * 128;
        a.kctx_row0 = NLAT + b * CTXL; a.klat_row0 = b * SEQ;
        att::attn_unit<64, 128, 128, 1>(c.lds, a);
    }
}
__device__ __forceinline__ void attn_odd_na(const Ctx& c_, int l) {
    const Ctx c = make_ctx(c_.lds);
    KParams& P = kparams(); const int i = l >> 1; const bool need_ctx = l < 3;
    const bf16_t* PB = (const bf16_t*)(P.ws + WS_U + U_PB); bf16_t* MIX = (bf16_t*)(P.ws + WS_U + U_MIX);
    att::Args a;
    a.Q = PB; a.ldq = OD_INP; a.K = PB; a.ldk = OD_INP; a.V = PB; a.ldv = OD_INP; a.C = 0.125f * LOG2E; a.rope = 0; a.rcos = nullptr; a.rsin = nullptr;
    a.O = MIX; a.ldo = DM; a.lam = 0.f; a.oscale = 1.f; a.subg = nullptr; a.nt_ctx = 4;
    const int nctxu = need_ctx ? 32 : 0, nu = nctxu + 1024;
    for (int u = xcd_unit_base(); u < nu; u += gridDim.x) {
        int b, h;
        if (u < nctxu) { b = u >> 3; h = u & 7; a.q_row0 = NLAT + b * CTXL; a.nt_lat = 0; a.g = 0; a.u0 = 0; a.klat_row0 = 0; }
        else { const int v = u - nctxu; b = v >> 8; h = (v >> 5) & 7; const int g = v & 31; a.g = g; a.u0 = min(max(4 * g - 4, 0), 116);
            a.q_row0 = b * SEQ + g * 256; a.nt_lat = 12; a.klat_row0 = b * SEQ + a.u0 * 64; }
        a.qcol = h * 64; a.kcol = 512 + h * 64; a.vcol = 1024 + h * 64; a.ocol = h * 64; a.kctx_row0 = NLAT + b * CTXL;
        a.rpb = P.in[22] + ((size_t)i * 8 + h) * 465;
        att::attn_unit<64, 64, 64, 2>(c.lds, a);
    }
}
__device__ __forceinline__ void attn_odd_mla(const Ctx& c_, int l) {
    const Ctx c = make_ctx(c_.lds);
    KParams& P = kparams(); const bool need_ctx = l < 3;
    const bf16_t* MO = (const bf16_t*)(P.ws + WS_U + U_MLAO); bf16_t* MIX = (bf16_t*)(P.ws + WS_U + U_MIX);
    att::Args a;
    a.Q = MO; a.ldq = MLA_N; a.K = MO; a.ldk = MLA_N; a.V = MO; a.ldv = MLA_N; a.C = 0.10206207261596575f * LOG2E;
    a.rcos = (const float*)(P.ws + WS_ROPED); a.rsin = a.rcos + SEQ * 16; a.O = MIX; a.ldo = DM; a.g = 0; a.u0 = 0; a.rpb = nullptr; a.lam = 0.f; a.oscale = 1.f; a.subg = nullptr; a.nt_ctx = 4;
    const int nctxu = need_ctx ? 16 : 0, nu = nctxu + 512;
    for (int u = xcd_unit_base(); u < nu; u += gridDim.x) {
        int b, h;
        if (u < nctxu) { b = u >> 2; h = u & 3; a.q_row0 = NLAT + b * CTXL; a.nt_lat = 0; a.rope = 0; }
        else { const int v = u - nctxu; b = v >> 7; h = (v >> 5) & 3; a.q_row0 = b * SEQ + (v & 31) * 256; a.nt_lat = SEQ / 64; a.rope = 2; }
        a.qcol = h * 96; a.kcol = 384 + h * 96; a.vcol = 768 + h * 128; a.ocol = 512 + h * 128; a.kctx_row0 = NLAT + b * CTXL; a.klat_row0 = b * SEQ;
        att::attn_unit<96, 96, 128, 0>(c.lds, a);
    }
}

constexpr int N_PHASES = 2 + 2 * (7 + 9);
__global__ void __launch_bounds__(512, 2) fwd_kernel(Params prm) {
    extern __shared__ __attribute__((aligned(16))) unsigned char lds_raw[];
    LAS unsigned char* lds = (LAS unsigned char*)lds_raw;
    const Ctx c{lds, 0, 0, 0, 0, 0};
    for (int u = threadIdx.x; u < (LDS_BYTES - LDS_MISC) / 4; u += 512) ((LAS unsigned*)(lds + LDS_MISC))[u] = 0u;
    __syncthreads();
    XcdBarrier bar;
    { unsigned char* ws0 = kparams().ws; bar.bar = (unsigned*)(ws0 + WS_CTL) + CW_BAR; bar.x = 0; bar.st = nullptr;
#if !MK_PER_PHASE
      bar = xcd_barrier_post((unsigned*)(ws0 + WS_CTL) + CW_BAR, (volatile LAS unsigned*)(lds + LDS_MISC + 32));
#endif
    }
    int ph = 0;
#ifndef PMASK
#define PMASK 0xffffffffu
#endif
#define PM(b) ((PMASK >> (b)) & 1u)
#define PH_ON() (ph >= kparams().ph_lo && ph < kparams().ph_hi)
#define PH_END() do { if (ph >= kparams().ph_lo && ph + 1 < kparams().ph_hi) xcd_barrier(bar); ++ph; } while (0)
#define WSP(off) ((bf16_t*)(ws + (off)))
#define HB WSP(WS_HB)
#define PB WSP(WS_U + U_PB)
#define MIX WSP(WS_U + U_MIX)
#define YB WSP(WS_U + U_YB)
#define HID WSP(WS_U + U_HID)
#define YS WSP(WS_U + U_YS)
#define A2 WSP(WS_U + U_A2)
#define MO WSP(WS_U + U_MLAO)

    if (PM(0) && PH_ON()) for (int rep = 0; rep < DUPN(0); ++rep) { prologue0(c); __syncthreads(); }
    PH_END();
    if (PM(1) && PH_ON()) for (int rep = 0; rep < DUPN(1); ++rep) ew_first(c);
    PH_END();
    for (int lp = 0; lp < 2; ++lp) {
        {
            const int l = 2 * lp, i = lp; const int mtok = l < 3 ? MTOT : NLAT, nMt = mtok / 256;
            if (PM(2) && PH_ON()) for (int rep = 0; rep < DUPN(2); ++rep) { unsigned char* ws = kparams().ws; pg8::Gemm g{}; g.A = HB; g.lda = DM; g.Bt = (const unsigned char*)(ws + WS_WINE) + (size_t)i * EV_IN * DM * 2; g.K = DM; g.nM = MTOT / 256; g.nN = EV_IN / 256; g.grouped = 0; g.estride = 0;
                pg8::EpiEvenIn E{PB, EV_IN, (f32x2*)(ws + WS_STATS), (const float*)(ws + WS_ROPEB), (const float*)(ws + WS_ROPEB) + SEQ * 32, WIN8(l) ? F8_INV : 1.f}; if (WIN8(l)) gemm8_even_in(lds, g, E); else gemm_even_in(lds, g, E); if (rep == 0) convert_moe_tail(c, i, 0, 7296, (MTOT / 256) * (EV_IN / 256)); }
            PH_END();
            if (PM(4) && PH_ON()) for (int rep = 0; rep < DUPN(4); ++rep) attn_even(c, l);
            PH_END();
            if (PM(5) && PH_ON()) for (int rep = 0; rep < DUPN(5); ++rep) { unsigned char* ws = kparams().ws; pg8::Gemm g{}; g.A = MIX; g.lda = DM; g.Bt = (const bf16_t*)(ws + WS_WOUTE) + (size_t)i * DM * DM; g.K = DM; g.nM = nMt; g.nN = DM / 256; g.grouped = 0; g.estride = 0;
                gemm_bf16(lds, g, YB, DM); if (rep == 0) convert_moe_tail(c, i, 7296, 14592, nMt * (DM / 256)); }
            PH_END();
            if (PM(6) && PH_ON()) { if (DUPN(6) > 1) ew_mid(c, l, mtok, true); ew_mid(c, l, mtok); }
            PH_END();
            if (PM(7) && PH_ON()) for (int rep = 0; rep < DUPN(7); ++rep) { unsigned char* ws = kparams().ws; pg8::Gemm g{}; g.A = HB; g.lda = DM; g.Bt = (const unsigned char*)(ws + WS_W13E) + (size_t)i * 2 * DFF * DM * 2; g.K = DM; g.nM = nMt; g.nN = 2 * DFF / 256; g.grouped = 0; g.estride = 0;
                if (FFN8(i)) gemm8_swiglu8(lds, g, (unsigned char*)HID, DFF); else gemm_swiglu(lds, g, HID, DFF);
                if (rep == 0) convert_moe_tail(c, i, 14592, 20224, nMt * (2 * DFF / 256)); }
            PH_END();
            if (PM(8) && PH_ON()) for (int rep = 0; rep < DUPN(8); ++rep) { unsigned char* ws = kparams().ws; pg8::Gemm g{}; g.A = HID; g.lda = DFF; g.Bt = (const unsigned char*)(ws + WS_W2E) + (size_t)i * DM * DFF * 2; g.K = DFF; g.nM = nMt; g.nN = DM / 256; g.grouped = 0; g.estride = 0;
                if (FFN8(i)) gemm8_bf16(lds, g, YS, DM); else gemm_bf16(lds, g, YS, DM);
                if (rep == 0) convert_moe_tail(c, i, 20224, MOE_CVT_ITEMS, nMt * (DM / 256)); }
            PH_END();
            if (PM(9) && PH_ON()) { if (DUPN(9) > 1) ew_last(c, l, mtok, true); ew_last(c, l, mtok); }
            PH_END();
        }
        {
            const int l = 2 * lp + 1, i = lp; const int mtok = l < 3 ? MTOT : NLAT, nMt = mtok / 256;
            if (PM(10) && PH_ON()) for (int rep = 0; rep < DUPN(10); ++rep) { unsigned char* ws = kparams().ws; pg8::Gemm g{}; g.A = HB; g.lda = DM; g.Bt = (const unsigned char*)(ws + WS_WINO) + (size_t)i * OD_INP * DM * 2; g.K = DM; g.nM = MTOT / 256; g.nN = OD_INP / 256; g.grouped = 0; g.estride = 0;
                pg8::EpiOddIn E{PB, OD_INP, (float*)(ws + WS_STATS), (const float*)(ws + WS_ROPED), (const float*)(ws + WS_ROPED) + SEQ * 16, WIN8(l) ? F8_INV : 1.f}; if (WIN8(l)) gemm8_odd_in(lds, g, E); else gemm_odd_in(lds, g, E); }
            PH_END();
            if (PM(12) && PH_ON()) for (int rep = 0; rep < DUPN(12); ++rep) { unsigned char* ws = kparams().ws; pg8::Gemm g{}; g.A = PB + 1536; g.lda = OD_INP; g.Bt = (const bf16_t*)(ws + WS_WMLA) + (size_t)i * MLA_N * MLA_K; g.K = MLA_K; g.nM = MTOT / 256; g.nN = MLA_N / 256; g.grouped = 0; g.estride = 0;
                pg8::EpiMlaUp E{MO, MLA_N, (const float*)(ws + WS_STATS)}; gemm_mla_up(lds, g, E); }
            PH_END();
            if (PH_ON()) { if (PM(13)) for (int rep = 0; rep < DUPN(13); ++rep) attn_odd_na(c, l); if (PM(14)) for (int rep = 0; rep < DUPN(14); ++rep) attn_odd_mla(c, l); }
            PH_END();
            if (PM(15) && PH_ON()) for (int rep = 0; rep < DUPN(15); ++rep) { unsigned char* ws = kparams().ws; pg8::Gemm g{}; g.A = MIX; g.lda = DM; g.Bt = (const bf16_t*)(ws + WS_WOUTO) + (size_t)i * DM * DM; g.K = DM; g.nM = nMt; g.nN = DM / 256; g.grouped = 0; g.estride = 0;
                gemm_bf16(lds, g, YB, DM); }
            PH_END();
            if (PM(16) && PH_ON()) { if (DUPN(16) > 1) ew_mid(c, l, mtok, true); ew_mid(c, l, mtok); }
            PH_END();
            if (PM(17) && PH_ON()) for (int rep = 0; rep < DUPN(17); ++rep) moe_gather(c, i, mtok);
            PH_END();
            if (PM(18) && PH_ON()) for (int rep = 0; rep < DUPN(18); ++rep) { unsigned char* ws = kparams().ws; pg8::Gemm g{}; g.A = YS; g.lda = DM; g.Bt = (const bf16_t*)(ws + WS_W13M); g.K = DM; g.nN = 2 * DFFE / 256; g.grouped = 1; g.estride = (size_t)2 * DFFE * DM;
                moe_offsets(kparams(), i, g.toff); g.nM = g.toff[8];
#if MOE_F8
                gemm8_swiglu8(lds, g, (unsigned char*)HID, DFFE);
#else
                gemm_swiglu(lds, g, HID, DFFE);
#endif
            }
            PH_END();
            if (PM(19) && PH_ON()) for (int rep = 0; rep < DUPN(19); ++rep) { unsigned char* ws = kparams().ws; pg8::Gemm g{}; g.A = HID; g.lda = DFFE; g.Bt = (const bf16_t*)(ws + WS_W2M); g.K = DFFE; g.nN = DM / 256; g.grouped = 1; g.estride = (size_t)DM * DFFE;
                moe_offsets(kparams(), i, g.toff); g.nM = g.toff[8];
#if MOE_F8
                gemm8_bf16(lds, g, YS, DM);
#else
                gemm_bf16(lds, g, YS, DM);
#endif
            }
            PH_END();
            if (PM(20) && PH_ON()) { if (DUPN(20) > 1) ew_last(c, l, mtok, true); ew_last(c, l, mtok); }
            PH_END();
        }
    }
#undef PH_ON
#undef PH_END
#undef HB
#undef PB
#undef MIX
#undef YB
#undef HID
#undef YS
#undef A2
#undef MO
}

extern "C" void kernel_launch(void* const* d_in, const int* in_sizes, int n_in, void* d_out, int out_size, void* d_ws, size_t ws_size, hipStream_t stream) {
    static int grid = 0;
    if (grid == 0) {
        int dev = 0, cus = 0;
        if (n_in != 31 || out_size != NLAT * DM || ws_size < WS_END) { fprintf(stderr, "kernel_launch: unexpected shapes or workspace (n_in %d out %d ws %zu need %zu)\n", n_in, out_size, ws_size, (size_t)WS_END); grid = -1; }
        else if (hipGetDevice(&dev) != hipSuccess || hipDeviceGetAttribute(&cus, hipDeviceAttributeMultiprocessorCount, dev) != hipSuccess) grid = -1;
        else if (hipFuncSetAttribute((const void*)fwd_kernel, hipFuncAttributeMaxDynamicSharedMemorySize, LDS_BYTES) != hipSuccess) grid = -1;
        else { int per_cu = 0; (void)hipOccupancyMaxActiveBlocksPerMultiprocessor(&per_cu, (const void*)fwd_kernel, 512, LDS_BYTES); (void)hipGetLastError(); grid = cus; }
    }
    if (grid < 0) { (void)hipMemsetAsync(d_out, 0, (size_t)out_size * 4, stream); return; }
    (void)hipMemsetAsync((char*)d_ws + WS_CTL, 0, CTL_BYTES, stream);
    Params p{};
    for (int i = 0; i < 31; ++i) p.in[i] = (const float*)d_in[i];
    p.out = (float*)d_out; p.ws = (unsigned char*)d_ws;
#if MK_PER_PHASE
    for (int k = 0; k < N_PHASES; ++k) { p.ph_lo = k; p.ph_hi = k + 1; hipLaunchKernelGGL(fwd_kernel, dim3(grid), dim3(512), LDS_BYTES, stream, p); }
#else
    p.ph_lo = 0; p.ph_hi = N_PHASES;
    hipLaunchKernelGGL(fwd_kernel, dim3(grid), dim3(512), LDS_BYTES, stream, p);
#endif
}
```

```cpp
#include <hip/hip_runtime.h>
#include <stdint.h>
#include <stdio.h>

#ifndef MK_PER_PHASE
#define MK_PER_PHASE 0
#endif
#ifndef DUP_MASK
#define DUP_MASK 0u
#endif
#define DUPN(b) (1 + (int)((DUP_MASK >> (b)) & 1u))
#ifndef FFN_F8
#define FFN_F8 1
#endif
#ifndef FFN_F8_FROM
#define FFN_F8_FROM 1
#endif
#define FFN8(i) (FFN_F8 && (i) >= FFN_F8_FROM)
#ifndef WIN_F8_FROM
#define WIN_F8_FROM 2
#endif
#define WIN8(l) ((l) >= WIN_F8_FROM)
#ifndef MOE_F8
#define MOE_F8 1
#endif

#define LAS __attribute__((address_space(3)))
typedef unsigned short bf16_t;
typedef short bf16x8 __attribute__((ext_vector_type(8)));
typedef short s16x4 __attribute__((ext_vector_type(4)));
typedef float f32x4 __attribute__((ext_vector_type(4)));
typedef float f32x2 __attribute__((ext_vector_type(2)));
typedef float f32x16 __attribute__((ext_vector_type(16)));
typedef unsigned u32x4 __attribute__((ext_vector_type(4)));
typedef unsigned u32x2 __attribute__((ext_vector_type(2)));

constexpr int DM = 1024, NB = 4, SEQ = 8192, NLAT = NB * SEQ, CTXL = 256, NCTX = NB * CTXL, MTOT = NLAT + NCTX;
constexpr int NMOD = 6;
constexpr int EV_IN = 2560, OD_IN = 1952, OD_INP = 2048, DFF = 2816, DFFE = 3584, NEXP = 8;
constexpr int MLA_N = 1280, MLA_K = 512;
constexpr int MS_MAX = 2 * MTOT + NEXP * 256;
constexpr float EPS = 1e-6f;
constexpr float LOG2E = 1.4426950408889634f;

constexpr size_t MiB = (size_t)1 << 20;
constexpr size_t WS_CTL = 0, CTL_BYTES = MiB;
constexpr size_t WS_MODS = 1 * MiB;
constexpr size_t WS_ROPEB = 2 * MiB;
constexpr size_t WS_ROPED = 4 * MiB;
constexpr size_t WS_SGUW = 5 * MiB;
constexpr size_t WS_TOKINFO = 6 * MiB;
constexpr size_t WS_TOKPOS = 8 * MiB;
constexpr size_t WS_CTXX = 10 * MiB;
constexpr size_t WS_WMLA = 14 * MiB;
constexpr size_t WS_WINE = 17 * MiB;
constexpr size_t WS_WOUTE = 27 * MiB;
constexpr size_t WS_W13E = 31 * MiB;
constexpr size_t WS_W2E = 53 * MiB;
constexpr size_t WS_WINO = 64 * MiB;
constexpr size_t WS_WOUTO = 72 * MiB;
constexpr size_t WS_W13M = 76 * MiB;
constexpr size_t WS_W2M = 188 * MiB;
constexpr size_t WS_HB = 244 * MiB;
constexpr size_t WS_U = 310 * MiB;
constexpr size_t U_PB = 0;
constexpr size_t U_MIX = 165 * MiB;
constexpr size_t U_A2 = 231 * MiB;
constexpr size_t U_MLAO = 264 * MiB;
constexpr size_t U_YB = 347 * MiB;
constexpr size_t U_HID = 0;
constexpr size_t U_XB = 549 * MiB;
constexpr size_t U_YS = 413 * MiB;
constexpr size_t WS_STATS = WS_U + 616 * MiB;
constexpr size_t WS_END = WS_STATS + 4 * MiB;
static_assert((size_t)MS_MAX * DFFE * (MOE_F8 ? 1 : 2) <= 347 * MiB && (size_t)MTOT * DFF * 2 <= 347 * MiB, "hid must stay clear of YB");
static_assert(U_YS + (size_t)MS_MAX * DM * 2 <= U_XB && U_XB + (size_t)MTOT * DM * 2 <= 616 * MiB, "ys / xb fit");

constexpr int CW_BAR = 4096;
constexpr int CW_MOECNT = 1024;

constexpr int LDS_BYTES = 147456;
constexpr int LDS_MISC = 131072;

__device__ __forceinline__ unsigned cvtpk(float lo, float hi) { unsigned r; asm volatile("v_cvt_pk_bf16_f32 %0, %1, %2" : "=v"(r) : "v"(lo), "v"(hi)); return r; }
__device__ __forceinline__ float bf2f(unsigned short b) { return __uint_as_float(((unsigned)b) << 16); }
__device__ __forceinline__ float bflo(unsigned w) { return __uint_as_float(w << 16); }
__device__ __forceinline__ float bfhi(unsigned w) { return __uint_as_float(w & 0xffff0000u); }
__device__ __forceinline__ bf16_t f2bf(float f) { return (bf16_t)(cvtpk(f, 0.f) & 0xffffu); }
typedef int i32x8 __attribute__((ext_vector_type(8)));
typedef int i32x4 __attribute__((ext_vector_type(4)));
constexpr float F8_ACT_SCALE = 4.f, F8_W_SCALE = 64.f, F8_INV = 1.f / (F8_ACT_SCALE * F8_W_SCALE);
__device__ __forceinline__ unsigned pk4_fp8(float a, float b, float c, float d) {
    a = __builtin_amdgcn_fmed3f(a, -448.f, 448.f); b = __builtin_amdgcn_fmed3f(b, -448.f, 448.f); c = __builtin_amdgcn_fmed3f(c, -448.f, 448.f); d = __builtin_amdgcn_fmed3f(d, -448.f, 448.f);
    int w = 0; w = __builtin_amdgcn_cvt_pk_fp8_f32(a, b, w, false); w = __builtin_amdgcn_cvt_pk_fp8_f32(c, d, w, true); return (unsigned)w; }
__device__ __forceinline__ float wave_sum(float v) {
#pragma unroll
    for (int o = 1; o < 64; o <<= 1) v += __shfl_xor(v, o);
    return v;
}
__device__ __forceinline__ float fast_exp2(float x) { return __builtin_amdgcn_exp2f(x); }
__device__ __forceinline__ float fast_rcp(float x) { return __builtin_amdgcn_rcpf(x); }
__device__ __forceinline__ float silu_f(float x) { return x * fast_rcp(1.f + fast_exp2(-x * LOG2E)); }
__device__ __forceinline__ float gelu_tanh_f(float x) { const float u = 0.7978845608028654f * (x + 0.044715f * x * x * x); return x * fast_rcp(1.f + fast_exp2(-2.f * LOG2E * u)); }
#define LDS_WAIT() asm volatile("s_waitcnt lgkmcnt(0)" ::: "memory")
#define VM_WAIT() asm volatile("s_waitcnt vmcnt(0)" ::: "memory")
__device__ __forceinline__ int opaque_bid() { int b = blockIdx.x; asm volatile("" : "+s"(b)); return b; }
__device__ __forceinline__ int xcd_unit_base() { const int b = opaque_bid(), G = (int)gridDim.x; return (G % 8 == 0) ? (b & 7) * (G >> 3) + (b >> 3) : b; }
__device__ __forceinline__ int opaque_tid() { int t = threadIdx.x; asm volatile("" : "+v"(t)); return t; }

#define XB_TMO      128
#define XB_XCNT(j)  (256  + 64 * (j))
#define XB_XSUB(j)  (1280 + 64 * (j))
#define XB_XGEN(j)  (2304 + 64 * (j))
#define XB_TOP      3328
#define XB_TOPGEN   3392
#define XCD_BAR_WORDS 3456
#define XB_SPIN_CAP (1u << 22)
__device__ __forceinline__ unsigned xb_ld(unsigned* p)              { return __hip_atomic_load(p, __ATOMIC_RELAXED, __HIP_MEMORY_SCOPE_AGENT); }
__device__ __forceinline__ unsigned xb_add(unsigned* p, unsigned v) { return __hip_atomic_fetch_add(p, v, __ATOMIC_RELAXED, __HIP_MEMORY_SCOPE_AGENT); }
__device__ __forceinline__ unsigned xb_xcc_id() { return (unsigned)__builtin_amdgcn_s_getreg((3 << 11) | 20) & 0xFu; }
#define XB_SPIN(cond, bar) do { unsigned _sp = 0; while (cond) { __builtin_amdgcn_s_sleep(1); \
    if ((++_sp & 255u) == 0u) { if (xb_ld(&(bar)[XB_TMO])) break; if (_sp > XB_SPIN_CAP) { atomicAdd(&(bar)[XB_TMO], 1u); break; } } } } while (0)
struct XcdBarrier { unsigned* bar; unsigned x; volatile LAS unsigned* st; };
__device__ __forceinline__ XcdBarrier xcd_barrier_post(unsigned* bar, volatile LAS unsigned* st) {
    XcdBarrier b; b.bar = bar; b.x = xb_xcc_id(); b.st = st;
    if (threadIdx.x == 0) (void)xb_add(&bar[XB_XCNT(b.x)], 1u);
    return b;
}
__device__ __forceinline__ void xcd_barrier_complete(unsigned* bar, unsigned x, unsigned& nloc, unsigned& nx) {
    const unsigned G = gridDim.x * gridDim.y * gridDim.z;
    unsigned sum, cnt, mine, sp = 0u;
    for (;;) {
        sum = 0u; cnt = 0u; mine = 0u;
#pragma unroll
        for (unsigned j = 0; j < 16; ++j) { const unsigned c = xb_ld(&bar[XB_XCNT(j)]); sum += c; cnt += (c > 0u) ? 1u : 0u; mine = (j == x) ? c : mine; }
        if (sum == G) break;
        __builtin_amdgcn_s_sleep(1);
        if ((++sp & 255u) == 0u) { if (xb_ld(&bar[XB_TMO])) break; if (sp > XB_SPIN_CAP) { atomicAdd(&bar[XB_TMO], 1u); break; } }
    }
    nloc = mine > 0u ? mine : 1u; nx = cnt > 0u ? cnt : 1u;
}
__device__ __forceinline__ void xcd_barrier(const XcdBarrier& b) {
    asm volatile("s_waitcnt vmcnt(0)" ::: "memory");
    __syncthreads();
    if (threadIdx.x == 0) {
        unsigned* bar = b.bar;
        __builtin_amdgcn_s_waitcnt(0);
        unsigned nloc = b.st[0], nx = b.st[1];
        if (nloc == 0u) { xcd_barrier_complete(bar, b.x, nloc, nx); b.st[0] = nloc; b.st[1] = nx; }
        const unsigned old = xb_add(&bar[XB_XSUB(b.x)], 1u);
        const unsigned gen = old / nloc;
        if (old + 1u == (gen + 1u) * nloc) {
            __builtin_amdgcn_fence(__ATOMIC_RELEASE, "agent");
            asm volatile("s_waitcnt vmcnt(0)" ::: "memory");
            const unsigned og = xb_add(&bar[XB_TOP], 1u);
            const unsigned tg = og / nx;
            if (og + 1u == (tg + 1u) * nx) xb_add(&bar[XB_TOPGEN], 1u);
            else XB_SPIN(xb_ld(&bar[XB_TOPGEN]) == tg, bar);
            __builtin_amdgcn_fence(__ATOMIC_ACQUIRE, "agent");
            xb_add(&bar[XB_XGEN(b.x)], 1u);
            asm volatile("s_waitcnt vmcnt(0)" ::: "memory");
        } else {
            XB_SPIN(xb_ld(&bar[XB_XGEN(b.x)]) == gen, bar);
            __builtin_amdgcn_fence(__ATOMIC_ACQUIRE, "agent");
            asm volatile("s_waitcnt vmcnt(0)" ::: "memory");
        }
    }
    __syncthreads();
}

namespace pg8 {
constexpr int BM = 256, BK = 64, HALF = 128, HTB = HALF * BK * 2, STAGE_BYTES = 8 * HTB, NXCD = 8, WGM = 4;
__device__ __forceinline__ int lds_byte(int r, int c) { const int st = (r >> 4) * 2 + (c >> 5), rr = r & 15, cc = c & 31, ob = rr * 64 + cc * 2; return st * 1024 + (ob ^ (((ob >> 9) & 1) << 5)); }
__device__ __forceinline__ void stage_rc(int b, int& R, int& C) { const int st = b / 1024, sb = b % 1024, swz = sb ^ (((sb >> 9) & 1) << 5); R = (st >> 1) * 16 + swz / 64; C = (st & 1) * 32 + (swz % 64) / 2; }
__device__ __forceinline__ int perm32(int rho) { const int n = rho >> 4, i = rho & 15; return 8 * (i >> 2) + 4 * n + (i & 3); }
struct Unit { int pm, pn, e; };
struct Gemm {
    const void* A; int lda;
    const void* Bt; int K;
    int nM, nN;
    int grouped; int toff[9]; size_t estride;
};
struct StaticOrder {
    int nM, nN, nwg, G, c;
    __device__ void init(int nM_, int nN_, int G_, int c_) { nM = nM_; nN = nN_; nwg = nM * nN; G = G_; c = c_; }
    __device__ __forceinline__ bool next(int i, Unit& u) const {
        const long L = (long)i * G + c; if (L >= nwg) return false;
        int wgid = (int)L; { const int q = nwg / NXCD, r = nwg % NXCD, xcd = wgid % NXCD, off = wgid / NXCD; wgid = (xcd < r ? xcd * (q + 1) : r * (q + 1) + (xcd - r) * q) + off; }
        const int nig = WGM * nN, gid = wgid / nig, fm = gid * WGM, gsz = (nM - fm) < WGM ? (nM - fm) : WGM;
        u.pm = fm + ((wgid % nig) % gsz); u.pn = (wgid % nig) / gsz; u.e = 0; return true;
    }
};
struct EpiBf16 {
    bf16_t* O; int ldc; float scale;
    __device__ __forceinline__ void operator()(const f32x4 (&acc)[2][2][4][2], const Unit& u, int wr, int wc, int fr, int fq) const {
        const int row0 = u.pm * BM + wr * 64 + fr, col0 = u.pn * BM + wc * 32 + 8 * fq;
#pragma unroll
        for (int ai = 0; ai < 2; ++ai)
#pragma unroll
            for (int m = 0; m < 4; ++m) { bf16_t* rowp = O + (size_t)(row0 + ai * HALF + m * 16) * ldc + col0;
#pragma unroll
                for (int bj = 0; bj < 2; ++bj) { const f32x4 v0 = acc[ai][bj][m][0] * scale, v1 = acc[ai][bj][m][1] * scale;
                    u32x4 w; w.x = cvtpk(v0[0], v0[1]); w.y = cvtpk(v0[2], v0[3]); w.z = cvtpk(v1[0], v1[1]); w.w = cvtpk(v1[2], v1[3]);
                    *(u32x4*)(rowp + bj * HALF) = w; } }
    }
};
__device__ __forceinline__ f32x4 swiglu4(f32x4 a, f32x4 b, float k1, float k2) {
    const f32x4 t = a * k1; f32x4 d;
#pragma unroll
    for (int j = 0; j < 4; ++j) d[j] = fast_exp2(t[j]);
    d = d + 1.f; f32x4 r;
#pragma unroll
    for (int j = 0; j < 4; ++j) r[j] = fast_rcp(d[j]);
    return (a * b) * (r * k2);
}
struct EpiSwiGLU {
    bf16_t* O; int ldc;
    __device__ __forceinline__ void operator()(const f32x4 (&acc)[2][2][4][2], const Unit& u, int wr, int wc, int fr, int fq) const {
        const int row0 = u.pm * BM + wr * 64 + fr, col0 = u.pn * HALF + wc * 32 + 8 * fq;
#pragma unroll
        for (int ai = 0; ai < 2; ++ai)
#pragma unroll
            for (int m = 0; m < 4; ++m) { bf16_t* rowp = O + (size_t)(row0 + ai * HALF + m * 16) * ldc + col0;
                const f32x4 r0 = swiglu4(acc[ai][0][m][0], acc[ai][1][m][0], -LOG2E, 1.f), r1 = swiglu4(acc[ai][0][m][1], acc[ai][1][m][1], -LOG2E, 1.f);
                u32x4 w; w.x = cvtpk(r0[0], r0[1]); w.y = cvtpk(r0[2], r0[3]); w.z = cvtpk(r1[0], r1[1]); w.w = cvtpk(r1[2], r1[3]);
                *(u32x4*)rowp = w; }
    }
};

struct EpiEvenIn {
    bf16_t* O; int ldc; f32x2* stats; const float* rcos; const float* rsin; float scale;
    __device__ __forceinline__ void operator()(const f32x4 (&acc)[2][2][4][2], const Unit& u, int wr, int wc, int fr, int fq) const {
        int upm = u.pm, upn = u.pn; asm volatile("" : "+s"(upm), "+s"(upn));
        const int row0 = upm * BM + wr * 64 + fr, col0 = upn * BM + wc * 32 + 8 * fq;
        const int kind = upn < 2 ? 0 : (upn < 4 ? 1 : (upn < 8 ? 2 : 3)); const bool lat = upm < NLAT / BM; const int t4 = 4 * (4 * (wc & 1) + fq);
#pragma unroll
        for (int ai = 0; ai < 2; ++ai)
#pragma unroll
            for (int m = 0; m < 4; ++m) { const int row = row0 + ai * HALF + m * 16; bf16_t* rowp = O + (size_t)row * ldc + col0;
                f32x4 cs = {1.f, 1.f, 1.f, 1.f}, sn = {0.f, 0.f, 0.f, 0.f}; float s1 = 0.f, s2 = 0.f;
                if (kind == 2 && lat) { const int sp = row & (SEQ - 1); cs = *(const f32x4*)(rcos + sp * 32 + t4); sn = *(const f32x4*)(rsin + sp * 32 + t4); }
#pragma unroll
                for (int bj = 0; bj < 2; ++bj) { f32x4 v0 = acc[ai][bj][m][0] * scale, v1 = acc[ai][bj][m][1] * scale;
                    if (kind < 2) {
#pragma unroll
                        for (int j = 0; j < 4; ++j) { v0[j] = gelu_tanh_f(v0[j]); v1[j] = gelu_tanh_f(v1[j]); }
                        if (kind == 1) { s1 += (v0[0] + v0[1]) + (v0[2] + v0[3]) + (v1[0] + v1[1]) + (v1[2] + v1[3]);
                            s2 += (v0[0] * v0[0] + v0[1] * v0[1]) + (v0[2] * v0[2] + v0[3] * v0[3]) + (v1[0] * v1[0] + v1[1] * v1[1]) + (v1[2] * v1[2] + v1[3] * v1[3]); } }
                    else if (kind == 2) { const f32x4 o0 = v0 * cs - v1 * sn, o1 = v1 * cs + v0 * sn; v0 = o0; v1 = o1; }
                    u32x4 w; w.x = cvtpk(v0[0], v0[1]); w.y = cvtpk(v0[2], v0[3]); w.z = cvtpk(v1[0], v1[1]); w.w = cvtpk(v1[2], v1[3]);
                    *(u32x4*)(rowp + bj * HALF) = w; }
                if (kind == 1) { s1 += __shfl_xor(s1, 16); s1 += __shfl_xor(s1, 32); s2 += __shfl_xor(s2, 16); s2 += __shfl_xor(s2, 32);
                    if (fq == 0) stats[(size_t)row * 8 + (upn - 2) * 4 + wc] = (f32x2){s1, s2}; } }
    }
};
struct EpiOddIn {
    bf16_t* O; int ldc; float* stats; const float* rcos; const float* rsin; float scale;
    __device__ __forceinline__ void operator()(const f32x4 (&acc)[2][2][4][2], const Unit& u, int wr, int wc, int fr, int fq) const {
        int upm = u.pm, upn = u.pn; asm volatile("" : "+s"(upm), "+s"(upn));
        const int row0 = upm * BM + wr * 64 + fr, col0 = upn * BM + wc * 32 + 8 * fq; const bool lat = upm < NLAT / BM;
#pragma unroll
        for (int ai = 0; ai < 2; ++ai)
#pragma unroll
            for (int m = 0; m < 4; ++m) { const int row = row0 + ai * HALF + m * 16; bf16_t* rowp = O + (size_t)row * ldc + col0; float ss = 0.f;
#pragma unroll
                for (int bj = 0; bj < 2; ++bj) { f32x4 v0 = acc[ai][bj][m][0] * scale, v1 = acc[ai][bj][m][1] * scale;
                    if (upn == 6 || (upn == 7 && bj == 0)) ss += (v0[0] * v0[0] + v0[1] * v0[1]) + (v0[2] * v0[2] + v0[3] * v0[3]) + (v1[0] * v1[0] + v1[1] * v1[1]) + (v1[2] * v1[2] + v1[3] * v1[3]);
                    if (upn == 7 && bj == 1 && wc == 0 && lat) { const int sp = row & (SEQ - 1); const f32x4 cs = *(const f32x4*)(rcos + sp * 16 + 4 * fq), sn = *(const f32x4*)(rsin + sp * 16 + 4 * fq);
                        const f32x4 o0 = v0 * cs - v1 * sn, o1 = v1 * cs + v0 * sn; v0 = o0; v1 = o1; }
                    u32x4 w; w.x = cvtpk(v0[0], v0[1]); w.y = cvtpk(v0[2], v0[3]); w.z = cvtpk(v1[0], v1[1]); w.w = cvtpk(v1[2], v1[3]);
                    *(u32x4*)(rowp + bj * HALF) = w; }
                if (upn >= 6) { ss += __shfl_xor(ss, 16); ss += __shfl_xor(ss, 32); if (fq == 0) stats[(size_t)row * 8 + (upn - 6) * 4 + wc] = ss; } }
    }
};
struct EpiMlaUp {
    bf16_t* O; int ldc; const float* stats;
    __device__ __forceinline__ void operator()(const f32x4 (&acc)[2][2][4][2], const Unit& u, int wr, int wc, int fr, int fq) const {
        const int row0 = u.pm * BM + wr * 64 + fr, col0 = u.pn * BM + wc * 32 + 8 * fq;
#pragma unroll
        for (int ai = 0; ai < 2; ++ai)
#pragma unroll
            for (int m = 0; m < 4; ++m) { const int row = row0 + ai * HALF + m * 16; bf16_t* rowp = O + (size_t)row * ldc + col0;
                const f32x4 pq = *(const f32x4*)(stats + (size_t)row * 8), pk = *(const f32x4*)(stats + (size_t)row * 8 + 4);
                const float rq = rsqrtf(((pq[0] + pq[1]) + (pq[2] + pq[3])) * (1.f / 256.f) + EPS), rk = rsqrtf(((pk[0] + pk[1]) + (pk[2] + pk[3])) * (1.f / 128.f) + EPS);
#pragma unroll
                for (int bj = 0; bj < 2; ++bj) { const int c0 = col0 + bj * HALF; const float sc = c0 < 384 ? rq : (c0 < 768 ? (((c0 - 384) % 96) < 64 ? rk : 1.f) : rk);
                    const f32x4 v0 = acc[ai][bj][m][0] * sc, v1 = acc[ai][bj][m][1] * sc;
                    u32x4 w; w.x = cvtpk(v0[0], v0[1]); w.y = cvtpk(v0[2], v0[3]); w.z = cvtpk(v1[0], v1[1]); w.w = cvtpk(v1[2], v1[3]);
                    *(u32x4*)(rowp + bj * HALF) = w; } }
    }
};
struct EpiSwiGLU8 {
    unsigned char* O; int ldc; float scale;
    __device__ __forceinline__ void operator()(const f32x4 (&acc)[2][2][4][2], const Unit& u, int wr, int wc, int fr, int fq) const {
        const int row0 = u.pm * BM + wr * 64 + fr, col0 = u.pn * HALF + wc * 32 + 8 * fq;
#pragma unroll
        for (int ai = 0; ai < 2; ++ai)
#pragma unroll
            for (int m = 0; m < 4; ++m) { unsigned char* rowp = O + (size_t)(row0 + ai * HALF + m * 16) * ldc + col0;
                const float k1 = -LOG2E * scale, k2 = F8_ACT_SCALE * scale * scale;
                const f32x4 r0 = swiglu4(acc[ai][0][m][0], acc[ai][1][m][0], k1, k2), r1 = swiglu4(acc[ai][0][m][1], acc[ai][1][m][1], k1, k2);
                u32x2 w; w.x = pk4_fp8(r0[0], r0[1], r0[2], r0[3]); w.y = pk4_fp8(r1[0], r1[1], r1[2], r1[3]);
                *(u32x2*)rowp = w; }
    }
};

template <class Epi, bool F8 = false>
__device__ __forceinline__ void gemm_phase(LAS unsigned char* lds, const Gemm& g, const Epi& E) {
    const int tid = opaque_tid(), wid = __builtin_amdgcn_readfirstlane(tid >> 6), lane = tid & 63, wr = wid >> 2, wc = wid & 3, fr = lane & 15, fq = lane >> 4;
    constexpr int ES = F8 ? 1 : 2;
    const int K = g.K, nt = K * ES / (BK * 2), lda = g.lda;
    StaticOrder S; S.init(g.nM, g.nN, (int)gridDim.x, opaque_bid());
    unsigned voffA[2], voffB[2];
#pragma unroll
    for (int i = 0; i < 2; ++i) { int R, C; stage_rc(tid * 16 + i * 8192, R, C); const int Rb = (R & ~31) + perm32(R & 31);
        voffA[i] = (unsigned)(R * lda * ES + C * 2); voffB[i] = (unsigned)(Rb * K * ES + C * 2); }
    const size_t kstep = (size_t)(BK * 2);
    const size_t hA = (size_t)HALF * lda * ES, tA = 2 * hA, hB = (size_t)HALF * K * ES, tB = 2 * hB;
    const unsigned ldsw = (unsigned)wid * 1024u;
    const int aoff = lds_byte(wr * 64 + fr, fq * 8), boff = lds_byte(wc * 32 + fr, fq * 8);
#define PG8_SA(b, h) (((b) * 2 + (h)) * HTB)
#define PG8_SB(b, h) ((4 + (b) * 2 + (h)) * HTB)
#define PG8_STAGE(bufoff, gbase, voff) do { _Pragma("unroll") for (int _i = 0; _i < 2; ++_i) \
        __builtin_amdgcn_global_load_lds((const unsigned*)((const char*)(gbase) + (voff)[_i]), (LAS unsigned*)(lds + (bufoff) + ldsw + _i * 8192), 16, 0, 0); } while (0)
#define PG8_LD8(base) __builtin_shufflevector(*(const LAS i32x4*)(base), *(const LAS i32x4*)((base) + 1024), 0, 1, 2, 3, 4, 5, 6, 7)
#define PG8_LDA(dst, b, h) do { _Pragma("unroll") for (int m = 0; m < 4; ++m) dst[m] = PG8_LD8(lds + PG8_SA(b, h) + aoff + m * 2048); } while (0)
#define PG8_LDB(dst, b, h) do { _Pragma("unroll") for (int n = 0; n < 2; ++n) dst[n] = PG8_LD8(lds + PG8_SB(b, h) + boff + n * 2048); } while (0)
#define PG8_H0(x) __builtin_bit_cast(bf16x8, __builtin_shufflevector(x, x, 0, 1, 2, 3))
#define PG8_H1(x) __builtin_bit_cast(bf16x8, __builtin_shufflevector(x, x, 4, 5, 6, 7))
#define PG8_MMA(ai, bj, At, Bt) do { __builtin_amdgcn_s_setprio(1); _Pragma("unroll") for (int m = 0; m < 4; ++m) _Pragma("unroll") for (int n = 0; n < 2; ++n) { \
        if constexpr (F8) asm volatile("v_mfma_f32_16x16x128_f8f6f4 %0, %1, %2, %0" : "+v"(acc[ai][bj][m][n]) : "v"(Bt[n]), "v"(At[m])); \
        else { acc[ai][bj][m][n] = __builtin_amdgcn_mfma_f32_16x16x32_bf16(PG8_H0(Bt[n]), PG8_H0(At[m]), acc[ai][bj][m][n], 0, 0, 0); \
               acc[ai][bj][m][n] = __builtin_amdgcn_mfma_f32_16x16x32_bf16(PG8_H1(Bt[n]), PG8_H1(At[m]), acc[ai][bj][m][n], 0, 0, 0); } } \
        __builtin_amdgcn_s_setprio(0); } while (0)
#define PG8_WAIT_V(n) asm volatile("s_waitcnt vmcnt(" #n ")" ::: "memory")
#define PG8_WAIT_L(n) asm volatile("s_waitcnt lgkmcnt(" #n ")" ::: "memory")
#define PG8_BAR __builtin_amdgcn_s_barrier()
#define PG8_SCHED __builtin_amdgcn_sched_barrier(0)
#define PG8_EXPERT(u) do { if (g.grouped) { int _e = 0; _Pragma("unroll") for (int _k = 1; _k < 8; ++_k) _e += ((u).pm >= g.toff[_k]) ? 1 : 0; (u).e = _e; } } while (0)
    Unit cur, nxt; int ui = 0;
    if (!S.next(0, cur)) return;
    PG8_EXPERT(cur);
    f32x4 acc[2][2][4][2];
#pragma unroll
    for (int a = 0; a < 2; ++a)
#pragma unroll
        for (int b = 0; b < 2; ++b)
#pragma unroll
            for (int m = 0; m < 4; ++m)
#pragma unroll
                for (int n = 0; n < 2; ++n) acc[a][b][m][n] = (f32x4){0.f, 0.f, 0.f, 0.f};
    i32x8 At[4], B0[2], B1[2];
    const char* cA = (const char*)g.A + (size_t)cur.pm * tA; const char* cB = ((const char*)g.Bt + (size_t)cur.e * g.estride * ES) + (size_t)cur.pn * tB;
    PG8_STAGE(PG8_SB(0, 0), cB, voffB); PG8_STAGE(PG8_SA(0, 0), cA, voffA); PG8_STAGE(PG8_SB(0, 1), cB + hB, voffB); PG8_STAGE(PG8_SA(0, 1), cA + hA, voffA);
    if (wr == 1) PG8_BAR;
    PG8_WAIT_V(4); PG8_BAR;
    PG8_STAGE(PG8_SB(1, 0), cB + kstep, voffB); PG8_STAGE(PG8_SA(1, 0), cA + kstep, voffA); PG8_STAGE(PG8_SB(1, 1), cB + hB + kstep, voffB);
    PG8_WAIT_V(6); PG8_BAR;
    for (;;) {
        const bool has_next = S.next(ui + 1, nxt);
        if (has_next) PG8_EXPERT(nxt);
        const char* nA = has_next ? (const char*)g.A + (size_t)nxt.pm * tA : cA; const char* nB = has_next ? ((const char*)g.Bt + (size_t)nxt.e * g.estride * ES) + (size_t)nxt.pn * tB : cB;
        for (int t = 0; t < nt; t += 2) {
            const bool last = (t == nt - 2);
            const char* a1 = cA + (size_t)(t + 1) * kstep;
            const char* a2 = last ? nA : cA + (size_t)(t + 2) * kstep; const char* b2 = last ? nB : cB + (size_t)(t + 2) * kstep;
            const char* a3 = a2 + kstep; const char* b3 = b2 + kstep;
            PG8_LDB(B0, 0, 0); PG8_SCHED; PG8_LDA(At, 0, 0); PG8_STAGE(PG8_SA(1, 1), a1 + hA, voffA);
            PG8_WAIT_L(8); PG8_BAR; PG8_WAIT_L(0); PG8_MMA(0, 0, At, B0); PG8_BAR; PG8_SCHED;
            PG8_LDB(B1, 0, 1); PG8_STAGE(PG8_SB(0, 0), b2, voffB);
            PG8_BAR; PG8_WAIT_L(0); PG8_MMA(0, 1, At, B1); PG8_BAR;
            PG8_LDA(At, 0, 1); PG8_STAGE(PG8_SA(0, 0), a2, voffA);
            PG8_BAR; PG8_WAIT_L(0); PG8_MMA(1, 0, At, B0); PG8_BAR; PG8_SCHED;
            PG8_STAGE(PG8_SB(0, 1), b2 + hB, voffB);
            PG8_WAIT_V(6); PG8_BAR; PG8_MMA(1, 1, At, B1); PG8_BAR;
            PG8_LDB(B0, 1, 0); PG8_SCHED; PG8_LDA(At, 1, 0); PG8_STAGE(PG8_SA(0, 1), a2 + hA, voffA);
            PG8_WAIT_L(8); PG8_BAR; PG8_WAIT_L(0); PG8_MMA(0, 0, At, B0); PG8_BAR; PG8_SCHED;
            PG8_LDB(B1, 1, 1); PG8_STAGE(PG8_SB(1, 0), b3, voffB);
            PG8_BAR; PG8_WAIT_L(0); PG8_MMA(0, 1, At, B1); PG8_BAR;
            PG8_LDA(At, 1, 1); PG8_STAGE(PG8_SA(1, 0), a3, voffA);
            PG8_BAR; PG8_WAIT_L(0); PG8_MMA(1, 0, At, B0); PG8_BAR; PG8_SCHED;
            PG8_STAGE(PG8_SB(1, 1), b3 + hB, voffB);
            PG8_WAIT_V(6); PG8_BAR; PG8_MMA(1, 1, At, B1); PG8_BAR;
        }
        if constexpr (F8) asm volatile("s_nop 15\n\ts_nop 15" ::: "memory");
        E(acc, cur, wr, wc, fr, fq);
        if (!has_next) break;
#pragma unroll
        for (int a = 0; a < 2; ++a)
#pragma unroll
            for (int b = 0; b < 2; ++b)
#pragma unroll
                for (int m = 0; m < 4; ++m)
#pragma unroll
                    for (int n = 0; n < 2; ++n) acc[a][b][m][n] = (f32x4){0.f, 0.f, 0.f, 0.f};
        cur = nxt; cA = nA; cB = nB; ++ui;
    }
    PG8_WAIT_V(0);
    if (wr == 0) PG8_BAR;
    PG8_BAR;
#undef PG8_SA
#undef PG8_SB
#undef PG8_STAGE
#undef PG8_LDA
#undef PG8_LDB
#undef PG8_MMA
#undef PG8_H0
#undef PG8_H1
#undef PG8_LD8
#undef PG8_WAIT_V
#undef PG8_WAIT_L
#undef PG8_BAR
#undef PG8_SCHED
#undef PG8_EXPERT
}
}

__device__ __forceinline__ void gemm_bf16(LAS unsigned char* lds, const pg8::Gemm& g, bf16_t* O, int ldc) { pg8::EpiBf16 E{O, ldc, 1.f}; pg8::gemm_phase(lds, g, E); }
__device__ __forceinline__ void gemm_even_in(LAS unsigned char* lds, const pg8::Gemm& g, const pg8::EpiEvenIn& E) { pg8::gemm_phase(lds, g, E); }
__device__ __forceinline__ void gemm8_even_in(LAS unsigned char* lds, const pg8::Gemm& g, const pg8::EpiEvenIn& E) { pg8::gemm_phase<pg8::EpiEvenIn, true>(lds, g, E); }
__device__ __forceinline__ void gemm8_odd_in(LAS unsigned char* lds, const pg8::Gemm& g, const pg8::EpiOddIn& E) { pg8::gemm_phase<pg8::EpiOddIn, true>(lds, g, E); }
__device__ __forceinline__ void gemm_odd_in(LAS unsigned char* lds, const pg8::Gemm& g, const pg8::EpiOddIn& E) { pg8::gemm_phase(lds, g, E); }
__device__ __forceinline__ void gemm_mla_up(LAS unsigned char* lds, const pg8::Gemm& g, const pg8::EpiMlaUp& E) { pg8::gemm_phase(lds, g, E); }
__device__ __forceinline__ void gemm8_bf16(LAS unsigned char* lds, const pg8::Gemm& g, bf16_t* O, int ldc) { pg8::EpiBf16 E{O, ldc, F8_INV}; pg8::gemm_phase<pg8::EpiBf16, true>(lds, g, E); }
__device__ __forceinline__ void gemm8_swiglu8(LAS unsigned char* lds, const pg8::Gemm& g, unsigned char* O, int ldc) { pg8::EpiSwiGLU8 E{O, ldc, F8_INV}; pg8::gemm_phase<pg8::EpiSwiGLU8, true>(lds, g, E); }
__device__ __forceinline__ void gemm_swiglu(LAS unsigned char* lds, const pg8::Gemm& g, bf16_t* O, int ldc) { pg8::EpiSwiGLU E{O, ldc}; pg8::gemm_phase(lds, g, E); }

namespace att {
#define SBAR() __builtin_amdgcn_sched_barrier(0)
__device__ __forceinline__ int crow(int r, int hi) { return (r & 3) + 8 * (r >> 2) + 4 * hi; }
__device__ __forceinline__ int v_st(int k, int c) { const int kk = (k & ~0xC) | ((k & 4) << 1) | ((k & 8) >> 1); return ((kk >> 3) * 4 + (c >> 5)) * 512 + ((kk & 7) * 32 + (c & 31)) * 2; }
__device__ __forceinline__ int v_st_plain(int k, int c) { return ((k >> 3) * 4 + (c >> 5)) * 512 + ((k & 7) * 32 + (c & 31)) * 2; }
__device__ __forceinline__ int v_rd_base(int lane) { return ((lane & 3) << 3) | (((lane >> 2) & 3) << 6) | (((lane >> 4) & 1) << 5) | (((lane >> 5) & 1) << 8); }
constexpr int v_rd_off(int d0, int ks, int half) { return d0 * 512 + ks * 4096 + half * 2048; }
template <int OFF> __device__ __forceinline__ s16x4 tr_read(unsigned vb) {
    s16x4 r; asm volatile("ds_read_b64_tr_b16 %0, %1 offset:%2" : "=&v"(r) : "v"(vb), "i"(OFF) : "memory"); return r;
}
template <int D0> __device__ __forceinline__ void pv_one(f32x16& od, unsigned vb, bf16x8 pa0, bf16x8 pa1, bf16x8 pa2, bf16x8 pa3) {
    const s16x4 l0 = tr_read<v_rd_off(D0, 0, 0)>(vb), h0 = tr_read<v_rd_off(D0, 0, 1)>(vb), l1 = tr_read<v_rd_off(D0, 1, 0)>(vb), h1 = tr_read<v_rd_off(D0, 1, 1)>(vb);
    const s16x4 l2 = tr_read<v_rd_off(D0, 2, 0)>(vb), h2 = tr_read<v_rd_off(D0, 2, 1)>(vb), l3 = tr_read<v_rd_off(D0, 3, 0)>(vb), h3 = tr_read<v_rd_off(D0, 3, 1)>(vb);
    asm volatile("s_waitcnt lgkmcnt(0)" ::: "memory"); SBAR();
#define PK(L, H) (bf16x8){L[0], L[1], L[2], L[3], H[0], H[1], H[2], H[3]}
    od = __builtin_amdgcn_mfma_f32_32x32x16_bf16(pa0, PK(l0, h0), od, 0, 0, 0);
    od = __builtin_amdgcn_mfma_f32_32x32x16_bf16(pa1, PK(l1, h1), od, 0, 0, 0);
    od = __builtin_amdgcn_mfma_f32_32x32x16_bf16(pa2, PK(l2, h2), od, 0, 0, 0);
    od = __builtin_amdgcn_mfma_f32_32x32x16_bf16(pa3, PK(l3, h3), od, 0, 0, 0);
#undef PK
}
template <int KS, int NO> __device__ __forceinline__ void pv_step(f32x16 (&o)[NO], unsigned vb, bf16x8 pa) {
    s16x4 l[NO], h[NO];
    l[0] = tr_read<v_rd_off(0, KS, 0)>(vb); h[0] = tr_read<v_rd_off(0, KS, 1)>(vb); l[1] = tr_read<v_rd_off(1, KS, 0)>(vb); h[1] = tr_read<v_rd_off(1, KS, 1)>(vb);
    if constexpr (NO == 4) { l[2] = tr_read<v_rd_off(2, KS, 0)>(vb); h[2] = tr_read<v_rd_off(2, KS, 1)>(vb); l[3] = tr_read<v_rd_off(3, KS, 0)>(vb); h[3] = tr_read<v_rd_off(3, KS, 1)>(vb); }
    asm volatile("s_waitcnt lgkmcnt(0)" ::: "memory"); SBAR();
#pragma unroll
    for (int d = 0; d < NO; ++d) o[d] = __builtin_amdgcn_mfma_f32_32x32x16_bf16(pa, (bf16x8){l[d][0], l[d][1], l[d][2], l[d][3], h[d][0], h[d][1], h[d][2], h[d][3]}, o[d], 0, 0, 0);
}
__device__ __forceinline__ void rot4(bf16x8& a, const float* cs, const float* sn) {
    const f32x4 c = *(const f32x4*)cs, s = *(const f32x4*)sn; float o[8];
#pragma unroll
    for (int e = 0; e < 4; ++e) { const float x1 = bf2f((unsigned short)a[e]), x2 = bf2f((unsigned short)a[4 + e]); o[e] = x1 * c[e] - x2 * s[e]; o[4 + e] = x2 * c[e] + x1 * s[e]; }
    u32x4 w = {cvtpk(o[0], o[1]), cvtpk(o[2], o[3]), cvtpk(o[4], o[5]), cvtpk(o[6], o[7])};
    a = *reinterpret_cast<bf16x8*>(&w);
}
struct Args {
    const bf16_t* Q; int ldq, qcol;
    const bf16_t* K; int ldk, kcol;
    const bf16_t* V; int ldv, vcol;
    int q_row0;
    int kctx_row0, klat_row0, nt_ctx, nt_lat;
    float C;
    int rope;
    const float* rcos; const float* rsin;
    bf16_t* O; int ldo, ocol;
    int g, u0; const float* rpb;
    float lam, oscale; const float* subg;
};

__device__ __forceinline__ unsigned off_a(unsigned row, unsigned ch) { return 2048u * (row >> 3) + 512u * (ch >> 2) + 64u * (row & 7) + 16u * ((ch & 3) ^ ((row >> 2) & 3)); }
template <int OFF> __device__ __forceinline__ s16x4 tr_read_u(unsigned addr) {
    s16x4 r; asm volatile("ds_read_b64_tr_b16 %0, %1 offset:%2" : "=&v"(r) : "v"(addr), "i"(OFF) : "memory"); return r;
}
template <int KS2, int DB0>
__device__ __forceinline__ void pv16_load(s16x4 (&L)[4], s16x4 (&H)[4], const unsigned (&vb)[2][2]) {
    L[0] = tr_read_u<8192 * KS2 + 512 * ((DB0 + 0) >> 1)>(vb[(DB0 + 0) & 1][0]); H[0] = tr_read_u<8192 * KS2 + 512 * ((DB0 + 0) >> 1)>(vb[(DB0 + 0) & 1][1]);
    L[1] = tr_read_u<8192 * KS2 + 512 * ((DB0 + 1) >> 1)>(vb[(DB0 + 1) & 1][0]); H[1] = tr_read_u<8192 * KS2 + 512 * ((DB0 + 1) >> 1)>(vb[(DB0 + 1) & 1][1]);
    L[2] = tr_read_u<8192 * KS2 + 512 * ((DB0 + 2) >> 1)>(vb[(DB0 + 2) & 1][0]); H[2] = tr_read_u<8192 * KS2 + 512 * ((DB0 + 2) >> 1)>(vb[(DB0 + 2) & 1][1]);
    L[3] = tr_read_u<8192 * KS2 + 512 * ((DB0 + 3) >> 1)>(vb[(DB0 + 3) & 1][0]); H[3] = tr_read_u<8192 * KS2 + 512 * ((DB0 + 3) >> 1)>(vb[(DB0 + 3) & 1][1]);
}
template <int DB0, int NDB>
__device__ __forceinline__ void pv16_mma(f32x4 (&o)[2][NDB], const s16x4 (&L)[4], const s16x4 (&H)[4], bf16x8 p0, bf16x8 p1) {
#pragma unroll
    for (int i = 0; i < 4; ++i) { const bf16x8 vf = {L[i][0], L[i][1], L[i][2], L[i][3], H[i][0], H[i][1], H[i][2], H[i][3]};
        o[0][DB0 + i] = __builtin_amdgcn_mfma_f32_16x16x32_bf16(p0, vf, o[0][DB0 + i], 0, 0, 0);
        o[1][DB0 + i] = __builtin_amdgcn_mfma_f32_16x16x32_bf16(p1, vf, o[1][DB0 + i], 0, 0, 0); }
}
#define PV16_WAIT(n) do { asm volatile("s_waitcnt lgkmcnt(" #n ")" ::: "memory"); SBAR(); } while (0)
template <int DQK, int KW, int DV, int MODE>
__device__ __forceinline__ void attn_unit(LAS unsigned char* lds, const Args& a) {
    constexpr int NKS = DQK / 32, NDB = DV / 16;
    constexpr int KSTR = KW * 2 + 16, KBUF = 64 * KSTR;
    constexpr int OFF_V = 3 * KBUF, OFF_WS = OFF_V + 3 * 16384, OFF_RPB = OFF_WS + 2048;
    const int tid = opaque_tid(), wid = __builtin_amdgcn_readfirstlane(tid >> 6), lane = tid & 63, n = lane & 15, g = lane >> 4;
    LAS unsigned char* Kl = lds; LAS unsigned char* Vl = lds + OFF_V;
    LAS float* wsf = (LAS float*)(lds + OFF_WS) + wid * 64; LAS float* li_l = wsf;
    LAS float* rpbl = (LAS float*)(lds + OFF_RPB);
    const int wq = (MODE == 1) ? (wid & 3) : wid, wmap = (MODE == 1) ? (wid >> 2) : 0;
    bf16x8 qf[2][NKS];
#pragma unroll
    for (int qb = 0; qb < 2; ++qb) {
        const int qrow = a.q_row0 + wq * 32 + qb * 16 + n;
        const bf16_t* Qw = a.Q + (size_t)qrow * a.ldq + a.qcol + wmap * 64 + g * 8;
#pragma unroll
        for (int ks = 0; ks < NKS; ++ks) qf[qb][ks] = *(const bf16x8*)(Qw + ks * 32);
        if (a.rope == 2) { if constexpr (NKS >= 3) { const int s = qrow & (SEQ - 1); rot4(qf[qb][2], a.rcos + s * 16 + 4 * g, a.rsin + s * 16 + 4 * g); } }
#pragma unroll
        for (int ks = 0; ks < NKS; ++ks) { float f[8];
#pragma unroll
            for (int e = 0; e < 8; ++e) f[e] = bf2f((unsigned short)qf[qb][ks][e]) * a.C;
            u32x4 w = {cvtpk(f[0], f[1]), cvtpk(f[2], f[3]), cvtpk(f[4], f[5]), cvtpk(f[6], f[7])}; qf[qb][ks] = *reinterpret_cast<bf16x8*>(&w); }
    }
    if (MODE == 2) { if (tid < 465) rpbl[tid] = a.rpb[tid] * LOG2E; }
    const int cq0 = (wid & 1) * 32 + n, cq1 = cq0 + 16, rq = 4 * a.g + (wid >> 1);
    const int rs = min(max(rq - 4, 0), 120), cs0 = min(max(cq0 - 8, 0), 48), cs1 = min(max(cq1 - 8, 0), 48);
    constexpr int NKB = KBUF / 1024, NBT = NKB + 16, NB = (NBT + 7) / 8;
    static_assert(KBUF % 1024 == 0, "K image is a whole number of 1 KB blocks");
    unsigned soff[NB];
#pragma unroll
    for (int i = 0; i < NB; ++i) { const int bb = wid + 8 * i; unsigned so = 0u;
        if (bb < NKB) { const int A = bb * 1024 + lane * 16, row = A / KSTR; int off = A % KSTR; if (off >= KW * 2) off = 0; so = (unsigned)(row * a.ldk * 2 + off); }
        else if (bb < NBT) { const int A = (bb - NKB) * 1024 + lane * 16, rho = ((A >> 11) << 3) | ((A >> 6) & 7); int ch = (((A >> 9) & 3) << 2) | (((A >> 4) & 3) ^ ((rho >> 2) & 3));
            if (DV == 64) ch &= 7;
            const int key = ((rho >> 5) * 2 + ((rho >> 2) & 1)) * 16 + 4 * ((rho >> 3) & 3) + (rho & 3);
            so = (unsigned)((key * a.ldv + ch * 8) * 2); }
        soff[i] = so; }
    const int NT = a.nt_ctx + a.nt_lat;
#define TILE_ROW(j) ((j) < a.nt_ctx ? a.kctx_row0 + 64 * (j) : a.klat_row0 + 64 * ((j) - a.nt_ctx))
#define DMA(t) do { const int _r0 = TILE_ROW(t), _sl = (t) % 3; const char* _kp = (const char*)(a.K + (size_t)_r0 * a.ldk + a.kcol); const char* _vp = (const char*)(a.V + (size_t)_r0 * a.ldv + a.vcol); \
    _Pragma("unroll") for (int _i = 0; _i < NB; ++_i) { const int _bb = wid + 8 * _i; \
        if (_bb < NKB) __builtin_amdgcn_global_load_lds((const unsigned*)(_kp + soff[_i]), (LAS unsigned*)(Kl + _sl * KBUF + _bb * 1024), 16, 0, 0); \
        else if (_bb < NBT) __builtin_amdgcn_global_load_lds((const unsigned*)(_vp + soff[_i]), (LAS unsigned*)(Vl + _sl * 16384 + (_bb - NKB) * 1024), 16, 0, 0); } } while (0)
#define DMA_SYNC() do { asm volatile("s_waitcnt vmcnt(0)" ::: "memory"); __syncthreads(); } while (0)
    float lsum0 = 0.f, lsum1 = 0.f;
    f32x4 o[2][NDB];
#pragma unroll
    for (int qb = 0; qb < 2; ++qb)
#pragma unroll
        for (int d = 0; d < NDB; ++d) o[qb][d] = (f32x4){0.f, 0.f, 0.f, 0.f};
    const unsigned kbase = (unsigned)(size_t)Kl + (unsigned)(n * KSTR + 16 * g + wmap * 128);
    unsigned vb0[2][2];
    { const unsigned q4 = (unsigned)n >> 2, p = (unsigned)n & 3;
#pragma unroll
      for (int cb = 0; cb < 2; ++cb)
#pragma unroll
          for (int t = 0; t < 2; ++t) vb0[cb][t] = (unsigned)(size_t)Vl + off_a(8u * g + 4u * t + q4, 2u * cb + (p >> 1)) + 8u * (p & 1); }
#define QKT(S, b) do { const unsigned _kb = kbase + (unsigned)((b) * KBUF); bf16x8 _kf[4][NKS]; \
    _Pragma("unroll") for (int kb = 0; kb < 4; ++kb) _Pragma("unroll") for (int ks = 0; ks < NKS; ++ks) _kf[kb][ks] = *(const LAS bf16x8*)(size_t)(_kb + kb * 16 * KSTR + ks * 64); \
    _Pragma("unroll") for (int kb = 0; kb < 4; ++kb) _Pragma("unroll") for (int qb = 0; qb < 2; ++qb) { f32x4 _acc = {0.f, 0.f, 0.f, 0.f}; \
        _Pragma("unroll") for (int ks = 0; ks < NKS; ++ks) _acc = __builtin_amdgcn_mfma_f32_16x16x32_bf16(_kf[kb][ks], qf[qb][ks], _acc, 0, 0, 0); \
        S[kb][qb] = _acc; } } while (0)
#define PARTIAL(S, j) do { \
    if (MODE == 2) { if ((j) >= a.nt_ctx) { const int kr = a.u0 + ((j) - a.nt_ctx); const bool rowok = (kr >= rs) && (kr < rs + 8); const int ro = min(max(kr - rq + 7, 0), 14); const LAS float* brow = rpbl + ro * 31; \
        _Pragma("unroll") for (int kb = 0; kb < 4; ++kb) _Pragma("unroll") for (int r = 0; r < 4; ++r) { const int ck = kb * 16 + 4 * g + r; \
            { const int dd = min(max(ck - cq0 + 15, 0), 30); const bool inw = rowok && ((unsigned)(ck - cs0) < 16u); const float bv = brow[dd]; S[kb][0][r] = inw ? S[kb][0][r] + bv : -1e30f; } \
            { const int dd = min(max(ck - cq1 + 15, 0), 30); const bool inw = rowok && ((unsigned)(ck - cs1) < 16u); const float bv = brow[dd]; S[kb][1][r] = inw ? S[kb][1][r] + bv : -1e30f; } } } } \
    _Pragma("unroll") for (int kb = 0; kb < 2; ++kb) _Pragma("unroll") for (int qb = 0; qb < 2; ++qb) _Pragma("unroll") for (int r = 0; r < 4; ++r) S[kb][qb][r] = fast_exp2(S[kb][qb][r]); } while (0)
#define FINISH(S) do { \
    _Pragma("unroll") for (int kb = 2; kb < 4; ++kb) _Pragma("unroll") for (int qb = 0; qb < 2; ++qb) _Pragma("unroll") for (int r = 0; r < 4; ++r) S[kb][qb][r] = fast_exp2(S[kb][qb][r]); \
    float _p0 = 0.f, _p1 = 0.f; \
    _Pragma("unroll") for (int kb = 0; kb < 4; ++kb) { _p0 += (S[kb][0][0] + S[kb][0][1]) + (S[kb][0][2] + S[kb][0][3]); _p1 += (S[kb][1][0] + S[kb][1][1]) + (S[kb][1][2] + S[kb][1][3]); } \
    lsum0 += _p0; lsum1 += _p1; \
    _Pragma("unroll") for (int qb = 0; qb < 2; ++qb) _Pragma("unroll") for (int k2 = 0; k2 < 2; ++k2) { \
        u32x4 _w = {cvtpk(S[2 * k2][qb][0], S[2 * k2][qb][1]), cvtpk(S[2 * k2][qb][2], S[2 * k2][qb][3]), cvtpk(S[2 * k2 + 1][qb][0], S[2 * k2 + 1][qb][1]), cvtpk(S[2 * k2 + 1][qb][2], S[2 * k2 + 1][qb][3])}; \
        pf[qb][k2] = *reinterpret_cast<bf16x8*>(&_w); } } while (0)
#define PV(b) do { unsigned _vb[2][2]; _Pragma("unroll") for (int cb = 0; cb < 2; ++cb) _Pragma("unroll") for (int t = 0; t < 2; ++t) _vb[cb][t] = vb0[cb][t] + (unsigned)(b) * 16384u; \
    s16x4 _La[4], _Ha[4], _Lb[4], _Hb[4]; \
    if constexpr (NDB == 8) { \
        pv16_load<0, 0>(_La, _Ha, _vb); pv16_load<0, 4>(_Lb, _Hb, _vb); \
        PV16_WAIT(8); pv16_mma<0, NDB>(o, _La, _Ha, pf[0][0], pf[1][0]); pv16_load<1, 0>(_La, _Ha, _vb); \
        PV16_WAIT(8); pv16_mma<4, NDB>(o, _Lb, _Hb, pf[0][0], pf[1][0]); pv16_load<1, 4>(_Lb, _Hb, _vb); \
        PV16_WAIT(8); pv16_mma<0, NDB>(o, _La, _Ha, pf[0][1], pf[1][1]); \
        PV16_WAIT(0); pv16_mma<4, NDB>(o, _Lb, _Hb, pf[0][1], pf[1][1]); \
    } else {   \
        pv16_load<0, 0>(_La, _Ha, _vb); PV16_WAIT(0); pv16_mma<0, NDB>(o, _La, _Ha, pf[0][0], pf[1][0]); \
        pv16_load<1, 0>(_La, _Ha, _vb); PV16_WAIT(0); pv16_mma<0, NDB>(o, _La, _Ha, pf[0][1], pf[1][1]); \
    } } while (0)
    f32x4 sA[4][2], sB[4][2]; bf16x8 pf[2][2];
    DMA(0); DMA_SYNC();
    DMA(1);
    QKT(sA, 0); PARTIAL(sA, 0);
    DMA_SYNC();
    int bm1 = 0, bj = 1, bn = 2;
    for (int j = 1; j + 1 < NT; j += 2) {
        DMA(j + 1);
        SBAR(); QKT(sB, bj);
        FINISH(sA); SBAR();
        PV(bm1); PARTIAL(sB, j);
        DMA_SYNC();
        if (j + 2 < NT) DMA(j + 2);
        SBAR(); QKT(sA, bn);
        FINISH(sB); SBAR();
        PV(bj); PARTIAL(sA, j + 1);
        DMA_SYNC();
        { const int t0 = bm1; bm1 = bn; bn = bj; bj = t0; }
    }
    SBAR(); QKT(sB, bj);
    FINISH(sA); SBAR();
    PV(bm1); PARTIAL(sB, NT - 1);
    FINISH(sB); SBAR();
    PV(bj);
    __syncthreads();
#undef TILE_ROW
#undef DMA
#undef DMA_SYNC
#undef QKT
#undef PARTIAL
#undef FINISH
#undef PV
#undef PV16_WAIT
    const int tid_e = opaque_tid(), lane_e = tid_e & 63, ne = lane_e & 15, ge = lane_e >> 4;
    lsum0 += __shfl_xor(lsum0, 16); lsum0 += __shfl_xor(lsum0, 32); lsum1 += __shfl_xor(lsum1, 16); lsum1 += __shfl_xor(lsum1, 32);
    if (ge == 0) { li_l[ne] = fmaxf(lsum0, 1e-37f); li_l[16 + ne] = fmaxf(lsum1, 1e-37f); } LDS_WAIT();
    float rl[2][4];
#pragma unroll
    for (int qb = 0; qb < 2; ++qb)
#pragma unroll
        for (int r = 0; r < 4; ++r) rl[qb][r] = fast_rcp(li_l[qb * 16 + 4 * ge + r]);
    if (MODE != 1) {
        constexpr int OS = DV + 8;
        LAS bf16_t* ob = (LAS bf16_t*)lds;
#pragma unroll
        for (int qb = 0; qb < 2; ++qb)
#pragma unroll
            for (int r = 0; r < 4; ++r) { const int orow = wid * 32 + qb * 16 + 4 * ge + r;
#pragma unroll
                for (int db = 0; db < NDB; ++db) ob[orow * OS + db * 16 + ne] = f2bf(o[qb][db][r] * rl[qb][r]); }
        __syncthreads();
        constexpr int CPT = DV / 16;
        const int row = tid_e >> 1, c0 = (tid_e & 1) * CPT;
        bf16_t* Ow = a.O + (size_t)(a.q_row0 + row) * a.ldo + a.ocol + c0 * 8;
#pragma unroll
        for (int cc = 0; cc < CPT; ++cc) *(u32x4*)(Ow + cc * 8) = *(const LAS u32x4*)(ob + row * OS + (c0 + cc) * 8);
    } else {
        LAS float* cb = (LAS float*)lds;
        if (wmap == 1) {
#pragma unroll
            for (int qb = 0; qb < 2; ++qb)
#pragma unroll
                for (int r = 0; r < 4; ++r) { const int row = wq * 32 + qb * 16 + 4 * ge + r;
#pragma unroll
                    for (int db = 0; db < NDB; ++db) cb[row * 129 + db * 16 + ne] = a.lam * o[qb][db][r] * rl[qb][r]; }
        }
        __syncthreads();
        if (wmap == 0) {
#pragma unroll
            for (int qb = 0; qb < 2; ++qb)
#pragma unroll
                for (int r = 0; r < 4; ++r) { const int row = wq * 32 + qb * 16 + 4 * ge + r;
#pragma unroll
                    for (int db = 0; db < NDB; ++db) { const int ix = row * 129 + db * 16 + ne; cb[ix] = o[qb][db][r] * rl[qb][r] - cb[ix]; } }
        }
        __syncthreads();
        const int row = tid_e >> 2, qd = tid_e & 3;
        float v[32]; float ss = 0.f;
#pragma unroll
        for (int i = 0; i < 32; ++i) { v[i] = cb[row * 129 + qd * 32 + i]; ss += v[i] * v[i]; }
        ss += __shfl_xor(ss, 1); ss += __shfl_xor(ss, 2);
        const float rstd = rsqrtf(ss * (1.f / 128.f) + EPS) * a.oscale;
        bf16_t* Ow = a.O + (size_t)(a.q_row0 + row) * a.ldo + a.ocol + qd * 32;
#pragma unroll
        for (int c = 0; c < 4; ++c) { float w[8];
#pragma unroll
            for (int e = 0; e < 8; ++e) w[e] = v[c * 8 + e] * rstd * a.subg[qd * 32 + c * 8 + e];
            u32x4 pk = {cvtpk(w[0], w[1]), cvtpk(w[2], w[3]), cvtpk(w[4], w[5]), cvtpk(w[6], w[7])};
            *(u32x4*)(Ow + c * 8) = pk; }
    }
    __syncthreads();
}

__device__ __forceinline__ void sgu_unit(LAS unsigned char* lds, const bf16_t* PB, const bf16_t* Wsb, const float* bs, const float* stats, const float* sgain, bf16_t* MIX, int rowbase, int g) {
    const int tid = opaque_tid(), wid = __builtin_amdgcn_readfirstlane(tid >> 6), lane = tid & 63, r32 = lane & 31, hi = lane >> 5;
    LAS unsigned char* Vl = lds;
#pragma unroll 2
    for (int i = 0; i < 4; ++i) { const int c = tid + 512 * i, row = c >> 4, ch = c & 15;
        const u32x4 x = *(const u32x4*)(PB + (size_t)(rowbase + row) * EV_IN + 512 + g * 128 + ch * 8);
        const f32x4* st = (const f32x4*)(stats + (size_t)(rowbase + row) * 16); const f32x4 a0 = st[0], a1 = st[1], a2 = st[2], a3 = st[3];
        const float s1 = ((a0[0] + a0[2]) + (a1[0] + a1[2])) + ((a2[0] + a2[2]) + (a3[0] + a3[2])), s2 = ((a0[1] + a0[3]) + (a1[1] + a1[3])) + ((a2[1] + a2[3]) + (a3[1] + a3[3]));
        const float mean = s1 * (1.f / 512.f), rstd = rsqrtf(fmaxf(s2 * (1.f / 512.f) - mean * mean, 0.f) + EPS);
        const f32x4 g0 = *(const f32x4*)(sgain + g * 128 + ch * 8), g1 = *(const f32x4*)(sgain + g * 128 + ch * 8 + 4);
        u32x4 y; y.x = cvtpk((bflo(x.x) - mean) * rstd * g0[0], (bfhi(x.x) - mean) * rstd * g0[1]); y.y = cvtpk((bflo(x.y) - mean) * rstd * g0[2], (bfhi(x.y) - mean) * rstd * g0[3]);
        y.z = cvtpk((bflo(x.z) - mean) * rstd * g1[0], (bfhi(x.z) - mean) * rstd * g1[1]); y.w = cvtpk((bflo(x.w) - mean) * rstd * g1[2], (bfhi(x.w) - mean) * rstd * g1[3]);
        *(LAS u32x4*)(Vl + (row >> 6) * 16384 + v_st(row & 63, ch * 8)) = y; }
    const int prow = (wid & 3) * 32, dh = wid >> 2;
    bf16x8 pa[2][4];
#pragma unroll
    for (int kt = 0; kt < 2; ++kt)
#pragma unroll
        for (int ks = 0; ks < 4; ++ks) pa[kt][ks] = *(const bf16x8*)(Wsb + (size_t)(g * 128 + prow + r32) * 128 + kt * 64 + ks * 16 + hi * 8);
    __syncthreads();
    f32x16 o[2];
    o[0] = (f32x16){0.f, 0.f, 0.f, 0.f, 0.f, 0.f, 0.f, 0.f, 0.f, 0.f, 0.f, 0.f, 0.f, 0.f, 0.f, 0.f}; o[1] = o[0];
    const unsigned vb0 = (unsigned)(size_t)Vl + (unsigned)v_rd_base(lane);
#pragma unroll
    for (int kt = 0; kt < 2; ++kt) { const unsigned vb = vb0 + kt * 16384u;
        if (dh == 0) { pv_one<0>(o[0], vb, pa[kt][0], pa[kt][1], pa[kt][2], pa[kt][3]); pv_one<1>(o[1], vb, pa[kt][0], pa[kt][1], pa[kt][2], pa[kt][3]); }
        else { pv_one<2>(o[0], vb, pa[kt][0], pa[kt][1], pa[kt][2], pa[kt][3]); pv_one<3>(o[1], vb, pa[kt][0], pa[kt][1], pa[kt][2], pa[kt][3]); } }
#pragma unroll
    for (int r = 0; r < 16; ++r) { const int p = prow + crow(r, hi); const float bias = bs[g * 128 + p];
#pragma unroll
        for (int dd = 0; dd < 2; ++dd) { const int d = (2 * dh + dd) * 32 + r32;
            const float u = bf2f(PB[(size_t)(rowbase + p) * EV_IN + g * 128 + d]);
            MIX[(size_t)(rowbase + p) * DM + g * 128 + d] = f2bf(u * (o[dd][r] + bias)); } }
    __syncthreads();
}
}

struct Params {
    const float* in[31];
    float* out;
    unsigned char* ws;
    int ph_lo, ph_hi;
};

struct Ctx {
    LAS unsigned char* lds;
    int tid, lane, wid, gw, NGW;
};
__device__ __forceinline__ Ctx make_ctx(LAS unsigned char* lds) { const int t = opaque_tid(), w = __builtin_amdgcn_readfirstlane(t >> 6); return Ctx{lds, t, t & 63, w, opaque_bid() * 8 + w, (int)gridDim.x * 8}; }
typedef const __attribute__((address_space(4))) Params KParams;
__device__ __forceinline__ KParams& kparams() { KParams* p = (KParams*)__builtin_amdgcn_kernarg_segment_ptr(); asm volatile("" : "+s"(p)); return *p; }

__device__ __forceinline__ bf16_t* xrow_ptr(KParams& P, int row) { return (bf16_t*)(P.ws + WS_U + U_XB) + (size_t)row * DM; }
__device__ __forceinline__ int mod_r(int row) { return row < NLAT ? (row >> 13) : 4; }
__device__ __forceinline__ f32x4 ld4(const float* p) { return *(const f32x4*)p; }
__device__ __forceinline__ f32x4 ldbf4(const bf16_t* p) { const u32x2 w = *(const u32x2*)p; return (f32x4){bflo(w.x), bfhi(w.x), bflo(w.y), bfhi(w.y)}; }
__device__ __forceinline__ void stbf4(bf16_t* p, f32x4 v) { u32x2 w; w.x = cvtpk(v[0], v[1]); w.y = cvtpk(v[2], v[3]); *(u32x2*)p = w; }
__device__ __forceinline__ float sumsq4(const f32x4 (&v)[4]) { float s = 0.f;
#pragma unroll
    for (int j = 0; j < 4; ++j) s += (v[j][0] * v[j][0] + v[j][1] * v[j][1]) + (v[j][2] * v[j][2] + v[j][3] * v[j][3]);
    return wave_sum(s); }
__device__ __forceinline__ void norm_mod(const f32x4 (&x)[4], f32x4 (&hv)[4], const float* gain, const float* shift, const float* scale, int lane) {
    const float rstd = rsqrtf(sumsq4(x) * (1.f / DM) + EPS);
#pragma unroll
    for (int j = 0; j < 4; ++j) { const int c = 4 * lane + 256 * j; const f32x4 g = ld4(gain + c), sh = ld4(shift + c), sc = ld4(scale + c);
        hv[j] = (x[j] * rstd) * g * (sc + 1.f) + sh; }
}
__device__ __forceinline__ void resid_add(f32x4 (&x)[4], const f32x4 (&y)[4], const float* gain, const float* gate, int lane) {
    const float rstd = rsqrtf(sumsq4(y) * (1.f / DM) + EPS);
#pragma unroll
    for (int j = 0; j < 4; ++j) { const int c = 4 * lane + 256 * j; const f32x4 g = ld4(gain + c), gt = ld4(gate + c);
        x[j] = x[j] + gt * ((y[j] * rstd) * g); }
}

__device__ __forceinline__ void wave_rows(const Ctx& c, int mtok, int& r0, int& r1) {
    const int bid = opaque_bid(); const int rpw = mtok / (int)gridDim.x, base = bid * rpw;
    r0 = base + (c.wid * rpw) / 8; r1 = base + ((c.wid + 1) * rpw) / 8;
    if (bid == (int)gridDim.x - 1 && c.wid == 7) r1 = mtok;
}
__device__ __forceinline__ void ld_gate(f32x4 (&G)[4], const float* gain, const float* gate, int lane) {
#pragma unroll
    for (int j = 0; j < 4; ++j) { const int cc = 4 * lane + 256 * j; G[j] = ld4(gain + cc) * ld4(gate + cc); } }
__device__ __forceinline__ void ld_mod(f32x4 (&A)[4], f32x4 (&B)[4], const float* gain, const float* shift, const float* scale, int lane) {
#pragma unroll
    for (int j = 0; j < 4; ++j) { const int cc = 4 * lane + 256 * j; A[j] = ld4(gain + cc) * (ld4(scale + cc) + 1.f); B[j] = ld4(shift + cc); } }
__device__ __forceinline__ void resid_add2(f32x4 (&x)[4], const f32x4 (&y)[4], const f32x4 (&G)[4]) {
    const float rstd = rsqrtf(sumsq4(y) * (1.f / DM) + EPS);
#pragma unroll
    for (int j = 0; j < 4; ++j) x[j] = x[j] + G[j] * (y[j] * rstd);
}
__device__ __forceinline__ void norm_mod2(const f32x4 (&x)[4], f32x4 (&hv)[4], const f32x4 (&A)[4], const f32x4 (&B)[4]) {
    const float rstd = rsqrtf(sumsq4(x) * (1.f / DM) + EPS);
#pragma unroll
    for (int j = 0; j < 4; ++j) hv[j] = (x[j] * rstd) * A[j] + B[j];
}

__device__ __forceinline__ int perm_row(int pmode, int n) {
    if (pmode == 1) { if (n >= 1024 && n < 2048) { const int d = n & 63, hb = n & ~63; return hb + ((d < 32) ? 8 * (d >> 2) + (d & 3) : 8 * ((d - 32) >> 2) + 4 + (d & 3)); } }
    else if (pmode == 2) { if (n >= 1920 && n < 1952) { const int d = n - 1920; return 1920 + ((d < 16) ? 8 * (d >> 2) + (d & 3) : 8 * ((d - 16) >> 2) + 4 + (d & 3)); } }
    return n;
}
struct TrD { const float* src; unsigned char* dst; int ldw, ldt, k0, n0, drow, pmode, f8; };
__device__ __forceinline__ TrD tr_desc(const float* W, int K, int N, unsigned char* WT, int r, int mode, int row_off, int pmode, int f8) {
    const int nblk = N / 32, kb = r / nblk, n0 = 32 * (r % nblk);
    const int drow = (mode == 0) ? row_off + n0 : (n0 >> 7) * 256 + (n0 & 127) + (mode == 2 ? 128 : 0);
    return TrD{W, WT, N, K, 64 * kb, n0, drow, pmode, f8};
}
#define TR_LOAD(v, d) do { const float* _p = (d).src + (size_t)((d).k0 + (lane >> 5)) * (d).ldw + (d).n0 + (lane & 31); \
        _Pragma("unroll") for (int _i = 0; _i < 32; ++_i) v[_i] = _p[(size_t)(2 * _i) * (d).ldw]; } while (0)
template <class F> __device__ __forceinline__ void tr_run(LAS float* scr, int lane, int first, int end, int stride, F dec) {
    if (first >= end) return;
    float v[32];
    TrD d = dec(first);
    TR_LOAD(v, d);
    for (int it = first; it < end; it += stride) {
        const TrD cur = d;
        const float sc = cur.f8 ? F8_W_SCALE : 1.f;
#pragma unroll
        for (int i = 0; i < 32; ++i) scr[(2 * i + (lane >> 5)) * 33 + (lane & 31)] = v[i] * sc;
        if (it + stride < end) { d = dec(it + stride); TR_LOAD(v, d); }
        LDS_WAIT(); asm volatile("" ::: "memory");
        const int c = lane & 7;
#pragma unroll
        for (int j = 0; j < 4; ++j) { const int n = (lane >> 3) + 8 * j; const LAS float* s = scr + (8 * c) * 33 + n;
            const int dr = cur.pmode ? perm_row(cur.pmode, cur.n0 + n) : cur.drow + n;
            const size_t eo = (size_t)dr * cur.ldt + cur.k0 + 8 * c;
            if (cur.f8) { u32x2 o; o.x = pk4_fp8(s[0 * 33], s[1 * 33], s[2 * 33], s[3 * 33]); o.y = pk4_fp8(s[4 * 33], s[5 * 33], s[6 * 33], s[7 * 33]); *(u32x2*)(cur.dst + eo) = o; }
            else { u32x4 o; o.x = cvtpk(s[0 * 33], s[1 * 33]); o.y = cvtpk(s[2 * 33], s[3 * 33]); o.z = cvtpk(s[4 * 33], s[5 * 33]); o.w = cvtpk(s[6 * 33], s[7 * 33]); *(u32x4*)(cur.dst + eo * 2) = o; } }
        LDS_WAIT(); asm volatile("" ::: "memory");
    }
}
constexpr int MOE_CVT_ITEMS = 24 * 1792;
__device__ __forceinline__ void convert_moe_items(const Ctx& c, int i, int t0, int t1, int wsel, int nsel) {
    LAS float* scr = (LAS float*)(c.lds + c.wid * 16384);
    if (wsel < 0) return;
    tr_run(scr, c.lane, t0 + wsel, t1, nsel, [i](int t) { KParams& P = kparams();
        const int mat = t / 1792, r = t % 1792, e = mat / 3, which = mat % 3;
        if (which < 2) return tr_desc(P.in[28 + which] + ((size_t)i * NEXP + e) * DM * DFFE, DM, DFFE, P.ws + WS_W13M + (size_t)e * 2 * DFFE * DM * (MOE_F8 ? 1 : 2), r, 1 + which, 0, 0, MOE_F8);
        return tr_desc(P.in[30] + ((size_t)i * NEXP + e) * DFFE * DM, DFFE, DM, P.ws + WS_W2M + (size_t)e * DM * DFFE * (MOE_F8 ? 1 : 2), r, 0, 0, 0, MOE_F8); });
}
constexpr int PI_EIN = (DM / 64) * (EV_IN / 32), PI_OUT = (DM / 64) * (DM / 32), PI_FFN = (DM / 64) * (DFF / 32), PI_OIN = (DM / 64) * (OD_IN / 32);
constexpr int PRO_ITEMS_L = PI_EIN + PI_OUT + 3 * PI_FFN + PI_OIN + PI_OUT, PRO_ITEMS = 2 * PRO_ITEMS_L;
__device__ __forceinline__ TrD pro_desc(int t) {
    KParams& P = kparams(); unsigned char* ws = P.ws;
    const int i = t / PRO_ITEMS_L; int r = t % PRO_ITEMS_L;
    if (r < PI_EIN) return tr_desc(P.in[7] + (size_t)i * DM * EV_IN, DM, EV_IN, ws + WS_WINE + (size_t)i * EV_IN * DM * 2, r, 0, 0, 1, WIN8(2 * i) ? 1 : 0);
    r -= PI_EIN;
    if (r < PI_OUT) return tr_desc(P.in[8] + (size_t)i * DM * DM, DM, DM, ws + WS_WOUTE + (size_t)i * DM * DM * 2, r, 0, 0, 0, 0);
    r -= PI_OUT;
    if (r < PI_FFN) return tr_desc(P.in[17] + (size_t)i * DM * DFF, DM, DFF, ws + WS_W13E + (size_t)i * 2 * DFF * DM * 2, r, 1, 0, 0, FFN8(i) ? 1 : 0);
    r -= PI_FFN;
    if (r < PI_FFN) return tr_desc(P.in[18] + (size_t)i * DM * DFF, DM, DFF, ws + WS_W13E + (size_t)i * 2 * DFF * DM * 2, r, 2, 0, 0, FFN8(i) ? 1 : 0);
    r -= PI_FFN;
    if (r < PI_FFN) return tr_desc(P.in[19] + (size_t)i * DFF * DM, DFF, DM, ws + WS_W2E + (size_t)i * DM * DFF * 2, r, 0, 0, 0, FFN8(i) ? 1 : 0);
    r -= PI_FFN;
    if (r < PI_OIN) return tr_desc(P.in[20] + (size_t)i * DM * OD_IN, DM, OD_IN, ws + WS_WINO + (size_t)i * OD_INP * DM * 2, r, 0, 0, 2, WIN8(2 * i + 1) ? 1 : 0);
    r -= PI_OIN;
    return tr_desc(P.in[21] + (size_t)i * DM * DM, DM, DM, ws + WS_WOUTO + (size_t)i * DM * DM * 2, r, 0, 0, 0, 0);
}
constexpr int PRO_GEMV_WGS = 192;
__device__ __forceinline__ void prologue0(const Ctx& c_) {
    const Ctx c = make_ctx(c_.lds);
    KParams& P = kparams(); unsigned char* ws = P.ws;
    const int bid = opaque_bid();
    if (bid < PRO_GEMV_WGS) {
        LAS float* sl = (LAS float*)c.lds;
        LAS float* part = (LAS float*)(c.lds + 32768);
        for (int i = c.tid; i < 5 * DM; i += 512) { const int r = i >> 10, k = i & 1023; const float x = r < 4 ? P.in[1][r * DM + k] : P.in[3][k]; sl[i] = x / (1.f + expf(-x)); }
        __syncthreads();
        const int lm = bid / 48, cbk = bid % 48, hi = c.lane >> 5, lo = c.lane & 31, n = cbk * 128 + 4 * lo;
        const float* W = P.in[4] + (size_t)lm * DM * (NMOD * DM) + n;
        f32x4 acc[5];
#pragma unroll
        for (int r = 0; r < 5; ++r) acc[r] = (f32x4){0.f, 0.f, 0.f, 0.f};
        const int kb = c.wid * 128 + hi;
        for (int k0 = 0; k0 < 128; k0 += 16) {
            f32x4 wv[8];
#pragma unroll
            for (int u = 0; u < 8; ++u) wv[u] = ld4(W + (size_t)(kb + k0 + 2 * u) * (NMOD * DM));
#pragma unroll
            for (int u = 0; u < 8; ++u)
#pragma unroll
                for (int r = 0; r < 5; ++r) acc[r] += wv[u] * sl[r * DM + kb + k0 + 2 * u];
        }
#pragma unroll
        for (int r = 0; r < 5; ++r) {
#pragma unroll
            for (int q = 0; q < 4; ++q) acc[r][q] += __shfl_xor(acc[r][q], 32);
            if (hi == 0) *(LAS f32x4*)(part + (c.wid * 5 + r) * 128 + 4 * lo) = acc[r]; }
        __syncthreads();
        for (int i = c.tid; i < 5 * 128; i += 512) { const int r = i >> 7, cc = i & 127; float s = 0.f;
#pragma unroll
            for (int w = 0; w < 8; ++w) s += part[(w * 5 + r) * 128 + cc];
            ((float*)(ws + WS_MODS))[(size_t)(lm * 5 + r) * (NMOD * DM) + cbk * 128 + cc] = s + P.in[5][lm * (NMOD * DM) + cbk * 128 + cc]; }
        __syncthreads();
    }
    {
        LAS float* scr = (LAS float*)(c.lds + c.wid * 16384);
        const int G = (int)gridDim.x, ng = G < PRO_GEMV_WGS ? G : PRO_GEMV_WGS, nslots = ng * 8 + (G - ng) * 16;
        if (bid < ng) tr_run(scr, c.lane, bid * 8 + c.wid, PRO_ITEMS, nslots, [](int t) { return pro_desc(t); });
        else { const int s0 = ng * 8 + ((bid - ng) * 8 + c.wid) * 2;
            tr_run(scr, c.lane, s0, PRO_ITEMS, nslots, [](int t) { return pro_desc(t); });
            tr_run(scr, c.lane, s0 + 1, PRO_ITEMS, nslots, [](int t) { return pro_desc(t); }); }
    }
    const int gt = bid * 512 + c.tid, NGT = gridDim.x * 512;
    for (int i = gt; i < 2 * (OD_INP - OD_IN) * DM * 2 / 16; i += NGT) { const int per = (OD_INP - OD_IN) * DM * 2 / 16, l = i / per, r = i % per;
        const int esz = WIN8(2 * l + 1) ? 1 : 2;
        if (r * 16 < (OD_INP - OD_IN) * DM * esz) *(u32x4*)(ws + WS_WINO + (size_t)l * OD_INP * DM * 2 + (size_t)OD_IN * DM * esz + (size_t)r * 16) = (u32x4){0u, 0u, 0u, 0u}; }
    for (int i = gt; i < 2 * (MLA_K / 8) * MLA_N; i += NGT) { const int l = i / ((MLA_K / 8) * MLA_N), k8 = (i / MLA_N) % (MLA_K / 8), n = i % MLA_N, k = 8 * k8;
        float v[8];
#pragma unroll
        for (int u = 0; u < 8; ++u) v[u] = 0.f;
        if (n < 384) { if (k < 256) { const int h = n / 96, j = n % 96; int sc = n;
                if (j >= 64) { const int p = j - 64, t = p >> 3, e = p & 7; sc = h * 96 + 64 + ((e < 4) ? 4 * t + e : 16 + 4 * t + (e - 4)); }
#pragma unroll
                for (int u = 0; u < 8; ++u) v[u] = P.in[24][((size_t)l * 256 + k + u) * 384 + sc] * P.in[23][l * 256 + k + u]; } }
        else if (n < 768) { const int h = (n - 384) / 96, j = (n - 384) % 96;
            if (j < 64) { if (k >= 256 && k < 384) {
#pragma unroll
                    for (int u = 0; u < 8; ++u) v[u] = P.in[26][((size_t)l * 128 + (k + u - 256)) * 768 + h * 192 + j] * P.in[25][l * 128 + (k + u - 256)]; } }
            else {
#pragma unroll
                for (int u = 0; u < 8; ++u) if (k + u == 384 + (j - 64)) v[u] = 1.f; } }
        else { const int h = (n - 768) / 128, j = (n - 768) % 128; if (k >= 256 && k < 384) {
#pragma unroll
                for (int u = 0; u < 8; ++u) v[u] = P.in[26][((size_t)l * 128 + (k + u - 256)) * 768 + h * 192 + 64 + j] * P.in[25][l * 128 + (k + u - 256)]; } }
        u32x4 o; o.x = cvtpk(v[0], v[1]); o.y = cvtpk(v[2], v[3]); o.z = cvtpk(v[4], v[5]); o.w = cvtpk(v[6], v[7]);
        *(u32x4*)((bf16_t*)(ws + WS_WMLA) + (size_t)l * MLA_N * MLA_K + (size_t)n * MLA_K + k) = o; }
    for (int i = gt; i < 2 * 4 * 128 * 128 / 4; i += NGT) stbf4((bf16_t*)(ws + WS_SGUW) + 4 * i, ld4(P.in[9] + 4 * i));
    for (int i = gt; i < SEQ * 32; i += NGT) { const int s = i >> 5, f = i & 31; const int pos = f < 16 ? (s >> 6) : (s & 63);
        const float inv = 1.0f / powf(10000.0f, (float)(f & 15) / 16.0f); const float ang = (float)pos * inv; float sn, cs; sincosf(ang, &sn, &cs);
        ((float*)(ws + WS_ROPEB))[i] = cs; ((float*)(ws + WS_ROPEB))[SEQ * 32 + i] = sn; }
    for (int i = gt; i < SEQ * 16; i += NGT) { const int s = i >> 4, f = i & 15; const int pos = f < 8 ? (s >> 6) : (s & 63);
        const float inv = 1.0f / powf(10000.0f, (float)(f & 7) / 8.0f); const float ang = (float)pos * inv; float sn, cs; sincosf(ang, &sn, &cs);
        ((float*)(ws + WS_ROPED))[i] = cs; ((float*)(ws + WS_ROPED))[SEQ * 16 + i] = sn; }
}

__device__ __forceinline__ void convert_moe_tail(const Ctx& c_, int i, int t0, int t1, int nunits) {
    const Ctx c = make_ctx(c_.lds);
    const int G = (int)gridDim.x, rem = nunits % G, bid = opaque_bid();
    const int first = rem;
    convert_moe_items(c, i, t0, t1, bid >= first ? (bid - first) * 8 + c.wid : -1, (G - first) * 8);
}

__device__ __forceinline__ void ew_first(const Ctx& c_) {
    const Ctx c = make_ctx(c_.lds);
    KParams& P = kparams(); const float* mods = (const float*)(P.ws + WS_MODS); bf16_t* HB = (bf16_t*)(P.ws + WS_HB);
    int r0, r1; wave_rows(c, MTOT, r0, r1);
    f32x4 A0[4], B0[4]; int rcur = -1;
    for (int row = r0; row < r1; ++row) {
        const float* src = row < NLAT ? P.in[0] + (size_t)row * DM : P.in[2] + (size_t)(row - NLAT) * DM;
        bf16_t* xr = xrow_ptr(P, row); const int r = mod_r(row);
        if (r != rcur) { rcur = r; const float* mb = mods + (size_t)(0 * 5 + r) * (NMOD * DM); ld_mod(A0, B0, P.in[6] + (0 * 4 + 0) * DM, mb + 0 * DM, mb + 1 * DM, c.lane); }
        f32x4 x[4], h[4];
#pragma unroll
        for (int j = 0; j < 4; ++j) { x[j] = ld4(src + 4 * c.lane + 256 * j); stbf4(xr + 4 * c.lane + 256 * j, x[j]); }
        norm_mod2(x, h, A0, B0);
#pragma unroll
        for (int j = 0; j < 4; ++j) stbf4(HB + (size_t)row * DM + 4 * c.lane + 256 * j, h[j]);
    }
}

__device__ __forceinline__ void ew_mid(const Ctx& c_, int l, int mtok, bool dry = false) {
    const Ctx c = make_ctx(c_.lds);
    KParams& P = kparams(); const float* mods = (const float*)(P.ws + WS_MODS); bf16_t* HB = (bf16_t*)(P.ws + WS_HB);
    const bf16_t* YB = (const bf16_t*)(P.ws + WS_U + U_YB);
    const bool odd = (l & 1) != 0; const int li = l >> 1;
    LAS float* wrl = (LAS float*)c.lds;
    if (odd) { for (int i = c.tid; i < DM * NEXP; i += 512) { const int col = i >> 3, e = i & 7; wrl[e * DM + col] = P.in[27][(size_t)li * DM * NEXP + i]; } __syncthreads(); }
    unsigned long long cw = 0ull; int st_e1 = 0, st_e2 = 0, st_l1 = 0, st_l2 = 0; float st_g1 = 0.f; int nrow = 0;
    int r0, r1; wave_rows(c, mtok, r0, r1);
    f32x4 G1[4], A2[4], B2[4]; int rcur = -1;
    u32x2 xa[4], ya[4], xb[4], yb[4];
#define EWM_LOAD(X, Y, rw) do { const int _row = (rw); const bf16_t* _xr = xrow_ptr(P, _row); \
        _Pragma("unroll") for (int j = 0; j < 4; ++j) { X[j] = *(const u32x2*)(_xr + 4 * c.lane + 256 * j); Y[j] = *(const u32x2*)(YB + (size_t)_row * DM + 4 * c.lane + 256 * j); } } while (0)
    if (r0 < r1) EWM_LOAD(xa, ya, r0);
    if (r0 + 1 < r1) EWM_LOAD(xb, yb, r0 + 1);
    for (int row = r0; row < r1; ++row, ++nrow) {
        bf16_t* xr = xrow_ptr(P, row); const int r = mod_r(row);
        if (r != rcur) { rcur = r; const float* mb = mods + (size_t)(l * 5 + r) * (NMOD * DM);
            ld_gate(G1, P.in[6] + (l * 4 + 1) * DM, mb + 2 * DM, c.lane); ld_mod(A2, B2, P.in[6] + (l * 4 + 2) * DM, mb + 3 * DM, mb + 4 * DM, c.lane); }
        f32x4 x[4], y[4], h[4];
#pragma unroll
        for (int j = 0; j < 4; ++j) { x[j] = (f32x4){bflo(xa[j].x), bfhi(xa[j].x), bflo(xa[j].y), bfhi(xa[j].y)}; y[j] = (f32x4){bflo(ya[j].x), bfhi(ya[j].x), bflo(ya[j].y), bfhi(ya[j].y)}; xa[j] = xb[j]; ya[j] = yb[j]; }
        if (row + 2 < r1) EWM_LOAD(xb, yb, row + 2);
        resid_add2(x, y, G1);
        bf16_t* xw = dry ? (bf16_t*)(P.ws + WS_U + U_YS) + (size_t)row * DM : xr; bf16_t* hw = (dry ? (bf16_t*)(P.ws + WS_U + U_PB) : HB) + (size_t)row * DM;
#pragma unroll
        for (int j = 0; j < 4; ++j) stbf4(xw + 4 * c.lane + 256 * j, x[j]);
        norm_mod2(x, h, A2, B2);
        if ((odd && MOE_F8) || (!odd && FFN8(li))) {
            unsigned char* h8 = (unsigned char*)(dry ? (bf16_t*)(P.ws + WS_U + U_PB) : HB) + (size_t)row * DM;
#pragma unroll
            for (int j = 0; j < 4; ++j) *(unsigned*)(h8 + 4 * c.lane + 256 * j) = pk4_fp8(h[j][0] * F8_ACT_SCALE, h[j][1] * F8_ACT_SCALE, h[j][2] * F8_ACT_SCALE, h[j][3] * F8_ACT_SCALE);
        } else {
#pragma unroll
            for (int j = 0; j < 4; ++j) stbf4(hw + 4 * c.lane + 256 * j, h[j]);
        }
        if (odd && !dry) {
            float lg[8];
#pragma unroll
            for (int e = 0; e < 8; ++e) { float sacc = 0.f;
#pragma unroll
                for (int j = 0; j < 4; ++j) { const f32x4 w = *(const LAS f32x4*)(wrl + e * DM + 4 * c.lane + 256 * j); sacc += (h[j][0] * w[0] + h[j][1] * w[1]) + (h[j][2] * w[2] + h[j][3] * w[3]); }
                lg[e] = wave_sum(sacc); }
            int e1 = 0; float v1 = lg[0];
#pragma unroll
            for (int e = 1; e < 8; ++e) if (lg[e] > v1) { v1 = lg[e]; e1 = e; }
            int e2 = -1; float v2 = -3.0e38f;
#pragma unroll
            for (int e = 0; e < 8; ++e) if (e != e1 && lg[e] > v2) { v2 = lg[e]; e2 = e; }
            if (e2 < 0) e2 = (e1 + 1) & 7;
            const float g1 = 1.f / (1.f + expf(v2 - v1));
            const int l1 = (int)((cw >> (8 * e1)) & 0xffull); cw += 1ull << (8 * e1);
            const int l2 = (int)((cw >> (8 * e2)) & 0xffull); cw += 1ull << (8 * e2);
            if (c.lane == nrow) { st_e1 = e1; st_e2 = e2; st_l1 = l1; st_l2 = l2; st_g1 = g1; }
        }
    }
    if (odd && !dry) {
        unsigned* cnt = (unsigned*)(P.ws + WS_CTL) + CW_MOECNT + li * 64;
        int base = 0;
        if (c.lane < 8) { const unsigned wc = (unsigned)((cw >> (8 * c.lane)) & 0xffull); base = wc ? (int)atomicAdd(cnt + c.lane, wc) : 0; }
        const int b1 = __shfl(base, st_e1), b2 = __shfl(base, st_e2);
        if (c.lane < nrow) { const int row = r0 + c.lane; int4* ti = (int4*)(P.ws + WS_TOKINFO) + (size_t)row * 2;
            ti[0] = make_int4(st_e1, b1 + st_l1, st_e2, b2 + st_l2); ti[1] = make_int4(__float_as_int(st_g1), __float_as_int(1.f - st_g1), 0, 0); }
        __syncthreads();
    }
#undef EWM_LOAD
}

__device__ __forceinline__ void moe_offsets(KParams& P, int li, int (&toff)[9]) {
    const unsigned* cnt = (const unsigned*)(P.ws + WS_CTL) + CW_MOECNT + li * 64; int acc = 0;
#pragma unroll
    for (int e = 0; e < 8; ++e) { toff[e] = acc; const unsigned n = __builtin_amdgcn_readfirstlane(__hip_atomic_load(cnt + e, __ATOMIC_RELAXED, __HIP_MEMORY_SCOPE_AGENT)); acc += (int)((n + 255u) >> 8); }
    toff[8] = acc;
}
__device__ __forceinline__ void moe_gather(const Ctx& c_, int li, int mtok) {
    const Ctx c = make_ctx(c_.lds);
    KParams& P = kparams(); int toff[9]; moe_offsets(P, li, toff);
    int tv = 0;
#pragma unroll
    for (int e = 0; e < 8; ++e) tv = (c.lane == e) ? toff[e] : tv;
    const bf16_t* HB = (const bf16_t*)(P.ws + WS_HB); bf16_t* HS = (bf16_t*)(P.ws + WS_U + U_YS);
    int r0, r1; wave_rows(c, mtok, r0, r1);
    for (int row = r0; row < r1; ++row) {
        const int4* ti = (const int4*)(P.ws + WS_TOKINFO) + (size_t)row * 2; const int4 a = ti[0], b = ti[1];
        const int pA = __shfl(tv, a.x) * 256 + a.y, pB = __shfl(tv, a.z) * 256 + a.w;
        if (c.lane == 0) ((int4*)(P.ws + WS_TOKPOS))[row] = make_int4(pA, pB, b.x, b.y);
#if MOE_F8
        const u32x4 v0 = ((const u32x4*)((const unsigned char*)HB + (size_t)row * DM))[c.lane];
        ((u32x4*)((unsigned char*)HS + (size_t)pA * DM))[c.lane] = v0; ((u32x4*)((unsigned char*)HS + (size_t)pB * DM))[c.lane] = v0;
#else
        const u32x4* src = (const u32x4*)(HB + (size_t)row * DM); const u32x4 v0 = src[c.lane], v1 = src[64 + c.lane];
        u32x4* dA = (u32x4*)(HS + (size_t)pA * DM); u32x4* dB = (u32x4*)(HS + (size_t)pB * DM);
        dA[c.lane] = v0; dA[64 + c.lane] = v1; dB[c.lane] = v0; dB[64 + c.lane] = v1;
#endif
    }
}

__device__ __forceinline__ void ew_last(const Ctx& c_, int l, int mtok, bool dry = false) {
    const Ctx c = make_ctx(c_.lds);
    KParams& P = kparams(); const float* mods = (const float*)(P.ws + WS_MODS); bf16_t* HB = (bf16_t*)(P.ws + WS_HB);
    const bf16_t* YS = (const bf16_t*)(P.ws + WS_U + U_YS); const bool odd = (l & 1) != 0;
    int r0, r1; wave_rows(c, mtok, r0, r1);
    f32x4 G3[4], A0[4], B0[4]; int rcur = -1;
    u32x2 xa[4], ya[4], za[4], xb[4], yb[4], zb[4]; float gAa = 0.f, gBa = 0.f, gAb = 0.f, gBb = 0.f;
#define EWL_LOAD(X, Y, Z, GA, GB, rw) do { const int _row = (rw); const bf16_t* _xr = xrow_ptr(P, _row); \
        if (odd) { const int4 tp = ((const int4*)(P.ws + WS_TOKPOS))[_row]; GA = __int_as_float(tp.z); GB = __int_as_float(tp.w); \
            _Pragma("unroll") for (int j = 0; j < 4; ++j) { Y[j] = *(const u32x2*)(YS + (size_t)tp.x * DM + 4 * c.lane + 256 * j); Z[j] = *(const u32x2*)(YS + (size_t)tp.y * DM + 4 * c.lane + 256 * j); } } \
        else { _Pragma("unroll") for (int j = 0; j < 4; ++j) Y[j] = *(const u32x2*)(YS + (size_t)_row * DM + 4 * c.lane + 256 * j); } \
        _Pragma("unroll") for (int j = 0; j < 4; ++j) X[j] = *(const u32x2*)(_xr + 4 * c.lane + 256 * j); } while (0)
    if (r0 < r1) EWL_LOAD(xa, ya, za, gAa, gBa, r0);
    if (r0 + 1 < r1) EWL_LOAD(xb, yb, zb, gAb, gBb, r0 + 1);
    for (int row = r0; row < r1; ++row) {
        bf16_t* xr = xrow_ptr(P, row); const int r = mod_r(row);
        if (r != rcur) { rcur = r; const float* mb = mods + (size_t)(l * 5 + r) * (NMOD * DM);
            ld_gate(G3, P.in[6] + (l * 4 + 3) * DM, mb + 5 * DM, c.lane);
            if (l < 3) { const float* mn = mods + (size_t)((l + 1) * 5 + r) * (NMOD * DM); ld_mod(A0, B0, P.in[6] + ((l + 1) * 4 + 0) * DM, mn + 0 * DM, mn + 1 * DM, c.lane); } }
        f32x4 x[4], y[4], h[4];
#pragma unroll
        for (int j = 0; j < 4; ++j) { x[j] = (f32x4){bflo(xa[j].x), bfhi(xa[j].x), bflo(xa[j].y), bfhi(xa[j].y)};
            y[j] = (f32x4){bflo(ya[j].x), bfhi(ya[j].x), bflo(ya[j].y), bfhi(ya[j].y)};
            if (odd) y[j] = y[j] * gAa + (f32x4){bflo(za[j].x), bfhi(za[j].x), bflo(za[j].y), bfhi(za[j].y)} * gBa;
            xa[j] = xb[j]; ya[j] = yb[j]; za[j] = zb[j]; }
        gAa = gAb; gBa = gBb;
        if (row + 2 < r1) EWL_LOAD(xb, yb, zb, gAb, gBb, row + 2);
        resid_add2(x, y, G3);
        bf16_t* hw = (dry ? (bf16_t*)(P.ws + WS_U + U_MIX) : HB) + (size_t)row * DM;
        if (l == 3 && !dry) { float* ow = P.out + (size_t)row * DM;
#pragma unroll
            for (int j = 0; j < 4; ++j) *(f32x4*)(ow + 4 * c.lane + 256 * j) = x[j]; }
        else { bf16_t* xw = dry ? (bf16_t*)(P.ws + WS_U + U_PB) + (size_t)row * DM : xr;
#pragma unroll
            for (int j = 0; j < 4; ++j) stbf4(xw + 4 * c.lane + 256 * j, x[j]); }
        if (l < 3) { norm_mod2(x, h, A0, B0);
            if (WIN8(l + 1)) { unsigned char* h8 = (unsigned char*)(dry ? (bf16_t*)(P.ws + WS_U + U_MIX) : HB) + (size_t)row * DM;
#pragma unroll
                for (int j = 0; j < 4; ++j) *(unsigned*)(h8 + 4 * c.lane + 256 * j) = pk4_fp8(h[j][0] * F8_ACT_SCALE, h[j][1] * F8_ACT_SCALE, h[j][2] * F8_ACT_SCALE, h[j][3] * F8_ACT_SCALE); }
            else {
#pragma unroll
                for (int j = 0; j < 4; ++j) stbf4(hw + 4 * c.lane + 256 * j, h[j]); } }
    }
#undef EWL_LOAD
}

__device__ __forceinline__ void attn_even(const Ctx& c_, int l) {
    const Ctx c = make_ctx(c_.lds);
    KParams& P = kparams(); const int i = l >> 1; const bool need_ctx = l < 3;
    const bf16_t* PB = (const bf16_t*)(P.ws + WS_U + U_PB); bf16_t* MIX = (bf16_t*)(P.ws + WS_U + U_MIX);
    const int nchunk = need_ctx ? 264 : 256;
    for (int u = opaque_bid(); u < nchunk * 4; u += gridDim.x) att::sgu_unit(c.lds, PB, (const bf16_t*)(P.ws + WS_SGUW) + (size_t)i * 4 * 128 * 128, P.in[10] + i * 512, (const float*)(P.ws + WS_STATS), P.in[11] + i * 512, MIX, (u >> 2) * 128, u & 3);
    float d1 = 0.f, d2 = 0.f;
    if (c.lane < 64) { d1 = P.in[12][i * 64 + c.lane] * P.in[13][i * 64 + c.lane]; d2 = P.in[14][i * 64 + c.lane] * P.in[15][i * 64 + c.lane]; }
    const float lam_init = 0.8f - 0.6f * expf(-0.3f * (float)l);
    const float lam = expf(wave_sum(d1)) - expf(wave_sum(d2)) + lam_init;
    att::Args a;
    a.Q = PB; a.ldq = EV_IN; a.K = PB; a.ldk = EV_IN; a.V = PB; a.ldv = EV_IN; a.C = 0.125f * LOG2E;
    a.rcos = (const float*)(P.ws + WS_ROPEB); a.rsin = a.rcos + SEQ * 32; a.O = MIX; a.ldo = DM; a.g = 0; a.u0 = 0; a.rpb = nullptr;
    a.lam = lam; a.oscale = 1.f - lam_init; a.subg = P.in[16] + i * 128; a.nt_ctx = 4;
    const int nctxu = need_ctx ? 32 : 0, nu = nctxu + 1024;
    for (int u = xcd_unit_base(); u < nu; u += gridDim.x) {
        int b, h;
        if (u < nctxu) { b = u >> 3; h = (u >> 1) & 3; a.q_row0 = NLAT + b * CTXL + (u & 1) * 128; a.nt_lat = 0; a.rope = 0; }
        else { const int v = u - nctxu; b = v >> 8; h = (v >> 6) & 3; a.q_row0 = b * SEQ + (v & 63) * 128; a.nt_lat = SEQ / 64; a.rope = 0; }
        a.qcol = 1024 + h * 128; a.kcol = 1536 + h * 128; a.vcol = 2048 + h * 128; a.ocol = 512 + h * 128;
        a.kctx_row0 = NLAT + b * CTXL; a.klat_row0 = b * SEQ;
        att::attn_unit<64, 128, 128, 1>(c.lds, a);
    }
}
__device__ __forceinline__ void attn_odd_na(const Ctx& c_, int l) {
    const Ctx c = make_ctx(c_.lds);
    KParams& P = kparams(); const int i = l >> 1; const bool need_ctx = l < 3;
    const bf16_t* PB = (const bf16_t*)(P.ws + WS_U + U_PB); bf16_t* MIX = (bf16_t*)(P.ws + WS_U + U_MIX);
    att::Args a;
    a.Q = PB; a.ldq = OD_INP; a.K = PB; a.ldk = OD_INP; a.V = PB; a.ldv = OD_INP; a.C = 0.125f * LOG2E; a.rope = 0; a.rcos = nullptr; a.rsin = nullptr;
    a.O = MIX; a.ldo = DM; a.lam = 0.f; a.oscale = 1.f; a.subg = nullptr; a.nt_ctx = 4;
    const int nctxu = need_ctx ? 32 : 0, nu = nctxu + 1024;
    for (int u = xcd_unit_base(); u < nu; u += gridDim.x) {
        int b, h;
        if (u < nctxu) { b = u >> 3; h = u & 7; a.q_row0 = NLAT + b * CTXL; a.nt_lat = 0; a.g = 0; a.u0 = 0; a.klat_row0 = 0; }
        else { const int v = u - nctxu; b = v >> 8; h = (v >> 5) & 7; const int g = v & 31; a.g = g; a.u0 = min(max(4 * g - 4, 0), 116);
            a.q_row0 = b * SEQ + g * 256; a.nt_lat = 12; a.klat_row0 = b * SEQ + a.u0 * 64; }
        a.qcol = h * 64; a.kcol = 512 + h * 64; a.vcol = 1024 + h * 64; a.ocol = h * 64; a.kctx_row0 = NLAT + b * CTXL;
        a.rpb = P.in[22] + ((size_t)i * 8 + h) * 465;
        att::attn_unit<64, 64, 64, 2>(c.lds, a);
    }
}
__device__ __forceinline__ void attn_odd_mla(const Ctx& c_, int l) {
    const Ctx c = make_ctx(c_.lds);
    KParams& P = kparams(); const bool need_ctx = l < 3;
    const bf16_t* MO = (const bf16_t*)(P.ws + WS_U + U_MLAO); bf16_t* MIX = (bf16_t*)(P.ws + WS_U + U_MIX);
    att::Args a;
    a.Q = MO; a.ldq = MLA_N; a.K = MO; a.ldk = MLA_N; a.V = MO; a.ldv = MLA_N; a.C = 0.10206207261596575f * LOG2E;
    a.rcos = (const float*)(P.ws + WS_ROPED); a.rsin = a.rcos + SEQ * 16; a.O = MIX; a.ldo = DM; a.g = 0; a.u0 = 0; a.rpb = nullptr; a.lam = 0.f; a.oscale = 1.f; a.subg = nullptr; a.nt_ctx = 4;
    const int nctxu = need_ctx ? 16 : 0, nu = nctxu + 512;
    for (int u = xcd_unit_base(); u < nu; u += gridDim.x) {
        int b, h;
        if (u < nctxu) { b = u >> 2; h = u & 3; a.q_row0 = NLAT + b * CTXL; a.nt_lat = 0; a.rope = 0; }
        else { const int v = u - nctxu; b = v >> 7; h = (v >> 5) & 3; a.q_row0 = b * SEQ + (v & 31) * 256; a.nt_lat = SEQ / 64; a.rope = 2; }
        a.qcol = h * 96; a.kcol = 384 + h * 96; a.vcol = 768 + h * 128; a.ocol = 512 + h * 128; a.kctx_row0 = NLAT + b * CTXL; a.klat_row0 = b * SEQ;
        att::attn_unit<96, 96, 128, 0>(c.lds, a);
    }
}

constexpr int N_PHASES = 2 + 2 * (7 + 9);
__global__ void __launch_bounds__(512, 2) fwd_kernel(Params prm) {
    extern __shared__ __attribute__((aligned(16))) unsigned char lds_raw[];
    LAS unsigned char* lds = (LAS unsigned char*)lds_raw;
    const Ctx c{lds, 0, 0, 0, 0, 0};
    for (int u = threadIdx.x; u < (LDS_BYTES - LDS_MISC) / 4; u += 512) ((LAS unsigned*)(lds + LDS_MISC))[u] = 0u;
    __syncthreads();
    XcdBarrier bar;
    { unsigned char* ws0 = kparams().ws; bar.bar = (unsigned*)(ws0 + WS_CTL) + CW_BAR; bar.x = 0; bar.st = nullptr;
#if !MK_PER_PHASE
      bar = xcd_barrier_post((unsigned*)(ws0 + WS_CTL) + CW_BAR, (volatile LAS unsigned*)(lds + LDS_MISC + 32));
#endif
    }
    int ph = 0;
#ifndef PMASK
#define PMASK 0xffffffffu
#endif
#define PM(b) ((PMASK >> (b)) & 1u)
#define PH_ON() (ph >= kparams().ph_lo && ph < kparams().ph_hi)
#define PH_END() do { if (ph >= kparams().ph_lo && ph + 1 < kparams().ph_hi) xcd_barrier(bar); ++ph; } while (0)
#define WSP(off) ((bf16_t*)(ws + (off)))
#define HB WSP(WS_HB)
#define PB WSP(WS_U + U_PB)
#define MIX WSP(WS_U + U_MIX)
#define YB WSP(WS_U + U_YB)
#define HID WSP(WS_U + U_HID)
#define YS WSP(WS_U + U_YS)
#define A2 WSP(WS_U + U_A2)
#define MO WSP(WS_U + U_MLAO)

    if (PM(0) && PH_ON()) for (int rep = 0; rep < DUPN(0); ++rep) { prologue0(c); __syncthreads(); }
    PH_END();
    if (PM(1) && PH_ON()) for (int rep = 0; rep < DUPN(1); ++rep) ew_first(c);
    PH_END();
    for (int lp = 0; lp < 2; ++lp) {
        {
            const int l = 2 * lp, i = lp; const int mtok = l < 3 ? MTOT : NLAT, nMt = mtok / 256;
            if (PM(2) && PH_ON()) for (int rep = 0; rep < DUPN(2); ++rep) { unsigned char* ws = kparams().ws; pg8::Gemm g{}; g.A = HB; g.lda = DM; g.Bt = (const unsigned char*)(ws + WS_WINE) + (size_t)i * EV_IN * DM * 2; g.K = DM; g.nM = MTOT / 256; g.nN = EV_IN / 256; g.grouped = 0; g.estride = 0;
                pg8::EpiEvenIn E{PB, EV_IN, (f32x2*)(ws + WS_STATS), (const float*)(ws + WS_ROPEB), (const float*)(ws + WS_ROPEB) + SEQ * 32, WIN8(l) ? F8_INV : 1.f}; if (WIN8(l)) gemm8_even_in(lds, g, E); else gemm_even_in(lds, g, E); if (rep == 0) convert_moe_tail(c, i, 0, 7296, (MTOT / 256) * (EV_IN / 256)); }
            PH_END();
            if (PM(4) && PH_ON()) for (int rep = 0; rep < DUPN(4); ++rep) attn_even(c, l);
            PH_END();
            if (PM(5) && PH_ON()) for (int rep = 0; rep < DUPN(5); ++rep) { unsigned char* ws = kparams().ws; pg8::Gemm g{}; g.A = MIX; g.lda = DM; g.Bt = (const bf16_t*)(ws + WS_WOUTE) + (size_t)i * DM * DM; g.K = DM; g.nM = nMt; g.nN = DM / 256; g.grouped = 0; g.estride = 0;
                gemm_bf16(lds, g, YB, DM); if (rep == 0) convert_moe_tail(c, i, 7296, 14592, nMt * (DM / 256)); }
            PH_END();
            if (PM(6) && PH_ON()) { if (DUPN(6) > 1) ew_mid(c, l, mtok, true); ew_mid(c, l, mtok); }
            PH_END();
            if (PM(7) && PH_ON()) for (int rep = 0; rep < DUPN(7); ++rep) { unsigned char* ws = kparams().ws; pg8::Gemm g{}; g.A = HB; g.lda = DM; g.Bt = (const unsigned char*)(ws + WS_W13E) + (size_t)i * 2 * DFF * DM * 2; g.K = DM; g.nM = nMt; g.nN = 2 * DFF / 256; g.grouped = 0; g.estride = 0;
                if (FFN8(i)) gemm8_swiglu8(lds, g, (unsigned char*)HID, DFF); else gemm_swiglu(lds, g, HID, DFF);
                if (rep == 0) convert_moe_tail(c, i, 14592, 20224, nMt * (2 * DFF / 256)); }
            PH_END();
            if (PM(8) && PH_ON()) for (int rep = 0; rep < DUPN(8); ++rep) { unsigned char* ws = kparams().ws; pg8::Gemm g{}; g.A = HID; g.lda = DFF; g.Bt = (const unsigned char*)(ws + WS_W2E) + (size_t)i * DM * DFF * 2; g.K = DFF; g.nM = nMt; g.nN = DM / 256; g.grouped = 0; g.estride = 0;
                if (FFN8(i)) gemm8_bf16(lds, g, YS, DM); else gemm_bf16(lds, g, YS, DM);
                if (rep == 0) convert_moe_tail(c, i, 20224, MOE_CVT_ITEMS, nMt * (DM / 256)); }
            PH_END();
            if (PM(9) && PH_ON()) { if (DUPN(9) > 1) ew_last(c, l, mtok, true); ew_last(c, l, mtok); }
            PH_END();
        }
        {
            const int l = 2 * lp + 1, i = lp; const int mtok = l < 3 ? MTOT : NLAT, nMt = mtok / 256;
            if (PM(10) && PH_ON()) for (int rep = 0; rep < DUPN(10); ++rep) { unsigned char* ws = kparams().ws; pg8::Gemm g{}; g.A = HB; g.lda = DM; g.Bt = (const unsigned char*)(ws + WS_WINO) + (size_t)i * OD_INP * DM * 2; g.K = DM; g.nM = MTOT / 256; g.nN = OD_INP / 256; g.grouped = 0; g.estride = 0;
                pg8::EpiOddIn E{PB, OD_INP, (float*)(ws + WS_STATS), (const float*)(ws + WS_ROPED), (const float*)(ws + WS_ROPED) + SEQ * 16, WIN8(l) ? F8_INV : 1.f}; if (WIN8(l)) gemm8_odd_in(lds, g, E); else gemm_odd_in(lds, g, E); }
            PH_END();
            if (PM(12) && PH_ON()) for (int rep = 0; rep < DUPN(12); ++rep) { unsigned char* ws = kparams().ws; pg8::Gemm g{}; g.A = PB + 1536; g.lda = OD_INP; g.Bt = (const bf16_t*)(ws + WS_WMLA) + (size_t)i * MLA_N * MLA_K; g.K = MLA_K; g.nM = MTOT / 256; g.nN = MLA_N / 256; g.grouped = 0; g.estride = 0;
                pg8::EpiMlaUp E{MO, MLA_N, (const float*)(ws + WS_STATS)}; gemm_mla_up(lds, g, E); }
            PH_END();
            if (PH_ON()) { if (PM(13)) for (int rep = 0; rep < DUPN(13); ++rep) attn_odd_na(c, l); if (PM(14)) for (int rep = 0; rep < DUPN(14); ++rep) attn_odd_mla(c, l); }
            PH_END();
            if (PM(15) && PH_ON()) for (int rep = 0; rep < DUPN(15); ++rep) { unsigned char* ws = kparams().ws; pg8::Gemm g{}; g.A = MIX; g.lda = DM; g.Bt = (const bf16_t*)(ws + WS_WOUTO) + (size_t)i * DM * DM; g.K = DM; g.nM = nMt; g.nN = DM / 256; g.grouped = 0; g.estride = 0;
                gemm_bf16(lds, g, YB, DM); }
            PH_END();
            if (PM(16) && PH_ON()) { if (DUPN(16) > 1) ew_mid(c, l, mtok, true); ew_mid(c, l, mtok); }
            PH_END();
            if (PM(17) && PH_ON()) for (int rep = 0; rep < DUPN(17); ++rep) moe_gather(c, i, mtok);
            PH_END();
            if (PM(18) && PH_ON()) for (int rep = 0; rep < DUPN(18); ++rep) { unsigned char* ws = kparams().ws; pg8::Gemm g{}; g.A = YS; g.lda = DM; g.Bt = (const bf16_t*)(ws + WS_W13M); g.K = DM; g.nN = 2 * DFFE / 256; g.grouped = 1; g.estride = (size_t)2 * DFFE * DM;
                moe_offsets(kparams(), i, g.toff); g.nM = g.toff[8];
#if MOE_F8
                gemm8_swiglu8(lds, g, (unsigned char*)HID, DFFE);
#else
                gemm_swiglu(lds, g, HID, DFFE);
#endif
            }
            PH_END();
            if (PM(19) && PH_ON()) for (int rep = 0; rep < DUPN(19); ++rep) { unsigned char* ws = kparams().ws; pg8::Gemm g{}; g.A = HID; g.lda = DFFE; g.Bt = (const bf16_t*)(ws + WS_W2M); g.K = DFFE; g.nN = DM / 256; g.grouped = 1; g.estride = (size_t)DM * DFFE;
                moe_offsets(kparams(), i, g.toff); g.nM = g.toff[8];
#if MOE_F8
                gemm8_bf16(lds, g, YS, DM);
#else
                gemm_bf16(lds, g, YS, DM);
#endif
            }
            PH_END();
            if (PM(20) && PH_ON()) { if (DUPN(20) > 1) ew_last(c, l, mtok, true); ew_last(c, l, mtok); }
            PH_END();
        }
    }
#undef PH_ON
#undef PH_END
#undef HB
#undef PB
#undef MIX
#undef YB
#undef HID
#undef YS
#undef A2
#undef MO
}

extern "C" void kernel_launch(void* const* d_in, const int* in_sizes, int n_in, void* d_out, int out_size, void* d_ws, size_t ws_size, hipStream_t stream) {
    static int grid = 0;
    if (grid == 0) {
        int dev = 0, cus = 0;
        if (n_in != 31 || out_size != NLAT * DM || ws_size < WS_END) { fprintf(stderr, "kernel_launch: unexpected shapes or workspace (n_in %d out %d ws %zu need %zu)\n", n_in, out_size, ws_size, (size_t)WS_END); grid = -1; }
        else if (hipGetDevice(&dev) != hipSuccess || hipDeviceGetAttribute(&cus, hipDeviceAttributeMultiprocessorCount, dev) != hipSuccess) grid = -1;
        else if (hipFuncSetAttribute((const void*)fwd_kernel, hipFuncAttributeMaxDynamicSharedMemorySize, LDS_BYTES) != hipSuccess) grid = -1;
        else { int per_cu = 0; (void)hipOccupancyMaxActiveBlocksPerMultiprocessor(&per_cu, (const void*)fwd_kernel, 512, LDS_BYTES); (void)hipGetLastError(); grid = cus; }
    }
    if (grid < 0) { (void)hipMemsetAsync(d_out, 0, (size_t)out_size * 4, stream); return; }
    (void)hipMemsetAsync((char*)d_ws + WS_CTL, 0, CTL_BYTES, stream);
    Params p{};
    for (int i = 0; i < 31; ++i) p.in[i] = (const float*)d_in[i];
    p.out = (float*)d_out; p.ws = (unsigned char*)d_ws;
#if MK_PER_PHASE
    for (int k = 0; k < N_PHASES; ++k) { p.ph_lo = k; p.ph_hi = k + 1; hipLaunchKernelGGL(fwd_kernel, dim3(grid), dim3(512), LDS_BYTES, stream, p); }
#else
    p.ph_lo = 0; p.ph_hi = N_PHASES;
    hipLaunchKernelGGL(fwd_kernel, dim3(grid), dim3(512), LDS_BYTES, stream, p);
#endif
}
```

```cpp
#include <hip/hip_runtime.h>
#include <stdint.h>
#include <stdio.h>

#ifndef MK_PER_PHASE
#define MK_PER_PHASE 0
#endif
#ifndef DUP_MASK
#define FOLD_GATHER 1
#define CHAIN_WOUT 1
#define DUP_MASK 0u
#endif
#define DUPN(b) (1 + (int)((DUP_MASK >> (b)) & 1u))
#ifndef FFN_F8
#define FFN_F8 1
#endif
#ifndef FFN_F8_FROM
#define FFN_F8_FROM 1
#endif
#define FFN8(i) (FFN_F8 && (i) >= FFN_F8_FROM)
#define FFN_F8D_FROM 0
#define FFN8D(i) (FFN_F8 && (i) >= FFN_F8D_FROM)
#ifndef WIN_F8_FROM
#define WIN_F8_FROM 2
#endif
#define WIN8(l) ((l) >= WIN_F8_FROM)
#ifndef MOE_F8
#define MOE_F8 1
#endif

#define LAS __attribute__((address_space(3)))
typedef unsigned short bf16_t;
typedef short bf16x8 __attribute__((ext_vector_type(8)));
typedef short s16x4 __attribute__((ext_vector_type(4)));
typedef float f32x4 __attribute__((ext_vector_type(4)));
typedef float f32x2 __attribute__((ext_vector_type(2)));
typedef float f32x16 __attribute__((ext_vector_type(16)));
typedef unsigned u32x4 __attribute__((ext_vector_type(4)));
typedef float f32x4u __attribute__((ext_vector_type(4), aligned(4)));
typedef unsigned u32x2 __attribute__((ext_vector_type(2)));

constexpr int DM = 1024, NB = 4, SEQ = 8192, NLAT = NB * SEQ, CTXL = 256, NCTX = NB * CTXL, MTOT = NLAT + NCTX;
constexpr int NMOD = 6;
constexpr int EV_IN = 2560, OD_IN = 1952, OD_INP = 2048, DFF = 2816, DFFE = 3584, NEXP = 8;
constexpr int MLA_N = 1280, MLA_K = 512;
constexpr int MS_MAX = 2 * MTOT + NEXP * 256;
constexpr float EPS = 1e-6f;
constexpr float LOG2E = 1.4426950408889634f;

constexpr size_t MiB = (size_t)1 << 20;
constexpr size_t WS_CTL = 0, CTL_BYTES = MiB;
constexpr size_t WS_MODS = 1 * MiB;
constexpr size_t WS_ROPEB = 2 * MiB;
constexpr size_t WS_ROPED = 4 * MiB;
constexpr size_t WS_SGUW = 5 * MiB;
constexpr size_t WS_TOKINFO = 6 * MiB;
constexpr size_t WS_TOKPOS = 8 * MiB;
constexpr size_t WS_CTXX = 10 * MiB;
constexpr size_t WS_WMLA = 14 * MiB;
constexpr size_t WS_WINE = 17 * MiB;
constexpr size_t WS_WOUTE = 27 * MiB;
constexpr size_t WS_W13E = 31 * MiB;
constexpr size_t WS_W2E = 53 * MiB;
constexpr size_t WS_WINO = 64 * MiB;
constexpr size_t WS_WOUTO = 72 * MiB;
constexpr size_t WS_W13M = 76 * MiB;
constexpr size_t WS_W2M = 188 * MiB;
constexpr size_t WS_HB = 244 * MiB;
constexpr size_t WS_U = 310 * MiB;
constexpr size_t U_PB = 0;
constexpr size_t U_MIX = 165 * MiB;
constexpr size_t U_A2 = 231 * MiB;
constexpr size_t U_MLAO = 264 * MiB;
constexpr size_t U_YB = 347 * MiB;
constexpr size_t U_HID = 0;
constexpr size_t U_XB = 549 * MiB;
constexpr size_t U_YS = 413 * MiB;
constexpr size_t WS_STATS = WS_U + 616 * MiB;
constexpr size_t WS_END = WS_STATS + 4 * MiB;
static_assert((size_t)MS_MAX * DFFE * (MOE_F8 ? 1 : 2) <= 347 * MiB && (size_t)MTOT * DFF * 2 <= 347 * MiB, "hid must stay clear of YB");
static_assert(U_YS + (size_t)MS_MAX * DM * 2 <= U_XB && U_XB + (size_t)MTOT * DM * 2 <= 616 * MiB, "ys / xb fit");

constexpr int CW_BAR = 4096;
constexpr int CW_MOECNT = 1024;
constexpr int CW_ARR = 200000;
constexpr int CW_DEP = 65536;

constexpr int LDS_BYTES = 147456;
constexpr int LDS_MISC = 131072;

__device__ __forceinline__ unsigned cvtpk(float lo, float hi) { unsigned r; asm("v_cvt_pk_bf16_f32 %0, %1, %2" : "=v"(r) : "v"(lo), "v"(hi)); return r; }
__device__ __forceinline__ float bf2f(unsigned short b) { return __uint_as_float(((unsigned)b) << 16); }
__device__ __forceinline__ float bflo(unsigned w) { return __uint_as_float(w << 16); }
__device__ __forceinline__ float bfhi(unsigned w) { return __uint_as_float(w & 0xffff0000u); }
__device__ __forceinline__ bf16_t f2bf(float f) { return (bf16_t)(cvtpk(f, 0.f) & 0xffffu); }
typedef int i32x8 __attribute__((ext_vector_type(8)));
typedef int i32x4 __attribute__((ext_vector_type(4)));
constexpr float F8_ACT_SCALE = 4.f, F8_W_SCALE = 64.f, F8_INV = 1.f / (F8_ACT_SCALE * F8_W_SCALE);
__device__ __forceinline__ unsigned pk4_fp8(float a, float b, float c, float d) {
    a = __builtin_amdgcn_fmed3f(a, -448.f, 448.f); b = __builtin_amdgcn_fmed3f(b, -448.f, 448.f); c = __builtin_amdgcn_fmed3f(c, -448.f, 448.f); d = __builtin_amdgcn_fmed3f(d, -448.f, 448.f);
    int w = 0; w = __builtin_amdgcn_cvt_pk_fp8_f32(a, b, w, false); w = __builtin_amdgcn_cvt_pk_fp8_f32(c, d, w, true); return (unsigned)w; }
template <int CTRL, int RM> __device__ __forceinline__ float dpp_get(float v) { return __int_as_float(__builtin_amdgcn_update_dpp(0, __float_as_int(v), CTRL, RM, 0xf, false)); }
__device__ __forceinline__ float wave_sum(float v) {
    v += dpp_get<0xB1, 0xf>(v);
    v += dpp_get<0x4E, 0xf>(v);
    v += dpp_get<0x141, 0xf>(v);
    v += dpp_get<0x140, 0xf>(v);
    v += dpp_get<0x142, 0xa>(v);
    v += dpp_get<0x143, 0xc>(v);
    return __int_as_float(__builtin_amdgcn_readlane(__float_as_int(v), 63));
}
__device__ __forceinline__ float fast_exp2(float x) { return __builtin_amdgcn_exp2f(x); }
__device__ __forceinline__ float fast_rcp(float x) { return __builtin_amdgcn_rcpf(x); }
__device__ __forceinline__ float silu_f(float x) { return x * fast_rcp(1.f + fast_exp2(-x * LOG2E)); }
__device__ __forceinline__ float gelu_tanh_f(float x) { const float arg = x * __builtin_fmaf(x * x, -0.1029432395800235f, -2.302208198144325f); return x * fast_rcp(1.f + fast_exp2(arg)); }
#define LDS_WAIT() asm volatile("s_waitcnt lgkmcnt(0)" ::: "memory")
#define VM_WAIT() asm volatile("s_waitcnt vmcnt(0)" ::: "memory")
__device__ __forceinline__ int opaque_bid() { int b = blockIdx.x; asm volatile("" : "+s"(b)); return b; }
__device__ __forceinline__ int xcd_unit_base() { const int b = opaque_bid(), G = (int)gridDim.x; return (G % 8 == 0) ? (b & 7) * (G >> 3) + (b >> 3) : b; }
__device__ __forceinline__ int opaque_tid() { int t = threadIdx.x; asm volatile("" : "+v"(t)); return t; }

#define XB_TMO      128
#define XB_XCNT(j)  (256  + 64 * (j))
#define XB_XSUB(j)  (1280 + 64 * (j))
#define XB_XGEN(j)  (2304 + 64 * (j))
#define XB_TOP      3328
#define XB_TOPGEN   3392
#define XCD_BAR_WORDS 3456
#define XB_SPIN_CAP (1u << 22)
__device__ __forceinline__ unsigned xb_ld(unsigned* p)              { return __hip_atomic_load(p, __ATOMIC_RELAXED, __HIP_MEMORY_SCOPE_AGENT); }
__device__ __forceinline__ unsigned xb_add(unsigned* p, unsigned v) { return __hip_atomic_fetch_add(p, v, __ATOMIC_RELAXED, __HIP_MEMORY_SCOPE_AGENT); }
__device__ __forceinline__ unsigned xb_xcc_id() { return (unsigned)__builtin_amdgcn_s_getreg((3 << 11) | 20) & 0xFu; }
#define XB_SPIN(cond, bar) do { unsigned _sp = 0; while (cond) { __builtin_amdgcn_s_sleep(1); \
    if ((++_sp & 255u) == 0u) { if (xb_ld(&(bar)[XB_TMO])) break; if (_sp > XB_SPIN_CAP) { atomicAdd(&(bar)[XB_TMO], 1u); break; } } } } while (0)
struct XcdBarrier { unsigned* bar; unsigned x; volatile LAS unsigned* st; };
__device__ __forceinline__ XcdBarrier xcd_barrier_post(unsigned* bar, volatile LAS unsigned* st) {
    XcdBarrier b; b.bar = bar; b.x = xb_xcc_id(); b.st = st;
    if (threadIdx.x == 0) (void)xb_add(&bar[XB_XCNT(b.x)], 1u);
    return b;
}
__device__ __forceinline__ void xcd_barrier_complete(unsigned* bar, unsigned x, unsigned& nloc, unsigned& nx) {
    const unsigned G = gridDim.x * gridDim.y * gridDim.z;
    unsigned sum, cnt, mine, sp = 0u;
    for (;;) {
        sum = 0u; cnt = 0u; mine = 0u;
#pragma unroll
        for (unsigned j = 0; j < 16; ++j) { const unsigned c = xb_ld(&bar[XB_XCNT(j)]); sum += c; cnt += (c > 0u) ? 1u : 0u; mine = (j == x) ? c : mine; }
        if (sum == G) break;
        __builtin_amdgcn_s_sleep(1);
        if ((++sp & 255u) == 0u) { if (xb_ld(&bar[XB_TMO])) break; if (sp > XB_SPIN_CAP) { atomicAdd(&bar[XB_TMO], 1u); break; } }
    }
    nloc = mine > 0u ? mine : 1u; nx = cnt > 0u ? cnt : 1u;
}
__device__ __forceinline__ void xcd_barrier(const XcdBarrier& b) {
    asm volatile("s_waitcnt vmcnt(0)" ::: "memory");
    __syncthreads();
    if (threadIdx.x == 0) {
        unsigned* bar = b.bar;
        __builtin_amdgcn_s_waitcnt(0);
        unsigned nloc = b.st[0], nx = b.st[1];
        if (nloc == 0u) { xcd_barrier_complete(bar, b.x, nloc, nx); b.st[0] = nloc; b.st[1] = nx; }
        const unsigned old = xb_add(&bar[XB_XSUB(b.x)], 1u);
        const unsigned gen = old / nloc;
        if (old + 1u == (gen + 1u) * nloc) {
            __builtin_amdgcn_fence(__ATOMIC_RELEASE, "agent");
            asm volatile("s_waitcnt vmcnt(0)" ::: "memory");
            const unsigned og = xb_add(&bar[XB_TOP], 1u);
            const unsigned tg = og / nx;
            if (og + 1u == (tg + 1u) * nx) xb_add(&bar[XB_TOPGEN], 1u);
            else XB_SPIN(xb_ld(&bar[XB_TOPGEN]) == tg, bar);
            __builtin_amdgcn_fence(__ATOMIC_ACQUIRE, "agent");
            xb_add(&bar[XB_XGEN(b.x)], 1u);
            asm volatile("s_waitcnt vmcnt(0)" ::: "memory");
        } else {
            XB_SPIN(xb_ld(&bar[XB_XGEN(b.x)]) == gen, bar);
            __builtin_amdgcn_fence(__ATOMIC_ACQUIRE, "agent");
            asm volatile("s_waitcnt vmcnt(0)" ::: "memory");
        }
    }
    __syncthreads();
}

namespace pg8 {
constexpr int BM = 256, BK = 64, HALF = 128, HTB = HALF * BK * 2, STAGE_BYTES = 8 * HTB, NXCD = 8, WGM = 4;
__device__ __forceinline__ int lds_byte(int r, int c) { const int st = (r >> 4) * 2 + (c >> 5), rr = r & 15, cc = c & 31, ob = rr * 64 + cc * 2; return st * 1024 + (ob ^ (((ob >> 9) & 1) << 5)); }
__device__ __forceinline__ void stage_rc(int b, int& R, int& C) { const int st = b / 1024, sb = b % 1024, swz = sb ^ (((sb >> 9) & 1) << 5); R = (st >> 1) * 16 + swz / 64; C = (st & 1) * 32 + (swz % 64) / 2; }
__device__ __forceinline__ int perm32(int rho) { const int n = rho >> 4, i = rho & 15; return 8 * (i >> 2) + 4 * n + (i & 3); }
struct Unit { int pm, pn, e; };
struct Gemm {
    const void* A; int lda;
    const void* Bt; int K;
    int nM, nN;
    int grouped; int toff[9]; size_t estride;
    unsigned* sig; int nMl;
};
struct StaticOrder {
    int nM, nN, nwg, G, c, nMl;
    __device__ void init(int nM_, int nN_, int G_, int c_, int nMl_ = 0) { nM = nM_; nN = nN_; nwg = nM * nN; G = G_; c = c_; nMl = nMl_; }
    __device__ __forceinline__ bool next(int i, Unit& u) const {
        const long L = (long)i * G + c; if (L >= nwg) return false;
        const int nMe = nMl ? nMl : nM, nwe = nMe * nN;
        if (L >= nwe) { const int t = (int)L - nwe; u.pm = nMe + t / nN; u.pn = t % nN; u.e = 0; return true; }
        int wgid = (int)L; { const int q = nwe / NXCD, r = nwe % NXCD, xcd = wgid % NXCD, off = wgid / NXCD; wgid = (xcd < r ? xcd * (q + 1) : r * (q + 1) + (xcd - r) * q) + off; }
        const int nig = WGM * nN, gid = wgid / nig, fm = gid * WGM, gsz = (nMe - fm) < WGM ? (nMe - fm) : WGM;
        u.pm = fm + ((wgid % nig) % gsz); u.pn = (wgid % nig) / gsz; u.e = 0; return true;
    }
};
struct EpiBf16 {
    bf16_t* O; int ldc; float scale; int wt;
    __device__ __forceinline__ void operator()(const f32x4 (&acc)[2][2][4][2], const Unit& u, int wr, int wc, int fr, int fq) const {
        const int row0 = u.pm * BM + wr * 64 + fr, col0 = u.pn * BM + wc * 32 + 8 * fq;
#pragma unroll
        for (int ai = 0; ai < 2; ++ai)
#pragma unroll
            for (int m = 0; m < 4; ++m) { bf16_t* rowp = O + (size_t)(row0 + ai * HALF + m * 16) * ldc + col0;
#pragma unroll
                for (int bj = 0; bj < 2; ++bj) { const f32x4 v0 = acc[ai][bj][m][0] * scale, v1 = acc[ai][bj][m][1] * scale;
                    u32x4 w; w.x = cvtpk(v0[0], v0[1]); w.y = cvtpk(v0[2], v0[3]); w.z = cvtpk(v1[0], v1[1]); w.w = cvtpk(v1[2], v1[3]);
                    if (wt) asm volatile("global_store_dwordx4 %0, %1, off sc1\n\ts_nop 2" :: "v"(rowp + bj * HALF), "v"(w) : "memory");
                    else *(u32x4*)(rowp + bj * HALF) = w; } }
    }
};
__device__ __forceinline__ f32x4 swiglu4(f32x4 a, f32x4 b, float k1, float k2) {
    const f32x4 t = a * k1; f32x4 d;
#pragma unroll
    for (int j = 0; j < 4; ++j) d[j] = fast_exp2(t[j]);
    const float k2i = 1.f / k2;
    d = d * k2i + k2i; f32x4 r;
#pragma unroll
    for (int j = 0; j < 4; ++j) r[j] = fast_rcp(d[j]);
    return (a * b) * r;
}
struct EpiSwiGLU {
    bf16_t* O; int ldc;
    __device__ __forceinline__ void operator()(const f32x4 (&acc)[2][2][4][2], const Unit& u, int wr, int wc, int fr, int fq) const {
        const int row0 = u.pm * BM + wr * 64 + fr, col0 = u.pn * HALF + wc * 32 + 8 * fq;
#pragma unroll
        for (int ai = 0; ai < 2; ++ai)
#pragma unroll
            for (int m = 0; m < 4; ++m) { bf16_t* rowp = O + (size_t)(row0 + ai * HALF + m * 16) * ldc + col0;
                const f32x4 r0 = swiglu4(acc[ai][0][m][0], acc[ai][1][m][0], -LOG2E, 1.f), r1 = swiglu4(acc[ai][0][m][1], acc[ai][1][m][1], -LOG2E, 1.f);
                u32x4 w; w.x = cvtpk(r0[0], r0[1]); w.y = cvtpk(r0[2], r0[3]); w.z = cvtpk(r1[0], r1[1]); w.w = cvtpk(r1[2], r1[3]);
                *(u32x4*)rowp = w; }
    }
};

struct EpiEvenIn {
    bf16_t* O; int ldc; f32x2* stats; const float* rcos; const float* rsin; float scale;
    __device__ __forceinline__ void operator()(const f32x4 (&acc)[2][2][4][2], const Unit& u, int wr, int wc, int fr, int fq) const {
        int upm = u.pm, upn = u.pn; asm volatile("" : "+s"(upm), "+s"(upn));
        const int row0 = upm * BM + wr * 64 + fr, col0 = upn * BM + wc * 32 + 8 * fq;
        const int kind = upn < 2 ? 0 : (upn < 4 ? 1 : (upn < 8 ? 2 : 3)); const bool lat = upm < NLAT / BM; const int t4 = 4 * (4 * (wc & 1) + fq);
        f32x4 csA[2][4], snA[2][4];
        if (kind == 2) {
#pragma unroll
            for (int ai = 0; ai < 2; ++ai)
#pragma unroll
                for (int m = 0; m < 4; ++m) { const int sp = (row0 + ai * HALF + m * 16) & (SEQ - 1);
                    if (lat) { csA[ai][m] = *(const f32x4*)(rcos + sp * 32 + t4); snA[ai][m] = *(const f32x4*)(rsin + sp * 32 + t4); }
                    else { csA[ai][m] = (f32x4){1.f, 1.f, 1.f, 1.f}; snA[ai][m] = (f32x4){0.f, 0.f, 0.f, 0.f}; } }
        }
#pragma unroll
        for (int ai = 0; ai < 2; ++ai)
#pragma unroll
            for (int m = 0; m < 4; ++m) { const int row = row0 + ai * HALF + m * 16; bf16_t* rowp = O + (size_t)row * ldc + col0;
                float s1 = 0.f, s2 = 0.f;
#pragma unroll
                for (int bj = 0; bj < 2; ++bj) { f32x4 v0 = acc[ai][bj][m][0] * scale, v1 = acc[ai][bj][m][1] * scale;
                    if (kind < 2) {
#pragma unroll
                        for (int j = 0; j < 4; ++j) { v0[j] = gelu_tanh_f(v0[j]); v1[j] = gelu_tanh_f(v1[j]); }
                        if (kind == 1) { s1 += (v0[0] + v0[1]) + (v0[2] + v0[3]) + (v1[0] + v1[1]) + (v1[2] + v1[3]);
                            s2 += (v0[0] * v0[0] + v0[1] * v0[1]) + (v0[2] * v0[2] + v0[3] * v0[3]) + (v1[0] * v1[0] + v1[1] * v1[1]) + (v1[2] * v1[2] + v1[3] * v1[3]); } }
                    else if (kind == 2) { const f32x4 cs = csA[ai][m], sn = snA[ai][m]; const f32x4 o0 = v0 * cs - v1 * sn, o1 = v1 * cs + v0 * sn; v0 = o0; v1 = o1; }
                    u32x4 w; w.x = cvtpk(v0[0], v0[1]); w.y = cvtpk(v0[2], v0[3]); w.z = cvtpk(v1[0], v1[1]); w.w = cvtpk(v1[2], v1[3]);
                    *(u32x4*)(rowp + bj * HALF) = w; }
                if (kind == 1) { s1 += __shfl_xor(s1, 16); s1 += __shfl_xor(s1, 32); s2 += __shfl_xor(s2, 16); s2 += __shfl_xor(s2, 32);
                    if (fq == 0) stats[(size_t)row * 8 + (upn - 2) * 4 + wc] = (f32x2){s1, s2}; } }
    }
};
struct EpiOddIn {
    bf16_t* O; int ldc; float* stats; const float* rcos; const float* rsin; float scale;
    __device__ __forceinline__ void operator()(const f32x4 (&acc)[2][2][4][2], const Unit& u, int wr, int wc, int fr, int fq) const {
        int upm = u.pm, upn = u.pn; asm volatile("" : "+s"(upm), "+s"(upn));
        const int row0 = upm * BM + wr * 64 + fr, col0 = upn * BM + wc * 32 + 8 * fq; const bool lat = upm < NLAT / BM;
        const bool ropet = (upn == 7) && (wc == 0) && lat;
        f32x4 csA[2][4], snA[2][4];
        if (ropet) {
#pragma unroll
            for (int ai = 0; ai < 2; ++ai)
#pragma unroll
                for (int m = 0; m < 4; ++m) { const int sp = (row0 + ai * HALF + m * 16) & (SEQ - 1); csA[ai][m] = *(const f32x4*)(rcos + sp * 16 + 4 * fq); snA[ai][m] = *(const f32x4*)(rsin + sp * 16 + 4 * fq); }
        }
#pragma unroll
        for (int ai = 0; ai < 2; ++ai)
#pragma unroll
            for (int m = 0; m < 4; ++m) { const int row = row0 + ai * HALF + m * 16; bf16_t* rowp = O + (size_t)row * ldc + col0; float ss = 0.f;
#pragma unroll
                for (int bj = 0; bj < 2; ++bj) { f32x4 v0 = acc[ai][bj][m][0] * scale, v1 = acc[ai][bj][m][1] * scale;
                    if (upn == 6 || (upn == 7 && bj == 0)) ss += (v0[0] * v0[0] + v0[1] * v0[1]) + (v0[2] * v0[2] + v0[3] * v0[3]) + (v1[0] * v1[0] + v1[1] * v1[1]) + (v1[2] * v1[2] + v1[3] * v1[3]);
                    if (ropet && bj == 1) { const f32x4 cs = csA[ai][m], sn = snA[ai][m];
                        const f32x4 o0 = v0 * cs - v1 * sn, o1 = v1 * cs + v0 * sn; v0 = o0; v1 = o1; }
                    u32x4 w; w.x = cvtpk(v0[0], v0[1]); w.y = cvtpk(v0[2], v0[3]); w.z = cvtpk(v1[0], v1[1]); w.w = cvtpk(v1[2], v1[3]);
                    *(u32x4*)(rowp + bj * HALF) = w; }
                if (upn >= 6) { ss += __shfl_xor(ss, 16); ss += __shfl_xor(ss, 32); if (fq == 0) stats[(size_t)row * 8 + (upn - 6) * 4 + wc] = ss; } }
    }
};
struct EpiMlaUp {
    bf16_t* O; int ldc; const float* stats;
    __device__ __forceinline__ void operator()(const f32x4 (&acc)[2][2][4][2], const Unit& u, int wr, int wc, int fr, int fq) const {
        const int row0 = u.pm * BM + wr * 64 + fr, col0 = u.pn * BM + wc * 32 + 8 * fq;
        f32x4 pqA[2][4], pkA[2][4]; float rqA[2][4], rkA[2][4];
#pragma unroll
        for (int ai = 0; ai < 2; ++ai)
#pragma unroll
            for (int m = 0; m < 4; ++m) { const int row = row0 + ai * HALF + m * 16; pqA[ai][m] = *(const f32x4*)(stats + (size_t)row * 8); pkA[ai][m] = *(const f32x4*)(stats + (size_t)row * 8 + 4); }
#pragma unroll
        for (int ai = 0; ai < 2; ++ai)
#pragma unroll
            for (int m = 0; m < 4; ++m) { const f32x4 pq = pqA[ai][m], pk = pkA[ai][m];
                rqA[ai][m] = rsqrtf(((pq[0] + pq[1]) + (pq[2] + pq[3])) * (1.f / 256.f) + EPS); rkA[ai][m] = rsqrtf(((pk[0] + pk[1]) + (pk[2] + pk[3])) * (1.f / 128.f) + EPS); }
#pragma unroll
        for (int ai = 0; ai < 2; ++ai)
#pragma unroll
            for (int m = 0; m < 4; ++m) { const int row = row0 + ai * HALF + m * 16; bf16_t* rowp = O + (size_t)row * ldc + col0;
                const float rq = rqA[ai][m], rk = rkA[ai][m];
#pragma unroll
                for (int bj = 0; bj < 2; ++bj) { const int c0 = col0 + bj * HALF; const float sc = c0 < 384 ? rq : (c0 < 768 ? (((c0 - 384) % 96) < 64 ? rk : 1.f) : rk);
                    const f32x4 v0 = acc[ai][bj][m][0] * sc, v1 = acc[ai][bj][m][1] * sc;
                    u32x4 w; w.x = cvtpk(v0[0], v0[1]); w.y = cvtpk(v0[2], v0[3]); w.z = cvtpk(v1[0], v1[1]); w.w = cvtpk(v1[2], v1[3]);
                    *(u32x4*)(rowp + bj * HALF) = w; } }
    }
};
struct EpiSwiGLU8 {
    unsigned char* O; int ldc; float scale;
    __device__ __forceinline__ void operator()(const f32x4 (&acc)[2][2][4][2], const Unit& u, int wr, int wc, int fr, int fq) const {
        const int row0 = u.pm * BM + wr * 64 + fr, col0 = u.pn * HALF + wc * 32 + 8 * fq;
#pragma unroll
        for (int ai = 0; ai < 2; ++ai)
#pragma unroll
            for (int m = 0; m < 4; ++m) { unsigned char* rowp = O + (size_t)(row0 + ai * HALF + m * 16) * ldc + col0;
                const float k1 = -LOG2E * scale, k2 = F8_ACT_SCALE * scale * scale;
                const f32x4 r0 = swiglu4(acc[ai][0][m][0], acc[ai][1][m][0], k1, k2), r1 = swiglu4(acc[ai][0][m][1], acc[ai][1][m][1], k1, k2);
                u32x2 w; w.x = pk4_fp8(r0[0], r0[1], r0[2], r0[3]); w.y = pk4_fp8(r1[0], r1[1], r1[2], r1[3]);
                *(u32x2*)rowp = w; }
    }
};

template <class Epi, bool F8 = false>
__device__ __forceinline__ void gemm_phase(LAS unsigned char* lds, const Gemm& g, const Epi& E) {
    const int tid = opaque_tid(), wid = __builtin_amdgcn_readfirstlane(tid >> 6), lane = tid & 63, wr = wid >> 2, wc = wid & 3, fr = lane & 15, fq = lane >> 4;
    constexpr int ES = F8 ? 1 : 2;
    const int K = g.K, nt = K * ES / (BK * 2), lda = g.lda;
    StaticOrder S; S.init(g.nM, g.nN, (int)gridDim.x, opaque_bid(), g.nMl);
    unsigned voffA[2], voffB[2];
#pragma unroll
    for (int i = 0; i < 2; ++i) { int R, C; stage_rc(tid * 16 + i * 8192, R, C); const int Rb = (R & ~31) + perm32(R & 31);
        voffA[i] = (unsigned)(R * lda * ES + C * 2); voffB[i] = (unsigned)(Rb * K * ES + C * 2); }
    const size_t kstep = (size_t)(BK * 2);
    const size_t hA = (size_t)HALF * lda * ES, tA = 2 * hA, hB = (size_t)HALF * K * ES, tB = 2 * hB;
    const unsigned ldsw = (unsigned)wid * 1024u;
    const int aoff = lds_byte(wr * 64 + fr, fq * 8), boff = lds_byte(wc * 32 + fr, fq * 8);
#define PG8_SA(b, h) (((b) * 2 + (h)) * HTB)
#define PG8_SB(b, h) ((4 + (b) * 2 + (h)) * HTB)
#define PG8_STAGE(bufoff, gbase, voff) do { _Pragma("unroll") for (int _i = 0; _i < 2; ++_i) \
        __builtin_amdgcn_global_load_lds((const unsigned*)((const char*)(gbase) + (voff)[_i]), (LAS unsigned*)(lds + (bufoff) + ldsw + _i * 8192), 16, 0, 0); } while (0)
#define PG8_LD8(base) __builtin_shufflevector(*(const LAS i32x4*)(base), *(const LAS i32x4*)((base) + 1024), 0, 1, 2, 3, 4, 5, 6, 7)
#define PG8_LDA(dst, b, h) do { _Pragma("unroll") for (int m = 0; m < 4; ++m) dst[m] = PG8_LD8(lds + PG8_SA(b, h) + aoff + m * 2048); } while (0)
#define PG8_LDB(dst, b, h) do { _Pragma("unroll") for (int n = 0; n < 2; ++n) dst[n] = PG8_LD8(lds + PG8_SB(b, h) + boff + n * 2048); } while (0)
#define PG8_H0(x) __builtin_bit_cast(bf16x8, __builtin_shufflevector(x, x, 0, 1, 2, 3))
#define PG8_H1(x) __builtin_bit_cast(bf16x8, __builtin_shufflevector(x, x, 4, 5, 6, 7))
#define PG8_MMA(ai, bj, At, Bt) do { __builtin_amdgcn_s_setprio(1); _Pragma("unroll") for (int m = 0; m < 4; ++m) _Pragma("unroll") for (int n = 0; n < 2; ++n) { \
        if constexpr (F8) asm volatile("v_mfma_f32_16x16x128_f8f6f4 %0, %1, %2, %0" : "+v"(acc[ai][bj][m][n]) : "v"(Bt[n]), "v"(At[m])); \
        else { acc[ai][bj][m][n] = __builtin_amdgcn_mfma_f32_16x16x32_bf16(PG8_H0(Bt[n]), PG8_H0(At[m]), acc[ai][bj][m][n], 0, 0, 0); \
               acc[ai][bj][m][n] = __builtin_amdgcn_mfma_f32_16x16x32_bf16(PG8_H1(Bt[n]), PG8_H1(At[m]), acc[ai][bj][m][n], 0, 0, 0); } } \
        __builtin_amdgcn_s_setprio(0); } while (0)
#define PG8_WAIT_V(n) asm volatile("s_waitcnt vmcnt(" #n ")" ::: "memory")
#define PG8_WAIT_L(n) asm volatile("s_waitcnt lgkmcnt(" #n ")" ::: "memory")
#define PG8_BAR __builtin_amdgcn_s_barrier()
#define PG8_SCHED __builtin_amdgcn_sched_barrier(0)
#define PG8_EXPERT(u) do { if (g.grouped) { int _e = 0; _Pragma("unroll") for (int _k = 1; _k < 8; ++_k) _e += ((u).pm >= g.toff[_k]) ? 1 : 0; (u).e = _e; } } while (0)
    Unit cur, nxt; int ui = 0;
    if (!S.next(0, cur)) return;
    PG8_EXPERT(cur);
    f32x4 acc[2][2][4][2];
#pragma unroll
    for (int a = 0; a < 2; ++a)
#pragma unroll
        for (int b = 0; b < 2; ++b)
#pragma unroll
            for (int m = 0; m < 4; ++m)
#pragma unroll
                for (int n = 0; n < 2; ++n) acc[a][b][m][n] = (f32x4){0.f, 0.f, 0.f, 0.f};
    i32x8 At[4], B0[2], B1[2];
    const char* cA = (const char*)g.A + (size_t)cur.pm * tA; const char* cB = ((const char*)g.Bt + (size_t)cur.e * g.estride * ES) + (size_t)cur.pn * tB;
    PG8_STAGE(PG8_SB(0, 0), cB, voffB); PG8_STAGE(PG8_SA(0, 0), cA, voffA); PG8_STAGE(PG8_SB(0, 1), cB + hB, voffB); PG8_STAGE(PG8_SA(0, 1), cA + hA, voffA);
    if (wr == 1) PG8_BAR;
    PG8_WAIT_V(4); PG8_BAR;
    PG8_STAGE(PG8_SB(1, 0), cB + kstep, voffB); PG8_STAGE(PG8_SA(1, 0), cA + kstep, voffA); PG8_STAGE(PG8_SB(1, 1), cB + hB + kstep, voffB);
    PG8_WAIT_V(6); PG8_BAR;
    for (;;) {
        const bool has_next = S.next(ui + 1, nxt);
        if (has_next) PG8_EXPERT(nxt);
        const char* nA = has_next ? (const char*)g.A + (size_t)nxt.pm * tA : cA; const char* nB = has_next ? ((const char*)g.Bt + (size_t)nxt.e * g.estride * ES) + (size_t)nxt.pn * tB : cB;
        for (int t = 0; t < nt; t += 2) {
            const bool last = (t == nt - 2);
            const char* a1 = cA + (size_t)(t + 1) * kstep;
            const char* a2 = last ? nA : cA + (size_t)(t + 2) * kstep; const char* b2 = last ? nB : cB + (size_t)(t + 2) * kstep;
            const char* a3 = a2 + kstep; const char* b3 = b2 + kstep;
            PG8_LDB(B0, 0, 0); PG8_SCHED; PG8_LDA(At, 0, 0); PG8_STAGE(PG8_SA(1, 1), a1 + hA, voffA);
            PG8_WAIT_L(8); PG8_BAR; PG8_WAIT_L(0); PG8_MMA(0, 0, At, B0); PG8_BAR; PG8_SCHED;
            PG8_LDB(B1, 0, 1); PG8_STAGE(PG8_SB(0, 0), b2, voffB);
            PG8_BAR; PG8_WAIT_L(0); PG8_MMA(0, 1, At, B1); PG8_BAR;
            PG8_LDA(At, 0, 1); PG8_STAGE(PG8_SA(0, 0), a2, voffA);
            PG8_BAR; PG8_WAIT_L(0); PG8_MMA(1, 0, At, B0); PG8_BAR; PG8_SCHED;
            PG8_STAGE(PG8_SB(0, 1), b2 + hB, voffB);
            PG8_WAIT_V(6); PG8_BAR; PG8_MMA(1, 1, At, B1); PG8_BAR;
            PG8_LDB(B0, 1, 0); PG8_SCHED; PG8_LDA(At, 1, 0); PG8_STAGE(PG8_SA(0, 1), a2 + hA, voffA);
            PG8_WAIT_L(8); PG8_BAR; PG8_WAIT_L(0); PG8_MMA(0, 0, At, B0); PG8_BAR; PG8_SCHED;
            PG8_LDB(B1, 1, 1); PG8_STAGE(PG8_SB(1, 0), b3, voffB);
            PG8_BAR; PG8_WAIT_L(0); PG8_MMA(0, 1, At, B1); PG8_BAR;
            PG8_LDA(At, 1, 1); PG8_STAGE(PG8_SA(1, 0), a3, voffA);
            PG8_BAR; PG8_WAIT_L(0); PG8_MMA(1, 0, At, B0); PG8_BAR; PG8_SCHED;
            PG8_STAGE(PG8_SB(1, 1), b3 + hB, voffB);
            PG8_WAIT_V(6); PG8_BAR; PG8_MMA(1, 1, At, B1); PG8_BAR;
        }
        if constexpr (F8) { PG8_SCHED; asm volatile("s_nop 15\n\ts_nop 15" ::: "memory"); PG8_SCHED; }
        E(acc, cur, wr, wc, fr, fq);
        if (g.sig) { PG8_WAIT_V(0); PG8_BAR; if (wid == 4 && lane == 0) (void)xb_add(g.sig + cur.pm * 64, 1u); }
        if (!has_next) break;
#pragma unroll
        for (int a = 0; a < 2; ++a)
#pragma unroll
            for (int b = 0; b < 2; ++b)
#pragma unroll
                for (int m = 0; m < 4; ++m)
#pragma unroll
                    for (int n = 0; n < 2; ++n) acc[a][b][m][n] = (f32x4){0.f, 0.f, 0.f, 0.f};
        cur = nxt; cA = nA; cB = nB; ++ui;
    }
    PG8_WAIT_V(0);
    if (wr == 0) PG8_BAR;
    PG8_BAR;
#undef PG8_SA
#undef PG8_SB
#undef PG8_STAGE
#undef PG8_LDA
#undef PG8_LDB
#undef PG8_MMA
#undef PG8_H0
#undef PG8_H1
#undef PG8_LD8
#undef PG8_WAIT_V
#undef PG8_WAIT_L
#undef PG8_BAR
#undef PG8_SCHED
#undef PG8_EXPERT
}
}

__device__ __forceinline__ void gemm_bf16(LAS unsigned char* lds, const pg8::Gemm& g, bf16_t* O, int ldc, int wt = 0) { pg8::EpiBf16 E{O, ldc, 1.f, wt}; pg8::gemm_phase(lds, g, E); }
__device__ __forceinline__ void gemm_even_in(LAS unsigned char* lds, const pg8::Gemm& g, const pg8::EpiEvenIn& E) { pg8::gemm_phase(lds, g, E); }
__device__ __forceinline__ void gemm8_even_in(LAS unsigned char* lds, const pg8::Gemm& g, const pg8::EpiEvenIn& E) { pg8::gemm_phase<pg8::EpiEvenIn, true>(lds, g, E); }
__device__ __forceinline__ void gemm8_odd_in(LAS unsigned char* lds, const pg8::Gemm& g, const pg8::EpiOddIn& E) { pg8::gemm_phase<pg8::EpiOddIn, true>(lds, g, E); }
__device__ __forceinline__ void gemm_odd_in(LAS unsigned char* lds, const pg8::Gemm& g, const pg8::EpiOddIn& E) { pg8::gemm_phase(lds, g, E); }
__device__ __forceinline__ void gemm_mla_up(LAS unsigned char* lds, const pg8::Gemm& g, const pg8::EpiMlaUp& E) { pg8::gemm_phase(lds, g, E); }
__device__ __forceinline__ void gemm8_bf16(LAS unsigned char* lds, const pg8::Gemm& g, bf16_t* O, int ldc) { pg8::EpiBf16 E{O, ldc, F8_INV, 0}; pg8::gemm_phase<pg8::EpiBf16, true>(lds, g, E); }
__device__ __forceinline__ void gemm8_swiglu8(LAS unsigned char* lds, const pg8::Gemm& g, unsigned char* O, int ldc) { pg8::EpiSwiGLU8 E{O, ldc, F8_INV}; pg8::gemm_phase<pg8::EpiSwiGLU8, true>(lds, g, E); }
__device__ __forceinline__ void gemm_swiglu(LAS unsigned char* lds, const pg8::Gemm& g, bf16_t* O, int ldc) { pg8::EpiSwiGLU E{O, ldc}; pg8::gemm_phase(lds, g, E); }
__device__ __forceinline__ void gemm_swiglu_to8(LAS unsigned char* lds, const pg8::Gemm& g, unsigned char* O, int ldc) { pg8::EpiSwiGLU8 E{O, ldc, 1.f}; pg8::gemm_phase<pg8::EpiSwiGLU8, false>(lds, g, E); }

namespace att {
#define SBAR() __builtin_amdgcn_sched_barrier(0)
__device__ __forceinline__ int crow(int r, int hi) { return (r & 3) + 8 * (r >> 2) + 4 * hi; }
__device__ __forceinline__ int v_st(int k, int c) { const int kk = (k & ~0xC) | ((k & 4) << 1) | ((k & 8) >> 1); return ((kk >> 3) * 4 + (c >> 5)) * 512 + ((kk & 7) * 32 + (c & 31)) * 2; }
__device__ __forceinline__ int v_st_plain(int k, int c) { return ((k >> 3) * 4 + (c >> 5)) * 512 + ((k & 7) * 32 + (c & 31)) * 2; }
__device__ __forceinline__ int v_rd_base(int lane) { return ((lane & 3) << 3) | (((lane >> 2) & 3) << 6) | (((lane >> 4) & 1) << 5) | (((lane >> 5) & 1) << 8); }
constexpr int v_rd_off(int d0, int ks, int half) { return d0 * 512 + ks * 4096 + half * 2048; }
template <int OFF> __device__ __forceinline__ s16x4 tr_read(unsigned vb) {
    s16x4 r; asm volatile("ds_read_b64_tr_b16 %0, %1 offset:%2" : "=&v"(r) : "v"(vb), "i"(OFF) : "memory"); return r;
}
template <int D0> __device__ __forceinline__ void pv_one(f32x16& od, unsigned vb, bf16x8 pa0, bf16x8 pa1, bf16x8 pa2, bf16x8 pa3) {
    const s16x4 l0 = tr_read<v_rd_off(D0, 0, 0)>(vb), h0 = tr_read<v_rd_off(D0, 0, 1)>(vb), l1 = tr_read<v_rd_off(D0, 1, 0)>(vb), h1 = tr_read<v_rd_off(D0, 1, 1)>(vb);
    const s16x4 l2 = tr_read<v_rd_off(D0, 2, 0)>(vb), h2 = tr_read<v_rd_off(D0, 2, 1)>(vb), l3 = tr_read<v_rd_off(D0, 3, 0)>(vb), h3 = tr_read<v_rd_off(D0, 3, 1)>(vb);
    asm volatile("s_waitcnt lgkmcnt(0)" ::: "memory"); SBAR();
#define PK(L, H) (bf16x8){L[0], L[1], L[2], L[3], H[0], H[1], H[2], H[3]}
    od = __builtin_amdgcn_mfma_f32_32x32x16_bf16(pa0, PK(l0, h0), od, 0, 0, 0);
    od = __builtin_amdgcn_mfma_f32_32x32x16_bf16(pa1, PK(l1, h1), od, 0, 0, 0);
    od = __builtin_amdgcn_mfma_f32_32x32x16_bf16(pa2, PK(l2, h2), od, 0, 0, 0);
    od = __builtin_amdgcn_mfma_f32_32x32x16_bf16(pa3, PK(l3, h3), od, 0, 0, 0);
#undef PK
}
template <int KS, int NO> __device__ __forceinline__ void pv_step(f32x16 (&o)[NO], unsigned vb, bf16x8 pa) {
    s16x4 l[NO], h[NO];
    l[0] = tr_read<v_rd_off(0, KS, 0)>(vb); h[0] = tr_read<v_rd_off(0, KS, 1)>(vb); l[1] = tr_read<v_rd_off(1, KS, 0)>(vb); h[1] = tr_read<v_rd_off(1, KS, 1)>(vb);
    if constexpr (NO == 4) { l[2] = tr_read<v_rd_off(2, KS, 0)>(vb); h[2] = tr_read<v_rd_off(2, KS, 1)>(vb); l[3] = tr_read<v_rd_off(3, KS, 0)>(vb); h[3] = tr_read<v_rd_off(3, KS, 1)>(vb); }
    asm volatile("s_waitcnt lgkmcnt(0)" ::: "memory"); SBAR();
#pragma unroll
    for (int d = 0; d < NO; ++d) o[d] = __builtin_amdgcn_mfma_f32_32x32x16_bf16(pa, (bf16x8){l[d][0], l[d][1], l[d][2], l[d][3], h[d][0], h[d][1], h[d][2], h[d][3]}, o[d], 0, 0, 0);
}
__device__ __forceinline__ void rot4(bf16x8& a, const float* cs, const float* sn) {
    const f32x4 c = *(const f32x4*)cs, s = *(const f32x4*)sn; float o[8];
#pragma unroll
    for (int e = 0; e < 4; ++e) { const float x1 = bf2f((unsigned short)a[e]), x2 = bf2f((unsigned short)a[4 + e]); o[e] = x1 * c[e] - x2 * s[e]; o[4 + e] = x2 * c[e] + x1 * s[e]; }
    u32x4 w = {cvtpk(o[0], o[1]), cvtpk(o[2], o[3]), cvtpk(o[4], o[5]), cvtpk(o[6], o[7])};
    a = *reinterpret_cast<bf16x8*>(&w);
}
struct Args {
    const bf16_t* Q; int ldq, qcol;
    const bf16_t* K; int ldk, kcol;
    const bf16_t* V; int ldv, vcol;
    int q_row0;
    int kctx_row0, klat_row0, nt_ctx, nt_lat;
    float C;
    int rope;
    const float* rcos; const float* rsin;
    bf16_t* O; int ldo, ocol;
    int g, u0; const float* rpb;
    float lam, oscale; const float* subg;
};

__device__ __forceinline__ unsigned off_a(unsigned row, unsigned ch) { return 2048u * (row >> 3) + 512u * (ch >> 2) + 64u * (row & 7) + 16u * ((ch & 3) ^ ((row >> 2) & 3)); }
template <int OFF> __device__ __forceinline__ s16x4 tr_read_u(unsigned addr) {
    s16x4 r; asm volatile("ds_read_b64_tr_b16 %0, %1 offset:%2" : "=&v"(r) : "v"(addr), "i"(OFF) : "memory"); return r;
}
template <int KS2, int DB0>
__device__ __forceinline__ void pv16_load(s16x4 (&L)[4], s16x4 (&H)[4], const unsigned (&vb)[2][2]) {
    L[0] = tr_read_u<8192 * KS2 + 512 * ((DB0 + 0) >> 1)>(vb[(DB0 + 0) & 1][0]); H[0] = tr_read_u<8192 * KS2 + 512 * ((DB0 + 0) >> 1)>(vb[(DB0 + 0) & 1][1]);
    L[1] = tr_read_u<8192 * KS2 + 512 * ((DB0 + 1) >> 1)>(vb[(DB0 + 1) & 1][0]); H[1] = tr_read_u<8192 * KS2 + 512 * ((DB0 + 1) >> 1)>(vb[(DB0 + 1) & 1][1]);
    L[2] = tr_read_u<8192 * KS2 + 512 * ((DB0 + 2) >> 1)>(vb[(DB0 + 2) & 1][0]); H[2] = tr_read_u<8192 * KS2 + 512 * ((DB0 + 2) >> 1)>(vb[(DB0 + 2) & 1][1]);
    L[3] = tr_read_u<8192 * KS2 + 512 * ((DB0 + 3) >> 1)>(vb[(DB0 + 3) & 1][0]); H[3] = tr_read_u<8192 * KS2 + 512 * ((DB0 + 3) >> 1)>(vb[(DB0 + 3) & 1][1]);
}
template <int DB0, int NDB>
__device__ __forceinline__ void pv16_mma(f32x4 (&o)[2][NDB], const s16x4 (&L)[4], const s16x4 (&H)[4], bf16x8 p0, bf16x8 p1) {
#pragma unroll
    for (int i = 0; i < 4; ++i) { const bf16x8 vf = {L[i][0], L[i][1], L[i][2], L[i][3], H[i][0], H[i][1], H[i][2], H[i][3]};
        o[0][DB0 + i] = __builtin_amdgcn_mfma_f32_16x16x32_bf16(p0, vf, o[0][DB0 + i], 0, 0, 0);
        o[1][DB0 + i] = __builtin_amdgcn_mfma_f32_16x16x32_bf16(p1, vf, o[1][DB0 + i], 0, 0, 0); }
}
#define PV16_WAIT(n) do { asm volatile("s_waitcnt lgkmcnt(" #n ")" ::: "memory"); SBAR(); } while (0)
template <int DQK, int KW, int DV, int MODE>
__device__ __forceinline__ void attn_unit(LAS unsigned char* lds, const Args& a) {
    constexpr int NKS = DQK / 32, NDB = DV / 16;
    constexpr int KSTR = KW * 2 + 16, KBUF = 64 * KSTR;
    constexpr int OFF_V = 3 * KBUF, OFF_WS = OFF_V + 3 * 16384, OFF_RPB = OFF_WS + 2048;
    const int tid = opaque_tid(), wid = __builtin_amdgcn_readfirstlane(tid >> 6), lane = tid & 63, n = lane & 15, g = lane >> 4;
    LAS unsigned char* Kl = lds; LAS unsigned char* Vl = lds + OFF_V;
    LAS float* wsf = (LAS float*)(lds + OFF_WS) + wid * 64; LAS float* li_l = wsf;
    LAS float* rpbl = (LAS float*)(lds + OFF_RPB) + 64;
    const int wq = (MODE == 1) ? (wid & 3) : wid, wmap = (MODE == 1) ? (wid >> 2) : 0;
    bf16x8 qf[2][NKS];
#pragma unroll
    for (int qb = 0; qb < 2; ++qb) {
        const int qrow = a.q_row0 + wq * 32 + qb * 16 + n;
        const bf16_t* Qw = a.Q + (size_t)qrow * a.ldq + a.qcol + wmap * 64 + g * 8;
#pragma unroll
        for (int ks = 0; ks < NKS; ++ks) qf[qb][ks] = *(const bf16x8*)(Qw + ks * 32);
        if (a.rope == 2) { if constexpr (NKS >= 3) { const int s = qrow & (SEQ - 1); rot4(qf[qb][2], a.rcos + s * 16 + 4 * g, a.rsin + s * 16 + 4 * g); } }
#pragma unroll
        for (int ks = 0; ks < NKS; ++ks) { float f[8];
#pragma unroll
            for (int e = 0; e < 8; ++e) f[e] = bf2f((unsigned short)qf[qb][ks][e]) * a.C;
            u32x4 w = {cvtpk(f[0], f[1]), cvtpk(f[2], f[3]), cvtpk(f[4], f[5]), cvtpk(f[6], f[7])}; qf[qb][ks] = *reinterpret_cast<bf16x8*>(&w); }
    }
    const int cq0 = (wid & 1) * 32 + n, cq1 = cq0 + 16, rq = 4 * a.g + (wid >> 1);
    const int rs = min(max(rq - 4, 0), 120), cs0 = min(max(cq0 - 8, 0), 48), cs1 = min(max(cq1 - 8, 0), 48);
    unsigned namask = 0u;
    if (MODE == 2) {
#pragma unroll
        for (int kb = 0; kb < 4; ++kb)
#pragma unroll
            for (int r = 0; r < 4; ++r) { const int ck = kb * 16 + 4 * g + r;
                namask |= (((unsigned)(ck - cs0) < 16u) ? 1u : 0u) << (kb * 4 + r); namask |= (((unsigned)(ck - cs1) < 16u) ? 1u : 0u) << (16 + kb * 4 + r); }
    }
    constexpr int NKB = KBUF / 1024, NBT = NKB + 16, NB = (NBT + 7) / 8;
    static_assert(KBUF % 1024 == 0, "K image is a whole number of 1 KB blocks");
    unsigned soff[NB];
#pragma unroll
    for (int i = 0; i < NB; ++i) { const int bb = wid + 8 * i; unsigned so = 0u;
        if (bb < NKB) { const int A = bb * 1024 + lane * 16, row = A / KSTR; int off = A % KSTR; if (off >= KW * 2) off = 0; so = (unsigned)(row * a.ldk * 2 + off); }
        else if (bb < NBT) { const int A = (bb - NKB) * 1024 + lane * 16, rho = ((A >> 11) << 3) | ((A >> 6) & 7); int ch = (((A >> 9) & 3) << 2) | (((A >> 4) & 3) ^ ((rho >> 2) & 3));
            if (DV == 64) ch &= 7;
            const int key = ((rho >> 5) * 2 + ((rho >> 2) & 1)) * 16 + 4 * ((rho >> 3) & 3) + (rho & 3);
            so = (unsigned)((key * a.ldv + ch * 8) * 2); }
        soff[i] = so; }
    const int NT = a.nt_ctx + a.nt_lat;
#define TILE_ROW(j) ((j) < a.nt_ctx ? a.kctx_row0 + 64 * (j) : a.klat_row0 + 64 * ((j) - a.nt_ctx))
#define DMA(t) do { const int _r0 = TILE_ROW(t), _sl = (t) % 3; const char* _kp = (const char*)(a.K + (size_t)_r0 * a.ldk + a.kcol); const char* _vp = (const char*)(a.V + (size_t)_r0 * a.ldv + a.vcol); \
    _Pragma("unroll") for (int _i = 0; _i < NB; ++_i) { const int _bb = wid + 8 * _i; const bool _isk = _bb < NKB;   \
        const char* _src = (_isk ? _kp : _vp) + soff[_i]; LAS unsigned char* _dst = _isk ? (Kl + _sl * KBUF + _bb * 1024) : (Vl + _sl * 16384 + (_bb - NKB) * 1024); \
        if (_i + 1 < NB || _bb < NBT) __builtin_amdgcn_global_load_lds((const unsigned*)_src, (LAS unsigned*)_dst, 16, 0, 0); } } while (0)
#define DMA_SYNC() do { asm volatile("s_waitcnt vmcnt(0)" ::: "memory"); __syncthreads(); } while (0)
    float lsum0 = 0.f, lsum1 = 0.f;
    f32x4 o[2][NDB];
#pragma unroll
    for (int qb = 0; qb < 2; ++qb)
#pragma unroll
        for (int d = 0; d < NDB; ++d) o[qb][d] = (f32x4){0.f, 0.f, 0.f, 0.f};
    const unsigned kbase = (unsigned)(size_t)Kl + (unsigned)(n * KSTR + 16 * g + wmap * 128);
    unsigned vb0[2][2];
    { const unsigned q4 = (unsigned)n >> 2, p = (unsigned)n & 3;
#pragma unroll
      for (int cb = 0; cb < 2; ++cb)
#pragma unroll
          for (int t = 0; t < 2; ++t) vb0[cb][t] = (unsigned)(size_t)Vl + off_a(8u * g + 4u * t + q4, 2u * cb + (p >> 1)) + 8u * (p & 1); }
#define QKT(S, b) do { const unsigned _kb = kbase + (unsigned)((b) * KBUF); bf16x8 _kf[4][NKS]; \
    _Pragma("unroll") for (int kb = 0; kb < 4; ++kb) _Pragma("unroll") for (int ks = 0; ks < NKS; ++ks) _kf[kb][ks] = *(const LAS bf16x8*)(size_t)(_kb + kb * 16 * KSTR + ks * 64); \
    _Pragma("unroll") for (int kb = 0; kb < 4; ++kb) _Pragma("unroll") for (int qb = 0; qb < 2; ++qb) { f32x4 _acc = {0.f, 0.f, 0.f, 0.f}; \
        _Pragma("unroll") for (int ks = 0; ks < NKS; ++ks) _acc = __builtin_amdgcn_mfma_f32_16x16x32_bf16(_kf[kb][ks], qf[qb][ks], _acc, 0, 0, 0); \
        S[kb][qb] = _acc; } } while (0)
#define PARTIAL(S, j) do { \
    if (MODE == 2) { if ((j) >= a.nt_ctx) { const int kr = a.u0 + ((j) - a.nt_ctx); const bool rowok = (kr >= rs) && (kr < rs + 8);   \
        if (rowok) { const LAS float* b0 = rpbl + (kr - rq + 7) * 31 + 15 - cq0 + 4 * g; const LAS float* b1 = b0 - 16;   \
            _Pragma("unroll") for (int kb = 0; kb < 4; ++kb) { const f32x4u bv0 = *(const LAS f32x4u*)(b0 + kb * 16), bv1 = *(const LAS f32x4u*)(b1 + kb * 16);   \
                _Pragma("unroll") for (int r = 0; r < 4; ++r) { const float t0 = S[kb][0][r] + bv0[r], t1 = S[kb][1][r] + bv1[r]; \
                    S[kb][0][r] = ((namask >> (kb * 4 + r)) & 1u) ? t0 : -1e30f; S[kb][1][r] = ((namask >> (16 + kb * 4 + r)) & 1u) ? t1 : -1e30f; } } } \
        else { _Pragma("unroll") for (int kb = 0; kb < 4; ++kb) _Pragma("unroll") for (int r = 0; r < 4; ++r) { S[kb][0][r] = -1e30f; S[kb][1][r] = -1e30f; } } } } \
    _Pragma("unroll") for (int kb = 0; kb < 2; ++kb) _Pragma("unroll") for (int qb = 0; qb < 2; ++qb) _Pragma("unroll") for (int r = 0; r < 4; ++r) S[kb][qb][r] = fast_exp2(S[kb][qb][r]); } while (0)
#define FINISH(S) do { \
    _Pragma("unroll") for (int kb = 2; kb < 4; ++kb) _Pragma("unroll") for (int qb = 0; qb < 2; ++qb) _Pragma("unroll") for (int r = 0; r < 4; ++r) S[kb][qb][r] = fast_exp2(S[kb][qb][r]); \
    float _p0 = 0.f, _p1 = 0.f; \
    _Pragma("unroll") for (int kb = 0; kb < 4; ++kb) { _p0 += (S[kb][0][0] + S[kb][0][1]) + (S[kb][0][2] + S[kb][0][3]); _p1 += (S[kb][1][0] + S[kb][1][1]) + (S[kb][1][2] + S[kb][1][3]); } \
    lsum0 += _p0; lsum1 += _p1; \
    _Pragma("unroll") for (int qb = 0; qb < 2; ++qb) _Pragma("unroll") for (int k2 = 0; k2 < 2; ++k2) { \
        u32x4 _w = {cvtpk(S[2 * k2][qb][0], S[2 * k2][qb][1]), cvtpk(S[2 * k2][qb][2], S[2 * k2][qb][3]), cvtpk(S[2 * k2 + 1][qb][0], S[2 * k2 + 1][qb][1]), cvtpk(S[2 * k2 + 1][qb][2], S[2 * k2 + 1][qb][3])}; \
        pf[qb][k2] = *reinterpret_cast<bf16x8*>(&_w); } } while (0)
#define PV(b) do { unsigned _vb[2][2]; _Pragma("unroll") for (int cb = 0; cb < 2; ++cb) _Pragma("unroll") for (int t = 0; t < 2; ++t) _vb[cb][t] = vb0[cb][t] + (unsigned)(b) * 16384u; \
    s16x4 _La[4], _Ha[4], _Lb[4], _Hb[4]; \
    if constexpr (NDB == 8) { \
        pv16_load<0, 0>(_La, _Ha, _vb); pv16_load<0, 4>(_Lb, _Hb, _vb); \
        PV16_WAIT(8); pv16_mma<0, NDB>(o, _La, _Ha, pf[0][0], pf[1][0]); pv16_load<1, 0>(_La, _Ha, _vb); \
        PV16_WAIT(8); pv16_mma<4, NDB>(o, _Lb, _Hb, pf[0][0], pf[1][0]); pv16_load<1, 4>(_Lb, _Hb, _vb); \
        PV16_WAIT(8); pv16_mma<0, NDB>(o, _La, _Ha, pf[0][1], pf[1][1]); \
        PV16_WAIT(0); pv16_mma<4, NDB>(o, _Lb, _Hb, pf[0][1], pf[1][1]); \
    } else {   \
        pv16_load<0, 0>(_La, _Ha, _vb); PV16_WAIT(0); pv16_mma<0, NDB>(o, _La, _Ha, pf[0][0], pf[1][0]); \
        pv16_load<1, 0>(_La, _Ha, _vb); PV16_WAIT(0); pv16_mma<0, NDB>(o, _La, _Ha, pf[0][1], pf[1][1]); \
    } } while (0)
    f32x4 sA[4][2], sB[4][2]; bf16x8 pf[2][2];
    DMA(0); DMA(1);
    if (MODE == 2) { if (tid < 465) rpbl[tid] = a.rpb[tid] * LOG2E; }
    DMA_SYNC();
    QKT(sA, 0); PARTIAL(sA, 0);
    int bm1 = 0, bj = 1, bn = 2;
    for (int j = 1; j + 1 < NT; j += 2) {
        DMA(j + 1);
        SBAR(); QKT(sB, bj);
        FINISH(sA); SBAR();
        PV(bm1); PARTIAL(sB, j);
        DMA_SYNC();
        if (j + 2 < NT) DMA(j + 2);
        SBAR(); QKT(sA, bn);
        FINISH(sB); SBAR();
        PV(bj); PARTIAL(sA, j + 1);
        DMA_SYNC();
        { const int t0 = bm1; bm1 = bn; bn = bj; bj = t0; }
    }
    SBAR(); QKT(sB, bj);
    FINISH(sA); SBAR();
    PV(bm1); PARTIAL(sB, NT - 1);
    FINISH(sB); SBAR();
    PV(bj);
    __syncthreads();
#undef TILE_ROW
#undef DMA
#undef DMA_SYNC
#undef QKT
#undef PARTIAL
#undef FINISH
#undef PV
#undef PV16_WAIT
    const int tid_e = opaque_tid(), lane_e = tid_e & 63, ne = lane_e & 15, ge = lane_e >> 4;
    lsum0 += __shfl_xor(lsum0, 16); lsum0 += __shfl_xor(lsum0, 32); lsum1 += __shfl_xor(lsum1, 16); lsum1 += __shfl_xor(lsum1, 32);
    if (ge == 0) { li_l[ne] = fmaxf(lsum0, 1e-37f); li_l[16 + ne] = fmaxf(lsum1, 1e-37f); } LDS_WAIT();
    float rl[2][4];
#pragma unroll
    for (int qb = 0; qb < 2; ++qb)
#pragma unroll
        for (int r = 0; r < 4; ++r) rl[qb][r] = fast_rcp(li_l[qb * 16 + 4 * ge + r]);
    if (MODE != 1) {
        constexpr int OS = DV + 8;
        LAS bf16_t* ob = (LAS bf16_t*)lds;
#pragma unroll
        for (int qb = 0; qb < 2; ++qb)
#pragma unroll
            for (int r = 0; r < 4; ++r) { const int orow = wid * 32 + qb * 16 + 4 * ge + r;
#pragma unroll
                for (int db = 0; db < NDB; ++db) ob[orow * OS + db * 16 + ne] = f2bf(o[qb][db][r] * rl[qb][r]); }
        __syncthreads();
        constexpr int CPT = DV / 16;
        const int row = tid_e >> 1, c0 = (tid_e & 1) * CPT;
        bf16_t* Ow = a.O + (size_t)(a.q_row0 + row) * a.ldo + a.ocol + c0 * 8;
#pragma unroll
        for (int cc = 0; cc < CPT; ++cc) *(u32x4*)(Ow + cc * 8) = *(const LAS u32x4*)(ob + row * OS + (c0 + cc) * 8);
    } else {
        LAS float* cb = (LAS float*)lds;
        if (wmap == 1) {
#pragma unroll
            for (int qb = 0; qb < 2; ++qb)
#pragma unroll
                for (int r = 0; r < 4; ++r) { const int row = wq * 32 + qb * 16 + 4 * ge + r;
#pragma unroll
                    for (int db = 0; db < NDB; ++db) cb[row * 129 + db * 16 + ne] = a.lam * o[qb][db][r] * rl[qb][r]; }
        }
        __syncthreads();
        if (wmap == 0) {
#pragma unroll
            for (int qb = 0; qb < 2; ++qb)
#pragma unroll
                for (int r = 0; r < 4; ++r) { const int row = wq * 32 + qb * 16 + 4 * ge + r;
#pragma unroll
                    for (int db = 0; db < NDB; ++db) { const int ix = row * 129 + db * 16 + ne; cb[ix] = o[qb][db][r] * rl[qb][r] - cb[ix]; } }
        }
        __syncthreads();
        const int row = tid_e >> 2, qd = tid_e & 3;
        float v[32]; float ss = 0.f;
#pragma unroll
        for (int i = 0; i < 32; ++i) { v[i] = cb[row * 129 + qd * 32 + i]; ss += v[i] * v[i]; }
        ss += __shfl_xor(ss, 1); ss += __shfl_xor(ss, 2);
        const float rstd = rsqrtf(ss * (1.f / 128.f) + EPS) * a.oscale;
        bf16_t* Ow = a.O + (size_t)(a.q_row0 + row) * a.ldo + a.ocol + qd * 32;
        f32x4 sg[8];
#pragma unroll
        for (int i = 0; i < 8; ++i) sg[i] = *(const f32x4*)(a.subg + qd * 32 + 4 * i);
#pragma unroll
        for (int c = 0; c < 4; ++c) { float w[8];
#pragma unroll
            for (int e = 0; e < 8; ++e) w[e] = v[c * 8 + e] * rstd * sg[2 * c + (e >> 2)][e & 3];
            u32x4 pk = {cvtpk(w[0], w[1]), cvtpk(w[2], w[3]), cvtpk(w[4], w[5]), cvtpk(w[6], w[7])};
            *(u32x4*)(Ow + c * 8) = pk; }
    }
    __syncthreads();
}

__device__ __forceinline__ void sgu_unit(LAS unsigned char* lds, const bf16_t* PB, const bf16_t* Wsb, const float* bs, const float* stats, const float* sgain, bf16_t* MIX, int rowbase, int g) {
    const int tid = opaque_tid(), wid = __builtin_amdgcn_readfirstlane(tid >> 6), lane = tid & 63, r32 = lane & 31, hi = lane >> 5;
    LAS unsigned char* Vl = lds;
    u32x4 xs[4]; f32x4 sa[4][4];
    const int ch = tid & 15;
    const f32x4 g0 = *(const f32x4*)(sgain + g * 128 + ch * 8), g1 = *(const f32x4*)(sgain + g * 128 + ch * 8 + 4);
#pragma unroll
    for (int i = 0; i < 4; ++i) { const int row = (tid + 512 * i) >> 4;
        xs[i] = *(const u32x4*)(PB + (size_t)(rowbase + row) * EV_IN + 512 + g * 128 + ch * 8);
        const f32x4* st = (const f32x4*)(stats + (size_t)(rowbase + row) * 16); sa[i][0] = st[0]; sa[i][1] = st[1]; sa[i][2] = st[2]; sa[i][3] = st[3]; }
#pragma unroll
    for (int i = 0; i < 4; ++i) { const int row = (tid + 512 * i) >> 4; const u32x4 x = xs[i]; const f32x4 a0 = sa[i][0], a1 = sa[i][1], a2 = sa[i][2], a3 = sa[i][3];
        const float s1 = ((a0[0] + a0[2]) + (a1[0] + a1[2])) + ((a2[0] + a2[2]) + (a3[0] + a3[2])), s2 = ((a0[1] + a0[3]) + (a1[1] + a1[3])) + ((a2[1] + a2[3]) + (a3[1] + a3[3]));
        const float mean = s1 * (1.f / 512.f), rstd = rsqrtf(fmaxf(s2 * (1.f / 512.f) - mean * mean, 0.f) + EPS);
        u32x4 y; y.x = cvtpk((bflo(x.x) - mean) * rstd * g0[0], (bfhi(x.x) - mean) * rstd * g0[1]); y.y = cvtpk((bflo(x.y) - mean) * rstd * g0[2], (bfhi(x.y) - mean) * rstd * g0[3]);
        y.z = cvtpk((bflo(x.z) - mean) * rstd * g1[0], (bfhi(x.z) - mean) * rstd * g1[1]); y.w = cvtpk((bflo(x.w) - mean) * rstd * g1[2], (bfhi(x.w) - mean) * rstd * g1[3]);
        *(LAS u32x4*)(Vl + (row >> 6) * 16384 + v_st(row & 63, ch * 8)) = y; }
    const int prow = (wid & 3) * 32, dh = wid >> 2;
    unsigned short uu[16][2]; float bb[16];
#pragma unroll
    for (int r = 0; r < 16; ++r) { const int p = prow + crow(r, hi); bb[r] = bs[g * 128 + p];
#pragma unroll
        for (int dd = 0; dd < 2; ++dd) uu[r][dd] = PB[(size_t)(rowbase + p) * EV_IN + g * 128 + (2 * dh + dd) * 32 + r32]; }
    bf16x8 pa[2][4];
#pragma unroll
    for (int kt = 0; kt < 2; ++kt)
#pragma unroll
        for (int ks = 0; ks < 4; ++ks) pa[kt][ks] = *(const bf16x8*)(Wsb + (size_t)(g * 128 + prow + r32) * 128 + kt * 64 + ks * 16 + hi * 8);
    __syncthreads();
    f32x16 o[2];
    o[0] = (f32x16){0.f, 0.f, 0.f, 0.f, 0.f, 0.f, 0.f, 0.f, 0.f, 0.f, 0.f, 0.f, 0.f, 0.f, 0.f, 0.f}; o[1] = o[0];
    const unsigned vb0 = (unsigned)(size_t)Vl + (unsigned)v_rd_base(lane);
#pragma unroll
    for (int kt = 0; kt < 2; ++kt) { const unsigned vb = vb0 + kt * 16384u;
        if (dh == 0) { pv_one<0>(o[0], vb, pa[kt][0], pa[kt][1], pa[kt][2], pa[kt][3]); pv_one<1>(o[1], vb, pa[kt][0], pa[kt][1], pa[kt][2], pa[kt][3]); }
        else { pv_one<2>(o[0], vb, pa[kt][0], pa[kt][1], pa[kt][2], pa[kt][3]); pv_one<3>(o[1], vb, pa[kt][0], pa[kt][1], pa[kt][2], pa[kt][3]); } }
#pragma unroll
    for (int r = 0; r < 16; ++r) { const int p = prow + crow(r, hi);
#pragma unroll
        for (int dd = 0; dd < 2; ++dd) { const int d = (2 * dh + dd) * 32 + r32;
            MIX[(size_t)(rowbase + p) * DM + g * 128 + d] = f2bf(bf2f(uu[r][dd]) * (o[dd][r] + bb[r])); } }
    __syncthreads();
}
}

struct Params {
    const float* in[31];
    float* out;
    unsigned char* ws;
    int ph_lo, ph_hi;
};

struct Ctx {
    LAS unsigned char* lds;
    int tid, lane, wid, gw, NGW;
};
__device__ __forceinline__ Ctx make_ctx(LAS unsigned char* lds) { const int t = opaque_tid(), w = __builtin_amdgcn_readfirstlane(t >> 6); return Ctx{lds, t, t & 63, w, opaque_bid() * 8 + w, (int)gridDim.x * 8}; }
typedef const __attribute__((address_space(4))) Params KParams;
__device__ __forceinline__ KParams& kparams() { KParams* p = (KParams*)__builtin_amdgcn_kernarg_segment_ptr(); asm volatile("" : "+s"(p)); return *p; }

__device__ __forceinline__ bf16_t* xrow_ptr(KParams& P, int row) { return (bf16_t*)(P.ws + WS_U + U_XB) + (size_t)row * DM; }
__device__ __forceinline__ int mod_r(int row) { return row < NLAT ? (row >> 13) : 4; }
__device__ __forceinline__ f32x4 ld4(const float* p) { return *(const f32x4*)p; }
__device__ __forceinline__ f32x4 ldbf4(const bf16_t* p) { const u32x2 w = *(const u32x2*)p; return (f32x4){bflo(w.x), bfhi(w.x), bflo(w.y), bfhi(w.y)}; }
__device__ __forceinline__ void stbf4(bf16_t* p, f32x4 v) { u32x2 w; w.x = cvtpk(v[0], v[1]); w.y = cvtpk(v[2], v[3]); *(u32x2*)p = w; }
__device__ __forceinline__ float sumsq4(const f32x4 (&v)[4]) { float s = 0.f;
#pragma unroll
    for (int j = 0; j < 4; ++j) s += (v[j][0] * v[j][0] + v[j][1] * v[j][1]) + (v[j][2] * v[j][2] + v[j][3] * v[j][3]);
    return wave_sum(s); }
__device__ __forceinline__ void norm_mod(const f32x4 (&x)[4], f32x4 (&hv)[4], const float* gain, const float* shift, const float* scale, int lane) {
    const float rstd = rsqrtf(sumsq4(x) * (1.f / DM) + EPS);
#pragma unroll
    for (int j = 0; j < 4; ++j) { const int c = 4 * lane + 256 * j; const f32x4 g = ld4(gain + c), sh = ld4(shift + c), sc = ld4(scale + c);
        hv[j] = (x[j] * rstd) * g * (sc + 1.f) + sh; }
}
__device__ __forceinline__ void resid_add(f32x4 (&x)[4], const f32x4 (&y)[4], const float* gain, const float* gate, int lane) {
    const float rstd = rsqrtf(sumsq4(y) * (1.f / DM) + EPS);
#pragma unroll
    for (int j = 0; j < 4; ++j) { const int c = 4 * lane + 256 * j; const f32x4 g = ld4(gain + c), gt = ld4(gate + c);
        x[j] = x[j] + gt * ((y[j] * rstd) * g); }
}

__device__ __forceinline__ void wave_rows(const Ctx& c, int mtok, int& r0, int& r1) {
    const int bid = opaque_bid(); const int rpw = mtok / (int)gridDim.x, base = bid * rpw;
    r0 = base + (c.wid * rpw) / 8; r1 = base + ((c.wid + 1) * rpw) / 8;
    if (bid == (int)gridDim.x - 1 && c.wid == 7) r1 = mtok;
}
__device__ __forceinline__ void ld_gate(f32x4 (&G)[4], const float* gain, const float* gate, int lane) {
#pragma unroll
    for (int j = 0; j < 4; ++j) { const int cc = 4 * lane + 256 * j; G[j] = ld4(gain + cc) * ld4(gate + cc); } }
__device__ __forceinline__ void ld_mod(f32x4 (&A)[4], f32x4 (&B)[4], const float* gain, const float* shift, const float* scale, int lane) {
#pragma unroll
    for (int j = 0; j < 4; ++j) { const int cc = 4 * lane + 256 * j; A[j] = ld4(gain + cc) * (ld4(scale + cc) + 1.f); B[j] = ld4(shift + cc); } }
__device__ __forceinline__ void resid_add2(f32x4 (&x)[4], const f32x4 (&y)[4], const f32x4 (&G)[4]) {
    const float rstd = rsqrtf(sumsq4(y) * (1.f / DM) + EPS);
#pragma unroll
    for (int j = 0; j < 4; ++j) x[j] = x[j] + G[j] * (y[j] * rstd);
}
__device__ __forceinline__ void norm_mod2(const f32x4 (&x)[4], f32x4 (&hv)[4], const f32x4 (&A)[4], const f32x4 (&B)[4]) {
    const float rstd = rsqrtf(sumsq4(x) * (1.f / DM) + EPS);
#pragma unroll
    for (int j = 0; j < 4; ++j) hv[j] = (x[j] * rstd) * A[j] + B[j];
}

__device__ __forceinline__ int perm_row(int pmode, int n) {
    if (pmode == 1) { if (n >= 1024 && n < 2048) { const int d = n & 63, hb = n & ~63; return hb + ((d < 32) ? 8 * (d >> 2) + (d & 3) : 8 * ((d - 32) >> 2) + 4 + (d & 3)); } }
    else if (pmode == 2) { if (n >= 1920 && n < 1952) { const int d = n - 1920; return 1920 + ((d < 16) ? 8 * (d >> 2) + (d & 3) : 8 * ((d - 16) >> 2) + 4 + (d & 3)); } }
    return n;
}
struct TrD { const float* src; unsigned char* dst; int ldw, ldt, k0, n0, drow, pmode, f8; };
__device__ __forceinline__ TrD tr_desc(const float* W, int K, int N, unsigned char* WT, int r, int mode, int row_off, int pmode, int f8) {
    const int nblk = N / 32, kb = r / nblk, n0 = 32 * (r % nblk);
    const int drow = (mode == 0) ? row_off + n0 : (n0 >> 7) * 256 + (n0 & 127) + (mode == 2 ? 128 : 0);
    return TrD{W, WT, N, K, 64 * kb, n0, drow, pmode, f8};
}
#define TR_LOAD(v, d) do { const float* _p = (d).src + (size_t)((d).k0 + (lane >> 5)) * (d).ldw + (d).n0 + (lane & 31); \
        _Pragma("unroll") for (int _i = 0; _i < 32; ++_i) v[_i] = _p[(size_t)(2 * _i) * (d).ldw]; } while (0)
template <class F> __device__ __forceinline__ void tr_run(LAS float* scr, int lane, int first, int end, int stride, F dec) {
    if (first >= end) return;
    float v[32];
    TrD d = dec(first);
    TR_LOAD(v, d);
    for (int it = first; it < end; it += stride) {
        const TrD cur = d;
        const float sc = cur.f8 ? F8_W_SCALE : 1.f;
#pragma unroll
        for (int i = 0; i < 32; ++i) scr[(2 * i + (lane >> 5)) * 33 + (lane & 31)] = v[i] * sc;
        if (it + stride < end) { d = dec(it + stride); TR_LOAD(v, d); }
        LDS_WAIT(); asm volatile("" ::: "memory");
        const int c = lane & 7;
#pragma unroll
        for (int j = 0; j < 4; ++j) { const int n = (lane >> 3) + 8 * j; const LAS float* s = scr + (8 * c) * 33 + n;
            const int dr = cur.pmode ? perm_row(cur.pmode, cur.n0 + n) : cur.drow + n;
            const size_t eo = (size_t)dr * cur.ldt + cur.k0 + 8 * c;
            if (cur.f8) { u32x2 o; o.x = pk4_fp8(s[0 * 33], s[1 * 33], s[2 * 33], s[3 * 33]); o.y = pk4_fp8(s[4 * 33], s[5 * 33], s[6 * 33], s[7 * 33]); *(u32x2*)(cur.dst + eo) = o; }
            else { u32x4 o; o.x = cvtpk(s[0 * 33], s[1 * 33]); o.y = cvtpk(s[2 * 33], s[3 * 33]); o.z = cvtpk(s[4 * 33], s[5 * 33]); o.w = cvtpk(s[6 * 33], s[7 * 33]); *(u32x4*)(cur.dst + eo * 2) = o; } }
        LDS_WAIT(); asm volatile("" ::: "memory");
    }
}
constexpr int MOE_CVT_ITEMS = 24 * 1792;
__device__ __forceinline__ void convert_moe_items(const Ctx& c, int i, int t0, int t1, int wsel, int nsel) {
    LAS float* scr = (LAS float*)(c.lds + c.wid * 16384);
    if (wsel < 0) return;
    tr_run(scr, c.lane, t0 + wsel, t1, nsel, [i](int t) { KParams& P = kparams();
        const int mat = t / 1792, r = t % 1792, e = mat / 3, which = mat % 3;
        if (which < 2) return tr_desc(P.in[28 + which] + ((size_t)i * NEXP + e) * DM * DFFE, DM, DFFE, P.ws + WS_W13M + (size_t)e * 2 * DFFE * DM * (MOE_F8 ? 1 : 2), r, 1 + which, 0, 0, MOE_F8);
        return tr_desc(P.in[30] + ((size_t)i * NEXP + e) * DFFE * DM, DFFE, DM, P.ws + WS_W2M + (size_t)e * DM * DFFE * (MOE_F8 ? 1 : 2), r, 0, 0, 0, MOE_F8); });
}
constexpr int PI_EIN = (DM / 64) * (EV_IN / 32), PI_OUT = (DM / 64) * (DM / 32), PI_FFN = (DM / 64) * (DFF / 32), PI_OIN = (DM / 64) * (OD_IN / 32);
constexpr int PRO_ITEMS_L = PI_EIN + PI_OUT + 3 * PI_FFN + PI_OIN + PI_OUT, PRO_ITEMS = 2 * PRO_ITEMS_L;
__device__ __forceinline__ TrD pro_desc(int t) {
    KParams& P = kparams(); unsigned char* ws = P.ws;
    const int i = t / PRO_ITEMS_L; int r = t % PRO_ITEMS_L;
    if (r < PI_EIN) return tr_desc(P.in[7] + (size_t)i * DM * EV_IN, DM, EV_IN, ws + WS_WINE + (size_t)i * EV_IN * DM * 2, r, 0, 0, 1, WIN8(2 * i) ? 1 : 0);
    r -= PI_EIN;
    if (r < PI_OUT) return tr_desc(P.in[8] + (size_t)i * DM * DM, DM, DM, ws + WS_WOUTE + (size_t)i * DM * DM * 2, r, 0, 0, 0, 0);
    r -= PI_OUT;
    if (r < PI_FFN) return tr_desc(P.in[17] + (size_t)i * DM * DFF, DM, DFF, ws + WS_W13E + (size_t)i * 2 * DFF * DM * 2, r, 1, 0, 0, FFN8(i) ? 1 : 0);
    r -= PI_FFN;
    if (r < PI_FFN) return tr_desc(P.in[18] + (size_t)i * DM * DFF, DM, DFF, ws + WS_W13E + (size_t)i * 2 * DFF * DM * 2, r, 2, 0, 0, FFN8(i) ? 1 : 0);
    r -= PI_FFN;
    if (r < PI_FFN) return tr_desc(P.in[19] + (size_t)i * DFF * DM, DFF, DM, ws + WS_W2E + (size_t)i * DM * DFF * 2, r, 0, 0, 0, FFN8D(i) ? 1 : 0);
    r -= PI_FFN;
    if (r < PI_OIN) return tr_desc(P.in[20] + (size_t)i * DM * OD_IN, DM, OD_IN, ws + WS_WINO + (size_t)i * OD_INP * DM * 2, r, 0, 0, 2, WIN8(2 * i + 1) ? 1 : 0);
    r -= PI_OIN;
    return tr_desc(P.in[21] + (size_t)i * DM * DM, DM, DM, ws + WS_WOUTO + (size_t)i * DM * DM * 2, r, 0, 0, 0, 0);
}
constexpr int PRO_E0 = PI_EIN + PI_OUT + 3 * PI_FFN;
template <int CW> __device__ __forceinline__ void mods_gemv_task(const Ctx& c, int lm, int cb) {
    constexpr int LPR = CW / 4, RPL = 64 / LPR;
    KParams& P = kparams();
    LAS float* sl = (LAS float*)c.lds;
    LAS float* part = (LAS float*)(c.lds + 32768);
    __syncthreads();
    for (int i = c.tid; i < 5 * DM; i += 512) { const int r = i >> 10, k = i & 1023; const float x = r < 4 ? P.in[1][r * DM + k] : P.in[3][k]; sl[i] = x / (1.f + expf(-x)); }
    __syncthreads();
    const int sub = c.lane / LPR, lo = c.lane % LPR, n = cb * CW + 4 * lo;
    const float* W = P.in[4] + (size_t)lm * DM * (NMOD * DM) + n;
    f32x4 acc[5];
#pragma unroll
    for (int r = 0; r < 5; ++r) acc[r] = (f32x4){0.f, 0.f, 0.f, 0.f};
    const int kb = c.wid * 128 + sub;
    for (int k0 = 0; k0 < 128; k0 += 8 * RPL) {
        f32x4 wv[8];
#pragma unroll
        for (int u = 0; u < 8; ++u) wv[u] = ld4(W + (size_t)(kb + k0 + RPL * u) * (NMOD * DM));
#pragma unroll
        for (int u = 0; u < 8; ++u)
#pragma unroll
            for (int r = 0; r < 5; ++r) acc[r] += wv[u] * sl[r * DM + kb + k0 + RPL * u];
    }
#pragma unroll
    for (int r = 0; r < 5; ++r) {
#pragma unroll
        for (int m = LPR; m < 64; m <<= 1)
#pragma unroll
            for (int q = 0; q < 4; ++q) acc[r][q] += __shfl_xor(acc[r][q], m);
        if (sub == 0) *(LAS f32x4*)(part + (c.wid * 5 + r) * CW + 4 * lo) = acc[r]; }
    __syncthreads();
    for (int i = c.tid; i < 5 * CW; i += 512) { const int r = i / CW, cc = i % CW; float s = 0.f;
#pragma unroll
        for (int w = 0; w < 8; ++w) s += part[(w * 5 + r) * CW + cc];
        ((float*)(P.ws + WS_MODS))[(size_t)(lm * 5 + r) * (NMOD * DM) + cb * CW + cc] = s + P.in[5][lm * (NMOD * DM) + cb * CW + cc]; }
    __syncthreads();
}
constexpr int PRO_MOE0 = 14592;
constexpr int PRO_GEMV_WGS = NMOD * DM / 64;
__device__ __forceinline__ void prologue0(const Ctx& c_) {
    const Ctx c = make_ctx(c_.lds);
    KParams& P = kparams(); unsigned char* ws = P.ws;
    const int bid = opaque_bid();
    if (bid < PRO_GEMV_WGS) mods_gemv_task<64>(c, 0, bid);
    {
        LAS float* scr = (LAS float*)(c.lds + c.wid * 16384);
        const int G = (int)gridDim.x, ng = G < PRO_GEMV_WGS ? G : PRO_GEMV_WGS, nslots = ng * 8 + (G - ng) * 16;
        if (bid < ng) tr_run(scr, c.lane, bid * 8 + c.wid, PRO_E0, nslots, [](int t) { return pro_desc(t); });
        else { const int s0 = ng * 8 + ((bid - ng) * 8 + c.wid) * 2;
            tr_run(scr, c.lane, s0, PRO_E0, nslots, [](int t) { return pro_desc(t); });
            tr_run(scr, c.lane, s0 + 1, PRO_E0, nslots, [](int t) { return pro_desc(t); }); }
    }
    convert_moe_items(c, 0, 7296, PRO_MOE0, c.gw, c.NGW);
    const int gt = bid * 512 + c.tid, NGT = gridDim.x * 512;
    for (int i = gt; i < 2 * (OD_INP - OD_IN) * DM * 2 / 16; i += NGT) { const int per = (OD_INP - OD_IN) * DM * 2 / 16, l = i / per, r = i % per;
        const int esz = WIN8(2 * l + 1) ? 1 : 2;
        if (r * 16 < (OD_INP - OD_IN) * DM * esz) *(u32x4*)(ws + WS_WINO + (size_t)l * OD_INP * DM * 2 + (size_t)OD_IN * DM * esz + (size_t)r * 16) = (u32x4){0u, 0u, 0u, 0u}; }
    for (int i = gt; i < 2 * (MLA_K / 8) * MLA_N; i += NGT) { const int l = i / ((MLA_K / 8) * MLA_N), k8 = (i / MLA_N) % (MLA_K / 8), n = i % MLA_N, k = 8 * k8;
        float v[8];
#pragma unroll
        for (int u = 0; u < 8; ++u) v[u] = 0.f;
        if (n < 384) { if (k < 256) { const int h = n / 96, j = n % 96; int sc = n;
                if (j >= 64) { const int p = j - 64, t = p >> 3, e = p & 7; sc = h * 96 + 64 + ((e < 4) ? 4 * t + e : 16 + 4 * t + (e - 4)); }
#pragma unroll
                for (int u = 0; u < 8; ++u) v[u] = P.in[24][((size_t)l * 256 + k + u) * 384 + sc] * P.in[23][l * 256 + k + u]; } }
        else if (n < 768) { const int h = (n - 384) / 96, j = (n - 384) % 96;
            if (j < 64) { if (k >= 256 && k < 384) {
#pragma unroll
                    for (int u = 0; u < 8; ++u) v[u] = P.in[26][((size_t)l * 128 + (k + u - 256)) * 768 + h * 192 + j] * P.in[25][l * 128 + (k + u - 256)]; } }
            else {
#pragma unroll
                for (int u = 0; u < 8; ++u) if (k + u == 384 + (j - 64)) v[u] = 1.f; } }
        else { const int h = (n - 768) / 128, j = (n - 768) % 128; if (k >= 256 && k < 384) {
#pragma unroll
                for (int u = 0; u < 8; ++u) v[u] = P.in[26][((size_t)l * 128 + (k + u - 256)) * 768 + h * 192 + 64 + j] * P.in[25][l * 128 + (k + u - 256)]; } }
        u32x4 o; o.x = cvtpk(v[0], v[1]); o.y = cvtpk(v[2], v[3]); o.z = cvtpk(v[4], v[5]); o.w = cvtpk(v[6], v[7]);
        *(u32x4*)((bf16_t*)(ws + WS_WMLA) + (size_t)l * MLA_N * MLA_K + (size_t)n * MLA_K + k) = o; }
    for (int i = gt; i < 2 * 4 * 128 * 128 / 4; i += NGT) stbf4((bf16_t*)(ws + WS_SGUW) + 4 * i, ld4(P.in[9] + 4 * i));
    for (int i = gt; i < SEQ * 32; i += NGT) { const int s = i >> 5, f = i & 31; const int pos = f < 16 ? (s >> 6) : (s & 63);
        const float inv = 1.0f / powf(10000.0f, (float)(f & 15) / 16.0f); const float ang = (float)pos * inv; float sn, cs; sincosf(ang, &sn, &cs);
        ((float*)(ws + WS_ROPEB))[i] = cs; ((float*)(ws + WS_ROPEB))[SEQ * 32 + i] = sn; }
    for (int i = gt; i < SEQ * 16; i += NGT) { const int s = i >> 4, f = i & 15; const int pos = f < 8 ? (s >> 6) : (s & 63);
        const float inv = 1.0f / powf(10000.0f, (float)(f & 7) / 8.0f); const float ang = (float)pos * inv; float sn, cs; sincosf(ang, &sn, &cs);
        ((float*)(ws + WS_ROPED))[i] = cs; ((float*)(ws + WS_ROPED))[SEQ * 16 + i] = sn; }
}

__device__ __forceinline__ void convert_moe_tail(const Ctx& c_, int i, int t0, int t1, int nunits) {
    const Ctx c = make_ctx(c_.lds);
    const int G = (int)gridDim.x, rem = nunits % G, bid = opaque_bid();
    const int first = rem;
    convert_moe_items(c, i, t0, t1, bid >= first ? (bid - first) * 8 + c.wid : -1, (G - first) * 8);
}

__device__ __forceinline__ void pro_tail(const Ctx& c_, int g0, int g1, int t0, int t1, int nunits) {
    const Ctx c = make_ctx(c_.lds);
    const int G = (int)gridDim.x, rem = nunits % G, bid = opaque_bid();
    if (bid < rem) return;
    const int idx = bid - rem, nw = G - rem;
    for (int task = g0 + idx; task < g1; task += nw) mods_gemv_task<128>(c, task / 48, task % 48);
    tr_run((LAS float*)(c.lds + c.wid * 16384), c.lane, t0 + idx * 8 + c.wid, t1, nw * 8, [](int t) { return pro_desc(t); });
}

__device__ __forceinline__ void ew_first(const Ctx& c_) {
    const Ctx c = make_ctx(c_.lds);
    KParams& P = kparams(); const float* mods = (const float*)(P.ws + WS_MODS); bf16_t* HB = (bf16_t*)(P.ws + WS_HB);
    int r0, r1; wave_rows(c, MTOT, r0, r1);
    f32x4 A0[4], B0[4]; int rcur = -1;
    f32x4 xn[4];
#define EWF_LOAD(rw) do { const int _row = (rw); const float* _src = _row < NLAT ? P.in[0] + (size_t)_row * DM : P.in[2] + (size_t)(_row - NLAT) * DM; \
        _Pragma("unroll") for (int j = 0; j < 4; ++j) xn[j] = ld4(_src + 4 * c.lane + 256 * j); } while (0)
    if (r0 < r1) EWF_LOAD(r0);
    for (int row = r0; row < r1; ++row) {
        bf16_t* xr = xrow_ptr(P, row); const int r = mod_r(row);
        if (r != rcur) { rcur = r; const float* mb = mods + (size_t)(0 * 5 + r) * (NMOD * DM); ld_mod(A0, B0, P.in[6] + (0 * 4 + 0) * DM, mb + 0 * DM, mb + 1 * DM, c.lane); }
        f32x4 x[4], h[4];
#pragma unroll
        for (int j = 0; j < 4; ++j) x[j] = xn[j];
        if (row + 1 < r1) EWF_LOAD(row + 1);
#pragma unroll
        for (int j = 0; j < 4; ++j) stbf4(xr + 4 * c.lane + 256 * j, x[j]);
        norm_mod2(x, h, A0, B0);
#pragma unroll
        for (int j = 0; j < 4; ++j) stbf4(HB + (size_t)row * DM + 4 * c.lane + 256 * j, h[j]);
    }
}
#undef EWF_LOAD

__device__ __forceinline__ void moe_offsets(KParams& P, int li, int (&toff)[9]);
__device__ __forceinline__ void ew_mid(const Ctx& c_, int l, int mtok, bool dry = false, bool chained = false) {
    const Ctx c = make_ctx(c_.lds);
    KParams& P = kparams(); const float* mods = (const float*)(P.ws + WS_MODS); bf16_t* HB = (bf16_t*)(P.ws + WS_HB);
    const bf16_t* YB = (const bf16_t*)(P.ws + WS_U + U_YB);
    const bool odd = (l & 1) != 0; const int li = l >> 1;
    LAS float* wrl = (LAS float*)c.lds;
    if (odd) { for (int i = c.tid; i < DM * NEXP; i += 512) { const int col = i >> 3, e = i & 7; wrl[e * DM + col] = P.in[27][(size_t)li * DM * NEXP + i]; } __syncthreads(); }
    unsigned long long cw = 0ull; int st_e1 = 0, st_e2 = 0, st_l1 = 0, st_l2 = 0; float st_g1 = 0.f; int nrow = 0;
    int r0, r1;
    if (chained) {
        const int G = (int)gridDim.x, rem = ((mtok / 256) * (DM / 256)) % G, bid = opaque_bid();
        if (bid < rem) { const int hw = bid * 8 + c.wid, nhw = rem * 8, nctx = mtok - NLAT; r0 = NLAT + (hw * nctx) / nhw; r1 = NLAT + ((hw + 1) * nctx) / nhw; }
        else { const int lw = (bid - rem) * 8 + c.wid, nlw = (G - rem) * 8, nrow = rem > 0 ? NLAT : mtok; r0 = (int)(((long)lw * nrow) / nlw); r1 = (int)(((long)(lw + 1) * nrow) / nlw); }
        if (r0 < r1) {
            unsigned* dep = (unsigned*)(P.ws + WS_CTL) + CW_DEP + l * 16384;
            for (int mt = r0 >> 8; mt <= ((r1 - 1) >> 8); ++mt) { unsigned sp = 0;
                while ((unsigned)__builtin_amdgcn_readfirstlane((int)xb_ld(dep + mt * 64)) < (unsigned)(DM / 256)) { __builtin_amdgcn_s_sleep(1); if (++sp > (1u << 22)) break; } }
            __builtin_amdgcn_fence(__ATOMIC_ACQUIRE, "agent");
        }
    } else wave_rows(c, mtok, r0, r1);
    f32x4 G1[4], A2[4], B2[4]; int rcur = -1;
    u32x2 xa[4], ya[4], xb[4], yb[4];
#define EWM_LOAD(X, Y, rw) do { const int _row = (rw); const bf16_t* _xr = xrow_ptr(P, _row); \
        _Pragma("unroll") for (int j = 0; j < 4; ++j) { X[j] = *(const u32x2*)(_xr + 4 * c.lane + 256 * j); Y[j] = *(const u32x2*)(YB + (size_t)_row * DM + 4 * c.lane + 256 * j); } } while (0)
    if (r0 < r1) EWM_LOAD(xa, ya, r0);
    if (r0 + 1 < r1) EWM_LOAD(xb, yb, r0 + 1);
    for (int row = r0; row < r1; ++row, ++nrow) {
        bf16_t* xr = xrow_ptr(P, row); const int r = mod_r(row);
        if (r != rcur) { rcur = r; const float* mb = mods + (size_t)(l * 5 + r) * (NMOD * DM);
            ld_gate(G1, P.in[6] + (l * 4 + 1) * DM, mb + 2 * DM, c.lane); ld_mod(A2, B2, P.in[6] + (l * 4 + 2) * DM, mb + 3 * DM, mb + 4 * DM, c.lane); }
        f32x4 x[4], y[4], h[4];
#pragma unroll
        for (int j = 0; j < 4; ++j) { x[j] = (f32x4){bflo(xa[j].x), bfhi(xa[j].x), bflo(xa[j].y), bfhi(xa[j].y)}; y[j] = (f32x4){bflo(ya[j].x), bfhi(ya[j].x), bflo(ya[j].y), bfhi(ya[j].y)}; xa[j] = xb[j]; ya[j] = yb[j]; }
        if (row + 2 < r1) EWM_LOAD(xb, yb, row + 2);
        resid_add2(x, y, G1);
        bf16_t* xw = dry ? (bf16_t*)(P.ws + WS_U + U_YS) + (size_t)row * DM : xr; bf16_t* hw = (dry ? (bf16_t*)(P.ws + WS_U + U_PB) : HB) + (size_t)row * DM;
#pragma unroll
        for (int j = 0; j < 4; ++j) stbf4(xw + 4 * c.lane + 256 * j, x[j]);
        norm_mod2(x, h, A2, B2);
        if ((odd && MOE_F8) || (!odd && FFN8(li))) {
            unsigned char* h8 = (unsigned char*)(dry ? (bf16_t*)(P.ws + WS_U + U_PB) : HB) + (size_t)row * DM;
#pragma unroll
            for (int j = 0; j < 4; ++j) *(unsigned*)(h8 + 4 * c.lane + 256 * j) = pk4_fp8(h[j][0] * F8_ACT_SCALE, h[j][1] * F8_ACT_SCALE, h[j][2] * F8_ACT_SCALE, h[j][3] * F8_ACT_SCALE);
        } else {
#pragma unroll
            for (int j = 0; j < 4; ++j) stbf4(hw + 4 * c.lane + 256 * j, h[j]);
        }
        if (odd && !dry) {
            float lg[8];
#pragma unroll
            for (int e = 0; e < 8; ++e) { float sacc = 0.f;
#pragma unroll
                for (int j = 0; j < 4; ++j) { const f32x4 w = *(const LAS f32x4*)(wrl + e * DM + 4 * c.lane + 256 * j); sacc += (h[j][0] * w[0] + h[j][1] * w[1]) + (h[j][2] * w[2] + h[j][3] * w[3]); }
                lg[e] = wave_sum(sacc); }
            int e1 = 0; float v1 = lg[0];
#pragma unroll
            for (int e = 1; e < 8; ++e) if (lg[e] > v1) { v1 = lg[e]; e1 = e; }
            int e2 = -1; float v2 = -3.0e38f;
#pragma unroll
            for (int e = 0; e < 8; ++e) if (e != e1 && lg[e] > v2) { v2 = lg[e]; e2 = e; }
            if (e2 < 0) e2 = (e1 + 1) & 7;
            const float g1 = 1.f / (1.f + expf(v2 - v1));
            const int l1 = (int)((cw >> (8 * e1)) & 0xffull); cw += 1ull << (8 * e1);
            const int l2 = (int)((cw >> (8 * e2)) & 0xffull); cw += 1ull << (8 * e2);
            if (c.lane == nrow) { st_e1 = e1; st_e2 = e2; st_l1 = l1; st_l2 = l2; st_g1 = g1; }
        }
    }
    if (odd && !dry) {
        unsigned* cnt = (unsigned*)(P.ws + WS_CTL) + CW_MOECNT + li * 64;
        int base = 0;
        if (c.lane < 8) { const unsigned wc = (unsigned)((cw >> (8 * c.lane)) & 0xffull); base = wc ? (int)atomicAdd(cnt + c.lane, wc) : 0; }
        const int b1 = __shfl(base, st_e1), b2 = __shfl(base, st_e2);
#if FOLD_GATHER && MOE_F8
        __syncthreads();
        if (c.tid == 0) { unsigned* arr = (unsigned*)(P.ws + WS_CTL) + CW_ARR + li * 64; (void)xb_add(arr, 1u); unsigned sp = 0;
            while (xb_ld(arr) < (unsigned)gridDim.x) { __builtin_amdgcn_s_sleep(2); if (++sp > (1u << 22)) break; } }
        __syncthreads();
        int toff[9]; moe_offsets(P, li, toff);
        int tv = 0;
#pragma unroll
        for (int e = 0; e < 8; ++e) tv = (c.lane == e) ? toff[e] : tv;
        const int pa_l = __shfl(tv, st_e1) * 256 + b1 + st_l1, pb_l = __shfl(tv, st_e2) * 256 + b2 + st_l2;
        const unsigned char* H8 = (const unsigned char*)HB; unsigned char* HS8 = (unsigned char*)(P.ws + WS_U + U_YS);
        for (int i0 = 0; i0 < nrow; i0 += 4) {
            u32x4 vv[4];
#pragma unroll
            for (int k = 0; k < 4; ++k) { const int i = i0 + k < nrow ? i0 + k : nrow - 1; vv[k] = ((const u32x4*)(H8 + (size_t)(r0 + i) * DM))[c.lane]; }
#pragma unroll
            for (int k = 0; k < 4; ++k) { const int i = i0 + k; if (i < nrow) { const int row = r0 + i; const int pA = __shfl(pa_l, i), pB = __shfl(pb_l, i); const float g1 = __shfl(st_g1, i);
                if (c.lane == 0) ((int4*)(P.ws + WS_TOKPOS))[row] = make_int4(pA, pB, __float_as_int(g1), __float_as_int(1.f - g1));
                ((u32x4*)(HS8 + (size_t)pA * DM))[c.lane] = vv[k]; ((u32x4*)(HS8 + (size_t)pB * DM))[c.lane] = vv[k]; } } }
        __syncthreads();
#else
        if (c.lane < nrow) { const int row = r0 + c.lane; int4* ti = (int4*)(P.ws + WS_TOKINFO) + (size_t)row * 2;
            ti[0] = make_int4(st_e1, b1 + st_l1, st_e2, b2 + st_l2); ti[1] = make_int4(__float_as_int(st_g1), __float_as_int(1.f - st_g1), 0, 0); }
        __syncthreads();
#endif
    }
#undef EWM_LOAD
}

__device__ __forceinline__ void moe_offsets(KParams& P, int li, int (&toff)[9]) {
    const unsigned* cnt = (const unsigned*)(P.ws + WS_CTL) + CW_MOECNT + li * 64; int acc = 0;
    const int ln = (int)(threadIdx.x & 63u);
    const unsigned nv = __hip_atomic_load(cnt + (ln & 7), __ATOMIC_RELAXED, __HIP_MEMORY_SCOPE_AGENT);
#pragma unroll
    for (int e = 0; e < 8; ++e) { toff[e] = acc; const unsigned n = (unsigned)__builtin_amdgcn_readlane((int)nv, e); acc += (int)((n + 255u) >> 8); }
    toff[8] = acc;
}
__device__ __forceinline__ void moe_gather(const Ctx& c_, int li, int mtok) {
    const Ctx c = make_ctx(c_.lds);
    KParams& P = kparams(); int toff[9]; moe_offsets(P, li, toff);
    int tv = 0;
#pragma unroll
    for (int e = 0; e < 8; ++e) tv = (c.lane == e) ? toff[e] : tv;
    const bf16_t* HB = (const bf16_t*)(P.ws + WS_HB); bf16_t* HS = (bf16_t*)(P.ws + WS_U + U_YS);
    int r0, r1; wave_rows(c, mtok, r0, r1);
    for (int row = r0; row < r1; ++row) {
        const int4* ti = (const int4*)(P.ws + WS_TOKINFO) + (size_t)row * 2; const int4 a = ti[0], b = ti[1];
        const int pA = __shfl(tv, a.x) * 256 + a.y, pB = __shfl(tv, a.z) * 256 + a.w;
        if (c.lane == 0) ((int4*)(P.ws + WS_TOKPOS))[row] = make_int4(pA, pB, b.x, b.y);
#if MOE_F8
        const u32x4 v0 = ((const u32x4*)((const unsigned char*)HB + (size_t)row * DM))[c.lane];
        ((u32x4*)((unsigned char*)HS + (size_t)pA * DM))[c.lane] = v0; ((u32x4*)((unsigned char*)HS + (size_t)pB * DM))[c.lane] = v0;
#else
        const u32x4* src = (const u32x4*)(HB + (size_t)row * DM); const u32x4 v0 = src[c.lane], v1 = src[64 + c.lane];
        u32x4* dA = (u32x4*)(HS + (size_t)pA * DM); u32x4* dB = (u32x4*)(HS + (size_t)pB * DM);
        dA[c.lane] = v0; dA[64 + c.lane] = v1; dB[c.lane] = v0; dB[64 + c.lane] = v1;
#endif
    }
}

__device__ __forceinline__ void ew_last(const Ctx& c_, int l, int mtok, bool dry = false) {
    const Ctx c = make_ctx(c_.lds);
    KParams& P = kparams(); const float* mods = (const float*)(P.ws + WS_MODS); bf16_t* HB = (bf16_t*)(P.ws + WS_HB);
    const bf16_t* YS = (const bf16_t*)(P.ws + WS_U + U_YS); const bool odd = (l & 1) != 0;
    int r0, r1; wave_rows(c, mtok, r0, r1);
    f32x4 G3[4], A0[4], B0[4]; int rcur = -1;
    u32x2 xa[4], ya[4], za[4], xb[4], yb[4], zb[4]; float gAa = 0.f, gBa = 0.f, gAb = 0.f, gBb = 0.f;
#define EWL_LOAD(X, Y, Z, GA, GB, rw) do { const int _row = (rw); const bf16_t* _xr = xrow_ptr(P, _row); \
        if (odd) { const int4 tp = ((const int4*)(P.ws + WS_TOKPOS))[_row]; GA = __int_as_float(tp.z); GB = __int_as_float(tp.w); \
            _Pragma("unroll") for (int j = 0; j < 4; ++j) { Y[j] = *(const u32x2*)(YS + (size_t)tp.x * DM + 4 * c.lane + 256 * j); Z[j] = *(const u32x2*)(YS + (size_t)tp.y * DM + 4 * c.lane + 256 * j); } } \
        else { _Pragma("unroll") for (int j = 0; j < 4; ++j) Y[j] = *(const u32x2*)(YS + (size_t)_row * DM + 4 * c.lane + 256 * j); } \
        _Pragma("unroll") for (int j = 0; j < 4; ++j) X[j] = *(const u32x2*)(_xr + 4 * c.lane + 256 * j); } while (0)
    if (r0 < r1) EWL_LOAD(xa, ya, za, gAa, gBa, r0);
    if (r0 + 1 < r1) EWL_LOAD(xb, yb, zb, gAb, gBb, r0 + 1);
    for (int row = r0; row < r1; ++row) {
        bf16_t* xr = xrow_ptr(P, row); const int r = mod_r(row);
        if (r != rcur) { rcur = r; const float* mb = mods + (size_t)(l * 5 + r) * (NMOD * DM);
            ld_gate(G3, P.in[6] + (l * 4 + 3) * DM, mb + 5 * DM, c.lane);
            if (l < 3) { const float* mn = mods + (size_t)((l + 1) * 5 + r) * (NMOD * DM); ld_mod(A0, B0, P.in[6] + ((l + 1) * 4 + 0) * DM, mn + 0 * DM, mn + 1 * DM, c.lane); } }
        f32x4 x[4], y[4], h[4];
#pragma unroll
        for (int j = 0; j < 4; ++j) { x[j] = (f32x4){bflo(xa[j].x), bfhi(xa[j].x), bflo(xa[j].y), bfhi(xa[j].y)};
            y[j] = (f32x4){bflo(ya[j].x), bfhi(ya[j].x), bflo(ya[j].y), bfhi(ya[j].y)};
            if (odd) y[j] = y[j] * gAa + (f32x4){bflo(za[j].x), bfhi(za[j].x), bflo(za[j].y), bfhi(za[j].y)} * gBa;
            xa[j] = xb[j]; ya[j] = yb[j]; za[j] = zb[j]; }
        gAa = gAb; gBa = gBb;
        if (row + 2 < r1) EWL_LOAD(xb, yb, zb, gAb, gBb, row + 2);
        resid_add2(x, y, G3);
        bf16_t* hw = (dry ? (bf16_t*)(P.ws + WS_U + U_MIX) : HB) + (size_t)row * DM;
        if (l == 3 && !dry) { float* ow = P.out + (size_t)row * DM;
#pragma unroll
            for (int j = 0; j < 4; ++j) *(f32x4*)(ow + 4 * c.lane + 256 * j) = x[j]; }
        else { bf16_t* xw = dry ? (bf16_t*)(P.ws + WS_U + U_PB) + (size_t)row * DM : xr;
#pragma unroll
            for (int j = 0; j < 4; ++j) stbf4(xw + 4 * c.lane + 256 * j, x[j]); }
        if (l < 3) { norm_mod2(x, h, A0, B0);
            if (WIN8(l + 1)) { unsigned char* h8 = (unsigned char*)(dry ? (bf16_t*)(P.ws + WS_U + U_MIX) : HB) + (size_t)row * DM;
#pragma unroll
                for (int j = 0; j < 4; ++j) *(unsigned*)(h8 + 4 * c.lane + 256 * j) = pk4_fp8(h[j][0] * F8_ACT_SCALE, h[j][1] * F8_ACT_SCALE, h[j][2] * F8_ACT_SCALE, h[j][3] * F8_ACT_SCALE); }
            else {
#pragma unroll
                for (int j = 0; j < 4; ++j) stbf4(hw + 4 * c.lane + 256 * j, h[j]); } }
    }
#undef EWL_LOAD
}

__device__ __forceinline__ void attn_even(const Ctx& c_, int l) {
    const Ctx c = make_ctx(c_.lds);
    KParams& P = kparams(); const int i = l >> 1; const bool need_ctx = l < 3;
    const bf16_t* PB = (const bf16_t*)(P.ws + WS_U + U_PB); bf16_t* MIX = (bf16_t*)(P.ws + WS_U + U_MIX);
    const int nchunk = need_ctx ? 264 : 256;
    const int sgu_b1 = (opaque_bid() + 1) % (int)gridDim.x, sgu_u0 = ((int)gridDim.x % 8 == 0) ? (sgu_b1 & 7) * ((int)gridDim.x >> 3) + (sgu_b1 >> 3) : sgu_b1;
    for (int u = sgu_u0; u < nchunk * 4; u += gridDim.x) att::sgu_unit(c.lds, PB, (const bf16_t*)(P.ws + WS_SGUW) + (size_t)i * 4 * 128 * 128, P.in[10] + i * 512, (const float*)(P.ws + WS_STATS), P.in[11] + i * 512, MIX, (u >> 2) * 128, u & 3);
    float d1 = 0.f, d2 = 0.f;
    if (c.lane < 64) { d1 = P.in[12][i * 64 + c.lane] * P.in[13][i * 64 + c.lane]; d2 = P.in[14][i * 64 + c.lane] * P.in[15][i * 64 + c.lane]; }
    const float lam_init = 0.8f - 0.6f * expf(-0.3f * (float)l);
    const float lam = expf(wave_sum(d1)) - expf(wave_sum(d2)) + lam_init;
    att::Args a;
    a.Q = PB; a.ldq = EV_IN; a.K = PB; a.ldk = EV_IN; a.V = PB; a.ldv = EV_IN; a.C = 0.125f * LOG2E;
    a.rcos = (const float*)(P.ws + WS_ROPEB); a.rsin = a.rcos + SEQ * 32; a.O = MIX; a.ldo = DM; a.g = 0; a.u0 = 0; a.rpb = nullptr;
    a.lam = lam; a.oscale = 1.f - lam_init; a.subg = P.in[16] + i * 128; a.nt_ctx = 4;
    const int nctxu = need_ctx ? 32 : 0, nu = nctxu + 1024;
    for (int u = xcd_unit_base(); u < nu; u += gridDim.x) {
        int b, h;
        if (u < nctxu) { b = u >> 3; h = (u >> 1) & 3; a.q_row0 = NLAT + b * CTXL + (u & 1) * 128; a.nt_lat = 0; a.rope = 0; }
        else { const int v = u - nctxu; b = v >> 8; h = (v >> 6) & 3; a.q_row0 = b * SEQ + (v & 63) * 128; a.nt_lat = SEQ / 64; a.rope = 0; }
        a.qcol = 1024 + h * 128; a.kcol = 1536 + h * 128; a.vcol = 2048 + h * 128; a.ocol = 512 + h * 128;
        a.kctx_row0 = NLAT + b * CTXL; a.klat_row0 = b * SEQ;
        att::attn_unit<64, 128, 128, 1>(c.lds, a);
    }
}
__device__ __forceinline__ void attn_odd_na(const Ctx& c_, int l) {
    const Ctx c = make_ctx(c_.lds);
    KParams& P = kparams(); const int i = l >> 1; const bool need_ctx = l < 3;
    const bf16_t* PB = (const bf16_t*)(P.ws + WS_U + U_PB); bf16_t* MIX = (bf16_t*)(P.ws + WS_U + U_MIX);
    att::Args a;
    a.Q = PB; a.ldq = OD_INP; a.K = PB; a.ldk = OD_INP; a.V = PB; a.ldv = OD_INP; a.C = 0.125f * LOG2E; a.rope = 0; a.rcos = nullptr; a.rsin = nullptr;
    a.O = MIX; a.ldo = DM; a.lam = 0.f; a.oscale = 1.f; a.subg = nullptr; a.nt_ctx = 4;
    const int nctxu = need_ctx ? 32 : 0, nu = nctxu + 1024;
    for (int u = xcd_unit_base(); u < nu; u += gridDim.x) {
        int b, h;
        if (u < nctxu) { b = u >> 3; h = u & 7; a.q_row0 = NLAT + b * CTXL; a.nt_lat = 0; a.g = 0; a.u0 = 0; a.klat_row0 = 0; }
        else { const int v = u - nctxu; b = v >> 8; h = (v >> 5) & 7; const int g = v & 31; a.g = g; a.u0 = min(max(4 * g - 4, 0), 116);
            a.q_row0 = b * SEQ + g * 256; a.nt_lat = 12; a.klat_row0 = b * SEQ + a.u0 * 64; }
        a.qcol = h * 64; a.kcol = 512 + h * 64; a.vcol = 1024 + h * 64; a.ocol = h * 64; a.kctx_row0 = NLAT + b * CTXL;
        a.rpb = P.in[22] + ((size_t)i * 8 + h) * 465;
        att::attn_unit<64, 64, 64, 2>(c.lds, a);
    }
}
__device__ __forceinline__ void attn_odd_mla(const Ctx& c_, int l) {
    const Ctx c = make_ctx(c_.lds);
    KParams& P = kparams(); const bool need_ctx = l < 3;
    const bf16_t* MO = (const bf16_t*)(P.ws + WS_U + U_MLAO); bf16_t* MIX = (bf16_t*)(P.ws + WS_U + U_MIX);
    att::Args a;
    a.Q = MO; a.ldq = MLA_N; a.K = MO; a.ldk = MLA_N; a.V = MO; a.ldv = MLA_N; a.C = 0.10206207261596575f * LOG2E;
    a.rcos = (const float*)(P.ws + WS_ROPED); a.rsin = a.rcos + SEQ * 16; a.O = MIX; a.ldo = DM; a.g = 0; a.u0 = 0; a.rpb = nullptr; a.lam = 0.f; a.oscale = 1.f; a.subg = nullptr; a.nt_ctx = 4;
    const int nctxu = need_ctx ? 16 : 0, nu = nctxu + 512;
    for (int u = xcd_unit_base(); u < nu; u += gridDim.x) {
        int b, h;
        if (u < nctxu) { b = u >> 2; h = u & 3; a.q_row0 = NLAT + b * CTXL; a.nt_lat = 0; a.rope = 0; }
        else { const int v = u - nctxu; b = v >> 7; h = (v >> 5) & 3; a.q_row0 = b * SEQ + (v & 31) * 256; a.nt_lat = SEQ / 64; a.rope = 2; }
        a.qcol = h * 96; a.kcol = 384 + h * 96; a.vcol = 768 + h * 128; a.ocol = 512 + h * 128; a.kctx_row0 = NLAT + b * CTXL; a.klat_row0 = b * SEQ;
        att::attn_unit<96, 96, 128, 0>(c.lds, a);
    }
}

constexpr int N_PHASES = 2 + 2 * (7 + 9) - ((FOLD_GATHER && MOE_F8) ? 2 : 0);
__global__ void __launch_bounds__(512, 2) fwd_kernel(Params prm) {
    extern __shared__ __attribute__((aligned(16))) unsigned char lds_raw[];
    LAS unsigned char* lds = (LAS unsigned char*)lds_raw;
    const Ctx c{lds, 0, 0, 0, 0, 0};
    for (int u = threadIdx.x; u < (LDS_BYTES - LDS_MISC) / 4; u += 512) ((LAS unsigned*)(lds + LDS_MISC))[u] = 0u;
    __syncthreads();
    XcdBarrier bar;
    { unsigned char* ws0 = kparams().ws; bar.bar = (unsigned*)(ws0 + WS_CTL) + CW_BAR; bar.x = 0; bar.st = nullptr;
#if !MK_PER_PHASE
      bar = xcd_barrier_post((unsigned*)(ws0 + WS_CTL) + CW_BAR, (volatile LAS unsigned*)(lds + LDS_MISC + 32));
#endif
    }
    int ph = 0;
#ifndef PMASK
#define PMASK 0xffffffffu
#endif
#define PM(b) ((PMASK >> (b)) & 1u)
#define PH_ON() (ph >= kparams().ph_lo && ph < kparams().ph_hi)
#define PH_END() do { if (ph >= kparams().ph_lo && ph + 1 < kparams().ph_hi) xcd_barrier(bar); ++ph; } while (0)
#define PH_END_IF(cond) do { if ((cond) && ph >= kparams().ph_lo && ph + 1 < kparams().ph_hi) xcd_barrier(bar); ++ph; } while (0)
#define CHAIN(l) (CHAIN_WOUT && (l) < 4)
#define WSP(off) ((bf16_t*)(ws + (off)))
#define HB WSP(WS_HB)
#define PB WSP(WS_U + U_PB)
#define MIX WSP(WS_U + U_MIX)
#define YB WSP(WS_U + U_YB)
#define HID WSP(WS_U + U_HID)
#define YS WSP(WS_U + U_YS)
#define A2 WSP(WS_U + U_A2)
#define MO WSP(WS_U + U_MLAO)

    if (PM(0) && PH_ON()) for (int rep = 0; rep < DUPN(0); ++rep) { prologue0(c); __syncthreads(); }
    PH_END();
    if (PM(1) && PH_ON()) for (int rep = 0; rep < DUPN(1); ++rep) ew_first(c);
    PH_END();
    for (int lp = 0; lp < 2; ++lp) {
        {
            const int l = 2 * lp, i = lp; const int mtok = l < 3 ? MTOT : NLAT, nMt = mtok / 256;
            if (PM(2) && PH_ON()) for (int rep = 0; rep < DUPN(2); ++rep) { unsigned char* ws = kparams().ws; pg8::Gemm g{}; g.A = HB; g.lda = DM; g.Bt = (const unsigned char*)(ws + WS_WINE) + (size_t)i * EV_IN * DM * 2; g.K = DM; g.nM = MTOT / 256; g.nN = EV_IN / 256; g.grouped = 0; g.estride = 0;
                pg8::EpiEvenIn E{PB, EV_IN, (f32x2*)(ws + WS_STATS), (const float*)(ws + WS_ROPEB), (const float*)(ws + WS_ROPEB) + SEQ * 32, WIN8(l) ? F8_INV : 1.f}; if (WIN8(l)) gemm8_even_in(lds, g, E); else gemm_even_in(lds, g, E); if (rep == 0) { pro_tail(c, lp == 0 ? 48 : 0, lp == 0 ? 96 : 0, lp == 0 ? PRO_E0 : 0, lp == 0 ? PRO_ITEMS_L : 0, (MTOT / 256) * (EV_IN / 256)); convert_moe_tail(c, i, 0, 7296, (MTOT / 256) * (EV_IN / 256)); } }
            PH_END();
            if (PM(4) && PH_ON()) for (int rep = 0; rep < DUPN(4); ++rep) attn_even(c, l);
            PH_END();
            if (PM(5) && PH_ON()) for (int rep = 0; rep < DUPN(5); ++rep) { unsigned char* ws = kparams().ws; pg8::Gemm g{}; g.A = MIX; g.lda = DM; g.Bt = (const bf16_t*)(ws + WS_WOUTE) + (size_t)i * DM * DM; g.K = DM; g.nM = nMt; g.nN = DM / 256; g.grouped = 0; g.estride = 0;
                if (CHAIN(l)) { g.sig = (unsigned*)(ws + WS_CTL) + CW_DEP + l * 16384; g.nMl = NLAT / 256; }
                gemm_bf16(lds, g, YB, DM, CHAIN(l) ? 1 : 0); if (rep == 0) convert_moe_tail(c, i, lp == 0 ? 14592 : 7296, 14592, nMt * (DM / 256)); }
            PH_END_IF(!CHAIN(l));
            if (PM(6) && PH_ON()) { if (DUPN(6) > 1) ew_mid(c, l, mtok, true); ew_mid(c, l, mtok, false, CHAIN(l)); }
            PH_END();
            if (PM(7) && PH_ON()) for (int rep = 0; rep < DUPN(7); ++rep) { unsigned char* ws = kparams().ws; pg8::Gemm g{}; g.A = HB; g.lda = DM; g.Bt = (const unsigned char*)(ws + WS_W13E) + (size_t)i * 2 * DFF * DM * 2; g.K = DM; g.nM = nMt; g.nN = 2 * DFF / 256; g.grouped = 0; g.estride = 0;
                if (FFN8(i)) gemm8_swiglu8(lds, g, (unsigned char*)HID, DFF); else if (FFN8D(i)) gemm_swiglu_to8(lds, g, (unsigned char*)HID, DFF); else gemm_swiglu(lds, g, HID, DFF);
                if (rep == 0) convert_moe_tail(c, i, 14592, 20224, nMt * (2 * DFF / 256)); }
            PH_END();
            if (PM(8) && PH_ON()) for (int rep = 0; rep < DUPN(8); ++rep) { unsigned char* ws = kparams().ws; pg8::Gemm g{}; g.A = HID; g.lda = DFF; g.Bt = (const unsigned char*)(ws + WS_W2E) + (size_t)i * DM * DFF * 2; g.K = DFF; g.nM = nMt; g.nN = DM / 256; g.grouped = 0; g.estride = 0;
                if (FFN8D(i)) gemm8_bf16(lds, g, YS, DM); else gemm_bf16(lds, g, YS, DM);
                if (rep == 0) convert_moe_tail(c, i, 20224, MOE_CVT_ITEMS, nMt * (DM / 256)); }
            PH_END();
            if (PM(9) && PH_ON()) { if (DUPN(9) > 1) ew_last(c, l, mtok, true); ew_last(c, l, mtok); }
            PH_END();
        }
        {
            const int l = 2 * lp + 1, i = lp; const int mtok = l < 3 ? MTOT : NLAT, nMt = mtok / 256;
            if (PM(10) && PH_ON()) for (int rep = 0; rep < DUPN(10); ++rep) { unsigned char* ws = kparams().ws; pg8::Gemm g{}; g.A = HB; g.lda = DM; g.Bt = (const unsigned char*)(ws + WS_WINO) + (size_t)i * OD_INP * DM * 2; g.K = DM; g.nM = MTOT / 256; g.nN = OD_INP / 256; g.grouped = 0; g.estride = 0;
                pg8::EpiOddIn E{PB, OD_INP, (float*)(ws + WS_STATS), (const float*)(ws + WS_ROPED), (const float*)(ws + WS_ROPED) + SEQ * 16, WIN8(l) ? F8_INV : 1.f}; if (WIN8(l)) gemm8_odd_in(lds, g, E); else gemm_odd_in(lds, g, E);
                if (rep == 0) pro_tail(c, lp == 0 ? 96 : 0, lp == 0 ? 192 : 0, lp == 0 ? PRO_ITEMS_L : 0, lp == 0 ? PRO_ITEMS_L + 3500 : 0, (MTOT / 256) * (OD_INP / 256)); }
            PH_END();
            if (PM(12) && PH_ON()) for (int rep = 0; rep < DUPN(12); ++rep) { unsigned char* ws = kparams().ws; pg8::Gemm g{}; g.A = PB + 1536; g.lda = OD_INP; g.Bt = (const bf16_t*)(ws + WS_WMLA) + (size_t)i * MLA_N * MLA_K; g.K = MLA_K; g.nM = MTOT / 256; g.nN = MLA_N / 256; g.grouped = 0; g.estride = 0;
                pg8::EpiMlaUp E{MO, MLA_N, (const float*)(ws + WS_STATS)}; gemm_mla_up(lds, g, E); }
            PH_END();
            if (PH_ON()) { if (PM(13)) for (int rep = 0; rep < DUPN(13); ++rep) attn_odd_na(c, l); if (PM(14)) for (int rep = 0; rep < DUPN(14); ++rep) attn_odd_mla(c, l); }
            PH_END();
            if (PM(15) && PH_ON()) for (int rep = 0; rep < DUPN(15); ++rep) { unsigned char* ws = kparams().ws; pg8::Gemm g{}; g.A = MIX; g.lda = DM; g.Bt = (const bf16_t*)(ws + WS_WOUTO) + (size_t)i * DM * DM; g.K = DM; g.nM = nMt; g.nN = DM / 256; g.grouped = 0; g.estride = 0;
                if (CHAIN(l)) { g.sig = (unsigned*)(ws + WS_CTL) + CW_DEP + l * 16384; g.nMl = NLAT / 256; }
                gemm_bf16(lds, g, YB, DM, CHAIN(l) ? 1 : 0); }
            PH_END_IF(!CHAIN(l));
            if (PM(16) && PH_ON()) { if (DUPN(16) > 1) ew_mid(c, l, mtok, true); ew_mid(c, l, mtok, false, CHAIN(l)); }
            PH_END();
#if !(FOLD_GATHER && MOE_F8)
            if (PM(17) && PH_ON()) for (int rep = 0; rep < DUPN(17); ++rep) moe_gather(c, i, mtok);
            PH_END();
#endif
            if (PM(18) && PH_ON()) for (int rep = 0; rep < DUPN(18); ++rep) { unsigned char* ws = kparams().ws; pg8::Gemm g{}; g.A = YS; g.lda = DM; g.Bt = (const bf16_t*)(ws + WS_W13M); g.K = DM; g.nN = 2 * DFFE / 256; g.grouped = 1; g.estride = (size_t)2 * DFFE * DM;
                moe_offsets(kparams(), i, g.toff); g.nM = g.toff[8];
#if MOE_F8
                gemm8_swiglu8(lds, g, (unsigned char*)HID, DFFE);
#else
                gemm_swiglu(lds, g, HID, DFFE);
#endif
            }
            PH_END();
            if (PM(19) && PH_ON()) for (int rep = 0; rep < DUPN(19); ++rep) { unsigned char* ws = kparams().ws; pg8::Gemm g{}; g.A = HID; g.lda = DFFE; g.Bt = (const bf16_t*)(ws + WS_W2M); g.K = DFFE; g.nN = DM / 256; g.grouped = 1; g.estride = (size_t)DM * DFFE;
                moe_offsets(kparams(), i, g.toff); g.nM = g.toff[8];
#if MOE_F8
                gemm8_bf16(lds, g, YS, DM);
#else
                gemm_bf16(lds, g, YS, DM);
#endif
                if (rep == 0) pro_tail(c, 0, 0, lp == 0 ? PRO_ITEMS_L + 3500 : 0, lp == 0 ? PRO_ITEMS : 0, g.nM * (DM / 256));
            }
            PH_END();
            if (PM(20) && PH_ON()) { if (DUPN(20) > 1) ew_last(c, l, mtok, true); ew_last(c, l, mtok); }
            PH_END();
        }
    }
#undef PH_ON
#undef PH_END
#undef HB
#undef PB
#undef MIX
#undef YB
#undef HID
#undef YS
#undef A2
#undef MO
}

extern "C" void kernel_launch(void* const* d_in, const int* in_sizes, int n_in, void* d_out, int out_size, void* d_ws, size_t ws_size, hipStream_t stream) {
    static int grid = 0;
    if (grid == 0) {
        int dev = 0, cus = 0;
        if (n_in != 31 || out_size != NLAT * DM || ws_size < WS_END) { fprintf(stderr, "kernel_launch: unexpected shapes or workspace (n_in %d out %d ws %zu need %zu)\n", n_in, out_size, ws_size, (size_t)WS_END); grid = -1; }
        else if (hipGetDevice(&dev) != hipSuccess || hipDeviceGetAttribute(&cus, hipDeviceAttributeMultiprocessorCount, dev) != hipSuccess) grid = -1;
        else if (hipFuncSetAttribute((const void*)fwd_kernel, hipFuncAttributeMaxDynamicSharedMemorySize, LDS_BYTES) != hipSuccess) grid = -1;
        else { int per_cu = 0; (void)hipOccupancyMaxActiveBlocksPerMultiprocessor(&per_cu, (const void*)fwd_kernel, 512, LDS_BYTES); (void)hipGetLastError(); grid = cus; }
    }
    if (grid < 0) { (void)hipMemsetAsync(d_out, 0, (size_t)out_size * 4, stream); return; }
    (void)hipMemsetAsync((char*)d_ws + WS_CTL, 0, CTL_BYTES, stream);
    Params p{};
    for (int i = 0; i < 31; ++i) p.in[i] = (const float*)d_in[i];
    p.out = (float*)d_out; p.ws = (unsigned char*)d_ws;
#if MK_PER_PHASE
    for (int k = 0; k < N_PHASES; ++k) { p.ph_lo = k; p.ph_hi = k + 1; hipLaunchKernelGGL(fwd_kernel, dim3(grid), dim3(512), LDS_BYTES, stream, p); }
#else
    p.ph_lo = 0; p.ph_hi = N_PHASES;
    hipLaunchKernelGGL(fwd_kernel, dim3(grid), dim3(512), LDS_BYTES, stream, p);
#endif
}
```

```cpp
#include <hip/hip_runtime.h>
#include <stdint.h>
#include <stdio.h>

#ifndef MK_PER_PHASE
#define MK_PER_PHASE 0
#endif
#ifndef DUP_MASK
#define FOLD_GATHER 1
#define CHAIN_WOUT 1
#define DUP_MASK 0u
#endif
#define DUPN(b) (1 + (int)((DUP_MASK >> (b)) & 1u))
#ifndef FFN_F8
#define FFN_F8 1
#endif
#ifndef FFN_F8_FROM
#define FFN_F8_FROM 1
#endif
#define FFN8(i) (FFN_F8 && (i) >= FFN_F8_FROM)
#define FFN_F8D_FROM 0
#define FFN8D(i) (FFN_F8 && (i) >= FFN_F8D_FROM)
#ifndef WIN_F8_FROM
#define WIN_F8_FROM 2
#endif
#define WIN8(l) ((l) >= WIN_F8_FROM)
#ifndef MOE_F8
#define MOE_F8 1
#endif

#define LAS __attribute__((address_space(3)))
typedef unsigned short bf16_t;
typedef short bf16x8 __attribute__((ext_vector_type(8)));
typedef short s16x4 __attribute__((ext_vector_type(4)));
typedef float f32x4 __attribute__((ext_vector_type(4)));
typedef float f32x2 __attribute__((ext_vector_type(2)));
typedef float f32x16 __attribute__((ext_vector_type(16)));
typedef unsigned u32x4 __attribute__((ext_vector_type(4)));
typedef float f32x4u __attribute__((ext_vector_type(4), aligned(4)));
typedef unsigned u32x2 __attribute__((ext_vector_type(2)));

constexpr int DM = 1024, NB = 4, SEQ = 8192, NLAT = NB * SEQ, CTXL = 256, NCTX = NB * CTXL, MTOT = NLAT + NCTX;
constexpr int NMOD = 6;
constexpr int EV_IN = 2560, OD_IN = 1952, OD_INP = 2048, DFF = 2816, DFFE = 3584, NEXP = 8;
constexpr int MLA_N = 1280, MLA_K = 512;
constexpr int MS_MAX = 2 * MTOT + NEXP * 256;
constexpr float EPS = 1e-6f;
constexpr float LOG2E = 1.4426950408889634f;

constexpr size_t MiB = (size_t)1 << 20;
constexpr size_t WS_CTL = 0, CTL_BYTES = MiB;
constexpr size_t WS_MODS = 1 * MiB;
constexpr size_t WS_ROPEB = 2 * MiB;
constexpr size_t WS_ROPED = 4 * MiB;
constexpr size_t WS_SGUW = 5 * MiB;
constexpr size_t WS_TOKINFO = 6 * MiB;
constexpr size_t WS_TOKPOS = 8 * MiB;
constexpr size_t WS_CTXX = 10 * MiB;
constexpr size_t WS_WMLA = 14 * MiB;
constexpr size_t WS_WINE = 17 * MiB;
constexpr size_t WS_WOUTE = 27 * MiB;
constexpr size_t WS_W13E = 31 * MiB;
constexpr size_t WS_W2E = 53 * MiB;
constexpr size_t WS_WINO = 64 * MiB;
constexpr size_t WS_WOUTO = 72 * MiB;
constexpr size_t WS_W13M = 76 * MiB;
constexpr size_t WS_W2M = 188 * MiB;
constexpr size_t WS_HB = 244 * MiB;
constexpr size_t WS_U = 310 * MiB;
constexpr size_t U_PB = 0;
constexpr size_t U_MIX = 165 * MiB;
constexpr size_t U_A2 = 231 * MiB;
constexpr size_t U_MLAO = 264 * MiB;
constexpr size_t U_YB = 347 * MiB;
constexpr size_t U_HID = 0;
constexpr size_t U_XB = 549 * MiB;
constexpr size_t U_YS = 413 * MiB;
constexpr size_t WS_STATS = WS_U + 616 * MiB;
constexpr size_t WS_END = WS_STATS + 4 * MiB;
static_assert((size_t)MS_MAX * DFFE * (MOE_F8 ? 1 : 2) <= 347 * MiB && (size_t)MTOT * DFF * 2 <= 347 * MiB, "hid must stay clear of YB");
static_assert(U_YS + (size_t)MS_MAX * DM * 2 <= U_XB && U_XB + (size_t)MTOT * DM * 2 <= 616 * MiB, "ys / xb fit");

constexpr int CW_BAR = 4096;
constexpr int CW_MOECNT = 1024;
constexpr int CW_ARR = 200000;
constexpr int CW_DEP = 65536;

constexpr int LDS_BYTES = 147456;
constexpr int LDS_MISC = 131072;

__device__ __forceinline__ unsigned cvtpk(float lo, float hi) { unsigned r; asm("v_cvt_pk_bf16_f32 %0, %1, %2" : "=v"(r) : "v"(lo), "v"(hi)); return r; }
__device__ __forceinline__ float bf2f(unsigned short b) { return __uint_as_float(((unsigned)b) << 16); }
__device__ __forceinline__ float bflo(unsigned w) { return __uint_as_float(w << 16); }
__device__ __forceinline__ float bfhi(unsigned w) { return __uint_as_float(w & 0xffff0000u); }
__device__ __forceinline__ bf16_t f2bf(float f) { return (bf16_t)(cvtpk(f, 0.f) & 0xffffu); }
typedef int i32x8 __attribute__((ext_vector_type(8)));
typedef int i32x4 __attribute__((ext_vector_type(4)));
constexpr float F8_ACT_SCALE = 4.f, F8_W_SCALE = 64.f, F8_INV = 1.f / (F8_ACT_SCALE * F8_W_SCALE);
__device__ __forceinline__ unsigned pk4_fp8(float a, float b, float c, float d) {
    a = __builtin_amdgcn_fmed3f(a, -448.f, 448.f); b = __builtin_amdgcn_fmed3f(b, -448.f, 448.f); c = __builtin_amdgcn_fmed3f(c, -448.f, 448.f); d = __builtin_amdgcn_fmed3f(d, -448.f, 448.f);
    int w = 0; w = __builtin_amdgcn_cvt_pk_fp8_f32(a, b, w, false); w = __builtin_amdgcn_cvt_pk_fp8_f32(c, d, w, true); return (unsigned)w; }
template <int CTRL, int RM> __device__ __forceinline__ float dpp_get(float v) { return __int_as_float(__builtin_amdgcn_update_dpp(0, __float_as_int(v), CTRL, RM, 0xf, false)); }
__device__ __forceinline__ float wave_sum(float v) {
    v += dpp_get<0xB1, 0xf>(v);
    v += dpp_get<0x4E, 0xf>(v);
    v += dpp_get<0x141, 0xf>(v);
    v += dpp_get<0x140, 0xf>(v);
    v += dpp_get<0x142, 0xa>(v);
    v += dpp_get<0x143, 0xc>(v);
    return __int_as_float(__builtin_amdgcn_readlane(__float_as_int(v), 63));
}
__device__ __forceinline__ float fast_exp2(float x) { return __builtin_amdgcn_exp2f(x); }
__device__ __forceinline__ float fast_rcp(float x) { return __builtin_amdgcn_rcpf(x); }
__device__ __forceinline__ float silu_f(float x) { return x * fast_rcp(1.f + fast_exp2(-x * LOG2E)); }
__device__ __forceinline__ float gelu_tanh_f(float x) { const float arg = x * __builtin_fmaf(x * x, -0.1029432395800235f, -2.302208198144325f); return x * fast_rcp(1.f + fast_exp2(arg)); }
#define LDS_WAIT() asm volatile("s_waitcnt lgkmcnt(0)" ::: "memory")
#define VM_WAIT() asm volatile("s_waitcnt vmcnt(0)" ::: "memory")
__device__ __forceinline__ int opaque_bid() { int b = blockIdx.x; asm volatile("" : "+s"(b)); return b; }
__device__ __forceinline__ int xcd_unit_base() { const int b = opaque_bid(), G = (int)gridDim.x; return (G % 8 == 0) ? (b & 7) * (G >> 3) + (b >> 3) : b; }
__device__ __forceinline__ int opaque_tid() { int t = threadIdx.x; asm volatile("" : "+v"(t)); return t; }

#define XB_TMO      128
#define XB_XCNT(j)  (256  + 64 * (j))
#define XB_XSUB(j)  (1280 + 64 * (j))
#define XB_XGEN(j)  (2304 + 64 * (j))
#define XB_TOP      3328
#define XB_TOPGEN   3392
#define XCD_BAR_WORDS 3456
#define XB_SPIN_CAP (1u << 22)
__device__ __forceinline__ unsigned xb_ld(unsigned* p)              { return __hip_atomic_load(p, __ATOMIC_RELAXED, __HIP_MEMORY_SCOPE_AGENT); }
__device__ __forceinline__ unsigned xb_add(unsigned* p, unsigned v) { return __hip_atomic_fetch_add(p, v, __ATOMIC_RELAXED, __HIP_MEMORY_SCOPE_AGENT); }
__device__ __forceinline__ unsigned xb_xcc_id() { return (unsigned)__builtin_amdgcn_s_getreg((3 << 11) | 20) & 0xFu; }
#define XB_SPIN(cond, bar) do { unsigned _sp = 0; while (cond) { __builtin_amdgcn_s_sleep(1); \
    if ((++_sp & 255u) == 0u) { if (xb_ld(&(bar)[XB_TMO])) break; if (_sp > XB_SPIN_CAP) { atomicAdd(&(bar)[XB_TMO], 1u); break; } } } } while (0)
struct XcdBarrier { unsigned* bar; unsigned x; volatile LAS unsigned* st; };
__device__ __forceinline__ XcdBarrier xcd_barrier_post(unsigned* bar, volatile LAS unsigned* st) {
    XcdBarrier b; b.bar = bar; b.x = xb_xcc_id(); b.st = st;
    if (threadIdx.x == 0) (void)xb_add(&bar[XB_XCNT(b.x)], 1u);
    return b;
}
__device__ __forceinline__ void xcd_barrier_complete(unsigned* bar, unsigned x, unsigned& nloc, unsigned& nx) {
    const unsigned G = gridDim.x * gridDim.y * gridDim.z;
    unsigned sum, cnt, mine, sp = 0u;
    for (;;) {
        sum = 0u; cnt = 0u; mine = 0u;
#pragma unroll
        for (unsigned j = 0; j < 16; ++j) { const unsigned c = xb_ld(&bar[XB_XCNT(j)]); sum += c; cnt += (c > 0u) ? 1u : 0u; mine = (j == x) ? c : mine; }
        if (sum == G) break;
        __builtin_amdgcn_s_sleep(1);
        if ((++sp & 255u) == 0u) { if (xb_ld(&bar[XB_TMO])) break; if (sp > XB_SPIN_CAP) { atomicAdd(&bar[XB_TMO], 1u); break; } }
    }
    nloc = mine > 0u ? mine : 1u; nx = cnt > 0u ? cnt : 1u;
}
__device__ __forceinline__ void xcd_barrier(const XcdBarrier& b) {
    asm volatile("s_waitcnt vmcnt(0)" ::: "memory");
    __syncthreads();
    if (threadIdx.x == 0) {
        unsigned* bar = b.bar;
        __builtin_amdgcn_s_waitcnt(0);
        unsigned nloc = b.st[0], nx = b.st[1];
        if (nloc == 0u) { xcd_barrier_complete(bar, b.x, nloc, nx); b.st[0] = nloc; b.st[1] = nx; }
        const unsigned old = xb_add(&bar[XB_XSUB(b.x)], 1u);
        const unsigned gen = old / nloc;
        if (old + 1u == (gen + 1u) * nloc) {
            __builtin_amdgcn_fence(__ATOMIC_RELEASE, "agent");
            asm volatile("s_waitcnt vmcnt(0)" ::: "memory");
            const unsigned og = xb_add(&bar[XB_TOP], 1u);
            const unsigned tg = og / nx;
            if (og + 1u == (tg + 1u) * nx) xb_add(&bar[XB_TOPGEN], 1u);
            else XB_SPIN(xb_ld(&bar[XB_TOPGEN]) == tg, bar);
            __builtin_amdgcn_fence(__ATOMIC_ACQUIRE, "agent");
            xb_add(&bar[XB_XGEN(b.x)], 1u);
            asm volatile("s_waitcnt vmcnt(0)" ::: "memory");
        } else {
            XB_SPIN(xb_ld(&bar[XB_XGEN(b.x)]) == gen, bar);
            __builtin_amdgcn_fence(__ATOMIC_ACQUIRE, "agent");
            asm volatile("s_waitcnt vmcnt(0)" ::: "memory");
        }
    }
    __syncthreads();
}

namespace pg8 {
constexpr int BM = 256, BK = 64, HALF = 128, HTB = HALF * BK * 2, STAGE_BYTES = 8 * HTB, NXCD = 8, WGM = 4;
__device__ __forceinline__ int lds_byte(int r, int c) { const int st = (r >> 4) * 2 + (c >> 5), rr = r & 15, cc = c & 31, ob = rr * 64 + cc * 2; return st * 1024 + (ob ^ (((ob >> 9) & 1) << 5)); }
__device__ __forceinline__ void stage_rc(int b, int& R, int& C) { const int st = b / 1024, sb = b % 1024, swz = sb ^ (((sb >> 9) & 1) << 5); R = (st >> 1) * 16 + swz / 64; C = (st & 1) * 32 + (swz % 64) / 2; }
__device__ __forceinline__ int perm32(int rho) { const int n = rho >> 4, i = rho & 15; return 8 * (i >> 2) + 4 * n + (i & 3); }
struct Unit { int pm, pn, e; };
struct Gemm {
    const void* A; int lda;
    const void* Bt; int K;
    int nM, nN;
    int grouped; int toff[9]; size_t estride;
    unsigned* sig; int nMl;
};
struct StaticOrder {
    int nM, nN, nwg, G, c, nMl;
    __device__ void init(int nM_, int nN_, int G_, int c_, int nMl_ = 0) { nM = nM_; nN = nN_; nwg = nM * nN; G = G_; c = c_; nMl = nMl_; }
    __device__ __forceinline__ bool next(int i, Unit& u) const {
        const long L = (long)i * G + c; if (L >= nwg) return false;
        const int nMe = nMl ? nMl : nM, nwe = nMe * nN;
        if (L >= nwe) { const int t = (int)L - nwe; u.pm = nMe + t / nN; u.pn = t % nN; u.e = 0; return true; }
        int wgid = (int)L; { const int q = nwe / NXCD, r = nwe % NXCD, xcd = wgid % NXCD, off = wgid / NXCD; wgid = (xcd < r ? xcd * (q + 1) : r * (q + 1) + (xcd - r) * q) + off; }
        const int nig = WGM * nN, gid = wgid / nig, fm = gid * WGM, gsz = (nMe - fm) < WGM ? (nMe - fm) : WGM;
        u.pm = fm + ((wgid % nig) % gsz); u.pn = (wgid % nig) / gsz; u.e = 0; return true;
    }
};
struct EpiBf16 {
    bf16_t* O; int ldc; float scale; int wt;
    __device__ __forceinline__ void operator()(const f32x4 (&acc)[2][2][4][2], const Unit& u, int wr, int wc, int fr, int fq) const {
        const int row0 = u.pm * BM + wr * 64 + fr, col0 = u.pn * BM + wc * 32 + 8 * fq;
#pragma unroll
        for (int ai = 0; ai < 2; ++ai)
#pragma unroll
            for (int m = 0; m < 4; ++m) { bf16_t* rowp = O + (size_t)(row0 + ai * HALF + m * 16) * ldc + col0;
#pragma unroll
                for (int bj = 0; bj < 2; ++bj) { const f32x4 v0 = acc[ai][bj][m][0] * scale, v1 = acc[ai][bj][m][1] * scale;
                    u32x4 w; w.x = cvtpk(v0[0], v0[1]); w.y = cvtpk(v0[2], v0[3]); w.z = cvtpk(v1[0], v1[1]); w.w = cvtpk(v1[2], v1[3]);
                    if (wt) asm volatile("global_store_dwordx4 %0, %1, off sc1\n\ts_nop 2" :: "v"(rowp + bj * HALF), "v"(w) : "memory");
                    else *(u32x4*)(rowp + bj * HALF) = w; } }
    }
};
__device__ __forceinline__ f32x4 swiglu4(f32x4 a, f32x4 b, float k1, float k2) {
    const f32x4 t = a * k1; f32x4 d;
#pragma unroll
    for (int j = 0; j < 4; ++j) d[j] = fast_exp2(t[j]);
    const float k2i = 1.f / k2;
    d = d * k2i + k2i; f32x4 r;
#pragma unroll
    for (int j = 0; j < 4; ++j) r[j] = fast_rcp(d[j]);
    return (a * b) * r;
}
struct EpiSwiGLU {
    bf16_t* O; int ldc;
    __device__ __forceinline__ void operator()(const f32x4 (&acc)[2][2][4][2], const Unit& u, int wr, int wc, int fr, int fq) const {
        const int row0 = u.pm * BM + wr * 64 + fr, col0 = u.pn * HALF + wc * 32 + 8 * fq;
#pragma unroll
        for (int ai = 0; ai < 2; ++ai)
#pragma unroll
            for (int m = 0; m < 4; ++m) { bf16_t* rowp = O + (size_t)(row0 + ai * HALF + m * 16) * ldc + col0;
                const f32x4 r0 = swiglu4(acc[ai][0][m][0], acc[ai][1][m][0], -LOG2E, 1.f), r1 = swiglu4(acc[ai][0][m][1], acc[ai][1][m][1], -LOG2E, 1.f);
                u32x4 w; w.x = cvtpk(r0[0], r0[1]); w.y = cvtpk(r0[2], r0[3]); w.z = cvtpk(r1[0], r1[1]); w.w = cvtpk(r1[2], r1[3]);
                *(u32x4*)rowp = w; }
    }
};

struct EpiEvenIn {
    bf16_t* O; int ldc; f32x2* stats; const float* rcos; const float* rsin; float scale;
    __device__ __forceinline__ void operator()(const f32x4 (&acc)[2][2][4][2], const Unit& u, int wr, int wc, int fr, int fq) const {
        int upm = u.pm, upn = u.pn; asm volatile("" : "+s"(upm), "+s"(upn));
        const int row0 = upm * BM + wr * 64 + fr, col0 = upn * BM + wc * 32 + 8 * fq;
        const int kind = upn < 2 ? 0 : (upn < 4 ? 1 : (upn < 8 ? 2 : 3)); const bool lat = upm < NLAT / BM; const int t4 = 4 * (4 * (wc & 1) + fq);
        f32x4 csA[2][4], snA[2][4];
        if (kind == 2) {
#pragma unroll
            for (int ai = 0; ai < 2; ++ai)
#pragma unroll
                for (int m = 0; m < 4; ++m) { const int sp = (row0 + ai * HALF + m * 16) & (SEQ - 1);
                    if (lat) { csA[ai][m] = *(const f32x4*)(rcos + sp * 32 + t4); snA[ai][m] = *(const f32x4*)(rsin + sp * 32 + t4); }
                    else { csA[ai][m] = (f32x4){1.f, 1.f, 1.f, 1.f}; snA[ai][m] = (f32x4){0.f, 0.f, 0.f, 0.f}; } }
        }
#pragma unroll
        for (int ai = 0; ai < 2; ++ai)
#pragma unroll
            for (int m = 0; m < 4; ++m) { const int row = row0 + ai * HALF + m * 16; bf16_t* rowp = O + (size_t)row * ldc + col0;
                float s1 = 0.f, s2 = 0.f;
#pragma unroll
                for (int bj = 0; bj < 2; ++bj) { f32x4 v0 = acc[ai][bj][m][0] * scale, v1 = acc[ai][bj][m][1] * scale;
                    if (kind < 2) {
#pragma unroll
                        for (int j = 0; j < 4; ++j) { v0[j] = gelu_tanh_f(v0[j]); v1[j] = gelu_tanh_f(v1[j]); }
                        if (kind == 1) { s1 += (v0[0] + v0[1]) + (v0[2] + v0[3]) + (v1[0] + v1[1]) + (v1[2] + v1[3]);
                            s2 += (v0[0] * v0[0] + v0[1] * v0[1]) + (v0[2] * v0[2] + v0[3] * v0[3]) + (v1[0] * v1[0] + v1[1] * v1[1]) + (v1[2] * v1[2] + v1[3] * v1[3]); } }
                    else if (kind == 2) { const f32x4 cs = csA[ai][m], sn = snA[ai][m]; const f32x4 o0 = v0 * cs - v1 * sn, o1 = v1 * cs + v0 * sn; v0 = o0; v1 = o1; }
                    u32x4 w; w.x = cvtpk(v0[0], v0[1]); w.y = cvtpk(v0[2], v0[3]); w.z = cvtpk(v1[0], v1[1]); w.w = cvtpk(v1[2], v1[3]);
                    *(u32x4*)(rowp + bj * HALF) = w; }
                if (kind == 1) { s1 += __shfl_xor(s1, 16); s1 += __shfl_xor(s1, 32); s2 += __shfl_xor(s2, 16); s2 += __shfl_xor(s2, 32);
                    if (fq == 0) stats[(size_t)row * 8 + (upn - 2) * 4 + wc] = (f32x2){s1, s2}; } }
    }
};
struct EpiOddIn {
    bf16_t* O; int ldc; float* stats; const float* rcos; const float* rsin; float scale;
    __device__ __forceinline__ void operator()(const f32x4 (&acc)[2][2][4][2], const Unit& u, int wr, int wc, int fr, int fq) const {
        int upm = u.pm, upn = u.pn; asm volatile("" : "+s"(upm), "+s"(upn));
        const int row0 = upm * BM + wr * 64 + fr, col0 = upn * BM + wc * 32 + 8 * fq; const bool lat = upm < NLAT / BM;
        const bool ropet = (upn == 7) && (wc == 0) && lat;
        f32x4 csA[2][4], snA[2][4];
        if (ropet) {
#pragma unroll
            for (int ai = 0; ai < 2; ++ai)
#pragma unroll
                for (int m = 0; m < 4; ++m) { const int sp = (row0 + ai * HALF + m * 16) & (SEQ - 1); csA[ai][m] = *(const f32x4*)(rcos + sp * 16 + 4 * fq); snA[ai][m] = *(const f32x4*)(rsin + sp * 16 + 4 * fq); }
        }
#pragma unroll
        for (int ai = 0; ai < 2; ++ai)
#pragma unroll
            for (int m = 0; m < 4; ++m) { const int row = row0 + ai * HALF + m * 16; bf16_t* rowp = O + (size_t)row * ldc + col0; float ss = 0.f;
#pragma unroll
                for (int bj = 0; bj < 2; ++bj) { f32x4 v0 = acc[ai][bj][m][0] * scale, v1 = acc[ai][bj][m][1] * scale;
                    if (upn == 6 || (upn == 7 && bj == 0)) ss += (v0[0] * v0[0] + v0[1] * v0[1]) + (v0[2] * v0[2] + v0[3] * v0[3]) + (v1[0] * v1[0] + v1[1] * v1[1]) + (v1[2] * v1[2] + v1[3] * v1[3]);
                    if (ropet && bj == 1) { const f32x4 cs = csA[ai][m], sn = snA[ai][m];
                        const f32x4 o0 = v0 * cs - v1 * sn, o1 = v1 * cs + v0 * sn; v0 = o0; v1 = o1; }
                    u32x4 w; w.x = cvtpk(v0[0], v0[1]); w.y = cvtpk(v0[2], v0[3]); w.z = cvtpk(v1[0], v1[1]); w.w = cvtpk(v1[2], v1[3]);
                    *(u32x4*)(rowp + bj * HALF) = w; }
                if (upn >= 6) { ss += __shfl_xor(ss, 16); ss += __shfl_xor(ss, 32); if (fq == 0) stats[(size_t)row * 8 + (upn - 6) * 4 + wc] = ss; } }
    }
};
struct EpiMlaUp {
    bf16_t* O; int ldc; const float* stats;
    __device__ __forceinline__ void operator()(const f32x4 (&acc)[2][2][4][2], const Unit& u, int wr, int wc, int fr, int fq) const {
        const int row0 = u.pm * BM + wr * 64 + fr, col0 = u.pn * BM + wc * 32 + 8 * fq;
        f32x4 pqA[2][4], pkA[2][4]; float rqA[2][4], rkA[2][4];
#pragma unroll
        for (int ai = 0; ai < 2; ++ai)
#pragma unroll
            for (int m = 0; m < 4; ++m) { const int row = row0 + ai * HALF + m * 16; pqA[ai][m] = *(const f32x4*)(stats + (size_t)row * 8); pkA[ai][m] = *(const f32x4*)(stats + (size_t)row * 8 + 4); }
#pragma unroll
        for (int ai = 0; ai < 2; ++ai)
#pragma unroll
            for (int m = 0; m < 4; ++m) { const f32x4 pq = pqA[ai][m], pk = pkA[ai][m];
                rqA[ai][m] = rsqrtf(((pq[0] + pq[1]) + (pq[2] + pq[3])) * (1.f / 256.f) + EPS); rkA[ai][m] = rsqrtf(((pk[0] + pk[1]) + (pk[2] + pk[3])) * (1.f / 128.f) + EPS); }
#pragma unroll
        for (int ai = 0; ai < 2; ++ai)
#pragma unroll
            for (int m = 0; m < 4; ++m) { const int row = row0 + ai * HALF + m * 16; bf16_t* rowp = O + (size_t)row * ldc + col0;
                const float rq = rqA[ai][m], rk = rkA[ai][m];
#pragma unroll
                for (int bj = 0; bj < 2; ++bj) { const int c0 = col0 + bj * HALF; const float sc = c0 < 384 ? rq : (c0 < 768 ? (((c0 - 384) % 96) < 64 ? rk : 1.f) : rk);
                    const f32x4 v0 = acc[ai][bj][m][0] * sc, v1 = acc[ai][bj][m][1] * sc;
                    u32x4 w; w.x = cvtpk(v0[0], v0[1]); w.y = cvtpk(v0[2], v0[3]); w.z = cvtpk(v1[0], v1[1]); w.w = cvtpk(v1[2], v1[3]);
                    *(u32x4*)(rowp + bj * HALF) = w; } }
    }
};
struct EpiSwiGLU8 {
    unsigned char* O; int ldc; float scale;
    __device__ __forceinline__ void operator()(const f32x4 (&acc)[2][2][4][2], const Unit& u, int wr, int wc, int fr, int fq) const {
        const int row0 = u.pm * BM + wr * 64 + fr, col0 = u.pn * HALF + wc * 32 + 8 * fq;
#pragma unroll
        for (int ai = 0; ai < 2; ++ai)
#pragma unroll
            for (int m = 0; m < 4; ++m) { unsigned char* rowp = O + (size_t)(row0 + ai * HALF + m * 16) * ldc + col0;
                const float k1 = -LOG2E * scale, k2 = F8_ACT_SCALE * scale * scale;
                const f32x4 r0 = swiglu4(acc[ai][0][m][0], acc[ai][1][m][0], k1, k2), r1 = swiglu4(acc[ai][0][m][1], acc[ai][1][m][1], k1, k2);
                u32x2 w; w.x = pk4_fp8(r0[0], r0[1], r0[2], r0[3]); w.y = pk4_fp8(r1[0], r1[1], r1[2], r1[3]);
                *(u32x2*)rowp = w; }
    }
};

template <class Epi, bool F8 = false>
__device__ __forceinline__ void gemm_phase(LAS unsigned char* lds, const Gemm& g, const Epi& E) {
    const int tid = opaque_tid(), wid = __builtin_amdgcn_readfirstlane(tid >> 6), lane = tid & 63, wr = wid >> 2, wc = wid & 3, fr = lane & 15, fq = lane >> 4;
    constexpr int ES = F8 ? 1 : 2;
    const int K = g.K, nt = K * ES / (BK * 2), lda = g.lda;
    StaticOrder S; S.init(g.nM, g.nN, (int)gridDim.x, opaque_bid(), g.nMl);
    unsigned voffA[2], voffB[2];
#pragma unroll
    for (int i = 0; i < 2; ++i) { int R, C; stage_rc(tid * 16 + i * 8192, R, C); const int Rb = (R & ~31) + perm32(R & 31);
        voffA[i] = (unsigned)(R * lda * ES + C * 2); voffB[i] = (unsigned)(Rb * K * ES + C * 2); }
    const size_t kstep = (size_t)(BK * 2);
    const size_t hA = (size_t)HALF * lda * ES, tA = 2 * hA, hB = (size_t)HALF * K * ES, tB = 2 * hB;
    const unsigned ldsw = (unsigned)wid * 1024u;
    const int aoff = lds_byte(wr * 64 + fr, fq * 8), boff = lds_byte(wc * 32 + fr, fq * 8);
#define PG8_SA(b, h) (((b) * 2 + (h)) * HTB)
#define PG8_SB(b, h) ((4 + (b) * 2 + (h)) * HTB)
#define PG8_STAGE(bufoff, gbase, voff) do { _Pragma("unroll") for (int _i = 0; _i < 2; ++_i) \
        __builtin_amdgcn_global_load_lds((const unsigned*)((const char*)(gbase) + (voff)[_i]), (LAS unsigned*)(lds + (bufoff) + ldsw + _i * 8192), 16, 0, 0); } while (0)
#define PG8_LD8(base) __builtin_shufflevector(*(const LAS i32x4*)(base), *(const LAS i32x4*)((base) + 1024), 0, 1, 2, 3, 4, 5, 6, 7)
#define PG8_LDA(dst, b, h) do { _Pragma("unroll") for (int m = 0; m < 4; ++m) dst[m] = PG8_LD8(lds + PG8_SA(b, h) + aoff + m * 2048); } while (0)
#define PG8_LDB(dst, b, h) do { _Pragma("unroll") for (int n = 0; n < 2; ++n) dst[n] = PG8_LD8(lds + PG8_SB(b, h) + boff + n * 2048); } while (0)
#define PG8_H0(x) __builtin_bit_cast(bf16x8, __builtin_shufflevector(x, x, 0, 1, 2, 3))
#define PG8_H1(x) __builtin_bit_cast(bf16x8, __builtin_shufflevector(x, x, 4, 5, 6, 7))
#define PG8_MMA(ai, bj, At, Bt) do { __builtin_amdgcn_s_setprio(1); _Pragma("unroll") for (int m = 0; m < 4; ++m) _Pragma("unroll") for (int n = 0; n < 2; ++n) { \
        if constexpr (F8) asm volatile("v_mfma_f32_16x16x128_f8f6f4 %0, %1, %2, %0" : "+v"(acc[ai][bj][m][n]) : "v"(Bt[n]), "v"(At[m])); \
        else { acc[ai][bj][m][n] = __builtin_amdgcn_mfma_f32_16x16x32_bf16(PG8_H0(Bt[n]), PG8_H0(At[m]), acc[ai][bj][m][n], 0, 0, 0); \
               acc[ai][bj][m][n] = __builtin_amdgcn_mfma_f32_16x16x32_bf16(PG8_H1(Bt[n]), PG8_H1(At[m]), acc[ai][bj][m][n], 0, 0, 0); } } \
        __builtin_amdgcn_s_setprio(0); } while (0)
#define PG8_WAIT_V(n) asm volatile("s_waitcnt vmcnt(" #n ")" ::: "memory")
#define PG8_WAIT_L(n) asm volatile("s_waitcnt lgkmcnt(" #n ")" ::: "memory")
#define PG8_BAR __builtin_amdgcn_s_barrier()
#define PG8_SCHED __builtin_amdgcn_sched_barrier(0)
#define PG8_EXPERT(u) do { if (g.grouped) { int _e = 0; _Pragma("unroll") for (int _k = 1; _k < 8; ++_k) _e += ((u).pm >= g.toff[_k]) ? 1 : 0; (u).e = _e; } } while (0)
    Unit cur, nxt; int ui = 0;
    if (!S.next(0, cur)) return;
    PG8_EXPERT(cur);
    f32x4 acc[2][2][4][2];
#pragma unroll
    for (int a = 0; a < 2; ++a)
#pragma unroll
        for (int b = 0; b < 2; ++b)
#pragma unroll
            for (int m = 0; m < 4; ++m)
#pragma unroll
                for (int n = 0; n < 2; ++n) acc[a][b][m][n] = (f32x4){0.f, 0.f, 0.f, 0.f};
    i32x8 At[4], B0[2], B1[2];
    const char* cA = (const char*)g.A + (size_t)cur.pm * tA; const char* cB = ((const char*)g.Bt + (size_t)cur.e * g.estride * ES) + (size_t)cur.pn * tB;
    PG8_STAGE(PG8_SB(0, 0), cB, voffB); PG8_STAGE(PG8_SA(0, 0), cA, voffA); PG8_STAGE(PG8_SB(0, 1), cB + hB, voffB); PG8_STAGE(PG8_SA(0, 1), cA + hA, voffA);
    if (wr == 1) PG8_BAR;
    PG8_WAIT_V(4); PG8_BAR;
    PG8_STAGE(PG8_SB(1, 0), cB + kstep, voffB); PG8_STAGE(PG8_SA(1, 0), cA + kstep, voffA); PG8_STAGE(PG8_SB(1, 1), cB + hB + kstep, voffB);
    PG8_WAIT_V(6); PG8_BAR;
    for (;;) {
        const bool has_next = S.next(ui + 1, nxt);
        if (has_next) PG8_EXPERT(nxt);
        const char* nA = has_next ? (const char*)g.A + (size_t)nxt.pm * tA : cA; const char* nB = has_next ? ((const char*)g.Bt + (size_t)nxt.e * g.estride * ES) + (size_t)nxt.pn * tB : cB;
        for (int t = 0; t < nt; t += 2) {
            const bool last = (t == nt - 2);
            const char* a1 = cA + (size_t)(t + 1) * kstep;
            const char* a2 = last ? nA : cA + (size_t)(t + 2) * kstep; const char* b2 = last ? nB : cB + (size_t)(t + 2) * kstep;
            const char* a3 = a2 + kstep; const char* b3 = b2 + kstep;
            PG8_LDB(B0, 0, 0); PG8_SCHED; PG8_LDA(At, 0, 0); PG8_STAGE(PG8_SA(1, 1), a1 + hA, voffA);
            PG8_WAIT_L(8); PG8_BAR; PG8_WAIT_L(0); PG8_MMA(0, 0, At, B0); PG8_BAR; PG8_SCHED;
            PG8_LDB(B1, 0, 1); PG8_STAGE(PG8_SB(0, 0), b2, voffB);
            PG8_BAR; PG8_WAIT_L(0); PG8_MMA(0, 1, At, B1); PG8_BAR;
            PG8_LDA(At, 0, 1); PG8_STAGE(PG8_SA(0, 0), a2, voffA);
            PG8_BAR; PG8_WAIT_L(0); PG8_MMA(1, 0, At, B0); PG8_BAR; PG8_SCHED;
            PG8_STAGE(PG8_SB(0, 1), b2 + hB, voffB);
            PG8_WAIT_V(6); PG8_BAR; PG8_MMA(1, 1, At, B1); PG8_BAR;
            PG8_LDB(B0, 1, 0); PG8_SCHED; PG8_LDA(At, 1, 0); PG8_STAGE(PG8_SA(0, 1), a2 + hA, voffA);
            PG8_WAIT_L(8); PG8_BAR; PG8_WAIT_L(0); PG8_MMA(0, 0, At, B0); PG8_BAR; PG8_SCHED;
            PG8_LDB(B1, 1, 1); PG8_STAGE(PG8_SB(1, 0), b3, voffB);
            PG8_BAR; PG8_WAIT_L(0); PG8_MMA(0, 1, At, B1); PG8_BAR;
            PG8_LDA(At, 1, 1); PG8_STAGE(PG8_SA(1, 0), a3, voffA);
            PG8_BAR; PG8_WAIT_L(0); PG8_MMA(1, 0, At, B0); PG8_BAR; PG8_SCHED;
            PG8_STAGE(PG8_SB(1, 1), b3 + hB, voffB);
            PG8_WAIT_V(6); PG8_BAR; PG8_MMA(1, 1, At, B1); PG8_BAR;
        }
        if constexpr (F8) { PG8_SCHED; asm volatile("s_nop 15\n\ts_nop 15" ::: "memory"); PG8_SCHED; }
        E(acc, cur, wr, wc, fr, fq);
        if (g.sig) { PG8_WAIT_V(0); PG8_BAR; if (wid == 4 && lane == 0) (void)xb_add(g.sig + cur.pm * 64, 1u); }
        if (!has_next) break;
#pragma unroll
        for (int a = 0; a < 2; ++a)
#pragma unroll
            for (int b = 0; b < 2; ++b)
#pragma unroll
                for (int m = 0; m < 4; ++m)
#pragma unroll
                    for (int n = 0; n < 2; ++n) acc[a][b][m][n] = (f32x4){0.f, 0.f, 0.f, 0.f};
        cur = nxt; cA = nA; cB = nB; ++ui;
    }
    PG8_WAIT_V(0);
    if (wr == 0) PG8_BAR;
    PG8_BAR;
#undef PG8_SA
#undef PG8_SB
#undef PG8_STAGE
#undef PG8_LDA
#undef PG8_LDB
#undef PG8_MMA
#undef PG8_H0
#undef PG8_H1
#undef PG8_LD8
#undef PG8_WAIT_V
#undef PG8_WAIT_L
#undef PG8_BAR
#undef PG8_SCHED
#undef PG8_EXPERT
}
}

__device__ __forceinline__ void gemm_bf16(LAS unsigned char* lds, const pg8::Gemm& g, bf16_t* O, int ldc, int wt = 0) { pg8::EpiBf16 E{O, ldc, 1.f, wt}; pg8::gemm_phase(lds, g, E); }
__device__ __forceinline__ void gemm_even_in(LAS unsigned char* lds, const pg8::Gemm& g, const pg8::EpiEvenIn& E) { pg8::gemm_phase(lds, g, E); }
__device__ __forceinline__ void gemm8_even_in(LAS unsigned char* lds, const pg8::Gemm& g, const pg8::EpiEvenIn& E) { pg8::gemm_phase<pg8::EpiEvenIn, true>(lds, g, E); }
__device__ __forceinline__ void gemm8_odd_in(LAS unsigned char* lds, const pg8::Gemm& g, const pg8::EpiOddIn& E) { pg8::gemm_phase<pg8::EpiOddIn, true>(lds, g, E); }
__device__ __forceinline__ void gemm_odd_in(LAS unsigned char* lds, const pg8::Gemm& g, const pg8::EpiOddIn& E) { pg8::gemm_phase(lds, g, E); }
__device__ __forceinline__ void gemm_mla_up(LAS unsigned char* lds, const pg8::Gemm& g, const pg8::EpiMlaUp& E) { pg8::gemm_phase(lds, g, E); }
__device__ __forceinline__ void gemm8_bf16(LAS unsigned char* lds, const pg8::Gemm& g, bf16_t* O, int ldc) { pg8::EpiBf16 E{O, ldc, F8_INV, 0}; pg8::gemm_phase<pg8::EpiBf16, true>(lds, g, E); }
__device__ __forceinline__ void gemm8_swiglu8(LAS unsigned char* lds, const pg8::Gemm& g, unsigned char* O, int ldc) { pg8::EpiSwiGLU8 E{O, ldc, F8_INV}; pg8::gemm_phase<pg8::EpiSwiGLU8, true>(lds, g, E); }
__device__ __forceinline__ void gemm_swiglu(LAS unsigned char* lds, const pg8::Gemm& g, bf16_t* O, int ldc) { pg8::EpiSwiGLU E{O, ldc}; pg8::gemm_phase(lds, g, E); }
__device__ __forceinline__ void gemm_swiglu_to8(LAS unsigned char* lds, const pg8::Gemm& g, unsigned char* O, int ldc) { pg8::EpiSwiGLU8 E{O, ldc, 1.f}; pg8::gemm_phase<pg8::EpiSwiGLU8, false>(lds, g, E); }

namespace att {
#define SBAR() __builtin_amdgcn_sched_barrier(0)
__device__ __forceinline__ int crow(int r, int hi) { return (r & 3) + 8 * (r >> 2) + 4 * hi; }
__device__ __forceinline__ int v_st(int k, int c) { const int kk = (k & ~0xC) | ((k & 4) << 1) | ((k & 8) >> 1); return ((kk >> 3) * 4 + (c >> 5)) * 512 + ((kk & 7) * 32 + (c & 31)) * 2; }
__device__ __forceinline__ int v_st_plain(int k, int c) { return ((k >> 3) * 4 + (c >> 5)) * 512 + ((k & 7) * 32 + (c & 31)) * 2; }
__device__ __forceinline__ int v_rd_base(int lane) { return ((lane & 3) << 3) | (((lane >> 2) & 3) << 6) | (((lane >> 4) & 1) << 5) | (((lane >> 5) & 1) << 8); }
constexpr int v_rd_off(int d0, int ks, int half) { return d0 * 512 + ks * 4096 + half * 2048; }
template <int OFF> __device__ __forceinline__ s16x4 tr_read(unsigned vb) {
    s16x4 r; asm volatile("ds_read_b64_tr_b16 %0, %1 offset:%2" : "=&v"(r) : "v"(vb), "i"(OFF) : "memory"); return r;
}
template <int D0> __device__ __forceinline__ void pv_one(f32x16& od, unsigned vb, bf16x8 pa0, bf16x8 pa1, bf16x8 pa2, bf16x8 pa3) {
    const s16x4 l0 = tr_read<v_rd_off(D0, 0, 0)>(vb), h0 = tr_read<v_rd_off(D0, 0, 1)>(vb), l1 = tr_read<v_rd_off(D0, 1, 0)>(vb), h1 = tr_read<v_rd_off(D0, 1, 1)>(vb);
    const s16x4 l2 = tr_read<v_rd_off(D0, 2, 0)>(vb), h2 = tr_read<v_rd_off(D0, 2, 1)>(vb), l3 = tr_read<v_rd_off(D0, 3, 0)>(vb), h3 = tr_read<v_rd_off(D0, 3, 1)>(vb);
    asm volatile("s_waitcnt lgkmcnt(0)" ::: "memory"); SBAR();
#define PK(L, H) (bf16x8){L[0], L[1], L[2], L[3], H[0], H[1], H[2], H[3]}
    od = __builtin_amdgcn_mfma_f32_32x32x16_bf16(pa0, PK(l0, h0), od, 0, 0, 0);
    od = __builtin_amdgcn_mfma_f32_32x32x16_bf16(pa1, PK(l1, h1), od, 0, 0, 0);
    od = __builtin_amdgcn_mfma_f32_32x32x16_bf16(pa2, PK(l2, h2), od, 0, 0, 0);
    od = __builtin_amdgcn_mfma_f32_32x32x16_bf16(pa3, PK(l3, h3), od, 0, 0, 0);
#undef PK
}
template <int KS, int NO> __device__ __forceinline__ void pv_step(f32x16 (&o)[NO], unsigned vb, bf16x8 pa) {
    s16x4 l[NO], h[NO];
    l[0] = tr_read<v_rd_off(0, KS, 0)>(vb); h[0] = tr_read<v_rd_off(0, KS, 1)>(vb); l[1] = tr_read<v_rd_off(1, KS, 0)>(vb); h[1] = tr_read<v_rd_off(1, KS, 1)>(vb);
    if constexpr (NO == 4) { l[2] = tr_read<v_rd_off(2, KS, 0)>(vb); h[2] = tr_read<v_rd_off(2, KS, 1)>(vb); l[3] = tr_read<v_rd_off(3, KS, 0)>(vb); h[3] = tr_read<v_rd_off(3, KS, 1)>(vb); }
    asm volatile("s_waitcnt lgkmcnt(0)" ::: "memory"); SBAR();
#pragma unroll
    for (int d = 0; d < NO; ++d) o[d] = __builtin_amdgcn_mfma_f32_32x32x16_bf16(pa, (bf16x8){l[d][0], l[d][1], l[d][2], l[d][3], h[d][0], h[d][1], h[d][2], h[d][3]}, o[d], 0, 0, 0);
}
__device__ __forceinline__ void rot4(bf16x8& a, const float* cs, const float* sn) {
    const f32x4 c = *(const f32x4*)cs, s = *(const f32x4*)sn; float o[8];
#pragma unroll
    for (int e = 0; e < 4; ++e) { const float x1 = bf2f((unsigned short)a[e]), x2 = bf2f((unsigned short)a[4 + e]); o[e] = x1 * c[e] - x2 * s[e]; o[4 + e] = x2 * c[e] + x1 * s[e]; }
    u32x4 w = {cvtpk(o[0], o[1]), cvtpk(o[2], o[3]), cvtpk(o[4], o[5]), cvtpk(o[6], o[7])};
    a = *reinterpret_cast<bf16x8*>(&w);
}
struct Args {
    const bf16_t* Q; int ldq, qcol;
    const bf16_t* K; int ldk, kcol;
    const bf16_t* V; int ldv, vcol;
    int q_row0;
    int kctx_row0, klat_row0, nt_ctx, nt_lat;
    float C;
    int rope;
    const float* rcos; const float* rsin;
    bf16_t* O; int ldo, ocol;
    int g, u0; const float* rpb;
    float lam, oscale; const float* subg;
};

__device__ __forceinline__ unsigned off_a(unsigned row, unsigned ch) { return 2048u * (row >> 3) + 512u * (ch >> 2) + 64u * (row & 7) + 16u * ((ch & 3) ^ ((row >> 2) & 3)); }
template <int OFF> __device__ __forceinline__ s16x4 tr_read_u(unsigned addr) {
    s16x4 r; asm volatile("ds_read_b64_tr_b16 %0, %1 offset:%2" : "=&v"(r) : "v"(addr), "i"(OFF) : "memory"); return r;
}
template <int KS2, int DB0>
__device__ __forceinline__ void pv16_load(s16x4 (&L)[4], s16x4 (&H)[4], const unsigned (&vb)[2][2]) {
    L[0] = tr_read_u<8192 * KS2 + 512 * ((DB0 + 0) >> 1)>(vb[(DB0 + 0) & 1][0]); H[0] = tr_read_u<8192 * KS2 + 512 * ((DB0 + 0) >> 1)>(vb[(DB0 + 0) & 1][1]);
    L[1] = tr_read_u<8192 * KS2 + 512 * ((DB0 + 1) >> 1)>(vb[(DB0 + 1) & 1][0]); H[1] = tr_read_u<8192 * KS2 + 512 * ((DB0 + 1) >> 1)>(vb[(DB0 + 1) & 1][1]);
    L[2] = tr_read_u<8192 * KS2 + 512 * ((DB0 + 2) >> 1)>(vb[(DB0 + 2) & 1][0]); H[2] = tr_read_u<8192 * KS2 + 512 * ((DB0 + 2) >> 1)>(vb[(DB0 + 2) & 1][1]);
    L[3] = tr_read_u<8192 * KS2 + 512 * ((DB0 + 3) >> 1)>(vb[(DB0 + 3) & 1][0]); H[3] = tr_read_u<8192 * KS2 + 512 * ((DB0 + 3) >> 1)>(vb[(DB0 + 3) & 1][1]);
}
template <int DB0, int NDB>
__device__ __forceinline__ void pv16_mma(f32x4 (&o)[2][NDB], const s16x4 (&L)[4], const s16x4 (&H)[4], bf16x8 p0, bf16x8 p1) {
#pragma unroll
    for (int i = 0; i < 4; ++i) { const bf16x8 vf = {L[i][0], L[i][1], L[i][2], L[i][3], H[i][0], H[i][1], H[i][2], H[i][3]};
        o[0][DB0 + i] = __builtin_amdgcn_mfma_f32_16x16x32_bf16(p0, vf, o[0][DB0 + i], 0, 0, 0);
        o[1][DB0 + i] = __builtin_amdgcn_mfma_f32_16x16x32_bf16(p1, vf, o[1][DB0 + i], 0, 0, 0); }
}
#define PV16_WAIT(n) do { asm volatile("s_waitcnt lgkmcnt(" #n ")" ::: "memory"); SBAR(); } while (0)
template <int DQK, int KW, int DV, int MODE>
__device__ __forceinline__ void attn_unit(LAS unsigned char* lds, const Args& a) {
    constexpr int NKS = DQK / 32, NDB = DV / 16;
    constexpr int KSTR = KW * 2 + 16, KBUF = 64 * KSTR;
    constexpr int OFF_V = 3 * KBUF, OFF_WS = OFF_V + 3 * 16384, OFF_RPB = OFF_WS + 2048;
    const int tid = opaque_tid(), wid = __builtin_amdgcn_readfirstlane(tid >> 6), lane = tid & 63, n = lane & 15, g = lane >> 4;
    LAS unsigned char* Kl = lds; LAS unsigned char* Vl = lds + OFF_V;
    LAS float* wsf = (LAS float*)(lds + OFF_WS) + wid * 64; LAS float* li_l = wsf;
    LAS float* rpbl = (LAS float*)(lds + OFF_RPB) + 64;
    const int wq = (MODE == 1) ? (wid & 3) : wid, wmap = (MODE == 1) ? (wid >> 2) : 0;
    bf16x8 qf[2][NKS];
#pragma unroll
    for (int qb = 0; qb < 2; ++qb) {
        const int qrow = a.q_row0 + wq * 32 + qb * 16 + n;
        const bf16_t* Qw = a.Q + (size_t)qrow * a.ldq + a.qcol + wmap * 64 + g * 8;
#pragma unroll
        for (int ks = 0; ks < NKS; ++ks) qf[qb][ks] = *(const bf16x8*)(Qw + ks * 32);
        if (a.rope == 2) { if constexpr (NKS >= 3) { const int s = qrow & (SEQ - 1); rot4(qf[qb][2], a.rcos + s * 16 + 4 * g, a.rsin + s * 16 + 4 * g); } }
#pragma unroll
        for (int ks = 0; ks < NKS; ++ks) { float f[8];
#pragma unroll
            for (int e = 0; e < 8; ++e) f[e] = bf2f((unsigned short)qf[qb][ks][e]) * a.C;
            u32x4 w = {cvtpk(f[0], f[1]), cvtpk(f[2], f[3]), cvtpk(f[4], f[5]), cvtpk(f[6], f[7])}; qf[qb][ks] = *reinterpret_cast<bf16x8*>(&w); }
    }
    const int cq0 = (wid & 1) * 32 + n, cq1 = cq0 + 16, rq = 4 * a.g + (wid >> 1);
    const int rs = min(max(rq - 4, 0), 120), cs0 = min(max(cq0 - 8, 0), 48), cs1 = min(max(cq1 - 8, 0), 48);
    unsigned namask = 0u;
    if (MODE == 2) {
#pragma unroll
        for (int kb = 0; kb < 4; ++kb)
#pragma unroll
            for (int r = 0; r < 4; ++r) { const int ck = kb * 16 + 4 * g + r;
                namask |= (((unsigned)(ck - cs0) < 16u) ? 1u : 0u) << (kb * 4 + r); namask |= (((unsigned)(ck - cs1) < 16u) ? 1u : 0u) << (16 + kb * 4 + r); }
    }
    constexpr int NKB = KBUF / 1024, NBT = NKB + 16, NB = (NBT + 7) / 8;
    static_assert(KBUF % 1024 == 0, "K image is a whole number of 1 KB blocks");
    unsigned soff[NB];
#pragma unroll
    for (int i = 0; i < NB; ++i) { const int bb = wid + 8 * i; unsigned so = 0u;
        if (bb < NKB) { const int A = bb * 1024 + lane * 16, row = A / KSTR; int off = A % KSTR; if (off >= KW * 2) off = 0; so = (unsigned)(row * a.ldk * 2 + off); }
        else if (bb < NBT) { const int A = (bb - NKB) * 1024 + lane * 16, rho = ((A >> 11) << 3) | ((A >> 6) & 7); int ch = (((A >> 9) & 3) << 2) | (((A >> 4) & 3) ^ ((rho >> 2) & 3));
            if (DV == 64) ch &= 7;
            const int key = ((rho >> 5) * 2 + ((rho >> 2) & 1)) * 16 + 4 * ((rho >> 3) & 3) + (rho & 3);
            so = (unsigned)((key * a.ldv + ch * 8) * 2); }
        soff[i] = so; }
    const int NT = a.nt_ctx + a.nt_lat;
#define TILE_ROW(j) ((j) < a.nt_ctx ? a.kctx_row0 + 64 * (j) : a.klat_row0 + 64 * ((j) - a.nt_ctx))
#define DMA(t) do { const int _r0 = TILE_ROW(t), _sl = (t) % 3; const char* _kp = (const char*)(a.K + (size_t)_r0 * a.ldk + a.kcol); const char* _vp = (const char*)(a.V + (size_t)_r0 * a.ldv + a.vcol); \
    _Pragma("unroll") for (int _i = 0; _i < NB; ++_i) { const int _bb = wid + 8 * _i; const bool _isk = _bb < NKB;   \
        const char* _src = (_isk ? _kp : _vp) + soff[_i]; LAS unsigned char* _dst = _isk ? (Kl + _sl * KBUF + _bb * 1024) : (Vl + _sl * 16384 + (_bb - NKB) * 1024); \
        if (_i + 1 < NB || _bb < NBT) __builtin_amdgcn_global_load_lds((const unsigned*)_src, (LAS unsigned*)_dst, 16, 0, 0); } } while (0)
#define DMA_SYNC() do { asm volatile("s_waitcnt vmcnt(0)" ::: "memory"); __syncthreads(); } while (0)
    float lsum0 = 0.f, lsum1 = 0.f;
    f32x4 o[2][NDB];
#pragma unroll
    for (int qb = 0; qb < 2; ++qb)
#pragma unroll
        for (int d = 0; d < NDB; ++d) o[qb][d] = (f32x4){0.f, 0.f, 0.f, 0.f};
    const unsigned kbase = (unsigned)(size_t)Kl + (unsigned)(n * KSTR + 16 * g + wmap * 128);
    unsigned vb0[2][2];
    { const unsigned q4 = (unsigned)n >> 2, p = (unsigned)n & 3;
#pragma unroll
      for (int cb = 0; cb < 2; ++cb)
#pragma unroll
          for (int t = 0; t < 2; ++t) vb0[cb][t] = (unsigned)(size_t)Vl + off_a(8u * g + 4u * t + q4, 2u * cb + (p >> 1)) + 8u * (p & 1); }
#define QKT(S, b) do { const unsigned _kb = kbase + (unsigned)((b) * KBUF); bf16x8 _kf[4][NKS]; \
    _Pragma("unroll") for (int kb = 0; kb < 4; ++kb) _Pragma("unroll") for (int ks = 0; ks < NKS; ++ks) _kf[kb][ks] = *(const LAS bf16x8*)(size_t)(_kb + kb * 16 * KSTR + ks * 64); \
    _Pragma("unroll") for (int kb = 0; kb < 4; ++kb) _Pragma("unroll") for (int qb = 0; qb < 2; ++qb) { f32x4 _acc = {0.f, 0.f, 0.f, 0.f}; \
        _Pragma("unroll") for (int ks = 0; ks < NKS; ++ks) _acc = __builtin_amdgcn_mfma_f32_16x16x32_bf16(_kf[kb][ks], qf[qb][ks], _acc, 0, 0, 0); \
        S[kb][qb] = _acc; } } while (0)
#define PARTIAL(S, j) do { \
    if (MODE == 2) { if ((j) >= a.nt_ctx) { const int kr = a.u0 + ((j) - a.nt_ctx); const bool rowok = (kr >= rs) && (kr < rs + 8);   \
        if (rowok) { const LAS float* b0 = rpbl + (kr - rq + 7) * 31 + 15 - cq0 + 4 * g; const LAS float* b1 = b0 - 16;   \
            _Pragma("unroll") for (int kb = 0; kb < 4; ++kb) { const f32x4u bv0 = *(const LAS f32x4u*)(b0 + kb * 16), bv1 = *(const LAS f32x4u*)(b1 + kb * 16);   \
                _Pragma("unroll") for (int r = 0; r < 4; ++r) { const float t0 = S[kb][0][r] + bv0[r], t1 = S[kb][1][r] + bv1[r]; \
                    S[kb][0][r] = ((namask >> (kb * 4 + r)) & 1u) ? t0 : -1e30f; S[kb][1][r] = ((namask >> (16 + kb * 4 + r)) & 1u) ? t1 : -1e30f; } } } \
        else { _Pragma("unroll") for (int kb = 0; kb < 4; ++kb) _Pragma("unroll") for (int r = 0; r < 4; ++r) { S[kb][0][r] = -1e30f; S[kb][1][r] = -1e30f; } } } } \
    _Pragma("unroll") for (int kb = 0; kb < 2; ++kb) _Pragma("unroll") for (int qb = 0; qb < 2; ++qb) _Pragma("unroll") for (int r = 0; r < 4; ++r) S[kb][qb][r] = fast_exp2(S[kb][qb][r]); } while (0)
#define FINISH(S) do { \
    _Pragma("unroll") for (int kb = 2; kb < 4; ++kb) _Pragma("unroll") for (int qb = 0; qb < 2; ++qb) _Pragma("unroll") for (int r = 0; r < 4; ++r) S[kb][qb][r] = fast_exp2(S[kb][qb][r]); \
    float _p0 = 0.f, _p1 = 0.f; \
    _Pragma("unroll") for (int kb = 0; kb < 4; ++kb) { _p0 += (S[kb][0][0] + S[kb][0][1]) + (S[kb][0][2] + S[kb][0][3]); _p1 += (S[kb][1][0] + S[kb][1][1]) + (S[kb][1][2] + S[kb][1][3]); } \
    lsum0 += _p0; lsum1 += _p1; \
    _Pragma("unroll") for (int qb = 0; qb < 2; ++qb) _Pragma("unroll") for (int k2 = 0; k2 < 2; ++k2) { \
        u32x4 _w = {cvtpk(S[2 * k2][qb][0], S[2 * k2][qb][1]), cvtpk(S[2 * k2][qb][2], S[2 * k2][qb][3]), cvtpk(S[2 * k2 + 1][qb][0], S[2 * k2 + 1][qb][1]), cvtpk(S[2 * k2 + 1][qb][2], S[2 * k2 + 1][qb][3])}; \
        pf[qb][k2] = *reinterpret_cast<bf16x8*>(&_w); } } while (0)
#define PV(b) do { unsigned _vb[2][2]; _Pragma("unroll") for (int cb = 0; cb < 2; ++cb) _Pragma("unroll") for (int t = 0; t < 2; ++t) _vb[cb][t] = vb0[cb][t] + (unsigned)(b) * 16384u; \
    s16x4 _La[4], _Ha[4], _Lb[4], _Hb[4]; \
    if constexpr (NDB == 8) { \
        pv16_load<0, 0>(_La, _Ha, _vb); pv16_load<0, 4>(_Lb, _Hb, _vb); \
        PV16_WAIT(8); pv16_mma<0, NDB>(o, _La, _Ha, pf[0][0], pf[1][0]); pv16_load<1, 0>(_La, _Ha, _vb); \
        PV16_WAIT(8); pv16_mma<4, NDB>(o, _Lb, _Hb, pf[0][0], pf[1][0]); pv16_load<1, 4>(_Lb, _Hb, _vb); \
        PV16_WAIT(8); pv16_mma<0, NDB>(o, _La, _Ha, pf[0][1], pf[1][1]); \
        PV16_WAIT(0); pv16_mma<4, NDB>(o, _Lb, _Hb, pf[0][1], pf[1][1]); \
    } else {   \
        pv16_load<0, 0>(_La, _Ha, _vb); PV16_WAIT(0); pv16_mma<0, NDB>(o, _La, _Ha, pf[0][0], pf[1][0]); \
        pv16_load<1, 0>(_La, _Ha, _vb); PV16_WAIT(0); pv16_mma<0, NDB>(o, _La, _Ha, pf[0][1], pf[1][1]); \
    } } while (0)
    f32x4 sA[4][2], sB[4][2]; bf16x8 pf[2][2];
    DMA(0); DMA(1);
    if (MODE == 2) { if (tid < 465) rpbl[tid] = a.rpb[tid] * LOG2E; }
    DMA_SYNC();
    QKT(sA, 0); PARTIAL(sA, 0);
    int bm1 = 0, bj = 1, bn = 2;
    for (int j = 1; j + 1 < NT; j += 2) {
        DMA(j + 1);
        SBAR(); QKT(sB, bj);
        FINISH(sA); SBAR();
        PV(bm1); PARTIAL(sB, j);
        DMA_SYNC();
        if (j + 2 < NT) DMA(j + 2);
        SBAR(); QKT(sA, bn);
        FINISH(sB); SBAR();
        PV(bj); PARTIAL(sA, j + 1);
        DMA_SYNC();
        { const int t0 = bm1; bm1 = bn; bn = bj; bj = t0; }
    }
    SBAR(); QKT(sB, bj);
    FINISH(sA); SBAR();
    PV(bm1); PARTIAL(sB, NT - 1);
    FINISH(sB); SBAR();
    PV(bj);
    __syncthreads();
#undef TILE_ROW
#undef DMA
#undef DMA_SYNC
#undef QKT
#undef PARTIAL
#undef FINISH
#undef PV
#undef PV16_WAIT
    const int tid_e = opaque_tid(), lane_e = tid_e & 63, ne = lane_e & 15, ge = lane_e >> 4;
    lsum0 += __shfl_xor(lsum0, 16); lsum0 += __shfl_xor(lsum0, 32); lsum1 += __shfl_xor(lsum1, 16); lsum1 += __shfl_xor(lsum1, 32);
    if (ge == 0) { li_l[ne] = fmaxf(lsum0, 1e-37f); li_l[16 + ne] = fmaxf(lsum1, 1e-37f); } LDS_WAIT();
    float rl[2][4];
#pragma unroll
    for (int qb = 0; qb < 2; ++qb)
#pragma unroll
        for (int r = 0; r < 4; ++r) rl[qb][r] = fast_rcp(li_l[qb * 16 + 4 * ge + r]);
    if (MODE != 1) {
        constexpr int OS = DV + 8;
        LAS bf16_t* ob = (LAS bf16_t*)lds;
#pragma unroll
        for (int qb = 0; qb < 2; ++qb)
#pragma unroll
            for (int r = 0; r < 4; ++r) { const int orow = wid * 32 + qb * 16 + 4 * ge + r;
#pragma unroll
                for (int db = 0; db < NDB; ++db) ob[orow * OS + db * 16 + ne] = f2bf(o[qb][db][r] * rl[qb][r]); }
        __syncthreads();
        constexpr int CPT = DV / 16;
        const int row = tid_e >> 1, c0 = (tid_e & 1) * CPT;
        bf16_t* Ow = a.O + (size_t)(a.q_row0 + row) * a.ldo + a.ocol + c0 * 8;
#pragma unroll
        for (int cc = 0; cc < CPT; ++cc) *(u32x4*)(Ow + cc * 8) = *(const LAS u32x4*)(ob + row * OS + (c0 + cc) * 8);
    } else {
        LAS float* cb = (LAS float*)lds;
        if (wmap == 1) {
#pragma unroll
            for (int qb = 0; qb < 2; ++qb)
#pragma unroll
                for (int r = 0; r < 4; ++r) { const int row = wq * 32 + qb * 16 + 4 * ge + r;
#pragma unroll
                    for (int db = 0; db < NDB; ++db) cb[row * 129 + db * 16 + ne] = a.lam * o[qb][db][r] * rl[qb][r]; }
        }
        __syncthreads();
        if (wmap == 0) {
#pragma unroll
            for (int qb = 0; qb < 2; ++qb)
#pragma unroll
                for (int r = 0; r < 4; ++r) { const int row = wq * 32 + qb * 16 + 4 * ge + r;
#pragma unroll
                    for (int db = 0; db < NDB; ++db) { const int ix = row * 129 + db * 16 + ne; cb[ix] = o[qb][db][r] * rl[qb][r] - cb[ix]; } }
        }
        __syncthreads();
        const int row = tid_e >> 2, qd = tid_e & 3;
        float v[32]; float ss = 0.f;
#pragma unroll
        for (int i = 0; i < 32; ++i) { v[i] = cb[row * 129 + qd * 32 + i]; ss += v[i] * v[i]; }
        ss += __shfl_xor(ss, 1); ss += __shfl_xor(ss, 2);
        const float rstd = rsqrtf(ss * (1.f / 128.f) + EPS) * a.oscale;
        bf16_t* Ow = a.O + (size_t)(a.q_row0 + row) * a.ldo + a.ocol + qd * 32;
        f32x4 sg[8];
#pragma unroll
        for (int i = 0; i < 8; ++i) sg[i] = *(const f32x4*)(a.subg + qd * 32 + 4 * i);
#pragma unroll
        for (int c = 0; c < 4; ++c) { float w[8];
#pragma unroll
            for (int e = 0; e < 8; ++e) w[e] = v[c * 8 + e] * rstd * sg[2 * c + (e >> 2)][e & 3];
            u32x4 pk = {cvtpk(w[0], w[1]), cvtpk(w[2], w[3]), cvtpk(w[4], w[5]), cvtpk(w[6], w[7])};
            *(u32x4*)(Ow + c * 8) = pk; }
    }
    __syncthreads();
}

__device__ __forceinline__ void sgu_unit(LAS unsigned char* lds, const bf16_t* PB, const bf16_t* Wsb, const float* bs, const float* stats, const float* sgain, bf16_t* MIX, int rowbase, int g) {
    const int tid = opaque_tid(), wid = __builtin_amdgcn_readfirstlane(tid >> 6), lane = tid & 63, r32 = lane & 31, hi = lane >> 5;
    LAS unsigned char* Vl = lds;
    u32x4 xs[4]; f32x4 sa[4][4];
    const int ch = tid & 15;
    const f32x4 g0 = *(const f32x4*)(sgain + g * 128 + ch * 8), g1 = *(const f32x4*)(sgain + g * 128 + ch * 8 + 4);
#pragma unroll
    for (int i = 0; i < 4; ++i) { const int row = (tid + 512 * i) >> 4;
        xs[i] = *(const u32x4*)(PB + (size_t)(rowbase + row) * EV_IN + 512 + g * 128 + ch * 8);
        const f32x4* st = (const f32x4*)(stats + (size_t)(rowbase + row) * 16); sa[i][0] = st[0]; sa[i][1] = st[1]; sa[i][2] = st[2]; sa[i][3] = st[3]; }
#pragma unroll
    for (int i = 0; i < 4; ++i) { const int row = (tid + 512 * i) >> 4; const u32x4 x = xs[i]; const f32x4 a0 = sa[i][0], a1 = sa[i][1], a2 = sa[i][2], a3 = sa[i][3];
        const float s1 = ((a0[0] + a0[2]) + (a1[0] + a1[2])) + ((a2[0] + a2[2]) + (a3[0] + a3[2])), s2 = ((a0[1] + a0[3]) + (a1[1] + a1[3])) + ((a2[1] + a2[3]) + (a3[1] + a3[3]));
        const float mean = s1 * (1.f / 512.f), rstd = rsqrtf(fmaxf(s2 * (1.f / 512.f) - mean * mean, 0.f) + EPS);
        u32x4 y; y.x = cvtpk((bflo(x.x) - mean) * rstd * g0[0], (bfhi(x.x) - mean) * rstd * g0[1]); y.y = cvtpk((bflo(x.y) - mean) * rstd * g0[2], (bfhi(x.y) - mean) * rstd * g0[3]);
        y.z = cvtpk((bflo(x.z) - mean) * rstd * g1[0], (bfhi(x.z) - mean) * rstd * g1[1]); y.w = cvtpk((bflo(x.w) - mean) * rstd * g1[2], (bfhi(x.w) - mean) * rstd * g1[3]);
        *(LAS u32x4*)(Vl + (row >> 6) * 16384 + v_st(row & 63, ch * 8)) = y; }
    const int prow = (wid & 3) * 32, dh = wid >> 2;
    bf16x8 pa[2][4];
#pragma unroll
    for (int kt = 0; kt < 2; ++kt)
#pragma unroll
        for (int ks = 0; ks < 4; ++ks) pa[kt][ks] = *(const bf16x8*)(Wsb + (size_t)(g * 128 + prow + r32) * 128 + kt * 64 + ks * 16 + hi * 8);
    __syncthreads();
    f32x16 o[2];
    o[0] = (f32x16){0.f, 0.f, 0.f, 0.f, 0.f, 0.f, 0.f, 0.f, 0.f, 0.f, 0.f, 0.f, 0.f, 0.f, 0.f, 0.f}; o[1] = o[0];
    const unsigned vb0 = (unsigned)(size_t)Vl + (unsigned)v_rd_base(lane);
#pragma unroll
    for (int kt = 0; kt < 2; ++kt) { const unsigned vb = vb0 + kt * 16384u;
        if (dh == 0) { pv_one<0>(o[0], vb, pa[kt][0], pa[kt][1], pa[kt][2], pa[kt][3]); pv_one<1>(o[1], vb, pa[kt][0], pa[kt][1], pa[kt][2], pa[kt][3]); }
        else { pv_one<2>(o[0], vb, pa[kt][0], pa[kt][1], pa[kt][2], pa[kt][3]); pv_one<3>(o[1], vb, pa[kt][0], pa[kt][1], pa[kt][2], pa[kt][3]); } }
    unsigned short uu[16][2]; float bb[16];
#pragma unroll
    for (int r = 0; r < 16; ++r) { const int p = prow + crow(r, hi); bb[r] = bs[g * 128 + p];
#pragma unroll
        for (int dd = 0; dd < 2; ++dd) uu[r][dd] = PB[(size_t)(rowbase + p) * EV_IN + g * 128 + (2 * dh + dd) * 32 + r32]; }
#pragma unroll
    for (int r = 0; r < 16; ++r) { const int p = prow + crow(r, hi);
#pragma unroll
        for (int dd = 0; dd < 2; ++dd) { const int d = (2 * dh + dd) * 32 + r32;
            MIX[(size_t)(rowbase + p) * DM + g * 128 + d] = f2bf(bf2f(uu[r][dd]) * (o[dd][r] + bb[r])); } }
    __syncthreads();
}
}

struct Params {
    const float* in[31];
    float* out;
    unsigned char* ws;
    int ph_lo, ph_hi;
};

struct Ctx {
    LAS unsigned char* lds;
    int tid, lane, wid, gw, NGW;
};
__device__ __forceinline__ Ctx make_ctx(LAS unsigned char* lds) { const int t = opaque_tid(), w = __builtin_amdgcn_readfirstlane(t >> 6); return Ctx{lds, t, t & 63, w, opaque_bid() * 8 + w, (int)gridDim.x * 8}; }
typedef const __attribute__((address_space(4))) Params KParams;
__device__ __forceinline__ KParams& kparams() { KParams* p = (KParams*)__builtin_amdgcn_kernarg_segment_ptr(); asm volatile("" : "+s"(p)); return *p; }

__device__ __forceinline__ bf16_t* xrow_ptr(KParams& P, int row) { return (bf16_t*)(P.ws + WS_U + U_XB) + (size_t)row * DM; }
__device__ __forceinline__ int mod_r(int row) { return row < NLAT ? (row >> 13) : 4; }
__device__ __forceinline__ f32x4 ld4(const float* p) { return *(const f32x4*)p; }
__device__ __forceinline__ f32x4 ldbf4(const bf16_t* p) { const u32x2 w = *(const u32x2*)p; return (f32x4){bflo(w.x), bfhi(w.x), bflo(w.y), bfhi(w.y)}; }
__device__ __forceinline__ void stbf4(bf16_t* p, f32x4 v) { u32x2 w; w.x = cvtpk(v[0], v[1]); w.y = cvtpk(v[2], v[3]); *(u32x2*)p = w; }
__device__ __forceinline__ float sumsq4(const f32x4 (&v)[4]) { float s = 0.f;
#pragma unroll
    for (int j = 0; j < 4; ++j) s += (v[j][0] * v[j][0] + v[j][1] * v[j][1]) + (v[j][2] * v[j][2] + v[j][3] * v[j][3]);
    return wave_sum(s); }
__device__ __forceinline__ void norm_mod(const f32x4 (&x)[4], f32x4 (&hv)[4], const float* gain, const float* shift, const float* scale, int lane) {
    const float rstd = rsqrtf(sumsq4(x) * (1.f / DM) + EPS);
#pragma unroll
    for (int j = 0; j < 4; ++j) { const int c = 4 * lane + 256 * j; const f32x4 g = ld4(gain + c), sh = ld4(shift + c), sc = ld4(scale + c);
        hv[j] = (x[j] * rstd) * g * (sc + 1.f) + sh; }
}
__device__ __forceinline__ void resid_add(f32x4 (&x)[4], const f32x4 (&y)[4], const float* gain, const float* gate, int lane) {
    const float rstd = rsqrtf(sumsq4(y) * (1.f / DM) + EPS);
#pragma unroll
    for (int j = 0; j < 4; ++j) { const int c = 4 * lane + 256 * j; const f32x4 g = ld4(gain + c), gt = ld4(gate + c);
        x[j] = x[j] + gt * ((y[j] * rstd) * g); }
}

__device__ __forceinline__ void wave_rows(const Ctx& c, int mtok, int& r0, int& r1) {
    const int bid = opaque_bid(); const int rpw = mtok / (int)gridDim.x, base = bid * rpw;
    r0 = base + (c.wid * rpw) / 8; r1 = base + ((c.wid + 1) * rpw) / 8;
    if (bid == (int)gridDim.x - 1 && c.wid == 7) r1 = mtok;
}
__device__ __forceinline__ void ld_gate(f32x4 (&G)[4], const float* gain, const float* gate, int lane) {
#pragma unroll
    for (int j = 0; j < 4; ++j) { const int cc = 4 * lane + 256 * j; G[j] = ld4(gain + cc) * ld4(gate + cc); } }
__device__ __forceinline__ void ld_mod(f32x4 (&A)[4], f32x4 (&B)[4], const float* gain, const float* shift, const float* scale, int lane) {
#pragma unroll
    for (int j = 0; j < 4; ++j) { const int cc = 4 * lane + 256 * j; A[j] = ld4(gain + cc) * (ld4(scale + cc) + 1.f); B[j] = ld4(shift + cc); } }
__device__ __forceinline__ void resid_add2(f32x4 (&x)[4], const f32x4 (&y)[4], const f32x4 (&G)[4]) {
    const float rstd = rsqrtf(sumsq4(y) * (1.f / DM) + EPS);
#pragma unroll
    for (int j = 0; j < 4; ++j) x[j] = x[j] + G[j] * (y[j] * rstd);
}
__device__ __forceinline__ void norm_mod2(const f32x4 (&x)[4], f32x4 (&hv)[4], const f32x4 (&A)[4], const f32x4 (&B)[4]) {
    const float rstd = rsqrtf(sumsq4(x) * (1.f / DM) + EPS);
#pragma unroll
    for (int j = 0; j < 4; ++j) hv[j] = (x[j] * rstd) * A[j] + B[j];
}

__device__ __forceinline__ int perm_row(int pmode, int n) {
    if (pmode == 1) { if (n >= 1024 && n < 2048) { const int d = n & 63, hb = n & ~63; return hb + ((d < 32) ? 8 * (d >> 2) + (d & 3) : 8 * ((d - 32) >> 2) + 4 + (d & 3)); } }
    else if (pmode == 2) { if (n >= 1920 && n < 1952) { const int d = n - 1920; return 1920 + ((d < 16) ? 8 * (d >> 2) + (d & 3) : 8 * ((d - 16) >> 2) + 4 + (d & 3)); } }
    return n;
}
struct TrD { const float* src; unsigned char* dst; int ldw, ldt, k0, n0, drow, pmode, f8; };
__device__ __forceinline__ TrD tr_desc(const float* W, int K, int N, unsigned char* WT, int r, int mode, int row_off, int pmode, int f8) {
    const int nblk = N / 32, kb = r / nblk, n0 = 32 * (r % nblk);
    const int drow = (mode == 0) ? row_off + n0 : (n0 >> 7) * 256 + (n0 & 127) + (mode == 2 ? 128 : 0);
    return TrD{W, WT, N, K, 64 * kb, n0, drow, pmode, f8};
}
#define TR_LOAD(v, d) do { const float* _p = (d).src + (size_t)((d).k0 + (lane >> 5)) * (d).ldw + (d).n0 + (lane & 31); \
        _Pragma("unroll") for (int _i = 0; _i < 32; ++_i) v[_i] = _p[(size_t)(2 * _i) * (d).ldw]; } while (0)
template <class F> __device__ __forceinline__ void tr_run(LAS float* scr, int lane, int first, int end, int stride, F dec) {
    if (first >= end) return;
    float v[32];
    TrD d = dec(first);
    TR_LOAD(v, d);
    for (int it = first; it < end; it += stride) {
        const TrD cur = d;
        const float sc = cur.f8 ? F8_W_SCALE : 1.f;
#pragma unroll
        for (int i = 0; i < 32; ++i) scr[(2 * i + (lane >> 5)) * 33 + (lane & 31)] = v[i] * sc;
        if (it + stride < end) { d = dec(it + stride); TR_LOAD(v, d); }
        LDS_WAIT(); asm volatile("" ::: "memory");
        const int c = lane & 7;
#pragma unroll
        for (int j = 0; j < 4; ++j) { const int n = (lane >> 3) + 8 * j; const LAS float* s = scr + (8 * c) * 33 + n;
            const int dr = cur.pmode ? perm_row(cur.pmode, cur.n0 + n) : cur.drow + n;
            const size_t eo = (size_t)dr * cur.ldt + cur.k0 + 8 * c;
            if (cur.f8) { u32x2 o; o.x = pk4_fp8(s[0 * 33], s[1 * 33], s[2 * 33], s[3 * 33]); o.y = pk4_fp8(s[4 * 33], s[5 * 33], s[6 * 33], s[7 * 33]); *(u32x2*)(cur.dst + eo) = o; }
            else { u32x4 o; o.x = cvtpk(s[0 * 33], s[1 * 33]); o.y = cvtpk(s[2 * 33], s[3 * 33]); o.z = cvtpk(s[4 * 33], s[5 * 33]); o.w = cvtpk(s[6 * 33], s[7 * 33]); *(u32x4*)(cur.dst + eo * 2) = o; } }
        LDS_WAIT(); asm volatile("" ::: "memory");
    }
}
constexpr int MOE_CVT_ITEMS = 24 * 1792;
__device__ __forceinline__ void convert_moe_items(const Ctx& c, int i, int t0, int t1, int wsel, int nsel) {
    LAS float* scr = (LAS float*)(c.lds + c.wid * 16384);
    if (wsel < 0) return;
    tr_run(scr, c.lane, t0 + wsel, t1, nsel, [i](int t) { KParams& P = kparams();
        const int mat = t / 1792, r = t % 1792, e = mat / 3, which = mat % 3;
        if (which < 2) return tr_desc(P.in[28 + which] + ((size_t)i * NEXP + e) * DM * DFFE, DM, DFFE, P.ws + WS_W13M + (size_t)e * 2 * DFFE * DM * (MOE_F8 ? 1 : 2), r, 1 + which, 0, 0, MOE_F8);
        return tr_desc(P.in[30] + ((size_t)i * NEXP + e) * DFFE * DM, DFFE, DM, P.ws + WS_W2M + (size_t)e * DM * DFFE * (MOE_F8 ? 1 : 2), r, 0, 0, 0, MOE_F8); });
}
constexpr int PI_EIN = (DM / 64) * (EV_IN / 32), PI_OUT = (DM / 64) * (DM / 32), PI_FFN = (DM / 64) * (DFF / 32), PI_OIN = (DM / 64) * (OD_IN / 32);
constexpr int PRO_ITEMS_L = PI_EIN + PI_OUT + 3 * PI_FFN + PI_OIN + PI_OUT, PRO_ITEMS = 2 * PRO_ITEMS_L;
__device__ __forceinline__ TrD pro_desc(int t) {
    KParams& P = kparams(); unsigned char* ws = P.ws;
    const int i = t / PRO_ITEMS_L; int r = t % PRO_ITEMS_L;
    if (r < PI_EIN) return tr_desc(P.in[7] + (size_t)i * DM * EV_IN, DM, EV_IN, ws + WS_WINE + (size_t)i * EV_IN * DM * 2, r, 0, 0, 1, WIN8(2 * i) ? 1 : 0);
    r -= PI_EIN;
    if (r < PI_OUT) return tr_desc(P.in[8] + (size_t)i * DM * DM, DM, DM, ws + WS_WOUTE + (size_t)i * DM * DM * 2, r, 0, 0, 0, 0);
    r -= PI_OUT;
    if (r < PI_FFN) return tr_desc(P.in[17] + (size_t)i * DM * DFF, DM, DFF, ws + WS_W13E + (size_t)i * 2 * DFF * DM * 2, r, 1, 0, 0, FFN8(i) ? 1 : 0);
    r -= PI_FFN;
    if (r < PI_FFN) return tr_desc(P.in[18] + (size_t)i * DM * DFF, DM, DFF, ws + WS_W13E + (size_t)i * 2 * DFF * DM * 2, r, 2, 0, 0, FFN8(i) ? 1 : 0);
    r -= PI_FFN;
    if (r < PI_FFN) return tr_desc(P.in[19] + (size_t)i * DFF * DM, DFF, DM, ws + WS_W2E + (size_t)i * DM * DFF * 2, r, 0, 0, 0, FFN8D(i) ? 1 : 0);
    r -= PI_FFN;
    if (r < PI_OIN) return tr_desc(P.in[20] + (size_t)i * DM * OD_IN, DM, OD_IN, ws + WS_WINO + (size_t)i * OD_INP * DM * 2, r, 0, 0, 2, WIN8(2 * i + 1) ? 1 : 0);
    r -= PI_OIN;
    return tr_desc(P.in[21] + (size_t)i * DM * DM, DM, DM, ws + WS_WOUTO + (size_t)i * DM * DM * 2, r, 0, 0, 0, 0);
}
constexpr int PRO_E0 = PI_EIN + PI_OUT + 3 * PI_FFN;
template <int CW> __device__ __forceinline__ void mods_gemv_task(const Ctx& c, int lm, int cb) {
    constexpr int LPR = CW / 4, RPL = 64 / LPR;
    KParams& P = kparams();
    LAS float* sl = (LAS float*)c.lds;
    LAS float* part = (LAS float*)(c.lds + 32768);
    __syncthreads();
    for (int i = c.tid; i < 5 * DM; i += 512) { const int r = i >> 10, k = i & 1023; const float x = r < 4 ? P.in[1][r * DM + k] : P.in[3][k]; sl[i] = x / (1.f + expf(-x)); }
    __syncthreads();
    const int sub = c.lane / LPR, lo = c.lane % LPR, n = cb * CW + 4 * lo;
    const float* W = P.in[4] + (size_t)lm * DM * (NMOD * DM) + n;
    f32x4 acc[5];
#pragma unroll
    for (int r = 0; r < 5; ++r) acc[r] = (f32x4){0.f, 0.f, 0.f, 0.f};
    const int kb = c.wid * 128 + sub;
    for (int k0 = 0; k0 < 128; k0 += 8 * RPL) {
        f32x4 wv[8];
#pragma unroll
        for (int u = 0; u < 8; ++u) wv[u] = ld4(W + (size_t)(kb + k0 + RPL * u) * (NMOD * DM));
#pragma unroll
        for (int u = 0; u < 8; ++u)
#pragma unroll
            for (int r = 0; r < 5; ++r) acc[r] += wv[u] * sl[r * DM + kb + k0 + RPL * u];
    }
#pragma unroll
    for (int r = 0; r < 5; ++r) {
#pragma unroll
        for (int m = LPR; m < 64; m <<= 1)
#pragma unroll
            for (int q = 0; q < 4; ++q) acc[r][q] += __shfl_xor(acc[r][q], m);
        if (sub == 0) *(LAS f32x4*)(part + (c.wid * 5 + r) * CW + 4 * lo) = acc[r]; }
    __syncthreads();
    for (int i = c.tid; i < 5 * CW; i += 512) { const int r = i / CW, cc = i % CW; float s = 0.f;
#pragma unroll
        for (int w = 0; w < 8; ++w) s += part[(w * 5 + r) * CW + cc];
        ((float*)(P.ws + WS_MODS))[(size_t)(lm * 5 + r) * (NMOD * DM) + cb * CW + cc] = s + P.in[5][lm * (NMOD * DM) + cb * CW + cc]; }
    __syncthreads();
}
constexpr int PRO_MOE0 = 14592;
constexpr int PRO_GEMV_WGS = NMOD * DM / 64;
__device__ __forceinline__ void prologue0(const Ctx& c_) {
    const Ctx c = make_ctx(c_.lds);
    KParams& P = kparams(); unsigned char* ws = P.ws;
    const int bid = opaque_bid();
    if (bid < PRO_GEMV_WGS) mods_gemv_task<64>(c, 0, bid);
    {
        LAS float* scr = (LAS float*)(c.lds + c.wid * 16384);
        const int G = (int)gridDim.x, ng = G < PRO_GEMV_WGS ? G : PRO_GEMV_WGS, nslots = ng * 8 + (G - ng) * 16;
        if (bid < ng) tr_run(scr, c.lane, bid * 8 + c.wid, PRO_E0, nslots, [](int t) { return pro_desc(t); });
        else { const int s0 = ng * 8 + ((bid - ng) * 8 + c.wid) * 2;
            tr_run(scr, c.lane, s0, PRO_E0, nslots, [](int t) { return pro_desc(t); });
            tr_run(scr, c.lane, s0 + 1, PRO_E0, nslots, [](int t) { return pro_desc(t); }); }
    }
    convert_moe_items(c, 0, 7296, PRO_MOE0, c.gw, c.NGW);
    const int gt = bid * 512 + c.tid, NGT = gridDim.x * 512;
    for (int i = gt; i < 2 * (OD_INP - OD_IN) * DM * 2 / 16; i += NGT) { const int per = (OD_INP - OD_IN) * DM * 2 / 16, l = i / per, r = i % per;
        const int esz = WIN8(2 * l + 1) ? 1 : 2;
        if (r * 16 < (OD_INP - OD_IN) * DM * esz) *(u32x4*)(ws + WS_WINO + (size_t)l * OD_INP * DM * 2 + (size_t)OD_IN * DM * esz + (size_t)r * 16) = (u32x4){0u, 0u, 0u, 0u}; }
    for (int i = gt; i < 2 * (MLA_K / 8) * MLA_N; i += NGT) { const int l = i / ((MLA_K / 8) * MLA_N), k8 = (i / MLA_N) % (MLA_K / 8), n = i % MLA_N, k = 8 * k8;
        float v[8];
#pragma unroll
        for (int u = 0; u < 8; ++u) v[u] = 0.f;
        if (n < 384) { if (k < 256) { const int h = n / 96, j = n % 96; int sc = n;
                if (j >= 64) { const int p = j - 64, t = p >> 3, e = p & 7; sc = h * 96 + 64 + ((e < 4) ? 4 * t + e : 16 + 4 * t + (e - 4)); }
#pragma unroll
                for (int u = 0; u < 8; ++u) v[u] = P.in[24][((size_t)l * 256 + k + u) * 384 + sc] * P.in[23][l * 256 + k + u]; } }
        else if (n < 768) { const int h = (n - 384) / 96, j = (n - 384) % 96;
            if (j < 64) { if (k >= 256 && k < 384) {
#pragma unroll
                    for (int u = 0; u < 8; ++u) v[u] = P.in[26][((size_t)l * 128 + (k + u - 256)) * 768 + h * 192 + j] * P.in[25][l * 128 + (k + u - 256)]; } }
            else {
#pragma unroll
                for (int u = 0; u < 8; ++u) if (k + u == 384 + (j - 64)) v[u] = 1.f; } }
        else { const int h = (n - 768) / 128, j = (n - 768) % 128; if (k >= 256 && k < 384) {
#pragma unroll
                for (int u = 0; u < 8; ++u) v[u] = P.in[26][((size_t)l * 128 + (k + u - 256)) * 768 + h * 192 + 64 + j] * P.in[25][l * 128 + (k + u - 256)]; } }
        u32x4 o; o.x = cvtpk(v[0], v[1]); o.y = cvtpk(v[2], v[3]); o.z = cvtpk(v[4], v[5]); o.w = cvtpk(v[6], v[7]);
        *(u32x4*)((bf16_t*)(ws + WS_WMLA) + (size_t)l * MLA_N * MLA_K + (size_t)n * MLA_K + k) = o; }
    for (int i = gt; i < 2 * 4 * 128 * 128 / 4; i += NGT) stbf4((bf16_t*)(ws + WS_SGUW) + 4 * i, ld4(P.in[9] + 4 * i));
    for (int i = gt; i < SEQ * 32; i += NGT) { const int s = i >> 5, f = i & 31; const int pos = f < 16 ? (s >> 6) : (s & 63);
        const float inv = 1.0f / powf(10000.0f, (float)(f & 15) / 16.0f); const float ang = (float)pos * inv; float sn, cs; sincosf(ang, &sn, &cs);
        ((float*)(ws + WS_ROPEB))[i] = cs; ((float*)(ws + WS_ROPEB))[SEQ * 32 + i] = sn; }
    for (int i = gt; i < SEQ * 16; i += NGT) { const int s = i >> 4, f = i & 15; const int pos = f < 8 ? (s >> 6) : (s & 63);
        const float inv = 1.0f / powf(10000.0f, (float)(f & 7) / 8.0f); const float ang = (float)pos * inv; float sn, cs; sincosf(ang, &sn, &cs);
        ((float*)(ws + WS_ROPED))[i] = cs; ((float*)(ws + WS_ROPED))[SEQ * 16 + i] = sn; }
}

__device__ __forceinline__ void convert_moe_tail(const Ctx& c_, int i, int t0, int t1, int nunits) {
    const Ctx c = make_ctx(c_.lds);
    const int G = (int)gridDim.x, rem = nunits % G, bid = opaque_bid();
    const int first = rem;
    convert_moe_items(c, i, t0, t1, bid >= first ? (bid - first) * 8 + c.wid : -1, (G - first) * 8);
}

__device__ __forceinline__ void pro_tail(const Ctx& c_, int g0, int g1, int t0, int t1, int nunits) {
    const Ctx c = make_ctx(c_.lds);
    const int G = (int)gridDim.x, rem = nunits % G, bid = opaque_bid();
    if (bid < rem) return;
    const int idx = bid - rem, nw = G - rem;
    for (int task = g0 + idx; task < g1; task += nw) mods_gemv_task<128>(c, task / 48, task % 48);
    tr_run((LAS float*)(c.lds + c.wid * 16384), c.lane, t0 + idx * 8 + c.wid, t1, nw * 8, [](int t) { return pro_desc(t); });
}

__device__ __forceinline__ void ew_first(const Ctx& c_) {
    const Ctx c = make_ctx(c_.lds);
    KParams& P = kparams(); const float* mods = (const float*)(P.ws + WS_MODS); bf16_t* HB = (bf16_t*)(P.ws + WS_HB);
    int r0, r1; wave_rows(c, MTOT, r0, r1);
    f32x4 A0[4], B0[4]; int rcur = -1;
    f32x4 xn[4];
#define EWF_LOAD(rw) do { const int _row = (rw); const float* _src = _row < NLAT ? P.in[0] + (size_t)_row * DM : P.in[2] + (size_t)(_row - NLAT) * DM; \
        _Pragma("unroll") for (int j = 0; j < 4; ++j) xn[j] = ld4(_src + 4 * c.lane + 256 * j); } while (0)
    if (r0 < r1) EWF_LOAD(r0);
    for (int row = r0; row < r1; ++row) {
        bf16_t* xr = xrow_ptr(P, row); const int r = mod_r(row);
        if (r != rcur) { rcur = r; const float* mb = mods + (size_t)(0 * 5 + r) * (NMOD * DM); ld_mod(A0, B0, P.in[6] + (0 * 4 + 0) * DM, mb + 0 * DM, mb + 1 * DM, c.lane); }
        f32x4 x[4], h[4];
#pragma unroll
        for (int j = 0; j < 4; ++j) x[j] = xn[j];
        if (row + 1 < r1) EWF_LOAD(row + 1);
#pragma unroll
        for (int j = 0; j < 4; ++j) stbf4(xr + 4 * c.lane + 256 * j, x[j]);
        norm_mod2(x, h, A0, B0);
#pragma unroll
        for (int j = 0; j < 4; ++j) stbf4(HB + (size_t)row * DM + 4 * c.lane + 256 * j, h[j]);
    }
}
#undef EWF_LOAD

__device__ __forceinline__ void moe_offsets(KParams& P, int li, int (&toff)[9]);
__device__ __forceinline__ void ew_mid(const Ctx& c_, int l, int mtok, bool dry = false, bool chained = false) {
    const Ctx c = make_ctx(c_.lds);
    KParams& P = kparams(); const float* mods = (const float*)(P.ws + WS_MODS); bf16_t* HB = (bf16_t*)(P.ws + WS_HB);
    const bf16_t* YB = (const bf16_t*)(P.ws + WS_U + U_YB);
    const bool odd = (l & 1) != 0; const int li = l >> 1;
    LAS float* wrl = (LAS float*)c.lds;
    if (odd) { for (int i = c.tid; i < DM * NEXP; i += 512) { const int col = i >> 3, e = i & 7; wrl[e * DM + col] = P.in[27][(size_t)li * DM * NEXP + i]; } __syncthreads(); }
    unsigned long long cw = 0ull; int st_e1 = 0, st_e2 = 0, st_l1 = 0, st_l2 = 0; float st_g1 = 0.f; int nrow = 0;
    int r0, r1;
    if (chained) {
        const int G = (int)gridDim.x, rem = ((mtok / 256) * (DM / 256)) % G, bid = opaque_bid();
        if (bid < rem) { const int hw = bid * 8 + c.wid, nhw = rem * 8, nctx = mtok - NLAT; r0 = NLAT + (hw * nctx) / nhw; r1 = NLAT + ((hw + 1) * nctx) / nhw; }
        else { const int lw = (bid - rem) * 8 + c.wid, nlw = (G - rem) * 8, nrow = rem > 0 ? NLAT : mtok; r0 = (int)(((long)lw * nrow) / nlw); r1 = (int)(((long)(lw + 1) * nrow) / nlw); }
        if (r0 < r1) {
            unsigned* dep = (unsigned*)(P.ws + WS_CTL) + CW_DEP + l * 16384;
            for (int mt = r0 >> 8; mt <= ((r1 - 1) >> 8); ++mt) { unsigned sp = 0;
                while ((unsigned)__builtin_amdgcn_readfirstlane((int)xb_ld(dep + mt * 64)) < (unsigned)(DM / 256)) { __builtin_amdgcn_s_sleep(1); if (++sp > (1u << 22)) break; } }
            __builtin_amdgcn_fence(__ATOMIC_ACQUIRE, "agent");
        }
    } else wave_rows(c, mtok, r0, r1);
    f32x4 G1[4], A2[4], B2[4]; int rcur = -1;
    u32x2 xa[4], ya[4], xb[4], yb[4];
#define EWM_LOAD(X, Y, rw) do { const int _row = (rw); const bf16_t* _xr = xrow_ptr(P, _row); \
        _Pragma("unroll") for (int j = 0; j < 4; ++j) { X[j] = *(const u32x2*)(_xr + 4 * c.lane + 256 * j); Y[j] = *(const u32x2*)(YB + (size_t)_row * DM + 4 * c.lane + 256 * j); } } while (0)
    if (r0 < r1) EWM_LOAD(xa, ya, r0);
    if (r0 + 1 < r1) EWM_LOAD(xb, yb, r0 + 1);
    for (int row = r0; row < r1; ++row, ++nrow) {
        bf16_t* xr = xrow_ptr(P, row); const int r = mod_r(row);
        if (r != rcur) { rcur = r; const float* mb = mods + (size_t)(l * 5 + r) * (NMOD * DM);
            ld_gate(G1, P.in[6] + (l * 4 + 1) * DM, mb + 2 * DM, c.lane); ld_mod(A2, B2, P.in[6] + (l * 4 + 2) * DM, mb + 3 * DM, mb + 4 * DM, c.lane); }
        f32x4 x[4], y[4], h[4];
#pragma unroll
        for (int j = 0; j < 4; ++j) { x[j] = (f32x4){bflo(xa[j].x), bfhi(xa[j].x), bflo(xa[j].y), bfhi(xa[j].y)}; y[j] = (f32x4){bflo(ya[j].x), bfhi(ya[j].x), bflo(ya[j].y), bfhi(ya[j].y)}; xa[j] = xb[j]; ya[j] = yb[j]; }
        if (row + 2 < r1) EWM_LOAD(xb, yb, row + 2);
        resid_add2(x, y, G1);
        bf16_t* xw = dry ? (bf16_t*)(P.ws + WS_U + U_YS) + (size_t)row * DM : xr; bf16_t* hw = (dry ? (bf16_t*)(P.ws + WS_U + U_PB) : HB) + (size_t)row * DM;
#pragma unroll
        for (int j = 0; j < 4; ++j) stbf4(xw + 4 * c.lane + 256 * j, x[j]);
        norm_mod2(x, h, A2, B2);
        if ((odd && MOE_F8) || (!odd && FFN8(li))) {
            unsigned char* h8 = (unsigned char*)(dry ? (bf16_t*)(P.ws + WS_U + U_PB) : HB) + (size_t)row * DM;
#pragma unroll
            for (int j = 0; j < 4; ++j) *(unsigned*)(h8 + 4 * c.lane + 256 * j) = pk4_fp8(h[j][0] * F8_ACT_SCALE, h[j][1] * F8_ACT_SCALE, h[j][2] * F8_ACT_SCALE, h[j][3] * F8_ACT_SCALE);
        } else {
#pragma unroll
            for (int j = 0; j < 4; ++j) stbf4(hw + 4 * c.lane + 256 * j, h[j]);
        }
        if (odd && !dry) {
            float lg[8];
#pragma unroll
            for (int e = 0; e < 8; ++e) { float sacc = 0.f;
#pragma unroll
                for (int j = 0; j < 4; ++j) { const f32x4 w = *(const LAS f32x4*)(wrl + e * DM + 4 * c.lane + 256 * j); sacc += (h[j][0] * w[0] + h[j][1] * w[1]) + (h[j][2] * w[2] + h[j][3] * w[3]); }
                lg[e] = wave_sum(sacc); }
            int e1 = 0; float v1 = lg[0];
#pragma unroll
            for (int e = 1; e < 8; ++e) if (lg[e] > v1) { v1 = lg[e]; e1 = e; }
            int e2 = -1; float v2 = -3.0e38f;
#pragma unroll
            for (int e = 0; e < 8; ++e) if (e != e1 && lg[e] > v2) { v2 = lg[e]; e2 = e; }
            if (e2 < 0) e2 = (e1 + 1) & 7;
            const float g1 = 1.f / (1.f + expf(v2 - v1));
            const int l1 = (int)((cw >> (8 * e1)) & 0xffull); cw += 1ull << (8 * e1);
            const int l2 = (int)((cw >> (8 * e2)) & 0xffull); cw += 1ull << (8 * e2);
            if (c.lane == nrow) { st_e1 = e1; st_e2 = e2; st_l1 = l1; st_l2 = l2; st_g1 = g1; }
        }
    }
    if (odd && !dry) {
        unsigned* cnt = (unsigned*)(P.ws + WS_CTL) + CW_MOECNT + li * 64;
        int base = 0;
        if (c.lane < 8) { const unsigned wc = (unsigned)((cw >> (8 * c.lane)) & 0xffull); base = wc ? (int)atomicAdd(cnt + c.lane, wc) : 0; }
        const int b1 = __shfl(base, st_e1), b2 = __shfl(base, st_e2);
#if FOLD_GATHER && MOE_F8
        __syncthreads();
        if (c.tid == 0) { unsigned* arr = (unsigned*)(P.ws + WS_CTL) + CW_ARR + li * 64; (void)xb_add(arr, 1u); unsigned sp = 0;
            while (xb_ld(arr) < (unsigned)gridDim.x) { __builtin_amdgcn_s_sleep(2); if (++sp > (1u << 22)) break; } }
        __syncthreads();
        int toff[9]; moe_offsets(P, li, toff);
        int tv = 0;
#pragma unroll
        for (int e = 0; e < 8; ++e) tv = (c.lane == e) ? toff[e] : tv;
        const int pa_l = __shfl(tv, st_e1) * 256 + b1 + st_l1, pb_l = __shfl(tv, st_e2) * 256 + b2 + st_l2;
        const unsigned char* H8 = (const unsigned char*)HB; unsigned char* HS8 = (unsigned char*)(P.ws + WS_U + U_YS);
        for (int i0 = 0; i0 < nrow; i0 += 4) {
            u32x4 vv[4];
#pragma unroll
            for (int k = 0; k < 4; ++k) { const int i = i0 + k < nrow ? i0 + k : nrow - 1; vv[k] = ((const u32x4*)(H8 + (size_t)(r0 + i) * DM))[c.lane]; }
#pragma unroll
            for (int k = 0; k < 4; ++k) { const int i = i0 + k; if (i < nrow) { const int row = r0 + i; const int pA = __shfl(pa_l, i), pB = __shfl(pb_l, i); const float g1 = __shfl(st_g1, i);
                if (c.lane == 0) ((int4*)(P.ws + WS_TOKPOS))[row] = make_int4(pA, pB, __float_as_int(g1), __float_as_int(1.f - g1));
                ((u32x4*)(HS8 + (size_t)pA * DM))[c.lane] = vv[k]; ((u32x4*)(HS8 + (size_t)pB * DM))[c.lane] = vv[k]; } } }
        __syncthreads();
#else
        if (c.lane < nrow) { const int row = r0 + c.lane; int4* ti = (int4*)(P.ws + WS_TOKINFO) + (size_t)row * 2;
            ti[0] = make_int4(st_e1, b1 + st_l1, st_e2, b2 + st_l2); ti[1] = make_int4(__float_as_int(st_g1), __float_as_int(1.f - st_g1), 0, 0); }
        __syncthreads();
#endif
    }
#undef EWM_LOAD
}

__device__ __forceinline__ void moe_offsets(KParams& P, int li, int (&toff)[9]) {
    const unsigned* cnt = (const unsigned*)(P.ws + WS_CTL) + CW_MOECNT + li * 64; int acc = 0;
    const int ln = (int)(threadIdx.x & 63u);
    const unsigned nv = __hip_atomic_load(cnt + (ln & 7), __ATOMIC_RELAXED, __HIP_MEMORY_SCOPE_AGENT);
#pragma unroll
    for (int e = 0; e < 8; ++e) { toff[e] = acc; const unsigned n = (unsigned)__builtin_amdgcn_readlane((int)nv, e); acc += (int)((n + 255u) >> 8); }
    toff[8] = acc;
}
__device__ __forceinline__ void moe_gather(const Ctx& c_, int li, int mtok) {
    const Ctx c = make_ctx(c_.lds);
    KParams& P = kparams(); int toff[9]; moe_offsets(P, li, toff);
    int tv = 0;
#pragma unroll
    for (int e = 0; e < 8; ++e) tv = (c.lane == e) ? toff[e] : tv;
    const bf16_t* HB = (const bf16_t*)(P.ws + WS_HB); bf16_t* HS = (bf16_t*)(P.ws + WS_U + U_YS);
    int r0, r1; wave_rows(c, mtok, r0, r1);
    for (int row = r0; row < r1; ++row) {
        const int4* ti = (const int4*)(P.ws + WS_TOKINFO) + (size_t)row * 2; const int4 a = ti[0], b = ti[1];
        const int pA = __shfl(tv, a.x) * 256 + a.y, pB = __shfl(tv, a.z) * 256 + a.w;
        if (c.lane == 0) ((int4*)(P.ws + WS_TOKPOS))[row] = make_int4(pA, pB, b.x, b.y);
#if MOE_F8
        const u32x4 v0 = ((const u32x4*)((const unsigned char*)HB + (size_t)row * DM))[c.lane];
        ((u32x4*)((unsigned char*)HS + (size_t)pA * DM))[c.lane] = v0; ((u32x4*)((unsigned char*)HS + (size_t)pB * DM))[c.lane] = v0;
#else
        const u32x4* src = (const u32x4*)(HB + (size_t)row * DM); const u32x4 v0 = src[c.lane], v1 = src[64 + c.lane];
        u32x4* dA = (u32x4*)(HS + (size_t)pA * DM); u32x4* dB = (u32x4*)(HS + (size_t)pB * DM);
        dA[c.lane] = v0; dA[64 + c.lane] = v1; dB[c.lane] = v0; dB[64 + c.lane] = v1;
#endif
    }
}

__device__ __forceinline__ void ew_last(const Ctx& c_, int l, int mtok, bool dry = false) {
    const Ctx c = make_ctx(c_.lds);
    KParams& P = kparams(); const float* mods = (const float*)(P.ws + WS_MODS); bf16_t* HB = (bf16_t*)(P.ws + WS_HB);
    const bf16_t* YS = (const bf16_t*)(P.ws + WS_U + U_YS); const bool odd = (l & 1) != 0;
    int r0, r1; wave_rows(c, mtok, r0, r1);
    f32x4 G3[4], A0[4], B0[4]; int rcur = -1;
    u32x2 xa[4], ya[4], za[4], xb[4], yb[4], zb[4]; float gAa = 0.f, gBa = 0.f, gAb = 0.f, gBb = 0.f;
#define EWL_LOAD(X, Y, Z, GA, GB, rw, TP) do { const int _row = (rw); const bf16_t* _xr = xrow_ptr(P, _row); \
        if (odd) { const int4 tp = (TP); GA = __int_as_float(tp.z); GB = __int_as_float(tp.w); \
            _Pragma("unroll") for (int j = 0; j < 4; ++j) { Y[j] = *(const u32x2*)(YS + (size_t)tp.x * DM + 4 * c.lane + 256 * j); Z[j] = *(const u32x2*)(YS + (size_t)tp.y * DM + 4 * c.lane + 256 * j); } } \
        else { _Pragma("unroll") for (int j = 0; j < 4; ++j) Y[j] = *(const u32x2*)(YS + (size_t)_row * DM + 4 * c.lane + 256 * j); } \
        _Pragma("unroll") for (int j = 0; j < 4; ++j) X[j] = *(const u32x2*)(_xr + 4 * c.lane + 256 * j); } while (0)
    const int4* tpos = (const int4*)(P.ws + WS_TOKPOS); const int4 tpz = make_int4(0, 0, 0, 0);
    int4 tp0 = tpz, tp1 = tpz, tpq = tpz;
    if (odd) { if (r0 < r1) tp0 = tpos[r0]; if (r0 + 1 < r1) tp1 = tpos[r0 + 1]; if (r0 + 2 < r1) tpq = tpos[r0 + 2]; }
    if (r0 < r1) EWL_LOAD(xa, ya, za, gAa, gBa, r0, tp0);
    if (r0 + 1 < r1) EWL_LOAD(xb, yb, zb, gAb, gBb, r0 + 1, tp1);
    for (int row = r0; row < r1; ++row) {
        bf16_t* xr = xrow_ptr(P, row); const int r = mod_r(row);
        if (r != rcur) { rcur = r; const float* mb = mods + (size_t)(l * 5 + r) * (NMOD * DM);
            ld_gate(G3, P.in[6] + (l * 4 + 3) * DM, mb + 5 * DM, c.lane);
            if (l < 3) { const float* mn = mods + (size_t)((l + 1) * 5 + r) * (NMOD * DM); ld_mod(A0, B0, P.in[6] + ((l + 1) * 4 + 0) * DM, mn + 0 * DM, mn + 1 * DM, c.lane); } }
        f32x4 x[4], y[4], h[4];
#pragma unroll
        for (int j = 0; j < 4; ++j) { x[j] = (f32x4){bflo(xa[j].x), bfhi(xa[j].x), bflo(xa[j].y), bfhi(xa[j].y)};
            y[j] = (f32x4){bflo(ya[j].x), bfhi(ya[j].x), bflo(ya[j].y), bfhi(ya[j].y)};
            if (odd) y[j] = y[j] * gAa + (f32x4){bflo(za[j].x), bfhi(za[j].x), bflo(za[j].y), bfhi(za[j].y)} * gBa;
            xa[j] = xb[j]; ya[j] = yb[j]; za[j] = zb[j]; }
        gAa = gAb; gBa = gBb;
        if (row + 2 < r1) EWL_LOAD(xb, yb, zb, gAb, gBb, row + 2, tpq);
        if (odd && row + 3 < r1) tpq = tpos[row + 3];
        resid_add2(x, y, G3);
        bf16_t* hw = (dry ? (bf16_t*)(P.ws + WS_U + U_MIX) : HB) + (size_t)row * DM;
        if (l == 3 && !dry) { float* ow = P.out + (size_t)row * DM;
#pragma unroll
            for (int j = 0; j < 4; ++j) *(f32x4*)(ow + 4 * c.lane + 256 * j) = x[j]; }
        else { bf16_t* xw = dry ? (bf16_t*)(P.ws + WS_U + U_PB) + (size_t)row * DM : xr;
#pragma unroll
            for (int j = 0; j < 4; ++j) stbf4(xw + 4 * c.lane + 256 * j, x[j]); }
        if (l < 3) { norm_mod2(x, h, A0, B0);
            if (WIN8(l + 1)) { unsigned char* h8 = (unsigned char*)(dry ? (bf16_t*)(P.ws + WS_U + U_MIX) : HB) + (size_t)row * DM;
#pragma unroll
                for (int j = 0; j < 4; ++j) *(unsigned*)(h8 + 4 * c.lane + 256 * j) = pk4_fp8(h[j][0] * F8_ACT_SCALE, h[j][1] * F8_ACT_SCALE, h[j][2] * F8_ACT_SCALE, h[j][3] * F8_ACT_SCALE); }
            else {
#pragma unroll
                for (int j = 0; j < 4; ++j) stbf4(hw + 4 * c.lane + 256 * j, h[j]); } }
    }
#undef EWL_LOAD
}

__device__ __forceinline__ void attn_even(const Ctx& c_, int l) {
    const Ctx c = make_ctx(c_.lds);
    KParams& P = kparams(); const int i = l >> 1; const bool need_ctx = l < 3;
    const bf16_t* PB = (const bf16_t*)(P.ws + WS_U + U_PB); bf16_t* MIX = (bf16_t*)(P.ws + WS_U + U_MIX);
    const int nchunk = need_ctx ? 264 : 256;
    const int sgu_b1 = (opaque_bid() + 1) % (int)gridDim.x, sgu_u0 = ((int)gridDim.x % 8 == 0) ? (sgu_b1 & 7) * ((int)gridDim.x >> 3) + (sgu_b1 >> 3) : sgu_b1;
    for (int u = sgu_u0; u < nchunk * 4; u += gridDim.x) att::sgu_unit(c.lds, PB, (const bf16_t*)(P.ws + WS_SGUW) + (size_t)i * 4 * 128 * 128, P.in[10] + i * 512, (const float*)(P.ws + WS_STATS), P.in[11] + i * 512, MIX, (u >> 2) * 128, u & 3);
    float d1 = 0.f, d2 = 0.f;
    if (c.lane < 64) { d1 = P.in[12][i * 64 + c.lane] * P.in[13][i * 64 + c.lane]; d2 = P.in[14][i * 64 + c.lane] * P.in[15][i * 64 + c.lane]; }
    const float lam_init = 0.8f - 0.6f * expf(-0.3f * (float)l);
    const float lam = expf(wave_sum(d1)) - expf(wave_sum(d2)) + lam_init;
    att::Args a;
    a.Q = PB; a.ldq = EV_IN; a.K = PB; a.ldk = EV_IN; a.V = PB; a.ldv = EV_IN; a.C = 0.125f * LOG2E;
    a.rcos = (const float*)(P.ws + WS_ROPEB); a.rsin = a.rcos + SEQ * 32; a.O = MIX; a.ldo = DM; a.g = 0; a.u0 = 0; a.rpb = nullptr;
    a.lam = lam; a.oscale = 1.f - lam_init; a.subg = P.in[16] + i * 128; a.nt_ctx = 4;
    const int nctxu = need_ctx ? 32 : 0, nu = nctxu + 1024;
    for (int u = xcd_unit_base(); u < nu; u += gridDim.x) {
        int b, h;
        if (u < nctxu) { b = u >> 3; h = (u >> 1) & 3; a.q_row0 = NLAT + b * CTXL + (u & 1) * 128; a.nt_lat = 0; a.rope = 0; }
        else { const int v = u - nctxu; b = v >> 8; h = (v >> 6) & 3; a.q_row0 = b * SEQ + (v & 63) * 128; a.nt_lat = SEQ / 64; a.rope = 0; }
        a.qcol = 1024 + h * 128; a.kcol = 1536 + h * 128; a.vcol = 2048 + h * 128; a.ocol = 512 + h * 128;
        a.kctx_row0 = NLAT + b * CTXL; a.klat_row0 = b * SEQ;
        att::attn_unit<64, 128, 128, 1>(c.lds, a);
    }
}
__device__ __forceinline__ void attn_odd_na(const Ctx& c_, int l) {
    const Ctx c = make_ctx(c_.lds);
    KParams& P = kparams(); const int i = l >> 1; const bool need_ctx = l < 3;
    const bf16_t* PB = (const bf16_t*)(P.ws + WS_U + U_PB); bf16_t* MIX = (bf16_t*)(P.ws + WS_U + U_MIX);
    att::Args a;
    a.Q = PB; a.ldq = OD_INP; a.K = PB; a.ldk = OD_INP; a.V = PB; a.ldv = OD_INP; a.C = 0.125f * LOG2E; a.rope = 0; a.rcos = nullptr; a.rsin = nullptr;
    a.O = MIX; a.ldo = DM; a.lam = 0.f; a.oscale = 1.f; a.subg = nullptr; a.nt_ctx = 4;
    const int nctxu = need_ctx ? 32 : 0, nu = nctxu + 1024;
    for (int u = xcd_unit_base(); u < nu; u += gridDim.x) {
        int b, h;
        if (u < nctxu) { b = u >> 3; h = u & 7; a.q_row0 = NLAT + b * CTXL; a.nt_lat = 0; a.g = 0; a.u0 = 0; a.klat_row0 = 0; }
        else { const int v = u - nctxu; b = v >> 8; h = (v >> 5) & 7; const int g = v & 31; a.g = g; a.u0 = min(max(4 * g - 4, 0), 116);
            a.q_row0 = b * SEQ + g * 256; a.nt_lat = 12; a.klat_row0 = b * SEQ + a.u0 * 64; }
        a.qcol = h * 64; a.kcol = 512 + h * 64; a.vcol = 1024 + h * 64; a.ocol = h * 64; a.kctx_row0 = NLAT + b * CTXL;
        a.rpb = P.in[22] + ((size_t)i * 8 + h) * 465;
        att::attn_unit<64, 64, 64, 2>(c.lds, a);
    }
}
__device__ __forceinline__ void attn_odd_mla(const Ctx& c_, int l) {
    const Ctx c = make_ctx(c_.lds);
    KParams& P = kparams(); const bool need_ctx = l < 3;
    const bf16_t* MO = (const bf16_t*)(P.ws + WS_U + U_MLAO); bf16_t* MIX = (bf16_t*)(P.ws + WS_U + U_MIX);
    att::Args a;
    a.Q = MO; a.ldq = MLA_N; a.K = MO; a.ldk = MLA_N; a.V = MO; a.ldv = MLA_N; a.C = 0.10206207261596575f * LOG2E;
    a.rcos = (const float*)(P.ws + WS_ROPED); a.rsin = a.rcos + SEQ * 16; a.O = MIX; a.ldo = DM; a.g = 0; a.u0 = 0; a.rpb = nullptr; a.lam = 0.f; a.oscale = 1.f; a.subg = nullptr; a.nt_ctx = 4;
    const int nctxu = need_ctx ? 16 : 0, nu = nctxu + 512;
    for (int u = xcd_unit_base(); u < nu; u += gridDim.x) {
        int b, h;
        if (u < nctxu) { b = u >> 2; h = u & 3; a.q_row0 = NLAT + b * CTXL; a.nt_lat = 0; a.rope = 0; }
        else { const int v = u - nctxu; b = v >> 7; h = (v >> 5) & 3; a.q_row0 = b * SEQ + (v & 31) * 256; a.nt_lat = SEQ / 64; a.rope = 2; }
        a.qcol = h * 96; a.kcol = 384 + h * 96; a.vcol = 768 + h * 128; a.ocol = 512 + h * 128; a.kctx_row0 = NLAT + b * CTXL; a.klat_row0 = b * SEQ;
        att::attn_unit<96, 96, 128, 0>(c.lds, a);
    }
}

constexpr int N_PHASES = 2 + 2 * (7 + 9) - ((FOLD_GATHER && MOE_F8) ? 2 : 0);
__global__ void __launch_bounds__(512, 2) fwd_kernel(Params prm) {
    extern __shared__ __attribute__((aligned(16))) unsigned char lds_raw[];
    LAS unsigned char* lds = (LAS unsigned char*)lds_raw;
    const Ctx c{lds, 0, 0, 0, 0, 0};
    for (int u = threadIdx.x; u < (LDS_BYTES - LDS_MISC) / 4; u += 512) ((LAS unsigned*)(lds + LDS_MISC))[u] = 0u;
    __syncthreads();
    XcdBarrier bar;
    { unsigned char* ws0 = kparams().ws; bar.bar = (unsigned*)(ws0 + WS_CTL) + CW_BAR; bar.x = 0; bar.st = nullptr;
#if !MK_PER_PHASE
      bar = xcd_barrier_post((unsigned*)(ws0 + WS_CTL) + CW_BAR, (volatile LAS unsigned*)(lds + LDS_MISC + 32));
#endif
    }
    int ph = 0;
#ifndef PMASK
#define PMASK 0xffffffffu
#endif
#define PM(b) ((PMASK >> (b)) & 1u)
#define PH_ON() (ph >= kparams().ph_lo && ph < kparams().ph_hi)
#define PH_END() do { if (ph >= kparams().ph_lo && ph + 1 < kparams().ph_hi) xcd_barrier(bar); ++ph; } while (0)
#define PH_END_IF(cond) do { if ((cond) && ph >= kparams().ph_lo && ph + 1 < kparams().ph_hi) xcd_barrier(bar); ++ph; } while (0)
#define CHAIN(l) (CHAIN_WOUT && (l) < 4)
#define WSP(off) ((bf16_t*)(ws + (off)))
#define HB WSP(WS_HB)
#define PB WSP(WS_U + U_PB)
#define MIX WSP(WS_U + U_MIX)
#define YB WSP(WS_U + U_YB)
#define HID WSP(WS_U + U_HID)
#define YS WSP(WS_U + U_YS)
#define A2 WSP(WS_U + U_A2)
#define MO WSP(WS_U + U_MLAO)

    if (PM(0) && PH_ON()) for (int rep = 0; rep < DUPN(0); ++rep) { prologue0(c); __syncthreads(); }
    PH_END();
    if (PM(1) && PH_ON()) for (int rep = 0; rep < DUPN(1); ++rep) ew_first(c);
    PH_END();
    for (int lp = 0; lp < 2; ++lp) {
        {
            const int l = 2 * lp, i = lp; const int mtok = l < 3 ? MTOT : NLAT, nMt = mtok / 256;
            if (PM(2) && PH_ON()) for (int rep = 0; rep < DUPN(2); ++rep) { unsigned char* ws = kparams().ws; pg8::Gemm g{}; g.A = HB; g.lda = DM; g.Bt = (const unsigned char*)(ws + WS_WINE) + (size_t)i * EV_IN * DM * 2; g.K = DM; g.nM = MTOT / 256; g.nN = EV_IN / 256; g.grouped = 0; g.estride = 0;
                pg8::EpiEvenIn E{PB, EV_IN, (f32x2*)(ws + WS_STATS), (const float*)(ws + WS_ROPEB), (const float*)(ws + WS_ROPEB) + SEQ * 32, WIN8(l) ? F8_INV : 1.f}; if (WIN8(l)) gemm8_even_in(lds, g, E); else gemm_even_in(lds, g, E); if (rep == 0) { pro_tail(c, lp == 0 ? 48 : 0, lp == 0 ? 96 : 0, lp == 0 ? PRO_E0 : 0, lp == 0 ? PRO_ITEMS_L : 0, (MTOT / 256) * (EV_IN / 256)); convert_moe_tail(c, i, 0, 7296, (MTOT / 256) * (EV_IN / 256)); } }
            PH_END();
            if (PM(4) && PH_ON()) for (int rep = 0; rep < DUPN(4); ++rep) attn_even(c, l);
            PH_END();
            if (PM(5) && PH_ON()) for (int rep = 0; rep < DUPN(5); ++rep) { unsigned char* ws = kparams().ws; pg8::Gemm g{}; g.A = MIX; g.lda = DM; g.Bt = (const bf16_t*)(ws + WS_WOUTE) + (size_t)i * DM * DM; g.K = DM; g.nM = nMt; g.nN = DM / 256; g.grouped = 0; g.estride = 0;
                if (CHAIN(l)) { g.sig = (unsigned*)(ws + WS_CTL) + CW_DEP + l * 16384; g.nMl = NLAT / 256; }
                gemm_bf16(lds, g, YB, DM, CHAIN(l) ? 1 : 0); if (rep == 0) convert_moe_tail(c, i, lp == 0 ? 14592 : 7296, 14592, nMt * (DM / 256)); }
            PH_END_IF(!CHAIN(l));
            if (PM(6) && PH_ON()) { if (DUPN(6) > 1) ew_mid(c, l, mtok, true); ew_mid(c, l, mtok, false, CHAIN(l)); }
            PH_END();
            if (PM(7) && PH_ON()) for (int rep = 0; rep < DUPN(7); ++rep) { unsigned char* ws = kparams().ws; pg8::Gemm g{}; g.A = HB; g.lda = DM; g.Bt = (const unsigned char*)(ws + WS_W13E) + (size_t)i * 2 * DFF * DM * 2; g.K = DM; g.nM = nMt; g.nN = 2 * DFF / 256; g.grouped = 0; g.estride = 0;
                if (FFN8(i)) gemm8_swiglu8(lds, g, (unsigned char*)HID, DFF); else if (FFN8D(i)) gemm_swiglu_to8(lds, g, (unsigned char*)HID, DFF); else gemm_swiglu(lds, g, HID, DFF);
                if (rep == 0) convert_moe_tail(c, i, 14592, 20224, nMt * (2 * DFF / 256)); }
            PH_END();
            if (PM(8) && PH_ON()) for (int rep = 0; rep < DUPN(8); ++rep) { unsigned char* ws = kparams().ws; pg8::Gemm g{}; g.A = HID; g.lda = DFF; g.Bt = (const unsigned char*)(ws + WS_W2E) + (size_t)i * DM * DFF * 2; g.K = DFF; g.nM = nMt; g.nN = DM / 256; g.grouped = 0; g.estride = 0;
                if (FFN8D(i)) gemm8_bf16(lds, g, YS, DM); else gemm_bf16(lds, g, YS, DM);
                if (rep == 0) convert_moe_tail(c, i, 20224, MOE_CVT_ITEMS, nMt * (DM / 256)); }
            PH_END();
            if (PM(9) && PH_ON()) { if (DUPN(9) > 1) ew_last(c, l, mtok, true); ew_last(c, l, mtok); }
            PH_END();
        }
        {
            const int l = 2 * lp + 1, i = lp; const int mtok = l < 3 ? MTOT : NLAT, nMt = mtok / 256;
            if (PM(10) && PH_ON()) for (int rep = 0; rep < DUPN(10); ++rep) { unsigned char* ws = kparams().ws; pg8::Gemm g{}; g.A = HB; g.lda = DM; g.Bt = (const unsigned char*)(ws + WS_WINO) + (size_t)i * OD_INP * DM * 2; g.K = DM; g.nM = MTOT / 256; g.nN = OD_INP / 256; g.grouped = 0; g.estride = 0;
                pg8::EpiOddIn E{PB, OD_INP, (float*)(ws + WS_STATS), (const float*)(ws + WS_ROPED), (const float*)(ws + WS_ROPED) + SEQ * 16, WIN8(l) ? F8_INV : 1.f}; if (WIN8(l)) gemm8_odd_in(lds, g, E); else gemm_odd_in(lds, g, E);
                if (rep == 0) pro_tail(c, lp == 0 ? 96 : 0, lp == 0 ? 192 : 0, lp == 0 ? PRO_ITEMS_L : 0, lp == 0 ? PRO_ITEMS_L + 3500 : 0, (MTOT / 256) * (OD_INP / 256)); }
            PH_END();
            if (PM(12) && PH_ON()) for (int rep = 0; rep < DUPN(12); ++rep) { unsigned char* ws = kparams().ws; pg8::Gemm g{}; g.A = PB + 1536; g.lda = OD_INP; g.Bt = (const bf16_t*)(ws + WS_WMLA) + (size_t)i * MLA_N * MLA_K; g.K = MLA_K; g.nM = MTOT / 256; g.nN = MLA_N / 256; g.grouped = 0; g.estride = 0;
                pg8::EpiMlaUp E{MO, MLA_N, (const float*)(ws + WS_STATS)}; gemm_mla_up(lds, g, E); }
            PH_END();
            if (PH_ON()) { if (PM(13)) for (int rep = 0; rep < DUPN(13); ++rep) attn_odd_na(c, l); if (PM(14)) for (int rep = 0; rep < DUPN(14); ++rep) attn_odd_mla(c, l); }
            PH_END();
            if (PM(15) && PH_ON()) for (int rep = 0; rep < DUPN(15); ++rep) { unsigned char* ws = kparams().ws; pg8::Gemm g{}; g.A = MIX; g.lda = DM; g.Bt = (const bf16_t*)(ws + WS_WOUTO) + (size_t)i * DM * DM; g.K = DM; g.nM = nMt; g.nN = DM / 256; g.grouped = 0; g.estride = 0;
                if (CHAIN(l)) { g.sig = (unsigned*)(ws + WS_CTL) + CW_DEP + l * 16384; g.nMl = NLAT / 256; }
                gemm_bf16(lds, g, YB, DM, CHAIN(l) ? 1 : 0); }
            PH_END_IF(!CHAIN(l));
            if (PM(16) && PH_ON()) { if (DUPN(16) > 1) ew_mid(c, l, mtok, true); ew_mid(c, l, mtok, false, CHAIN(l)); }
            PH_END();
#if !(FOLD_GATHER && MOE_F8)
            if (PM(17) && PH_ON()) for (int rep = 0; rep < DUPN(17); ++rep) moe_gather(c, i, mtok);
            PH_END();
#endif
            if (PM(18) && PH_ON()) for (int rep = 0; rep < DUPN(18); ++rep) { unsigned char* ws = kparams().ws; pg8::Gemm g{}; g.A = YS; g.lda = DM; g.Bt = (const bf16_t*)(ws + WS_W13M); g.K = DM; g.nN = 2 * DFFE / 256; g.grouped = 1; g.estride = (size_t)2 * DFFE * DM;
                moe_offsets(kparams(), i, g.toff); g.nM = g.toff[8];
#if MOE_F8
                gemm8_swiglu8(lds, g, (unsigned char*)HID, DFFE);
#else
                gemm_swiglu(lds, g, HID, DFFE);
#endif
            }
            PH_END();
            if (PM(19) && PH_ON()) for (int rep = 0; rep < DUPN(19); ++rep) { unsigned char* ws = kparams().ws; pg8::Gemm g{}; g.A = HID; g.lda = DFFE; g.Bt = (const bf16_t*)(ws + WS_W2M); g.K = DFFE; g.nN = DM / 256; g.grouped = 1; g.estride = (size_t)DM * DFFE;
                moe_offsets(kparams(), i, g.toff); g.nM = g.toff[8];
#if MOE_F8
                gemm8_bf16(lds, g, YS, DM);
#else
                gemm_bf16(lds, g, YS, DM);
#endif
                if (rep == 0) pro_tail(c, 0, 0, lp == 0 ? PRO_ITEMS_L + 3500 : 0, lp == 0 ? PRO_ITEMS : 0, g.nM * (DM / 256));
            }
            PH_END();
            if (PM(20) && PH_ON()) { if (DUPN(20) > 1) ew_last(c, l, mtok, true); ew_last(c, l, mtok); }
            PH_END();
        }
    }
#undef PH_ON
#undef PH_END
#undef HB
#undef PB
#undef MIX
#undef YB
#undef HID
#undef YS
#undef A2
#undef MO
}

extern "C" void kernel_launch(void* const* d_in, const int* in_sizes, int n_in, void* d_out, int out_size, void* d_ws, size_t ws_size, hipStream_t stream) {
    static int grid = 0;
    if (grid == 0) {
        int dev = 0, cus = 0;
        if (n_in != 31 || out_size != NLAT * DM || ws_size < WS_END) { fprintf(stderr, "kernel_launch: unexpected shapes or workspace (n_in %d out %d ws %zu need %zu)\n", n_in, out_size, ws_size, (size_t)WS_END); grid = -1; }
        else if (hipGetDevice(&dev) != hipSuccess || hipDeviceGetAttribute(&cus, hipDeviceAttributeMultiprocessorCount, dev) != hipSuccess) grid = -1;
        else if (hipFuncSetAttribute((const void*)fwd_kernel, hipFuncAttributeMaxDynamicSharedMemorySize, LDS_BYTES) != hipSuccess) grid = -1;
        else { int per_cu = 0; (void)hipOccupancyMaxActiveBlocksPerMultiprocessor(&per_cu, (const void*)fwd_kernel, 512, LDS_BYTES); (void)hipGetLastError(); grid = cus; }
    }
    if (grid < 0) { (void)hipMemsetAsync(d_out, 0, (size_t)out_size * 4, stream); return; }
    (void)hipMemsetAsync((char*)d_ws + WS_CTL, 0, CTL_BYTES, stream);
    Params p{};
    for (int i = 0; i < 31; ++i) p.in[i] = (const float*)d_in[i];
    p.out = (float*)d_out; p.ws = (unsigned char*)d_ws;
#if MK_PER_PHASE
    for (int k = 0; k < N_PHASES; ++k) { p.ph_lo = k; p.ph_hi = k + 1; hipLaunchKernelGGL(fwd_kernel, dim3(grid), dim3(512), LDS_BYTES, stream, p); }
#else
    p.ph_lo = 0; p.ph_hi = N_PHASES;
    hipLaunchKernelGGL(fwd_kernel, dim3(grid), dim3(512), LDS_BYTES, stream, p);
#endif
}
```
